# Optimizing an MI355X kernel written in HIP

```python
import math
import jax, jax.numpy as jnp
from jax import lax
import numpy as np

D_MODEL = 1024
BATCH = 4
SEQ = 4096
DEPTH = 4

D_MIX = D_MODEL
N_MIXERS = 4
GROUP_W = D_MIX // N_MIXERS
HEAD_DIM = 64
N_HEADS_G = GROUP_W // HEAD_DIM
SSD_STATE = 128
SSD_CONV = 4
SSD_CHUNK = 128
RWKV_DECAY_LORA = 32
RWKV_A_LORA = 32
RWKV_GATE_LORA = 64
RWKV_GN_EPS = 64e-5
GLA_DK = GROUP_W // 2
GLA_HEAD_K = GLA_DK // N_HEADS_G
GLA_GATE_LORA = 16
GLA_GATE_TAU = 16.0
GLA_CHUNK = 64
MLSTM_CONV = 4
MLSTM_CHUNK = 64
N_EXPERTS = 32
TOP_K = 4
D_EXPERT = D_MODEL
SWIGLU_LIMIT = 7.0
SWIGLU_ALPHA = 1.702
EXPERT_BLOCK = 128
PLE_DIM = 256
DEEPNORM_ALPHA = (2 * DEPTH) ** 0.25
DEEPNORM_BETA = (8 * DEPTH) ** -0.25
LN_EPS = 1e-5
NORM_EPS = 1e-5

SSD_SPLITS = (GROUP_W, GROUP_W, SSD_STATE, SSD_STATE, N_HEADS_G)
RWKV_SPLITS = (GROUP_W, GROUP_W, GROUP_W, RWKV_DECAY_LORA, RWKV_A_LORA, RWKV_GATE_LORA)
GLA_SPLITS = (GLA_DK, GLA_DK, GROUP_W, GLA_GATE_LORA, GROUP_W)
MLSTM_SPLITS = (GROUP_W, GROUP_W, GROUP_W, N_HEADS_G, N_HEADS_G, GROUP_W)
SSD_W = sum(SSD_SPLITS)
RWKV_W = sum(RWKV_SPLITS)
GLA_W = sum(GLA_SPLITS)
MLSTM_W = sum(MLSTM_SPLITS)
D_IN_PROJ = SSD_W + RWKV_W + GLA_W + MLSTM_W

kernel_name = "hybrid_ssd_rwkv7_gla_mlstm_moe_deepnorm"


def _split(u, sizes):
    idx = np.cumsum(sizes)[:-1].tolist()
    return jnp.split(u, idx, axis=-1)


def _causal_mask(n):
    return jnp.tril(jnp.ones((n, n), dtype=bool))


def _causal_dwconv(u, w, b):
    k, c = w.shape
    y = lax.conv_general_dilated(u, w[:, None, :].astype(u.dtype), window_strides=(1,),
                                 padding=[(k - 1, 0)], dimension_numbers=("NWC", "WIO", "NWC"),
                                 feature_group_count=c)
    return y + b


def _token_shift(u):
    return jnp.pad(u, ((0, 0), (1, 0), (0, 0)))[:, :-1]


def _heads(u, n_heads):
    return u.reshape(*u.shape[:-1], n_heads, u.shape[-1] // n_heads)


def _to_chunks(u, size):
    b, s, h = u.shape[:3]
    u = u.reshape(b, s // size, size, h, *u.shape[3:])
    return jnp.moveaxis(u, 3, 1)


def _from_chunks(y):
    y = jnp.moveaxis(y, 1, 3)
    return y.reshape(y.shape[0], y.shape[1] * y.shape[2], *y.shape[3:])


def _chunk_states(decay, contrib):
    d = jnp.moveaxis(decay, 2, 0)
    u = jnp.moveaxis(contrib, 2, 0)

    def step(s, inp):
        dc, uc = inp
        return dc * s + uc, s

    _, prev = lax.scan(step, jnp.zeros_like(u[0]), (d, u))
    return jnp.moveaxis(prev, 0, 2)


def _layer_norm(x, g, b):
    xf = x.astype(jnp.float32)
    mu = jnp.mean(xf, -1, keepdims=True)
    xc = xf - mu
    var = jnp.mean(xc * xc, -1, keepdims=True)
    return (xc * lax.rsqrt(var + LN_EPS) * g + b).astype(x.dtype)


def _group_norm(y, n_heads, gain, bias, eps, center):
    yf = _heads(y.astype(jnp.float32), n_heads)
    if center:
        yf = yf - jnp.mean(yf, -1, keepdims=True)
    yf = yf * lax.rsqrt(jnp.mean(yf * yf, -1, keepdims=True) + eps)
    yf = yf.reshape(y.shape) * gain
    if bias is not None:
        yf = yf + bias
    return yf


def _ssd_mixer(u, conv_w, conv_b, a_log, dt_bias, d_skip, norm_g):
    bsz, seq, _ = u.shape
    z, xr, bm, cm, dt = _split(u, SSD_SPLITS)
    xbc = jax.nn.silu(_causal_dwconv(jnp.concatenate([xr, bm, cm], -1), conv_w, conv_b))
    xs, bm, cm = _split(xbc, (GROUP_W, SSD_STATE, SSD_STATE))
    xs = _heads(xs, N_HEADS_G)
    dt = jax.nn.softplus(dt + dt_bias)
    nc = seq // SSD_CHUNK
    xc = _to_chunks(xs * dt[..., None], SSD_CHUNK)
    adt = _to_chunks(dt * (-jnp.exp(a_log)), SSD_CHUNK)
    bc = bm.reshape(bsz, nc, SSD_CHUNK, SSD_STATE)
    cc = cm.reshape(bsz, nc, SSD_CHUNK, SSD_STATE)
    acum = jnp.cumsum(adt, axis=-1)
    lmat = jnp.exp(jnp.where(_causal_mask(SSD_CHUNK), acum[..., :, None] - acum[..., None, :], -jnp.inf))
    y_diag = jnp.einsum("bcln,bcsn,bhcls,bhcsp->bhclp", cc, bc, lmat, xc)
    decay_states = jnp.exp(acum[..., -1:] - acum)
    states = jnp.einsum("bcsn,bhcs,bhcsp->bhcpn", bc, decay_states, xc)
    prev = _chunk_states(jnp.exp(acum[..., -1])[..., None, None], states)
    y_off = jnp.einsum("bcln,bhcpn,bhcl->bhclp", cc, prev, jnp.exp(acum))
    y = _from_chunks(y_diag + y_off) + xs * d_skip[:, None]
    y = y.reshape(bsz, seq, GROUP_W) * jax.nn.silu(z)
    return _group_norm(y, 1, norm_g, None, NORM_EPS, center=False)


def _rwkv7_mixer(u, mu, w0, w_up, a0, a_up, g_up, k_k, k_a, r_k, ln_g, ln_b):
    bsz, seq, _ = u.shape
    u = u + (_token_shift(u) - u) * mu
    r, k, v, wd, ad, gd = _split(u, RWKV_SPLITS)
    w = -jax.nn.softplus(-(w0 + jnp.tanh(wd) @ w_up)) - 0.5
    decay = jnp.exp(-jnp.exp(w))
    a = jax.nn.sigmoid(a0 + ad @ a_up)
    g = jax.nn.sigmoid(gd) @ g_up
    kk = _heads(k * k_k, N_HEADS_G)
    kk = kk / jnp.maximum(jnp.linalg.norm(kk, axis=-1, keepdims=True), 1e-12)
    k = k * (1.0 + (a - 1.0) * k_a)
    rh, wh, kh, vh, ah = (_heads(t, N_HEADS_G) for t in (r, decay, k, v, a))
    seq_major = [jnp.moveaxis(t, 1, 0) for t in (rh, wh, kh, vh, -kk, kk * ah)]

    def step(state, inp):
        r_t, w_t, k_t, v_t, a_t, b_t = inp
        sa = jnp.einsum("bhvk,bhk->bhv", state, a_t)
        state = (state * w_t[:, :, None, :] + sa[..., None] * b_t[:, :, None, :]
                 + v_t[..., None] * k_t[:, :, None, :])
        return state, jnp.einsum("bhvk,bhk->bhv", state, r_t)

    s0 = jnp.zeros((bsz, N_HEADS_G, HEAD_DIM, HEAD_DIM), rh.dtype)
    _, o = lax.scan(step, s0, tuple(seq_major))
    o = jnp.moveaxis(o, 0, 1).reshape(bsz, seq, GROUP_W)
    o = _group_norm(o, N_HEADS_G, ln_g, ln_b, RWKV_GN_EPS, center=True)
    bonus = jnp.sum(rh * kh * r_k, -1, keepdims=True) * vh
    return (o + bonus.reshape(bsz, seq, GROUP_W)) * g


def _gla_mixer(u, gate_up, gate_b, norm_g):
    bsz, seq, _ = u.shape
    q, k, v, gd, og = _split(u, GLA_SPLITS)
    log_a = jax.nn.log_sigmoid(gd @ gate_up + gate_b) / GLA_GATE_TAU
    qc = _to_chunks(_heads(q, N_HEADS_G), GLA_CHUNK) * GLA_HEAD_K ** -0.5
    kc = _to_chunks(_heads(k, N_HEADS_G), GLA_CHUNK)
    vc = _to_chunks(_heads(v, N_HEADS_G), GLA_CHUNK)
    bcum = jnp.cumsum(_to_chunks(_heads(log_a, N_HEADS_G), GLA_CHUNK), axis=3)
    q_dec = qc * jnp.exp(bcum)
    k_inv = kc * jnp.exp(-bcum)
    attn = jnp.where(_causal_mask(GLA_CHUNK), jnp.einsum("bhctd,bhcsd->bhcts", q_dec, k_inv), 0.0)
    o_intra = jnp.einsum("bhcts,bhcsv->bhctv", attn, vc)
    b_last = bcum[..., -1, :]
    contrib = jnp.einsum("bhcsd,bhcsv->bhcdv", kc * jnp.exp(b_last[..., None, :] - bcum), vc)
    prev = _chunk_states(jnp.exp(b_last)[..., None], contrib)
    o_inter = jnp.einsum("bhctd,bhcdv->bhctv", q_dec, prev)
    o = _from_chunks(o_intra + o_inter).reshape(bsz, seq, GROUP_W)
    return _group_norm(o, N_HEADS_G, norm_g, None, NORM_EPS, center=False) * jax.nn.silu(og)


def _mlstm_mixer(u, conv_w, conv_b, i_b, f_b, norm_g):
    bsz, seq, _ = u.shape
    q, k, v, ig, fg, og = _split(u, MLSTM_SPLITS)
    q, k = _split(jax.nn.silu(_causal_dwconv(jnp.concatenate([q, k], -1), conv_w, conv_b)), (GROUP_W, GROUP_W))
    qc = _to_chunks(_heads(q, N_HEADS_G), MLSTM_CHUNK) * HEAD_DIM ** -0.5
    kc = _to_chunks(_heads(k, N_HEADS_G), MLSTM_CHUNK)
    vc = _to_chunks(_heads(v, N_HEADS_G), MLSTM_CHUNK)
    i_pre = _to_chunks(ig + i_b, MLSTM_CHUNK)
    b = jnp.cumsum(_to_chunks(jax.nn.log_sigmoid(fg + f_b), MLSTM_CHUNK), axis=-1)
    b_last = b[..., -1]
    dmat = jnp.where(_causal_mask(MLSTM_CHUNK), b[..., :, None] - b[..., None, :] + i_pre[..., None, :], -jnp.inf)
    a_st = b_last[..., None] - b + i_pre
    m_loc = jnp.max(a_st, -1)
    w_st = jnp.exp(a_st - m_loc[..., None])
    c_contrib = jnp.einsum("bhcs,bhcsv,bhcsk->bhcvk", w_st, vc, kc)
    n_contrib = jnp.einsum("bhcs,bhcsk->bhck", w_st, kc)

    def step(carry, inp):
        c_s, n_s, m_s = carry
        bl, ml, cu, nu = inp
        m_new = jnp.maximum(bl + m_s, ml)
        s_old = jnp.exp(bl + m_s - m_new)
        s_new = jnp.exp(ml - m_new)
        c_new = s_old[..., None, None] * c_s + s_new[..., None, None] * cu
        n_new = s_old[..., None] * n_s + s_new[..., None] * nu
        return (c_new, n_new, m_new), (c_s, n_s, m_s)

    init = (jnp.zeros_like(c_contrib[:, :, 0]), jnp.zeros_like(n_contrib[:, :, 0]), jnp.zeros_like(b_last[:, :, 0]))
    xs = tuple(jnp.moveaxis(t, 2, 0) for t in (b_last, m_loc, c_contrib, n_contrib))
    _, (c_prev, n_prev, m_prev) = lax.scan(step, init, xs)
    c_prev, n_prev, m_prev = (jnp.moveaxis(t, 0, 2) for t in (c_prev, n_prev, m_prev))
    m_inter = b + m_prev[..., None]
    m_row = jnp.maximum(m_inter, jnp.max(dmat, -1))
    w_inter = jnp.exp(m_inter - m_row)
    scores = jnp.einsum("bhctk,bhcsk->bhcts", qc, kc) * jnp.exp(dmat - m_row[..., None])
    num = (w_inter[..., None] * jnp.einsum("bhcvk,bhctk->bhctv", c_prev, qc)
           + jnp.einsum("bhcts,bhcsv->bhctv", scores, vc))
    den = w_inter * jnp.einsum("bhck,bhctk->bhct", n_prev, qc) + jnp.sum(scores, -1)
    h = num / jnp.maximum(jnp.abs(den), jnp.exp(-m_row))[..., None]
    h = _from_chunks(h).reshape(bsz, seq, GROUP_W) * jax.nn.sigmoid(og)
    return _group_norm(h, N_HEADS_G, norm_g, None, NORM_EPS, center=True)


def _moe_ffn(x2d, router_w, router_b, w_gu, b_gu, w_down, b_down):
    t, d = x2d.shape
    n_assign = t * TOP_K
    logits = (x2d @ router_w + router_b).astype(jnp.float32)
    top_val, top_idx = lax.top_k(logits, TOP_K)
    gate = jax.nn.softmax(top_val, axis=-1)
    flat_e = top_idx.reshape(-1)
    flat_tok = jnp.arange(n_assign, dtype=jnp.int32) // TOP_K
    order = jnp.argsort(flat_e)
    e_s, tok_s, g_s = flat_e[order], flat_tok[order], gate.reshape(-1)[order]
    counts = jnp.zeros((N_EXPERTS,), jnp.int32).at[flat_e].add(1)
    padded = (counts + EXPERT_BLOCK - 1) // EXPERT_BLOCK * EXPERT_BLOCK
    start = jnp.cumsum(counts) - counts
    pend = jnp.cumsum(padded)
    pstart = pend - padded
    dest = pstart[e_s] + (jnp.arange(n_assign, dtype=jnp.int32) - start[e_s])
    n_blocks = (n_assign + N_EXPERTS * (EXPERT_BLOCK - 1) + EXPERT_BLOCK - 1) // EXPERT_BLOCK
    n_rows = n_blocks * EXPERT_BLOCK
    row_tok = jnp.full((n_rows,), t, jnp.int32).at[dest].set(tok_s)
    row_gate = jnp.zeros((n_rows,), jnp.float32).at[dest].set(g_s)
    block_expert = jnp.minimum(jnp.searchsorted(pend, jnp.arange(n_blocks) * EXPERT_BLOCK, side="right"),
                               N_EXPERTS - 1)
    x_pad = jnp.concatenate([x2d, jnp.zeros((1, d), x2d.dtype)], 0)
    xb = x_pad[row_tok].reshape(n_blocks, EXPERT_BLOCK, d)

    def expert_block(args):
        xblk, e = args
        hg, hl = jnp.split(xblk @ w_gu[e] + b_gu[e], 2, axis=-1)
        hg = jnp.minimum(hg, SWIGLU_LIMIT)
        hl = jnp.clip(hl, -SWIGLU_LIMIT, SWIGLU_LIMIT)
        glu = hg * jax.nn.sigmoid(hg * SWIGLU_ALPHA)
        return ((hl + 1.0) * glu) @ w_down[e] + b_down[e]

    yb = lax.map(expert_block, (xb, block_expert)).reshape(n_rows, d)
    y = (yb * row_gate[:, None]).astype(x2d.dtype)
    return jnp.zeros((t + 1, d), x2d.dtype).at[row_tok].add(y)[:t]


def setup_inputs(seed: int = 0) -> dict:
    key = jax.random.key(seed)
    ks = iter(jax.random.split(key, 64))
    f32 = jnp.float32
    L, W, H = DEPTH, GROUP_W, N_HEADS_G

    def nrm(shape, scale):
        return scale * jax.random.normal(next(ks), shape, f32)

    def uni(shape, lo, hi):
        return jax.random.uniform(next(ks), shape, f32, lo, hi)

    dt0 = jnp.exp(uni((L, H), math.log(1e-3), math.log(1e-1)))
    return {
        "x": nrm((BATCH, SEQ, D_MODEL), 1.0),
        "p": nrm((DEPTH, BATCH, SEQ, PLE_DIM), 1.0),
        "w_in": nrm((L, D_MODEL, D_IN_PROJ), D_MODEL ** -0.5),
        "w_out": nrm((L, D_MIX, D_MODEL), DEEPNORM_BETA * D_MIX ** -0.5),
        "ln1_g": 1.0 + nrm((L, D_MODEL), 0.02),
        "ln1_b": nrm((L, D_MODEL), 0.02),
        "ssd_conv_w": nrm((L, SSD_CONV, W + 2 * SSD_STATE), SSD_CONV ** -0.5),
        "ssd_conv_b": nrm((L, W + 2 * SSD_STATE), 0.02),
        "ssd_a_log": jnp.log(uni((L, H), 1.0, 16.0)),
        "ssd_dt_bias": dt0 + jnp.log(-jnp.expm1(-dt0)),
        "ssd_d": 1.0 + nrm((L, H), 0.1),
        "ssd_norm_g": 1.0 + nrm((L, W), 0.02),
        "rwkv_mu": uni((L, RWKV_W), 0.0, 1.0),
        "rwkv_w0": uni((L, W), -6.0, -1.0),
        "rwkv_w_up": nrm((L, RWKV_DECAY_LORA, W), 0.5 * RWKV_DECAY_LORA ** -0.5),
        "rwkv_a0": nrm((L, W), 0.1),
        "rwkv_a_up": nrm((L, RWKV_A_LORA, W), RWKV_A_LORA ** -0.5),
        "rwkv_g_up": nrm((L, RWKV_GATE_LORA, W), RWKV_GATE_LORA ** -0.5),
        "rwkv_k_k": 0.85 + nrm((L, W), 0.02),
        "rwkv_k_a": 1.0 + nrm((L, W), 0.02),
        "rwkv_r_k": nrm((L, H, HEAD_DIM), 0.1),
        "rwkv_ln_g": 1.0 + nrm((L, W), 0.02),
        "rwkv_ln_b": nrm((L, W), 0.02),
        "gla_gate_up": nrm((L, GLA_GATE_LORA, GLA_DK), GLA_GATE_LORA ** -0.5),
        "gla_gate_b": nrm((L, GLA_DK), 0.1),
        "gla_norm_g": 1.0 + nrm((L, W), 0.02),
        "mlstm_conv_w": nrm((L, MLSTM_CONV, 2 * W), MLSTM_CONV ** -0.5),
        "mlstm_conv_b": nrm((L, 2 * W), 0.02),
        "mlstm_i_b": nrm((L, H), 0.1),
        "mlstm_f_b": uni((L, H), 3.0, 6.0),
        "mlstm_norm_g": 1.0 + nrm((L, W), 0.02),
        "router_w": nrm((L, D_MODEL, N_EXPERTS), D_MODEL ** -0.5),
        "router_b": nrm((L, N_EXPERTS), 0.01),
        "exp_w_gu": nrm((L, N_EXPERTS, D_MODEL, 2 * D_EXPERT), D_MODEL ** -0.5),
        "exp_b_gu": nrm((L, N_EXPERTS, 2 * D_EXPERT), 0.01),
        "exp_w_down": nrm((L, N_EXPERTS, D_EXPERT, D_MODEL), DEEPNORM_BETA * D_EXPERT ** -0.5),
        "exp_b_down": nrm((L, N_EXPERTS, D_MODEL), 0.01),
        "ple_gate_w": nrm((L, D_MODEL, D_MODEL), D_MODEL ** -0.5),
        "ple_proj": nrm((L, PLE_DIM, D_MODEL), DEEPNORM_BETA * PLE_DIM ** -0.5),
        "ln2_g": 1.0 + nrm((L, D_MODEL), 0.02),
        "ln2_b": nrm((L, D_MODEL), 0.02),
    }


def reference(x, p, w_in, w_out, ln1_g, ln1_b,
              ssd_conv_w, ssd_conv_b, ssd_a_log, ssd_dt_bias, ssd_d, ssd_norm_g,
              rwkv_mu, rwkv_w0, rwkv_w_up, rwkv_a0, rwkv_a_up, rwkv_g_up, rwkv_k_k, rwkv_k_a,
              rwkv_r_k, rwkv_ln_g, rwkv_ln_b,
              gla_gate_up, gla_gate_b, gla_norm_g,
              mlstm_conv_w, mlstm_conv_b, mlstm_i_b, mlstm_f_b, mlstm_norm_g,
              router_w, router_b, exp_w_gu, exp_b_gu, exp_w_down, exp_b_down,
              ple_gate_w, ple_proj, ln2_g, ln2_b):
    bsz, seq, d = x.shape
    for i in range(DEPTH):
        u = (x @ w_in[i]).astype(jnp.float32)
        u_ssd, u_rwkv, u_gla, u_mlstm = _split(u, (SSD_W, RWKV_W, GLA_W, MLSTM_W))
        y_ssd = _ssd_mixer(u_ssd, ssd_conv_w[i], ssd_conv_b[i], ssd_a_log[i], ssd_dt_bias[i],
                           ssd_d[i], ssd_norm_g[i])
        y_rwkv = _rwkv7_mixer(u_rwkv, rwkv_mu[i], rwkv_w0[i], rwkv_w_up[i], rwkv_a0[i], rwkv_a_up[i],
                              rwkv_g_up[i], rwkv_k_k[i], rwkv_k_a[i], rwkv_r_k[i], rwkv_ln_g[i], rwkv_ln_b[i])
        y_gla = _gla_mixer(u_gla, gla_gate_up[i], gla_gate_b[i], gla_norm_g[i])
        y_mlstm = _mlstm_mixer(u_mlstm, mlstm_conv_w[i], mlstm_conv_b[i], mlstm_i_b[i], mlstm_f_b[i],
                               mlstm_norm_g[i])
        mix = jnp.concatenate([y_ssd, y_rwkv, y_gla, y_mlstm], -1).astype(x.dtype) @ w_out[i]
        x = _layer_norm(DEEPNORM_ALPHA * x + mix, ln1_g[i], ln1_b[i])
        ffn = _moe_ffn(x.reshape(bsz * seq, d), router_w[i], router_b[i], exp_w_gu[i], exp_b_gu[i],
                       exp_w_down[i], exp_b_down[i]).reshape(bsz, seq, d)
        h = DEEPNORM_ALPHA * x + ffn
        h = h + jax.nn.sigmoid(h @ ple_gate_w[i]) * (p[i] @ ple_proj[i])
        x = _layer_norm(h, ln2_g[i], ln2_b[i])
    return x
```

```cpp
#include <hip/hip_runtime.h>
#include <cstdio>
#include <cstdint>

#define GAS __attribute__((address_space(1)))
#define LAS __attribute__((address_space(3)))
typedef unsigned short bf16;
typedef unsigned v4u __attribute__((ext_vector_type(4)));
typedef unsigned v2u __attribute__((ext_vector_type(2)));
typedef float f32x4 __attribute__((ext_vector_type(4)));
typedef float f32x2 __attribute__((ext_vector_type(2)));
typedef short bf16x8 __attribute__((ext_vector_type(8)));
typedef GAS unsigned gu32;
#define RLX_AGENT __ATOMIC_RELAXED, __HIP_MEMORY_SCOPE_AGENT
#define LDS_WAIT() asm volatile("s_waitcnt lgkmcnt(0)" ::: "memory")
#define VM_WAIT() asm volatile("s_waitcnt vmcnt(0)" ::: "memory")

constexpr int NWAVES = 8;
constexpr int DEPTH = 4, BATCH = 4, SEQ = 4096, D = 1024, T = BATCH * SEQ;
constexpr int NU = 3484, NUP = 3584;
constexpr int NE = 32, TOPK = 4, ECAP = 16384;
constexpr int NCH = SEQ / 64;
constexpr int U_SSD_Z = 0, U_SSD_X = 256, U_SSD_B = 512, U_SSD_C = 640, U_SSD_DT = 768;
constexpr int U_RW = 772, U_RW_R = 772, U_RW_K = 1028, U_RW_V = 1284, U_RW_LO = 1540;
constexpr int U_GL_Q = 1668, U_GL_K = 1796, U_GL_V = 1924, U_GL_G = 2180, U_GL_OG = 2196;
constexpr int U_ML_Q = 2452, U_ML_K = 2708, U_ML_V = 2964, U_ML_I = 3220, U_ML_F = 3224, U_ML_O = 3228;
constexpr float DN_ALPHA = 1.6817928305074290f;
constexpr float LN_EPS = 1e-5f, NORM_EPS = 1e-5f, RWKV_GN_EPS = 64e-5f;

enum { I_X = 0, I_P, I_WIN, I_WOUT, I_LN1G, I_LN1B, I_SCW, I_SCB, I_SALOG, I_SDTB, I_SD, I_SNG,
       I_RMU, I_RW0, I_RWUP, I_RA0, I_RAUP, I_RGUP, I_RKK, I_RKA, I_RRK, I_RLNG, I_RLNB,
       I_GGUP, I_GGB, I_GNG, I_MCW, I_MCB, I_MIB, I_MFB, I_MNG,
       I_RTW, I_RTB, I_WGU, I_BGU, I_WDN, I_BDN, I_PGW, I_PPJ, I_LN2G, I_LN2B, N_IN };

constexpr size_t MiB = 1u << 20;
constexpr size_t WS_CTL = 0, CTL_ZERO_BYTES = 1 * MiB;
constexpr size_t WS_WIN_T = 2 * MiB;
constexpr size_t WS_WOUT_T = WS_WIN_T + (size_t)DEPTH * NUP * D * 2;
constexpr size_t WS_WGU_T = WS_WOUT_T + (size_t)DEPTH * D * D * 2;
constexpr size_t WS_WDN_T = WS_WGU_T + (size_t)DEPTH * NE * 2048 * D * 2;
constexpr size_t WS_WPG_T = WS_WDN_T + (size_t)DEPTH * NE * D * D * 2;
constexpr size_t WS_WPP_T = WS_WPG_T + (size_t)DEPTH * D * D * 2;
constexpr size_t WS_RWT = WS_WPP_T + (size_t)DEPTH * D * 256 * 2;
constexpr size_t WS_PB = WS_RWT + (size_t)DEPTH * NE * D * 4;
constexpr size_t WS_XB = WS_PB + (size_t)DEPTH * T * 256 * 2;
constexpr size_t WS_U = WS_XB + (size_t)T * D * 2;
constexpr size_t WS_PE = WS_U + (size_t)T * NUP * 4;
constexpr size_t WS_MIX = WS_PE + (size_t)T * D * 4;
constexpr size_t WS_Y1 = WS_MIX + (size_t)T * D * 2;
constexpr size_t WS_X1 = WS_Y1 + (size_t)T * D * 4;
constexpr size_t WS_X1B = WS_X1 + (size_t)T * D * 4;
constexpr size_t WS_SDEST = WS_X1B + (size_t)T * D * 2;
constexpr size_t WS_SGATE = WS_SDEST + (size_t)NE * ECAP * 4;
constexpr size_t WS_ABUF = WS_SGATE + (size_t)NE * ECAP * 4;
constexpr size_t WS_YBUF = WS_ABUF + (size_t)NE * ECAP * D * 2;
constexpr size_t WS_H = WS_YBUF + (size_t)T * 4 * D * 4;
constexpr size_t WS_HB = WS_H + (size_t)T * D * 4;
constexpr size_t WS_H2 = WS_HB + (size_t)T * D * 2;
constexpr size_t WS_SSD_ST = WS_H2 + (size_t)T * D * 4;
constexpr size_t WS_SSD_DEC = WS_SSD_ST + (size_t)16 * NCH * 64 * 128 * 4;
constexpr size_t WS_GLA_ST = WS_SSD_DEC + 16 * NCH * 4;
constexpr size_t WS_GLA_DEC = WS_GLA_ST + (size_t)16 * NCH * 32 * 64 * 4;
constexpr size_t WS_ML_C = WS_GLA_DEC + (size_t)4 * NCH * 128 * 4;
constexpr size_t WS_ML_N = WS_ML_C + (size_t)16 * NCH * 64 * 64 * 4;
constexpr size_t WS_ML_BL = WS_ML_N + (size_t)16 * NCH * 64 * 4;
constexpr size_t WS_ML_ML = WS_ML_BL + 16 * NCH * 4;
constexpr size_t WS_ML_M = WS_ML_ML + 16 * NCH * 4;
constexpr size_t WS_RW = WS_ML_M + 16 * NCH * 4;
constexpr size_t WS_RW_G = WS_RW + (size_t)T * 6 * 256 * 4;
constexpr size_t WS_RW_O = WS_RW_G + (size_t)T * 256 * 4;
constexpr size_t WS_LORA = WS_RW_O + (size_t)T * 256 * 4;
constexpr int LORA_PER_LAYER = 8192 + 8192 + 16384 + 2048;
constexpr size_t WS_END = WS_LORA + (size_t)DEPTH * LORA_PER_LAYER * 4;
constexpr int CW_BAR = 4096;
constexpr int CW_CNT = 16384;

constexpr int RING_BYTES = 147456;
constexpr int MISC_OFF = RING_BYTES;
constexpr int LDS_BYTES = RING_BYTES + 1024;
constexpr int MW_BAR = 8, MW_LCNT = 32, MW_LBASE = 64, MW_PFX = 96, MW_CNT = 136;

__device__ __forceinline__ unsigned cvt_pk_bf16(float lo, float hi) { unsigned r; asm volatile("v_cvt_pk_bf16_f32 %0, %1, %2" : "=v"(r) : "v"(lo), "v"(hi)); return r; }
__device__ __forceinline__ float bf2f(unsigned short b) { return __uint_as_float(((unsigned)b) << 16); }
__device__ __forceinline__ float sigmoidf_(float x) { return 1.0f / (1.0f + __expf(-x)); }
__device__ __forceinline__ float siluf_(float x) { return x / (1.0f + __expf(-x)); }
__device__ __forceinline__ float softplusf_(float x) { return fmaxf(x, 0.f) + log1pf(__expf(-fabsf(x))); }
__device__ __forceinline__ float logsigmoidf_(float x) { return fminf(x, 0.f) - log1pf(__expf(-fabsf(x))); }
__device__ __forceinline__ float wave_sum(float v) {
#pragma unroll
    for (int o = 1; o < 64; o <<= 1) v += __shfl_xor(v, o);
    return v;
}
__device__ __forceinline__ float wave_max(float v) {
#pragma unroll
    for (int o = 1; o < 64; o <<= 1) v = fmaxf(v, __shfl_xor(v, o));
    return v;
}
__device__ __forceinline__ float wave_scan_add(float v, int lane) {
#pragma unroll
    for (int o = 1; o < 64; o <<= 1) { const float t = __shfl_up(v, o); if (lane >= o) v += t; }
    return v;
}
__device__ __forceinline__ float wave_scan_max(float v, int lane) {
#pragma unroll
    for (int o = 1; o < 64; o <<= 1) { const float t = __shfl_up(v, o); if (lane >= o) v = fmaxf(v, t); }
    return v;
}
__device__ __forceinline__ f32x4 mm16(const LAS unsigned char* A, int lda, const LAS unsigned char* B, int ldb, int K, f32x4 acc, int fr, int fq) {
    const LAS unsigned char* ap = A + fr * lda + fq * 16; const LAS unsigned char* bp = B + fr * ldb + fq * 16;
    for (int k = 0; k < K; k += 32) {
        const bf16x8 a = *(const LAS bf16x8*)(ap + k * 2); const bf16x8 b = *(const LAS bf16x8*)(bp + k * 2);
        acc = __builtin_amdgcn_mfma_f32_16x16x32_bf16(b, a, acc, 0, 0, 0);
    }
    return acc;
}
__device__ __forceinline__ f32x4 mm16_gB(const LAS unsigned char* A, int lda, const float* B, int ldb, int K, f32x4 acc, int fr, int fq) {
    const LAS unsigned char* ap = A + fr * lda + fq * 16; const float* bp = B + (size_t)fr * ldb + fq * 8;
    for (int k = 0; k < K; k += 32) {
        const bf16x8 a = *(const LAS bf16x8*)(ap + k * 2);
        const f32x4 b0 = *(const f32x4*)(bp + k), b1 = *(const f32x4*)(bp + k + 4);
        v4u bw; bw.x = cvt_pk_bf16(b0.x, b0.y); bw.y = cvt_pk_bf16(b0.z, b0.w); bw.z = cvt_pk_bf16(b1.x, b1.y); bw.w = cvt_pk_bf16(b1.z, b1.w);
        const bf16x8 b = __builtin_bit_cast(bf16x8, bw);
        acc = __builtin_amdgcn_mfma_f32_16x16x32_bf16(b, a, acc, 0, 0, 0);
    }
    return acc;
}
__device__ __forceinline__ v4u pack8(const float (&v)[8]) { v4u o; o.x = cvt_pk_bf16(v[0], v[1]); o.y = cvt_pk_bf16(v[2], v[3]); o.z = cvt_pk_bf16(v[4], v[5]); o.w = cvt_pk_bf16(v[6], v[7]); return o; }

#define XB_TMO      128
#define XB_XCNT(j)  (256  + 64 * (j))
#define XB_XSUB(j)  (1280 + 64 * (j))
#define XB_XGEN(j)  (2304 + 64 * (j))
#define XB_TOP      3328
#define XB_TOPGEN   3392
#define XCD_BAR_WORDS 3456
#define XB_SPIN_CAP (1u << 18)
__device__ __forceinline__ unsigned xb_ld(unsigned* p)              { return __hip_atomic_load(p, __ATOMIC_RELAXED, __HIP_MEMORY_SCOPE_AGENT); }
__device__ __forceinline__ unsigned xb_add(unsigned* p, unsigned v) { return __hip_atomic_fetch_add(p, v, __ATOMIC_RELAXED, __HIP_MEMORY_SCOPE_AGENT); }
__device__ __forceinline__ unsigned xb_xcc_id() { return (unsigned)__builtin_amdgcn_s_getreg((3 << 11) | 20) & 0xFu; }
#define XB_SPIN(cond, bar) do { unsigned _sp = 0; while (cond) { __builtin_amdgcn_s_sleep(1); \
    if ((++_sp & 255u) == 0u) { if (xb_ld(&(bar)[XB_TMO])) break; if (_sp > XB_SPIN_CAP) { atomicAdd(&(bar)[XB_TMO], 1u); break; } } } } while (0)
struct XcdBarrier { unsigned* bar; unsigned x; volatile LAS unsigned* st; };
__device__ __forceinline__ XcdBarrier xcd_barrier_post(unsigned* bar, volatile LAS unsigned* st) {
    XcdBarrier b; b.bar = bar; b.x = xb_xcc_id(); b.st = st;
    if (threadIdx.x == 0) (void)xb_add(&bar[XB_XCNT(b.x)], 1u);
    return b;
}
__device__ __forceinline__ void xcd_barrier_complete(unsigned* bar, unsigned x, unsigned& nloc, unsigned& nx) {
    const unsigned G = gridDim.x * gridDim.y * gridDim.z;
    unsigned sum, cnt, mine, sp = 0u;
    for (;;) {
        sum = 0u; cnt = 0u; mine = 0u;
#pragma unroll
        for (unsigned j = 0; j < 16; ++j) { const unsigned c = xb_ld(&bar[XB_XCNT(j)]); sum += c; cnt += (c > 0u) ? 1u : 0u; mine = (j == x) ? c : mine; }
        if (sum == G) break;
        __builtin_amdgcn_s_sleep(1);
        if ((++sp & 255u) == 0u) { if (xb_ld(&bar[XB_TMO])) break; if (sp > XB_SPIN_CAP) { atomicAdd(&bar[XB_TMO], 1u); break; } }
    }
    nloc = mine > 0u ? mine : 1u; nx = cnt > 0u ? cnt : 1u;
}
__device__ __forceinline__ void xcd_barrier(const XcdBarrier& b) {
    asm volatile("s_waitcnt vmcnt(0)" ::: "memory");
    __syncthreads();
    if (threadIdx.x == 0) {
        unsigned* bar = b.bar;
        __builtin_amdgcn_s_waitcnt(0);
        unsigned nloc = b.st[0], nx = b.st[1];
        if (nloc == 0u) { xcd_barrier_complete(bar, b.x, nloc, nx); b.st[0] = nloc; b.st[1] = nx; }
        const unsigned old = xb_add(&bar[XB_XSUB(b.x)], 1u);
        const unsigned gen = old / nloc;
        if (old + 1u == (gen + 1u) * nloc) {
            __builtin_amdgcn_fence(__ATOMIC_RELEASE, "agent");
            asm volatile("s_waitcnt vmcnt(0)" ::: "memory");
            const unsigned og = xb_add(&bar[XB_TOP], 1u);
            const unsigned tg = og / nx;
            if (og + 1u == (tg + 1u) * nx) xb_add(&bar[XB_TOPGEN], 1u);
            else XB_SPIN(xb_ld(&bar[XB_TOPGEN]) == tg, bar);
            __builtin_amdgcn_fence(__ATOMIC_ACQUIRE, "agent");
            xb_add(&bar[XB_XGEN(b.x)], 1u);
            asm volatile("s_waitcnt vmcnt(0)" ::: "memory");
        } else {
            XB_SPIN(xb_ld(&bar[XB_XGEN(b.x)]) == gen, bar);
            __builtin_amdgcn_fence(__ATOMIC_ACQUIRE, "agent");
            asm volatile("s_waitcnt vmcnt(0)" ::: "memory");
        }
    }
    __syncthreads();
}

namespace pg8 {
constexpr int BM = 256, BK = 64, HALF = 128, HTB = HALF * BK * 2, STAGE_BYTES = 8 * HTB, NXCD = 8, WGM = 8;
__host__ __device__ __forceinline__ int lds_byte(int r, int c) { const int st = (r >> 4) * 2 + (c >> 5), rr = r & 15, cc = c & 31, ob = rr * 64 + cc * 2; return st * 1024 + (ob ^ (((ob >> 9) & 1) << 5)); }
__host__ __device__ __forceinline__ void stage_rc(int b, int& R, int& C) { const int st = b / 1024, sb = b % 1024, swz = sb ^ (((sb >> 9) & 1) << 5); R = (st >> 1) * 16 + swz / 64; C = (st & 1) * 32 + (swz % 64) / 2; }
__host__ __device__ __forceinline__ int perm32(int rho) { const int n = rho >> 4, i = rho & 15; return 8 * (i >> 2) + 4 * n + (i & 3); }

template <class Epi, class Sched>
__device__ __forceinline__ void gemm_phase(LAS unsigned char* lds, const int tid, const Sched& S, const Epi& E) {
    const int wid = __builtin_amdgcn_readfirstlane(tid >> 6), lane = tid & 63, wr = wid >> 2, wc = wid & 3, fr = lane & 15, fq = lane >> 4;
    const int K = S.K, nt = K / BK;
    unsigned voffB[2];
#pragma unroll
    for (int i = 0; i < 2; ++i) { int R, C; stage_rc(tid * 16 + i * 8192, R, C); const int Rb = Epi::PERM ? ((R & ~31) + perm32(R & 31)) : R; voffB[i] = (unsigned)(Rb * K + C) * 2u; }
    const size_t kstep = (size_t)(BK * 2);
    const size_t hstepB = S.hstepB;
    const unsigned ldsw = (unsigned)wid * 1024u;
    const int aoff = lds_byte(wr * 64 + fr, fq * 8), boff = lds_byte(wc * 32 + fr, fq * 8);
#define PG8_SA(b, h) (((b) * 2 + (h)) * HTB)
#define PG8_SB(b, h) ((4 + (b) * 2 + (h)) * HTB)
#define PG8_STAGE_B(bufoff, gbase) do { _Pragma("unroll") for (int _i = 0; _i < 2; ++_i) \
        __builtin_amdgcn_global_load_lds((const unsigned*)((const char*)(gbase) + voffB[_i]), (LAS unsigned*)(lds + (bufoff) + ldsw + _i * 8192), 16, 0, 0); } while (0)
#define PG8_STAGE_A(bufoff, gbase, v0, v1) do { \
        __builtin_amdgcn_global_load_lds((const unsigned*)((const char*)(gbase) + (v0)), (LAS unsigned*)(lds + (bufoff) + ldsw), 16, 0, 0); \
        __builtin_amdgcn_global_load_lds((const unsigned*)((const char*)(gbase) + (v1)), (LAS unsigned*)(lds + (bufoff) + ldsw + 8192), 16, 0, 0); } while (0)
#define PG8_LDA(dst, b, h) do { _Pragma("unroll") for (int m = 0; m < 4; ++m) _Pragma("unroll") for (int k = 0; k < 2; ++k) dst[m][k] = *(const LAS bf16x8*)(lds + PG8_SA(b, h) + aoff + m * 2048 + k * 1024); } while (0)
#define PG8_LDB(dst, b, h) do { _Pragma("unroll") for (int n = 0; n < 2; ++n) _Pragma("unroll") for (int k = 0; k < 2; ++k) dst[n][k] = *(const LAS bf16x8*)(lds + PG8_SB(b, h) + boff + n * 2048 + k * 1024); } while (0)
#define PG8_MMA(ai, bj, At, Bt) do { __builtin_amdgcn_s_setprio(1); _Pragma("unroll") for (int m = 0; m < 4; ++m) _Pragma("unroll") for (int n = 0; n < 2; ++n) _Pragma("unroll") for (int k = 0; k < 2; ++k) \
        acc[ai][bj][m][n] = __builtin_amdgcn_mfma_f32_16x16x32_bf16(Bt[n][k], At[m][k], acc[ai][bj][m][n], 0, 0, 0); __builtin_amdgcn_s_setprio(0); } while (0)
#define PG8_WAIT_V(n) asm volatile("s_waitcnt vmcnt(" #n ")" ::: "memory")
#define PG8_WAIT_L(n) asm volatile("s_waitcnt lgkmcnt(" #n ")" ::: "memory")
#define PG8_BAR __builtin_amdgcn_s_barrier()
#define PG8_SCHED __builtin_amdgcn_sched_barrier(0)
    typename Sched::Unit cur, nxt; int ui = 0;
    if (!S.next(0, cur)) return;
    f32x4 acc[2][2][4][2];
#pragma unroll
    for (int a = 0; a < 2; ++a)
#pragma unroll
        for (int b = 0; b < 2; ++b)
#pragma unroll
            for (int m = 0; m < 4; ++m)
#pragma unroll
                for (int n = 0; n < 2; ++n) acc[a][b][m][n] = (f32x4){0.f, 0.f, 0.f, 0.f};
    bf16x8 At[4][2], B0[2][2], B1[2][2];
    constexpr bool GA = Sched::GATHER;
    const size_t hstepA = GA ? (size_t)0 : (size_t)HALF * K * 2;
    unsigned vA[2][2];
    S.a_off(cur, tid, vA);
#define PG8_STAGE_AH(bufoff, base, vv, h) PG8_STAGE_A(bufoff, ((base) + (h) * hstepA), vv[GA ? (h) : 0][0], vv[GA ? (h) : 0][1])
    const char* cA = S.a_base(cur); const char* cB = S.b_base(cur);
    PG8_STAGE_B(PG8_SB(0, 0), cB); PG8_STAGE_B(PG8_SB(0, 1), cB + hstepB); PG8_STAGE_AH(PG8_SA(0, 0), cA, vA, 0); PG8_STAGE_AH(PG8_SA(0, 1), cA, vA, 1);
    if (wr == 1) PG8_BAR;
    PG8_WAIT_V(2); PG8_BAR;
    PG8_STAGE_B(PG8_SB(1, 0), cB + kstep); PG8_STAGE_AH(PG8_SA(1, 0), cA + kstep, vA, 0); PG8_STAGE_B(PG8_SB(1, 1), cB + hstepB + kstep);
    PG8_WAIT_V(6); PG8_BAR;
    for (;;) {
        const bool has_next = S.next(ui + 1, nxt);
        const char* nA = cA; const char* nB = cB;
        if (has_next) { nA = S.a_base(nxt); nB = S.b_base(nxt); }
        for (int t = 0; t < nt; t += 2) {
            const bool last = (t == nt - 2);
            const char* a1 = cA + (size_t)(t + 1) * kstep;
            const char* a2 = last ? nA : cA + (size_t)(t + 2) * kstep; const char* b2 = last ? nB : cB + (size_t)(t + 2) * kstep;
            const char* a3 = a2 + kstep; const char* b3 = b2 + kstep;
            PG8_LDB(B0, 0, 0); PG8_LDB(B1, 0, 1); PG8_SCHED; PG8_LDA(At, 0, 0); PG8_STAGE_AH(PG8_SA(1, 1), a1, vA, 1);
            if constexpr (GA) { if (last && has_next) S.a_off(nxt, tid, vA); }
            PG8_WAIT_V(8); PG8_WAIT_L(0); PG8_BAR; PG8_MMA(0, 0, At, B0); PG8_MMA(0, 1, At, B1); PG8_BAR; PG8_SCHED;
            PG8_LDA(At, 0, 1); PG8_STAGE_B(PG8_SB(0, 0), b2); PG8_STAGE_B(PG8_SB(0, 1), b2 + hstepB); PG8_STAGE_AH(PG8_SA(0, 0), a2, vA, 0);
            PG8_WAIT_V(8); PG8_WAIT_L(0); PG8_BAR; PG8_MMA(1, 0, At, B0); PG8_MMA(1, 1, At, B1); PG8_BAR; PG8_SCHED;
            PG8_LDB(B0, 1, 0); PG8_LDB(B1, 1, 1); PG8_SCHED; PG8_LDA(At, 1, 0); PG8_STAGE_AH(PG8_SA(0, 1), a2, vA, 1);
            PG8_WAIT_V(8); PG8_WAIT_L(0); PG8_BAR; PG8_MMA(0, 0, At, B0); PG8_MMA(0, 1, At, B1); PG8_BAR; PG8_SCHED;
            PG8_LDA(At, 1, 1); PG8_STAGE_B(PG8_SB(1, 0), b3); PG8_STAGE_B(PG8_SB(1, 1), b3 + hstepB); PG8_STAGE_AH(PG8_SA(1, 0), a3, vA, 0);
            PG8_WAIT_V(8); PG8_WAIT_L(0); PG8_BAR; PG8_MMA(1, 0, At, B0); PG8_MMA(1, 1, At, B1); PG8_BAR; PG8_SCHED;
        }
        if (wr == 0) PG8_BAR;
        { int fr_ = fr; asm volatile("" : "+v"(fr_)); E(acc, cur, wr, wc, fr_, fq); }
        if (!has_next) break;
#pragma unroll
        for (int a = 0; a < 2; ++a)
#pragma unroll
            for (int b = 0; b < 2; ++b)
#pragma unroll
                for (int m = 0; m < 4; ++m)
#pragma unroll
                    for (int n = 0; n < 2; ++n) acc[a][b][m][n] = (f32x4){0.f, 0.f, 0.f, 0.f};
        cur = nxt; cA = nA; cB = nB; ++ui;
        if (wr == 1) PG8_BAR;
    }
    PG8_WAIT_V(0);
    PG8_BAR;
#undef PG8_SA
#undef PG8_SB
#undef PG8_STAGE_A
#undef PG8_STAGE_AH
#undef PG8_STAGE_B
#undef PG8_LDA
#undef PG8_LDB
#undef PG8_MMA
#undef PG8_WAIT_V
#undef PG8_WAIT_L
#undef PG8_BAR
#undef PG8_SCHED
}
}
struct Args { const float* in[N_IN]; float* out; unsigned char* ws; int ph_lo, ph_hi; };
typedef const __attribute__((address_space(4))) unsigned long long* karg_t;
struct Frame {
    karg_t ka;
    LAS unsigned char* lds;
    volatile LAS unsigned* MISC;
    gu32* ctl;
    unsigned char* ws;
    float* out;
    int tid, lane, wave, vcu, G;
};
#define WSP(T_, off) ((T_*)(F.ws + (off)))
#define KIN(k) ((const float*)F.ka[(k)])
template <class P> __device__ __forceinline__ P launder_uniform(P p) {
    unsigned lo = (unsigned)(unsigned long long)p, hi = (unsigned)((unsigned long long)p >> 32);
    asm volatile("" : "+v"(lo), "+v"(hi));
    lo = __builtin_amdgcn_readfirstlane(lo); hi = __builtin_amdgcn_readfirstlane(hi);
    return (P)(((unsigned long long)hi << 32) | lo);
}
__device__ __forceinline__ void frame_refresh(Frame& F) {
    int t = F.tid; asm volatile("" : "+v"(t)); F.tid = t; F.lane = t & 63; F.wave = __builtin_amdgcn_readfirstlane(t >> 6);
    F.ws = launder_uniform(F.ws); F.ctl = (gu32*)(F.ws + WS_CTL);
    F.out = launder_uniform(F.out);
    F.ka = launder_uniform(F.ka);
}

namespace pg8 {
struct DenseSched {
    static constexpr bool GATHER = false;
    struct Unit { int pm, pn; };
    const bf16* A; const bf16* Bt; int K; size_t hstepB; int nM, nN, nwg, G, c;
    __device__ __forceinline__ void init(const bf16* A_, const bf16* Bt_, int M, int N, int K_, int G_, int c_) { A = A_; Bt = Bt_; K = K_; hstepB = (size_t)HALF * K_ * 2; nM = M / BM; nN = N / BM; nwg = nM * nN; G = G_; c = c_; }
    __device__ __forceinline__ bool next(int i, Unit& u) const {
        const long L = (long)i * G + c; if (L >= nwg) return false;
        int wgid = (int)L; { const int q = nwg / NXCD, r = nwg % NXCD, xcd = wgid % NXCD, off = wgid / NXCD; wgid = (xcd < r ? xcd * (q + 1) : r * (q + 1) + (xcd - r) * q) + off; }
        const int nig = WGM * nN, gid = wgid / nig, fm = gid * WGM, gsz = (nM - fm) < WGM ? (nM - fm) : WGM;
        u.pm = fm + ((wgid % nig) % gsz); u.pn = (wgid % nig) / gsz; return true;
    }
    __device__ __forceinline__ const char* a_base(const Unit& u) const { return (const char*)A + (size_t)u.pm * BM * K * 2; }
    __device__ __forceinline__ const char* b_base(const Unit& u) const { return (const char*)Bt + (size_t)u.pn * BM * K * 2; }
    __device__ __forceinline__ void a_off(const Unit&, int tid, unsigned (&v)[2][2]) const {
#pragma unroll
        for (int i = 0; i < 2; ++i) { int R, C; stage_rc(tid * 16 + i * 8192, R, C); v[0][i] = (unsigned)(R * K + C) * 2u; v[1][i] = v[0][i]; }
    }
};
struct MoeUnit { int e, mt, nt, cnt; };
struct MoeOrder {
    const volatile LAS unsigned* pfx;
    int NT, G, c;
    __device__ __forceinline__ bool decode(int i, MoeUnit& u) const {
        const int nwg = (int)pfx[32]; const long L = (long)i * G + c; if (L >= nwg) return false;
        int wgid = (int)L; { const int q = nwg / NXCD, r = nwg % NXCD, xcd = wgid % NXCD, off = wgid / NXCD; wgid = (xcd < r ? xcd * (q + 1) : r * (q + 1) + (xcd - r) * q) + off; }
        int e = 0;
#pragma unroll 1
        for (int j = 1; j < 32; ++j) e += ((int)pfx[j] <= wgid) ? 1 : 0;
        const int j = wgid - (int)pfx[e];
        u.e = e; u.mt = j / NT; u.nt = j % NT; u.cnt = (int)pfx[40 + e]; return true;
    }
};
struct Moe1Sched {
    static constexpr bool GATHER = true;
    typedef MoeUnit Unit;
    MoeOrder O; const bf16* X; const bf16* W; const int* sdest; int K; size_t hstepB;
    __device__ __forceinline__ bool next(int i, Unit& u) const { return O.decode(i, u); }
    __device__ __forceinline__ const char* a_base(const Unit&) const { return (const char*)X; }
    __device__ __forceinline__ const char* b_base(const Unit& u) const { return (const char*)W + ((size_t)u.e * 2048 + (size_t)u.nt * 128) * 1024 * 2; }
    __device__ __forceinline__ void a_off(const Unit& u, int tid, unsigned (&v)[2][2]) const {
#pragma unroll
        for (int i = 0; i < 2; ++i) { int R, C; stage_rc(tid * 16 + i * 8192, R, C);
#pragma unroll
            for (int h = 0; h < 2; ++h) { const int slot = u.mt * 256 + h * HALF + R; int tok = 0; if (slot < u.cnt) tok = sdest[u.e * ECAP + slot] >> 2; v[h][i] = (unsigned)(tok * 1024 + C) * 2u; } }
    }
};
struct Moe2Sched {
    static constexpr bool GATHER = false;
    typedef MoeUnit Unit;
    MoeOrder O; const bf16* Ab; const bf16* W; int K; size_t hstepB;
    __device__ __forceinline__ bool next(int i, Unit& u) const { return O.decode(i, u); }
    __device__ __forceinline__ const char* a_base(const Unit& u) const { return (const char*)Ab + ((size_t)u.e * ECAP + (size_t)u.mt * 256) * 1024 * 2; }
    __device__ __forceinline__ const char* b_base(const Unit& u) const { return (const char*)W + ((size_t)u.e * 1024 + (size_t)u.nt * 256) * 1024 * 2; }
    __device__ __forceinline__ void a_off(const Unit&, int tid, unsigned (&v)[2][2]) const {
#pragma unroll
        for (int i = 0; i < 2; ++i) { int R, C; stage_rc(tid * 16 + i * 8192, R, C); v[0][i] = (unsigned)(R * 1024 + C) * 2u; v[1][i] = v[0][i]; }
    }
};

struct EpiF32 {
    static constexpr bool PERM = false;
    float* C; int ldc; const float* base; float alpha;
    __device__ __forceinline__ void operator()(const f32x4 (&acc)[2][2][4][2], const DenseSched::Unit& u, int wr, int wc, int fr, int fq) const {
        const int row0 = u.pm * BM + wr * 64 + fr, col0 = u.pn * BM + wc * 32 + 4 * fq;
#pragma unroll
        for (int ai = 0; ai < 2; ++ai)
#pragma unroll
            for (int m = 0; m < 4; ++m) { const size_t ro = (size_t)(row0 + ai * HALF + m * 16) * ldc + col0;
#pragma unroll
                for (int bj = 0; bj < 2; ++bj)
#pragma unroll
                    for (int n = 0; n < 2; ++n) { f32x4 v = acc[ai][bj][m][n];
                        if (base) { const f32x4 b = *(const f32x4*)(base + ro + bj * HALF + n * 16); v = v + b * alpha; }
                        *(f32x4*)(C + ro + bj * HALF + n * 16) = v; } }
    }
};
struct EpiPle {
    static constexpr bool PERM = false;
    float* C; const float* hb; const float* pe;
    __device__ __forceinline__ void operator()(const f32x4 (&acc)[2][2][4][2], const DenseSched::Unit& u, int wr, int wc, int fr, int fq) const {
        const int row0 = u.pm * BM + wr * 64 + fr, col0 = u.pn * BM + wc * 32 + 4 * fq;
#pragma unroll
        for (int ai = 0; ai < 2; ++ai)
#pragma unroll
            for (int m = 0; m < 4; ++m) { const size_t ro = (size_t)(row0 + ai * HALF + m * 16) * 1024 + col0;
#pragma unroll
                for (int bj = 0; bj < 2; ++bj)
#pragma unroll
                    for (int n = 0; n < 2; ++n) { const f32x4 a = acc[ai][bj][m][n]; const f32x4 hv = *(const f32x4*)(hb + ro + bj * HALF + n * 16), pv = *(const f32x4*)(pe + ro + bj * HALF + n * 16);
                        f32x4 o; o.x = hv.x + sigmoidf_(a.x) * pv.x; o.y = hv.y + sigmoidf_(a.y) * pv.y; o.z = hv.z + sigmoidf_(a.z) * pv.z; o.w = hv.w + sigmoidf_(a.w) * pv.w;
                        *(f32x4*)(C + ro + bj * HALF + n * 16) = o; } }
    }
};
struct EpiMoe1 {
    static constexpr bool PERM = true;
    bf16* Ab; const float* bgu;
    __device__ __forceinline__ void operator()(const f32x4 (&acc)[2][2][4][2], const MoeUnit& u, int wr, int wc, int fr, int fq) const {
        const int col0 = u.nt * 128 + wc * 32 + 8 * fq;
        const float* bg = bgu + (size_t)u.e * 2048 + col0;
        const f32x4 bg0 = *(const f32x4*)(bg), bg1 = *(const f32x4*)(bg + 4), bl0 = *(const f32x4*)(bg + 1024), bl1 = *(const f32x4*)(bg + 1028);
#pragma unroll
        for (int ai = 0; ai < 2; ++ai)
#pragma unroll
            for (int m = 0; m < 4; ++m) { const int r = ai * HALF + wr * 64 + m * 16 + fr;
                bf16* rowp = Ab + ((size_t)u.e * ECAP + (size_t)u.mt * 256 + r) * 1024 + col0;
                float o[8];
#pragma unroll
                for (int n = 0; n < 2; ++n) { const f32x4 g4 = acc[ai][0][m][n] + (n ? bg1 : bg0), l4 = acc[ai][1][m][n] + (n ? bl1 : bl0);
#pragma unroll
                    for (int j = 0; j < 4; ++j) { const float g = fminf(g4[j], 7.0f), l = fminf(fmaxf(l4[j], -7.0f), 7.0f); o[n * 4 + j] = (l + 1.0f) * g * sigmoidf_(1.702f * g); } }
                *(v4u*)rowp = pack8(o); }
    }
};
struct EpiMoe2 {
    static constexpr bool PERM = false;
    float* Y; const float* bdn; const int* sdest; const float* sgate;
    __device__ __forceinline__ void operator()(const f32x4 (&acc)[2][2][4][2], const MoeUnit& u, int wr, int wc, int fr, int fq) const {
        const int col0 = u.nt * 256 + wc * 32 + 4 * fq;
        const float* bp = bdn + (size_t)u.e * 1024 + col0;
        f32x4 bv[2][2];
#pragma unroll
        for (int bj = 0; bj < 2; ++bj)
#pragma unroll
            for (int n = 0; n < 2; ++n) bv[bj][n] = *(const f32x4*)(bp + bj * HALF + n * 16);
#pragma unroll
        for (int ai = 0; ai < 2; ++ai)
#pragma unroll
            for (int m = 0; m < 4; ++m) { const int slot = u.mt * 256 + ai * HALF + wr * 64 + m * 16 + fr;
                if (slot < u.cnt) { const int dest = sdest[u.e * ECAP + slot]; const float gate = sgate[u.e * ECAP + slot];
                    float* rowp = Y + (size_t)dest * 1024 + col0;
#pragma unroll
                    for (int bj = 0; bj < 2; ++bj)
#pragma unroll
                        for (int n = 0; n < 2; ++n) *(f32x4*)(rowp + bj * HALF + n * 16) = (acc[ai][bj][m][n] + bv[bj][n]) * gate; } }
    }
};
}

__device__ __forceinline__ void p0_transpose_item(const float* W, int K, int N, int nblk, bf16* WT, LAS float* scr, int item, int lane) {
    const int kb = item / nblk, nb = item % nblk, k0 = 64 * kb, n0 = 32 * nb;
    const int nn = n0 + (lane & 31); const bool ok = nn < N;
#pragma unroll 8
    for (int i = 0; i < 32; ++i) { const int kk = 2 * i + (lane >> 5); scr[kk * 33 + (lane & 31)] = ok ? W[(size_t)(k0 + kk) * N + nn] : 0.f; }
    LDS_WAIT(); asm volatile("" ::: "memory");
    const int c = lane & 7;
#pragma unroll
    for (int j = 0; j < 4; ++j) { const int n = (lane >> 3) + 8 * j; const LAS float* s = scr + (8 * c) * 33 + n;
        v4u o; o.x = cvt_pk_bf16(s[0 * 33], s[1 * 33]); o.y = cvt_pk_bf16(s[2 * 33], s[3 * 33]); o.z = cvt_pk_bf16(s[4 * 33], s[5 * 33]); o.w = cvt_pk_bf16(s[6 * 33], s[7 * 33]);
        *(v4u*)(WT + (size_t)(n0 + n) * K + k0 + 8 * c) = o; }
    LDS_WAIT(); asm volatile("" ::: "memory");
}
__device__ __forceinline__ void cvt_rows(const float* src, bf16* dst, size_t n8, size_t i0, size_t stride) {
    for (size_t i = i0; i < n8; i += stride) { const f32x4 a = *(const f32x4*)(src + i * 8), b = *(const f32x4*)(src + i * 8 + 4);
        v4u o; o.x = cvt_pk_bf16(a.x, a.y); o.y = cvt_pk_bf16(a.z, a.w); o.z = cvt_pk_bf16(b.x, b.y); o.w = cvt_pk_bf16(b.z, b.w); *(v4u*)(dst + i * 8) = o; }
}
__device__ __forceinline__ void p0_prologue(Frame& F, const Args& A) {
    LAS float* scr = (LAS float*)(F.lds + F.wave * 16384);
    const int gw = F.vcu * NWAVES + F.wave, NGW = F.G * NWAVES;
    constexpr int I_IN = 16 * (NUP / 32), I_OUT = 16 * 32, I_GU = 16 * 64, I_DN = 16 * 32, I_PG = 16 * 32, I_PP = 4 * 32;
    constexpr int PER_LAYER = I_IN + I_OUT + NE * I_GU + NE * I_DN + I_PG + I_PP;
    for (int it = gw; it < DEPTH * PER_LAYER; it += NGW) {
        const int l = it / PER_LAYER; int r = it % PER_LAYER;
        if (r < I_IN) { p0_transpose_item(KIN(I_WIN) + (size_t)l * D * NU, D, NU, NUP / 32, WSP(bf16, WS_WIN_T) + (size_t)l * NUP * D, scr, r, F.lane); continue; } r -= I_IN;
        if (r < I_OUT) { p0_transpose_item(KIN(I_WOUT) + (size_t)l * D * D, D, D, 32, WSP(bf16, WS_WOUT_T) + (size_t)l * D * D, scr, r, F.lane); continue; } r -= I_OUT;
        if (r < NE * I_GU) { const int e = r / I_GU; p0_transpose_item(KIN(I_WGU) + ((size_t)l * NE + e) * D * 2048, D, 2048, 64, WSP(bf16, WS_WGU_T) + ((size_t)l * NE + e) * 2048 * D, scr, r % I_GU, F.lane); continue; } r -= NE * I_GU;
        if (r < NE * I_DN) { const int e = r / I_DN; p0_transpose_item(KIN(I_WDN) + ((size_t)l * NE + e) * D * D, D, D, 32, WSP(bf16, WS_WDN_T) + ((size_t)l * NE + e) * D * D, scr, r % I_DN, F.lane); continue; } r -= NE * I_DN;
        if (r < I_PG) { p0_transpose_item(KIN(I_PGW) + (size_t)l * D * D, D, D, 32, WSP(bf16, WS_WPG_T) + (size_t)l * D * D, scr, r, F.lane); continue; } r -= I_PG;
        p0_transpose_item(KIN(I_PPJ) + (size_t)l * 256 * D, 256, D, 32, WSP(bf16, WS_WPP_T) + (size_t)l * D * 256, scr, r, F.lane);
    }
    const size_t gt = (size_t)F.vcu * (NWAVES * 64) + F.tid, NT_ = (size_t)F.G * NWAVES * 64;
    cvt_rows(KIN(I_P), WSP(bf16, WS_PB), (size_t)DEPTH * T * 256 / 8, gt, NT_);
    cvt_rows(KIN(I_X), WSP(bf16, WS_XB), (size_t)T * D / 8, gt, NT_);
    for (size_t i = gt; i < (size_t)DEPTH * LORA_PER_LAYER; i += NT_) { const int l = (int)(i / LORA_PER_LAYER); int r = (int)(i % LORA_PER_LAYER); float v;
        if (r < 8192) { const int ch = r >> 5, j = r & 31; v = KIN(I_RWUP)[(size_t)l * 8192 + j * 256 + ch]; }
        else if (r < 16384) { r -= 8192; const int ch = r >> 5, j = r & 31; v = KIN(I_RAUP)[(size_t)l * 8192 + j * 256 + ch]; }
        else if (r < 32768) { r -= 16384; const int ch = r >> 6, j = r & 63; v = KIN(I_RGUP)[(size_t)l * 16384 + j * 256 + ch]; }
        else { r -= 32768; const int d = r >> 4, j = r & 15; v = KIN(I_GGUP)[(size_t)l * 2048 + j * 128 + d]; }
        WSP(float, WS_LORA)[i] = v; }
    for (size_t i = gt; i < (size_t)DEPTH * NE * D; i += NT_) { const int l = (int)(i / (NE * D)), r = (int)(i % (NE * D)), e = r / D, k = r % D; WSP(float, WS_RWT)[i] = KIN(I_RTW)[(size_t)l * D * NE + (size_t)k * NE + e]; }
}

__device__ __forceinline__ void p6_ln1_router(Frame& F, const Args& A, int layer) {
    const float* y1 = WSP(float, WS_Y1); float* x1 = WSP(float, WS_X1); bf16* x1b = WSP(bf16, WS_X1B);
    const float* g = KIN(I_LN1G) + layer * D; const float* bb = KIN(I_LN1B) + layer * D;
    const float* rwt = WSP(float, WS_RWT) + (size_t)layer * NE * D; const float* rb = KIN(I_RTB) + layer * NE;
    int* sdest = WSP(int, WS_SDEST); float* sgate = WSP(float, WS_SGATE);
    unsigned* cnt = (unsigned*)(F.ctl + CW_CNT + layer * NE * 16);
    LAS float* RWT = (LAS float*)F.lds;
    volatile LAS unsigned* lcnt = F.MISC + MW_LCNT; volatile LAS unsigned* lbase = F.MISC + MW_LBASE;
    for (int i = F.tid; i < NE * D / 4; i += NWAVES * 64) ((LAS f32x4*)RWT)[i] = ((const f32x4*)rwt)[i];
    const int lane = F.lane;
    const f32x4 gv[4] = { *(const f32x4*)(g + 4 * lane), *(const f32x4*)(g + 256 + 4 * lane), *(const f32x4*)(g + 512 + 4 * lane), *(const f32x4*)(g + 768 + 4 * lane) };
    const f32x4 bv[4] = { *(const f32x4*)(bb + 4 * lane), *(const f32x4*)(bb + 256 + 4 * lane), *(const f32x4*)(bb + 512 + 4 * lane), *(const f32x4*)(bb + 768 + 4 * lane) };
    const float rbias = rb[lane >> 1];
    for (int blk = F.vcu; blk < T / 64; blk += F.G) {
        if (F.tid < 32) lcnt[F.tid] = 0u;
        __syncthreads();
        int my_e = 0; float my_g = 0.f; unsigned my_r = 0u;
#pragma unroll 1
        for (int ri = 0; ri < 8; ++ri) {
            const int row = blk * 64 + F.wave * 8 + ri;
            const float* yr = y1 + (size_t)row * D;
            f32x4 v[4]; float s = 0.f;
#pragma unroll
            for (int j = 0; j < 4; ++j) { v[j] = *(const f32x4*)(yr + 256 * j + 4 * lane); s += (v[j].x + v[j].y) + (v[j].z + v[j].w); }
            const float mean = wave_sum(s) * (1.f / D); float s2 = 0.f;
#pragma unroll
            for (int j = 0; j < 4; ++j) { v[j] = v[j] - mean; s2 += (v[j].x * v[j].x + v[j].y * v[j].y) + (v[j].z * v[j].z + v[j].w * v[j].w); }
            const float rstd = 1.0f / sqrtf(wave_sum(s2) * (1.f / D) + LN_EPS);
#pragma unroll
            for (int j = 0; j < 4; ++j) { v[j] = v[j] * rstd * gv[j] + bv[j];
                *(f32x4*)(x1 + (size_t)row * D + 256 * j + 4 * lane) = v[j];
                v2u o; o.x = cvt_pk_bf16(v[j].x, v[j].y); o.y = cvt_pk_bf16(v[j].z, v[j].w); *(v2u*)(x1b + (size_t)row * D + 256 * j + 4 * lane) = o; }
            float p[32];
#pragma unroll
            for (int e = 0; e < 32; ++e) { float a = 0.f;
#pragma unroll
                for (int j = 0; j < 4; ++j) { const f32x4 w = *(const LAS f32x4*)(RWT + e * D + 256 * j + 4 * lane); a += (v[j].x * w.x + v[j].y * w.y) + (v[j].z * w.z + v[j].w * w.w); }
                p[e] = a; }
#pragma unroll
            for (int i = 0; i < 16; ++i) { const bool hi = (lane & 32) != 0; const float keep = hi ? p[i + 16] : p[i], send = hi ? p[i] : p[i + 16]; p[i] = keep + __shfl_xor(send, 32); }
#pragma unroll
            for (int i = 0; i < 8; ++i) { const bool hi = (lane & 16) != 0; const float keep = hi ? p[i + 8] : p[i], send = hi ? p[i] : p[i + 8]; p[i] = keep + __shfl_xor(send, 16); }
#pragma unroll
            for (int i = 0; i < 4; ++i) { const bool hi = (lane & 8) != 0; const float keep = hi ? p[i + 4] : p[i], send = hi ? p[i] : p[i + 4]; p[i] = keep + __shfl_xor(send, 8); }
#pragma unroll
            for (int i = 0; i < 2; ++i) { const bool hi = (lane & 4) != 0; const float keep = hi ? p[i + 2] : p[i], send = hi ? p[i] : p[i + 2]; p[i] = keep + __shfl_xor(send, 4); }
            { const bool hi = (lane & 2) != 0; const float keep = hi ? p[1] : p[0], send = hi ? p[0] : p[1]; p[0] = keep + __shfl_xor(send, 2); }
            float logit = p[0] + __shfl_xor(p[0], 1) + rbias;
            float tv[4]; int te[4];
#pragma unroll
            for (int k = 0; k < 4; ++k) {
                float bvv = logit; int bi = lane >> 1;
#pragma unroll
                for (int o = 2; o < 64; o <<= 1) { const float ov = __shfl_xor(bvv, o); const int oi = __shfl_xor(bi, o); if (ov > bvv || (ov == bvv && oi < bi)) { bvv = ov; bi = oi; } }
                tv[k] = bvv; te[k] = bi; if ((lane >> 1) == bi) logit = -INFINITY;
            }
            const float e1 = __expf(tv[1] - tv[0]), e2 = __expf(tv[2] - tv[0]), e3 = __expf(tv[3] - tv[0]); const float inv = 1.0f / (1.0f + e1 + e2 + e3);
            const int kk = lane & 3;
            const int ek = kk == 0 ? te[0] : kk == 1 ? te[1] : kk == 2 ? te[2] : te[3];
            const float gk = (kk == 0 ? 1.0f : kk == 1 ? e1 : kk == 2 ? e2 : e3) * inv;
            if ((lane >> 2) == ri) { my_e = ek; my_g = gk; my_r = atomicAdd((unsigned*)&lcnt[ek], 1u); }
        }
        __syncthreads();
        if (F.tid < 32) { const unsigned n = lcnt[F.tid]; lbase[F.tid] = n ? __hip_atomic_fetch_add(cnt + F.tid * 16, n, RLX_AGENT) : 0u; }
        __syncthreads();
        if (lane < 32) { const int row = blk * 64 + F.wave * 8 + (lane >> 2); const unsigned slot = (unsigned)my_e * ECAP + lbase[my_e] + my_r;
            sdest[slot] = row * 4 + (lane & 3); sgate[slot] = my_g; }
        __syncthreads();
    }
}
__device__ __forceinline__ void p9_combine(Frame& F, const Args& A) {
    const float* x1 = WSP(float, WS_X1); const float* yb = WSP(float, WS_YBUF); float* h = WSP(float, WS_H); bf16* hb = WSP(bf16, WS_HB);
    const int gw = F.vcu * NWAVES + F.wave, NGW = F.G * NWAVES, lane = F.lane;
    for (int row = gw; row < T; row += NGW) {
#pragma unroll
        for (int j = 0; j < 4; ++j) { const size_t o = (size_t)row * D + 256 * j + 4 * lane;
            f32x4 v = *(const f32x4*)(x1 + o) * DN_ALPHA;
#pragma unroll
            for (int k = 0; k < 4; ++k) v = v + *(const f32x4*)(yb + ((size_t)row * 4 + k) * D + 256 * j + 4 * lane);
            *(f32x4*)(h + o) = v; v2u w; w.x = cvt_pk_bf16(v.x, v.y); w.y = cvt_pk_bf16(v.z, v.w); *(v2u*)(hb + o) = w; }
    }
}
__device__ __forceinline__ void p11_ln2(Frame& F, const Args& A, int layer) {
    const float* h2 = WSP(float, WS_H2); bf16* xb = WSP(bf16, WS_XB);
    const float* g = KIN(I_LN2G) + layer * D; const float* bb = KIN(I_LN2B) + layer * D;
    const int gw = F.vcu * NWAVES + F.wave, NGW = F.G * NWAVES, lane = F.lane;
    for (int row = gw; row < T; row += NGW) {
        const float* yr = h2 + (size_t)row * D; f32x4 v[4]; float s = 0.f;
#pragma unroll
        for (int j = 0; j < 4; ++j) { v[j] = *(const f32x4*)(yr + 256 * j + 4 * lane); s += (v[j].x + v[j].y) + (v[j].z + v[j].w); }
        const float mean = wave_sum(s) * (1.f / D); float s2 = 0.f;
#pragma unroll
        for (int j = 0; j < 4; ++j) { v[j] = v[j] - mean; s2 += (v[j].x * v[j].x + v[j].y * v[j].y) + (v[j].z * v[j].z + v[j].w * v[j].w); }
        const float rstd = 1.0f / sqrtf(wave_sum(s2) * (1.f / D) + LN_EPS);
#pragma unroll
        for (int j = 0; j < 4; ++j) { const f32x4 gv = *(const f32x4*)(g + 256 * j + 4 * lane), bv = *(const f32x4*)(bb + 256 * j + 4 * lane);
            const f32x4 o = v[j] * rstd * gv + bv; const size_t off = (size_t)row * D + 256 * j + 4 * lane;
            *(f32x4*)(F.out + off) = o; v2u w; w.x = cvt_pk_bf16(o.x, o.y); w.y = cvt_pk_bf16(o.z, o.w); *(v2u*)(xb + off) = w; }
    }
}
__device__ __forceinline__ void moe_build_pfx(Frame& F, const Args& A, int layer, int NT) {
    volatile LAS unsigned* pfx = F.MISC + MW_PFX;
    __syncthreads();
    if (F.tid == 0) { unsigned acc = 0u;
        for (int e = 0; e < NE; ++e) { const unsigned c = __hip_atomic_load(F.ctl + CW_CNT + (layer * NE + e) * 16, RLX_AGENT); pfx[e] = acc; pfx[40 + e] = c; acc += ((c + 255u) >> 8) * (unsigned)NT; }
        pfx[32] = acc; }
    __syncthreads();
}
#define UU(t, col) (u[(size_t)(t) * NUP + (col)])
__device__ __forceinline__ void lds_st_bf16(LAS unsigned char* p, float v) { *(LAS unsigned short*)p = (unsigned short)(cvt_pk_bf16(v, 0.f) & 0xffffu); }
__device__ __forceinline__ void lds_st_bf16x4(LAS unsigned char* p, float a, float b, float c, float d) { v2u o; o.x = cvt_pk_bf16(a, b); o.y = cvt_pk_bf16(c, d); *(LAS v2u*)p = o; }

__device__ __forceinline__ void ssd_stage1(Frame& F, const Args& A, int layer, int b, int c) {
    const float* u = WSP(float, WS_U);
    LAS unsigned char* L = F.lds;
    LAS float* DT = (LAS float*)L; LAS float* AC = DT + 256;
    LAS unsigned char* BMT = L + 2048; LAS unsigned char* XCDT = BMT + 128 * 144;
    const int t0 = b * SEQ + c * 64, tid = F.tid, lane = F.lane, wave = F.wave;
    if (wave < 4) {
        const int hh = wave;
        const float dt = softplusf_(UU(t0 + lane, U_SSD_DT + hh) + KIN(I_SDTB)[layer * 4 + hh]);
        const float adt = -dt * __expf(KIN(I_SALOG)[layer * 4 + hh]);
        const float ac = wave_scan_add(adt, lane);
        DT[hh * 64 + lane] = dt; AC[hh * 64 + lane] = ac;
        if (lane == 63) WSP(float, WS_SSD_DEC)[(b * 4 + hh) * NCH + c] = __expf(ac);
    }
    __syncthreads();
    if (tid < 384) {
        const int cc = tid; const float* cw = KIN(I_SCW) + (size_t)layer * 2048 + cc; const float w0 = cw[0], w1 = cw[512], w2 = cw[1024], w3 = cw[1536], cb = KIN(I_SCB)[layer * 512 + cc];
        const float* up = u + (size_t)t0 * NUP + U_SSD_X + cc;
        float win0 = 0.f, win1 = 0.f, win2 = 0.f;
        if (c > 0) { win0 = up[-3 * NUP]; win1 = up[-2 * NUP]; win2 = up[-1 * NUP]; }
        const int hh = (cc >> 6) & 3; const bool isx = cc < 256;
        LAS unsigned char* dst = isx ? XCDT + cc * 144 : BMT + (cc - 256) * 144;
        const float aclast = AC[hh * 64 + 63];
#pragma unroll 1
        for (int l0 = 0; l0 < 64; l0 += 32) {
            float xv[32];
#pragma unroll
            for (int j = 0; j < 32; ++j) xv[j] = up[(l0 + j) * NUP];
#pragma unroll
            for (int j8 = 0; j8 < 4; ++j8) { float o[8];
#pragma unroll
                for (int j = 0; j < 8; ++j) { const int l = l0 + j8 * 8 + j; const float x = xv[j8 * 8 + j]; const float y = cb + w0 * win0 + w1 * win1 + w2 * win2 + w3 * x; win0 = win1; win1 = win2; win2 = x;
                    float s = siluf_(y); if (isx) s *= DT[hh * 64 + l] * __expf(aclast - AC[hh * 64 + l]); o[j] = s; }
                *(LAS v4u*)(dst + (l0 + j8 * 8) * 2) = pack8(o); }
        }
    }
    __syncthreads();
    { const int fr = lane & 15, fq = lane >> 4; float* st = WSP(float, WS_SSD_ST);
#pragma unroll 1
      for (int i = 0; i < 2; ++i) { const int row0 = (2 * wave + i) * 16; const int hh = row0 >> 6, p = (row0 & 63) + fr;
          float* dstp = st + (((size_t)(b * 4 + hh) * NCH + c) * 64 + p) * 128;
#pragma unroll 1
          for (int ntl = 0; ntl < 8; ++ntl) { f32x4 acc = {0.f, 0.f, 0.f, 0.f}; acc = mm16(XCDT + row0 * 144, 144, BMT + ntl * 16 * 144, 144, 64, acc, fr, fq);
              *(f32x4*)(dstp + ntl * 16 + 4 * fq) = acc; } } }
    __syncthreads();
}
__device__ __forceinline__ void ssd_stage3(Frame& F, const Args& A, int layer, int b, int c) {
    const float* u = WSP(float, WS_U);
    LAS unsigned char* L = F.lds;
    LAS float* DT = (LAS float*)L; LAS float* AC = DT + 256;
    LAS unsigned char* CM = L + 2048; LAS unsigned char* BM = CM + 64 * 272; LAS unsigned char* XCT = BM + 64 * 272; LAS unsigned char* MM = XCT + 256 * 144;
    LAS unsigned char* YG = XCT;
    const int t0 = b * SEQ + c * 64, tid = F.tid, lane = F.lane, wave = F.wave, fr = lane & 15, fq = lane >> 4;
    if (wave < 4) {
        const int hh = wave;
        const float dt = softplusf_(UU(t0 + lane, U_SSD_DT + hh) + KIN(I_SDTB)[layer * 4 + hh]);
        const float adt = -dt * __expf(KIN(I_SALOG)[layer * 4 + hh]);
        DT[hh * 64 + lane] = dt; AC[hh * 64 + lane] = wave_scan_add(adt, lane);
    }
    __syncthreads();
    {
        const int cc = tid; const float* cw = KIN(I_SCW) + (size_t)layer * 2048 + cc; const float w0 = cw[0], w1 = cw[512], w2 = cw[1024], w3 = cw[1536], cb = KIN(I_SCB)[layer * 512 + cc];
        const float* up = u + (size_t)t0 * NUP + U_SSD_X + cc;
        float win0 = 0.f, win1 = 0.f, win2 = 0.f;
        if (c > 0) { win0 = up[-3 * NUP]; win1 = up[-2 * NUP]; win2 = up[-1 * NUP]; }
        const int hh = (cc >> 6) & 3;
#pragma unroll 1
        for (int l0 = 0; l0 < 64; l0 += 32) {
            float xv[32];
#pragma unroll
            for (int j = 0; j < 32; ++j) xv[j] = up[(l0 + j) * NUP];
#pragma unroll
            for (int j8 = 0; j8 < 4; ++j8) { float o[8];
#pragma unroll
                for (int j = 0; j < 8; ++j) { const int l = l0 + j8 * 8 + j; const float x = xv[j8 * 8 + j]; const float y = cb + w0 * win0 + w1 * win1 + w2 * win2 + w3 * x; win0 = win1; win1 = win2; win2 = x;
                    float s = siluf_(y); if (cc < 256) s *= DT[hh * 64 + l]; o[j] = s; }
                if (cc < 256) *(LAS v4u*)(XCT + cc * 144 + (l0 + j8 * 8) * 2) = pack8(o);
                else { LAS unsigned char* d2 = (cc < 384 ? BM + (cc - 256) * 2 : CM + (cc - 384) * 2) + (l0 + j8 * 8) * 272;
#pragma unroll
                    for (int j = 0; j < 8; ++j) lds_st_bf16(d2 + j * 272, o[j]); } }
        }
    }
    __syncthreads();
#pragma unroll 1
    for (int i = 0; i < 2; ++i) { const int idx = 2 * wave + i, lt = idx >> 2, st = idx & 3;
        f32x4 acc = {0.f, 0.f, 0.f, 0.f}; acc = mm16(CM + lt * 16 * 272, 272, BM + st * 16 * 272, 272, 128, acc, fr, fq);
        const int l = lt * 16 + fr, s0 = st * 16 + 4 * fq;
#pragma unroll
        for (int hh = 0; hh < 4; ++hh) { const float al = AC[hh * 64 + l], dl = KIN(I_SD)[layer * 4 + hh] / DT[hh * 64 + l]; float o[4];
#pragma unroll
            for (int j = 0; j < 4; ++j) { const int s = s0 + j; float m = (l >= s) ? acc[j] * __expf(al - AC[hh * 64 + s]) : 0.f; if (l == s) m += dl; o[j] = m; }
            lds_st_bf16x4(MM + hh * 9216 + l * 144 + s0 * 2, o[0], o[1], o[2], o[3]); } }
    __syncthreads();
    f32x4 yv[2][4];
    { const int hh = wave >> 1; const float* prev = WSP(float, WS_SSD_ST) + ((size_t)(b * 4 + hh) * NCH + c) * 8192;
#pragma unroll
      for (int i = 0; i < 2; ++i) { const int lt = 2 * (wave & 1) + i, l = lt * 16 + fr; const float ea = __expf(AC[hh * 64 + l]);
#pragma unroll
          for (int pt = 0; pt < 4; ++pt) { f32x4 ad = {0.f, 0.f, 0.f, 0.f}, ao = {0.f, 0.f, 0.f, 0.f};
              ad = mm16(MM + hh * 9216 + lt * 16 * 144, 144, XCT + (hh * 64 + pt * 16) * 144, 144, 64, ad, fr, fq);
              ao = mm16_gB(CM + lt * 16 * 272, 272, prev + (size_t)(pt * 16) * 128, 128, 128, ao, fr, fq);
              const f32x4 z = *(const f32x4*)&UU(t0 + l, U_SSD_Z + hh * 64 + pt * 16 + 4 * fq);
              f32x4 y = ad + ao * ea; y.x *= siluf_(z.x); y.y *= siluf_(z.y); y.z *= siluf_(z.z); y.w *= siluf_(z.w); yv[i][pt] = y; } } }
    __syncthreads();
    { const int hh = wave >> 1;
#pragma unroll
      for (int i = 0; i < 2; ++i) { const int l = (2 * (wave & 1) + i) * 16 + fr;
#pragma unroll
          for (int pt = 0; pt < 4; ++pt) *(LAS f32x4*)(YG + l * 1040 + (hh * 64 + pt * 16 + 4 * fq) * 4) = yv[i][pt]; } }
    __syncthreads();
    { const f32x4 g = *(const f32x4*)(KIN(I_SNG) + layer * 256 + 4 * lane); bf16* mix = WSP(bf16, WS_MIX);
#pragma unroll 1
      for (int i = 0; i < 8; ++i) { const int l = wave * 8 + i; const f32x4 y = *(const LAS f32x4*)(YG + l * 1040 + lane * 16);
          const float ss = wave_sum((y.x * y.x + y.y * y.y) + (y.z * y.z + y.w * y.w)); const float r = 1.0f / sqrtf(ss * (1.f / 256.f) + NORM_EPS);
          v2u o; o.x = cvt_pk_bf16(y.x * r * g.x, y.y * r * g.y); o.y = cvt_pk_bf16(y.z * r * g.z, y.w * r * g.w);
          *(v2u*)(mix + (size_t)(t0 + l) * D + 4 * lane) = o; } }
    __syncthreads();
}

__device__ __forceinline__ float gla_bcum(Frame& F, const Args& A, int layer, int d, const LAS float* GD, LAS float* BC) {
    float gup[16];
    { const f32x4* gp4 = (const f32x4*)(WSP(float, WS_LORA) + (size_t)layer * LORA_PER_LAYER + 32768 + d * 16);
#pragma unroll
      for (int i = 0; i < 4; ++i) { const f32x4 a = gp4[i]; gup[4 * i] = a.x; gup[4 * i + 1] = a.y; gup[4 * i + 2] = a.z; gup[4 * i + 3] = a.w; } }
    const float gb = KIN(I_GGB)[layer * 128 + d]; float bc = 0.f;
#pragma unroll 2
    for (int l = 0; l < 64; ++l) { float x = gb;
#pragma unroll
        for (int i = 0; i < 16; ++i) x += GD[l * 16 + i] * gup[i];
        bc += logsigmoidf_(x) * 0.0625f; BC[l * 128 + d] = bc; }
    return bc;
}
__device__ __forceinline__ void gla_stage1(Frame& F, const Args& A, int layer, int b, int c) {
    const float* u = WSP(float, WS_U);
    LAS unsigned char* L = F.lds;
    LAS float* GD = (LAS float*)L; LAS float* BC = (LAS float*)(L + 4096);
    LAS unsigned char* KDT = L + 36864; LAS unsigned char* VT = KDT + 128 * 144;
    const int t0 = b * SEQ + c * 64, tid = F.tid, lane = F.lane, wave = F.wave, fr = lane & 15, fq = lane >> 4;
    if (tid < 256) { const int l = tid >> 2, q4 = tid & 3; *(LAS f32x4*)(GD + l * 16 + q4 * 4) = *(const f32x4*)&UU(t0 + l, U_GL_G + 4 * q4); }
    __syncthreads();
    if (tid < 128) {
        const int d = tid; const float blast = gla_bcum(F, A, layer, d, GD, BC);
        WSP(float, WS_GLA_DEC)[(size_t)(b * NCH + c) * 128 + d] = __expf(blast);
        const float* up = u + (size_t)t0 * NUP + U_GL_K + d;
#pragma unroll 1
        for (int l0 = 0; l0 < 64; l0 += 32) { float xv[32];
#pragma unroll
            for (int j = 0; j < 32; ++j) xv[j] = up[(l0 + j) * NUP];
#pragma unroll
            for (int j8 = 0; j8 < 4; ++j8) { float o[8];
#pragma unroll
                for (int j = 0; j < 8; ++j) { const int l = l0 + j8 * 8 + j; o[j] = xv[j8 * 8 + j] * __expf(blast - BC[l * 128 + d]); }
                *(LAS v4u*)(KDT + d * 144 + (l0 + j8 * 8) * 2) = pack8(o); } }
    } else if (tid < 384) {
        const int vch = tid - 128; const float* up = u + (size_t)t0 * NUP + U_GL_V + vch;
#pragma unroll 1
        for (int l0 = 0; l0 < 64; l0 += 32) { float xv[32];
#pragma unroll
            for (int j = 0; j < 32; ++j) xv[j] = up[(l0 + j) * NUP];
#pragma unroll
            for (int j8 = 0; j8 < 4; ++j8) { float o[8];
#pragma unroll
                for (int j = 0; j < 8; ++j) o[j] = xv[j8 * 8 + j];
                *(LAS v4u*)(VT + vch * 144 + (l0 + j8 * 8) * 2) = pack8(o); } }
    }
    __syncthreads();
    { float* st = WSP(float, WS_GLA_ST);
#pragma unroll 1
      for (int i = 0; i < 4; ++i) { const int idx = 4 * wave + i, hh = idx >> 3, dtl = (idx >> 2) & 1, vt = idx & 3;
          f32x4 acc = {0.f, 0.f, 0.f, 0.f}; acc = mm16(KDT + (hh * 32 + dtl * 16) * 144, 144, VT + (hh * 64 + vt * 16) * 144, 144, 64, acc, fr, fq);
          *(f32x4*)(st + (((size_t)(b * 4 + hh) * NCH + c) * 32 + dtl * 16 + fr) * 64 + vt * 16 + 4 * fq) = acc; } }
    __syncthreads();
}
__device__ __forceinline__ void gla_stage3(Frame& F, const Args& A, int layer, int b, int c) {
    const float* u = WSP(float, WS_U);
    LAS unsigned char* L = F.lds;
    LAS float* GD = (LAS float*)L; LAS float* BC = (LAS float*)(L + 4096); LAS unsigned char* ATT = L + 4096;
    LAS unsigned char* QD = L + 40960; LAS unsigned char* KI = QD + 64 * 272; LAS unsigned char* VT = KI + 64 * 272; LAS unsigned char* PVT = VT + 256 * 144;
    const int t0 = b * SEQ + c * 64, tid = F.tid, lane = F.lane, wave = F.wave, fr = lane & 15, fq = lane >> 4;
    if (tid < 256) { const int l = tid >> 2, q4 = tid & 3; *(LAS f32x4*)(GD + l * 16 + q4 * 4) = *(const f32x4*)&UU(t0 + l, U_GL_G + 4 * q4); }
    __syncthreads();
    if (tid < 128) {
        const int d = tid; (void)gla_bcum(F, A, layer, d, GD, BC);
        const float* uq = u + (size_t)t0 * NUP + U_GL_Q + d; const float* uk = u + (size_t)t0 * NUP + U_GL_K + d;
#pragma unroll 1
        for (int l0 = 0; l0 < 64; l0 += 16) { float qv[16], kv[16];
#pragma unroll
            for (int j = 0; j < 16; ++j) { qv[j] = uq[(l0 + j) * NUP]; kv[j] = uk[(l0 + j) * NUP]; }
#pragma unroll
            for (int j = 0; j < 16; ++j) { const int l = l0 + j; const float bc = BC[l * 128 + d];
                lds_st_bf16(QD + l * 272 + d * 2, qv[j] * 0.17677669529663687f * __expf(bc)); lds_st_bf16(KI + l * 272 + d * 2, kv[j] * __expf(-bc)); } }
    } else if (tid < 384) {
        const int vch = tid - 128; const float* up = u + (size_t)t0 * NUP + U_GL_V + vch;
#pragma unroll 1
        for (int l0 = 0; l0 < 64; l0 += 32) { float xv[32];
#pragma unroll
            for (int j = 0; j < 32; ++j) xv[j] = up[(l0 + j) * NUP];
#pragma unroll
            for (int j8 = 0; j8 < 4; ++j8) { float o[8];
#pragma unroll
                for (int j = 0; j < 8; ++j) o[j] = xv[j8 * 8 + j];
                *(LAS v4u*)(VT + vch * 144 + (l0 + j8 * 8) * 2) = pack8(o); } }
    } else {
        const float* prev = WSP(float, WS_GLA_ST);
#pragma unroll 4
        for (int i = tid - 384; i < 8192; i += 128) { const int hh = i >> 11, dd = (i >> 6) & 31, vv = i & 63;
            lds_st_bf16(PVT + (hh * 64 + vv) * 80 + dd * 2, prev[((size_t)(b * 4 + hh) * NCH + c) * 2048 + dd * 64 + vv]); }
    }
    __syncthreads();
    const int hh = wave >> 1;
#pragma unroll 1
    for (int i = 0; i < 2; ++i) { const int tt = 2 * (wave & 1) + i, t = tt * 16 + fr;
#pragma unroll
        for (int st = 0; st < 4; ++st) { f32x4 acc = {0.f, 0.f, 0.f, 0.f}; acc = mm16(QD + tt * 16 * 272 + hh * 64, 272, KI + st * 16 * 272 + hh * 64, 272, 32, acc, fr, fq);
            const int s0 = st * 16 + 4 * fq;
            lds_st_bf16x4(ATT + hh * 9216 + t * 144 + s0 * 2, t >= s0 ? acc[0] : 0.f, t >= s0 + 1 ? acc[1] : 0.f, t >= s0 + 2 ? acc[2] : 0.f, t >= s0 + 3 ? acc[3] : 0.f); } }
    __syncthreads();
    { bf16* mix = WSP(bf16, WS_MIX); const float* ng = KIN(I_GNG) + layer * 256;
#pragma unroll 1
      for (int i = 0; i < 2; ++i) { const int tt = 2 * (wave & 1) + i, t = tt * 16 + fr; f32x4 ov[4]; float ss = 0.f;
#pragma unroll
          for (int vt = 0; vt < 4; ++vt) { f32x4 acc = {0.f, 0.f, 0.f, 0.f};
              acc = mm16(ATT + hh * 9216 + tt * 16 * 144, 144, VT + (hh * 64 + vt * 16) * 144, 144, 64, acc, fr, fq);
              acc = mm16(QD + tt * 16 * 272 + hh * 64, 272, PVT + (hh * 64 + vt * 16) * 80, 80, 32, acc, fr, fq);
              ov[vt] = acc; ss += (acc.x * acc.x + acc.y * acc.y) + (acc.z * acc.z + acc.w * acc.w); }
          ss += __shfl_xor(ss, 16); ss += __shfl_xor(ss, 32);
          const float r = 1.0f / sqrtf(ss * (1.f / 64.f) + NORM_EPS);
#pragma unroll
          for (int vt = 0; vt < 4; ++vt) { const int col = hh * 64 + vt * 16 + 4 * fq; const f32x4 g = *(const f32x4*)(ng + col); const f32x4 og = *(const f32x4*)&UU(t0 + t, U_GL_OG + col);
              v2u o; o.x = cvt_pk_bf16(ov[vt].x * r * g.x * siluf_(og.x), ov[vt].y * r * g.y * siluf_(og.y)); o.y = cvt_pk_bf16(ov[vt].z * r * g.z * siluf_(og.z), ov[vt].w * r * g.w * siluf_(og.w));
              *(v2u*)(mix + (size_t)(t0 + t) * D + 512 + col) = o; } } }
    __syncthreads();
}

__device__ __forceinline__ void mlstm_stage1(Frame& F, const Args& A, int layer, int b, int c) {
    const float* u = WSP(float, WS_U);
    LAS unsigned char* L = F.lds;
    LAS float* WST = (LAS float*)L; LAS unsigned char* KT = L + 1024; LAS unsigned char* VWT = KT + 256 * 144;
    const int t0 = b * SEQ + c * 64, tid = F.tid, lane = F.lane, wave = F.wave, fr = lane & 15, fq = lane >> 4;
    if (wave < 4) {
        const int hh = wave;
        const float ig = UU(t0 + lane, U_ML_I + hh) + KIN(I_MIB)[layer * 4 + hh];
        const float lf = logsigmoidf_(UU(t0 + lane, U_ML_F + hh) + KIN(I_MFB)[layer * 4 + hh]);
        const float bc = wave_scan_add(lf, lane); const float blast = __shfl(bc, 63);
        const float ast = blast - bc + ig; const float mloc = wave_max(ast);
        WST[hh * 64 + lane] = __expf(ast - mloc);
        if (lane == 0) { WSP(float, WS_ML_BL)[(b * 4 + hh) * NCH + c] = blast; WSP(float, WS_ML_ML)[(b * 4 + hh) * NCH + c] = mloc; }
    } else {
        const int kch = tid - 256, cc = 256 + kch; const float* cw = KIN(I_MCW) + (size_t)layer * 2048 + cc; const float w0 = cw[0], w1 = cw[512], w2 = cw[1024], w3 = cw[1536], cb = KIN(I_MCB)[layer * 512 + cc];
        const float* up = u + (size_t)t0 * NUP + U_ML_K + kch;
        float win0 = 0.f, win1 = 0.f, win2 = 0.f;
        if (c > 0) { win0 = up[-3 * NUP]; win1 = up[-2 * NUP]; win2 = up[-1 * NUP]; }
#pragma unroll 1
        for (int l0 = 0; l0 < 64; l0 += 32) { float xv[32];
#pragma unroll
            for (int j = 0; j < 32; ++j) xv[j] = up[(l0 + j) * NUP];
#pragma unroll
            for (int j8 = 0; j8 < 4; ++j8) { float o[8];
#pragma unroll
                for (int j = 0; j < 8; ++j) { const float x = xv[j8 * 8 + j]; const float y = cb + w0 * win0 + w1 * win1 + w2 * win2 + w3 * x; win0 = win1; win1 = win2; win2 = x; o[j] = siluf_(y); }
                *(LAS v4u*)(KT + kch * 144 + (l0 + j8 * 8) * 2) = pack8(o); } }
    }
    __syncthreads();
    if (tid < 256) {
        const int vch = tid, hh = vch >> 6; const float* up = u + (size_t)t0 * NUP + U_ML_V + vch;
#pragma unroll 1
        for (int l0 = 0; l0 < 64; l0 += 32) { float xv[32];
#pragma unroll
            for (int j = 0; j < 32; ++j) xv[j] = up[(l0 + j) * NUP];
#pragma unroll
            for (int j8 = 0; j8 < 4; ++j8) { float o[8];
#pragma unroll
                for (int j = 0; j < 8; ++j) o[j] = xv[j8 * 8 + j] * WST[hh * 64 + l0 + j8 * 8 + j];
                *(LAS v4u*)(VWT + vch * 144 + (l0 + j8 * 8) * 2) = pack8(o); } }
    } else {
        const int kch = tid - 256, hh = kch >> 6; float n = 0.f;
#pragma unroll 8
        for (int s = 0; s < 64; ++s) n += WST[hh * 64 + s] * bf2f(*(const LAS unsigned short*)(KT + kch * 144 + s * 2));
        WSP(float, WS_ML_N)[((size_t)(b * 4 + hh) * NCH + c) * 64 + (kch & 63)] = n;
    }
    __syncthreads();
    { float* cst = WSP(float, WS_ML_C); const int hh = wave >> 1;
#pragma unroll 1
      for (int i = 0; i < 2; ++i) { const int vt = 2 * (wave & 1) + i;
#pragma unroll 1
          for (int kt = 0; kt < 4; ++kt) { f32x4 acc = {0.f, 0.f, 0.f, 0.f}; acc = mm16(VWT + (hh * 64 + vt * 16) * 144, 144, KT + (hh * 64 + kt * 16) * 144, 144, 64, acc, fr, fq);
              *(f32x4*)(cst + (((size_t)(b * 4 + hh) * NCH + c) * 64 + vt * 16 + fr) * 64 + kt * 16 + 4 * fq) = acc; } } }
    __syncthreads();
}
__device__ __forceinline__ void mlstm_stage3(Frame& F, const Args& A, int layer, int b, int c) {
    const float* u = WSP(float, WS_U);
    LAS unsigned char* L = F.lds;
    LAS float* BCU = (LAS float*)L; LAS float* GG = BCU + 256; LAS float* MROW = BCU + 512; LAS float* WINT = BCU + 768; LAS float* NPV = BCU + 1024;
    LAS unsigned char* Q = L + 6144; LAS unsigned char* KK = Q + 64 * 528; LAS unsigned char* VT = KK + 64 * 528; LAS unsigned char* SC = VT + 256 * 144;
    const int t0 = b * SEQ + c * 64, tid = F.tid, lane = F.lane, wave = F.wave, fr = lane & 15, fq = lane >> 4;
    if (wave < 4) {
        const int hh = wave;
        const float ig = UU(t0 + lane, U_ML_I + hh) + KIN(I_MIB)[layer * 4 + hh];
        const float lf = logsigmoidf_(UU(t0 + lane, U_ML_F + hh) + KIN(I_MFB)[layer * 4 + hh]);
        const float bc = wave_scan_add(lf, lane); const float gg = ig - bc;
        const float mprev = WSP(float, WS_ML_M)[(b * 4 + hh) * NCH + c];
        const float minter = bc + mprev, mintra = bc + wave_scan_max(gg, lane), mrow = fmaxf(minter, mintra);
        BCU[hh * 64 + lane] = bc; GG[hh * 64 + lane] = gg; MROW[hh * 64 + lane] = mrow; WINT[hh * 64 + lane] = __expf(minter - mrow);
        NPV[hh * 64 + lane] = WSP(float, WS_ML_N)[((size_t)(b * 4 + hh) * NCH + c) * 64 + lane];
    }
    {
        const int cc = tid; const float* cw = KIN(I_MCW) + (size_t)layer * 2048 + cc; const float w0 = cw[0], w1 = cw[512], w2 = cw[1024], w3 = cw[1536], cb = KIN(I_MCB)[layer * 512 + cc];
        const float* up = u + (size_t)t0 * NUP + U_ML_Q + cc;
        float win0 = 0.f, win1 = 0.f, win2 = 0.f;
        if (c > 0) { win0 = up[-3 * NUP]; win1 = up[-2 * NUP]; win2 = up[-1 * NUP]; }
        LAS unsigned char* dst = cc < 256 ? Q + cc * 2 : KK + (cc - 256) * 2; const float sc = cc < 256 ? 0.125f : 1.0f;
#pragma unroll 1
        for (int l0 = 0; l0 < 64; l0 += 32) { float xv[32];
#pragma unroll
            for (int j = 0; j < 32; ++j) xv[j] = up[(l0 + j) * NUP];
#pragma unroll
            for (int j = 0; j < 32; ++j) { const float x = xv[j]; const float y = cb + w0 * win0 + w1 * win1 + w2 * win2 + w3 * x; win0 = win1; win1 = win2; win2 = x; lds_st_bf16(dst + (l0 + j) * 528, siluf_(y) * sc); } }
        const int vch = tid & 255, lh = (tid >> 8) * 32; const float* uv = u + (size_t)(t0 + lh) * NUP + U_ML_V + vch;
        float xv[32];
#pragma unroll
        for (int j = 0; j < 32; ++j) xv[j] = uv[j * NUP];
#pragma unroll
        for (int j8 = 0; j8 < 4; ++j8) { float o[8];
#pragma unroll
            for (int j = 0; j < 8; ++j) o[j] = xv[j8 * 8 + j];
            *(LAS v4u*)(VT + vch * 144 + (lh + j8 * 8) * 2) = pack8(o); }
    }
    __syncthreads();
    { const int hh = wave >> 1; bf16* mix = WSP(bf16, WS_MIX); const float* ng = KIN(I_MNG) + layer * 256;
      const float* cprev = WSP(float, WS_ML_C) + ((size_t)(b * 4 + hh) * NCH + c) * 4096;
#pragma unroll 1
      for (int i = 0; i < 2; ++i) { const int tt = 2 * (wave & 1) + i, t = tt * 16 + fr;
          const float bt = BCU[hh * 64 + t] - MROW[hh * 64 + t]; float rs = 0.f;
#pragma unroll
          for (int st = 0; st < 4; ++st) { f32x4 acc = {0.f, 0.f, 0.f, 0.f}; acc = mm16(Q + tt * 16 * 528 + hh * 128, 528, KK + st * 16 * 528 + hh * 128, 528, 64, acc, fr, fq);
              const int s0 = st * 16 + 4 * fq; float o[4];
#pragma unroll
              for (int j = 0; j < 4; ++j) { const int s = s0 + j; const float v = (t >= s) ? acc[j] * __expf(bt + GG[hh * 64 + s]) : 0.f; o[j] = v; rs += v; }
              lds_st_bf16x4(SC + hh * 9216 + t * 144 + s0 * 2, o[0], o[1], o[2], o[3]); }
          rs += __shfl_xor(rs, 16); rs += __shfl_xor(rs, 32);
          float nq = 0.f;
#pragma unroll
          for (int j = 0; j < 16; ++j) nq += bf2f(*(const LAS unsigned short*)(Q + t * 528 + (hh * 64 + fq * 16 + j) * 2)) * NPV[hh * 64 + fq * 16 + j];
          nq += __shfl_xor(nq, 16); nq += __shfl_xor(nq, 32);
          const float wi = WINT[hh * 64 + t]; const float den = wi * nq + rs; const float dn = fmaxf(fabsf(den), __expf(-MROW[hh * 64 + t])); const float rdn = 1.0f / dn;
          LDS_WAIT();
          f32x4 hv[4]; float sm = 0.f;
#pragma unroll
          for (int vt = 0; vt < 4; ++vt) { f32x4 acc = {0.f, 0.f, 0.f, 0.f};
              acc = mm16_gB(Q + tt * 16 * 528 + hh * 128, 528, cprev + (size_t)(vt * 16) * 64, 64, 64, acc, fr, fq);
              acc = acc * wi;
              acc = mm16(SC + hh * 9216 + tt * 16 * 144, 144, VT + (hh * 64 + vt * 16) * 144, 144, 64, acc, fr, fq);
              const f32x4 og = *(const f32x4*)&UU(t0 + t, U_ML_O + hh * 64 + vt * 16 + 4 * fq);
              f32x4 h; h.x = acc.x * rdn * sigmoidf_(og.x); h.y = acc.y * rdn * sigmoidf_(og.y); h.z = acc.z * rdn * sigmoidf_(og.z); h.w = acc.w * rdn * sigmoidf_(og.w);
              hv[vt] = h; sm += (h.x + h.y) + (h.z + h.w); }
          sm += __shfl_xor(sm, 16); sm += __shfl_xor(sm, 32);
          const float mean = sm * (1.f / 64.f); float sq = 0.f;
#pragma unroll
          for (int vt = 0; vt < 4; ++vt) { hv[vt] = hv[vt] - mean; sq += (hv[vt].x * hv[vt].x + hv[vt].y * hv[vt].y) + (hv[vt].z * hv[vt].z + hv[vt].w * hv[vt].w); }
          sq += __shfl_xor(sq, 16); sq += __shfl_xor(sq, 32);
          const float r = 1.0f / sqrtf(sq * (1.f / 64.f) + NORM_EPS);
#pragma unroll
          for (int vt = 0; vt < 4; ++vt) { const int col = hh * 64 + vt * 16 + 4 * fq; const f32x4 g = *(const f32x4*)(ng + col);
              v2u o; o.x = cvt_pk_bf16(hv[vt].x * r * g.x, hv[vt].y * r * g.y); o.y = cvt_pk_bf16(hv[vt].z * r * g.z, hv[vt].w * r * g.w);
              *(v2u*)(mix + (size_t)(t0 + t) * D + 768 + col) = o; } } }
    __syncthreads();
}

__device__ __forceinline__ void rwkv_stage1(Frame& F, const Args& A, int layer, int ub) {
    const float* u = WSP(float, WS_U);
    LAS float* LO = (LAS float*)F.lds;
    const int t0 = ub * 64, tid = F.tid;
    const float* mu = KIN(I_RMU) + layer * 896;
    for (int i = tid; i < 64 * 128; i += NWAVES * 64) { const int l = i >> 7, j = i & 127, t = t0 + l; const float cur = UU(t, U_RW_LO + j); const float prv = (t & (SEQ - 1)) ? UU(t - 1, U_RW_LO + j) : 0.f;
        const float xs = cur + (prv - cur) * mu[768 + j]; LO[i] = j < 32 ? tanhf(xs) : (j < 64 ? xs : sigmoidf_(xs)); }
    __syncthreads();
    const int ch = tid & 255, half = tid >> 8;
    float* RW = WSP(float, WS_RW); float* RG = WSP(float, WS_RW_G);
    if (half == 0) {
        float wup[32], aup[32];
        { const f32x4* wp4 = (const f32x4*)(WSP(float, WS_LORA) + (size_t)layer * LORA_PER_LAYER + ch * 32); const f32x4* ap4 = (const f32x4*)(WSP(float, WS_LORA) + (size_t)layer * LORA_PER_LAYER + 8192 + ch * 32);
#pragma unroll
          for (int j = 0; j < 8; ++j) { const f32x4 a = wp4[j], b = ap4[j]; wup[4 * j] = a.x; wup[4 * j + 1] = a.y; wup[4 * j + 2] = a.z; wup[4 * j + 3] = a.w; aup[4 * j] = b.x; aup[4 * j + 1] = b.y; aup[4 * j + 2] = b.z; aup[4 * j + 3] = b.w; } }
        const float w0 = KIN(I_RW0)[layer * 256 + ch], a0 = KIN(I_RA0)[layer * 256 + ch], kkc = KIN(I_RKK)[layer * 256 + ch], kac = KIN(I_RKA)[layer * 256 + ch];
        const float mur = mu[ch], muk = mu[256 + ch], muv = mu[512 + ch];
        const bool seq0 = (t0 & (SEQ - 1)) == 0;
        float rp = seq0 ? 0.f : UU(t0 - 1, U_RW_R + ch), kp = seq0 ? 0.f : UU(t0 - 1, U_RW_K + ch), vp = seq0 ? 0.f : UU(t0 - 1, U_RW_V + ch);
#pragma unroll 1
        for (int l0 = 0; l0 < 64; l0 += 8) { float rc[8], kc[8], vc[8];
#pragma unroll
            for (int j = 0; j < 8; ++j) { rc[j] = UU(t0 + l0 + j, U_RW_R + ch); kc[j] = UU(t0 + l0 + j, U_RW_K + ch); vc[j] = UU(t0 + l0 + j, U_RW_V + ch); }
#pragma unroll
            for (int j = 0; j < 8; ++j) { const int l = l0 + j, t = t0 + l;
                const float r = rc[j] + (rp - rc[j]) * mur, k = kc[j] + (kp - kc[j]) * muk, v = vc[j] + (vp - vc[j]) * muv; rp = rc[j]; kp = kc[j]; vp = vc[j];
                float wp = w0, ap = a0;
#pragma unroll
                for (int q = 0; q < 32; ++q) { wp += LO[l * 128 + q] * wup[q]; ap += LO[l * 128 + 32 + q] * aup[q]; }
                const float w = -softplusf_(-wp) - 0.5f; const float dec = __expf(-__expf(w)); const float a = sigmoidf_(ap);
                const float kk = k * kkc; const float nrm = sqrtf(wave_sum(kk * kk)); const float kkn = kk / fmaxf(nrm, 1e-12f);
                const float k2 = k * (1.0f + (a - 1.0f) * kac);
                float* o = RW + (size_t)t * 1536 + ch; o[0] = r; o[256] = dec; o[512] = k2; o[768] = v; o[1024] = -kkn; o[1280] = kkn * a; } }
    } else {
        float gup[64];
        { const f32x4* gp4 = (const f32x4*)(WSP(float, WS_LORA) + (size_t)layer * LORA_PER_LAYER + 16384 + ch * 64);
#pragma unroll
          for (int j = 0; j < 16; ++j) { const f32x4 a = gp4[j]; gup[4 * j] = a.x; gup[4 * j + 1] = a.y; gup[4 * j + 2] = a.z; gup[4 * j + 3] = a.w; } }
#pragma unroll 1
        for (int l = 0; l < 64; ++l) { float g = 0.f;
#pragma unroll
            for (int j = 0; j < 64; ++j) g += LO[l * 128 + 64 + j] * gup[j];
            RG[(size_t)(t0 + l) * 256 + ch] = g; }
    }
    __syncthreads();
}
#define DPP_ADD(v, ctrl) v += __builtin_bit_cast(float, __builtin_amdgcn_update_dpp(0, __builtin_bit_cast(int, v), ctrl, 0xF, 0xF, true))
__device__ __forceinline__ float row16_sum(float v) { DPP_ADD(v, 0xB1); DPP_ADD(v, 0x4E); DPP_ADD(v, 0x141); DPP_ADD(v, 0x140); return v; }
__device__ __forceinline__ void rwkv_scan_wave(Frame& F, const Args& A, int wslot) {
    const int lane = F.lane, bh = wslot >> 4, b = bh >> 2, h = bh & 3, v0 = (wslot & 15) * 4 + (lane >> 4), kq = lane & 15;
    const float* RW = WSP(float, WS_RW) + (size_t)b * SEQ * 1536 + h * 64 + 4 * kq;
    const float* RV = WSP(float, WS_RW) + (size_t)b * SEQ * 1536 + 768 + h * 64 + v0;
    float* RO = WSP(float, WS_RW_O) + (size_t)b * SEQ * 256 + h * 64 + v0;
    f32x4 s = {0.f, 0.f, 0.f, 0.f};
    f32x4 r_[4], w_[4], k_[4], a_[4], b_[4]; float v_[4];
#define RW_LOAD(tb) do { _Pragma("unroll") for (int j = 0; j < 4; ++j) { const float* p = RW + (size_t)((tb) + j) * 1536; r_[j] = *(const f32x4*)p; w_[j] = *(const f32x4*)(p + 256); k_[j] = *(const f32x4*)(p + 512); a_[j] = *(const f32x4*)(p + 1024); b_[j] = *(const f32x4*)(p + 1280); v_[j] = RV[(size_t)((tb) + j) * 1536]; } } while (0)
    RW_LOAD(0);
#pragma unroll 1
    for (int tb = 0; tb < SEQ; tb += 4) {
        f32x4 rc[4], wc[4], kc[4], ac[4], bc[4]; float vc[4];
#pragma unroll
        for (int j = 0; j < 4; ++j) { rc[j] = r_[j]; wc[j] = w_[j]; kc[j] = k_[j]; ac[j] = a_[j]; bc[j] = b_[j]; vc[j] = v_[j]; }
        if (tb + 4 < SEQ) RW_LOAD(tb + 4);
#pragma unroll
        for (int j = 0; j < 4; ++j) {
            float p = (s.x * ac[j].x + s.y * ac[j].y) + (s.z * ac[j].z + s.w * ac[j].w);
            const float sa = row16_sum(p);
            s.x = s.x * wc[j].x + (sa * bc[j].x + vc[j] * kc[j].x); s.y = s.y * wc[j].y + (sa * bc[j].y + vc[j] * kc[j].y);
            s.z = s.z * wc[j].z + (sa * bc[j].z + vc[j] * kc[j].z); s.w = s.w * wc[j].w + (sa * bc[j].w + vc[j] * kc[j].w);
            float q = (s.x * rc[j].x + s.y * rc[j].y) + (s.z * rc[j].z + s.w * rc[j].w);
            const float o = row16_sum(q);
            if (kq == 0) RO[(size_t)(tb + j) * 256] = o;
        }
    }
#undef RW_LOAD
}
__device__ __forceinline__ void rwkv_stage3(Frame& F, const Args& A, int layer, int ub) {
    const int t0 = ub * 64, tid = F.tid, ch = tid & 255, half = tid >> 8;
    const float* RW = WSP(float, WS_RW); const float* RG = WSP(float, WS_RW_G); const float* RO = WSP(float, WS_RW_O); bf16* mix = WSP(bf16, WS_MIX);
    const float lg = KIN(I_RLNG)[layer * 256 + ch], lb = KIN(I_RLNB)[layer * 256 + ch], rk = KIN(I_RRK)[layer * 256 + ch];
#pragma unroll 4
    for (int li = 0; li < 32; ++li) { const int t = t0 + half * 32 + li;
        const float o = RO[(size_t)t * 256 + ch]; const float* p = RW + (size_t)t * 1536 + ch; const float r = p[0], k2 = p[512], v = p[768], g = RG[(size_t)t * 256 + ch];
        const float mean = wave_sum(o) * (1.f / 64.f); const float d = o - mean; const float var = wave_sum(d * d) * (1.f / 64.f);
        const float on = d * (1.0f / sqrtf(var + RWKV_GN_EPS)) * lg + lb; const float bonus = wave_sum(r * k2 * rk) * v;
        mix[(size_t)t * D + 256 + ch] = (bf16)(cvt_pk_bf16((on + bonus) * g, 0.f) & 0xffffu); }
}

__device__ __forceinline__ void scans_elementwise(Frame& F, const Args& A) {
    const int nthr = F.G * 448, gt = F.vcu * 448 + (F.tid - 64);
    constexpr int N_SSD = 16 * 64 * 128, N_GLA = 16 * 32 * 64, N_MLC = 16 * 64 * 64, N_MLN = 16 * 64;
    for (int i = gt; i < N_SSD + N_GLA + N_MLC + N_MLN; i += nthr) {
        if (i < N_SSD) { const int bh = i >> 13, pn = i & 8191; float* base = WSP(float, WS_SSD_ST) + (size_t)bh * NCH * 8192 + pn; const float* dec = WSP(float, WS_SSD_DEC) + bh * NCH; float S = 0.f;
#pragma unroll 1
            for (int c0 = 0; c0 < NCH; c0 += 8) { float x[8], dd[8];
#pragma unroll
                for (int j = 0; j < 8; ++j) { x[j] = base[(size_t)(c0 + j) * 8192]; dd[j] = dec[c0 + j]; }
#pragma unroll
                for (int j = 0; j < 8; ++j) { base[(size_t)(c0 + j) * 8192] = S; S = dd[j] * S + x[j]; } }
        } else if (i < N_SSD + N_GLA) { const int k = i - N_SSD, bh = k >> 11, dv = k & 2047, dd_ = dv >> 6, b = bh >> 2, hh = bh & 3; float* base = WSP(float, WS_GLA_ST) + (size_t)bh * NCH * 2048 + dv; const float* dec = WSP(float, WS_GLA_DEC) + (size_t)b * NCH * 128 + hh * 32 + dd_; float S = 0.f;
#pragma unroll 1
            for (int c0 = 0; c0 < NCH; c0 += 8) { float x[8], dd[8];
#pragma unroll
                for (int j = 0; j < 8; ++j) { x[j] = base[(size_t)(c0 + j) * 2048]; dd[j] = dec[(c0 + j) * 128]; }
#pragma unroll
                for (int j = 0; j < 8; ++j) { base[(size_t)(c0 + j) * 2048] = S; S = dd[j] * S + x[j]; } }
        } else { const int k = i - N_SSD - N_GLA; const bool isn = k >= N_MLC; const int kk = isn ? k - N_MLC : k; const int bh = isn ? (kk >> 6) : (kk >> 12), e = isn ? (kk & 63) : (kk & 4095), str = isn ? 64 : 4096;
            float* base = (isn ? WSP(float, WS_ML_N) : WSP(float, WS_ML_C)) + (size_t)bh * NCH * str + e; const float* bl = WSP(float, WS_ML_BL) + bh * NCH; const float* ml = WSP(float, WS_ML_ML) + bh * NCH; float* mo = WSP(float, WS_ML_M) + bh * NCH;
            float S = 0.f, m = 0.f;
#pragma unroll 1
            for (int c0 = 0; c0 < NCH; c0 += 8) { float x[8], b8[8], m8[8];
#pragma unroll
                for (int j = 0; j < 8; ++j) { x[j] = base[(size_t)(c0 + j) * str]; b8[j] = bl[c0 + j]; m8[j] = ml[c0 + j]; }
#pragma unroll
                for (int j = 0; j < 8; ++j) { const float mn = fmaxf(b8[j] + m, m8[j]); const float so = __expf(b8[j] + m - mn), sn = __expf(m8[j] - mn);
                    base[(size_t)(c0 + j) * str] = S; if (!isn && e == 0) mo[c0 + j] = m; S = so * S + sn * x[j]; m = mn; } }
        }
    }
}
#ifndef MK_PER_PHASE_LAUNCH
#define MK_PER_PHASE_LAUNCH 1
#endif
#ifndef PH_MASK
#define PH_MASK 0xFFF
#endif
#ifndef ST_MASK
#define ST_MASK 0xF
#endif
#define ST_ON(k) (((ST_MASK) >> (k)) & 1)
#define PH_ON(k) (((PH_MASK) >> (k)) & 1)
constexpr int PH_PER_LAYER = 11, N_PHASES = 1 + DEPTH * PH_PER_LAYER;
__global__ void __launch_bounds__(NWAVES * 64, 2) fwd_kernel(Args args) {
    extern __shared__ __attribute__((aligned(16))) unsigned char lds[];
    Frame F;
    F.lds = (LAS unsigned char*)lds;
    F.MISC = (volatile LAS unsigned*)(F.lds + MISC_OFF);
    F.tid = threadIdx.x; F.lane = F.tid & 63; F.wave = __builtin_amdgcn_readfirstlane(F.tid >> 6);
    F.G = gridDim.x; { const int bx = blockIdx.x; F.vcu = (F.G % 8 == 0) ? (bx % 8) * (F.G / 8) + bx / 8 : bx; }
    F.ka = (karg_t)__builtin_amdgcn_kernarg_segment_ptr(); F.ws = args.ws; F.ctl = (gu32*)(args.ws + WS_CTL); F.out = args.out;
    for (int i = F.tid; i < 256; i += NWAVES * 64) F.MISC[i] = 0u;
    __syncthreads();
    const int lo = args.ph_lo, hi = args.ph_hi;
    XcdBarrier bar; bar.bar = (unsigned*)(F.ctl + CW_BAR); bar.x = 0; bar.st = nullptr;
    if (hi - lo > 1) bar = xcd_barrier_post((unsigned*)(F.ctl + CW_BAR), F.MISC + MW_BAR);
#define IN_(k) (lo <= (k) && (k) < hi)
#define SEAM(k) do { if (IN_(k) && IN_((k) + 1)) xcd_barrier(bar); } while (0)

    if (PH_ON(11) && IN_(0)) { frame_refresh(F); p0_prologue(F, args); SEAM(0); }
#pragma unroll 1
    for (int layer = 0; layer < DEPTH; ++layer) {
        const int pb = 1 + layer * PH_PER_LAYER;
        if (PH_ON(0) && IN_(pb + 0)) { frame_refresh(F);
            { pg8::DenseSched S; S.init(WSP(bf16, WS_XB), WSP(bf16, WS_WIN_T) + (size_t)layer * NUP * D, T, NUP, D, F.G, (int)blockIdx.x);
              pg8::EpiF32 E{WSP(float, WS_U), NUP, nullptr, 0.f};
              pg8::gemm_phase<pg8::EpiF32, pg8::DenseSched>(F.lds, F.tid, S, E); }
            { pg8::DenseSched S; S.init(WSP(bf16, WS_PB) + (size_t)layer * T * 256, WSP(bf16, WS_WPP_T) + (size_t)layer * D * 256, T, D, 256, F.G, (int)blockIdx.x);
              pg8::EpiF32 E{WSP(float, WS_PE), D, nullptr, 0.f};
              pg8::gemm_phase<pg8::EpiF32, pg8::DenseSched>(F.lds, F.tid, S, E); }
            SEAM(pb + 0);
        }
        if (PH_ON(1) && IN_(pb + 1)) { frame_refresh(F);
            for (int un = F.vcu; un < 1024; un += F.G) { frame_refresh(F); const int ty = un >> 8, r = un & 255, b = r >> 6, c = r & 63;
                if (ST_ON(0) && ty == 0) ssd_stage1(F, args, layer, b, c); else if (ST_ON(1) && ty == 1) gla_stage1(F, args, layer, b, c); else if (ST_ON(2) && ty == 2) mlstm_stage1(F, args, layer, b, c); else if (ST_ON(3) && ty == 3) rwkv_stage1(F, args, layer, r); }
            SEAM(pb + 1);
        }
        if (PH_ON(2) && IN_(pb + 2)) { frame_refresh(F);
            if (F.wave == 0) { for (int ws_ = F.vcu; ws_ < 256; ws_ += F.G) rwkv_scan_wave(F, args, ws_); }
            else scans_elementwise(F, args);
            SEAM(pb + 2);
        }
        if (PH_ON(3) && IN_(pb + 3)) { frame_refresh(F);
            for (int un = F.vcu; un < 1024; un += F.G) { frame_refresh(F); const int ty = un >> 8, r = un & 255, b = r >> 6, c = r & 63;
                if (ST_ON(0) && ty == 0) ssd_stage3(F, args, layer, b, c); else if (ST_ON(1) && ty == 1) gla_stage3(F, args, layer, b, c); else if (ST_ON(2) && ty == 2) mlstm_stage3(F, args, layer, b, c); else if (ST_ON(3) && ty == 3) rwkv_stage3(F, args, layer, r); }
            SEAM(pb + 3);
        }
        if (PH_ON(4) && IN_(pb + 4)) { frame_refresh(F);
            pg8::DenseSched S; S.init(WSP(bf16, WS_MIX), WSP(bf16, WS_WOUT_T) + (size_t)layer * D * D, T, D, D, F.G, (int)blockIdx.x);
            pg8::EpiF32 E{WSP(float, WS_Y1), D, layer == 0 ? KIN(I_X) : (const float*)F.out, DN_ALPHA};
            pg8::gemm_phase<pg8::EpiF32, pg8::DenseSched>(F.lds, F.tid, S, E);
            SEAM(pb + 4);
        }
        if (PH_ON(5) && IN_(pb + 5)) { frame_refresh(F); p6_ln1_router(F, args, layer); SEAM(pb + 5); }
        if (PH_ON(6) && IN_(pb + 6)) { frame_refresh(F);
            moe_build_pfx(F, args, layer, 8);
            pg8::Moe1Sched S; S.O.pfx = F.MISC + MW_PFX; S.O.NT = 8; S.O.G = F.G; S.O.c = (int)blockIdx.x; S.X = WSP(bf16, WS_X1B); S.W = WSP(bf16, WS_WGU_T) + (size_t)layer * NE * 2048 * D; S.sdest = WSP(int, WS_SDEST); S.K = D; S.hstepB = (size_t)1024 * D * 2;
            pg8::EpiMoe1 E{WSP(bf16, WS_ABUF), KIN(I_BGU) + (size_t)layer * NE * 2048};
            pg8::gemm_phase<pg8::EpiMoe1, pg8::Moe1Sched>(F.lds, F.tid, S, E);
            SEAM(pb + 6);
        }
        if (PH_ON(7) && IN_(pb + 7)) { frame_refresh(F);
            moe_build_pfx(F, args, layer, 4);
            pg8::Moe2Sched S; S.O.pfx = F.MISC + MW_PFX; S.O.NT = 4; S.O.G = F.G; S.O.c = (int)blockIdx.x; S.Ab = WSP(bf16, WS_ABUF); S.W = WSP(bf16, WS_WDN_T) + (size_t)layer * NE * D * D; S.K = D; S.hstepB = (size_t)128 * D * 2;
            pg8::EpiMoe2 E{WSP(float, WS_YBUF), KIN(I_BDN) + (size_t)layer * NE * D, WSP(int, WS_SDEST), WSP(float, WS_SGATE)};
            pg8::gemm_phase<pg8::EpiMoe2, pg8::Moe2Sched>(F.lds, F.tid, S, E);
            SEAM(pb + 7);
        }
        if (PH_ON(8) && IN_(pb + 8)) { frame_refresh(F); p9_combine(F, args); SEAM(pb + 8); }
        if (PH_ON(9) && IN_(pb + 9)) { frame_refresh(F);
            pg8::DenseSched S; S.init(WSP(bf16, WS_HB), WSP(bf16, WS_WPG_T) + (size_t)layer * D * D, T, D, D, F.G, (int)blockIdx.x);
            pg8::EpiPle E{WSP(float, WS_H2), WSP(float, WS_H), WSP(float, WS_PE)};
            pg8::gemm_phase<pg8::EpiPle, pg8::DenseSched>(F.lds, F.tid, S, E);
            SEAM(pb + 9);
        }
        if (PH_ON(10) && IN_(pb + 10)) { frame_refresh(F); p11_ln2(F, args, layer); SEAM(pb + 10); }
    }
#undef IN_
#undef SEAM
}

extern "C" void kernel_launch(void* const* d_in, const int* in_sizes, int n_in, void* d_out, int out_size, void* d_ws, size_t ws_size, hipStream_t stream) {
    static int grid = 0;
    if (grid == 0) {
        if (n_in != N_IN || out_size != T * D || ws_size < WS_END) { fprintf(stderr, "kernel_launch: unexpected shapes (n_in %d, out %d, ws %zu < %zu); nothing launched\n", n_in, out_size, ws_size, (size_t)WS_END); grid = -1; return; }
        int dev = 0, cus = 0, per_cu = 0;
        if (hipGetDevice(&dev) != hipSuccess || hipDeviceGetAttribute(&cus, hipDeviceAttributeMultiprocessorCount, dev) != hipSuccess) { grid = -1; return; }
        if (hipFuncSetAttribute((const void*)fwd_kernel, hipFuncAttributeMaxDynamicSharedMemorySize, LDS_BYTES) != hipSuccess) { fprintf(stderr, "kernel_launch: hipFuncSetAttribute failed\n"); grid = -1; return; }
        if (hipOccupancyMaxActiveBlocksPerMultiprocessor(&per_cu, (const void*)fwd_kernel, NWAVES * 64, LDS_BYTES) != hipSuccess || per_cu < 1) { fprintf(stderr, "kernel_launch: occupancy query says %d blocks per CU\n", per_cu); }
        (void)hipGetLastError();
        grid = cus;
    }
    if (grid < 0) return;
    (void)hipMemsetAsync((char*)d_ws + WS_CTL, 0, CTL_ZERO_BYTES, stream);
    Args a{};
    for (int i = 0; i < N_IN; ++i) a.in[i] = (const float*)d_in[i];
    a.out = (float*)d_out; a.ws = (unsigned char*)d_ws;
#if MK_PER_PHASE_LAUNCH
    for (int ph = 0; ph < N_PHASES; ++ph) { a.ph_lo = ph; a.ph_hi = ph + 1; hipLaunchKernelGGL(fwd_kernel, dim3(grid), dim3(NWAVES * 64), LDS_BYTES, stream, a); }
#else
    a.ph_lo = 0; a.ph_hi = N_PHASES; hipLaunchKernelGGL(fwd_kernel, dim3(grid), dim3(NWAVES * 64), LDS_BYTES, stream, a);
#endif
    const hipError_t le = hipPeekAtLastError();
    if (le != hipSuccess) fprintf(stderr, "kernel_launch: launch failed: %s\n", hipGetErrorName(le));
}
```

```cpp
#include <hip/hip_runtime.h>
#include <cstdio>
#include <cstdint>

#define GAS __attribute__((address_space(1)))
#define LAS __attribute__((address_space(3)))
typedef unsigned short bf16;
typedef unsigned v4u __attribute__((ext_vector_type(4)));
typedef unsigned v2u __attribute__((ext_vector_type(2)));
typedef float f32x4 __attribute__((ext_vector_type(4)));
typedef float f32x2 __attribute__((ext_vector_type(2)));
typedef short bf16x8 __attribute__((ext_vector_type(8)));
typedef GAS unsigned gu32;
#define RLX_AGENT __ATOMIC_RELAXED, __HIP_MEMORY_SCOPE_AGENT
#define LDS_WAIT() asm volatile("s_waitcnt lgkmcnt(0)" ::: "memory")
#define VM_WAIT() asm volatile("s_waitcnt vmcnt(0)" ::: "memory")

constexpr int NWAVES = 8;
constexpr int DEPTH = 4, BATCH = 4, SEQ = 4096, D = 1024, T = BATCH * SEQ;
constexpr int NU = 3484, NUP = 3584;
constexpr int NE = 32, TOPK = 4, ECAP = 16384;
constexpr int NCH = SEQ / 64;
constexpr int U_SSD_Z = 0, U_SSD_X = 256, U_SSD_B = 512, U_SSD_C = 640, U_SSD_DT = 768;
constexpr int U_RW = 772, U_RW_R = 772, U_RW_K = 1028, U_RW_V = 1284, U_RW_LO = 1540;
constexpr int U_GL_Q = 1668, U_GL_K = 1796, U_GL_V = 1924, U_GL_G = 2180, U_GL_OG = 2196;
constexpr int U_ML_Q = 2452, U_ML_K = 2708, U_ML_V = 2964, U_ML_I = 3220, U_ML_F = 3224, U_ML_O = 3228;
constexpr float DN_ALPHA = 1.6817928305074290f;
constexpr float LN_EPS = 1e-5f, NORM_EPS = 1e-5f, RWKV_GN_EPS = 64e-5f;

enum { I_X = 0, I_P, I_WIN, I_WOUT, I_LN1G, I_LN1B, I_SCW, I_SCB, I_SALOG, I_SDTB, I_SD, I_SNG,
       I_RMU, I_RW0, I_RWUP, I_RA0, I_RAUP, I_RGUP, I_RKK, I_RKA, I_RRK, I_RLNG, I_RLNB,
       I_GGUP, I_GGB, I_GNG, I_MCW, I_MCB, I_MIB, I_MFB, I_MNG,
       I_RTW, I_RTB, I_WGU, I_BGU, I_WDN, I_BDN, I_PGW, I_PPJ, I_LN2G, I_LN2B, N_IN };

constexpr size_t MiB = 1u << 20;
constexpr size_t WS_CTL = 0, CTL_ZERO_BYTES = 1 * MiB;
constexpr size_t WS_WIN_T = 2 * MiB;
constexpr size_t WS_WOUT_T = WS_WIN_T + (size_t)DEPTH * NUP * D * 2;
constexpr size_t WS_WGU_T = WS_WOUT_T + (size_t)DEPTH * D * D * 2;
constexpr size_t WS_WDN_T = WS_WGU_T + (size_t)DEPTH * NE * 2048 * D * 2;
constexpr size_t WS_WPG_T = WS_WDN_T + (size_t)DEPTH * NE * D * D * 2;
constexpr size_t WS_WPP_T = WS_WPG_T + (size_t)DEPTH * D * D * 2;
constexpr size_t WS_RWT = WS_WPP_T + (size_t)DEPTH * D * 256 * 2;
constexpr size_t WS_PB = WS_RWT + (size_t)DEPTH * NE * D * 4;
constexpr size_t WS_XB = WS_PB + (size_t)DEPTH * T * 256 * 2;
constexpr size_t WS_U = WS_XB + (size_t)T * D * 2;
constexpr size_t WS_PE = WS_U + (size_t)T * NUP * 4;
constexpr size_t WS_MIX = WS_PE + (size_t)T * D * 4;
constexpr size_t WS_Y1 = WS_MIX + (size_t)T * D * 2;
constexpr size_t WS_X1 = WS_Y1 + (size_t)T * D * 4;
constexpr size_t WS_X1B = WS_X1 + (size_t)T * D * 4;
constexpr size_t WS_SDEST = WS_X1B + (size_t)T * D * 2;
constexpr size_t WS_SGATE = WS_SDEST + (size_t)NE * ECAP * 4;
constexpr size_t WS_ABUF = WS_SGATE + (size_t)NE * ECAP * 4;
constexpr size_t WS_YBUF = WS_ABUF + (size_t)NE * ECAP * D * 2;
constexpr size_t WS_H = WS_YBUF + (size_t)T * 4 * D * 4;
constexpr size_t WS_HB = WS_H + (size_t)T * D * 4;
constexpr size_t WS_H2 = WS_HB + (size_t)T * D * 2;
constexpr size_t WS_SSD_ST = WS_H2 + (size_t)T * D * 4;
constexpr size_t WS_SSD_DEC = WS_SSD_ST + (size_t)16 * NCH * 64 * 128 * 4;
constexpr size_t WS_GLA_ST = WS_SSD_DEC + 16 * NCH * 4;
constexpr size_t WS_GLA_DEC = WS_GLA_ST + (size_t)16 * NCH * 32 * 64 * 4;
constexpr size_t WS_ML_C = WS_GLA_DEC + (size_t)4 * NCH * 128 * 4;
constexpr size_t WS_ML_N = WS_ML_C + (size_t)16 * NCH * 64 * 64 * 4;
constexpr size_t WS_ML_BL = WS_ML_N + (size_t)16 * NCH * 64 * 4;
constexpr size_t WS_ML_ML = WS_ML_BL + 16 * NCH * 4;
constexpr size_t WS_ML_M = WS_ML_ML + 16 * NCH * 4;
constexpr size_t WS_RW = WS_ML_M + 16 * NCH * 4;
constexpr size_t WS_RW_G = WS_RW + (size_t)T * 6 * 256 * 4;
constexpr size_t WS_RW_O = WS_RW_G + (size_t)T * 256 * 4;
constexpr size_t WS_LORA = WS_RW_O + (size_t)T * 256 * 4;
constexpr int LORA_PER_LAYER = 8192 + 8192 + 16384 + 2048;
constexpr size_t WS_END = WS_LORA + (size_t)DEPTH * LORA_PER_LAYER * 4;
constexpr int CW_BAR = 4096;
constexpr int CW_CNT = 16384;

constexpr int RING_BYTES = 147456;
constexpr int MISC_OFF = RING_BYTES;
constexpr int LDS_BYTES = RING_BYTES + 1024;
constexpr int MW_BAR = 8, MW_LCNT = 32, MW_LBASE = 64, MW_PFX = 96, MW_CNT = 136;

__device__ __forceinline__ unsigned cvt_pk_bf16(float lo, float hi) { unsigned r; asm volatile("v_cvt_pk_bf16_f32 %0, %1, %2" : "=v"(r) : "v"(lo), "v"(hi)); return r; }
__device__ __forceinline__ float bf2f(unsigned short b) { return __uint_as_float(((unsigned)b) << 16); }
__device__ __forceinline__ float sigmoidf_(float x) { return 1.0f / (1.0f + __expf(-x)); }
__device__ __forceinline__ float siluf_(float x) { return x / (1.0f + __expf(-x)); }
__device__ __forceinline__ float softplusf_(float x) { return fmaxf(x, 0.f) + log1pf(__expf(-fabsf(x))); }
__device__ __forceinline__ float logsigmoidf_(float x) { return fminf(x, 0.f) - log1pf(__expf(-fabsf(x))); }
__device__ __forceinline__ float wave_sum(float v) {
#pragma unroll
    for (int o = 1; o < 64; o <<= 1) v += __shfl_xor(v, o);
    return v;
}
__device__ __forceinline__ float wave_max(float v) {
#pragma unroll
    for (int o = 1; o < 64; o <<= 1) v = fmaxf(v, __shfl_xor(v, o));
    return v;
}
__device__ __forceinline__ float wave_scan_add(float v, int lane) {
#pragma unroll
    for (int o = 1; o < 64; o <<= 1) { const float t = __shfl_up(v, o); if (lane >= o) v += t; }
    return v;
}
__device__ __forceinline__ float wave_scan_max(float v, int lane) {
#pragma unroll
    for (int o = 1; o < 64; o <<= 1) { const float t = __shfl_up(v, o); if (lane >= o) v = fmaxf(v, t); }
    return v;
}
__device__ __forceinline__ f32x4 mm16(const LAS unsigned char* A, int lda, const LAS unsigned char* B, int ldb, int K, f32x4 acc, int fr, int fq) {
    const LAS unsigned char* ap = A + fr * lda + fq * 16; const LAS unsigned char* bp = B + fr * ldb + fq * 16;
    for (int k = 0; k < K; k += 32) {
        const bf16x8 a = *(const LAS bf16x8*)(ap + k * 2); const bf16x8 b = *(const LAS bf16x8*)(bp + k * 2);
        acc = __builtin_amdgcn_mfma_f32_16x16x32_bf16(b, a, acc, 0, 0, 0);
    }
    return acc;
}
__device__ __forceinline__ f32x4 mm16_gB(const LAS unsigned char* A, int lda, const float* B, int ldb, int K, f32x4 acc, int fr, int fq) {
    const LAS unsigned char* ap = A + fr * lda + fq * 16; const float* bp = B + (size_t)fr * ldb + fq * 8;
    for (int k = 0; k < K; k += 32) {
        const bf16x8 a = *(const LAS bf16x8*)(ap + k * 2);
        const f32x4 b0 = *(const f32x4*)(bp + k), b1 = *(const f32x4*)(bp + k + 4);
        v4u bw; bw.x = cvt_pk_bf16(b0.x, b0.y); bw.y = cvt_pk_bf16(b0.z, b0.w); bw.z = cvt_pk_bf16(b1.x, b1.y); bw.w = cvt_pk_bf16(b1.z, b1.w);
        const bf16x8 b = __builtin_bit_cast(bf16x8, bw);
        acc = __builtin_amdgcn_mfma_f32_16x16x32_bf16(b, a, acc, 0, 0, 0);
    }
    return acc;
}
__device__ __forceinline__ v4u pack8(const float (&v)[8]) { v4u o; o.x = cvt_pk_bf16(v[0], v[1]); o.y = cvt_pk_bf16(v[2], v[3]); o.z = cvt_pk_bf16(v[4], v[5]); o.w = cvt_pk_bf16(v[6], v[7]); return o; }

#define XB_TMO      128
#define XB_XCNT(j)  (256  + 64 * (j))
#define XB_XSUB(j)  (1280 + 64 * (j))
#define XB_XGEN(j)  (2304 + 64 * (j))
#define XB_TOP      3328
#define XB_TOPGEN   3392
#define XCD_BAR_WORDS 3456
#define XB_SPIN_CAP (1u << 18)
__device__ __forceinline__ unsigned xb_ld(unsigned* p)              { return __hip_atomic_load(p, __ATOMIC_RELAXED, __HIP_MEMORY_SCOPE_AGENT); }
__device__ __forceinline__ unsigned xb_add(unsigned* p, unsigned v) { return __hip_atomic_fetch_add(p, v, __ATOMIC_RELAXED, __HIP_MEMORY_SCOPE_AGENT); }
__device__ __forceinline__ unsigned xb_xcc_id() { return (unsigned)__builtin_amdgcn_s_getreg((3 << 11) | 20) & 0xFu; }
#define XB_SPIN(cond, bar) do { unsigned _sp = 0; while (cond) { __builtin_amdgcn_s_sleep(1); \
    if ((++_sp & 255u) == 0u) { if (xb_ld(&(bar)[XB_TMO])) break; if (_sp > XB_SPIN_CAP) { atomicAdd(&(bar)[XB_TMO], 1u); break; } } } } while (0)
struct XcdBarrier { unsigned* bar; unsigned x; volatile LAS unsigned* st; };
__device__ __forceinline__ XcdBarrier xcd_barrier_post(unsigned* bar, volatile LAS unsigned* st) {
    XcdBarrier b; b.bar = bar; b.x = xb_xcc_id(); b.st = st;
    if (threadIdx.x == 0) (void)xb_add(&bar[XB_XCNT(b.x)], 1u);
    return b;
}
__device__ __forceinline__ void xcd_barrier_complete(unsigned* bar, unsigned x, unsigned& nloc, unsigned& nx) {
    const unsigned G = gridDim.x * gridDim.y * gridDim.z;
    unsigned sum, cnt, mine, sp = 0u;
    for (;;) {
        sum = 0u; cnt = 0u; mine = 0u;
#pragma unroll
        for (unsigned j = 0; j < 16; ++j) { const unsigned c = xb_ld(&bar[XB_XCNT(j)]); sum += c; cnt += (c > 0u) ? 1u : 0u; mine = (j == x) ? c : mine; }
        if (sum == G) break;
        __builtin_amdgcn_s_sleep(1);
        if ((++sp & 255u) == 0u) { if (xb_ld(&bar[XB_TMO])) break; if (sp > XB_SPIN_CAP) { atomicAdd(&bar[XB_TMO], 1u); break; } }
    }
    nloc = mine > 0u ? mine : 1u; nx = cnt > 0u ? cnt : 1u;
}
__device__ __forceinline__ void xcd_barrier(const XcdBarrier& b) {
    asm volatile("s_waitcnt vmcnt(0)" ::: "memory");
    __syncthreads();
    if (threadIdx.x == 0) {
        unsigned* bar = b.bar;
        __builtin_amdgcn_s_waitcnt(0);
        unsigned nloc = b.st[0], nx = b.st[1];
        if (nloc == 0u) { xcd_barrier_complete(bar, b.x, nloc, nx); b.st[0] = nloc; b.st[1] = nx; }
        const unsigned old = xb_add(&bar[XB_XSUB(b.x)], 1u);
        const unsigned gen = old / nloc;
        if (old + 1u == (gen + 1u) * nloc) {
            __builtin_amdgcn_fence(__ATOMIC_RELEASE, "agent");
            asm volatile("s_waitcnt vmcnt(0)" ::: "memory");
            const unsigned og = xb_add(&bar[XB_TOP], 1u);
            const unsigned tg = og / nx;
            if (og + 1u == (tg + 1u) * nx) xb_add(&bar[XB_TOPGEN], 1u);
            else XB_SPIN(xb_ld(&bar[XB_TOPGEN]) == tg, bar);
            __builtin_amdgcn_fence(__ATOMIC_ACQUIRE, "agent");
            xb_add(&bar[XB_XGEN(b.x)], 1u);
            asm volatile("s_waitcnt vmcnt(0)" ::: "memory");
        } else {
            XB_SPIN(xb_ld(&bar[XB_XGEN(b.x)]) == gen, bar);
            __builtin_amdgcn_fence(__ATOMIC_ACQUIRE, "agent");
            asm volatile("s_waitcnt vmcnt(0)" ::: "memory");
        }
    }
    __syncthreads();
}

namespace pg8 {
constexpr int BM = 256, BK = 64, HALF = 128, HTB = HALF * BK * 2, STAGE_BYTES = 8 * HTB, NXCD = 8, WGM = 8;
__host__ __device__ __forceinline__ int lds_byte(int r, int c) { const int st = (r >> 4) * 2 + (c >> 5), rr = r & 15, cc = c & 31, ob = rr * 64 + cc * 2; return st * 1024 + (ob ^ (((ob >> 9) & 1) << 5)); }
__host__ __device__ __forceinline__ void stage_rc(int b, int& R, int& C) { const int st = b / 1024, sb = b % 1024, swz = sb ^ (((sb >> 9) & 1) << 5); R = (st >> 1) * 16 + swz / 64; C = (st & 1) * 32 + (swz % 64) / 2; }
__host__ __device__ __forceinline__ int perm32(int rho) { const int n = rho >> 4, i = rho & 15; return 8 * (i >> 2) + 4 * n + (i & 3); }

template <class Epi, class Sched>
__device__ __forceinline__ void gemm_phase(LAS unsigned char* lds, const int tid, const Sched& S, const Epi& E) {
    const int wid = __builtin_amdgcn_readfirstlane(tid >> 6), lane = tid & 63, wr = wid >> 2, wc = wid & 3, fr = lane & 15, fq = lane >> 4;
    const int K = S.K, nt = K / BK;
    unsigned voffB[2];
#pragma unroll
    for (int i = 0; i < 2; ++i) { int R, C; stage_rc(tid * 16 + i * 8192, R, C); const int Rb = Epi::PERM ? ((R & ~31) + perm32(R & 31)) : R; voffB[i] = (unsigned)(Rb * K + C) * 2u; }
    const size_t kstep = (size_t)(BK * 2);
    const size_t hstepB = S.hstepB;
    const unsigned ldsw = (unsigned)wid * 1024u;
    const int aoff = lds_byte(wr * 64 + fr, fq * 8), boff = lds_byte(wc * 32 + fr, fq * 8);
#define PG8_SA(b, h) (((b) * 2 + (h)) * HTB)
#define PG8_SB(b, h) ((4 + (b) * 2 + (h)) * HTB)
#define PG8_STAGE_B(bufoff, gbase) do { _Pragma("unroll") for (int _i = 0; _i < 2; ++_i) \
        __builtin_amdgcn_global_load_lds((const unsigned*)((const char*)(gbase) + voffB[_i]), (LAS unsigned*)(lds + (bufoff) + ldsw + _i * 8192), 16, 0, 0); } while (0)
#define PG8_STAGE_A(bufoff, gbase, v0, v1) do { \
        __builtin_amdgcn_global_load_lds((const unsigned*)((const char*)(gbase) + (v0)), (LAS unsigned*)(lds + (bufoff) + ldsw), 16, 0, 0); \
        __builtin_amdgcn_global_load_lds((const unsigned*)((const char*)(gbase) + (v1)), (LAS unsigned*)(lds + (bufoff) + ldsw + 8192), 16, 0, 0); } while (0)
#define PG8_LDA(dst, b, h) do { _Pragma("unroll") for (int m = 0; m < 4; ++m) _Pragma("unroll") for (int k = 0; k < 2; ++k) dst[m][k] = *(const LAS bf16x8*)(lds + PG8_SA(b, h) + aoff + m * 2048 + k * 1024); } while (0)
#define PG8_LDB(dst, b, h) do { _Pragma("unroll") for (int n = 0; n < 2; ++n) _Pragma("unroll") for (int k = 0; k < 2; ++k) dst[n][k] = *(const LAS bf16x8*)(lds + PG8_SB(b, h) + boff + n * 2048 + k * 1024); } while (0)
#define PG8_MMA(ai, bj, At, Bt) do { __builtin_amdgcn_s_setprio(1); _Pragma("unroll") for (int m = 0; m < 4; ++m) _Pragma("unroll") for (int n = 0; n < 2; ++n) _Pragma("unroll") for (int k = 0; k < 2; ++k) \
        acc[ai][bj][m][n] = __builtin_amdgcn_mfma_f32_16x16x32_bf16(Bt[n][k], At[m][k], acc[ai][bj][m][n], 0, 0, 0); __builtin_amdgcn_s_setprio(0); } while (0)
#define PG8_WAIT_V(n) asm volatile("s_waitcnt vmcnt(" #n ")" ::: "memory")
#define PG8_WAIT_L(n) asm volatile("s_waitcnt lgkmcnt(" #n ")" ::: "memory")
#define PG8_BAR __builtin_amdgcn_s_barrier()
#define PG8_SCHED __builtin_amdgcn_sched_barrier(0)
    typename Sched::Unit cur, nxt; int ui = 0;
    if (!S.next(0, cur)) return;
    f32x4 acc[2][2][4][2];
#pragma unroll
    for (int a = 0; a < 2; ++a)
#pragma unroll
        for (int b = 0; b < 2; ++b)
#pragma unroll
            for (int m = 0; m < 4; ++m)
#pragma unroll
                for (int n = 0; n < 2; ++n) acc[a][b][m][n] = (f32x4){0.f, 0.f, 0.f, 0.f};
    bf16x8 At[4][2], B0[2][2], B1[2][2];
    constexpr bool GA = Sched::GATHER;
    const size_t hstepA = GA ? (size_t)0 : (size_t)HALF * K * 2;
    unsigned vA[2][2];
    S.a_off(cur, tid, vA);
#define PG8_STAGE_AH(bufoff, base, vv, h) PG8_STAGE_A(bufoff, ((base) + (h) * hstepA), vv[GA ? (h) : 0][0], vv[GA ? (h) : 0][1])
    const char* cA = S.a_base(cur); const char* cB = S.b_base(cur);
    PG8_STAGE_B(PG8_SB(0, 0), cB); PG8_STAGE_B(PG8_SB(0, 1), cB + hstepB); PG8_STAGE_AH(PG8_SA(0, 0), cA, vA, 0); PG8_STAGE_AH(PG8_SA(0, 1), cA, vA, 1);
    if (wr == 1) PG8_BAR;
    PG8_WAIT_V(2); PG8_BAR;
    PG8_STAGE_B(PG8_SB(1, 0), cB + kstep); PG8_STAGE_AH(PG8_SA(1, 0), cA + kstep, vA, 0); PG8_STAGE_B(PG8_SB(1, 1), cB + hstepB + kstep);
    PG8_WAIT_V(6); PG8_BAR;
    for (;;) {
        const bool has_next = S.next(ui + 1, nxt);
        const char* nA = cA; const char* nB = cB;
        if (has_next) { nA = S.a_base(nxt); nB = S.b_base(nxt); }
        for (int t = 0; t < nt; t += 2) {
            const bool last = (t == nt - 2);
            const char* a1 = cA + (size_t)(t + 1) * kstep;
            const char* a2 = last ? nA : cA + (size_t)(t + 2) * kstep; const char* b2 = last ? nB : cB + (size_t)(t + 2) * kstep;
            const char* a3 = a2 + kstep; const char* b3 = b2 + kstep;
            PG8_LDB(B0, 0, 0); PG8_LDB(B1, 0, 1); PG8_SCHED; PG8_LDA(At, 0, 0); PG8_STAGE_AH(PG8_SA(1, 1), a1, vA, 1);
            if constexpr (GA) { if (last && has_next) S.a_off(nxt, tid, vA); }
            PG8_WAIT_V(8); PG8_WAIT_L(0); PG8_BAR; PG8_MMA(0, 0, At, B0); PG8_MMA(0, 1, At, B1); PG8_BAR; PG8_SCHED;
            PG8_LDA(At, 0, 1); PG8_STAGE_B(PG8_SB(0, 0), b2); PG8_STAGE_B(PG8_SB(0, 1), b2 + hstepB); PG8_STAGE_AH(PG8_SA(0, 0), a2, vA, 0);
            PG8_WAIT_V(8); PG8_WAIT_L(0); PG8_BAR; PG8_MMA(1, 0, At, B0); PG8_MMA(1, 1, At, B1); PG8_BAR; PG8_SCHED;
            PG8_LDB(B0, 1, 0); PG8_LDB(B1, 1, 1); PG8_SCHED; PG8_LDA(At, 1, 0); PG8_STAGE_AH(PG8_SA(0, 1), a2, vA, 1);
            PG8_WAIT_V(8); PG8_WAIT_L(0); PG8_BAR; PG8_MMA(0, 0, At, B0); PG8_MMA(0, 1, At, B1); PG8_BAR; PG8_SCHED;
            PG8_LDA(At, 1, 1); PG8_STAGE_B(PG8_SB(1, 0), b3); PG8_STAGE_B(PG8_SB(1, 1), b3 + hstepB); PG8_STAGE_AH(PG8_SA(1, 0), a3, vA, 0);
            PG8_WAIT_V(8); PG8_WAIT_L(0); PG8_BAR; PG8_MMA(1, 0, At, B0); PG8_MMA(1, 1, At, B1); PG8_BAR; PG8_SCHED;
        }
        if (wr == 0) PG8_BAR;
        { int fr_ = fr; asm volatile("" : "+v"(fr_)); E(acc, cur, wr, wc, fr_, fq); }
        if (!has_next) break;
#pragma unroll
        for (int a = 0; a < 2; ++a)
#pragma unroll
            for (int b = 0; b < 2; ++b)
#pragma unroll
                for (int m = 0; m < 4; ++m)
#pragma unroll
                    for (int n = 0; n < 2; ++n) acc[a][b][m][n] = (f32x4){0.f, 0.f, 0.f, 0.f};
        cur = nxt; cA = nA; cB = nB; ++ui;
        if (wr == 1) PG8_BAR;
    }
    PG8_WAIT_V(0);
    PG8_BAR;
#undef PG8_SA
#undef PG8_SB
#undef PG8_STAGE_A
#undef PG8_STAGE_AH
#undef PG8_STAGE_B
#undef PG8_LDA
#undef PG8_LDB
#undef PG8_MMA
#undef PG8_WAIT_V
#undef PG8_WAIT_L
#undef PG8_BAR
#undef PG8_SCHED
}
}
struct Args { const float* in[N_IN]; float* out; unsigned char* ws; int ph_lo, ph_hi; };
typedef const __attribute__((address_space(4))) unsigned long long* karg_t;
struct Frame {
    karg_t ka;
    LAS unsigned char* lds;
    volatile LAS unsigned* MISC;
    gu32* ctl;
    unsigned char* ws;
    float* out;
    int tid, lane, wave, vcu, G;
};
#define WSP(T_, off) ((T_*)(F.ws + (off)))
#define KIN(k) ((const float*)F.ka[(k)])
template <class P> __device__ __forceinline__ P launder_uniform(P p) {
    unsigned lo = (unsigned)(unsigned long long)p, hi = (unsigned)((unsigned long long)p >> 32);
    asm volatile("" : "+v"(lo), "+v"(hi));
    lo = __builtin_amdgcn_readfirstlane(lo); hi = __builtin_amdgcn_readfirstlane(hi);
    return (P)(((unsigned long long)hi << 32) | lo);
}
__device__ __forceinline__ void frame_refresh(Frame& F) {
    int t = F.tid; asm volatile("" : "+v"(t)); F.tid = t; F.lane = t & 63; F.wave = __builtin_amdgcn_readfirstlane(t >> 6);
    F.ws = launder_uniform(F.ws); F.ctl = (gu32*)(F.ws + WS_CTL);
    F.out = launder_uniform(F.out);
    F.ka = launder_uniform(F.ka);
}

namespace pg8 {
struct DenseSched {
    static constexpr bool GATHER = false;
    struct Unit { int pm, pn; };
    const bf16* A; const bf16* Bt; int K; size_t hstepB; int nM, nN, nwg, G, c;
    __device__ __forceinline__ void init(const bf16* A_, const bf16* Bt_, int M, int N, int K_, int G_, int c_) { A = A_; Bt = Bt_; K = K_; hstepB = (size_t)HALF * K_ * 2; nM = M / BM; nN = N / BM; nwg = nM * nN; G = G_; c = c_; }
    __device__ __forceinline__ bool next(int i, Unit& u) const {
        const long L = (long)i * G + c; if (L >= nwg) return false;
        int wgid = (int)L; { const int q = nwg / NXCD, r = nwg % NXCD, xcd = wgid % NXCD, off = wgid / NXCD; wgid = (xcd < r ? xcd * (q + 1) : r * (q + 1) + (xcd - r) * q) + off; }
        const int nig = WGM * nN, gid = wgid / nig, fm = gid * WGM, gsz = (nM - fm) < WGM ? (nM - fm) : WGM;
        u.pm = fm + ((wgid % nig) % gsz); u.pn = (wgid % nig) / gsz; return true;
    }
    __device__ __forceinline__ const char* a_base(const Unit& u) const { return (const char*)A + (size_t)u.pm * BM * K * 2; }
    __device__ __forceinline__ const char* b_base(const Unit& u) const { return (const char*)Bt + (size_t)u.pn * BM * K * 2; }
    __device__ __forceinline__ void a_off(const Unit&, int tid, unsigned (&v)[2][2]) const {
#pragma unroll
        for (int i = 0; i < 2; ++i) { int R, C; stage_rc(tid * 16 + i * 8192, R, C); v[0][i] = (unsigned)(R * K + C) * 2u; v[1][i] = v[0][i]; }
    }
};
struct MoeUnit { int e, mt, nt, cnt; };
struct MoeOrder {
    const volatile LAS unsigned* pfx;
    int NT, G, c;
    __device__ __forceinline__ bool decode(int i, MoeUnit& u) const {
        const int nwg = (int)pfx[32]; const long L = (long)i * G + c; if (L >= nwg) return false;
        int wgid = (int)L; { const int q = nwg / NXCD, r = nwg % NXCD, xcd = wgid % NXCD, off = wgid / NXCD; wgid = (xcd < r ? xcd * (q + 1) : r * (q + 1) + (xcd - r) * q) + off; }
        int e = 0;
#pragma unroll 1
        for (int j = 1; j < 32; ++j) e += ((int)pfx[j] <= wgid) ? 1 : 0;
        const int j = wgid - (int)pfx[e];
        u.e = e; u.mt = j / NT; u.nt = j % NT; u.cnt = (int)pfx[40 + e]; return true;
    }
};
struct Moe1Sched {
    static constexpr bool GATHER = true;
    typedef MoeUnit Unit;
    MoeOrder O; const bf16* X; const bf16* W; const int* sdest; int K; size_t hstepB;
    __device__ __forceinline__ bool next(int i, Unit& u) const { return O.decode(i, u); }
    __device__ __forceinline__ const char* a_base(const Unit&) const { return (const char*)X; }
    __device__ __forceinline__ const char* b_base(const Unit& u) const { return (const char*)W + ((size_t)u.e * 2048 + (size_t)u.nt * 128) * 1024 * 2; }
    __device__ __forceinline__ void a_off(const Unit& u, int tid, unsigned (&v)[2][2]) const {
#pragma unroll
        for (int i = 0; i < 2; ++i) { int R, C; stage_rc(tid * 16 + i * 8192, R, C);
#pragma unroll
            for (int h = 0; h < 2; ++h) { const int slot = u.mt * 256 + h * HALF + R; int tok = 0; if (slot < u.cnt) tok = sdest[u.e * ECAP + slot] >> 2; v[h][i] = (unsigned)(tok * 1024 + C) * 2u; } }
    }
};
struct Moe2Sched {
    static constexpr bool GATHER = false;
    typedef MoeUnit Unit;
    MoeOrder O; const bf16* Ab; const bf16* W; int K; size_t hstepB;
    __device__ __forceinline__ bool next(int i, Unit& u) const { return O.decode(i, u); }
    __device__ __forceinline__ const char* a_base(const Unit& u) const { return (const char*)Ab + ((size_t)u.e * ECAP + (size_t)u.mt * 256) * 1024 * 2; }
    __device__ __forceinline__ const char* b_base(const Unit& u) const { return (const char*)W + ((size_t)u.e * 1024 + (size_t)u.nt * 256) * 1024 * 2; }
    __device__ __forceinline__ void a_off(const Unit&, int tid, unsigned (&v)[2][2]) const {
#pragma unroll
        for (int i = 0; i < 2; ++i) { int R, C; stage_rc(tid * 16 + i * 8192, R, C); v[0][i] = (unsigned)(R * 1024 + C) * 2u; v[1][i] = v[0][i]; }
    }
};

struct EpiF32 {
    static constexpr bool PERM = false;
    float* C; int ldc; const float* base; float alpha;
    __device__ __forceinline__ void operator()(const f32x4 (&acc)[2][2][4][2], const DenseSched::Unit& u, int wr, int wc, int fr, int fq) const {
        const int row0 = u.pm * BM + wr * 64 + fr, col0 = u.pn * BM + wc * 32 + 4 * fq;
#pragma unroll
        for (int ai = 0; ai < 2; ++ai)
#pragma unroll
            for (int m = 0; m < 4; ++m) { const size_t ro = (size_t)(row0 + ai * HALF + m * 16) * ldc + col0;
#pragma unroll
                for (int bj = 0; bj < 2; ++bj)
#pragma unroll
                    for (int n = 0; n < 2; ++n) { f32x4 v = acc[ai][bj][m][n];
                        if (base) { const f32x4 b = *(const f32x4*)(base + ro + bj * HALF + n * 16); v = v + b * alpha; }
                        *(f32x4*)(C + ro + bj * HALF + n * 16) = v; } }
    }
};
struct EpiPle {
    static constexpr bool PERM = false;
    float* C; const float* hb; const float* pe;
    __device__ __forceinline__ void operator()(const f32x4 (&acc)[2][2][4][2], const DenseSched::Unit& u, int wr, int wc, int fr, int fq) const {
        const int row0 = u.pm * BM + wr * 64 + fr, col0 = u.pn * BM + wc * 32 + 4 * fq;
#pragma unroll
        for (int ai = 0; ai < 2; ++ai)
#pragma unroll
            for (int m = 0; m < 4; ++m) { const size_t ro = (size_t)(row0 + ai * HALF + m * 16) * 1024 + col0;
#pragma unroll
                for (int bj = 0; bj < 2; ++bj)
#pragma unroll
                    for (int n = 0; n < 2; ++n) { const f32x4 a = acc[ai][bj][m][n]; const f32x4 hv = *(const f32x4*)(hb + ro + bj * HALF + n * 16), pv = *(const f32x4*)(pe + ro + bj * HALF + n * 16);
                        f32x4 o; o.x = hv.x + sigmoidf_(a.x) * pv.x; o.y = hv.y + sigmoidf_(a.y) * pv.y; o.z = hv.z + sigmoidf_(a.z) * pv.z; o.w = hv.w + sigmoidf_(a.w) * pv.w;
                        *(f32x4*)(C + ro + bj * HALF + n * 16) = o; } }
    }
};
struct EpiMoe1 {
    static constexpr bool PERM = true;
    bf16* Ab; const float* bgu;
    __device__ __forceinline__ void operator()(const f32x4 (&acc)[2][2][4][2], const MoeUnit& u, int wr, int wc, int fr, int fq) const {
        const int col0 = u.nt * 128 + wc * 32 + 8 * fq;
        const float* bg = bgu + (size_t)u.e * 2048 + col0;
        const f32x4 bg0 = *(const f32x4*)(bg), bg1 = *(const f32x4*)(bg + 4), bl0 = *(const f32x4*)(bg + 1024), bl1 = *(const f32x4*)(bg + 1028);
#pragma unroll
        for (int ai = 0; ai < 2; ++ai)
#pragma unroll
            for (int m = 0; m < 4; ++m) { const int r = ai * HALF + wr * 64 + m * 16 + fr;
                bf16* rowp = Ab + ((size_t)u.e * ECAP + (size_t)u.mt * 256 + r) * 1024 + col0;
                float o[8];
#pragma unroll
                for (int n = 0; n < 2; ++n) { const f32x4 g4 = acc[ai][0][m][n] + (n ? bg1 : bg0), l4 = acc[ai][1][m][n] + (n ? bl1 : bl0);
#pragma unroll
                    for (int j = 0; j < 4; ++j) { const float g = fminf(g4[j], 7.0f), l = fminf(fmaxf(l4[j], -7.0f), 7.0f); o[n * 4 + j] = (l + 1.0f) * g * sigmoidf_(1.702f * g); } }
                *(v4u*)rowp = pack8(o); }
    }
};
struct EpiMoe2 {
    static constexpr bool PERM = false;
    float* Y; const float* bdn; const int* sdest; const float* sgate;
    __device__ __forceinline__ void operator()(const f32x4 (&acc)[2][2][4][2], const MoeUnit& u, int wr, int wc, int fr, int fq) const {
        const int col0 = u.nt * 256 + wc * 32 + 4 * fq;
        const float* bp = bdn + (size_t)u.e * 1024 + col0;
        f32x4 bv[2][2];
#pragma unroll
        for (int bj = 0; bj < 2; ++bj)
#pragma unroll
            for (int n = 0; n < 2; ++n) bv[bj][n] = *(const f32x4*)(bp + bj * HALF + n * 16);
#pragma unroll
        for (int ai = 0; ai < 2; ++ai)
#pragma unroll
            for (int m = 0; m < 4; ++m) { const int slot = u.mt * 256 + ai * HALF + wr * 64 + m * 16 + fr;
                if (slot < u.cnt) { const int dest = sdest[u.e * ECAP + slot]; const float gate = sgate[u.e * ECAP + slot];
                    float* rowp = Y + (size_t)dest * 1024 + col0;
#pragma unroll
                    for (int bj = 0; bj < 2; ++bj)
#pragma unroll
                        for (int n = 0; n < 2; ++n) *(f32x4*)(rowp + bj * HALF + n * 16) = (acc[ai][bj][m][n] + bv[bj][n]) * gate; } }
    }
};
}

__device__ __forceinline__ void p0_transpose_item(const float* W, int K, int N, int nblk, bf16* WT, LAS float* scr, int item, int lane) {
    const int kb = item / nblk, nb = item % nblk, k0 = 64 * kb, n0 = 32 * nb;
    const int nn = n0 + (lane & 31); const bool ok = nn < N;
#pragma unroll 8
    for (int i = 0; i < 32; ++i) { const int kk = 2 * i + (lane >> 5); scr[kk * 33 + (lane & 31)] = ok ? W[(size_t)(k0 + kk) * N + nn] : 0.f; }
    LDS_WAIT(); asm volatile("" ::: "memory");
    const int c = lane & 7;
#pragma unroll
    for (int j = 0; j < 4; ++j) { const int n = (lane >> 3) + 8 * j; const LAS float* s = scr + (8 * c) * 33 + n;
        v4u o; o.x = cvt_pk_bf16(s[0 * 33], s[1 * 33]); o.y = cvt_pk_bf16(s[2 * 33], s[3 * 33]); o.z = cvt_pk_bf16(s[4 * 33], s[5 * 33]); o.w = cvt_pk_bf16(s[6 * 33], s[7 * 33]);
        *(v4u*)(WT + (size_t)(n0 + n) * K + k0 + 8 * c) = o; }
    LDS_WAIT(); asm volatile("" ::: "memory");
}
__device__ __forceinline__ void cvt_rows(const float* src, bf16* dst, size_t n8, size_t i0, size_t stride) {
    for (size_t i = i0; i < n8; i += stride) { const f32x4 a = *(const f32x4*)(src + i * 8), b = *(const f32x4*)(src + i * 8 + 4);
        v4u o; o.x = cvt_pk_bf16(a.x, a.y); o.y = cvt_pk_bf16(a.z, a.w); o.z = cvt_pk_bf16(b.x, b.y); o.w = cvt_pk_bf16(b.z, b.w); *(v4u*)(dst + i * 8) = o; }
}
__device__ __forceinline__ void p0_prologue(Frame& F, const Args& A) {
    LAS float* scr = (LAS float*)(F.lds + F.wave * 16384);
    const int gw = F.vcu * NWAVES + F.wave, NGW = F.G * NWAVES;
    constexpr int I_IN = 16 * (NUP / 32), I_OUT = 16 * 32, I_GU = 16 * 64, I_DN = 16 * 32, I_PG = 16 * 32, I_PP = 4 * 32;
    constexpr int PER_LAYER = I_IN + I_OUT + NE * I_GU + NE * I_DN + I_PG + I_PP;
    for (int it = gw; it < DEPTH * PER_LAYER; it += NGW) {
        const int l = it / PER_LAYER; int r = it % PER_LAYER;
        if (r < I_IN) { p0_transpose_item(KIN(I_WIN) + (size_t)l * D * NU, D, NU, NUP / 32, WSP(bf16, WS_WIN_T) + (size_t)l * NUP * D, scr, r, F.lane); continue; } r -= I_IN;
        if (r < I_OUT) { p0_transpose_item(KIN(I_WOUT) + (size_t)l * D * D, D, D, 32, WSP(bf16, WS_WOUT_T) + (size_t)l * D * D, scr, r, F.lane); continue; } r -= I_OUT;
        if (r < NE * I_GU) { const int e = r / I_GU; p0_transpose_item(KIN(I_WGU) + ((size_t)l * NE + e) * D * 2048, D, 2048, 64, WSP(bf16, WS_WGU_T) + ((size_t)l * NE + e) * 2048 * D, scr, r % I_GU, F.lane); continue; } r -= NE * I_GU;
        if (r < NE * I_DN) { const int e = r / I_DN; p0_transpose_item(KIN(I_WDN) + ((size_t)l * NE + e) * D * D, D, D, 32, WSP(bf16, WS_WDN_T) + ((size_t)l * NE + e) * D * D, scr, r % I_DN, F.lane); continue; } r -= NE * I_DN;
        if (r < I_PG) { p0_transpose_item(KIN(I_PGW) + (size_t)l * D * D, D, D, 32, WSP(bf16, WS_WPG_T) + (size_t)l * D * D, scr, r, F.lane); continue; } r -= I_PG;
        p0_transpose_item(KIN(I_PPJ) + (size_t)l * 256 * D, 256, D, 32, WSP(bf16, WS_WPP_T) + (size_t)l * D * 256, scr, r, F.lane);
    }
    const size_t gt = (size_t)F.vcu * (NWAVES * 64) + F.tid, NT_ = (size_t)F.G * NWAVES * 64;
    cvt_rows(KIN(I_P), WSP(bf16, WS_PB), (size_t)DEPTH * T * 256 / 8, gt, NT_);
    cvt_rows(KIN(I_X), WSP(bf16, WS_XB), (size_t)T * D / 8, gt, NT_);
    for (size_t i = gt; i < (size_t)DEPTH * LORA_PER_LAYER; i += NT_) { const int l = (int)(i / LORA_PER_LAYER); int r = (int)(i % LORA_PER_LAYER); float v;
        if (r < 8192) { const int ch = r >> 5, j = r & 31; v = KIN(I_RWUP)[(size_t)l * 8192 + j * 256 + ch]; }
        else if (r < 16384) { r -= 8192; const int ch = r >> 5, j = r & 31; v = KIN(I_RAUP)[(size_t)l * 8192 + j * 256 + ch]; }
        else if (r < 32768) { r -= 16384; const int ch = r >> 6, j = r & 63; v = KIN(I_RGUP)[(size_t)l * 16384 + j * 256 + ch]; }
        else { r -= 32768; const int d = r >> 4, j = r & 15; v = KIN(I_GGUP)[(size_t)l * 2048 + j * 128 + d]; }
        WSP(float, WS_LORA)[i] = v; }
    for (size_t i = gt; i < (size_t)DEPTH * NE * D; i += NT_) { const int l = (int)(i / (NE * D)), r = (int)(i % (NE * D)), e = r / D, k = r % D; WSP(float, WS_RWT)[i] = KIN(I_RTW)[(size_t)l * D * NE + (size_t)k * NE + e]; }
}

__device__ __forceinline__ void p6_ln1_router(Frame& F, const Args& A, int layer) {
    const float* y1 = WSP(float, WS_Y1); float* x1 = WSP(float, WS_X1); bf16* x1b = WSP(bf16, WS_X1B);
    const float* g = KIN(I_LN1G) + layer * D; const float* bb = KIN(I_LN1B) + layer * D;
    const float* rwt = WSP(float, WS_RWT) + (size_t)layer * NE * D; const float* rb = KIN(I_RTB) + layer * NE;
    int* sdest = WSP(int, WS_SDEST); float* sgate = WSP(float, WS_SGATE);
    unsigned* cnt = (unsigned*)(F.ctl + CW_CNT + layer * NE * 16);
    LAS float* RWT = (LAS float*)F.lds;
    volatile LAS unsigned* lcnt = F.MISC + MW_LCNT; volatile LAS unsigned* lbase = F.MISC + MW_LBASE;
    for (int i = F.tid; i < NE * D / 4; i += NWAVES * 64) ((LAS f32x4*)RWT)[i] = ((const f32x4*)rwt)[i];
    const int lane = F.lane;
    const f32x4 gv[4] = { *(const f32x4*)(g + 4 * lane), *(const f32x4*)(g + 256 + 4 * lane), *(const f32x4*)(g + 512 + 4 * lane), *(const f32x4*)(g + 768 + 4 * lane) };
    const f32x4 bv[4] = { *(const f32x4*)(bb + 4 * lane), *(const f32x4*)(bb + 256 + 4 * lane), *(const f32x4*)(bb + 512 + 4 * lane), *(const f32x4*)(bb + 768 + 4 * lane) };
    const float rbias = rb[lane >> 1];
    for (int blk = F.vcu; blk < T / 64; blk += F.G) {
        if (F.tid < 32) lcnt[F.tid] = 0u;
        __syncthreads();
        int my_e = 0; float my_g = 0.f; unsigned my_r = 0u;
#pragma unroll 1
        for (int ri = 0; ri < 8; ++ri) {
            const int row = blk * 64 + F.wave * 8 + ri;
            const float* yr = y1 + (size_t)row * D;
            f32x4 v[4]; float s = 0.f;
#pragma unroll
            for (int j = 0; j < 4; ++j) { v[j] = *(const f32x4*)(yr + 256 * j + 4 * lane); s += (v[j].x + v[j].y) + (v[j].z + v[j].w); }
            const float mean = wave_sum(s) * (1.f / D); float s2 = 0.f;
#pragma unroll
            for (int j = 0; j < 4; ++j) { v[j] = v[j] - mean; s2 += (v[j].x * v[j].x + v[j].y * v[j].y) + (v[j].z * v[j].z + v[j].w * v[j].w); }
            const float rstd = 1.0f / sqrtf(wave_sum(s2) * (1.f / D) + LN_EPS);
#pragma unroll
            for (int j = 0; j < 4; ++j) { v[j] = v[j] * rstd * gv[j] + bv[j];
                *(f32x4*)(x1 + (size_t)row * D + 256 * j + 4 * lane) = v[j];
                v2u o; o.x = cvt_pk_bf16(v[j].x, v[j].y); o.y = cvt_pk_bf16(v[j].z, v[j].w); *(v2u*)(x1b + (size_t)row * D + 256 * j + 4 * lane) = o; }
            float p[32];
#pragma unroll
            for (int e = 0; e < 32; ++e) { float a = 0.f;
#pragma unroll
                for (int j = 0; j < 4; ++j) { const f32x4 w = *(const LAS f32x4*)(RWT + e * D + 256 * j + 4 * lane); a += (v[j].x * w.x + v[j].y * w.y) + (v[j].z * w.z + v[j].w * w.w); }
                p[e] = a; }
#pragma unroll
            for (int i = 0; i < 16; ++i) { const bool hi = (lane & 32) != 0; const float keep = hi ? p[i + 16] : p[i], send = hi ? p[i] : p[i + 16]; p[i] = keep + __shfl_xor(send, 32); }
#pragma unroll
            for (int i = 0; i < 8; ++i) { const bool hi = (lane & 16) != 0; const float keep = hi ? p[i + 8] : p[i], send = hi ? p[i] : p[i + 8]; p[i] = keep + __shfl_xor(send, 16); }
#pragma unroll
            for (int i = 0; i < 4; ++i) { const bool hi = (lane & 8) != 0; const float keep = hi ? p[i + 4] : p[i], send = hi ? p[i] : p[i + 4]; p[i] = keep + __shfl_xor(send, 8); }
#pragma unroll
            for (int i = 0; i < 2; ++i) { const bool hi = (lane & 4) != 0; const float keep = hi ? p[i + 2] : p[i], send = hi ? p[i] : p[i + 2]; p[i] = keep + __shfl_xor(send, 4); }
            { const bool hi = (lane & 2) != 0; const float keep = hi ? p[1] : p[0], send = hi ? p[0] : p[1]; p[0] = keep + __shfl_xor(send, 2); }
            float logit = p[0] + __shfl_xor(p[0], 1) + rbias;
            float tv[4]; int te[4];
#pragma unroll
            for (int k = 0; k < 4; ++k) {
                float bvv = logit; int bi = lane >> 1;
#pragma unroll
                for (int o = 2; o < 64; o <<= 1) { const float ov = __shfl_xor(bvv, o); const int oi = __shfl_xor(bi, o); if (ov > bvv || (ov == bvv && oi < bi)) { bvv = ov; bi = oi; } }
                tv[k] = bvv; te[k] = bi; if ((lane >> 1) == bi) logit = -INFINITY;
            }
            const float e1 = __expf(tv[1] - tv[0]), e2 = __expf(tv[2] - tv[0]), e3 = __expf(tv[3] - tv[0]); const float inv = 1.0f / (1.0f + e1 + e2 + e3);
            const int kk = lane & 3;
            const int ek = kk == 0 ? te[0] : kk == 1 ? te[1] : kk == 2 ? te[2] : te[3];
            const float gk = (kk == 0 ? 1.0f : kk == 1 ? e1 : kk == 2 ? e2 : e3) * inv;
            if ((lane >> 2) == ri) { my_e = ek; my_g = gk; my_r = atomicAdd((unsigned*)&lcnt[ek], 1u); }
        }
        __syncthreads();
        if (F.tid < 32) { const unsigned n = lcnt[F.tid]; lbase[F.tid] = n ? __hip_atomic_fetch_add(cnt + F.tid * 16, n, RLX_AGENT) : 0u; }
        __syncthreads();
        if (lane < 32) { const int row = blk * 64 + F.wave * 8 + (lane >> 2); const unsigned slot = (unsigned)my_e * ECAP + lbase[my_e] + my_r;
            sdest[slot] = row * 4 + (lane & 3); sgate[slot] = my_g; }
        __syncthreads();
    }
}
__device__ __forceinline__ void p9_combine(Frame& F, const Args& A) {
    const float* x1 = WSP(float, WS_X1); const float* yb = WSP(float, WS_YBUF); float* h = WSP(float, WS_H); bf16* hb = WSP(bf16, WS_HB);
    const int gw = F.vcu * NWAVES + F.wave, NGW = F.G * NWAVES, lane = F.lane;
    for (int row = gw; row < T; row += NGW) {
#pragma unroll
        for (int j = 0; j < 4; ++j) { const size_t o = (size_t)row * D + 256 * j + 4 * lane;
            f32x4 v = *(const f32x4*)(x1 + o) * DN_ALPHA;
#pragma unroll
            for (int k = 0; k < 4; ++k) v = v + *(const f32x4*)(yb + ((size_t)row * 4 + k) * D + 256 * j + 4 * lane);
            *(f32x4*)(h + o) = v; v2u w; w.x = cvt_pk_bf16(v.x, v.y); w.y = cvt_pk_bf16(v.z, v.w); *(v2u*)(hb + o) = w; }
    }
}
__device__ __forceinline__ void p11_ln2(Frame& F, const Args& A, int layer) {
    const float* h2 = WSP(float, WS_H2); bf16* xb = WSP(bf16, WS_XB);
    const float* g = KIN(I_LN2G) + layer * D; const float* bb = KIN(I_LN2B) + layer * D;
    const int gw = F.vcu * NWAVES + F.wave, NGW = F.G * NWAVES, lane = F.lane;
    for (int row = gw; row < T; row += NGW) {
        const float* yr = h2 + (size_t)row * D; f32x4 v[4]; float s = 0.f;
#pragma unroll
        for (int j = 0; j < 4; ++j) { v[j] = *(const f32x4*)(yr + 256 * j + 4 * lane); s += (v[j].x + v[j].y) + (v[j].z + v[j].w); }
        const float mean = wave_sum(s) * (1.f / D); float s2 = 0.f;
#pragma unroll
        for (int j = 0; j < 4; ++j) { v[j] = v[j] - mean; s2 += (v[j].x * v[j].x + v[j].y * v[j].y) + (v[j].z * v[j].z + v[j].w * v[j].w); }
        const float rstd = 1.0f / sqrtf(wave_sum(s2) * (1.f / D) + LN_EPS);
#pragma unroll
        for (int j = 0; j < 4; ++j) { const f32x4 gv = *(const f32x4*)(g + 256 * j + 4 * lane), bv = *(const f32x4*)(bb + 256 * j + 4 * lane);
            const f32x4 o = v[j] * rstd * gv + bv; const size_t off = (size_t)row * D + 256 * j + 4 * lane;
            *(f32x4*)(F.out + off) = o; v2u w; w.x = cvt_pk_bf16(o.x, o.y); w.y = cvt_pk_bf16(o.z, o.w); *(v2u*)(xb + off) = w; }
    }
}
__device__ __forceinline__ void moe_build_pfx(Frame& F, const Args& A, int layer, int NT) {
    volatile LAS unsigned* pfx = F.MISC + MW_PFX;
    __syncthreads();
    if (F.tid == 0) { unsigned acc = 0u;
        for (int e = 0; e < NE; ++e) { const unsigned c = __hip_atomic_load(F.ctl + CW_CNT + (layer * NE + e) * 16, RLX_AGENT); pfx[e] = acc; pfx[40 + e] = c; acc += ((c + 255u) >> 8) * (unsigned)NT; }
        pfx[32] = acc; }
    __syncthreads();
}
#define UU(t, col) (u[(size_t)(t) * NUP + (col)])
__device__ __forceinline__ void lds_st_bf16(LAS unsigned char* p, float v) { *(LAS unsigned short*)p = (unsigned short)(cvt_pk_bf16(v, 0.f) & 0xffffu); }
__device__ __forceinline__ void lds_st_bf16x4(LAS unsigned char* p, float a, float b, float c, float d) { v2u o; o.x = cvt_pk_bf16(a, b); o.y = cvt_pk_bf16(c, d); *(LAS v2u*)p = o; }

__device__ __forceinline__ void ssd_stage1(Frame& F, const Args& A, int layer, int b, int c) {
    const float* u = WSP(float, WS_U);
    LAS unsigned char* L = F.lds;
    LAS float* DT = (LAS float*)L; LAS float* AC = DT + 256;
    LAS unsigned char* BMT = L + 2048; LAS unsigned char* XCDT = BMT + 128 * 144;
    const int t0 = b * SEQ + c * 64, tid = F.tid, lane = F.lane, wave = F.wave;
    if (wave < 4) {
        const int hh = wave;
        const float dt = softplusf_(UU(t0 + lane, U_SSD_DT + hh) + KIN(I_SDTB)[layer * 4 + hh]);
        const float adt = -dt * __expf(KIN(I_SALOG)[layer * 4 + hh]);
        const float ac = wave_scan_add(adt, lane);
        DT[hh * 64 + lane] = dt; AC[hh * 64 + lane] = ac;
        if (lane == 63) WSP(float, WS_SSD_DEC)[(b * 4 + hh) * NCH + c] = __expf(ac);
    }
    __syncthreads();
    if (tid < 384) {
        const int cc = tid; const float* cw = KIN(I_SCW) + (size_t)layer * 2048 + cc; const float w0 = cw[0], w1 = cw[512], w2 = cw[1024], w3 = cw[1536], cb = KIN(I_SCB)[layer * 512 + cc];
        const float* up = u + (size_t)t0 * NUP + U_SSD_X + cc;
        float win0 = 0.f, win1 = 0.f, win2 = 0.f;
        if (c > 0) { win0 = up[-3 * NUP]; win1 = up[-2 * NUP]; win2 = up[-1 * NUP]; }
        const int hh = (cc >> 6) & 3; const bool isx = cc < 256;
        LAS unsigned char* dst = isx ? XCDT + cc * 144 : BMT + (cc - 256) * 144;
        const float aclast = AC[hh * 64 + 63];
#pragma unroll 1
        for (int l0 = 0; l0 < 64; l0 += 32) {
            float xv[32];
#pragma unroll
            for (int j = 0; j < 32; ++j) xv[j] = up[(l0 + j) * NUP];
#pragma unroll
            for (int j8 = 0; j8 < 4; ++j8) { float o[8];
#pragma unroll
                for (int j = 0; j < 8; ++j) { const int l = l0 + j8 * 8 + j; const float x = xv[j8 * 8 + j]; const float y = cb + w0 * win0 + w1 * win1 + w2 * win2 + w3 * x; win0 = win1; win1 = win2; win2 = x;
                    float s = siluf_(y); if (isx) s *= DT[hh * 64 + l] * __expf(aclast - AC[hh * 64 + l]); o[j] = s; }
                *(LAS v4u*)(dst + (l0 + j8 * 8) * 2) = pack8(o); }
        }
    }
    __syncthreads();
    { const int fr = lane & 15, fq = lane >> 4; float* st = WSP(float, WS_SSD_ST);
#pragma unroll 1
      for (int i = 0; i < 2; ++i) { const int row0 = (2 * wave + i) * 16; const int hh = row0 >> 6, p = (row0 & 63) + fr;
          float* dstp = st + (((size_t)(b * 4 + hh) * NCH + c) * 64 + p) * 128;
#pragma unroll 1
          for (int ntl = 0; ntl < 8; ++ntl) { f32x4 acc = {0.f, 0.f, 0.f, 0.f}; acc = mm16(XCDT + row0 * 144, 144, BMT + ntl * 16 * 144, 144, 64, acc, fr, fq);
              *(f32x4*)(dstp + ntl * 16 + 4 * fq) = acc; } } }
    __syncthreads();
}
__device__ __forceinline__ void ssd_stage3(Frame& F, const Args& A, int layer, int b, int c) {
    const float* u = WSP(float, WS_U);
    LAS unsigned char* L = F.lds;
    LAS float* DT = (LAS float*)L; LAS float* AC = DT + 256;
    LAS unsigned char* CM = L + 2048; LAS unsigned char* BM = CM + 64 * 272; LAS unsigned char* XCT = BM + 64 * 272; LAS unsigned char* MM = XCT + 256 * 144;
    LAS unsigned char* YG = XCT;
    const int t0 = b * SEQ + c * 64, tid = F.tid, lane = F.lane, wave = F.wave, fr = lane & 15, fq = lane >> 4;
    if (wave < 4) {
        const int hh = wave;
        const float dt = softplusf_(UU(t0 + lane, U_SSD_DT + hh) + KIN(I_SDTB)[layer * 4 + hh]);
        const float adt = -dt * __expf(KIN(I_SALOG)[layer * 4 + hh]);
        DT[hh * 64 + lane] = dt; AC[hh * 64 + lane] = wave_scan_add(adt, lane);
    }
    __syncthreads();
    {
        const int cc = tid; const float* cw = KIN(I_SCW) + (size_t)layer * 2048 + cc; const float w0 = cw[0], w1 = cw[512], w2 = cw[1024], w3 = cw[1536], cb = KIN(I_SCB)[layer * 512 + cc];
        const float* up = u + (size_t)t0 * NUP + U_SSD_X + cc;
        float win0 = 0.f, win1 = 0.f, win2 = 0.f;
        if (c > 0) { win0 = up[-3 * NUP]; win1 = up[-2 * NUP]; win2 = up[-1 * NUP]; }
        const int hh = (cc >> 6) & 3;
#pragma unroll 1
        for (int l0 = 0; l0 < 64; l0 += 32) {
            float xv[32];
#pragma unroll
            for (int j = 0; j < 32; ++j) xv[j] = up[(l0 + j) * NUP];
#pragma unroll
            for (int j8 = 0; j8 < 4; ++j8) { float o[8];
#pragma unroll
                for (int j = 0; j < 8; ++j) { const int l = l0 + j8 * 8 + j; const float x = xv[j8 * 8 + j]; const float y = cb + w0 * win0 + w1 * win1 + w2 * win2 + w3 * x; win0 = win1; win1 = win2; win2 = x;
                    float s = siluf_(y); if (cc < 256) s *= DT[hh * 64 + l]; o[j] = s; }
                if (cc < 256) *(LAS v4u*)(XCT + cc * 144 + (l0 + j8 * 8) * 2) = pack8(o);
                else { LAS unsigned char* d2 = (cc < 384 ? BM + (cc - 256) * 2 : CM + (cc - 384) * 2) + (l0 + j8 * 8) * 272;
#pragma unroll
                    for (int j = 0; j < 8; ++j) lds_st_bf16(d2 + j * 272, o[j]); } }
        }
    }
    __syncthreads();
#pragma unroll 1
    for (int i = 0; i < 2; ++i) { const int idx = 2 * wave + i, lt = idx >> 2, st = idx & 3;
        f32x4 acc = {0.f, 0.f, 0.f, 0.f}; acc = mm16(CM + lt * 16 * 272, 272, BM + st * 16 * 272, 272, 128, acc, fr, fq);
        const int l = lt * 16 + fr, s0 = st * 16 + 4 * fq;
#pragma unroll
        for (int hh = 0; hh < 4; ++hh) { const float al = AC[hh * 64 + l], dl = KIN(I_SD)[layer * 4 + hh] / DT[hh * 64 + l]; float o[4];
#pragma unroll
            for (int j = 0; j < 4; ++j) { const int s = s0 + j; float m = (l >= s) ? acc[j] * __expf(al - AC[hh * 64 + s]) : 0.f; if (l == s) m += dl; o[j] = m; }
            lds_st_bf16x4(MM + hh * 9216 + l * 144 + s0 * 2, o[0], o[1], o[2], o[3]); } }
    __syncthreads();
    f32x4 yv[2][4];
    { const int hh = wave >> 1; const float* prev = WSP(float, WS_SSD_ST) + ((size_t)(b * 4 + hh) * NCH + c) * 8192;
#pragma unroll
      for (int i = 0; i < 2; ++i) { const int lt = 2 * (wave & 1) + i, l = lt * 16 + fr; const float ea = __expf(AC[hh * 64 + l]);
#pragma unroll
          for (int pt = 0; pt < 4; ++pt) { f32x4 ad = {0.f, 0.f, 0.f, 0.f}, ao = {0.f, 0.f, 0.f, 0.f};
              ad = mm16(MM + hh * 9216 + lt * 16 * 144, 144, XCT + (hh * 64 + pt * 16) * 144, 144, 64, ad, fr, fq);
              ao = mm16_gB(CM + lt * 16 * 272, 272, prev + (size_t)(pt * 16) * 128, 128, 128, ao, fr, fq);
              const f32x4 z = *(const f32x4*)&UU(t0 + l, U_SSD_Z + hh * 64 + pt * 16 + 4 * fq);
              f32x4 y = ad + ao * ea; y.x *= siluf_(z.x); y.y *= siluf_(z.y); y.z *= siluf_(z.z); y.w *= siluf_(z.w); yv[i][pt] = y; } } }
    __syncthreads();
    { const int hh = wave >> 1;
#pragma unroll
      for (int i = 0; i < 2; ++i) { const int l = (2 * (wave & 1) + i) * 16 + fr;
#pragma unroll
          for (int pt = 0; pt < 4; ++pt) *(LAS f32x4*)(YG + l * 1040 + (hh * 64 + pt * 16 + 4 * fq) * 4) = yv[i][pt]; } }
    __syncthreads();
    { const f32x4 g = *(const f32x4*)(KIN(I_SNG) + layer * 256 + 4 * lane); bf16* mix = WSP(bf16, WS_MIX);
#pragma unroll 1
      for (int i = 0; i < 8; ++i) { const int l = wave * 8 + i; const f32x4 y = *(const LAS f32x4*)(YG + l * 1040 + lane * 16);
          const float ss = wave_sum((y.x * y.x + y.y * y.y) + (y.z * y.z + y.w * y.w)); const float r = 1.0f / sqrtf(ss * (1.f / 256.f) + NORM_EPS);
          v2u o; o.x = cvt_pk_bf16(y.x * r * g.x, y.y * r * g.y); o.y = cvt_pk_bf16(y.z * r * g.z, y.w * r * g.w);
          *(v2u*)(mix + (size_t)(t0 + l) * D + 4 * lane) = o; } }
    __syncthreads();
}

__device__ __forceinline__ float gla_bcum(Frame& F, const Args& A, int layer, int d, const LAS float* GD, LAS float* BC) {
    float gup[16];
    { const f32x4* gp4 = (const f32x4*)(WSP(float, WS_LORA) + (size_t)layer * LORA_PER_LAYER + 32768 + d * 16);
#pragma unroll
      for (int i = 0; i < 4; ++i) { const f32x4 a = gp4[i]; gup[4 * i] = a.x; gup[4 * i + 1] = a.y; gup[4 * i + 2] = a.z; gup[4 * i + 3] = a.w; } }
    const float gb = KIN(I_GGB)[layer * 128 + d]; float bc = 0.f;
#pragma unroll 2
    for (int l = 0; l < 64; ++l) { float x = gb;
#pragma unroll
        for (int i = 0; i < 16; ++i) x += GD[l * 16 + i] * gup[i];
        bc += logsigmoidf_(x) * 0.0625f; BC[l * 128 + d] = bc; }
    return bc;
}
__device__ __forceinline__ void gla_stage1(Frame& F, const Args& A, int layer, int b, int c) {
    const float* u = WSP(float, WS_U);
    LAS unsigned char* L = F.lds;
    LAS float* GD = (LAS float*)L; LAS float* BC = (LAS float*)(L + 4096);
    LAS unsigned char* KDT = L + 36864; LAS unsigned char* VT = KDT + 128 * 144;
    const int t0 = b * SEQ + c * 64, tid = F.tid, lane = F.lane, wave = F.wave, fr = lane & 15, fq = lane >> 4;
    if (tid < 256) { const int l = tid >> 2, q4 = tid & 3; *(LAS f32x4*)(GD + l * 16 + q4 * 4) = *(const f32x4*)&UU(t0 + l, U_GL_G + 4 * q4); }
    __syncthreads();
    if (tid < 128) {
        const int d = tid; const float blast = gla_bcum(F, A, layer, d, GD, BC);
        WSP(float, WS_GLA_DEC)[(size_t)(b * NCH + c) * 128 + d] = __expf(blast);
        const float* up = u + (size_t)t0 * NUP + U_GL_K + d;
#pragma unroll 1
        for (int l0 = 0; l0 < 64; l0 += 32) { float xv[32];
#pragma unroll
            for (int j = 0; j < 32; ++j) xv[j] = up[(l0 + j) * NUP];
#pragma unroll
            for (int j8 = 0; j8 < 4; ++j8) { float o[8];
#pragma unroll
                for (int j = 0; j < 8; ++j) { const int l = l0 + j8 * 8 + j; o[j] = xv[j8 * 8 + j] * __expf(blast - BC[l * 128 + d]); }
                *(LAS v4u*)(KDT + d * 144 + (l0 + j8 * 8) * 2) = pack8(o); } }
    } else if (tid < 384) {
        const int vch = tid - 128; const float* up = u + (size_t)t0 * NUP + U_GL_V + vch;
#pragma unroll 1
        for (int l0 = 0; l0 < 64; l0 += 32) { float xv[32];
#pragma unroll
            for (int j = 0; j < 32; ++j) xv[j] = up[(l0 + j) * NUP];
#pragma unroll
            for (int j8 = 0; j8 < 4; ++j8) { float o[8];
#pragma unroll
                for (int j = 0; j < 8; ++j) o[j] = xv[j8 * 8 + j];
                *(LAS v4u*)(VT + vch * 144 + (l0 + j8 * 8) * 2) = pack8(o); } }
    }
    __syncthreads();
    { float* st = WSP(float, WS_GLA_ST);
#pragma unroll 1
      for (int i = 0; i < 4; ++i) { const int idx = 4 * wave + i, hh = idx >> 3, dtl = (idx >> 2) & 1, vt = idx & 3;
          f32x4 acc = {0.f, 0.f, 0.f, 0.f}; acc = mm16(KDT + (hh * 32 + dtl * 16) * 144, 144, VT + (hh * 64 + vt * 16) * 144, 144, 64, acc, fr, fq);
          *(f32x4*)(st + (((size_t)(b * 4 + hh) * NCH + c) * 32 + dtl * 16 + fr) * 64 + vt * 16 + 4 * fq) = acc; } }
    __syncthreads();
}
__device__ __forceinline__ void gla_stage3(Frame& F, const Args& A, int layer, int b, int c) {
    const float* u = WSP(float, WS_U);
    LAS unsigned char* L = F.lds;
    LAS float* GD = (LAS float*)L; LAS float* BC = (LAS float*)(L + 4096); LAS unsigned char* ATT = L + 4096;
    LAS unsigned char* QD = L + 40960; LAS unsigned char* KI = QD + 64 * 272; LAS unsigned char* VT = KI + 64 * 272; LAS unsigned char* PVT = VT + 256 * 144;
    const int t0 = b * SEQ + c * 64, tid = F.tid, lane = F.lane, wave = F.wave, fr = lane & 15, fq = lane >> 4;
    if (tid < 256) { const int l = tid >> 2, q4 = tid & 3; *(LAS f32x4*)(GD + l * 16 + q4 * 4) = *(const f32x4*)&UU(t0 + l, U_GL_G + 4 * q4); }
    __syncthreads();
    if (tid < 128) {
        const int d = tid; (void)gla_bcum(F, A, layer, d, GD, BC);
        const float* uq = u + (size_t)t0 * NUP + U_GL_Q + d; const float* uk = u + (size_t)t0 * NUP + U_GL_K + d;
#pragma unroll 1
        for (int l0 = 0; l0 < 64; l0 += 16) { float qv[16], kv[16];
#pragma unroll
            for (int j = 0; j < 16; ++j) { qv[j] = uq[(l0 + j) * NUP]; kv[j] = uk[(l0 + j) * NUP]; }
#pragma unroll
            for (int j = 0; j < 16; ++j) { const int l = l0 + j; const float bc = BC[l * 128 + d];
                lds_st_bf16(QD + l * 272 + d * 2, qv[j] * 0.17677669529663687f * __expf(bc)); lds_st_bf16(KI + l * 272 + d * 2, kv[j] * __expf(-bc)); } }
    } else if (tid < 384) {
        const int vch = tid - 128; const float* up = u + (size_t)t0 * NUP + U_GL_V + vch;
#pragma unroll 1
        for (int l0 = 0; l0 < 64; l0 += 32) { float xv[32];
#pragma unroll
            for (int j = 0; j < 32; ++j) xv[j] = up[(l0 + j) * NUP];
#pragma unroll
            for (int j8 = 0; j8 < 4; ++j8) { float o[8];
#pragma unroll
                for (int j = 0; j < 8; ++j) o[j] = xv[j8 * 8 + j];
                *(LAS v4u*)(VT + vch * 144 + (l0 + j8 * 8) * 2) = pack8(o); } }
    } else {
        const float* prev = WSP(float, WS_GLA_ST);
#pragma unroll 4
        for (int i = tid - 384; i < 8192; i += 128) { const int hh = i >> 11, dd = (i >> 6) & 31, vv = i & 63;
            lds_st_bf16(PVT + (hh * 64 + vv) * 80 + dd * 2, prev[((size_t)(b * 4 + hh) * NCH + c) * 2048 + dd * 64 + vv]); }
    }
    __syncthreads();
    const int hh = wave >> 1;
#pragma unroll 1
    for (int i = 0; i < 2; ++i) { const int tt = 2 * (wave & 1) + i, t = tt * 16 + fr;
#pragma unroll
        for (int st = 0; st < 4; ++st) { f32x4 acc = {0.f, 0.f, 0.f, 0.f}; acc = mm16(QD + tt * 16 * 272 + hh * 64, 272, KI + st * 16 * 272 + hh * 64, 272, 32, acc, fr, fq);
            const int s0 = st * 16 + 4 * fq;
            lds_st_bf16x4(ATT + hh * 9216 + t * 144 + s0 * 2, t >= s0 ? acc[0] : 0.f, t >= s0 + 1 ? acc[1] : 0.f, t >= s0 + 2 ? acc[2] : 0.f, t >= s0 + 3 ? acc[3] : 0.f); } }
    __syncthreads();
    { bf16* mix = WSP(bf16, WS_MIX); const float* ng = KIN(I_GNG) + layer * 256;
#pragma unroll 1
      for (int i = 0; i < 2; ++i) { const int tt = 2 * (wave & 1) + i, t = tt * 16 + fr; f32x4 ov[4]; float ss = 0.f;
#pragma unroll
          for (int vt = 0; vt < 4; ++vt) { f32x4 acc = {0.f, 0.f, 0.f, 0.f};
              acc = mm16(ATT + hh * 9216 + tt * 16 * 144, 144, VT + (hh * 64 + vt * 16) * 144, 144, 64, acc, fr, fq);
              acc = mm16(QD + tt * 16 * 272 + hh * 64, 272, PVT + (hh * 64 + vt * 16) * 80, 80, 32, acc, fr, fq);
              ov[vt] = acc; ss += (acc.x * acc.x + acc.y * acc.y) + (acc.z * acc.z + acc.w * acc.w); }
          ss += __shfl_xor(ss, 16); ss += __shfl_xor(ss, 32);
          const float r = 1.0f / sqrtf(ss * (1.f / 64.f) + NORM_EPS);
#pragma unroll
          for (int vt = 0; vt < 4; ++vt) { const int col = hh * 64 + vt * 16 + 4 * fq; const f32x4 g = *(const f32x4*)(ng + col); const f32x4 og = *(const f32x4*)&UU(t0 + t, U_GL_OG + col);
              v2u o; o.x = cvt_pk_bf16(ov[vt].x * r * g.x * siluf_(og.x), ov[vt].y * r * g.y * siluf_(og.y)); o.y = cvt_pk_bf16(ov[vt].z * r * g.z * siluf_(og.z), ov[vt].w * r * g.w * siluf_(og.w));
              *(v2u*)(mix + (size_t)(t0 + t) * D + 512 + col) = o; } } }
    __syncthreads();
}

__device__ __forceinline__ void mlstm_stage1(Frame& F, const Args& A, int layer, int b, int c) {
    const float* u = WSP(float, WS_U);
    LAS unsigned char* L = F.lds;
    LAS float* WST = (LAS float*)L; LAS unsigned char* KT = L + 1024; LAS unsigned char* VWT = KT + 256 * 144;
    const int t0 = b * SEQ + c * 64, tid = F.tid, lane = F.lane, wave = F.wave, fr = lane & 15, fq = lane >> 4;
    if (wave < 4) {
        const int hh = wave;
        const float ig = UU(t0 + lane, U_ML_I + hh) + KIN(I_MIB)[layer * 4 + hh];
        const float lf = logsigmoidf_(UU(t0 + lane, U_ML_F + hh) + KIN(I_MFB)[layer * 4 + hh]);
        const float bc = wave_scan_add(lf, lane); const float blast = __shfl(bc, 63);
        const float ast = blast - bc + ig; const float mloc = wave_max(ast);
        WST[hh * 64 + lane] = __expf(ast - mloc);
        if (lane == 0) { WSP(float, WS_ML_BL)[(b * 4 + hh) * NCH + c] = blast; WSP(float, WS_ML_ML)[(b * 4 + hh) * NCH + c] = mloc; }
    } else {
        const int kch = tid - 256, cc = 256 + kch; const float* cw = KIN(I_MCW) + (size_t)layer * 2048 + cc; const float w0 = cw[0], w1 = cw[512], w2 = cw[1024], w3 = cw[1536], cb = KIN(I_MCB)[layer * 512 + cc];
        const float* up = u + (size_t)t0 * NUP + U_ML_K + kch;
        float win0 = 0.f, win1 = 0.f, win2 = 0.f;
        if (c > 0) { win0 = up[-3 * NUP]; win1 = up[-2 * NUP]; win2 = up[-1 * NUP]; }
#pragma unroll 1
        for (int l0 = 0; l0 < 64; l0 += 32) { float xv[32];
#pragma unroll
            for (int j = 0; j < 32; ++j) xv[j] = up[(l0 + j) * NUP];
#pragma unroll
            for (int j8 = 0; j8 < 4; ++j8) { float o[8];
#pragma unroll
                for (int j = 0; j < 8; ++j) { const float x = xv[j8 * 8 + j]; const float y = cb + w0 * win0 + w1 * win1 + w2 * win2 + w3 * x; win0 = win1; win1 = win2; win2 = x; o[j] = siluf_(y); }
                *(LAS v4u*)(KT + kch * 144 + (l0 + j8 * 8) * 2) = pack8(o); } }
    }
    __syncthreads();
    if (tid < 256) {
        const int vch = tid, hh = vch >> 6; const float* up = u + (size_t)t0 * NUP + U_ML_V + vch;
#pragma unroll 1
        for (int l0 = 0; l0 < 64; l0 += 32) { float xv[32];
#pragma unroll
            for (int j = 0; j < 32; ++j) xv[j] = up[(l0 + j) * NUP];
#pragma unroll
            for (int j8 = 0; j8 < 4; ++j8) { float o[8];
#pragma unroll
                for (int j = 0; j < 8; ++j) o[j] = xv[j8 * 8 + j] * WST[hh * 64 + l0 + j8 * 8 + j];
                *(LAS v4u*)(VWT + vch * 144 + (l0 + j8 * 8) * 2) = pack8(o); } }
    } else {
        const int kch = tid - 256, hh = kch >> 6; float n = 0.f;
#pragma unroll 8
        for (int s = 0; s < 64; ++s) n += WST[hh * 64 + s] * bf2f(*(const LAS unsigned short*)(KT + kch * 144 + s * 2));
        WSP(float, WS_ML_N)[((size_t)(b * 4 + hh) * NCH + c) * 64 + (kch & 63)] = n;
    }
    __syncthreads();
    { float* cst = WSP(float, WS_ML_C); const int hh = wave >> 1;
#pragma unroll 1
      for (int i = 0; i < 2; ++i) { const int vt = 2 * (wave & 1) + i;
#pragma unroll 1
          for (int kt = 0; kt < 4; ++kt) { f32x4 acc = {0.f, 0.f, 0.f, 0.f}; acc = mm16(VWT + (hh * 64 + vt * 16) * 144, 144, KT + (hh * 64 + kt * 16) * 144, 144, 64, acc, fr, fq);
              *(f32x4*)(cst + (((size_t)(b * 4 + hh) * NCH + c) * 64 + vt * 16 + fr) * 64 + kt * 16 + 4 * fq) = acc; } } }
    __syncthreads();
}
__device__ __forceinline__ void mlstm_stage3(Frame& F, const Args& A, int layer, int b, int c) {
    const float* u = WSP(float, WS_U);
    LAS unsigned char* L = F.lds;
    LAS float* BCU = (LAS float*)L; LAS float* GG = BCU + 256; LAS float* MROW = BCU + 512; LAS float* WINT = BCU + 768; LAS float* NPV = BCU + 1024;
    LAS unsigned char* Q = L + 6144; LAS unsigned char* KK = Q + 64 * 528; LAS unsigned char* VT = KK + 64 * 528; LAS unsigned char* SC = VT + 256 * 144;
    const int t0 = b * SEQ + c * 64, tid = F.tid, lane = F.lane, wave = F.wave, fr = lane & 15, fq = lane >> 4;
    if (wave < 4) {
        const int hh = wave;
        const float ig = UU(t0 + lane, U_ML_I + hh) + KIN(I_MIB)[layer * 4 + hh];
        const float lf = logsigmoidf_(UU(t0 + lane, U_ML_F + hh) + KIN(I_MFB)[layer * 4 + hh]);
        const float bc = wave_scan_add(lf, lane); const float gg = ig - bc;
        const float mprev = WSP(float, WS_ML_M)[(b * 4 + hh) * NCH + c];
        const float minter = bc + mprev, mintra = bc + wave_scan_max(gg, lane), mrow = fmaxf(minter, mintra);
        BCU[hh * 64 + lane] = bc; GG[hh * 64 + lane] = gg; MROW[hh * 64 + lane] = mrow; WINT[hh * 64 + lane] = __expf(minter - mrow);
        NPV[hh * 64 + lane] = WSP(float, WS_ML_N)[((size_t)(b * 4 + hh) * NCH + c) * 64 + lane];
    }
    {
        const int cc = tid; const float* cw = KIN(I_MCW) + (size_t)layer * 2048 + cc; const float w0 = cw[0], w1 = cw[512], w2 = cw[1024], w3 = cw[1536], cb = KIN(I_MCB)[layer * 512 + cc];
        const float* up = u + (size_t)t0 * NUP + U_ML_Q + cc;
        float win0 = 0.f, win1 = 0.f, win2 = 0.f;
        if (c > 0) { win0 = up[-3 * NUP]; win1 = up[-2 * NUP]; win2 = up[-1 * NUP]; }
        LAS unsigned char* dst = cc < 256 ? Q + cc * 2 : KK + (cc - 256) * 2; const float sc = cc < 256 ? 0.125f : 1.0f;
#pragma unroll 1
        for (int l0 = 0; l0 < 64; l0 += 32) { float xv[32];
#pragma unroll
            for (int j = 0; j < 32; ++j) xv[j] = up[(l0 + j) * NUP];
#pragma unroll
            for (int j = 0; j < 32; ++j) { const float x = xv[j]; const float y = cb + w0 * win0 + w1 * win1 + w2 * win2 + w3 * x; win0 = win1; win1 = win2; win2 = x; lds_st_bf16(dst + (l0 + j) * 528, siluf_(y) * sc); } }
        const int vch = tid & 255, lh = (tid >> 8) * 32; const float* uv = u + (size_t)(t0 + lh) * NUP + U_ML_V + vch;
        float xv[32];
#pragma unroll
        for (int j = 0; j < 32; ++j) xv[j] = uv[j * NUP];
#pragma unroll
        for (int j8 = 0; j8 < 4; ++j8) { float o[8];
#pragma unroll
            for (int j = 0; j < 8; ++j) o[j] = xv[j8 * 8 + j];
            *(LAS v4u*)(VT + vch * 144 + (lh + j8 * 8) * 2) = pack8(o); }
    }
    __syncthreads();
    { const int hh = wave >> 1; bf16* mix = WSP(bf16, WS_MIX); const float* ng = KIN(I_MNG) + layer * 256;
      const float* cprev = WSP(float, WS_ML_C) + ((size_t)(b * 4 + hh) * NCH + c) * 4096;
#pragma unroll 1
      for (int i = 0; i < 2; ++i) { const int tt = 2 * (wave & 1) + i, t = tt * 16 + fr;
          const float bt = BCU[hh * 64 + t] - MROW[hh * 64 + t]; float rs = 0.f;
#pragma unroll
          for (int st = 0; st < 4; ++st) { f32x4 acc = {0.f, 0.f, 0.f, 0.f}; acc = mm16(Q + tt * 16 * 528 + hh * 128, 528, KK + st * 16 * 528 + hh * 128, 528, 64, acc, fr, fq);
              const int s0 = st * 16 + 4 * fq; float o[4];
#pragma unroll
              for (int j = 0; j < 4; ++j) { const int s = s0 + j; const float v = (t >= s) ? acc[j] * __expf(bt + GG[hh * 64 + s]) : 0.f; o[j] = v; rs += v; }
              lds_st_bf16x4(SC + hh * 9216 + t * 144 + s0 * 2, o[0], o[1], o[2], o[3]); }
          rs += __shfl_xor(rs, 16); rs += __shfl_xor(rs, 32);
          float nq = 0.f;
#pragma unroll
          for (int j = 0; j < 16; ++j) nq += bf2f(*(const LAS unsigned short*)(Q + t * 528 + (hh * 64 + fq * 16 + j) * 2)) * NPV[hh * 64 + fq * 16 + j];
          nq += __shfl_xor(nq, 16); nq += __shfl_xor(nq, 32);
          const float wi = WINT[hh * 64 + t]; const float den = wi * nq + rs; const float dn = fmaxf(fabsf(den), __expf(-MROW[hh * 64 + t])); const float rdn = 1.0f / dn;
          LDS_WAIT();
          f32x4 hv[4]; float sm = 0.f;
#pragma unroll
          for (int vt = 0; vt < 4; ++vt) { f32x4 acc = {0.f, 0.f, 0.f, 0.f};
              acc = mm16_gB(Q + tt * 16 * 528 + hh * 128, 528, cprev + (size_t)(vt * 16) * 64, 64, 64, acc, fr, fq);
              acc = acc * wi;
              acc = mm16(SC + hh * 9216 + tt * 16 * 144, 144, VT + (hh * 64 + vt * 16) * 144, 144, 64, acc, fr, fq);
              const f32x4 og = *(const f32x4*)&UU(t0 + t, U_ML_O + hh * 64 + vt * 16 + 4 * fq);
              f32x4 h; h.x = acc.x * rdn * sigmoidf_(og.x); h.y = acc.y * rdn * sigmoidf_(og.y); h.z = acc.z * rdn * sigmoidf_(og.z); h.w = acc.w * rdn * sigmoidf_(og.w);
              hv[vt] = h; sm += (h.x + h.y) + (h.z + h.w); }
          sm += __shfl_xor(sm, 16); sm += __shfl_xor(sm, 32);
          const float mean = sm * (1.f / 64.f); float sq = 0.f;
#pragma unroll
          for (int vt = 0; vt < 4; ++vt) { hv[vt] = hv[vt] - mean; sq += (hv[vt].x * hv[vt].x + hv[vt].y * hv[vt].y) + (hv[vt].z * hv[vt].z + hv[vt].w * hv[vt].w); }
          sq += __shfl_xor(sq, 16); sq += __shfl_xor(sq, 32);
          const float r = 1.0f / sqrtf(sq * (1.f / 64.f) + NORM_EPS);
#pragma unroll
          for (int vt = 0; vt < 4; ++vt) { const int col = hh * 64 + vt * 16 + 4 * fq; const f32x4 g = *(const f32x4*)(ng + col);
              v2u o; o.x = cvt_pk_bf16(hv[vt].x * r * g.x, hv[vt].y * r * g.y); o.y = cvt_pk_bf16(hv[vt].z * r * g.z, hv[vt].w * r * g.w);
              *(v2u*)(mix + (size_t)(t0 + t) * D + 768 + col) = o; } } }
    __syncthreads();
}

__device__ __forceinline__ void rwkv_stage1(Frame& F, const Args& A, int layer, int ub) {
    const float* u = WSP(float, WS_U);
    LAS float* LO = (LAS float*)F.lds;
    const int t0 = ub * 64, tid = F.tid;
    const float* mu = KIN(I_RMU) + layer * 896;
    for (int i = tid; i < 64 * 128; i += NWAVES * 64) { const int l = i >> 7, j = i & 127, t = t0 + l; const float cur = UU(t, U_RW_LO + j); const float prv = (t & (SEQ - 1)) ? UU(t - 1, U_RW_LO + j) : 0.f;
        const float xs = cur + (prv - cur) * mu[768 + j]; LO[i] = j < 32 ? tanhf(xs) : (j < 64 ? xs : sigmoidf_(xs)); }
    __syncthreads();
    const int ch = tid & 255, half = tid >> 8;
    float* RW = WSP(float, WS_RW); float* RG = WSP(float, WS_RW_G);
    if (half == 0) {
        float wup[32], aup[32];
        { const f32x4* wp4 = (const f32x4*)(WSP(float, WS_LORA) + (size_t)layer * LORA_PER_LAYER + ch * 32); const f32x4* ap4 = (const f32x4*)(WSP(float, WS_LORA) + (size_t)layer * LORA_PER_LAYER + 8192 + ch * 32);
#pragma unroll
          for (int j = 0; j < 8; ++j) { const f32x4 a = wp4[j], b = ap4[j]; wup[4 * j] = a.x; wup[4 * j + 1] = a.y; wup[4 * j + 2] = a.z; wup[4 * j + 3] = a.w; aup[4 * j] = b.x; aup[4 * j + 1] = b.y; aup[4 * j + 2] = b.z; aup[4 * j + 3] = b.w; } }
        const float w0 = KIN(I_RW0)[layer * 256 + ch], a0 = KIN(I_RA0)[layer * 256 + ch], kkc = KIN(I_RKK)[layer * 256 + ch], kac = KIN(I_RKA)[layer * 256 + ch];
        const float mur = mu[ch], muk = mu[256 + ch], muv = mu[512 + ch];
        const bool seq0 = (t0 & (SEQ - 1)) == 0;
        float rp = seq0 ? 0.f : UU(t0 - 1, U_RW_R + ch), kp = seq0 ? 0.f : UU(t0 - 1, U_RW_K + ch), vp = seq0 ? 0.f : UU(t0 - 1, U_RW_V + ch);
#pragma unroll 1
        for (int l0 = 0; l0 < 64; l0 += 8) { float rc[8], kc[8], vc[8];
#pragma unroll
            for (int j = 0; j < 8; ++j) { rc[j] = UU(t0 + l0 + j, U_RW_R + ch); kc[j] = UU(t0 + l0 + j, U_RW_K + ch); vc[j] = UU(t0 + l0 + j, U_RW_V + ch); }
#pragma unroll
            for (int j = 0; j < 8; ++j) { const int l = l0 + j, t = t0 + l;
                const float r = rc[j] + (rp - rc[j]) * mur, k = kc[j] + (kp - kc[j]) * muk, v = vc[j] + (vp - vc[j]) * muv; rp = rc[j]; kp = kc[j]; vp = vc[j];
                float wp = w0, ap = a0;
#pragma unroll
                for (int q = 0; q < 32; ++q) { wp += LO[l * 128 + q] * wup[q]; ap += LO[l * 128 + 32 + q] * aup[q]; }
                const float w = -softplusf_(-wp) - 0.5f; const float dec = __expf(-__expf(w)); const float a = sigmoidf_(ap);
                const float kk = k * kkc; const float nrm = sqrtf(wave_sum(kk * kk)); const float kkn = kk / fmaxf(nrm, 1e-12f);
                const float k2 = k * (1.0f + (a - 1.0f) * kac);
                float* o = RW + (size_t)t * 1536 + ch; o[0] = r; o[256] = dec; o[512] = k2; o[768] = v; o[1024] = -kkn; o[1280] = kkn * a; } }
    } else {
        float gup[64];
        { const f32x4* gp4 = (const f32x4*)(WSP(float, WS_LORA) + (size_t)layer * LORA_PER_LAYER + 16384 + ch * 64);
#pragma unroll
          for (int j = 0; j < 16; ++j) { const f32x4 a = gp4[j]; gup[4 * j] = a.x; gup[4 * j + 1] = a.y; gup[4 * j + 2] = a.z; gup[4 * j + 3] = a.w; } }
#pragma unroll 1
        for (int l = 0; l < 64; ++l) { float g = 0.f;
#pragma unroll
            for (int j = 0; j < 64; ++j) g += LO[l * 128 + 64 + j] * gup[j];
            RG[(size_t)(t0 + l) * 256 + ch] = g; }
    }
    __syncthreads();
}
#define DPP_ADD(v, ctrl) v += __builtin_bit_cast(float, __builtin_amdgcn_update_dpp(0, __builtin_bit_cast(int, v), ctrl, 0xF, 0xF, true))
__device__ __forceinline__ float row16_sum(float v) { DPP_ADD(v, 0xB1); DPP_ADD(v, 0x4E); DPP_ADD(v, 0x141); DPP_ADD(v, 0x140); return v; }
__device__ __forceinline__ void rwkv_scan_wave(Frame& F, const Args& A, int wslot) {
    const int lane = F.lane, bh = wslot >> 4, b = bh >> 2, h = bh & 3, v0 = (wslot & 15) * 4 + (lane >> 4), kq = lane & 15;
    const float* RW = WSP(float, WS_RW) + (size_t)b * SEQ * 1536 + h * 64 + 4 * kq;
    const float* RV = WSP(float, WS_RW) + (size_t)b * SEQ * 1536 + 768 + h * 64 + v0;
    float* RO = WSP(float, WS_RW_O) + (size_t)b * SEQ * 256 + h * 64 + v0;
    f32x4 s = {0.f, 0.f, 0.f, 0.f};
    f32x4 r_[4], w_[4], k_[4], a_[4], b_[4]; float v_[4];
#define RW_LOAD(tb) do { _Pragma("unroll") for (int j = 0; j < 4; ++j) { const float* p = RW + (size_t)((tb) + j) * 1536; r_[j] = *(const f32x4*)p; w_[j] = *(const f32x4*)(p + 256); k_[j] = *(const f32x4*)(p + 512); a_[j] = *(const f32x4*)(p + 1024); b_[j] = *(const f32x4*)(p + 1280); v_[j] = RV[(size_t)((tb) + j) * 1536]; } } while (0)
    RW_LOAD(0);
#pragma unroll 1
    for (int tb = 0; tb < SEQ; tb += 4) {
        f32x4 rc[4], wc[4], kc[4], ac[4], bc[4]; float vc[4];
#pragma unroll
        for (int j = 0; j < 4; ++j) { rc[j] = r_[j]; wc[j] = w_[j]; kc[j] = k_[j]; ac[j] = a_[j]; bc[j] = b_[j]; vc[j] = v_[j]; }
        if (tb + 4 < SEQ) RW_LOAD(tb + 4);
#pragma unroll
        for (int j = 0; j < 4; ++j) {
            float p = (s.x * ac[j].x + s.y * ac[j].y) + (s.z * ac[j].z + s.w * ac[j].w);
            const float sa = row16_sum(p);
            s.x = s.x * wc[j].x + (sa * bc[j].x + vc[j] * kc[j].x); s.y = s.y * wc[j].y + (sa * bc[j].y + vc[j] * kc[j].y);
            s.z = s.z * wc[j].z + (sa * bc[j].z + vc[j] * kc[j].z); s.w = s.w * wc[j].w + (sa * bc[j].w + vc[j] * kc[j].w);
            float q = (s.x * rc[j].x + s.y * rc[j].y) + (s.z * rc[j].z + s.w * rc[j].w);
            const float o = row16_sum(q);
            if (kq == 0) RO[(size_t)(tb + j) * 256] = o;
        }
    }
#undef RW_LOAD
}
__device__ __forceinline__ void rwkv_stage3(Frame& F, const Args& A, int layer, int ub) {
    const int t0 = ub * 64, tid = F.tid, ch = tid & 255, half = tid >> 8;
    const float* RW = WSP(float, WS_RW); const float* RG = WSP(float, WS_RW_G); const float* RO = WSP(float, WS_RW_O); bf16* mix = WSP(bf16, WS_MIX);
    const float lg = KIN(I_RLNG)[layer * 256 + ch], lb = KIN(I_RLNB)[layer * 256 + ch], rk = KIN(I_RRK)[layer * 256 + ch];
#pragma unroll 4
    for (int li = 0; li < 32; ++li) { const int t = t0 + half * 32 + li;
        const float o = RO[(size_t)t * 256 + ch]; const float* p = RW + (size_t)t * 1536 + ch; const float r = p[0], k2 = p[512], v = p[768], g = RG[(size_t)t * 256 + ch];
        const float mean = wave_sum(o) * (1.f / 64.f); const float d = o - mean; const float var = wave_sum(d * d) * (1.f / 64.f);
        const float on = d * (1.0f / sqrtf(var + RWKV_GN_EPS)) * lg + lb; const float bonus = wave_sum(r * k2 * rk) * v;
        mix[(size_t)t * D + 256 + ch] = (bf16)(cvt_pk_bf16((on + bonus) * g, 0.f) & 0xffffu); }
}

__device__ __forceinline__ void scans_elementwise(Frame& F, const Args& A) {
    const int nthr = F.G * 448, gt = F.vcu * 448 + (F.tid - 64);
    constexpr int N_SSD = 16 * 64 * 128, N_GLA = 16 * 32 * 64, N_MLC = 16 * 64 * 64, N_MLN = 16 * 64;
    for (int i = gt; i < N_SSD + N_GLA + N_MLC + N_MLN; i += nthr) {
        if (i < N_SSD) { const int bh = i >> 13, pn = i & 8191; float* base = WSP(float, WS_SSD_ST) + (size_t)bh * NCH * 8192 + pn; const float* dec = WSP(float, WS_SSD_DEC) + bh * NCH; float S = 0.f;
#pragma unroll 1
            for (int c0 = 0; c0 < NCH; c0 += 8) { float x[8], dd[8];
#pragma unroll
                for (int j = 0; j < 8; ++j) { x[j] = base[(size_t)(c0 + j) * 8192]; dd[j] = dec[c0 + j]; }
#pragma unroll
                for (int j = 0; j < 8; ++j) { base[(size_t)(c0 + j) * 8192] = S; S = dd[j] * S + x[j]; } }
        } else if (i < N_SSD + N_GLA) { const int k = i - N_SSD, bh = k >> 11, dv = k & 2047, dd_ = dv >> 6, b = bh >> 2, hh = bh & 3; float* base = WSP(float, WS_GLA_ST) + (size_t)bh * NCH * 2048 + dv; const float* dec = WSP(float, WS_GLA_DEC) + (size_t)b * NCH * 128 + hh * 32 + dd_; float S = 0.f;
#pragma unroll 1
            for (int c0 = 0; c0 < NCH; c0 += 8) { float x[8], dd[8];
#pragma unroll
                for (int j = 0; j < 8; ++j) { x[j] = base[(size_t)(c0 + j) * 2048]; dd[j] = dec[(c0 + j) * 128]; }
#pragma unroll
                for (int j = 0; j < 8; ++j) { base[(size_t)(c0 + j) * 2048] = S; S = dd[j] * S + x[j]; } }
        } else { const int k = i - N_SSD - N_GLA; const bool isn = k >= N_MLC; const int kk = isn ? k - N_MLC : k; const int bh = isn ? (kk >> 6) : (kk >> 12), e = isn ? (kk & 63) : (kk & 4095), str = isn ? 64 : 4096;
            float* base = (isn ? WSP(float, WS_ML_N) : WSP(float, WS_ML_C)) + (size_t)bh * NCH * str + e; const float* bl = WSP(float, WS_ML_BL) + bh * NCH; const float* ml = WSP(float, WS_ML_ML) + bh * NCH; float* mo = WSP(float, WS_ML_M) + bh * NCH;
            float S = 0.f, m = 0.f;
#pragma unroll 1
            for (int c0 = 0; c0 < NCH; c0 += 8) { float x[8], b8[8], m8[8];
#pragma unroll
                for (int j = 0; j < 8; ++j) { x[j] = base[(size_t)(c0 + j) * str]; b8[j] = bl[c0 + j]; m8[j] = ml[c0 + j]; }
#pragma unroll
                for (int j = 0; j < 8; ++j) { const float mn = fmaxf(b8[j] + m, m8[j]); const float so = __expf(b8[j] + m - mn), sn = __expf(m8[j] - mn);
                    base[(size_t)(c0 + j) * str] = S; if (!isn && e == 0) mo[c0 + j] = m; S = so * S + sn * x[j]; m = mn; } }
        }
    }
}
#ifndef MK_PER_PHASE_LAUNCH
#define MK_PER_PHASE_LAUNCH 0
#endif
#ifndef PH_MASK
#define PH_MASK 0xFFF
#endif
#ifndef ST_MASK
#define ST_MASK 0xF
#endif
#define ST_ON(k) (((ST_MASK) >> (k)) & 1)
#define PH_ON(k) (((PH_MASK) >> (k)) & 1)
constexpr int PH_PER_LAYER = 11, N_PHASES = 1 + DEPTH * PH_PER_LAYER;
__global__ void __launch_bounds__(NWAVES * 64, 2) fwd_kernel(Args args) {
    extern __shared__ __attribute__((aligned(16))) unsigned char lds[];
    Frame F;
    F.lds = (LAS unsigned char*)lds;
    F.MISC = (volatile LAS unsigned*)(F.lds + MISC_OFF);
    F.tid = threadIdx.x; F.lane = F.tid & 63; F.wave = __builtin_amdgcn_readfirstlane(F.tid >> 6);
    F.G = gridDim.x; { const int bx = blockIdx.x; F.vcu = (F.G % 8 == 0) ? (bx % 8) * (F.G / 8) + bx / 8 : bx; }
    F.ka = (karg_t)__builtin_amdgcn_kernarg_segment_ptr(); F.ws = args.ws; F.ctl = (gu32*)(args.ws + WS_CTL); F.out = args.out;
    for (int i = F.tid; i < 256; i += NWAVES * 64) F.MISC[i] = 0u;
    __syncthreads();
    const int lo = args.ph_lo, hi = args.ph_hi;
    XcdBarrier bar; bar.bar = (unsigned*)(F.ctl + CW_BAR); bar.x = 0; bar.st = nullptr;
    if (hi - lo > 1) bar = xcd_barrier_post((unsigned*)(F.ctl + CW_BAR), F.MISC + MW_BAR);
#define IN_(k) (lo <= (k) && (k) < hi)
#define SEAM(k) do { if (IN_(k) && IN_((k) + 1)) xcd_barrier(bar); } while (0)

    if (PH_ON(11) && IN_(0)) { frame_refresh(F); p0_prologue(F, args); SEAM(0); }
#pragma unroll 1
    for (int layer = 0; layer < DEPTH; ++layer) {
        const int pb = 1 + layer * PH_PER_LAYER;
        if (PH_ON(0) && IN_(pb + 0)) { frame_refresh(F);
            { pg8::DenseSched S; S.init(WSP(bf16, WS_XB), WSP(bf16, WS_WIN_T) + (size_t)layer * NUP * D, T, NUP, D, F.G, (int)blockIdx.x);
              pg8::EpiF32 E{WSP(float, WS_U), NUP, nullptr, 0.f};
              pg8::gemm_phase<pg8::EpiF32, pg8::DenseSched>(F.lds, F.tid, S, E); }
            { pg8::DenseSched S; S.init(WSP(bf16, WS_PB) + (size_t)layer * T * 256, WSP(bf16, WS_WPP_T) + (size_t)layer * D * 256, T, D, 256, F.G, (int)blockIdx.x);
              pg8::EpiF32 E{WSP(float, WS_PE), D, nullptr, 0.f};
              pg8::gemm_phase<pg8::EpiF32, pg8::DenseSched>(F.lds, F.tid, S, E); }
            SEAM(pb + 0);
        }
        if (PH_ON(1) && IN_(pb + 1)) { frame_refresh(F);
            for (int un = F.vcu; un < 1024; un += F.G) { frame_refresh(F); const int ty = un >> 8, r = un & 255, b = r >> 6, c = r & 63;
                if (ST_ON(0) && ty == 0) ssd_stage1(F, args, layer, b, c); else if (ST_ON(1) && ty == 1) gla_stage1(F, args, layer, b, c); else if (ST_ON(2) && ty == 2) mlstm_stage1(F, args, layer, b, c); else if (ST_ON(3) && ty == 3) rwkv_stage1(F, args, layer, r); }
            SEAM(pb + 1);
        }
        if (PH_ON(2) && IN_(pb + 2)) { frame_refresh(F);
            if (F.wave == 0) { for (int ws_ = F.vcu; ws_ < 256; ws_ += F.G) rwkv_scan_wave(F, args, ws_); }
            else scans_elementwise(F, args);
            SEAM(pb + 2);
        }
        if (PH_ON(3) && IN_(pb + 3)) { frame_refresh(F);
            for (int un = F.vcu; un < 1024; un += F.G) { frame_refresh(F); const int ty = un >> 8, r = un & 255, b = r >> 6, c = r & 63;
                if (ST_ON(0) && ty == 0) ssd_stage3(F, args, layer, b, c); else if (ST_ON(1) && ty == 1) gla_stage3(F, args, layer, b, c); else if (ST_ON(2) && ty == 2) mlstm_stage3(F, args, layer, b, c); else if (ST_ON(3) && ty == 3) rwkv_stage3(F, args, layer, r); }
            SEAM(pb + 3);
        }
        if (PH_ON(4) && IN_(pb + 4)) { frame_refresh(F);
            pg8::DenseSched S; S.init(WSP(bf16, WS_MIX), WSP(bf16, WS_WOUT_T) + (size_t)layer * D * D, T, D, D, F.G, (int)blockIdx.x);
            pg8::EpiF32 E{WSP(float, WS_Y1), D, layer == 0 ? KIN(I_X) : (const float*)F.out, DN_ALPHA};
            pg8::gemm_phase<pg8::EpiF32, pg8::DenseSched>(F.lds, F.tid, S, E);
            SEAM(pb + 4);
        }
        if (PH_ON(5) && IN_(pb + 5)) { frame_refresh(F); p6_ln1_router(F, args, layer); SEAM(pb + 5); }
        if (PH_ON(6) && IN_(pb + 6)) { frame_refresh(F);
            moe_build_pfx(F, args, layer, 8);
            pg8::Moe1Sched S; S.O.pfx = F.MISC + MW_PFX; S.O.NT = 8; S.O.G = F.G; S.O.c = (int)blockIdx.x; S.X = WSP(bf16, WS_X1B); S.W = WSP(bf16, WS_WGU_T) + (size_t)layer * NE * 2048 * D; S.sdest = WSP(int, WS_SDEST); S.K = D; S.hstepB = (size_t)1024 * D * 2;
            pg8::EpiMoe1 E{WSP(bf16, WS_ABUF), KIN(I_BGU) + (size_t)layer * NE * 2048};
            pg8::gemm_phase<pg8::EpiMoe1, pg8::Moe1Sched>(F.lds, F.tid, S, E);
            SEAM(pb + 6);
        }
        if (PH_ON(7) && IN_(pb + 7)) { frame_refresh(F);
            moe_build_pfx(F, args, layer, 4);
            pg8::Moe2Sched S; S.O.pfx = F.MISC + MW_PFX; S.O.NT = 4; S.O.G = F.G; S.O.c = (int)blockIdx.x; S.Ab = WSP(bf16, WS_ABUF); S.W = WSP(bf16, WS_WDN_T) + (size_t)layer * NE * D * D; S.K = D; S.hstepB = (size_t)128 * D * 2;
            pg8::EpiMoe2 E{WSP(float, WS_YBUF), KIN(I_BDN) + (size_t)layer * NE * D, WSP(int, WS_SDEST), WSP(float, WS_SGATE)};
            pg8::gemm_phase<pg8::EpiMoe2, pg8::Moe2Sched>(F.lds, F.tid, S, E);
            SEAM(pb + 7);
        }
        if (PH_ON(8) && IN_(pb + 8)) { frame_refresh(F); p9_combine(F, args); SEAM(pb + 8); }
        if (PH_ON(9) && IN_(pb + 9)) { frame_refresh(F);
            pg8::DenseSched S; S.init(WSP(bf16, WS_HB), WSP(bf16, WS_WPG_T) + (size_t)layer * D * D, T, D, D, F.G, (int)blockIdx.x);
            pg8::EpiPle E{WSP(float, WS_H2), WSP(float, WS_H), WSP(float, WS_PE)};
            pg8::gemm_phase<pg8::EpiPle, pg8::DenseSched>(F.lds, F.tid, S, E);
            SEAM(pb + 9);
        }
        if (PH_ON(10) && IN_(pb + 10)) { frame_refresh(F); p11_ln2(F, args, layer); SEAM(pb + 10); }
    }
#undef IN_
#undef SEAM
}

extern "C" void kernel_launch(void* const* d_in, const int* in_sizes, int n_in, void* d_out, int out_size, void* d_ws, size_t ws_size, hipStream_t stream) {
    static int grid = 0;
    if (grid == 0) {
        if (n_in != N_IN || out_size != T * D || ws_size < WS_END) { fprintf(stderr, "kernel_launch: unexpected shapes (n_in %d, out %d, ws %zu < %zu); nothing launched\n", n_in, out_size, ws_size, (size_t)WS_END); grid = -1; return; }
        int dev = 0, cus = 0, per_cu = 0;
        if (hipGetDevice(&dev) != hipSuccess || hipDeviceGetAttribute(&cus, hipDeviceAttributeMultiprocessorCount, dev) != hipSuccess) { grid = -1; return; }
        if (hipFuncSetAttribute((const void*)fwd_kernel, hipFuncAttributeMaxDynamicSharedMemorySize, LDS_BYTES) != hipSuccess) { fprintf(stderr, "kernel_launch: hipFuncSetAttribute failed\n"); grid = -1; return; }
        if (hipOccupancyMaxActiveBlocksPerMultiprocessor(&per_cu, (const void*)fwd_kernel, NWAVES * 64, LDS_BYTES) != hipSuccess || per_cu < 1) { fprintf(stderr, "kernel_launch: occupancy query says %d blocks per CU\n", per_cu); }
        (void)hipGetLastError();
        grid = cus;
    }
    if (grid < 0) return;
    (void)hipMemsetAsync((char*)d_ws + WS_CTL, 0, CTL_ZERO_BYTES, stream);
    Args a{};
    for (int i = 0; i < N_IN; ++i) a.in[i] = (const float*)d_in[i];
    a.out = (float*)d_out; a.ws = (unsigned char*)d_ws;
#if MK_PER_PHASE_LAUNCH
    for (int ph = 0; ph < N_PHASES; ++ph) { a.ph_lo = ph; a.ph_hi = ph + 1; hipLaunchKernelGGL(fwd_kernel, dim3(grid), dim3(NWAVES * 64), LDS_BYTES, stream, a); }
#else
    a.ph_lo = 0; a.ph_hi = N_PHASES; hipLaunchKernelGGL(fwd_kernel, dim3(grid), dim3(NWAVES * 64), LDS_BYTES, stream, a);
#endif
    const hipError_t le = hipPeekAtLastError();
    if (le != hipSuccess) fprintf(stderr, "kernel_launch: launch failed: %s\n", hipGetErrorName(le));
}
```

```cpp
#include <hip/hip_runtime.h>
#include <cstdio>
#include <cstdint>

#define GAS __attribute__((address_space(1)))
#define LAS __attribute__((address_space(3)))
typedef unsigned short bf16;
typedef unsigned v4u __attribute__((ext_vector_type(4)));
typedef unsigned v2u __attribute__((ext_vector_type(2)));
typedef float f32x4 __attribute__((ext_vector_type(4)));
typedef float f32x2 __attribute__((ext_vector_type(2)));
typedef short bf16x8 __attribute__((ext_vector_type(8)));
typedef GAS unsigned gu32;
#define RLX_AGENT __ATOMIC_RELAXED, __HIP_MEMORY_SCOPE_AGENT
#define LDS_WAIT() asm volatile("s_waitcnt lgkmcnt(0)" ::: "memory")
#define VM_WAIT() asm volatile("s_waitcnt vmcnt(0)" ::: "memory")

constexpr int NWAVES = 8;
constexpr int DEPTH = 4, BATCH = 4, SEQ = 4096, D = 1024, T = BATCH * SEQ;
constexpr int NU = 3484, NUP = 3584;
constexpr int NE = 32, TOPK = 4, ECAP = 16384;
constexpr int NCH = SEQ / 64;
constexpr int U_SSD_Z = 0, U_SSD_X = 256, U_SSD_B = 512, U_SSD_C = 640, U_SSD_DT = 768;
constexpr int U_RW = 772, U_RW_R = 772, U_RW_K = 1028, U_RW_V = 1284, U_RW_LO = 1540;
constexpr int U_GL_Q = 1668, U_GL_K = 1796, U_GL_V = 1924, U_GL_G = 2180, U_GL_OG = 2196;
constexpr int U_ML_Q = 2452, U_ML_K = 2708, U_ML_V = 2964, U_ML_I = 3220, U_ML_F = 3224, U_ML_O = 3228;
constexpr float DN_ALPHA = 1.6817928305074290f;
constexpr float LN_EPS = 1e-5f, NORM_EPS = 1e-5f, RWKV_GN_EPS = 64e-5f;

enum { I_X = 0, I_P, I_WIN, I_WOUT, I_LN1G, I_LN1B, I_SCW, I_SCB, I_SALOG, I_SDTB, I_SD, I_SNG,
       I_RMU, I_RW0, I_RWUP, I_RA0, I_RAUP, I_RGUP, I_RKK, I_RKA, I_RRK, I_RLNG, I_RLNB,
       I_GGUP, I_GGB, I_GNG, I_MCW, I_MCB, I_MIB, I_MFB, I_MNG,
       I_RTW, I_RTB, I_WGU, I_BGU, I_WDN, I_BDN, I_PGW, I_PPJ, I_LN2G, I_LN2B, N_IN };

constexpr size_t MiB = 1u << 20;
constexpr size_t WS_CTL = 0, CTL_ZERO_BYTES = 1 * MiB;
constexpr size_t WS_WIN_T = 2 * MiB;
constexpr size_t WS_WOUT_T = WS_WIN_T + (size_t)DEPTH * NUP * D * 2;
constexpr size_t WS_WGU_T = WS_WOUT_T + (size_t)DEPTH * D * D * 2;
constexpr size_t WS_WDN_T = WS_WGU_T + (size_t)DEPTH * NE * 2048 * D * 2;
constexpr size_t WS_WPG_T = WS_WDN_T + (size_t)DEPTH * NE * D * D * 2;
constexpr size_t WS_WPP_T = WS_WPG_T + (size_t)DEPTH * D * D * 2;
constexpr size_t WS_RWT = WS_WPP_T + (size_t)DEPTH * D * 256 * 2;
constexpr size_t WS_PB = WS_RWT + (size_t)DEPTH * NE * D * 4;
constexpr size_t WS_XB = WS_PB + (size_t)DEPTH * T * 256 * 2;
constexpr size_t WS_U = WS_XB + (size_t)T * D * 2;
constexpr size_t WS_PE = WS_U + (size_t)T * NUP * 4;
constexpr size_t WS_MIX = WS_PE + (size_t)T * D * 4;
constexpr size_t WS_Y1 = WS_MIX + (size_t)T * D * 2;
constexpr size_t WS_X1 = WS_Y1 + (size_t)T * D * 4;
constexpr size_t WS_X1B = WS_X1 + (size_t)T * D * 4;
constexpr size_t WS_SDEST = WS_X1B + (size_t)T * D * 2;
constexpr size_t WS_SGATE = WS_SDEST + (size_t)NE * ECAP * 4;
constexpr size_t WS_ABUF = WS_SGATE + (size_t)NE * ECAP * 4;
constexpr size_t WS_YBUF = WS_ABUF + (size_t)NE * ECAP * D * 2;
constexpr size_t WS_H = WS_YBUF + (size_t)T * 4 * D * 4;
constexpr size_t WS_HB = WS_H + (size_t)T * D * 4;
constexpr size_t WS_H2 = WS_HB + (size_t)T * D * 2;
constexpr size_t WS_SSD_ST = WS_H2 + (size_t)T * D * 4;
constexpr size_t WS_SSD_DEC = WS_SSD_ST + (size_t)16 * NCH * 64 * 128 * 4;
constexpr size_t WS_GLA_ST = WS_SSD_DEC + 16 * NCH * 4;
constexpr size_t WS_GLA_DEC = WS_GLA_ST + (size_t)16 * NCH * 32 * 64 * 4;
constexpr size_t WS_ML_C = WS_GLA_DEC + (size_t)4 * NCH * 128 * 4;
constexpr size_t WS_ML_N = WS_ML_C + (size_t)16 * NCH * 64 * 64 * 4;
constexpr size_t WS_ML_BL = WS_ML_N + (size_t)16 * NCH * 64 * 4;
constexpr size_t WS_ML_ML = WS_ML_BL + 16 * NCH * 4;
constexpr size_t WS_ML_M = WS_ML_ML + 16 * NCH * 4;
constexpr size_t WS_RW = WS_ML_M + 16 * NCH * 4;
constexpr size_t WS_RW_G = WS_RW + (size_t)T * 3 * 256 * 4;
constexpr size_t WS_RW_RH = WS_RW_G + (size_t)T * 256 * 4;
constexpr size_t WS_RW_O0 = WS_RW_RH + (size_t)1024 * 4096 * 2;
constexpr size_t WS_RW_GF = WS_RW_O0 + (size_t)1024 * 4096 * 4;
constexpr size_t WS_RW_HT = WS_RW_GF + (size_t)1024 * 4096 * 2;
constexpr size_t WS_RW_PT = WS_RW_HT + (size_t)1024 * 4096 * 4;
constexpr size_t WS_LORA = WS_RW_PT + (size_t)1024 * 4096 * 2;
constexpr int LORA_PER_LAYER = 8192 + 8192 + 16384 + 2048;
constexpr size_t WS_END = WS_LORA + (size_t)DEPTH * LORA_PER_LAYER * 4;
constexpr int CW_BAR = 4096;
constexpr int CW_DBG = 32768;
constexpr int CW_CNT = 16384;

constexpr int RING_BYTES = 147456;
constexpr int MISC_OFF = RING_BYTES;
constexpr int LDS_BYTES = RING_BYTES + 1024;
constexpr int MW_BAR = 8, MW_LCNT = 32, MW_LBASE = 64, MW_PFX = 96, MW_CNT = 136, MW_GAMC = 168;

typedef __bf16 bf16x2_t __attribute__((ext_vector_type(2)));
__device__ __forceinline__ unsigned cvt_pk_bf16(float lo, float hi) { const f32x2 v = {lo, hi}; const bf16x2_t b = __builtin_convertvector(v, bf16x2_t); return __builtin_bit_cast(unsigned, b); }
__device__ __forceinline__ float bf2f(unsigned short b) { return __uint_as_float(((unsigned)b) << 16); }
__device__ __forceinline__ float sigmoidf_(float x) { return 1.0f / (1.0f + __expf(-x)); }
__device__ __forceinline__ float siluf_(float x) { return x / (1.0f + __expf(-x)); }
__device__ __forceinline__ float softplusf_(float x) { return fmaxf(x, 0.f) + log1pf(__expf(-fabsf(x))); }
__device__ __forceinline__ float logsigmoidf_(float x) { return fminf(x, 0.f) - log1pf(__expf(-fabsf(x))); }
__device__ __forceinline__ float wave_sum(float v) {
#pragma unroll
    for (int o = 1; o < 64; o <<= 1) v += __shfl_xor(v, o);
    return v;
}
__device__ __forceinline__ float wave_max(float v) {
#pragma unroll
    for (int o = 1; o < 64; o <<= 1) v = fmaxf(v, __shfl_xor(v, o));
    return v;
}
__device__ __forceinline__ float wave_scan_add(float v, int lane) {
#pragma unroll
    for (int o = 1; o < 64; o <<= 1) { const float t = __shfl_up(v, o); if (lane >= o) v += t; }
    return v;
}
__device__ __forceinline__ float wave_scan_max(float v, int lane) {
#pragma unroll
    for (int o = 1; o < 64; o <<= 1) { const float t = __shfl_up(v, o); if (lane >= o) v = fmaxf(v, t); }
    return v;
}
__device__ __forceinline__ f32x4 mm16(const LAS unsigned char* A, int lda, const LAS unsigned char* B, int ldb, int K, f32x4 acc, int fr, int fq) {
    const LAS unsigned char* ap = A + fr * lda + fq * 16; const LAS unsigned char* bp = B + fr * ldb + fq * 16;
    for (int k = 0; k < K; k += 32) {
        const bf16x8 a = *(const LAS bf16x8*)(ap + k * 2); const bf16x8 b = *(const LAS bf16x8*)(bp + k * 2);
        acc = __builtin_amdgcn_mfma_f32_16x16x32_bf16(b, a, acc, 0, 0, 0);
    }
    return acc;
}
__device__ __forceinline__ f32x4 mm16_gB(const LAS unsigned char* A, int lda, const float* B, int ldb, int K, f32x4 acc, int fr, int fq) {
    const LAS unsigned char* ap = A + fr * lda + fq * 16; const float* bp = B + (size_t)fr * ldb + fq * 8;
    for (int k = 0; k < K; k += 32) {
        const bf16x8 a = *(const LAS bf16x8*)(ap + k * 2);
        const f32x4 b0 = *(const f32x4*)(bp + k), b1 = *(const f32x4*)(bp + k + 4);
        v4u bw; bw.x = cvt_pk_bf16(b0.x, b0.y); bw.y = cvt_pk_bf16(b0.z, b0.w); bw.z = cvt_pk_bf16(b1.x, b1.y); bw.w = cvt_pk_bf16(b1.z, b1.w);
        const bf16x8 b = __builtin_bit_cast(bf16x8, bw);
        acc = __builtin_amdgcn_mfma_f32_16x16x32_bf16(b, a, acc, 0, 0, 0);
    }
    return acc;
}
__device__ __forceinline__ f32x4 mm16_gAB(const bf16* A, int lda, const bf16* B, int ldb, int K, f32x4 acc, int fr, int fq) {
    const bf16* ap = A + (size_t)fr * lda + fq * 8; const bf16* bp = B + (size_t)fr * ldb + fq * 8;
    for (int k = 0; k < K; k += 32) { const bf16x8 a = *(const bf16x8*)(ap + k), b = *(const bf16x8*)(bp + k); acc = __builtin_amdgcn_mfma_f32_16x16x32_bf16(b, a, acc, 0, 0, 0); }
    return acc;
}
__device__ __forceinline__ v4u pack8(const float (&v)[8]) { v4u o; o.x = cvt_pk_bf16(v[0], v[1]); o.y = cvt_pk_bf16(v[2], v[3]); o.z = cvt_pk_bf16(v[4], v[5]); o.w = cvt_pk_bf16(v[6], v[7]); return o; }

#define XB_TMO      128
#define XB_XCNT(j)  (256  + 64 * (j))
#define XB_XSUB(j)  (1280 + 64 * (j))
#define XB_XGEN(j)  (2304 + 64 * (j))
#define XB_TOP      3328
#define XB_TOPGEN   3392
#define XCD_BAR_WORDS 3456
#define XB_SPIN_CAP (1u << 18)
__device__ __forceinline__ unsigned xb_ld(unsigned* p)              { return __hip_atomic_load(p, __ATOMIC_RELAXED, __HIP_MEMORY_SCOPE_AGENT); }
__device__ __forceinline__ unsigned xb_add(unsigned* p, unsigned v) { return __hip_atomic_fetch_add(p, v, __ATOMIC_RELAXED, __HIP_MEMORY_SCOPE_AGENT); }
__device__ __forceinline__ unsigned xb_xcc_id() { return (unsigned)__builtin_amdgcn_s_getreg((3 << 11) | 20) & 0xFu; }
#define XB_SPIN(cond, bar) do { unsigned _sp = 0; while (cond) { __builtin_amdgcn_s_sleep(1); \
    if ((++_sp & 255u) == 0u) { if (xb_ld(&(bar)[XB_TMO])) break; if (_sp > XB_SPIN_CAP) { atomicAdd(&(bar)[XB_TMO], 1u); break; } } } } while (0)
struct XcdBarrier { unsigned* bar; unsigned x; volatile LAS unsigned* st; };
__device__ __forceinline__ XcdBarrier xcd_barrier_post(unsigned* bar, volatile LAS unsigned* st) {
    XcdBarrier b; b.bar = bar; b.x = xb_xcc_id(); b.st = st;
    if (threadIdx.x == 0) (void)xb_add(&bar[XB_XCNT(b.x)], 1u);
    return b;
}
__device__ __forceinline__ void xcd_barrier_complete(unsigned* bar, unsigned x, unsigned& nloc, unsigned& nx) {
    const unsigned G = gridDim.x * gridDim.y * gridDim.z;
    unsigned sum, cnt, mine, sp = 0u;
    for (;;) {
        sum = 0u; cnt = 0u; mine = 0u;
#pragma unroll
        for (unsigned j = 0; j < 16; ++j) { const unsigned c = xb_ld(&bar[XB_XCNT(j)]); sum += c; cnt += (c > 0u) ? 1u : 0u; mine = (j == x) ? c : mine; }
        if (sum == G) break;
        __builtin_amdgcn_s_sleep(1);
        if ((++sp & 255u) == 0u) { if (xb_ld(&bar[XB_TMO])) break; if (sp > XB_SPIN_CAP) { atomicAdd(&bar[XB_TMO], 1u); break; } }
    }
    nloc = mine > 0u ? mine : 1u; nx = cnt > 0u ? cnt : 1u;
}
__device__ __forceinline__ void xcd_barrier(const XcdBarrier& b) {
    asm volatile("s_waitcnt vmcnt(0)" ::: "memory");
    __syncthreads();
    if (threadIdx.x == 0) {
        unsigned* bar = b.bar;
        __builtin_amdgcn_s_waitcnt(0);
        unsigned nloc = b.st[0], nx = b.st[1];
        if (nloc == 0u) { xcd_barrier_complete(bar, b.x, nloc, nx); b.st[0] = nloc; b.st[1] = nx; }
        const unsigned old = xb_add(&bar[XB_XSUB(b.x)], 1u);
        const unsigned gen = old / nloc;
        if (old + 1u == (gen + 1u) * nloc) {
            __builtin_amdgcn_fence(__ATOMIC_RELEASE, "agent");
            asm volatile("s_waitcnt vmcnt(0)" ::: "memory");
            const unsigned og = xb_add(&bar[XB_TOP], 1u);
            const unsigned tg = og / nx;
            if (og + 1u == (tg + 1u) * nx) xb_add(&bar[XB_TOPGEN], 1u);
            else XB_SPIN(xb_ld(&bar[XB_TOPGEN]) == tg, bar);
            __builtin_amdgcn_fence(__ATOMIC_ACQUIRE, "agent");
            xb_add(&bar[XB_XGEN(b.x)], 1u);
            asm volatile("s_waitcnt vmcnt(0)" ::: "memory");
        } else {
            XB_SPIN(xb_ld(&bar[XB_XGEN(b.x)]) == gen, bar);
            __builtin_amdgcn_fence(__ATOMIC_ACQUIRE, "agent");
            asm volatile("s_waitcnt vmcnt(0)" ::: "memory");
        }
    }
    __syncthreads();
}

namespace pg8 {
constexpr int BM = 256, BK = 64, HALF = 128, HTB = HALF * BK * 2, STAGE_BYTES = 8 * HTB, NXCD = 8, WGM = 8;
__host__ __device__ __forceinline__ int lds_byte(int r, int c) { const int st = (r >> 4) * 2 + (c >> 5), rr = r & 15, cc = c & 31, ob = rr * 64 + cc * 2; return st * 1024 + (ob ^ (((ob >> 9) & 1) << 5)); }
__host__ __device__ __forceinline__ void stage_rc(int b, int& R, int& C) { const int st = b / 1024, sb = b % 1024, swz = sb ^ (((sb >> 9) & 1) << 5); R = (st >> 1) * 16 + swz / 64; C = (st & 1) * 32 + (swz % 64) / 2; }
__host__ __device__ __forceinline__ int perm32(int rho) { const int n = rho >> 4, i = rho & 15; return 8 * (i >> 2) + 4 * n + (i & 3); }

template <class Epi, class Sched>
__device__ __forceinline__ void gemm_phase(LAS unsigned char* lds, const int tid, const Sched& S, const Epi& E) {
    const int wid = __builtin_amdgcn_readfirstlane(tid >> 6), lane = tid & 63, wr = wid >> 2, wc = wid & 3, fr = lane & 15, fq = lane >> 4;
    const int K = S.K, nt = K / BK;
    unsigned voffB[2];
#pragma unroll
    for (int i = 0; i < 2; ++i) { int R, C; stage_rc(tid * 16 + i * 8192, R, C); const int Rb = Epi::PERM ? ((R & ~31) + perm32(R & 31)) : R; voffB[i] = (unsigned)(Rb * K + C) * 2u; }
    const size_t kstep = (size_t)(BK * 2);
    const size_t hstepB = S.hstepB;
    const unsigned ldsw = (unsigned)wid * 1024u;
    const int aoff = lds_byte(wr * 64 + fr, fq * 8), boff = lds_byte(wc * 32 + fr, fq * 8);
#define PG8_SA(b, h) (((b) * 2 + (h)) * HTB)
#define PG8_SB(b, h) ((4 + (b) * 2 + (h)) * HTB)
#define PG8_STAGE_B(bufoff, gbase) do { _Pragma("unroll") for (int _i = 0; _i < 2; ++_i) \
        __builtin_amdgcn_global_load_lds((const unsigned*)((const char*)(gbase) + voffB[_i]), (LAS unsigned*)(lds + (bufoff) + ldsw + _i * 8192), 16, 0, 0); } while (0)
#define PG8_STAGE_A(bufoff, gbase, v0, v1) do { \
        __builtin_amdgcn_global_load_lds((const unsigned*)((const char*)(gbase) + (v0)), (LAS unsigned*)(lds + (bufoff) + ldsw), 16, 0, 0); \
        __builtin_amdgcn_global_load_lds((const unsigned*)((const char*)(gbase) + (v1)), (LAS unsigned*)(lds + (bufoff) + ldsw + 8192), 16, 0, 0); } while (0)
#define PG8_LDA(dst, b, h) do { _Pragma("unroll") for (int m = 0; m < 4; ++m) _Pragma("unroll") for (int k = 0; k < 2; ++k) dst[m][k] = *(const LAS bf16x8*)(lds + PG8_SA(b, h) + aoff + m * 2048 + k * 1024); } while (0)
#define PG8_LDB(dst, b, h) do { _Pragma("unroll") for (int n = 0; n < 2; ++n) _Pragma("unroll") for (int k = 0; k < 2; ++k) dst[n][k] = *(const LAS bf16x8*)(lds + PG8_SB(b, h) + boff + n * 2048 + k * 1024); } while (0)
#define PG8_MMA(ai, bj, At, Bt) do { __builtin_amdgcn_s_setprio(1); _Pragma("unroll") for (int m = 0; m < 4; ++m) _Pragma("unroll") for (int n = 0; n < 2; ++n) _Pragma("unroll") for (int k = 0; k < 2; ++k) \
        acc[ai][bj][m][n] = __builtin_amdgcn_mfma_f32_16x16x32_bf16(Bt[n][k], At[m][k], acc[ai][bj][m][n], 0, 0, 0); __builtin_amdgcn_s_setprio(0); } while (0)
#define PG8_WAIT_V(n) asm volatile("s_waitcnt vmcnt(" #n ")" ::: "memory")
#define PG8_WAIT_L(n) asm volatile("s_waitcnt lgkmcnt(" #n ")" ::: "memory")
#define PG8_BAR __builtin_amdgcn_s_barrier()
#define PG8_SCHED __builtin_amdgcn_sched_barrier(0)
    typename Sched::Unit cur, nxt; int ui = 0;
    if (!S.next(0, cur)) return;
    f32x4 acc[2][2][4][2];
#pragma unroll
    for (int a = 0; a < 2; ++a)
#pragma unroll
        for (int b = 0; b < 2; ++b)
#pragma unroll
            for (int m = 0; m < 4; ++m)
#pragma unroll
                for (int n = 0; n < 2; ++n) acc[a][b][m][n] = (f32x4){0.f, 0.f, 0.f, 0.f};
    bf16x8 At[4][2], B0[2][2], B1[2][2];
    constexpr bool GA = Sched::GATHER;
    const size_t hstepA = GA ? (size_t)0 : (size_t)HALF * K * 2;
    unsigned vA[2][2];
    S.a_off(cur, tid, vA);
#define PG8_STAGE_AH(bufoff, base, vv, h) PG8_STAGE_A(bufoff, ((base) + (h) * hstepA), vv[GA ? (h) : 0][0], vv[GA ? (h) : 0][1])
    const char* cA = S.a_base(cur); const char* cB = S.b_base(cur);
    PG8_STAGE_B(PG8_SB(0, 0), cB); PG8_STAGE_B(PG8_SB(0, 1), cB + hstepB); PG8_STAGE_AH(PG8_SA(0, 0), cA, vA, 0); PG8_STAGE_AH(PG8_SA(0, 1), cA, vA, 1);
    if (wr == 1) PG8_BAR;
    PG8_WAIT_V(2); PG8_BAR;
    PG8_STAGE_B(PG8_SB(1, 0), cB + kstep); PG8_STAGE_AH(PG8_SA(1, 0), cA + kstep, vA, 0); PG8_STAGE_B(PG8_SB(1, 1), cB + hstepB + kstep);
    PG8_WAIT_V(6); PG8_BAR;
    for (;;) {
        const bool has_next = S.next(ui + 1, nxt);
        const char* nA = cA; const char* nB = cB;
        if (has_next) { nA = S.a_base(nxt); nB = S.b_base(nxt); }
        for (int t = 0; t < nt; t += 2) {
            const bool last = (t == nt - 2);
            const char* a1 = cA + (size_t)(t + 1) * kstep;
            const char* a2 = last ? nA : cA + (size_t)(t + 2) * kstep; const char* b2 = last ? nB : cB + (size_t)(t + 2) * kstep;
            const char* a3 = a2 + kstep; const char* b3 = b2 + kstep;
            PG8_LDB(B0, 0, 0); PG8_LDB(B1, 0, 1); PG8_SCHED; PG8_LDA(At, 0, 0); PG8_STAGE_AH(PG8_SA(1, 1), a1, vA, 1);
            if constexpr (GA) { if (last && has_next) S.a_off(nxt, tid, vA); }
            PG8_WAIT_V(8); PG8_WAIT_L(0); PG8_BAR; PG8_MMA(0, 0, At, B0); PG8_MMA(0, 1, At, B1); PG8_BAR; PG8_SCHED;
            PG8_LDA(At, 0, 1); PG8_STAGE_B(PG8_SB(0, 0), b2); PG8_STAGE_B(PG8_SB(0, 1), b2 + hstepB); PG8_STAGE_AH(PG8_SA(0, 0), a2, vA, 0);
            PG8_WAIT_V(8); PG8_WAIT_L(0); PG8_BAR; PG8_MMA(1, 0, At, B0); PG8_MMA(1, 1, At, B1); PG8_BAR; PG8_SCHED;
            PG8_LDB(B0, 1, 0); PG8_LDB(B1, 1, 1); PG8_SCHED; PG8_LDA(At, 1, 0); PG8_STAGE_AH(PG8_SA(0, 1), a2, vA, 1);
            PG8_WAIT_V(8); PG8_WAIT_L(0); PG8_BAR; PG8_MMA(0, 0, At, B0); PG8_MMA(0, 1, At, B1); PG8_BAR; PG8_SCHED;
            PG8_LDA(At, 1, 1); PG8_STAGE_B(PG8_SB(1, 0), b3); PG8_STAGE_B(PG8_SB(1, 1), b3 + hstepB); PG8_STAGE_AH(PG8_SA(1, 0), a3, vA, 0);
            PG8_WAIT_V(8); PG8_WAIT_L(0); PG8_BAR; PG8_MMA(1, 0, At, B0); PG8_MMA(1, 1, At, B1); PG8_BAR; PG8_SCHED;
        }
        if (wr == 0) PG8_BAR;
        { int fr_ = fr; asm volatile("" : "+v"(fr_)); E(acc, cur, wr, wc, fr_, fq); }
        if (!has_next) break;
#pragma unroll
        for (int a = 0; a < 2; ++a)
#pragma unroll
            for (int b = 0; b < 2; ++b)
#pragma unroll
                for (int m = 0; m < 4; ++m)
#pragma unroll
                    for (int n = 0; n < 2; ++n) acc[a][b][m][n] = (f32x4){0.f, 0.f, 0.f, 0.f};
        cur = nxt; cA = nA; cB = nB; ++ui;
        if (wr == 1) PG8_BAR;
    }
    PG8_WAIT_V(0);
    PG8_BAR;
#undef PG8_SA
#undef PG8_SB
#undef PG8_STAGE_A
#undef PG8_STAGE_AH
#undef PG8_STAGE_B
#undef PG8_LDA
#undef PG8_LDB
#undef PG8_MMA
#undef PG8_WAIT_V
#undef PG8_WAIT_L
#undef PG8_BAR
#undef PG8_SCHED
}
}
struct Args { const float* in[N_IN]; float* out; unsigned char* ws; int ph_lo, ph_hi; };
typedef const __attribute__((address_space(4))) unsigned long long* karg_t;
struct Frame {
    karg_t ka;
    LAS unsigned char* lds;
    volatile LAS unsigned* MISC;
    gu32* ctl;
    unsigned char* ws;
    float* out;
    int tid, lane, wave, vcu, G;
};
#define WSP(T_, off) ((T_*)(F.ws + (off)))
#define KIN(k) ((const float*)F.ka[(k)])
#ifdef DBG_SEL
#define DBG_STAT(k, val) do { const float _v = (val); if ((k) == DBG_SEL) { if (fabsf(_v) < 3e38f) atomicMax((unsigned*)(F.ctl + CW_DBG), __float_as_uint(fabsf(_v))); else atomicAdd((unsigned*)(F.ctl + CW_DBG + 1), 1u); } } while (0)
#else
#define DBG_STAT(k, val) do { } while (0)
#endif
template <class P> __device__ __forceinline__ P launder_uniform(P p) {
    unsigned lo = (unsigned)(unsigned long long)p, hi = (unsigned)((unsigned long long)p >> 32);
    asm volatile("" : "+v"(lo), "+v"(hi));
    lo = __builtin_amdgcn_readfirstlane(lo); hi = __builtin_amdgcn_readfirstlane(hi);
    return (P)(((unsigned long long)hi << 32) | lo);
}
__device__ __forceinline__ void frame_refresh(Frame& F) {
    int t = F.tid; asm volatile("" : "+v"(t)); F.tid = t; F.lane = t & 63; F.wave = __builtin_amdgcn_readfirstlane(t >> 6);
    F.ws = launder_uniform(F.ws); F.ctl = (gu32*)(F.ws + WS_CTL);
    F.out = launder_uniform(F.out);
    F.ka = launder_uniform(F.ka);
}

namespace pg8 {
struct DenseSched {
    static constexpr bool GATHER = false;
    struct Unit { int pm, pn; };
    const bf16* A; const bf16* Bt; int K; size_t hstepB; int nM, nN, nwg, G, c;
    __device__ __forceinline__ void init(const bf16* A_, const bf16* Bt_, int M, int N, int K_, int G_, int c_) { A = A_; Bt = Bt_; K = K_; hstepB = (size_t)HALF * K_ * 2; nM = M / BM; nN = N / BM; nwg = nM * nN; G = G_; c = c_; }
    __device__ __forceinline__ bool next(int i, Unit& u) const {
        const long L = (long)i * G + c; if (L >= nwg) return false;
        int wgid = (int)L; { const int q = nwg / NXCD, r = nwg % NXCD, xcd = wgid % NXCD, off = wgid / NXCD; wgid = (xcd < r ? xcd * (q + 1) : r * (q + 1) + (xcd - r) * q) + off; }
        const int nig = WGM * nN, gid = wgid / nig, fm = gid * WGM, gsz = (nM - fm) < WGM ? (nM - fm) : WGM;
        u.pm = fm + ((wgid % nig) % gsz); u.pn = (wgid % nig) / gsz; return true;
    }
    __device__ __forceinline__ const char* a_base(const Unit& u) const { return (const char*)A + (size_t)u.pm * BM * K * 2; }
    __device__ __forceinline__ const char* b_base(const Unit& u) const { return (const char*)Bt + (size_t)u.pn * BM * K * 2; }
    __device__ __forceinline__ void a_off(const Unit&, int tid, unsigned (&v)[2][2]) const {
#pragma unroll
        for (int i = 0; i < 2; ++i) { int R, C; stage_rc(tid * 16 + i * 8192, R, C); v[0][i] = (unsigned)(R * K + C) * 2u; v[1][i] = v[0][i]; }
    }
};
struct MoeUnit { int e, mt, nt, cnt; };
struct MoeOrder {
    const volatile LAS unsigned* pfx;
    int NT, G, c;
    __device__ __forceinline__ bool decode(int i, MoeUnit& u) const {
        const int nwg = (int)pfx[32]; const long L = (long)i * G + c; if (L >= nwg) return false;
        int wgid = (int)L; { const int q = nwg / NXCD, r = nwg % NXCD, xcd = wgid % NXCD, off = wgid / NXCD; wgid = (xcd < r ? xcd * (q + 1) : r * (q + 1) + (xcd - r) * q) + off; }
        int e = 0;
#pragma unroll 1
        for (int j = 1; j < 32; ++j) e += ((int)pfx[j] <= wgid) ? 1 : 0;
        const int j = wgid - (int)pfx[e];
        u.e = e; u.mt = j / NT; u.nt = j % NT; u.cnt = (int)pfx[40 + e]; return true;
    }
};
struct Moe1Sched {
    static constexpr bool GATHER = true;
    typedef MoeUnit Unit;
    MoeOrder O; const bf16* X; const bf16* W; const int* sdest; int K; size_t hstepB;
    __device__ __forceinline__ bool next(int i, Unit& u) const { return O.decode(i, u); }
    __device__ __forceinline__ const char* a_base(const Unit&) const { return (const char*)X; }
    __device__ __forceinline__ const char* b_base(const Unit& u) const { return (const char*)W + ((size_t)u.e * 2048 + (size_t)u.nt * 128) * 1024 * 2; }
    __device__ __forceinline__ void a_off(const Unit& u, int tid, unsigned (&v)[2][2]) const {
#pragma unroll
        for (int i = 0; i < 2; ++i) { int R, C; stage_rc(tid * 16 + i * 8192, R, C);
#pragma unroll
            for (int h = 0; h < 2; ++h) { const int slot = u.mt * 256 + h * HALF + R; int tok = 0; if (slot < u.cnt) tok = sdest[u.e * ECAP + slot] >> 2; v[h][i] = (unsigned)(tok * 1024 + C) * 2u; } }
    }
};
struct Moe2Sched {
    static constexpr bool GATHER = false;
    typedef MoeUnit Unit;
    MoeOrder O; const bf16* Ab; const bf16* W; int K; size_t hstepB;
    __device__ __forceinline__ bool next(int i, Unit& u) const { return O.decode(i, u); }
    __device__ __forceinline__ const char* a_base(const Unit& u) const { return (const char*)Ab + ((size_t)u.e * ECAP + (size_t)u.mt * 256) * 1024 * 2; }
    __device__ __forceinline__ const char* b_base(const Unit& u) const { return (const char*)W + ((size_t)u.e * 1024 + (size_t)u.nt * 256) * 1024 * 2; }
    __device__ __forceinline__ void a_off(const Unit&, int tid, unsigned (&v)[2][2]) const {
#pragma unroll
        for (int i = 0; i < 2; ++i) { int R, C; stage_rc(tid * 16 + i * 8192, R, C); v[0][i] = (unsigned)(R * 1024 + C) * 2u; v[1][i] = v[0][i]; }
    }
};

struct EpiF32 {
    static constexpr bool PERM = false;
    float* C; int ldc; const float* base; float alpha;
    __device__ __forceinline__ void operator()(const f32x4 (&acc)[2][2][4][2], const DenseSched::Unit& u, int wr, int wc, int fr, int fq) const {
        const int row0 = u.pm * BM + wr * 64 + fr, col0 = u.pn * BM + wc * 32 + 4 * fq;
#pragma unroll
        for (int ai = 0; ai < 2; ++ai)
#pragma unroll
            for (int m = 0; m < 4; ++m) { const size_t ro = (size_t)(row0 + ai * HALF + m * 16) * ldc + col0;
#pragma unroll
                for (int bj = 0; bj < 2; ++bj)
#pragma unroll
                    for (int n = 0; n < 2; ++n) { f32x4 v = acc[ai][bj][m][n];
                        if (base) { const f32x4 b = *(const f32x4*)(base + ro + bj * HALF + n * 16); v = v + b * alpha; }
                        *(f32x4*)(C + ro + bj * HALF + n * 16) = v; } }
    }
};
struct EpiPle {
    static constexpr bool PERM = false;
    float* C; const float* hb; const float* pe;
    __device__ __forceinline__ void operator()(const f32x4 (&acc)[2][2][4][2], const DenseSched::Unit& u, int wr, int wc, int fr, int fq) const {
        const int row0 = u.pm * BM + wr * 64 + fr, col0 = u.pn * BM + wc * 32 + 4 * fq;
#pragma unroll
        for (int ai = 0; ai < 2; ++ai)
#pragma unroll
            for (int m = 0; m < 4; ++m) { const size_t ro = (size_t)(row0 + ai * HALF + m * 16) * 1024 + col0;
#pragma unroll
                for (int bj = 0; bj < 2; ++bj)
#pragma unroll
                    for (int n = 0; n < 2; ++n) { const f32x4 a = acc[ai][bj][m][n]; const f32x4 hv = *(const f32x4*)(hb + ro + bj * HALF + n * 16), pv = *(const f32x4*)(pe + ro + bj * HALF + n * 16);
                        f32x4 o; o.x = hv.x + sigmoidf_(a.x) * pv.x; o.y = hv.y + sigmoidf_(a.y) * pv.y; o.z = hv.z + sigmoidf_(a.z) * pv.z; o.w = hv.w + sigmoidf_(a.w) * pv.w;
                        *(f32x4*)(C + ro + bj * HALF + n * 16) = o; } }
    }
};
struct EpiMoe1 {
    static constexpr bool PERM = true;
    bf16* Ab; const float* bgu;
    __device__ __forceinline__ void operator()(const f32x4 (&acc)[2][2][4][2], const MoeUnit& u, int wr, int wc, int fr, int fq) const {
        const int col0 = u.nt * 128 + wc * 32 + 8 * fq;
        const float* bg = bgu + (size_t)u.e * 2048 + col0;
        const f32x4 bg0 = *(const f32x4*)(bg), bg1 = *(const f32x4*)(bg + 4), bl0 = *(const f32x4*)(bg + 1024), bl1 = *(const f32x4*)(bg + 1028);
#pragma unroll
        for (int ai = 0; ai < 2; ++ai)
#pragma unroll
            for (int m = 0; m < 4; ++m) { const int r = ai * HALF + wr * 64 + m * 16 + fr;
                bf16* rowp = Ab + ((size_t)u.e * ECAP + (size_t)u.mt * 256 + r) * 1024 + col0;
                float o[8];
#pragma unroll
                for (int n = 0; n < 2; ++n) { const f32x4 g4 = acc[ai][0][m][n] + (n ? bg1 : bg0), l4 = acc[ai][1][m][n] + (n ? bl1 : bl0);
#pragma unroll
                    for (int j = 0; j < 4; ++j) { const float g = fminf(g4[j], 7.0f), l = fminf(fmaxf(l4[j], -7.0f), 7.0f); o[n * 4 + j] = (l + 1.0f) * g * sigmoidf_(1.702f * g); } }
                *(v4u*)rowp = pack8(o); }
    }
};
struct EpiMoe2 {
    static constexpr bool PERM = false;
    float* Y; const float* bdn; const int* sdest; const float* sgate;
    __device__ __forceinline__ void operator()(const f32x4 (&acc)[2][2][4][2], const MoeUnit& u, int wr, int wc, int fr, int fq) const {
        const int col0 = u.nt * 256 + wc * 32 + 4 * fq;
        const float* bp = bdn + (size_t)u.e * 1024 + col0;
        f32x4 bv[2][2];
#pragma unroll
        for (int bj = 0; bj < 2; ++bj)
#pragma unroll
            for (int n = 0; n < 2; ++n) bv[bj][n] = *(const f32x4*)(bp + bj * HALF + n * 16);
#pragma unroll
        for (int ai = 0; ai < 2; ++ai)
#pragma unroll
            for (int m = 0; m < 4; ++m) { const int slot = u.mt * 256 + ai * HALF + wr * 64 + m * 16 + fr;
                if (slot < u.cnt) { const int dest = sdest[u.e * ECAP + slot]; const float gate = sgate[u.e * ECAP + slot];
                    float* rowp = Y + (size_t)dest * 1024 + col0;
#pragma unroll
                    for (int bj = 0; bj < 2; ++bj)
#pragma unroll
                        for (int n = 0; n < 2; ++n) *(f32x4*)(rowp + bj * HALF + n * 16) = (acc[ai][bj][m][n] + bv[bj][n]) * gate; } }
    }
};
}

__device__ __forceinline__ void p0_transpose_item(const float* W, int K, int N, int nblk, bf16* WT, int item, int lane) {
    const int kb = item / nblk, nb = item % nblk, k0 = 64 * kb, n = 64 * nb + lane;
    const bool ok = n < N; const float* src = W + (size_t)k0 * N + (ok ? n : 0);
    float x[64];
#pragma unroll
    for (int j = 0; j < 64; ++j) x[j] = src[(size_t)j * N];
    bf16* dst = WT + (size_t)n * K + k0;
#pragma unroll
    for (int q = 0; q < 8; ++q) { v4u o; o.x = cvt_pk_bf16(x[8 * q], x[8 * q + 1]); o.y = cvt_pk_bf16(x[8 * q + 2], x[8 * q + 3]); o.z = cvt_pk_bf16(x[8 * q + 4], x[8 * q + 5]); o.w = cvt_pk_bf16(x[8 * q + 6], x[8 * q + 7]);
        if (!ok) o = (v4u){0u, 0u, 0u, 0u};
        *(v4u*)(dst + 8 * q) = o; }
}
__device__ __forceinline__ void cvt_rows(const float* src, bf16* dst, size_t n8, size_t i0, size_t stride) {
    for (size_t i = i0; i < n8; i += stride) { const f32x4 a = *(const f32x4*)(src + i * 8), b = *(const f32x4*)(src + i * 8 + 4);
        v4u o; o.x = cvt_pk_bf16(a.x, a.y); o.y = cvt_pk_bf16(a.z, a.w); o.z = cvt_pk_bf16(b.x, b.y); o.w = cvt_pk_bf16(b.z, b.w); *(v4u*)(dst + i * 8) = o; }
}
__device__ __forceinline__ void p0_prologue(Frame& F, const Args& A) {
    const int gw = F.vcu * NWAVES + F.wave, NGW = F.G * NWAVES;
    constexpr int I_IN = 16 * (NUP / 64), I_OUT = 16 * 16, I_GU = 16 * 32, I_DN = 16 * 16, I_PG = 16 * 16, I_PP = 4 * 16;
    constexpr int PER_LAYER = I_IN + I_OUT + NE * I_GU + NE * I_DN + I_PG + I_PP;
#pragma unroll 1
    for (int it = gw; it < DEPTH * PER_LAYER; it += NGW) {
        const int l = it / PER_LAYER; int r = it % PER_LAYER;
        const float* W; bf16* WT; int K = D, N = D, nblk = 16;
        if (r < I_IN) { W = KIN(I_WIN) + (size_t)l * D * NU; WT = WSP(bf16, WS_WIN_T) + (size_t)l * NUP * D; N = NU; nblk = NUP / 64; }
        else if ((r -= I_IN) < I_OUT) { W = KIN(I_WOUT) + (size_t)l * D * D; WT = WSP(bf16, WS_WOUT_T) + (size_t)l * D * D; }
        else if ((r -= I_OUT) < NE * I_GU) { const int e = r / I_GU; r %= I_GU; W = KIN(I_WGU) + ((size_t)l * NE + e) * D * 2048; WT = WSP(bf16, WS_WGU_T) + ((size_t)l * NE + e) * 2048 * D; N = 2048; nblk = 32; }
        else if ((r -= NE * I_GU) < NE * I_DN) { const int e = r / I_DN; r %= I_DN; W = KIN(I_WDN) + ((size_t)l * NE + e) * D * D; WT = WSP(bf16, WS_WDN_T) + ((size_t)l * NE + e) * D * D; }
        else if ((r -= NE * I_DN) < I_PG) { W = KIN(I_PGW) + (size_t)l * D * D; WT = WSP(bf16, WS_WPG_T) + (size_t)l * D * D; }
        else { r -= I_PG; W = KIN(I_PPJ) + (size_t)l * 256 * D; WT = WSP(bf16, WS_WPP_T) + (size_t)l * D * 256; K = 256; }
        p0_transpose_item(W, K, N, nblk, WT, r, F.lane);
    }
    const size_t gt = (size_t)F.vcu * (NWAVES * 64) + F.tid, NT_ = (size_t)F.G * NWAVES * 64;
    cvt_rows(KIN(I_P), WSP(bf16, WS_PB), (size_t)DEPTH * T * 256 / 8, gt, NT_);
    cvt_rows(KIN(I_X), WSP(bf16, WS_XB), (size_t)T * D / 8, gt, NT_);
    for (size_t i = gt; i < (size_t)DEPTH * LORA_PER_LAYER; i += NT_) { const int l = (int)(i / LORA_PER_LAYER); int r = (int)(i % LORA_PER_LAYER); float v;
        if (r < 8192) { const int ch = r >> 5, j = r & 31; v = KIN(I_RWUP)[(size_t)l * 8192 + j * 256 + ch]; }
        else if (r < 16384) { r -= 8192; const int ch = r >> 5, j = r & 31; v = KIN(I_RAUP)[(size_t)l * 8192 + j * 256 + ch]; }
        else if (r < 32768) { r -= 16384; const int ch = r >> 6, j = r & 63; v = KIN(I_RGUP)[(size_t)l * 16384 + j * 256 + ch]; }
        else { r -= 32768; const int d = r >> 4, j = r & 15; v = KIN(I_GGUP)[(size_t)l * 2048 + j * 128 + d]; }
        WSP(float, WS_LORA)[i] = v; }
    for (size_t i = gt; i < (size_t)DEPTH * NE * D; i += NT_) { const int l = (int)(i / (NE * D)), r = (int)(i % (NE * D)), e = r / D, k = r % D; WSP(float, WS_RWT)[i] = KIN(I_RTW)[(size_t)l * D * NE + (size_t)k * NE + e]; }
}

__device__ __forceinline__ void p6_ln1_router(Frame& F, const Args& A, int layer) {
    const float* y1 = WSP(float, WS_Y1); float* x1 = WSP(float, WS_X1); bf16* x1b = WSP(bf16, WS_X1B);
    const float* g = KIN(I_LN1G) + layer * D; const float* bb = KIN(I_LN1B) + layer * D;
    const float* rwt = WSP(float, WS_RWT) + (size_t)layer * NE * D; const float* rb = KIN(I_RTB) + layer * NE;
    int* sdest = WSP(int, WS_SDEST); float* sgate = WSP(float, WS_SGATE);
    unsigned* cnt = (unsigned*)(F.ctl + CW_CNT + layer * NE * 16);
    LAS float* RWT = (LAS float*)F.lds;
    volatile LAS unsigned* lcnt = F.MISC + MW_LCNT; volatile LAS unsigned* lbase = F.MISC + MW_LBASE;
    for (int i = F.tid; i < NE * D / 4; i += NWAVES * 64) ((LAS f32x4*)RWT)[i] = ((const f32x4*)rwt)[i];
    const int lane = F.lane;
    const f32x4 gv[4] = { *(const f32x4*)(g + 4 * lane), *(const f32x4*)(g + 256 + 4 * lane), *(const f32x4*)(g + 512 + 4 * lane), *(const f32x4*)(g + 768 + 4 * lane) };
    const f32x4 bv[4] = { *(const f32x4*)(bb + 4 * lane), *(const f32x4*)(bb + 256 + 4 * lane), *(const f32x4*)(bb + 512 + 4 * lane), *(const f32x4*)(bb + 768 + 4 * lane) };
    const float rbias = rb[lane >> 1];
    for (int blk = F.vcu; blk < T / 64; blk += F.G) {
        if (F.tid < 32) lcnt[F.tid] = 0u;
        __syncthreads();
        int my_e = 0; float my_g = 0.f; unsigned my_r = 0u;
#pragma unroll 1
        for (int ri = 0; ri < 8; ++ri) {
            const int row = blk * 64 + F.wave * 8 + ri;
            const float* yr = y1 + (size_t)row * D;
            f32x4 v[4]; float s = 0.f;
#pragma unroll
            for (int j = 0; j < 4; ++j) { v[j] = *(const f32x4*)(yr + 256 * j + 4 * lane); s += (v[j].x + v[j].y) + (v[j].z + v[j].w); }
            const float mean = wave_sum(s) * (1.f / D); float s2 = 0.f;
#pragma unroll
            for (int j = 0; j < 4; ++j) { v[j] = v[j] - mean; s2 += (v[j].x * v[j].x + v[j].y * v[j].y) + (v[j].z * v[j].z + v[j].w * v[j].w); }
            const float rstd = 1.0f / sqrtf(wave_sum(s2) * (1.f / D) + LN_EPS);
#pragma unroll
            for (int j = 0; j < 4; ++j) { v[j] = v[j] * rstd * gv[j] + bv[j];
                *(f32x4*)(x1 + (size_t)row * D + 256 * j + 4 * lane) = v[j];
                v2u o; o.x = cvt_pk_bf16(v[j].x, v[j].y); o.y = cvt_pk_bf16(v[j].z, v[j].w); *(v2u*)(x1b + (size_t)row * D + 256 * j + 4 * lane) = o; }
            float p[32];
#pragma unroll
            for (int e = 0; e < 32; ++e) { float a = 0.f;
#pragma unroll
                for (int j = 0; j < 4; ++j) { const f32x4 w = *(const LAS f32x4*)(RWT + e * D + 256 * j + 4 * lane); a += (v[j].x * w.x + v[j].y * w.y) + (v[j].z * w.z + v[j].w * w.w); }
                p[e] = a; }
#pragma unroll
            for (int i = 0; i < 16; ++i) { const bool hi = (lane & 32) != 0; const float keep = hi ? p[i + 16] : p[i], send = hi ? p[i] : p[i + 16]; p[i] = keep + __shfl_xor(send, 32); }
#pragma unroll
            for (int i = 0; i < 8; ++i) { const bool hi = (lane & 16) != 0; const float keep = hi ? p[i + 8] : p[i], send = hi ? p[i] : p[i + 8]; p[i] = keep + __shfl_xor(send, 16); }
#pragma unroll
            for (int i = 0; i < 4; ++i) { const bool hi = (lane & 8) != 0; const float keep = hi ? p[i + 4] : p[i], send = hi ? p[i] : p[i + 4]; p[i] = keep + __shfl_xor(send, 8); }
#pragma unroll
            for (int i = 0; i < 2; ++i) { const bool hi = (lane & 4) != 0; const float keep = hi ? p[i + 2] : p[i], send = hi ? p[i] : p[i + 2]; p[i] = keep + __shfl_xor(send, 4); }
            { const bool hi = (lane & 2) != 0; const float keep = hi ? p[1] : p[0], send = hi ? p[0] : p[1]; p[0] = keep + __shfl_xor(send, 2); }
            float logit = p[0] + __shfl_xor(p[0], 1) + rbias;
            float tv[4]; int te[4];
#pragma unroll
            for (int k = 0; k < 4; ++k) {
                float bvv = logit; int bi = lane >> 1;
#pragma unroll
                for (int o = 2; o < 64; o <<= 1) { const float ov = __shfl_xor(bvv, o); const int oi = __shfl_xor(bi, o); if (ov > bvv || (ov == bvv && oi < bi)) { bvv = ov; bi = oi; } }
                tv[k] = bvv; te[k] = bi; if ((lane >> 1) == bi) logit = -INFINITY;
            }
            const float e1 = __expf(tv[1] - tv[0]), e2 = __expf(tv[2] - tv[0]), e3 = __expf(tv[3] - tv[0]); const float inv = 1.0f / (1.0f + e1 + e2 + e3);
            const int kk = lane & 3;
            const int ek = kk == 0 ? te[0] : kk == 1 ? te[1] : kk == 2 ? te[2] : te[3];
            const float gk = (kk == 0 ? 1.0f : kk == 1 ? e1 : kk == 2 ? e2 : e3) * inv;
            if ((lane >> 2) == ri) { my_e = ek; my_g = gk; my_r = atomicAdd((unsigned*)&lcnt[ek], 1u); }
        }
        __syncthreads();
        if (F.tid < 32) { const unsigned n = lcnt[F.tid]; lbase[F.tid] = n ? __hip_atomic_fetch_add(cnt + F.tid * 16, n, RLX_AGENT) : 0u; }
        __syncthreads();
        if (lane < 32) { const int row = blk * 64 + F.wave * 8 + (lane >> 2); const unsigned slot = (unsigned)my_e * ECAP + lbase[my_e] + my_r;
            sdest[slot] = row * 4 + (lane & 3); sgate[slot] = my_g; }
        __syncthreads();
    }
}
__device__ __forceinline__ void p9_combine(Frame& F, const Args& A) {
    const float* x1 = WSP(float, WS_X1); const float* yb = WSP(float, WS_YBUF); float* h = WSP(float, WS_H); bf16* hb = WSP(bf16, WS_HB);
    const int gw = F.vcu * NWAVES + F.wave, NGW = F.G * NWAVES, lane = F.lane;
    for (int row = gw; row < T; row += NGW) {
#pragma unroll
        for (int j = 0; j < 4; ++j) { const size_t o = (size_t)row * D + 256 * j + 4 * lane;
            f32x4 v = *(const f32x4*)(x1 + o) * DN_ALPHA;
#pragma unroll
            for (int k = 0; k < 4; ++k) v = v + *(const f32x4*)(yb + ((size_t)row * 4 + k) * D + 256 * j + 4 * lane);
            *(f32x4*)(h + o) = v; v2u w; w.x = cvt_pk_bf16(v.x, v.y); w.y = cvt_pk_bf16(v.z, v.w); *(v2u*)(hb + o) = w; }
    }
}
__device__ __forceinline__ void p11_ln2(Frame& F, const Args& A, int layer) {
    const float* h2 = WSP(float, WS_H2); bf16* xb = WSP(bf16, WS_XB);
    const float* g = KIN(I_LN2G) + layer * D; const float* bb = KIN(I_LN2B) + layer * D;
    const int gw = F.vcu * NWAVES + F.wave, NGW = F.G * NWAVES, lane = F.lane;
    for (int row = gw; row < T; row += NGW) {
        const float* yr = h2 + (size_t)row * D; f32x4 v[4]; float s = 0.f;
#pragma unroll
        for (int j = 0; j < 4; ++j) { v[j] = *(const f32x4*)(yr + 256 * j + 4 * lane); s += (v[j].x + v[j].y) + (v[j].z + v[j].w); }
        const float mean = wave_sum(s) * (1.f / D); float s2 = 0.f;
#pragma unroll
        for (int j = 0; j < 4; ++j) { v[j] = v[j] - mean; s2 += (v[j].x * v[j].x + v[j].y * v[j].y) + (v[j].z * v[j].z + v[j].w * v[j].w); }
        const float rstd = 1.0f / sqrtf(wave_sum(s2) * (1.f / D) + LN_EPS);
#pragma unroll
        for (int j = 0; j < 4; ++j) { const f32x4 gv = *(const f32x4*)(g + 256 * j + 4 * lane), bv = *(const f32x4*)(bb + 256 * j + 4 * lane);
            const f32x4 o = v[j] * rstd * gv + bv; const size_t off = (size_t)row * D + 256 * j + 4 * lane;
            *(f32x4*)(F.out + off) = o; v2u w; w.x = cvt_pk_bf16(o.x, o.y); w.y = cvt_pk_bf16(o.z, o.w); *(v2u*)(xb + off) = w; }
    }
}
__device__ __forceinline__ void moe_build_pfx(Frame& F, const Args& A, int layer, int NT) {
    volatile LAS unsigned* pfx = F.MISC + MW_PFX;
    __syncthreads();
    if (F.tid == 0) { unsigned acc = 0u;
        for (int e = 0; e < NE; ++e) { const unsigned c = __hip_atomic_load(F.ctl + CW_CNT + (layer * NE + e) * 16, RLX_AGENT); pfx[e] = acc; pfx[40 + e] = c; acc += ((c + 255u) >> 8) * (unsigned)NT; }
        pfx[32] = acc; }
    __syncthreads();
}
#define UU(t, col) (u[(size_t)(t) * NUP + (col)])
__device__ __forceinline__ void lds_st_bf16(LAS unsigned char* p, float v) { *(LAS unsigned short*)p = (unsigned short)(cvt_pk_bf16(v, 0.f) & 0xffffu); }
__device__ __forceinline__ void lds_st_bf16x4(LAS unsigned char* p, float a, float b, float c, float d) { v2u o; o.x = cvt_pk_bf16(a, b); o.y = cvt_pk_bf16(c, d); *(LAS v2u*)p = o; }

__device__ __forceinline__ void ssd_stage1(Frame& F, const Args& A, int layer, int b, int c) {
    const float* u = WSP(float, WS_U);
    LAS unsigned char* L = F.lds;
    LAS float* DT = (LAS float*)L; LAS float* AC = DT + 256;
    LAS unsigned char* BMT = L + 2048; LAS unsigned char* XCDT = BMT + 128 * 144;
    const int t0 = b * SEQ + c * 64, tid = F.tid, lane = F.lane, wave = F.wave;
    if (wave < 4) {
        const int hh = wave;
        const float dt = softplusf_(UU(t0 + lane, U_SSD_DT + hh) + KIN(I_SDTB)[layer * 4 + hh]);
        const float adt = -dt * __expf(KIN(I_SALOG)[layer * 4 + hh]);
        const float ac = wave_scan_add(adt, lane);
        DT[hh * 64 + lane] = dt; AC[hh * 64 + lane] = ac;
        if (lane == 63) WSP(float, WS_SSD_DEC)[(b * 4 + hh) * NCH + c] = __expf(ac);
    }
    __syncthreads();
    if (tid < 384) {
        const int cc = tid; const float* cw = KIN(I_SCW) + (size_t)layer * 2048 + cc; const float w0 = cw[0], w1 = cw[512], w2 = cw[1024], w3 = cw[1536], cb = KIN(I_SCB)[layer * 512 + cc];
        const float* up = u + (size_t)t0 * NUP + U_SSD_X + cc;
        float win0 = 0.f, win1 = 0.f, win2 = 0.f;
        if (c > 0) { win0 = up[-3 * NUP]; win1 = up[-2 * NUP]; win2 = up[-1 * NUP]; }
        const int hh = (cc >> 6) & 3; const bool isx = cc < 256;
        LAS unsigned char* dst = isx ? XCDT + cc * 144 : BMT + (cc - 256) * 144;
        const float aclast = AC[hh * 64 + 63];
#pragma unroll 1
        for (int l0 = 0; l0 < 64; l0 += 32) {
            float xv[32];
#pragma unroll
            for (int j = 0; j < 32; ++j) xv[j] = up[(l0 + j) * NUP];
#pragma unroll
            for (int j8 = 0; j8 < 4; ++j8) { float o[8];
#pragma unroll
                for (int j = 0; j < 8; ++j) { const int l = l0 + j8 * 8 + j; const float x = xv[j8 * 8 + j]; const float y = cb + w0 * win0 + w1 * win1 + w2 * win2 + w3 * x; win0 = win1; win1 = win2; win2 = x;
                    float s = siluf_(y); if (isx) s *= DT[hh * 64 + l] * __expf(aclast - AC[hh * 64 + l]); o[j] = s; }
                *(LAS v4u*)(dst + (l0 + j8 * 8) * 2) = pack8(o); }
        }
    }
    __syncthreads();
    { const int fr = lane & 15, fq = lane >> 4; float* st = WSP(float, WS_SSD_ST);
#pragma unroll 1
      for (int i = 0; i < 2; ++i) { const int row0 = (2 * wave + i) * 16; const int hh = row0 >> 6, p = (row0 & 63) + fr;
          float* dstp = st + (((size_t)(b * 4 + hh) * NCH + c) * 64 + p) * 128;
#pragma unroll 1
          for (int ntl = 0; ntl < 8; ++ntl) { f32x4 acc = {0.f, 0.f, 0.f, 0.f}; acc = mm16(XCDT + row0 * 144, 144, BMT + ntl * 16 * 144, 144, 64, acc, fr, fq);
              *(f32x4*)(dstp + ntl * 16 + 4 * fq) = acc; } } }
    __syncthreads();
}
__device__ __forceinline__ void ssd_stage3(Frame& F, const Args& A, int layer, int b, int c) {
    const float* u = WSP(float, WS_U);
    LAS unsigned char* L = F.lds;
    LAS float* DT = (LAS float*)L; LAS float* AC = DT + 256;
    LAS unsigned char* CM = L + 2048; LAS unsigned char* BM = CM + 64 * 272; LAS unsigned char* XCT = BM + 64 * 272; LAS unsigned char* MM = XCT + 256 * 144;
    LAS unsigned char* YG = XCT;
    const int t0 = b * SEQ + c * 64, tid = F.tid, lane = F.lane, wave = F.wave, fr = lane & 15, fq = lane >> 4;
    if (wave < 4) {
        const int hh = wave;
        const float dt = softplusf_(UU(t0 + lane, U_SSD_DT + hh) + KIN(I_SDTB)[layer * 4 + hh]);
        const float adt = -dt * __expf(KIN(I_SALOG)[layer * 4 + hh]);
        DT[hh * 64 + lane] = dt; AC[hh * 64 + lane] = wave_scan_add(adt, lane);
    }
    __syncthreads();
    {
        const int cc = tid; const float* cw = KIN(I_SCW) + (size_t)layer * 2048 + cc; const float w0 = cw[0], w1 = cw[512], w2 = cw[1024], w3 = cw[1536], cb = KIN(I_SCB)[layer * 512 + cc];
        const float* up = u + (size_t)t0 * NUP + U_SSD_X + cc;
        float win0 = 0.f, win1 = 0.f, win2 = 0.f;
        if (c > 0) { win0 = up[-3 * NUP]; win1 = up[-2 * NUP]; win2 = up[-1 * NUP]; }
        const int hh = (cc >> 6) & 3;
#pragma unroll 1
        for (int l0 = 0; l0 < 64; l0 += 32) {
            float xv[32];
#pragma unroll
            for (int j = 0; j < 32; ++j) xv[j] = up[(l0 + j) * NUP];
#pragma unroll
            for (int j8 = 0; j8 < 4; ++j8) { float o[8];
#pragma unroll
                for (int j = 0; j < 8; ++j) { const int l = l0 + j8 * 8 + j; const float x = xv[j8 * 8 + j]; const float y = cb + w0 * win0 + w1 * win1 + w2 * win2 + w3 * x; win0 = win1; win1 = win2; win2 = x;
                    float s = siluf_(y); if (cc < 256) s *= DT[hh * 64 + l]; o[j] = s; }
                if (cc < 256) *(LAS v4u*)(XCT + cc * 144 + (l0 + j8 * 8) * 2) = pack8(o);
                else { LAS unsigned char* d2 = (cc < 384 ? BM + (cc - 256) * 2 : CM + (cc - 384) * 2) + (l0 + j8 * 8) * 272;
#pragma unroll
                    for (int j = 0; j < 8; ++j) lds_st_bf16(d2 + j * 272, o[j]); } }
        }
    }
    __syncthreads();
#pragma unroll 1
    for (int i = 0; i < 2; ++i) { const int idx = 2 * wave + i, lt = idx >> 2, st = idx & 3;
        f32x4 acc = {0.f, 0.f, 0.f, 0.f}; acc = mm16(CM + lt * 16 * 272, 272, BM + st * 16 * 272, 272, 128, acc, fr, fq);
        const int l = lt * 16 + fr, s0 = st * 16 + 4 * fq;
#pragma unroll
        for (int hh = 0; hh < 4; ++hh) { const float al = AC[hh * 64 + l], dl = KIN(I_SD)[layer * 4 + hh] / DT[hh * 64 + l]; float o[4];
#pragma unroll
            for (int j = 0; j < 4; ++j) { const int s = s0 + j; float m = (l >= s) ? acc[j] * __expf(al - AC[hh * 64 + s]) : 0.f; if (l == s) m += dl; o[j] = m; }
            lds_st_bf16x4(MM + hh * 9216 + l * 144 + s0 * 2, o[0], o[1], o[2], o[3]); } }
    __syncthreads();
    f32x4 yv[2][4];
    { const int hh = wave >> 1; const float* prev = WSP(float, WS_SSD_ST) + ((size_t)(b * 4 + hh) * NCH + c) * 8192;
#pragma unroll
      for (int i = 0; i < 2; ++i) { const int lt = 2 * (wave & 1) + i, l = lt * 16 + fr; const float ea = __expf(AC[hh * 64 + l]);
#pragma unroll
          for (int pt = 0; pt < 4; ++pt) { f32x4 ad = {0.f, 0.f, 0.f, 0.f}, ao = {0.f, 0.f, 0.f, 0.f};
              ad = mm16(MM + hh * 9216 + lt * 16 * 144, 144, XCT + (hh * 64 + pt * 16) * 144, 144, 64, ad, fr, fq);
              ao = mm16_gB(CM + lt * 16 * 272, 272, prev + (size_t)(pt * 16) * 128, 128, 128, ao, fr, fq);
              const f32x4 z = *(const f32x4*)&UU(t0 + l, U_SSD_Z + hh * 64 + pt * 16 + 4 * fq);
              f32x4 y = ad + ao * ea; y.x *= siluf_(z.x); y.y *= siluf_(z.y); y.z *= siluf_(z.z); y.w *= siluf_(z.w); yv[i][pt] = y; } } }
    __syncthreads();
    { const int hh = wave >> 1;
#pragma unroll
      for (int i = 0; i < 2; ++i) { const int l = (2 * (wave & 1) + i) * 16 + fr;
#pragma unroll
          for (int pt = 0; pt < 4; ++pt) *(LAS f32x4*)(YG + l * 1040 + (hh * 64 + pt * 16 + 4 * fq) * 4) = yv[i][pt]; } }
    __syncthreads();
    { const f32x4 g = *(const f32x4*)(KIN(I_SNG) + layer * 256 + 4 * lane); bf16* mix = WSP(bf16, WS_MIX);
#pragma unroll 1
      for (int i = 0; i < 8; ++i) { const int l = wave * 8 + i; const f32x4 y = *(const LAS f32x4*)(YG + l * 1040 + lane * 16);
          const float ss = wave_sum((y.x * y.x + y.y * y.y) + (y.z * y.z + y.w * y.w)); const float r = 1.0f / sqrtf(ss * (1.f / 256.f) + NORM_EPS);
          v2u o; o.x = cvt_pk_bf16(y.x * r * g.x, y.y * r * g.y); o.y = cvt_pk_bf16(y.z * r * g.z, y.w * r * g.w);
          *(v2u*)(mix + (size_t)(t0 + l) * D + 4 * lane) = o; } }
    __syncthreads();
}

__device__ __forceinline__ float gla_bcum(Frame& F, const Args& A, int layer, int d, const LAS float* GD, LAS float* BC) {
    float gup[16];
    { const f32x4* gp4 = (const f32x4*)(WSP(float, WS_LORA) + (size_t)layer * LORA_PER_LAYER + 32768 + d * 16);
#pragma unroll
      for (int i = 0; i < 4; ++i) { const f32x4 a = gp4[i]; gup[4 * i] = a.x; gup[4 * i + 1] = a.y; gup[4 * i + 2] = a.z; gup[4 * i + 3] = a.w; } }
    const float gb = KIN(I_GGB)[layer * 128 + d]; float bc = 0.f;
#pragma unroll 2
    for (int l = 0; l < 64; ++l) { float x = gb;
#pragma unroll
        for (int i = 0; i < 16; ++i) x += GD[l * 16 + i] * gup[i];
        bc += logsigmoidf_(x) * 0.0625f; BC[l * 128 + d] = bc; }
    return bc;
}
__device__ __forceinline__ void gla_stage1(Frame& F, const Args& A, int layer, int b, int c) {
    const float* u = WSP(float, WS_U);
    LAS unsigned char* L = F.lds;
    LAS float* GD = (LAS float*)L; LAS float* BC = (LAS float*)(L + 4096);
    LAS unsigned char* KDT = L + 36864; LAS unsigned char* VT = KDT + 128 * 144;
    const int t0 = b * SEQ + c * 64, tid = F.tid, lane = F.lane, wave = F.wave, fr = lane & 15, fq = lane >> 4;
    if (tid < 256) { const int l = tid >> 2, q4 = tid & 3; *(LAS f32x4*)(GD + l * 16 + q4 * 4) = *(const f32x4*)&UU(t0 + l, U_GL_G + 4 * q4); }
    __syncthreads();
    if (tid < 128) {
        const int d = tid; const float blast = gla_bcum(F, A, layer, d, GD, BC);
        WSP(float, WS_GLA_DEC)[(size_t)(b * NCH + c) * 128 + d] = __expf(blast);
        const float* up = u + (size_t)t0 * NUP + U_GL_K + d;
#pragma unroll 1
        for (int l0 = 0; l0 < 64; l0 += 32) { float xv[32];
#pragma unroll
            for (int j = 0; j < 32; ++j) xv[j] = up[(l0 + j) * NUP];
#pragma unroll
            for (int j8 = 0; j8 < 4; ++j8) { float o[8];
#pragma unroll
                for (int j = 0; j < 8; ++j) { const int l = l0 + j8 * 8 + j; o[j] = xv[j8 * 8 + j] * __expf(blast - BC[l * 128 + d]); }
                *(LAS v4u*)(KDT + d * 144 + (l0 + j8 * 8) * 2) = pack8(o); } }
    } else if (tid < 384) {
        const int vch = tid - 128; const float* up = u + (size_t)t0 * NUP + U_GL_V + vch;
#pragma unroll 1
        for (int l0 = 0; l0 < 64; l0 += 32) { float xv[32];
#pragma unroll
            for (int j = 0; j < 32; ++j) xv[j] = up[(l0 + j) * NUP];
#pragma unroll
            for (int j8 = 0; j8 < 4; ++j8) { float o[8];
#pragma unroll
                for (int j = 0; j < 8; ++j) o[j] = xv[j8 * 8 + j];
                *(LAS v4u*)(VT + vch * 144 + (l0 + j8 * 8) * 2) = pack8(o); } }
    }
    __syncthreads();
    { float* st = WSP(float, WS_GLA_ST);
#pragma unroll 1
      for (int i = 0; i < 4; ++i) { const int idx = 4 * wave + i, hh = idx >> 3, dtl = (idx >> 2) & 1, vt = idx & 3;
          f32x4 acc = {0.f, 0.f, 0.f, 0.f}; acc = mm16(KDT + (hh * 32 + dtl * 16) * 144, 144, VT + (hh * 64 + vt * 16) * 144, 144, 64, acc, fr, fq);
          *(f32x4*)(st + (((size_t)(b * 4 + hh) * NCH + c) * 32 + dtl * 16 + fr) * 64 + vt * 16 + 4 * fq) = acc; } }
    __syncthreads();
}
__device__ __forceinline__ void gla_stage3(Frame& F, const Args& A, int layer, int b, int c) {
    const float* u = WSP(float, WS_U);
    LAS unsigned char* L = F.lds;
    LAS float* GD = (LAS float*)L; LAS float* BC = (LAS float*)(L + 4096); LAS unsigned char* ATT = L + 4096;
    LAS unsigned char* QD = L + 40960; LAS unsigned char* KI = QD + 64 * 272; LAS unsigned char* VT = KI + 64 * 272; LAS unsigned char* PVT = VT + 256 * 144;
    const int t0 = b * SEQ + c * 64, tid = F.tid, lane = F.lane, wave = F.wave, fr = lane & 15, fq = lane >> 4;
    if (tid < 256) { const int l = tid >> 2, q4 = tid & 3; *(LAS f32x4*)(GD + l * 16 + q4 * 4) = *(const f32x4*)&UU(t0 + l, U_GL_G + 4 * q4); }
    __syncthreads();
    if (tid < 128) {
        const int d = tid; (void)gla_bcum(F, A, layer, d, GD, BC);
        const float* uq = u + (size_t)t0 * NUP + U_GL_Q + d; const float* uk = u + (size_t)t0 * NUP + U_GL_K + d;
#pragma unroll 1
        for (int l0 = 0; l0 < 64; l0 += 16) { float qv[16], kv[16];
#pragma unroll
            for (int j = 0; j < 16; ++j) { qv[j] = uq[(l0 + j) * NUP]; kv[j] = uk[(l0 + j) * NUP]; }
#pragma unroll
            for (int j = 0; j < 16; ++j) { const int l = l0 + j; const float bc = BC[l * 128 + d];
                lds_st_bf16(QD + l * 272 + d * 2, qv[j] * 0.17677669529663687f * __expf(bc)); lds_st_bf16(KI + l * 272 + d * 2, kv[j] * __expf(-bc)); } }
    } else if (tid < 384) {
        const int vch = tid - 128; const float* up = u + (size_t)t0 * NUP + U_GL_V + vch;
#pragma unroll 1
        for (int l0 = 0; l0 < 64; l0 += 32) { float xv[32];
#pragma unroll
            for (int j = 0; j < 32; ++j) xv[j] = up[(l0 + j) * NUP];
#pragma unroll
            for (int j8 = 0; j8 < 4; ++j8) { float o[8];
#pragma unroll
                for (int j = 0; j < 8; ++j) o[j] = xv[j8 * 8 + j];
                *(LAS v4u*)(VT + vch * 144 + (l0 + j8 * 8) * 2) = pack8(o); } }
    } else {
        const float* prev = WSP(float, WS_GLA_ST);
#pragma unroll 4
        for (int i = tid - 384; i < 8192; i += 128) { const int hh = i >> 11, dd = (i >> 6) & 31, vv = i & 63;
            lds_st_bf16(PVT + (hh * 64 + vv) * 80 + dd * 2, prev[((size_t)(b * 4 + hh) * NCH + c) * 2048 + dd * 64 + vv]); }
    }
    __syncthreads();
    const int hh = wave >> 1;
#pragma unroll 1
    for (int i = 0; i < 2; ++i) { const int tt = 2 * (wave & 1) + i, t = tt * 16 + fr;
#pragma unroll
        for (int st = 0; st < 4; ++st) { f32x4 acc = {0.f, 0.f, 0.f, 0.f}; acc = mm16(QD + tt * 16 * 272 + hh * 64, 272, KI + st * 16 * 272 + hh * 64, 272, 32, acc, fr, fq);
            const int s0 = st * 16 + 4 * fq;
            lds_st_bf16x4(ATT + hh * 9216 + t * 144 + s0 * 2, t >= s0 ? acc[0] : 0.f, t >= s0 + 1 ? acc[1] : 0.f, t >= s0 + 2 ? acc[2] : 0.f, t >= s0 + 3 ? acc[3] : 0.f); } }
    __syncthreads();
    { bf16* mix = WSP(bf16, WS_MIX); const float* ng = KIN(I_GNG) + layer * 256;
#pragma unroll 1
      for (int i = 0; i < 2; ++i) { const int tt = 2 * (wave & 1) + i, t = tt * 16 + fr; f32x4 ov[4]; float ss = 0.f;
#pragma unroll
          for (int vt = 0; vt < 4; ++vt) { f32x4 acc = {0.f, 0.f, 0.f, 0.f};
              acc = mm16(ATT + hh * 9216 + tt * 16 * 144, 144, VT + (hh * 64 + vt * 16) * 144, 144, 64, acc, fr, fq);
              acc = mm16(QD + tt * 16 * 272 + hh * 64, 272, PVT + (hh * 64 + vt * 16) * 80, 80, 32, acc, fr, fq);
              ov[vt] = acc; ss += (acc.x * acc.x + acc.y * acc.y) + (acc.z * acc.z + acc.w * acc.w); }
          ss += __shfl_xor(ss, 16); ss += __shfl_xor(ss, 32);
          const float r = 1.0f / sqrtf(ss * (1.f / 64.f) + NORM_EPS);
#pragma unroll
          for (int vt = 0; vt < 4; ++vt) { const int col = hh * 64 + vt * 16 + 4 * fq; const f32x4 g = *(const f32x4*)(ng + col); const f32x4 og = *(const f32x4*)&UU(t0 + t, U_GL_OG + col);
              v2u o; o.x = cvt_pk_bf16(ov[vt].x * r * g.x * siluf_(og.x), ov[vt].y * r * g.y * siluf_(og.y)); o.y = cvt_pk_bf16(ov[vt].z * r * g.z * siluf_(og.z), ov[vt].w * r * g.w * siluf_(og.w));
              *(v2u*)(mix + (size_t)(t0 + t) * D + 512 + col) = o; } } }
    __syncthreads();
}

__device__ __forceinline__ void mlstm_stage1(Frame& F, const Args& A, int layer, int b, int c) {
    const float* u = WSP(float, WS_U);
    LAS unsigned char* L = F.lds;
    LAS float* WST = (LAS float*)L; LAS unsigned char* KT = L + 1024; LAS unsigned char* VWT = KT + 256 * 144;
    const int t0 = b * SEQ + c * 64, tid = F.tid, lane = F.lane, wave = F.wave, fr = lane & 15, fq = lane >> 4;
    if (wave < 4) {
        const int hh = wave;
        const float ig = UU(t0 + lane, U_ML_I + hh) + KIN(I_MIB)[layer * 4 + hh];
        const float lf = logsigmoidf_(UU(t0 + lane, U_ML_F + hh) + KIN(I_MFB)[layer * 4 + hh]);
        const float bc = wave_scan_add(lf, lane); const float blast = __shfl(bc, 63);
        const float ast = blast - bc + ig; const float mloc = wave_max(ast);
        WST[hh * 64 + lane] = __expf(ast - mloc);
        if (lane == 0) { WSP(float, WS_ML_BL)[(b * 4 + hh) * NCH + c] = blast; WSP(float, WS_ML_ML)[(b * 4 + hh) * NCH + c] = mloc; }
    } else {
        const int kch = tid - 256, cc = 256 + kch; const float* cw = KIN(I_MCW) + (size_t)layer * 2048 + cc; const float w0 = cw[0], w1 = cw[512], w2 = cw[1024], w3 = cw[1536], cb = KIN(I_MCB)[layer * 512 + cc];
        const float* up = u + (size_t)t0 * NUP + U_ML_K + kch;
        float win0 = 0.f, win1 = 0.f, win2 = 0.f;
        if (c > 0) { win0 = up[-3 * NUP]; win1 = up[-2 * NUP]; win2 = up[-1 * NUP]; }
#pragma unroll 1
        for (int l0 = 0; l0 < 64; l0 += 32) { float xv[32];
#pragma unroll
            for (int j = 0; j < 32; ++j) xv[j] = up[(l0 + j) * NUP];
#pragma unroll
            for (int j8 = 0; j8 < 4; ++j8) { float o[8];
#pragma unroll
                for (int j = 0; j < 8; ++j) { const float x = xv[j8 * 8 + j]; const float y = cb + w0 * win0 + w1 * win1 + w2 * win2 + w3 * x; win0 = win1; win1 = win2; win2 = x; o[j] = siluf_(y); }
                *(LAS v4u*)(KT + kch * 144 + (l0 + j8 * 8) * 2) = pack8(o); } }
    }
    __syncthreads();
    if (tid < 256) {
        const int vch = tid, hh = vch >> 6; const float* up = u + (size_t)t0 * NUP + U_ML_V + vch;
#pragma unroll 1
        for (int l0 = 0; l0 < 64; l0 += 32) { float xv[32];
#pragma unroll
            for (int j = 0; j < 32; ++j) xv[j] = up[(l0 + j) * NUP];
#pragma unroll
            for (int j8 = 0; j8 < 4; ++j8) { float o[8];
#pragma unroll
                for (int j = 0; j < 8; ++j) o[j] = xv[j8 * 8 + j] * WST[hh * 64 + l0 + j8 * 8 + j];
                *(LAS v4u*)(VWT + vch * 144 + (l0 + j8 * 8) * 2) = pack8(o); } }
    } else {
        const int kch = tid - 256, hh = kch >> 6; float n = 0.f;
#pragma unroll 8
        for (int s = 0; s < 64; ++s) n += WST[hh * 64 + s] * bf2f(*(const LAS unsigned short*)(KT + kch * 144 + s * 2));
        WSP(float, WS_ML_N)[((size_t)(b * 4 + hh) * NCH + c) * 64 + (kch & 63)] = n;
    }
    __syncthreads();
    { float* cst = WSP(float, WS_ML_C); const int hh = wave >> 1;
#pragma unroll 1
      for (int i = 0; i < 2; ++i) { const int vt = 2 * (wave & 1) + i;
#pragma unroll 1
          for (int kt = 0; kt < 4; ++kt) { f32x4 acc = {0.f, 0.f, 0.f, 0.f}; acc = mm16(VWT + (hh * 64 + vt * 16) * 144, 144, KT + (hh * 64 + kt * 16) * 144, 144, 64, acc, fr, fq);
              *(f32x4*)(cst + (((size_t)(b * 4 + hh) * NCH + c) * 64 + vt * 16 + fr) * 64 + kt * 16 + 4 * fq) = acc; } } }
    __syncthreads();
}
__device__ __forceinline__ void mlstm_stage3(Frame& F, const Args& A, int layer, int b, int c) {
    const float* u = WSP(float, WS_U);
    LAS unsigned char* L = F.lds;
    LAS float* BCU = (LAS float*)L; LAS float* GG = BCU + 256; LAS float* MROW = BCU + 512; LAS float* WINT = BCU + 768; LAS float* NPV = BCU + 1024;
    LAS unsigned char* Q = L + 6144; LAS unsigned char* KK = Q + 64 * 528; LAS unsigned char* VT = KK + 64 * 528; LAS unsigned char* SC = VT + 256 * 144;
    const int t0 = b * SEQ + c * 64, tid = F.tid, lane = F.lane, wave = F.wave, fr = lane & 15, fq = lane >> 4;
    if (wave < 4) {
        const int hh = wave;
        const float ig = UU(t0 + lane, U_ML_I + hh) + KIN(I_MIB)[layer * 4 + hh];
        const float lf = logsigmoidf_(UU(t0 + lane, U_ML_F + hh) + KIN(I_MFB)[layer * 4 + hh]);
        const float bc = wave_scan_add(lf, lane); const float gg = ig - bc;
        const float mprev = WSP(float, WS_ML_M)[(b * 4 + hh) * NCH + c];
        const float minter = bc + mprev, mintra = bc + wave_scan_max(gg, lane), mrow = fmaxf(minter, mintra);
        BCU[hh * 64 + lane] = bc; GG[hh * 64 + lane] = gg; MROW[hh * 64 + lane] = mrow; WINT[hh * 64 + lane] = __expf(minter - mrow);
        NPV[hh * 64 + lane] = WSP(float, WS_ML_N)[((size_t)(b * 4 + hh) * NCH + c) * 64 + lane];
    }
    {
        const int cc = tid; const float* cw = KIN(I_MCW) + (size_t)layer * 2048 + cc; const float w0 = cw[0], w1 = cw[512], w2 = cw[1024], w3 = cw[1536], cb = KIN(I_MCB)[layer * 512 + cc];
        const float* up = u + (size_t)t0 * NUP + U_ML_Q + cc;
        float win0 = 0.f, win1 = 0.f, win2 = 0.f;
        if (c > 0) { win0 = up[-3 * NUP]; win1 = up[-2 * NUP]; win2 = up[-1 * NUP]; }
        LAS unsigned char* dst = cc < 256 ? Q + cc * 2 : KK + (cc - 256) * 2; const float sc = cc < 256 ? 0.125f : 1.0f;
#pragma unroll 1
        for (int l0 = 0; l0 < 64; l0 += 32) { float xv[32];
#pragma unroll
            for (int j = 0; j < 32; ++j) xv[j] = up[(l0 + j) * NUP];
#pragma unroll
            for (int j = 0; j < 32; ++j) { const float x = xv[j]; const float y = cb + w0 * win0 + w1 * win1 + w2 * win2 + w3 * x; win0 = win1; win1 = win2; win2 = x; lds_st_bf16(dst + (l0 + j) * 528, siluf_(y) * sc); } }
        const int vch = tid & 255, lh = (tid >> 8) * 32; const float* uv = u + (size_t)(t0 + lh) * NUP + U_ML_V + vch;
        float xv[32];
#pragma unroll
        for (int j = 0; j < 32; ++j) xv[j] = uv[j * NUP];
#pragma unroll
        for (int j8 = 0; j8 < 4; ++j8) { float o[8];
#pragma unroll
            for (int j = 0; j < 8; ++j) o[j] = xv[j8 * 8 + j];
            *(LAS v4u*)(VT + vch * 144 + (lh + j8 * 8) * 2) = pack8(o); }
    }
    __syncthreads();
    { const int hh = wave >> 1; bf16* mix = WSP(bf16, WS_MIX); const float* ng = KIN(I_MNG) + layer * 256;
      const float* cprev = WSP(float, WS_ML_C) + ((size_t)(b * 4 + hh) * NCH + c) * 4096;
#pragma unroll 1
      for (int i = 0; i < 2; ++i) { const int tt = 2 * (wave & 1) + i, t = tt * 16 + fr;
          const float bt = BCU[hh * 64 + t] - MROW[hh * 64 + t]; float rs = 0.f;
#pragma unroll
          for (int st = 0; st < 4; ++st) { f32x4 acc = {0.f, 0.f, 0.f, 0.f}; acc = mm16(Q + tt * 16 * 528 + hh * 128, 528, KK + st * 16 * 528 + hh * 128, 528, 64, acc, fr, fq);
              const int s0 = st * 16 + 4 * fq; float o[4];
#pragma unroll
              for (int j = 0; j < 4; ++j) { const int s = s0 + j; const float v = (t >= s) ? acc[j] * __expf(bt + GG[hh * 64 + s]) : 0.f; o[j] = v; rs += v; }
              lds_st_bf16x4(SC + hh * 9216 + t * 144 + s0 * 2, o[0], o[1], o[2], o[3]); }
          rs += __shfl_xor(rs, 16); rs += __shfl_xor(rs, 32);
          float nq = 0.f;
#pragma unroll
          for (int j = 0; j < 16; ++j) nq += bf2f(*(const LAS unsigned short*)(Q + t * 528 + (hh * 64 + fq * 16 + j) * 2)) * NPV[hh * 64 + fq * 16 + j];
          nq += __shfl_xor(nq, 16); nq += __shfl_xor(nq, 32);
          const float wi = WINT[hh * 64 + t]; const float den = wi * nq + rs; const float dn = fmaxf(fabsf(den), __expf(-MROW[hh * 64 + t])); const float rdn = 1.0f / dn;
          LDS_WAIT();
          f32x4 hv[4]; float sm = 0.f;
#pragma unroll
          for (int vt = 0; vt < 4; ++vt) { f32x4 acc = {0.f, 0.f, 0.f, 0.f};
              acc = mm16_gB(Q + tt * 16 * 528 + hh * 128, 528, cprev + (size_t)(vt * 16) * 64, 64, 64, acc, fr, fq);
              acc = acc * wi;
              acc = mm16(SC + hh * 9216 + tt * 16 * 144, 144, VT + (hh * 64 + vt * 16) * 144, 144, 64, acc, fr, fq);
              const f32x4 og = *(const f32x4*)&UU(t0 + t, U_ML_O + hh * 64 + vt * 16 + 4 * fq);
              f32x4 h; h.x = acc.x * rdn * sigmoidf_(og.x); h.y = acc.y * rdn * sigmoidf_(og.y); h.z = acc.z * rdn * sigmoidf_(og.z); h.w = acc.w * rdn * sigmoidf_(og.w);
              hv[vt] = h; sm += (h.x + h.y) + (h.z + h.w); }
          sm += __shfl_xor(sm, 16); sm += __shfl_xor(sm, 32);
          const float mean = sm * (1.f / 64.f); float sq = 0.f;
#pragma unroll
          for (int vt = 0; vt < 4; ++vt) { hv[vt] = hv[vt] - mean; sq += (hv[vt].x * hv[vt].x + hv[vt].y * hv[vt].y) + (hv[vt].z * hv[vt].z + hv[vt].w * hv[vt].w); }
          sq += __shfl_xor(sq, 16); sq += __shfl_xor(sq, 32);
          const float r = 1.0f / sqrtf(sq * (1.f / 64.f) + NORM_EPS);
#pragma unroll
          for (int vt = 0; vt < 4; ++vt) { const int col = hh * 64 + vt * 16 + 4 * fq; const f32x4 g = *(const f32x4*)(ng + col);
              v2u o; o.x = cvt_pk_bf16(hv[vt].x * r * g.x, hv[vt].y * r * g.y); o.y = cvt_pk_bf16(hv[vt].z * r * g.z, hv[vt].w * r * g.w);
              *(v2u*)(mix + (size_t)(t0 + t) * D + 768 + col) = o; } } }
    __syncthreads();
}

__device__ __forceinline__ void rwkv_stage1(Frame& F, const Args& A, int layer, int ub) {
    const float* u = WSP(float, WS_U);
    LAS unsigned char* L = F.lds;
    LAS float* LOWA = (LAS float*)L;
    LAS float* CUM = (LAS float*)(L + 16384);
    LAS float* AAB = CUM;
    LAS unsigned char* M0 = L + 16384 + 16640;
#define RM(i) (M0 + (i) * 9216)
    LAS float* LOG = (LAS float*)RM(0);
    LAS float* GAMC = (LAS float*)(F.MISC + MW_GAMC);
    const int t0 = ub * 64, c = ub & 63, tid = F.tid, lane = F.lane, wave = F.wave;
    const float* mu = KIN(I_RMU) + layer * 896;
    for (int i = tid; i < 64 * 128; i += NWAVES * 64) { const int l = i >> 7, j = i & 127, t = t0 + l; const float cur = UU(t, U_RW_LO + j); const float prv = (t & (SEQ - 1)) ? UU(t - 1, U_RW_LO + j) : 0.f;
        const float xs = cur + (prv - cur) * mu[768 + j];
        if (j < 64) LOWA[l * 64 + j] = j < 32 ? tanhf(xs) : xs; else LOG[l * 64 + j - 64] = sigmoidf_(xs); }
    __syncthreads();
    { const int ch = tid & 255, half = tid >> 8; float* RG = WSP(float, WS_RW_G);
      float gup[64];
      { const f32x4* gp4 = (const f32x4*)(WSP(float, WS_LORA) + (size_t)layer * LORA_PER_LAYER + 16384 + ch * 64);
#pragma unroll
        for (int j = 0; j < 16; ++j) { const f32x4 a = gp4[j]; gup[4 * j] = a.x; gup[4 * j + 1] = a.y; gup[4 * j + 2] = a.z; gup[4 * j + 3] = a.w; } }
#pragma unroll 1
      for (int li = 0; li < 32; ++li) { const int l = half * 32 + li; float g = 0.f;
#pragma unroll
          for (int j = 0; j < 64; ++j) g += LOG[l * 64 + j] * gup[j];
          RG[(size_t)(t0 + l) * 256 + ch] = g; } }
    __syncthreads();
    const int b_ = ub >> 6;
#pragma unroll 1
    for (int hh = 0; hh < 4; ++hh) {
        int ch = lane, fr = lane & 15, fq = lane >> 4; asm volatile("" : "+v"(ch), "+v"(fr), "+v"(fq));
        const int tg = wave, cg = hh * 64 + ch; const size_t un = (size_t)(b_ * 4 + hh) * NCH + c;
        float rr[8], k2r[8], vr[8], ar[8], br[8];
        {
            float wup[32], aup[32];
            { const f32x4* wp4 = (const f32x4*)(WSP(float, WS_LORA) + (size_t)layer * LORA_PER_LAYER + cg * 32); const f32x4* ap4 = (const f32x4*)(WSP(float, WS_LORA) + (size_t)layer * LORA_PER_LAYER + 8192 + cg * 32);
#pragma unroll
              for (int j = 0; j < 8; ++j) { const f32x4 a = wp4[j], b = ap4[j]; wup[4 * j] = a.x; wup[4 * j + 1] = a.y; wup[4 * j + 2] = a.z; wup[4 * j + 3] = a.w; aup[4 * j] = b.x; aup[4 * j + 1] = b.y; aup[4 * j + 2] = b.z; aup[4 * j + 3] = b.w; } }
            const float w0 = KIN(I_RW0)[layer * 256 + cg], a0 = KIN(I_RA0)[layer * 256 + cg], kkc = KIN(I_RKK)[layer * 256 + cg], kac = KIN(I_RKA)[layer * 256 + cg];
            const float mur = mu[cg], muk = mu[256 + cg], muv = mu[512 + cg];
            const int tb = t0 + tg * 8; const bool nop = (c == 0) && (tg == 0);
            float rp = nop ? 0.f : UU(tb - 1, U_RW_R + cg), kp = nop ? 0.f : UU(tb - 1, U_RW_K + cg), vp = nop ? 0.f : UU(tb - 1, U_RW_V + cg);
            float rc[8], kc[8], vc[8];
#pragma unroll
            for (int j = 0; j < 8; ++j) { rc[j] = UU(tb + j, U_RW_R + cg); kc[j] = UU(tb + j, U_RW_K + cg); vc[j] = UU(tb + j, U_RW_V + cg); }
            float* RW = WSP(float, WS_RW);
#pragma unroll
            for (int j = 0; j < 8; ++j) { const int l = tg * 8 + j;
                const float r = rc[j] + (rp - rc[j]) * mur, k = kc[j] + (kp - kc[j]) * muk, v = vc[j] + (vp - vc[j]) * muv; rp = rc[j]; kp = kc[j]; vp = vc[j];
                float wp = w0, ap = a0;
#pragma unroll
                for (int q = 0; q < 32; ++q) { wp += LOWA[l * 64 + q] * wup[q]; ap += LOWA[l * 64 + 32 + q] * aup[q]; }
                const float w = -softplusf_(-wp) - 0.5f; const float lw = -__expf(w); const float al = sigmoidf_(ap);
                const float kk = k * kkc; const float nrm = sqrtf(wave_sum(kk * kk)); const float kkn = kk / fmaxf(nrm, 1e-12f);
                const float k2 = k * (1.0f + (al - 1.0f) * kac);
                rr[j] = r; k2r[j] = k2; vr[j] = v; ar[j] = -kkn; br[j] = kkn * al; CUM[l * 64 + ch] = lw;
                DBG_STAT(0, r); DBG_STAT(1, k2); DBG_STAT(2, v); DBG_STAT(3, kkn); DBG_STAT(4, al); DBG_STAT(5, lw);
#ifdef RW_ZERO_A
                ar[j] = 0.f;
#endif
#ifdef RW_A_RAW
                ar[j] = -kk * 0.1f;
#endif
#ifdef RW_ZERO_B
                br[j] = 0.f;
#endif
                float* o = RW + (size_t)(tb + j) * 768 + cg; o[0] = r; o[256] = k2; o[512] = v; }
        }
        __syncthreads();
        if (wave == 0) { float s = 0.f;
#pragma unroll 8
            for (int l = 0; l < 64; ++l) { s += CUM[l * 64 + ch]; CUM[l * 64 + ch] = s; } }
        __syncthreads();
        {
            const float gC = CUM[63 * 64 + ch]; float oat[8], obb[8], okb[8], ov[8];
#pragma unroll
            for (int j = 0; j < 8; ++j) { const int l = tg * 8 + j; const float gt = CUM[l * 64 + ch], gm = l > 0 ? CUM[(l - 1) * 64 + ch] : 0.f;
                const float at = ar[j] * __expf(gm), rt = rr[j] * __expf(gt), en = __expf(-gt), ec = __expf(gC - gt);
                lds_st_bf16(RM(0) + l * 144 + ch * 2, at); lds_st_bf16(RM(1) + l * 144 + ch * 2, rt); lds_st_bf16(RM(2) + l * 144 + ch * 2, br[j] * en); lds_st_bf16(RM(3) + l * 144 + ch * 2, k2r[j] * en);
                oat[j] = at; obb[j] = br[j] * ec; okb[j] = k2r[j] * ec; ov[j] = vr[j];
                DBG_STAT(6, at); DBG_STAT(7, rt); DBG_STAT(8, br[j] * en); DBG_STAT(9, k2r[j] * en); DBG_STAT(10, gt); }
            *(LAS v4u*)(RM(4) + ch * 144 + tg * 16) = pack8(oat); *(LAS v4u*)(RM(5) + ch * 144 + tg * 16) = pack8(obb); *(LAS v4u*)(RM(6) + ch * 144 + tg * 16) = pack8(okb); *(LAS v4u*)(RM(7) + ch * 144 + tg * 16) = pack8(ov);
            if (tg == 0) GAMC[ch] = __expf(gC);
        }
        __syncthreads();
        {
            const int which = wave >> 1; const LAS unsigned char* Aop = which < 2 ? RM(0) : RM(1); const LAS unsigned char* Bop = (which & 1) ? RM(3) : RM(2);
#pragma unroll 1
            for (int i2 = 0; i2 < 2; ++i2) { const int tt = 2 * (wave & 1) + i2, t = tt * 16 + fr;
#pragma unroll
                for (int it = 0; it < 4; ++it) { f32x4 acc = {0.f, 0.f, 0.f, 0.f}; acc = mm16(Aop + tt * 16 * 144, 144, Bop + it * 16 * 144, 144, 64, acc, fr, fq);
                    const int i0 = it * 16 + 4 * fq; const int lim = which < 2 ? t : t + 1;
                    const float o0 = (i0 < lim) ? acc[0] : 0.f, o1 = (i0 + 1 < lim) ? acc[1] : 0.f, o2 = (i0 + 2 < lim) ? acc[2] : 0.f, o3 = (i0 + 3 < lim) ? acc[3] : 0.f;
#ifdef RW_CLAMP_AAK
                    float q0 = o0, q1 = o1, q2 = o2, q3 = o3;
                    if (which == 1) { q0 = fabsf(o0) < 1e30f ? o0 : 0.f; q1 = fabsf(o1) < 1e30f ? o1 : 0.f; q2 = fabsf(o2) < 1e30f ? o2 : 0.f; q3 = fabsf(o3) < 1e30f ? o3 : 0.f; }
                    if (which == 0) *(LAS f32x4*)(AAB + t * 64 + i0) = (f32x4){o0, o1, o2, o3};
                    else lds_st_bf16x4(RM(7 + which) + t * 144 + i0 * 2, q0, q1, q2, q3);
                    continue;
#endif
                    if (which == 0) { DBG_STAT(11, o0); DBG_STAT(11, o1); DBG_STAT(11, o2); DBG_STAT(11, o3); } if (which == 1) { DBG_STAT(12, o0); DBG_STAT(12, o1); DBG_STAT(12, o2); DBG_STAT(12, o3); } if (which == 2) { DBG_STAT(13, o0); DBG_STAT(13, o3); } if (which == 3) { DBG_STAT(14, o0); DBG_STAT(14, o3); }
                    if (which == 0) *(LAS f32x4*)(AAB + t * 64 + i0) = (f32x4){o0, o1, o2, o3};
                    else lds_st_bf16x4(RM(7 + which) + t * 144 + i0 * 2, o0, o1, o2, o3); } }
        }
        __syncthreads();
        {
#pragma unroll 1
            for (int i2 = 0; i2 < 2; ++i2) { const int idx = wave * 2 + i2, vt = idx >> 2, tt = idx & 3; f32x4 acc = {0.f, 0.f, 0.f, 0.f};
                acc = mm16(RM(7) + vt * 16 * 144, 144, RM(8) + tt * 16 * 144, 144, 64, acc, fr, fq);
                DBG_STAT(15, acc[0]); DBG_STAT(15, acc[1]); DBG_STAT(15, acc[2]); DBG_STAT(15, acc[3]);
                lds_st_bf16x4(RM(0) + (vt * 16 + fr) * 144 + (tt * 16 + 4 * fq) * 2, acc[0], acc[1], acc[2], acc[3]); }
        }
        if (wave == 0) {
            float x[64];
#pragma unroll
            for (int t = 0; t < 64; ++t) { float acc = (t == ch) ? 1.0f : 0.f;
#pragma unroll
                for (int i4 = 0; i4 < (t + 3) / 4; ++i4) { const f32x4 q = *(const LAS f32x4*)(AAB + t * 64 + 4 * i4);
                    acc += q.x * x[4 * i4]; if (4 * i4 + 1 < t) acc += q.y * x[4 * i4 + 1]; if (4 * i4 + 2 < t) acc += q.z * x[4 * i4 + 2]; if (4 * i4 + 3 < t) acc += q.w * x[4 * i4 + 3]; }
                x[t] = acc; DBG_STAT(16, acc); lds_st_bf16(RM(11) + t * 144 + ch * 2, acc); asm volatile("" ::: "memory"); }
        }
        __syncthreads();
        {
            const int rt = wave >> 1;
#pragma unroll
            for (int i2 = 0; i2 < 2; ++i2) { const int tt = 2 * (wave & 1) + i2;
                f32x4 acc = {0.f, 0.f, 0.f, 0.f}; acc = mm16(RM(4) + rt * 16 * 144, 144, RM(11) + tt * 16 * 144, 144, 64, acc, fr, fq);
                DBG_STAT(17, acc[0]); DBG_STAT(17, acc[1]); DBG_STAT(17, acc[2]); DBG_STAT(17, acc[3]);
                lds_st_bf16x4(RM(2) + (rt * 16 + fr) * 144 + (tt * 16 + 4 * fq) * 2, acc[0], acc[1], acc[2], acc[3]);
                f32x4 ac2 = {0.f, 0.f, 0.f, 0.f}; ac2 = mm16(RM(0) + rt * 16 * 144, 144, RM(11) + tt * 16 * 144, 144, 64, ac2, fr, fq);
                DBG_STAT(18, ac2[0]); DBG_STAT(18, ac2[1]); DBG_STAT(18, ac2[2]); DBG_STAT(18, ac2[3]);
                lds_st_bf16x4(RM(3) + (rt * 16 + fr) * 144 + (tt * 16 + 4 * fq) * 2, ac2[0], ac2[1], ac2[2], ac2[3]); }
        }
        __syncthreads();
        {
            const int which = wave >> 1;
#pragma unroll 1
            for (int i2 = 0; i2 < 2; ++i2) { const int rt = 2 * (wave & 1) + i2, row = rt * 16 + fr;
#pragma unroll
                for (int ct = 0; ct < 4; ++ct) { f32x4 acc = {0.f, 0.f, 0.f, 0.f}; const int c0 = ct * 16 + 4 * fq;
                    if (which == 0) { acc = mm16(RM(9) + rt * 16 * 144, 144, RM(2) + ct * 16 * 144, 144, 64, acc, fr, fq);
                        const v2u rw = *(const LAS v2u*)(RM(1) + row * 144 + c0 * 2);
                        acc[0] += __uint_as_float(rw.x << 16); acc[1] += __uint_as_float(rw.x & 0xffff0000u); acc[2] += __uint_as_float(rw.y << 16); acc[3] += __uint_as_float(rw.y & 0xffff0000u);
                        DBG_STAT(19, acc[0]); DBG_STAT(19, acc[1]); DBG_STAT(19, acc[2]); DBG_STAT(19, acc[3]);
                        v2u o; o.x = cvt_pk_bf16(acc[0], acc[1]); o.y = cvt_pk_bf16(acc[2], acc[3]); *(v2u*)(WSP(bf16, WS_RW_RH) + un * 4096 + row * 64 + c0) = o; }
                    else if (which == 1) {
#ifndef RW_NO_U0
                        acc = mm16(RM(9) + rt * 16 * 144, 144, RM(3) + ct * 16 * 144, 144, 64, acc, fr, fq);
#endif
                        acc = mm16(RM(10) + rt * 16 * 144, 144, RM(7) + ct * 16 * 144, 144, 64, acc, fr, fq);
                        DBG_STAT(20, acc[0]); DBG_STAT(20, acc[1]); DBG_STAT(20, acc[2]); DBG_STAT(20, acc[3]);
                        *(f32x4*)(WSP(float, WS_RW_O0) + un * 4096 + row * 64 + c0) = acc; }
                    else if (which == 2) { acc = mm16(RM(5) + rt * 16 * 144, 144, RM(2) + ct * 16 * 144, 144, 64, acc, fr, fq);
                        const float gd = GAMC[row]; if (row == c0) acc[0] += gd; if (row == c0 + 1) acc[1] += gd; if (row == c0 + 2) acc[2] += gd; if (row == c0 + 3) acc[3] += gd;
                        DBG_STAT(21, acc[0]); DBG_STAT(21, acc[1]); DBG_STAT(21, acc[2]); DBG_STAT(21, acc[3]);
                        v2u o; o.x = cvt_pk_bf16(acc[0], acc[1]); o.y = cvt_pk_bf16(acc[2], acc[3]);
                        *(v2u*)((unsigned char*)(WSP(bf16, WS_RW_GF) + un * 4096) + ((rt * 2 + (ct >> 1)) * 64 + ch) * 16 + (ct & 1) * 8) = o; }
                    else { acc = mm16(RM(3) + rt * 16 * 144, 144, RM(5) + ct * 16 * 144, 144, 64, acc, fr, fq); acc = mm16(RM(7) + rt * 16 * 144, 144, RM(6) + ct * 16 * 144, 144, 64, acc, fr, fq);
                        DBG_STAT(22, acc[0]); DBG_STAT(22, acc[1]); DBG_STAT(22, acc[2]); DBG_STAT(22, acc[3]);
                        *(f32x4*)(WSP(float, WS_RW_HT) + un * 4096 + row * 64 + c0) = acc; } } }
        }
        __syncthreads();
    }
#undef RM
}
__device__ __forceinline__ void rwkv_scan_wave(Frame& F, const Args& A, int wslot) {
    const int lane = F.lane, fr = lane & 15, fq = lane >> 4, bh = wslot >> 2, v0 = (wslot & 3) * 16;
    const bf16* GF = WSP(bf16, WS_RW_GF) + (size_t)bh * NCH * 4096; const float* HT = WSP(float, WS_RW_HT) + (size_t)bh * NCH * 4096 + (size_t)(v0 + fr) * 64 + 4 * fq;
    bf16* PT = WSP(bf16, WS_RW_PT) + (size_t)bh * NCH * 4096 + (size_t)(v0 + fr) * 64 + 4 * fq;
    f32x4 P[4] = {{0.f, 0.f, 0.f, 0.f}, {0.f, 0.f, 0.f, 0.f}, {0.f, 0.f, 0.f, 0.f}, {0.f, 0.f, 0.f, 0.f}};
    bf16x8 ga[4][2]; f32x4 hv[4];
#define RW2_LOAD(cc) do { _Pragma("unroll") for (int m = 0; m < 4; ++m) { hv[m] = *(const f32x4*)(HT + (size_t)(cc) * 4096 + 16 * m); \
        _Pragma("unroll") for (int s = 0; s < 2; ++s) ga[m][s] = *(const bf16x8*)(GF + (size_t)(cc) * 4096 + ((m * 2 + s) * 64 + lane) * 8); } } while (0)
    RW2_LOAD(0);
#pragma unroll 1
    for (int c = 0; c < NCH; ++c) {
        bf16x8 gc[4][2]; f32x4 acc[4];
#pragma unroll
        for (int m = 0; m < 4; ++m) { acc[m] = hv[m]; gc[m][0] = ga[m][0]; gc[m][1] = ga[m][1]; }
        if (c + 1 < NCH) RW2_LOAD(c + 1);
        v4u bs[2];
#pragma unroll
        for (int s = 0; s < 2; ++s) { bs[s].x = cvt_pk_bf16(P[2 * s][0], P[2 * s][1]); bs[s].y = cvt_pk_bf16(P[2 * s][2], P[2 * s][3]); bs[s].z = cvt_pk_bf16(P[2 * s + 1][0], P[2 * s + 1][1]); bs[s].w = cvt_pk_bf16(P[2 * s + 1][2], P[2 * s + 1][3]); }
        *(v2u*)(PT + (size_t)c * 4096) = (v2u){bs[0].x, bs[0].y}; *(v2u*)(PT + (size_t)c * 4096 + 16) = (v2u){bs[0].z, bs[0].w};
        *(v2u*)(PT + (size_t)c * 4096 + 32) = (v2u){bs[1].x, bs[1].y}; *(v2u*)(PT + (size_t)c * 4096 + 48) = (v2u){bs[1].z, bs[1].w};
#pragma unroll
        for (int m = 0; m < 4; ++m) { acc[m] = __builtin_amdgcn_mfma_f32_16x16x32_bf16(gc[m][0], __builtin_bit_cast(bf16x8, bs[0]), acc[m], 0, 0, 0);
            acc[m] = __builtin_amdgcn_mfma_f32_16x16x32_bf16(gc[m][1], __builtin_bit_cast(bf16x8, bs[1]), acc[m], 0, 0, 0); P[m] = acc[m]; DBG_STAT(23, acc[m][0]); DBG_STAT(23, acc[m][1]); DBG_STAT(23, acc[m][2]); DBG_STAT(23, acc[m][3]); }
    }
#undef RW2_LOAD
}
__device__ __forceinline__ void rwkv_stage3(Frame& F, const Args& A, int layer, int ub) {
    const int t0 = ub * 64, b_ = ub >> 6, c = ub & 63, lane = F.lane, wave = F.wave, fr = lane & 15, fq = lane >> 4, hh = wave >> 1;
    const size_t un = (size_t)(b_ * 4 + hh) * NCH + c;
    const bf16* RH = WSP(bf16, WS_RW_RH) + un * 4096; const bf16* PT = WSP(bf16, WS_RW_PT) + un * 4096; const float* O0 = WSP(float, WS_RW_O0) + un * 4096;
    const float* RW = WSP(float, WS_RW); const float* RG = WSP(float, WS_RW_G); bf16* mix = WSP(bf16, WS_MIX);
    const float* lg = KIN(I_RLNG) + layer * 256 + hh * 64; const float* lb = KIN(I_RLNB) + layer * 256 + hh * 64; const float* rk = KIN(I_RRK) + layer * 256 + hh * 64;
#pragma unroll 1
    for (int i = 0; i < 2; ++i) { const int tt = 2 * (wave & 1) + i, tl = tt * 16 + fr, t = t0 + tl;
        f32x4 ov[4]; float sm = 0.f;
#pragma unroll
        for (int vt = 0; vt < 4; ++vt) { f32x4 acc = *(const f32x4*)(O0 + tl * 64 + vt * 16 + 4 * fq);
#ifndef RW_NO_STATE
            acc = mm16_gAB(RH + tt * 16 * 64, 64, PT + vt * 16 * 64, 64, 64, acc, fr, fq);
#endif
            ov[vt] = acc; DBG_STAT(24, acc[0]); DBG_STAT(24, acc[1]); DBG_STAT(24, acc[2]); DBG_STAT(24, acc[3]); sm += (acc.x + acc.y) + (acc.z + acc.w); }
        sm += __shfl_xor(sm, 16); sm += __shfl_xor(sm, 32);
        const float mean = sm * (1.f / 64.f); float sq = 0.f;
#pragma unroll
        for (int vt = 0; vt < 4; ++vt) { ov[vt] = ov[vt] - mean; sq += (ov[vt].x * ov[vt].x + ov[vt].y * ov[vt].y) + (ov[vt].z * ov[vt].z + ov[vt].w * ov[vt].w); }
        sq += __shfl_xor(sq, 16); sq += __shfl_xor(sq, 32);
        const float rs = 1.0f / sqrtf(sq * (1.f / 64.f) + RWKV_GN_EPS);
        float bd = 0.f;
#pragma unroll
        for (int q = 0; q < 4; ++q) { const f32x4 r4 = *(const f32x4*)(RW + (size_t)t * 768 + hh * 64 + fq * 16 + 4 * q), k4 = *(const f32x4*)(RW + (size_t)t * 768 + 256 + hh * 64 + fq * 16 + 4 * q), c4 = *(const f32x4*)(rk + fq * 16 + 4 * q);
            bd += (r4.x * k4.x * c4.x + r4.y * k4.y * c4.y) + (r4.z * k4.z * c4.z + r4.w * k4.w * c4.w); }
        bd += __shfl_xor(bd, 16); bd += __shfl_xor(bd, 32);
#pragma unroll
        for (int vt = 0; vt < 4; ++vt) { const int col = vt * 16 + 4 * fq; const f32x4 g4 = *(const f32x4*)(lg + col), b4 = *(const f32x4*)(lb + col);
            const f32x4 v4 = *(const f32x4*)(RW + (size_t)t * 768 + 512 + hh * 64 + col), gg = *(const f32x4*)(RG + (size_t)t * 256 + hh * 64 + col);
            float e0 = (ov[vt].x * rs * g4.x + b4.x + bd * v4.x) * gg.x, e1 = (ov[vt].y * rs * g4.y + b4.y + bd * v4.y) * gg.y, e2 = (ov[vt].z * rs * g4.z + b4.z + bd * v4.z) * gg.z, e3 = (ov[vt].w * rs * g4.w + b4.w + bd * v4.w) * gg.w;
#ifdef RW_SANITIZE
            e0 = (fabsf(e0) < 1e30f) ? e0 : 0.f; e1 = (fabsf(e1) < 1e30f) ? e1 : 0.f; e2 = (fabsf(e2) < 1e30f) ? e2 : 0.f; e3 = (fabsf(e3) < 1e30f) ? e3 : 0.f;
#endif
            v2u o; o.x = cvt_pk_bf16(e0, e1); o.y = cvt_pk_bf16(e2, e3);
            *(v2u*)(mix + (size_t)t * D + 256 + hh * 64 + col) = o; } }
}

__device__ __forceinline__ void scans_elementwise(Frame& F, const Args& A) {
    const int nthr = F.G * 448, gt = F.vcu * 448 + (F.tid - 64);
    constexpr int N_SSD = 16 * 64 * 128, N_GLA = 16 * 32 * 64, N_MLC = 16 * 64 * 64, N_MLN = 16 * 64;
    for (int i = gt; i < N_SSD + N_GLA + N_MLC + N_MLN; i += nthr) {
        if (i < N_SSD) { const int bh = i >> 13, pn = i & 8191; float* base = WSP(float, WS_SSD_ST) + (size_t)bh * NCH * 8192 + pn; const float* dec = WSP(float, WS_SSD_DEC) + bh * NCH; float S = 0.f;
#pragma unroll 1
            for (int c0 = 0; c0 < NCH; c0 += 8) { float x[8], dd[8];
#pragma unroll
                for (int j = 0; j < 8; ++j) { x[j] = base[(size_t)(c0 + j) * 8192]; dd[j] = dec[c0 + j]; }
#pragma unroll
                for (int j = 0; j < 8; ++j) { base[(size_t)(c0 + j) * 8192] = S; S = dd[j] * S + x[j]; } }
        } else if (i < N_SSD + N_GLA) { const int k = i - N_SSD, bh = k >> 11, dv = k & 2047, dd_ = dv >> 6, b = bh >> 2, hh = bh & 3; float* base = WSP(float, WS_GLA_ST) + (size_t)bh * NCH * 2048 + dv; const float* dec = WSP(float, WS_GLA_DEC) + (size_t)b * NCH * 128 + hh * 32 + dd_; float S = 0.f;
#pragma unroll 1
            for (int c0 = 0; c0 < NCH; c0 += 8) { float x[8], dd[8];
#pragma unroll
                for (int j = 0; j < 8; ++j) { x[j] = base[(size_t)(c0 + j) * 2048]; dd[j] = dec[(c0 + j) * 128]; }
#pragma unroll
                for (int j = 0; j < 8; ++j) { base[(size_t)(c0 + j) * 2048] = S; S = dd[j] * S + x[j]; } }
        } else { const int k = i - N_SSD - N_GLA; const bool isn = k >= N_MLC; const int kk = isn ? k - N_MLC : k; const int bh = isn ? (kk >> 6) : (kk >> 12), e = isn ? (kk & 63) : (kk & 4095), str = isn ? 64 : 4096;
            float* base = (isn ? WSP(float, WS_ML_N) : WSP(float, WS_ML_C)) + (size_t)bh * NCH * str + e; const float* bl = WSP(float, WS_ML_BL) + bh * NCH; const float* ml = WSP(float, WS_ML_ML) + bh * NCH; float* mo = WSP(float, WS_ML_M) + bh * NCH;
            float S = 0.f, m = 0.f;
#pragma unroll 1
            for (int c0 = 0; c0 < NCH; c0 += 8) { float x[8], b8[8], m8[8];
#pragma unroll
                for (int j = 0; j < 8; ++j) { x[j] = base[(size_t)(c0 + j) * str]; b8[j] = bl[c0 + j]; m8[j] = ml[c0 + j]; }
#pragma unroll
                for (int j = 0; j < 8; ++j) { const float mn = fmaxf(b8[j] + m, m8[j]); const float so = __expf(b8[j] + m - mn), sn = __expf(m8[j] - mn);
                    base[(size_t)(c0 + j) * str] = S; if (!isn && e == 0) mo[c0 + j] = m; S = so * S + sn * x[j]; m = mn; } }
        }
    }
}
#ifndef MK_PER_PHASE_LAUNCH
#define MK_PER_PHASE_LAUNCH 0
#endif
#ifndef PH_MASK
#define PH_MASK 0xFFF
#endif
#ifndef ST_MASK
#define ST_MASK 0xF
#endif
#define ST_ON(k) (((ST_MASK) >> (k)) & 1)
#ifndef DUP_MASK
#define DUP_MASK 0
#endif
#define DUP_N(k) ((((DUP_MASK) >> (k)) & 1) ? 2 : 1)
#define PH_ON(k) (((PH_MASK) >> (k)) & 1)
constexpr int PH_PER_LAYER = 11, N_PHASES = 1 + DEPTH * PH_PER_LAYER;
__global__ void __launch_bounds__(NWAVES * 64, 2) fwd_kernel(Args args) {
    extern __shared__ __attribute__((aligned(16))) unsigned char lds[];
    Frame F;
    F.lds = (LAS unsigned char*)lds;
    F.MISC = (volatile LAS unsigned*)(F.lds + MISC_OFF);
    F.tid = threadIdx.x; F.lane = F.tid & 63; F.wave = __builtin_amdgcn_readfirstlane(F.tid >> 6);
    F.G = gridDim.x; { const int bx = blockIdx.x; F.vcu = (F.G % 8 == 0) ? (bx % 8) * (F.G / 8) + bx / 8 : bx; }
    F.ka = (karg_t)__builtin_amdgcn_kernarg_segment_ptr(); F.ws = args.ws; F.ctl = (gu32*)(args.ws + WS_CTL); F.out = args.out;
    for (int i = F.tid; i < 256; i += NWAVES * 64) F.MISC[i] = 0u;
    __syncthreads();
    const int lo = args.ph_lo, hi = args.ph_hi;
    XcdBarrier bar; bar.bar = (unsigned*)(F.ctl + CW_BAR); bar.x = 0; bar.st = nullptr;
    if (hi - lo > 1) bar = xcd_barrier_post((unsigned*)(F.ctl + CW_BAR), F.MISC + MW_BAR);
#define IN_(k) (lo <= (k) && (k) < hi)
#define SEAM(k) do { if (IN_(k) && IN_((k) + 1)) xcd_barrier(bar); } while (0)

    if (PH_ON(11) && IN_(0)) { for (int rep_ = 0; rep_ < DUP_N(11); ++rep_) { frame_refresh(F); p0_prologue(F, args); } SEAM(0); }
#pragma unroll 1
    for (int layer = 0; layer < DEPTH; ++layer) {
        const int pb = 1 + layer * PH_PER_LAYER;
        if (PH_ON(0) && IN_(pb + 0)) { for (int rep_ = 0; rep_ < DUP_N(0); ++rep_) { frame_refresh(F);
            { pg8::DenseSched S; S.init(WSP(bf16, WS_XB), WSP(bf16, WS_WIN_T) + (size_t)layer * NUP * D, T, NUP, D, F.G, (int)blockIdx.x);
              pg8::EpiF32 E{WSP(float, WS_U), NUP, nullptr, 0.f};
              pg8::gemm_phase<pg8::EpiF32, pg8::DenseSched>(F.lds, F.tid, S, E); }
            { pg8::DenseSched S; S.init(WSP(bf16, WS_PB) + (size_t)layer * T * 256, WSP(bf16, WS_WPP_T) + (size_t)layer * D * 256, T, D, 256, F.G, (int)blockIdx.x);
              pg8::EpiF32 E{WSP(float, WS_PE), D, nullptr, 0.f};
              pg8::gemm_phase<pg8::EpiF32, pg8::DenseSched>(F.lds, F.tid, S, E); }
            } SEAM(pb + 0);
        }
        if (PH_ON(1) && IN_(pb + 1)) { for (int rep_ = 0; rep_ < DUP_N(1); ++rep_) { frame_refresh(F);
            for (int un = F.vcu; un < 1024; un += F.G) { frame_refresh(F); const int ty = un >> 8, r = un & 255, b = r >> 6, c = r & 63;
                if (ST_ON(0) && ty == 0) ssd_stage1(F, args, layer, b, c); else if (ST_ON(1) && ty == 1) gla_stage1(F, args, layer, b, c); else if (ST_ON(2) && ty == 2) mlstm_stage1(F, args, layer, b, c); else if (ST_ON(3) && ty == 3) rwkv_stage1(F, args, layer, r); }
            } SEAM(pb + 1);
        }
        if (PH_ON(2) && IN_(pb + 2)) { for (int rep_ = 0; rep_ < DUP_N(2); ++rep_) { frame_refresh(F);
            if (F.wave == 0) { for (int ws_ = F.vcu; ws_ < 64; ws_ += F.G) rwkv_scan_wave(F, args, ws_); }
            else if (rep_ == 0) scans_elementwise(F, args);
            } SEAM(pb + 2);
        }
        if (PH_ON(3) && IN_(pb + 3)) { for (int rep_ = 0; rep_ < DUP_N(3); ++rep_) { frame_refresh(F);
            for (int un = F.vcu; un < 1024; un += F.G) { frame_refresh(F); const int ty = un >> 8, r = un & 255, b = r >> 6, c = r & 63;
                if (ST_ON(0) && ty == 0) ssd_stage3(F, args, layer, b, c); else if (ST_ON(1) && ty == 1) gla_stage3(F, args, layer, b, c); else if (ST_ON(2) && ty == 2) mlstm_stage3(F, args, layer, b, c); else if (ST_ON(3) && ty == 3) rwkv_stage3(F, args, layer, r); }
            } SEAM(pb + 3);
        }
        if (PH_ON(4) && IN_(pb + 4)) { for (int rep_ = 0; rep_ < DUP_N(4); ++rep_) { frame_refresh(F);
            pg8::DenseSched S; S.init(WSP(bf16, WS_MIX), WSP(bf16, WS_WOUT_T) + (size_t)layer * D * D, T, D, D, F.G, (int)blockIdx.x);
            pg8::EpiF32 E{WSP(float, WS_Y1), D, layer == 0 ? KIN(I_X) : (const float*)F.out, DN_ALPHA};
            pg8::gemm_phase<pg8::EpiF32, pg8::DenseSched>(F.lds, F.tid, S, E);
            } SEAM(pb + 4);
        }
        if (PH_ON(5) && IN_(pb + 5)) { for (int rep_ = 0; rep_ < DUP_N(5); ++rep_) { frame_refresh(F); p6_ln1_router(F, args, layer); } SEAM(pb + 5); }
        if (PH_ON(6) && IN_(pb + 6)) { for (int rep_ = 0; rep_ < DUP_N(6); ++rep_) { frame_refresh(F);
            moe_build_pfx(F, args, layer, 8);
            pg8::Moe1Sched S; S.O.pfx = F.MISC + MW_PFX; S.O.NT = 8; S.O.G = F.G; S.O.c = (int)blockIdx.x; S.X = WSP(bf16, WS_X1B); S.W = WSP(bf16, WS_WGU_T) + (size_t)layer * NE * 2048 * D; S.sdest = WSP(int, WS_SDEST); S.K = D; S.hstepB = (size_t)1024 * D * 2;
            pg8::EpiMoe1 E{WSP(bf16, WS_ABUF), KIN(I_BGU) + (size_t)layer * NE * 2048};
            pg8::gemm_phase<pg8::EpiMoe1, pg8::Moe1Sched>(F.lds, F.tid, S, E);
            } SEAM(pb + 6);
        }
        if (PH_ON(7) && IN_(pb + 7)) { for (int rep_ = 0; rep_ < DUP_N(7); ++rep_) { frame_refresh(F);
            moe_build_pfx(F, args, layer, 4);
            pg8::Moe2Sched S; S.O.pfx = F.MISC + MW_PFX; S.O.NT = 4; S.O.G = F.G; S.O.c = (int)blockIdx.x; S.Ab = WSP(bf16, WS_ABUF); S.W = WSP(bf16, WS_WDN_T) + (size_t)layer * NE * D * D; S.K = D; S.hstepB = (size_t)128 * D * 2;
            pg8::EpiMoe2 E{WSP(float, WS_YBUF), KIN(I_BDN) + (size_t)layer * NE * D, WSP(int, WS_SDEST), WSP(float, WS_SGATE)};
            pg8::gemm_phase<pg8::EpiMoe2, pg8::Moe2Sched>(F.lds, F.tid, S, E);
            } SEAM(pb + 7);
        }
        if (PH_ON(8) && IN_(pb + 8)) { for (int rep_ = 0; rep_ < DUP_N(8); ++rep_) { frame_refresh(F); p9_combine(F, args); } SEAM(pb + 8); }
        if (PH_ON(9) && IN_(pb + 9)) { for (int rep_ = 0; rep_ < DUP_N(9); ++rep_) { frame_refresh(F);
            pg8::DenseSched S; S.init(WSP(bf16, WS_HB), WSP(bf16, WS_WPG_T) + (size_t)layer * D * D, T, D, D, F.G, (int)blockIdx.x);
            pg8::EpiPle E{WSP(float, WS_H2), WSP(float, WS_H), WSP(float, WS_PE)};
            pg8::gemm_phase<pg8::EpiPle, pg8::DenseSched>(F.lds, F.tid, S, E);
            } SEAM(pb + 9);
        }
        if (PH_ON(10) && IN_(pb + 10)) { for (int rep_ = 0; rep_ < DUP_N(10); ++rep_) { frame_refresh(F); p11_ln2(F, args, layer); } SEAM(pb + 10); }
    }
#ifdef DBG_SEL
    if (hi - lo > 1) { xcd_barrier(bar);
        const unsigned mx = __hip_atomic_load(F.ctl + CW_DBG, RLX_AGENT), nf = __hip_atomic_load(F.ctl + CW_DBG + 1, RLX_AGENT);
        float code;
        { const float m = __uint_as_float(mx); int b = (m > 0.f) ? (int)floorf(log10f(m)) + 30 : 0; b = b < 0 ? 0 : (b > 60 ? 60 : b); if (nf) b += 100; code = sqrtf(10.0f * (float)(b + 1)); }
        for (size_t i = (size_t)blockIdx.x * 512 + threadIdx.x; i < (size_t)T * D; i += (size_t)gridDim.x * 512) F.out[i] = code; }
#endif
#undef IN_
#undef SEAM
}

extern "C" void kernel_launch(void* const* d_in, const int* in_sizes, int n_in, void* d_out, int out_size, void* d_ws, size_t ws_size, hipStream_t stream) {
    static int grid = 0;
    if (grid == 0) {
        if (n_in != N_IN || out_size != T * D || ws_size < WS_END) { fprintf(stderr, "kernel_launch: unexpected shapes (n_in %d, out %d, ws %zu < %zu); nothing launched\n", n_in, out_size, ws_size, (size_t)WS_END); grid = -1; return; }
        int dev = 0, cus = 0, per_cu = 0;
        if (hipGetDevice(&dev) != hipSuccess || hipDeviceGetAttribute(&cus, hipDeviceAttributeMultiprocessorCount, dev) != hipSuccess) { grid = -1; return; }
        if (hipFuncSetAttribute((const void*)fwd_kernel, hipFuncAttributeMaxDynamicSharedMemorySize, LDS_BYTES) != hipSuccess) { fprintf(stderr, "kernel_launch: hipFuncSetAttribute failed\n"); grid = -1; return; }
        if (hipOccupancyMaxActiveBlocksPerMultiprocessor(&per_cu, (const void*)fwd_kernel, NWAVES * 64, LDS_BYTES) != hipSuccess || per_cu < 1) { fprintf(stderr, "kernel_launch: occupancy query says %d blocks per CU\n", per_cu); }
        (void)hipGetLastError();
        grid = cus;
    }
    if (grid < 0) return;
    (void)hipMemsetAsync((char*)d_ws + WS_CTL, 0, CTL_ZERO_BYTES, stream);
    Args a{};
    for (int i = 0; i < N_IN; ++i) a.in[i] = (const float*)d_in[i];
    a.out = (float*)d_out; a.ws = (unsigned char*)d_ws;
#if MK_PER_PHASE_LAUNCH
    for (int ph = 0; ph < N_PHASES; ++ph) { a.ph_lo = ph; a.ph_hi = ph + 1; hipLaunchKernelGGL(fwd_kernel, dim3(grid), dim3(NWAVES * 64), LDS_BYTES, stream, a); }
#else
    a.ph_lo = 0; a.ph_hi = N_PHASES; hipLaunchKernelGGL(fwd_kernel, dim3(grid), dim3(NWAVES * 64), LDS_BYTES, stream, a);
#endif
    const hipError_t le = hipPeekAtLastError();
    if (le != hipSuccess) fprintf(stderr, "kernel_launch: launch failed: %s\n", hipGetErrorName(le));
}
```

```cpp
#include <hip/hip_runtime.h>
#include <cstdio>
#include <cstdint>

#define GAS __attribute__((address_space(1)))
#define LAS __attribute__((address_space(3)))
typedef unsigned short bf16;
typedef unsigned v4u __attribute__((ext_vector_type(4)));
typedef unsigned v2u __attribute__((ext_vector_type(2)));
typedef float f32x4 __attribute__((ext_vector_type(4)));
typedef float f32x2 __attribute__((ext_vector_type(2)));
typedef short bf16x8 __attribute__((ext_vector_type(8)));
typedef GAS unsigned gu32;
#define RLX_AGENT __ATOMIC_RELAXED, __HIP_MEMORY_SCOPE_AGENT
#define LDS_WAIT() asm volatile("s_waitcnt lgkmcnt(0)" ::: "memory")
#define VM_WAIT() asm volatile("s_waitcnt vmcnt(0)" ::: "memory")

constexpr int NWAVES = 8;
constexpr int DEPTH = 4, BATCH = 4, SEQ = 4096, D = 1024, T = BATCH * SEQ;
constexpr int NU = 3484, NUP = 3584;
constexpr int NE = 32, TOPK = 4, ECAP = 16384;
constexpr int NCH = SEQ / 64;
constexpr int U_SSD_Z = 0, U_SSD_X = 256, U_SSD_B = 512, U_SSD_C = 640, U_SSD_DT = 768;
constexpr int U_RW = 772, U_RW_R = 772, U_RW_K = 1028, U_RW_V = 1284, U_RW_LO = 1540;
constexpr int U_GL_Q = 1668, U_GL_K = 1796, U_GL_V = 1924, U_GL_G = 2180, U_GL_OG = 2196;
constexpr int U_ML_Q = 2452, U_ML_K = 2708, U_ML_V = 2964, U_ML_I = 3220, U_ML_F = 3224, U_ML_O = 3228;
constexpr float DN_ALPHA = 1.6817928305074290f;
constexpr float LN_EPS = 1e-5f, NORM_EPS = 1e-5f, RWKV_GN_EPS = 64e-5f;

enum { I_X = 0, I_P, I_WIN, I_WOUT, I_LN1G, I_LN1B, I_SCW, I_SCB, I_SALOG, I_SDTB, I_SD, I_SNG,
       I_RMU, I_RW0, I_RWUP, I_RA0, I_RAUP, I_RGUP, I_RKK, I_RKA, I_RRK, I_RLNG, I_RLNB,
       I_GGUP, I_GGB, I_GNG, I_MCW, I_MCB, I_MIB, I_MFB, I_MNG,
       I_RTW, I_RTB, I_WGU, I_BGU, I_WDN, I_BDN, I_PGW, I_PPJ, I_LN2G, I_LN2B, N_IN };

constexpr size_t MiB = 1u << 20;
constexpr size_t WS_CTL = 0, CTL_ZERO_BYTES = 1 * MiB;
constexpr size_t WS_WIN_T = 2 * MiB;
constexpr size_t WS_WOUT_T = WS_WIN_T + (size_t)DEPTH * NUP * D * 2;
constexpr size_t WS_WGU_T = WS_WOUT_T + (size_t)DEPTH * D * D * 2;
constexpr size_t WS_WDN_T = WS_WGU_T + (size_t)DEPTH * NE * 2048 * D * 2;
constexpr size_t WS_WPG_T = WS_WDN_T + (size_t)DEPTH * NE * D * D * 2;
constexpr size_t WS_WPP_T = WS_WPG_T + (size_t)DEPTH * D * D * 2;
constexpr size_t WS_RWT = WS_WPP_T + (size_t)DEPTH * D * 256 * 2;
constexpr size_t WS_PB = WS_RWT + (size_t)DEPTH * NE * D * 4;
constexpr size_t WS_XB = WS_PB + (size_t)DEPTH * T * 256 * 2;
constexpr size_t WS_U = WS_XB + (size_t)T * D * 2;
constexpr size_t WS_PE = WS_U + (size_t)T * NUP * 2;
constexpr size_t WS_MIX = WS_PE + (size_t)T * D * 4;
constexpr size_t WS_Y1 = WS_MIX + (size_t)T * D * 2;
constexpr size_t WS_X1 = WS_Y1 + (size_t)T * D * 4;
constexpr size_t WS_X1B = WS_X1 + (size_t)T * D * 4;
constexpr size_t WS_SDEST = WS_X1B + (size_t)T * D * 2;
constexpr size_t WS_SGATE = WS_SDEST + (size_t)NE * ECAP * 4;
constexpr size_t WS_ABUF = WS_SGATE + (size_t)NE * ECAP * 4;
constexpr size_t WS_YBUF = WS_ABUF + (size_t)NE * ECAP * D * 2;
constexpr size_t WS_H = WS_YBUF + (size_t)T * 4 * D * 2;
constexpr size_t WS_HB = WS_H + (size_t)T * D * 4;
constexpr size_t WS_H2 = WS_HB + (size_t)T * D * 2;
constexpr size_t WS_SSD_ST = WS_H2 + (size_t)T * D * 4;
constexpr size_t WS_SSD_DEC = WS_SSD_ST + (size_t)16 * NCH * 64 * 128 * 4;
constexpr size_t WS_GLA_ST = WS_SSD_DEC + 16 * NCH * 4;
constexpr size_t WS_GLA_DEC = WS_GLA_ST + (size_t)16 * NCH * 32 * 64 * 4;
constexpr size_t WS_ML_C = WS_GLA_DEC + (size_t)4 * NCH * 128 * 4;
constexpr size_t WS_ML_N = WS_ML_C + (size_t)16 * NCH * 64 * 64 * 4;
constexpr size_t WS_ML_BL = WS_ML_N + (size_t)16 * NCH * 64 * 4;
constexpr size_t WS_ML_ML = WS_ML_BL + 16 * NCH * 4;
constexpr size_t WS_ML_M = WS_ML_ML + 16 * NCH * 4;
constexpr size_t WS_RW = WS_ML_M + 16 * NCH * 4;
constexpr size_t WS_RW_G = WS_RW + (size_t)T * 3 * 256 * 4;
constexpr size_t WS_RW_RH = WS_RW_G + (size_t)T * 256 * 4;
constexpr size_t WS_RW_O0 = WS_RW_RH + (size_t)1024 * 4096 * 2;
constexpr size_t WS_RW_GF = WS_RW_O0 + (size_t)1024 * 4096 * 4;
constexpr size_t WS_RW_HT = WS_RW_GF + (size_t)1024 * 4096 * 2;
constexpr size_t WS_RW_PT = WS_RW_HT + (size_t)1024 * 4096 * 4;
constexpr size_t WS_LORA = WS_RW_PT + (size_t)1024 * 4096 * 2;
constexpr int LORA_PER_LAYER = 8192 + 8192 + 16384 + 2048;
constexpr size_t WS_END = WS_LORA + (size_t)DEPTH * LORA_PER_LAYER * 4;
constexpr int CW_BAR = 4096;
constexpr int CW_DBG = 32768;
constexpr int CW_CNT = 16384;

constexpr int RING_BYTES = 147456;
constexpr int MISC_OFF = RING_BYTES;
constexpr int LDS_BYTES = RING_BYTES + 1024;
constexpr int MW_BAR = 8, MW_LCNT = 32, MW_LBASE = 64, MW_PFX = 96, MW_CNT = 136, MW_GAMC = 168;

typedef __bf16 bf16x2_t __attribute__((ext_vector_type(2)));
__device__ __forceinline__ unsigned cvt_pk_bf16(float lo, float hi) { const f32x2 v = {lo, hi}; const bf16x2_t b = __builtin_convertvector(v, bf16x2_t); return __builtin_bit_cast(unsigned, b); }
__device__ __forceinline__ float bf2f(unsigned short b) { return __uint_as_float(((unsigned)b) << 16); }
__device__ __forceinline__ float sigmoidf_(float x) { return 1.0f / (1.0f + __expf(-x)); }
__device__ __forceinline__ float siluf_(float x) { return x / (1.0f + __expf(-x)); }
__device__ __forceinline__ float softplusf_(float x) { return fmaxf(x, 0.f) + log1pf(__expf(-fabsf(x))); }
__device__ __forceinline__ float logsigmoidf_(float x) { return fminf(x, 0.f) - log1pf(__expf(-fabsf(x))); }
__device__ __forceinline__ float wave_sum(float v) {
#pragma unroll
    for (int o = 1; o < 64; o <<= 1) v += __shfl_xor(v, o);
    return v;
}
__device__ __forceinline__ float wave_max(float v) {
#pragma unroll
    for (int o = 1; o < 64; o <<= 1) v = fmaxf(v, __shfl_xor(v, o));
    return v;
}
__device__ __forceinline__ float wave_scan_add(float v, int lane) {
#pragma unroll
    for (int o = 1; o < 64; o <<= 1) { const float t = __shfl_up(v, o); if (lane >= o) v += t; }
    return v;
}
__device__ __forceinline__ float wave_scan_max(float v, int lane) {
#pragma unroll
    for (int o = 1; o < 64; o <<= 1) { const float t = __shfl_up(v, o); if (lane >= o) v = fmaxf(v, t); }
    return v;
}
__device__ __forceinline__ f32x4 mm16(const LAS unsigned char* A, int lda, const LAS unsigned char* B, int ldb, int K, f32x4 acc, int fr, int fq) {
    const LAS unsigned char* ap = A + fr * lda + fq * 16; const LAS unsigned char* bp = B + fr * ldb + fq * 16;
    for (int k = 0; k < K; k += 32) {
        const bf16x8 a = *(const LAS bf16x8*)(ap + k * 2); const bf16x8 b = *(const LAS bf16x8*)(bp + k * 2);
        acc = __builtin_amdgcn_mfma_f32_16x16x32_bf16(b, a, acc, 0, 0, 0);
    }
    return acc;
}
__device__ __forceinline__ f32x4 mm16_gB(const LAS unsigned char* A, int lda, const float* B, int ldb, int K, f32x4 acc, int fr, int fq) {
    const LAS unsigned char* ap = A + fr * lda + fq * 16; const float* bp = B + (size_t)fr * ldb + fq * 8;
    for (int k = 0; k < K; k += 32) {
        const bf16x8 a = *(const LAS bf16x8*)(ap + k * 2);
        const f32x4 b0 = *(const f32x4*)(bp + k), b1 = *(const f32x4*)(bp + k + 4);
        v4u bw; bw.x = cvt_pk_bf16(b0.x, b0.y); bw.y = cvt_pk_bf16(b0.z, b0.w); bw.z = cvt_pk_bf16(b1.x, b1.y); bw.w = cvt_pk_bf16(b1.z, b1.w);
        const bf16x8 b = __builtin_bit_cast(bf16x8, bw);
        acc = __builtin_amdgcn_mfma_f32_16x16x32_bf16(b, a, acc, 0, 0, 0);
    }
    return acc;
}
__device__ __forceinline__ f32x4 mm16_gAB(const bf16* A, int lda, const bf16* B, int ldb, int K, f32x4 acc, int fr, int fq) {
    const bf16* ap = A + (size_t)fr * lda + fq * 8; const bf16* bp = B + (size_t)fr * ldb + fq * 8;
    for (int k = 0; k < K; k += 32) { const bf16x8 a = *(const bf16x8*)(ap + k), b = *(const bf16x8*)(bp + k); acc = __builtin_amdgcn_mfma_f32_16x16x32_bf16(b, a, acc, 0, 0, 0); }
    return acc;
}
__device__ __forceinline__ v4u pack8(const float (&v)[8]) { v4u o; o.x = cvt_pk_bf16(v[0], v[1]); o.y = cvt_pk_bf16(v[2], v[3]); o.z = cvt_pk_bf16(v[4], v[5]); o.w = cvt_pk_bf16(v[6], v[7]); return o; }

#define XB_TMO      128
#define XB_XCNT(j)  (256  + 64 * (j))
#define XB_XSUB(j)  (1280 + 64 * (j))
#define XB_XGEN(j)  (2304 + 64 * (j))
#define XB_TOP      3328
#define XB_TOPGEN   3392
#define XCD_BAR_WORDS 3456
#define XB_SPIN_CAP (1u << 18)
__device__ __forceinline__ unsigned xb_ld(unsigned* p)              { return __hip_atomic_load(p, __ATOMIC_RELAXED, __HIP_MEMORY_SCOPE_AGENT); }
__device__ __forceinline__ unsigned xb_add(unsigned* p, unsigned v) { return __hip_atomic_fetch_add(p, v, __ATOMIC_RELAXED, __HIP_MEMORY_SCOPE_AGENT); }
__device__ __forceinline__ unsigned xb_xcc_id() { return (unsigned)__builtin_amdgcn_s_getreg((3 << 11) | 20) & 0xFu; }
#define XB_SPIN(cond, bar) do { unsigned _sp = 0; while (cond) { __builtin_amdgcn_s_sleep(1); \
    if ((++_sp & 255u) == 0u) { if (xb_ld(&(bar)[XB_TMO])) break; if (_sp > XB_SPIN_CAP) { atomicAdd(&(bar)[XB_TMO], 1u); break; } } } } while (0)
struct XcdBarrier { unsigned* bar; unsigned x; volatile LAS unsigned* st; };
__device__ __forceinline__ XcdBarrier xcd_barrier_post(unsigned* bar, volatile LAS unsigned* st) {
    XcdBarrier b; b.bar = bar; b.x = xb_xcc_id(); b.st = st;
    if (threadIdx.x == 0) (void)xb_add(&bar[XB_XCNT(b.x)], 1u);
    return b;
}
__device__ __forceinline__ void xcd_barrier_complete(unsigned* bar, unsigned x, unsigned& nloc, unsigned& nx) {
    const unsigned G = gridDim.x * gridDim.y * gridDim.z;
    unsigned sum, cnt, mine, sp = 0u;
    for (;;) {
        sum = 0u; cnt = 0u; mine = 0u;
#pragma unroll
        for (unsigned j = 0; j < 16; ++j) { const unsigned c = xb_ld(&bar[XB_XCNT(j)]); sum += c; cnt += (c > 0u) ? 1u : 0u; mine = (j == x) ? c : mine; }
        if (sum == G) break;
        __builtin_amdgcn_s_sleep(1);
        if ((++sp & 255u) == 0u) { if (xb_ld(&bar[XB_TMO])) break; if (sp > XB_SPIN_CAP) { atomicAdd(&bar[XB_TMO], 1u); break; } }
    }
    nloc = mine > 0u ? mine : 1u; nx = cnt > 0u ? cnt : 1u;
}
__device__ __forceinline__ void xcd_barrier(const XcdBarrier& b) {
    asm volatile("s_waitcnt vmcnt(0)" ::: "memory");
    __syncthreads();
    if (threadIdx.x == 0) {
        unsigned* bar = b.bar;
        __builtin_amdgcn_s_waitcnt(0);
        unsigned nloc = b.st[0], nx = b.st[1];
        if (nloc == 0u) { xcd_barrier_complete(bar, b.x, nloc, nx); b.st[0] = nloc; b.st[1] = nx; }
        const unsigned old = xb_add(&bar[XB_XSUB(b.x)], 1u);
        const unsigned gen = old / nloc;
        if (old + 1u == (gen + 1u) * nloc) {
            __builtin_amdgcn_fence(__ATOMIC_RELEASE, "agent");
            asm volatile("s_waitcnt vmcnt(0)" ::: "memory");
            const unsigned og = xb_add(&bar[XB_TOP], 1u);
            const unsigned tg = og / nx;
            if (og + 1u == (tg + 1u) * nx) xb_add(&bar[XB_TOPGEN], 1u);
            else XB_SPIN(xb_ld(&bar[XB_TOPGEN]) == tg, bar);
            __builtin_amdgcn_fence(__ATOMIC_ACQUIRE, "agent");
            xb_add(&bar[XB_XGEN(b.x)], 1u);
            asm volatile("s_waitcnt vmcnt(0)" ::: "memory");
        } else {
            XB_SPIN(xb_ld(&bar[XB_XGEN(b.x)]) == gen, bar);
            __builtin_amdgcn_fence(__ATOMIC_ACQUIRE, "agent");
            asm volatile("s_waitcnt vmcnt(0)" ::: "memory");
        }
    }
    __syncthreads();
}

namespace pg8 {
constexpr int BM = 256, BK = 64, HALF = 128, HTB = HALF * BK * 2, STAGE_BYTES = 8 * HTB, NXCD = 8, WGM = 8;
__host__ __device__ __forceinline__ int lds_byte(int r, int c) { const int st = (r >> 4) * 2 + (c >> 5), rr = r & 15, cc = c & 31, ob = rr * 64 + cc * 2; return st * 1024 + (ob ^ (((ob >> 9) & 1) << 5)); }
__host__ __device__ __forceinline__ void stage_rc(int b, int& R, int& C) { const int st = b / 1024, sb = b % 1024, swz = sb ^ (((sb >> 9) & 1) << 5); R = (st >> 1) * 16 + swz / 64; C = (st & 1) * 32 + (swz % 64) / 2; }
__host__ __device__ __forceinline__ int perm32(int rho) { const int n = rho >> 4, i = rho & 15; return 8 * (i >> 2) + 4 * n + (i & 3); }

template <class Epi, class Sched>
__device__ __forceinline__ void gemm_phase(LAS unsigned char* lds, const int tid, const Sched& S, const Epi& E) {
    const int wid = __builtin_amdgcn_readfirstlane(tid >> 6), lane = tid & 63, wr = wid >> 2, wc = wid & 3, fr = lane & 15, fq = lane >> 4;
    const int K = S.K, nt = K / BK;
    unsigned voffB[2];
#pragma unroll
    for (int i = 0; i < 2; ++i) { int R, C; stage_rc(tid * 16 + i * 8192, R, C); const int Rb = Epi::PERM ? ((R & ~31) + perm32(R & 31)) : R; voffB[i] = (unsigned)(Rb * K + C) * 2u; }
    const size_t kstep = (size_t)(BK * 2);
    const size_t hstepB = S.hstepB;
    const unsigned ldsw = (unsigned)wid * 1024u;
    const int aoff = lds_byte(wr * 64 + fr, fq * 8), boff = lds_byte(wc * 32 + fr, fq * 8);
#define PG8_SA(b, h) (((b) * 2 + (h)) * HTB)
#define PG8_SB(b, h) ((4 + (b) * 2 + (h)) * HTB)
#define PG8_STAGE_B(bufoff, gbase) do { _Pragma("unroll") for (int _i = 0; _i < 2; ++_i) \
        __builtin_amdgcn_global_load_lds((const unsigned*)((const char*)(gbase) + voffB[_i]), (LAS unsigned*)(lds + (bufoff) + ldsw + _i * 8192), 16, 0, 0); } while (0)
#define PG8_STAGE_A(bufoff, gbase, v0, v1) do { \
        __builtin_amdgcn_global_load_lds((const unsigned*)((const char*)(gbase) + (v0)), (LAS unsigned*)(lds + (bufoff) + ldsw), 16, 0, 0); \
        __builtin_amdgcn_global_load_lds((const unsigned*)((const char*)(gbase) + (v1)), (LAS unsigned*)(lds + (bufoff) + ldsw + 8192), 16, 0, 0); } while (0)
#define PG8_LDA(dst, b, h) do { _Pragma("unroll") for (int m = 0; m < 4; ++m) _Pragma("unroll") for (int k = 0; k < 2; ++k) dst[m][k] = *(const LAS bf16x8*)(lds + PG8_SA(b, h) + aoff + m * 2048 + k * 1024); } while (0)
#define PG8_LDB(dst, b, h) do { _Pragma("unroll") for (int n = 0; n < 2; ++n) _Pragma("unroll") for (int k = 0; k < 2; ++k) dst[n][k] = *(const LAS bf16x8*)(lds + PG8_SB(b, h) + boff + n * 2048 + k * 1024); } while (0)
#define PG8_MMA(ai, bj, At, Bt) do { __builtin_amdgcn_s_setprio(1); _Pragma("unroll") for (int m = 0; m < 4; ++m) _Pragma("unroll") for (int n = 0; n < 2; ++n) _Pragma("unroll") for (int k = 0; k < 2; ++k) \
        acc[ai][bj][m][n] = __builtin_amdgcn_mfma_f32_16x16x32_bf16(Bt[n][k], At[m][k], acc[ai][bj][m][n], 0, 0, 0); __builtin_amdgcn_s_setprio(0); } while (0)
#define PG8_WAIT_V(n) asm volatile("s_waitcnt vmcnt(" #n ")" ::: "memory")
#define PG8_WAIT_L(n) asm volatile("s_waitcnt lgkmcnt(" #n ")" ::: "memory")
#define PG8_BAR __builtin_amdgcn_s_barrier()
#define PG8_SCHED __builtin_amdgcn_sched_barrier(0)
    typename Sched::Unit cur, nxt; int ui = 0;
    if (!S.next(0, cur)) return;
    f32x4 acc[2][2][4][2];
#pragma unroll
    for (int a = 0; a < 2; ++a)
#pragma unroll
        for (int b = 0; b < 2; ++b)
#pragma unroll
            for (int m = 0; m < 4; ++m)
#pragma unroll
                for (int n = 0; n < 2; ++n) acc[a][b][m][n] = (f32x4){0.f, 0.f, 0.f, 0.f};
    bf16x8 At[4][2], B0[2][2], B1[2][2];
    constexpr bool GA = Sched::GATHER;
    const size_t hstepA = GA ? (size_t)0 : (size_t)HALF * K * 2;
    unsigned vA[2][2];
    S.a_off(cur, tid, vA);
#define PG8_STAGE_AH(bufoff, base, vv, h) PG8_STAGE_A(bufoff, ((base) + (h) * hstepA), vv[GA ? (h) : 0][0], vv[GA ? (h) : 0][1])
    const char* cA = S.a_base(cur); const char* cB = S.b_base(cur);
    PG8_STAGE_B(PG8_SB(0, 0), cB); PG8_STAGE_B(PG8_SB(0, 1), cB + hstepB); PG8_STAGE_AH(PG8_SA(0, 0), cA, vA, 0); PG8_STAGE_AH(PG8_SA(0, 1), cA, vA, 1);
    if (wr == 1) PG8_BAR;
    PG8_WAIT_V(2); PG8_BAR;
    PG8_STAGE_B(PG8_SB(1, 0), cB + kstep); PG8_STAGE_AH(PG8_SA(1, 0), cA + kstep, vA, 0); PG8_STAGE_B(PG8_SB(1, 1), cB + hstepB + kstep);
    PG8_WAIT_V(6); PG8_BAR;
    for (;;) {
        const bool has_next = S.next(ui + 1, nxt);
        const char* nA = cA; const char* nB = cB;
        if (has_next) { nA = S.a_base(nxt); nB = S.b_base(nxt); }
        for (int t = 0; t < nt; t += 2) {
            const bool last = (t == nt - 2);
            const char* a1 = cA + (size_t)(t + 1) * kstep;
            const char* a2 = last ? nA : cA + (size_t)(t + 2) * kstep; const char* b2 = last ? nB : cB + (size_t)(t + 2) * kstep;
            const char* a3 = a2 + kstep; const char* b3 = b2 + kstep;
            PG8_LDB(B0, 0, 0); PG8_LDB(B1, 0, 1); PG8_SCHED; PG8_LDA(At, 0, 0); PG8_STAGE_AH(PG8_SA(1, 1), a1, vA, 1);
            if constexpr (GA) { if (last && has_next) S.a_off(nxt, tid, vA); }
            PG8_WAIT_V(8); PG8_WAIT_L(0); PG8_BAR; PG8_MMA(0, 0, At, B0); PG8_MMA(0, 1, At, B1); PG8_BAR; PG8_SCHED;
            PG8_LDA(At, 0, 1); PG8_STAGE_B(PG8_SB(0, 0), b2); PG8_STAGE_B(PG8_SB(0, 1), b2 + hstepB); PG8_STAGE_AH(PG8_SA(0, 0), a2, vA, 0);
            PG8_WAIT_V(8); PG8_WAIT_L(0); PG8_BAR; PG8_MMA(1, 0, At, B0); PG8_MMA(1, 1, At, B1); PG8_BAR; PG8_SCHED;
            PG8_LDB(B0, 1, 0); PG8_LDB(B1, 1, 1); PG8_SCHED; PG8_LDA(At, 1, 0); PG8_STAGE_AH(PG8_SA(0, 1), a2, vA, 1);
            PG8_WAIT_V(8); PG8_WAIT_L(0); PG8_BAR; PG8_MMA(0, 0, At, B0); PG8_MMA(0, 1, At, B1); PG8_BAR; PG8_SCHED;
            PG8_LDA(At, 1, 1); PG8_STAGE_B(PG8_SB(1, 0), b3); PG8_STAGE_B(PG8_SB(1, 1), b3 + hstepB); PG8_STAGE_AH(PG8_SA(1, 0), a3, vA, 0);
            PG8_WAIT_V(8); PG8_WAIT_L(0); PG8_BAR; PG8_MMA(1, 0, At, B0); PG8_MMA(1, 1, At, B1); PG8_BAR; PG8_SCHED;
        }
        if (wr == 0) PG8_BAR;
        { int fr_ = fr, fq_ = fq; asm volatile("" : "+v"(fr_), "+v"(fq_)); E(acc, cur, wr, wc, fr_, fq_); }
        if (!has_next) break;
#pragma unroll
        for (int a = 0; a < 2; ++a)
#pragma unroll
            for (int b = 0; b < 2; ++b)
#pragma unroll
                for (int m = 0; m < 4; ++m)
#pragma unroll
                    for (int n = 0; n < 2; ++n) acc[a][b][m][n] = (f32x4){0.f, 0.f, 0.f, 0.f};
        cur = nxt; cA = nA; cB = nB; ++ui;
        if (wr == 1) PG8_BAR;
    }
    PG8_WAIT_V(0);
    PG8_BAR;
#undef PG8_SA
#undef PG8_SB
#undef PG8_STAGE_A
#undef PG8_STAGE_AH
#undef PG8_STAGE_B
#undef PG8_LDA
#undef PG8_LDB
#undef PG8_MMA
#undef PG8_WAIT_V
#undef PG8_WAIT_L
#undef PG8_BAR
#undef PG8_SCHED
}
}
struct Args { const float* in[N_IN]; float* out; unsigned char* ws; int ph_lo, ph_hi; };
typedef const __attribute__((address_space(4))) unsigned long long* karg_t;
struct Frame {
    karg_t ka;
    LAS unsigned char* lds;
    volatile LAS unsigned* MISC;
    gu32* ctl;
    unsigned char* ws;
    float* out;
    int tid, lane, wave, vcu, G;
};
#define WSP(T_, off) ((T_*)(F.ws + (off)))
#define KIN(k) ((const float*)F.ka[(k)])
#ifdef DBG_SEL
#define DBG_STAT(k, val) do { const float _v = (val); if ((k) == DBG_SEL) { if (fabsf(_v) < 3e38f) atomicMax((unsigned*)(F.ctl + CW_DBG), __float_as_uint(fabsf(_v))); else atomicAdd((unsigned*)(F.ctl + CW_DBG + 1), 1u); } } while (0)
#else
#define DBG_STAT(k, val) do { } while (0)
#endif
template <class P> __device__ __forceinline__ P launder_uniform(P p) {
    unsigned lo = (unsigned)(unsigned long long)p, hi = (unsigned)((unsigned long long)p >> 32);
    asm volatile("" : "+v"(lo), "+v"(hi));
    lo = __builtin_amdgcn_readfirstlane(lo); hi = __builtin_amdgcn_readfirstlane(hi);
    return (P)(((unsigned long long)hi << 32) | lo);
}
__device__ __forceinline__ void frame_refresh(Frame& F) {
    int t = F.tid; asm volatile("" : "+v"(t)); F.tid = t; F.lane = t & 63; F.wave = __builtin_amdgcn_readfirstlane(t >> 6);
    F.ws = launder_uniform(F.ws); F.ctl = (gu32*)(F.ws + WS_CTL);
    F.out = launder_uniform(F.out);
    F.ka = launder_uniform(F.ka);
}

namespace pg8 {
struct DenseSched {
    static constexpr bool GATHER = false;
    struct Unit { int pm, pn; };
    const bf16* A; const bf16* Bt; int K; size_t hstepB; int nM, nN, nwg, G, c;
    __device__ __forceinline__ void init(const bf16* A_, const bf16* Bt_, int M, int N, int K_, int G_, int c_) { A = A_; Bt = Bt_; K = K_; hstepB = (size_t)HALF * K_ * 2; nM = M / BM; nN = N / BM; nwg = nM * nN; G = G_; c = c_; }
    __device__ __forceinline__ bool next(int i, Unit& u) const {
        const long L = (long)i * G + c; if (L >= nwg) return false;
        int wgid = (int)L; { const int q = nwg / NXCD, r = nwg % NXCD, xcd = wgid % NXCD, off = wgid / NXCD; wgid = (xcd < r ? xcd * (q + 1) : r * (q + 1) + (xcd - r) * q) + off; }
        const int nig = WGM * nN, gid = wgid / nig, fm = gid * WGM, gsz = (nM - fm) < WGM ? (nM - fm) : WGM;
        u.pm = fm + ((wgid % nig) % gsz); u.pn = (wgid % nig) / gsz; return true;
    }
    __device__ __forceinline__ const char* a_base(const Unit& u) const { return (const char*)A + (size_t)u.pm * BM * K * 2; }
    __device__ __forceinline__ const char* b_base(const Unit& u) const { return (const char*)Bt + (size_t)u.pn * BM * K * 2; }
    __device__ __forceinline__ void a_off(const Unit&, int tid, unsigned (&v)[2][2]) const {
#pragma unroll
        for (int i = 0; i < 2; ++i) { int R, C; stage_rc(tid * 16 + i * 8192, R, C); v[0][i] = (unsigned)(R * K + C) * 2u; v[1][i] = v[0][i]; }
    }
};
struct MoeUnit { int e, mt, nt, cnt; };
struct MoeOrder {
    const volatile LAS unsigned* pfx;
    int NT, G, c;
    __device__ __forceinline__ bool decode(int i, MoeUnit& u) const {
        const int nwg = (int)pfx[32]; const long L = (long)i * G + c; if (L >= nwg) return false;
        int wgid = (int)L; { const int q = nwg / NXCD, r = nwg % NXCD, xcd = wgid % NXCD, off = wgid / NXCD; wgid = (xcd < r ? xcd * (q + 1) : r * (q + 1) + (xcd - r) * q) + off; }
        int e = 0;
#pragma unroll 1
        for (int j = 1; j < 32; ++j) e += ((int)pfx[j] <= wgid) ? 1 : 0;
        const int j = wgid - (int)pfx[e];
        u.e = e; u.mt = j / NT; u.nt = j % NT; u.cnt = (int)pfx[40 + e]; return true;
    }
};
struct Moe1Sched {
    static constexpr bool GATHER = true;
    typedef MoeUnit Unit;
    MoeOrder O; const bf16* X; const bf16* W; const int* sdest; int K; size_t hstepB;
    __device__ __forceinline__ bool next(int i, Unit& u) const { return O.decode(i, u); }
    __device__ __forceinline__ const char* a_base(const Unit&) const { return (const char*)X; }
    __device__ __forceinline__ const char* b_base(const Unit& u) const { return (const char*)W + ((size_t)u.e * 2048 + (size_t)u.nt * 128) * 1024 * 2; }
    __device__ __forceinline__ void a_off(const Unit& u, int tid, unsigned (&v)[2][2]) const {
#pragma unroll
        for (int i = 0; i < 2; ++i) { int R, C; stage_rc(tid * 16 + i * 8192, R, C);
#pragma unroll
            for (int h = 0; h < 2; ++h) { const int slot = u.mt * 256 + h * HALF + R; int tok = 0; if (slot < u.cnt) tok = sdest[u.e * ECAP + slot] >> 2; v[h][i] = (unsigned)(tok * 1024 + C) * 2u; } }
    }
};
struct Moe2Sched {
    static constexpr bool GATHER = false;
    typedef MoeUnit Unit;
    MoeOrder O; const bf16* Ab; const bf16* W; int K; size_t hstepB;
    __device__ __forceinline__ bool next(int i, Unit& u) const { return O.decode(i, u); }
    __device__ __forceinline__ const char* a_base(const Unit& u) const { return (const char*)Ab + ((size_t)u.e * ECAP + (size_t)u.mt * 256) * 1024 * 2; }
    __device__ __forceinline__ const char* b_base(const Unit& u) const { return (const char*)W + ((size_t)u.e * 1024 + (size_t)u.nt * 256) * 1024 * 2; }
    __device__ __forceinline__ void a_off(const Unit&, int tid, unsigned (&v)[2][2]) const {
#pragma unroll
        for (int i = 0; i < 2; ++i) { int R, C; stage_rc(tid * 16 + i * 8192, R, C); v[0][i] = (unsigned)(R * 1024 + C) * 2u; v[1][i] = v[0][i]; }
    }
};

struct EpiF32 {
    static constexpr bool PERM = false;
    float* C; int ldc; const float* base; float alpha;
    __device__ __forceinline__ void operator()(const f32x4 (&acc)[2][2][4][2], const DenseSched::Unit& u, int wr, int wc, int fr, int fq) const {
        const int row0 = u.pm * BM + wr * 64 + fr, col0 = u.pn * BM + wc * 32 + 4 * fq;
#pragma unroll
        for (int ai = 0; ai < 2; ++ai)
#pragma unroll
            for (int m = 0; m < 4; ++m) { const size_t ro = (size_t)(row0 + ai * HALF + m * 16) * ldc + col0;
#pragma unroll
                for (int bj = 0; bj < 2; ++bj)
#pragma unroll
                    for (int n = 0; n < 2; ++n) { f32x4 v = acc[ai][bj][m][n];
                        if (base) { const f32x4 b = *(const f32x4*)(base + ro + bj * HALF + n * 16); v = v + b * alpha; }
                        *(f32x4*)(C + ro + bj * HALF + n * 16) = v; } }
    }
};
struct EpiB16 {
    static constexpr bool PERM = true;
    bf16* O; int ldc;
    __device__ __forceinline__ void operator()(const f32x4 (&acc)[2][2][4][2], const DenseSched::Unit& u, int wr, int wc, int fr, int fq) const {
        const int row0 = u.pm * BM + wr * 64 + fr, col0 = u.pn * BM + wc * 32 + 8 * fq;
#pragma unroll
        for (int ai = 0; ai < 2; ++ai)
#pragma unroll
            for (int m = 0; m < 4; ++m) { bf16* rowp = O + (size_t)(row0 + ai * HALF + m * 16) * ldc + col0;
#pragma unroll
                for (int bj = 0; bj < 2; ++bj) { const f32x4 v0 = acc[ai][bj][m][0], v1 = acc[ai][bj][m][1];
                    v4u w; w.x = cvt_pk_bf16(v0[0], v0[1]); w.y = cvt_pk_bf16(v0[2], v0[3]); w.z = cvt_pk_bf16(v1[0], v1[1]); w.w = cvt_pk_bf16(v1[2], v1[3]);
                    *(v4u*)(rowp + bj * HALF) = w; } }
    }
};
struct EpiPle {
    static constexpr bool PERM = false;
    float* C; const float* hb; const float* pe;
    __device__ __forceinline__ void operator()(const f32x4 (&acc)[2][2][4][2], const DenseSched::Unit& u, int wr, int wc, int fr, int fq) const {
        const int row0 = u.pm * BM + wr * 64 + fr, col0 = u.pn * BM + wc * 32 + 4 * fq;
#pragma unroll
        for (int ai = 0; ai < 2; ++ai)
#pragma unroll
            for (int m = 0; m < 4; ++m) { const size_t ro = (size_t)(row0 + ai * HALF + m * 16) * 1024 + col0;
#pragma unroll
                for (int bj = 0; bj < 2; ++bj)
#pragma unroll
                    for (int n = 0; n < 2; ++n) { const f32x4 a = acc[ai][bj][m][n]; const f32x4 hv = *(const f32x4*)(hb + ro + bj * HALF + n * 16), pv = *(const f32x4*)(pe + ro + bj * HALF + n * 16);
                        f32x4 o; o.x = hv.x + sigmoidf_(a.x) * pv.x; o.y = hv.y + sigmoidf_(a.y) * pv.y; o.z = hv.z + sigmoidf_(a.z) * pv.z; o.w = hv.w + sigmoidf_(a.w) * pv.w;
                        *(f32x4*)(C + ro + bj * HALF + n * 16) = o; } }
    }
};
struct EpiMoe1 {
    static constexpr bool PERM = true;
    bf16* Ab; const float* bgu;
    __device__ __forceinline__ void operator()(const f32x4 (&acc)[2][2][4][2], const MoeUnit& u, int wr, int wc, int fr, int fq) const {
        const int col0 = u.nt * 128 + wc * 32 + 8 * fq;
        const float* bg = bgu + (size_t)u.e * 2048 + col0;
        const f32x4 bg0 = *(const f32x4*)(bg), bg1 = *(const f32x4*)(bg + 4), bl0 = *(const f32x4*)(bg + 1024), bl1 = *(const f32x4*)(bg + 1028);
#pragma unroll
        for (int ai = 0; ai < 2; ++ai)
#pragma unroll
            for (int m = 0; m < 4; ++m) { const int r = ai * HALF + wr * 64 + m * 16 + fr;
                bf16* rowp = Ab + ((size_t)u.e * ECAP + (size_t)u.mt * 256 + r) * 1024 + col0;
                float o[8];
#pragma unroll
                for (int n = 0; n < 2; ++n) { const f32x4 g4 = acc[ai][0][m][n] + (n ? bg1 : bg0), l4 = acc[ai][1][m][n] + (n ? bl1 : bl0);
#pragma unroll
                    for (int j = 0; j < 4; ++j) { const float g = fminf(g4[j], 7.0f), l = fminf(fmaxf(l4[j], -7.0f), 7.0f); o[n * 4 + j] = (l + 1.0f) * g * sigmoidf_(1.702f * g); } }
                *(v4u*)rowp = pack8(o); }
    }
};
struct EpiMoe2 {
    static constexpr bool PERM = true;
    bf16* Y; const float* bdn; const int* sdest; const float* sgate;
    __device__ __forceinline__ void operator()(const f32x4 (&acc)[2][2][4][2], const MoeUnit& u, int wr, int wc, int fr, int fq) const {
        const int col0 = u.nt * 256 + wc * 32 + 8 * fq;
        const float* bp = bdn + (size_t)u.e * 1024 + col0;
        int dest[2][4]; float gate[2][4];
#pragma unroll
        for (int ai = 0; ai < 2; ++ai)
#pragma unroll
            for (int m = 0; m < 4; ++m) { const int slot = u.mt * 256 + ai * HALF + wr * 64 + m * 16 + fr; const bool ok = slot < u.cnt; const int si = u.e * ECAP + (ok ? slot : 0);
                dest[ai][m] = ok ? sdest[si] : -1; gate[ai][m] = sgate[si]; }
        f32x4 bv[2][2];
#pragma unroll
        for (int bj = 0; bj < 2; ++bj)
#pragma unroll
            for (int n = 0; n < 2; ++n) bv[bj][n] = *(const f32x4*)(bp + bj * HALF + 4 * n);
#pragma unroll
        for (int ai = 0; ai < 2; ++ai)
#pragma unroll
            for (int m = 0; m < 4; ++m) {
                if (dest[ai][m] >= 0) { const float g = gate[ai][m]; bf16* rowp = Y + (size_t)dest[ai][m] * 1024 + col0;
#pragma unroll
                    for (int bj = 0; bj < 2; ++bj) { const f32x4 v0 = (acc[ai][bj][m][0] + bv[bj][0]) * g, v1 = (acc[ai][bj][m][1] + bv[bj][1]) * g;
                        v4u w; w.x = cvt_pk_bf16(v0[0], v0[1]); w.y = cvt_pk_bf16(v0[2], v0[3]); w.z = cvt_pk_bf16(v1[0], v1[1]); w.w = cvt_pk_bf16(v1[2], v1[3]);
                        *(v4u*)(rowp + bj * HALF) = w; } } }
    }
};
}

__device__ __forceinline__ void p0_transpose_item(const float* W, int K, int N, int nblk, bf16* WT, int item, int lane) {
    const int kb = item / nblk, nb = item % nblk, k0 = 64 * kb, n = 64 * nb + lane;
    const bool ok = n < N; const float* src = W + (size_t)k0 * N + (ok ? n : 0);
    float x[64];
#pragma unroll
    for (int j = 0; j < 64; ++j) x[j] = src[(size_t)j * N];
    bf16* dst = WT + (size_t)n * K + k0;
#pragma unroll
    for (int q = 0; q < 8; ++q) { v4u o; o.x = cvt_pk_bf16(x[8 * q], x[8 * q + 1]); o.y = cvt_pk_bf16(x[8 * q + 2], x[8 * q + 3]); o.z = cvt_pk_bf16(x[8 * q + 4], x[8 * q + 5]); o.w = cvt_pk_bf16(x[8 * q + 6], x[8 * q + 7]);
        if (!ok) o = (v4u){0u, 0u, 0u, 0u};
        *(v4u*)(dst + 8 * q) = o; }
}
__device__ __forceinline__ void cvt_rows(const float* src, bf16* dst, size_t n8, size_t i0, size_t stride) {
    for (size_t i = i0; i < n8; i += stride) { const f32x4 a = *(const f32x4*)(src + i * 8), b = *(const f32x4*)(src + i * 8 + 4);
        v4u o; o.x = cvt_pk_bf16(a.x, a.y); o.y = cvt_pk_bf16(a.z, a.w); o.z = cvt_pk_bf16(b.x, b.y); o.w = cvt_pk_bf16(b.z, b.w); *(v4u*)(dst + i * 8) = o; }
}
__device__ __forceinline__ void p0_prologue(Frame& F, const Args& A) {
    const int gw = F.vcu * NWAVES + F.wave, NGW = F.G * NWAVES;
    constexpr int I_IN = 16 * (NUP / 64), I_OUT = 16 * 16, I_GU = 16 * 32, I_DN = 16 * 16, I_PG = 16 * 16, I_PP = 4 * 16;
    constexpr int PER_LAYER = I_IN + I_OUT + NE * I_GU + NE * I_DN + I_PG + I_PP;
#pragma unroll 1
    for (int it = gw; it < DEPTH * PER_LAYER; it += NGW) {
        const int l = it / PER_LAYER; int r = it % PER_LAYER;
        const float* W; bf16* WT; int K = D, N = D, nblk = 16;
        if (r < I_IN) { W = KIN(I_WIN) + (size_t)l * D * NU; WT = WSP(bf16, WS_WIN_T) + (size_t)l * NUP * D; N = NU; nblk = NUP / 64; }
        else if ((r -= I_IN) < I_OUT) { W = KIN(I_WOUT) + (size_t)l * D * D; WT = WSP(bf16, WS_WOUT_T) + (size_t)l * D * D; }
        else if ((r -= I_OUT) < NE * I_GU) { const int e = r / I_GU; r %= I_GU; W = KIN(I_WGU) + ((size_t)l * NE + e) * D * 2048; WT = WSP(bf16, WS_WGU_T) + ((size_t)l * NE + e) * 2048 * D; N = 2048; nblk = 32; }
        else if ((r -= NE * I_GU) < NE * I_DN) { const int e = r / I_DN; r %= I_DN; W = KIN(I_WDN) + ((size_t)l * NE + e) * D * D; WT = WSP(bf16, WS_WDN_T) + ((size_t)l * NE + e) * D * D; }
        else if ((r -= NE * I_DN) < I_PG) { W = KIN(I_PGW) + (size_t)l * D * D; WT = WSP(bf16, WS_WPG_T) + (size_t)l * D * D; }
        else { r -= I_PG; W = KIN(I_PPJ) + (size_t)l * 256 * D; WT = WSP(bf16, WS_WPP_T) + (size_t)l * D * 256; K = 256; }
        p0_transpose_item(W, K, N, nblk, WT, r, F.lane);
    }
    const size_t gt = (size_t)F.vcu * (NWAVES * 64) + F.tid, NT_ = (size_t)F.G * NWAVES * 64;
    cvt_rows(KIN(I_P), WSP(bf16, WS_PB), (size_t)DEPTH * T * 256 / 8, gt, NT_);
    cvt_rows(KIN(I_X), WSP(bf16, WS_XB), (size_t)T * D / 8, gt, NT_);
    for (size_t i = gt; i < (size_t)DEPTH * LORA_PER_LAYER; i += NT_) { const int l = (int)(i / LORA_PER_LAYER); int r = (int)(i % LORA_PER_LAYER); float v;
        if (r < 8192) { const int ch = r >> 5, j = r & 31; v = KIN(I_RWUP)[(size_t)l * 8192 + j * 256 + ch]; }
        else if (r < 16384) { r -= 8192; const int ch = r >> 5, j = r & 31; v = KIN(I_RAUP)[(size_t)l * 8192 + j * 256 + ch]; }
        else if (r < 32768) { r -= 16384; const int ch = r >> 6, j = r & 63; v = KIN(I_RGUP)[(size_t)l * 16384 + j * 256 + ch]; }
        else { r -= 32768; const int d = r >> 4, j = r & 15; v = KIN(I_GGUP)[(size_t)l * 2048 + j * 128 + d]; }
        WSP(float, WS_LORA)[i] = v; }
    for (size_t i = gt; i < (size_t)DEPTH * NE * D; i += NT_) { const int l = (int)(i / (NE * D)), r = (int)(i % (NE * D)), e = r / D, k = r % D; WSP(float, WS_RWT)[i] = KIN(I_RTW)[(size_t)l * D * NE + (size_t)k * NE + e]; }
}

__device__ __forceinline__ void p6_ln1_router(Frame& F, const Args& A, int layer) {
    const float* y1 = WSP(float, WS_Y1); float* x1 = WSP(float, WS_X1); bf16* x1b = WSP(bf16, WS_X1B);
    const float* g = KIN(I_LN1G) + layer * D; const float* bb = KIN(I_LN1B) + layer * D;
    const float* rwt = WSP(float, WS_RWT) + (size_t)layer * NE * D; const float* rb = KIN(I_RTB) + layer * NE;
    int* sdest = WSP(int, WS_SDEST); float* sgate = WSP(float, WS_SGATE);
    unsigned* cnt = (unsigned*)(F.ctl + CW_CNT + layer * NE * 16);
    LAS float* RWT = (LAS float*)F.lds;
    volatile LAS unsigned* lcnt = F.MISC + MW_LCNT; volatile LAS unsigned* lbase = F.MISC + MW_LBASE;
    for (int i = F.tid; i < NE * D / 4; i += NWAVES * 64) ((LAS f32x4*)RWT)[i] = ((const f32x4*)rwt)[i];
    const int lane = F.lane;
    const f32x4 gv[4] = { *(const f32x4*)(g + 4 * lane), *(const f32x4*)(g + 256 + 4 * lane), *(const f32x4*)(g + 512 + 4 * lane), *(const f32x4*)(g + 768 + 4 * lane) };
    const f32x4 bv[4] = { *(const f32x4*)(bb + 4 * lane), *(const f32x4*)(bb + 256 + 4 * lane), *(const f32x4*)(bb + 512 + 4 * lane), *(const f32x4*)(bb + 768 + 4 * lane) };
    const float rbias = rb[lane >> 1];
    for (int blk = F.vcu; blk < T / 64; blk += F.G) {
        if (F.tid < 32) lcnt[F.tid] = 0u;
        __syncthreads();
        int my_e = 0; float my_g = 0.f; unsigned my_r = 0u;
#pragma unroll 1
        for (int ri = 0; ri < 8; ++ri) {
            const int row = blk * 64 + F.wave * 8 + ri;
            const float* yr = y1 + (size_t)row * D;
            f32x4 v[4]; float s = 0.f;
#pragma unroll
            for (int j = 0; j < 4; ++j) { v[j] = *(const f32x4*)(yr + 256 * j + 4 * lane); s += (v[j].x + v[j].y) + (v[j].z + v[j].w); }
            const float mean = wave_sum(s) * (1.f / D); float s2 = 0.f;
#pragma unroll
            for (int j = 0; j < 4; ++j) { v[j] = v[j] - mean; s2 += (v[j].x * v[j].x + v[j].y * v[j].y) + (v[j].z * v[j].z + v[j].w * v[j].w); }
            const float rstd = 1.0f / sqrtf(wave_sum(s2) * (1.f / D) + LN_EPS);
#pragma unroll
            for (int j = 0; j < 4; ++j) { v[j] = v[j] * rstd * gv[j] + bv[j];
                *(f32x4*)(x1 + (size_t)row * D + 256 * j + 4 * lane) = v[j];
                v2u o; o.x = cvt_pk_bf16(v[j].x, v[j].y); o.y = cvt_pk_bf16(v[j].z, v[j].w); *(v2u*)(x1b + (size_t)row * D + 256 * j + 4 * lane) = o; }
            float p[32];
#pragma unroll
            for (int e = 0; e < 32; ++e) { float a = 0.f;
#pragma unroll
                for (int j = 0; j < 4; ++j) { const f32x4 w = *(const LAS f32x4*)(RWT + e * D + 256 * j + 4 * lane); a += (v[j].x * w.x + v[j].y * w.y) + (v[j].z * w.z + v[j].w * w.w); }
                p[e] = a; }
#pragma unroll
            for (int i = 0; i < 16; ++i) { const bool hi = (lane & 32) != 0; const float keep = hi ? p[i + 16] : p[i], send = hi ? p[i] : p[i + 16]; p[i] = keep + __shfl_xor(send, 32); }
#pragma unroll
            for (int i = 0; i < 8; ++i) { const bool hi = (lane & 16) != 0; const float keep = hi ? p[i + 8] : p[i], send = hi ? p[i] : p[i + 8]; p[i] = keep + __shfl_xor(send, 16); }
#pragma unroll
            for (int i = 0; i < 4; ++i) { const bool hi = (lane & 8) != 0; const float keep = hi ? p[i + 4] : p[i], send = hi ? p[i] : p[i + 4]; p[i] = keep + __shfl_xor(send, 8); }
#pragma unroll
            for (int i = 0; i < 2; ++i) { const bool hi = (lane & 4) != 0; const float keep = hi ? p[i + 2] : p[i], send = hi ? p[i] : p[i + 2]; p[i] = keep + __shfl_xor(send, 4); }
            { const bool hi = (lane & 2) != 0; const float keep = hi ? p[1] : p[0], send = hi ? p[0] : p[1]; p[0] = keep + __shfl_xor(send, 2); }
            float logit = p[0] + __shfl_xor(p[0], 1) + rbias;
            float tv[4]; int te[4];
#pragma unroll
            for (int k = 0; k < 4; ++k) {
                float bvv = logit; int bi = lane >> 1;
#pragma unroll
                for (int o = 2; o < 64; o <<= 1) { const float ov = __shfl_xor(bvv, o); const int oi = __shfl_xor(bi, o); if (ov > bvv || (ov == bvv && oi < bi)) { bvv = ov; bi = oi; } }
                tv[k] = bvv; te[k] = bi; if ((lane >> 1) == bi) logit = -INFINITY;
            }
            const float e1 = __expf(tv[1] - tv[0]), e2 = __expf(tv[2] - tv[0]), e3 = __expf(tv[3] - tv[0]); const float inv = 1.0f / (1.0f + e1 + e2 + e3);
            const int kk = lane & 3;
            const int ek = kk == 0 ? te[0] : kk == 1 ? te[1] : kk == 2 ? te[2] : te[3];
            const float gk = (kk == 0 ? 1.0f : kk == 1 ? e1 : kk == 2 ? e2 : e3) * inv;
            if ((lane >> 2) == ri) { my_e = ek; my_g = gk; my_r = atomicAdd((unsigned*)&lcnt[ek], 1u); }
        }
        __syncthreads();
        if (F.tid < 32) { const unsigned n = lcnt[F.tid]; lbase[F.tid] = n ? __hip_atomic_fetch_add(cnt + F.tid * 16, n, RLX_AGENT) : 0u; }
        __syncthreads();
        if (lane < 32) { const int row = blk * 64 + F.wave * 8 + (lane >> 2); const unsigned slot = (unsigned)my_e * ECAP + lbase[my_e] + my_r;
            sdest[slot] = row * 4 + (lane & 3); sgate[slot] = my_g; }
        __syncthreads();
    }
}
__device__ __forceinline__ void p9_combine(Frame& F, const Args& A) {
    const float* x1 = WSP(float, WS_X1); const bf16* yb = WSP(bf16, WS_YBUF); float* h = WSP(float, WS_H); bf16* hb = WSP(bf16, WS_HB);
    const int gw = F.vcu * NWAVES + F.wave, NGW = F.G * NWAVES, lane = F.lane;
    for (int row = gw; row < T; row += NGW) {
        v4u y[4][2]; f32x4 xa[2][2];
#pragma unroll
        for (int j = 0; j < 2; ++j) {
#pragma unroll
            for (int k = 0; k < 4; ++k) y[k][j] = *(const v4u*)(yb + ((size_t)row * 4 + k) * D + 512 * j + 8 * lane);
            xa[j][0] = *(const f32x4*)(x1 + (size_t)row * D + 512 * j + 8 * lane); xa[j][1] = *(const f32x4*)(x1 + (size_t)row * D + 512 * j + 8 * lane + 4); }
#pragma unroll
        for (int j = 0; j < 2; ++j) { f32x4 v0 = xa[j][0] * DN_ALPHA, v1 = xa[j][1] * DN_ALPHA;
#pragma unroll
            for (int k = 0; k < 4; ++k) { const v4u w = y[k][j];
                v0 = v0 + (f32x4){__uint_as_float(w.x << 16), __uint_as_float(w.x & 0xffff0000u), __uint_as_float(w.y << 16), __uint_as_float(w.y & 0xffff0000u)};
                v1 = v1 + (f32x4){__uint_as_float(w.z << 16), __uint_as_float(w.z & 0xffff0000u), __uint_as_float(w.w << 16), __uint_as_float(w.w & 0xffff0000u)}; }
            const size_t o = (size_t)row * D + 512 * j + 8 * lane;
            *(f32x4*)(h + o) = v0; *(f32x4*)(h + o + 4) = v1;
            v4u wv; wv.x = cvt_pk_bf16(v0.x, v0.y); wv.y = cvt_pk_bf16(v0.z, v0.w); wv.z = cvt_pk_bf16(v1.x, v1.y); wv.w = cvt_pk_bf16(v1.z, v1.w); *(v4u*)(hb + o) = wv; }
    }
}
__device__ __forceinline__ void p11_ln2(Frame& F, const Args& A, int layer) {
    const float* h2 = WSP(float, WS_H2); bf16* xb = WSP(bf16, WS_XB);
    const float* g = KIN(I_LN2G) + layer * D; const float* bb = KIN(I_LN2B) + layer * D;
    const int gw = F.vcu * NWAVES + F.wave, NGW = F.G * NWAVES, lane = F.lane;
    for (int row = gw; row < T; row += NGW) {
        const float* yr = h2 + (size_t)row * D; f32x4 v[4]; float s = 0.f;
#pragma unroll
        for (int j = 0; j < 4; ++j) { v[j] = *(const f32x4*)(yr + 256 * j + 4 * lane); s += (v[j].x + v[j].y) + (v[j].z + v[j].w); }
        const float mean = wave_sum(s) * (1.f / D); float s2 = 0.f;
#pragma unroll
        for (int j = 0; j < 4; ++j) { v[j] = v[j] - mean; s2 += (v[j].x * v[j].x + v[j].y * v[j].y) + (v[j].z * v[j].z + v[j].w * v[j].w); }
        const float rstd = 1.0f / sqrtf(wave_sum(s2) * (1.f / D) + LN_EPS);
#pragma unroll
        for (int j = 0; j < 4; ++j) { const f32x4 gv = *(const f32x4*)(g + 256 * j + 4 * lane), bv = *(const f32x4*)(bb + 256 * j + 4 * lane);
            const f32x4 o = v[j] * rstd * gv + bv; const size_t off = (size_t)row * D + 256 * j + 4 * lane;
            *(f32x4*)(F.out + off) = o; v2u w; w.x = cvt_pk_bf16(o.x, o.y); w.y = cvt_pk_bf16(o.z, o.w); *(v2u*)(xb + off) = w; }
    }
}
__device__ __forceinline__ void moe_build_pfx(Frame& F, const Args& A, int layer, int NT) {
    volatile LAS unsigned* pfx = F.MISC + MW_PFX;
    __syncthreads();
    if (F.tid == 0) { unsigned acc = 0u;
        for (int e = 0; e < NE; ++e) { const unsigned c = __hip_atomic_load(F.ctl + CW_CNT + (layer * NE + e) * 16, RLX_AGENT); pfx[e] = acc; pfx[40 + e] = c; acc += ((c + 255u) >> 8) * (unsigned)NT; }
        pfx[32] = acc; }
    __syncthreads();
}
#define UU(t, col) bf2f(u[(size_t)(t) * NUP + (col)])
#define UU4(t, col) ldu4(u + (size_t)(t) * NUP + (col))
__device__ __forceinline__ f32x4 ldu4(const bf16* p) { const v2u w = *(const v2u*)p; return (f32x4){__uint_as_float(w.x << 16), __uint_as_float(w.x & 0xffff0000u), __uint_as_float(w.y << 16), __uint_as_float(w.y & 0xffff0000u)}; }
__device__ __forceinline__ void lds_st_bf16(LAS unsigned char* p, float v) { *(LAS unsigned short*)p = (unsigned short)(cvt_pk_bf16(v, 0.f) & 0xffffu); }
__device__ __forceinline__ void lds_st_bf16x4(LAS unsigned char* p, float a, float b, float c, float d) { v2u o; o.x = cvt_pk_bf16(a, b); o.y = cvt_pk_bf16(c, d); *(LAS v2u*)p = o; }

__device__ __forceinline__ void ssd_stage1(Frame& F, const Args& A, int layer, int b, int c) {
    const bf16* u = WSP(bf16, WS_U);
    LAS unsigned char* L = F.lds;
    LAS float* DT = (LAS float*)L; LAS float* AC = DT + 256;
    LAS unsigned char* BMT = L + 2048; LAS unsigned char* XCDT = BMT + 128 * 144;
    const int t0 = b * SEQ + c * 64, tid = F.tid, lane = F.lane, wave = F.wave;
    if (wave < 4) {
        const int hh = wave;
        const float dt = softplusf_(UU(t0 + lane, U_SSD_DT + hh) + KIN(I_SDTB)[layer * 4 + hh]);
        const float adt = -dt * __expf(KIN(I_SALOG)[layer * 4 + hh]);
        const float ac = wave_scan_add(adt, lane);
        DT[hh * 64 + lane] = dt; AC[hh * 64 + lane] = ac;
        if (lane == 63) WSP(float, WS_SSD_DEC)[(b * 4 + hh) * NCH + c] = __expf(ac);
    }
    __syncthreads();
    if (tid < 384) {
        const int cc = tid; const float* cw = KIN(I_SCW) + (size_t)layer * 2048 + cc; const float w0 = cw[0], w1 = cw[512], w2 = cw[1024], w3 = cw[1536], cb = KIN(I_SCB)[layer * 512 + cc];
        const bf16* up = u + (size_t)t0 * NUP + U_SSD_X + cc;
        float win0 = 0.f, win1 = 0.f, win2 = 0.f;
        if (c > 0) { win0 = bf2f(up[-3 * NUP]); win1 = bf2f(up[-2 * NUP]); win2 = bf2f(up[-1 * NUP]); }
        const int hh = (cc >> 6) & 3; const bool isx = cc < 256;
        LAS unsigned char* dst = isx ? XCDT + cc * 144 : BMT + (cc - 256) * 144;
        const float aclast = AC[hh * 64 + 63];
#pragma unroll 1
        for (int l0 = 0; l0 < 64; l0 += 32) {
            float xv[32];
#pragma unroll
            for (int j = 0; j < 32; ++j) xv[j] = bf2f(up[(l0 + j) * NUP]);
#pragma unroll
            for (int j8 = 0; j8 < 4; ++j8) { float o[8];
#pragma unroll
                for (int j = 0; j < 8; ++j) { const int l = l0 + j8 * 8 + j; const float x = xv[j8 * 8 + j]; const float y = cb + w0 * win0 + w1 * win1 + w2 * win2 + w3 * x; win0 = win1; win1 = win2; win2 = x;
                    float s = siluf_(y); if (isx) s *= DT[hh * 64 + l] * __expf(aclast - AC[hh * 64 + l]); o[j] = s; }
                *(LAS v4u*)(dst + (l0 + j8 * 8) * 2) = pack8(o); }
        }
    }
    __syncthreads();
    { const int fr = lane & 15, fq = lane >> 4; float* st = WSP(float, WS_SSD_ST);
#pragma unroll 1
      for (int i = 0; i < 2; ++i) { const int row0 = (2 * wave + i) * 16; const int hh = row0 >> 6, p = (row0 & 63) + fr;
          float* dstp = st + (((size_t)(b * 4 + hh) * NCH + c) * 64 + p) * 128;
#pragma unroll 1
          for (int ntl = 0; ntl < 8; ++ntl) { f32x4 acc = {0.f, 0.f, 0.f, 0.f}; acc = mm16(XCDT + row0 * 144, 144, BMT + ntl * 16 * 144, 144, 64, acc, fr, fq);
              *(f32x4*)(dstp + ntl * 16 + 4 * fq) = acc; } } }
    __syncthreads();
}
__device__ __forceinline__ void ssd_stage3(Frame& F, const Args& A, int layer, int b, int c) {
    const bf16* u = WSP(bf16, WS_U);
    LAS unsigned char* L = F.lds;
    LAS float* DT = (LAS float*)L; LAS float* AC = DT + 256;
    LAS unsigned char* CM = L + 2048; LAS unsigned char* BM = CM + 64 * 272; LAS unsigned char* XCT = BM + 64 * 272; LAS unsigned char* MM = XCT + 256 * 144;
    LAS unsigned char* YG = XCT;
    const int t0 = b * SEQ + c * 64, tid = F.tid, lane = F.lane, wave = F.wave, fr = lane & 15, fq = lane >> 4;
    if (wave < 4) {
        const int hh = wave;
        const float dt = softplusf_(UU(t0 + lane, U_SSD_DT + hh) + KIN(I_SDTB)[layer * 4 + hh]);
        const float adt = -dt * __expf(KIN(I_SALOG)[layer * 4 + hh]);
        DT[hh * 64 + lane] = dt; AC[hh * 64 + lane] = wave_scan_add(adt, lane);
    }
    __syncthreads();
    {
        const int cc = tid; const float* cw = KIN(I_SCW) + (size_t)layer * 2048 + cc; const float w0 = cw[0], w1 = cw[512], w2 = cw[1024], w3 = cw[1536], cb = KIN(I_SCB)[layer * 512 + cc];
        const bf16* up = u + (size_t)t0 * NUP + U_SSD_X + cc;
        float win0 = 0.f, win1 = 0.f, win2 = 0.f;
        if (c > 0) { win0 = bf2f(up[-3 * NUP]); win1 = bf2f(up[-2 * NUP]); win2 = bf2f(up[-1 * NUP]); }
        const int hh = (cc >> 6) & 3;
#pragma unroll 1
        for (int l0 = 0; l0 < 64; l0 += 32) {
            float xv[32];
#pragma unroll
            for (int j = 0; j < 32; ++j) xv[j] = bf2f(up[(l0 + j) * NUP]);
#pragma unroll
            for (int j8 = 0; j8 < 4; ++j8) { float o[8];
#pragma unroll
                for (int j = 0; j < 8; ++j) { const int l = l0 + j8 * 8 + j; const float x = xv[j8 * 8 + j]; const float y = cb + w0 * win0 + w1 * win1 + w2 * win2 + w3 * x; win0 = win1; win1 = win2; win2 = x;
                    float s = siluf_(y); if (cc < 256) s *= DT[hh * 64 + l]; o[j] = s; }
                if (cc < 256) *(LAS v4u*)(XCT + cc * 144 + (l0 + j8 * 8) * 2) = pack8(o);
                else { LAS unsigned char* d2 = (cc < 384 ? BM + (cc - 256) * 2 : CM + (cc - 384) * 2) + (l0 + j8 * 8) * 272;
#pragma unroll
                    for (int j = 0; j < 8; ++j) lds_st_bf16(d2 + j * 272, o[j]); } }
        }
    }
    __syncthreads();
#pragma unroll 1
    for (int i = 0; i < 2; ++i) { const int idx = 2 * wave + i, lt = idx >> 2, st = idx & 3;
        f32x4 acc = {0.f, 0.f, 0.f, 0.f}; acc = mm16(CM + lt * 16 * 272, 272, BM + st * 16 * 272, 272, 128, acc, fr, fq);
        const int l = lt * 16 + fr, s0 = st * 16 + 4 * fq;
#pragma unroll
        for (int hh = 0; hh < 4; ++hh) { const float al = AC[hh * 64 + l], dl = KIN(I_SD)[layer * 4 + hh] / DT[hh * 64 + l]; float o[4];
#pragma unroll
            for (int j = 0; j < 4; ++j) { const int s = s0 + j; float m = (l >= s) ? acc[j] * __expf(al - AC[hh * 64 + s]) : 0.f; if (l == s) m += dl; o[j] = m; }
            lds_st_bf16x4(MM + hh * 9216 + l * 144 + s0 * 2, o[0], o[1], o[2], o[3]); } }
    __syncthreads();
    f32x4 yv[2][4];
    { const int hh = wave >> 1; const float* prev = WSP(float, WS_SSD_ST) + ((size_t)(b * 4 + hh) * NCH + c) * 8192;
#pragma unroll
      for (int i = 0; i < 2; ++i) { const int lt = 2 * (wave & 1) + i, l = lt * 16 + fr; const float ea = __expf(AC[hh * 64 + l]);
#pragma unroll
          for (int pt = 0; pt < 4; ++pt) { f32x4 ad = {0.f, 0.f, 0.f, 0.f}, ao = {0.f, 0.f, 0.f, 0.f};
              ad = mm16(MM + hh * 9216 + lt * 16 * 144, 144, XCT + (hh * 64 + pt * 16) * 144, 144, 64, ad, fr, fq);
              ao = mm16_gB(CM + lt * 16 * 272, 272, prev + (size_t)(pt * 16) * 128, 128, 128, ao, fr, fq);
              const f32x4 z = UU4(t0 + l, U_SSD_Z + hh * 64 + pt * 16 + 4 * fq);
              f32x4 y = ad + ao * ea; y.x *= siluf_(z.x); y.y *= siluf_(z.y); y.z *= siluf_(z.z); y.w *= siluf_(z.w); yv[i][pt] = y; } } }
    __syncthreads();
    { const int hh = wave >> 1;
#pragma unroll
      for (int i = 0; i < 2; ++i) { const int l = (2 * (wave & 1) + i) * 16 + fr;
#pragma unroll
          for (int pt = 0; pt < 4; ++pt) *(LAS f32x4*)(YG + l * 1040 + (hh * 64 + pt * 16 + 4 * fq) * 4) = yv[i][pt]; } }
    __syncthreads();
    { const f32x4 g = *(const f32x4*)(KIN(I_SNG) + layer * 256 + 4 * lane); bf16* mix = WSP(bf16, WS_MIX);
#pragma unroll 1
      for (int i = 0; i < 8; ++i) { const int l = wave * 8 + i; const f32x4 y = *(const LAS f32x4*)(YG + l * 1040 + lane * 16);
          const float ss = wave_sum((y.x * y.x + y.y * y.y) + (y.z * y.z + y.w * y.w)); const float r = 1.0f / sqrtf(ss * (1.f / 256.f) + NORM_EPS);
          v2u o; o.x = cvt_pk_bf16(y.x * r * g.x, y.y * r * g.y); o.y = cvt_pk_bf16(y.z * r * g.z, y.w * r * g.w);
          *(v2u*)(mix + (size_t)(t0 + l) * D + 4 * lane) = o; } }
    __syncthreads();
}

__device__ __forceinline__ float gla_bcum(Frame& F, const Args& A, int layer, int d, const LAS float* GD, LAS float* BC) {
    float gup[16];
    { const f32x4* gp4 = (const f32x4*)(WSP(float, WS_LORA) + (size_t)layer * LORA_PER_LAYER + 32768 + d * 16);
#pragma unroll
      for (int i = 0; i < 4; ++i) { const f32x4 a = gp4[i]; gup[4 * i] = a.x; gup[4 * i + 1] = a.y; gup[4 * i + 2] = a.z; gup[4 * i + 3] = a.w; } }
    const float gb = KIN(I_GGB)[layer * 128 + d]; float bc = 0.f;
#pragma unroll 2
    for (int l = 0; l < 64; ++l) { float x = gb;
#pragma unroll
        for (int i = 0; i < 16; ++i) x += GD[l * 16 + i] * gup[i];
        bc += logsigmoidf_(x) * 0.0625f; BC[l * 128 + d] = bc; }
    return bc;
}
__device__ __forceinline__ void gla_stage1(Frame& F, const Args& A, int layer, int b, int c) {
    const bf16* u = WSP(bf16, WS_U);
    LAS unsigned char* L = F.lds;
    LAS float* GD = (LAS float*)L; LAS float* BC = (LAS float*)(L + 4096);
    LAS unsigned char* KDT = L + 36864; LAS unsigned char* VT = KDT + 128 * 144;
    const int t0 = b * SEQ + c * 64, tid = F.tid, lane = F.lane, wave = F.wave, fr = lane & 15, fq = lane >> 4;
    if (tid < 256) { const int l = tid >> 2, q4 = tid & 3; *(LAS f32x4*)(GD + l * 16 + q4 * 4) = UU4(t0 + l, U_GL_G + 4 * q4); }
    __syncthreads();
    if (tid < 128) {
        const int d = tid; const float blast = gla_bcum(F, A, layer, d, GD, BC);
        WSP(float, WS_GLA_DEC)[(size_t)(b * NCH + c) * 128 + d] = __expf(blast);
        const bf16* up = u + (size_t)t0 * NUP + U_GL_K + d;
#pragma unroll 1
        for (int l0 = 0; l0 < 64; l0 += 32) { float xv[32];
#pragma unroll
            for (int j = 0; j < 32; ++j) xv[j] = bf2f(up[(l0 + j) * NUP]);
#pragma unroll
            for (int j8 = 0; j8 < 4; ++j8) { float o[8];
#pragma unroll
                for (int j = 0; j < 8; ++j) { const int l = l0 + j8 * 8 + j; o[j] = xv[j8 * 8 + j] * __expf(blast - BC[l * 128 + d]); }
                *(LAS v4u*)(KDT + d * 144 + (l0 + j8 * 8) * 2) = pack8(o); } }
    } else if (tid < 384) {
        const int vch = tid - 128; const bf16* up = u + (size_t)t0 * NUP + U_GL_V + vch;
#pragma unroll 1
        for (int l0 = 0; l0 < 64; l0 += 32) { float xv[32];
#pragma unroll
            for (int j = 0; j < 32; ++j) xv[j] = bf2f(up[(l0 + j) * NUP]);
#pragma unroll
            for (int j8 = 0; j8 < 4; ++j8) { float o[8];
#pragma unroll
                for (int j = 0; j < 8; ++j) o[j] = xv[j8 * 8 + j];
                *(LAS v4u*)(VT + vch * 144 + (l0 + j8 * 8) * 2) = pack8(o); } }
    }
    __syncthreads();
    { float* st = WSP(float, WS_GLA_ST);
#pragma unroll 1
      for (int i = 0; i < 4; ++i) { const int idx = 4 * wave + i, hh = idx >> 3, dtl = (idx >> 2) & 1, vt = idx & 3;
          f32x4 acc = {0.f, 0.f, 0.f, 0.f}; acc = mm16(KDT + (hh * 32 + dtl * 16) * 144, 144, VT + (hh * 64 + vt * 16) * 144, 144, 64, acc, fr, fq);
          *(f32x4*)(st + (((size_t)(b * 4 + hh) * NCH + c) * 32 + dtl * 16 + fr) * 64 + vt * 16 + 4 * fq) = acc; } }
    __syncthreads();
}
__device__ __forceinline__ void gla_stage3(Frame& F, const Args& A, int layer, int b, int c) {
    const bf16* u = WSP(bf16, WS_U);
    LAS unsigned char* L = F.lds;
    LAS float* GD = (LAS float*)L; LAS float* BC = (LAS float*)(L + 4096); LAS unsigned char* ATT = L + 4096;
    LAS unsigned char* QD = L + 40960; LAS unsigned char* KI = QD + 64 * 272; LAS unsigned char* VT = KI + 64 * 272; LAS unsigned char* PVT = VT + 256 * 144;
    const int t0 = b * SEQ + c * 64, tid = F.tid, lane = F.lane, wave = F.wave, fr = lane & 15, fq = lane >> 4;
    if (tid < 256) { const int l = tid >> 2, q4 = tid & 3; *(LAS f32x4*)(GD + l * 16 + q4 * 4) = UU4(t0 + l, U_GL_G + 4 * q4); }
    __syncthreads();
    if (tid < 128) {
        const int d = tid; (void)gla_bcum(F, A, layer, d, GD, BC);
        const bf16* uq = u + (size_t)t0 * NUP + U_GL_Q + d; const bf16* uk = u + (size_t)t0 * NUP + U_GL_K + d;
#pragma unroll 1
        for (int l0 = 0; l0 < 64; l0 += 16) { float qv[16], kv[16];
#pragma unroll
            for (int j = 0; j < 16; ++j) { qv[j] = bf2f(uq[(l0 + j) * NUP]); kv[j] = bf2f(uk[(l0 + j) * NUP]); }
#pragma unroll
            for (int j = 0; j < 16; ++j) { const int l = l0 + j; const float bc = BC[l * 128 + d];
                lds_st_bf16(QD + l * 272 + d * 2, qv[j] * 0.17677669529663687f * __expf(bc)); lds_st_bf16(KI + l * 272 + d * 2, kv[j] * __expf(-bc)); } }
    } else if (tid < 384) {
        const int vch = tid - 128; const bf16* up = u + (size_t)t0 * NUP + U_GL_V + vch;
#pragma unroll 1
        for (int l0 = 0; l0 < 64; l0 += 32) { float xv[32];
#pragma unroll
            for (int j = 0; j < 32; ++j) xv[j] = bf2f(up[(l0 + j) * NUP]);
#pragma unroll
            for (int j8 = 0; j8 < 4; ++j8) { float o[8];
#pragma unroll
                for (int j = 0; j < 8; ++j) o[j] = xv[j8 * 8 + j];
                *(LAS v4u*)(VT + vch * 144 + (l0 + j8 * 8) * 2) = pack8(o); } }
    } else {
        const float* prev = WSP(float, WS_GLA_ST);
#pragma unroll 4
        for (int i = tid - 384; i < 8192; i += 128) { const int hh = i >> 11, dd = (i >> 6) & 31, vv = i & 63;
            lds_st_bf16(PVT + (hh * 64 + vv) * 80 + dd * 2, prev[((size_t)(b * 4 + hh) * NCH + c) * 2048 + dd * 64 + vv]); }
    }
    __syncthreads();
    const int hh = wave >> 1;
#pragma unroll 1
    for (int i = 0; i < 2; ++i) { const int tt = 2 * (wave & 1) + i, t = tt * 16 + fr;
#pragma unroll
        for (int st = 0; st < 4; ++st) { f32x4 acc = {0.f, 0.f, 0.f, 0.f}; acc = mm16(QD + tt * 16 * 272 + hh * 64, 272, KI + st * 16 * 272 + hh * 64, 272, 32, acc, fr, fq);
            const int s0 = st * 16 + 4 * fq;
            lds_st_bf16x4(ATT + hh * 9216 + t * 144 + s0 * 2, t >= s0 ? acc[0] : 0.f, t >= s0 + 1 ? acc[1] : 0.f, t >= s0 + 2 ? acc[2] : 0.f, t >= s0 + 3 ? acc[3] : 0.f); } }
    __syncthreads();
    { bf16* mix = WSP(bf16, WS_MIX); const float* ng = KIN(I_GNG) + layer * 256;
#pragma unroll 1
      for (int i = 0; i < 2; ++i) { const int tt = 2 * (wave & 1) + i, t = tt * 16 + fr; f32x4 ov[4]; float ss = 0.f;
#pragma unroll
          for (int vt = 0; vt < 4; ++vt) { f32x4 acc = {0.f, 0.f, 0.f, 0.f};
              acc = mm16(ATT + hh * 9216 + tt * 16 * 144, 144, VT + (hh * 64 + vt * 16) * 144, 144, 64, acc, fr, fq);
              acc = mm16(QD + tt * 16 * 272 + hh * 64, 272, PVT + (hh * 64 + vt * 16) * 80, 80, 32, acc, fr, fq);
              ov[vt] = acc; ss += (acc.x * acc.x + acc.y * acc.y) + (acc.z * acc.z + acc.w * acc.w); }
          ss += __shfl_xor(ss, 16); ss += __shfl_xor(ss, 32);
          const float r = 1.0f / sqrtf(ss * (1.f / 64.f) + NORM_EPS);
#pragma unroll
          for (int vt = 0; vt < 4; ++vt) { const int col = hh * 64 + vt * 16 + 4 * fq; const f32x4 g = *(const f32x4*)(ng + col); const f32x4 og = UU4(t0 + t, U_GL_OG + col);
              v2u o; o.x = cvt_pk_bf16(ov[vt].x * r * g.x * siluf_(og.x), ov[vt].y * r * g.y * siluf_(og.y)); o.y = cvt_pk_bf16(ov[vt].z * r * g.z * siluf_(og.z), ov[vt].w * r * g.w * siluf_(og.w));
              *(v2u*)(mix + (size_t)(t0 + t) * D + 512 + col) = o; } } }
    __syncthreads();
}

__device__ __forceinline__ void mlstm_stage1(Frame& F, const Args& A, int layer, int b, int c) {
    const bf16* u = WSP(bf16, WS_U);
    LAS unsigned char* L = F.lds;
    LAS float* WST = (LAS float*)L; LAS unsigned char* KT = L + 1024; LAS unsigned char* VWT = KT + 256 * 144;
    const int t0 = b * SEQ + c * 64, tid = F.tid, lane = F.lane, wave = F.wave, fr = lane & 15, fq = lane >> 4;
    if (wave < 4) {
        const int hh = wave;
        const float ig = UU(t0 + lane, U_ML_I + hh) + KIN(I_MIB)[layer * 4 + hh];
        const float lf = logsigmoidf_(UU(t0 + lane, U_ML_F + hh) + KIN(I_MFB)[layer * 4 + hh]);
        const float bc = wave_scan_add(lf, lane); const float blast = __shfl(bc, 63);
        const float ast = blast - bc + ig; const float mloc = wave_max(ast);
        WST[hh * 64 + lane] = __expf(ast - mloc);
        if (lane == 0) { WSP(float, WS_ML_BL)[(b * 4 + hh) * NCH + c] = blast; WSP(float, WS_ML_ML)[(b * 4 + hh) * NCH + c] = mloc; }
    } else {
        const int kch = tid - 256, cc = 256 + kch; const float* cw = KIN(I_MCW) + (size_t)layer * 2048 + cc; const float w0 = cw[0], w1 = cw[512], w2 = cw[1024], w3 = cw[1536], cb = KIN(I_MCB)[layer * 512 + cc];
        const bf16* up = u + (size_t)t0 * NUP + U_ML_K + kch;
        float win0 = 0.f, win1 = 0.f, win2 = 0.f;
        if (c > 0) { win0 = bf2f(up[-3 * NUP]); win1 = bf2f(up[-2 * NUP]); win2 = bf2f(up[-1 * NUP]); }
#pragma unroll 1
        for (int l0 = 0; l0 < 64; l0 += 32) { float xv[32];
#pragma unroll
            for (int j = 0; j < 32; ++j) xv[j] = bf2f(up[(l0 + j) * NUP]);
#pragma unroll
            for (int j8 = 0; j8 < 4; ++j8) { float o[8];
#pragma unroll
                for (int j = 0; j < 8; ++j) { const float x = xv[j8 * 8 + j]; const float y = cb + w0 * win0 + w1 * win1 + w2 * win2 + w3 * x; win0 = win1; win1 = win2; win2 = x; o[j] = siluf_(y); }
                *(LAS v4u*)(KT + kch * 144 + (l0 + j8 * 8) * 2) = pack8(o); } }
    }
    __syncthreads();
    if (tid < 256) {
        const int vch = tid, hh = vch >> 6; const bf16* up = u + (size_t)t0 * NUP + U_ML_V + vch;
#pragma unroll 1
        for (int l0 = 0; l0 < 64; l0 += 32) { float xv[32];
#pragma unroll
            for (int j = 0; j < 32; ++j) xv[j] = bf2f(up[(l0 + j) * NUP]);
#pragma unroll
            for (int j8 = 0; j8 < 4; ++j8) { float o[8];
#pragma unroll
                for (int j = 0; j < 8; ++j) o[j] = xv[j8 * 8 + j] * WST[hh * 64 + l0 + j8 * 8 + j];
                *(LAS v4u*)(VWT + vch * 144 + (l0 + j8 * 8) * 2) = pack8(o); } }
    } else {
        const int kch = tid - 256, hh = kch >> 6; float n = 0.f;
#pragma unroll 8
        for (int s = 0; s < 64; ++s) n += WST[hh * 64 + s] * bf2f(*(const LAS unsigned short*)(KT + kch * 144 + s * 2));
        WSP(float, WS_ML_N)[((size_t)(b * 4 + hh) * NCH + c) * 64 + (kch & 63)] = n;
    }
    __syncthreads();
    { float* cst = WSP(float, WS_ML_C); const int hh = wave >> 1;
#pragma unroll 1
      for (int i = 0; i < 2; ++i) { const int vt = 2 * (wave & 1) + i;
#pragma unroll 1
          for (int kt = 0; kt < 4; ++kt) { f32x4 acc = {0.f, 0.f, 0.f, 0.f}; acc = mm16(VWT + (hh * 64 + vt * 16) * 144, 144, KT + (hh * 64 + kt * 16) * 144, 144, 64, acc, fr, fq);
              *(f32x4*)(cst + (((size_t)(b * 4 + hh) * NCH + c) * 64 + vt * 16 + fr) * 64 + kt * 16 + 4 * fq) = acc; } } }
    __syncthreads();
}
__device__ __forceinline__ void mlstm_stage3(Frame& F, const Args& A, int layer, int b, int c) {
    const bf16* u = WSP(bf16, WS_U);
    LAS unsigned char* L = F.lds;
    LAS float* BCU = (LAS float*)L; LAS float* GG = BCU + 256; LAS float* MROW = BCU + 512; LAS float* WINT = BCU + 768; LAS float* NPV = BCU + 1024;
    LAS unsigned char* Q = L + 6144; LAS unsigned char* KK = Q + 64 * 528; LAS unsigned char* VT = KK + 64 * 528; LAS unsigned char* SC = VT + 256 * 144;
    const int t0 = b * SEQ + c * 64, tid = F.tid, lane = F.lane, wave = F.wave, fr = lane & 15, fq = lane >> 4;
    if (wave < 4) {
        const int hh = wave;
        const float ig = UU(t0 + lane, U_ML_I + hh) + KIN(I_MIB)[layer * 4 + hh];
        const float lf = logsigmoidf_(UU(t0 + lane, U_ML_F + hh) + KIN(I_MFB)[layer * 4 + hh]);
        const float bc = wave_scan_add(lf, lane); const float gg = ig - bc;
        const float mprev = WSP(float, WS_ML_M)[(b * 4 + hh) * NCH + c];
        const float minter = bc + mprev, mintra = bc + wave_scan_max(gg, lane), mrow = fmaxf(minter, mintra);
        BCU[hh * 64 + lane] = bc; GG[hh * 64 + lane] = gg; MROW[hh * 64 + lane] = mrow; WINT[hh * 64 + lane] = __expf(minter - mrow);
        NPV[hh * 64 + lane] = WSP(float, WS_ML_N)[((size_t)(b * 4 + hh) * NCH + c) * 64 + lane];
    }
    {
        const int cc = tid; const float* cw = KIN(I_MCW) + (size_t)layer * 2048 + cc; const float w0 = cw[0], w1 = cw[512], w2 = cw[1024], w3 = cw[1536], cb = KIN(I_MCB)[layer * 512 + cc];
        const bf16* up = u + (size_t)t0 * NUP + U_ML_Q + cc;
        float win0 = 0.f, win1 = 0.f, win2 = 0.f;
        if (c > 0) { win0 = bf2f(up[-3 * NUP]); win1 = bf2f(up[-2 * NUP]); win2 = bf2f(up[-1 * NUP]); }
        LAS unsigned char* dst = cc < 256 ? Q + cc * 2 : KK + (cc - 256) * 2; const float sc = cc < 256 ? 0.125f : 1.0f;
#pragma unroll 1
        for (int l0 = 0; l0 < 64; l0 += 32) { float xv[32];
#pragma unroll
            for (int j = 0; j < 32; ++j) xv[j] = bf2f(up[(l0 + j) * NUP]);
#pragma unroll
            for (int j = 0; j < 32; ++j) { const float x = xv[j]; const float y = cb + w0 * win0 + w1 * win1 + w2 * win2 + w3 * x; win0 = win1; win1 = win2; win2 = x; lds_st_bf16(dst + (l0 + j) * 528, siluf_(y) * sc); } }
        const int vch = tid & 255, lh = (tid >> 8) * 32; const bf16* uv = u + (size_t)(t0 + lh) * NUP + U_ML_V + vch;
        float xv[32];
#pragma unroll
        for (int j = 0; j < 32; ++j) xv[j] = bf2f(uv[j * NUP]);
#pragma unroll
        for (int j8 = 0; j8 < 4; ++j8) { float o[8];
#pragma unroll
            for (int j = 0; j < 8; ++j) o[j] = xv[j8 * 8 + j];
            *(LAS v4u*)(VT + vch * 144 + (lh + j8 * 8) * 2) = pack8(o); }
    }
    __syncthreads();
    { const int hh = wave >> 1; bf16* mix = WSP(bf16, WS_MIX); const float* ng = KIN(I_MNG) + layer * 256;
      const float* cprev = WSP(float, WS_ML_C) + ((size_t)(b * 4 + hh) * NCH + c) * 4096;
#pragma unroll 1
      for (int i = 0; i < 2; ++i) { const int tt = 2 * (wave & 1) + i, t = tt * 16 + fr;
          const float bt = BCU[hh * 64 + t] - MROW[hh * 64 + t]; float rs = 0.f;
#pragma unroll
          for (int st = 0; st < 4; ++st) { f32x4 acc = {0.f, 0.f, 0.f, 0.f}; acc = mm16(Q + tt * 16 * 528 + hh * 128, 528, KK + st * 16 * 528 + hh * 128, 528, 64, acc, fr, fq);
              const int s0 = st * 16 + 4 * fq; float o[4];
#pragma unroll
              for (int j = 0; j < 4; ++j) { const int s = s0 + j; const float v = (t >= s) ? acc[j] * __expf(bt + GG[hh * 64 + s]) : 0.f; o[j] = v; rs += v; }
              lds_st_bf16x4(SC + hh * 9216 + t * 144 + s0 * 2, o[0], o[1], o[2], o[3]); }
          rs += __shfl_xor(rs, 16); rs += __shfl_xor(rs, 32);
          float nq = 0.f;
#pragma unroll
          for (int j = 0; j < 16; ++j) nq += bf2f(*(const LAS unsigned short*)(Q + t * 528 + (hh * 64 + fq * 16 + j) * 2)) * NPV[hh * 64 + fq * 16 + j];
          nq += __shfl_xor(nq, 16); nq += __shfl_xor(nq, 32);
          const float wi = WINT[hh * 64 + t]; const float den = wi * nq + rs; const float dn = fmaxf(fabsf(den), __expf(-MROW[hh * 64 + t])); const float rdn = 1.0f / dn;
          LDS_WAIT();
          f32x4 hv[4]; float sm = 0.f;
#pragma unroll
          for (int vt = 0; vt < 4; ++vt) { f32x4 acc = {0.f, 0.f, 0.f, 0.f};
              acc = mm16_gB(Q + tt * 16 * 528 + hh * 128, 528, cprev + (size_t)(vt * 16) * 64, 64, 64, acc, fr, fq);
              acc = acc * wi;
              acc = mm16(SC + hh * 9216 + tt * 16 * 144, 144, VT + (hh * 64 + vt * 16) * 144, 144, 64, acc, fr, fq);
              const f32x4 og = UU4(t0 + t, U_ML_O + hh * 64 + vt * 16 + 4 * fq);
              f32x4 h; h.x = acc.x * rdn * sigmoidf_(og.x); h.y = acc.y * rdn * sigmoidf_(og.y); h.z = acc.z * rdn * sigmoidf_(og.z); h.w = acc.w * rdn * sigmoidf_(og.w);
              hv[vt] = h; sm += (h.x + h.y) + (h.z + h.w); }
          sm += __shfl_xor(sm, 16); sm += __shfl_xor(sm, 32);
          const float mean = sm * (1.f / 64.f); float sq = 0.f;
#pragma unroll
          for (int vt = 0; vt < 4; ++vt) { hv[vt] = hv[vt] - mean; sq += (hv[vt].x * hv[vt].x + hv[vt].y * hv[vt].y) + (hv[vt].z * hv[vt].z + hv[vt].w * hv[vt].w); }
          sq += __shfl_xor(sq, 16); sq += __shfl_xor(sq, 32);
          const float r = 1.0f / sqrtf(sq * (1.f / 64.f) + NORM_EPS);
#pragma unroll
          for (int vt = 0; vt < 4; ++vt) { const int col = hh * 64 + vt * 16 + 4 * fq; const f32x4 g = *(const f32x4*)(ng + col);
              v2u o; o.x = cvt_pk_bf16(hv[vt].x * r * g.x, hv[vt].y * r * g.y); o.y = cvt_pk_bf16(hv[vt].z * r * g.z, hv[vt].w * r * g.w);
              *(v2u*)(mix + (size_t)(t0 + t) * D + 768 + col) = o; } } }
    __syncthreads();
}

__device__ __forceinline__ void rwkv_stage1(Frame& F, const Args& A, int layer, int ub) {
    const bf16* u = WSP(bf16, WS_U);
    LAS unsigned char* L = F.lds;
    LAS float* LOWA = (LAS float*)L;
    LAS float* CUM = (LAS float*)(L + 16384);
    LAS float* AAB = CUM;
    LAS float* TOT = CUM;
    LAS unsigned char* M0 = L + 16384 + 16640;
#define RM(i) (M0 + (i) * 9216)
    LAS float* LOG = (LAS float*)RM(0);
    LAS float* GAMC = (LAS float*)(F.MISC + MW_GAMC);
    const int t0 = ub * 64, c = ub & 63, tid = F.tid, lane = F.lane, wave = F.wave;
    const float* mu = KIN(I_RMU) + layer * 896;
#ifndef RW_DUP
#define RW_DUP -1
#endif
#define RW_REP(k) for (int rep__ = 0; rep__ < ((RW_DUP == (k)) ? 2 : 1); ++rep__)
    RW_REP(0) {
    {
        const int l = tid >> 3, jq = tid & 7, t = t0 + l; const bool has_prev = (t & (SEQ - 1)) != 0;
        f32x4 cur[4], prv[4];
#pragma unroll
        for (int q = 0; q < 4; ++q) { cur[q] = UU4(t, U_RW_LO + jq * 16 + 4 * q); prv[q] = has_prev ? UU4(t - 1, U_RW_LO + jq * 16 + 4 * q) : (f32x4){0.f, 0.f, 0.f, 0.f}; }
#pragma unroll
        for (int q = 0; q < 4; ++q) { const f32x4 m4 = *(const f32x4*)(mu + 768 + jq * 16 + 4 * q); const f32x4 xs = cur[q] + (prv[q] - cur[q]) * m4; const int j = jq * 16 + 4 * q;
            f32x4 o;
            if (j < 32) { o.x = tanhf(xs.x); o.y = tanhf(xs.y); o.z = tanhf(xs.z); o.w = tanhf(xs.w); } else if (j < 64) o = xs; else { o.x = sigmoidf_(xs.x); o.y = sigmoidf_(xs.y); o.z = sigmoidf_(xs.z); o.w = sigmoidf_(xs.w); }
            if (j < 64) *(LAS f32x4*)(LOWA + l * 64 + j) = o; else *(LAS f32x4*)(LOG + l * 64 + j - 64) = o; }
    }
    __syncthreads();
    { const int ch = tid & 255, half = tid >> 8; float* RG = WSP(float, WS_RW_G);
      float gup[64];
      { const f32x4* gp4 = (const f32x4*)(WSP(float, WS_LORA) + (size_t)layer * LORA_PER_LAYER + 16384 + ch * 64);
#pragma unroll
        for (int j = 0; j < 16; ++j) { const f32x4 a = gp4[j]; gup[4 * j] = a.x; gup[4 * j + 1] = a.y; gup[4 * j + 2] = a.z; gup[4 * j + 3] = a.w; } }
#pragma unroll 2
      for (int li = 0; li < 32; ++li) { const int l = half * 32 + li; float g0 = 0.f, g1 = 0.f;
#pragma unroll
          for (int j = 0; j < 16; ++j) { const f32x4 x4 = *(const LAS f32x4*)(LOG + l * 64 + 4 * j); g0 += x4.x * gup[4 * j] + x4.y * gup[4 * j + 1]; g1 += x4.z * gup[4 * j + 2] + x4.w * gup[4 * j + 3]; }
          RG[(size_t)(t0 + l) * 256 + ch] = g0 + g1; } }
    __syncthreads();
    }
    const int b_ = ub >> 6;
#pragma unroll 1
    for (int hh = 0; hh < 4; ++hh) {
        int ch = lane, fr = lane & 15, fq = lane >> 4; asm volatile("" : "+v"(ch), "+v"(fr), "+v"(fq));
        const int tg = wave, cg = hh * 64 + ch; const size_t un = (size_t)(b_ * 4 + hh) * NCH + c;
        float rr[8], k2r[8], vr[8], ar[8], br[8], pl[8];
        RW_REP(1) {
            float wup[32], aup[32];
            { const f32x4* wp4 = (const f32x4*)(WSP(float, WS_LORA) + (size_t)layer * LORA_PER_LAYER + cg * 32); const f32x4* ap4 = (const f32x4*)(WSP(float, WS_LORA) + (size_t)layer * LORA_PER_LAYER + 8192 + cg * 32);
#pragma unroll
              for (int j = 0; j < 8; ++j) { const f32x4 a = wp4[j], b = ap4[j]; wup[4 * j] = a.x; wup[4 * j + 1] = a.y; wup[4 * j + 2] = a.z; wup[4 * j + 3] = a.w; aup[4 * j] = b.x; aup[4 * j + 1] = b.y; aup[4 * j + 2] = b.z; aup[4 * j + 3] = b.w; } }
            const float w0 = KIN(I_RW0)[layer * 256 + cg], a0 = KIN(I_RA0)[layer * 256 + cg], kkc = KIN(I_RKK)[layer * 256 + cg], kac = KIN(I_RKA)[layer * 256 + cg];
            const float mur = mu[cg], muk = mu[256 + cg], muv = mu[512 + cg];
            const int tb = t0 + tg * 8; const bool nop = (c == 0) && (tg == 0);
            float rp = nop ? 0.f : UU(tb - 1, U_RW_R + cg), kp = nop ? 0.f : UU(tb - 1, U_RW_K + cg), vp = nop ? 0.f : UU(tb - 1, U_RW_V + cg);
            float rc[8], kc[8], vc[8];
#pragma unroll
            for (int j = 0; j < 8; ++j) { rc[j] = UU(tb + j, U_RW_R + cg); kc[j] = UU(tb + j, U_RW_K + cg); vc[j] = UU(tb + j, U_RW_V + cg); }
            float* RW = WSP(float, WS_RW);
            float kk[8], al[8], n2[8], run = 0.f;
#pragma unroll
            for (int j = 0; j < 8; ++j) { const int l = tg * 8 + j;
                const float r = rc[j] + (rp - rc[j]) * mur, k = kc[j] + (kp - kc[j]) * muk, v = vc[j] + (vp - vc[j]) * muv; rp = rc[j]; kp = kc[j]; vp = vc[j];
                float wp = w0, ap = a0;
#pragma unroll
                for (int q = 0; q < 8; ++q) { const f32x4 lw4 = *(const LAS f32x4*)(LOWA + l * 64 + 4 * q), la4 = *(const LAS f32x4*)(LOWA + l * 64 + 32 + 4 * q);
                    wp += (lw4.x * wup[4 * q] + lw4.y * wup[4 * q + 1]) + (lw4.z * wup[4 * q + 2] + lw4.w * wup[4 * q + 3]); ap += (la4.x * aup[4 * q] + la4.y * aup[4 * q + 1]) + (la4.z * aup[4 * q + 2] + la4.w * aup[4 * q + 3]); }
                const float w = -softplusf_(-wp) - 0.5f; run += -__expf(w); pl[j] = run; al[j] = sigmoidf_(ap);
                kk[j] = k * kkc; n2[j] = kk[j] * kk[j];
                k2r[j] = k * (1.0f + (al[j] - 1.0f) * kac); rr[j] = r; vr[j] = v;
                float* o = RW + (size_t)(tb + j) * 768 + cg; o[0] = r; o[256] = k2r[j]; o[512] = v; }
#pragma unroll
            for (int i = 0; i < 4; ++i) { const bool hi = (ch & 32) != 0; const float keep = hi ? n2[i + 4] : n2[i], send = hi ? n2[i] : n2[i + 4]; n2[i] = keep + __shfl_xor(send, 32); }
#pragma unroll
            for (int i = 0; i < 2; ++i) { const bool hi = (ch & 16) != 0; const float keep = hi ? n2[i + 2] : n2[i], send = hi ? n2[i] : n2[i + 2]; n2[i] = keep + __shfl_xor(send, 16); }
            { const bool hi = (ch & 8) != 0; const float keep = hi ? n2[1] : n2[0], send = hi ? n2[0] : n2[1]; n2[0] = keep + __shfl_xor(send, 8); }
            n2[0] += __shfl_xor(n2[0], 4); n2[0] += __shfl_xor(n2[0], 2); n2[0] += __shfl_xor(n2[0], 1);
#pragma unroll
            for (int j = 0; j < 8; ++j) { const float tot = __builtin_bit_cast(float, __builtin_amdgcn_readlane(__builtin_bit_cast(int, n2[0]), ((j & 4) ? 32 : 0) + ((j & 2) ? 16 : 0) + ((j & 1) ? 8 : 0)));
                const float kkn = kk[j] / fmaxf(sqrtf(tot), 1e-12f); ar[j] = -kkn; br[j] = kkn * al[j]; }
            TOT[tg * 64 + ch] = run;
        }
        __syncthreads();
        RW_REP(3) {
            float off = 0.f, gC = 0.f;
#pragma unroll
            for (int g = 0; g < 8; ++g) { const float tv = TOT[g * 64 + ch]; gC += tv; if (g < tg) off += tv; }
            float oat[8], obb[8], okb[8], ov[8];
#pragma unroll
            for (int j = 0; j < 8; ++j) { const int l = tg * 8 + j; const float gt = off + pl[j], gm = j > 0 ? off + pl[j - 1] : off;
                const float at = ar[j] * __expf(gm), rt = rr[j] * __expf(gt), en = __expf(-gt), ec = __expf(gC - gt);
                lds_st_bf16(RM(0) + l * 144 + ch * 2, at); lds_st_bf16(RM(1) + l * 144 + ch * 2, rt); lds_st_bf16(RM(2) + l * 144 + ch * 2, br[j] * en); lds_st_bf16(RM(3) + l * 144 + ch * 2, k2r[j] * en);
                oat[j] = at; obb[j] = br[j] * ec; okb[j] = k2r[j] * ec; ov[j] = vr[j]; }
            *(LAS v4u*)(RM(4) + ch * 144 + tg * 16) = pack8(oat); *(LAS v4u*)(RM(5) + ch * 144 + tg * 16) = pack8(obb); *(LAS v4u*)(RM(6) + ch * 144 + tg * 16) = pack8(okb); *(LAS v4u*)(RM(7) + ch * 144 + tg * 16) = pack8(ov);
            if (tg == 0) GAMC[ch] = __expf(gC);
        }
        __syncthreads();
        RW_REP(4) {
            const int which = wave >> 1; const LAS unsigned char* Aop = which < 2 ? RM(0) : RM(1); const LAS unsigned char* Bop = (which & 1) ? RM(3) : RM(2);
#pragma unroll 1
            for (int i2 = 0; i2 < 2; ++i2) { const int tt = 2 * (wave & 1) + i2, t = tt * 16 + fr;
#pragma unroll
                for (int it = 0; it < 4; ++it) { f32x4 acc = {0.f, 0.f, 0.f, 0.f}; acc = mm16(Aop + tt * 16 * 144, 144, Bop + it * 16 * 144, 144, 64, acc, fr, fq);
                    const int i0 = it * 16 + 4 * fq; const int lim = which < 2 ? t : t + 1;
                    const float o0 = (i0 < lim) ? acc[0] : 0.f, o1 = (i0 + 1 < lim) ? acc[1] : 0.f, o2 = (i0 + 2 < lim) ? acc[2] : 0.f, o3 = (i0 + 3 < lim) ? acc[3] : 0.f;
#ifdef RW_CLAMP_AAK
                    float q0 = o0, q1 = o1, q2 = o2, q3 = o3;
                    if (which == 1) { q0 = fabsf(o0) < 1e30f ? o0 : 0.f; q1 = fabsf(o1) < 1e30f ? o1 : 0.f; q2 = fabsf(o2) < 1e30f ? o2 : 0.f; q3 = fabsf(o3) < 1e30f ? o3 : 0.f; }
                    if (which == 0) *(LAS f32x4*)(AAB + t * 64 + i0) = (f32x4){o0, o1, o2, o3};
                    else lds_st_bf16x4(RM(7 + which) + t * 144 + i0 * 2, q0, q1, q2, q3);
                    continue;
#endif
                    if (which == 0) { DBG_STAT(11, o0); DBG_STAT(11, o1); DBG_STAT(11, o2); DBG_STAT(11, o3); } if (which == 1) { DBG_STAT(12, o0); DBG_STAT(12, o1); DBG_STAT(12, o2); DBG_STAT(12, o3); } if (which == 2) { DBG_STAT(13, o0); DBG_STAT(13, o3); } if (which == 3) { DBG_STAT(14, o0); DBG_STAT(14, o3); }
                    if (which == 0) *(LAS f32x4*)(AAB + t * 64 + i0) = (f32x4){o0, o1, o2, o3};
                    else lds_st_bf16x4(RM(7 + which) + t * 144 + i0 * 2, o0, o1, o2, o3); } }
        }
        __syncthreads();
        RW_REP(5) {
#pragma unroll 1
            for (int i2 = 0; i2 < 2; ++i2) { const int idx = wave * 2 + i2, vt = idx >> 2, tt = idx & 3; f32x4 acc = {0.f, 0.f, 0.f, 0.f};
                acc = mm16(RM(7) + vt * 16 * 144, 144, RM(8) + tt * 16 * 144, 144, 64, acc, fr, fq);
                DBG_STAT(15, acc[0]); DBG_STAT(15, acc[1]); DBG_STAT(15, acc[2]); DBG_STAT(15, acc[3]);
                lds_st_bf16x4(RM(0) + (vt * 16 + fr) * 144 + (tt * 16 + 4 * fq) * 2, acc[0], acc[1], acc[2], acc[3]); }
        }
        RW_REP(8) if (wave == 0) {
            float x[64]; f32x4 rowq[16];
#pragma unroll
            for (int t = 0; t < 64; ++t) {
                f32x4 cur[16];
#pragma unroll
                for (int i4 = 0; i4 < (t + 3) / 4; ++i4) cur[i4] = rowq[i4];
                if (t + 1 < 64) {
#pragma unroll
                    for (int i4 = 0; i4 < (t + 4) / 4; ++i4) rowq[i4] = *(const LAS f32x4*)(AAB + (t + 1) * 64 + 4 * i4); }
                float a0 = (t == ch) ? 1.0f : 0.f, a1 = 0.f, a2 = 0.f, a3 = 0.f;
#pragma unroll
                for (int i4 = 0; i4 < (t + 3) / 4; ++i4) { const f32x4 q = cur[i4];
                    a0 += q.x * x[4 * i4]; if (4 * i4 + 1 < t) a1 += q.y * x[4 * i4 + 1]; if (4 * i4 + 2 < t) a2 += q.z * x[4 * i4 + 2]; if (4 * i4 + 3 < t) a3 += q.w * x[4 * i4 + 3]; }
                const float acc = (a0 + a1) + (a2 + a3);
                x[t] = acc; lds_st_bf16(RM(11) + t * 144 + ch * 2, acc); }
        }
        __syncthreads();
        RW_REP(6) {
            const int rt = wave >> 1;
#pragma unroll
            for (int i2 = 0; i2 < 2; ++i2) { const int tt = 2 * (wave & 1) + i2;
                f32x4 acc = {0.f, 0.f, 0.f, 0.f}; acc = mm16(RM(4) + rt * 16 * 144, 144, RM(11) + tt * 16 * 144, 144, 64, acc, fr, fq);
                DBG_STAT(17, acc[0]); DBG_STAT(17, acc[1]); DBG_STAT(17, acc[2]); DBG_STAT(17, acc[3]);
                lds_st_bf16x4(RM(2) + (rt * 16 + fr) * 144 + (tt * 16 + 4 * fq) * 2, acc[0], acc[1], acc[2], acc[3]);
                f32x4 ac2 = {0.f, 0.f, 0.f, 0.f}; ac2 = mm16(RM(0) + rt * 16 * 144, 144, RM(11) + tt * 16 * 144, 144, 64, ac2, fr, fq);
                DBG_STAT(18, ac2[0]); DBG_STAT(18, ac2[1]); DBG_STAT(18, ac2[2]); DBG_STAT(18, ac2[3]);
                lds_st_bf16x4(RM(3) + (rt * 16 + fr) * 144 + (tt * 16 + 4 * fq) * 2, ac2[0], ac2[1], ac2[2], ac2[3]); }
        }
        __syncthreads();
        RW_REP(7) {
            const int which = wave >> 1;
#pragma unroll 1
            for (int i2 = 0; i2 < 2; ++i2) { const int rt = 2 * (wave & 1) + i2, row = rt * 16 + fr;
#pragma unroll
                for (int ct = 0; ct < 4; ++ct) { f32x4 acc = {0.f, 0.f, 0.f, 0.f}; const int c0 = ct * 16 + 4 * fq;
                    if (which == 0) { acc = mm16(RM(9) + rt * 16 * 144, 144, RM(2) + ct * 16 * 144, 144, 64, acc, fr, fq);
                        const v2u rw = *(const LAS v2u*)(RM(1) + row * 144 + c0 * 2);
                        acc[0] += __uint_as_float(rw.x << 16); acc[1] += __uint_as_float(rw.x & 0xffff0000u); acc[2] += __uint_as_float(rw.y << 16); acc[3] += __uint_as_float(rw.y & 0xffff0000u);
                        DBG_STAT(19, acc[0]); DBG_STAT(19, acc[1]); DBG_STAT(19, acc[2]); DBG_STAT(19, acc[3]);
                        v2u o; o.x = cvt_pk_bf16(acc[0], acc[1]); o.y = cvt_pk_bf16(acc[2], acc[3]); *(v2u*)(WSP(bf16, WS_RW_RH) + un * 4096 + row * 64 + c0) = o; }
                    else if (which == 1) {
#ifndef RW_NO_U0
                        acc = mm16(RM(9) + rt * 16 * 144, 144, RM(3) + ct * 16 * 144, 144, 64, acc, fr, fq);
#endif
                        acc = mm16(RM(10) + rt * 16 * 144, 144, RM(7) + ct * 16 * 144, 144, 64, acc, fr, fq);
                        DBG_STAT(20, acc[0]); DBG_STAT(20, acc[1]); DBG_STAT(20, acc[2]); DBG_STAT(20, acc[3]);
                        *(f32x4*)(WSP(float, WS_RW_O0) + un * 4096 + row * 64 + c0) = acc; }
                    else if (which == 2) { acc = mm16(RM(5) + rt * 16 * 144, 144, RM(2) + ct * 16 * 144, 144, 64, acc, fr, fq);
                        const float gd = GAMC[row]; if (row == c0) acc[0] += gd; if (row == c0 + 1) acc[1] += gd; if (row == c0 + 2) acc[2] += gd; if (row == c0 + 3) acc[3] += gd;
                        DBG_STAT(21, acc[0]); DBG_STAT(21, acc[1]); DBG_STAT(21, acc[2]); DBG_STAT(21, acc[3]);
                        v2u o; o.x = cvt_pk_bf16(acc[0], acc[1]); o.y = cvt_pk_bf16(acc[2], acc[3]);
                        *(v2u*)((unsigned char*)(WSP(bf16, WS_RW_GF) + un * 4096) + ((rt * 2 + (ct >> 1)) * 64 + ch) * 16 + (ct & 1) * 8) = o; }
                    else { acc = mm16(RM(3) + rt * 16 * 144, 144, RM(5) + ct * 16 * 144, 144, 64, acc, fr, fq); acc = mm16(RM(7) + rt * 16 * 144, 144, RM(6) + ct * 16 * 144, 144, 64, acc, fr, fq);
                        DBG_STAT(22, acc[0]); DBG_STAT(22, acc[1]); DBG_STAT(22, acc[2]); DBG_STAT(22, acc[3]);
                        *(f32x4*)(WSP(float, WS_RW_HT) + un * 4096 + row * 64 + c0) = acc; } } }
        }
        __syncthreads();
    }
#undef RM
}
__device__ __forceinline__ void rwkv_scan_wave(Frame& F, const Args& A, int wslot) {
    const int lane = F.lane, fr = lane & 15, fq = lane >> 4, bh = wslot >> 2, v0 = (wslot & 3) * 16;
    const bf16* GF = WSP(bf16, WS_RW_GF) + (size_t)bh * NCH * 4096; const float* HT = WSP(float, WS_RW_HT) + (size_t)bh * NCH * 4096 + (size_t)(v0 + fr) * 64 + 4 * fq;
    bf16* PT = WSP(bf16, WS_RW_PT) + (size_t)bh * NCH * 4096 + (size_t)(v0 + fr) * 64 + 4 * fq;
    f32x4 P[4] = {{0.f, 0.f, 0.f, 0.f}, {0.f, 0.f, 0.f, 0.f}, {0.f, 0.f, 0.f, 0.f}, {0.f, 0.f, 0.f, 0.f}};
    bf16x8 ga[4][2]; f32x4 hv[4];
#define RW2_LOAD(cc) do { _Pragma("unroll") for (int m = 0; m < 4; ++m) { hv[m] = *(const f32x4*)(HT + (size_t)(cc) * 4096 + 16 * m); \
        _Pragma("unroll") for (int s = 0; s < 2; ++s) ga[m][s] = *(const bf16x8*)(GF + (size_t)(cc) * 4096 + ((m * 2 + s) * 64 + lane) * 8); } } while (0)
    RW2_LOAD(0);
#pragma unroll 1
    for (int c = 0; c < NCH; ++c) {
        bf16x8 gc[4][2]; f32x4 acc[4];
#pragma unroll
        for (int m = 0; m < 4; ++m) { acc[m] = hv[m]; gc[m][0] = ga[m][0]; gc[m][1] = ga[m][1]; }
        if (c + 1 < NCH) RW2_LOAD(c + 1);
        v4u bs[2];
#pragma unroll
        for (int s = 0; s < 2; ++s) { bs[s].x = cvt_pk_bf16(P[2 * s][0], P[2 * s][1]); bs[s].y = cvt_pk_bf16(P[2 * s][2], P[2 * s][3]); bs[s].z = cvt_pk_bf16(P[2 * s + 1][0], P[2 * s + 1][1]); bs[s].w = cvt_pk_bf16(P[2 * s + 1][2], P[2 * s + 1][3]); }
        *(v2u*)(PT + (size_t)c * 4096) = (v2u){bs[0].x, bs[0].y}; *(v2u*)(PT + (size_t)c * 4096 + 16) = (v2u){bs[0].z, bs[0].w};
        *(v2u*)(PT + (size_t)c * 4096 + 32) = (v2u){bs[1].x, bs[1].y}; *(v2u*)(PT + (size_t)c * 4096 + 48) = (v2u){bs[1].z, bs[1].w};
#pragma unroll
        for (int m = 0; m < 4; ++m) { acc[m] = __builtin_amdgcn_mfma_f32_16x16x32_bf16(gc[m][0], __builtin_bit_cast(bf16x8, bs[0]), acc[m], 0, 0, 0);
            acc[m] = __builtin_amdgcn_mfma_f32_16x16x32_bf16(gc[m][1], __builtin_bit_cast(bf16x8, bs[1]), acc[m], 0, 0, 0); P[m] = acc[m]; DBG_STAT(23, acc[m][0]); DBG_STAT(23, acc[m][1]); DBG_STAT(23, acc[m][2]); DBG_STAT(23, acc[m][3]); }
    }
#undef RW2_LOAD
}
__device__ __forceinline__ void rwkv_stage3(Frame& F, const Args& A, int layer, int ub) {
    const int t0 = ub * 64, b_ = ub >> 6, c = ub & 63, lane = F.lane, wave = F.wave, fr = lane & 15, fq = lane >> 4, hh = wave >> 1;
    const size_t un = (size_t)(b_ * 4 + hh) * NCH + c;
    const bf16* RH = WSP(bf16, WS_RW_RH) + un * 4096; const bf16* PT = WSP(bf16, WS_RW_PT) + un * 4096; const float* O0 = WSP(float, WS_RW_O0) + un * 4096;
    const float* RW = WSP(float, WS_RW); const float* RG = WSP(float, WS_RW_G); bf16* mix = WSP(bf16, WS_MIX);
    const float* lg = KIN(I_RLNG) + layer * 256 + hh * 64; const float* lb = KIN(I_RLNB) + layer * 256 + hh * 64; const float* rk = KIN(I_RRK) + layer * 256 + hh * 64;
#pragma unroll 1
    for (int i = 0; i < 2; ++i) { const int tt = 2 * (wave & 1) + i, tl = tt * 16 + fr, t = t0 + tl;
        f32x4 ov[4]; float sm = 0.f;
#pragma unroll
        for (int vt = 0; vt < 4; ++vt) { f32x4 acc = *(const f32x4*)(O0 + tl * 64 + vt * 16 + 4 * fq);
#ifndef RW_NO_STATE
            acc = mm16_gAB(RH + tt * 16 * 64, 64, PT + vt * 16 * 64, 64, 64, acc, fr, fq);
#endif
            ov[vt] = acc; DBG_STAT(24, acc[0]); DBG_STAT(24, acc[1]); DBG_STAT(24, acc[2]); DBG_STAT(24, acc[3]); sm += (acc.x + acc.y) + (acc.z + acc.w); }
        sm += __shfl_xor(sm, 16); sm += __shfl_xor(sm, 32);
        const float mean = sm * (1.f / 64.f); float sq = 0.f;
#pragma unroll
        for (int vt = 0; vt < 4; ++vt) { ov[vt] = ov[vt] - mean; sq += (ov[vt].x * ov[vt].x + ov[vt].y * ov[vt].y) + (ov[vt].z * ov[vt].z + ov[vt].w * ov[vt].w); }
        sq += __shfl_xor(sq, 16); sq += __shfl_xor(sq, 32);
        const float rs = 1.0f / sqrtf(sq * (1.f / 64.f) + RWKV_GN_EPS);
        float bd = 0.f;
#pragma unroll
        for (int q = 0; q < 4; ++q) { const f32x4 r4 = *(const f32x4*)(RW + (size_t)t * 768 + hh * 64 + fq * 16 + 4 * q), k4 = *(const f32x4*)(RW + (size_t)t * 768 + 256 + hh * 64 + fq * 16 + 4 * q), c4 = *(const f32x4*)(rk + fq * 16 + 4 * q);
            bd += (r4.x * k4.x * c4.x + r4.y * k4.y * c4.y) + (r4.z * k4.z * c4.z + r4.w * k4.w * c4.w); }
        bd += __shfl_xor(bd, 16); bd += __shfl_xor(bd, 32);
#pragma unroll
        for (int vt = 0; vt < 4; ++vt) { const int col = vt * 16 + 4 * fq; const f32x4 g4 = *(const f32x4*)(lg + col), b4 = *(const f32x4*)(lb + col);
            const f32x4 v4 = *(const f32x4*)(RW + (size_t)t * 768 + 512 + hh * 64 + col), gg = *(const f32x4*)(RG + (size_t)t * 256 + hh * 64 + col);
            float e0 = (ov[vt].x * rs * g4.x + b4.x + bd * v4.x) * gg.x, e1 = (ov[vt].y * rs * g4.y + b4.y + bd * v4.y) * gg.y, e2 = (ov[vt].z * rs * g4.z + b4.z + bd * v4.z) * gg.z, e3 = (ov[vt].w * rs * g4.w + b4.w + bd * v4.w) * gg.w;
#ifdef RW_SANITIZE
            e0 = (fabsf(e0) < 1e30f) ? e0 : 0.f; e1 = (fabsf(e1) < 1e30f) ? e1 : 0.f; e2 = (fabsf(e2) < 1e30f) ? e2 : 0.f; e3 = (fabsf(e3) < 1e30f) ? e3 : 0.f;
#endif
            v2u o; o.x = cvt_pk_bf16(e0, e1); o.y = cvt_pk_bf16(e2, e3);
            *(v2u*)(mix + (size_t)t * D + 256 + hh * 64 + col) = o; } }
}

__device__ __forceinline__ void scans_elementwise(Frame& F, const Args& A) {
    const int nthr = F.G * 448, gt = F.vcu * 448 + (F.tid - 64);
    constexpr int N_SSD = 16 * 64 * 128, N_GLA = 16 * 32 * 64, N_MLC = 16 * 64 * 64, N_MLN = 16 * 64;
    for (int i = gt; i < N_SSD + N_GLA + N_MLC + N_MLN; i += nthr) {
        if (i < N_SSD) { const int bh = i >> 13, pn = i & 8191; float* base = WSP(float, WS_SSD_ST) + (size_t)bh * NCH * 8192 + pn; const float* dec = WSP(float, WS_SSD_DEC) + bh * NCH; float S = 0.f;
#pragma unroll 1
            for (int c0 = 0; c0 < NCH; c0 += 8) { float x[8], dd[8];
#pragma unroll
                for (int j = 0; j < 8; ++j) { x[j] = base[(size_t)(c0 + j) * 8192]; dd[j] = dec[c0 + j]; }
#pragma unroll
                for (int j = 0; j < 8; ++j) { base[(size_t)(c0 + j) * 8192] = S; S = dd[j] * S + x[j]; } }
        } else if (i < N_SSD + N_GLA) { const int k = i - N_SSD, bh = k >> 11, dv = k & 2047, dd_ = dv >> 6, b = bh >> 2, hh = bh & 3; float* base = WSP(float, WS_GLA_ST) + (size_t)bh * NCH * 2048 + dv; const float* dec = WSP(float, WS_GLA_DEC) + (size_t)b * NCH * 128 + hh * 32 + dd_; float S = 0.f;
#pragma unroll 1
            for (int c0 = 0; c0 < NCH; c0 += 8) { float x[8], dd[8];
#pragma unroll
                for (int j = 0; j < 8; ++j) { x[j] = base[(size_t)(c0 + j) * 2048]; dd[j] = dec[(c0 + j) * 128]; }
#pragma unroll
                for (int j = 0; j < 8; ++j) { base[(size_t)(c0 + j) * 2048] = S; S = dd[j] * S + x[j]; } }
        } else { const int k = i - N_SSD - N_GLA; const bool isn = k >= N_MLC; const int kk = isn ? k - N_MLC : k; const int bh = isn ? (kk >> 6) : (kk >> 12), e = isn ? (kk & 63) : (kk & 4095), str = isn ? 64 : 4096;
            float* base = (isn ? WSP(float, WS_ML_N) : WSP(float, WS_ML_C)) + (size_t)bh * NCH * str + e; const float* bl = WSP(float, WS_ML_BL) + bh * NCH; const float* ml = WSP(float, WS_ML_ML) + bh * NCH; float* mo = WSP(float, WS_ML_M) + bh * NCH;
            float S = 0.f, m = 0.f;
#pragma unroll 1
            for (int c0 = 0; c0 < NCH; c0 += 8) { float x[8], b8[8], m8[8];
#pragma unroll
                for (int j = 0; j < 8; ++j) { x[j] = base[(size_t)(c0 + j) * str]; b8[j] = bl[c0 + j]; m8[j] = ml[c0 + j]; }
#pragma unroll
                for (int j = 0; j < 8; ++j) { const float mn = fmaxf(b8[j] + m, m8[j]); const float so = __expf(b8[j] + m - mn), sn = __expf(m8[j] - mn);
                    base[(size_t)(c0 + j) * str] = S; if (!isn && e == 0) mo[c0 + j] = m; S = so * S + sn * x[j]; m = mn; } }
        }
    }
}
#ifndef MK_PER_PHASE_LAUNCH
#define MK_PER_PHASE_LAUNCH 0
#endif
#ifndef PH_MASK
#define PH_MASK 0xFFF
#endif
#ifndef ST_MASK
#define ST_MASK 0xF
#endif
#define ST_ON(k) (((ST_MASK) >> (k)) & 1)
#ifndef DUP_MASK
#define DUP_MASK 0
#endif
#define DUP_N(k) ((((DUP_MASK) >> (k)) & 1) ? 2 : 1)
#ifndef ST_DUP
#define ST_DUP 0
#endif
#define ST_REP(ty) ((((ST_DUP) >> (ty)) & 1) ? 2 : 1)
#define PH_ON(k) (((PH_MASK) >> (k)) & 1)
constexpr int PH_PER_LAYER = 11, N_PHASES = 1 + DEPTH * PH_PER_LAYER;
__global__ void __launch_bounds__(NWAVES * 64, 2) fwd_kernel(Args args) {
    extern __shared__ __attribute__((aligned(16))) unsigned char lds[];
    Frame F;
    F.lds = (LAS unsigned char*)lds;
    F.MISC = (volatile LAS unsigned*)(F.lds + MISC_OFF);
    F.tid = threadIdx.x; F.lane = F.tid & 63; F.wave = __builtin_amdgcn_readfirstlane(F.tid >> 6);
    F.G = gridDim.x; { const int bx = blockIdx.x; F.vcu = (F.G % 8 == 0) ? (bx % 8) * (F.G / 8) + bx / 8 : bx; }
    F.ka = (karg_t)__builtin_amdgcn_kernarg_segment_ptr(); F.ws = args.ws; F.ctl = (gu32*)(args.ws + WS_CTL); F.out = args.out;
    for (int i = F.tid; i < 256; i += NWAVES * 64) F.MISC[i] = 0u;
    __syncthreads();
    const int lo = args.ph_lo, hi = args.ph_hi;
    XcdBarrier bar; bar.bar = (unsigned*)(F.ctl + CW_BAR); bar.x = 0; bar.st = nullptr;
    if (hi - lo > 1) bar = xcd_barrier_post((unsigned*)(F.ctl + CW_BAR), F.MISC + MW_BAR);
#define IN_(k) (lo <= (k) && (k) < hi)
#define SEAM(k) do { if (IN_(k) && IN_((k) + 1)) xcd_barrier(bar); } while (0)

    if (PH_ON(11) && IN_(0)) { for (int rep_ = 0; rep_ < DUP_N(11); ++rep_) { frame_refresh(F); p0_prologue(F, args); } SEAM(0); }
#pragma unroll 1
    for (int layer = 0; layer < DEPTH; ++layer) {
        const int pb = 1 + layer * PH_PER_LAYER;
        if (PH_ON(0) && IN_(pb + 0)) { for (int rep_ = 0; rep_ < DUP_N(0); ++rep_) { frame_refresh(F);
            { pg8::DenseSched S; S.init(WSP(bf16, WS_XB), WSP(bf16, WS_WIN_T) + (size_t)layer * NUP * D, T, NUP, D, F.G, (int)blockIdx.x);
              pg8::EpiB16 E{WSP(bf16, WS_U), NUP};
              pg8::gemm_phase<pg8::EpiB16, pg8::DenseSched>(F.lds, F.tid, S, E); }
            { pg8::DenseSched S; S.init(WSP(bf16, WS_PB) + (size_t)layer * T * 256, WSP(bf16, WS_WPP_T) + (size_t)layer * D * 256, T, D, 256, F.G, (int)blockIdx.x);
              pg8::EpiF32 E{WSP(float, WS_PE), D, nullptr, 0.f};
              pg8::gemm_phase<pg8::EpiF32, pg8::DenseSched>(F.lds, F.tid, S, E); }
            } SEAM(pb + 0);
        }
        if (PH_ON(1) && IN_(pb + 1)) { for (int rep_ = 0; rep_ < DUP_N(1); ++rep_) { frame_refresh(F);
            for (int un = F.vcu; un < 1024; un += F.G) { frame_refresh(F); const int ty = un >> 8, r = un & 255, b = r >> 6, c = r & 63;
                if (ty == 0) { ssd_stage1(F, args, layer, b, c); if (ST_DUP & 1) ssd_stage1(F, args, layer, b, c); } else if (ty == 1) { gla_stage1(F, args, layer, b, c); if (ST_DUP & 2) gla_stage1(F, args, layer, b, c); } else if (ty == 2) { mlstm_stage1(F, args, layer, b, c); if (ST_DUP & 4) mlstm_stage1(F, args, layer, b, c); } else { rwkv_stage1(F, args, layer, r); if (ST_DUP & 8) rwkv_stage1(F, args, layer, r); } }
            } SEAM(pb + 1);
        }
        if (PH_ON(2) && IN_(pb + 2)) { for (int rep_ = 0; rep_ < DUP_N(2); ++rep_) { frame_refresh(F);
            if (F.wave == 0) { for (int ws_ = F.vcu; ws_ < 64; ws_ += F.G) rwkv_scan_wave(F, args, ws_); }
            else if (rep_ == 0) scans_elementwise(F, args);
            } SEAM(pb + 2);
        }
        if (PH_ON(3) && IN_(pb + 3)) { for (int rep_ = 0; rep_ < DUP_N(3); ++rep_) { frame_refresh(F);
            for (int un = F.vcu; un < 1024; un += F.G) { frame_refresh(F); const int ty = un >> 8, r = un & 255, b = r >> 6, c = r & 63;
                if (ty == 0) { ssd_stage3(F, args, layer, b, c); if (ST_DUP & 16) ssd_stage3(F, args, layer, b, c); } else if (ty == 1) { gla_stage3(F, args, layer, b, c); if (ST_DUP & 32) gla_stage3(F, args, layer, b, c); } else if (ty == 2) { mlstm_stage3(F, args, layer, b, c); if (ST_DUP & 64) mlstm_stage3(F, args, layer, b, c); } else { rwkv_stage3(F, args, layer, r); if (ST_DUP & 128) rwkv_stage3(F, args, layer, r); } }
            } SEAM(pb + 3);
        }
        if (PH_ON(4) && IN_(pb + 4)) { for (int rep_ = 0; rep_ < DUP_N(4); ++rep_) { frame_refresh(F);
            pg8::DenseSched S; S.init(WSP(bf16, WS_MIX), WSP(bf16, WS_WOUT_T) + (size_t)layer * D * D, T, D, D, F.G, (int)blockIdx.x);
            pg8::EpiF32 E{WSP(float, WS_Y1), D, layer == 0 ? KIN(I_X) : (const float*)F.out, DN_ALPHA};
            pg8::gemm_phase<pg8::EpiF32, pg8::DenseSched>(F.lds, F.tid, S, E);
            } SEAM(pb + 4);
        }
        if (PH_ON(5) && IN_(pb + 5)) { for (int rep_ = 0; rep_ < DUP_N(5); ++rep_) { frame_refresh(F); p6_ln1_router(F, args, layer); } SEAM(pb + 5); }
        if (PH_ON(6) && IN_(pb + 6)) { for (int rep_ = 0; rep_ < DUP_N(6); ++rep_) { frame_refresh(F);
            moe_build_pfx(F, args, layer, 8);
            pg8::Moe1Sched S; S.O.pfx = F.MISC + MW_PFX; S.O.NT = 8; S.O.G = F.G; S.O.c = (int)blockIdx.x; S.X = WSP(bf16, WS_X1B); S.W = WSP(bf16, WS_WGU_T) + (size_t)layer * NE * 2048 * D; S.sdest = WSP(int, WS_SDEST); S.K = D; S.hstepB = (size_t)1024 * D * 2;
            pg8::EpiMoe1 E{WSP(bf16, WS_ABUF), KIN(I_BGU) + (size_t)layer * NE * 2048};
            pg8::gemm_phase<pg8::EpiMoe1, pg8::Moe1Sched>(F.lds, F.tid, S, E);
            } SEAM(pb + 6);
        }
        if (PH_ON(7) && IN_(pb + 7)) { for (int rep_ = 0; rep_ < DUP_N(7); ++rep_) { frame_refresh(F);
            moe_build_pfx(F, args, layer, 4);
            pg8::Moe2Sched S; S.O.pfx = F.MISC + MW_PFX; S.O.NT = 4; S.O.G = F.G; S.O.c = (int)blockIdx.x; S.Ab = WSP(bf16, WS_ABUF); S.W = WSP(bf16, WS_WDN_T) + (size_t)layer * NE * D * D; S.K = D; S.hstepB = (size_t)128 * D * 2;
            pg8::EpiMoe2 E{WSP(bf16, WS_YBUF), KIN(I_BDN) + (size_t)layer * NE * D, WSP(int, WS_SDEST), WSP(float, WS_SGATE)};
            pg8::gemm_phase<pg8::EpiMoe2, pg8::Moe2Sched>(F.lds, F.tid, S, E);
            } SEAM(pb + 7);
        }
        if (PH_ON(8) && IN_(pb + 8)) { for (int rep_ = 0; rep_ < DUP_N(8); ++rep_) { frame_refresh(F); p9_combine(F, args); } SEAM(pb + 8); }
        if (PH_ON(9) && IN_(pb + 9)) { for (int rep_ = 0; rep_ < DUP_N(9); ++rep_) { frame_refresh(F);
            pg8::DenseSched S; S.init(WSP(bf16, WS_HB), WSP(bf16, WS_WPG_T) + (size_t)layer * D * D, T, D, D, F.G, (int)blockIdx.x);
            pg8::EpiPle E{WSP(float, WS_H2), WSP(float, WS_H), WSP(float, WS_PE)};
            pg8::gemm_phase<pg8::EpiPle, pg8::DenseSched>(F.lds, F.tid, S, E);
            } SEAM(pb + 9);
        }
        if (PH_ON(10) && IN_(pb + 10)) { for (int rep_ = 0; rep_ < DUP_N(10); ++rep_) { frame_refresh(F); p11_ln2(F, args, layer); } SEAM(pb + 10); }
    }
#ifdef DBG_SEL
    if (hi - lo > 1) { xcd_barrier(bar);
        const unsigned mx = __hip_atomic_load(F.ctl + CW_DBG, RLX_AGENT), nf = __hip_atomic_load(F.ctl + CW_DBG + 1, RLX_AGENT);
        float code;
        { const float m = __uint_as_float(mx); int b = (m > 0.f) ? (int)floorf(log10f(m)) + 30 : 0; b = b < 0 ? 0 : (b > 60 ? 60 : b); if (nf) b += 100; code = sqrtf(10.0f * (float)(b + 1)); }
        for (size_t i = (size_t)blockIdx.x * 512 + threadIdx.x; i < (size_t)T * D; i += (size_t)gridDim.x * 512) F.out[i] = code; }
#endif
#undef IN_
#undef SEAM
}

extern "C" void kernel_launch(void* const* d_in, const int* in_sizes, int n_in, void* d_out, int out_size, void* d_ws, size_t ws_size, hipStream_t stream) {
    static int grid = 0;
    if (grid == 0) {
        if (n_in != N_IN || out_size != T * D || ws_size < WS_END) { fprintf(stderr, "kernel_launch: unexpected shapes (n_in %d, out %d, ws %zu < %zu); nothing launched\n", n_in, out_size, ws_size, (size_t)WS_END); grid = -1; return; }
        int dev = 0, cus = 0, per_cu = 0;
        if (hipGetDevice(&dev) != hipSuccess || hipDeviceGetAttribute(&cus, hipDeviceAttributeMultiprocessorCount, dev) != hipSuccess) { grid = -1; return; }
        if (hipFuncSetAttribute((const void*)fwd_kernel, hipFuncAttributeMaxDynamicSharedMemorySize, LDS_BYTES) != hipSuccess) { fprintf(stderr, "kernel_launch: hipFuncSetAttribute failed\n"); grid = -1; return; }
        if (hipOccupancyMaxActiveBlocksPerMultiprocessor(&per_cu, (const void*)fwd_kernel, NWAVES * 64, LDS_BYTES) != hipSuccess || per_cu < 1) { fprintf(stderr, "kernel_launch: occupancy query says %d blocks per CU\n", per_cu); }
        (void)hipGetLastError();
        grid = cus;
    }
    if (grid < 0) return;
    (void)hipMemsetAsync((char*)d_ws + WS_CTL, 0, CTL_ZERO_BYTES, stream);
    Args a{};
    for (int i = 0; i < N_IN; ++i) a.in[i] = (const float*)d_in[i];
    a.out = (float*)d_out; a.ws = (unsigned char*)d_ws;
#if MK_PER_PHASE_LAUNCH
    for (int ph = 0; ph < N_PHASES; ++ph) { a.ph_lo = ph; a.ph_hi = ph + 1; hipLaunchKernelGGL(fwd_kernel, dim3(grid), dim3(NWAVES * 64), LDS_BYTES, stream, a); }
#else
    a.ph_lo = 0; a.ph_hi = N_PHASES; hipLaunchKernelGGL(fwd_kernel, dim3(grid), dim3(NWAVES * 64), LDS_BYTES, stream, a);
#endif
    const hipError_t le = hipPeekAtLastError();
    if (le != hipSuccess) fprintf(stderr, "kernel_launch: launch failed: %s\n", hipGetErrorName(le));
}
```

```cpp
#include <hip/hip_runtime.h>
#include <cstdio>
#include <cstdint>

#define GAS __attribute__((address_space(1)))
#define LAS __attribute__((address_space(3)))
typedef unsigned short bf16;
typedef unsigned v4u __attribute__((ext_vector_type(4)));
typedef unsigned v2u __attribute__((ext_vector_type(2)));
typedef float f32x4 __attribute__((ext_vector_type(4)));
typedef float f32x2 __attribute__((ext_vector_type(2)));
typedef short bf16x8 __attribute__((ext_vector_type(8)));
typedef GAS unsigned gu32;
#define RLX_AGENT __ATOMIC_RELAXED, __HIP_MEMORY_SCOPE_AGENT
#define LDS_WAIT() asm volatile("s_waitcnt lgkmcnt(0)" ::: "memory")
#define VM_WAIT() asm volatile("s_waitcnt vmcnt(0)" ::: "memory")

constexpr int NWAVES = 8;
constexpr int DEPTH = 4, BATCH = 4, SEQ = 4096, D = 1024, T = BATCH * SEQ;
constexpr int NU = 3484, NUP = 3584;
constexpr int NE = 32, TOPK = 4, ECAP = 16384;
constexpr int NCH = SEQ / 64;
constexpr int U_SSD_Z = 0, U_SSD_X = 256, U_SSD_B = 512, U_SSD_C = 640, U_SSD_DT = 768;
constexpr int U_RW = 772, U_RW_R = 772, U_RW_K = 1028, U_RW_V = 1284, U_RW_LO = 1540;
constexpr int U_GL_Q = 1668, U_GL_K = 1796, U_GL_V = 1924, U_GL_G = 2180, U_GL_OG = 2196;
constexpr int U_ML_Q = 2452, U_ML_K = 2708, U_ML_V = 2964, U_ML_I = 3220, U_ML_F = 3224, U_ML_O = 3228;
constexpr float DN_ALPHA = 1.6817928305074290f;
constexpr float LN_EPS = 1e-5f, NORM_EPS = 1e-5f, RWKV_GN_EPS = 64e-5f;

enum { I_X = 0, I_P, I_WIN, I_WOUT, I_LN1G, I_LN1B, I_SCW, I_SCB, I_SALOG, I_SDTB, I_SD, I_SNG,
       I_RMU, I_RW0, I_RWUP, I_RA0, I_RAUP, I_RGUP, I_RKK, I_RKA, I_RRK, I_RLNG, I_RLNB,
       I_GGUP, I_GGB, I_GNG, I_MCW, I_MCB, I_MIB, I_MFB, I_MNG,
       I_RTW, I_RTB, I_WGU, I_BGU, I_WDN, I_BDN, I_PGW, I_PPJ, I_LN2G, I_LN2B, N_IN };

constexpr size_t MiB = 1u << 20;
constexpr size_t WS_CTL = 0, CTL_ZERO_BYTES = 1 * MiB;
constexpr size_t WS_WIN_T = 2 * MiB;
constexpr size_t WS_WOUT_T = WS_WIN_T + (size_t)DEPTH * NUP * D * 2;
constexpr size_t WS_WGU_T = WS_WOUT_T + (size_t)DEPTH * D * D * 2;
constexpr size_t WS_WDN_T = WS_WGU_T + (size_t)DEPTH * NE * 2048 * D * 2;
constexpr size_t WS_WPG_T = WS_WDN_T + (size_t)DEPTH * NE * D * D * 2;
constexpr size_t WS_WPP_T = WS_WPG_T + (size_t)DEPTH * D * D * 2;
constexpr size_t WS_RWT = WS_WPP_T + (size_t)DEPTH * D * 256 * 2;
constexpr size_t WS_PB = WS_RWT + (size_t)DEPTH * NE * D * 4;
constexpr size_t WS_XB = WS_PB + (size_t)DEPTH * T * 256 * 2;
constexpr size_t WS_U = WS_XB + (size_t)T * D * 2;
constexpr size_t WS_PE = WS_U + (size_t)T * NUP * 2;
constexpr size_t WS_MIX = WS_PE + (size_t)T * D * 4;
constexpr size_t WS_Y1 = WS_MIX + (size_t)T * D * 2;
constexpr size_t WS_X1 = WS_Y1 + (size_t)T * D * 4;
constexpr size_t WS_X1B = WS_X1 + (size_t)T * D * 4;
constexpr size_t WS_SDEST = WS_X1B + (size_t)T * D * 2;
constexpr size_t WS_SGATE = WS_SDEST + (size_t)NE * ECAP * 4;
constexpr size_t WS_ABUF = WS_SGATE + (size_t)NE * ECAP * 4;
constexpr size_t WS_YBUF = WS_ABUF + (size_t)NE * ECAP * D * 2;
constexpr size_t WS_H = WS_YBUF + (size_t)T * 4 * D * 2;
constexpr size_t WS_HB = WS_H + (size_t)T * D * 4;
constexpr size_t WS_H2 = WS_HB + (size_t)T * D * 2;
constexpr size_t WS_SSD_ST = WS_H2 + (size_t)T * D * 4;
constexpr size_t WS_SSD_DEC = WS_SSD_ST + (size_t)16 * NCH * 64 * 128 * 4;
constexpr size_t WS_GLA_ST = WS_SSD_DEC + 16 * NCH * 4;
constexpr size_t WS_GLA_DEC = WS_GLA_ST + (size_t)16 * NCH * 32 * 64 * 4;
constexpr size_t WS_ML_C = WS_GLA_DEC + (size_t)4 * NCH * 128 * 4;
constexpr size_t WS_ML_N = WS_ML_C + (size_t)16 * NCH * 64 * 64 * 4;
constexpr size_t WS_ML_BL = WS_ML_N + (size_t)16 * NCH * 64 * 4;
constexpr size_t WS_ML_ML = WS_ML_BL + 16 * NCH * 4;
constexpr size_t WS_ML_M = WS_ML_ML + 16 * NCH * 4;
constexpr size_t WS_RW = WS_ML_M + 16 * NCH * 4;
constexpr size_t WS_RW_G = WS_RW + (size_t)T * 3 * 256 * 4;
constexpr size_t WS_RW_RH = WS_RW_G + (size_t)T * 256 * 4;
constexpr size_t WS_RW_O0 = WS_RW_RH + (size_t)1024 * 4096 * 2;
constexpr size_t WS_RW_GF = WS_RW_O0 + (size_t)1024 * 4096 * 4;
constexpr size_t WS_RW_HT = WS_RW_GF + (size_t)1024 * 4096 * 2;
constexpr size_t WS_RW_PT = WS_RW_HT + (size_t)1024 * 4096 * 4;
constexpr size_t WS_LORA = WS_RW_PT + (size_t)1024 * 4096 * 2;
constexpr int LORA_PER_LAYER = 8192 + 8192 + 16384 + 2048;
constexpr size_t WS_END = WS_LORA + (size_t)DEPTH * LORA_PER_LAYER * 4;
constexpr int CW_BAR = 4096;
constexpr int CW_DBG = 32768;
constexpr int CW_CNT = 16384;

constexpr int RING_BYTES = 147456;
constexpr int MISC_OFF = RING_BYTES;
constexpr int LDS_BYTES = RING_BYTES + 1024;
constexpr int MW_BAR = 8, MW_LCNT = 32, MW_LBASE = 64, MW_PFX = 96, MW_CNT = 136, MW_GAMC = 168;

typedef __bf16 bf16x2_t __attribute__((ext_vector_type(2)));
__device__ __forceinline__ unsigned cvt_pk_bf16(float lo, float hi) { const f32x2 v = {lo, hi}; const bf16x2_t b = __builtin_convertvector(v, bf16x2_t); return __builtin_bit_cast(unsigned, b); }
__device__ __forceinline__ float bf2f(unsigned short b) { return __uint_as_float(((unsigned)b) << 16); }
__device__ __forceinline__ float sigmoidf_(float x) { return 1.0f / (1.0f + __expf(-x)); }
__device__ __forceinline__ float siluf_(float x) { return x / (1.0f + __expf(-x)); }
__device__ __forceinline__ float softplusf_(float x) { return fmaxf(x, 0.f) + log1pf(__expf(-fabsf(x))); }
__device__ __forceinline__ float logsigmoidf_(float x) { return fminf(x, 0.f) - log1pf(__expf(-fabsf(x))); }
__device__ __forceinline__ float wave_sum(float v) {
#pragma unroll
    for (int o = 1; o < 64; o <<= 1) v += __shfl_xor(v, o);
    return v;
}
__device__ __forceinline__ float wave_max(float v) {
#pragma unroll
    for (int o = 1; o < 64; o <<= 1) v = fmaxf(v, __shfl_xor(v, o));
    return v;
}
__device__ __forceinline__ float wave_scan_add(float v, int lane) {
#pragma unroll
    for (int o = 1; o < 64; o <<= 1) { const float t = __shfl_up(v, o); if (lane >= o) v += t; }
    return v;
}
__device__ __forceinline__ float wave_scan_max(float v, int lane) {
#pragma unroll
    for (int o = 1; o < 64; o <<= 1) { const float t = __shfl_up(v, o); if (lane >= o) v = fmaxf(v, t); }
    return v;
}
__device__ __forceinline__ f32x4 mm16(const LAS unsigned char* A, int lda, const LAS unsigned char* B, int ldb, int K, f32x4 acc, int fr, int fq) {
    const LAS unsigned char* ap = A + fr * lda + fq * 16; const LAS unsigned char* bp = B + fr * ldb + fq * 16;
    for (int k = 0; k < K; k += 32) {
        const bf16x8 a = *(const LAS bf16x8*)(ap + k * 2); const bf16x8 b = *(const LAS bf16x8*)(bp + k * 2);
        acc = __builtin_amdgcn_mfma_f32_16x16x32_bf16(b, a, acc, 0, 0, 0);
    }
    return acc;
}
__device__ __forceinline__ f32x4 mm16_gB(const LAS unsigned char* A, int lda, const float* B, int ldb, int K, f32x4 acc, int fr, int fq) {
    const LAS unsigned char* ap = A + fr * lda + fq * 16; const float* bp = B + (size_t)fr * ldb + fq * 8;
    for (int k = 0; k < K; k += 32) {
        const bf16x8 a = *(const LAS bf16x8*)(ap + k * 2);
        const f32x4 b0 = *(const f32x4*)(bp + k), b1 = *(const f32x4*)(bp + k + 4);
        v4u bw; bw.x = cvt_pk_bf16(b0.x, b0.y); bw.y = cvt_pk_bf16(b0.z, b0.w); bw.z = cvt_pk_bf16(b1.x, b1.y); bw.w = cvt_pk_bf16(b1.z, b1.w);
        const bf16x8 b = __builtin_bit_cast(bf16x8, bw);
        acc = __builtin_amdgcn_mfma_f32_16x16x32_bf16(b, a, acc, 0, 0, 0);
    }
    return acc;
}
__device__ __forceinline__ f32x4 mm16_gAB(const bf16* A, int lda, const bf16* B, int ldb, int K, f32x4 acc, int fr, int fq) {
    const bf16* ap = A + (size_t)fr * lda + fq * 8; const bf16* bp = B + (size_t)fr * ldb + fq * 8;
    for (int k = 0; k < K; k += 32) { const bf16x8 a = *(const bf16x8*)(ap + k), b = *(const bf16x8*)(bp + k); acc = __builtin_amdgcn_mfma_f32_16x16x32_bf16(b, a, acc, 0, 0, 0); }
    return acc;
}
__device__ __forceinline__ bf16x8 ldfrag_f32(const float* p) { const f32x4 b0 = *(const f32x4*)p, b1 = *(const f32x4*)(p + 4);
    v4u bw; bw.x = cvt_pk_bf16(b0.x, b0.y); bw.y = cvt_pk_bf16(b0.z, b0.w); bw.z = cvt_pk_bf16(b1.x, b1.y); bw.w = cvt_pk_bf16(b1.z, b1.w); return __builtin_bit_cast(bf16x8, bw); }
template <int NK> __device__ __forceinline__ f32x4 mm16_rB(const LAS unsigned char* A, int lda, const bf16x8 (&b)[NK], f32x4 acc, int fr, int fq) {
    const LAS unsigned char* ap = A + fr * lda + fq * 16;
#pragma unroll
    for (int k = 0; k < NK; ++k) { const bf16x8 a = *(const LAS bf16x8*)(ap + k * 64); acc = __builtin_amdgcn_mfma_f32_16x16x32_bf16(b[k], a, acc, 0, 0, 0); }
    return acc;
}
__device__ __forceinline__ v4u pack8(const float (&v)[8]) { v4u o; o.x = cvt_pk_bf16(v[0], v[1]); o.y = cvt_pk_bf16(v[2], v[3]); o.z = cvt_pk_bf16(v[4], v[5]); o.w = cvt_pk_bf16(v[6], v[7]); return o; }

#define XB_TMO      128
#define XB_XCNT(j)  (256  + 64 * (j))
#define XB_XSUB(j)  (1280 + 64 * (j))
#define XB_XGEN(j)  (2304 + 64 * (j))
#define XB_TOP      3328
#define XB_TOPGEN   3392
#define XCD_BAR_WORDS 3456
#define XB_SPIN_CAP (1u << 18)
__device__ __forceinline__ unsigned xb_ld(unsigned* p)              { return __hip_atomic_load(p, __ATOMIC_RELAXED, __HIP_MEMORY_SCOPE_AGENT); }
__device__ __forceinline__ unsigned xb_add(unsigned* p, unsigned v) { return __hip_atomic_fetch_add(p, v, __ATOMIC_RELAXED, __HIP_MEMORY_SCOPE_AGENT); }
__device__ __forceinline__ unsigned xb_xcc_id() { return (unsigned)__builtin_amdgcn_s_getreg((3 << 11) | 20) & 0xFu; }
#define XB_SPIN(cond, bar) do { unsigned _sp = 0; while (cond) { __builtin_amdgcn_s_sleep(1); \
    if ((++_sp & 255u) == 0u) { if (xb_ld(&(bar)[XB_TMO])) break; if (_sp > XB_SPIN_CAP) { atomicAdd(&(bar)[XB_TMO], 1u); break; } } } } while (0)
struct XcdBarrier { unsigned* bar; unsigned x; volatile LAS unsigned* st; };
__device__ __forceinline__ XcdBarrier xcd_barrier_post(unsigned* bar, volatile LAS unsigned* st) {
    XcdBarrier b; b.bar = bar; b.x = xb_xcc_id(); b.st = st;
    if (threadIdx.x == 0) (void)xb_add(&bar[XB_XCNT(b.x)], 1u);
    return b;
}
__device__ __forceinline__ void xcd_barrier_complete(unsigned* bar, unsigned x, unsigned& nloc, unsigned& nx) {
    const unsigned G = gridDim.x * gridDim.y * gridDim.z;
    unsigned sum, cnt, mine, sp = 0u;
    for (;;) {
        sum = 0u; cnt = 0u; mine = 0u;
#pragma unroll
        for (unsigned j = 0; j < 16; ++j) { const unsigned c = xb_ld(&bar[XB_XCNT(j)]); sum += c; cnt += (c > 0u) ? 1u : 0u; mine = (j == x) ? c : mine; }
        if (sum == G) break;
        __builtin_amdgcn_s_sleep(1);
        if ((++sp & 255u) == 0u) { if (xb_ld(&bar[XB_TMO])) break; if (sp > XB_SPIN_CAP) { atomicAdd(&bar[XB_TMO], 1u); break; } }
    }
    nloc = mine > 0u ? mine : 1u; nx = cnt > 0u ? cnt : 1u;
}
__device__ __forceinline__ void xcd_barrier(const XcdBarrier& b) {
    asm volatile("s_waitcnt vmcnt(0)" ::: "memory");
    __syncthreads();
    if (threadIdx.x == 0) {
        unsigned* bar = b.bar;
        __builtin_amdgcn_s_waitcnt(0);
        unsigned nloc = b.st[0], nx = b.st[1];
        if (nloc == 0u) { xcd_barrier_complete(bar, b.x, nloc, nx); b.st[0] = nloc; b.st[1] = nx; }
        const unsigned old = xb_add(&bar[XB_XSUB(b.x)], 1u);
        const unsigned gen = old / nloc;
        if (old + 1u == (gen + 1u) * nloc) {
            __builtin_amdgcn_fence(__ATOMIC_RELEASE, "agent");
            asm volatile("s_waitcnt vmcnt(0)" ::: "memory");
            const unsigned og = xb_add(&bar[XB_TOP], 1u);
            const unsigned tg = og / nx;
            if (og + 1u == (tg + 1u) * nx) xb_add(&bar[XB_TOPGEN], 1u);
            else XB_SPIN(xb_ld(&bar[XB_TOPGEN]) == tg, bar);
            __builtin_amdgcn_fence(__ATOMIC_ACQUIRE, "agent");
            xb_add(&bar[XB_XGEN(b.x)], 1u);
            asm volatile("s_waitcnt vmcnt(0)" ::: "memory");
        } else {
            XB_SPIN(xb_ld(&bar[XB_XGEN(b.x)]) == gen, bar);
            __builtin_amdgcn_fence(__ATOMIC_ACQUIRE, "agent");
            asm volatile("s_waitcnt vmcnt(0)" ::: "memory");
        }
    }
    __syncthreads();
}

namespace pg8 {
constexpr int BM = 256, BK = 64, HALF = 128, HTB = HALF * BK * 2, STAGE_BYTES = 8 * HTB, NXCD = 8, WGM = 8;
__host__ __device__ __forceinline__ int lds_byte(int r, int c) { const int st = (r >> 4) * 2 + (c >> 5), rr = r & 15, cc = c & 31, ob = rr * 64 + cc * 2; return st * 1024 + (ob ^ (((ob >> 9) & 1) << 5)); }
__host__ __device__ __forceinline__ void stage_rc(int b, int& R, int& C) { const int st = b / 1024, sb = b % 1024, swz = sb ^ (((sb >> 9) & 1) << 5); R = (st >> 1) * 16 + swz / 64; C = (st & 1) * 32 + (swz % 64) / 2; }
__host__ __device__ __forceinline__ int perm32(int rho) { const int n = rho >> 4, i = rho & 15; return 8 * (i >> 2) + 4 * n + (i & 3); }

template <class Epi, class Sched>
__device__ __forceinline__ void gemm_phase(LAS unsigned char* lds, const int tid, const Sched& S, const Epi& E) {
    const int wid = __builtin_amdgcn_readfirstlane(tid >> 6), lane = tid & 63, wr = wid >> 2, wc = wid & 3, fr = lane & 15, fq = lane >> 4;
    const int K = S.K, nt = K / BK;
    unsigned voffB[2];
#pragma unroll
    for (int i = 0; i < 2; ++i) { int R, C; stage_rc(tid * 16 + i * 8192, R, C); const int Rb = Epi::PERM ? ((R & ~31) + perm32(R & 31)) : R; voffB[i] = (unsigned)(Rb * K + C) * 2u; }
    const size_t kstep = (size_t)(BK * 2);
    const size_t hstepB = S.hstepB;
    const unsigned ldsw = (unsigned)wid * 1024u;
    const int aoff = lds_byte(wr * 64 + fr, fq * 8), boff = lds_byte(wc * 32 + fr, fq * 8);
#define PG8_SA(b, h) (((b) * 2 + (h)) * HTB)
#define PG8_SB(b, h) ((4 + (b) * 2 + (h)) * HTB)
#define PG8_STAGE_B(bufoff, gbase) do { _Pragma("unroll") for (int _i = 0; _i < 2; ++_i) \
        __builtin_amdgcn_global_load_lds((const unsigned*)((const char*)(gbase) + voffB[_i]), (LAS unsigned*)(lds + (bufoff) + ldsw + _i * 8192), 16, 0, 0); } while (0)
#define PG8_STAGE_A(bufoff, gbase, v0, v1) do { \
        __builtin_amdgcn_global_load_lds((const unsigned*)((const char*)(gbase) + (v0)), (LAS unsigned*)(lds + (bufoff) + ldsw), 16, 0, 0); \
        __builtin_amdgcn_global_load_lds((const unsigned*)((const char*)(gbase) + (v1)), (LAS unsigned*)(lds + (bufoff) + ldsw + 8192), 16, 0, 0); } while (0)
#define PG8_LDA(dst, b, h) do { _Pragma("unroll") for (int m = 0; m < 4; ++m) _Pragma("unroll") for (int k = 0; k < 2; ++k) dst[m][k] = *(const LAS bf16x8*)(lds + PG8_SA(b, h) + aoff + m * 2048 + k * 1024); } while (0)
#define PG8_LDB(dst, b, h) do { _Pragma("unroll") for (int n = 0; n < 2; ++n) _Pragma("unroll") for (int k = 0; k < 2; ++k) dst[n][k] = *(const LAS bf16x8*)(lds + PG8_SB(b, h) + boff + n * 2048 + k * 1024); } while (0)
#define PG8_MMA(ai, bj, At, Bt) do { __builtin_amdgcn_s_setprio(1); _Pragma("unroll") for (int m = 0; m < 4; ++m) _Pragma("unroll") for (int n = 0; n < 2; ++n) _Pragma("unroll") for (int k = 0; k < 2; ++k) \
        acc[ai][bj][m][n] = __builtin_amdgcn_mfma_f32_16x16x32_bf16(Bt[n][k], At[m][k], acc[ai][bj][m][n], 0, 0, 0); __builtin_amdgcn_s_setprio(0); } while (0)
#define PG8_WAIT_V(n) asm volatile("s_waitcnt vmcnt(" #n ")" ::: "memory")
#define PG8_WAIT_L(n) asm volatile("s_waitcnt lgkmcnt(" #n ")" ::: "memory")
#define PG8_BAR __builtin_amdgcn_s_barrier()
#define PG8_SCHED __builtin_amdgcn_sched_barrier(0)
    typename Sched::Unit cur, nxt; int ui = 0;
    if (!S.next(0, cur)) return;
    f32x4 acc[2][2][4][2];
#pragma unroll
    for (int a = 0; a < 2; ++a)
#pragma unroll
        for (int b = 0; b < 2; ++b)
#pragma unroll
            for (int m = 0; m < 4; ++m)
#pragma unroll
                for (int n = 0; n < 2; ++n) acc[a][b][m][n] = (f32x4){0.f, 0.f, 0.f, 0.f};
    bf16x8 At[4][2], B0[2][2], B1[2][2];
    constexpr bool GA = Sched::GATHER;
    const size_t hstepA = GA ? (size_t)0 : (size_t)HALF * K * 2;
    unsigned vA[2][2];
    S.a_off(cur, tid, vA);
#define PG8_STAGE_AH(bufoff, base, vv, h) PG8_STAGE_A(bufoff, ((base) + (h) * hstepA), vv[GA ? (h) : 0][0], vv[GA ? (h) : 0][1])
    const char* cA = S.a_base(cur); const char* cB = S.b_base(cur);
    PG8_STAGE_B(PG8_SB(0, 0), cB); PG8_STAGE_B(PG8_SB(0, 1), cB + hstepB); PG8_STAGE_AH(PG8_SA(0, 0), cA, vA, 0); PG8_STAGE_AH(PG8_SA(0, 1), cA, vA, 1);
    if (wr == 1) PG8_BAR;
    PG8_WAIT_V(2); PG8_BAR;
    PG8_STAGE_B(PG8_SB(1, 0), cB + kstep); PG8_STAGE_AH(PG8_SA(1, 0), cA + kstep, vA, 0); PG8_STAGE_B(PG8_SB(1, 1), cB + hstepB + kstep);
    PG8_WAIT_V(6); PG8_BAR;
    for (;;) {
        const bool has_next = S.next(ui + 1, nxt);
        const char* nA = cA; const char* nB = cB;
        if (has_next) { nA = S.a_base(nxt); nB = S.b_base(nxt); }
        for (int t = 0; t < nt; t += 2) {
            const bool last = (t == nt - 2);
            const char* a1 = cA + (size_t)(t + 1) * kstep;
            const char* a2 = last ? nA : cA + (size_t)(t + 2) * kstep; const char* b2 = last ? nB : cB + (size_t)(t + 2) * kstep;
            const char* a3 = a2 + kstep; const char* b3 = b2 + kstep;
            PG8_LDB(B0, 0, 0); PG8_LDB(B1, 0, 1); PG8_SCHED; PG8_LDA(At, 0, 0); PG8_STAGE_AH(PG8_SA(1, 1), a1, vA, 1);
            if constexpr (GA) { if (last && has_next) S.a_off(nxt, tid, vA); }
            PG8_WAIT_V(8); PG8_WAIT_L(0); PG8_BAR; PG8_MMA(0, 0, At, B0); PG8_MMA(0, 1, At, B1); PG8_BAR; PG8_SCHED;
            PG8_LDA(At, 0, 1); PG8_STAGE_B(PG8_SB(0, 0), b2); PG8_STAGE_B(PG8_SB(0, 1), b2 + hstepB); PG8_STAGE_AH(PG8_SA(0, 0), a2, vA, 0);
            PG8_WAIT_V(8); PG8_WAIT_L(0); PG8_BAR; PG8_MMA(1, 0, At, B0); PG8_MMA(1, 1, At, B1); PG8_BAR; PG8_SCHED;
            PG8_LDB(B0, 1, 0); PG8_LDB(B1, 1, 1); PG8_SCHED; PG8_LDA(At, 1, 0); PG8_STAGE_AH(PG8_SA(0, 1), a2, vA, 1);
            PG8_WAIT_V(8); PG8_WAIT_L(0); PG8_BAR; PG8_MMA(0, 0, At, B0); PG8_MMA(0, 1, At, B1); PG8_BAR; PG8_SCHED;
            PG8_LDA(At, 1, 1); PG8_STAGE_B(PG8_SB(1, 0), b3); PG8_STAGE_B(PG8_SB(1, 1), b3 + hstepB); PG8_STAGE_AH(PG8_SA(1, 0), a3, vA, 0);
            PG8_WAIT_V(8); PG8_WAIT_L(0); PG8_BAR; PG8_MMA(1, 0, At, B0); PG8_MMA(1, 1, At, B1); PG8_BAR; PG8_SCHED;
        }
        if (wr == 0) PG8_BAR;
        { int fr_ = fr, fq_ = fq; asm volatile("" : "+v"(fr_), "+v"(fq_)); E(acc, cur, wr, wc, fr_, fq_); }
        if (!has_next) break;
#pragma unroll
        for (int a = 0; a < 2; ++a)
#pragma unroll
            for (int b = 0; b < 2; ++b)
#pragma unroll
                for (int m = 0; m < 4; ++m)
#pragma unroll
                    for (int n = 0; n < 2; ++n) acc[a][b][m][n] = (f32x4){0.f, 0.f, 0.f, 0.f};
        cur = nxt; cA = nA; cB = nB; ++ui;
        if (wr == 1) PG8_BAR;
    }
    PG8_WAIT_V(0);
    PG8_BAR;
#undef PG8_SA
#undef PG8_SB
#undef PG8_STAGE_A
#undef PG8_STAGE_AH
#undef PG8_STAGE_B
#undef PG8_LDA
#undef PG8_LDB
#undef PG8_MMA
#undef PG8_WAIT_V
#undef PG8_WAIT_L
#undef PG8_BAR
#undef PG8_SCHED
}
}
struct Args { const float* in[N_IN]; float* out; unsigned char* ws; int ph_lo, ph_hi; };
typedef const __attribute__((address_space(4))) unsigned long long* karg_t;
struct Frame {
    karg_t ka;
    LAS unsigned char* lds;
    volatile LAS unsigned* MISC;
    gu32* ctl;
    unsigned char* ws;
    float* out;
    int tid, lane, wave, vcu, G;
};
#define WSP(T_, off) ((T_*)(F.ws + (off)))
#define KIN(k) ((const float*)F.ka[(k)])
#ifdef DBG_SEL
#define DBG_STAT(k, val) do { const float _v = (val); if ((k) == DBG_SEL) { if (fabsf(_v) < 3e38f) atomicMax((unsigned*)(F.ctl + CW_DBG), __float_as_uint(fabsf(_v))); else atomicAdd((unsigned*)(F.ctl + CW_DBG + 1), 1u); } } while (0)
#else
#define DBG_STAT(k, val) do { } while (0)
#endif
template <class P> __device__ __forceinline__ P launder_uniform(P p) {
    unsigned lo = (unsigned)(unsigned long long)p, hi = (unsigned)((unsigned long long)p >> 32);
    asm volatile("" : "+v"(lo), "+v"(hi));
    lo = __builtin_amdgcn_readfirstlane(lo); hi = __builtin_amdgcn_readfirstlane(hi);
    return (P)(((unsigned long long)hi << 32) | lo);
}
__device__ __forceinline__ void frame_refresh(Frame& F) {
    int t = F.tid; asm volatile("" : "+v"(t)); F.tid = t; F.lane = t & 63; F.wave = __builtin_amdgcn_readfirstlane(t >> 6);
    F.ws = launder_uniform(F.ws); F.ctl = (gu32*)(F.ws + WS_CTL);
    F.out = launder_uniform(F.out);
    F.ka = launder_uniform(F.ka);
}

namespace pg8 {
struct DenseSched {
    static constexpr bool GATHER = false;
    struct Unit { int pm, pn; };
    const bf16* A; const bf16* Bt; int K; size_t hstepB; int nM, nN, nwg, G, c;
    __device__ __forceinline__ void init(const bf16* A_, const bf16* Bt_, int M, int N, int K_, int G_, int c_) { A = A_; Bt = Bt_; K = K_; hstepB = (size_t)HALF * K_ * 2; nM = M / BM; nN = N / BM; nwg = nM * nN; G = G_; c = c_; }
    __device__ __forceinline__ bool next(int i, Unit& u) const {
        const long L = (long)i * G + c; if (L >= nwg) return false;
        int wgid = (int)L; { const int q = nwg / NXCD, r = nwg % NXCD, xcd = wgid % NXCD, off = wgid / NXCD; wgid = (xcd < r ? xcd * (q + 1) : r * (q + 1) + (xcd - r) * q) + off; }
        const int nig = WGM * nN, gid = wgid / nig, fm = gid * WGM, gsz = (nM - fm) < WGM ? (nM - fm) : WGM;
        u.pm = fm + ((wgid % nig) % gsz); u.pn = (wgid % nig) / gsz; return true;
    }
    __device__ __forceinline__ const char* a_base(const Unit& u) const { return (const char*)A + (size_t)u.pm * BM * K * 2; }
    __device__ __forceinline__ const char* b_base(const Unit& u) const { return (const char*)Bt + (size_t)u.pn * BM * K * 2; }
    __device__ __forceinline__ void a_off(const Unit&, int tid, unsigned (&v)[2][2]) const {
#pragma unroll
        for (int i = 0; i < 2; ++i) { int R, C; stage_rc(tid * 16 + i * 8192, R, C); v[0][i] = (unsigned)(R * K + C) * 2u; v[1][i] = v[0][i]; }
    }
};
struct MoeUnit { int e, mt, nt, cnt; };
struct MoeOrder {
    const volatile LAS unsigned* pfx;
    int NT, G, c;
    __device__ __forceinline__ bool decode(int i, MoeUnit& u) const {
        const int nwg = (int)pfx[32]; const long L = (long)i * G + c; if (L >= nwg) return false;
        int wgid = (int)L; { const int q = nwg / NXCD, r = nwg % NXCD, xcd = wgid % NXCD, off = wgid / NXCD; wgid = (xcd < r ? xcd * (q + 1) : r * (q + 1) + (xcd - r) * q) + off; }
        int e = 0;
#pragma unroll 1
        for (int j = 1; j < 32; ++j) e += ((int)pfx[j] <= wgid) ? 1 : 0;
        const int j = wgid - (int)pfx[e];
        u.e = e; u.mt = j / NT; u.nt = j % NT; u.cnt = (int)pfx[40 + e]; return true;
    }
};
struct Moe1Sched {
    static constexpr bool GATHER = true;
    typedef MoeUnit Unit;
    MoeOrder O; const bf16* X; const bf16* W; const int* sdest; int K; size_t hstepB;
    __device__ __forceinline__ bool next(int i, Unit& u) const { return O.decode(i, u); }
    __device__ __forceinline__ const char* a_base(const Unit&) const { return (const char*)X; }
    __device__ __forceinline__ const char* b_base(const Unit& u) const { return (const char*)W + ((size_t)u.e * 2048 + (size_t)u.nt * 128) * 1024 * 2; }
    __device__ __forceinline__ void a_off(const Unit& u, int tid, unsigned (&v)[2][2]) const {
#pragma unroll
        for (int i = 0; i < 2; ++i) { int R, C; stage_rc(tid * 16 + i * 8192, R, C);
#pragma unroll
            for (int h = 0; h < 2; ++h) { const int slot = u.mt * 256 + h * HALF + R; int tok = 0; if (slot < u.cnt) tok = sdest[u.e * ECAP + slot] >> 2; v[h][i] = (unsigned)(tok * 1024 + C) * 2u; } }
    }
};
struct Moe2Sched {
    static constexpr bool GATHER = false;
    typedef MoeUnit Unit;
    MoeOrder O; const bf16* Ab; const bf16* W; int K; size_t hstepB;
    __device__ __forceinline__ bool next(int i, Unit& u) const { return O.decode(i, u); }
    __device__ __forceinline__ const char* a_base(const Unit& u) const { return (const char*)Ab + ((size_t)u.e * ECAP + (size_t)u.mt * 256) * 1024 * 2; }
    __device__ __forceinline__ const char* b_base(const Unit& u) const { return (const char*)W + ((size_t)u.e * 1024 + (size_t)u.nt * 256) * 1024 * 2; }
    __device__ __forceinline__ void a_off(const Unit&, int tid, unsigned (&v)[2][2]) const {
#pragma unroll
        for (int i = 0; i < 2; ++i) { int R, C; stage_rc(tid * 16 + i * 8192, R, C); v[0][i] = (unsigned)(R * 1024 + C) * 2u; v[1][i] = v[0][i]; }
    }
};

__device__ __forceinline__ void unpack8(const v4u w, f32x4& a, f32x4& b) {
    a = (f32x4){__uint_as_float(w.x << 16), __uint_as_float(w.x & 0xffff0000u), __uint_as_float(w.y << 16), __uint_as_float(w.y & 0xffff0000u)};
    b = (f32x4){__uint_as_float(w.z << 16), __uint_as_float(w.z & 0xffff0000u), __uint_as_float(w.w << 16), __uint_as_float(w.w & 0xffff0000u)}; }
struct EpiF32 {
    static constexpr bool PERM = false;
    float* C; int ldc; const float* base; float alpha;
    __device__ __forceinline__ void operator()(const f32x4 (&acc)[2][2][4][2], const DenseSched::Unit& u, int wr, int wc, int fr, int fq) const {
        const int row0 = u.pm * BM + wr * 64 + fr, col0 = u.pn * BM + wc * 32 + 4 * fq;
#pragma unroll
        for (int ai = 0; ai < 2; ++ai)
#pragma unroll
            for (int m = 0; m < 4; ++m) { const size_t ro = (size_t)(row0 + ai * HALF + m * 16) * ldc + col0;
#pragma unroll
                for (int bj = 0; bj < 2; ++bj)
#pragma unroll
                    for (int n = 0; n < 2; ++n) { f32x4 v = acc[ai][bj][m][n];
                        if (base) { const f32x4 b = *(const f32x4*)(base + ro + bj * HALF + n * 16); v = v + b * alpha; }
                        *(f32x4*)(C + ro + bj * HALF + n * 16) = v; } }
    }
};
struct EpiB16 {
    static constexpr bool PERM = true;
    bf16* O; int ldc; const bf16* base; float alpha;
    __device__ __forceinline__ void operator()(const f32x4 (&acc)[2][2][4][2], const DenseSched::Unit& u, int wr, int wc, int fr, int fq) const {
        const int row0 = u.pm * BM + wr * 64 + fr, col0 = u.pn * BM + wc * 32 + 8 * fq;
#pragma unroll
        for (int ai = 0; ai < 2; ++ai) {
            v4u bw[4][2];
            if (base) {
#pragma unroll
                for (int m = 0; m < 4; ++m)
#pragma unroll
                    for (int bj = 0; bj < 2; ++bj) bw[m][bj] = *(const v4u*)(base + (size_t)(row0 + ai * HALF + m * 16) * ldc + col0 + bj * HALF); }
#pragma unroll
            for (int m = 0; m < 4; ++m) { bf16* rowp = O + (size_t)(row0 + ai * HALF + m * 16) * ldc + col0;
#pragma unroll
                for (int bj = 0; bj < 2; ++bj) { f32x4 v0 = acc[ai][bj][m][0], v1 = acc[ai][bj][m][1];
                    if (base) { f32x4 b0, b1; unpack8(bw[m][bj], b0, b1); v0 = v0 + b0 * alpha; v1 = v1 + b1 * alpha; }
                    v4u w; w.x = cvt_pk_bf16(v0[0], v0[1]); w.y = cvt_pk_bf16(v0[2], v0[3]); w.z = cvt_pk_bf16(v1[0], v1[1]); w.w = cvt_pk_bf16(v1[2], v1[3]);
                    *(v4u*)(rowp + bj * HALF) = w; } } }
    }
};
struct EpiPle {
    static constexpr bool PERM = true;
    bf16* C; const bf16* hb; const bf16* pe;
    __device__ __forceinline__ void operator()(const f32x4 (&acc)[2][2][4][2], const DenseSched::Unit& u, int wr, int wc, int fr, int fq) const {
        const int row0 = u.pm * BM + wr * 64 + fr, col0 = u.pn * BM + wc * 32 + 8 * fq;
#pragma unroll
        for (int ai = 0; ai < 2; ++ai) {
            v4u hw[4][2], pw[4][2];
#pragma unroll
            for (int m = 0; m < 4; ++m)
#pragma unroll
                for (int bj = 0; bj < 2; ++bj) { const size_t ro = (size_t)(row0 + ai * HALF + m * 16) * 1024 + col0 + bj * HALF; hw[m][bj] = *(const v4u*)(hb + ro); pw[m][bj] = *(const v4u*)(pe + ro); }
#pragma unroll
            for (int m = 0; m < 4; ++m)
#pragma unroll
                for (int bj = 0; bj < 2; ++bj) { const size_t ro = (size_t)(row0 + ai * HALF + m * 16) * 1024 + col0 + bj * HALF;
                    f32x4 h0, h1, p0, p1; unpack8(hw[m][bj], h0, h1); unpack8(pw[m][bj], p0, p1); const f32x4 a0 = acc[ai][bj][m][0], a1 = acc[ai][bj][m][1];
                    f32x4 o0, o1;
#pragma unroll
                    for (int j = 0; j < 4; ++j) { o0[j] = h0[j] + sigmoidf_(a0[j]) * p0[j]; o1[j] = h1[j] + sigmoidf_(a1[j]) * p1[j]; }
                    v4u w; w.x = cvt_pk_bf16(o0[0], o0[1]); w.y = cvt_pk_bf16(o0[2], o0[3]); w.z = cvt_pk_bf16(o1[0], o1[1]); w.w = cvt_pk_bf16(o1[2], o1[3]);
                    *(v4u*)(C + ro) = w; } }
    }
};
struct EpiMoe1 {
    static constexpr bool PERM = true;
    bf16* Ab; const float* bgu;
    __device__ __forceinline__ void operator()(const f32x4 (&acc)[2][2][4][2], const MoeUnit& u, int wr, int wc, int fr, int fq) const {
        const int col0 = u.nt * 128 + wc * 32 + 8 * fq;
        const float* bg = bgu + (size_t)u.e * 2048 + col0;
        const f32x4 bg0 = *(const f32x4*)(bg), bg1 = *(const f32x4*)(bg + 4), bl0 = *(const f32x4*)(bg + 1024), bl1 = *(const f32x4*)(bg + 1028);
#pragma unroll
        for (int ai = 0; ai < 2; ++ai)
#pragma unroll
            for (int m = 0; m < 4; ++m) { const int r = ai * HALF + wr * 64 + m * 16 + fr;
                bf16* rowp = Ab + ((size_t)u.e * ECAP + (size_t)u.mt * 256 + r) * 1024 + col0;
                float o[8];
#pragma unroll
                for (int n = 0; n < 2; ++n) { const f32x4 g4 = acc[ai][0][m][n] + (n ? bg1 : bg0), l4 = acc[ai][1][m][n] + (n ? bl1 : bl0);
#pragma unroll
                    for (int j = 0; j < 4; ++j) { const float g = fminf(g4[j], 7.0f), l = fminf(fmaxf(l4[j], -7.0f), 7.0f); o[n * 4 + j] = (l + 1.0f) * g * sigmoidf_(1.702f * g); } }
                *(v4u*)rowp = pack8(o); }
    }
};
struct EpiMoe2 {
    static constexpr bool PERM = true;
    bf16* Y; const float* bdn; const int* sdest; const float* sgate;
    __device__ __forceinline__ void operator()(const f32x4 (&acc)[2][2][4][2], const MoeUnit& u, int wr, int wc, int fr, int fq) const {
        const int col0 = u.nt * 256 + wc * 32 + 8 * fq;
        const float* bp = bdn + (size_t)u.e * 1024 + col0;
        int dest[2][4]; float gate[2][4];
#pragma unroll
        for (int ai = 0; ai < 2; ++ai)
#pragma unroll
            for (int m = 0; m < 4; ++m) { const int slot = u.mt * 256 + ai * HALF + wr * 64 + m * 16 + fr; const bool ok = slot < u.cnt; const int si = u.e * ECAP + (ok ? slot : 0);
                dest[ai][m] = ok ? sdest[si] : -1; gate[ai][m] = sgate[si]; }
        f32x4 bv[2][2];
#pragma unroll
        for (int bj = 0; bj < 2; ++bj)
#pragma unroll
            for (int n = 0; n < 2; ++n) bv[bj][n] = *(const f32x4*)(bp + bj * HALF + 4 * n);
#pragma unroll
        for (int ai = 0; ai < 2; ++ai)
#pragma unroll
            for (int m = 0; m < 4; ++m) {
                if (dest[ai][m] >= 0) { const float g = gate[ai][m]; bf16* rowp = Y + (size_t)dest[ai][m] * 1024 + col0;
#pragma unroll
                    for (int bj = 0; bj < 2; ++bj) { const f32x4 v0 = (acc[ai][bj][m][0] + bv[bj][0]) * g, v1 = (acc[ai][bj][m][1] + bv[bj][1]) * g;
                        v4u w; w.x = cvt_pk_bf16(v0[0], v0[1]); w.y = cvt_pk_bf16(v0[2], v0[3]); w.z = cvt_pk_bf16(v1[0], v1[1]); w.w = cvt_pk_bf16(v1[2], v1[3]);
                        *(v4u*)(rowp + bj * HALF) = w; } } }
    }
};
}

__device__ __forceinline__ void p0_transpose_item(const float* W, int K, int N, int nblk, bf16* WT, int item, int lane) {
    const int kb = item / nblk, nb = item % nblk, k0 = 64 * kb, n = 64 * nb + lane;
    const bool ok = n < N; const float* src = W + (size_t)k0 * N + (ok ? n : 0);
    float x[64];
#pragma unroll
    for (int j = 0; j < 64; ++j) x[j] = src[(size_t)j * N];
    bf16* dst = WT + (size_t)n * K + k0;
#pragma unroll
    for (int q = 0; q < 8; ++q) { v4u o; o.x = cvt_pk_bf16(x[8 * q], x[8 * q + 1]); o.y = cvt_pk_bf16(x[8 * q + 2], x[8 * q + 3]); o.z = cvt_pk_bf16(x[8 * q + 4], x[8 * q + 5]); o.w = cvt_pk_bf16(x[8 * q + 6], x[8 * q + 7]);
        if (!ok) o = (v4u){0u, 0u, 0u, 0u};
        *(v4u*)(dst + 8 * q) = o; }
}
__device__ __forceinline__ void cvt_rows(const float* src, bf16* dst, size_t n8, size_t i0, size_t stride) {
    for (size_t i = i0; i < n8; i += stride) { const f32x4 a = *(const f32x4*)(src + i * 8), b = *(const f32x4*)(src + i * 8 + 4);
        v4u o; o.x = cvt_pk_bf16(a.x, a.y); o.y = cvt_pk_bf16(a.z, a.w); o.z = cvt_pk_bf16(b.x, b.y); o.w = cvt_pk_bf16(b.z, b.w); *(v4u*)(dst + i * 8) = o; }
}
__device__ __forceinline__ void p0_prologue(Frame& F, const Args& A) {
    const int gw = F.vcu * NWAVES + F.wave, NGW = F.G * NWAVES;
    constexpr int I_IN = 16 * (NUP / 64), I_OUT = 16 * 16, I_GU = 16 * 32, I_DN = 16 * 16, I_PG = 16 * 16, I_PP = 4 * 16;
    constexpr int PER_LAYER = I_IN + I_OUT + NE * I_GU + NE * I_DN + I_PG + I_PP;
#pragma unroll 1
    for (int it = gw; it < DEPTH * PER_LAYER; it += NGW) {
        const int l = it / PER_LAYER; int r = it % PER_LAYER;
        const float* W; bf16* WT; int K = D, N = D, nblk = 16;
        if (r < I_IN) { W = KIN(I_WIN) + (size_t)l * D * NU; WT = WSP(bf16, WS_WIN_T) + (size_t)l * NUP * D; N = NU; nblk = NUP / 64; }
        else if ((r -= I_IN) < I_OUT) { W = KIN(I_WOUT) + (size_t)l * D * D; WT = WSP(bf16, WS_WOUT_T) + (size_t)l * D * D; }
        else if ((r -= I_OUT) < NE * I_GU) { const int e = r / I_GU; r %= I_GU; W = KIN(I_WGU) + ((size_t)l * NE + e) * D * 2048; WT = WSP(bf16, WS_WGU_T) + ((size_t)l * NE + e) * 2048 * D; N = 2048; nblk = 32; }
        else if ((r -= NE * I_GU) < NE * I_DN) { const int e = r / I_DN; r %= I_DN; W = KIN(I_WDN) + ((size_t)l * NE + e) * D * D; WT = WSP(bf16, WS_WDN_T) + ((size_t)l * NE + e) * D * D; }
        else if ((r -= NE * I_DN) < I_PG) { W = KIN(I_PGW) + (size_t)l * D * D; WT = WSP(bf16, WS_WPG_T) + (size_t)l * D * D; }
        else { r -= I_PG; W = KIN(I_PPJ) + (size_t)l * 256 * D; WT = WSP(bf16, WS_WPP_T) + (size_t)l * D * 256; K = 256; }
        p0_transpose_item(W, K, N, nblk, WT, r, F.lane);
    }
    const size_t gt = (size_t)F.vcu * (NWAVES * 64) + F.tid, NT_ = (size_t)F.G * NWAVES * 64;
    cvt_rows(KIN(I_P), WSP(bf16, WS_PB), (size_t)DEPTH * T * 256 / 8, gt, NT_);
    cvt_rows(KIN(I_X), WSP(bf16, WS_XB), (size_t)T * D / 8, gt, NT_);
    for (size_t i = gt; i < (size_t)DEPTH * LORA_PER_LAYER; i += NT_) { const int l = (int)(i / LORA_PER_LAYER); int r = (int)(i % LORA_PER_LAYER); float v;
        if (r < 8192) { const int ch = r >> 5, j = r & 31; v = KIN(I_RWUP)[(size_t)l * 8192 + j * 256 + ch]; }
        else if (r < 16384) { r -= 8192; const int ch = r >> 5, j = r & 31; v = KIN(I_RAUP)[(size_t)l * 8192 + j * 256 + ch]; }
        else if (r < 32768) { r -= 16384; const int ch = r >> 6, j = r & 63; v = KIN(I_RGUP)[(size_t)l * 16384 + j * 256 + ch]; }
        else { r -= 32768; const int d = r >> 4, j = r & 15; v = KIN(I_GGUP)[(size_t)l * 2048 + j * 128 + d]; }
        WSP(float, WS_LORA)[i] = v; }
    for (size_t i = gt; i < (size_t)DEPTH * NE * D; i += NT_) { const int l = (int)(i / (NE * D)), r = (int)(i % (NE * D)), e = r / D, k = r % D; WSP(float, WS_RWT)[i] = KIN(I_RTW)[(size_t)l * D * NE + (size_t)k * NE + e]; }
}

__device__ __forceinline__ void p6_ln1_router(Frame& F, const Args& A, int layer) {
    const bf16* y1 = WSP(bf16, WS_Y1); bf16* x1b = WSP(bf16, WS_X1B);
    const float* g = KIN(I_LN1G) + layer * D; const float* bb = KIN(I_LN1B) + layer * D;
    const float* rwt = WSP(float, WS_RWT) + (size_t)layer * NE * D; const float* rb = KIN(I_RTB) + layer * NE;
    int* sdest = WSP(int, WS_SDEST); float* sgate = WSP(float, WS_SGATE);
    unsigned* cnt = (unsigned*)(F.ctl + CW_CNT + layer * NE * 16);
    LAS float* RWT = (LAS float*)F.lds;
    volatile LAS unsigned* lcnt = F.MISC + MW_LCNT; volatile LAS unsigned* lbase = F.MISC + MW_LBASE;
    for (int i = F.tid; i < NE * D / 4; i += NWAVES * 64) ((LAS f32x4*)RWT)[i] = ((const f32x4*)rwt)[i];
    const int lane = F.lane;
    const f32x4 gv[4] = { *(const f32x4*)(g + 4 * lane), *(const f32x4*)(g + 256 + 4 * lane), *(const f32x4*)(g + 512 + 4 * lane), *(const f32x4*)(g + 768 + 4 * lane) };
    const f32x4 bv[4] = { *(const f32x4*)(bb + 4 * lane), *(const f32x4*)(bb + 256 + 4 * lane), *(const f32x4*)(bb + 512 + 4 * lane), *(const f32x4*)(bb + 768 + 4 * lane) };
    const float rbias = rb[lane >> 1];
    for (int blk = F.vcu; blk < T / 64; blk += F.G) {
        if (F.tid < 32) lcnt[F.tid] = 0u;
        __syncthreads();
        int my_e = 0; float my_g = 0.f; unsigned my_r = 0u;
#pragma unroll 1
        for (int ri = 0; ri < 8; ++ri) {
            const int row = blk * 64 + F.wave * 8 + ri;
            const bf16* yr = y1 + (size_t)row * D;
            f32x4 v[4]; float s = 0.f;
#pragma unroll
            for (int j = 0; j < 4; ++j) { const v2u w = *(const v2u*)(yr + 256 * j + 4 * lane); v[j] = (f32x4){__uint_as_float(w.x << 16), __uint_as_float(w.x & 0xffff0000u), __uint_as_float(w.y << 16), __uint_as_float(w.y & 0xffff0000u)}; s += (v[j].x + v[j].y) + (v[j].z + v[j].w); }
            const float mean = wave_sum(s) * (1.f / D); float s2 = 0.f;
#pragma unroll
            for (int j = 0; j < 4; ++j) { v[j] = v[j] - mean; s2 += (v[j].x * v[j].x + v[j].y * v[j].y) + (v[j].z * v[j].z + v[j].w * v[j].w); }
            const float rstd = 1.0f / sqrtf(wave_sum(s2) * (1.f / D) + LN_EPS);
#pragma unroll
            for (int j = 0; j < 4; ++j) { v[j] = v[j] * rstd * gv[j] + bv[j];
                v2u o; o.x = cvt_pk_bf16(v[j].x, v[j].y); o.y = cvt_pk_bf16(v[j].z, v[j].w); *(v2u*)(x1b + (size_t)row * D + 256 * j + 4 * lane) = o; }
            float p[32];
#pragma unroll
            for (int e = 0; e < 32; ++e) { float a = 0.f;
#pragma unroll
                for (int j = 0; j < 4; ++j) { const f32x4 w = *(const LAS f32x4*)(RWT + e * D + 256 * j + 4 * lane); a += (v[j].x * w.x + v[j].y * w.y) + (v[j].z * w.z + v[j].w * w.w); }
                p[e] = a; }
#pragma unroll
            for (int i = 0; i < 16; ++i) { const bool hi = (lane & 32) != 0; const float keep = hi ? p[i + 16] : p[i], send = hi ? p[i] : p[i + 16]; p[i] = keep + __shfl_xor(send, 32); }
#pragma unroll
            for (int i = 0; i < 8; ++i) { const bool hi = (lane & 16) != 0; const float keep = hi ? p[i + 8] : p[i], send = hi ? p[i] : p[i + 8]; p[i] = keep + __shfl_xor(send, 16); }
#pragma unroll
            for (int i = 0; i < 4; ++i) { const bool hi = (lane & 8) != 0; const float keep = hi ? p[i + 4] : p[i], send = hi ? p[i] : p[i + 4]; p[i] = keep + __shfl_xor(send, 8); }
#pragma unroll
            for (int i = 0; i < 2; ++i) { const bool hi = (lane & 4) != 0; const float keep = hi ? p[i + 2] : p[i], send = hi ? p[i] : p[i + 2]; p[i] = keep + __shfl_xor(send, 4); }
            { const bool hi = (lane & 2) != 0; const float keep = hi ? p[1] : p[0], send = hi ? p[0] : p[1]; p[0] = keep + __shfl_xor(send, 2); }
            float logit = p[0] + __shfl_xor(p[0], 1) + rbias;
            float tv[4]; int te[4];
#pragma unroll
            for (int k = 0; k < 4; ++k) {
                float bvv = logit; int bi = lane >> 1;
#pragma unroll
                for (int o = 2; o < 64; o <<= 1) { const float ov = __shfl_xor(bvv, o); const int oi = __shfl_xor(bi, o); if (ov > bvv || (ov == bvv && oi < bi)) { bvv = ov; bi = oi; } }
                tv[k] = bvv; te[k] = bi; if ((lane >> 1) == bi) logit = -INFINITY;
            }
            const float e1 = __expf(tv[1] - tv[0]), e2 = __expf(tv[2] - tv[0]), e3 = __expf(tv[3] - tv[0]); const float inv = 1.0f / (1.0f + e1 + e2 + e3);
            const int kk = lane & 3;
            const int ek = kk == 0 ? te[0] : kk == 1 ? te[1] : kk == 2 ? te[2] : te[3];
            const float gk = (kk == 0 ? 1.0f : kk == 1 ? e1 : kk == 2 ? e2 : e3) * inv;
            if ((lane >> 2) == ri) { my_e = ek; my_g = gk; my_r = atomicAdd((unsigned*)&lcnt[ek], 1u); }
        }
        __syncthreads();
        if (F.tid < 32) { const unsigned n = lcnt[F.tid]; lbase[F.tid] = n ? __hip_atomic_fetch_add(cnt + F.tid * 16, n, RLX_AGENT) : 0u; }
        __syncthreads();
        if (lane < 32) { const int row = blk * 64 + F.wave * 8 + (lane >> 2); const unsigned slot = (unsigned)my_e * ECAP + lbase[my_e] + my_r;
            sdest[slot] = row * 4 + (lane & 3); sgate[slot] = my_g; }
        __syncthreads();
    }
}
__device__ __forceinline__ void p9_combine(Frame& F, const Args& A) {
    const bf16* x1b = WSP(bf16, WS_X1B); const bf16* yb = WSP(bf16, WS_YBUF); bf16* hb = WSP(bf16, WS_HB);
    const int gw = F.vcu * NWAVES + F.wave, NGW = F.G * NWAVES, lane = F.lane;
    for (int row = gw; row < T; row += NGW) {
        v4u y[4][2], xw[2];
#pragma unroll
        for (int j = 0; j < 2; ++j) {
#pragma unroll
            for (int k = 0; k < 4; ++k) y[k][j] = *(const v4u*)(yb + ((size_t)row * 4 + k) * D + 512 * j + 8 * lane);
            xw[j] = *(const v4u*)(x1b + (size_t)row * D + 512 * j + 8 * lane); }
#pragma unroll
        for (int j = 0; j < 2; ++j) { f32x4 v0, v1; pg8::unpack8(xw[j], v0, v1); v0 = v0 * DN_ALPHA; v1 = v1 * DN_ALPHA;
#pragma unroll
            for (int k = 0; k < 4; ++k) { f32x4 a, b; pg8::unpack8(y[k][j], a, b); v0 = v0 + a; v1 = v1 + b; }
            v4u wv; wv.x = cvt_pk_bf16(v0.x, v0.y); wv.y = cvt_pk_bf16(v0.z, v0.w); wv.z = cvt_pk_bf16(v1.x, v1.y); wv.w = cvt_pk_bf16(v1.z, v1.w); *(v4u*)(hb + (size_t)row * D + 512 * j + 8 * lane) = wv; }
    }
}
__device__ __forceinline__ void p11_ln2(Frame& F, const Args& A, int layer) {
    const bf16* h2 = WSP(bf16, WS_H2); bf16* xb = WSP(bf16, WS_XB);
    const float* g = KIN(I_LN2G) + layer * D; const float* bb = KIN(I_LN2B) + layer * D;
    const int gw = F.vcu * NWAVES + F.wave, NGW = F.G * NWAVES, lane = F.lane;
    for (int row = gw; row < T; row += NGW) {
        const bf16* yr = h2 + (size_t)row * D; f32x4 v[4]; float s = 0.f;
#pragma unroll
        for (int j = 0; j < 4; ++j) { const v2u w = *(const v2u*)(yr + 256 * j + 4 * lane); v[j] = (f32x4){__uint_as_float(w.x << 16), __uint_as_float(w.x & 0xffff0000u), __uint_as_float(w.y << 16), __uint_as_float(w.y & 0xffff0000u)}; s += (v[j].x + v[j].y) + (v[j].z + v[j].w); }
        const float mean = wave_sum(s) * (1.f / D); float s2 = 0.f;
#pragma unroll
        for (int j = 0; j < 4; ++j) { v[j] = v[j] - mean; s2 += (v[j].x * v[j].x + v[j].y * v[j].y) + (v[j].z * v[j].z + v[j].w * v[j].w); }
        const float rstd = 1.0f / sqrtf(wave_sum(s2) * (1.f / D) + LN_EPS);
#pragma unroll
        for (int j = 0; j < 4; ++j) { const f32x4 gv = *(const f32x4*)(g + 256 * j + 4 * lane), bv = *(const f32x4*)(bb + 256 * j + 4 * lane);
            const f32x4 o = v[j] * rstd * gv + bv; const size_t off = (size_t)row * D + 256 * j + 4 * lane;
            if (layer == DEPTH - 1) *(f32x4*)(F.out + off) = o; v2u w; w.x = cvt_pk_bf16(o.x, o.y); w.y = cvt_pk_bf16(o.z, o.w); *(v2u*)(xb + off) = w; }
    }
}
__device__ __forceinline__ void moe_build_pfx(Frame& F, const Args& A, int layer, int NT) {
    volatile LAS unsigned* pfx = F.MISC + MW_PFX;
    __syncthreads();
    if (F.tid == 0) { unsigned acc = 0u;
        for (int e = 0; e < NE; ++e) { const unsigned c = __hip_atomic_load(F.ctl + CW_CNT + (layer * NE + e) * 16, RLX_AGENT); pfx[e] = acc; pfx[40 + e] = c; acc += ((c + 255u) >> 8) * (unsigned)NT; }
        pfx[32] = acc; }
    __syncthreads();
}
#define UU(t, col) bf2f(u[(size_t)(t) * NUP + (col)])
#define UU4(t, col) ldu4(u + (size_t)(t) * NUP + (col))
__device__ __forceinline__ f32x4 ldu4(const bf16* p) { const v2u w = *(const v2u*)p; return (f32x4){__uint_as_float(w.x << 16), __uint_as_float(w.x & 0xffff0000u), __uint_as_float(w.y << 16), __uint_as_float(w.y & 0xffff0000u)}; }
__device__ __forceinline__ void lds_st_bf16(LAS unsigned char* p, float v) { *(LAS unsigned short*)p = (unsigned short)(cvt_pk_bf16(v, 0.f) & 0xffffu); }
__device__ __forceinline__ void lds_st_bf16x4(LAS unsigned char* p, float a, float b, float c, float d) { v2u o; o.x = cvt_pk_bf16(a, b); o.y = cvt_pk_bf16(c, d); *(LAS v2u*)p = o; }

__device__ __forceinline__ void ssd_stage1(Frame& F, const Args& A, int layer, int b, int c) {
    const bf16* u = WSP(bf16, WS_U);
    LAS unsigned char* L = F.lds;
    LAS float* DT = (LAS float*)L; LAS float* AC = DT + 256;
    LAS unsigned char* BMT = L + 2048; LAS unsigned char* XCDT = BMT + 128 * 144;
    const int t0 = b * SEQ + c * 64, tid = F.tid, lane = F.lane, wave = F.wave;
    if (wave < 4) {
        const int hh = wave;
        const float dt = softplusf_(UU(t0 + lane, U_SSD_DT + hh) + KIN(I_SDTB)[layer * 4 + hh]);
        const float adt = -dt * __expf(KIN(I_SALOG)[layer * 4 + hh]);
        const float ac = wave_scan_add(adt, lane);
        DT[hh * 64 + lane] = dt; AC[hh * 64 + lane] = ac;
        if (lane == 63) WSP(float, WS_SSD_DEC)[(b * 4 + hh) * NCH + c] = __expf(ac);
    }
    __syncthreads();
    if (tid < 384) {
        const int cc = tid; const float* cw = KIN(I_SCW) + (size_t)layer * 2048 + cc; const float w0 = cw[0], w1 = cw[512], w2 = cw[1024], w3 = cw[1536], cb = KIN(I_SCB)[layer * 512 + cc];
        const bf16* up = u + (size_t)t0 * NUP + U_SSD_X + cc;
        float win0 = 0.f, win1 = 0.f, win2 = 0.f;
        if (c > 0) { win0 = bf2f(up[-3 * NUP]); win1 = bf2f(up[-2 * NUP]); win2 = bf2f(up[-1 * NUP]); }
        const int hh = (cc >> 6) & 3; const bool isx = cc < 256;
        LAS unsigned char* dst = isx ? XCDT + cc * 144 : BMT + (cc - 256) * 144;
        const float aclast = AC[hh * 64 + 63];
#pragma unroll 1
        for (int l0 = 0; l0 < 64; l0 += 32) {
            float xv[32];
#pragma unroll
            for (int j = 0; j < 32; ++j) xv[j] = bf2f(up[(l0 + j) * NUP]);
#pragma unroll
            for (int j8 = 0; j8 < 4; ++j8) { float o[8];
#pragma unroll
                for (int j = 0; j < 8; ++j) { const int l = l0 + j8 * 8 + j; const float x = xv[j8 * 8 + j]; const float y = cb + w0 * win0 + w1 * win1 + w2 * win2 + w3 * x; win0 = win1; win1 = win2; win2 = x;
                    float s = siluf_(y); if (isx) s *= DT[hh * 64 + l] * __expf(aclast - AC[hh * 64 + l]); o[j] = s; }
                *(LAS v4u*)(dst + (l0 + j8 * 8) * 2) = pack8(o); }
        }
    }
    __syncthreads();
    { const int fr = lane & 15, fq = lane >> 4; float* st = WSP(float, WS_SSD_ST);
#pragma unroll 1
      for (int i = 0; i < 2; ++i) { const int row0 = (2 * wave + i) * 16; const int hh = row0 >> 6, p = (row0 & 63) + fr;
          float* dstp = st + (((size_t)(b * 4 + hh) * NCH + c) * 64 + p) * 128;
#pragma unroll 1
          for (int ntl = 0; ntl < 8; ++ntl) { f32x4 acc = {0.f, 0.f, 0.f, 0.f}; acc = mm16(XCDT + row0 * 144, 144, BMT + ntl * 16 * 144, 144, 64, acc, fr, fq);
              *(f32x4*)(dstp + ntl * 16 + 4 * fq) = acc; } } }
    __syncthreads();
}
__device__ __forceinline__ void ssd_stage3(Frame& F, const Args& A, int layer, int b, int c) {
    const bf16* u = WSP(bf16, WS_U);
    LAS unsigned char* L = F.lds;
    LAS float* DT = (LAS float*)L; LAS float* AC = DT + 256;
    LAS unsigned char* CM = L + 2048; LAS unsigned char* BM = CM + 64 * 272; LAS unsigned char* XCT = BM + 64 * 272; LAS unsigned char* MM = XCT + 256 * 144;
    LAS unsigned char* YG = XCT;
    const int t0 = b * SEQ + c * 64, tid = F.tid, lane = F.lane, wave = F.wave, fr = lane & 15, fq = lane >> 4;
    if (wave < 4) {
        const int hh = wave;
        const float dt = softplusf_(UU(t0 + lane, U_SSD_DT + hh) + KIN(I_SDTB)[layer * 4 + hh]);
        const float adt = -dt * __expf(KIN(I_SALOG)[layer * 4 + hh]);
        DT[hh * 64 + lane] = dt; AC[hh * 64 + lane] = wave_scan_add(adt, lane);
    }
    __syncthreads();
    {
        const int cc = tid; const float* cw = KIN(I_SCW) + (size_t)layer * 2048 + cc; const float w0 = cw[0], w1 = cw[512], w2 = cw[1024], w3 = cw[1536], cb = KIN(I_SCB)[layer * 512 + cc];
        const bf16* up = u + (size_t)t0 * NUP + U_SSD_X + cc;
        float win0 = 0.f, win1 = 0.f, win2 = 0.f;
        if (c > 0) { win0 = bf2f(up[-3 * NUP]); win1 = bf2f(up[-2 * NUP]); win2 = bf2f(up[-1 * NUP]); }
        const int hh = (cc >> 6) & 3;
#pragma unroll 1
        for (int l0 = 0; l0 < 64; l0 += 32) {
            float xv[32];
#pragma unroll
            for (int j = 0; j < 32; ++j) xv[j] = bf2f(up[(l0 + j) * NUP]);
#pragma unroll
            for (int j8 = 0; j8 < 4; ++j8) { float o[8];
#pragma unroll
                for (int j = 0; j < 8; ++j) { const int l = l0 + j8 * 8 + j; const float x = xv[j8 * 8 + j]; const float y = cb + w0 * win0 + w1 * win1 + w2 * win2 + w3 * x; win0 = win1; win1 = win2; win2 = x;
                    float s = siluf_(y); if (cc < 256) s *= DT[hh * 64 + l]; o[j] = s; }
                if (cc < 256) *(LAS v4u*)(XCT + cc * 144 + (l0 + j8 * 8) * 2) = pack8(o);
                else { LAS unsigned char* d2 = (cc < 384 ? BM + (cc - 256) * 2 : CM + (cc - 384) * 2) + (l0 + j8 * 8) * 272;
#pragma unroll
                    for (int j = 0; j < 8; ++j) lds_st_bf16(d2 + j * 272, o[j]); } }
        }
    }
    __syncthreads();
#pragma unroll 1
    for (int i = 0; i < 2; ++i) { const int idx = 2 * wave + i, lt = idx >> 2, st = idx & 3;
        f32x4 acc = {0.f, 0.f, 0.f, 0.f}; acc = mm16(CM + lt * 16 * 272, 272, BM + st * 16 * 272, 272, 128, acc, fr, fq);
        const int l = lt * 16 + fr, s0 = st * 16 + 4 * fq;
#pragma unroll
        for (int hh = 0; hh < 4; ++hh) { const float al = AC[hh * 64 + l], dl = KIN(I_SD)[layer * 4 + hh] / DT[hh * 64 + l]; float o[4];
#pragma unroll
            for (int j = 0; j < 4; ++j) { const int s = s0 + j; float m = (l >= s) ? acc[j] * __expf(al - AC[hh * 64 + s]) : 0.f; if (l == s) m += dl; o[j] = m; }
            lds_st_bf16x4(MM + hh * 9216 + l * 144 + s0 * 2, o[0], o[1], o[2], o[3]); } }
    __syncthreads();
    f32x4 yv[2][4];
    { const int hh = wave >> 1; const float* prev = WSP(float, WS_SSD_ST) + ((size_t)(b * 4 + hh) * NCH + c) * 8192;
      bf16x8 pf[4][4];
#pragma unroll
      for (int pt = 0; pt < 4; ++pt)
#pragma unroll
          for (int ks = 0; ks < 4; ++ks) pf[pt][ks] = ldfrag_f32(prev + (size_t)(pt * 16 + fr) * 128 + ks * 32 + fq * 8);
#pragma unroll
      for (int i = 0; i < 2; ++i) { const int lt = 2 * (wave & 1) + i, l = lt * 16 + fr; const float ea = __expf(AC[hh * 64 + l]);
#pragma unroll
          for (int pt = 0; pt < 4; ++pt) { f32x4 ad = {0.f, 0.f, 0.f, 0.f}, ao = {0.f, 0.f, 0.f, 0.f};
              ad = mm16(MM + hh * 9216 + lt * 16 * 144, 144, XCT + (hh * 64 + pt * 16) * 144, 144, 64, ad, fr, fq);
              ao = mm16_rB<4>(CM + lt * 16 * 272, 272, pf[pt], ao, fr, fq);
              const f32x4 z = UU4(t0 + l, U_SSD_Z + hh * 64 + pt * 16 + 4 * fq);
              f32x4 y = ad + ao * ea; y.x *= siluf_(z.x); y.y *= siluf_(z.y); y.z *= siluf_(z.z); y.w *= siluf_(z.w); yv[i][pt] = y; } } }
    __syncthreads();
    { const int hh = wave >> 1;
#pragma unroll
      for (int i = 0; i < 2; ++i) { const int l = (2 * (wave & 1) + i) * 16 + fr;
#pragma unroll
          for (int pt = 0; pt < 4; ++pt) *(LAS f32x4*)(YG + l * 1040 + (hh * 64 + pt * 16 + 4 * fq) * 4) = yv[i][pt]; } }
    __syncthreads();
    { const f32x4 g = *(const f32x4*)(KIN(I_SNG) + layer * 256 + 4 * lane); bf16* mix = WSP(bf16, WS_MIX);
#pragma unroll 1
      for (int i = 0; i < 8; ++i) { const int l = wave * 8 + i; const f32x4 y = *(const LAS f32x4*)(YG + l * 1040 + lane * 16);
          const float ss = wave_sum((y.x * y.x + y.y * y.y) + (y.z * y.z + y.w * y.w)); const float r = 1.0f / sqrtf(ss * (1.f / 256.f) + NORM_EPS);
          v2u o; o.x = cvt_pk_bf16(y.x * r * g.x, y.y * r * g.y); o.y = cvt_pk_bf16(y.z * r * g.z, y.w * r * g.w);
          *(v2u*)(mix + (size_t)(t0 + l) * D + 4 * lane) = o; } }
    __syncthreads();
}

__device__ __forceinline__ float gla_bcum(Frame& F, const Args& A, int layer, int d, const LAS float* GD, LAS float* BC) {
    float gup[16];
    { const f32x4* gp4 = (const f32x4*)(WSP(float, WS_LORA) + (size_t)layer * LORA_PER_LAYER + 32768 + d * 16);
#pragma unroll
      for (int i = 0; i < 4; ++i) { const f32x4 a = gp4[i]; gup[4 * i] = a.x; gup[4 * i + 1] = a.y; gup[4 * i + 2] = a.z; gup[4 * i + 3] = a.w; } }
    const float gb = KIN(I_GGB)[layer * 128 + d]; float bc = 0.f;
#pragma unroll 2
    for (int l = 0; l < 64; ++l) { float x = gb;
#pragma unroll
        for (int i = 0; i < 16; ++i) x += GD[l * 16 + i] * gup[i];
        bc += logsigmoidf_(x) * 0.0625f; BC[l * 128 + d] = bc; }
    return bc;
}
__device__ __forceinline__ void gla_stage1(Frame& F, const Args& A, int layer, int b, int c) {
    const bf16* u = WSP(bf16, WS_U);
    LAS unsigned char* L = F.lds;
    LAS float* GD = (LAS float*)L; LAS float* BC = (LAS float*)(L + 4096);
    LAS unsigned char* KDT = L + 36864; LAS unsigned char* VT = KDT + 128 * 144;
    const int t0 = b * SEQ + c * 64, tid = F.tid, lane = F.lane, wave = F.wave, fr = lane & 15, fq = lane >> 4;
    if (tid < 256) { const int l = tid >> 2, q4 = tid & 3; *(LAS f32x4*)(GD + l * 16 + q4 * 4) = UU4(t0 + l, U_GL_G + 4 * q4); }
    __syncthreads();
    if (tid < 128) {
        const int d = tid; const float blast = gla_bcum(F, A, layer, d, GD, BC);
        WSP(float, WS_GLA_DEC)[(size_t)(b * NCH + c) * 128 + d] = __expf(blast);
        const bf16* up = u + (size_t)t0 * NUP + U_GL_K + d;
#pragma unroll 1
        for (int l0 = 0; l0 < 64; l0 += 32) { float xv[32];
#pragma unroll
            for (int j = 0; j < 32; ++j) xv[j] = bf2f(up[(l0 + j) * NUP]);
#pragma unroll
            for (int j8 = 0; j8 < 4; ++j8) { float o[8];
#pragma unroll
                for (int j = 0; j < 8; ++j) { const int l = l0 + j8 * 8 + j; o[j] = xv[j8 * 8 + j] * __expf(blast - BC[l * 128 + d]); }
                *(LAS v4u*)(KDT + d * 144 + (l0 + j8 * 8) * 2) = pack8(o); } }
    } else if (tid < 384) {
        const int vch = tid - 128; const bf16* up = u + (size_t)t0 * NUP + U_GL_V + vch;
#pragma unroll 1
        for (int l0 = 0; l0 < 64; l0 += 32) { float xv[32];
#pragma unroll
            for (int j = 0; j < 32; ++j) xv[j] = bf2f(up[(l0 + j) * NUP]);
#pragma unroll
            for (int j8 = 0; j8 < 4; ++j8) { float o[8];
#pragma unroll
                for (int j = 0; j < 8; ++j) o[j] = xv[j8 * 8 + j];
                *(LAS v4u*)(VT + vch * 144 + (l0 + j8 * 8) * 2) = pack8(o); } }
    }
    __syncthreads();
    { float* st = WSP(float, WS_GLA_ST);
#pragma unroll 1
      for (int i = 0; i < 4; ++i) { const int idx = 4 * wave + i, hh = idx >> 3, dtl = (idx >> 2) & 1, vt = idx & 3;
          f32x4 acc = {0.f, 0.f, 0.f, 0.f}; acc = mm16(KDT + (hh * 32 + dtl * 16) * 144, 144, VT + (hh * 64 + vt * 16) * 144, 144, 64, acc, fr, fq);
          *(f32x4*)(st + (((size_t)(b * 4 + hh) * NCH + c) * 32 + dtl * 16 + fr) * 64 + vt * 16 + 4 * fq) = acc; } }
    __syncthreads();
}
__device__ __forceinline__ void gla_stage3(Frame& F, const Args& A, int layer, int b, int c) {
    const bf16* u = WSP(bf16, WS_U);
    LAS unsigned char* L = F.lds;
    LAS float* GD = (LAS float*)L; LAS float* BC = (LAS float*)(L + 4096); LAS unsigned char* ATT = L + 4096;
    LAS unsigned char* QD = L + 40960; LAS unsigned char* KI = QD + 64 * 272; LAS unsigned char* VT = KI + 64 * 272; LAS unsigned char* PVT = VT + 256 * 144;
    const int t0 = b * SEQ + c * 64, tid = F.tid, lane = F.lane, wave = F.wave, fr = lane & 15, fq = lane >> 4;
    if (tid < 256) { const int l = tid >> 2, q4 = tid & 3; *(LAS f32x4*)(GD + l * 16 + q4 * 4) = UU4(t0 + l, U_GL_G + 4 * q4); }
    __syncthreads();
    if (tid < 128) {
        const int d = tid; (void)gla_bcum(F, A, layer, d, GD, BC);
        const bf16* uq = u + (size_t)t0 * NUP + U_GL_Q + d; const bf16* uk = u + (size_t)t0 * NUP + U_GL_K + d;
#pragma unroll 1
        for (int l0 = 0; l0 < 64; l0 += 16) { float qv[16], kv[16];
#pragma unroll
            for (int j = 0; j < 16; ++j) { qv[j] = bf2f(uq[(l0 + j) * NUP]); kv[j] = bf2f(uk[(l0 + j) * NUP]); }
#pragma unroll
            for (int j = 0; j < 16; ++j) { const int l = l0 + j; const float bc = BC[l * 128 + d];
                lds_st_bf16(QD + l * 272 + d * 2, qv[j] * 0.17677669529663687f * __expf(bc)); lds_st_bf16(KI + l * 272 + d * 2, kv[j] * __expf(-bc)); } }
    } else if (tid < 384) {
        const int vch = tid - 128; const bf16* up = u + (size_t)t0 * NUP + U_GL_V + vch;
#pragma unroll 1
        for (int l0 = 0; l0 < 64; l0 += 32) { float xv[32];
#pragma unroll
            for (int j = 0; j < 32; ++j) xv[j] = bf2f(up[(l0 + j) * NUP]);
#pragma unroll
            for (int j8 = 0; j8 < 4; ++j8) { float o[8];
#pragma unroll
                for (int j = 0; j < 8; ++j) o[j] = xv[j8 * 8 + j];
                *(LAS v4u*)(VT + vch * 144 + (l0 + j8 * 8) * 2) = pack8(o); } }
    } else {
        const float* prev = WSP(float, WS_GLA_ST);
#pragma unroll 4
        for (int i = tid - 384; i < 8192; i += 128) { const int hh = i >> 11, dd = (i >> 6) & 31, vv = i & 63;
            lds_st_bf16(PVT + (hh * 64 + vv) * 80 + dd * 2, prev[((size_t)(b * 4 + hh) * NCH + c) * 2048 + dd * 64 + vv]); }
    }
    __syncthreads();
    const int hh = wave >> 1;
#pragma unroll 1
    for (int i = 0; i < 2; ++i) { const int tt = 2 * (wave & 1) + i, t = tt * 16 + fr;
#pragma unroll
        for (int st = 0; st < 4; ++st) { f32x4 acc = {0.f, 0.f, 0.f, 0.f}; acc = mm16(QD + tt * 16 * 272 + hh * 64, 272, KI + st * 16 * 272 + hh * 64, 272, 32, acc, fr, fq);
            const int s0 = st * 16 + 4 * fq;
            lds_st_bf16x4(ATT + hh * 9216 + t * 144 + s0 * 2, t >= s0 ? acc[0] : 0.f, t >= s0 + 1 ? acc[1] : 0.f, t >= s0 + 2 ? acc[2] : 0.f, t >= s0 + 3 ? acc[3] : 0.f); } }
    __syncthreads();
    { bf16* mix = WSP(bf16, WS_MIX); const float* ng = KIN(I_GNG) + layer * 256;
#pragma unroll 1
      for (int i = 0; i < 2; ++i) { const int tt = 2 * (wave & 1) + i, t = tt * 16 + fr; f32x4 ov[4]; float ss = 0.f;
#pragma unroll
          for (int vt = 0; vt < 4; ++vt) { f32x4 acc = {0.f, 0.f, 0.f, 0.f};
              acc = mm16(ATT + hh * 9216 + tt * 16 * 144, 144, VT + (hh * 64 + vt * 16) * 144, 144, 64, acc, fr, fq);
              acc = mm16(QD + tt * 16 * 272 + hh * 64, 272, PVT + (hh * 64 + vt * 16) * 80, 80, 32, acc, fr, fq);
              ov[vt] = acc; ss += (acc.x * acc.x + acc.y * acc.y) + (acc.z * acc.z + acc.w * acc.w); }
          ss += __shfl_xor(ss, 16); ss += __shfl_xor(ss, 32);
          const float r = 1.0f / sqrtf(ss * (1.f / 64.f) + NORM_EPS);
#pragma unroll
          for (int vt = 0; vt < 4; ++vt) { const int col = hh * 64 + vt * 16 + 4 * fq; const f32x4 g = *(const f32x4*)(ng + col); const f32x4 og = UU4(t0 + t, U_GL_OG + col);
              v2u o; o.x = cvt_pk_bf16(ov[vt].x * r * g.x * siluf_(og.x), ov[vt].y * r * g.y * siluf_(og.y)); o.y = cvt_pk_bf16(ov[vt].z * r * g.z * siluf_(og.z), ov[vt].w * r * g.w * siluf_(og.w));
              *(v2u*)(mix + (size_t)(t0 + t) * D + 512 + col) = o; } } }
    __syncthreads();
}

__device__ __forceinline__ void mlstm_stage1(Frame& F, const Args& A, int layer, int b, int c) {
    const bf16* u = WSP(bf16, WS_U);
    LAS unsigned char* L = F.lds;
    LAS float* WST = (LAS float*)L; LAS unsigned char* KT = L + 1024; LAS unsigned char* VWT = KT + 256 * 144;
    const int t0 = b * SEQ + c * 64, tid = F.tid, lane = F.lane, wave = F.wave, fr = lane & 15, fq = lane >> 4;
    if (wave < 4) {
        const int hh = wave;
        const float ig = UU(t0 + lane, U_ML_I + hh) + KIN(I_MIB)[layer * 4 + hh];
        const float lf = logsigmoidf_(UU(t0 + lane, U_ML_F + hh) + KIN(I_MFB)[layer * 4 + hh]);
        const float bc = wave_scan_add(lf, lane); const float blast = __shfl(bc, 63);
        const float ast = blast - bc + ig; const float mloc = wave_max(ast);
        WST[hh * 64 + lane] = __expf(ast - mloc);
        if (lane == 0) { WSP(float, WS_ML_BL)[(b * 4 + hh) * NCH + c] = blast; WSP(float, WS_ML_ML)[(b * 4 + hh) * NCH + c] = mloc; }
    } else {
        const int kch = tid - 256, cc = 256 + kch; const float* cw = KIN(I_MCW) + (size_t)layer * 2048 + cc; const float w0 = cw[0], w1 = cw[512], w2 = cw[1024], w3 = cw[1536], cb = KIN(I_MCB)[layer * 512 + cc];
        const bf16* up = u + (size_t)t0 * NUP + U_ML_K + kch;
        float win0 = 0.f, win1 = 0.f, win2 = 0.f;
        if (c > 0) { win0 = bf2f(up[-3 * NUP]); win1 = bf2f(up[-2 * NUP]); win2 = bf2f(up[-1 * NUP]); }
#pragma unroll 1
        for (int l0 = 0; l0 < 64; l0 += 32) { float xv[32];
#pragma unroll
            for (int j = 0; j < 32; ++j) xv[j] = bf2f(up[(l0 + j) * NUP]);
#pragma unroll
            for (int j8 = 0; j8 < 4; ++j8) { float o[8];
#pragma unroll
                for (int j = 0; j < 8; ++j) { const float x = xv[j8 * 8 + j]; const float y = cb + w0 * win0 + w1 * win1 + w2 * win2 + w3 * x; win0 = win1; win1 = win2; win2 = x; o[j] = siluf_(y); }
                *(LAS v4u*)(KT + kch * 144 + (l0 + j8 * 8) * 2) = pack8(o); } }
    }
    __syncthreads();
    if (tid < 256) {
        const int vch = tid, hh = vch >> 6; const bf16* up = u + (size_t)t0 * NUP + U_ML_V + vch;
#pragma unroll 1
        for (int l0 = 0; l0 < 64; l0 += 32) { float xv[32];
#pragma unroll
            for (int j = 0; j < 32; ++j) xv[j] = bf2f(up[(l0 + j) * NUP]);
#pragma unroll
            for (int j8 = 0; j8 < 4; ++j8) { float o[8];
#pragma unroll
                for (int j = 0; j < 8; ++j) o[j] = xv[j8 * 8 + j] * WST[hh * 64 + l0 + j8 * 8 + j];
                *(LAS v4u*)(VWT + vch * 144 + (l0 + j8 * 8) * 2) = pack8(o); } }
    } else {
        const int kch = tid - 256, hh = kch >> 6; float n = 0.f;
#pragma unroll 8
        for (int s = 0; s < 64; ++s) n += WST[hh * 64 + s] * bf2f(*(const LAS unsigned short*)(KT + kch * 144 + s * 2));
        WSP(float, WS_ML_N)[((size_t)(b * 4 + hh) * NCH + c) * 64 + (kch & 63)] = n;
    }
    __syncthreads();
    { float* cst = WSP(float, WS_ML_C); const int hh = wave >> 1;
#pragma unroll 1
      for (int i = 0; i < 2; ++i) { const int vt = 2 * (wave & 1) + i;
#pragma unroll 1
          for (int kt = 0; kt < 4; ++kt) { f32x4 acc = {0.f, 0.f, 0.f, 0.f}; acc = mm16(VWT + (hh * 64 + vt * 16) * 144, 144, KT + (hh * 64 + kt * 16) * 144, 144, 64, acc, fr, fq);
              *(f32x4*)(cst + (((size_t)(b * 4 + hh) * NCH + c) * 64 + vt * 16 + fr) * 64 + kt * 16 + 4 * fq) = acc; } } }
    __syncthreads();
}
__device__ __forceinline__ void mlstm_stage3(Frame& F, const Args& A, int layer, int b, int c) {
    const bf16* u = WSP(bf16, WS_U);
    LAS unsigned char* L = F.lds;
    LAS float* BCU = (LAS float*)L; LAS float* GG = BCU + 256; LAS float* MROW = BCU + 512; LAS float* WINT = BCU + 768; LAS float* NPV = BCU + 1024;
    LAS unsigned char* Q = L + 6144; LAS unsigned char* KK = Q + 64 * 528; LAS unsigned char* VT = KK + 64 * 528; LAS unsigned char* SC = VT + 256 * 144;
    const int t0 = b * SEQ + c * 64, tid = F.tid, lane = F.lane, wave = F.wave, fr = lane & 15, fq = lane >> 4;
    if (wave < 4) {
        const int hh = wave;
        const float ig = UU(t0 + lane, U_ML_I + hh) + KIN(I_MIB)[layer * 4 + hh];
        const float lf = logsigmoidf_(UU(t0 + lane, U_ML_F + hh) + KIN(I_MFB)[layer * 4 + hh]);
        const float bc = wave_scan_add(lf, lane); const float gg = ig - bc;
        const float mprev = WSP(float, WS_ML_M)[(b * 4 + hh) * NCH + c];
        const float minter = bc + mprev, mintra = bc + wave_scan_max(gg, lane), mrow = fmaxf(minter, mintra);
        BCU[hh * 64 + lane] = bc; GG[hh * 64 + lane] = gg; MROW[hh * 64 + lane] = mrow; WINT[hh * 64 + lane] = __expf(minter - mrow);
        NPV[hh * 64 + lane] = WSP(float, WS_ML_N)[((size_t)(b * 4 + hh) * NCH + c) * 64 + lane];
    }
    {
        const int cc = tid; const float* cw = KIN(I_MCW) + (size_t)layer * 2048 + cc; const float w0 = cw[0], w1 = cw[512], w2 = cw[1024], w3 = cw[1536], cb = KIN(I_MCB)[layer * 512 + cc];
        const bf16* up = u + (size_t)t0 * NUP + U_ML_Q + cc;
        float win0 = 0.f, win1 = 0.f, win2 = 0.f;
        if (c > 0) { win0 = bf2f(up[-3 * NUP]); win1 = bf2f(up[-2 * NUP]); win2 = bf2f(up[-1 * NUP]); }
        LAS unsigned char* dst = cc < 256 ? Q + cc * 2 : KK + (cc - 256) * 2; const float sc = cc < 256 ? 0.125f : 1.0f;
#pragma unroll 1
        for (int l0 = 0; l0 < 64; l0 += 32) { float xv[32];
#pragma unroll
            for (int j = 0; j < 32; ++j) xv[j] = bf2f(up[(l0 + j) * NUP]);
#pragma unroll
            for (int j = 0; j < 32; ++j) { const float x = xv[j]; const float y = cb + w0 * win0 + w1 * win1 + w2 * win2 + w3 * x; win0 = win1; win1 = win2; win2 = x; lds_st_bf16(dst + (l0 + j) * 528, siluf_(y) * sc); } }
        const int vch = tid & 255, lh = (tid >> 8) * 32; const bf16* uv = u + (size_t)(t0 + lh) * NUP + U_ML_V + vch;
        float xv[32];
#pragma unroll
        for (int j = 0; j < 32; ++j) xv[j] = bf2f(uv[j * NUP]);
#pragma unroll
        for (int j8 = 0; j8 < 4; ++j8) { float o[8];
#pragma unroll
            for (int j = 0; j < 8; ++j) o[j] = xv[j8 * 8 + j];
            *(LAS v4u*)(VT + vch * 144 + (lh + j8 * 8) * 2) = pack8(o); }
    }
    __syncthreads();
    { const int hh = wave >> 1; bf16* mix = WSP(bf16, WS_MIX); const float* ng = KIN(I_MNG) + layer * 256;
      const float* cprev = WSP(float, WS_ML_C) + ((size_t)(b * 4 + hh) * NCH + c) * 4096;
      bf16x8 cf[4][2];
#pragma unroll
      for (int vt = 0; vt < 4; ++vt)
#pragma unroll
          for (int ks = 0; ks < 2; ++ks) cf[vt][ks] = ldfrag_f32(cprev + (size_t)(vt * 16 + fr) * 64 + ks * 32 + fq * 8);
#pragma unroll 1
      for (int i = 0; i < 2; ++i) { const int tt = 2 * (wave & 1) + i, t = tt * 16 + fr;
          const float bt = BCU[hh * 64 + t] - MROW[hh * 64 + t]; float rs = 0.f;
#pragma unroll
          for (int st = 0; st < 4; ++st) { f32x4 acc = {0.f, 0.f, 0.f, 0.f}; acc = mm16(Q + tt * 16 * 528 + hh * 128, 528, KK + st * 16 * 528 + hh * 128, 528, 64, acc, fr, fq);
              const int s0 = st * 16 + 4 * fq; float o[4];
#pragma unroll
              for (int j = 0; j < 4; ++j) { const int s = s0 + j; const float v = (t >= s) ? acc[j] * __expf(bt + GG[hh * 64 + s]) : 0.f; o[j] = v; rs += v; }
              lds_st_bf16x4(SC + hh * 9216 + t * 144 + s0 * 2, o[0], o[1], o[2], o[3]); }
          rs += __shfl_xor(rs, 16); rs += __shfl_xor(rs, 32);
          float nq = 0.f;
#pragma unroll
          for (int j = 0; j < 16; ++j) nq += bf2f(*(const LAS unsigned short*)(Q + t * 528 + (hh * 64 + fq * 16 + j) * 2)) * NPV[hh * 64 + fq * 16 + j];
          nq += __shfl_xor(nq, 16); nq += __shfl_xor(nq, 32);
          const float wi = WINT[hh * 64 + t]; const float den = wi * nq + rs; const float dn = fmaxf(fabsf(den), __expf(-MROW[hh * 64 + t])); const float rdn = 1.0f / dn;
          LDS_WAIT();
          f32x4 hv[4]; float sm = 0.f;
#pragma unroll
          for (int vt = 0; vt < 4; ++vt) { f32x4 acc = {0.f, 0.f, 0.f, 0.f};
              acc = mm16_rB<2>(Q + tt * 16 * 528 + hh * 128, 528, cf[vt], acc, fr, fq);
              acc = acc * wi;
              acc = mm16(SC + hh * 9216 + tt * 16 * 144, 144, VT + (hh * 64 + vt * 16) * 144, 144, 64, acc, fr, fq);
              const f32x4 og = UU4(t0 + t, U_ML_O + hh * 64 + vt * 16 + 4 * fq);
              f32x4 h; h.x = acc.x * rdn * sigmoidf_(og.x); h.y = acc.y * rdn * sigmoidf_(og.y); h.z = acc.z * rdn * sigmoidf_(og.z); h.w = acc.w * rdn * sigmoidf_(og.w);
              hv[vt] = h; sm += (h.x + h.y) + (h.z + h.w); }
          sm += __shfl_xor(sm, 16); sm += __shfl_xor(sm, 32);
          const float mean = sm * (1.f / 64.f); float sq = 0.f;
#pragma unroll
          for (int vt = 0; vt < 4; ++vt) { hv[vt] = hv[vt] - mean; sq += (hv[vt].x * hv[vt].x + hv[vt].y * hv[vt].y) + (hv[vt].z * hv[vt].z + hv[vt].w * hv[vt].w); }
          sq += __shfl_xor(sq, 16); sq += __shfl_xor(sq, 32);
          const float r = 1.0f / sqrtf(sq * (1.f / 64.f) + NORM_EPS);
#pragma unroll
          for (int vt = 0; vt < 4; ++vt) { const int col = hh * 64 + vt * 16 + 4 * fq; const f32x4 g = *(const f32x4*)(ng + col);
              v2u o; o.x = cvt_pk_bf16(hv[vt].x * r * g.x, hv[vt].y * r * g.y); o.y = cvt_pk_bf16(hv[vt].z * r * g.z, hv[vt].w * r * g.w);
              *(v2u*)(mix + (size_t)(t0 + t) * D + 768 + col) = o; } } }
    __syncthreads();
}

__device__ __forceinline__ void rwkv_stage1(Frame& F, const Args& A, int layer, int ub) {
    const bf16* u = WSP(bf16, WS_U);
    LAS unsigned char* L = F.lds;
    LAS float* LOWA = (LAS float*)L;
    LAS float* CUM = (LAS float*)(L + 16384);
    LAS float* AAB = CUM;
    LAS float* TOT = CUM;
    LAS unsigned char* M0 = L + 16384 + 16640;
#define RM(i) (M0 + (i) * 9216)
    LAS float* LOG = (LAS float*)RM(0);
    LAS float* GAMC = (LAS float*)(F.MISC + MW_GAMC);
    const int t0 = ub * 64, c = ub & 63, tid = F.tid, lane = F.lane, wave = F.wave;
    const float* mu = KIN(I_RMU) + layer * 896;
#ifndef RW_DUP
#define RW_DUP -1
#endif
#define RW_REP(k) for (int rep__ = 0; rep__ < ((RW_DUP == (k)) ? 2 : 1); ++rep__)
    RW_REP(0) {
    {
        const int l = tid >> 3, jq = tid & 7, t = t0 + l; const bool has_prev = (t & (SEQ - 1)) != 0;
        f32x4 cur[4], prv[4];
#pragma unroll
        for (int q = 0; q < 4; ++q) { cur[q] = UU4(t, U_RW_LO + jq * 16 + 4 * q); prv[q] = has_prev ? UU4(t - 1, U_RW_LO + jq * 16 + 4 * q) : (f32x4){0.f, 0.f, 0.f, 0.f}; }
#pragma unroll
        for (int q = 0; q < 4; ++q) { const f32x4 m4 = *(const f32x4*)(mu + 768 + jq * 16 + 4 * q); const f32x4 xs = cur[q] + (prv[q] - cur[q]) * m4; const int j = jq * 16 + 4 * q;
            f32x4 o;
            if (j < 32) { o.x = tanhf(xs.x); o.y = tanhf(xs.y); o.z = tanhf(xs.z); o.w = tanhf(xs.w); } else if (j < 64) o = xs; else { o.x = sigmoidf_(xs.x); o.y = sigmoidf_(xs.y); o.z = sigmoidf_(xs.z); o.w = sigmoidf_(xs.w); }
            if (j < 64) *(LAS f32x4*)(LOWA + l * 64 + j) = o; else *(LAS f32x4*)(LOG + l * 64 + j - 64) = o; }
    }
    __syncthreads();
    { const int ch = tid & 255, half = tid >> 8; float* RG = WSP(float, WS_RW_G);
      float gup[64];
      { const f32x4* gp4 = (const f32x4*)(WSP(float, WS_LORA) + (size_t)layer * LORA_PER_LAYER + 16384 + ch * 64);
#pragma unroll
        for (int j = 0; j < 16; ++j) { const f32x4 a = gp4[j]; gup[4 * j] = a.x; gup[4 * j + 1] = a.y; gup[4 * j + 2] = a.z; gup[4 * j + 3] = a.w; } }
#pragma unroll 2
      for (int li = 0; li < 32; ++li) { const int l = half * 32 + li; float g0 = 0.f, g1 = 0.f;
#pragma unroll
          for (int j = 0; j < 16; ++j) { const f32x4 x4 = *(const LAS f32x4*)(LOG + l * 64 + 4 * j); g0 += x4.x * gup[4 * j] + x4.y * gup[4 * j + 1]; g1 += x4.z * gup[4 * j + 2] + x4.w * gup[4 * j + 3]; }
          RG[(size_t)(t0 + l) * 256 + ch] = g0 + g1; } }
    __syncthreads();
    }
    const int b_ = ub >> 6;
#pragma unroll 1
    for (int hh = 0; hh < 4; ++hh) {
        int ch = lane, fr = lane & 15, fq = lane >> 4; asm volatile("" : "+v"(ch), "+v"(fr), "+v"(fq));
        const int tg = wave, cg = hh * 64 + ch; const size_t un = (size_t)(b_ * 4 + hh) * NCH + c;
        float rr[8], k2r[8], vr[8], ar[8], br[8], pl[8];
        RW_REP(1) {
            float wup[32], aup[32];
            { const f32x4* wp4 = (const f32x4*)(WSP(float, WS_LORA) + (size_t)layer * LORA_PER_LAYER + cg * 32); const f32x4* ap4 = (const f32x4*)(WSP(float, WS_LORA) + (size_t)layer * LORA_PER_LAYER + 8192 + cg * 32);
#pragma unroll
              for (int j = 0; j < 8; ++j) { const f32x4 a = wp4[j], b = ap4[j]; wup[4 * j] = a.x; wup[4 * j + 1] = a.y; wup[4 * j + 2] = a.z; wup[4 * j + 3] = a.w; aup[4 * j] = b.x; aup[4 * j + 1] = b.y; aup[4 * j + 2] = b.z; aup[4 * j + 3] = b.w; } }
            const float w0 = KIN(I_RW0)[layer * 256 + cg], a0 = KIN(I_RA0)[layer * 256 + cg], kkc = KIN(I_RKK)[layer * 256 + cg], kac = KIN(I_RKA)[layer * 256 + cg];
            const float mur = mu[cg], muk = mu[256 + cg], muv = mu[512 + cg];
            const int tb = t0 + tg * 8; const bool nop = (c == 0) && (tg == 0);
            float rp = nop ? 0.f : UU(tb - 1, U_RW_R + cg), kp = nop ? 0.f : UU(tb - 1, U_RW_K + cg), vp = nop ? 0.f : UU(tb - 1, U_RW_V + cg);
            float rc[8], kc[8], vc[8];
#pragma unroll
            for (int j = 0; j < 8; ++j) { rc[j] = UU(tb + j, U_RW_R + cg); kc[j] = UU(tb + j, U_RW_K + cg); vc[j] = UU(tb + j, U_RW_V + cg); }
            float* RW = WSP(float, WS_RW);
            float kk[8], al[8], n2[8], run = 0.f;
#pragma unroll
            for (int j = 0; j < 8; ++j) { const int l = tg * 8 + j;
                const float r = rc[j] + (rp - rc[j]) * mur, k = kc[j] + (kp - kc[j]) * muk, v = vc[j] + (vp - vc[j]) * muv; rp = rc[j]; kp = kc[j]; vp = vc[j];
                float wp = w0, ap = a0;
#pragma unroll
                for (int q = 0; q < 8; ++q) { const f32x4 lw4 = *(const LAS f32x4*)(LOWA + l * 64 + 4 * q), la4 = *(const LAS f32x4*)(LOWA + l * 64 + 32 + 4 * q);
                    wp += (lw4.x * wup[4 * q] + lw4.y * wup[4 * q + 1]) + (lw4.z * wup[4 * q + 2] + lw4.w * wup[4 * q + 3]); ap += (la4.x * aup[4 * q] + la4.y * aup[4 * q + 1]) + (la4.z * aup[4 * q + 2] + la4.w * aup[4 * q + 3]); }
                const float w = -softplusf_(-wp) - 0.5f; run += -__expf(w); pl[j] = run; al[j] = sigmoidf_(ap);
                kk[j] = k * kkc; n2[j] = kk[j] * kk[j];
                k2r[j] = k * (1.0f + (al[j] - 1.0f) * kac); rr[j] = r; vr[j] = v;
                float* o = RW + (size_t)(tb + j) * 768 + cg; o[0] = r; o[256] = k2r[j]; o[512] = v; }
#pragma unroll
            for (int i = 0; i < 4; ++i) { const bool hi = (ch & 32) != 0; const float keep = hi ? n2[i + 4] : n2[i], send = hi ? n2[i] : n2[i + 4]; n2[i] = keep + __shfl_xor(send, 32); }
#pragma unroll
            for (int i = 0; i < 2; ++i) { const bool hi = (ch & 16) != 0; const float keep = hi ? n2[i + 2] : n2[i], send = hi ? n2[i] : n2[i + 2]; n2[i] = keep + __shfl_xor(send, 16); }
            { const bool hi = (ch & 8) != 0; const float keep = hi ? n2[1] : n2[0], send = hi ? n2[0] : n2[1]; n2[0] = keep + __shfl_xor(send, 8); }
            n2[0] += __shfl_xor(n2[0], 4); n2[0] += __shfl_xor(n2[0], 2); n2[0] += __shfl_xor(n2[0], 1);
#pragma unroll
            for (int j = 0; j < 8; ++j) { const float tot = __builtin_bit_cast(float, __builtin_amdgcn_readlane(__builtin_bit_cast(int, n2[0]), ((j & 4) ? 32 : 0) + ((j & 2) ? 16 : 0) + ((j & 1) ? 8 : 0)));
                const float kkn = kk[j] / fmaxf(sqrtf(tot), 1e-12f); ar[j] = -kkn; br[j] = kkn * al[j]; }
            TOT[tg * 64 + ch] = run;
        }
        __syncthreads();
        RW_REP(3) {
            float off = 0.f, gC = 0.f;
#pragma unroll
            for (int g = 0; g < 8; ++g) { const float tv = TOT[g * 64 + ch]; gC += tv; if (g < tg) off += tv; }
            float oat[8], obb[8], okb[8], ov[8];
#pragma unroll
            for (int j = 0; j < 8; ++j) { const int l = tg * 8 + j; const float gt = off + pl[j], gm = j > 0 ? off + pl[j - 1] : off;
                const float at = ar[j] * __expf(gm), rt = rr[j] * __expf(gt), en = __expf(-gt), ec = __expf(gC - gt);
                lds_st_bf16(RM(0) + l * 144 + ch * 2, at); lds_st_bf16(RM(1) + l * 144 + ch * 2, rt); lds_st_bf16(RM(2) + l * 144 + ch * 2, br[j] * en); lds_st_bf16(RM(3) + l * 144 + ch * 2, k2r[j] * en);
                oat[j] = at; obb[j] = br[j] * ec; okb[j] = k2r[j] * ec; ov[j] = vr[j]; }
            *(LAS v4u*)(RM(4) + ch * 144 + tg * 16) = pack8(oat); *(LAS v4u*)(RM(5) + ch * 144 + tg * 16) = pack8(obb); *(LAS v4u*)(RM(6) + ch * 144 + tg * 16) = pack8(okb); *(LAS v4u*)(RM(7) + ch * 144 + tg * 16) = pack8(ov);
            if (tg == 0) GAMC[ch] = __expf(gC);
        }
        __syncthreads();
        RW_REP(4) {
            const int which = wave >> 1; const LAS unsigned char* Aop = which < 2 ? RM(0) : RM(1); const LAS unsigned char* Bop = (which & 1) ? RM(3) : RM(2);
#pragma unroll 1
            for (int i2 = 0; i2 < 2; ++i2) { const int tt = 2 * (wave & 1) + i2, t = tt * 16 + fr;
#pragma unroll
                for (int it = 0; it < 4; ++it) { f32x4 acc = {0.f, 0.f, 0.f, 0.f}; acc = mm16(Aop + tt * 16 * 144, 144, Bop + it * 16 * 144, 144, 64, acc, fr, fq);
                    const int i0 = it * 16 + 4 * fq; const int lim = which < 2 ? t : t + 1;
                    const float o0 = (i0 < lim) ? acc[0] : 0.f, o1 = (i0 + 1 < lim) ? acc[1] : 0.f, o2 = (i0 + 2 < lim) ? acc[2] : 0.f, o3 = (i0 + 3 < lim) ? acc[3] : 0.f;
#ifdef RW_CLAMP_AAK
                    float q0 = o0, q1 = o1, q2 = o2, q3 = o3;
                    if (which == 1) { q0 = fabsf(o0) < 1e30f ? o0 : 0.f; q1 = fabsf(o1) < 1e30f ? o1 : 0.f; q2 = fabsf(o2) < 1e30f ? o2 : 0.f; q3 = fabsf(o3) < 1e30f ? o3 : 0.f; }
                    if (which == 0) *(LAS f32x4*)(AAB + t * 64 + i0) = (f32x4){o0, o1, o2, o3};
                    else lds_st_bf16x4(RM(7 + which) + t * 144 + i0 * 2, q0, q1, q2, q3);
                    continue;
#endif
                    if (which == 0) { DBG_STAT(11, o0); DBG_STAT(11, o1); DBG_STAT(11, o2); DBG_STAT(11, o3); } if (which == 1) { DBG_STAT(12, o0); DBG_STAT(12, o1); DBG_STAT(12, o2); DBG_STAT(12, o3); } if (which == 2) { DBG_STAT(13, o0); DBG_STAT(13, o3); } if (which == 3) { DBG_STAT(14, o0); DBG_STAT(14, o3); }
                    if (which == 0) *(LAS f32x4*)(AAB + t * 64 + i0) = (f32x4){o0, o1, o2, o3};
                    else lds_st_bf16x4(RM(7 + which) + t * 144 + i0 * 2, o0, o1, o2, o3); } }
        }
        __syncthreads();
        RW_REP(5) {
#pragma unroll 1
            for (int i2 = 0; i2 < 2; ++i2) { const int idx = wave * 2 + i2, vt = idx >> 2, tt = idx & 3; f32x4 acc = {0.f, 0.f, 0.f, 0.f};
                acc = mm16(RM(7) + vt * 16 * 144, 144, RM(8) + tt * 16 * 144, 144, 64, acc, fr, fq);
                DBG_STAT(15, acc[0]); DBG_STAT(15, acc[1]); DBG_STAT(15, acc[2]); DBG_STAT(15, acc[3]);
                lds_st_bf16x4(RM(0) + (vt * 16 + fr) * 144 + (tt * 16 + 4 * fq) * 2, acc[0], acc[1], acc[2], acc[3]); }
        }
        RW_REP(8) if (wave == 0) {
            float x[64]; f32x4 rowq[16];
#pragma unroll
            for (int t = 0; t < 64; ++t) {
                f32x4 cur[16];
#pragma unroll
                for (int i4 = 0; i4 < (t + 3) / 4; ++i4) cur[i4] = rowq[i4];
                if (t + 1 < 64) {
#pragma unroll
                    for (int i4 = 0; i4 < (t + 4) / 4; ++i4) rowq[i4] = *(const LAS f32x4*)(AAB + (t + 1) * 64 + 4 * i4); }
                float a0 = (t == ch) ? 1.0f : 0.f, a1 = 0.f, a2 = 0.f, a3 = 0.f;
#pragma unroll
                for (int i4 = 0; i4 < (t + 3) / 4; ++i4) { const f32x4 q = cur[i4];
                    a0 += q.x * x[4 * i4]; if (4 * i4 + 1 < t) a1 += q.y * x[4 * i4 + 1]; if (4 * i4 + 2 < t) a2 += q.z * x[4 * i4 + 2]; if (4 * i4 + 3 < t) a3 += q.w * x[4 * i4 + 3]; }
                const float acc = (a0 + a1) + (a2 + a3);
                x[t] = acc; lds_st_bf16(RM(11) + t * 144 + ch * 2, acc); }
        }
        __syncthreads();
        RW_REP(6) {
            const int rt = wave >> 1;
#pragma unroll
            for (int i2 = 0; i2 < 2; ++i2) { const int tt = 2 * (wave & 1) + i2;
                f32x4 acc = {0.f, 0.f, 0.f, 0.f}; acc = mm16(RM(4) + rt * 16 * 144, 144, RM(11) + tt * 16 * 144, 144, 64, acc, fr, fq);
                DBG_STAT(17, acc[0]); DBG_STAT(17, acc[1]); DBG_STAT(17, acc[2]); DBG_STAT(17, acc[3]);
                lds_st_bf16x4(RM(2) + (rt * 16 + fr) * 144 + (tt * 16 + 4 * fq) * 2, acc[0], acc[1], acc[2], acc[3]);
                f32x4 ac2 = {0.f, 0.f, 0.f, 0.f}; ac2 = mm16(RM(0) + rt * 16 * 144, 144, RM(11) + tt * 16 * 144, 144, 64, ac2, fr, fq);
                DBG_STAT(18, ac2[0]); DBG_STAT(18, ac2[1]); DBG_STAT(18, ac2[2]); DBG_STAT(18, ac2[3]);
                lds_st_bf16x4(RM(3) + (rt * 16 + fr) * 144 + (tt * 16 + 4 * fq) * 2, ac2[0], ac2[1], ac2[2], ac2[3]); }
        }
        __syncthreads();
        RW_REP(7) {
            const int which = wave >> 1;
#pragma unroll 1
            for (int i2 = 0; i2 < 2; ++i2) { const int rt = 2 * (wave & 1) + i2, row = rt * 16 + fr;
#pragma unroll
                for (int ct = 0; ct < 4; ++ct) { f32x4 acc = {0.f, 0.f, 0.f, 0.f}; const int c0 = ct * 16 + 4 * fq;
                    if (which == 0) { acc = mm16(RM(9) + rt * 16 * 144, 144, RM(2) + ct * 16 * 144, 144, 64, acc, fr, fq);
                        const v2u rw = *(const LAS v2u*)(RM(1) + row * 144 + c0 * 2);
                        acc[0] += __uint_as_float(rw.x << 16); acc[1] += __uint_as_float(rw.x & 0xffff0000u); acc[2] += __uint_as_float(rw.y << 16); acc[3] += __uint_as_float(rw.y & 0xffff0000u);
                        DBG_STAT(19, acc[0]); DBG_STAT(19, acc[1]); DBG_STAT(19, acc[2]); DBG_STAT(19, acc[3]);
                        v2u o; o.x = cvt_pk_bf16(acc[0], acc[1]); o.y = cvt_pk_bf16(acc[2], acc[3]); *(v2u*)(WSP(bf16, WS_RW_RH) + un * 4096 + row * 64 + c0) = o; }
                    else if (which == 1) {
#ifndef RW_NO_U0
                        acc = mm16(RM(9) + rt * 16 * 144, 144, RM(3) + ct * 16 * 144, 144, 64, acc, fr, fq);
#endif
                        acc = mm16(RM(10) + rt * 16 * 144, 144, RM(7) + ct * 16 * 144, 144, 64, acc, fr, fq);
                        DBG_STAT(20, acc[0]); DBG_STAT(20, acc[1]); DBG_STAT(20, acc[2]); DBG_STAT(20, acc[3]);
                        *(f32x4*)(WSP(float, WS_RW_O0) + un * 4096 + row * 64 + c0) = acc; }
                    else if (which == 2) { acc = mm16(RM(5) + rt * 16 * 144, 144, RM(2) + ct * 16 * 144, 144, 64, acc, fr, fq);
                        const float gd = GAMC[row]; if (row == c0) acc[0] += gd; if (row == c0 + 1) acc[1] += gd; if (row == c0 + 2) acc[2] += gd; if (row == c0 + 3) acc[3] += gd;
                        DBG_STAT(21, acc[0]); DBG_STAT(21, acc[1]); DBG_STAT(21, acc[2]); DBG_STAT(21, acc[3]);
                        v2u o; o.x = cvt_pk_bf16(acc[0], acc[1]); o.y = cvt_pk_bf16(acc[2], acc[3]);
                        *(v2u*)((unsigned char*)(WSP(bf16, WS_RW_GF) + un * 4096) + ((rt * 2 + (ct >> 1)) * 64 + ch) * 16 + (ct & 1) * 8) = o; }
                    else { acc = mm16(RM(3) + rt * 16 * 144, 144, RM(5) + ct * 16 * 144, 144, 64, acc, fr, fq); acc = mm16(RM(7) + rt * 16 * 144, 144, RM(6) + ct * 16 * 144, 144, 64, acc, fr, fq);
                        DBG_STAT(22, acc[0]); DBG_STAT(22, acc[1]); DBG_STAT(22, acc[2]); DBG_STAT(22, acc[3]);
                        *(f32x4*)(WSP(float, WS_RW_HT) + un * 4096 + row * 64 + c0) = acc; } } }
        }
        __syncthreads();
    }
#undef RM
}
__device__ __forceinline__ void rwkv_scan_wave(Frame& F, const Args& A, int wslot) {
    const int lane = F.lane, fr = lane & 15, fq = lane >> 4, bh = wslot >> 2, v0 = (wslot & 3) * 16;
    const bf16* GF = WSP(bf16, WS_RW_GF) + (size_t)bh * NCH * 4096; const float* HT = WSP(float, WS_RW_HT) + (size_t)bh * NCH * 4096 + (size_t)(v0 + fr) * 64 + 4 * fq;
    bf16* PT = WSP(bf16, WS_RW_PT) + (size_t)bh * NCH * 4096 + (size_t)(v0 + fr) * 64 + 4 * fq;
    f32x4 P[4] = {{0.f, 0.f, 0.f, 0.f}, {0.f, 0.f, 0.f, 0.f}, {0.f, 0.f, 0.f, 0.f}, {0.f, 0.f, 0.f, 0.f}};
    bf16x8 ga[4][2]; f32x4 hv[4];
#define RW2_LOAD(cc) do { _Pragma("unroll") for (int m = 0; m < 4; ++m) { hv[m] = *(const f32x4*)(HT + (size_t)(cc) * 4096 + 16 * m); \
        _Pragma("unroll") for (int s = 0; s < 2; ++s) ga[m][s] = *(const bf16x8*)(GF + (size_t)(cc) * 4096 + ((m * 2 + s) * 64 + lane) * 8); } } while (0)
    RW2_LOAD(0);
#pragma unroll 1
    for (int c = 0; c < NCH; ++c) {
        bf16x8 gc[4][2]; f32x4 acc[4];
#pragma unroll
        for (int m = 0; m < 4; ++m) { acc[m] = hv[m]; gc[m][0] = ga[m][0]; gc[m][1] = ga[m][1]; }
        if (c + 1 < NCH) RW2_LOAD(c + 1);
        v4u bs[2];
#pragma unroll
        for (int s = 0; s < 2; ++s) { bs[s].x = cvt_pk_bf16(P[2 * s][0], P[2 * s][1]); bs[s].y = cvt_pk_bf16(P[2 * s][2], P[2 * s][3]); bs[s].z = cvt_pk_bf16(P[2 * s + 1][0], P[2 * s + 1][1]); bs[s].w = cvt_pk_bf16(P[2 * s + 1][2], P[2 * s + 1][3]); }
        *(v2u*)(PT + (size_t)c * 4096) = (v2u){bs[0].x, bs[0].y}; *(v2u*)(PT + (size_t)c * 4096 + 16) = (v2u){bs[0].z, bs[0].w};
        *(v2u*)(PT + (size_t)c * 4096 + 32) = (v2u){bs[1].x, bs[1].y}; *(v2u*)(PT + (size_t)c * 4096 + 48) = (v2u){bs[1].z, bs[1].w};
#pragma unroll
        for (int m = 0; m < 4; ++m) { acc[m] = __builtin_amdgcn_mfma_f32_16x16x32_bf16(gc[m][0], __builtin_bit_cast(bf16x8, bs[0]), acc[m], 0, 0, 0);
            acc[m] = __builtin_amdgcn_mfma_f32_16x16x32_bf16(gc[m][1], __builtin_bit_cast(bf16x8, bs[1]), acc[m], 0, 0, 0); P[m] = acc[m]; DBG_STAT(23, acc[m][0]); DBG_STAT(23, acc[m][1]); DBG_STAT(23, acc[m][2]); DBG_STAT(23, acc[m][3]); }
    }
#undef RW2_LOAD
}
__device__ __forceinline__ void rwkv_stage3(Frame& F, const Args& A, int layer, int ub) {
    const int t0 = ub * 64, b_ = ub >> 6, c = ub & 63, lane = F.lane, wave = F.wave, fr = lane & 15, fq = lane >> 4, hh = wave >> 1;
    const size_t un = (size_t)(b_ * 4 + hh) * NCH + c;
    const bf16* RH = WSP(bf16, WS_RW_RH) + un * 4096; const bf16* PT = WSP(bf16, WS_RW_PT) + un * 4096; const float* O0 = WSP(float, WS_RW_O0) + un * 4096;
    const float* RW = WSP(float, WS_RW); const float* RG = WSP(float, WS_RW_G); bf16* mix = WSP(bf16, WS_MIX);
    const float* lg = KIN(I_RLNG) + layer * 256 + hh * 64; const float* lb = KIN(I_RLNB) + layer * 256 + hh * 64; const float* rk = KIN(I_RRK) + layer * 256 + hh * 64;
    bf16x8 pfr[4][2];
#pragma unroll
    for (int vt = 0; vt < 4; ++vt)
#pragma unroll
        for (int ks = 0; ks < 2; ++ks) pfr[vt][ks] = *(const bf16x8*)(PT + (size_t)(vt * 16 + fr) * 64 + ks * 32 + fq * 8);
#pragma unroll 1
    for (int i = 0; i < 2; ++i) { const int tt = 2 * (wave & 1) + i, tl = tt * 16 + fr, t = t0 + tl;
        const bf16x8 ra0 = *(const bf16x8*)(RH + (size_t)tl * 64 + fq * 8), ra1 = *(const bf16x8*)(RH + (size_t)tl * 64 + 32 + fq * 8);
        f32x4 ov[4]; float sm = 0.f;
#pragma unroll
        for (int vt = 0; vt < 4; ++vt) { f32x4 acc = *(const f32x4*)(O0 + tl * 64 + vt * 16 + 4 * fq);
            acc = __builtin_amdgcn_mfma_f32_16x16x32_bf16(pfr[vt][0], ra0, acc, 0, 0, 0); acc = __builtin_amdgcn_mfma_f32_16x16x32_bf16(pfr[vt][1], ra1, acc, 0, 0, 0);
            ov[vt] = acc; DBG_STAT(24, acc[0]); DBG_STAT(24, acc[1]); DBG_STAT(24, acc[2]); DBG_STAT(24, acc[3]); sm += (acc.x + acc.y) + (acc.z + acc.w); }
        sm += __shfl_xor(sm, 16); sm += __shfl_xor(sm, 32);
        const float mean = sm * (1.f / 64.f); float sq = 0.f;
#pragma unroll
        for (int vt = 0; vt < 4; ++vt) { ov[vt] = ov[vt] - mean; sq += (ov[vt].x * ov[vt].x + ov[vt].y * ov[vt].y) + (ov[vt].z * ov[vt].z + ov[vt].w * ov[vt].w); }
        sq += __shfl_xor(sq, 16); sq += __shfl_xor(sq, 32);
        const float rs = 1.0f / sqrtf(sq * (1.f / 64.f) + RWKV_GN_EPS);
        float bd = 0.f;
#pragma unroll
        for (int q = 0; q < 4; ++q) { const f32x4 r4 = *(const f32x4*)(RW + (size_t)t * 768 + hh * 64 + fq * 16 + 4 * q), k4 = *(const f32x4*)(RW + (size_t)t * 768 + 256 + hh * 64 + fq * 16 + 4 * q), c4 = *(const f32x4*)(rk + fq * 16 + 4 * q);
            bd += (r4.x * k4.x * c4.x + r4.y * k4.y * c4.y) + (r4.z * k4.z * c4.z + r4.w * k4.w * c4.w); }
        bd += __shfl_xor(bd, 16); bd += __shfl_xor(bd, 32);
#pragma unroll
        for (int vt = 0; vt < 4; ++vt) { const int col = vt * 16 + 4 * fq; const f32x4 g4 = *(const f32x4*)(lg + col), b4 = *(const f32x4*)(lb + col);
            const f32x4 v4 = *(const f32x4*)(RW + (size_t)t * 768 + 512 + hh * 64 + col), gg = *(const f32x4*)(RG + (size_t)t * 256 + hh * 64 + col);
            float e0 = (ov[vt].x * rs * g4.x + b4.x + bd * v4.x) * gg.x, e1 = (ov[vt].y * rs * g4.y + b4.y + bd * v4.y) * gg.y, e2 = (ov[vt].z * rs * g4.z + b4.z + bd * v4.z) * gg.z, e3 = (ov[vt].w * rs * g4.w + b4.w + bd * v4.w) * gg.w;
#ifdef RW_SANITIZE
            e0 = (fabsf(e0) < 1e30f) ? e0 : 0.f; e1 = (fabsf(e1) < 1e30f) ? e1 : 0.f; e2 = (fabsf(e2) < 1e30f) ? e2 : 0.f; e3 = (fabsf(e3) < 1e30f) ? e3 : 0.f;
#endif
            v2u o; o.x = cvt_pk_bf16(e0, e1); o.y = cvt_pk_bf16(e2, e3);
            *(v2u*)(mix + (size_t)t * D + 256 + hh * 64 + col) = o; } }
}

__device__ __forceinline__ void scans_elementwise(Frame& F, const Args& A) {
    const int nthr = F.G * 448, gt = F.vcu * 448 + (F.tid - 64);
    constexpr int N_SSD = 16 * 64 * 128, N_GLA = 16 * 32 * 64, N_MLC = 16 * 64 * 64, N_MLN = 16 * 64;
    for (int i = gt; i < N_SSD + N_GLA + N_MLC + N_MLN; i += nthr) {
        if (i < N_SSD) { const int bh = i >> 13, pn = i & 8191; float* base = WSP(float, WS_SSD_ST) + (size_t)bh * NCH * 8192 + pn; const float* dec = WSP(float, WS_SSD_DEC) + bh * NCH; float S = 0.f;
#pragma unroll 1
            for (int c0 = 0; c0 < NCH; c0 += 8) { float x[8], dd[8];
#pragma unroll
                for (int j = 0; j < 8; ++j) { x[j] = base[(size_t)(c0 + j) * 8192]; dd[j] = dec[c0 + j]; }
#pragma unroll
                for (int j = 0; j < 8; ++j) { base[(size_t)(c0 + j) * 8192] = S; S = dd[j] * S + x[j]; } }
        } else if (i < N_SSD + N_GLA) { const int k = i - N_SSD, bh = k >> 11, dv = k & 2047, dd_ = dv >> 6, b = bh >> 2, hh = bh & 3; float* base = WSP(float, WS_GLA_ST) + (size_t)bh * NCH * 2048 + dv; const float* dec = WSP(float, WS_GLA_DEC) + (size_t)b * NCH * 128 + hh * 32 + dd_; float S = 0.f;
#pragma unroll 1
            for (int c0 = 0; c0 < NCH; c0 += 8) { float x[8], dd[8];
#pragma unroll
                for (int j = 0; j < 8; ++j) { x[j] = base[(size_t)(c0 + j) * 2048]; dd[j] = dec[(c0 + j) * 128]; }
#pragma unroll
                for (int j = 0; j < 8; ++j) { base[(size_t)(c0 + j) * 2048] = S; S = dd[j] * S + x[j]; } }
        } else { const int k = i - N_SSD - N_GLA; const bool isn = k >= N_MLC; const int kk = isn ? k - N_MLC : k; const int bh = isn ? (kk >> 6) : (kk >> 12), e = isn ? (kk & 63) : (kk & 4095), str = isn ? 64 : 4096;
            float* base = (isn ? WSP(float, WS_ML_N) : WSP(float, WS_ML_C)) + (size_t)bh * NCH * str + e; const float* bl = WSP(float, WS_ML_BL) + bh * NCH; const float* ml = WSP(float, WS_ML_ML) + bh * NCH; float* mo = WSP(float, WS_ML_M) + bh * NCH;
            float S = 0.f, m = 0.f;
#pragma unroll 1
            for (int c0 = 0; c0 < NCH; c0 += 8) { float x[8], b8[8], m8[8];
#pragma unroll
                for (int j = 0; j < 8; ++j) { x[j] = base[(size_t)(c0 + j) * str]; b8[j] = bl[c0 + j]; m8[j] = ml[c0 + j]; }
#pragma unroll
                for (int j = 0; j < 8; ++j) { const float mn = fmaxf(b8[j] + m, m8[j]); const float so = __expf(b8[j] + m - mn), sn = __expf(m8[j] - mn);
                    base[(size_t)(c0 + j) * str] = S; if (!isn && e == 0) mo[c0 + j] = m; S = so * S + sn * x[j]; m = mn; } }
        }
    }
}
#ifndef MK_PER_PHASE_LAUNCH
#define MK_PER_PHASE_LAUNCH 0
#endif
#ifndef PH_MASK
#define PH_MASK 0xFFF
#endif
#ifndef ST_MASK
#define ST_MASK 0xF
#endif
#define ST_ON(k) (((ST_MASK) >> (k)) & 1)
#ifndef DUP_MASK
#define DUP_MASK 0x100
#endif
#define DUP_N(k) ((((DUP_MASK) >> (k)) & 1) ? 2 : 1)
#ifndef ST_DUP
#define ST_DUP 0
#endif
#define ST_REP(ty) ((((ST_DUP) >> (ty)) & 1) ? 2 : 1)
#define PH_ON(k) (((PH_MASK) >> (k)) & 1)
constexpr int PH_PER_LAYER = 11, N_PHASES = 1 + DEPTH * PH_PER_LAYER;
__global__ void __launch_bounds__(NWAVES * 64, 2) fwd_kernel(Args args) {
    extern __shared__ __attribute__((aligned(16))) unsigned char lds[];
    Frame F;
    F.lds = (LAS unsigned char*)lds;
    F.MISC = (volatile LAS unsigned*)(F.lds + MISC_OFF);
    F.tid = threadIdx.x; F.lane = F.tid & 63; F.wave = __builtin_amdgcn_readfirstlane(F.tid >> 6);
    F.G = gridDim.x; { const int bx = blockIdx.x; F.vcu = (F.G % 8 == 0) ? (bx % 8) * (F.G / 8) + bx / 8 : bx; }
    F.ka = (karg_t)__builtin_amdgcn_kernarg_segment_ptr(); F.ws = args.ws; F.ctl = (gu32*)(args.ws + WS_CTL); F.out = args.out;
    for (int i = F.tid; i < 256; i += NWAVES * 64) F.MISC[i] = 0u;
    __syncthreads();
    const int lo = args.ph_lo, hi = args.ph_hi;
    XcdBarrier bar; bar.bar = (unsigned*)(F.ctl + CW_BAR); bar.x = 0; bar.st = nullptr;
    if (hi - lo > 1) bar = xcd_barrier_post((unsigned*)(F.ctl + CW_BAR), F.MISC + MW_BAR);
#define IN_(k) (lo <= (k) && (k) < hi)
#define SEAM(k) do { if (IN_(k) && IN_((k) + 1)) xcd_barrier(bar); } while (0)

    if (PH_ON(11) && IN_(0)) { for (int rep_ = 0; rep_ < DUP_N(11); ++rep_) { frame_refresh(F); p0_prologue(F, args); } SEAM(0); }
#pragma unroll 1
    for (int layer = 0; layer < DEPTH; ++layer) {
        const int pb = 1 + layer * PH_PER_LAYER;
        if (PH_ON(0) && IN_(pb + 0)) { for (int rep_ = 0; rep_ < DUP_N(0); ++rep_) { frame_refresh(F);
            { pg8::DenseSched S; S.init(WSP(bf16, WS_XB), WSP(bf16, WS_WIN_T) + (size_t)layer * NUP * D, T, NUP, D, F.G, (int)blockIdx.x);
              pg8::EpiB16 E{WSP(bf16, WS_U), NUP, nullptr, 0.f};
              pg8::gemm_phase<pg8::EpiB16, pg8::DenseSched>(F.lds, F.tid, S, E); }
            { pg8::DenseSched S; S.init(WSP(bf16, WS_PB) + (size_t)layer * T * 256, WSP(bf16, WS_WPP_T) + (size_t)layer * D * 256, T, D, 256, F.G, (int)blockIdx.x);
              pg8::EpiB16 E{WSP(bf16, WS_PE), D, nullptr, 0.f};
              pg8::gemm_phase<pg8::EpiB16, pg8::DenseSched>(F.lds, F.tid, S, E); }
            } SEAM(pb + 0);
        }
        if (PH_ON(1) && IN_(pb + 1)) { for (int rep_ = 0; rep_ < DUP_N(1); ++rep_) { frame_refresh(F);
            for (int un = F.vcu; un < 1024; un += F.G) { frame_refresh(F); const int ty = un >> 8, r = un & 255, b = r >> 6, c = r & 63;
                if (ty == 0) { ssd_stage1(F, args, layer, b, c); if (ST_DUP & 1) ssd_stage1(F, args, layer, b, c); } else if (ty == 1) { gla_stage1(F, args, layer, b, c); if (ST_DUP & 2) gla_stage1(F, args, layer, b, c); } else if (ty == 2) { mlstm_stage1(F, args, layer, b, c); if (ST_DUP & 4) mlstm_stage1(F, args, layer, b, c); } else { rwkv_stage1(F, args, layer, r); if (ST_DUP & 8) rwkv_stage1(F, args, layer, r); } }
            } SEAM(pb + 1);
        }
        if (PH_ON(2) && IN_(pb + 2)) { for (int rep_ = 0; rep_ < DUP_N(2); ++rep_) { frame_refresh(F);
            if (F.wave == 0) { for (int ws_ = F.vcu; ws_ < 64; ws_ += F.G) rwkv_scan_wave(F, args, ws_); }
            else if (rep_ == 0) scans_elementwise(F, args);
            } SEAM(pb + 2);
        }
        if (PH_ON(3) && IN_(pb + 3)) { for (int rep_ = 0; rep_ < DUP_N(3); ++rep_) { frame_refresh(F);
            for (int un = F.vcu; un < 1024; un += F.G) { frame_refresh(F); const int ty = un >> 8, r = un & 255, b = r >> 6, c = r & 63;
                if (ty == 0) { ssd_stage3(F, args, layer, b, c); if (ST_DUP & 16) ssd_stage3(F, args, layer, b, c); } else if (ty == 1) { gla_stage3(F, args, layer, b, c); if (ST_DUP & 32) gla_stage3(F, args, layer, b, c); } else if (ty == 2) { mlstm_stage3(F, args, layer, b, c); if (ST_DUP & 64) mlstm_stage3(F, args, layer, b, c); } else { rwkv_stage3(F, args, layer, r); if (ST_DUP & 128) rwkv_stage3(F, args, layer, r); } }
            } SEAM(pb + 3);
        }
        if (PH_ON(4) && IN_(pb + 4)) { for (int rep_ = 0; rep_ < DUP_N(4); ++rep_) { frame_refresh(F);
            pg8::DenseSched S; S.init(WSP(bf16, WS_MIX), WSP(bf16, WS_WOUT_T) + (size_t)layer * D * D, T, D, D, F.G, (int)blockIdx.x);
            pg8::EpiB16 E{WSP(bf16, WS_Y1), D, WSP(bf16, WS_XB), DN_ALPHA};
            pg8::gemm_phase<pg8::EpiB16, pg8::DenseSched>(F.lds, F.tid, S, E);
            } SEAM(pb + 4);
        }
        if (PH_ON(5) && IN_(pb + 5)) { for (int rep_ = 0; rep_ < DUP_N(5); ++rep_) { frame_refresh(F); p6_ln1_router(F, args, layer); } SEAM(pb + 5); }
        if (PH_ON(6) && IN_(pb + 6)) { for (int rep_ = 0; rep_ < DUP_N(6); ++rep_) { frame_refresh(F);
            moe_build_pfx(F, args, layer, 8);
            pg8::Moe1Sched S; S.O.pfx = F.MISC + MW_PFX; S.O.NT = 8; S.O.G = F.G; S.O.c = (int)blockIdx.x; S.X = WSP(bf16, WS_X1B); S.W = WSP(bf16, WS_WGU_T) + (size_t)layer * NE * 2048 * D; S.sdest = WSP(int, WS_SDEST); S.K = D; S.hstepB = (size_t)1024 * D * 2;
            pg8::EpiMoe1 E{WSP(bf16, WS_ABUF), KIN(I_BGU) + (size_t)layer * NE * 2048};
            pg8::gemm_phase<pg8::EpiMoe1, pg8::Moe1Sched>(F.lds, F.tid, S, E);
            } SEAM(pb + 6);
        }
        if (PH_ON(7) && IN_(pb + 7)) { for (int rep_ = 0; rep_ < DUP_N(7); ++rep_) { frame_refresh(F);
            moe_build_pfx(F, args, layer, 4);
            pg8::Moe2Sched S; S.O.pfx = F.MISC + MW_PFX; S.O.NT = 4; S.O.G = F.G; S.O.c = (int)blockIdx.x; S.Ab = WSP(bf16, WS_ABUF); S.W = WSP(bf16, WS_WDN_T) + (size_t)layer * NE * D * D; S.K = D; S.hstepB = (size_t)128 * D * 2;
            pg8::EpiMoe2 E{WSP(bf16, WS_YBUF), KIN(I_BDN) + (size_t)layer * NE * D, WSP(int, WS_SDEST), WSP(float, WS_SGATE)};
            pg8::gemm_phase<pg8::EpiMoe2, pg8::Moe2Sched>(F.lds, F.tid, S, E);
            } SEAM(pb + 7);
        }
        if (PH_ON(8) && IN_(pb + 8)) { for (int rep_ = 0; rep_ < DUP_N(8); ++rep_) { frame_refresh(F); p9_combine(F, args); } SEAM(pb + 8); }
        if (PH_ON(9) && IN_(pb + 9)) { for (int rep_ = 0; rep_ < DUP_N(9); ++rep_) { frame_refresh(F);
            pg8::DenseSched S; S.init(WSP(bf16, WS_HB), WSP(bf16, WS_WPG_T) + (size_t)layer * D * D, T, D, D, F.G, (int)blockIdx.x);
            pg8::EpiPle E{WSP(bf16, WS_H2), WSP(bf16, WS_HB), WSP(bf16, WS_PE)};
            pg8::gemm_phase<pg8::EpiPle, pg8::DenseSched>(F.lds, F.tid, S, E);
            } SEAM(pb + 9);
        }
        if (PH_ON(10) && IN_(pb + 10)) { for (int rep_ = 0; rep_ < DUP_N(10); ++rep_) { frame_refresh(F); p11_ln2(F, args, layer); } SEAM(pb + 10); }
    }
#ifdef DBG_SEL
    if (hi - lo > 1) { xcd_barrier(bar);
        const unsigned mx = __hip_atomic_load(F.ctl + CW_DBG, RLX_AGENT), nf = __hip_atomic_load(F.ctl + CW_DBG + 1, RLX_AGENT);
        float code;
        { const float m = __uint_as_float(mx); int b = (m > 0.f) ? (int)floorf(log10f(m)) + 30 : 0; b = b < 0 ? 0 : (b > 60 ? 60 : b); if (nf) b += 100; code = sqrtf(10.0f * (float)(b + 1)); }
        for (size_t i = (size_t)blockIdx.x * 512 + threadIdx.x; i < (size_t)T * D; i += (size_t)gridDim.x * 512) F.out[i] = code; }
#endif
#undef IN_
#undef SEAM
}

extern "C" void kernel_launch(void* const* d_in, const int* in_sizes, int n_in, void* d_out, int out_size, void* d_ws, size_t ws_size, hipStream_t stream) {
    static int grid = 0;
    if (grid == 0) {
        if (n_in != N_IN || out_size != T * D || ws_size < WS_END) { fprintf(stderr, "kernel_launch: unexpected shapes (n_in %d, out %d, ws %zu < %zu); nothing launched\n", n_in, out_size, ws_size, (size_t)WS_END); grid = -1; return; }
        int dev = 0, cus = 0, per_cu = 0;
        if (hipGetDevice(&dev) != hipSuccess || hipDeviceGetAttribute(&cus, hipDeviceAttributeMultiprocessorCount, dev) != hipSuccess) { grid = -1; return; }
        if (hipFuncSetAttribute((const void*)fwd_kernel, hipFuncAttributeMaxDynamicSharedMemorySize, LDS_BYTES) != hipSuccess) { fprintf(stderr, "kernel_launch: hipFuncSetAttribute failed\n"); grid = -1; return; }
        if (hipOccupancyMaxActiveBlocksPerMultiprocessor(&per_cu, (const void*)fwd_kernel, NWAVES * 64, LDS_BYTES) != hipSuccess || per_cu < 1) { fprintf(stderr, "kernel_launch: occupancy query says %d blocks per CU\n", per_cu); }
        (void)hipGetLastError();
        grid = cus;
    }
    if (grid < 0) return;
    (void)hipMemsetAsync((char*)d_ws + WS_CTL, 0, CTL_ZERO_BYTES, stream);
    Args a{};
    for (int i = 0; i < N_IN; ++i) a.in[i] = (const float*)d_in[i];
    a.out = (float*)d_out; a.ws = (unsigned char*)d_ws;
#if MK_PER_PHASE_LAUNCH
    for (int ph = 0; ph < N_PHASES; ++ph) { a.ph_lo = ph; a.ph_hi = ph + 1; hipLaunchKernelGGL(fwd_kernel, dim3(grid), dim3(NWAVES * 64), LDS_BYTES, stream, a); }
#else
    a.ph_lo = 0; a.ph_hi = N_PHASES; hipLaunchKernelGGL(fwd_kernel, dim3(grid), dim3(NWAVES * 64), LDS_BYTES, stream, a);
#endif
    const hipError_t le = hipPeekAtLastError();
    if (le != hipSuccess) fprintf(stderr, "kernel_launch: launch failed: %s\n", hipGetErrorName(le));
}
```

```cpp
#include <hip/hip_runtime.h>
#include <cstdio>
#include <cstdint>

#define GAS __attribute__((address_space(1)))
#define LAS __attribute__((address_space(3)))
typedef unsigned short bf16;
typedef unsigned v4u __attribute__((ext_vector_type(4)));
typedef unsigned v2u __attribute__((ext_vector_type(2)));
typedef float f32x4 __attribute__((ext_vector_type(4)));
typedef float f32x2 __attribute__((ext_vector_type(2)));
typedef short bf16x8 __attribute__((ext_vector_type(8)));
typedef GAS unsigned gu32;
#define RLX_AGENT __ATOMIC_RELAXED, __HIP_MEMORY_SCOPE_AGENT
#define LDS_WAIT() asm volatile("s_waitcnt lgkmcnt(0)" ::: "memory")
#define VM_WAIT() asm volatile("s_waitcnt vmcnt(0)" ::: "memory")

constexpr int NWAVES = 8;
constexpr int DEPTH = 4, BATCH = 4, SEQ = 4096, D = 1024, T = BATCH * SEQ;
constexpr int NU = 3484, NUP = 3584;
constexpr int NE = 32, TOPK = 4, ECAP = 16384;
constexpr int NCH = SEQ / 64;
constexpr int U_SSD_Z = 0, U_SSD_X = 256, U_SSD_B = 512, U_SSD_C = 640, U_SSD_DT = 768;
constexpr int U_RW = 772, U_RW_R = 772, U_RW_K = 1028, U_RW_V = 1284, U_RW_LO = 1540;
constexpr int U_GL_Q = 1668, U_GL_K = 1796, U_GL_V = 1924, U_GL_G = 2180, U_GL_OG = 2196;
constexpr int U_ML_Q = 2452, U_ML_K = 2708, U_ML_V = 2964, U_ML_I = 3220, U_ML_F = 3224, U_ML_O = 3228;
constexpr float DN_ALPHA = 1.6817928305074290f;
constexpr float LN_EPS = 1e-5f, NORM_EPS = 1e-5f, RWKV_GN_EPS = 64e-5f;

enum { I_X = 0, I_P, I_WIN, I_WOUT, I_LN1G, I_LN1B, I_SCW, I_SCB, I_SALOG, I_SDTB, I_SD, I_SNG,
       I_RMU, I_RW0, I_RWUP, I_RA0, I_RAUP, I_RGUP, I_RKK, I_RKA, I_RRK, I_RLNG, I_RLNB,
       I_GGUP, I_GGB, I_GNG, I_MCW, I_MCB, I_MIB, I_MFB, I_MNG,
       I_RTW, I_RTB, I_WGU, I_BGU, I_WDN, I_BDN, I_PGW, I_PPJ, I_LN2G, I_LN2B, N_IN };

constexpr size_t MiB = 1u << 20;
constexpr size_t WS_CTL = 0, CTL_ZERO_BYTES = 1 * MiB;
constexpr size_t WS_WIN_T = 2 * MiB;
constexpr size_t WS_WOUT_T = WS_WIN_T + (size_t)DEPTH * NUP * D * 2;
constexpr size_t WS_WGU_T = WS_WOUT_T + (size_t)DEPTH * D * D * 2;
constexpr size_t WS_WDN_T = WS_WGU_T + (size_t)DEPTH * NE * 2048 * D * 2;
constexpr size_t WS_WPG_T = WS_WDN_T + (size_t)DEPTH * NE * D * D * 2;
constexpr size_t WS_WPP_T = WS_WPG_T + (size_t)DEPTH * D * D * 2;
constexpr size_t WS_RWT = WS_WPP_T + (size_t)DEPTH * D * 256 * 2;
constexpr size_t WS_PB = WS_RWT + (size_t)DEPTH * NE * D * 4;
constexpr size_t WS_XB = WS_PB + (size_t)DEPTH * T * 256 * 2;
constexpr size_t WS_U = WS_XB + (size_t)T * D * 2;
constexpr size_t WS_PE = WS_U + (size_t)T * NUP * 2;
constexpr size_t WS_MIX = WS_PE + (size_t)T * D * 4;
constexpr size_t WS_Y1 = WS_MIX + (size_t)T * D * 2;
constexpr size_t WS_X1 = WS_Y1 + (size_t)T * D * 4;
constexpr size_t WS_X1B = WS_X1 + (size_t)T * D * 4;
constexpr size_t WS_SDEST = WS_X1B + (size_t)T * D * 2;
constexpr size_t WS_SGATE = WS_SDEST + (size_t)NE * ECAP * 4;
constexpr size_t WS_ABUF = WS_SGATE + (size_t)NE * ECAP * 4;
constexpr size_t WS_YBUF = WS_ABUF + (size_t)NE * ECAP * D * 2;
constexpr size_t WS_H = WS_YBUF + (size_t)T * 4 * D * 2;
constexpr size_t WS_HB = WS_H + (size_t)T * D * 4;
constexpr size_t WS_H2 = WS_HB + (size_t)T * D * 2;
constexpr size_t WS_SSD_ST = WS_H2 + (size_t)T * D * 4;
constexpr size_t WS_SSD_DEC = WS_SSD_ST + (size_t)16 * NCH * 64 * 128 * 4;
constexpr size_t WS_GLA_ST = WS_SSD_DEC + 16 * NCH * 4;
constexpr size_t WS_GLA_DEC = WS_GLA_ST + (size_t)16 * NCH * 32 * 64 * 4;
constexpr size_t WS_ML_C = WS_GLA_DEC + (size_t)4 * NCH * 128 * 4;
constexpr size_t WS_ML_N = WS_ML_C + (size_t)16 * NCH * 64 * 64 * 4;
constexpr size_t WS_ML_BL = WS_ML_N + (size_t)16 * NCH * 64 * 4;
constexpr size_t WS_ML_ML = WS_ML_BL + 16 * NCH * 4;
constexpr size_t WS_ML_M = WS_ML_ML + 16 * NCH * 4;
constexpr size_t WS_RW = WS_ML_M + 16 * NCH * 4;
constexpr size_t WS_RW_G = WS_RW + (size_t)T * 3 * 256 * 4;
constexpr size_t WS_RW_RH = WS_RW_G + (size_t)T * 256 * 4;
constexpr size_t WS_RW_O0 = WS_RW_RH + (size_t)1024 * 4096 * 2;
constexpr size_t WS_RW_GF = WS_RW_O0 + (size_t)1024 * 4096 * 4;
constexpr size_t WS_RW_HT = WS_RW_GF + (size_t)1024 * 4096 * 2;
constexpr size_t WS_RW_PT = WS_RW_HT + (size_t)1024 * 4096 * 4;
constexpr size_t WS_LORA = WS_RW_PT + (size_t)1024 * 4096 * 2;
constexpr int LORA_PER_LAYER = 8192 + 8192 + 16384 + 2048;
constexpr size_t WS_END = WS_LORA + (size_t)DEPTH * LORA_PER_LAYER * 4;
constexpr int CW_BAR = 4096;
constexpr int CW_DBG = 32768;
constexpr int CW_CNT = 16384;

constexpr int RING_BYTES = 147456;
constexpr int MISC_OFF = RING_BYTES;
constexpr int LDS_BYTES = RING_BYTES + 1024;
constexpr int MW_BAR = 8, MW_LCNT = 32, MW_LBASE = 64, MW_PFX = 96, MW_CNT = 136, MW_GAMC = 168;

typedef __bf16 bf16x2_t __attribute__((ext_vector_type(2)));
__device__ __forceinline__ unsigned cvt_pk_bf16(float lo, float hi) { const f32x2 v = {lo, hi}; const bf16x2_t b = __builtin_convertvector(v, bf16x2_t); return __builtin_bit_cast(unsigned, b); }
__device__ __forceinline__ float bf2f(unsigned short b) { return __uint_as_float(((unsigned)b) << 16); }
__device__ __forceinline__ float sigmoidf_(float x) { return 1.0f / (1.0f + __expf(-x)); }
__device__ __forceinline__ float siluf_(float x) { return x / (1.0f + __expf(-x)); }
__device__ __forceinline__ float softplusf_(float x) { return fmaxf(x, 0.f) + log1pf(__expf(-fabsf(x))); }
__device__ __forceinline__ float logsigmoidf_(float x) { return fminf(x, 0.f) - log1pf(__expf(-fabsf(x))); }
__device__ __forceinline__ float wave_sum(float v) {
#pragma unroll
    for (int o = 1; o < 64; o <<= 1) v += __shfl_xor(v, o);
    return v;
}
__device__ __forceinline__ float wave_max(float v) {
#pragma unroll
    for (int o = 1; o < 64; o <<= 1) v = fmaxf(v, __shfl_xor(v, o));
    return v;
}
__device__ __forceinline__ float wave_scan_add(float v, int lane) {
#pragma unroll
    for (int o = 1; o < 64; o <<= 1) { const float t = __shfl_up(v, o); if (lane >= o) v += t; }
    return v;
}
__device__ __forceinline__ float wave_scan_max(float v, int lane) {
#pragma unroll
    for (int o = 1; o < 64; o <<= 1) { const float t = __shfl_up(v, o); if (lane >= o) v = fmaxf(v, t); }
    return v;
}
__device__ __forceinline__ f32x4 mm16(const LAS unsigned char* A, int lda, const LAS unsigned char* B, int ldb, int K, f32x4 acc, int fr, int fq) {
    const LAS unsigned char* ap = A + fr * lda + fq * 16; const LAS unsigned char* bp = B + fr * ldb + fq * 16;
    for (int k = 0; k < K; k += 32) {
        const bf16x8 a = *(const LAS bf16x8*)(ap + k * 2); const bf16x8 b = *(const LAS bf16x8*)(bp + k * 2);
        acc = __builtin_amdgcn_mfma_f32_16x16x32_bf16(b, a, acc, 0, 0, 0);
    }
    return acc;
}
__device__ __forceinline__ f32x4 mm16_gB(const LAS unsigned char* A, int lda, const float* B, int ldb, int K, f32x4 acc, int fr, int fq) {
    const LAS unsigned char* ap = A + fr * lda + fq * 16; const float* bp = B + (size_t)fr * ldb + fq * 8;
    for (int k = 0; k < K; k += 32) {
        const bf16x8 a = *(const LAS bf16x8*)(ap + k * 2);
        const f32x4 b0 = *(const f32x4*)(bp + k), b1 = *(const f32x4*)(bp + k + 4);
        v4u bw; bw.x = cvt_pk_bf16(b0.x, b0.y); bw.y = cvt_pk_bf16(b0.z, b0.w); bw.z = cvt_pk_bf16(b1.x, b1.y); bw.w = cvt_pk_bf16(b1.z, b1.w);
        const bf16x8 b = __builtin_bit_cast(bf16x8, bw);
        acc = __builtin_amdgcn_mfma_f32_16x16x32_bf16(b, a, acc, 0, 0, 0);
    }
    return acc;
}
__device__ __forceinline__ f32x4 mm16_gAB(const bf16* A, int lda, const bf16* B, int ldb, int K, f32x4 acc, int fr, int fq) {
    const bf16* ap = A + (size_t)fr * lda + fq * 8; const bf16* bp = B + (size_t)fr * ldb + fq * 8;
    for (int k = 0; k < K; k += 32) { const bf16x8 a = *(const bf16x8*)(ap + k), b = *(const bf16x8*)(bp + k); acc = __builtin_amdgcn_mfma_f32_16x16x32_bf16(b, a, acc, 0, 0, 0); }
    return acc;
}
__device__ __forceinline__ bf16x8 ldfrag_f32(const float* p) { const f32x4 b0 = *(const f32x4*)p, b1 = *(const f32x4*)(p + 4);
    v4u bw; bw.x = cvt_pk_bf16(b0.x, b0.y); bw.y = cvt_pk_bf16(b0.z, b0.w); bw.z = cvt_pk_bf16(b1.x, b1.y); bw.w = cvt_pk_bf16(b1.z, b1.w); return __builtin_bit_cast(bf16x8, bw); }
template <int NK> __device__ __forceinline__ f32x4 mm16_rB(const LAS unsigned char* A, int lda, const bf16x8 (&b)[NK], f32x4 acc, int fr, int fq) {
    const LAS unsigned char* ap = A + fr * lda + fq * 16;
#pragma unroll
    for (int k = 0; k < NK; ++k) { const bf16x8 a = *(const LAS bf16x8*)(ap + k * 64); acc = __builtin_amdgcn_mfma_f32_16x16x32_bf16(b[k], a, acc, 0, 0, 0); }
    return acc;
}
__device__ __forceinline__ v4u pack8(const float (&v)[8]) { v4u o; o.x = cvt_pk_bf16(v[0], v[1]); o.y = cvt_pk_bf16(v[2], v[3]); o.z = cvt_pk_bf16(v[4], v[5]); o.w = cvt_pk_bf16(v[6], v[7]); return o; }

#define XB_TMO      128
#define XB_XCNT(j)  (256  + 64 * (j))
#define XB_XSUB(j)  (1280 + 64 * (j))
#define XB_XGEN(j)  (2304 + 64 * (j))
#define XB_TOP      3328
#define XB_TOPGEN   3392
#define XCD_BAR_WORDS 3456
#define XB_SPIN_CAP (1u << 18)
__device__ __forceinline__ unsigned xb_ld(unsigned* p)              { return __hip_atomic_load(p, __ATOMIC_RELAXED, __HIP_MEMORY_SCOPE_AGENT); }
__device__ __forceinline__ unsigned xb_add(unsigned* p, unsigned v) { return __hip_atomic_fetch_add(p, v, __ATOMIC_RELAXED, __HIP_MEMORY_SCOPE_AGENT); }
__device__ __forceinline__ unsigned xb_xcc_id() { return (unsigned)__builtin_amdgcn_s_getreg((3 << 11) | 20) & 0xFu; }
#define XB_SPIN(cond, bar) do { unsigned _sp = 0; while (cond) { __builtin_amdgcn_s_sleep(1); \
    if ((++_sp & 255u) == 0u) { if (xb_ld(&(bar)[XB_TMO])) break; if (_sp > XB_SPIN_CAP) { atomicAdd(&(bar)[XB_TMO], 1u); break; } } } } while (0)
struct XcdBarrier { unsigned* bar; unsigned x; volatile LAS unsigned* st; };
__device__ __forceinline__ XcdBarrier xcd_barrier_post(unsigned* bar, volatile LAS unsigned* st) {
    XcdBarrier b; b.bar = bar; b.x = xb_xcc_id(); b.st = st;
    if (threadIdx.x == 0) (void)xb_add(&bar[XB_XCNT(b.x)], 1u);
    return b;
}
__device__ __forceinline__ void xcd_barrier_complete(unsigned* bar, unsigned x, unsigned& nloc, unsigned& nx) {
    const unsigned G = gridDim.x * gridDim.y * gridDim.z;
    unsigned sum, cnt, mine, sp = 0u;
    for (;;) {
        sum = 0u; cnt = 0u; mine = 0u;
#pragma unroll
        for (unsigned j = 0; j < 16; ++j) { const unsigned c = xb_ld(&bar[XB_XCNT(j)]); sum += c; cnt += (c > 0u) ? 1u : 0u; mine = (j == x) ? c : mine; }
        if (sum == G) break;
        __builtin_amdgcn_s_sleep(1);
        if ((++sp & 255u) == 0u) { if (xb_ld(&bar[XB_TMO])) break; if (sp > XB_SPIN_CAP) { atomicAdd(&bar[XB_TMO], 1u); break; } }
    }
    nloc = mine > 0u ? mine : 1u; nx = cnt > 0u ? cnt : 1u;
}
__device__ __forceinline__ void xcd_barrier(const XcdBarrier& b) {
    asm volatile("s_waitcnt vmcnt(0)" ::: "memory");
    __syncthreads();
    if (threadIdx.x == 0) {
        unsigned* bar = b.bar;
        __builtin_amdgcn_s_waitcnt(0);
        unsigned nloc = b.st[0], nx = b.st[1];
        if (nloc == 0u) { xcd_barrier_complete(bar, b.x, nloc, nx); b.st[0] = nloc; b.st[1] = nx; }
        const unsigned old = xb_add(&bar[XB_XSUB(b.x)], 1u);
        const unsigned gen = old / nloc;
        if (old + 1u == (gen + 1u) * nloc) {
            __builtin_amdgcn_fence(__ATOMIC_RELEASE, "agent");
            asm volatile("s_waitcnt vmcnt(0)" ::: "memory");
            const unsigned og = xb_add(&bar[XB_TOP], 1u);
            const unsigned tg = og / nx;
            if (og + 1u == (tg + 1u) * nx) xb_add(&bar[XB_TOPGEN], 1u);
            else XB_SPIN(xb_ld(&bar[XB_TOPGEN]) == tg, bar);
            __builtin_amdgcn_fence(__ATOMIC_ACQUIRE, "agent");
            xb_add(&bar[XB_XGEN(b.x)], 1u);
            asm volatile("s_waitcnt vmcnt(0)" ::: "memory");
        } else {
            XB_SPIN(xb_ld(&bar[XB_XGEN(b.x)]) == gen, bar);
            __builtin_amdgcn_fence(__ATOMIC_ACQUIRE, "agent");
            asm volatile("s_waitcnt vmcnt(0)" ::: "memory");
        }
    }
    __syncthreads();
}

namespace pg8 {
constexpr int BM = 256, BK = 64, HALF = 128, HTB = HALF * BK * 2, STAGE_BYTES = 8 * HTB, NXCD = 8, WGM = 8;
__host__ __device__ __forceinline__ int lds_byte(int r, int c) { const int st = (r >> 4) * 2 + (c >> 5), rr = r & 15, cc = c & 31, ob = rr * 64 + cc * 2; return st * 1024 + (ob ^ (((ob >> 9) & 1) << 5)); }
__host__ __device__ __forceinline__ void stage_rc(int b, int& R, int& C) { const int st = b / 1024, sb = b % 1024, swz = sb ^ (((sb >> 9) & 1) << 5); R = (st >> 1) * 16 + swz / 64; C = (st & 1) * 32 + (swz % 64) / 2; }
__host__ __device__ __forceinline__ int perm32(int rho) { const int n = rho >> 4, i = rho & 15; return 8 * (i >> 2) + 4 * n + (i & 3); }

template <class Epi, class Sched>
__device__ __forceinline__ void gemm_phase(LAS unsigned char* lds, const int tid, const Sched& S, const Epi& E) {
    const int wid = __builtin_amdgcn_readfirstlane(tid >> 6), lane = tid & 63, wr = wid >> 2, wc = wid & 3, fr = lane & 15, fq = lane >> 4;
    const int K = S.K, nt = K / BK;
    unsigned voffB[2];
#pragma unroll
    for (int i = 0; i < 2; ++i) { int R, C; stage_rc(tid * 16 + i * 8192, R, C); const int Rb = Epi::PERM ? ((R & ~31) + perm32(R & 31)) : R; voffB[i] = (unsigned)(Rb * K + C) * 2u; }
    const size_t kstep = (size_t)(BK * 2);
    const size_t hstepB = S.hstepB;
    const unsigned ldsw = (unsigned)wid * 1024u;
    const int aoff = lds_byte(wr * 64 + fr, fq * 8), boff = lds_byte(wc * 32 + fr, fq * 8);
#define PG8_SA(b, h) (((b) * 2 + (h)) * HTB)
#define PG8_SB(b, h) ((4 + (b) * 2 + (h)) * HTB)
#define PG8_STAGE_B(bufoff, gbase) do { _Pragma("unroll") for (int _i = 0; _i < 2; ++_i) \
        __builtin_amdgcn_global_load_lds((const unsigned*)((const char*)(gbase) + voffB[_i]), (LAS unsigned*)(lds + (bufoff) + ldsw + _i * 8192), 16, 0, 0); } while (0)
#define PG8_STAGE_A(bufoff, gbase, v0, v1) do { \
        __builtin_amdgcn_global_load_lds((const unsigned*)((const char*)(gbase) + (v0)), (LAS unsigned*)(lds + (bufoff) + ldsw), 16, 0, 0); \
        __builtin_amdgcn_global_load_lds((const unsigned*)((const char*)(gbase) + (v1)), (LAS unsigned*)(lds + (bufoff) + ldsw + 8192), 16, 0, 0); } while (0)
#define PG8_LDA(dst, b, h) do { _Pragma("unroll") for (int m = 0; m < 4; ++m) _Pragma("unroll") for (int k = 0; k < 2; ++k) dst[m][k] = *(const LAS bf16x8*)(lds + PG8_SA(b, h) + aoff + m * 2048 + k * 1024); } while (0)
#define PG8_LDB(dst, b, h) do { _Pragma("unroll") for (int n = 0; n < 2; ++n) _Pragma("unroll") for (int k = 0; k < 2; ++k) dst[n][k] = *(const LAS bf16x8*)(lds + PG8_SB(b, h) + boff + n * 2048 + k * 1024); } while (0)
#define PG8_MMA(ai, bj, At, Bt) do { __builtin_amdgcn_s_setprio(1); _Pragma("unroll") for (int m = 0; m < 4; ++m) _Pragma("unroll") for (int n = 0; n < 2; ++n) _Pragma("unroll") for (int k = 0; k < 2; ++k) \
        acc[ai][bj][m][n] = __builtin_amdgcn_mfma_f32_16x16x32_bf16(Bt[n][k], At[m][k], acc[ai][bj][m][n], 0, 0, 0); __builtin_amdgcn_s_setprio(0); } while (0)
#define PG8_WAIT_V(n) asm volatile("s_waitcnt vmcnt(" #n ")" ::: "memory")
#define PG8_WAIT_L(n) asm volatile("s_waitcnt lgkmcnt(" #n ")" ::: "memory")
#define PG8_BAR __builtin_amdgcn_s_barrier()
#define PG8_SCHED __builtin_amdgcn_sched_barrier(0)
    typename Sched::Unit cur, nxt; int ui = 0;
    if (!S.next(0, cur)) return;
    f32x4 acc[2][2][4][2];
#pragma unroll
    for (int a = 0; a < 2; ++a)
#pragma unroll
        for (int b = 0; b < 2; ++b)
#pragma unroll
            for (int m = 0; m < 4; ++m)
#pragma unroll
                for (int n = 0; n < 2; ++n) acc[a][b][m][n] = (f32x4){0.f, 0.f, 0.f, 0.f};
    bf16x8 At[4][2], B0[2][2], B1[2][2];
    constexpr bool GA = Sched::GATHER;
    const size_t hstepA = GA ? (size_t)0 : (size_t)HALF * K * 2;
    unsigned vA[2][2];
    S.a_off(cur, tid, vA);
#define PG8_STAGE_AH(bufoff, base, vv, h) PG8_STAGE_A(bufoff, ((base) + (h) * hstepA), vv[GA ? (h) : 0][0], vv[GA ? (h) : 0][1])
    const char* cA = S.a_base(cur); const char* cB = S.b_base(cur);
    PG8_STAGE_B(PG8_SB(0, 0), cB); PG8_STAGE_B(PG8_SB(0, 1), cB + hstepB); PG8_STAGE_AH(PG8_SA(0, 0), cA, vA, 0); PG8_STAGE_AH(PG8_SA(0, 1), cA, vA, 1);
    if (wr == 1) PG8_BAR;
    PG8_WAIT_V(2); PG8_BAR;
    PG8_STAGE_B(PG8_SB(1, 0), cB + kstep); PG8_STAGE_AH(PG8_SA(1, 0), cA + kstep, vA, 0); PG8_STAGE_B(PG8_SB(1, 1), cB + hstepB + kstep);
    PG8_WAIT_V(6); PG8_BAR;
    for (;;) {
        const bool has_next = S.next(ui + 1, nxt);
        const char* nA = cA; const char* nB = cB;
        if (has_next) { nA = S.a_base(nxt); nB = S.b_base(nxt); }
        for (int t = 0; t < nt; t += 2) {
            const bool last = (t == nt - 2);
            const char* a1 = cA + (size_t)(t + 1) * kstep;
            const char* a2 = last ? nA : cA + (size_t)(t + 2) * kstep; const char* b2 = last ? nB : cB + (size_t)(t + 2) * kstep;
            const char* a3 = a2 + kstep; const char* b3 = b2 + kstep;
            PG8_LDB(B0, 0, 0); PG8_LDB(B1, 0, 1); PG8_SCHED; PG8_LDA(At, 0, 0); PG8_STAGE_AH(PG8_SA(1, 1), a1, vA, 1);
            if constexpr (GA) { if (last && has_next) S.a_off(nxt, tid, vA); }
            PG8_WAIT_V(8); PG8_WAIT_L(0); PG8_BAR; PG8_MMA(0, 0, At, B0); PG8_MMA(0, 1, At, B1); PG8_BAR; PG8_SCHED;
            PG8_LDA(At, 0, 1); PG8_STAGE_B(PG8_SB(0, 0), b2); PG8_STAGE_B(PG8_SB(0, 1), b2 + hstepB); PG8_STAGE_AH(PG8_SA(0, 0), a2, vA, 0);
            PG8_WAIT_V(8); PG8_WAIT_L(0); PG8_BAR; PG8_MMA(1, 0, At, B0); PG8_MMA(1, 1, At, B1); PG8_BAR; PG8_SCHED;
            PG8_LDB(B0, 1, 0); PG8_LDB(B1, 1, 1); PG8_SCHED; PG8_LDA(At, 1, 0); PG8_STAGE_AH(PG8_SA(0, 1), a2, vA, 1);
            PG8_WAIT_V(8); PG8_WAIT_L(0); PG8_BAR; PG8_MMA(0, 0, At, B0); PG8_MMA(0, 1, At, B1); PG8_BAR; PG8_SCHED;
            PG8_LDA(At, 1, 1); PG8_STAGE_B(PG8_SB(1, 0), b3); PG8_STAGE_B(PG8_SB(1, 1), b3 + hstepB); PG8_STAGE_AH(PG8_SA(1, 0), a3, vA, 0);
            PG8_WAIT_V(8); PG8_WAIT_L(0); PG8_BAR; PG8_MMA(1, 0, At, B0); PG8_MMA(1, 1, At, B1); PG8_BAR; PG8_SCHED;
        }
        if (wr == 0) PG8_BAR;
        { int fr_ = fr, fq_ = fq; asm volatile("" : "+v"(fr_), "+v"(fq_)); E(acc, cur, wr, wc, fr_, fq_); }
        if (!has_next) break;
#pragma unroll
        for (int a = 0; a < 2; ++a)
#pragma unroll
            for (int b = 0; b < 2; ++b)
#pragma unroll
                for (int m = 0; m < 4; ++m)
#pragma unroll
                    for (int n = 0; n < 2; ++n) acc[a][b][m][n] = (f32x4){0.f, 0.f, 0.f, 0.f};
        cur = nxt; cA = nA; cB = nB; ++ui;
        if (wr == 1) PG8_BAR;
    }
    PG8_WAIT_V(0);
    PG8_BAR;
#undef PG8_SA
#undef PG8_SB
#undef PG8_STAGE_A
#undef PG8_STAGE_AH
#undef PG8_STAGE_B
#undef PG8_LDA
#undef PG8_LDB
#undef PG8_MMA
#undef PG8_WAIT_V
#undef PG8_WAIT_L
#undef PG8_BAR
#undef PG8_SCHED
}
}
struct Args { const float* in[N_IN]; float* out; unsigned char* ws; int ph_lo, ph_hi; };
typedef const __attribute__((address_space(4))) unsigned long long* karg_t;
struct Frame {
    karg_t ka;
    LAS unsigned char* lds;
    volatile LAS unsigned* MISC;
    gu32* ctl;
    unsigned char* ws;
    float* out;
    int tid, lane, wave, vcu, G;
};
#define WSP(T_, off) ((T_*)(F.ws + (off)))
#define KIN(k) ((const float*)F.ka[(k)])
#ifdef DBG_SEL
#define DBG_STAT(k, val) do { const float _v = (val); if ((k) == DBG_SEL) { if (fabsf(_v) < 3e38f) atomicMax((unsigned*)(F.ctl + CW_DBG), __float_as_uint(fabsf(_v))); else atomicAdd((unsigned*)(F.ctl + CW_DBG + 1), 1u); } } while (0)
#else
#define DBG_STAT(k, val) do { } while (0)
#endif
template <class P> __device__ __forceinline__ P launder_uniform(P p) {
    unsigned lo = (unsigned)(unsigned long long)p, hi = (unsigned)((unsigned long long)p >> 32);
    asm volatile("" : "+v"(lo), "+v"(hi));
    lo = __builtin_amdgcn_readfirstlane(lo); hi = __builtin_amdgcn_readfirstlane(hi);
    return (P)(((unsigned long long)hi << 32) | lo);
}
__device__ __forceinline__ void frame_refresh(Frame& F) {
    int t = F.tid; asm volatile("" : "+v"(t)); F.tid = t; F.lane = t & 63; F.wave = __builtin_amdgcn_readfirstlane(t >> 6);
    F.ws = launder_uniform(F.ws); F.ctl = (gu32*)(F.ws + WS_CTL);
    F.out = launder_uniform(F.out);
    F.ka = launder_uniform(F.ka);
}

namespace pg8 {
struct DenseSched {
    static constexpr bool GATHER = false;
    struct Unit { int pm, pn; };
    const bf16* A; const bf16* Bt; int K; size_t hstepB; int nM, nN, nwg, G, c;
    __device__ __forceinline__ void init(const bf16* A_, const bf16* Bt_, int M, int N, int K_, int G_, int c_) { A = A_; Bt = Bt_; K = K_; hstepB = (size_t)HALF * K_ * 2; nM = M / BM; nN = N / BM; nwg = nM * nN; G = G_; c = c_; }
    __device__ __forceinline__ bool next(int i, Unit& u) const {
        const long L = (long)i * G + c; if (L >= nwg) return false;
        int wgid = (int)L; { const int q = nwg / NXCD, r = nwg % NXCD, xcd = wgid % NXCD, off = wgid / NXCD; wgid = (xcd < r ? xcd * (q + 1) : r * (q + 1) + (xcd - r) * q) + off; }
        const int nig = WGM * nN, gid = wgid / nig, fm = gid * WGM, gsz = (nM - fm) < WGM ? (nM - fm) : WGM;
        u.pm = fm + ((wgid % nig) % gsz); u.pn = (wgid % nig) / gsz; return true;
    }
    __device__ __forceinline__ const char* a_base(const Unit& u) const { return (const char*)A + (size_t)u.pm * BM * K * 2; }
    __device__ __forceinline__ const char* b_base(const Unit& u) const { return (const char*)Bt + (size_t)u.pn * BM * K * 2; }
    __device__ __forceinline__ void a_off(const Unit&, int tid, unsigned (&v)[2][2]) const {
#pragma unroll
        for (int i = 0; i < 2; ++i) { int R, C; stage_rc(tid * 16 + i * 8192, R, C); v[0][i] = (unsigned)(R * K + C) * 2u; v[1][i] = v[0][i]; }
    }
};
struct MoeUnit { int e, mt, nt, cnt; };
struct MoeOrder {
    const volatile LAS unsigned* pfx;
    int NT, G, c;
    __device__ __forceinline__ bool decode(int i, MoeUnit& u) const {
        const int nwg = (int)pfx[32]; const long L = (long)i * G + c; if (L >= nwg) return false;
        int wgid = (int)L; { const int q = nwg / NXCD, r = nwg % NXCD, xcd = wgid % NXCD, off = wgid / NXCD; wgid = (xcd < r ? xcd * (q + 1) : r * (q + 1) + (xcd - r) * q) + off; }
        int e = 0;
#pragma unroll 1
        for (int j = 1; j < 32; ++j) e += ((int)pfx[j] <= wgid) ? 1 : 0;
        const int j = wgid - (int)pfx[e];
        u.e = e; u.mt = j / NT; u.nt = j % NT; u.cnt = (int)pfx[40 + e]; return true;
    }
};
struct Moe1Sched {
    static constexpr bool GATHER = true;
    typedef MoeUnit Unit;
    MoeOrder O; const bf16* X; const bf16* W; const int* sdest; int K; size_t hstepB;
    __device__ __forceinline__ bool next(int i, Unit& u) const { return O.decode(i, u); }
    __device__ __forceinline__ const char* a_base(const Unit&) const { return (const char*)X; }
    __device__ __forceinline__ const char* b_base(const Unit& u) const { return (const char*)W + ((size_t)u.e * 2048 + (size_t)u.nt * 128) * 1024 * 2; }
    __device__ __forceinline__ void a_off(const Unit& u, int tid, unsigned (&v)[2][2]) const {
#pragma unroll
        for (int i = 0; i < 2; ++i) { int R, C; stage_rc(tid * 16 + i * 8192, R, C);
#pragma unroll
            for (int h = 0; h < 2; ++h) { const int slot = u.mt * 256 + h * HALF + R; int tok = 0; if (slot < u.cnt) tok = sdest[u.e * ECAP + slot] >> 2; v[h][i] = (unsigned)(tok * 1024 + C) * 2u; } }
    }
};
struct Moe2Sched {
    static constexpr bool GATHER = false;
    typedef MoeUnit Unit;
    MoeOrder O; const bf16* Ab; const bf16* W; int K; size_t hstepB;
    __device__ __forceinline__ bool next(int i, Unit& u) const { return O.decode(i, u); }
    __device__ __forceinline__ const char* a_base(const Unit& u) const { return (const char*)Ab + ((size_t)u.e * ECAP + (size_t)u.mt * 256) * 1024 * 2; }
    __device__ __forceinline__ const char* b_base(const Unit& u) const { return (const char*)W + ((size_t)u.e * 1024 + (size_t)u.nt * 256) * 1024 * 2; }
    __device__ __forceinline__ void a_off(const Unit&, int tid, unsigned (&v)[2][2]) const {
#pragma unroll
        for (int i = 0; i < 2; ++i) { int R, C; stage_rc(tid * 16 + i * 8192, R, C); v[0][i] = (unsigned)(R * 1024 + C) * 2u; v[1][i] = v[0][i]; }
    }
};

__device__ __forceinline__ void unpack8(const v4u w, f32x4& a, f32x4& b) {
    a = (f32x4){__uint_as_float(w.x << 16), __uint_as_float(w.x & 0xffff0000u), __uint_as_float(w.y << 16), __uint_as_float(w.y & 0xffff0000u)};
    b = (f32x4){__uint_as_float(w.z << 16), __uint_as_float(w.z & 0xffff0000u), __uint_as_float(w.w << 16), __uint_as_float(w.w & 0xffff0000u)}; }
struct EpiF32 {
    static constexpr bool PERM = false;
    float* C; int ldc; const float* base; float alpha;
    __device__ __forceinline__ void operator()(const f32x4 (&acc)[2][2][4][2], const DenseSched::Unit& u, int wr, int wc, int fr, int fq) const {
        const int row0 = u.pm * BM + wr * 64 + fr, col0 = u.pn * BM + wc * 32 + 4 * fq;
#pragma unroll
        for (int ai = 0; ai < 2; ++ai)
#pragma unroll
            for (int m = 0; m < 4; ++m) { const size_t ro = (size_t)(row0 + ai * HALF + m * 16) * ldc + col0;
#pragma unroll
                for (int bj = 0; bj < 2; ++bj)
#pragma unroll
                    for (int n = 0; n < 2; ++n) { f32x4 v = acc[ai][bj][m][n];
                        if (base) { const f32x4 b = *(const f32x4*)(base + ro + bj * HALF + n * 16); v = v + b * alpha; }
                        *(f32x4*)(C + ro + bj * HALF + n * 16) = v; } }
    }
};
struct EpiB16 {
    static constexpr bool PERM = true;
    bf16* O; int ldc; const bf16* base; float alpha;
    __device__ __forceinline__ void operator()(const f32x4 (&acc)[2][2][4][2], const DenseSched::Unit& u, int wr, int wc, int fr, int fq) const {
        const int row0 = u.pm * BM + wr * 64 + fr, col0 = u.pn * BM + wc * 32 + 8 * fq;
#pragma unroll
        for (int ai = 0; ai < 2; ++ai) {
            v4u bw[4][2];
            if (base) {
#pragma unroll
                for (int m = 0; m < 4; ++m)
#pragma unroll
                    for (int bj = 0; bj < 2; ++bj) bw[m][bj] = *(const v4u*)(base + (size_t)(row0 + ai * HALF + m * 16) * ldc + col0 + bj * HALF); }
#pragma unroll
            for (int m = 0; m < 4; ++m) { bf16* rowp = O + (size_t)(row0 + ai * HALF + m * 16) * ldc + col0;
#pragma unroll
                for (int bj = 0; bj < 2; ++bj) { f32x4 v0 = acc[ai][bj][m][0], v1 = acc[ai][bj][m][1];
                    if (base) { f32x4 b0, b1; unpack8(bw[m][bj], b0, b1); v0 = v0 + b0 * alpha; v1 = v1 + b1 * alpha; }
                    v4u w; w.x = cvt_pk_bf16(v0[0], v0[1]); w.y = cvt_pk_bf16(v0[2], v0[3]); w.z = cvt_pk_bf16(v1[0], v1[1]); w.w = cvt_pk_bf16(v1[2], v1[3]);
                    *(v4u*)(rowp + bj * HALF) = w; } } }
    }
};
struct EpiPle {
    static constexpr bool PERM = true;
    bf16* C; const bf16* hb; const bf16* pe;
    __device__ __forceinline__ void operator()(const f32x4 (&acc)[2][2][4][2], const DenseSched::Unit& u, int wr, int wc, int fr, int fq) const {
        const int row0 = u.pm * BM + wr * 64 + fr, col0 = u.pn * BM + wc * 32 + 8 * fq;
#pragma unroll
        for (int ai = 0; ai < 2; ++ai) {
            v4u hw[4][2], pw[4][2];
#pragma unroll
            for (int m = 0; m < 4; ++m)
#pragma unroll
                for (int bj = 0; bj < 2; ++bj) { const size_t ro = (size_t)(row0 + ai * HALF + m * 16) * 1024 + col0 + bj * HALF; hw[m][bj] = *(const v4u*)(hb + ro); pw[m][bj] = *(const v4u*)(pe + ro); }
#pragma unroll
            for (int m = 0; m < 4; ++m)
#pragma unroll
                for (int bj = 0; bj < 2; ++bj) { const size_t ro = (size_t)(row0 + ai * HALF + m * 16) * 1024 + col0 + bj * HALF;
                    f32x4 h0, h1, p0, p1; unpack8(hw[m][bj], h0, h1); unpack8(pw[m][bj], p0, p1); const f32x4 a0 = acc[ai][bj][m][0], a1 = acc[ai][bj][m][1];
                    f32x4 o0, o1;
#pragma unroll
                    for (int j = 0; j < 4; ++j) { o0[j] = h0[j] + sigmoidf_(a0[j]) * p0[j]; o1[j] = h1[j] + sigmoidf_(a1[j]) * p1[j]; }
                    v4u w; w.x = cvt_pk_bf16(o0[0], o0[1]); w.y = cvt_pk_bf16(o0[2], o0[3]); w.z = cvt_pk_bf16(o1[0], o1[1]); w.w = cvt_pk_bf16(o1[2], o1[3]);
                    *(v4u*)(C + ro) = w; } }
    }
};
struct EpiMoe1 {
    static constexpr bool PERM = true;
    bf16* Ab; const float* bgu;
    __device__ __forceinline__ void operator()(const f32x4 (&acc)[2][2][4][2], const MoeUnit& u, int wr, int wc, int fr, int fq) const {
        const int col0 = u.nt * 128 + wc * 32 + 8 * fq;
        const float* bg = bgu + (size_t)u.e * 2048 + col0;
        const f32x4 bg0 = *(const f32x4*)(bg), bg1 = *(const f32x4*)(bg + 4), bl0 = *(const f32x4*)(bg + 1024), bl1 = *(const f32x4*)(bg + 1028);
#pragma unroll
        for (int ai = 0; ai < 2; ++ai)
#pragma unroll
            for (int m = 0; m < 4; ++m) { const int r = ai * HALF + wr * 64 + m * 16 + fr;
                bf16* rowp = Ab + ((size_t)u.e * ECAP + (size_t)u.mt * 256 + r) * 1024 + col0;
                float o[8];
#pragma unroll
                for (int n = 0; n < 2; ++n) { const f32x4 g4 = acc[ai][0][m][n] + (n ? bg1 : bg0), l4 = acc[ai][1][m][n] + (n ? bl1 : bl0);
#pragma unroll
                    for (int j = 0; j < 4; ++j) { const float g = fminf(g4[j], 7.0f), l = fminf(fmaxf(l4[j], -7.0f), 7.0f); o[n * 4 + j] = (l + 1.0f) * g * sigmoidf_(1.702f * g); } }
                *(v4u*)rowp = pack8(o); }
    }
};
struct EpiMoe2 {
    static constexpr bool PERM = true;
    bf16* Y; const float* bdn; const int* sdest; const float* sgate;
    __device__ __forceinline__ void operator()(const f32x4 (&acc)[2][2][4][2], const MoeUnit& u, int wr, int wc, int fr, int fq) const {
        const int col0 = u.nt * 256 + wc * 32 + 8 * fq;
        const float* bp = bdn + (size_t)u.e * 1024 + col0;
        int dest[2][4]; float gate[2][4];
#pragma unroll
        for (int ai = 0; ai < 2; ++ai)
#pragma unroll
            for (int m = 0; m < 4; ++m) { const int slot = u.mt * 256 + ai * HALF + wr * 64 + m * 16 + fr; const bool ok = slot < u.cnt; const int si = u.e * ECAP + (ok ? slot : 0);
                dest[ai][m] = ok ? sdest[si] : -1; gate[ai][m] = sgate[si]; }
        f32x4 bv[2][2];
#pragma unroll
        for (int bj = 0; bj < 2; ++bj)
#pragma unroll
            for (int n = 0; n < 2; ++n) bv[bj][n] = *(const f32x4*)(bp + bj * HALF + 4 * n);
#pragma unroll
        for (int ai = 0; ai < 2; ++ai)
#pragma unroll
            for (int m = 0; m < 4; ++m) {
                if (dest[ai][m] >= 0) { const float g = gate[ai][m]; bf16* rowp = Y + (size_t)dest[ai][m] * 1024 + col0;
#pragma unroll
                    for (int bj = 0; bj < 2; ++bj) { const f32x4 v0 = (acc[ai][bj][m][0] + bv[bj][0]) * g, v1 = (acc[ai][bj][m][1] + bv[bj][1]) * g;
                        v4u w; w.x = cvt_pk_bf16(v0[0], v0[1]); w.y = cvt_pk_bf16(v0[2], v0[3]); w.z = cvt_pk_bf16(v1[0], v1[1]); w.w = cvt_pk_bf16(v1[2], v1[3]);
                        *(v4u*)(rowp + bj * HALF) = w; } } }
    }
};
}

__device__ __forceinline__ void p0_transpose_item(const float* W, int K, int N, int nblk, bf16* WT, int item, int lane) {
    const int kb = item / nblk, nb = item % nblk, k0 = 64 * kb, n = 64 * nb + lane;
    const bool ok = n < N; const float* src = W + (size_t)k0 * N + (ok ? n : 0);
    float x[64];
#pragma unroll
    for (int j = 0; j < 64; ++j) x[j] = __builtin_nontemporal_load(src + (size_t)j * N);
    bf16* dst = WT + (size_t)n * K + k0;
#pragma unroll
    for (int q = 0; q < 8; ++q) { v4u o; o.x = cvt_pk_bf16(x[8 * q], x[8 * q + 1]); o.y = cvt_pk_bf16(x[8 * q + 2], x[8 * q + 3]); o.z = cvt_pk_bf16(x[8 * q + 4], x[8 * q + 5]); o.w = cvt_pk_bf16(x[8 * q + 6], x[8 * q + 7]);
        if (!ok) o = (v4u){0u, 0u, 0u, 0u};
        *(v4u*)(dst + 8 * q) = o; }
}
__device__ __forceinline__ void cvt_rows(const float* src, bf16* dst, size_t n8, size_t i0, size_t stride) {
    for (size_t i = i0; i < n8; i += stride) { const f32x4 a = *(const f32x4*)(src + i * 8), b = *(const f32x4*)(src + i * 8 + 4);
        v4u o; o.x = cvt_pk_bf16(a.x, a.y); o.y = cvt_pk_bf16(a.z, a.w); o.z = cvt_pk_bf16(b.x, b.y); o.w = cvt_pk_bf16(b.z, b.w); *(v4u*)(dst + i * 8) = o; }
}
__device__ __forceinline__ void p0_prologue(Frame& F, const Args& A) {
    const int gw = F.vcu * NWAVES + F.wave, NGW = F.G * NWAVES;
    constexpr int I_IN = 16 * (NUP / 64), I_OUT = 16 * 16, I_GU = 16 * 32, I_DN = 16 * 16, I_PG = 16 * 16, I_PP = 4 * 16;
    constexpr int PER_LAYER = I_IN + I_OUT + NE * I_GU + NE * I_DN + I_PG + I_PP;
#pragma unroll 1
    for (int it = gw; it < DEPTH * PER_LAYER; it += NGW) {
        const int l = it / PER_LAYER; int r = it % PER_LAYER;
        const float* W; bf16* WT; int K = D, N = D, nblk = 16;
        if (r < I_IN) { W = KIN(I_WIN) + (size_t)l * D * NU; WT = WSP(bf16, WS_WIN_T) + (size_t)l * NUP * D; N = NU; nblk = NUP / 64; }
        else if ((r -= I_IN) < I_OUT) { W = KIN(I_WOUT) + (size_t)l * D * D; WT = WSP(bf16, WS_WOUT_T) + (size_t)l * D * D; }
        else if ((r -= I_OUT) < NE * I_GU) { const int e = r / I_GU; r %= I_GU; W = KIN(I_WGU) + ((size_t)l * NE + e) * D * 2048; WT = WSP(bf16, WS_WGU_T) + ((size_t)l * NE + e) * 2048 * D; N = 2048; nblk = 32; }
        else if ((r -= NE * I_GU) < NE * I_DN) { const int e = r / I_DN; r %= I_DN; W = KIN(I_WDN) + ((size_t)l * NE + e) * D * D; WT = WSP(bf16, WS_WDN_T) + ((size_t)l * NE + e) * D * D; }
        else if ((r -= NE * I_DN) < I_PG) { W = KIN(I_PGW) + (size_t)l * D * D; WT = WSP(bf16, WS_WPG_T) + (size_t)l * D * D; }
        else { r -= I_PG; W = KIN(I_PPJ) + (size_t)l * 256 * D; WT = WSP(bf16, WS_WPP_T) + (size_t)l * D * 256; K = 256; }
        p0_transpose_item(W, K, N, nblk, WT, r, F.lane);
    }
    const size_t gt = (size_t)F.vcu * (NWAVES * 64) + F.tid, NT_ = (size_t)F.G * NWAVES * 64;
    cvt_rows(KIN(I_P), WSP(bf16, WS_PB), (size_t)DEPTH * T * 256 / 8, gt, NT_);
    cvt_rows(KIN(I_X), WSP(bf16, WS_XB), (size_t)T * D / 8, gt, NT_);
    for (size_t i = gt; i < (size_t)DEPTH * LORA_PER_LAYER; i += NT_) { const int l = (int)(i / LORA_PER_LAYER); int r = (int)(i % LORA_PER_LAYER); float v;
        if (r < 8192) { const int ch = r >> 5, j = r & 31; v = KIN(I_RWUP)[(size_t)l * 8192 + j * 256 + ch]; }
        else if (r < 16384) { r -= 8192; const int ch = r >> 5, j = r & 31; v = KIN(I_RAUP)[(size_t)l * 8192 + j * 256 + ch]; }
        else if (r < 32768) { r -= 16384; const int ch = r >> 6, j = r & 63; v = KIN(I_RGUP)[(size_t)l * 16384 + j * 256 + ch]; }
        else { r -= 32768; const int d = r >> 4, j = r & 15; v = KIN(I_GGUP)[(size_t)l * 2048 + j * 128 + d]; }
        WSP(float, WS_LORA)[i] = v; }
    for (size_t i = gt; i < (size_t)DEPTH * NE * D; i += NT_) { const int l = (int)(i / (NE * D)), r = (int)(i % (NE * D)), e = r / D, k = r % D; WSP(float, WS_RWT)[i] = KIN(I_RTW)[(size_t)l * D * NE + (size_t)k * NE + e]; }
}

__device__ __forceinline__ void router_pick(float (&p)[32], int lane, float rbias, int& ek, float& gk) {
#pragma unroll
    for (int i = 0; i < 16; ++i) { const bool hi = (lane & 32) != 0; const float keep = hi ? p[i + 16] : p[i], send = hi ? p[i] : p[i + 16]; p[i] = keep + __shfl_xor(send, 32); }
#pragma unroll
    for (int i = 0; i < 8; ++i) { const bool hi = (lane & 16) != 0; const float keep = hi ? p[i + 8] : p[i], send = hi ? p[i] : p[i + 8]; p[i] = keep + __shfl_xor(send, 16); }
#pragma unroll
    for (int i = 0; i < 4; ++i) { const bool hi = (lane & 8) != 0; const float keep = hi ? p[i + 4] : p[i], send = hi ? p[i] : p[i + 4]; p[i] = keep + __shfl_xor(send, 8); }
#pragma unroll
    for (int i = 0; i < 2; ++i) { const bool hi = (lane & 4) != 0; const float keep = hi ? p[i + 2] : p[i], send = hi ? p[i] : p[i + 2]; p[i] = keep + __shfl_xor(send, 4); }
    { const bool hi = (lane & 2) != 0; const float keep = hi ? p[1] : p[0], send = hi ? p[0] : p[1]; p[0] = keep + __shfl_xor(send, 2); }
    const float logit = p[0] + __shfl_xor(p[0], 1) + rbias;
    const int me = lane >> 1; int rank = 0;
#pragma unroll
    for (int e = 0; e < 32; ++e) { const float le = __builtin_bit_cast(float, __builtin_amdgcn_readlane(__builtin_bit_cast(int, logit), 2 * e)); rank += (le > logit || (le == logit && e < me)) ? 1 : 0; }
    float tv[4]; int te[4];
#pragma unroll
    for (int k = 0; k < 4; ++k) { const unsigned long long m = __ballot(rank == k); const int src = (int)__builtin_ctzll(m);
        te[k] = src >> 1; tv[k] = __builtin_bit_cast(float, __builtin_amdgcn_readlane(__builtin_bit_cast(int, logit), src)); }
    const float e1 = __expf(tv[1] - tv[0]), e2 = __expf(tv[2] - tv[0]), e3 = __expf(tv[3] - tv[0]); const float inv = 1.0f / (1.0f + e1 + e2 + e3);
    const int kk = lane & 3;
    ek = kk == 0 ? te[0] : kk == 1 ? te[1] : kk == 2 ? te[2] : te[3];
    gk = (kk == 0 ? 1.0f : kk == 1 ? e1 : kk == 2 ? e2 : e3) * inv;
}
template <bool DRY> __device__ __forceinline__ void p6_ln1_router(Frame& F, const Args& A, int layer) {
    const bf16* y1 = WSP(bf16, WS_Y1); bf16* x1b = WSP(bf16, WS_X1B);
    const float* g = KIN(I_LN1G) + layer * D; const float* bb = KIN(I_LN1B) + layer * D;
    const float* rwt = WSP(float, WS_RWT) + (size_t)layer * NE * D; const float* rb = KIN(I_RTB) + layer * NE;
    int* sdest = WSP(int, WS_SDEST); float* sgate = WSP(float, WS_SGATE);
    unsigned* cnt = (unsigned*)(F.ctl + CW_CNT + layer * NE * 16);
    LAS float* RWT = (LAS float*)F.lds;
    volatile LAS unsigned* lcnt = F.MISC + MW_LCNT; volatile LAS unsigned* lbase = F.MISC + MW_LBASE;
    for (int i = F.tid; i < NE * D / 4; i += NWAVES * 64) ((LAS f32x4*)RWT)[i] = ((const f32x4*)rwt)[i];
    const int lane = F.lane;
    const float rbias = rb[lane >> 1];
    for (int blk = F.vcu; blk < T / 64; blk += F.G) {
        if (F.tid < 32) lcnt[F.tid] = 0u;
        __syncthreads();
        int my_e = 0; float my_g = 0.f; unsigned my_r = 0u;
#pragma unroll 1
        for (int ri = 0; ri < 8; ++ri) {
            int lo_ = lane; asm volatile("" : "+v"(lo_));
            const f32x4 gv[4] = { *(const f32x4*)(g + 4 * lo_), *(const f32x4*)(g + 256 + 4 * lo_), *(const f32x4*)(g + 512 + 4 * lo_), *(const f32x4*)(g + 768 + 4 * lo_) };
            const f32x4 bv[4] = { *(const f32x4*)(bb + 4 * lo_), *(const f32x4*)(bb + 256 + 4 * lo_), *(const f32x4*)(bb + 512 + 4 * lo_), *(const f32x4*)(bb + 768 + 4 * lo_) };
            f32x4 v[4];
            { const int row = blk * 64 + F.wave * 8 + ri; const bf16* yr = y1 + (size_t)row * D; float s = 0.f;
#pragma unroll
                for (int j = 0; j < 4; ++j) { const v2u w = *(const v2u*)(yr + 256 * j + 4 * lane); v[j] = (f32x4){__uint_as_float(w.x << 16), __uint_as_float(w.x & 0xffff0000u), __uint_as_float(w.y << 16), __uint_as_float(w.y & 0xffff0000u)}; s += (v[j].x + v[j].y) + (v[j].z + v[j].w); }
                const float mean = wave_sum(s) * (1.f / D); float s2 = 0.f;
#pragma unroll
                for (int j = 0; j < 4; ++j) { v[j] = v[j] - mean; s2 += (v[j].x * v[j].x + v[j].y * v[j].y) + (v[j].z * v[j].z + v[j].w * v[j].w); }
                const float rstd = 1.0f / sqrtf(wave_sum(s2) * (1.f / D) + LN_EPS);
#pragma unroll
                for (int j = 0; j < 4; ++j) { v[j] = v[j] * rstd * gv[j] + bv[j];
                    v2u o; o.x = cvt_pk_bf16(v[j].x, v[j].y); o.y = cvt_pk_bf16(v[j].z, v[j].w); *(v2u*)(x1b + (size_t)row * D + 256 * j + 4 * lane) = o; } }
            float p0[32];
#pragma unroll
            for (int e = 0; e < 32; ++e) { float a0 = 0.f;
#pragma unroll
                for (int j = 0; j < 4; ++j) { const f32x4 w = *(const LAS f32x4*)(RWT + e * D + 256 * j + 4 * lane); a0 += (v[j].x * w.x + v[j].y * w.y) + (v[j].z * w.z + v[j].w * w.w); }
                p0[e] = a0; }
            int ek0; float gk0;
            router_pick(p0, lane, rbias, ek0, gk0);
            if ((lane >> 2) == ri) { my_e = ek0; my_g = gk0; my_r = DRY ? 0u : atomicAdd((unsigned*)&lcnt[ek0], 1u); }
        }
        __syncthreads();
        if (!DRY && F.tid < 32) { const unsigned n = lcnt[F.tid]; lbase[F.tid] = n ? __hip_atomic_fetch_add(cnt + F.tid * 16, n, RLX_AGENT) : 0u; }
        __syncthreads();
        if (!DRY && lane < 32) { const int row = blk * 64 + F.wave * 8 + (lane >> 2); const unsigned slot = (unsigned)my_e * ECAP + lbase[my_e] + my_r;
            sdest[slot] = row * 4 + (lane & 3); sgate[slot] = my_g; }
        __syncthreads();
    }
}
__device__ __forceinline__ void p9_combine(Frame& F, const Args& A) {
    const bf16* x1b = WSP(bf16, WS_X1B); const bf16* yb = WSP(bf16, WS_YBUF); bf16* hb = WSP(bf16, WS_HB);
    const int gw = F.vcu * NWAVES + F.wave, NGW = F.G * NWAVES, lane = F.lane;
    for (int row = gw; row < T; row += NGW) {
        v4u y[4][2], xw[2];
#pragma unroll
        for (int j = 0; j < 2; ++j) {
#pragma unroll
            for (int k = 0; k < 4; ++k) y[k][j] = *(const v4u*)(yb + ((size_t)row * 4 + k) * D + 512 * j + 8 * lane);
            xw[j] = *(const v4u*)(x1b + (size_t)row * D + 512 * j + 8 * lane); }
#pragma unroll
        for (int j = 0; j < 2; ++j) { f32x4 v0, v1; pg8::unpack8(xw[j], v0, v1); v0 = v0 * DN_ALPHA; v1 = v1 * DN_ALPHA;
#pragma unroll
            for (int k = 0; k < 4; ++k) { f32x4 a, b; pg8::unpack8(y[k][j], a, b); v0 = v0 + a; v1 = v1 + b; }
            v4u wv; wv.x = cvt_pk_bf16(v0.x, v0.y); wv.y = cvt_pk_bf16(v0.z, v0.w); wv.z = cvt_pk_bf16(v1.x, v1.y); wv.w = cvt_pk_bf16(v1.z, v1.w); *(v4u*)(hb + (size_t)row * D + 512 * j + 8 * lane) = wv; }
    }
}
__device__ __forceinline__ void p11_ln2(Frame& F, const Args& A, int layer) {
    const bf16* h2 = WSP(bf16, WS_H2); bf16* xb = WSP(bf16, WS_XB);
    const float* g = KIN(I_LN2G) + layer * D; const float* bb = KIN(I_LN2B) + layer * D;
    const int gw = F.vcu * NWAVES + F.wave, NGW = F.G * NWAVES, lane = F.lane;
    for (int row = gw; row < T; row += NGW) {
        const bf16* yr = h2 + (size_t)row * D; f32x4 v[4]; float s = 0.f;
#pragma unroll
        for (int j = 0; j < 4; ++j) { const v2u w = *(const v2u*)(yr + 256 * j + 4 * lane); v[j] = (f32x4){__uint_as_float(w.x << 16), __uint_as_float(w.x & 0xffff0000u), __uint_as_float(w.y << 16), __uint_as_float(w.y & 0xffff0000u)}; s += (v[j].x + v[j].y) + (v[j].z + v[j].w); }
        const float mean = wave_sum(s) * (1.f / D); float s2 = 0.f;
#pragma unroll
        for (int j = 0; j < 4; ++j) { v[j] = v[j] - mean; s2 += (v[j].x * v[j].x + v[j].y * v[j].y) + (v[j].z * v[j].z + v[j].w * v[j].w); }
        const float rstd = 1.0f / sqrtf(wave_sum(s2) * (1.f / D) + LN_EPS);
#pragma unroll
        for (int j = 0; j < 4; ++j) { const f32x4 gv = *(const f32x4*)(g + 256 * j + 4 * lane), bv = *(const f32x4*)(bb + 256 * j + 4 * lane);
            const f32x4 o = v[j] * rstd * gv + bv; const size_t off = (size_t)row * D + 256 * j + 4 * lane;
            if (layer == DEPTH - 1) *(f32x4*)(F.out + off) = o; v2u w; w.x = cvt_pk_bf16(o.x, o.y); w.y = cvt_pk_bf16(o.z, o.w); *(v2u*)(xb + off) = w; }
    }
}
__device__ __forceinline__ void moe_build_pfx(Frame& F, const Args& A, int layer, int NT) {
    volatile LAS unsigned* pfx = F.MISC + MW_PFX;
    __syncthreads();
    if (F.tid == 0) { unsigned acc = 0u;
        for (int e = 0; e < NE; ++e) { const unsigned c = __hip_atomic_load(F.ctl + CW_CNT + (layer * NE + e) * 16, RLX_AGENT); pfx[e] = acc; pfx[40 + e] = c; acc += ((c + 255u) >> 8) * (unsigned)NT; }
        pfx[32] = acc; }
    __syncthreads();
}
#define UU(t, col) bf2f(u[(size_t)(t) * NUP + (col)])
#define UU4(t, col) ldu4(u + (size_t)(t) * NUP + (col))
__device__ __forceinline__ f32x4 ldu4(const bf16* p) { const v2u w = *(const v2u*)p; return (f32x4){__uint_as_float(w.x << 16), __uint_as_float(w.x & 0xffff0000u), __uint_as_float(w.y << 16), __uint_as_float(w.y & 0xffff0000u)}; }
__device__ __forceinline__ void lds_st_bf16(LAS unsigned char* p, float v) { *(LAS unsigned short*)p = (unsigned short)(cvt_pk_bf16(v, 0.f) & 0xffffu); }
__device__ __forceinline__ void lds_st_bf16x4(LAS unsigned char* p, float a, float b, float c, float d) { v2u o; o.x = cvt_pk_bf16(a, b); o.y = cvt_pk_bf16(c, d); *(LAS v2u*)p = o; }

__device__ __forceinline__ void ssd_stage1(Frame& F, const Args& A, int layer, int b, int c) {
    const bf16* u = WSP(bf16, WS_U);
    LAS unsigned char* L = F.lds;
    LAS float* DT = (LAS float*)L; LAS float* AC = DT + 256;
    LAS unsigned char* BMT = L + 2048; LAS unsigned char* XCDT = BMT + 128 * 144;
    const int t0 = b * SEQ + c * 64, tid = F.tid, lane = F.lane, wave = F.wave;
    if (wave < 4) {
        const int hh = wave;
        const float dt = softplusf_(UU(t0 + lane, U_SSD_DT + hh) + KIN(I_SDTB)[layer * 4 + hh]);
        const float adt = -dt * __expf(KIN(I_SALOG)[layer * 4 + hh]);
        const float ac = wave_scan_add(adt, lane);
        DT[hh * 64 + lane] = dt; AC[hh * 64 + lane] = ac;
        if (lane == 63) WSP(float, WS_SSD_DEC)[(b * 4 + hh) * NCH + c] = __expf(ac);
    }
    __syncthreads();
    if (tid < 384) {
        const int cc = tid; const float* cw = KIN(I_SCW) + (size_t)layer * 2048 + cc; const float w0 = cw[0], w1 = cw[512], w2 = cw[1024], w3 = cw[1536], cb = KIN(I_SCB)[layer * 512 + cc];
        const bf16* up = u + (size_t)t0 * NUP + U_SSD_X + cc;
        float win0 = 0.f, win1 = 0.f, win2 = 0.f;
        if (c > 0) { win0 = bf2f(up[-3 * NUP]); win1 = bf2f(up[-2 * NUP]); win2 = bf2f(up[-1 * NUP]); }
        const int hh = (cc >> 6) & 3; const bool isx = cc < 256;
        LAS unsigned char* dst = isx ? XCDT + cc * 144 : BMT + (cc - 256) * 144;
        const float aclast = AC[hh * 64 + 63];
#pragma unroll 1
        for (int l0 = 0; l0 < 64; l0 += 32) {
            float xv[32];
#pragma unroll
            for (int j = 0; j < 32; ++j) xv[j] = bf2f(up[(l0 + j) * NUP]);
#pragma unroll
            for (int j8 = 0; j8 < 4; ++j8) { float o[8];
#pragma unroll
                for (int j = 0; j < 8; ++j) { const int l = l0 + j8 * 8 + j; const float x = xv[j8 * 8 + j]; const float y = cb + w0 * win0 + w1 * win1 + w2 * win2 + w3 * x; win0 = win1; win1 = win2; win2 = x;
                    float s = siluf_(y); if (isx) s *= DT[hh * 64 + l] * __expf(aclast - AC[hh * 64 + l]); o[j] = s; }
                *(LAS v4u*)(dst + (l0 + j8 * 8) * 2) = pack8(o); }
        }
    }
    __syncthreads();
    { const int fr = lane & 15, fq = lane >> 4; float* st = WSP(float, WS_SSD_ST);
#pragma unroll 1
      for (int i = 0; i < 2; ++i) { const int row0 = (2 * wave + i) * 16; const int hh = row0 >> 6, p = (row0 & 63) + fr;
          float* dstp = st + (((size_t)(b * 4 + hh) * NCH + c) * 64 + p) * 128;
#pragma unroll 1
          for (int ntl = 0; ntl < 8; ++ntl) { f32x4 acc = {0.f, 0.f, 0.f, 0.f}; acc = mm16(XCDT + row0 * 144, 144, BMT + ntl * 16 * 144, 144, 64, acc, fr, fq);
              *(f32x4*)(dstp + ntl * 16 + 4 * fq) = acc; } } }
    __syncthreads();
}
__device__ __forceinline__ void ssd_stage3(Frame& F, const Args& A, int layer, int b, int c) {
    const bf16* u = WSP(bf16, WS_U);
    LAS unsigned char* L = F.lds;
    LAS float* DT = (LAS float*)L; LAS float* AC = DT + 256;
    LAS unsigned char* CM = L + 2048; LAS unsigned char* BM = CM + 64 * 272; LAS unsigned char* XCT = BM + 64 * 272; LAS unsigned char* MM = XCT + 256 * 144;
    LAS unsigned char* YG = XCT;
    const int t0 = b * SEQ + c * 64, tid = F.tid, lane = F.lane, wave = F.wave, fr = lane & 15, fq = lane >> 4;
    if (wave < 4) {
        const int hh = wave;
        const float dt = softplusf_(UU(t0 + lane, U_SSD_DT + hh) + KIN(I_SDTB)[layer * 4 + hh]);
        const float adt = -dt * __expf(KIN(I_SALOG)[layer * 4 + hh]);
        DT[hh * 64 + lane] = dt; AC[hh * 64 + lane] = wave_scan_add(adt, lane);
    }
    __syncthreads();
    {
        const int cc = tid; const float* cw = KIN(I_SCW) + (size_t)layer * 2048 + cc; const float w0 = cw[0], w1 = cw[512], w2 = cw[1024], w3 = cw[1536], cb = KIN(I_SCB)[layer * 512 + cc];
        const bf16* up = u + (size_t)t0 * NUP + U_SSD_X + cc;
        float win0 = 0.f, win1 = 0.f, win2 = 0.f;
        if (c > 0) { win0 = bf2f(up[-3 * NUP]); win1 = bf2f(up[-2 * NUP]); win2 = bf2f(up[-1 * NUP]); }
        const int hh = (cc >> 6) & 3;
#pragma unroll 1
        for (int l0 = 0; l0 < 64; l0 += 32) {
            float xv[32];
#pragma unroll
            for (int j = 0; j < 32; ++j) xv[j] = bf2f(up[(l0 + j) * NUP]);
#pragma unroll
            for (int j8 = 0; j8 < 4; ++j8) { float o[8];
#pragma unroll
                for (int j = 0; j < 8; ++j) { const int l = l0 + j8 * 8 + j; const float x = xv[j8 * 8 + j]; const float y = cb + w0 * win0 + w1 * win1 + w2 * win2 + w3 * x; win0 = win1; win1 = win2; win2 = x;
                    float s = siluf_(y); if (cc < 256) s *= DT[hh * 64 + l]; o[j] = s; }
                if (cc < 256) *(LAS v4u*)(XCT + cc * 144 + (l0 + j8 * 8) * 2) = pack8(o);
                else { LAS unsigned char* d2 = (cc < 384 ? BM + (cc - 256) * 2 : CM + (cc - 384) * 2) + (l0 + j8 * 8) * 272;
#pragma unroll
                    for (int j = 0; j < 8; ++j) lds_st_bf16(d2 + j * 272, o[j]); } }
        }
    }
    __syncthreads();
#pragma unroll 1
    for (int i = 0; i < 2; ++i) { const int idx = 2 * wave + i, lt = idx >> 2, st = idx & 3;
        f32x4 acc = {0.f, 0.f, 0.f, 0.f}; acc = mm16(CM + lt * 16 * 272, 272, BM + st * 16 * 272, 272, 128, acc, fr, fq);
        const int l = lt * 16 + fr, s0 = st * 16 + 4 * fq;
#pragma unroll
        for (int hh = 0; hh < 4; ++hh) { const float al = AC[hh * 64 + l], dl = KIN(I_SD)[layer * 4 + hh] / DT[hh * 64 + l]; float o[4];
#pragma unroll
            for (int j = 0; j < 4; ++j) { const int s = s0 + j; float m = (l >= s) ? acc[j] * __expf(al - AC[hh * 64 + s]) : 0.f; if (l == s) m += dl; o[j] = m; }
            lds_st_bf16x4(MM + hh * 9216 + l * 144 + s0 * 2, o[0], o[1], o[2], o[3]); } }
    __syncthreads();
    f32x4 yv[2][4];
    { const int hh = wave >> 1; const float* prev = WSP(float, WS_SSD_ST) + ((size_t)(b * 4 + hh) * NCH + c) * 8192;
      bf16x8 pf[4][4];
#pragma unroll
      for (int pt = 0; pt < 4; ++pt)
#pragma unroll
          for (int ks = 0; ks < 4; ++ks) pf[pt][ks] = ldfrag_f32(prev + (size_t)(pt * 16 + fr) * 128 + ks * 32 + fq * 8);
#pragma unroll
      for (int i = 0; i < 2; ++i) { const int lt = 2 * (wave & 1) + i, l = lt * 16 + fr; const float ea = __expf(AC[hh * 64 + l]);
#pragma unroll
          for (int pt = 0; pt < 4; ++pt) { f32x4 ad = {0.f, 0.f, 0.f, 0.f}, ao = {0.f, 0.f, 0.f, 0.f};
              ad = mm16(MM + hh * 9216 + lt * 16 * 144, 144, XCT + (hh * 64 + pt * 16) * 144, 144, 64, ad, fr, fq);
              ao = mm16_rB<4>(CM + lt * 16 * 272, 272, pf[pt], ao, fr, fq);
              const f32x4 z = UU4(t0 + l, U_SSD_Z + hh * 64 + pt * 16 + 4 * fq);
              f32x4 y = ad + ao * ea; y.x *= siluf_(z.x); y.y *= siluf_(z.y); y.z *= siluf_(z.z); y.w *= siluf_(z.w); yv[i][pt] = y; } } }
    __syncthreads();
    { const int hh = wave >> 1;
#pragma unroll
      for (int i = 0; i < 2; ++i) { const int l = (2 * (wave & 1) + i) * 16 + fr;
#pragma unroll
          for (int pt = 0; pt < 4; ++pt) *(LAS f32x4*)(YG + l * 1040 + (hh * 64 + pt * 16 + 4 * fq) * 4) = yv[i][pt]; } }
    __syncthreads();
    { const f32x4 g = *(const f32x4*)(KIN(I_SNG) + layer * 256 + 4 * lane); bf16* mix = WSP(bf16, WS_MIX);
#pragma unroll 1
      for (int i = 0; i < 8; ++i) { const int l = wave * 8 + i; const f32x4 y = *(const LAS f32x4*)(YG + l * 1040 + lane * 16);
          const float ss = wave_sum((y.x * y.x + y.y * y.y) + (y.z * y.z + y.w * y.w)); const float r = 1.0f / sqrtf(ss * (1.f / 256.f) + NORM_EPS);
          v2u o; o.x = cvt_pk_bf16(y.x * r * g.x, y.y * r * g.y); o.y = cvt_pk_bf16(y.z * r * g.z, y.w * r * g.w);
          *(v2u*)(mix + (size_t)(t0 + l) * D + 4 * lane) = o; } }
    __syncthreads();
}

__device__ __forceinline__ float gla_bcum(Frame& F, const Args& A, int layer, int d, const LAS float* GD, LAS float* BC) {
    float gup[16];
    { const f32x4* gp4 = (const f32x4*)(WSP(float, WS_LORA) + (size_t)layer * LORA_PER_LAYER + 32768 + d * 16);
#pragma unroll
      for (int i = 0; i < 4; ++i) { const f32x4 a = gp4[i]; gup[4 * i] = a.x; gup[4 * i + 1] = a.y; gup[4 * i + 2] = a.z; gup[4 * i + 3] = a.w; } }
    const float gb = KIN(I_GGB)[layer * 128 + d]; float bc = 0.f;
#pragma unroll 2
    for (int l = 0; l < 64; ++l) { float x = gb;
#pragma unroll
        for (int i = 0; i < 16; ++i) x += GD[l * 16 + i] * gup[i];
        bc += logsigmoidf_(x) * 0.0625f; BC[l * 128 + d] = bc; }
    return bc;
}
__device__ __forceinline__ void gla_stage1(Frame& F, const Args& A, int layer, int b, int c) {
    const bf16* u = WSP(bf16, WS_U);
    LAS unsigned char* L = F.lds;
    LAS float* GD = (LAS float*)L; LAS float* BC = (LAS float*)(L + 4096);
    LAS unsigned char* KDT = L + 36864; LAS unsigned char* VT = KDT + 128 * 144;
    const int t0 = b * SEQ + c * 64, tid = F.tid, lane = F.lane, wave = F.wave, fr = lane & 15, fq = lane >> 4;
    if (tid < 256) { const int l = tid >> 2, q4 = tid & 3; *(LAS f32x4*)(GD + l * 16 + q4 * 4) = UU4(t0 + l, U_GL_G + 4 * q4); }
    __syncthreads();
    if (tid < 128) {
        const int d = tid; const float blast = gla_bcum(F, A, layer, d, GD, BC);
        WSP(float, WS_GLA_DEC)[(size_t)(b * NCH + c) * 128 + d] = __expf(blast);
        const bf16* up = u + (size_t)t0 * NUP + U_GL_K + d;
#pragma unroll 1
        for (int l0 = 0; l0 < 64; l0 += 32) { float xv[32];
#pragma unroll
            for (int j = 0; j < 32; ++j) xv[j] = bf2f(up[(l0 + j) * NUP]);
#pragma unroll
            for (int j8 = 0; j8 < 4; ++j8) { float o[8];
#pragma unroll
                for (int j = 0; j < 8; ++j) { const int l = l0 + j8 * 8 + j; o[j] = xv[j8 * 8 + j] * __expf(blast - BC[l * 128 + d]); }
                *(LAS v4u*)(KDT + d * 144 + (l0 + j8 * 8) * 2) = pack8(o); } }
    } else if (tid < 384) {
        const int vch = tid - 128; const bf16* up = u + (size_t)t0 * NUP + U_GL_V + vch;
#pragma unroll 1
        for (int l0 = 0; l0 < 64; l0 += 32) { float xv[32];
#pragma unroll
            for (int j = 0; j < 32; ++j) xv[j] = bf2f(up[(l0 + j) * NUP]);
#pragma unroll
            for (int j8 = 0; j8 < 4; ++j8) { float o[8];
#pragma unroll
                for (int j = 0; j < 8; ++j) o[j] = xv[j8 * 8 + j];
                *(LAS v4u*)(VT + vch * 144 + (l0 + j8 * 8) * 2) = pack8(o); } }
    }
    __syncthreads();
    { float* st = WSP(float, WS_GLA_ST);
#pragma unroll 1
      for (int i = 0; i < 4; ++i) { const int idx = 4 * wave + i, hh = idx >> 3, dtl = (idx >> 2) & 1, vt = idx & 3;
          f32x4 acc = {0.f, 0.f, 0.f, 0.f}; acc = mm16(KDT + (hh * 32 + dtl * 16) * 144, 144, VT + (hh * 64 + vt * 16) * 144, 144, 64, acc, fr, fq);
          *(f32x4*)(st + (((size_t)(b * 4 + hh) * NCH + c) * 32 + dtl * 16 + fr) * 64 + vt * 16 + 4 * fq) = acc; } }
    __syncthreads();
}
__device__ __forceinline__ void gla_stage3(Frame& F, const Args& A, int layer, int b, int c) {
    const bf16* u = WSP(bf16, WS_U);
    LAS unsigned char* L = F.lds;
    LAS float* GD = (LAS float*)L; LAS float* BC = (LAS float*)(L + 4096); LAS unsigned char* ATT = L + 4096;
    LAS unsigned char* QD = L + 40960; LAS unsigned char* KI = QD + 64 * 272; LAS unsigned char* VT = KI + 64 * 272; LAS unsigned char* PVT = VT + 256 * 144;
    const int t0 = b * SEQ + c * 64, tid = F.tid, lane = F.lane, wave = F.wave, fr = lane & 15, fq = lane >> 4;
    if (tid < 256) { const int l = tid >> 2, q4 = tid & 3; *(LAS f32x4*)(GD + l * 16 + q4 * 4) = UU4(t0 + l, U_GL_G + 4 * q4); }
    __syncthreads();
    if (tid < 128) {
        const int d = tid; (void)gla_bcum(F, A, layer, d, GD, BC);
        const bf16* uq = u + (size_t)t0 * NUP + U_GL_Q + d; const bf16* uk = u + (size_t)t0 * NUP + U_GL_K + d;
#pragma unroll 1
        for (int l0 = 0; l0 < 64; l0 += 16) { float qv[16], kv[16];
#pragma unroll
            for (int j = 0; j < 16; ++j) { qv[j] = bf2f(uq[(l0 + j) * NUP]); kv[j] = bf2f(uk[(l0 + j) * NUP]); }
#pragma unroll
            for (int j = 0; j < 16; ++j) { const int l = l0 + j; const float bc = BC[l * 128 + d];
                lds_st_bf16(QD + l * 272 + d * 2, qv[j] * 0.17677669529663687f * __expf(bc)); lds_st_bf16(KI + l * 272 + d * 2, kv[j] * __expf(-bc)); } }
    } else if (tid < 384) {
        const int vch = tid - 128; const bf16* up = u + (size_t)t0 * NUP + U_GL_V + vch;
#pragma unroll 1
        for (int l0 = 0; l0 < 64; l0 += 32) { float xv[32];
#pragma unroll
            for (int j = 0; j < 32; ++j) xv[j] = bf2f(up[(l0 + j) * NUP]);
#pragma unroll
            for (int j8 = 0; j8 < 4; ++j8) { float o[8];
#pragma unroll
                for (int j = 0; j < 8; ++j) o[j] = xv[j8 * 8 + j];
                *(LAS v4u*)(VT + vch * 144 + (l0 + j8 * 8) * 2) = pack8(o); } }
    } else {
        const float* prev = WSP(float, WS_GLA_ST);
#pragma unroll 4
        for (int i = tid - 384; i < 8192; i += 128) { const int hh = i >> 11, dd = (i >> 6) & 31, vv = i & 63;
            lds_st_bf16(PVT + (hh * 64 + vv) * 80 + dd * 2, prev[((size_t)(b * 4 + hh) * NCH + c) * 2048 + dd * 64 + vv]); }
    }
    __syncthreads();
    const int hh = wave >> 1;
#pragma unroll 1
    for (int i = 0; i < 2; ++i) { const int tt = 2 * (wave & 1) + i, t = tt * 16 + fr;
#pragma unroll
        for (int st = 0; st < 4; ++st) { f32x4 acc = {0.f, 0.f, 0.f, 0.f}; acc = mm16(QD + tt * 16 * 272 + hh * 64, 272, KI + st * 16 * 272 + hh * 64, 272, 32, acc, fr, fq);
            const int s0 = st * 16 + 4 * fq;
            lds_st_bf16x4(ATT + hh * 9216 + t * 144 + s0 * 2, t >= s0 ? acc[0] : 0.f, t >= s0 + 1 ? acc[1] : 0.f, t >= s0 + 2 ? acc[2] : 0.f, t >= s0 + 3 ? acc[3] : 0.f); } }
    __syncthreads();
    { bf16* mix = WSP(bf16, WS_MIX); const float* ng = KIN(I_GNG) + layer * 256;
#pragma unroll 1
      for (int i = 0; i < 2; ++i) { const int tt = 2 * (wave & 1) + i, t = tt * 16 + fr; f32x4 ov[4]; float ss = 0.f;
#pragma unroll
          for (int vt = 0; vt < 4; ++vt) { f32x4 acc = {0.f, 0.f, 0.f, 0.f};
              acc = mm16(ATT + hh * 9216 + tt * 16 * 144, 144, VT + (hh * 64 + vt * 16) * 144, 144, 64, acc, fr, fq);
              acc = mm16(QD + tt * 16 * 272 + hh * 64, 272, PVT + (hh * 64 + vt * 16) * 80, 80, 32, acc, fr, fq);
              ov[vt] = acc; ss += (acc.x * acc.x + acc.y * acc.y) + (acc.z * acc.z + acc.w * acc.w); }
          ss += __shfl_xor(ss, 16); ss += __shfl_xor(ss, 32);
          const float r = 1.0f / sqrtf(ss * (1.f / 64.f) + NORM_EPS);
#pragma unroll
          for (int vt = 0; vt < 4; ++vt) { const int col = hh * 64 + vt * 16 + 4 * fq; const f32x4 g = *(const f32x4*)(ng + col); const f32x4 og = UU4(t0 + t, U_GL_OG + col);
              v2u o; o.x = cvt_pk_bf16(ov[vt].x * r * g.x * siluf_(og.x), ov[vt].y * r * g.y * siluf_(og.y)); o.y = cvt_pk_bf16(ov[vt].z * r * g.z * siluf_(og.z), ov[vt].w * r * g.w * siluf_(og.w));
              *(v2u*)(mix + (size_t)(t0 + t) * D + 512 + col) = o; } } }
    __syncthreads();
}

__device__ __forceinline__ void mlstm_stage1(Frame& F, const Args& A, int layer, int b, int c) {
    const bf16* u = WSP(bf16, WS_U);
    LAS unsigned char* L = F.lds;
    LAS float* WST = (LAS float*)L; LAS unsigned char* KT = L + 1024; LAS unsigned char* VWT = KT + 256 * 144;
    const int t0 = b * SEQ + c * 64, tid = F.tid, lane = F.lane, wave = F.wave, fr = lane & 15, fq = lane >> 4;
    if (wave < 4) {
        const int hh = wave;
        const float ig = UU(t0 + lane, U_ML_I + hh) + KIN(I_MIB)[layer * 4 + hh];
        const float lf = logsigmoidf_(UU(t0 + lane, U_ML_F + hh) + KIN(I_MFB)[layer * 4 + hh]);
        const float bc = wave_scan_add(lf, lane); const float blast = __shfl(bc, 63);
        const float ast = blast - bc + ig; const float mloc = wave_max(ast);
        WST[hh * 64 + lane] = __expf(ast - mloc);
        if (lane == 0) { WSP(float, WS_ML_BL)[(b * 4 + hh) * NCH + c] = blast; WSP(float, WS_ML_ML)[(b * 4 + hh) * NCH + c] = mloc; }
    } else {
        const int kch = tid - 256, cc = 256 + kch; const float* cw = KIN(I_MCW) + (size_t)layer * 2048 + cc; const float w0 = cw[0], w1 = cw[512], w2 = cw[1024], w3 = cw[1536], cb = KIN(I_MCB)[layer * 512 + cc];
        const bf16* up = u + (size_t)t0 * NUP + U_ML_K + kch;
        float win0 = 0.f, win1 = 0.f, win2 = 0.f;
        if (c > 0) { win0 = bf2f(up[-3 * NUP]); win1 = bf2f(up[-2 * NUP]); win2 = bf2f(up[-1 * NUP]); }
#pragma unroll 1
        for (int l0 = 0; l0 < 64; l0 += 32) { float xv[32];
#pragma unroll
            for (int j = 0; j < 32; ++j) xv[j] = bf2f(up[(l0 + j) * NUP]);
#pragma unroll
            for (int j8 = 0; j8 < 4; ++j8) { float o[8];
#pragma unroll
                for (int j = 0; j < 8; ++j) { const float x = xv[j8 * 8 + j]; const float y = cb + w0 * win0 + w1 * win1 + w2 * win2 + w3 * x; win0 = win1; win1 = win2; win2 = x; o[j] = siluf_(y); }
                *(LAS v4u*)(KT + kch * 144 + (l0 + j8 * 8) * 2) = pack8(o); } }
    }
    __syncthreads();
    if (tid < 256) {
        const int vch = tid, hh = vch >> 6; const bf16* up = u + (size_t)t0 * NUP + U_ML_V + vch;
#pragma unroll 1
        for (int l0 = 0; l0 < 64; l0 += 32) { float xv[32];
#pragma unroll
            for (int j = 0; j < 32; ++j) xv[j] = bf2f(up[(l0 + j) * NUP]);
#pragma unroll
            for (int j8 = 0; j8 < 4; ++j8) { float o[8];
#pragma unroll
                for (int j = 0; j < 8; ++j) o[j] = xv[j8 * 8 + j] * WST[hh * 64 + l0 + j8 * 8 + j];
                *(LAS v4u*)(VWT + vch * 144 + (l0 + j8 * 8) * 2) = pack8(o); } }
    } else {
        const int kch = tid - 256, hh = kch >> 6; float n = 0.f;
#pragma unroll 8
        for (int s = 0; s < 64; ++s) n += WST[hh * 64 + s] * bf2f(*(const LAS unsigned short*)(KT + kch * 144 + s * 2));
        WSP(float, WS_ML_N)[((size_t)(b * 4 + hh) * NCH + c) * 64 + (kch & 63)] = n;
    }
    __syncthreads();
    { float* cst = WSP(float, WS_ML_C); const int hh = wave >> 1;
#pragma unroll 1
      for (int i = 0; i < 2; ++i) { const int vt = 2 * (wave & 1) + i;
#pragma unroll 1
          for (int kt = 0; kt < 4; ++kt) { f32x4 acc = {0.f, 0.f, 0.f, 0.f}; acc = mm16(VWT + (hh * 64 + vt * 16) * 144, 144, KT + (hh * 64 + kt * 16) * 144, 144, 64, acc, fr, fq);
              *(f32x4*)(cst + (((size_t)(b * 4 + hh) * NCH + c) * 64 + vt * 16 + fr) * 64 + kt * 16 + 4 * fq) = acc; } } }
    __syncthreads();
}
__device__ __forceinline__ void mlstm_stage3(Frame& F, const Args& A, int layer, int b, int c) {
    const bf16* u = WSP(bf16, WS_U);
    LAS unsigned char* L = F.lds;
    LAS float* BCU = (LAS float*)L; LAS float* GG = BCU + 256; LAS float* MROW = BCU + 512; LAS float* WINT = BCU + 768; LAS float* NPV = BCU + 1024;
    LAS unsigned char* Q = L + 6144; LAS unsigned char* KK = Q + 64 * 528; LAS unsigned char* VT = KK + 64 * 528; LAS unsigned char* SC = VT + 256 * 144;
    const int t0 = b * SEQ + c * 64, tid = F.tid, lane = F.lane, wave = F.wave, fr = lane & 15, fq = lane >> 4;
    if (wave < 4) {
        const int hh = wave;
        const float ig = UU(t0 + lane, U_ML_I + hh) + KIN(I_MIB)[layer * 4 + hh];
        const float lf = logsigmoidf_(UU(t0 + lane, U_ML_F + hh) + KIN(I_MFB)[layer * 4 + hh]);
        const float bc = wave_scan_add(lf, lane); const float gg = ig - bc;
        const float mprev = WSP(float, WS_ML_M)[(b * 4 + hh) * NCH + c];
        const float minter = bc + mprev, mintra = bc + wave_scan_max(gg, lane), mrow = fmaxf(minter, mintra);
        BCU[hh * 64 + lane] = bc; GG[hh * 64 + lane] = gg; MROW[hh * 64 + lane] = mrow; WINT[hh * 64 + lane] = __expf(minter - mrow);
        NPV[hh * 64 + lane] = WSP(float, WS_ML_N)[((size_t)(b * 4 + hh) * NCH + c) * 64 + lane];
    }
    {
        const int cc = tid; const float* cw = KIN(I_MCW) + (size_t)layer * 2048 + cc; const float w0 = cw[0], w1 = cw[512], w2 = cw[1024], w3 = cw[1536], cb = KIN(I_MCB)[layer * 512 + cc];
        const bf16* up = u + (size_t)t0 * NUP + U_ML_Q + cc;
        float win0 = 0.f, win1 = 0.f, win2 = 0.f;
        if (c > 0) { win0 = bf2f(up[-3 * NUP]); win1 = bf2f(up[-2 * NUP]); win2 = bf2f(up[-1 * NUP]); }
        LAS unsigned char* dst = cc < 256 ? Q + cc * 2 : KK + (cc - 256) * 2; const float sc = cc < 256 ? 0.125f : 1.0f;
#pragma unroll 1
        for (int l0 = 0; l0 < 64; l0 += 32) { float xv[32];
#pragma unroll
            for (int j = 0; j < 32; ++j) xv[j] = bf2f(up[(l0 + j) * NUP]);
#pragma unroll
            for (int j = 0; j < 32; ++j) { const float x = xv[j]; const float y = cb + w0 * win0 + w1 * win1 + w2 * win2 + w3 * x; win0 = win1; win1 = win2; win2 = x; lds_st_bf16(dst + (l0 + j) * 528, siluf_(y) * sc); } }
        const int vch = tid & 255, lh = (tid >> 8) * 32; const bf16* uv = u + (size_t)(t0 + lh) * NUP + U_ML_V + vch;
        float xv[32];
#pragma unroll
        for (int j = 0; j < 32; ++j) xv[j] = bf2f(uv[j * NUP]);
#pragma unroll
        for (int j8 = 0; j8 < 4; ++j8) { float o[8];
#pragma unroll
            for (int j = 0; j < 8; ++j) o[j] = xv[j8 * 8 + j];
            *(LAS v4u*)(VT + vch * 144 + (lh + j8 * 8) * 2) = pack8(o); }
    }
    __syncthreads();
    { const int hh = wave >> 1; bf16* mix = WSP(bf16, WS_MIX); const float* ng = KIN(I_MNG) + layer * 256;
      const float* cprev = WSP(float, WS_ML_C) + ((size_t)(b * 4 + hh) * NCH + c) * 4096;
      bf16x8 cf[4][2];
#pragma unroll
      for (int vt = 0; vt < 4; ++vt)
#pragma unroll
          for (int ks = 0; ks < 2; ++ks) cf[vt][ks] = ldfrag_f32(cprev + (size_t)(vt * 16 + fr) * 64 + ks * 32 + fq * 8);
#pragma unroll 1
      for (int i = 0; i < 2; ++i) { const int tt = 2 * (wave & 1) + i, t = tt * 16 + fr;
          const float bt = BCU[hh * 64 + t] - MROW[hh * 64 + t]; float rs = 0.f;
#pragma unroll
          for (int st = 0; st < 4; ++st) { f32x4 acc = {0.f, 0.f, 0.f, 0.f}; acc = mm16(Q + tt * 16 * 528 + hh * 128, 528, KK + st * 16 * 528 + hh * 128, 528, 64, acc, fr, fq);
              const int s0 = st * 16 + 4 * fq; float o[4];
#pragma unroll
              for (int j = 0; j < 4; ++j) { const int s = s0 + j; const float v = (t >= s) ? acc[j] * __expf(bt + GG[hh * 64 + s]) : 0.f; o[j] = v; rs += v; }
              lds_st_bf16x4(SC + hh * 9216 + t * 144 + s0 * 2, o[0], o[1], o[2], o[3]); }
          rs += __shfl_xor(rs, 16); rs += __shfl_xor(rs, 32);
          float nq = 0.f;
#pragma unroll
          for (int j = 0; j < 16; ++j) nq += bf2f(*(const LAS unsigned short*)(Q + t * 528 + (hh * 64 + fq * 16 + j) * 2)) * NPV[hh * 64 + fq * 16 + j];
          nq += __shfl_xor(nq, 16); nq += __shfl_xor(nq, 32);
          const float wi = WINT[hh * 64 + t]; const float den = wi * nq + rs; const float dn = fmaxf(fabsf(den), __expf(-MROW[hh * 64 + t])); const float rdn = 1.0f / dn;
          LDS_WAIT();
          f32x4 hv[4]; float sm = 0.f;
#pragma unroll
          for (int vt = 0; vt < 4; ++vt) { f32x4 acc = {0.f, 0.f, 0.f, 0.f};
              acc = mm16_rB<2>(Q + tt * 16 * 528 + hh * 128, 528, cf[vt], acc, fr, fq);
              acc = acc * wi;
              acc = mm16(SC + hh * 9216 + tt * 16 * 144, 144, VT + (hh * 64 + vt * 16) * 144, 144, 64, acc, fr, fq);
              const f32x4 og = UU4(t0 + t, U_ML_O + hh * 64 + vt * 16 + 4 * fq);
              f32x4 h; h.x = acc.x * rdn * sigmoidf_(og.x); h.y = acc.y * rdn * sigmoidf_(og.y); h.z = acc.z * rdn * sigmoidf_(og.z); h.w = acc.w * rdn * sigmoidf_(og.w);
              hv[vt] = h; sm += (h.x + h.y) + (h.z + h.w); }
          sm += __shfl_xor(sm, 16); sm += __shfl_xor(sm, 32);
          const float mean = sm * (1.f / 64.f); float sq = 0.f;
#pragma unroll
          for (int vt = 0; vt < 4; ++vt) { hv[vt] = hv[vt] - mean; sq += (hv[vt].x * hv[vt].x + hv[vt].y * hv[vt].y) + (hv[vt].z * hv[vt].z + hv[vt].w * hv[vt].w); }
          sq += __shfl_xor(sq, 16); sq += __shfl_xor(sq, 32);
          const float r = 1.0f / sqrtf(sq * (1.f / 64.f) + NORM_EPS);
#pragma unroll
          for (int vt = 0; vt < 4; ++vt) { const int col = hh * 64 + vt * 16 + 4 * fq; const f32x4 g = *(const f32x4*)(ng + col);
              v2u o; o.x = cvt_pk_bf16(hv[vt].x * r * g.x, hv[vt].y * r * g.y); o.y = cvt_pk_bf16(hv[vt].z * r * g.z, hv[vt].w * r * g.w);
              *(v2u*)(mix + (size_t)(t0 + t) * D + 768 + col) = o; } } }
    __syncthreads();
}

__device__ __forceinline__ void rwkv_stage1(Frame& F, const Args& A, int layer, int ub) {
    const bf16* u = WSP(bf16, WS_U);
    LAS unsigned char* L = F.lds;
    LAS float* LOWA = (LAS float*)L;
    LAS float* CUM = (LAS float*)(L + 16384);
    LAS float* AAB = CUM;
    LAS float* TOT = CUM;
    LAS unsigned char* M0 = L + 16384 + 16640;
#define RM(i) (M0 + (i) * 9216)
    LAS float* LOG = (LAS float*)RM(0);
    LAS float* GAMC = (LAS float*)(F.MISC + MW_GAMC);
    const int t0 = ub * 64, c = ub & 63, tid = F.tid, lane = F.lane, wave = F.wave;
    const float* mu = KIN(I_RMU) + layer * 896;
#ifndef RW_DUP
#define RW_DUP -1
#endif
#define RW_REP(k) for (int rep__ = 0; rep__ < ((RW_DUP == (k)) ? 2 : 1); ++rep__)
    RW_REP(0) {
    {
        const int l = tid >> 3, jq = tid & 7, t = t0 + l; const bool has_prev = (t & (SEQ - 1)) != 0;
        f32x4 cur[4], prv[4];
#pragma unroll
        for (int q = 0; q < 4; ++q) { cur[q] = UU4(t, U_RW_LO + jq * 16 + 4 * q); prv[q] = has_prev ? UU4(t - 1, U_RW_LO + jq * 16 + 4 * q) : (f32x4){0.f, 0.f, 0.f, 0.f}; }
#pragma unroll
        for (int q = 0; q < 4; ++q) { const f32x4 m4 = *(const f32x4*)(mu + 768 + jq * 16 + 4 * q); const f32x4 xs = cur[q] + (prv[q] - cur[q]) * m4; const int j = jq * 16 + 4 * q;
            f32x4 o;
            if (j < 32) { o.x = tanhf(xs.x); o.y = tanhf(xs.y); o.z = tanhf(xs.z); o.w = tanhf(xs.w); } else if (j < 64) o = xs; else { o.x = sigmoidf_(xs.x); o.y = sigmoidf_(xs.y); o.z = sigmoidf_(xs.z); o.w = sigmoidf_(xs.w); }
            if (j < 64) *(LAS f32x4*)(LOWA + l * 64 + j) = o; else *(LAS f32x4*)(LOG + l * 64 + j - 64) = o; }
    }
    __syncthreads();
    { const int ch = tid & 255, half = tid >> 8; float* RG = WSP(float, WS_RW_G);
      float gup[64];
      { const f32x4* gp4 = (const f32x4*)(WSP(float, WS_LORA) + (size_t)layer * LORA_PER_LAYER + 16384 + ch * 64);
#pragma unroll
        for (int j = 0; j < 16; ++j) { const f32x4 a = gp4[j]; gup[4 * j] = a.x; gup[4 * j + 1] = a.y; gup[4 * j + 2] = a.z; gup[4 * j + 3] = a.w; } }
#pragma unroll 2
      for (int li = 0; li < 32; ++li) { const int l = half * 32 + li; float g0 = 0.f, g1 = 0.f;
#pragma unroll
          for (int j = 0; j < 16; ++j) { const f32x4 x4 = *(const LAS f32x4*)(LOG + l * 64 + 4 * j); g0 += x4.x * gup[4 * j] + x4.y * gup[4 * j + 1]; g1 += x4.z * gup[4 * j + 2] + x4.w * gup[4 * j + 3]; }
          RG[(size_t)(t0 + l) * 256 + ch] = g0 + g1; } }
    __syncthreads();
    }
    const int b_ = ub >> 6;
#pragma unroll 1
    for (int hh = 0; hh < 4; ++hh) {
        int ch = lane, fr = lane & 15, fq = lane >> 4; asm volatile("" : "+v"(ch), "+v"(fr), "+v"(fq));
        const int tg = wave, cg = hh * 64 + ch; const size_t un = (size_t)(b_ * 4 + hh) * NCH + c;
        float rr[8], k2r[8], vr[8], ar[8], br[8], pl[8];
        RW_REP(1) {
            float wup[32], aup[32];
            { const f32x4* wp4 = (const f32x4*)(WSP(float, WS_LORA) + (size_t)layer * LORA_PER_LAYER + cg * 32); const f32x4* ap4 = (const f32x4*)(WSP(float, WS_LORA) + (size_t)layer * LORA_PER_LAYER + 8192 + cg * 32);
#pragma unroll
              for (int j = 0; j < 8; ++j) { const f32x4 a = wp4[j], b = ap4[j]; wup[4 * j] = a.x; wup[4 * j + 1] = a.y; wup[4 * j + 2] = a.z; wup[4 * j + 3] = a.w; aup[4 * j] = b.x; aup[4 * j + 1] = b.y; aup[4 * j + 2] = b.z; aup[4 * j + 3] = b.w; } }
            const float w0 = KIN(I_RW0)[layer * 256 + cg], a0 = KIN(I_RA0)[layer * 256 + cg], kkc = KIN(I_RKK)[layer * 256 + cg], kac = KIN(I_RKA)[layer * 256 + cg];
            const float mur = mu[cg], muk = mu[256 + cg], muv = mu[512 + cg];
            const int tb = t0 + tg * 8; const bool nop = (c == 0) && (tg == 0);
            float rp = nop ? 0.f : UU(tb - 1, U_RW_R + cg), kp = nop ? 0.f : UU(tb - 1, U_RW_K + cg), vp = nop ? 0.f : UU(tb - 1, U_RW_V + cg);
            float rc[8], kc[8], vc[8];
#pragma unroll
            for (int j = 0; j < 8; ++j) { rc[j] = UU(tb + j, U_RW_R + cg); kc[j] = UU(tb + j, U_RW_K + cg); vc[j] = UU(tb + j, U_RW_V + cg); }
            float* RW = WSP(float, WS_RW);
            float kk[8], al[8], n2[8], run = 0.f;
#pragma unroll
            for (int j = 0; j < 8; ++j) { const int l = tg * 8 + j;
                const float r = rc[j] + (rp - rc[j]) * mur, k = kc[j] + (kp - kc[j]) * muk, v = vc[j] + (vp - vc[j]) * muv; rp = rc[j]; kp = kc[j]; vp = vc[j];
                float wp = w0, ap = a0;
#pragma unroll
                for (int q = 0; q < 8; ++q) { const f32x4 lw4 = *(const LAS f32x4*)(LOWA + l * 64 + 4 * q), la4 = *(const LAS f32x4*)(LOWA + l * 64 + 32 + 4 * q);
                    wp += (lw4.x * wup[4 * q] + lw4.y * wup[4 * q + 1]) + (lw4.z * wup[4 * q + 2] + lw4.w * wup[4 * q + 3]); ap += (la4.x * aup[4 * q] + la4.y * aup[4 * q + 1]) + (la4.z * aup[4 * q + 2] + la4.w * aup[4 * q + 3]); }
                const float w = -softplusf_(-wp) - 0.5f; run += -__expf(w); pl[j] = run; al[j] = sigmoidf_(ap);
                kk[j] = k * kkc; n2[j] = kk[j] * kk[j];
                k2r[j] = k * (1.0f + (al[j] - 1.0f) * kac); rr[j] = r; vr[j] = v;
                float* o = RW + (size_t)(tb + j) * 768 + cg; o[0] = r; o[256] = k2r[j]; o[512] = v; }
#pragma unroll
            for (int i = 0; i < 4; ++i) { const bool hi = (ch & 32) != 0; const float keep = hi ? n2[i + 4] : n2[i], send = hi ? n2[i] : n2[i + 4]; n2[i] = keep + __shfl_xor(send, 32); }
#pragma unroll
            for (int i = 0; i < 2; ++i) { const bool hi = (ch & 16) != 0; const float keep = hi ? n2[i + 2] : n2[i], send = hi ? n2[i] : n2[i + 2]; n2[i] = keep + __shfl_xor(send, 16); }
            { const bool hi = (ch & 8) != 0; const float keep = hi ? n2[1] : n2[0], send = hi ? n2[0] : n2[1]; n2[0] = keep + __shfl_xor(send, 8); }
            n2[0] += __shfl_xor(n2[0], 4); n2[0] += __shfl_xor(n2[0], 2); n2[0] += __shfl_xor(n2[0], 1);
#pragma unroll
            for (int j = 0; j < 8; ++j) { const float tot = __builtin_bit_cast(float, __builtin_amdgcn_readlane(__builtin_bit_cast(int, n2[0]), ((j & 4) ? 32 : 0) + ((j & 2) ? 16 : 0) + ((j & 1) ? 8 : 0)));
                const float kkn = kk[j] / fmaxf(sqrtf(tot), 1e-12f); ar[j] = -kkn; br[j] = kkn * al[j]; }
            TOT[tg * 64 + ch] = run;
        }
        __syncthreads();
        RW_REP(3) {
            float off = 0.f, gC = 0.f;
#pragma unroll
            for (int g = 0; g < 8; ++g) { const float tv = TOT[g * 64 + ch]; gC += tv; if (g < tg) off += tv; }
            float oat[8], obb[8], okb[8], ov[8];
#pragma unroll
            for (int j = 0; j < 8; ++j) { const int l = tg * 8 + j; const float gt = off + pl[j], gm = j > 0 ? off + pl[j - 1] : off;
                const float at = ar[j] * __expf(gm), rt = rr[j] * __expf(gt), en = __expf(-gt), ec = __expf(gC - gt);
                lds_st_bf16(RM(0) + l * 144 + ch * 2, at); lds_st_bf16(RM(1) + l * 144 + ch * 2, rt); lds_st_bf16(RM(2) + l * 144 + ch * 2, br[j] * en); lds_st_bf16(RM(3) + l * 144 + ch * 2, k2r[j] * en);
                oat[j] = at; obb[j] = br[j] * ec; okb[j] = k2r[j] * ec; ov[j] = vr[j]; }
            *(LAS v4u*)(RM(4) + ch * 144 + tg * 16) = pack8(oat); *(LAS v4u*)(RM(5) + ch * 144 + tg * 16) = pack8(obb); *(LAS v4u*)(RM(6) + ch * 144 + tg * 16) = pack8(okb); *(LAS v4u*)(RM(7) + ch * 144 + tg * 16) = pack8(ov);
            if (tg == 0) GAMC[ch] = __expf(gC);
        }
        __syncthreads();
        RW_REP(4) {
            const int which = wave >> 1; const LAS unsigned char* Aop = which < 2 ? RM(0) : RM(1); const LAS unsigned char* Bop = (which & 1) ? RM(3) : RM(2);
#pragma unroll 1
            for (int i2 = 0; i2 < 2; ++i2) { const int tt = 2 * (wave & 1) + i2, t = tt * 16 + fr;
#pragma unroll
                for (int it = 0; it < 4; ++it) { f32x4 acc = {0.f, 0.f, 0.f, 0.f}; acc = mm16(Aop + tt * 16 * 144, 144, Bop + it * 16 * 144, 144, 64, acc, fr, fq);
                    const int i0 = it * 16 + 4 * fq; const int lim = which < 2 ? t : t + 1;
                    const float o0 = (i0 < lim) ? acc[0] : 0.f, o1 = (i0 + 1 < lim) ? acc[1] : 0.f, o2 = (i0 + 2 < lim) ? acc[2] : 0.f, o3 = (i0 + 3 < lim) ? acc[3] : 0.f;
#ifdef RW_CLAMP_AAK
                    float q0 = o0, q1 = o1, q2 = o2, q3 = o3;
                    if (which == 1) { q0 = fabsf(o0) < 1e30f ? o0 : 0.f; q1 = fabsf(o1) < 1e30f ? o1 : 0.f; q2 = fabsf(o2) < 1e30f ? o2 : 0.f; q3 = fabsf(o3) < 1e30f ? o3 : 0.f; }
                    if (which == 0) *(LAS f32x4*)(AAB + t * 64 + i0) = (f32x4){o0, o1, o2, o3};
                    else lds_st_bf16x4(RM(7 + which) + t * 144 + i0 * 2, q0, q1, q2, q3);
                    continue;
#endif
                    if (which == 0) { DBG_STAT(11, o0); DBG_STAT(11, o1); DBG_STAT(11, o2); DBG_STAT(11, o3); } if (which == 1) { DBG_STAT(12, o0); DBG_STAT(12, o1); DBG_STAT(12, o2); DBG_STAT(12, o3); } if (which == 2) { DBG_STAT(13, o0); DBG_STAT(13, o3); } if (which == 3) { DBG_STAT(14, o0); DBG_STAT(14, o3); }
                    if (which == 0) *(LAS f32x4*)(AAB + t * 64 + i0) = (f32x4){o0, o1, o2, o3};
                    else lds_st_bf16x4(RM(7 + which) + t * 144 + i0 * 2, o0, o1, o2, o3); } }
        }
        __syncthreads();
        RW_REP(5) {
#pragma unroll 1
            for (int i2 = 0; i2 < 2; ++i2) { const int idx = wave * 2 + i2, vt = idx >> 2, tt = idx & 3; f32x4 acc = {0.f, 0.f, 0.f, 0.f};
                acc = mm16(RM(7) + vt * 16 * 144, 144, RM(8) + tt * 16 * 144, 144, 64, acc, fr, fq);
                DBG_STAT(15, acc[0]); DBG_STAT(15, acc[1]); DBG_STAT(15, acc[2]); DBG_STAT(15, acc[3]);
                lds_st_bf16x4(RM(0) + (vt * 16 + fr) * 144 + (tt * 16 + 4 * fq) * 2, acc[0], acc[1], acc[2], acc[3]); }
        }
        RW_REP(8) if (wave == 0) {
            float x[64]; f32x4 rowq[16];
#pragma unroll
            for (int t = 0; t < 64; ++t) {
                f32x4 cur[16];
#pragma unroll
                for (int i4 = 0; i4 < (t + 3) / 4; ++i4) cur[i4] = rowq[i4];
                if (t + 1 < 64) {
#pragma unroll
                    for (int i4 = 0; i4 < (t + 4) / 4; ++i4) rowq[i4] = *(const LAS f32x4*)(AAB + (t + 1) * 64 + 4 * i4); }
                float a0 = (t == ch) ? 1.0f : 0.f, a1 = 0.f, a2 = 0.f, a3 = 0.f;
#pragma unroll
                for (int i4 = 0; i4 < (t + 3) / 4; ++i4) { const f32x4 q = cur[i4];
                    a0 += q.x * x[4 * i4]; if (4 * i4 + 1 < t) a1 += q.y * x[4 * i4 + 1]; if (4 * i4 + 2 < t) a2 += q.z * x[4 * i4 + 2]; if (4 * i4 + 3 < t) a3 += q.w * x[4 * i4 + 3]; }
                const float acc = (a0 + a1) + (a2 + a3);
                x[t] = acc; lds_st_bf16(RM(11) + t * 144 + ch * 2, acc); }
        }
        __syncthreads();
        RW_REP(6) {
            const int rt = wave >> 1;
#pragma unroll
            for (int i2 = 0; i2 < 2; ++i2) { const int tt = 2 * (wave & 1) + i2;
                f32x4 acc = {0.f, 0.f, 0.f, 0.f}; acc = mm16(RM(4) + rt * 16 * 144, 144, RM(11) + tt * 16 * 144, 144, 64, acc, fr, fq);
                DBG_STAT(17, acc[0]); DBG_STAT(17, acc[1]); DBG_STAT(17, acc[2]); DBG_STAT(17, acc[3]);
                lds_st_bf16x4(RM(2) + (rt * 16 + fr) * 144 + (tt * 16 + 4 * fq) * 2, acc[0], acc[1], acc[2], acc[3]);
                f32x4 ac2 = {0.f, 0.f, 0.f, 0.f}; ac2 = mm16(RM(0) + rt * 16 * 144, 144, RM(11) + tt * 16 * 144, 144, 64, ac2, fr, fq);
                DBG_STAT(18, ac2[0]); DBG_STAT(18, ac2[1]); DBG_STAT(18, ac2[2]); DBG_STAT(18, ac2[3]);
                lds_st_bf16x4(RM(3) + (rt * 16 + fr) * 144 + (tt * 16 + 4 * fq) * 2, ac2[0], ac2[1], ac2[2], ac2[3]); }
        }
        __syncthreads();
        RW_REP(7) {
            const int which = wave >> 1;
#pragma unroll 1
            for (int i2 = 0; i2 < 2; ++i2) { const int rt = 2 * (wave & 1) + i2, row = rt * 16 + fr;
#pragma unroll
                for (int ct = 0; ct < 4; ++ct) { f32x4 acc = {0.f, 0.f, 0.f, 0.f}; const int c0 = ct * 16 + 4 * fq;
                    if (which == 0) { acc = mm16(RM(9) + rt * 16 * 144, 144, RM(2) + ct * 16 * 144, 144, 64, acc, fr, fq);
                        const v2u rw = *(const LAS v2u*)(RM(1) + row * 144 + c0 * 2);
                        acc[0] += __uint_as_float(rw.x << 16); acc[1] += __uint_as_float(rw.x & 0xffff0000u); acc[2] += __uint_as_float(rw.y << 16); acc[3] += __uint_as_float(rw.y & 0xffff0000u);
                        DBG_STAT(19, acc[0]); DBG_STAT(19, acc[1]); DBG_STAT(19, acc[2]); DBG_STAT(19, acc[3]);
                        v2u o; o.x = cvt_pk_bf16(acc[0], acc[1]); o.y = cvt_pk_bf16(acc[2], acc[3]); *(v2u*)(WSP(bf16, WS_RW_RH) + un * 4096 + row * 64 + c0) = o; }
                    else if (which == 1) {
#ifndef RW_NO_U0
                        acc = mm16(RM(9) + rt * 16 * 144, 144, RM(3) + ct * 16 * 144, 144, 64, acc, fr, fq);
#endif
                        acc = mm16(RM(10) + rt * 16 * 144, 144, RM(7) + ct * 16 * 144, 144, 64, acc, fr, fq);
                        DBG_STAT(20, acc[0]); DBG_STAT(20, acc[1]); DBG_STAT(20, acc[2]); DBG_STAT(20, acc[3]);
                        *(f32x4*)(WSP(float, WS_RW_O0) + un * 4096 + row * 64 + c0) = acc; }
                    else if (which == 2) { acc = mm16(RM(5) + rt * 16 * 144, 144, RM(2) + ct * 16 * 144, 144, 64, acc, fr, fq);
                        const float gd = GAMC[row]; if (row == c0) acc[0] += gd; if (row == c0 + 1) acc[1] += gd; if (row == c0 + 2) acc[2] += gd; if (row == c0 + 3) acc[3] += gd;
                        DBG_STAT(21, acc[0]); DBG_STAT(21, acc[1]); DBG_STAT(21, acc[2]); DBG_STAT(21, acc[3]);
                        v2u o; o.x = cvt_pk_bf16(acc[0], acc[1]); o.y = cvt_pk_bf16(acc[2], acc[3]);
                        *(v2u*)((unsigned char*)(WSP(bf16, WS_RW_GF) + un * 4096) + ((rt * 2 + (ct >> 1)) * 64 + ch) * 16 + (ct & 1) * 8) = o; }
                    else { acc = mm16(RM(3) + rt * 16 * 144, 144, RM(5) + ct * 16 * 144, 144, 64, acc, fr, fq); acc = mm16(RM(7) + rt * 16 * 144, 144, RM(6) + ct * 16 * 144, 144, 64, acc, fr, fq);
                        DBG_STAT(22, acc[0]); DBG_STAT(22, acc[1]); DBG_STAT(22, acc[2]); DBG_STAT(22, acc[3]);
                        *(f32x4*)(WSP(float, WS_RW_HT) + un * 4096 + row * 64 + c0) = acc; } } }
        }
        __syncthreads();
    }
#undef RM
}
__device__ __forceinline__ void rwkv_scan_wave(Frame& F, const Args& A, int wslot) {
    const int lane = F.lane, fr = lane & 15, fq = lane >> 4, bh = wslot >> 2, v0 = (wslot & 3) * 16;
    const bf16* GF = WSP(bf16, WS_RW_GF) + (size_t)bh * NCH * 4096; const float* HT = WSP(float, WS_RW_HT) + (size_t)bh * NCH * 4096 + (size_t)(v0 + fr) * 64 + 4 * fq;
    bf16* PT = WSP(bf16, WS_RW_PT) + (size_t)bh * NCH * 4096 + (size_t)(v0 + fr) * 64 + 4 * fq;
    f32x4 P[4] = {{0.f, 0.f, 0.f, 0.f}, {0.f, 0.f, 0.f, 0.f}, {0.f, 0.f, 0.f, 0.f}, {0.f, 0.f, 0.f, 0.f}};
    bf16x8 ga[4][2]; f32x4 hv[4];
#define RW2_LOAD(cc) do { _Pragma("unroll") for (int m = 0; m < 4; ++m) { hv[m] = *(const f32x4*)(HT + (size_t)(cc) * 4096 + 16 * m); \
        _Pragma("unroll") for (int s = 0; s < 2; ++s) ga[m][s] = *(const bf16x8*)(GF + (size_t)(cc) * 4096 + ((m * 2 + s) * 64 + lane) * 8); } } while (0)
    RW2_LOAD(0);
#pragma unroll 1
    for (int c = 0; c < NCH; ++c) {
        bf16x8 gc[4][2]; f32x4 acc[4];
#pragma unroll
        for (int m = 0; m < 4; ++m) { acc[m] = hv[m]; gc[m][0] = ga[m][0]; gc[m][1] = ga[m][1]; }
        if (c + 1 < NCH) RW2_LOAD(c + 1);
        v4u bs[2];
#pragma unroll
        for (int s = 0; s < 2; ++s) { bs[s].x = cvt_pk_bf16(P[2 * s][0], P[2 * s][1]); bs[s].y = cvt_pk_bf16(P[2 * s][2], P[2 * s][3]); bs[s].z = cvt_pk_bf16(P[2 * s + 1][0], P[2 * s + 1][1]); bs[s].w = cvt_pk_bf16(P[2 * s + 1][2], P[2 * s + 1][3]); }
        *(v2u*)(PT + (size_t)c * 4096) = (v2u){bs[0].x, bs[0].y}; *(v2u*)(PT + (size_t)c * 4096 + 16) = (v2u){bs[0].z, bs[0].w};
        *(v2u*)(PT + (size_t)c * 4096 + 32) = (v2u){bs[1].x, bs[1].y}; *(v2u*)(PT + (size_t)c * 4096 + 48) = (v2u){bs[1].z, bs[1].w};
#pragma unroll
        for (int m = 0; m < 4; ++m) { acc[m] = __builtin_amdgcn_mfma_f32_16x16x32_bf16(gc[m][0], __builtin_bit_cast(bf16x8, bs[0]), acc[m], 0, 0, 0);
            acc[m] = __builtin_amdgcn_mfma_f32_16x16x32_bf16(gc[m][1], __builtin_bit_cast(bf16x8, bs[1]), acc[m], 0, 0, 0); P[m] = acc[m]; DBG_STAT(23, acc[m][0]); DBG_STAT(23, acc[m][1]); DBG_STAT(23, acc[m][2]); DBG_STAT(23, acc[m][3]); }
    }
#undef RW2_LOAD
}
__device__ __forceinline__ void rwkv_stage3(Frame& F, const Args& A, int layer, int ub) {
    const int t0 = ub * 64, b_ = ub >> 6, c = ub & 63, lane = F.lane, wave = F.wave, fr = lane & 15, fq = lane >> 4, hh = wave >> 1;
    const size_t un = (size_t)(b_ * 4 + hh) * NCH + c;
    const bf16* RH = WSP(bf16, WS_RW_RH) + un * 4096; const bf16* PT = WSP(bf16, WS_RW_PT) + un * 4096; const float* O0 = WSP(float, WS_RW_O0) + un * 4096;
    const float* RW = WSP(float, WS_RW); const float* RG = WSP(float, WS_RW_G); bf16* mix = WSP(bf16, WS_MIX);
    const float* lg = KIN(I_RLNG) + layer * 256 + hh * 64; const float* lb = KIN(I_RLNB) + layer * 256 + hh * 64; const float* rk = KIN(I_RRK) + layer * 256 + hh * 64;
    bf16x8 pfr[4][2];
#pragma unroll
    for (int vt = 0; vt < 4; ++vt)
#pragma unroll
        for (int ks = 0; ks < 2; ++ks) pfr[vt][ks] = *(const bf16x8*)(PT + (size_t)(vt * 16 + fr) * 64 + ks * 32 + fq * 8);
#pragma unroll 1
    for (int i = 0; i < 2; ++i) { const int tt = 2 * (wave & 1) + i, tl = tt * 16 + fr, t = t0 + tl;
        const bf16x8 ra0 = *(const bf16x8*)(RH + (size_t)tl * 64 + fq * 8), ra1 = *(const bf16x8*)(RH + (size_t)tl * 64 + 32 + fq * 8);
        f32x4 ov[4]; float sm = 0.f;
#pragma unroll
        for (int vt = 0; vt < 4; ++vt) { f32x4 acc = *(const f32x4*)(O0 + tl * 64 + vt * 16 + 4 * fq);
            acc = __builtin_amdgcn_mfma_f32_16x16x32_bf16(pfr[vt][0], ra0, acc, 0, 0, 0); acc = __builtin_amdgcn_mfma_f32_16x16x32_bf16(pfr[vt][1], ra1, acc, 0, 0, 0);
            ov[vt] = acc; DBG_STAT(24, acc[0]); DBG_STAT(24, acc[1]); DBG_STAT(24, acc[2]); DBG_STAT(24, acc[3]); sm += (acc.x + acc.y) + (acc.z + acc.w); }
        sm += __shfl_xor(sm, 16); sm += __shfl_xor(sm, 32);
        const float mean = sm * (1.f / 64.f); float sq = 0.f;
#pragma unroll
        for (int vt = 0; vt < 4; ++vt) { ov[vt] = ov[vt] - mean; sq += (ov[vt].x * ov[vt].x + ov[vt].y * ov[vt].y) + (ov[vt].z * ov[vt].z + ov[vt].w * ov[vt].w); }
        sq += __shfl_xor(sq, 16); sq += __shfl_xor(sq, 32);
        const float rs = 1.0f / sqrtf(sq * (1.f / 64.f) + RWKV_GN_EPS);
        float bd = 0.f;
#pragma unroll
        for (int q = 0; q < 4; ++q) { const f32x4 r4 = *(const f32x4*)(RW + (size_t)t * 768 + hh * 64 + fq * 16 + 4 * q), k4 = *(const f32x4*)(RW + (size_t)t * 768 + 256 + hh * 64 + fq * 16 + 4 * q), c4 = *(const f32x4*)(rk + fq * 16 + 4 * q);
            bd += (r4.x * k4.x * c4.x + r4.y * k4.y * c4.y) + (r4.z * k4.z * c4.z + r4.w * k4.w * c4.w); }
        bd += __shfl_xor(bd, 16); bd += __shfl_xor(bd, 32);
#pragma unroll
        for (int vt = 0; vt < 4; ++vt) { const int col = vt * 16 + 4 * fq; const f32x4 g4 = *(const f32x4*)(lg + col), b4 = *(const f32x4*)(lb + col);
            const f32x4 v4 = *(const f32x4*)(RW + (size_t)t * 768 + 512 + hh * 64 + col), gg = *(const f32x4*)(RG + (size_t)t * 256 + hh * 64 + col);
            float e0 = (ov[vt].x * rs * g4.x + b4.x + bd * v4.x) * gg.x, e1 = (ov[vt].y * rs * g4.y + b4.y + bd * v4.y) * gg.y, e2 = (ov[vt].z * rs * g4.z + b4.z + bd * v4.z) * gg.z, e3 = (ov[vt].w * rs * g4.w + b4.w + bd * v4.w) * gg.w;
#ifdef RW_SANITIZE
            e0 = (fabsf(e0) < 1e30f) ? e0 : 0.f; e1 = (fabsf(e1) < 1e30f) ? e1 : 0.f; e2 = (fabsf(e2) < 1e30f) ? e2 : 0.f; e3 = (fabsf(e3) < 1e30f) ? e3 : 0.f;
#endif
            v2u o; o.x = cvt_pk_bf16(e0, e1); o.y = cvt_pk_bf16(e2, e3);
            *(v2u*)(mix + (size_t)t * D + 256 + hh * 64 + col) = o; } }
}

__device__ __forceinline__ void scans_elementwise(Frame& F, const Args& A) {
    const int nthr = F.G * 448, gt = F.vcu * 448 + (F.tid - 64);
    constexpr int N_SSD = 16 * 64 * 128, N_GLA = 16 * 32 * 64, N_MLC = 16 * 64 * 64, N_MLN = 16 * 64;
    for (int i = gt; i < N_SSD + N_GLA + N_MLC + N_MLN; i += nthr) {
        if (i < N_SSD) { const int bh = i >> 13, pn = i & 8191; float* base = WSP(float, WS_SSD_ST) + (size_t)bh * NCH * 8192 + pn; const float* dec = WSP(float, WS_SSD_DEC) + bh * NCH; float S = 0.f;
#pragma unroll 1
            for (int c0 = 0; c0 < NCH; c0 += 32) { float x[32], dd[32];
#pragma unroll
                for (int j = 0; j < 32; ++j) { x[j] = base[(size_t)(c0 + j) * 8192]; dd[j] = dec[c0 + j]; }
#pragma unroll
                for (int j = 0; j < 32; ++j) { base[(size_t)(c0 + j) * 8192] = S; S = dd[j] * S + x[j]; } }
        } else if (i < N_SSD + N_GLA) { const int k = i - N_SSD, bh = k >> 11, dv = k & 2047, dd_ = dv >> 6, b = bh >> 2, hh = bh & 3; float* base = WSP(float, WS_GLA_ST) + (size_t)bh * NCH * 2048 + dv; const float* dec = WSP(float, WS_GLA_DEC) + (size_t)b * NCH * 128 + hh * 32 + dd_; float S = 0.f;
#pragma unroll 1
            for (int c0 = 0; c0 < NCH; c0 += 32) { float x[32], dd[32];
#pragma unroll
                for (int j = 0; j < 32; ++j) { x[j] = base[(size_t)(c0 + j) * 2048]; dd[j] = dec[(c0 + j) * 128]; }
#pragma unroll
                for (int j = 0; j < 32; ++j) { base[(size_t)(c0 + j) * 2048] = S; S = dd[j] * S + x[j]; } }
        } else { const int k = i - N_SSD - N_GLA; const bool isn = k >= N_MLC; const int kk = isn ? k - N_MLC : k; const int bh = isn ? (kk >> 6) : (kk >> 12), e = isn ? (kk & 63) : (kk & 4095), str = isn ? 64 : 4096;
            float* base = (isn ? WSP(float, WS_ML_N) : WSP(float, WS_ML_C)) + (size_t)bh * NCH * str + e; const float* bl = WSP(float, WS_ML_BL) + bh * NCH; const float* ml = WSP(float, WS_ML_ML) + bh * NCH; float* mo = WSP(float, WS_ML_M) + bh * NCH;
            float S = 0.f, m = 0.f;
#pragma unroll 1
            for (int c0 = 0; c0 < NCH; c0 += 32) { float x[32], b8[32], m8[32];
#pragma unroll
                for (int j = 0; j < 32; ++j) { x[j] = base[(size_t)(c0 + j) * str]; b8[j] = bl[c0 + j]; m8[j] = ml[c0 + j]; }
#pragma unroll
                for (int j = 0; j < 32; ++j) { const float mn = fmaxf(b8[j] + m, m8[j]); const float so = __expf(b8[j] + m - mn), sn = __expf(m8[j] - mn);
                    base[(size_t)(c0 + j) * str] = S; if (!isn && e == 0) mo[c0 + j] = m; S = so * S + sn * x[j]; m = mn; } }
        }
    }
}
#ifndef MK_PER_PHASE_LAUNCH
#define MK_PER_PHASE_LAUNCH 0
#endif
#ifndef PH_MASK
#define PH_MASK 0xFFF
#endif
#ifndef ST_MASK
#define ST_MASK 0xF
#endif
#define ST_ON(k) (((ST_MASK) >> (k)) & 1)
#ifndef DUP_MASK
#define DUP_MASK 0
#endif
#define DUP_N(k) ((((DUP_MASK) >> (k)) & 1) ? 2 : 1)
#ifndef ST_DUP
#define ST_DUP 0
#endif
#define ST_REP(ty) ((((ST_DUP) >> (ty)) & 1) ? 2 : 1)
#define PH_ON(k) (((PH_MASK) >> (k)) & 1)
constexpr int PH_PER_LAYER = 11, N_PHASES = 1 + DEPTH * PH_PER_LAYER;
__global__ void __launch_bounds__(NWAVES * 64, 2) fwd_kernel(Args args) {
    extern __shared__ __attribute__((aligned(16))) unsigned char lds[];
    Frame F;
    F.lds = (LAS unsigned char*)lds;
    F.MISC = (volatile LAS unsigned*)(F.lds + MISC_OFF);
    F.tid = threadIdx.x; F.lane = F.tid & 63; F.wave = __builtin_amdgcn_readfirstlane(F.tid >> 6);
    F.G = gridDim.x; { const int bx = blockIdx.x; F.vcu = (F.G % 8 == 0) ? (bx % 8) * (F.G / 8) + bx / 8 : bx; }
    F.ka = (karg_t)__builtin_amdgcn_kernarg_segment_ptr(); F.ws = args.ws; F.ctl = (gu32*)(args.ws + WS_CTL); F.out = args.out;
    for (int i = F.tid; i < 256; i += NWAVES * 64) F.MISC[i] = 0u;
    __syncthreads();
    const int lo = args.ph_lo, hi = args.ph_hi;
#ifdef DBG_TSEL
    if (blockIdx.x == 0 && threadIdx.x == 0) __hip_atomic_store(F.ctl + CW_DBG + 15, (unsigned)__builtin_amdgcn_s_memrealtime(), RLX_AGENT);
#endif
    XcdBarrier bar; bar.bar = (unsigned*)(F.ctl + CW_BAR); bar.x = 0; bar.st = nullptr;
    if (hi - lo > 1) bar = xcd_barrier_post((unsigned*)(F.ctl + CW_BAR), F.MISC + MW_BAR);
#define IN_(k) (lo <= (k) && (k) < hi)
#ifdef DBG_TSEL
#ifndef DBG_TQ
#define DBG_TQ 50.0f
#endif
#define TSTAMP(k) do { if (blockIdx.x == 0 && threadIdx.x == 0) __hip_atomic_store(F.ctl + CW_DBG + 16 + ((k) == 11 ? 0 : 1 + layer_ * PH_PER_LAYER + (k)), (unsigned)__builtin_amdgcn_s_memrealtime(), RLX_AGENT); } while (0)
#else
#define TSTAMP(k) do { } while (0)
#endif
#ifdef BAR_DUP
#define SEAM(k) do { if (IN_(k) && IN_((k) + 1)) { xcd_barrier(bar); xcd_barrier(bar); } } while (0)
#else
#define SEAM(k) do { if (IN_(k) && IN_((k) + 1)) xcd_barrier(bar); } while (0)
#endif

    if (PH_ON(11) && IN_(0)) { for (int rep_ = 0; rep_ < DUP_N(11); ++rep_) { frame_refresh(F); p0_prologue(F, args); } SEAM(0); { const int layer_ = 0; TSTAMP(11); (void)layer_; } }
#pragma unroll 1
    for (int layer = 0; layer < DEPTH; ++layer) {
        const int pb = 1 + layer * PH_PER_LAYER; const int layer_ = layer; (void)layer_;
        if (PH_ON(0) && IN_(pb + 0)) { for (int rep_ = 0; rep_ < DUP_N(0); ++rep_) { frame_refresh(F);
            { pg8::DenseSched S; S.init(WSP(bf16, WS_XB), WSP(bf16, WS_WIN_T) + (size_t)layer * NUP * D, T, NUP, D, F.G, (int)blockIdx.x);
              pg8::EpiB16 E{WSP(bf16, WS_U), NUP, nullptr, 0.f};
              pg8::gemm_phase<pg8::EpiB16, pg8::DenseSched>(F.lds, F.tid, S, E); }
            { pg8::DenseSched S; S.init(WSP(bf16, WS_PB) + (size_t)layer * T * 256, WSP(bf16, WS_WPP_T) + (size_t)layer * D * 256, T, D, 256, F.G, (int)blockIdx.x);
              pg8::EpiB16 E{WSP(bf16, WS_PE), D, nullptr, 0.f};
              pg8::gemm_phase<pg8::EpiB16, pg8::DenseSched>(F.lds, F.tid, S, E); }
            } SEAM(pb + 0); TSTAMP(0);
        }
        if (PH_ON(1) && IN_(pb + 1)) { for (int rep_ = 0; rep_ < DUP_N(1); ++rep_) { frame_refresh(F);
            for (int un = F.vcu; un < 1024; un += F.G) { frame_refresh(F); const int ty = un >> 8, r = un & 255, b = r >> 6, c = r & 63;
                if (ty == 0) { ssd_stage1(F, args, layer, b, c); if (ST_DUP & 1) ssd_stage1(F, args, layer, b, c); } else if (ty == 1) { gla_stage1(F, args, layer, b, c); if (ST_DUP & 2) gla_stage1(F, args, layer, b, c); } else if (ty == 2) { mlstm_stage1(F, args, layer, b, c); if (ST_DUP & 4) mlstm_stage1(F, args, layer, b, c); } else { rwkv_stage1(F, args, layer, r); if (ST_DUP & 8) rwkv_stage1(F, args, layer, r); } }
            } SEAM(pb + 1); TSTAMP(1);
        }
        if (PH_ON(2) && IN_(pb + 2)) { for (int rep_ = 0; rep_ < DUP_N(2); ++rep_) { frame_refresh(F);
            if (F.wave == 0) { for (int ws_ = F.vcu; ws_ < 64; ws_ += F.G) rwkv_scan_wave(F, args, ws_); }
            else if (rep_ == 0) scans_elementwise(F, args);
            } SEAM(pb + 2); TSTAMP(2);
        }
        if (PH_ON(3) && IN_(pb + 3)) { for (int rep_ = 0; rep_ < DUP_N(3); ++rep_) { frame_refresh(F);
            for (int un = F.vcu; un < 1024; un += F.G) { frame_refresh(F); const int ty = un >> 8, r = un & 255, b = r >> 6, c = r & 63;
                if (ty == 0) { ssd_stage3(F, args, layer, b, c); if (ST_DUP & 16) ssd_stage3(F, args, layer, b, c); } else if (ty == 1) { gla_stage3(F, args, layer, b, c); if (ST_DUP & 32) gla_stage3(F, args, layer, b, c); } else if (ty == 2) { mlstm_stage3(F, args, layer, b, c); if (ST_DUP & 64) mlstm_stage3(F, args, layer, b, c); } else { rwkv_stage3(F, args, layer, r); if (ST_DUP & 128) rwkv_stage3(F, args, layer, r); } }
            } SEAM(pb + 3); TSTAMP(3);
        }
        if (PH_ON(4) && IN_(pb + 4)) { for (int rep_ = 0; rep_ < DUP_N(4); ++rep_) { frame_refresh(F);
            pg8::DenseSched S; S.init(WSP(bf16, WS_MIX), WSP(bf16, WS_WOUT_T) + (size_t)layer * D * D, T, D, D, F.G, (int)blockIdx.x);
            pg8::EpiB16 E{WSP(bf16, WS_Y1), D, WSP(bf16, WS_XB), DN_ALPHA};
            pg8::gemm_phase<pg8::EpiB16, pg8::DenseSched>(F.lds, F.tid, S, E);
            } SEAM(pb + 4); TSTAMP(4);
        }
        if (PH_ON(5) && IN_(pb + 5)) { if (DUP_N(5) == 2) { frame_refresh(F); p6_ln1_router<true>(F, args, layer); } frame_refresh(F); p6_ln1_router<false>(F, args, layer); SEAM(pb + 5); TSTAMP(5); }
        if (PH_ON(6) && IN_(pb + 6)) { for (int rep_ = 0; rep_ < DUP_N(6); ++rep_) { frame_refresh(F);
            moe_build_pfx(F, args, layer, 8);
            pg8::Moe1Sched S; S.O.pfx = F.MISC + MW_PFX; S.O.NT = 8; S.O.G = F.G; S.O.c = (int)blockIdx.x; S.X = WSP(bf16, WS_X1B); S.W = WSP(bf16, WS_WGU_T) + (size_t)layer * NE * 2048 * D; S.sdest = WSP(int, WS_SDEST); S.K = D; S.hstepB = (size_t)1024 * D * 2;
            pg8::EpiMoe1 E{WSP(bf16, WS_ABUF), KIN(I_BGU) + (size_t)layer * NE * 2048};
            pg8::gemm_phase<pg8::EpiMoe1, pg8::Moe1Sched>(F.lds, F.tid, S, E);
            } SEAM(pb + 6); TSTAMP(6);
        }
        if (PH_ON(7) && IN_(pb + 7)) { for (int rep_ = 0; rep_ < DUP_N(7); ++rep_) { frame_refresh(F);
            moe_build_pfx(F, args, layer, 4);
            pg8::Moe2Sched S; S.O.pfx = F.MISC + MW_PFX; S.O.NT = 4; S.O.G = F.G; S.O.c = (int)blockIdx.x; S.Ab = WSP(bf16, WS_ABUF); S.W = WSP(bf16, WS_WDN_T) + (size_t)layer * NE * D * D; S.K = D; S.hstepB = (size_t)128 * D * 2;
            pg8::EpiMoe2 E{WSP(bf16, WS_YBUF), KIN(I_BDN) + (size_t)layer * NE * D, WSP(int, WS_SDEST), WSP(float, WS_SGATE)};
            pg8::gemm_phase<pg8::EpiMoe2, pg8::Moe2Sched>(F.lds, F.tid, S, E);
            } SEAM(pb + 7); TSTAMP(7);
        }
        if (PH_ON(8) && IN_(pb + 8)) { for (int rep_ = 0; rep_ < DUP_N(8); ++rep_) { frame_refresh(F); p9_combine(F, args); } SEAM(pb + 8); TSTAMP(8); }
        if (PH_ON(9) && IN_(pb + 9)) { for (int rep_ = 0; rep_ < DUP_N(9); ++rep_) { frame_refresh(F);
            pg8::DenseSched S; S.init(WSP(bf16, WS_HB), WSP(bf16, WS_WPG_T) + (size_t)layer * D * D, T, D, D, F.G, (int)blockIdx.x);
            pg8::EpiPle E{WSP(bf16, WS_H2), WSP(bf16, WS_HB), WSP(bf16, WS_PE)};
            pg8::gemm_phase<pg8::EpiPle, pg8::DenseSched>(F.lds, F.tid, S, E);
            } SEAM(pb + 9); TSTAMP(9);
        }
        if (PH_ON(10) && IN_(pb + 10)) { for (int rep_ = 0; rep_ < DUP_N(10); ++rep_) { frame_refresh(F); p11_ln2(F, args, layer); } SEAM(pb + 10); TSTAMP(10); }
    }
#ifdef DBG_TSEL
    if (hi - lo > 1) { xcd_barrier(bar);
        unsigned ticks = 0u;
        if (DBG_TSEL == 11) ticks = __hip_atomic_load(F.ctl + CW_DBG + 16, RLX_AGENT) - __hip_atomic_load(F.ctl + CW_DBG + 15, RLX_AGENT);
        else for (int l = 0; l < DEPTH; ++l) { const int pi = 1 + l * PH_PER_LAYER + DBG_TSEL; ticks += __hip_atomic_load(F.ctl + CW_DBG + 16 + pi, RLX_AGENT) - __hip_atomic_load(F.ctl + CW_DBG + 16 + pi - 1, RLX_AGENT); }
        const float us = floorf((float)ticks * 0.01f / DBG_TQ) * DBG_TQ; const float code = sqrtf(us * 0.05f);
        for (size_t i = (size_t)blockIdx.x * 512 + threadIdx.x; i < (size_t)T * D; i += (size_t)gridDim.x * 512) F.out[i] = code; }
#endif
#ifdef DBG_SEL
    if (hi - lo > 1) { xcd_barrier(bar);
        const unsigned mx = __hip_atomic_load(F.ctl + CW_DBG, RLX_AGENT), nf = __hip_atomic_load(F.ctl + CW_DBG + 1, RLX_AGENT);
        float code;
        { const float m = __uint_as_float(mx); int b = (m > 0.f) ? (int)floorf(log10f(m)) + 30 : 0; b = b < 0 ? 0 : (b > 60 ? 60 : b); if (nf) b += 100; code = sqrtf(10.0f * (float)(b + 1)); }
        for (size_t i = (size_t)blockIdx.x * 512 + threadIdx.x; i < (size_t)T * D; i += (size_t)gridDim.x * 512) F.out[i] = code; }
#endif
#undef IN_
#undef SEAM
}

extern "C" void kernel_launch(void* const* d_in, const int* in_sizes, int n_in, void* d_out, int out_size, void* d_ws, size_t ws_size, hipStream_t stream) {
    static int grid = 0;
    if (grid == 0) {
        if (n_in != N_IN || out_size != T * D || ws_size < WS_END) { fprintf(stderr, "kernel_launch: unexpected shapes (n_in %d, out %d, ws %zu < %zu); nothing launched\n", n_in, out_size, ws_size, (size_t)WS_END); grid = -1; return; }
        int dev = 0, cus = 0, per_cu = 0;
        if (hipGetDevice(&dev) != hipSuccess || hipDeviceGetAttribute(&cus, hipDeviceAttributeMultiprocessorCount, dev) != hipSuccess) { grid = -1; return; }
        if (hipFuncSetAttribute((const void*)fwd_kernel, hipFuncAttributeMaxDynamicSharedMemorySize, LDS_BYTES) != hipSuccess) { fprintf(stderr, "kernel_launch: hipFuncSetAttribute failed\n"); grid = -1; return; }
        if (hipOccupancyMaxActiveBlocksPerMultiprocessor(&per_cu, (const void*)fwd_kernel, NWAVES * 64, LDS_BYTES) != hipSuccess || per_cu < 1) { fprintf(stderr, "kernel_launch: occupancy query says %d blocks per CU\n", per_cu); }
        (void)hipGetLastError();
        grid = cus;
    }
    if (grid < 0) return;
    (void)hipMemsetAsync((char*)d_ws + WS_CTL, 0, CTL_ZERO_BYTES, stream);
    Args a{};
    for (int i = 0; i < N_IN; ++i) a.in[i] = (const float*)d_in[i];
    a.out = (float*)d_out; a.ws = (unsigned char*)d_ws;
#if MK_PER_PHASE_LAUNCH
    for (int ph = 0; ph < N_PHASES; ++ph) { a.ph_lo = ph; a.ph_hi = ph + 1; hipLaunchKernelGGL(fwd_kernel, dim3(grid), dim3(NWAVES * 64), LDS_BYTES, stream, a); }
#else
    a.ph_lo = 0; a.ph_hi = N_PHASES; hipLaunchKernelGGL(fwd_kernel, dim3(grid), dim3(NWAVES * 64), LDS_BYTES, stream, a);
#endif
    const hipError_t le = hipPeekAtLastError();
    if (le != hipSuccess) fprintf(stderr, "kernel_launch: launch failed: %s\n", hipGetErrorName(le));
}
```

```cpp
#include <hip/hip_runtime.h>
#include <cstdio>
#include <cstdint>

#define GAS __attribute__((address_space(1)))
#define LAS __attribute__((address_space(3)))
typedef unsigned short bf16;
typedef unsigned v4u __attribute__((ext_vector_type(4)));
typedef unsigned v2u __attribute__((ext_vector_type(2)));
typedef float f32x4 __attribute__((ext_vector_type(4)));
typedef float f32x2 __attribute__((ext_vector_type(2)));
typedef short bf16x8 __attribute__((ext_vector_type(8)));
typedef int v4i_t __attribute__((ext_vector_type(4)));
typedef int v8i_t __attribute__((ext_vector_type(8)));
typedef GAS unsigned gu32;
#define RLX_AGENT __ATOMIC_RELAXED, __HIP_MEMORY_SCOPE_AGENT
#define LDS_WAIT() asm volatile("s_waitcnt lgkmcnt(0)" ::: "memory")
#define VM_WAIT() asm volatile("s_waitcnt vmcnt(0)" ::: "memory")

constexpr int NWAVES = 8;
constexpr int DEPTH = 4, BATCH = 4, SEQ = 4096, D = 1024, T = BATCH * SEQ;
constexpr int NU = 3484, NUP = 3584;
constexpr int NE = 32, TOPK = 4, ECAP = 16384;
constexpr int NCH = SEQ / 64;
constexpr int U_SSD_Z = 0, U_SSD_X = 256, U_SSD_B = 512, U_SSD_C = 640, U_SSD_DT = 768;
constexpr int U_RW = 772, U_RW_R = 772, U_RW_K = 1028, U_RW_V = 1284, U_RW_LO = 1540;
constexpr int U_GL_Q = 1668, U_GL_K = 1796, U_GL_V = 1924, U_GL_G = 2180, U_GL_OG = 2196;
constexpr int U_ML_Q = 2452, U_ML_K = 2708, U_ML_V = 2964, U_ML_I = 3220, U_ML_F = 3224, U_ML_O = 3228;
constexpr float DN_ALPHA = 1.6817928305074290f;
constexpr float LN_EPS = 1e-5f, NORM_EPS = 1e-5f, RWKV_GN_EPS = 64e-5f;

enum { I_X = 0, I_P, I_WIN, I_WOUT, I_LN1G, I_LN1B, I_SCW, I_SCB, I_SALOG, I_SDTB, I_SD, I_SNG,
       I_RMU, I_RW0, I_RWUP, I_RA0, I_RAUP, I_RGUP, I_RKK, I_RKA, I_RRK, I_RLNG, I_RLNB,
       I_GGUP, I_GGB, I_GNG, I_MCW, I_MCB, I_MIB, I_MFB, I_MNG,
       I_RTW, I_RTB, I_WGU, I_BGU, I_WDN, I_BDN, I_PGW, I_PPJ, I_LN2G, I_LN2B, N_IN };

constexpr size_t MiB = 1u << 20;
constexpr size_t WS_CTL = 0, CTL_ZERO_BYTES = 1 * MiB;
constexpr size_t WS_WIN_T = 2 * MiB;
constexpr size_t WS_WOUT_T = WS_WIN_T + (size_t)DEPTH * NUP * D * 2;
constexpr size_t WS_WGU_T = WS_WOUT_T + (size_t)DEPTH * D * D * 2;
constexpr size_t WS_WDN_T = WS_WGU_T + (size_t)DEPTH * NE * 2048 * D * 2;
constexpr size_t WS_WPG_T = WS_WDN_T + (size_t)DEPTH * NE * D * D * 2;
constexpr size_t WS_WPP_T = WS_WPG_T + (size_t)DEPTH * D * D * 2;
constexpr size_t WS_RWT = WS_WPP_T + (size_t)DEPTH * D * 256 * 2;
constexpr size_t WS_PB = WS_RWT + (size_t)DEPTH * NE * D * 4;
constexpr size_t WS_XB = WS_PB + (size_t)DEPTH * T * 256 * 2;
constexpr size_t WS_U = WS_XB + (size_t)T * D * 2;
constexpr size_t WS_PE = WS_U + (size_t)T * NUP * 2;
constexpr size_t WS_MIX = WS_PE + (size_t)T * D * 4;
constexpr size_t WS_Y1 = WS_MIX + (size_t)T * D * 2;
constexpr size_t WS_X1 = WS_Y1 + (size_t)T * D * 4;
constexpr size_t WS_X1B = WS_X1 + (size_t)T * D * 4;
constexpr size_t WS_SDEST = WS_X1B + (size_t)T * D * 2;
constexpr size_t WS_SGATE = WS_SDEST + (size_t)NE * ECAP * 4;
constexpr size_t WS_ABUF = WS_SGATE + (size_t)NE * ECAP * 4;
constexpr size_t WS_YBUF = WS_ABUF + (size_t)NE * ECAP * D * 2;
constexpr size_t WS_H = WS_YBUF + (size_t)T * 4 * D * 2;
constexpr size_t WS_HB = WS_H + (size_t)T * D * 4;
constexpr size_t WS_H2 = WS_HB + (size_t)T * D * 2;
constexpr size_t WS_SSD_ST = WS_H2 + (size_t)T * D * 4;
constexpr size_t WS_SSD_DEC = WS_SSD_ST + (size_t)16 * NCH * 64 * 128 * 4;
constexpr size_t WS_GLA_ST = WS_SSD_DEC + 16 * NCH * 4;
constexpr size_t WS_GLA_DEC = WS_GLA_ST + (size_t)16 * NCH * 32 * 64 * 4;
constexpr size_t WS_ML_C = WS_GLA_DEC + (size_t)4 * NCH * 128 * 4;
constexpr size_t WS_ML_N = WS_ML_C + (size_t)16 * NCH * 64 * 64 * 4;
constexpr size_t WS_ML_BL = WS_ML_N + (size_t)16 * NCH * 64 * 4;
constexpr size_t WS_ML_ML = WS_ML_BL + 16 * NCH * 4;
constexpr size_t WS_ML_M = WS_ML_ML + 16 * NCH * 4;
constexpr size_t WS_RW = WS_ML_M + 16 * NCH * 4;
constexpr size_t WS_RW_G = WS_RW + (size_t)T * 3 * 256 * 4;
constexpr size_t WS_RW_RH = WS_RW_G + (size_t)T * 256 * 4;
constexpr size_t WS_RW_O0 = WS_RW_RH + (size_t)1024 * 4096 * 2;
constexpr size_t WS_RW_GF = WS_RW_O0 + (size_t)1024 * 4096 * 4;
constexpr size_t WS_RW_HT = WS_RW_GF + (size_t)1024 * 4096 * 2;
constexpr size_t WS_RW_PT = WS_RW_HT + (size_t)1024 * 4096 * 4;
constexpr size_t WS_LORA = WS_RW_PT + (size_t)1024 * 4096 * 2;
constexpr int LORA_PER_LAYER = 8192 + 8192 + 16384 + 2048;
constexpr size_t WS_WGU_Q = WS_LORA + (size_t)DEPTH * LORA_PER_LAYER * 4;
constexpr size_t WS_WDN_Q = WS_WGU_Q + (size_t)DEPTH * NE * 2048 * D;
constexpr size_t WS_X1Q = WS_WDN_Q + (size_t)DEPTH * NE * D * D;
constexpr size_t WS_ABUFQ = WS_X1Q + (size_t)T * D;
constexpr size_t WS_END = WS_ABUFQ + (size_t)NE * ECAP * D;
#ifndef MOE_FP8
#define MOE_FP8 1
#endif
#ifndef MOE2_FP8
#define MOE2_FP8 0
#endif
constexpr int CW_BAR = 4096;
constexpr int CW_DBG = 32768;
constexpr int CW_CNT = 16384;

constexpr int RING_BYTES = 147456;
constexpr int MISC_OFF = RING_BYTES;
constexpr int LDS_BYTES = RING_BYTES + 1024;
constexpr int MW_BAR = 8, MW_LCNT = 32, MW_LBASE = 64, MW_PFX = 96, MW_CNT = 136, MW_GAMC = 168;

typedef __bf16 bf16x2_t __attribute__((ext_vector_type(2)));
__device__ __forceinline__ unsigned cvt_pk_bf16(float lo, float hi) { const f32x2 v = {lo, hi}; const bf16x2_t b = __builtin_convertvector(v, bf16x2_t); return __builtin_bit_cast(unsigned, b); }
__device__ __forceinline__ unsigned cvt4_fp8(float a, float b, float c, float d) { int w = 0; w = __builtin_amdgcn_cvt_pk_fp8_f32(a, b, w, false); w = __builtin_amdgcn_cvt_pk_fp8_f32(c, d, w, true); return (unsigned)w; }
__device__ __forceinline__ float bf2f(unsigned short b) { return __uint_as_float(((unsigned)b) << 16); }
__device__ __forceinline__ float sigmoidf_(float x) { return 1.0f / (1.0f + __expf(-x)); }
__device__ __forceinline__ float siluf_(float x) { return x / (1.0f + __expf(-x)); }
__device__ __forceinline__ float softplusf_(float x) { return fmaxf(x, 0.f) + log1pf(__expf(-fabsf(x))); }
__device__ __forceinline__ float logsigmoidf_(float x) { return fminf(x, 0.f) - log1pf(__expf(-fabsf(x))); }
__device__ __forceinline__ float wave_sum(float v) {
#pragma unroll
    for (int o = 1; o < 64; o <<= 1) v += __shfl_xor(v, o);
    return v;
}
__device__ __forceinline__ float wave_max(float v) {
#pragma unroll
    for (int o = 1; o < 64; o <<= 1) v = fmaxf(v, __shfl_xor(v, o));
    return v;
}
__device__ __forceinline__ float wave_scan_add(float v, int lane) {
#pragma unroll
    for (int o = 1; o < 64; o <<= 1) { const float t = __shfl_up(v, o); if (lane >= o) v += t; }
    return v;
}
__device__ __forceinline__ float wave_scan_max(float v, int lane) {
#pragma unroll
    for (int o = 1; o < 64; o <<= 1) { const float t = __shfl_up(v, o); if (lane >= o) v = fmaxf(v, t); }
    return v;
}
__device__ __forceinline__ f32x4 mm16(const LAS unsigned char* A, int lda, const LAS unsigned char* B, int ldb, int K, f32x4 acc, int fr, int fq) {
    const LAS unsigned char* ap = A + fr * lda + fq * 16; const LAS unsigned char* bp = B + fr * ldb + fq * 16;
    for (int k = 0; k < K; k += 32) {
        const bf16x8 a = *(const LAS bf16x8*)(ap + k * 2); const bf16x8 b = *(const LAS bf16x8*)(bp + k * 2);
        acc = __builtin_amdgcn_mfma_f32_16x16x32_bf16(b, a, acc, 0, 0, 0);
    }
    return acc;
}
__device__ __forceinline__ f32x4 mm16_gB(const LAS unsigned char* A, int lda, const float* B, int ldb, int K, f32x4 acc, int fr, int fq) {
    const LAS unsigned char* ap = A + fr * lda + fq * 16; const float* bp = B + (size_t)fr * ldb + fq * 8;
    for (int k = 0; k < K; k += 32) {
        const bf16x8 a = *(const LAS bf16x8*)(ap + k * 2);
        const f32x4 b0 = *(const f32x4*)(bp + k), b1 = *(const f32x4*)(bp + k + 4);
        v4u bw; bw.x = cvt_pk_bf16(b0.x, b0.y); bw.y = cvt_pk_bf16(b0.z, b0.w); bw.z = cvt_pk_bf16(b1.x, b1.y); bw.w = cvt_pk_bf16(b1.z, b1.w);
        const bf16x8 b = __builtin_bit_cast(bf16x8, bw);
        acc = __builtin_amdgcn_mfma_f32_16x16x32_bf16(b, a, acc, 0, 0, 0);
    }
    return acc;
}
__device__ __forceinline__ f32x4 mm16_gAB(const bf16* A, int lda, const bf16* B, int ldb, int K, f32x4 acc, int fr, int fq) {
    const bf16* ap = A + (size_t)fr * lda + fq * 8; const bf16* bp = B + (size_t)fr * ldb + fq * 8;
    for (int k = 0; k < K; k += 32) { const bf16x8 a = *(const bf16x8*)(ap + k), b = *(const bf16x8*)(bp + k); acc = __builtin_amdgcn_mfma_f32_16x16x32_bf16(b, a, acc, 0, 0, 0); }
    return acc;
}
__device__ __forceinline__ bf16x8 ldfrag_f32(const float* p) { const f32x4 b0 = *(const f32x4*)p, b1 = *(const f32x4*)(p + 4);
    v4u bw; bw.x = cvt_pk_bf16(b0.x, b0.y); bw.y = cvt_pk_bf16(b0.z, b0.w); bw.z = cvt_pk_bf16(b1.x, b1.y); bw.w = cvt_pk_bf16(b1.z, b1.w); return __builtin_bit_cast(bf16x8, bw); }
template <int NK> __device__ __forceinline__ f32x4 mm16_rB(const LAS unsigned char* A, int lda, const bf16x8 (&b)[NK], f32x4 acc, int fr, int fq) {
    const LAS unsigned char* ap = A + fr * lda + fq * 16;
#pragma unroll
    for (int k = 0; k < NK; ++k) { const bf16x8 a = *(const LAS bf16x8*)(ap + k * 64); acc = __builtin_amdgcn_mfma_f32_16x16x32_bf16(b[k], a, acc, 0, 0, 0); }
    return acc;
}
__device__ __forceinline__ v4u pack8(const float (&v)[8]) { v4u o; o.x = cvt_pk_bf16(v[0], v[1]); o.y = cvt_pk_bf16(v[2], v[3]); o.z = cvt_pk_bf16(v[4], v[5]); o.w = cvt_pk_bf16(v[6], v[7]); return o; }

#define XB_TMO      128
#define XB_XCNT(j)  (256  + 64 * (j))
#define XB_XSUB(j)  (1280 + 64 * (j))
#define XB_XGEN(j)  (2304 + 64 * (j))
#define XB_TOP      3328
#define XB_TOPGEN   3392
#define XCD_BAR_WORDS 3456
#define XB_SPIN_CAP (1u << 18)
__device__ __forceinline__ unsigned xb_ld(unsigned* p)              { return __hip_atomic_load(p, __ATOMIC_RELAXED, __HIP_MEMORY_SCOPE_AGENT); }
__device__ __forceinline__ unsigned xb_add(unsigned* p, unsigned v) { return __hip_atomic_fetch_add(p, v, __ATOMIC_RELAXED, __HIP_MEMORY_SCOPE_AGENT); }
__device__ __forceinline__ unsigned xb_xcc_id() { return (unsigned)__builtin_amdgcn_s_getreg((3 << 11) | 20) & 0xFu; }
#define XB_SPIN(cond, bar) do { unsigned _sp = 0; while (cond) { __builtin_amdgcn_s_sleep(1); \
    if ((++_sp & 255u) == 0u) { if (xb_ld(&(bar)[XB_TMO])) break; if (_sp > XB_SPIN_CAP) { atomicAdd(&(bar)[XB_TMO], 1u); break; } } } } while (0)
struct XcdBarrier { unsigned* bar; unsigned x; volatile LAS unsigned* st; };
__device__ __forceinline__ XcdBarrier xcd_barrier_post(unsigned* bar, volatile LAS unsigned* st) {
    XcdBarrier b; b.bar = bar; b.x = xb_xcc_id(); b.st = st;
    if (threadIdx.x == 0) (void)xb_add(&bar[XB_XCNT(b.x)], 1u);
    return b;
}
__device__ __forceinline__ void xcd_barrier_complete(unsigned* bar, unsigned x, unsigned& nloc, unsigned& nx) {
    const unsigned G = gridDim.x * gridDim.y * gridDim.z;
    unsigned sum, cnt, mine, sp = 0u;
    for (;;) {
        sum = 0u; cnt = 0u; mine = 0u;
#pragma unroll
        for (unsigned j = 0; j < 16; ++j) { const unsigned c = xb_ld(&bar[XB_XCNT(j)]); sum += c; cnt += (c > 0u) ? 1u : 0u; mine = (j == x) ? c : mine; }
        if (sum == G) break;
        __builtin_amdgcn_s_sleep(1);
        if ((++sp & 255u) == 0u) { if (xb_ld(&bar[XB_TMO])) break; if (sp > XB_SPIN_CAP) { atomicAdd(&bar[XB_TMO], 1u); break; } }
    }
    nloc = mine > 0u ? mine : 1u; nx = cnt > 0u ? cnt : 1u;
}
__device__ __forceinline__ void xcd_barrier(const XcdBarrier& b) {
    asm volatile("s_waitcnt vmcnt(0)" ::: "memory");
    __syncthreads();
    if (threadIdx.x == 0) {
        unsigned* bar = b.bar;
        __builtin_amdgcn_s_waitcnt(0);
        unsigned nloc = b.st[0], nx = b.st[1];
        if (nloc == 0u) { xcd_barrier_complete(bar, b.x, nloc, nx); b.st[0] = nloc; b.st[1] = nx; }
        const unsigned old = xb_add(&bar[XB_XSUB(b.x)], 1u);
        const unsigned gen = old / nloc;
        if (old + 1u == (gen + 1u) * nloc) {
            __builtin_amdgcn_fence(__ATOMIC_RELEASE, "agent");
            asm volatile("s_waitcnt vmcnt(0)" ::: "memory");
            const unsigned og = xb_add(&bar[XB_TOP], 1u);
            const unsigned tg = og / nx;
            if (og + 1u == (tg + 1u) * nx) xb_add(&bar[XB_TOPGEN], 1u);
            else XB_SPIN(xb_ld(&bar[XB_TOPGEN]) == tg, bar);
            __builtin_amdgcn_fence(__ATOMIC_ACQUIRE, "agent");
            xb_add(&bar[XB_XGEN(b.x)], 1u);
            asm volatile("s_waitcnt vmcnt(0)" ::: "memory");
        } else {
            XB_SPIN(xb_ld(&bar[XB_XGEN(b.x)]) == gen, bar);
            __builtin_amdgcn_fence(__ATOMIC_ACQUIRE, "agent");
            asm volatile("s_waitcnt vmcnt(0)" ::: "memory");
        }
    }
    __syncthreads();
}

namespace pg8 {
constexpr int BM = 256, BK = 64, HALF = 128, HTB = HALF * BK * 2, STAGE_BYTES = 8 * HTB, NXCD = 8, WGM = 8;
__host__ __device__ __forceinline__ int lds_byte(int r, int c) { const int st = (r >> 4) * 2 + (c >> 5), rr = r & 15, cc = c & 31, ob = rr * 64 + cc * 2; return st * 1024 + (ob ^ (((ob >> 9) & 1) << 5)); }
__host__ __device__ __forceinline__ void stage_rc(int b, int& R, int& C) { const int st = b / 1024, sb = b % 1024, swz = sb ^ (((sb >> 9) & 1) << 5); R = (st >> 1) * 16 + swz / 64; C = (st & 1) * 32 + (swz % 64) / 2; }
__host__ __device__ __forceinline__ int perm32(int rho) { const int n = rho >> 4, i = rho & 15; return 8 * (i >> 2) + 4 * n + (i & 3); }

template <class Epi, class Sched>
__device__ __forceinline__ void gemm_phase(LAS unsigned char* lds, const int tid, const Sched& S, const Epi& E) {
    const int wid = __builtin_amdgcn_readfirstlane(tid >> 6), lane = tid & 63, wr = wid >> 2, wc = wid & 3, fr = lane & 15, fq = lane >> 4;
    const int K = S.K, nt = K / BK;
    unsigned voffB[2];
#pragma unroll
    for (int i = 0; i < 2; ++i) { int R, C; stage_rc(tid * 16 + i * 8192, R, C); const int Rb = Epi::PERM ? ((R & ~31) + perm32(R & 31)) : R; voffB[i] = (unsigned)(Rb * K + C) * 2u; }
    const size_t kstep = (size_t)(BK * 2);
    const size_t hstepB = S.hstepB;
    const unsigned ldsw = (unsigned)wid * 1024u;
    constexpr bool F8 = Sched::FP8;
    const int aoff = F8 ? lds_byte(wr * 64 + fr, fq * 16) : lds_byte(wr * 64 + fr, fq * 8), boff = F8 ? lds_byte(wc * 32 + fr, fq * 16) : lds_byte(wc * 32 + fr, fq * 8);
#define PG8_SA(b, h) (((b) * 2 + (h)) * HTB)
#define PG8_SB(b, h) ((4 + (b) * 2 + (h)) * HTB)
#define PG8_STAGE_B(bufoff, gbase) do { _Pragma("unroll") for (int _i = 0; _i < 2; ++_i) \
        __builtin_amdgcn_global_load_lds((const unsigned*)((const char*)(gbase) + voffB[_i]), (LAS unsigned*)(lds + (bufoff) + ldsw + _i * 8192), 16, 0, 0); } while (0)
#define PG8_STAGE_A(bufoff, gbase, v0, v1) do { \
        __builtin_amdgcn_global_load_lds((const unsigned*)((const char*)(gbase) + (v0)), (LAS unsigned*)(lds + (bufoff) + ldsw), 16, 0, 0); \
        __builtin_amdgcn_global_load_lds((const unsigned*)((const char*)(gbase) + (v1)), (LAS unsigned*)(lds + (bufoff) + ldsw + 8192), 16, 0, 0); } while (0)
#define PG8_FOFF(k) (F8 ? (k) * 16 : (k) * 1024)
#define PG8_LDA(dst, b, h) do { _Pragma("unroll") for (int m = 0; m < 4; ++m) { if constexpr (F8) dst##8[m] = *(const LAS v8i_t*)(lds + PG8_SA(b, h) + aoff + m * 2048); \
        else { _Pragma("unroll") for (int k = 0; k < 2; ++k) dst[m][k] = *(const LAS bf16x8*)(lds + PG8_SA(b, h) + aoff + m * 2048 + k * 1024); } } } while (0)
#define PG8_LDB(dst, b, h) do { _Pragma("unroll") for (int n = 0; n < 2; ++n) { if constexpr (F8) dst##8[n] = *(const LAS v8i_t*)(lds + PG8_SB(b, h) + boff + n * 2048); \
        else { _Pragma("unroll") for (int k = 0; k < 2; ++k) dst[n][k] = *(const LAS bf16x8*)(lds + PG8_SB(b, h) + boff + n * 2048 + k * 1024); } } } while (0)
#define PG8_CAT(x) __builtin_shufflevector(__builtin_bit_cast(v4i_t, x[0]), __builtin_bit_cast(v4i_t, x[1]), 0, 1, 2, 3, 4, 5, 6, 7)
#define PG8_MMA(ai, bj, At, Bt) do { __builtin_amdgcn_s_setprio(1); _Pragma("unroll") for (int m = 0; m < 4; ++m) _Pragma("unroll") for (int n = 0; n < 2; ++n) { \
        if constexpr (F8) acc[ai][bj][m][n] = __builtin_amdgcn_mfma_scale_f32_16x16x128_f8f6f4(Bt##8[n], At##8[m], acc[ai][bj][m][n], 0, 0, 0, S.scaleB, 0, S.scaleA); \
        else { _Pragma("unroll") for (int k = 0; k < 2; ++k) acc[ai][bj][m][n] = __builtin_amdgcn_mfma_f32_16x16x32_bf16(Bt[n][k], At[m][k], acc[ai][bj][m][n], 0, 0, 0); } } __builtin_amdgcn_s_setprio(0); } while (0)
#define PG8_WAIT_V(n) asm volatile("s_waitcnt vmcnt(" #n ")" ::: "memory")
#define PG8_WAIT_L(n) asm volatile("s_waitcnt lgkmcnt(" #n ")" ::: "memory")
#define PG8_BAR __builtin_amdgcn_s_barrier()
#define PG8_SCHED __builtin_amdgcn_sched_barrier(0)
    typename Sched::Unit cur, nxt; int ui = 0;
    if (!S.next(0, cur)) return;
    f32x4 acc[2][2][4][2];
#pragma unroll
    for (int a = 0; a < 2; ++a)
#pragma unroll
        for (int b = 0; b < 2; ++b)
#pragma unroll
            for (int m = 0; m < 4; ++m)
#pragma unroll
                for (int n = 0; n < 2; ++n) acc[a][b][m][n] = (f32x4){0.f, 0.f, 0.f, 0.f};
    bf16x8 At[4][2], B0[2][2], B1[2][2]; v8i_t At8[4], B08[2], B18[2];
    constexpr bool GA = Sched::GATHER;
    const size_t hstepA = GA ? (size_t)0 : (size_t)HALF * K * 2;
    unsigned vA[2][2];
    S.a_off(cur, tid, vA);
#define PG8_STAGE_AH(bufoff, base, vv, h) PG8_STAGE_A(bufoff, ((base) + (h) * hstepA), vv[GA ? (h) : 0][0], vv[GA ? (h) : 0][1])
    const char* cA = S.a_base(cur); const char* cB = S.b_base(cur);
    PG8_STAGE_B(PG8_SB(0, 0), cB); PG8_STAGE_B(PG8_SB(0, 1), cB + hstepB); PG8_STAGE_AH(PG8_SA(0, 0), cA, vA, 0); PG8_STAGE_AH(PG8_SA(0, 1), cA, vA, 1);
    if (wr == 1) PG8_BAR;
    PG8_WAIT_V(2); PG8_BAR;
    PG8_STAGE_B(PG8_SB(1, 0), cB + kstep); PG8_STAGE_AH(PG8_SA(1, 0), cA + kstep, vA, 0); PG8_STAGE_B(PG8_SB(1, 1), cB + hstepB + kstep);
    PG8_WAIT_V(6); PG8_BAR;
    for (;;) {
        const bool has_next = S.next(ui + 1, nxt);
        const char* nA = cA; const char* nB = cB;
        if (has_next) { nA = S.a_base(nxt); nB = S.b_base(nxt); }
        for (int t = 0; t < nt; t += 2) {
            const bool last = (t == nt - 2);
            const char* a1 = cA + (size_t)(t + 1) * kstep;
            const char* a2 = last ? nA : cA + (size_t)(t + 2) * kstep; const char* b2 = last ? nB : cB + (size_t)(t + 2) * kstep;
            const char* a3 = a2 + kstep; const char* b3 = b2 + kstep;
            PG8_LDB(B0, 0, 0); PG8_LDB(B1, 0, 1); PG8_SCHED; PG8_LDA(At, 0, 0); PG8_STAGE_AH(PG8_SA(1, 1), a1, vA, 1);
            if constexpr (GA) { if (last && has_next) S.a_off(nxt, tid, vA); }
            PG8_WAIT_V(8); PG8_WAIT_L(0); PG8_BAR; PG8_MMA(0, 0, At, B0); PG8_MMA(0, 1, At, B1); PG8_BAR; PG8_SCHED;
            PG8_LDA(At, 0, 1); PG8_STAGE_B(PG8_SB(0, 0), b2); PG8_STAGE_B(PG8_SB(0, 1), b2 + hstepB); PG8_STAGE_AH(PG8_SA(0, 0), a2, vA, 0);
            PG8_WAIT_V(8); PG8_WAIT_L(0); PG8_BAR; PG8_MMA(1, 0, At, B0); PG8_MMA(1, 1, At, B1); PG8_BAR; PG8_SCHED;
            PG8_LDB(B0, 1, 0); PG8_LDB(B1, 1, 1); PG8_SCHED; PG8_LDA(At, 1, 0); PG8_STAGE_AH(PG8_SA(0, 1), a2, vA, 1);
            PG8_WAIT_V(8); PG8_WAIT_L(0); PG8_BAR; PG8_MMA(0, 0, At, B0); PG8_MMA(0, 1, At, B1); PG8_BAR; PG8_SCHED;
            PG8_LDA(At, 1, 1); PG8_STAGE_B(PG8_SB(1, 0), b3); PG8_STAGE_B(PG8_SB(1, 1), b3 + hstepB); PG8_STAGE_AH(PG8_SA(1, 0), a3, vA, 0);
            PG8_WAIT_V(8); PG8_WAIT_L(0); PG8_BAR; PG8_MMA(1, 0, At, B0); PG8_MMA(1, 1, At, B1); PG8_BAR; PG8_SCHED;
        }
        if (wr == 0) PG8_BAR;
        { int fr_ = fr, fq_ = fq; asm volatile("" : "+v"(fr_), "+v"(fq_)); E(acc, cur, wr, wc, fr_, fq_); }
        if (!has_next) break;
#pragma unroll
        for (int a = 0; a < 2; ++a)
#pragma unroll
            for (int b = 0; b < 2; ++b)
#pragma unroll
                for (int m = 0; m < 4; ++m)
#pragma unroll
                    for (int n = 0; n < 2; ++n) acc[a][b][m][n] = (f32x4){0.f, 0.f, 0.f, 0.f};
        cur = nxt; cA = nA; cB = nB; ++ui;
        if (wr == 1) PG8_BAR;
    }
    PG8_WAIT_V(0);
    PG8_BAR;
#undef PG8_SA
#undef PG8_SB
#undef PG8_STAGE_A
#undef PG8_STAGE_AH
#undef PG8_STAGE_B
#undef PG8_LDA
#undef PG8_LDB
#undef PG8_MMA
#undef PG8_CAT
#undef PG8_FOFF
#undef PG8_WAIT_V
#undef PG8_WAIT_L
#undef PG8_BAR
#undef PG8_SCHED
}
}
struct Args { const float* in[N_IN]; float* out; unsigned char* ws; int ph_lo, ph_hi; };
typedef const __attribute__((address_space(4))) unsigned long long* karg_t;
struct Frame {
    karg_t ka;
    LAS unsigned char* lds;
    volatile LAS unsigned* MISC;
    gu32* ctl;
    unsigned char* ws;
    float* out;
    int tid, lane, wave, vcu, G;
};
#define WSP(T_, off) ((T_*)(F.ws + (off)))
#define KIN(k) ((const float*)F.ka[(k)])
#ifdef DBG_SEL
#define DBG_STAT(k, val) do { const float _v = (val); if ((k) == DBG_SEL) { if (fabsf(_v) < 3e38f) atomicMax((unsigned*)(F.ctl + CW_DBG), __float_as_uint(fabsf(_v))); else atomicAdd((unsigned*)(F.ctl + CW_DBG + 1), 1u); } } while (0)
#else
#define DBG_STAT(k, val) do { } while (0)
#endif
template <class P> __device__ __forceinline__ P launder_uniform(P p) {
    unsigned lo = (unsigned)(unsigned long long)p, hi = (unsigned)((unsigned long long)p >> 32);
    asm volatile("" : "+v"(lo), "+v"(hi));
    lo = __builtin_amdgcn_readfirstlane(lo); hi = __builtin_amdgcn_readfirstlane(hi);
    return (P)(((unsigned long long)hi << 32) | lo);
}
__device__ __forceinline__ void frame_refresh(Frame& F) {
    int t = F.tid; asm volatile("" : "+v"(t)); F.tid = t; F.lane = t & 63; F.wave = __builtin_amdgcn_readfirstlane(t >> 6);
    F.ws = launder_uniform(F.ws); F.ctl = (gu32*)(F.ws + WS_CTL);
    F.out = launder_uniform(F.out);
    F.ka = launder_uniform(F.ka);
}

namespace pg8 {
struct DenseSched {
    static constexpr bool GATHER = false, FP8 = false; static constexpr int scaleA = 0, scaleB = 0;
    struct Unit { int pm, pn; };
    const bf16* A; const bf16* Bt; int K; size_t hstepB; int nM, nN, nwg, G, c;
    __device__ __forceinline__ void init(const bf16* A_, const bf16* Bt_, int M, int N, int K_, int G_, int c_) { A = A_; Bt = Bt_; K = K_; hstepB = (size_t)HALF * K_ * 2; nM = M / BM; nN = N / BM; nwg = nM * nN; G = G_; c = c_; }
    __device__ __forceinline__ bool next(int i, Unit& u) const {
        const long L = (long)i * G + c; if (L >= nwg) return false;
        int wgid = (int)L; { const int q = nwg / NXCD, r = nwg % NXCD, xcd = wgid % NXCD, off = wgid / NXCD; wgid = (xcd < r ? xcd * (q + 1) : r * (q + 1) + (xcd - r) * q) + off; }
        const int nig = WGM * nN, gid = wgid / nig, fm = gid * WGM, gsz = (nM - fm) < WGM ? (nM - fm) : WGM;
        u.pm = fm + ((wgid % nig) % gsz); u.pn = (wgid % nig) / gsz; return true;
    }
    __device__ __forceinline__ const char* a_base(const Unit& u) const { return (const char*)A + (size_t)u.pm * BM * K * 2; }
    __device__ __forceinline__ const char* b_base(const Unit& u) const { return (const char*)Bt + (size_t)u.pn * BM * K * 2; }
    __device__ __forceinline__ void a_off(const Unit&, int tid, unsigned (&v)[2][2]) const {
#pragma unroll
        for (int i = 0; i < 2; ++i) { int R, C; stage_rc(tid * 16 + i * 8192, R, C); v[0][i] = (unsigned)(R * K + C) * 2u; v[1][i] = v[0][i]; }
    }
};
struct MoeUnit { int e, mt, nt, cnt; };
struct MoeOrder {
    const volatile LAS unsigned* pfx;
    int NT, G, c;
    __device__ __forceinline__ bool decode(int i, MoeUnit& u) const {
        const int nwg = (int)pfx[32]; const long L = (long)i * G + c; if (L >= nwg) return false;
        int wgid = (int)L; { const int q = nwg / NXCD, r = nwg % NXCD, xcd = wgid % NXCD, off = wgid / NXCD; wgid = (xcd < r ? xcd * (q + 1) : r * (q + 1) + (xcd - r) * q) + off; }
        int e = 0;
#pragma unroll 1
        for (int j = 1; j < 32; ++j) e += ((int)pfx[j] <= wgid) ? 1 : 0;
        const int j = wgid - (int)pfx[e];
        u.e = e; u.mt = j / NT; u.nt = j % NT; u.cnt = (int)pfx[40 + e]; return true;
    }
};
struct Moe1Sched {
    static constexpr bool GATHER = true, FP8 = (MOE_FP8 != 0); static constexpr int EB = FP8 ? 1 : 2; static constexpr int scaleA = 0x7F7F7F7F, scaleB = 0x7A7A7A7A;
    typedef MoeUnit Unit;
    MoeOrder O; const unsigned char* X; const unsigned char* W; const int* sdest; int K; size_t hstepB;
    __device__ __forceinline__ bool next(int i, Unit& u) const { return O.decode(i, u); }
    __device__ __forceinline__ const char* a_base(const Unit&) const { return (const char*)X; }
    __device__ __forceinline__ const char* b_base(const Unit& u) const { return (const char*)W + ((size_t)u.e * 2048 + (size_t)u.nt * 128) * 1024 * EB; }
    __device__ __forceinline__ void a_off(const Unit& u, int tid, unsigned (&v)[2][2]) const {
#pragma unroll
        for (int i = 0; i < 2; ++i) { int R, C; stage_rc(tid * 16 + i * 8192, R, C);
#pragma unroll
            for (int h = 0; h < 2; ++h) { const int slot = u.mt * 256 + h * HALF + R; int tok = 0; if (slot < u.cnt) tok = sdest[u.e * ECAP + slot] >> 2; v[h][i] = (unsigned)(tok * 1024 * EB + C * 2); } }
    }
};
struct Moe2Sched {
    static constexpr bool GATHER = true, FP8 = (MOE2_FP8 != 0); static constexpr int EB = FP8 ? 1 : 2; static constexpr int scaleA = 0x7F7F7F7F, scaleB = 0x79797979;
    typedef MoeUnit Unit;
    MoeOrder O; const unsigned char* Ab; const unsigned char* W; int K; size_t hstepB;
    __device__ __forceinline__ bool next(int i, Unit& u) const { return O.decode(i, u); }
    __device__ __forceinline__ const char* a_base(const Unit& u) const { return (const char*)Ab + ((size_t)u.e * ECAP + (size_t)u.mt * 256) * 1024 * EB; }
    __device__ __forceinline__ const char* b_base(const Unit& u) const { return (const char*)W + ((size_t)u.e * 1024 + (size_t)u.nt * 256) * 1024 * EB; }
    __device__ __forceinline__ void a_off(const Unit&, int tid, unsigned (&v)[2][2]) const {
#pragma unroll
        for (int i = 0; i < 2; ++i) { int R, C; stage_rc(tid * 16 + i * 8192, R, C); v[0][i] = (unsigned)(R * 1024 * EB + C * 2); v[1][i] = v[0][i] + (unsigned)(HALF * 1024 * EB); }
    }
};

__device__ __forceinline__ void unpack8(const v4u w, f32x4& a, f32x4& b) {
    a = (f32x4){__uint_as_float(w.x << 16), __uint_as_float(w.x & 0xffff0000u), __uint_as_float(w.y << 16), __uint_as_float(w.y & 0xffff0000u)};
    b = (f32x4){__uint_as_float(w.z << 16), __uint_as_float(w.z & 0xffff0000u), __uint_as_float(w.w << 16), __uint_as_float(w.w & 0xffff0000u)}; }
struct EpiF32 {
    static constexpr bool PERM = false;
    float* C; int ldc; const float* base; float alpha;
    __device__ __forceinline__ void operator()(const f32x4 (&acc)[2][2][4][2], const DenseSched::Unit& u, int wr, int wc, int fr, int fq) const {
        const int row0 = u.pm * BM + wr * 64 + fr, col0 = u.pn * BM + wc * 32 + 4 * fq;
#pragma unroll
        for (int ai = 0; ai < 2; ++ai)
#pragma unroll
            for (int m = 0; m < 4; ++m) { const size_t ro = (size_t)(row0 + ai * HALF + m * 16) * ldc + col0;
#pragma unroll
                for (int bj = 0; bj < 2; ++bj)
#pragma unroll
                    for (int n = 0; n < 2; ++n) { f32x4 v = acc[ai][bj][m][n];
                        if (base) { const f32x4 b = *(const f32x4*)(base + ro + bj * HALF + n * 16); v = v + b * alpha; }
                        *(f32x4*)(C + ro + bj * HALF + n * 16) = v; } }
    }
};
struct EpiB16 {
    static constexpr bool PERM = true;
    bf16* O; int ldc; const bf16* base; float alpha;
    __device__ __forceinline__ void operator()(const f32x4 (&acc)[2][2][4][2], const DenseSched::Unit& u, int wr, int wc, int fr, int fq) const {
        const int row0 = u.pm * BM + wr * 64 + fr, col0 = u.pn * BM + wc * 32 + 8 * fq;
#pragma unroll
        for (int ai = 0; ai < 2; ++ai) {
            v4u bw[4][2];
            if (base) {
#pragma unroll
                for (int m = 0; m < 4; ++m)
#pragma unroll
                    for (int bj = 0; bj < 2; ++bj) bw[m][bj] = *(const v4u*)(base + (size_t)(row0 + ai * HALF + m * 16) * ldc + col0 + bj * HALF); }
#pragma unroll
            for (int m = 0; m < 4; ++m) { bf16* rowp = O + (size_t)(row0 + ai * HALF + m * 16) * ldc + col0;
#pragma unroll
                for (int bj = 0; bj < 2; ++bj) { f32x4 v0 = acc[ai][bj][m][0], v1 = acc[ai][bj][m][1];
                    if (base) { f32x4 b0, b1; unpack8(bw[m][bj], b0, b1); v0 = v0 + b0 * alpha; v1 = v1 + b1 * alpha; }
                    v4u w; w.x = cvt_pk_bf16(v0[0], v0[1]); w.y = cvt_pk_bf16(v0[2], v0[3]); w.z = cvt_pk_bf16(v1[0], v1[1]); w.w = cvt_pk_bf16(v1[2], v1[3]);
                    *(v4u*)(rowp + bj * HALF) = w; } } }
    }
};
struct EpiPle {
    static constexpr bool PERM = true;
    bf16* C; const bf16* hb; const bf16* pe;
    __device__ __forceinline__ void operator()(const f32x4 (&acc)[2][2][4][2], const DenseSched::Unit& u, int wr, int wc, int fr, int fq) const {
        const int row0 = u.pm * BM + wr * 64 + fr, col0 = u.pn * BM + wc * 32 + 8 * fq;
#pragma unroll
        for (int ai = 0; ai < 2; ++ai) {
            v4u hw[4][2], pw[4][2];
#pragma unroll
            for (int m = 0; m < 4; ++m)
#pragma unroll
                for (int bj = 0; bj < 2; ++bj) { const size_t ro = (size_t)(row0 + ai * HALF + m * 16) * 1024 + col0 + bj * HALF; hw[m][bj] = *(const v4u*)(hb + ro); pw[m][bj] = *(const v4u*)(pe + ro); }
#pragma unroll
            for (int m = 0; m < 4; ++m)
#pragma unroll
                for (int bj = 0; bj < 2; ++bj) { const size_t ro = (size_t)(row0 + ai * HALF + m * 16) * 1024 + col0 + bj * HALF;
                    f32x4 h0, h1, p0, p1; unpack8(hw[m][bj], h0, h1); unpack8(pw[m][bj], p0, p1); const f32x4 a0 = acc[ai][bj][m][0], a1 = acc[ai][bj][m][1];
                    f32x4 o0, o1;
#pragma unroll
                    for (int j = 0; j < 4; ++j) { o0[j] = h0[j] + sigmoidf_(a0[j]) * p0[j]; o1[j] = h1[j] + sigmoidf_(a1[j]) * p1[j]; }
                    v4u w; w.x = cvt_pk_bf16(o0[0], o0[1]); w.y = cvt_pk_bf16(o0[2], o0[3]); w.z = cvt_pk_bf16(o1[0], o1[1]); w.w = cvt_pk_bf16(o1[2], o1[3]);
                    *(v4u*)(C + ro) = w; } }
    }
};
struct EpiMoe1 {
    static constexpr bool PERM = true;
    bf16* Ab; const float* bgu; unsigned char* AbQ;
    __device__ __forceinline__ void operator()(const f32x4 (&acc)[2][2][4][2], const MoeUnit& u, int wr, int wc, int fr, int fq) const {
        const int col0 = u.nt * 128 + wc * 32 + 8 * fq;
        const float* bg = bgu + (size_t)u.e * 2048 + col0;
        const f32x4 bg0 = *(const f32x4*)(bg), bg1 = *(const f32x4*)(bg + 4), bl0 = *(const f32x4*)(bg + 1024), bl1 = *(const f32x4*)(bg + 1028);
#pragma unroll
        for (int ai = 0; ai < 2; ++ai)
#pragma unroll
            for (int m = 0; m < 4; ++m) { const int r = ai * HALF + wr * 64 + m * 16 + fr;
                bf16* rowp = Ab + ((size_t)u.e * ECAP + (size_t)u.mt * 256 + r) * 1024 + col0;
                float o[8];
#pragma unroll
                for (int n = 0; n < 2; ++n) { const f32x4 g4 = acc[ai][0][m][n] + (n ? bg1 : bg0), l4 = acc[ai][1][m][n] + (n ? bl1 : bl0);
#pragma unroll
                    for (int j = 0; j < 4; ++j) { const float g = fminf(g4[j], 7.0f), l = fminf(fmaxf(l4[j], -7.0f), 7.0f); o[n * 4 + j] = (l + 1.0f) * g * sigmoidf_(1.702f * g); } }
                if constexpr (MOE2_FP8) { v2u q; q.x = cvt4_fp8(o[0], o[1], o[2], o[3]); q.y = cvt4_fp8(o[4], o[5], o[6], o[7]); *(v2u*)((unsigned char*)AbQ + ((size_t)u.e * ECAP + (size_t)u.mt * 256 + r) * 1024 + col0) = q; }
                else *(v4u*)rowp = pack8(o); }
    }
};
struct EpiMoe2 {
    static constexpr bool PERM = true;
    bf16* Y; const float* bdn; const int* sdest; const float* sgate;
    __device__ __forceinline__ void operator()(const f32x4 (&acc)[2][2][4][2], const MoeUnit& u, int wr, int wc, int fr, int fq) const {
        const int col0 = u.nt * 256 + wc * 32 + 8 * fq;
        const float* bp = bdn + (size_t)u.e * 1024 + col0;
#pragma unroll
        for (int ai = 0; ai < 2; ++ai) {
            f32x4 bv[2][2];
#pragma unroll
            for (int bj = 0; bj < 2; ++bj)
#pragma unroll
                for (int n = 0; n < 2; ++n) bv[bj][n] = *(const f32x4*)(bp + bj * HALF + 4 * n);
            int dest[4]; float gate[4];
#pragma unroll
            for (int m = 0; m < 4; ++m) { const int slot = u.mt * 256 + ai * HALF + wr * 64 + m * 16 + fr; const bool ok = slot < u.cnt; const int si = u.e * ECAP + (ok ? slot : 0);
                dest[m] = ok ? sdest[si] : T * 4; gate[m] = sgate[si]; }
#pragma unroll
            for (int m = 0; m < 4; ++m) {
                { const float g = gate[m]; bf16* rowp = Y + (size_t)dest[m] * 1024 + col0;
#pragma unroll
                    for (int bj = 0; bj < 2; ++bj) { const f32x4 v0 = (acc[ai][bj][m][0] + bv[bj][0]) * g, v1 = (acc[ai][bj][m][1] + bv[bj][1]) * g;
                        v4u w; w.x = cvt_pk_bf16(v0[0], v0[1]); w.y = cvt_pk_bf16(v0[2], v0[3]); w.z = cvt_pk_bf16(v1[0], v1[1]); w.w = cvt_pk_bf16(v1[2], v1[3]);
                        *(v4u*)(rowp + bj * HALF) = w; } } } }
    }
};
}

__device__ __forceinline__ void p0_transpose_item(const float* W, int K, int N, int nblk, bf16* WT, int item, int lane) {
    const int kb = item / nblk, nb = item % nblk, k0 = 64 * kb, n = 64 * nb + lane;
    const bool ok = n < N; const float* src = W + (size_t)k0 * N + (ok ? n : 0);
    float x[64];
#pragma unroll
    for (int j = 0; j < 64; ++j) x[j] = __builtin_nontemporal_load(src + (size_t)j * N);
    bf16* dst = WT + (size_t)n * K + k0;
#pragma unroll
    for (int q = 0; q < 8; ++q) { v4u o; o.x = cvt_pk_bf16(x[8 * q], x[8 * q + 1]); o.y = cvt_pk_bf16(x[8 * q + 2], x[8 * q + 3]); o.z = cvt_pk_bf16(x[8 * q + 4], x[8 * q + 5]); o.w = cvt_pk_bf16(x[8 * q + 6], x[8 * q + 7]);
        if (!ok) o = (v4u){0u, 0u, 0u, 0u};
        *(v4u*)(dst + 8 * q) = o; }
}
__device__ __forceinline__ void cvt_rows(const float* src, bf16* dst, size_t n8, size_t i0, size_t stride) {
    for (size_t i = i0; i < n8; i += stride) { const f32x4 a = *(const f32x4*)(src + i * 8), b = *(const f32x4*)(src + i * 8 + 4);
        v4u o; o.x = cvt_pk_bf16(a.x, a.y); o.y = cvt_pk_bf16(a.z, a.w); o.z = cvt_pk_bf16(b.x, b.y); o.w = cvt_pk_bf16(b.z, b.w); *(v4u*)(dst + i * 8) = o; }
}
__device__ __forceinline__ void p0_prologue(Frame& F, const Args& A) {
    const int gw = F.vcu * NWAVES + F.wave, NGW = F.G * NWAVES;
    constexpr int I_IN = 16 * (NUP / 64), I_OUT = 16 * 16, I_GU = 16 * 32, I_DN = 16 * 16, I_PG = 16 * 16, I_PP = 4 * 16;
    constexpr int PER_LAYER = I_IN + I_OUT + NE * I_GU + NE * I_DN + I_PG + I_PP;
#pragma unroll 1
    for (int it = gw; it < DEPTH * PER_LAYER; it += NGW) {
        const int l = it / PER_LAYER; int r = it % PER_LAYER;
        const float* W; bf16* WT; int K = D, N = D, nblk = 16;
        if (r < I_IN) { W = KIN(I_WIN) + (size_t)l * D * NU; WT = WSP(bf16, WS_WIN_T) + (size_t)l * NUP * D; N = NU; nblk = NUP / 64; }
        else if ((r -= I_IN) < I_OUT) { W = KIN(I_WOUT) + (size_t)l * D * D; WT = WSP(bf16, WS_WOUT_T) + (size_t)l * D * D; }
        else if ((r -= I_OUT) < NE * I_GU) { if (MOE_FP8) continue; const int e = r / I_GU; r %= I_GU; W = KIN(I_WGU) + ((size_t)l * NE + e) * D * 2048; WT = WSP(bf16, WS_WGU_T) + ((size_t)l * NE + e) * 2048 * D; N = 2048; nblk = 32; }
        else if ((r -= NE * I_GU) < NE * I_DN) { if (MOE2_FP8) continue; const int e = r / I_DN; r %= I_DN; W = KIN(I_WDN) + ((size_t)l * NE + e) * D * D; WT = WSP(bf16, WS_WDN_T) + ((size_t)l * NE + e) * D * D; }
        else if ((r -= NE * I_DN) < I_PG) { W = KIN(I_PGW) + (size_t)l * D * D; WT = WSP(bf16, WS_WPG_T) + (size_t)l * D * D; }
        else { r -= I_PG; W = KIN(I_PPJ) + (size_t)l * 256 * D; WT = WSP(bf16, WS_WPP_T) + (size_t)l * D * 256; K = 256; }
        p0_transpose_item(W, K, N, nblk, WT, r, F.lane);
    }
#if MOE_FP8
    constexpr int Q_GU = 16 * 32, Q_DN = 16 * 16, Q_PER_LAYER = NE * (Q_GU + Q_DN);
#pragma unroll 1
    for (int it = gw; it < DEPTH * Q_PER_LAYER; it += NGW) {
        const int l = it / Q_PER_LAYER; int r = it % Q_PER_LAYER; const float* W; unsigned char* WQ; int N; float sc;
        if (r < NE * Q_GU) { const int e = r / Q_GU; r %= Q_GU; W = KIN(I_WGU) + ((size_t)l * NE + e) * D * 2048; WQ = WSP(unsigned char, WS_WGU_Q) + ((size_t)l * NE + e) * 2048 * D; N = 2048; sc = 32.0f; }
        else { if (!MOE2_FP8) continue; r -= NE * Q_GU; const int e = r / Q_DN; r %= Q_DN; W = KIN(I_WDN) + ((size_t)l * NE + e) * D * D; WQ = WSP(unsigned char, WS_WDN_Q) + ((size_t)l * NE + e) * D * D; N = D; sc = 64.0f; }
        const int nblk = N / 64, kb = r / nblk, nb = r % nblk, k0 = 64 * kb, n = 64 * nb + F.lane;
        const float* src = W + (size_t)k0 * N + n; float x[64];
#pragma unroll
        for (int j = 0; j < 64; ++j) x[j] = __builtin_nontemporal_load(src + (size_t)j * N) * sc;
        unsigned char* dst = WQ + (size_t)n * D + k0;
#pragma unroll
        for (int q = 0; q < 4; ++q) { v4u o; o.x = cvt4_fp8(x[16 * q], x[16 * q + 1], x[16 * q + 2], x[16 * q + 3]); o.y = cvt4_fp8(x[16 * q + 4], x[16 * q + 5], x[16 * q + 6], x[16 * q + 7]);
            o.z = cvt4_fp8(x[16 * q + 8], x[16 * q + 9], x[16 * q + 10], x[16 * q + 11]); o.w = cvt4_fp8(x[16 * q + 12], x[16 * q + 13], x[16 * q + 14], x[16 * q + 15]); *(v4u*)(dst + 16 * q) = o; }
    }
#endif
    const size_t gt = (size_t)F.vcu * (NWAVES * 64) + F.tid, NT_ = (size_t)F.G * NWAVES * 64;
    cvt_rows(KIN(I_P), WSP(bf16, WS_PB), (size_t)DEPTH * T * 256 / 8, gt, NT_);
    cvt_rows(KIN(I_X), WSP(bf16, WS_XB), (size_t)T * D / 8, gt, NT_);
    for (size_t i = gt; i < (size_t)DEPTH * LORA_PER_LAYER; i += NT_) { const int l = (int)(i / LORA_PER_LAYER); int r = (int)(i % LORA_PER_LAYER); float v;
        if (r < 8192) { const int ch = r >> 5, j = r & 31; v = KIN(I_RWUP)[(size_t)l * 8192 + j * 256 + ch]; }
        else if (r < 16384) { r -= 8192; const int ch = r >> 5, j = r & 31; v = KIN(I_RAUP)[(size_t)l * 8192 + j * 256 + ch]; }
        else if (r < 32768) { r -= 16384; const int ch = r >> 6, j = r & 63; v = KIN(I_RGUP)[(size_t)l * 16384 + j * 256 + ch]; }
        else { r -= 32768; const int d = r >> 4, j = r & 15; v = KIN(I_GGUP)[(size_t)l * 2048 + j * 128 + d]; }
        WSP(float, WS_LORA)[i] = v; }
    for (size_t i = gt; i < (size_t)DEPTH * NE * D; i += NT_) { const int l = (int)(i / (NE * D)), r = (int)(i % (NE * D)), e = r / D, k = r % D; WSP(float, WS_RWT)[i] = KIN(I_RTW)[(size_t)l * D * NE + (size_t)k * NE + e]; }
}

__device__ __forceinline__ void router_pick(float (&p)[32], int lane, float rbias, int& ek, float& gk) {
#pragma unroll
    for (int i = 0; i < 16; ++i) { const bool hi = (lane & 32) != 0; const float keep = hi ? p[i + 16] : p[i], send = hi ? p[i] : p[i + 16]; p[i] = keep + __shfl_xor(send, 32); }
#pragma unroll
    for (int i = 0; i < 8; ++i) { const bool hi = (lane & 16) != 0; const float keep = hi ? p[i + 8] : p[i], send = hi ? p[i] : p[i + 8]; p[i] = keep + __shfl_xor(send, 16); }
#pragma unroll
    for (int i = 0; i < 4; ++i) { const bool hi = (lane & 8) != 0; const float keep = hi ? p[i + 4] : p[i], send = hi ? p[i] : p[i + 4]; p[i] = keep + __shfl_xor(send, 8); }
#pragma unroll
    for (int i = 0; i < 2; ++i) { const bool hi = (lane & 4) != 0; const float keep = hi ? p[i + 2] : p[i], send = hi ? p[i] : p[i + 2]; p[i] = keep + __shfl_xor(send, 4); }
    { const bool hi = (lane & 2) != 0; const float keep = hi ? p[1] : p[0], send = hi ? p[0] : p[1]; p[0] = keep + __shfl_xor(send, 2); }
    const float logit = p[0] + __shfl_xor(p[0], 1) + rbias;
    const int me = lane >> 1; int rank = 0;
#pragma unroll
    for (int e = 0; e < 32; ++e) { const float le = __builtin_bit_cast(float, __builtin_amdgcn_readlane(__builtin_bit_cast(int, logit), 2 * e)); rank += (le > logit || (le == logit && e < me)) ? 1 : 0; }
    float tv[4]; int te[4];
#pragma unroll
    for (int k = 0; k < 4; ++k) { const unsigned long long m = __ballot(rank == k); const int src = (int)__builtin_ctzll(m);
        te[k] = src >> 1; tv[k] = __builtin_bit_cast(float, __builtin_amdgcn_readlane(__builtin_bit_cast(int, logit), src)); }
    const float e1 = __expf(tv[1] - tv[0]), e2 = __expf(tv[2] - tv[0]), e3 = __expf(tv[3] - tv[0]); const float inv = 1.0f / (1.0f + e1 + e2 + e3);
    const int kk = lane & 3;
    ek = kk == 0 ? te[0] : kk == 1 ? te[1] : kk == 2 ? te[2] : te[3];
    gk = (kk == 0 ? 1.0f : kk == 1 ? e1 : kk == 2 ? e2 : e3) * inv;
}
template <bool DRY> __device__ __forceinline__ void p6_ln1_router(Frame& F, const Args& A, int layer) {
    const bf16* y1 = WSP(bf16, WS_Y1); bf16* x1b = WSP(bf16, WS_X1B);
    const float* g = KIN(I_LN1G) + layer * D; const float* bb = KIN(I_LN1B) + layer * D;
    const float* rwt = WSP(float, WS_RWT) + (size_t)layer * NE * D; const float* rb = KIN(I_RTB) + layer * NE;
    int* sdest = WSP(int, WS_SDEST); float* sgate = WSP(float, WS_SGATE);
    unsigned* cnt = (unsigned*)(F.ctl + CW_CNT + layer * NE * 16);
    LAS float* RWT = (LAS float*)F.lds;
    volatile LAS unsigned* lcnt = F.MISC + MW_LCNT; volatile LAS unsigned* lbase = F.MISC + MW_LBASE;
    for (int i = F.tid; i < NE * D / 4; i += NWAVES * 64) ((LAS f32x4*)RWT)[i] = ((const f32x4*)rwt)[i];
    const int lane = F.lane;
    const float rbias = rb[lane >> 1];
    for (int blk = F.vcu; blk < T / 64; blk += F.G) {
        if (F.tid < 32) lcnt[F.tid] = 0u;
        __syncthreads();
        int my_e = 0; float my_g = 0.f; unsigned my_r = 0u;
#pragma unroll 1
        for (int ri = 0; ri < 8; ++ri) {
            int lo_ = lane; asm volatile("" : "+v"(lo_));
            const f32x4 gv[4] = { *(const f32x4*)(g + 4 * lo_), *(const f32x4*)(g + 256 + 4 * lo_), *(const f32x4*)(g + 512 + 4 * lo_), *(const f32x4*)(g + 768 + 4 * lo_) };
            const f32x4 bv[4] = { *(const f32x4*)(bb + 4 * lo_), *(const f32x4*)(bb + 256 + 4 * lo_), *(const f32x4*)(bb + 512 + 4 * lo_), *(const f32x4*)(bb + 768 + 4 * lo_) };
            f32x4 v[4];
            { const int row = blk * 64 + F.wave * 8 + ri; const bf16* yr = y1 + (size_t)row * D; float s = 0.f;
#pragma unroll
                for (int j = 0; j < 4; ++j) { const v2u w = *(const v2u*)(yr + 256 * j + 4 * lane); v[j] = (f32x4){__uint_as_float(w.x << 16), __uint_as_float(w.x & 0xffff0000u), __uint_as_float(w.y << 16), __uint_as_float(w.y & 0xffff0000u)}; s += (v[j].x + v[j].y) + (v[j].z + v[j].w); }
                const float mean = wave_sum(s) * (1.f / D); float s2 = 0.f;
#pragma unroll
                for (int j = 0; j < 4; ++j) { v[j] = v[j] - mean; s2 += (v[j].x * v[j].x + v[j].y * v[j].y) + (v[j].z * v[j].z + v[j].w * v[j].w); }
                const float rstd = 1.0f / sqrtf(wave_sum(s2) * (1.f / D) + LN_EPS);
#pragma unroll
                for (int j = 0; j < 4; ++j) { v[j] = v[j] * rstd * gv[j] + bv[j];
                    v2u o; o.x = cvt_pk_bf16(v[j].x, v[j].y); o.y = cvt_pk_bf16(v[j].z, v[j].w); *(v2u*)(x1b + (size_t)row * D + 256 * j + 4 * lane) = o;
                    if (MOE_FP8) *(unsigned*)(WSP(unsigned char, WS_X1Q) + (size_t)row * D + 256 * j + 4 * lane) = cvt4_fp8(v[j].x, v[j].y, v[j].z, v[j].w); } }
            float p0[32];
#pragma unroll
            for (int e = 0; e < 32; ++e) { float a0 = 0.f;
#pragma unroll
                for (int j = 0; j < 4; ++j) { const f32x4 w = *(const LAS f32x4*)(RWT + e * D + 256 * j + 4 * lane); a0 += (v[j].x * w.x + v[j].y * w.y) + (v[j].z * w.z + v[j].w * w.w); }
                p0[e] = a0; }
            int ek0; float gk0;
            router_pick(p0, lane, rbias, ek0, gk0);
            if ((lane >> 2) == ri) { my_e = ek0; my_g = gk0; my_r = DRY ? 0u : atomicAdd((unsigned*)&lcnt[ek0], 1u); }
        }
        __syncthreads();
        if (!DRY && F.tid < 32) { const unsigned n = lcnt[F.tid]; lbase[F.tid] = n ? __hip_atomic_fetch_add(cnt + F.tid * 16, n, RLX_AGENT) : 0u; }
        __syncthreads();
        if (!DRY && lane < 32) { const int row = blk * 64 + F.wave * 8 + (lane >> 2); const unsigned slot = (unsigned)my_e * ECAP + lbase[my_e] + my_r;
            sdest[slot] = row * 4 + (lane & 3); sgate[slot] = my_g; }
        __syncthreads();
    }
}
__device__ __forceinline__ void p9_combine(Frame& F, const Args& A) {
    const bf16* x1b = WSP(bf16, WS_X1B); const bf16* yb = WSP(bf16, WS_YBUF); bf16* hb = WSP(bf16, WS_HB);
    const int gw = F.vcu * NWAVES + F.wave, NGW = F.G * NWAVES, lane = F.lane;
    for (int row = gw; row < T; row += NGW) {
        v4u y[4][2], xw[2];
#pragma unroll
        for (int j = 0; j < 2; ++j) {
#pragma unroll
            for (int k = 0; k < 4; ++k) y[k][j] = *(const v4u*)(yb + ((size_t)row * 4 + k) * D + 512 * j + 8 * lane);
            xw[j] = *(const v4u*)(x1b + (size_t)row * D + 512 * j + 8 * lane); }
#pragma unroll
        for (int j = 0; j < 2; ++j) { f32x4 v0, v1; pg8::unpack8(xw[j], v0, v1); v0 = v0 * DN_ALPHA; v1 = v1 * DN_ALPHA;
#pragma unroll
            for (int k = 0; k < 4; ++k) { f32x4 a, b; pg8::unpack8(y[k][j], a, b); v0 = v0 + a; v1 = v1 + b; }
            v4u wv; wv.x = cvt_pk_bf16(v0.x, v0.y); wv.y = cvt_pk_bf16(v0.z, v0.w); wv.z = cvt_pk_bf16(v1.x, v1.y); wv.w = cvt_pk_bf16(v1.z, v1.w); *(v4u*)(hb + (size_t)row * D + 512 * j + 8 * lane) = wv; }
    }
}
__device__ __forceinline__ void p11_ln2(Frame& F, const Args& A, int layer) {
    const bf16* h2 = WSP(bf16, WS_H2); bf16* xb = WSP(bf16, WS_XB);
    const float* g = KIN(I_LN2G) + layer * D; const float* bb = KIN(I_LN2B) + layer * D;
    const int gw = F.vcu * NWAVES + F.wave, NGW = F.G * NWAVES, lane = F.lane;
    for (int row = gw; row < T; row += NGW) {
        const bf16* yr = h2 + (size_t)row * D; f32x4 v[4]; float s = 0.f;
#pragma unroll
        for (int j = 0; j < 4; ++j) { const v2u w = *(const v2u*)(yr + 256 * j + 4 * lane); v[j] = (f32x4){__uint_as_float(w.x << 16), __uint_as_float(w.x & 0xffff0000u), __uint_as_float(w.y << 16), __uint_as_float(w.y & 0xffff0000u)}; s += (v[j].x + v[j].y) + (v[j].z + v[j].w); }
        const float mean = wave_sum(s) * (1.f / D); float s2 = 0.f;
#pragma unroll
        for (int j = 0; j < 4; ++j) { v[j] = v[j] - mean; s2 += (v[j].x * v[j].x + v[j].y * v[j].y) + (v[j].z * v[j].z + v[j].w * v[j].w); }
        const float rstd = 1.0f / sqrtf(wave_sum(s2) * (1.f / D) + LN_EPS);
#pragma unroll
        for (int j = 0; j < 4; ++j) { const f32x4 gv = *(const f32x4*)(g + 256 * j + 4 * lane), bv = *(const f32x4*)(bb + 256 * j + 4 * lane);
            const f32x4 o = v[j] * rstd * gv + bv; const size_t off = (size_t)row * D + 256 * j + 4 * lane;
            if (layer == DEPTH - 1) *(f32x4*)(F.out + off) = o; v2u w; w.x = cvt_pk_bf16(o.x, o.y); w.y = cvt_pk_bf16(o.z, o.w); *(v2u*)(xb + off) = w; }
    }
}
__device__ __forceinline__ void moe_build_pfx(Frame& F, const Args& A, int layer, int NT) {
    volatile LAS unsigned* pfx = F.MISC + MW_PFX;
    __syncthreads();
    if (F.tid == 0) { unsigned acc = 0u;
        for (int e = 0; e < NE; ++e) { const unsigned c = __hip_atomic_load(F.ctl + CW_CNT + (layer * NE + e) * 16, RLX_AGENT); pfx[e] = acc; pfx[40 + e] = c; acc += ((c + 255u) >> 8) * (unsigned)NT; }
        pfx[32] = acc; }
    __syncthreads();
}
#define UU(t, col) bf2f(u[(size_t)(t) * NUP + (col)])
#define UU4(t, col) ldu4(u + (size_t)(t) * NUP + (col))
__device__ __forceinline__ f32x4 ldu4(const bf16* p) { const v2u w = *(const v2u*)p; return (f32x4){__uint_as_float(w.x << 16), __uint_as_float(w.x & 0xffff0000u), __uint_as_float(w.y << 16), __uint_as_float(w.y & 0xffff0000u)}; }
__device__ __forceinline__ void lds_st_bf16(LAS unsigned char* p, float v) { *(LAS unsigned short*)p = (unsigned short)(cvt_pk_bf16(v, 0.f) & 0xffffu); }
__device__ __forceinline__ void lds_st_bf16x4(LAS unsigned char* p, float a, float b, float c, float d) { v2u o; o.x = cvt_pk_bf16(a, b); o.y = cvt_pk_bf16(c, d); *(LAS v2u*)p = o; }

__device__ __forceinline__ void ssd_stage1(Frame& F, const Args& A, int layer, int b, int c) {
    const bf16* u = WSP(bf16, WS_U);
    LAS unsigned char* L = F.lds;
    LAS float* DT = (LAS float*)L; LAS float* AC = DT + 256;
    LAS unsigned char* BMT = L + 2048; LAS unsigned char* XCDT = BMT + 128 * 144;
    const int t0 = b * SEQ + c * 64, tid = F.tid, lane = F.lane, wave = F.wave;
    if (wave < 4) {
        const int hh = wave;
        const float dt = softplusf_(UU(t0 + lane, U_SSD_DT + hh) + KIN(I_SDTB)[layer * 4 + hh]);
        const float adt = -dt * __expf(KIN(I_SALOG)[layer * 4 + hh]);
        const float ac = wave_scan_add(adt, lane);
        DT[hh * 64 + lane] = dt; AC[hh * 64 + lane] = ac;
        if (lane == 63) WSP(float, WS_SSD_DEC)[(b * 4 + hh) * NCH + c] = __expf(ac);
    }
    __syncthreads();
    if (tid < 384) {
        const int cc = tid; const float* cw = KIN(I_SCW) + (size_t)layer * 2048 + cc; const float w0 = cw[0], w1 = cw[512], w2 = cw[1024], w3 = cw[1536], cb = KIN(I_SCB)[layer * 512 + cc];
        const bf16* up = u + (size_t)t0 * NUP + U_SSD_X + cc;
        float win0 = 0.f, win1 = 0.f, win2 = 0.f;
        if (c > 0) { win0 = bf2f(up[-3 * NUP]); win1 = bf2f(up[-2 * NUP]); win2 = bf2f(up[-1 * NUP]); }
        const int hh = (cc >> 6) & 3; const bool isx = cc < 256;
        LAS unsigned char* dst = isx ? XCDT + cc * 144 : BMT + (cc - 256) * 144;
        const float aclast = AC[hh * 64 + 63];
#pragma unroll 1
        for (int l0 = 0; l0 < 64; l0 += 32) {
            float xv[32];
#pragma unroll
            for (int j = 0; j < 32; ++j) xv[j] = bf2f(up[(l0 + j) * NUP]);
#pragma unroll
            for (int j8 = 0; j8 < 4; ++j8) { float o[8];
#pragma unroll
                for (int j = 0; j < 8; ++j) { const int l = l0 + j8 * 8 + j; const float x = xv[j8 * 8 + j]; const float y = cb + w0 * win0 + w1 * win1 + w2 * win2 + w3 * x; win0 = win1; win1 = win2; win2 = x;
                    float s = siluf_(y); if (isx) s *= DT[hh * 64 + l] * __expf(aclast - AC[hh * 64 + l]); o[j] = s; }
                *(LAS v4u*)(dst + (l0 + j8 * 8) * 2) = pack8(o); }
        }
    }
    __syncthreads();
    { const int fr = lane & 15, fq = lane >> 4; float* st = WSP(float, WS_SSD_ST);
#pragma unroll 1
      for (int i = 0; i < 2; ++i) { const int row0 = (2 * wave + i) * 16; const int hh = row0 >> 6, p = (row0 & 63) + fr;
          float* dstp = st + (((size_t)(b * 4 + hh) * NCH + c) * 64 + p) * 128;
#pragma unroll 1
          for (int ntl = 0; ntl < 8; ++ntl) { f32x4 acc = {0.f, 0.f, 0.f, 0.f}; acc = mm16(XCDT + row0 * 144, 144, BMT + ntl * 16 * 144, 144, 64, acc, fr, fq);
              *(f32x4*)(dstp + ntl * 16 + 4 * fq) = acc; } } }
    __syncthreads();
}
__device__ __forceinline__ void ssd_stage3(Frame& F, const Args& A, int layer, int b, int c) {
    const bf16* u = WSP(bf16, WS_U);
    LAS unsigned char* L = F.lds;
    LAS float* DT = (LAS float*)L; LAS float* AC = DT + 256;
    LAS unsigned char* CM = L + 2048; LAS unsigned char* BM = CM + 64 * 272; LAS unsigned char* XCT = BM + 64 * 272; LAS unsigned char* MM = XCT + 256 * 144;
    LAS unsigned char* YG = XCT;
    const int t0 = b * SEQ + c * 64, tid = F.tid, lane = F.lane, wave = F.wave, fr = lane & 15, fq = lane >> 4;
    if (wave < 4) {
        const int hh = wave;
        const float dt = softplusf_(UU(t0 + lane, U_SSD_DT + hh) + KIN(I_SDTB)[layer * 4 + hh]);
        const float adt = -dt * __expf(KIN(I_SALOG)[layer * 4 + hh]);
        DT[hh * 64 + lane] = dt; AC[hh * 64 + lane] = wave_scan_add(adt, lane);
    }
    __syncthreads();
    {
        const int cc = tid; const float* cw = KIN(I_SCW) + (size_t)layer * 2048 + cc; const float w0 = cw[0], w1 = cw[512], w2 = cw[1024], w3 = cw[1536], cb = KIN(I_SCB)[layer * 512 + cc];
        const bf16* up = u + (size_t)t0 * NUP + U_SSD_X + cc;
        float win0 = 0.f, win1 = 0.f, win2 = 0.f;
        if (c > 0) { win0 = bf2f(up[-3 * NUP]); win1 = bf2f(up[-2 * NUP]); win2 = bf2f(up[-1 * NUP]); }
        const int hh = (cc >> 6) & 3;
#pragma unroll 1
        for (int l0 = 0; l0 < 64; l0 += 32) {
            float xv[32];
#pragma unroll
            for (int j = 0; j < 32; ++j) xv[j] = bf2f(up[(l0 + j) * NUP]);
#pragma unroll
            for (int j8 = 0; j8 < 4; ++j8) { float o[8];
#pragma unroll
                for (int j = 0; j < 8; ++j) { const int l = l0 + j8 * 8 + j; const float x = xv[j8 * 8 + j]; const float y = cb + w0 * win0 + w1 * win1 + w2 * win2 + w3 * x; win0 = win1; win1 = win2; win2 = x;
                    float s = siluf_(y); if (cc < 256) s *= DT[hh * 64 + l]; o[j] = s; }
                if (cc < 256) *(LAS v4u*)(XCT + cc * 144 + (l0 + j8 * 8) * 2) = pack8(o);
                else { LAS unsigned char* d2 = (cc < 384 ? BM + (cc - 256) * 2 : CM + (cc - 384) * 2) + (l0 + j8 * 8) * 272;
#pragma unroll
                    for (int j = 0; j < 8; ++j) lds_st_bf16(d2 + j * 272, o[j]); } }
        }
    }
    __syncthreads();
#pragma unroll 1
    for (int i = 0; i < 2; ++i) { const int idx = 2 * wave + i, lt = idx >> 2, st = idx & 3;
        f32x4 acc = {0.f, 0.f, 0.f, 0.f}; acc = mm16(CM + lt * 16 * 272, 272, BM + st * 16 * 272, 272, 128, acc, fr, fq);
        const int l = lt * 16 + fr, s0 = st * 16 + 4 * fq;
#pragma unroll
        for (int hh = 0; hh < 4; ++hh) { const float al = AC[hh * 64 + l], dl = KIN(I_SD)[layer * 4 + hh] / DT[hh * 64 + l]; float o[4];
#pragma unroll
            for (int j = 0; j < 4; ++j) { const int s = s0 + j; float m = (l >= s) ? acc[j] * __expf(al - AC[hh * 64 + s]) : 0.f; if (l == s) m += dl; o[j] = m; }
            lds_st_bf16x4(MM + hh * 9216 + l * 144 + s0 * 2, o[0], o[1], o[2], o[3]); } }
    __syncthreads();
    f32x4 yv[2][4];
    { const int hh = wave >> 1; const float* prev = WSP(float, WS_SSD_ST) + ((size_t)(b * 4 + hh) * NCH + c) * 8192;
      bf16x8 pf[4][4];
#pragma unroll
      for (int pt = 0; pt < 4; ++pt)
#pragma unroll
          for (int ks = 0; ks < 4; ++ks) pf[pt][ks] = ldfrag_f32(prev + (size_t)(pt * 16 + fr) * 128 + ks * 32 + fq * 8);
#pragma unroll
      for (int i = 0; i < 2; ++i) { const int lt = 2 * (wave & 1) + i, l = lt * 16 + fr; const float ea = __expf(AC[hh * 64 + l]);
#pragma unroll
          for (int pt = 0; pt < 4; ++pt) { f32x4 ad = {0.f, 0.f, 0.f, 0.f}, ao = {0.f, 0.f, 0.f, 0.f};
              ad = mm16(MM + hh * 9216 + lt * 16 * 144, 144, XCT + (hh * 64 + pt * 16) * 144, 144, 64, ad, fr, fq);
              ao = mm16_rB<4>(CM + lt * 16 * 272, 272, pf[pt], ao, fr, fq);
              const f32x4 z = UU4(t0 + l, U_SSD_Z + hh * 64 + pt * 16 + 4 * fq);
              f32x4 y = ad + ao * ea; y.x *= siluf_(z.x); y.y *= siluf_(z.y); y.z *= siluf_(z.z); y.w *= siluf_(z.w); yv[i][pt] = y; } } }
    __syncthreads();
    { const int hh = wave >> 1;
#pragma unroll
      for (int i = 0; i < 2; ++i) { const int l = (2 * (wave & 1) + i) * 16 + fr;
#pragma unroll
          for (int pt = 0; pt < 4; ++pt) *(LAS f32x4*)(YG + l * 1040 + (hh * 64 + pt * 16 + 4 * fq) * 4) = yv[i][pt]; } }
    __syncthreads();
    { const f32x4 g = *(const f32x4*)(KIN(I_SNG) + layer * 256 + 4 * lane); bf16* mix = WSP(bf16, WS_MIX);
#pragma unroll 1
      for (int i = 0; i < 8; ++i) { const int l = wave * 8 + i; const f32x4 y = *(const LAS f32x4*)(YG + l * 1040 + lane * 16);
          const float ss = wave_sum((y.x * y.x + y.y * y.y) + (y.z * y.z + y.w * y.w)); const float r = 1.0f / sqrtf(ss * (1.f / 256.f) + NORM_EPS);
          v2u o; o.x = cvt_pk_bf16(y.x * r * g.x, y.y * r * g.y); o.y = cvt_pk_bf16(y.z * r * g.z, y.w * r * g.w);
          *(v2u*)(mix + (size_t)(t0 + l) * D + 4 * lane) = o; } }
    __syncthreads();
}

__device__ __forceinline__ float gla_bcum(Frame& F, const Args& A, int layer, int d, const LAS float* GD, LAS float* BC) {
    float gup[16];
    { const f32x4* gp4 = (const f32x4*)(WSP(float, WS_LORA) + (size_t)layer * LORA_PER_LAYER + 32768 + d * 16);
#pragma unroll
      for (int i = 0; i < 4; ++i) { const f32x4 a = gp4[i]; gup[4 * i] = a.x; gup[4 * i + 1] = a.y; gup[4 * i + 2] = a.z; gup[4 * i + 3] = a.w; } }
    const float gb = KIN(I_GGB)[layer * 128 + d]; float bc = 0.f;
#pragma unroll 2
    for (int l = 0; l < 64; ++l) { float x = gb;
#pragma unroll
        for (int i = 0; i < 16; ++i) x += GD[l * 16 + i] * gup[i];
        bc += logsigmoidf_(x) * 0.0625f; BC[l * 128 + d] = bc; }
    return bc;
}
__device__ __forceinline__ void gla_stage1(Frame& F, const Args& A, int layer, int b, int c) {
    const bf16* u = WSP(bf16, WS_U);
    LAS unsigned char* L = F.lds;
    LAS float* GD = (LAS float*)L; LAS float* BC = (LAS float*)(L + 4096);
    LAS unsigned char* KDT = L + 36864; LAS unsigned char* VT = KDT + 128 * 144;
    const int t0 = b * SEQ + c * 64, tid = F.tid, lane = F.lane, wave = F.wave, fr = lane & 15, fq = lane >> 4;
    if (tid < 256) { const int l = tid >> 2, q4 = tid & 3; *(LAS f32x4*)(GD + l * 16 + q4 * 4) = UU4(t0 + l, U_GL_G + 4 * q4); }
    __syncthreads();
    if (tid < 128) {
        const int d = tid; const float blast = gla_bcum(F, A, layer, d, GD, BC);
        WSP(float, WS_GLA_DEC)[(size_t)(b * NCH + c) * 128 + d] = __expf(blast);
        const bf16* up = u + (size_t)t0 * NUP + U_GL_K + d;
#pragma unroll 1
        for (int l0 = 0; l0 < 64; l0 += 32) { float xv[32];
#pragma unroll
            for (int j = 0; j < 32; ++j) xv[j] = bf2f(up[(l0 + j) * NUP]);
#pragma unroll
            for (int j8 = 0; j8 < 4; ++j8) { float o[8];
#pragma unroll
                for (int j = 0; j < 8; ++j) { const int l = l0 + j8 * 8 + j; o[j] = xv[j8 * 8 + j] * __expf(blast - BC[l * 128 + d]); }
                *(LAS v4u*)(KDT + d * 144 + (l0 + j8 * 8) * 2) = pack8(o); } }
    } else if (tid < 384) {
        const int vch = tid - 128; const bf16* up = u + (size_t)t0 * NUP + U_GL_V + vch;
#pragma unroll 1
        for (int l0 = 0; l0 < 64; l0 += 32) { float xv[32];
#pragma unroll
            for (int j = 0; j < 32; ++j) xv[j] = bf2f(up[(l0 + j) * NUP]);
#pragma unroll
            for (int j8 = 0; j8 < 4; ++j8) { float o[8];
#pragma unroll
                for (int j = 0; j < 8; ++j) o[j] = xv[j8 * 8 + j];
                *(LAS v4u*)(VT + vch * 144 + (l0 + j8 * 8) * 2) = pack8(o); } }
    }
    __syncthreads();
    { float* st = WSP(float, WS_GLA_ST);
#pragma unroll 1
      for (int i = 0; i < 4; ++i) { const int idx = 4 * wave + i, hh = idx >> 3, dtl = (idx >> 2) & 1, vt = idx & 3;
          f32x4 acc = {0.f, 0.f, 0.f, 0.f}; acc = mm16(KDT + (hh * 32 + dtl * 16) * 144, 144, VT + (hh * 64 + vt * 16) * 144, 144, 64, acc, fr, fq);
          *(f32x4*)(st + (((size_t)(b * 4 + hh) * NCH + c) * 32 + dtl * 16 + fr) * 64 + vt * 16 + 4 * fq) = acc; } }
    __syncthreads();
}
__device__ __forceinline__ void gla_stage3(Frame& F, const Args& A, int layer, int b, int c) {
    const bf16* u = WSP(bf16, WS_U);
    LAS unsigned char* L = F.lds;
    LAS float* GD = (LAS float*)L; LAS float* BC = (LAS float*)(L + 4096); LAS unsigned char* ATT = L + 4096;
    LAS unsigned char* QD = L + 40960; LAS unsigned char* KI = QD + 64 * 272; LAS unsigned char* VT = KI + 64 * 272; LAS unsigned char* PVT = VT + 256 * 144;
    const int t0 = b * SEQ + c * 64, tid = F.tid, lane = F.lane, wave = F.wave, fr = lane & 15, fq = lane >> 4;
    if (tid < 256) { const int l = tid >> 2, q4 = tid & 3; *(LAS f32x4*)(GD + l * 16 + q4 * 4) = UU4(t0 + l, U_GL_G + 4 * q4); }
    __syncthreads();
    if (tid < 128) {
        const int d = tid; (void)gla_bcum(F, A, layer, d, GD, BC);
        const bf16* uq = u + (size_t)t0 * NUP + U_GL_Q + d; const bf16* uk = u + (size_t)t0 * NUP + U_GL_K + d;
#pragma unroll 1
        for (int l0 = 0; l0 < 64; l0 += 16) { float qv[16], kv[16];
#pragma unroll
            for (int j = 0; j < 16; ++j) { qv[j] = bf2f(uq[(l0 + j) * NUP]); kv[j] = bf2f(uk[(l0 + j) * NUP]); }
#pragma unroll
            for (int j = 0; j < 16; ++j) { const int l = l0 + j; const float bc = BC[l * 128 + d];
                lds_st_bf16(QD + l * 272 + d * 2, qv[j] * 0.17677669529663687f * __expf(bc)); lds_st_bf16(KI + l * 272 + d * 2, kv[j] * __expf(-bc)); } }
    } else if (tid < 384) {
        const int vch = tid - 128; const bf16* up = u + (size_t)t0 * NUP + U_GL_V + vch;
#pragma unroll 1
        for (int l0 = 0; l0 < 64; l0 += 32) { float xv[32];
#pragma unroll
            for (int j = 0; j < 32; ++j) xv[j] = bf2f(up[(l0 + j) * NUP]);
#pragma unroll
            for (int j8 = 0; j8 < 4; ++j8) { float o[8];
#pragma unroll
                for (int j = 0; j < 8; ++j) o[j] = xv[j8 * 8 + j];
                *(LAS v4u*)(VT + vch * 144 + (l0 + j8 * 8) * 2) = pack8(o); } }
    } else {
        const float* prev = WSP(float, WS_GLA_ST);
#pragma unroll 4
        for (int i = tid - 384; i < 8192; i += 128) { const int hh = i >> 11, dd = (i >> 6) & 31, vv = i & 63;
            lds_st_bf16(PVT + (hh * 64 + vv) * 80 + dd * 2, prev[((size_t)(b * 4 + hh) * NCH + c) * 2048 + dd * 64 + vv]); }
    }
    __syncthreads();
    const int hh = wave >> 1;
#pragma unroll 1
    for (int i = 0; i < 2; ++i) { const int tt = 2 * (wave & 1) + i, t = tt * 16 + fr;
#pragma unroll
        for (int st = 0; st < 4; ++st) { f32x4 acc = {0.f, 0.f, 0.f, 0.f}; acc = mm16(QD + tt * 16 * 272 + hh * 64, 272, KI + st * 16 * 272 + hh * 64, 272, 32, acc, fr, fq);
            const int s0 = st * 16 + 4 * fq;
            lds_st_bf16x4(ATT + hh * 9216 + t * 144 + s0 * 2, t >= s0 ? acc[0] : 0.f, t >= s0 + 1 ? acc[1] : 0.f, t >= s0 + 2 ? acc[2] : 0.f, t >= s0 + 3 ? acc[3] : 0.f); } }
    __syncthreads();
    { bf16* mix = WSP(bf16, WS_MIX); const float* ng = KIN(I_GNG) + layer * 256;
#pragma unroll 1
      for (int i = 0; i < 2; ++i) { const int tt = 2 * (wave & 1) + i, t = tt * 16 + fr; f32x4 ov[4]; float ss = 0.f;
#pragma unroll
          for (int vt = 0; vt < 4; ++vt) { f32x4 acc = {0.f, 0.f, 0.f, 0.f};
              acc = mm16(ATT + hh * 9216 + tt * 16 * 144, 144, VT + (hh * 64 + vt * 16) * 144, 144, 64, acc, fr, fq);
              acc = mm16(QD + tt * 16 * 272 + hh * 64, 272, PVT + (hh * 64 + vt * 16) * 80, 80, 32, acc, fr, fq);
              ov[vt] = acc; ss += (acc.x * acc.x + acc.y * acc.y) + (acc.z * acc.z + acc.w * acc.w); }
          ss += __shfl_xor(ss, 16); ss += __shfl_xor(ss, 32);
          const float r = 1.0f / sqrtf(ss * (1.f / 64.f) + NORM_EPS);
#pragma unroll
          for (int vt = 0; vt < 4; ++vt) { const int col = hh * 64 + vt * 16 + 4 * fq; const f32x4 g = *(const f32x4*)(ng + col); const f32x4 og = UU4(t0 + t, U_GL_OG + col);
              v2u o; o.x = cvt_pk_bf16(ov[vt].x * r * g.x * siluf_(og.x), ov[vt].y * r * g.y * siluf_(og.y)); o.y = cvt_pk_bf16(ov[vt].z * r * g.z * siluf_(og.z), ov[vt].w * r * g.w * siluf_(og.w));
              *(v2u*)(mix + (size_t)(t0 + t) * D + 512 + col) = o; } } }
    __syncthreads();
}

__device__ __forceinline__ void mlstm_stage1(Frame& F, const Args& A, int layer, int b, int c) {
    const bf16* u = WSP(bf16, WS_U);
    LAS unsigned char* L = F.lds;
    LAS float* WST = (LAS float*)L; LAS unsigned char* KT = L + 1024; LAS unsigned char* VWT = KT + 256 * 144;
    const int t0 = b * SEQ + c * 64, tid = F.tid, lane = F.lane, wave = F.wave, fr = lane & 15, fq = lane >> 4;
    if (wave < 4) {
        const int hh = wave;
        const float ig = UU(t0 + lane, U_ML_I + hh) + KIN(I_MIB)[layer * 4 + hh];
        const float lf = logsigmoidf_(UU(t0 + lane, U_ML_F + hh) + KIN(I_MFB)[layer * 4 + hh]);
        const float bc = wave_scan_add(lf, lane); const float blast = __shfl(bc, 63);
        const float ast = blast - bc + ig; const float mloc = wave_max(ast);
        WST[hh * 64 + lane] = __expf(ast - mloc);
        if (lane == 0) { WSP(float, WS_ML_BL)[(b * 4 + hh) * NCH + c] = blast; WSP(float, WS_ML_ML)[(b * 4 + hh) * NCH + c] = mloc; }
    } else {
        const int kch = tid - 256, cc = 256 + kch; const float* cw = KIN(I_MCW) + (size_t)layer * 2048 + cc; const float w0 = cw[0], w1 = cw[512], w2 = cw[1024], w3 = cw[1536], cb = KIN(I_MCB)[layer * 512 + cc];
        const bf16* up = u + (size_t)t0 * NUP + U_ML_K + kch;
        float win0 = 0.f, win1 = 0.f, win2 = 0.f;
        if (c > 0) { win0 = bf2f(up[-3 * NUP]); win1 = bf2f(up[-2 * NUP]); win2 = bf2f(up[-1 * NUP]); }
#pragma unroll 1
        for (int l0 = 0; l0 < 64; l0 += 32) { float xv[32];
#pragma unroll
            for (int j = 0; j < 32; ++j) xv[j] = bf2f(up[(l0 + j) * NUP]);
#pragma unroll
            for (int j8 = 0; j8 < 4; ++j8) { float o[8];
#pragma unroll
                for (int j = 0; j < 8; ++j) { const float x = xv[j8 * 8 + j]; const float y = cb + w0 * win0 + w1 * win1 + w2 * win2 + w3 * x; win0 = win1; win1 = win2; win2 = x; o[j] = siluf_(y); }
                *(LAS v4u*)(KT + kch * 144 + (l0 + j8 * 8) * 2) = pack8(o); } }
    }
    __syncthreads();
    if (tid < 256) {
        const int vch = tid, hh = vch >> 6; const bf16* up = u + (size_t)t0 * NUP + U_ML_V + vch;
#pragma unroll 1
        for (int l0 = 0; l0 < 64; l0 += 32) { float xv[32];
#pragma unroll
            for (int j = 0; j < 32; ++j) xv[j] = bf2f(up[(l0 + j) * NUP]);
#pragma unroll
            for (int j8 = 0; j8 < 4; ++j8) { float o[8];
#pragma unroll
                for (int j = 0; j < 8; ++j) o[j] = xv[j8 * 8 + j] * WST[hh * 64 + l0 + j8 * 8 + j];
                *(LAS v4u*)(VWT + vch * 144 + (l0 + j8 * 8) * 2) = pack8(o); } }
    } else {
        const int kch = tid - 256, hh = kch >> 6; float n = 0.f;
#pragma unroll 8
        for (int s = 0; s < 64; ++s) n += WST[hh * 64 + s] * bf2f(*(const LAS unsigned short*)(KT + kch * 144 + s * 2));
        WSP(float, WS_ML_N)[((size_t)(b * 4 + hh) * NCH + c) * 64 + (kch & 63)] = n;
    }
    __syncthreads();
    { float* cst = WSP(float, WS_ML_C); const int hh = wave >> 1;
#pragma unroll 1
      for (int i = 0; i < 2; ++i) { const int vt = 2 * (wave & 1) + i;
#pragma unroll 1
          for (int kt = 0; kt < 4; ++kt) { f32x4 acc = {0.f, 0.f, 0.f, 0.f}; acc = mm16(VWT + (hh * 64 + vt * 16) * 144, 144, KT + (hh * 64 + kt * 16) * 144, 144, 64, acc, fr, fq);
              *(f32x4*)(cst + (((size_t)(b * 4 + hh) * NCH + c) * 64 + vt * 16 + fr) * 64 + kt * 16 + 4 * fq) = acc; } } }
    __syncthreads();
}
__device__ __forceinline__ void mlstm_stage3(Frame& F, const Args& A, int layer, int b, int c) {
    const bf16* u = WSP(bf16, WS_U);
    LAS unsigned char* L = F.lds;
    LAS float* BCU = (LAS float*)L; LAS float* GG = BCU + 256; LAS float* MROW = BCU + 512; LAS float* WINT = BCU + 768; LAS float* NPV = BCU + 1024;
    LAS unsigned char* Q = L + 6144; LAS unsigned char* KK = Q + 64 * 528; LAS unsigned char* VT = KK + 64 * 528; LAS unsigned char* SC = VT + 256 * 144;
    const int t0 = b * SEQ + c * 64, tid = F.tid, lane = F.lane, wave = F.wave, fr = lane & 15, fq = lane >> 4;
    if (wave < 4) {
        const int hh = wave;
        const float ig = UU(t0 + lane, U_ML_I + hh) + KIN(I_MIB)[layer * 4 + hh];
        const float lf = logsigmoidf_(UU(t0 + lane, U_ML_F + hh) + KIN(I_MFB)[layer * 4 + hh]);
        const float bc = wave_scan_add(lf, lane); const float gg = ig - bc;
        const float mprev = WSP(float, WS_ML_M)[(b * 4 + hh) * NCH + c];
        const float minter = bc + mprev, mintra = bc + wave_scan_max(gg, lane), mrow = fmaxf(minter, mintra);
        BCU[hh * 64 + lane] = bc; GG[hh * 64 + lane] = gg; MROW[hh * 64 + lane] = mrow; WINT[hh * 64 + lane] = __expf(minter - mrow);
        NPV[hh * 64 + lane] = WSP(float, WS_ML_N)[((size_t)(b * 4 + hh) * NCH + c) * 64 + lane];
    }
    {
        const int cc = tid; const float* cw = KIN(I_MCW) + (size_t)layer * 2048 + cc; const float w0 = cw[0], w1 = cw[512], w2 = cw[1024], w3 = cw[1536], cb = KIN(I_MCB)[layer * 512 + cc];
        const bf16* up = u + (size_t)t0 * NUP + U_ML_Q + cc;
        float win0 = 0.f, win1 = 0.f, win2 = 0.f;
        if (c > 0) { win0 = bf2f(up[-3 * NUP]); win1 = bf2f(up[-2 * NUP]); win2 = bf2f(up[-1 * NUP]); }
        LAS unsigned char* dst = cc < 256 ? Q + cc * 2 : KK + (cc - 256) * 2; const float sc = cc < 256 ? 0.125f : 1.0f;
#pragma unroll 1
        for (int l0 = 0; l0 < 64; l0 += 32) { float xv[32];
#pragma unroll
            for (int j = 0; j < 32; ++j) xv[j] = bf2f(up[(l0 + j) * NUP]);
#pragma unroll
            for (int j = 0; j < 32; ++j) { const float x = xv[j]; const float y = cb + w0 * win0 + w1 * win1 + w2 * win2 + w3 * x; win0 = win1; win1 = win2; win2 = x; lds_st_bf16(dst + (l0 + j) * 528, siluf_(y) * sc); } }
        const int vch = tid & 255, lh = (tid >> 8) * 32; const bf16* uv = u + (size_t)(t0 + lh) * NUP + U_ML_V + vch;
        float xv[32];
#pragma unroll
        for (int j = 0; j < 32; ++j) xv[j] = bf2f(uv[j * NUP]);
#pragma unroll
        for (int j8 = 0; j8 < 4; ++j8) { float o[8];
#pragma unroll
            for (int j = 0; j < 8; ++j) o[j] = xv[j8 * 8 + j];
            *(LAS v4u*)(VT + vch * 144 + (lh + j8 * 8) * 2) = pack8(o); }
    }
    __syncthreads();
    { const int hh = wave >> 1; bf16* mix = WSP(bf16, WS_MIX); const float* ng = KIN(I_MNG) + layer * 256;
      const float* cprev = WSP(float, WS_ML_C) + ((size_t)(b * 4 + hh) * NCH + c) * 4096;
      bf16x8 cf[4][2];
#pragma unroll
      for (int vt = 0; vt < 4; ++vt)
#pragma unroll
          for (int ks = 0; ks < 2; ++ks) cf[vt][ks] = ldfrag_f32(cprev + (size_t)(vt * 16 + fr) * 64 + ks * 32 + fq * 8);
#pragma unroll 1
      for (int i = 0; i < 2; ++i) { const int tt = 2 * (wave & 1) + i, t = tt * 16 + fr;
          const float bt = BCU[hh * 64 + t] - MROW[hh * 64 + t]; float rs = 0.f;
#pragma unroll
          for (int st = 0; st < 4; ++st) { f32x4 acc = {0.f, 0.f, 0.f, 0.f}; acc = mm16(Q + tt * 16 * 528 + hh * 128, 528, KK + st * 16 * 528 + hh * 128, 528, 64, acc, fr, fq);
              const int s0 = st * 16 + 4 * fq; float o[4];
#pragma unroll
              for (int j = 0; j < 4; ++j) { const int s = s0 + j; const float v = (t >= s) ? acc[j] * __expf(bt + GG[hh * 64 + s]) : 0.f; o[j] = v; rs += v; }
              lds_st_bf16x4(SC + hh * 9216 + t * 144 + s0 * 2, o[0], o[1], o[2], o[3]); }
          rs += __shfl_xor(rs, 16); rs += __shfl_xor(rs, 32);
          float nq = 0.f;
#pragma unroll
          for (int j = 0; j < 16; ++j) nq += bf2f(*(const LAS unsigned short*)(Q + t * 528 + (hh * 64 + fq * 16 + j) * 2)) * NPV[hh * 64 + fq * 16 + j];
          nq += __shfl_xor(nq, 16); nq += __shfl_xor(nq, 32);
          const float wi = WINT[hh * 64 + t]; const float den = wi * nq + rs; const float dn = fmaxf(fabsf(den), __expf(-MROW[hh * 64 + t])); const float rdn = 1.0f / dn;
          LDS_WAIT();
          f32x4 hv[4]; float sm = 0.f;
#pragma unroll
          for (int vt = 0; vt < 4; ++vt) { f32x4 acc = {0.f, 0.f, 0.f, 0.f};
              acc = mm16_rB<2>(Q + tt * 16 * 528 + hh * 128, 528, cf[vt], acc, fr, fq);
              acc = acc * wi;
              acc = mm16(SC + hh * 9216 + tt * 16 * 144, 144, VT + (hh * 64 + vt * 16) * 144, 144, 64, acc, fr, fq);
              const f32x4 og = UU4(t0 + t, U_ML_O + hh * 64 + vt * 16 + 4 * fq);
              f32x4 h; h.x = acc.x * rdn * sigmoidf_(og.x); h.y = acc.y * rdn * sigmoidf_(og.y); h.z = acc.z * rdn * sigmoidf_(og.z); h.w = acc.w * rdn * sigmoidf_(og.w);
              hv[vt] = h; sm += (h.x + h.y) + (h.z + h.w); }
          sm += __shfl_xor(sm, 16); sm += __shfl_xor(sm, 32);
          const float mean = sm * (1.f / 64.f); float sq = 0.f;
#pragma unroll
          for (int vt = 0; vt < 4; ++vt) { hv[vt] = hv[vt] - mean; sq += (hv[vt].x * hv[vt].x + hv[vt].y * hv[vt].y) + (hv[vt].z * hv[vt].z + hv[vt].w * hv[vt].w); }
          sq += __shfl_xor(sq, 16); sq += __shfl_xor(sq, 32);
          const float r = 1.0f / sqrtf(sq * (1.f / 64.f) + NORM_EPS);
#pragma unroll
          for (int vt = 0; vt < 4; ++vt) { const int col = hh * 64 + vt * 16 + 4 * fq; const f32x4 g = *(const f32x4*)(ng + col);
              v2u o; o.x = cvt_pk_bf16(hv[vt].x * r * g.x, hv[vt].y * r * g.y); o.y = cvt_pk_bf16(hv[vt].z * r * g.z, hv[vt].w * r * g.w);
              *(v2u*)(mix + (size_t)(t0 + t) * D + 768 + col) = o; } } }
    __syncthreads();
}

__device__ __forceinline__ void rwkv_stage1(Frame& F, const Args& A, int layer, int ub) {
    const bf16* u = WSP(bf16, WS_U);
    LAS unsigned char* L = F.lds;
    LAS float* LOWA = (LAS float*)L;
    LAS float* CUM = (LAS float*)(L + 16384);
    LAS float* AAB = CUM;
    LAS float* TOT = CUM;
    LAS unsigned char* M0 = L + 16384 + 16640;
#define RM(i) (M0 + (i) * 9216)
    LAS float* LOG = (LAS float*)RM(0);
    LAS float* GAMC = (LAS float*)(F.MISC + MW_GAMC);
    const int t0 = ub * 64, c = ub & 63, tid = F.tid, lane = F.lane, wave = F.wave;
    const float* mu = KIN(I_RMU) + layer * 896;
#ifndef RW_DUP
#define RW_DUP -1
#endif
#define RW_REP(k) for (int rep__ = 0; rep__ < ((RW_DUP == (k)) ? 2 : 1); ++rep__)
    RW_REP(0) {
    {
        const int l = tid >> 3, jq = tid & 7, t = t0 + l; const bool has_prev = (t & (SEQ - 1)) != 0;
        f32x4 cur[4], prv[4];
#pragma unroll
        for (int q = 0; q < 4; ++q) { cur[q] = UU4(t, U_RW_LO + jq * 16 + 4 * q); prv[q] = has_prev ? UU4(t - 1, U_RW_LO + jq * 16 + 4 * q) : (f32x4){0.f, 0.f, 0.f, 0.f}; }
#pragma unroll
        for (int q = 0; q < 4; ++q) { const f32x4 m4 = *(const f32x4*)(mu + 768 + jq * 16 + 4 * q); const f32x4 xs = cur[q] + (prv[q] - cur[q]) * m4; const int j = jq * 16 + 4 * q;
            f32x4 o;
            if (j < 32) { o.x = tanhf(xs.x); o.y = tanhf(xs.y); o.z = tanhf(xs.z); o.w = tanhf(xs.w); } else if (j < 64) o = xs; else { o.x = sigmoidf_(xs.x); o.y = sigmoidf_(xs.y); o.z = sigmoidf_(xs.z); o.w = sigmoidf_(xs.w); }
            if (j < 64) *(LAS f32x4*)(LOWA + l * 64 + j) = o; else *(LAS f32x4*)(LOG + l * 64 + j - 64) = o; }
    }
    __syncthreads();
    { const int ch = tid & 255, half = tid >> 8; float* RG = WSP(float, WS_RW_G);
      float gup[64];
      { const f32x4* gp4 = (const f32x4*)(WSP(float, WS_LORA) + (size_t)layer * LORA_PER_LAYER + 16384 + ch * 64);
#pragma unroll
        for (int j = 0; j < 16; ++j) { const f32x4 a = gp4[j]; gup[4 * j] = a.x; gup[4 * j + 1] = a.y; gup[4 * j + 2] = a.z; gup[4 * j + 3] = a.w; } }
#pragma unroll 2
      for (int li = 0; li < 32; ++li) { const int l = half * 32 + li; float g0 = 0.f, g1 = 0.f;
#pragma unroll
          for (int j = 0; j < 16; ++j) { const f32x4 x4 = *(const LAS f32x4*)(LOG + l * 64 + 4 * j); g0 += x4.x * gup[4 * j] + x4.y * gup[4 * j + 1]; g1 += x4.z * gup[4 * j + 2] + x4.w * gup[4 * j + 3]; }
          RG[(size_t)(t0 + l) * 256 + ch] = g0 + g1; } }
    __syncthreads();
    }
    const int b_ = ub >> 6;
#pragma unroll 1
    for (int hh = 0; hh < 4; ++hh) {
        int ch = lane, fr = lane & 15, fq = lane >> 4; asm volatile("" : "+v"(ch), "+v"(fr), "+v"(fq));
        const int tg = wave, cg = hh * 64 + ch; const size_t un = (size_t)(b_ * 4 + hh) * NCH + c;
        float rr[8], k2r[8], vr[8], ar[8], br[8], pl[8];
        RW_REP(1) {
            float wup[32], aup[32];
            { const f32x4* wp4 = (const f32x4*)(WSP(float, WS_LORA) + (size_t)layer * LORA_PER_LAYER + cg * 32); const f32x4* ap4 = (const f32x4*)(WSP(float, WS_LORA) + (size_t)layer * LORA_PER_LAYER + 8192 + cg * 32);
#pragma unroll
              for (int j = 0; j < 8; ++j) { const f32x4 a = wp4[j], b = ap4[j]; wup[4 * j] = a.x; wup[4 * j + 1] = a.y; wup[4 * j + 2] = a.z; wup[4 * j + 3] = a.w; aup[4 * j] = b.x; aup[4 * j + 1] = b.y; aup[4 * j + 2] = b.z; aup[4 * j + 3] = b.w; } }
            const float w0 = KIN(I_RW0)[layer * 256 + cg], a0 = KIN(I_RA0)[layer * 256 + cg], kkc = KIN(I_RKK)[layer * 256 + cg], kac = KIN(I_RKA)[layer * 256 + cg];
            const float mur = mu[cg], muk = mu[256 + cg], muv = mu[512 + cg];
            const int tb = t0 + tg * 8; const bool nop = (c == 0) && (tg == 0);
            float rp = nop ? 0.f : UU(tb - 1, U_RW_R + cg), kp = nop ? 0.f : UU(tb - 1, U_RW_K + cg), vp = nop ? 0.f : UU(tb - 1, U_RW_V + cg);
            float rc[8], kc[8], vc[8];
#pragma unroll
            for (int j = 0; j < 8; ++j) { rc[j] = UU(tb + j, U_RW_R + cg); kc[j] = UU(tb + j, U_RW_K + cg); vc[j] = UU(tb + j, U_RW_V + cg); }
            float* RW = WSP(float, WS_RW);
            float kk[8], al[8], n2[8], run = 0.f;
#pragma unroll
            for (int j = 0; j < 8; ++j) { const int l = tg * 8 + j;
                const float r = rc[j] + (rp - rc[j]) * mur, k = kc[j] + (kp - kc[j]) * muk, v = vc[j] + (vp - vc[j]) * muv; rp = rc[j]; kp = kc[j]; vp = vc[j];
                float wp = w0, ap = a0;
#pragma unroll
                for (int q = 0; q < 8; ++q) { const f32x4 lw4 = *(const LAS f32x4*)(LOWA + l * 64 + 4 * q), la4 = *(const LAS f32x4*)(LOWA + l * 64 + 32 + 4 * q);
                    wp += (lw4.x * wup[4 * q] + lw4.y * wup[4 * q + 1]) + (lw4.z * wup[4 * q + 2] + lw4.w * wup[4 * q + 3]); ap += (la4.x * aup[4 * q] + la4.y * aup[4 * q + 1]) + (la4.z * aup[4 * q + 2] + la4.w * aup[4 * q + 3]); }
                const float w = -softplusf_(-wp) - 0.5f; run += -__expf(w); pl[j] = run; al[j] = sigmoidf_(ap);
                kk[j] = k * kkc; n2[j] = kk[j] * kk[j];
                k2r[j] = k * (1.0f + (al[j] - 1.0f) * kac); rr[j] = r; vr[j] = v;
                float* o = RW + (size_t)(tb + j) * 768 + cg; o[0] = r; o[256] = k2r[j]; o[512] = v; }
#pragma unroll
            for (int i = 0; i < 4; ++i) { const bool hi = (ch & 32) != 0; const float keep = hi ? n2[i + 4] : n2[i], send = hi ? n2[i] : n2[i + 4]; n2[i] = keep + __shfl_xor(send, 32); }
#pragma unroll
            for (int i = 0; i < 2; ++i) { const bool hi = (ch & 16) != 0; const float keep = hi ? n2[i + 2] : n2[i], send = hi ? n2[i] : n2[i + 2]; n2[i] = keep + __shfl_xor(send, 16); }
            { const bool hi = (ch & 8) != 0; const float keep = hi ? n2[1] : n2[0], send = hi ? n2[0] : n2[1]; n2[0] = keep + __shfl_xor(send, 8); }
            n2[0] += __shfl_xor(n2[0], 4); n2[0] += __shfl_xor(n2[0], 2); n2[0] += __shfl_xor(n2[0], 1);
#pragma unroll
            for (int j = 0; j < 8; ++j) { const float tot = __builtin_bit_cast(float, __builtin_amdgcn_readlane(__builtin_bit_cast(int, n2[0]), ((j & 4) ? 32 : 0) + ((j & 2) ? 16 : 0) + ((j & 1) ? 8 : 0)));
                const float kkn = kk[j] / fmaxf(sqrtf(tot), 1e-12f); ar[j] = -kkn; br[j] = kkn * al[j]; }
            TOT[tg * 64 + ch] = run;
        }
        __syncthreads();
        RW_REP(3) {
            float off = 0.f, gC = 0.f;
#pragma unroll
            for (int g = 0; g < 8; ++g) { const float tv = TOT[g * 64 + ch]; gC += tv; if (g < tg) off += tv; }
            float oat[8], obb[8], okb[8], ov[8];
#pragma unroll
            for (int j = 0; j < 8; ++j) { const int l = tg * 8 + j; const float gt = off + pl[j], gm = j > 0 ? off + pl[j - 1] : off;
                const float at = ar[j] * __expf(gm), rt = rr[j] * __expf(gt), en = __expf(-gt), ec = __expf(gC - gt);
                lds_st_bf16(RM(0) + l * 144 + ch * 2, at); lds_st_bf16(RM(1) + l * 144 + ch * 2, rt); lds_st_bf16(RM(2) + l * 144 + ch * 2, br[j] * en); lds_st_bf16(RM(3) + l * 144 + ch * 2, k2r[j] * en);
                oat[j] = at; obb[j] = br[j] * ec; okb[j] = k2r[j] * ec; ov[j] = vr[j]; }
            *(LAS v4u*)(RM(4) + ch * 144 + tg * 16) = pack8(oat); *(LAS v4u*)(RM(5) + ch * 144 + tg * 16) = pack8(obb); *(LAS v4u*)(RM(6) + ch * 144 + tg * 16) = pack8(okb); *(LAS v4u*)(RM(7) + ch * 144 + tg * 16) = pack8(ov);
            if (tg == 0) GAMC[ch] = __expf(gC);
        }
        __syncthreads();
        RW_REP(4) {
            const int which = wave >> 1; const LAS unsigned char* Aop = which < 2 ? RM(0) : RM(1); const LAS unsigned char* Bop = (which & 1) ? RM(3) : RM(2);
#pragma unroll 1
            for (int i2 = 0; i2 < 2; ++i2) { const int tt = 2 * (wave & 1) + i2, t = tt * 16 + fr;
#pragma unroll
                for (int it = 0; it < 4; ++it) { f32x4 acc = {0.f, 0.f, 0.f, 0.f}; acc = mm16(Aop + tt * 16 * 144, 144, Bop + it * 16 * 144, 144, 64, acc, fr, fq);
                    const int i0 = it * 16 + 4 * fq; const int lim = which < 2 ? t : t + 1;
                    const float o0 = (i0 < lim) ? acc[0] : 0.f, o1 = (i0 + 1 < lim) ? acc[1] : 0.f, o2 = (i0 + 2 < lim) ? acc[2] : 0.f, o3 = (i0 + 3 < lim) ? acc[3] : 0.f;
#ifdef RW_CLAMP_AAK
                    float q0 = o0, q1 = o1, q2 = o2, q3 = o3;
                    if (which == 1) { q0 = fabsf(o0) < 1e30f ? o0 : 0.f; q1 = fabsf(o1) < 1e30f ? o1 : 0.f; q2 = fabsf(o2) < 1e30f ? o2 : 0.f; q3 = fabsf(o3) < 1e30f ? o3 : 0.f; }
                    if (which == 0) *(LAS f32x4*)(AAB + t * 64 + i0) = (f32x4){o0, o1, o2, o3};
                    else lds_st_bf16x4(RM(7 + which) + t * 144 + i0 * 2, q0, q1, q2, q3);
                    continue;
#endif
                    if (which == 0) { DBG_STAT(11, o0); DBG_STAT(11, o1); DBG_STAT(11, o2); DBG_STAT(11, o3); } if (which == 1) { DBG_STAT(12, o0); DBG_STAT(12, o1); DBG_STAT(12, o2); DBG_STAT(12, o3); } if (which == 2) { DBG_STAT(13, o0); DBG_STAT(13, o3); } if (which == 3) { DBG_STAT(14, o0); DBG_STAT(14, o3); }
                    if (which == 0) *(LAS f32x4*)(AAB + t * 64 + i0) = (f32x4){o0, o1, o2, o3};
                    else lds_st_bf16x4(RM(7 + which) + t * 144 + i0 * 2, o0, o1, o2, o3); } }
        }
        __syncthreads();
        RW_REP(5) {
#pragma unroll 1
            for (int i2 = 0; i2 < 2; ++i2) { const int idx = wave * 2 + i2, vt = idx >> 2, tt = idx & 3; f32x4 acc = {0.f, 0.f, 0.f, 0.f};
                acc = mm16(RM(7) + vt * 16 * 144, 144, RM(8) + tt * 16 * 144, 144, 64, acc, fr, fq);
                DBG_STAT(15, acc[0]); DBG_STAT(15, acc[1]); DBG_STAT(15, acc[2]); DBG_STAT(15, acc[3]);
                lds_st_bf16x4(RM(0) + (vt * 16 + fr) * 144 + (tt * 16 + 4 * fq) * 2, acc[0], acc[1], acc[2], acc[3]); }
        }
        RW_REP(8) if (wave == 0) {
            float x[64]; f32x4 rowq[16];
#pragma unroll
            for (int t = 0; t < 64; ++t) {
                f32x4 cur[16];
#pragma unroll
                for (int i4 = 0; i4 < (t + 3) / 4; ++i4) cur[i4] = rowq[i4];
                if (t + 1 < 64) {
#pragma unroll
                    for (int i4 = 0; i4 < (t + 4) / 4; ++i4) rowq[i4] = *(const LAS f32x4*)(AAB + (t + 1) * 64 + 4 * i4); }
                float a0 = (t == ch) ? 1.0f : 0.f, a1 = 0.f, a2 = 0.f, a3 = 0.f;
#pragma unroll
                for (int i4 = 0; i4 < (t + 3) / 4; ++i4) { const f32x4 q = cur[i4];
                    a0 += q.x * x[4 * i4]; if (4 * i4 + 1 < t) a1 += q.y * x[4 * i4 + 1]; if (4 * i4 + 2 < t) a2 += q.z * x[4 * i4 + 2]; if (4 * i4 + 3 < t) a3 += q.w * x[4 * i4 + 3]; }
                const float acc = (a0 + a1) + (a2 + a3);
                x[t] = acc; lds_st_bf16(RM(11) + t * 144 + ch * 2, acc); }
        }
        __syncthreads();
        RW_REP(6) {
            const int rt = wave >> 1;
#pragma unroll
            for (int i2 = 0; i2 < 2; ++i2) { const int tt = 2 * (wave & 1) + i2;
                f32x4 acc = {0.f, 0.f, 0.f, 0.f}; acc = mm16(RM(4) + rt * 16 * 144, 144, RM(11) + tt * 16 * 144, 144, 64, acc, fr, fq);
                DBG_STAT(17, acc[0]); DBG_STAT(17, acc[1]); DBG_STAT(17, acc[2]); DBG_STAT(17, acc[3]);
                lds_st_bf16x4(RM(2) + (rt * 16 + fr) * 144 + (tt * 16 + 4 * fq) * 2, acc[0], acc[1], acc[2], acc[3]);
                f32x4 ac2 = {0.f, 0.f, 0.f, 0.f}; ac2 = mm16(RM(0) + rt * 16 * 144, 144, RM(11) + tt * 16 * 144, 144, 64, ac2, fr, fq);
                DBG_STAT(18, ac2[0]); DBG_STAT(18, ac2[1]); DBG_STAT(18, ac2[2]); DBG_STAT(18, ac2[3]);
                lds_st_bf16x4(RM(3) + (rt * 16 + fr) * 144 + (tt * 16 + 4 * fq) * 2, ac2[0], ac2[1], ac2[2], ac2[3]); }
        }
        __syncthreads();
        RW_REP(7) {
            const int which = wave >> 1;
#pragma unroll 1
            for (int i2 = 0; i2 < 2; ++i2) { const int rt = 2 * (wave & 1) + i2, row = rt * 16 + fr;
#pragma unroll
                for (int ct = 0; ct < 4; ++ct) { f32x4 acc = {0.f, 0.f, 0.f, 0.f}; const int c0 = ct * 16 + 4 * fq;
                    if (which == 0) { acc = mm16(RM(9) + rt * 16 * 144, 144, RM(2) + ct * 16 * 144, 144, 64, acc, fr, fq);
                        const v2u rw = *(const LAS v2u*)(RM(1) + row * 144 + c0 * 2);
                        acc[0] += __uint_as_float(rw.x << 16); acc[1] += __uint_as_float(rw.x & 0xffff0000u); acc[2] += __uint_as_float(rw.y << 16); acc[3] += __uint_as_float(rw.y & 0xffff0000u);
                        DBG_STAT(19, acc[0]); DBG_STAT(19, acc[1]); DBG_STAT(19, acc[2]); DBG_STAT(19, acc[3]);
                        v2u o; o.x = cvt_pk_bf16(acc[0], acc[1]); o.y = cvt_pk_bf16(acc[2], acc[3]); *(v2u*)(WSP(bf16, WS_RW_RH) + un * 4096 + row * 64 + c0) = o; }
                    else if (which == 1) {
#ifndef RW_NO_U0
                        acc = mm16(RM(9) + rt * 16 * 144, 144, RM(3) + ct * 16 * 144, 144, 64, acc, fr, fq);
#endif
                        acc = mm16(RM(10) + rt * 16 * 144, 144, RM(7) + ct * 16 * 144, 144, 64, acc, fr, fq);
                        DBG_STAT(20, acc[0]); DBG_STAT(20, acc[1]); DBG_STAT(20, acc[2]); DBG_STAT(20, acc[3]);
                        *(f32x4*)(WSP(float, WS_RW_O0) + un * 4096 + row * 64 + c0) = acc; }
                    else if (which == 2) { acc = mm16(RM(5) + rt * 16 * 144, 144, RM(2) + ct * 16 * 144, 144, 64, acc, fr, fq);
                        const float gd = GAMC[row]; if (row == c0) acc[0] += gd; if (row == c0 + 1) acc[1] += gd; if (row == c0 + 2) acc[2] += gd; if (row == c0 + 3) acc[3] += gd;
                        DBG_STAT(21, acc[0]); DBG_STAT(21, acc[1]); DBG_STAT(21, acc[2]); DBG_STAT(21, acc[3]);
                        v2u o; o.x = cvt_pk_bf16(acc[0], acc[1]); o.y = cvt_pk_bf16(acc[2], acc[3]);
                        *(v2u*)((unsigned char*)(WSP(bf16, WS_RW_GF) + un * 4096) + ((rt * 2 + (ct >> 1)) * 64 + ch) * 16 + (ct & 1) * 8) = o; }
                    else { acc = mm16(RM(3) + rt * 16 * 144, 144, RM(5) + ct * 16 * 144, 144, 64, acc, fr, fq); acc = mm16(RM(7) + rt * 16 * 144, 144, RM(6) + ct * 16 * 144, 144, 64, acc, fr, fq);
                        DBG_STAT(22, acc[0]); DBG_STAT(22, acc[1]); DBG_STAT(22, acc[2]); DBG_STAT(22, acc[3]);
                        *(f32x4*)(WSP(float, WS_RW_HT) + un * 4096 + row * 64 + c0) = acc; } } }
        }
        __syncthreads();
    }
#undef RM
}
__device__ __forceinline__ void rwkv_scan_wave(Frame& F, const Args& A, int wslot) {
    const int lane = F.lane, fr = lane & 15, fq = lane >> 4, bh = wslot >> 2, v0 = (wslot & 3) * 16;
    const bf16* GF = WSP(bf16, WS_RW_GF) + (size_t)bh * NCH * 4096; const float* HT = WSP(float, WS_RW_HT) + (size_t)bh * NCH * 4096 + (size_t)(v0 + fr) * 64 + 4 * fq;
    bf16* PT = WSP(bf16, WS_RW_PT) + (size_t)bh * NCH * 4096 + (size_t)(v0 + fr) * 64 + 4 * fq;
    f32x4 P[4] = {{0.f, 0.f, 0.f, 0.f}, {0.f, 0.f, 0.f, 0.f}, {0.f, 0.f, 0.f, 0.f}, {0.f, 0.f, 0.f, 0.f}};
    bf16x8 ga[4][2]; f32x4 hv[4];
#define RW2_LOAD(cc) do { _Pragma("unroll") for (int m = 0; m < 4; ++m) { hv[m] = *(const f32x4*)(HT + (size_t)(cc) * 4096 + 16 * m); \
        _Pragma("unroll") for (int s = 0; s < 2; ++s) ga[m][s] = *(const bf16x8*)(GF + (size_t)(cc) * 4096 + ((m * 2 + s) * 64 + lane) * 8); } } while (0)
    RW2_LOAD(0);
#pragma unroll 1
    for (int c = 0; c < NCH; ++c) {
        bf16x8 gc[4][2]; f32x4 acc[4];
#pragma unroll
        for (int m = 0; m < 4; ++m) { acc[m] = hv[m]; gc[m][0] = ga[m][0]; gc[m][1] = ga[m][1]; }
        if (c + 1 < NCH) RW2_LOAD(c + 1);
        v4u bs[2];
#pragma unroll
        for (int s = 0; s < 2; ++s) { bs[s].x = cvt_pk_bf16(P[2 * s][0], P[2 * s][1]); bs[s].y = cvt_pk_bf16(P[2 * s][2], P[2 * s][3]); bs[s].z = cvt_pk_bf16(P[2 * s + 1][0], P[2 * s + 1][1]); bs[s].w = cvt_pk_bf16(P[2 * s + 1][2], P[2 * s + 1][3]); }
        *(v2u*)(PT + (size_t)c * 4096) = (v2u){bs[0].x, bs[0].y}; *(v2u*)(PT + (size_t)c * 4096 + 16) = (v2u){bs[0].z, bs[0].w};
        *(v2u*)(PT + (size_t)c * 4096 + 32) = (v2u){bs[1].x, bs[1].y}; *(v2u*)(PT + (size_t)c * 4096 + 48) = (v2u){bs[1].z, bs[1].w};
#pragma unroll
        for (int m = 0; m < 4; ++m) { acc[m] = __builtin_amdgcn_mfma_f32_16x16x32_bf16(gc[m][0], __builtin_bit_cast(bf16x8, bs[0]), acc[m], 0, 0, 0);
            acc[m] = __builtin_amdgcn_mfma_f32_16x16x32_bf16(gc[m][1], __builtin_bit_cast(bf16x8, bs[1]), acc[m], 0, 0, 0); P[m] = acc[m]; DBG_STAT(23, acc[m][0]); DBG_STAT(23, acc[m][1]); DBG_STAT(23, acc[m][2]); DBG_STAT(23, acc[m][3]); }
    }
#undef RW2_LOAD
}
__device__ __forceinline__ void rwkv_stage3(Frame& F, const Args& A, int layer, int ub) {
    const int t0 = ub * 64, b_ = ub >> 6, c = ub & 63, lane = F.lane, wave = F.wave, fr = lane & 15, fq = lane >> 4, hh = wave >> 1;
    const size_t un = (size_t)(b_ * 4 + hh) * NCH + c;
    const bf16* RH = WSP(bf16, WS_RW_RH) + un * 4096; const bf16* PT = WSP(bf16, WS_RW_PT) + un * 4096; const float* O0 = WSP(float, WS_RW_O0) + un * 4096;
    const float* RW = WSP(float, WS_RW); const float* RG = WSP(float, WS_RW_G); bf16* mix = WSP(bf16, WS_MIX);
    const float* lg = KIN(I_RLNG) + layer * 256 + hh * 64; const float* lb = KIN(I_RLNB) + layer * 256 + hh * 64; const float* rk = KIN(I_RRK) + layer * 256 + hh * 64;
    bf16x8 pfr[4][2];
#pragma unroll
    for (int vt = 0; vt < 4; ++vt)
#pragma unroll
        for (int ks = 0; ks < 2; ++ks) pfr[vt][ks] = *(const bf16x8*)(PT + (size_t)(vt * 16 + fr) * 64 + ks * 32 + fq * 8);
#pragma unroll 1
    for (int i = 0; i < 2; ++i) { const int tt = 2 * (wave & 1) + i, tl = tt * 16 + fr, t = t0 + tl;
        const bf16x8 ra0 = *(const bf16x8*)(RH + (size_t)tl * 64 + fq * 8), ra1 = *(const bf16x8*)(RH + (size_t)tl * 64 + 32 + fq * 8);
        f32x4 ov[4]; float sm = 0.f;
#pragma unroll
        for (int vt = 0; vt < 4; ++vt) { f32x4 acc = *(const f32x4*)(O0 + tl * 64 + vt * 16 + 4 * fq);
            acc = __builtin_amdgcn_mfma_f32_16x16x32_bf16(pfr[vt][0], ra0, acc, 0, 0, 0); acc = __builtin_amdgcn_mfma_f32_16x16x32_bf16(pfr[vt][1], ra1, acc, 0, 0, 0);
            ov[vt] = acc; DBG_STAT(24, acc[0]); DBG_STAT(24, acc[1]); DBG_STAT(24, acc[2]); DBG_STAT(24, acc[3]); sm += (acc.x + acc.y) + (acc.z + acc.w); }
        sm += __shfl_xor(sm, 16); sm += __shfl_xor(sm, 32);
        const float mean = sm * (1.f / 64.f); float sq = 0.f;
#pragma unroll
        for (int vt = 0; vt < 4; ++vt) { ov[vt] = ov[vt] - mean; sq += (ov[vt].x * ov[vt].x + ov[vt].y * ov[vt].y) + (ov[vt].z * ov[vt].z + ov[vt].w * ov[vt].w); }
        sq += __shfl_xor(sq, 16); sq += __shfl_xor(sq, 32);
        const float rs = 1.0f / sqrtf(sq * (1.f / 64.f) + RWKV_GN_EPS);
        float bd = 0.f;
#pragma unroll
        for (int q = 0; q < 4; ++q) { const f32x4 r4 = *(const f32x4*)(RW + (size_t)t * 768 + hh * 64 + fq * 16 + 4 * q), k4 = *(const f32x4*)(RW + (size_t)t * 768 + 256 + hh * 64 + fq * 16 + 4 * q), c4 = *(const f32x4*)(rk + fq * 16 + 4 * q);
            bd += (r4.x * k4.x * c4.x + r4.y * k4.y * c4.y) + (r4.z * k4.z * c4.z + r4.w * k4.w * c4.w); }
        bd += __shfl_xor(bd, 16); bd += __shfl_xor(bd, 32);
#pragma unroll
        for (int vt = 0; vt < 4; ++vt) { const int col = vt * 16 + 4 * fq; const f32x4 g4 = *(const f32x4*)(lg + col), b4 = *(const f32x4*)(lb + col);
            const f32x4 v4 = *(const f32x4*)(RW + (size_t)t * 768 + 512 + hh * 64 + col), gg = *(const f32x4*)(RG + (size_t)t * 256 + hh * 64 + col);
            float e0 = (ov[vt].x * rs * g4.x + b4.x + bd * v4.x) * gg.x, e1 = (ov[vt].y * rs * g4.y + b4.y + bd * v4.y) * gg.y, e2 = (ov[vt].z * rs * g4.z + b4.z + bd * v4.z) * gg.z, e3 = (ov[vt].w * rs * g4.w + b4.w + bd * v4.w) * gg.w;
#ifdef RW_SANITIZE
            e0 = (fabsf(e0) < 1e30f) ? e0 : 0.f; e1 = (fabsf(e1) < 1e30f) ? e1 : 0.f; e2 = (fabsf(e2) < 1e30f) ? e2 : 0.f; e3 = (fabsf(e3) < 1e30f) ? e3 : 0.f;
#endif
            v2u o; o.x = cvt_pk_bf16(e0, e1); o.y = cvt_pk_bf16(e2, e3);
            *(v2u*)(mix + (size_t)t * D + 256 + hh * 64 + col) = o; } }
}

__device__ __forceinline__ void scans_elementwise(Frame& F, const Args& A) {
    const int nthr = F.G * 448, gt = F.vcu * 448 + (F.tid - 64);
    constexpr int N_SSD = 16 * 64 * 128, N_GLA = 16 * 32 * 64, N_MLC = 16 * 64 * 64, N_MLN = 16 * 64;
    for (int i = gt; i < N_SSD + N_GLA + N_MLC + N_MLN; i += nthr) {
        if (i < N_SSD) { const int bh = i >> 13, pn = i & 8191; float* base = WSP(float, WS_SSD_ST) + (size_t)bh * NCH * 8192 + pn; const float* dec = WSP(float, WS_SSD_DEC) + bh * NCH; float S = 0.f;
#pragma unroll 1
            for (int c0 = 0; c0 < NCH; c0 += 32) { float x[32], dd[32];
#pragma unroll
                for (int j = 0; j < 32; ++j) { x[j] = base[(size_t)(c0 + j) * 8192]; dd[j] = dec[c0 + j]; }
#pragma unroll
                for (int j = 0; j < 32; ++j) { base[(size_t)(c0 + j) * 8192] = S; S = dd[j] * S + x[j]; } }
        } else if (i < N_SSD + N_GLA) { const int k = i - N_SSD, bh = k >> 11, dv = k & 2047, dd_ = dv >> 6, b = bh >> 2, hh = bh & 3; float* base = WSP(float, WS_GLA_ST) + (size_t)bh * NCH * 2048 + dv; const float* dec = WSP(float, WS_GLA_DEC) + (size_t)b * NCH * 128 + hh * 32 + dd_; float S = 0.f;
#pragma unroll 1
            for (int c0 = 0; c0 < NCH; c0 += 32) { float x[32], dd[32];
#pragma unroll
                for (int j = 0; j < 32; ++j) { x[j] = base[(size_t)(c0 + j) * 2048]; dd[j] = dec[(c0 + j) * 128]; }
#pragma unroll
                for (int j = 0; j < 32; ++j) { base[(size_t)(c0 + j) * 2048] = S; S = dd[j] * S + x[j]; } }
        } else { const int k = i - N_SSD - N_GLA; const bool isn = k >= N_MLC; const int kk = isn ? k - N_MLC : k; const int bh = isn ? (kk >> 6) : (kk >> 12), e = isn ? (kk & 63) : (kk & 4095), str = isn ? 64 : 4096;
            float* base = (isn ? WSP(float, WS_ML_N) : WSP(float, WS_ML_C)) + (size_t)bh * NCH * str + e; const float* bl = WSP(float, WS_ML_BL) + bh * NCH; const float* ml = WSP(float, WS_ML_ML) + bh * NCH; float* mo = WSP(float, WS_ML_M) + bh * NCH;
            float S = 0.f, m = 0.f;
#pragma unroll 1
            for (int c0 = 0; c0 < NCH; c0 += 32) { float x[32], b8[32], m8[32];
#pragma unroll
                for (int j = 0; j < 32; ++j) { x[j] = base[(size_t)(c0 + j) * str]; b8[j] = bl[c0 + j]; m8[j] = ml[c0 + j]; }
#pragma unroll
                for (int j = 0; j < 32; ++j) { const float mn = fmaxf(b8[j] + m, m8[j]); const float so = __expf(b8[j] + m - mn), sn = __expf(m8[j] - mn);
                    base[(size_t)(c0 + j) * str] = S; if (!isn && e == 0) mo[c0 + j] = m; S = so * S + sn * x[j]; m = mn; } }
        }
    }
}
#ifndef MK_PER_PHASE_LAUNCH
#define MK_PER_PHASE_LAUNCH 0
#endif
#ifndef PH_MASK
#define PH_MASK 0xFFF
#endif
#ifndef ST_MASK
#define ST_MASK 0xF
#endif
#define ST_ON(k) (((ST_MASK) >> (k)) & 1)
#ifndef DUP_MASK
#define DUP_MASK 0
#endif
#define DUP_N(k) ((((DUP_MASK) >> (k)) & 1) ? 2 : 1)
#ifndef ST_DUP
#define ST_DUP 0
#endif
#define ST_REP(ty) ((((ST_DUP) >> (ty)) & 1) ? 2 : 1)
#define PH_ON(k) (((PH_MASK) >> (k)) & 1)
constexpr int PH_PER_LAYER = 11, N_PHASES = 1 + DEPTH * PH_PER_LAYER;
__global__ void __launch_bounds__(NWAVES * 64, 2) fwd_kernel(Args args) {
    extern __shared__ __attribute__((aligned(16))) unsigned char lds[];
    Frame F;
    F.lds = (LAS unsigned char*)lds;
    F.MISC = (volatile LAS unsigned*)(F.lds + MISC_OFF);
    F.tid = threadIdx.x; F.lane = F.tid & 63; F.wave = __builtin_amdgcn_readfirstlane(F.tid >> 6);
    F.G = gridDim.x; { const int bx = blockIdx.x; F.vcu = (F.G % 8 == 0) ? (bx % 8) * (F.G / 8) + bx / 8 : bx; }
    F.ka = (karg_t)__builtin_amdgcn_kernarg_segment_ptr(); F.ws = args.ws; F.ctl = (gu32*)(args.ws + WS_CTL); F.out = args.out;
    for (int i = F.tid; i < 256; i += NWAVES * 64) F.MISC[i] = 0u;
    __syncthreads();
    const int lo = args.ph_lo, hi = args.ph_hi;
#ifdef DBG_TSEL
    if (blockIdx.x == 0 && threadIdx.x == 0) __hip_atomic_store(F.ctl + CW_DBG + 15, (unsigned)__builtin_amdgcn_s_memrealtime(), RLX_AGENT);
#endif
    XcdBarrier bar; bar.bar = (unsigned*)(F.ctl + CW_BAR); bar.x = 0; bar.st = nullptr;
    if (hi - lo > 1) bar = xcd_barrier_post((unsigned*)(F.ctl + CW_BAR), F.MISC + MW_BAR);
#define IN_(k) (lo <= (k) && (k) < hi)
#ifdef DBG_TSEL
#ifndef DBG_TQ
#define DBG_TQ 50.0f
#endif
#define TSTAMP(k) do { if (blockIdx.x == 0 && threadIdx.x == 0) __hip_atomic_store(F.ctl + CW_DBG + 16 + ((k) == 11 ? 0 : 1 + layer_ * PH_PER_LAYER + (k)), (unsigned)__builtin_amdgcn_s_memrealtime(), RLX_AGENT); } while (0)
#else
#define TSTAMP(k) do { } while (0)
#endif
#ifdef BAR_DUP
#define SEAM(k) do { if (IN_(k) && IN_((k) + 1)) { xcd_barrier(bar); xcd_barrier(bar); } } while (0)
#else
#define SEAM(k) do { if (IN_(k) && IN_((k) + 1)) xcd_barrier(bar); } while (0)
#endif

    if (PH_ON(11) && IN_(0)) { for (int rep_ = 0; rep_ < DUP_N(11); ++rep_) { frame_refresh(F); p0_prologue(F, args); } SEAM(0); { const int layer_ = 0; TSTAMP(11); (void)layer_; } }
#pragma unroll 1
    for (int layer = 0; layer < DEPTH; ++layer) {
        const int pb = 1 + layer * PH_PER_LAYER; const int layer_ = layer; (void)layer_;
        if (PH_ON(0) && IN_(pb + 0)) { for (int rep_ = 0; rep_ < DUP_N(0); ++rep_) { frame_refresh(F);
            { pg8::DenseSched S; S.init(WSP(bf16, WS_XB), WSP(bf16, WS_WIN_T) + (size_t)layer * NUP * D, T, NUP, D, F.G, (int)blockIdx.x);
              pg8::EpiB16 E{WSP(bf16, WS_U), NUP, nullptr, 0.f};
              pg8::gemm_phase<pg8::EpiB16, pg8::DenseSched>(F.lds, F.tid, S, E); }
            { pg8::DenseSched S; S.init(WSP(bf16, WS_PB) + (size_t)layer * T * 256, WSP(bf16, WS_WPP_T) + (size_t)layer * D * 256, T, D, 256, F.G, (int)blockIdx.x);
              pg8::EpiB16 E{WSP(bf16, WS_PE), D, nullptr, 0.f};
              pg8::gemm_phase<pg8::EpiB16, pg8::DenseSched>(F.lds, F.tid, S, E); }
            } SEAM(pb + 0); TSTAMP(0);
        }
        if (PH_ON(1) && IN_(pb + 1)) { for (int rep_ = 0; rep_ < DUP_N(1); ++rep_) { frame_refresh(F);
            for (int un = F.vcu; un < 1024; un += F.G) { frame_refresh(F); const int ty = un >> 8, r = un & 255, b = r >> 6, c = r & 63;
                if (ty == 0) { ssd_stage1(F, args, layer, b, c); if (ST_DUP & 1) ssd_stage1(F, args, layer, b, c); } else if (ty == 1) { gla_stage1(F, args, layer, b, c); if (ST_DUP & 2) gla_stage1(F, args, layer, b, c); } else if (ty == 2) { mlstm_stage1(F, args, layer, b, c); if (ST_DUP & 4) mlstm_stage1(F, args, layer, b, c); } else { rwkv_stage1(F, args, layer, r); if (ST_DUP & 8) rwkv_stage1(F, args, layer, r); } }
            } SEAM(pb + 1); TSTAMP(1);
        }
        if (PH_ON(2) && IN_(pb + 2)) { for (int rep_ = 0; rep_ < DUP_N(2); ++rep_) { frame_refresh(F);
            if (F.wave == 0) { for (int ws_ = F.vcu; ws_ < 64; ws_ += F.G) rwkv_scan_wave(F, args, ws_); }
            else if (rep_ == 0) scans_elementwise(F, args);
            } SEAM(pb + 2); TSTAMP(2);
        }
        if (PH_ON(3) && IN_(pb + 3)) { for (int rep_ = 0; rep_ < DUP_N(3); ++rep_) { frame_refresh(F);
            for (int un = F.vcu; un < 1024; un += F.G) { frame_refresh(F); const int ty = un >> 8, r = un & 255, b = r >> 6, c = r & 63;
                if (ty == 0) { ssd_stage3(F, args, layer, b, c); if (ST_DUP & 16) ssd_stage3(F, args, layer, b, c); } else if (ty == 1) { gla_stage3(F, args, layer, b, c); if (ST_DUP & 32) gla_stage3(F, args, layer, b, c); } else if (ty == 2) { mlstm_stage3(F, args, layer, b, c); if (ST_DUP & 64) mlstm_stage3(F, args, layer, b, c); } else { rwkv_stage3(F, args, layer, r); if (ST_DUP & 128) rwkv_stage3(F, args, layer, r); } }
            } SEAM(pb + 3); TSTAMP(3);
        }
        if (PH_ON(4) && IN_(pb + 4)) { for (int rep_ = 0; rep_ < DUP_N(4); ++rep_) { frame_refresh(F);
            pg8::DenseSched S; S.init(WSP(bf16, WS_MIX), WSP(bf16, WS_WOUT_T) + (size_t)layer * D * D, T, D, D, F.G, (int)blockIdx.x);
            pg8::EpiB16 E{WSP(bf16, WS_Y1), D, WSP(bf16, WS_XB), DN_ALPHA};
            pg8::gemm_phase<pg8::EpiB16, pg8::DenseSched>(F.lds, F.tid, S, E);
            } SEAM(pb + 4); TSTAMP(4);
        }
        if (PH_ON(5) && IN_(pb + 5)) { if (DUP_N(5) == 2) { frame_refresh(F); p6_ln1_router<true>(F, args, layer); } frame_refresh(F); p6_ln1_router<false>(F, args, layer); SEAM(pb + 5); TSTAMP(5); }
        if (PH_ON(6) && IN_(pb + 6)) { for (int rep_ = 0; rep_ < DUP_N(6); ++rep_) { frame_refresh(F);
            moe_build_pfx(F, args, layer, 8);
            pg8::Moe1Sched S; S.O.pfx = F.MISC + MW_PFX; S.O.NT = 8; S.O.G = F.G; S.O.c = (int)blockIdx.x; S.sdest = WSP(int, WS_SDEST);
            if (MOE_FP8) { S.X = WSP(unsigned char, WS_X1Q); S.W = WSP(unsigned char, WS_WGU_Q) + (size_t)layer * NE * 2048 * D; S.K = D / 2; S.hstepB = (size_t)1024 * D; }
            else { S.X = WSP(unsigned char, WS_X1B); S.W = WSP(unsigned char, WS_WGU_T) + (size_t)layer * NE * 2048 * D * 2; S.K = D; S.hstepB = (size_t)1024 * D * 2; }
            pg8::EpiMoe1 E{WSP(bf16, WS_ABUF), KIN(I_BGU) + (size_t)layer * NE * 2048, WSP(unsigned char, WS_ABUFQ)};
            pg8::gemm_phase<pg8::EpiMoe1, pg8::Moe1Sched>(F.lds, F.tid, S, E);
            } SEAM(pb + 6); TSTAMP(6);
        }
        if (PH_ON(7) && IN_(pb + 7)) { for (int rep_ = 0; rep_ < DUP_N(7); ++rep_) { frame_refresh(F);
            moe_build_pfx(F, args, layer, 4);
            pg8::Moe2Sched S; S.O.pfx = F.MISC + MW_PFX; S.O.NT = 4; S.O.G = F.G; S.O.c = (int)blockIdx.x; if (MOE2_FP8) { S.Ab = WSP(unsigned char, WS_ABUFQ); S.W = WSP(unsigned char, WS_WDN_Q) + (size_t)layer * NE * D * D; S.K = D / 2; S.hstepB = (size_t)128 * D; }
            else { S.Ab = WSP(unsigned char, WS_ABUF); S.W = WSP(unsigned char, WS_WDN_T) + (size_t)layer * NE * D * D * 2; S.K = D; S.hstepB = (size_t)128 * D * 2; }
            pg8::EpiMoe2 E{WSP(bf16, WS_YBUF), KIN(I_BDN) + (size_t)layer * NE * D, WSP(int, WS_SDEST), WSP(float, WS_SGATE)};
            pg8::gemm_phase<pg8::EpiMoe2, pg8::Moe2Sched>(F.lds, F.tid, S, E);
            } SEAM(pb + 7); TSTAMP(7);
        }
        if (PH_ON(8) && IN_(pb + 8)) { for (int rep_ = 0; rep_ < DUP_N(8); ++rep_) { frame_refresh(F); p9_combine(F, args); } SEAM(pb + 8); TSTAMP(8); }
        if (PH_ON(9) && IN_(pb + 9)) { for (int rep_ = 0; rep_ < DUP_N(9); ++rep_) { frame_refresh(F);
            pg8::DenseSched S; S.init(WSP(bf16, WS_HB), WSP(bf16, WS_WPG_T) + (size_t)layer * D * D, T, D, D, F.G, (int)blockIdx.x);
            pg8::EpiPle E{WSP(bf16, WS_H2), WSP(bf16, WS_HB), WSP(bf16, WS_PE)};
            pg8::gemm_phase<pg8::EpiPle, pg8::DenseSched>(F.lds, F.tid, S, E);
            } SEAM(pb + 9); TSTAMP(9);
        }
        if (PH_ON(10) && IN_(pb + 10)) { for (int rep_ = 0; rep_ < DUP_N(10); ++rep_) { frame_refresh(F); p11_ln2(F, args, layer); } SEAM(pb + 10); TSTAMP(10); }
    }
#ifdef DBG_TSEL
    if (hi - lo > 1) { xcd_barrier(bar);
        unsigned ticks = 0u;
        if (DBG_TSEL == 11) ticks = __hip_atomic_load(F.ctl + CW_DBG + 16, RLX_AGENT) - __hip_atomic_load(F.ctl + CW_DBG + 15, RLX_AGENT);
        else for (int l = 0; l < DEPTH; ++l) { const int pi = 1 + l * PH_PER_LAYER + DBG_TSEL; ticks += __hip_atomic_load(F.ctl + CW_DBG + 16 + pi, RLX_AGENT) - __hip_atomic_load(F.ctl + CW_DBG + 16 + pi - 1, RLX_AGENT); }
        const float us = floorf((float)ticks * 0.01f / DBG_TQ) * DBG_TQ; const float code = sqrtf(us * 0.05f);
        for (size_t i = (size_t)blockIdx.x * 512 + threadIdx.x; i < (size_t)T * D; i += (size_t)gridDim.x * 512) F.out[i] = code; }
#endif
#ifdef DBG_SEL
    if (hi - lo > 1) { xcd_barrier(bar);
        const unsigned mx = __hip_atomic_load(F.ctl + CW_DBG, RLX_AGENT), nf = __hip_atomic_load(F.ctl + CW_DBG + 1, RLX_AGENT);
        float code;
        { const float m = __uint_as_float(mx); int b = (m > 0.f) ? (int)floorf(log10f(m)) + 30 : 0; b = b < 0 ? 0 : (b > 60 ? 60 : b); if (nf) b += 100; code = sqrtf(10.0f * (float)(b + 1)); }
        for (size_t i = (size_t)blockIdx.x * 512 + threadIdx.x; i < (size_t)T * D; i += (size_t)gridDim.x * 512) F.out[i] = code; }
#endif
#undef IN_
#undef SEAM
}

extern "C" void kernel_launch(void* const* d_in, const int* in_sizes, int n_in, void* d_out, int out_size, void* d_ws, size_t ws_size, hipStream_t stream) {
    static int grid = 0;
    if (grid == 0) {
        if (n_in != N_IN || out_size != T * D || ws_size < WS_END) { fprintf(stderr, "kernel_launch: unexpected shapes (n_in %d, out %d, ws %zu < %zu); nothing launched\n", n_in, out_size, ws_size, (size_t)WS_END); grid = -1; return; }
        int dev = 0, cus = 0, per_cu = 0;
        if (hipGetDevice(&dev) != hipSuccess || hipDeviceGetAttribute(&cus, hipDeviceAttributeMultiprocessorCount, dev) != hipSuccess) { grid = -1; return; }
        if (hipFuncSetAttribute((const void*)fwd_kernel, hipFuncAttributeMaxDynamicSharedMemorySize, LDS_BYTES) != hipSuccess) { fprintf(stderr, "kernel_launch: hipFuncSetAttribute failed\n"); grid = -1; return; }
        if (hipOccupancyMaxActiveBlocksPerMultiprocessor(&per_cu, (const void*)fwd_kernel, NWAVES * 64, LDS_BYTES) != hipSuccess || per_cu < 1) { fprintf(stderr, "kernel_launch: occupancy query says %d blocks per CU\n", per_cu); }
        (void)hipGetLastError();
        grid = cus;
    }
    if (grid < 0) return;
    (void)hipMemsetAsync((char*)d_ws + WS_CTL, 0, CTL_ZERO_BYTES, stream);
    Args a{};
    for (int i = 0; i < N_IN; ++i) a.in[i] = (const float*)d_in[i];
    a.out = (float*)d_out; a.ws = (unsigned char*)d_ws;
#if MK_PER_PHASE_LAUNCH
    for (int ph = 0; ph < N_PHASES; ++ph) { a.ph_lo = ph; a.ph_hi = ph + 1; hipLaunchKernelGGL(fwd_kernel, dim3(grid), dim3(NWAVES * 64), LDS_BYTES, stream, a); }
#else
    a.ph_lo = 0; a.ph_hi = N_PHASES; hipLaunchKernelGGL(fwd_kernel, dim3(grid), dim3(NWAVES * 64), LDS_BYTES, stream, a);
#endif
    const hipError_t le = hipPeekAtLastError();
    if (le != hipSuccess) fprintf(stderr, "kernel_launch: launch failed: %s\n", hipGetErrorName(le));
}
```

```cpp
#include <hip/hip_runtime.h>
#include <cstdio>
#include <cstdint>

#define GAS __attribute__((address_space(1)))
#define LAS __attribute__((address_space(3)))
typedef unsigned short bf16;
typedef unsigned v4u __attribute__((ext_vector_type(4)));
typedef unsigned v2u __attribute__((ext_vector_type(2)));
typedef float f32x4 __attribute__((ext_vector_type(4)));
typedef float f32x2 __attribute__((ext_vector_type(2)));
typedef short bf16x8 __attribute__((ext_vector_type(8)));
typedef int v4i_t __attribute__((ext_vector_type(4)));
typedef int v8i_t __attribute__((ext_vector_type(8)));
typedef GAS unsigned gu32;
#define RLX_AGENT __ATOMIC_RELAXED, __HIP_MEMORY_SCOPE_AGENT
#define LDS_WAIT() asm volatile("s_waitcnt lgkmcnt(0)" ::: "memory")
#define VM_WAIT() asm volatile("s_waitcnt vmcnt(0)" ::: "memory")

constexpr int NWAVES = 8;
constexpr int DEPTH = 4, BATCH = 4, SEQ = 4096, D = 1024, T = BATCH * SEQ;
constexpr int NU = 3484, NUP = 3584;
constexpr int NE = 32, TOPK = 4, ECAP = 16384;
constexpr int NCH = SEQ / 64;
constexpr int U_SSD_Z = 0, U_SSD_X = 256, U_SSD_B = 512, U_SSD_C = 640, U_SSD_DT = 768;
constexpr int U_RW = 772, U_RW_R = 772, U_RW_K = 1028, U_RW_V = 1284, U_RW_LO = 1540;
constexpr int U_GL_Q = 1668, U_GL_K = 1796, U_GL_V = 1924, U_GL_G = 2180, U_GL_OG = 2196;
constexpr int U_ML_Q = 2452, U_ML_K = 2708, U_ML_V = 2964, U_ML_I = 3220, U_ML_F = 3224, U_ML_O = 3228;
constexpr float DN_ALPHA = 1.6817928305074290f;
constexpr float LN_EPS = 1e-5f, NORM_EPS = 1e-5f, RWKV_GN_EPS = 64e-5f;

enum { I_X = 0, I_P, I_WIN, I_WOUT, I_LN1G, I_LN1B, I_SCW, I_SCB, I_SALOG, I_SDTB, I_SD, I_SNG,
       I_RMU, I_RW0, I_RWUP, I_RA0, I_RAUP, I_RGUP, I_RKK, I_RKA, I_RRK, I_RLNG, I_RLNB,
       I_GGUP, I_GGB, I_GNG, I_MCW, I_MCB, I_MIB, I_MFB, I_MNG,
       I_RTW, I_RTB, I_WGU, I_BGU, I_WDN, I_BDN, I_PGW, I_PPJ, I_LN2G, I_LN2B, N_IN };

constexpr size_t MiB = 1u << 20;
constexpr size_t WS_CTL = 0, CTL_ZERO_BYTES = 1 * MiB;
constexpr size_t WS_WIN_T = 2 * MiB;
constexpr size_t WS_WOUT_T = WS_WIN_T + (size_t)DEPTH * NUP * D * 2;
constexpr size_t WS_WGU_T = WS_WOUT_T + (size_t)DEPTH * D * D * 2;
constexpr size_t WS_WDN_T = WS_WGU_T + (size_t)DEPTH * NE * 2048 * D * 2;
constexpr size_t WS_WPG_T = WS_WDN_T + (size_t)DEPTH * NE * D * D * 2;
constexpr size_t WS_WPP_T = WS_WPG_T + (size_t)DEPTH * D * D * 2;
constexpr size_t WS_RWT = WS_WPP_T + (size_t)DEPTH * D * 256 * 2;
constexpr size_t WS_PB = WS_RWT + (size_t)DEPTH * NE * D * 4;
constexpr size_t WS_XB = WS_PB + (size_t)DEPTH * T * 256 * 2;
constexpr size_t WS_U = WS_XB + (size_t)T * D * 2;
constexpr size_t WS_PE = WS_U + (size_t)T * NUP * 2;
constexpr size_t WS_MIX = WS_PE + (size_t)T * D * 4;
constexpr size_t WS_Y1 = WS_MIX + (size_t)T * D * 2;
constexpr size_t WS_X1 = WS_Y1 + (size_t)T * D * 4;
constexpr size_t WS_X1B = WS_X1 + (size_t)T * D * 4;
constexpr size_t WS_SDEST = WS_X1B + (size_t)T * D * 2;
constexpr size_t WS_SGATE = WS_SDEST + (size_t)NE * ECAP * 4;
constexpr size_t WS_ABUF = WS_SGATE + (size_t)NE * ECAP * 4;
constexpr size_t WS_YBUF = WS_ABUF + (size_t)NE * ECAP * D * 2;
constexpr size_t WS_H = WS_YBUF + (size_t)T * 4 * D * 2;
constexpr size_t WS_HB = WS_H + (size_t)T * D * 4;
constexpr size_t WS_H2 = WS_HB + (size_t)T * D * 2;
constexpr size_t WS_SSD_ST = WS_H2 + (size_t)T * D * 4;
constexpr size_t WS_SSD_DEC = WS_SSD_ST + (size_t)16 * NCH * 64 * 128 * 4;
constexpr size_t WS_GLA_ST = WS_SSD_DEC + 16 * NCH * 4;
constexpr size_t WS_GLA_DEC = WS_GLA_ST + (size_t)16 * NCH * 32 * 64 * 4;
constexpr size_t WS_ML_C = WS_GLA_DEC + (size_t)4 * NCH * 128 * 4;
constexpr size_t WS_ML_N = WS_ML_C + (size_t)16 * NCH * 64 * 64 * 4;
constexpr size_t WS_ML_BL = WS_ML_N + (size_t)16 * NCH * 64 * 4;
constexpr size_t WS_ML_ML = WS_ML_BL + 16 * NCH * 4;
constexpr size_t WS_ML_M = WS_ML_ML + 16 * NCH * 4;
constexpr size_t WS_RW = WS_ML_M + 16 * NCH * 4;
constexpr size_t WS_RW_G = WS_RW + (size_t)T * 3 * 256 * 4;
constexpr size_t WS_RW_RH = WS_RW_G + (size_t)T * 256 * 4;
constexpr size_t WS_RW_O0 = WS_RW_RH + (size_t)1024 * 4096 * 2;
constexpr size_t WS_RW_GF = WS_RW_O0 + (size_t)1024 * 4096 * 4;
constexpr size_t WS_RW_HT = WS_RW_GF + (size_t)1024 * 4096 * 2;
constexpr size_t WS_RW_PT = WS_RW_HT + (size_t)1024 * 4096 * 4;
constexpr size_t WS_LORA = WS_RW_PT + (size_t)1024 * 4096 * 2;
constexpr int LORA_PER_LAYER = 8192 + 8192 + 16384 + 2048;
constexpr size_t WS_WGU_Q = WS_LORA + (size_t)DEPTH * LORA_PER_LAYER * 4;
constexpr size_t WS_WDN_Q = WS_WGU_Q + (size_t)DEPTH * NE * 2048 * D;
constexpr size_t WS_X1Q = WS_WDN_Q + (size_t)DEPTH * NE * D * D;
constexpr size_t WS_ABUFQ = WS_X1Q + (size_t)T * D;
constexpr size_t WS_END = WS_ABUFQ + (size_t)NE * ECAP * D;
#ifndef MOE_FP8
#define MOE_FP8 1
#endif
#ifndef MOE2_FP8
#define MOE2_FP8 1
#endif
constexpr int CW_BAR = 4096;
constexpr int CW_DBG = 32768;
constexpr int CW_CNT = 16384;

constexpr int RING_BYTES = 147456;
constexpr int MISC_OFF = RING_BYTES;
constexpr int LDS_BYTES = RING_BYTES + 1024;
constexpr int MW_BAR = 8, MW_LCNT = 32, MW_LBASE = 64, MW_PFX = 96, MW_CNT = 136, MW_GAMC = 168;

typedef __bf16 bf16x2_t __attribute__((ext_vector_type(2)));
__device__ __forceinline__ unsigned cvt_pk_bf16(float lo, float hi) { const f32x2 v = {lo, hi}; const bf16x2_t b = __builtin_convertvector(v, bf16x2_t); return __builtin_bit_cast(unsigned, b); }
__device__ __forceinline__ unsigned cvt4_fp8(float a, float b, float c, float d) { int w = 0; w = __builtin_amdgcn_cvt_pk_fp8_f32(a, b, w, false); w = __builtin_amdgcn_cvt_pk_fp8_f32(c, d, w, true); return (unsigned)w; }
__device__ __forceinline__ float bf2f(unsigned short b) { return __uint_as_float(((unsigned)b) << 16); }
__device__ __forceinline__ float sigmoidf_(float x) { return 1.0f / (1.0f + __expf(-x)); }
__device__ __forceinline__ float siluf_(float x) { return x / (1.0f + __expf(-x)); }
__device__ __forceinline__ float softplusf_(float x) { return fmaxf(x, 0.f) + log1pf(__expf(-fabsf(x))); }
__device__ __forceinline__ float logsigmoidf_(float x) { return fminf(x, 0.f) - log1pf(__expf(-fabsf(x))); }
__device__ __forceinline__ int lane_now() { int l = (int)__builtin_amdgcn_mbcnt_hi(~0u, __builtin_amdgcn_mbcnt_lo(~0u, 0u)); asm volatile("" : "+v"(l)); return l; }
__device__ __forceinline__ float my_shfl_idx(float v, int src) { return __builtin_bit_cast(float, __builtin_amdgcn_ds_bpermute(src << 2, __builtin_bit_cast(int, v))); }
__device__ __forceinline__ int my_shfl_idx(int v, int src) { return __builtin_amdgcn_ds_bpermute(src << 2, v); }
template <class V> __device__ __forceinline__ V my_shfl_xor(V v, int o) { return my_shfl_idx(v, lane_now() ^ o); }
template <class V> __device__ __forceinline__ V my_shfl_up(V v, int o) { const int l = lane_now(); return my_shfl_idx(v, l >= o ? l - o : l); }
#define __shfl_xor(v, o) my_shfl_xor(v, o)
#define __shfl_up(v, o) my_shfl_up(v, o)
#define __shfl(v, s) my_shfl_idx(v, s)
__device__ __forceinline__ float wave_sum(float v) {
#pragma unroll
    for (int o = 1; o < 64; o <<= 1) v += __shfl_xor(v, o);
    return v;
}
__device__ __forceinline__ float wave_max(float v) {
#pragma unroll
    for (int o = 1; o < 64; o <<= 1) v = fmaxf(v, __shfl_xor(v, o));
    return v;
}
__device__ __forceinline__ float wave_scan_add(float v, int lane) {
#pragma unroll
    for (int o = 1; o < 64; o <<= 1) { const float t = __shfl_up(v, o); if (lane >= o) v += t; }
    return v;
}
__device__ __forceinline__ float wave_scan_max(float v, int lane) {
#pragma unroll
    for (int o = 1; o < 64; o <<= 1) { const float t = __shfl_up(v, o); if (lane >= o) v = fmaxf(v, t); }
    return v;
}
__device__ __forceinline__ f32x4 mm16(const LAS unsigned char* A, int lda, const LAS unsigned char* B, int ldb, int K, f32x4 acc, int fr, int fq) {
    const LAS unsigned char* ap = A + fr * lda + fq * 16; const LAS unsigned char* bp = B + fr * ldb + fq * 16;
    for (int k = 0; k < K; k += 32) {
        const bf16x8 a = *(const LAS bf16x8*)(ap + k * 2); const bf16x8 b = *(const LAS bf16x8*)(bp + k * 2);
        acc = __builtin_amdgcn_mfma_f32_16x16x32_bf16(b, a, acc, 0, 0, 0);
    }
    return acc;
}
__device__ __forceinline__ f32x4 mm16_gB(const LAS unsigned char* A, int lda, const float* B, int ldb, int K, f32x4 acc, int fr, int fq) {
    const LAS unsigned char* ap = A + fr * lda + fq * 16; const float* bp = B + (size_t)fr * ldb + fq * 8;
    for (int k = 0; k < K; k += 32) {
        const bf16x8 a = *(const LAS bf16x8*)(ap + k * 2);
        const f32x4 b0 = *(const f32x4*)(bp + k), b1 = *(const f32x4*)(bp + k + 4);
        v4u bw; bw.x = cvt_pk_bf16(b0.x, b0.y); bw.y = cvt_pk_bf16(b0.z, b0.w); bw.z = cvt_pk_bf16(b1.x, b1.y); bw.w = cvt_pk_bf16(b1.z, b1.w);
        const bf16x8 b = __builtin_bit_cast(bf16x8, bw);
        acc = __builtin_amdgcn_mfma_f32_16x16x32_bf16(b, a, acc, 0, 0, 0);
    }
    return acc;
}
__device__ __forceinline__ f32x4 mm16_gAB(const bf16* A, int lda, const bf16* B, int ldb, int K, f32x4 acc, int fr, int fq) {
    const bf16* ap = A + (size_t)fr * lda + fq * 8; const bf16* bp = B + (size_t)fr * ldb + fq * 8;
    for (int k = 0; k < K; k += 32) { const bf16x8 a = *(const bf16x8*)(ap + k), b = *(const bf16x8*)(bp + k); acc = __builtin_amdgcn_mfma_f32_16x16x32_bf16(b, a, acc, 0, 0, 0); }
    return acc;
}
__device__ __forceinline__ bf16x8 ldfrag_f32(const float* p) { const f32x4 b0 = *(const f32x4*)p, b1 = *(const f32x4*)(p + 4);
    v4u bw; bw.x = cvt_pk_bf16(b0.x, b0.y); bw.y = cvt_pk_bf16(b0.z, b0.w); bw.z = cvt_pk_bf16(b1.x, b1.y); bw.w = cvt_pk_bf16(b1.z, b1.w); return __builtin_bit_cast(bf16x8, bw); }
template <int NK> __device__ __forceinline__ f32x4 mm16_rB(const LAS unsigned char* A, int lda, const bf16x8 (&b)[NK], f32x4 acc, int fr, int fq) {
    const LAS unsigned char* ap = A + fr * lda + fq * 16;
#pragma unroll
    for (int k = 0; k < NK; ++k) { const bf16x8 a = *(const LAS bf16x8*)(ap + k * 64); acc = __builtin_amdgcn_mfma_f32_16x16x32_bf16(b[k], a, acc, 0, 0, 0); }
    return acc;
}
__device__ __forceinline__ v4u pack8(const float (&v)[8]) { v4u o; o.x = cvt_pk_bf16(v[0], v[1]); o.y = cvt_pk_bf16(v[2], v[3]); o.z = cvt_pk_bf16(v[4], v[5]); o.w = cvt_pk_bf16(v[6], v[7]); return o; }

#define XB_TMO      128
#define XB_XCNT(j)  (256  + 64 * (j))
#define XB_XSUB(j)  (1280 + 64 * (j))
#define XB_XGEN(j)  (2304 + 64 * (j))
#define XB_TOP      3328
#define XB_TOPGEN   3392
#define XCD_BAR_WORDS 3456
#define XB_SPIN_CAP (1u << 18)
__device__ __forceinline__ unsigned xb_ld(unsigned* p)              { return __hip_atomic_load(p, __ATOMIC_RELAXED, __HIP_MEMORY_SCOPE_AGENT); }
__device__ __forceinline__ unsigned xb_add(unsigned* p, unsigned v) { return __hip_atomic_fetch_add(p, v, __ATOMIC_RELAXED, __HIP_MEMORY_SCOPE_AGENT); }
__device__ __forceinline__ unsigned xb_xcc_id() { return (unsigned)__builtin_amdgcn_s_getreg((3 << 11) | 20) & 0xFu; }
#define XB_SPIN(cond, bar) do { unsigned _sp = 0; while (cond) { __builtin_amdgcn_s_sleep(1); \
    if ((++_sp & 255u) == 0u) { if (xb_ld(&(bar)[XB_TMO])) break; if (_sp > XB_SPIN_CAP) { atomicAdd(&(bar)[XB_TMO], 1u); break; } } } } while (0)
struct XcdBarrier { unsigned* bar; unsigned x; volatile LAS unsigned* st; };
__device__ __forceinline__ XcdBarrier xcd_barrier_post(unsigned* bar, volatile LAS unsigned* st) {
    XcdBarrier b; b.bar = bar; b.x = xb_xcc_id(); b.st = st;
    if (threadIdx.x == 0) (void)xb_add(&bar[XB_XCNT(b.x)], 1u);
    return b;
}
__device__ __forceinline__ void xcd_barrier_complete(unsigned* bar, unsigned x, unsigned& nloc, unsigned& nx) {
    const unsigned G = gridDim.x * gridDim.y * gridDim.z;
    unsigned sum, cnt, mine, sp = 0u;
    for (;;) {
        sum = 0u; cnt = 0u; mine = 0u;
#pragma unroll
        for (unsigned j = 0; j < 16; ++j) { const unsigned c = xb_ld(&bar[XB_XCNT(j)]); sum += c; cnt += (c > 0u) ? 1u : 0u; mine = (j == x) ? c : mine; }
        if (sum == G) break;
        __builtin_amdgcn_s_sleep(1);
        if ((++sp & 255u) == 0u) { if (xb_ld(&bar[XB_TMO])) break; if (sp > XB_SPIN_CAP) { atomicAdd(&bar[XB_TMO], 1u); break; } }
    }
    nloc = mine > 0u ? mine : 1u; nx = cnt > 0u ? cnt : 1u;
}
__device__ __forceinline__ void xcd_barrier(const XcdBarrier& b) {
    asm volatile("s_waitcnt vmcnt(0)" ::: "memory");
    __syncthreads();
    if (threadIdx.x == 0) {
        unsigned* bar = b.bar;
        __builtin_amdgcn_s_waitcnt(0);
        unsigned nloc = b.st[0], nx = b.st[1];
        if (nloc == 0u) { xcd_barrier_complete(bar, b.x, nloc, nx); b.st[0] = nloc; b.st[1] = nx; }
        const unsigned old = xb_add(&bar[XB_XSUB(b.x)], 1u);
        const unsigned gen = old / nloc;
        if (old + 1u == (gen + 1u) * nloc) {
            __builtin_amdgcn_fence(__ATOMIC_RELEASE, "agent");
            asm volatile("s_waitcnt vmcnt(0)" ::: "memory");
            const unsigned og = xb_add(&bar[XB_TOP], 1u);
            const unsigned tg = og / nx;
            if (og + 1u == (tg + 1u) * nx) xb_add(&bar[XB_TOPGEN], 1u);
            else XB_SPIN(xb_ld(&bar[XB_TOPGEN]) == tg, bar);
            __builtin_amdgcn_fence(__ATOMIC_ACQUIRE, "agent");
            xb_add(&bar[XB_XGEN(b.x)], 1u);
            asm volatile("s_waitcnt vmcnt(0)" ::: "memory");
        } else {
            XB_SPIN(xb_ld(&bar[XB_XGEN(b.x)]) == gen, bar);
            __builtin_amdgcn_fence(__ATOMIC_ACQUIRE, "agent");
            asm volatile("s_waitcnt vmcnt(0)" ::: "memory");
        }
    }
    __syncthreads();
}

namespace pg8 {
constexpr int BM = 256, BK = 64, HALF = 128, HTB = HALF * BK * 2, STAGE_BYTES = 8 * HTB, NXCD = 8, WGM = 8;
__host__ __device__ __forceinline__ int lds_byte(int r, int c) { const int st = (r >> 4) * 2 + (c >> 5), rr = r & 15, cc = c & 31, ob = rr * 64 + cc * 2; return st * 1024 + (ob ^ (((ob >> 9) & 1) << 5)); }
__host__ __device__ __forceinline__ void stage_rc(int b, int& R, int& C) { const int st = b / 1024, sb = b % 1024, swz = sb ^ (((sb >> 9) & 1) << 5); R = (st >> 1) * 16 + swz / 64; C = (st & 1) * 32 + (swz % 64) / 2; }
__host__ __device__ __forceinline__ int perm32(int rho) { const int n = rho >> 4, i = rho & 15; return 8 * (i >> 2) + 4 * n + (i & 3); }

template <class Epi, class Sched>
__device__ __forceinline__ void gemm_phase(LAS unsigned char* lds, const int tid, const Sched& S, const Epi& E) {
    const int wid = __builtin_amdgcn_readfirstlane(tid >> 6), lane = tid & 63, wr = wid >> 2, wc = wid & 3, fr = lane & 15, fq = lane >> 4;
    const int K = S.K, nt = K / BK;
    unsigned voffB[2];
#pragma unroll
    for (int i = 0; i < 2; ++i) { int R, C; stage_rc(tid * 16 + i * 8192, R, C); const int Rb = Epi::PERM ? ((R & ~31) + perm32(R & 31)) : R; voffB[i] = (unsigned)(Rb * K + C) * 2u; }
    const size_t kstep = (size_t)(BK * 2);
    const size_t hstepB = S.hstepB;
    const unsigned ldsw = (unsigned)wid * 1024u;
    constexpr bool F8 = Sched::FP8;
    const int aoff = F8 ? lds_byte(wr * 64 + fr, fq * 16) : lds_byte(wr * 64 + fr, fq * 8), boff = F8 ? lds_byte(wc * 32 + fr, fq * 16) : lds_byte(wc * 32 + fr, fq * 8);
#define PG8_SA(b, h) (((b) * 2 + (h)) * HTB)
#define PG8_SB(b, h) ((4 + (b) * 2 + (h)) * HTB)
#define PG8_STAGE_B(bufoff, gbase) do { _Pragma("unroll") for (int _i = 0; _i < 2; ++_i) \
        __builtin_amdgcn_global_load_lds((const unsigned*)((const char*)(gbase) + voffB[_i]), (LAS unsigned*)(lds + (bufoff) + ldsw + _i * 8192), 16, 0, 0); } while (0)
#define PG8_STAGE_A(bufoff, gbase, v0, v1) do { \
        __builtin_amdgcn_global_load_lds((const unsigned*)((const char*)(gbase) + (v0)), (LAS unsigned*)(lds + (bufoff) + ldsw), 16, 0, 0); \
        __builtin_amdgcn_global_load_lds((const unsigned*)((const char*)(gbase) + (v1)), (LAS unsigned*)(lds + (bufoff) + ldsw + 8192), 16, 0, 0); } while (0)
#define PG8_FOFF(k) (F8 ? (k) * 16 : (k) * 1024)
#define PG8_LDA(dst, b, h) do { _Pragma("unroll") for (int m = 0; m < 4; ++m) { if constexpr (F8) dst##8[m] = *(const LAS v8i_t*)(lds + PG8_SA(b, h) + aoff + m * 2048); \
        else { _Pragma("unroll") for (int k = 0; k < 2; ++k) dst[m][k] = *(const LAS bf16x8*)(lds + PG8_SA(b, h) + aoff + m * 2048 + k * 1024); } } } while (0)
#define PG8_LDB(dst, b, h) do { _Pragma("unroll") for (int n = 0; n < 2; ++n) { if constexpr (F8) dst##8[n] = *(const LAS v8i_t*)(lds + PG8_SB(b, h) + boff + n * 2048); \
        else { _Pragma("unroll") for (int k = 0; k < 2; ++k) dst[n][k] = *(const LAS bf16x8*)(lds + PG8_SB(b, h) + boff + n * 2048 + k * 1024); } } } while (0)
#define PG8_CAT(x) __builtin_shufflevector(__builtin_bit_cast(v4i_t, x[0]), __builtin_bit_cast(v4i_t, x[1]), 0, 1, 2, 3, 4, 5, 6, 7)
#define PG8_MMA(ai, bj, At, Bt) do { __builtin_amdgcn_s_setprio(1); _Pragma("unroll") for (int m = 0; m < 4; ++m) _Pragma("unroll") for (int n = 0; n < 2; ++n) { \
        if constexpr (F8) acc[ai][bj][m][n] = __builtin_amdgcn_mfma_scale_f32_16x16x128_f8f6f4(Bt##8[n], At##8[m], acc[ai][bj][m][n], 0, 0, 0, S.scaleB, 0, S.scaleA); \
        else { _Pragma("unroll") for (int k = 0; k < 2; ++k) acc[ai][bj][m][n] = __builtin_amdgcn_mfma_f32_16x16x32_bf16(Bt[n][k], At[m][k], acc[ai][bj][m][n], 0, 0, 0); } } __builtin_amdgcn_s_setprio(0); } while (0)
#define PG8_WAIT_V(n) asm volatile("s_waitcnt vmcnt(" #n ")" ::: "memory")
#define PG8_WAIT_L(n) asm volatile("s_waitcnt lgkmcnt(" #n ")" ::: "memory")
#define PG8_BAR __builtin_amdgcn_s_barrier()
#define PG8_SCHED __builtin_amdgcn_sched_barrier(0)
    typename Sched::Unit cur, nxt; int ui = 0;
    if (!S.next(0, cur)) return;
    f32x4 acc[2][2][4][2];
#pragma unroll
    for (int a = 0; a < 2; ++a)
#pragma unroll
        for (int b = 0; b < 2; ++b)
#pragma unroll
            for (int m = 0; m < 4; ++m)
#pragma unroll
                for (int n = 0; n < 2; ++n) acc[a][b][m][n] = (f32x4){0.f, 0.f, 0.f, 0.f};
    bf16x8 At[4][2], B0[2][2], B1[2][2]; v8i_t At8[4], B08[2], B18[2];
    constexpr bool GA = Sched::GATHER;
    const size_t hstepA = GA ? (size_t)0 : (size_t)HALF * K * 2;
    unsigned vA[2][2];
    S.a_off(cur, tid, vA);
#define PG8_STAGE_AH(bufoff, base, vv, h) PG8_STAGE_A(bufoff, ((base) + (h) * hstepA), vv[GA ? (h) : 0][0], vv[GA ? (h) : 0][1])
    const char* cA = S.a_base(cur); const char* cB = S.b_base(cur);
    PG8_STAGE_B(PG8_SB(0, 0), cB); PG8_STAGE_B(PG8_SB(0, 1), cB + hstepB); PG8_STAGE_AH(PG8_SA(0, 0), cA, vA, 0); PG8_STAGE_AH(PG8_SA(0, 1), cA, vA, 1);
    if (wr == 1) PG8_BAR;
    PG8_WAIT_V(2); PG8_BAR;
    PG8_STAGE_B(PG8_SB(1, 0), cB + kstep); PG8_STAGE_AH(PG8_SA(1, 0), cA + kstep, vA, 0); PG8_STAGE_B(PG8_SB(1, 1), cB + hstepB + kstep);
    PG8_WAIT_V(6); PG8_BAR;
    for (;;) {
        const bool has_next = S.next(ui + 1, nxt);
        const char* nA = cA; const char* nB = cB;
        if (has_next) { nA = S.a_base(nxt); nB = S.b_base(nxt); }
        for (int t = 0; t < nt; t += 2) {
            const bool last = (t == nt - 2);
            const char* a1 = cA + (size_t)(t + 1) * kstep;
            const char* a2 = last ? nA : cA + (size_t)(t + 2) * kstep; const char* b2 = last ? nB : cB + (size_t)(t + 2) * kstep;
            const char* a3 = a2 + kstep; const char* b3 = b2 + kstep;
            PG8_LDB(B0, 0, 0); PG8_LDB(B1, 0, 1); PG8_SCHED; PG8_LDA(At, 0, 0); PG8_STAGE_AH(PG8_SA(1, 1), a1, vA, 1);
            if constexpr (GA) { if (last && has_next) S.a_off(nxt, tid, vA); }
            PG8_WAIT_V(8); PG8_WAIT_L(0); PG8_BAR; PG8_MMA(0, 0, At, B0); PG8_MMA(0, 1, At, B1); PG8_BAR; PG8_SCHED;
            PG8_LDA(At, 0, 1); PG8_STAGE_B(PG8_SB(0, 0), b2); PG8_STAGE_B(PG8_SB(0, 1), b2 + hstepB); PG8_STAGE_AH(PG8_SA(0, 0), a2, vA, 0);
            PG8_WAIT_V(8); PG8_WAIT_L(0); PG8_BAR; PG8_MMA(1, 0, At, B0); PG8_MMA(1, 1, At, B1); PG8_BAR; PG8_SCHED;
            PG8_LDB(B0, 1, 0); PG8_LDB(B1, 1, 1); PG8_SCHED; PG8_LDA(At, 1, 0); PG8_STAGE_AH(PG8_SA(0, 1), a2, vA, 1);
            PG8_WAIT_V(8); PG8_WAIT_L(0); PG8_BAR; PG8_MMA(0, 0, At, B0); PG8_MMA(0, 1, At, B1); PG8_BAR; PG8_SCHED;
            PG8_LDA(At, 1, 1); PG8_STAGE_B(PG8_SB(1, 0), b3); PG8_STAGE_B(PG8_SB(1, 1), b3 + hstepB); PG8_STAGE_AH(PG8_SA(1, 0), a3, vA, 0);
            PG8_WAIT_V(8); PG8_WAIT_L(0); PG8_BAR; PG8_MMA(1, 0, At, B0); PG8_MMA(1, 1, At, B1); PG8_BAR; PG8_SCHED;
        }
        if (wr == 0) PG8_BAR;
        { int fr_ = fr, fq_ = fq; asm volatile("" : "+v"(fr_), "+v"(fq_)); E(acc, cur, wr, wc, fr_, fq_); }
        if (!has_next) break;
#pragma unroll
        for (int a = 0; a < 2; ++a)
#pragma unroll
            for (int b = 0; b < 2; ++b)
#pragma unroll
                for (int m = 0; m < 4; ++m)
#pragma unroll
                    for (int n = 0; n < 2; ++n) acc[a][b][m][n] = (f32x4){0.f, 0.f, 0.f, 0.f};
        cur = nxt; cA = nA; cB = nB; ++ui;
        if (wr == 1) PG8_BAR;
    }
    PG8_WAIT_V(0);
    PG8_BAR;
#undef PG8_SA
#undef PG8_SB
#undef PG8_STAGE_A
#undef PG8_STAGE_AH
#undef PG8_STAGE_B
#undef PG8_LDA
#undef PG8_LDB
#undef PG8_MMA
#undef PG8_CAT
#undef PG8_FOFF
#undef PG8_WAIT_V
#undef PG8_WAIT_L
#undef PG8_BAR
#undef PG8_SCHED
}
}
struct Args { const float* in[N_IN]; float* out; unsigned char* ws; int ph_lo, ph_hi; };
typedef const __attribute__((address_space(4))) unsigned long long* karg_t;
struct Frame {
    karg_t ka;
    LAS unsigned char* lds;
    volatile LAS unsigned* MISC;
    gu32* ctl;
    unsigned char* ws;
    float* out;
    int tid, lane, wave, vcu, G;
};
#define WSP(T_, off) ((T_*)(F.ws + (off)))
#define KIN(k) ((const float*)F.ka[(k)])
#ifdef DBG_SEL
#define DBG_STAT(k, val) do { const float _v = (val); if ((k) == DBG_SEL) { if (fabsf(_v) < 3e38f) atomicMax((unsigned*)(F.ctl + CW_DBG), __float_as_uint(fabsf(_v))); else atomicAdd((unsigned*)(F.ctl + CW_DBG + 1), 1u); } } while (0)
#else
#define DBG_STAT(k, val) do { } while (0)
#endif
template <class P> __device__ __forceinline__ P launder_uniform(P p) {
    unsigned lo = (unsigned)(unsigned long long)p, hi = (unsigned)((unsigned long long)p >> 32);
    asm volatile("" : "+v"(lo), "+v"(hi));
    lo = __builtin_amdgcn_readfirstlane(lo); hi = __builtin_amdgcn_readfirstlane(hi);
    return (P)(((unsigned long long)hi << 32) | lo);
}
__device__ __forceinline__ void frame_refresh(Frame& F) {
    int t = F.tid; asm volatile("" : "+v"(t)); F.tid = t; F.lane = t & 63; F.wave = __builtin_amdgcn_readfirstlane(t >> 6);
    F.ws = launder_uniform(F.ws); F.ctl = (gu32*)(F.ws + WS_CTL);
    F.out = launder_uniform(F.out);
    F.ka = launder_uniform(F.ka);
}

namespace pg8 {
struct DenseSched {
    static constexpr bool GATHER = false, FP8 = false; static constexpr int scaleA = 0, scaleB = 0;
    struct Unit { int pm, pn; };
    const bf16* A; const bf16* Bt; int K; size_t hstepB; int nM, nN, nwg, G, c;
    __device__ __forceinline__ void init(const bf16* A_, const bf16* Bt_, int M, int N, int K_, int G_, int c_) { A = A_; Bt = Bt_; K = K_; hstepB = (size_t)HALF * K_ * 2; nM = M / BM; nN = N / BM; nwg = nM * nN; G = G_; c = c_; }
    __device__ __forceinline__ bool next(int i, Unit& u) const {
        const long L = (long)i * G + c; if (L >= nwg) return false;
        int wgid = (int)L; { const int q = nwg / NXCD, r = nwg % NXCD, xcd = wgid % NXCD, off = wgid / NXCD; wgid = (xcd < r ? xcd * (q + 1) : r * (q + 1) + (xcd - r) * q) + off; }
        const int nig = WGM * nN, gid = wgid / nig, fm = gid * WGM, gsz = (nM - fm) < WGM ? (nM - fm) : WGM;
        u.pm = fm + ((wgid % nig) % gsz); u.pn = (wgid % nig) / gsz; return true;
    }
    __device__ __forceinline__ const char* a_base(const Unit& u) const { return (const char*)A + (size_t)u.pm * BM * K * 2; }
    __device__ __forceinline__ const char* b_base(const Unit& u) const { return (const char*)Bt + (size_t)u.pn * BM * K * 2; }
    __device__ __forceinline__ void a_off(const Unit&, int tid, unsigned (&v)[2][2]) const {
#pragma unroll
        for (int i = 0; i < 2; ++i) { int R, C; stage_rc(tid * 16 + i * 8192, R, C); v[0][i] = (unsigned)(R * K + C) * 2u; v[1][i] = v[0][i]; }
    }
};
struct MoeUnit { int e, mt, nt, cnt; };
struct MoeOrder {
    const volatile LAS unsigned* pfx;
    int NT, G, c;
    __device__ __forceinline__ bool decode(int i, MoeUnit& u) const {
        const int nwg = (int)pfx[32]; const long L = (long)i * G + c; if (L >= nwg) return false;
        int wgid = (int)L; { const int q = nwg / NXCD, r = nwg % NXCD, xcd = wgid % NXCD, off = wgid / NXCD; wgid = (xcd < r ? xcd * (q + 1) : r * (q + 1) + (xcd - r) * q) + off; }
        int e = 0;
#pragma unroll 1
        for (int j = 1; j < 32; ++j) e += ((int)pfx[j] <= wgid) ? 1 : 0;
        const int j = wgid - (int)pfx[e];
        u.e = e; u.mt = j / NT; u.nt = j % NT; u.cnt = (int)pfx[40 + e]; return true;
    }
};
struct Moe1Sched {
    static constexpr bool GATHER = true, FP8 = (MOE_FP8 != 0); static constexpr int EB = FP8 ? 1 : 2; static constexpr int scaleA = 0x7F7F7F7F, scaleB = 0x7A7A7A7A;
    typedef MoeUnit Unit;
    MoeOrder O; const unsigned char* X; const unsigned char* W; const int* sdest; int K; size_t hstepB;
    __device__ __forceinline__ bool next(int i, Unit& u) const { return O.decode(i, u); }
    __device__ __forceinline__ const char* a_base(const Unit&) const { return (const char*)X; }
    __device__ __forceinline__ const char* b_base(const Unit& u) const { return (const char*)W + ((size_t)u.e * 2048 + (size_t)u.nt * 128) * 1024 * EB; }
    __device__ __forceinline__ void a_off(const Unit& u, int tid, unsigned (&v)[2][2]) const {
#pragma unroll
        for (int i = 0; i < 2; ++i) { int R, C; stage_rc(tid * 16 + i * 8192, R, C);
#pragma unroll
            for (int h = 0; h < 2; ++h) { const int slot = u.mt * 256 + h * HALF + R; int tok = 0; if (slot < u.cnt) tok = sdest[u.e * ECAP + slot] >> 2; v[h][i] = (unsigned)(tok * 1024 * EB + C * 2); } }
    }
};
struct Moe2Sched {
    static constexpr bool GATHER = true, FP8 = (MOE2_FP8 != 0); static constexpr int EB = FP8 ? 1 : 2; static constexpr int scaleA = 0x7F7F7F7F, scaleB = 0x79797979;
    typedef MoeUnit Unit;
    MoeOrder O; const unsigned char* Ab; const unsigned char* W; int K; size_t hstepB;
    __device__ __forceinline__ bool next(int i, Unit& u) const { return O.decode(i, u); }
    __device__ __forceinline__ const char* a_base(const Unit& u) const { return (const char*)Ab + ((size_t)u.e * ECAP + (size_t)u.mt * 256) * 1024 * EB; }
    __device__ __forceinline__ const char* b_base(const Unit& u) const { return (const char*)W + ((size_t)u.e * 1024 + (size_t)u.nt * 256) * 1024 * EB; }
    __device__ __forceinline__ void a_off(const Unit&, int tid, unsigned (&v)[2][2]) const {
        int t_ = tid; asm volatile("" : "+v"(t_));
#pragma unroll
        for (int i = 0; i < 2; ++i) { int R, C; stage_rc(t_ * 16 + i * 8192, R, C); v[0][i] = (unsigned)(R * 1024 * EB + C * 2); v[1][i] = v[0][i] + (unsigned)(HALF * 1024 * EB); }
    }
};

__device__ __forceinline__ void unpack8(const v4u w, f32x4& a, f32x4& b) {
    a = (f32x4){__uint_as_float(w.x << 16), __uint_as_float(w.x & 0xffff0000u), __uint_as_float(w.y << 16), __uint_as_float(w.y & 0xffff0000u)};
    b = (f32x4){__uint_as_float(w.z << 16), __uint_as_float(w.z & 0xffff0000u), __uint_as_float(w.w << 16), __uint_as_float(w.w & 0xffff0000u)}; }
struct EpiF32 {
    static constexpr bool PERM = false;
    float* C; int ldc; const float* base; float alpha;
    __device__ __forceinline__ void operator()(const f32x4 (&acc)[2][2][4][2], const DenseSched::Unit& u, int wr, int wc, int fr, int fq) const {
        const int row0 = u.pm * BM + wr * 64 + fr, col0 = u.pn * BM + wc * 32 + 4 * fq;
#pragma unroll
        for (int ai = 0; ai < 2; ++ai)
#pragma unroll
            for (int m = 0; m < 4; ++m) { const size_t ro = (size_t)(row0 + ai * HALF + m * 16) * ldc + col0;
#pragma unroll
                for (int bj = 0; bj < 2; ++bj)
#pragma unroll
                    for (int n = 0; n < 2; ++n) { f32x4 v = acc[ai][bj][m][n];
                        if (base) { const f32x4 b = *(const f32x4*)(base + ro + bj * HALF + n * 16); v = v + b * alpha; }
                        *(f32x4*)(C + ro + bj * HALF + n * 16) = v; } }
    }
};
struct EpiB16 {
    static constexpr bool PERM = true;
    bf16* O; int ldc; const bf16* base; float alpha;
    __device__ __forceinline__ void operator()(const f32x4 (&acc)[2][2][4][2], const DenseSched::Unit& u, int wr, int wc, int fr, int fq) const {
        const int row0 = u.pm * BM + wr * 64 + fr, col0 = u.pn * BM + wc * 32 + 8 * fq;
#pragma unroll
        for (int ai = 0; ai < 2; ++ai) {
            v4u bw[4][2];
            if (base) {
#pragma unroll
                for (int m = 0; m < 4; ++m)
#pragma unroll
                    for (int bj = 0; bj < 2; ++bj) bw[m][bj] = *(const v4u*)(base + (size_t)(row0 + ai * HALF + m * 16) * ldc + col0 + bj * HALF); }
#pragma unroll
            for (int m = 0; m < 4; ++m) { bf16* rowp = O + (size_t)(row0 + ai * HALF + m * 16) * ldc + col0;
#pragma unroll
                for (int bj = 0; bj < 2; ++bj) { f32x4 v0 = acc[ai][bj][m][0], v1 = acc[ai][bj][m][1];
                    if (base) { f32x4 b0, b1; unpack8(bw[m][bj], b0, b1); v0 = v0 + b0 * alpha; v1 = v1 + b1 * alpha; }
                    v4u w; w.x = cvt_pk_bf16(v0[0], v0[1]); w.y = cvt_pk_bf16(v0[2], v0[3]); w.z = cvt_pk_bf16(v1[0], v1[1]); w.w = cvt_pk_bf16(v1[2], v1[3]);
                    *(v4u*)(rowp + bj * HALF) = w; } } }
    }
};
struct EpiPle {
    static constexpr bool PERM = true;
    bf16* C; const bf16* hb; const bf16* pe;
    __device__ __forceinline__ void operator()(const f32x4 (&acc)[2][2][4][2], const DenseSched::Unit& u, int wr, int wc, int fr, int fq) const {
        const int row0 = u.pm * BM + wr * 64 + fr, col0 = u.pn * BM + wc * 32 + 8 * fq;
#pragma unroll
        for (int ai = 0; ai < 2; ++ai) {
            v4u hw[4][2], pw[4][2];
#pragma unroll
            for (int m = 0; m < 4; ++m)
#pragma unroll
                for (int bj = 0; bj < 2; ++bj) { const size_t ro = (size_t)(row0 + ai * HALF + m * 16) * 1024 + col0 + bj * HALF; hw[m][bj] = *(const v4u*)(hb + ro); pw[m][bj] = *(const v4u*)(pe + ro); }
#pragma unroll
            for (int m = 0; m < 4; ++m)
#pragma unroll
                for (int bj = 0; bj < 2; ++bj) { const size_t ro = (size_t)(row0 + ai * HALF + m * 16) * 1024 + col0 + bj * HALF;
                    f32x4 h0, h1, p0, p1; unpack8(hw[m][bj], h0, h1); unpack8(pw[m][bj], p0, p1); const f32x4 a0 = acc[ai][bj][m][0], a1 = acc[ai][bj][m][1];
                    f32x4 o0, o1;
#pragma unroll
                    for (int j = 0; j < 4; ++j) { o0[j] = h0[j] + sigmoidf_(a0[j]) * p0[j]; o1[j] = h1[j] + sigmoidf_(a1[j]) * p1[j]; }
                    v4u w; w.x = cvt_pk_bf16(o0[0], o0[1]); w.y = cvt_pk_bf16(o0[2], o0[3]); w.z = cvt_pk_bf16(o1[0], o1[1]); w.w = cvt_pk_bf16(o1[2], o1[3]);
                    *(v4u*)(C + ro) = w; } }
    }
};
struct EpiMoe1 {
    static constexpr bool PERM = true;
    bf16* Ab; const float* bgu; unsigned char* AbQ;
    __device__ __forceinline__ void operator()(const f32x4 (&acc)[2][2][4][2], const MoeUnit& u, int wr, int wc, int fr, int fq) const {
        const int col0 = u.nt * 128 + wc * 32 + 8 * fq;
        const float* bg = bgu + (size_t)u.e * 2048 + col0;
        const f32x4 bg0 = *(const f32x4*)(bg), bg1 = *(const f32x4*)(bg + 4), bl0 = *(const f32x4*)(bg + 1024), bl1 = *(const f32x4*)(bg + 1028);
#pragma unroll
        for (int ai = 0; ai < 2; ++ai)
#pragma unroll
            for (int m = 0; m < 4; ++m) { const int r = ai * HALF + wr * 64 + m * 16 + fr;
                bf16* rowp = Ab + ((size_t)u.e * ECAP + (size_t)u.mt * 256 + r) * 1024 + col0;
                float o[8];
#pragma unroll
                for (int n = 0; n < 2; ++n) { const f32x4 g4 = acc[ai][0][m][n] + (n ? bg1 : bg0), l4 = acc[ai][1][m][n] + (n ? bl1 : bl0);
#pragma unroll
                    for (int j = 0; j < 4; ++j) { const float g = fminf(g4[j], 7.0f), l = fminf(fmaxf(l4[j], -7.0f), 7.0f); o[n * 4 + j] = (l + 1.0f) * g * sigmoidf_(1.702f * g); } }
                if constexpr (MOE2_FP8) { v2u q; q.x = cvt4_fp8(o[0], o[1], o[2], o[3]); q.y = cvt4_fp8(o[4], o[5], o[6], o[7]); *(v2u*)((unsigned char*)AbQ + ((size_t)u.e * ECAP + (size_t)u.mt * 256 + r) * 1024 + col0) = q; }
                else *(v4u*)rowp = pack8(o); }
    }
};
struct EpiMoe2 {
    static constexpr bool PERM = true;
    bf16* Y; const float* bdn; const int* sdest; const float* sgate;
    __device__ __forceinline__ void operator()(const f32x4 (&acc)[2][2][4][2], const MoeUnit& u, int wr, int wc, int fr, int fq) const {
        const int col0 = u.nt * 256 + wc * 32 + 8 * fq;
        const float* bp = bdn + (size_t)u.e * 1024 + col0;
#pragma unroll
        for (int ai = 0; ai < 2; ++ai) {
            f32x4 bv[2][2];
#pragma unroll
            for (int bj = 0; bj < 2; ++bj)
#pragma unroll
                for (int n = 0; n < 2; ++n) bv[bj][n] = *(const f32x4*)(bp + bj * HALF + 4 * n);
            int dest[4]; float gate[4];
#pragma unroll
            for (int m = 0; m < 4; ++m) { const int slot = u.mt * 256 + ai * HALF + wr * 64 + m * 16 + fr; const bool ok = slot < u.cnt; const int si = u.e * ECAP + (ok ? slot : 0);
                dest[m] = ok ? sdest[si] : T * 4; gate[m] = sgate[si]; }
#pragma unroll
            for (int m = 0; m < 4; ++m) {
                { const float g = gate[m]; bf16* rowp = Y + (size_t)dest[m] * 1024 + col0;
#pragma unroll
                    for (int bj = 0; bj < 2; ++bj) { const f32x4 v0 = (acc[ai][bj][m][0] + bv[bj][0]) * g, v1 = (acc[ai][bj][m][1] + bv[bj][1]) * g;
                        v4u w; w.x = cvt_pk_bf16(v0[0], v0[1]); w.y = cvt_pk_bf16(v0[2], v0[3]); w.z = cvt_pk_bf16(v1[0], v1[1]); w.w = cvt_pk_bf16(v1[2], v1[3]);
                        *(v4u*)(rowp + bj * HALF) = w; } } } }
    }
};
}

__device__ __forceinline__ void p0_transpose_item(const float* W, int K, int N, int nblk, bf16* WT, int item, int lane) {
    const int kb = item / nblk, nb = item % nblk, k0 = 64 * kb, n = 64 * nb + lane;
    const bool ok = n < N; const float* src = W + (size_t)k0 * N + (ok ? n : 0);
    float x[64];
#pragma unroll
    for (int j = 0; j < 64; ++j) x[j] = __builtin_nontemporal_load(src + (size_t)j * N);
    bf16* dst = WT + (size_t)n * K + k0;
#pragma unroll
    for (int q = 0; q < 8; ++q) { v4u o; o.x = cvt_pk_bf16(x[8 * q], x[8 * q + 1]); o.y = cvt_pk_bf16(x[8 * q + 2], x[8 * q + 3]); o.z = cvt_pk_bf16(x[8 * q + 4], x[8 * q + 5]); o.w = cvt_pk_bf16(x[8 * q + 6], x[8 * q + 7]);
        if (!ok) o = (v4u){0u, 0u, 0u, 0u};
        *(v4u*)(dst + 8 * q) = o; }
}
__device__ __forceinline__ void cvt_rows(const float* src, bf16* dst, size_t n8, size_t i0, size_t stride) {
    for (size_t i = i0; i < n8; i += stride) { const f32x4 a = *(const f32x4*)(src + i * 8), b = *(const f32x4*)(src + i * 8 + 4);
        v4u o; o.x = cvt_pk_bf16(a.x, a.y); o.y = cvt_pk_bf16(a.z, a.w); o.z = cvt_pk_bf16(b.x, b.y); o.w = cvt_pk_bf16(b.z, b.w); *(v4u*)(dst + i * 8) = o; }
}
__device__ __forceinline__ void p0_prologue(Frame& F, const Args& A) {
    const int gw = F.vcu * NWAVES + F.wave, NGW = F.G * NWAVES;
    constexpr int I_IN = 16 * (NUP / 64), I_OUT = 16 * 16, I_GU = 16 * 32, I_DN = 16 * 16, I_PG = 16 * 16, I_PP = 4 * 16;
    constexpr int PER_LAYER = I_IN + I_OUT + NE * I_GU + NE * I_DN + I_PG + I_PP;
#pragma unroll 1
    for (int it = gw; it < DEPTH * PER_LAYER; it += NGW) {
        const int l = it / PER_LAYER; int r = it % PER_LAYER;
        const float* W; bf16* WT; int K = D, N = D, nblk = 16;
        if (r < I_IN) { W = KIN(I_WIN) + (size_t)l * D * NU; WT = WSP(bf16, WS_WIN_T) + (size_t)l * NUP * D; N = NU; nblk = NUP / 64; }
        else if ((r -= I_IN) < I_OUT) { W = KIN(I_WOUT) + (size_t)l * D * D; WT = WSP(bf16, WS_WOUT_T) + (size_t)l * D * D; }
        else if ((r -= I_OUT) < NE * I_GU) { if (MOE_FP8) continue; const int e = r / I_GU; r %= I_GU; W = KIN(I_WGU) + ((size_t)l * NE + e) * D * 2048; WT = WSP(bf16, WS_WGU_T) + ((size_t)l * NE + e) * 2048 * D; N = 2048; nblk = 32; }
        else if ((r -= NE * I_GU) < NE * I_DN) { if (MOE2_FP8) continue; const int e = r / I_DN; r %= I_DN; W = KIN(I_WDN) + ((size_t)l * NE + e) * D * D; WT = WSP(bf16, WS_WDN_T) + ((size_t)l * NE + e) * D * D; }
        else if ((r -= NE * I_DN) < I_PG) { W = KIN(I_PGW) + (size_t)l * D * D; WT = WSP(bf16, WS_WPG_T) + (size_t)l * D * D; }
        else { r -= I_PG; W = KIN(I_PPJ) + (size_t)l * 256 * D; WT = WSP(bf16, WS_WPP_T) + (size_t)l * D * 256; K = 256; }
        p0_transpose_item(W, K, N, nblk, WT, r, F.lane);
    }
#if MOE_FP8
    constexpr int Q_GU = 16 * 32, Q_DN = 16 * 16, Q_PER_LAYER = NE * (Q_GU + Q_DN);
#pragma unroll 1
    for (int it = gw; it < DEPTH * Q_PER_LAYER; it += NGW) {
        const int l = it / Q_PER_LAYER; int r = it % Q_PER_LAYER; const float* W; unsigned char* WQ; int N; float sc;
        if (r < NE * Q_GU) { const int e = r / Q_GU; r %= Q_GU; W = KIN(I_WGU) + ((size_t)l * NE + e) * D * 2048; WQ = WSP(unsigned char, WS_WGU_Q) + ((size_t)l * NE + e) * 2048 * D; N = 2048; sc = 32.0f; }
        else { if (!MOE2_FP8) continue; r -= NE * Q_GU; const int e = r / Q_DN; r %= Q_DN; W = KIN(I_WDN) + ((size_t)l * NE + e) * D * D; WQ = WSP(unsigned char, WS_WDN_Q) + ((size_t)l * NE + e) * D * D; N = D; sc = 64.0f; }
        const int nblk = N / 64, kb = r / nblk, nb = r % nblk, k0 = 64 * kb, n = 64 * nb + F.lane;
        const float* src = W + (size_t)k0 * N + n; float x[64];
#pragma unroll
        for (int j = 0; j < 64; ++j) x[j] = __builtin_nontemporal_load(src + (size_t)j * N) * sc;
        unsigned char* dst = WQ + (size_t)n * D + k0;
#pragma unroll
        for (int q = 0; q < 4; ++q) { v4u o; o.x = cvt4_fp8(x[16 * q], x[16 * q + 1], x[16 * q + 2], x[16 * q + 3]); o.y = cvt4_fp8(x[16 * q + 4], x[16 * q + 5], x[16 * q + 6], x[16 * q + 7]);
            o.z = cvt4_fp8(x[16 * q + 8], x[16 * q + 9], x[16 * q + 10], x[16 * q + 11]); o.w = cvt4_fp8(x[16 * q + 12], x[16 * q + 13], x[16 * q + 14], x[16 * q + 15]); *(v4u*)(dst + 16 * q) = o; }
    }
#endif
    const size_t gt = (size_t)F.vcu * (NWAVES * 64) + F.tid, NT_ = (size_t)F.G * NWAVES * 64;
    cvt_rows(KIN(I_P), WSP(bf16, WS_PB), (size_t)DEPTH * T * 256 / 8, gt, NT_);
    cvt_rows(KIN(I_X), WSP(bf16, WS_XB), (size_t)T * D / 8, gt, NT_);
    for (size_t i = gt; i < (size_t)DEPTH * LORA_PER_LAYER; i += NT_) { const int l = (int)(i / LORA_PER_LAYER); int r = (int)(i % LORA_PER_LAYER); float v;
        if (r < 8192) { const int ch = r >> 5, j = r & 31; v = KIN(I_RWUP)[(size_t)l * 8192 + j * 256 + ch]; }
        else if (r < 16384) { r -= 8192; const int ch = r >> 5, j = r & 31; v = KIN(I_RAUP)[(size_t)l * 8192 + j * 256 + ch]; }
        else if (r < 32768) { r -= 16384; const int ch = r >> 6, j = r & 63; v = KIN(I_RGUP)[(size_t)l * 16384 + j * 256 + ch]; }
        else { r -= 32768; const int d = r >> 4, j = r & 15; v = KIN(I_GGUP)[(size_t)l * 2048 + j * 128 + d]; }
        WSP(float, WS_LORA)[i] = v; }
    for (size_t i = gt; i < (size_t)DEPTH * NE * D; i += NT_) { const int l = (int)(i / (NE * D)), r = (int)(i % (NE * D)), e = r / D, k = r % D; WSP(float, WS_RWT)[i] = KIN(I_RTW)[(size_t)l * D * NE + (size_t)k * NE + e]; }
}

__device__ __forceinline__ void router_pick(float (&p)[32], int lane, float rbias, int& ek, float& gk) {
#pragma unroll
    for (int i = 0; i < 16; ++i) { const bool hi = (lane & 32) != 0; const float keep = hi ? p[i + 16] : p[i], send = hi ? p[i] : p[i + 16]; p[i] = keep + __shfl_xor(send, 32); }
#pragma unroll
    for (int i = 0; i < 8; ++i) { const bool hi = (lane & 16) != 0; const float keep = hi ? p[i + 8] : p[i], send = hi ? p[i] : p[i + 8]; p[i] = keep + __shfl_xor(send, 16); }
#pragma unroll
    for (int i = 0; i < 4; ++i) { const bool hi = (lane & 8) != 0; const float keep = hi ? p[i + 4] : p[i], send = hi ? p[i] : p[i + 4]; p[i] = keep + __shfl_xor(send, 8); }
#pragma unroll
    for (int i = 0; i < 2; ++i) { const bool hi = (lane & 4) != 0; const float keep = hi ? p[i + 2] : p[i], send = hi ? p[i] : p[i + 2]; p[i] = keep + __shfl_xor(send, 4); }
    { const bool hi = (lane & 2) != 0; const float keep = hi ? p[1] : p[0], send = hi ? p[0] : p[1]; p[0] = keep + __shfl_xor(send, 2); }
    const float logit = p[0] + __shfl_xor(p[0], 1) + rbias;
    const int me = lane >> 1; int rank = 0;
#pragma unroll
    for (int e = 0; e < 32; ++e) { const float le = __builtin_bit_cast(float, __builtin_amdgcn_readlane(__builtin_bit_cast(int, logit), 2 * e)); rank += (le > logit || (le == logit && e < me)) ? 1 : 0; }
    float tv[4]; int te[4];
#pragma unroll
    for (int k = 0; k < 4; ++k) { const unsigned long long m = __ballot(rank == k); const int src = (int)__builtin_ctzll(m);
        te[k] = src >> 1; tv[k] = __builtin_bit_cast(float, __builtin_amdgcn_readlane(__builtin_bit_cast(int, logit), src)); }
    const float e1 = __expf(tv[1] - tv[0]), e2 = __expf(tv[2] - tv[0]), e3 = __expf(tv[3] - tv[0]); const float inv = 1.0f / (1.0f + e1 + e2 + e3);
    const int kk = lane & 3;
    ek = kk == 0 ? te[0] : kk == 1 ? te[1] : kk == 2 ? te[2] : te[3];
    gk = (kk == 0 ? 1.0f : kk == 1 ? e1 : kk == 2 ? e2 : e3) * inv;
}
template <bool DRY> __device__ __forceinline__ void p6_ln1_router(Frame& F, const Args& A, int layer) {
    const bf16* y1 = WSP(bf16, WS_Y1); bf16* x1b = WSP(bf16, WS_X1B);
    const float* g = KIN(I_LN1G) + layer * D; const float* bb = KIN(I_LN1B) + layer * D;
    const float* rwt = WSP(float, WS_RWT) + (size_t)layer * NE * D; const float* rb = KIN(I_RTB) + layer * NE;
    int* sdest = WSP(int, WS_SDEST); float* sgate = WSP(float, WS_SGATE);
    unsigned* cnt = (unsigned*)(F.ctl + CW_CNT + layer * NE * 16);
    LAS float* RWT = (LAS float*)F.lds;
    volatile LAS unsigned* lcnt = F.MISC + MW_LCNT; volatile LAS unsigned* lbase = F.MISC + MW_LBASE;
    for (int i = F.tid; i < NE * D / 4; i += NWAVES * 64) ((LAS f32x4*)RWT)[i] = ((const f32x4*)rwt)[i];
    const int lane = F.lane;
    const float rbias = rb[lane >> 1];
    for (int blk = F.vcu; blk < T / 64; blk += F.G) {
        if (F.tid < 32) lcnt[F.tid] = 0u;
        __syncthreads();
        int my_e = 0; float my_g = 0.f; unsigned my_r = 0u;
#pragma unroll 1
        for (int ri = 0; ri < 8; ++ri) {
            int lo_ = lane; asm volatile("" : "+v"(lo_));
            const f32x4 gv[4] = { *(const f32x4*)(g + 4 * lo_), *(const f32x4*)(g + 256 + 4 * lo_), *(const f32x4*)(g + 512 + 4 * lo_), *(const f32x4*)(g + 768 + 4 * lo_) };
            const f32x4 bv[4] = { *(const f32x4*)(bb + 4 * lo_), *(const f32x4*)(bb + 256 + 4 * lo_), *(const f32x4*)(bb + 512 + 4 * lo_), *(const f32x4*)(bb + 768 + 4 * lo_) };
            f32x4 v[4];
            { const int row = blk * 64 + F.wave * 8 + ri; const bf16* yr = y1 + (size_t)row * D; float s = 0.f;
#pragma unroll
                for (int j = 0; j < 4; ++j) { const v2u w = *(const v2u*)(yr + 256 * j + 4 * lane); v[j] = (f32x4){__uint_as_float(w.x << 16), __uint_as_float(w.x & 0xffff0000u), __uint_as_float(w.y << 16), __uint_as_float(w.y & 0xffff0000u)}; s += (v[j].x + v[j].y) + (v[j].z + v[j].w); }
                const float mean = wave_sum(s) * (1.f / D); float s2 = 0.f;
#pragma unroll
                for (int j = 0; j < 4; ++j) { v[j] = v[j] - mean; s2 += (v[j].x * v[j].x + v[j].y * v[j].y) + (v[j].z * v[j].z + v[j].w * v[j].w); }
                const float rstd = 1.0f / sqrtf(wave_sum(s2) * (1.f / D) + LN_EPS);
#pragma unroll
                for (int j = 0; j < 4; ++j) { v[j] = v[j] * rstd * gv[j] + bv[j];
                    v2u o; o.x = cvt_pk_bf16(v[j].x, v[j].y); o.y = cvt_pk_bf16(v[j].z, v[j].w); *(v2u*)(x1b + (size_t)row * D + 256 * j + 4 * lane) = o;
                    if (MOE_FP8) *(unsigned*)(WSP(unsigned char, WS_X1Q) + (size_t)row * D + 256 * j + 4 * lane) = cvt4_fp8(v[j].x, v[j].y, v[j].z, v[j].w); } }
            float p0[32];
#pragma unroll
            for (int e = 0; e < 32; ++e) { float a0 = 0.f;
#pragma unroll
                for (int j = 0; j < 4; ++j) { const f32x4 w = *(const LAS f32x4*)(RWT + e * D + 256 * j + 4 * lane); a0 += (v[j].x * w.x + v[j].y * w.y) + (v[j].z * w.z + v[j].w * w.w); }
                p0[e] = a0; }
            int ek0; float gk0;
            router_pick(p0, lane, rbias, ek0, gk0);
            if ((lane >> 2) == ri) { my_e = ek0; my_g = gk0; my_r = DRY ? 0u : atomicAdd((unsigned*)&lcnt[ek0], 1u); }
        }
        __syncthreads();
        if (!DRY && F.tid < 32) { const unsigned n = lcnt[F.tid]; lbase[F.tid] = n ? __hip_atomic_fetch_add(cnt + F.tid * 16, n, RLX_AGENT) : 0u; }
        __syncthreads();
        if (!DRY && lane < 32) { const int row = blk * 64 + F.wave * 8 + (lane >> 2); const unsigned slot = (unsigned)my_e * ECAP + lbase[my_e] + my_r;
            sdest[slot] = row * 4 + (lane & 3); sgate[slot] = my_g; }
        __syncthreads();
    }
}
__device__ __forceinline__ void p9_combine(Frame& F, const Args& A) {
    const bf16* x1b = WSP(bf16, WS_X1B); const bf16* yb = WSP(bf16, WS_YBUF); bf16* hb = WSP(bf16, WS_HB);
    const int gw = F.vcu * NWAVES + F.wave, NGW = F.G * NWAVES, lane = F.lane;
    for (int row = gw; row < T; row += NGW) {
        v4u y[4][2], xw[2];
#pragma unroll
        for (int j = 0; j < 2; ++j) {
#pragma unroll
            for (int k = 0; k < 4; ++k) y[k][j] = *(const v4u*)(yb + ((size_t)row * 4 + k) * D + 512 * j + 8 * lane);
            xw[j] = *(const v4u*)(x1b + (size_t)row * D + 512 * j + 8 * lane); }
#pragma unroll
        for (int j = 0; j < 2; ++j) { f32x4 v0, v1; pg8::unpack8(xw[j], v0, v1); v0 = v0 * DN_ALPHA; v1 = v1 * DN_ALPHA;
#pragma unroll
            for (int k = 0; k < 4; ++k) { f32x4 a, b; pg8::unpack8(y[k][j], a, b); v0 = v0 + a; v1 = v1 + b; }
            v4u wv; wv.x = cvt_pk_bf16(v0.x, v0.y); wv.y = cvt_pk_bf16(v0.z, v0.w); wv.z = cvt_pk_bf16(v1.x, v1.y); wv.w = cvt_pk_bf16(v1.z, v1.w); *(v4u*)(hb + (size_t)row * D + 512 * j + 8 * lane) = wv; }
    }
}
__device__ __forceinline__ void p11_ln2(Frame& F, const Args& A, int layer) {
    const bf16* h2 = WSP(bf16, WS_H2); bf16* xb = WSP(bf16, WS_XB);
    const float* g = KIN(I_LN2G) + layer * D; const float* bb = KIN(I_LN2B) + layer * D;
    const int gw = F.vcu * NWAVES + F.wave, NGW = F.G * NWAVES, lane = F.lane;
    for (int row = gw; row < T; row += NGW) {
        const bf16* yr = h2 + (size_t)row * D; f32x4 v[4]; float s = 0.f;
#pragma unroll
        for (int j = 0; j < 4; ++j) { const v2u w = *(const v2u*)(yr + 256 * j + 4 * lane); v[j] = (f32x4){__uint_as_float(w.x << 16), __uint_as_float(w.x & 0xffff0000u), __uint_as_float(w.y << 16), __uint_as_float(w.y & 0xffff0000u)}; s += (v[j].x + v[j].y) + (v[j].z + v[j].w); }
        const float mean = wave_sum(s) * (1.f / D); float s2 = 0.f;
#pragma unroll
        for (int j = 0; j < 4; ++j) { v[j] = v[j] - mean; s2 += (v[j].x * v[j].x + v[j].y * v[j].y) + (v[j].z * v[j].z + v[j].w * v[j].w); }
        const float rstd = 1.0f / sqrtf(wave_sum(s2) * (1.f / D) + LN_EPS);
#pragma unroll
        for (int j = 0; j < 4; ++j) { const f32x4 gv = *(const f32x4*)(g + 256 * j + 4 * lane), bv = *(const f32x4*)(bb + 256 * j + 4 * lane);
            const f32x4 o = v[j] * rstd * gv + bv; const size_t off = (size_t)row * D + 256 * j + 4 * lane;
            if (layer == DEPTH - 1) *(f32x4*)(F.out + off) = o; v2u w; w.x = cvt_pk_bf16(o.x, o.y); w.y = cvt_pk_bf16(o.z, o.w); *(v2u*)(xb + off) = w; }
    }
}
__device__ __forceinline__ void moe_build_pfx(Frame& F, const Args& A, int layer, int NT) {
    volatile LAS unsigned* pfx = F.MISC + MW_PFX;
    __syncthreads();
    if (F.tid == 0) { unsigned acc = 0u;
        for (int e = 0; e < NE; ++e) { const unsigned c = __hip_atomic_load(F.ctl + CW_CNT + (layer * NE + e) * 16, RLX_AGENT); pfx[e] = acc; pfx[40 + e] = c; acc += ((c + 255u) >> 8) * (unsigned)NT; }
        pfx[32] = acc; }
    __syncthreads();
}
#define UU(t, col) bf2f(u[(size_t)(t) * NUP + (col)])
#define UU4(t, col) ldu4(u + (size_t)(t) * NUP + (col))
__device__ __forceinline__ f32x4 ldu4(const bf16* p) { const v2u w = *(const v2u*)p; return (f32x4){__uint_as_float(w.x << 16), __uint_as_float(w.x & 0xffff0000u), __uint_as_float(w.y << 16), __uint_as_float(w.y & 0xffff0000u)}; }
__device__ __forceinline__ void lds_st_bf16(LAS unsigned char* p, float v) { *(LAS unsigned short*)p = (unsigned short)(cvt_pk_bf16(v, 0.f) & 0xffffu); }
__device__ __forceinline__ void lds_st_bf16x4(LAS unsigned char* p, float a, float b, float c, float d) { v2u o; o.x = cvt_pk_bf16(a, b); o.y = cvt_pk_bf16(c, d); *(LAS v2u*)p = o; }

__device__ __forceinline__ void ssd_stage1(Frame& F, const Args& A, int layer, int b, int c) {
    const bf16* u = WSP(bf16, WS_U);
    LAS unsigned char* L = F.lds;
    LAS float* DT = (LAS float*)L; LAS float* AC = DT + 256;
    LAS unsigned char* BMT = L + 2048; LAS unsigned char* XCDT = BMT + 128 * 144;
    const int t0 = b * SEQ + c * 64, tid = F.tid, lane = F.lane, wave = F.wave;
    if (wave < 4) {
        const int hh = wave;
        const float dt = softplusf_(UU(t0 + lane, U_SSD_DT + hh) + KIN(I_SDTB)[layer * 4 + hh]);
        const float adt = -dt * __expf(KIN(I_SALOG)[layer * 4 + hh]);
        const float ac = wave_scan_add(adt, lane);
        DT[hh * 64 + lane] = dt; AC[hh * 64 + lane] = ac;
        if (lane == 63) WSP(float, WS_SSD_DEC)[(b * 4 + hh) * NCH + c] = __expf(ac);
    }
    __syncthreads();
    if (tid < 384) {
        const int cc = tid; const float* cw = KIN(I_SCW) + (size_t)layer * 2048 + cc; const float w0 = cw[0], w1 = cw[512], w2 = cw[1024], w3 = cw[1536], cb = KIN(I_SCB)[layer * 512 + cc];
        const bf16* up = u + (size_t)t0 * NUP + U_SSD_X + cc;
        float win0 = 0.f, win1 = 0.f, win2 = 0.f;
        if (c > 0) { win0 = bf2f(up[-3 * NUP]); win1 = bf2f(up[-2 * NUP]); win2 = bf2f(up[-1 * NUP]); }
        const int hh = (cc >> 6) & 3; const bool isx = cc < 256;
        LAS unsigned char* dst = isx ? XCDT + cc * 144 : BMT + (cc - 256) * 144;
        const float aclast = AC[hh * 64 + 63];
#pragma unroll 1
        for (int l0 = 0; l0 < 64; l0 += 32) {
            float xv[32];
#pragma unroll
            for (int j = 0; j < 32; ++j) xv[j] = bf2f(up[(l0 + j) * NUP]);
#pragma unroll
            for (int j8 = 0; j8 < 4; ++j8) { float o[8];
#pragma unroll
                for (int j = 0; j < 8; ++j) { const int l = l0 + j8 * 8 + j; const float x = xv[j8 * 8 + j]; const float y = cb + w0 * win0 + w1 * win1 + w2 * win2 + w3 * x; win0 = win1; win1 = win2; win2 = x;
                    float s = siluf_(y); if (isx) s *= DT[hh * 64 + l] * __expf(aclast - AC[hh * 64 + l]); o[j] = s; }
                *(LAS v4u*)(dst + (l0 + j8 * 8) * 2) = pack8(o); }
        }
    }
    __syncthreads();
    { const int fr = lane & 15, fq = lane >> 4; float* st = WSP(float, WS_SSD_ST);
#pragma unroll 1
      for (int i = 0; i < 2; ++i) { const int row0 = (2 * wave + i) * 16; const int hh = row0 >> 6, p = (row0 & 63) + fr;
          float* dstp = st + (((size_t)(b * 4 + hh) * NCH + c) * 64 + p) * 128;
#pragma unroll 1
          for (int ntl = 0; ntl < 8; ++ntl) { f32x4 acc = {0.f, 0.f, 0.f, 0.f}; acc = mm16(XCDT + row0 * 144, 144, BMT + ntl * 16 * 144, 144, 64, acc, fr, fq);
              *(f32x4*)(dstp + ntl * 16 + 4 * fq) = acc; } } }
    __syncthreads();
}
__device__ __forceinline__ void ssd_stage3(Frame& F, const Args& A, int layer, int b, int c) {
    const bf16* u = WSP(bf16, WS_U);
    LAS unsigned char* L = F.lds;
    LAS float* DT = (LAS float*)L; LAS float* AC = DT + 256;
    LAS unsigned char* CM = L + 2048; LAS unsigned char* BM = CM + 64 * 272; LAS unsigned char* XCT = BM + 64 * 272; LAS unsigned char* MM = XCT + 256 * 144;
    LAS unsigned char* YG = XCT;
    const int t0 = b * SEQ + c * 64, tid = F.tid, lane = F.lane, wave = F.wave, fr = lane & 15, fq = lane >> 4;
    if (wave < 4) {
        const int hh = wave;
        const float dt = softplusf_(UU(t0 + lane, U_SSD_DT + hh) + KIN(I_SDTB)[layer * 4 + hh]);
        const float adt = -dt * __expf(KIN(I_SALOG)[layer * 4 + hh]);
        DT[hh * 64 + lane] = dt; AC[hh * 64 + lane] = wave_scan_add(adt, lane);
    }
    __syncthreads();
    {
        const int cc = tid; const float* cw = KIN(I_SCW) + (size_t)layer * 2048 + cc; const float w0 = cw[0], w1 = cw[512], w2 = cw[1024], w3 = cw[1536], cb = KIN(I_SCB)[layer * 512 + cc];
        const bf16* up = u + (size_t)t0 * NUP + U_SSD_X + cc;
        float win0 = 0.f, win1 = 0.f, win2 = 0.f;
        if (c > 0) { win0 = bf2f(up[-3 * NUP]); win1 = bf2f(up[-2 * NUP]); win2 = bf2f(up[-1 * NUP]); }
        const int hh = (cc >> 6) & 3;
#pragma unroll 1
        for (int l0 = 0; l0 < 64; l0 += 32) {
            float xv[32];
#pragma unroll
            for (int j = 0; j < 32; ++j) xv[j] = bf2f(up[(l0 + j) * NUP]);
#pragma unroll
            for (int j8 = 0; j8 < 4; ++j8) { float o[8];
#pragma unroll
                for (int j = 0; j < 8; ++j) { const int l = l0 + j8 * 8 + j; const float x = xv[j8 * 8 + j]; const float y = cb + w0 * win0 + w1 * win1 + w2 * win2 + w3 * x; win0 = win1; win1 = win2; win2 = x;
                    float s = siluf_(y); if (cc < 256) s *= DT[hh * 64 + l]; o[j] = s; }
                if (cc < 256) *(LAS v4u*)(XCT + cc * 144 + (l0 + j8 * 8) * 2) = pack8(o);
                else { LAS unsigned char* d2 = (cc < 384 ? BM + (cc - 256) * 2 : CM + (cc - 384) * 2) + (l0 + j8 * 8) * 272;
#pragma unroll
                    for (int j = 0; j < 8; ++j) lds_st_bf16(d2 + j * 272, o[j]); } }
        }
    }
    __syncthreads();
#pragma unroll 1
    for (int i = 0; i < 2; ++i) { const int idx = 2 * wave + i, lt = idx >> 2, st = idx & 3;
        f32x4 acc = {0.f, 0.f, 0.f, 0.f}; acc = mm16(CM + lt * 16 * 272, 272, BM + st * 16 * 272, 272, 128, acc, fr, fq);
        const int l = lt * 16 + fr, s0 = st * 16 + 4 * fq;
#pragma unroll
        for (int hh = 0; hh < 4; ++hh) { const float al = AC[hh * 64 + l], dl = KIN(I_SD)[layer * 4 + hh] / DT[hh * 64 + l]; float o[4];
#pragma unroll
            for (int j = 0; j < 4; ++j) { const int s = s0 + j; float m = (l >= s) ? acc[j] * __expf(al - AC[hh * 64 + s]) : 0.f; if (l == s) m += dl; o[j] = m; }
            lds_st_bf16x4(MM + hh * 9216 + l * 144 + s0 * 2, o[0], o[1], o[2], o[3]); } }
    __syncthreads();
    f32x4 yv[2][4];
    { const int hh = wave >> 1; const float* prev = WSP(float, WS_SSD_ST) + ((size_t)(b * 4 + hh) * NCH + c) * 8192;
      bf16x8 pf[4][4];
#pragma unroll
      for (int pt = 0; pt < 4; ++pt)
#pragma unroll
          for (int ks = 0; ks < 4; ++ks) pf[pt][ks] = ldfrag_f32(prev + (size_t)(pt * 16 + fr) * 128 + ks * 32 + fq * 8);
#pragma unroll
      for (int i = 0; i < 2; ++i) { const int lt = 2 * (wave & 1) + i, l = lt * 16 + fr; const float ea = __expf(AC[hh * 64 + l]);
#pragma unroll
          for (int pt = 0; pt < 4; ++pt) { f32x4 ad = {0.f, 0.f, 0.f, 0.f}, ao = {0.f, 0.f, 0.f, 0.f};
              ad = mm16(MM + hh * 9216 + lt * 16 * 144, 144, XCT + (hh * 64 + pt * 16) * 144, 144, 64, ad, fr, fq);
              ao = mm16_rB<4>(CM + lt * 16 * 272, 272, pf[pt], ao, fr, fq);
              const f32x4 z = UU4(t0 + l, U_SSD_Z + hh * 64 + pt * 16 + 4 * fq);
              f32x4 y = ad + ao * ea; y.x *= siluf_(z.x); y.y *= siluf_(z.y); y.z *= siluf_(z.z); y.w *= siluf_(z.w); yv[i][pt] = y; } } }
    __syncthreads();
    { const int hh = wave >> 1;
#pragma unroll
      for (int i = 0; i < 2; ++i) { const int l = (2 * (wave & 1) + i) * 16 + fr;
#pragma unroll
          for (int pt = 0; pt < 4; ++pt) *(LAS f32x4*)(YG + l * 1040 + (hh * 64 + pt * 16 + 4 * fq) * 4) = yv[i][pt]; } }
    __syncthreads();
    { const f32x4 g = *(const f32x4*)(KIN(I_SNG) + layer * 256 + 4 * lane); bf16* mix = WSP(bf16, WS_MIX);
#pragma unroll 1
      for (int i = 0; i < 8; ++i) { const int l = wave * 8 + i; const f32x4 y = *(const LAS f32x4*)(YG + l * 1040 + lane * 16);
          const float ss = wave_sum((y.x * y.x + y.y * y.y) + (y.z * y.z + y.w * y.w)); const float r = 1.0f / sqrtf(ss * (1.f / 256.f) + NORM_EPS);
          v2u o; o.x = cvt_pk_bf16(y.x * r * g.x, y.y * r * g.y); o.y = cvt_pk_bf16(y.z * r * g.z, y.w * r * g.w);
          *(v2u*)(mix + (size_t)(t0 + l) * D + 4 * lane) = o; } }
    __syncthreads();
}

__device__ __forceinline__ float gla_bcum(Frame& F, const Args& A, int layer, int d, const LAS float* GD, LAS float* BC) {
    float gup[16];
    { const f32x4* gp4 = (const f32x4*)(WSP(float, WS_LORA) + (size_t)layer * LORA_PER_LAYER + 32768 + d * 16);
#pragma unroll
      for (int i = 0; i < 4; ++i) { const f32x4 a = gp4[i]; gup[4 * i] = a.x; gup[4 * i + 1] = a.y; gup[4 * i + 2] = a.z; gup[4 * i + 3] = a.w; } }
    const float gb = KIN(I_GGB)[layer * 128 + d]; float bc = 0.f;
#pragma unroll 2
    for (int l = 0; l < 64; ++l) { float x = gb;
#pragma unroll
        for (int i = 0; i < 16; ++i) x += GD[l * 16 + i] * gup[i];
        bc += logsigmoidf_(x) * 0.0625f; BC[l * 128 + d] = bc; }
    return bc;
}
__device__ __forceinline__ void gla_stage1(Frame& F, const Args& A, int layer, int b, int c) {
    const bf16* u = WSP(bf16, WS_U);
    LAS unsigned char* L = F.lds;
    LAS float* GD = (LAS float*)L; LAS float* BC = (LAS float*)(L + 4096);
    LAS unsigned char* KDT = L + 36864; LAS unsigned char* VT = KDT + 128 * 144;
    const int t0 = b * SEQ + c * 64, tid = F.tid, lane = F.lane, wave = F.wave, fr = lane & 15, fq = lane >> 4;
    if (tid < 256) { const int l = tid >> 2, q4 = tid & 3; *(LAS f32x4*)(GD + l * 16 + q4 * 4) = UU4(t0 + l, U_GL_G + 4 * q4); }
    __syncthreads();
    if (tid < 128) {
        const int d = tid; const float blast = gla_bcum(F, A, layer, d, GD, BC);
        WSP(float, WS_GLA_DEC)[(size_t)(b * NCH + c) * 128 + d] = __expf(blast);
        const bf16* up = u + (size_t)t0 * NUP + U_GL_K + d;
#pragma unroll 1
        for (int l0 = 0; l0 < 64; l0 += 32) { float xv[32];
#pragma unroll
            for (int j = 0; j < 32; ++j) xv[j] = bf2f(up[(l0 + j) * NUP]);
#pragma unroll
            for (int j8 = 0; j8 < 4; ++j8) { float o[8];
#pragma unroll
                for (int j = 0; j < 8; ++j) { const int l = l0 + j8 * 8 + j; o[j] = xv[j8 * 8 + j] * __expf(blast - BC[l * 128 + d]); }
                *(LAS v4u*)(KDT + d * 144 + (l0 + j8 * 8) * 2) = pack8(o); } }
    } else if (tid < 384) {
        const int vch = tid - 128; const bf16* up = u + (size_t)t0 * NUP + U_GL_V + vch;
#pragma unroll 1
        for (int l0 = 0; l0 < 64; l0 += 32) { float xv[32];
#pragma unroll
            for (int j = 0; j < 32; ++j) xv[j] = bf2f(up[(l0 + j) * NUP]);
#pragma unroll
            for (int j8 = 0; j8 < 4; ++j8) { float o[8];
#pragma unroll
                for (int j = 0; j < 8; ++j) o[j] = xv[j8 * 8 + j];
                *(LAS v4u*)(VT + vch * 144 + (l0 + j8 * 8) * 2) = pack8(o); } }
    }
    __syncthreads();
    { float* st = WSP(float, WS_GLA_ST);
#pragma unroll 1
      for (int i = 0; i < 4; ++i) { const int idx = 4 * wave + i, hh = idx >> 3, dtl = (idx >> 2) & 1, vt = idx & 3;
          f32x4 acc = {0.f, 0.f, 0.f, 0.f}; acc = mm16(KDT + (hh * 32 + dtl * 16) * 144, 144, VT + (hh * 64 + vt * 16) * 144, 144, 64, acc, fr, fq);
          *(f32x4*)(st + (((size_t)(b * 4 + hh) * NCH + c) * 32 + dtl * 16 + fr) * 64 + vt * 16 + 4 * fq) = acc; } }
    __syncthreads();
}
__device__ __forceinline__ void gla_stage3(Frame& F, const Args& A, int layer, int b, int c) {
    const bf16* u = WSP(bf16, WS_U);
    LAS unsigned char* L = F.lds;
    LAS float* GD = (LAS float*)L; LAS float* BC = (LAS float*)(L + 4096); LAS unsigned char* ATT = L + 4096;
    LAS unsigned char* QD = L + 40960; LAS unsigned char* KI = QD + 64 * 272; LAS unsigned char* VT = KI + 64 * 272; LAS unsigned char* PVT = VT + 256 * 144;
    const int t0 = b * SEQ + c * 64, tid = F.tid, lane = F.lane, wave = F.wave, fr = lane & 15, fq = lane >> 4;
    if (tid < 256) { const int l = tid >> 2, q4 = tid & 3; *(LAS f32x4*)(GD + l * 16 + q4 * 4) = UU4(t0 + l, U_GL_G + 4 * q4); }
    __syncthreads();
    if (tid < 128) {
        const int d = tid; (void)gla_bcum(F, A, layer, d, GD, BC);
        const bf16* uq = u + (size_t)t0 * NUP + U_GL_Q + d; const bf16* uk = u + (size_t)t0 * NUP + U_GL_K + d;
#pragma unroll 1
        for (int l0 = 0; l0 < 64; l0 += 16) { float qv[16], kv[16];
#pragma unroll
            for (int j = 0; j < 16; ++j) { qv[j] = bf2f(uq[(l0 + j) * NUP]); kv[j] = bf2f(uk[(l0 + j) * NUP]); }
#pragma unroll
            for (int j = 0; j < 16; ++j) { const int l = l0 + j; const float bc = BC[l * 128 + d];
                lds_st_bf16(QD + l * 272 + d * 2, qv[j] * 0.17677669529663687f * __expf(bc)); lds_st_bf16(KI + l * 272 + d * 2, kv[j] * __expf(-bc)); } }
    } else if (tid < 384) {
        const int vch = tid - 128; const bf16* up = u + (size_t)t0 * NUP + U_GL_V + vch;
#pragma unroll 1
        for (int l0 = 0; l0 < 64; l0 += 32) { float xv[32];
#pragma unroll
            for (int j = 0; j < 32; ++j) xv[j] = bf2f(up[(l0 + j) * NUP]);
#pragma unroll
            for (int j8 = 0; j8 < 4; ++j8) { float o[8];
#pragma unroll
                for (int j = 0; j < 8; ++j) o[j] = xv[j8 * 8 + j];
                *(LAS v4u*)(VT + vch * 144 + (l0 + j8 * 8) * 2) = pack8(o); } }
    } else {
        const float* prev = WSP(float, WS_GLA_ST);
#pragma unroll 4
        for (int i = tid - 384; i < 8192; i += 128) { const int hh = i >> 11, dd = (i >> 6) & 31, vv = i & 63;
            lds_st_bf16(PVT + (hh * 64 + vv) * 80 + dd * 2, prev[((size_t)(b * 4 + hh) * NCH + c) * 2048 + dd * 64 + vv]); }
    }
    __syncthreads();
    const int hh = wave >> 1;
#pragma unroll 1
    for (int i = 0; i < 2; ++i) { const int tt = 2 * (wave & 1) + i, t = tt * 16 + fr;
#pragma unroll
        for (int st = 0; st < 4; ++st) { f32x4 acc = {0.f, 0.f, 0.f, 0.f}; acc = mm16(QD + tt * 16 * 272 + hh * 64, 272, KI + st * 16 * 272 + hh * 64, 272, 32, acc, fr, fq);
            const int s0 = st * 16 + 4 * fq;
            lds_st_bf16x4(ATT + hh * 9216 + t * 144 + s0 * 2, t >= s0 ? acc[0] : 0.f, t >= s0 + 1 ? acc[1] : 0.f, t >= s0 + 2 ? acc[2] : 0.f, t >= s0 + 3 ? acc[3] : 0.f); } }
    __syncthreads();
    { bf16* mix = WSP(bf16, WS_MIX); const float* ng = KIN(I_GNG) + layer * 256;
#pragma unroll 1
      for (int i = 0; i < 2; ++i) { const int tt = 2 * (wave & 1) + i, t = tt * 16 + fr; f32x4 ov[4]; float ss = 0.f;
#pragma unroll
          for (int vt = 0; vt < 4; ++vt) { f32x4 acc = {0.f, 0.f, 0.f, 0.f};
              acc = mm16(ATT + hh * 9216 + tt * 16 * 144, 144, VT + (hh * 64 + vt * 16) * 144, 144, 64, acc, fr, fq);
              acc = mm16(QD + tt * 16 * 272 + hh * 64, 272, PVT + (hh * 64 + vt * 16) * 80, 80, 32, acc, fr, fq);
              ov[vt] = acc; ss += (acc.x * acc.x + acc.y * acc.y) + (acc.z * acc.z + acc.w * acc.w); }
          ss += __shfl_xor(ss, 16); ss += __shfl_xor(ss, 32);
          const float r = 1.0f / sqrtf(ss * (1.f / 64.f) + NORM_EPS);
#pragma unroll
          for (int vt = 0; vt < 4; ++vt) { const int col = hh * 64 + vt * 16 + 4 * fq; const f32x4 g = *(const f32x4*)(ng + col); const f32x4 og = UU4(t0 + t, U_GL_OG + col);
              v2u o; o.x = cvt_pk_bf16(ov[vt].x * r * g.x * siluf_(og.x), ov[vt].y * r * g.y * siluf_(og.y)); o.y = cvt_pk_bf16(ov[vt].z * r * g.z * siluf_(og.z), ov[vt].w * r * g.w * siluf_(og.w));
              *(v2u*)(mix + (size_t)(t0 + t) * D + 512 + col) = o; } } }
    __syncthreads();
}

__device__ __forceinline__ void mlstm_stage1(Frame& F, const Args& A, int layer, int b, int c) {
    const bf16* u = WSP(bf16, WS_U);
    LAS unsigned char* L = F.lds;
    LAS float* WST = (LAS float*)L; LAS unsigned char* KT = L + 1024; LAS unsigned char* VWT = KT + 256 * 144;
    const int t0 = b * SEQ + c * 64, tid = F.tid, lane = F.lane, wave = F.wave, fr = lane & 15, fq = lane >> 4;
    if (wave < 4) {
        const int hh = wave;
        const float ig = UU(t0 + lane, U_ML_I + hh) + KIN(I_MIB)[layer * 4 + hh];
        const float lf = logsigmoidf_(UU(t0 + lane, U_ML_F + hh) + KIN(I_MFB)[layer * 4 + hh]);
        const float bc = wave_scan_add(lf, lane); const float blast = __shfl(bc, 63);
        const float ast = blast - bc + ig; const float mloc = wave_max(ast);
        WST[hh * 64 + lane] = __expf(ast - mloc);
        if (lane == 0) { WSP(float, WS_ML_BL)[(b * 4 + hh) * NCH + c] = blast; WSP(float, WS_ML_ML)[(b * 4 + hh) * NCH + c] = mloc; }
    } else {
        const int kch = tid - 256, cc = 256 + kch; const float* cw = KIN(I_MCW) + (size_t)layer * 2048 + cc; const float w0 = cw[0], w1 = cw[512], w2 = cw[1024], w3 = cw[1536], cb = KIN(I_MCB)[layer * 512 + cc];
        const bf16* up = u + (size_t)t0 * NUP + U_ML_K + kch;
        float win0 = 0.f, win1 = 0.f, win2 = 0.f;
        if (c > 0) { win0 = bf2f(up[-3 * NUP]); win1 = bf2f(up[-2 * NUP]); win2 = bf2f(up[-1 * NUP]); }
#pragma unroll 1
        for (int l0 = 0; l0 < 64; l0 += 32) { float xv[32];
#pragma unroll
            for (int j = 0; j < 32; ++j) xv[j] = bf2f(up[(l0 + j) * NUP]);
#pragma unroll
            for (int j8 = 0; j8 < 4; ++j8) { float o[8];
#pragma unroll
                for (int j = 0; j < 8; ++j) { const float x = xv[j8 * 8 + j]; const float y = cb + w0 * win0 + w1 * win1 + w2 * win2 + w3 * x; win0 = win1; win1 = win2; win2 = x; o[j] = siluf_(y); }
                *(LAS v4u*)(KT + kch * 144 + (l0 + j8 * 8) * 2) = pack8(o); } }
    }
    __syncthreads();
    if (tid < 256) {
        const int vch = tid, hh = vch >> 6; const bf16* up = u + (size_t)t0 * NUP + U_ML_V + vch;
#pragma unroll 1
        for (int l0 = 0; l0 < 64; l0 += 32) { float xv[32];
#pragma unroll
            for (int j = 0; j < 32; ++j) xv[j] = bf2f(up[(l0 + j) * NUP]);
#pragma unroll
            for (int j8 = 0; j8 < 4; ++j8) { float o[8];
#pragma unroll
                for (int j = 0; j < 8; ++j) o[j] = xv[j8 * 8 + j] * WST[hh * 64 + l0 + j8 * 8 + j];
                *(LAS v4u*)(VWT + vch * 144 + (l0 + j8 * 8) * 2) = pack8(o); } }
    } else {
        const int kch = tid - 256, hh = kch >> 6; float n = 0.f;
#pragma unroll 8
        for (int s = 0; s < 64; ++s) n += WST[hh * 64 + s] * bf2f(*(const LAS unsigned short*)(KT + kch * 144 + s * 2));
        WSP(float, WS_ML_N)[((size_t)(b * 4 + hh) * NCH + c) * 64 + (kch & 63)] = n;
    }
    __syncthreads();
    { float* cst = WSP(float, WS_ML_C); const int hh = wave >> 1;
#pragma unroll 1
      for (int i = 0; i < 2; ++i) { const int vt = 2 * (wave & 1) + i;
#pragma unroll 1
          for (int kt = 0; kt < 4; ++kt) { f32x4 acc = {0.f, 0.f, 0.f, 0.f}; acc = mm16(VWT + (hh * 64 + vt * 16) * 144, 144, KT + (hh * 64 + kt * 16) * 144, 144, 64, acc, fr, fq);
              *(f32x4*)(cst + (((size_t)(b * 4 + hh) * NCH + c) * 64 + vt * 16 + fr) * 64 + kt * 16 + 4 * fq) = acc; } } }
    __syncthreads();
}
__device__ __forceinline__ void mlstm_stage3(Frame& F, const Args& A, int layer, int b, int c) {
    const bf16* u = WSP(bf16, WS_U);
    LAS unsigned char* L = F.lds;
    LAS float* BCU = (LAS float*)L; LAS float* GG = BCU + 256; LAS float* MROW = BCU + 512; LAS float* WINT = BCU + 768; LAS float* NPV = BCU + 1024;
    LAS unsigned char* Q = L + 6144; LAS unsigned char* KK = Q + 64 * 528; LAS unsigned char* VT = KK + 64 * 528; LAS unsigned char* SC = VT + 256 * 144;
    const int t0 = b * SEQ + c * 64, tid = F.tid, lane = F.lane, wave = F.wave, fr = lane & 15, fq = lane >> 4;
    if (wave < 4) {
        const int hh = wave;
        const float ig = UU(t0 + lane, U_ML_I + hh) + KIN(I_MIB)[layer * 4 + hh];
        const float lf = logsigmoidf_(UU(t0 + lane, U_ML_F + hh) + KIN(I_MFB)[layer * 4 + hh]);
        const float bc = wave_scan_add(lf, lane); const float gg = ig - bc;
        const float mprev = WSP(float, WS_ML_M)[(b * 4 + hh) * NCH + c];
        const float minter = bc + mprev, mintra = bc + wave_scan_max(gg, lane), mrow = fmaxf(minter, mintra);
        BCU[hh * 64 + lane] = bc; GG[hh * 64 + lane] = gg; MROW[hh * 64 + lane] = mrow; WINT[hh * 64 + lane] = __expf(minter - mrow);
        NPV[hh * 64 + lane] = WSP(float, WS_ML_N)[((size_t)(b * 4 + hh) * NCH + c) * 64 + lane];
    }
    {
        const int cc = tid; const float* cw = KIN(I_MCW) + (size_t)layer * 2048 + cc; const float w0 = cw[0], w1 = cw[512], w2 = cw[1024], w3 = cw[1536], cb = KIN(I_MCB)[layer * 512 + cc];
        const bf16* up = u + (size_t)t0 * NUP + U_ML_Q + cc;
        float win0 = 0.f, win1 = 0.f, win2 = 0.f;
        if (c > 0) { win0 = bf2f(up[-3 * NUP]); win1 = bf2f(up[-2 * NUP]); win2 = bf2f(up[-1 * NUP]); }
        LAS unsigned char* dst = cc < 256 ? Q + cc * 2 : KK + (cc - 256) * 2; const float sc = cc < 256 ? 0.125f : 1.0f;
#pragma unroll 1
        for (int l0 = 0; l0 < 64; l0 += 32) { float xv[32];
#pragma unroll
            for (int j = 0; j < 32; ++j) xv[j] = bf2f(up[(l0 + j) * NUP]);
#pragma unroll
            for (int j = 0; j < 32; ++j) { const float x = xv[j]; const float y = cb + w0 * win0 + w1 * win1 + w2 * win2 + w3 * x; win0 = win1; win1 = win2; win2 = x; lds_st_bf16(dst + (l0 + j) * 528, siluf_(y) * sc); } }
        const int vch = tid & 255, lh = (tid >> 8) * 32; const bf16* uv = u + (size_t)(t0 + lh) * NUP + U_ML_V + vch;
        float xv[32];
#pragma unroll
        for (int j = 0; j < 32; ++j) xv[j] = bf2f(uv[j * NUP]);
#pragma unroll
        for (int j8 = 0; j8 < 4; ++j8) { float o[8];
#pragma unroll
            for (int j = 0; j < 8; ++j) o[j] = xv[j8 * 8 + j];
            *(LAS v4u*)(VT + vch * 144 + (lh + j8 * 8) * 2) = pack8(o); }
    }
    __syncthreads();
    { const int hh = wave >> 1; bf16* mix = WSP(bf16, WS_MIX); const float* ng = KIN(I_MNG) + layer * 256;
      const float* cprev = WSP(float, WS_ML_C) + ((size_t)(b * 4 + hh) * NCH + c) * 4096;
      bf16x8 cf[4][2];
#pragma unroll
      for (int vt = 0; vt < 4; ++vt)
#pragma unroll
          for (int ks = 0; ks < 2; ++ks) cf[vt][ks] = ldfrag_f32(cprev + (size_t)(vt * 16 + fr) * 64 + ks * 32 + fq * 8);
#pragma unroll 1
      for (int i = 0; i < 2; ++i) { const int tt = 2 * (wave & 1) + i, t = tt * 16 + fr;
          const float bt = BCU[hh * 64 + t] - MROW[hh * 64 + t]; float rs = 0.f;
#pragma unroll
          for (int st = 0; st < 4; ++st) { f32x4 acc = {0.f, 0.f, 0.f, 0.f}; acc = mm16(Q + tt * 16 * 528 + hh * 128, 528, KK + st * 16 * 528 + hh * 128, 528, 64, acc, fr, fq);
              const int s0 = st * 16 + 4 * fq; float o[4];
#pragma unroll
              for (int j = 0; j < 4; ++j) { const int s = s0 + j; const float v = (t >= s) ? acc[j] * __expf(bt + GG[hh * 64 + s]) : 0.f; o[j] = v; rs += v; }
              lds_st_bf16x4(SC + hh * 9216 + t * 144 + s0 * 2, o[0], o[1], o[2], o[3]); }
          rs += __shfl_xor(rs, 16); rs += __shfl_xor(rs, 32);
          float nq = 0.f;
#pragma unroll
          for (int j = 0; j < 16; ++j) nq += bf2f(*(const LAS unsigned short*)(Q + t * 528 + (hh * 64 + fq * 16 + j) * 2)) * NPV[hh * 64 + fq * 16 + j];
          nq += __shfl_xor(nq, 16); nq += __shfl_xor(nq, 32);
          const float wi = WINT[hh * 64 + t]; const float den = wi * nq + rs; const float dn = fmaxf(fabsf(den), __expf(-MROW[hh * 64 + t])); const float rdn = 1.0f / dn;
          LDS_WAIT();
          f32x4 hv[4]; float sm = 0.f;
#pragma unroll
          for (int vt = 0; vt < 4; ++vt) { f32x4 acc = {0.f, 0.f, 0.f, 0.f};
              acc = mm16_rB<2>(Q + tt * 16 * 528 + hh * 128, 528, cf[vt], acc, fr, fq);
              acc = acc * wi;
              acc = mm16(SC + hh * 9216 + tt * 16 * 144, 144, VT + (hh * 64 + vt * 16) * 144, 144, 64, acc, fr, fq);
              const f32x4 og = UU4(t0 + t, U_ML_O + hh * 64 + vt * 16 + 4 * fq);
              f32x4 h; h.x = acc.x * rdn * sigmoidf_(og.x); h.y = acc.y * rdn * sigmoidf_(og.y); h.z = acc.z * rdn * sigmoidf_(og.z); h.w = acc.w * rdn * sigmoidf_(og.w);
              hv[vt] = h; sm += (h.x + h.y) + (h.z + h.w); }
          sm += __shfl_xor(sm, 16); sm += __shfl_xor(sm, 32);
          const float mean = sm * (1.f / 64.f); float sq = 0.f;
#pragma unroll
          for (int vt = 0; vt < 4; ++vt) { hv[vt] = hv[vt] - mean; sq += (hv[vt].x * hv[vt].x + hv[vt].y * hv[vt].y) + (hv[vt].z * hv[vt].z + hv[vt].w * hv[vt].w); }
          sq += __shfl_xor(sq, 16); sq += __shfl_xor(sq, 32);
          const float r = 1.0f / sqrtf(sq * (1.f / 64.f) + NORM_EPS);
#pragma unroll
          for (int vt = 0; vt < 4; ++vt) { const int col = hh * 64 + vt * 16 + 4 * fq; const f32x4 g = *(const f32x4*)(ng + col);
              v2u o; o.x = cvt_pk_bf16(hv[vt].x * r * g.x, hv[vt].y * r * g.y); o.y = cvt_pk_bf16(hv[vt].z * r * g.z, hv[vt].w * r * g.w);
              *(v2u*)(mix + (size_t)(t0 + t) * D + 768 + col) = o; } } }
    __syncthreads();
}

__device__ __forceinline__ void rwkv_stage1(Frame& F, const Args& A, int layer, int ub) {
    const bf16* u = WSP(bf16, WS_U);
    LAS unsigned char* L = F.lds;
    LAS float* LOWA = (LAS float*)L;
    LAS float* CUM = (LAS float*)(L + 16384);
    LAS float* AAB = CUM;
    LAS float* TOT = CUM;
    LAS unsigned char* M0 = L + 16384 + 16640;
#define RM(i) (M0 + (i) * 9216)
    LAS float* LOG = (LAS float*)RM(0);
    LAS float* GAMC = (LAS float*)(F.MISC + MW_GAMC);
    const int t0 = ub * 64, c = ub & 63, tid = F.tid, lane = F.lane, wave = F.wave;
    const float* mu = KIN(I_RMU) + layer * 896;
#ifndef RW_DUP
#define RW_DUP -1
#endif
#define RW_REP(k) for (int rep__ = 0; rep__ < ((RW_DUP == (k)) ? 2 : 1); ++rep__)
    RW_REP(0) {
    {
        const int l = tid >> 3, jq = tid & 7, t = t0 + l; const bool has_prev = (t & (SEQ - 1)) != 0;
        f32x4 cur[4], prv[4];
#pragma unroll
        for (int q = 0; q < 4; ++q) { cur[q] = UU4(t, U_RW_LO + jq * 16 + 4 * q); prv[q] = has_prev ? UU4(t - 1, U_RW_LO + jq * 16 + 4 * q) : (f32x4){0.f, 0.f, 0.f, 0.f}; }
#pragma unroll
        for (int q = 0; q < 4; ++q) { const f32x4 m4 = *(const f32x4*)(mu + 768 + jq * 16 + 4 * q); const f32x4 xs = cur[q] + (prv[q] - cur[q]) * m4; const int j = jq * 16 + 4 * q;
            f32x4 o;
            if (j < 32) { o.x = tanhf(xs.x); o.y = tanhf(xs.y); o.z = tanhf(xs.z); o.w = tanhf(xs.w); } else if (j < 64) o = xs; else { o.x = sigmoidf_(xs.x); o.y = sigmoidf_(xs.y); o.z = sigmoidf_(xs.z); o.w = sigmoidf_(xs.w); }
            if (j < 64) *(LAS f32x4*)(LOWA + l * 64 + j) = o; else *(LAS f32x4*)(LOG + l * 64 + j - 64) = o; }
    }
    __syncthreads();
    { const int ch = tid & 255, half = tid >> 8; float* RG = WSP(float, WS_RW_G);
      float gup[64];
      { const f32x4* gp4 = (const f32x4*)(WSP(float, WS_LORA) + (size_t)layer * LORA_PER_LAYER + 16384 + ch * 64);
#pragma unroll
        for (int j = 0; j < 16; ++j) { const f32x4 a = gp4[j]; gup[4 * j] = a.x; gup[4 * j + 1] = a.y; gup[4 * j + 2] = a.z; gup[4 * j + 3] = a.w; } }
#pragma unroll 2
      for (int li = 0; li < 32; ++li) { const int l = half * 32 + li; float g0 = 0.f, g1 = 0.f;
#pragma unroll
          for (int j = 0; j < 16; ++j) { const f32x4 x4 = *(const LAS f32x4*)(LOG + l * 64 + 4 * j); g0 += x4.x * gup[4 * j] + x4.y * gup[4 * j + 1]; g1 += x4.z * gup[4 * j + 2] + x4.w * gup[4 * j + 3]; }
          RG[(size_t)(t0 + l) * 256 + ch] = g0 + g1; } }
    __syncthreads();
    }
    const int b_ = ub >> 6;
#pragma unroll 1
    for (int hh = 0; hh < 4; ++hh) {
        int ch = lane, fr = lane & 15, fq = lane >> 4; asm volatile("" : "+v"(ch), "+v"(fr), "+v"(fq));
        const int tg = wave, cg = hh * 64 + ch; const size_t un = (size_t)(b_ * 4 + hh) * NCH + c;
        float rr[8], k2r[8], vr[8], ar[8], br[8], pl[8];
        RW_REP(1) {
            float wup[32], aup[32];
            { const f32x4* wp4 = (const f32x4*)(WSP(float, WS_LORA) + (size_t)layer * LORA_PER_LAYER + cg * 32); const f32x4* ap4 = (const f32x4*)(WSP(float, WS_LORA) + (size_t)layer * LORA_PER_LAYER + 8192 + cg * 32);
#pragma unroll
              for (int j = 0; j < 8; ++j) { const f32x4 a = wp4[j], b = ap4[j]; wup[4 * j] = a.x; wup[4 * j + 1] = a.y; wup[4 * j + 2] = a.z; wup[4 * j + 3] = a.w; aup[4 * j] = b.x; aup[4 * j + 1] = b.y; aup[4 * j + 2] = b.z; aup[4 * j + 3] = b.w; } }
            const float w0 = KIN(I_RW0)[layer * 256 + cg], a0 = KIN(I_RA0)[layer * 256 + cg], kkc = KIN(I_RKK)[layer * 256 + cg], kac = KIN(I_RKA)[layer * 256 + cg];
            const float mur = mu[cg], muk = mu[256 + cg], muv = mu[512 + cg];
            const int tb = t0 + tg * 8; const bool nop = (c == 0) && (tg == 0);
            float rp = nop ? 0.f : UU(tb - 1, U_RW_R + cg), kp = nop ? 0.f : UU(tb - 1, U_RW_K + cg), vp = nop ? 0.f : UU(tb - 1, U_RW_V + cg);
            float rc[8], kc[8], vc[8];
#pragma unroll
            for (int j = 0; j < 8; ++j) { rc[j] = UU(tb + j, U_RW_R + cg); kc[j] = UU(tb + j, U_RW_K + cg); vc[j] = UU(tb + j, U_RW_V + cg); }
            float* RW = WSP(float, WS_RW);
            float kk[8], al[8], n2[8], run = 0.f;
#pragma unroll
            for (int j = 0; j < 8; ++j) { const int l = tg * 8 + j;
                const float r = rc[j] + (rp - rc[j]) * mur, k = kc[j] + (kp - kc[j]) * muk, v = vc[j] + (vp - vc[j]) * muv; rp = rc[j]; kp = kc[j]; vp = vc[j];
                float wp = w0, ap = a0;
#pragma unroll
                for (int q = 0; q < 8; ++q) { const f32x4 lw4 = *(const LAS f32x4*)(LOWA + l * 64 + 4 * q), la4 = *(const LAS f32x4*)(LOWA + l * 64 + 32 + 4 * q);
                    wp += (lw4.x * wup[4 * q] + lw4.y * wup[4 * q + 1]) + (lw4.z * wup[4 * q + 2] + lw4.w * wup[4 * q + 3]); ap += (la4.x * aup[4 * q] + la4.y * aup[4 * q + 1]) + (la4.z * aup[4 * q + 2] + la4.w * aup[4 * q + 3]); }
                const float w = -softplusf_(-wp) - 0.5f; run += -__expf(w); pl[j] = run; al[j] = sigmoidf_(ap);
                kk[j] = k * kkc; n2[j] = kk[j] * kk[j];
                k2r[j] = k * (1.0f + (al[j] - 1.0f) * kac); rr[j] = r; vr[j] = v;
                float* o = RW + (size_t)(tb + j) * 768 + cg; o[0] = r; o[256] = k2r[j]; o[512] = v; }
#pragma unroll
            for (int i = 0; i < 4; ++i) { const bool hi = (ch & 32) != 0; const float keep = hi ? n2[i + 4] : n2[i], send = hi ? n2[i] : n2[i + 4]; n2[i] = keep + __shfl_xor(send, 32); }
#pragma unroll
            for (int i = 0; i < 2; ++i) { const bool hi = (ch & 16) != 0; const float keep = hi ? n2[i + 2] : n2[i], send = hi ? n2[i] : n2[i + 2]; n2[i] = keep + __shfl_xor(send, 16); }
            { const bool hi = (ch & 8) != 0; const float keep = hi ? n2[1] : n2[0], send = hi ? n2[0] : n2[1]; n2[0] = keep + __shfl_xor(send, 8); }
            n2[0] += __shfl_xor(n2[0], 4); n2[0] += __shfl_xor(n2[0], 2); n2[0] += __shfl_xor(n2[0], 1);
#pragma unroll
            for (int j = 0; j < 8; ++j) { const float tot = __builtin_bit_cast(float, __builtin_amdgcn_readlane(__builtin_bit_cast(int, n2[0]), ((j & 4) ? 32 : 0) + ((j & 2) ? 16 : 0) + ((j & 1) ? 8 : 0)));
                const float kkn = kk[j] / fmaxf(sqrtf(tot), 1e-12f); ar[j] = -kkn; br[j] = kkn * al[j]; }
            TOT[tg * 64 + ch] = run;
        }
        __syncthreads();
        RW_REP(3) {
            float off = 0.f, gC = 0.f;
#pragma unroll
            for (int g = 0; g < 8; ++g) { const float tv = TOT[g * 64 + ch]; gC += tv; if (g < tg) off += tv; }
            float oat[8], obb[8], okb[8], ov[8];
#pragma unroll
            for (int j = 0; j < 8; ++j) { const int l = tg * 8 + j; const float gt = off + pl[j], gm = j > 0 ? off + pl[j - 1] : off;
                const float at = ar[j] * __expf(gm), rt = rr[j] * __expf(gt), en = __expf(-gt), ec = __expf(gC - gt);
                lds_st_bf16(RM(0) + l * 144 + ch * 2, at); lds_st_bf16(RM(1) + l * 144 + ch * 2, rt); lds_st_bf16(RM(2) + l * 144 + ch * 2, br[j] * en); lds_st_bf16(RM(3) + l * 144 + ch * 2, k2r[j] * en);
                oat[j] = at; obb[j] = br[j] * ec; okb[j] = k2r[j] * ec; ov[j] = vr[j]; }
            *(LAS v4u*)(RM(4) + ch * 144 + tg * 16) = pack8(oat); *(LAS v4u*)(RM(5) + ch * 144 + tg * 16) = pack8(obb); *(LAS v4u*)(RM(6) + ch * 144 + tg * 16) = pack8(okb); *(LAS v4u*)(RM(7) + ch * 144 + tg * 16) = pack8(ov);
            if (tg == 0) GAMC[ch] = __expf(gC);
        }
        __syncthreads();
        RW_REP(4) {
            const int which = wave >> 1; const LAS unsigned char* Aop = which < 2 ? RM(0) : RM(1); const LAS unsigned char* Bop = (which & 1) ? RM(3) : RM(2);
#pragma unroll 1
            for (int i2 = 0; i2 < 2; ++i2) { const int tt = 2 * (wave & 1) + i2, t = tt * 16 + fr;
#pragma unroll
                for (int it = 0; it < 4; ++it) { f32x4 acc = {0.f, 0.f, 0.f, 0.f}; acc = mm16(Aop + tt * 16 * 144, 144, Bop + it * 16 * 144, 144, 64, acc, fr, fq);
                    const int i0 = it * 16 + 4 * fq; const int lim = which < 2 ? t : t + 1;
                    const float o0 = (i0 < lim) ? acc[0] : 0.f, o1 = (i0 + 1 < lim) ? acc[1] : 0.f, o2 = (i0 + 2 < lim) ? acc[2] : 0.f, o3 = (i0 + 3 < lim) ? acc[3] : 0.f;
#ifdef RW_CLAMP_AAK
                    float q0 = o0, q1 = o1, q2 = o2, q3 = o3;
                    if (which == 1) { q0 = fabsf(o0) < 1e30f ? o0 : 0.f; q1 = fabsf(o1) < 1e30f ? o1 : 0.f; q2 = fabsf(o2) < 1e30f ? o2 : 0.f; q3 = fabsf(o3) < 1e30f ? o3 : 0.f; }
                    if (which == 0) *(LAS f32x4*)(AAB + t * 64 + i0) = (f32x4){o0, o1, o2, o3};
                    else lds_st_bf16x4(RM(7 + which) + t * 144 + i0 * 2, q0, q1, q2, q3);
                    continue;
#endif
                    if (which == 0) { DBG_STAT(11, o0); DBG_STAT(11, o1); DBG_STAT(11, o2); DBG_STAT(11, o3); } if (which == 1) { DBG_STAT(12, o0); DBG_STAT(12, o1); DBG_STAT(12, o2); DBG_STAT(12, o3); } if (which == 2) { DBG_STAT(13, o0); DBG_STAT(13, o3); } if (which == 3) { DBG_STAT(14, o0); DBG_STAT(14, o3); }
                    if (which == 0) *(LAS f32x4*)(AAB + t * 64 + i0) = (f32x4){o0, o1, o2, o3};
                    else lds_st_bf16x4(RM(7 + which) + t * 144 + i0 * 2, o0, o1, o2, o3); } }
        }
        __syncthreads();
        RW_REP(5) {
#pragma unroll 1
            for (int i2 = 0; i2 < 2; ++i2) { const int idx = wave * 2 + i2, vt = idx >> 2, tt = idx & 3; f32x4 acc = {0.f, 0.f, 0.f, 0.f};
                acc = mm16(RM(7) + vt * 16 * 144, 144, RM(8) + tt * 16 * 144, 144, 64, acc, fr, fq);
                DBG_STAT(15, acc[0]); DBG_STAT(15, acc[1]); DBG_STAT(15, acc[2]); DBG_STAT(15, acc[3]);
                lds_st_bf16x4(RM(0) + (vt * 16 + fr) * 144 + (tt * 16 + 4 * fq) * 2, acc[0], acc[1], acc[2], acc[3]); }
        }
        RW_REP(8) if (wave == 0) {
            float x[64]; f32x4 rowq[16];
#pragma unroll
            for (int t = 0; t < 64; ++t) {
                f32x4 cur[16];
#pragma unroll
                for (int i4 = 0; i4 < (t + 3) / 4; ++i4) cur[i4] = rowq[i4];
                if (t + 1 < 64) {
#pragma unroll
                    for (int i4 = 0; i4 < (t + 4) / 4; ++i4) rowq[i4] = *(const LAS f32x4*)(AAB + (t + 1) * 64 + 4 * i4); }
                float a0 = (t == ch) ? 1.0f : 0.f, a1 = 0.f, a2 = 0.f, a3 = 0.f;
#pragma unroll
                for (int i4 = 0; i4 < (t + 3) / 4; ++i4) { const f32x4 q = cur[i4];
                    a0 += q.x * x[4 * i4]; if (4 * i4 + 1 < t) a1 += q.y * x[4 * i4 + 1]; if (4 * i4 + 2 < t) a2 += q.z * x[4 * i4 + 2]; if (4 * i4 + 3 < t) a3 += q.w * x[4 * i4 + 3]; }
                const float acc = (a0 + a1) + (a2 + a3);
                x[t] = acc; lds_st_bf16(RM(11) + t * 144 + ch * 2, acc); }
        }
        __syncthreads();
        RW_REP(6) {
            const int rt = wave >> 1;
#pragma unroll
            for (int i2 = 0; i2 < 2; ++i2) { const int tt = 2 * (wave & 1) + i2;
                f32x4 acc = {0.f, 0.f, 0.f, 0.f}; acc = mm16(RM(4) + rt * 16 * 144, 144, RM(11) + tt * 16 * 144, 144, 64, acc, fr, fq);
                DBG_STAT(17, acc[0]); DBG_STAT(17, acc[1]); DBG_STAT(17, acc[2]); DBG_STAT(17, acc[3]);
                lds_st_bf16x4(RM(2) + (rt * 16 + fr) * 144 + (tt * 16 + 4 * fq) * 2, acc[0], acc[1], acc[2], acc[3]);
                f32x4 ac2 = {0.f, 0.f, 0.f, 0.f}; ac2 = mm16(RM(0) + rt * 16 * 144, 144, RM(11) + tt * 16 * 144, 144, 64, ac2, fr, fq);
                DBG_STAT(18, ac2[0]); DBG_STAT(18, ac2[1]); DBG_STAT(18, ac2[2]); DBG_STAT(18, ac2[3]);
                lds_st_bf16x4(RM(3) + (rt * 16 + fr) * 144 + (tt * 16 + 4 * fq) * 2, ac2[0], ac2[1], ac2[2], ac2[3]); }
        }
        __syncthreads();
        RW_REP(7) {
            const int which = wave >> 1;
#pragma unroll 1
            for (int i2 = 0; i2 < 2; ++i2) { const int rt = 2 * (wave & 1) + i2, row = rt * 16 + fr;
#pragma unroll
                for (int ct = 0; ct < 4; ++ct) { f32x4 acc = {0.f, 0.f, 0.f, 0.f}; const int c0 = ct * 16 + 4 * fq;
                    if (which == 0) { acc = mm16(RM(9) + rt * 16 * 144, 144, RM(2) + ct * 16 * 144, 144, 64, acc, fr, fq);
                        const v2u rw = *(const LAS v2u*)(RM(1) + row * 144 + c0 * 2);
                        acc[0] += __uint_as_float(rw.x << 16); acc[1] += __uint_as_float(rw.x & 0xffff0000u); acc[2] += __uint_as_float(rw.y << 16); acc[3] += __uint_as_float(rw.y & 0xffff0000u);
                        DBG_STAT(19, acc[0]); DBG_STAT(19, acc[1]); DBG_STAT(19, acc[2]); DBG_STAT(19, acc[3]);
                        v2u o; o.x = cvt_pk_bf16(acc[0], acc[1]); o.y = cvt_pk_bf16(acc[2], acc[3]); *(v2u*)(WSP(bf16, WS_RW_RH) + un * 4096 + row * 64 + c0) = o; }
                    else if (which == 1) {
#ifndef RW_NO_U0
                        acc = mm16(RM(9) + rt * 16 * 144, 144, RM(3) + ct * 16 * 144, 144, 64, acc, fr, fq);
#endif
                        acc = mm16(RM(10) + rt * 16 * 144, 144, RM(7) + ct * 16 * 144, 144, 64, acc, fr, fq);
                        DBG_STAT(20, acc[0]); DBG_STAT(20, acc[1]); DBG_STAT(20, acc[2]); DBG_STAT(20, acc[3]);
                        *(f32x4*)(WSP(float, WS_RW_O0) + un * 4096 + row * 64 + c0) = acc; }
                    else if (which == 2) { acc = mm16(RM(5) + rt * 16 * 144, 144, RM(2) + ct * 16 * 144, 144, 64, acc, fr, fq);
                        const float gd = GAMC[row]; if (row == c0) acc[0] += gd; if (row == c0 + 1) acc[1] += gd; if (row == c0 + 2) acc[2] += gd; if (row == c0 + 3) acc[3] += gd;
                        DBG_STAT(21, acc[0]); DBG_STAT(21, acc[1]); DBG_STAT(21, acc[2]); DBG_STAT(21, acc[3]);
                        v2u o; o.x = cvt_pk_bf16(acc[0], acc[1]); o.y = cvt_pk_bf16(acc[2], acc[3]);
                        *(v2u*)((unsigned char*)(WSP(bf16, WS_RW_GF) + un * 4096) + ((rt * 2 + (ct >> 1)) * 64 + ch) * 16 + (ct & 1) * 8) = o; }
                    else { acc = mm16(RM(3) + rt * 16 * 144, 144, RM(5) + ct * 16 * 144, 144, 64, acc, fr, fq); acc = mm16(RM(7) + rt * 16 * 144, 144, RM(6) + ct * 16 * 144, 144, 64, acc, fr, fq);
                        DBG_STAT(22, acc[0]); DBG_STAT(22, acc[1]); DBG_STAT(22, acc[2]); DBG_STAT(22, acc[3]);
                        *(f32x4*)(WSP(float, WS_RW_HT) + un * 4096 + row * 64 + c0) = acc; } } }
        }
        __syncthreads();
    }
#undef RM
}
__device__ __forceinline__ void rwkv_scan_wave(Frame& F, const Args& A, int wslot) {
    const int lane = F.lane, fr = lane & 15, fq = lane >> 4, bh = wslot >> 2, v0 = (wslot & 3) * 16;
    const bf16* GF = WSP(bf16, WS_RW_GF) + (size_t)bh * NCH * 4096; const float* HT = WSP(float, WS_RW_HT) + (size_t)bh * NCH * 4096 + (size_t)(v0 + fr) * 64 + 4 * fq;
    bf16* PT = WSP(bf16, WS_RW_PT) + (size_t)bh * NCH * 4096 + (size_t)(v0 + fr) * 64 + 4 * fq;
    f32x4 P[4] = {{0.f, 0.f, 0.f, 0.f}, {0.f, 0.f, 0.f, 0.f}, {0.f, 0.f, 0.f, 0.f}, {0.f, 0.f, 0.f, 0.f}};
    bf16x8 ga[4][2]; f32x4 hv[4];
#define RW2_LOAD(cc) do { _Pragma("unroll") for (int m = 0; m < 4; ++m) { hv[m] = *(const f32x4*)(HT + (size_t)(cc) * 4096 + 16 * m); \
        _Pragma("unroll") for (int s = 0; s < 2; ++s) ga[m][s] = *(const bf16x8*)(GF + (size_t)(cc) * 4096 + ((m * 2 + s) * 64 + lane) * 8); } } while (0)
    RW2_LOAD(0);
#pragma unroll 1
    for (int c = 0; c < NCH; ++c) {
        bf16x8 gc[4][2]; f32x4 acc[4];
#pragma unroll
        for (int m = 0; m < 4; ++m) { acc[m] = hv[m]; gc[m][0] = ga[m][0]; gc[m][1] = ga[m][1]; }
        if (c + 1 < NCH) RW2_LOAD(c + 1);
        v4u bs[2];
#pragma unroll
        for (int s = 0; s < 2; ++s) { bs[s].x = cvt_pk_bf16(P[2 * s][0], P[2 * s][1]); bs[s].y = cvt_pk_bf16(P[2 * s][2], P[2 * s][3]); bs[s].z = cvt_pk_bf16(P[2 * s + 1][0], P[2 * s + 1][1]); bs[s].w = cvt_pk_bf16(P[2 * s + 1][2], P[2 * s + 1][3]); }
        *(v2u*)(PT + (size_t)c * 4096) = (v2u){bs[0].x, bs[0].y}; *(v2u*)(PT + (size_t)c * 4096 + 16) = (v2u){bs[0].z, bs[0].w};
        *(v2u*)(PT + (size_t)c * 4096 + 32) = (v2u){bs[1].x, bs[1].y}; *(v2u*)(PT + (size_t)c * 4096 + 48) = (v2u){bs[1].z, bs[1].w};
#pragma unroll
        for (int m = 0; m < 4; ++m) { acc[m] = __builtin_amdgcn_mfma_f32_16x16x32_bf16(gc[m][0], __builtin_bit_cast(bf16x8, bs[0]), acc[m], 0, 0, 0);
            acc[m] = __builtin_amdgcn_mfma_f32_16x16x32_bf16(gc[m][1], __builtin_bit_cast(bf16x8, bs[1]), acc[m], 0, 0, 0); P[m] = acc[m]; DBG_STAT(23, acc[m][0]); DBG_STAT(23, acc[m][1]); DBG_STAT(23, acc[m][2]); DBG_STAT(23, acc[m][3]); }
    }
#undef RW2_LOAD
}
__device__ __forceinline__ void rwkv_stage3(Frame& F, const Args& A, int layer, int ub) {
    const int t0 = ub * 64, b_ = ub >> 6, c = ub & 63, lane = F.lane, wave = F.wave, fr = lane & 15, fq = lane >> 4, hh = wave >> 1;
    const size_t un = (size_t)(b_ * 4 + hh) * NCH + c;
    const bf16* RH = WSP(bf16, WS_RW_RH) + un * 4096; const bf16* PT = WSP(bf16, WS_RW_PT) + un * 4096; const float* O0 = WSP(float, WS_RW_O0) + un * 4096;
    const float* RW = WSP(float, WS_RW); const float* RG = WSP(float, WS_RW_G); bf16* mix = WSP(bf16, WS_MIX);
    const float* lg = KIN(I_RLNG) + layer * 256 + hh * 64; const float* lb = KIN(I_RLNB) + layer * 256 + hh * 64; const float* rk = KIN(I_RRK) + layer * 256 + hh * 64;
    bf16x8 pfr[4][2];
#pragma unroll
    for (int vt = 0; vt < 4; ++vt)
#pragma unroll
        for (int ks = 0; ks < 2; ++ks) pfr[vt][ks] = *(const bf16x8*)(PT + (size_t)(vt * 16 + fr) * 64 + ks * 32 + fq * 8);
#pragma unroll 1
    for (int i = 0; i < 2; ++i) { const int tt = 2 * (wave & 1) + i, tl = tt * 16 + fr, t = t0 + tl;
        const bf16x8 ra0 = *(const bf16x8*)(RH + (size_t)tl * 64 + fq * 8), ra1 = *(const bf16x8*)(RH + (size_t)tl * 64 + 32 + fq * 8);
        f32x4 ov[4]; float sm = 0.f;
#pragma unroll
        for (int vt = 0; vt < 4; ++vt) { f32x4 acc = *(const f32x4*)(O0 + tl * 64 + vt * 16 + 4 * fq);
            acc = __builtin_amdgcn_mfma_f32_16x16x32_bf16(pfr[vt][0], ra0, acc, 0, 0, 0); acc = __builtin_amdgcn_mfma_f32_16x16x32_bf16(pfr[vt][1], ra1, acc, 0, 0, 0);
            ov[vt] = acc; DBG_STAT(24, acc[0]); DBG_STAT(24, acc[1]); DBG_STAT(24, acc[2]); DBG_STAT(24, acc[3]); sm += (acc.x + acc.y) + (acc.z + acc.w); }
        sm += __shfl_xor(sm, 16); sm += __shfl_xor(sm, 32);
        const float mean = sm * (1.f / 64.f); float sq = 0.f;
#pragma unroll
        for (int vt = 0; vt < 4; ++vt) { ov[vt] = ov[vt] - mean; sq += (ov[vt].x * ov[vt].x + ov[vt].y * ov[vt].y) + (ov[vt].z * ov[vt].z + ov[vt].w * ov[vt].w); }
        sq += __shfl_xor(sq, 16); sq += __shfl_xor(sq, 32);
        const float rs = 1.0f / sqrtf(sq * (1.f / 64.f) + RWKV_GN_EPS);
        float bd = 0.f;
#pragma unroll
        for (int q = 0; q < 4; ++q) { const f32x4 r4 = *(const f32x4*)(RW + (size_t)t * 768 + hh * 64 + fq * 16 + 4 * q), k4 = *(const f32x4*)(RW + (size_t)t * 768 + 256 + hh * 64 + fq * 16 + 4 * q), c4 = *(const f32x4*)(rk + fq * 16 + 4 * q);
            bd += (r4.x * k4.x * c4.x + r4.y * k4.y * c4.y) + (r4.z * k4.z * c4.z + r4.w * k4.w * c4.w); }
        bd += __shfl_xor(bd, 16); bd += __shfl_xor(bd, 32);
#pragma unroll
        for (int vt = 0; vt < 4; ++vt) { const int col = vt * 16 + 4 * fq; const f32x4 g4 = *(const f32x4*)(lg + col), b4 = *(const f32x4*)(lb + col);
            const f32x4 v4 = *(const f32x4*)(RW + (size_t)t * 768 + 512 + hh * 64 + col), gg = *(const f32x4*)(RG + (size_t)t * 256 + hh * 64 + col);
            float e0 = (ov[vt].x * rs * g4.x + b4.x + bd * v4.x) * gg.x, e1 = (ov[vt].y * rs * g4.y + b4.y + bd * v4.y) * gg.y, e2 = (ov[vt].z * rs * g4.z + b4.z + bd * v4.z) * gg.z, e3 = (ov[vt].w * rs * g4.w + b4.w + bd * v4.w) * gg.w;
#ifdef RW_SANITIZE
            e0 = (fabsf(e0) < 1e30f) ? e0 : 0.f; e1 = (fabsf(e1) < 1e30f) ? e1 : 0.f; e2 = (fabsf(e2) < 1e30f) ? e2 : 0.f; e3 = (fabsf(e3) < 1e30f) ? e3 : 0.f;
#endif
            v2u o; o.x = cvt_pk_bf16(e0, e1); o.y = cvt_pk_bf16(e2, e3);
            *(v2u*)(mix + (size_t)t * D + 256 + hh * 64 + col) = o; } }
}

__device__ __forceinline__ void scans_elementwise(Frame& F, const Args& A) {
    const int nthr = F.G * 448, gt = F.vcu * 448 + (F.tid - 64);
    constexpr int N_SSD = 16 * 64 * 128, N_GLA = 16 * 32 * 64, N_MLC = 16 * 64 * 64, N_MLN = 16 * 64;
    for (int i = gt; i < N_SSD + N_GLA + N_MLC + N_MLN; i += nthr) {
        if (i < N_SSD) { const int bh = i >> 13, pn = i & 8191; float* base = WSP(float, WS_SSD_ST) + (size_t)bh * NCH * 8192 + pn; const float* dec = WSP(float, WS_SSD_DEC) + bh * NCH; float S = 0.f;
#pragma unroll 1
            for (int c0 = 0; c0 < NCH; c0 += 32) { float x[32], dd[32];
#pragma unroll
                for (int j = 0; j < 32; ++j) { x[j] = base[(size_t)(c0 + j) * 8192]; dd[j] = dec[c0 + j]; }
#pragma unroll
                for (int j = 0; j < 32; ++j) { base[(size_t)(c0 + j) * 8192] = S; S = dd[j] * S + x[j]; } }
        } else if (i < N_SSD + N_GLA) { const int k = i - N_SSD, bh = k >> 11, dv = k & 2047, dd_ = dv >> 6, b = bh >> 2, hh = bh & 3; float* base = WSP(float, WS_GLA_ST) + (size_t)bh * NCH * 2048 + dv; const float* dec = WSP(float, WS_GLA_DEC) + (size_t)b * NCH * 128 + hh * 32 + dd_; float S = 0.f;
#pragma unroll 1
            for (int c0 = 0; c0 < NCH; c0 += 32) { float x[32], dd[32];
#pragma unroll
                for (int j = 0; j < 32; ++j) { x[j] = base[(size_t)(c0 + j) * 2048]; dd[j] = dec[(c0 + j) * 128]; }
#pragma unroll
                for (int j = 0; j < 32; ++j) { base[(size_t)(c0 + j) * 2048] = S; S = dd[j] * S + x[j]; } }
        } else { const int k = i - N_SSD - N_GLA; const bool isn = k >= N_MLC; const int kk = isn ? k - N_MLC : k; const int bh = isn ? (kk >> 6) : (kk >> 12), e = isn ? (kk & 63) : (kk & 4095), str = isn ? 64 : 4096;
            float* base = (isn ? WSP(float, WS_ML_N) : WSP(float, WS_ML_C)) + (size_t)bh * NCH * str + e; const float* bl = WSP(float, WS_ML_BL) + bh * NCH; const float* ml = WSP(float, WS_ML_ML) + bh * NCH; float* mo = WSP(float, WS_ML_M) + bh * NCH;
            float S = 0.f, m = 0.f;
#pragma unroll 1
            for (int c0 = 0; c0 < NCH; c0 += 32) { float x[32], b8[32], m8[32];
#pragma unroll
                for (int j = 0; j < 32; ++j) { x[j] = base[(size_t)(c0 + j) * str]; b8[j] = bl[c0 + j]; m8[j] = ml[c0 + j]; }
#pragma unroll
                for (int j = 0; j < 32; ++j) { const float mn = fmaxf(b8[j] + m, m8[j]); const float so = __expf(b8[j] + m - mn), sn = __expf(m8[j] - mn);
                    base[(size_t)(c0 + j) * str] = S; if (!isn && e == 0) mo[c0 + j] = m; S = so * S + sn * x[j]; m = mn; } }
        }
    }
}
#ifndef MK_PER_PHASE_LAUNCH
#define MK_PER_PHASE_LAUNCH 0
#endif
#ifndef PH_MASK
#define PH_MASK 0xFFF
#endif
#ifndef ST_MASK
#define ST_MASK 0xF
#endif
#define ST_ON(k) (((ST_MASK) >> (k)) & 1)
#ifndef DUP_MASK
#define DUP_MASK 0
#endif
#define DUP_N(k) ((((DUP_MASK) >> (k)) & 1) ? 2 : 1)
#ifndef ST_DUP
#define ST_DUP 0
#endif
#define ST_REP(ty) ((((ST_DUP) >> (ty)) & 1) ? 2 : 1)
#define PH_ON(k) (((PH_MASK) >> (k)) & 1)
constexpr int PH_PER_LAYER = 11, N_PHASES = 1 + DEPTH * PH_PER_LAYER;
__global__ void __launch_bounds__(NWAVES * 64, 2) fwd_kernel(Args args) {
    extern __shared__ __attribute__((aligned(16))) unsigned char lds[];
    Frame F;
    F.lds = (LAS unsigned char*)lds;
    F.MISC = (volatile LAS unsigned*)(F.lds + MISC_OFF);
    F.tid = threadIdx.x; F.lane = F.tid & 63; F.wave = __builtin_amdgcn_readfirstlane(F.tid >> 6);
    F.G = gridDim.x; { const int bx = blockIdx.x; F.vcu = (F.G % 8 == 0) ? (bx % 8) * (F.G / 8) + bx / 8 : bx; }
    F.ka = (karg_t)__builtin_amdgcn_kernarg_segment_ptr(); F.ws = args.ws; F.ctl = (gu32*)(args.ws + WS_CTL); F.out = args.out;
    for (int i = F.tid; i < 256; i += NWAVES * 64) F.MISC[i] = 0u;
    __syncthreads();
    const int lo = args.ph_lo, hi = args.ph_hi;
#ifdef DBG_TSEL
    if (blockIdx.x == 0 && threadIdx.x == 0) __hip_atomic_store(F.ctl + CW_DBG + 15, (unsigned)__builtin_amdgcn_s_memrealtime(), RLX_AGENT);
#endif
    XcdBarrier bar; bar.bar = (unsigned*)(F.ctl + CW_BAR); bar.x = 0; bar.st = nullptr;
    if (hi - lo > 1) bar = xcd_barrier_post((unsigned*)(F.ctl + CW_BAR), F.MISC + MW_BAR);
#define IN_(k) (lo <= (k) && (k) < hi)
#ifdef DBG_TSEL
#ifndef DBG_TQ
#define DBG_TQ 50.0f
#endif
#define TSTAMP(k) do { if (blockIdx.x == 0 && threadIdx.x == 0) __hip_atomic_store(F.ctl + CW_DBG + 16 + ((k) == 11 ? 0 : 1 + layer_ * PH_PER_LAYER + (k)), (unsigned)__builtin_amdgcn_s_memrealtime(), RLX_AGENT); } while (0)
#else
#define TSTAMP(k) do { } while (0)
#endif
#ifdef BAR_DUP
#define SEAM(k) do { if (IN_(k) && IN_((k) + 1)) { xcd_barrier(bar); xcd_barrier(bar); } } while (0)
#else
#define SEAM(k) do { if (IN_(k) && IN_((k) + 1)) xcd_barrier(bar); } while (0)
#endif

    if (PH_ON(11) && IN_(0)) { for (int rep_ = 0; rep_ < DUP_N(11); ++rep_) { frame_refresh(F); p0_prologue(F, args); } SEAM(0); { const int layer_ = 0; TSTAMP(11); (void)layer_; } }
#pragma unroll 1
    for (int layer = 0; layer < DEPTH; ++layer) {
        const int pb = 1 + layer * PH_PER_LAYER; const int layer_ = layer; (void)layer_;
        if (PH_ON(0) && IN_(pb + 0)) { for (int rep_ = 0; rep_ < DUP_N(0); ++rep_) { frame_refresh(F);
            { pg8::DenseSched S; S.init(WSP(bf16, WS_XB), WSP(bf16, WS_WIN_T) + (size_t)layer * NUP * D, T, NUP, D, F.G, (int)blockIdx.x);
              pg8::EpiB16 E{WSP(bf16, WS_U), NUP, nullptr, 0.f};
              pg8::gemm_phase<pg8::EpiB16, pg8::DenseSched>(F.lds, F.tid, S, E); }
            { pg8::DenseSched S; S.init(WSP(bf16, WS_PB) + (size_t)layer * T * 256, WSP(bf16, WS_WPP_T) + (size_t)layer * D * 256, T, D, 256, F.G, (int)blockIdx.x);
              pg8::EpiB16 E{WSP(bf16, WS_PE), D, nullptr, 0.f};
              pg8::gemm_phase<pg8::EpiB16, pg8::DenseSched>(F.lds, F.tid, S, E); }
            } SEAM(pb + 0); TSTAMP(0);
        }
        if (PH_ON(1) && IN_(pb + 1)) { for (int rep_ = 0; rep_ < DUP_N(1); ++rep_) { frame_refresh(F);
            for (int un = F.vcu; un < 1024; un += F.G) { frame_refresh(F); const int ty = un >> 8, r = un & 255, b = r >> 6, c = r & 63;
                if (ty == 0) { ssd_stage1(F, args, layer, b, c); if (ST_DUP & 1) ssd_stage1(F, args, layer, b, c); } else if (ty == 1) { gla_stage1(F, args, layer, b, c); if (ST_DUP & 2) gla_stage1(F, args, layer, b, c); } else if (ty == 2) { mlstm_stage1(F, args, layer, b, c); if (ST_DUP & 4) mlstm_stage1(F, args, layer, b, c); } else { rwkv_stage1(F, args, layer, r); if (ST_DUP & 8) rwkv_stage1(F, args, layer, r); } }
            } SEAM(pb + 1); TSTAMP(1);
        }
        if (PH_ON(2) && IN_(pb + 2)) { for (int rep_ = 0; rep_ < DUP_N(2); ++rep_) { frame_refresh(F);
            if (F.wave == 0) { for (int ws_ = F.vcu; ws_ < 64; ws_ += F.G) rwkv_scan_wave(F, args, ws_); }
            else if (rep_ == 0) scans_elementwise(F, args);
            } SEAM(pb + 2); TSTAMP(2);
        }
        if (PH_ON(3) && IN_(pb + 3)) { for (int rep_ = 0; rep_ < DUP_N(3); ++rep_) { frame_refresh(F);
            for (int un = F.vcu; un < 1024; un += F.G) { frame_refresh(F); const int ty = un >> 8, r = un & 255, b = r >> 6, c = r & 63;
                if (ty == 0) { ssd_stage3(F, args, layer, b, c); if (ST_DUP & 16) ssd_stage3(F, args, layer, b, c); } else if (ty == 1) { gla_stage3(F, args, layer, b, c); if (ST_DUP & 32) gla_stage3(F, args, layer, b, c); } else if (ty == 2) { mlstm_stage3(F, args, layer, b, c); if (ST_DUP & 64) mlstm_stage3(F, args, layer, b, c); } else { rwkv_stage3(F, args, layer, r); if (ST_DUP & 128) rwkv_stage3(F, args, layer, r); } }
            } SEAM(pb + 3); TSTAMP(3);
        }
        if (PH_ON(4) && IN_(pb + 4)) { for (int rep_ = 0; rep_ < DUP_N(4); ++rep_) { frame_refresh(F);
            pg8::DenseSched S; S.init(WSP(bf16, WS_MIX), WSP(bf16, WS_WOUT_T) + (size_t)layer * D * D, T, D, D, F.G, (int)blockIdx.x);
            pg8::EpiB16 E{WSP(bf16, WS_Y1), D, WSP(bf16, WS_XB), DN_ALPHA};
            pg8::gemm_phase<pg8::EpiB16, pg8::DenseSched>(F.lds, F.tid, S, E);
            } SEAM(pb + 4); TSTAMP(4);
        }
        if (PH_ON(5) && IN_(pb + 5)) { if (DUP_N(5) == 2) { frame_refresh(F); p6_ln1_router<true>(F, args, layer); } frame_refresh(F); p6_ln1_router<false>(F, args, layer); SEAM(pb + 5); TSTAMP(5); }
        if (PH_ON(6) && IN_(pb + 6)) { for (int rep_ = 0; rep_ < DUP_N(6); ++rep_) { frame_refresh(F);
            moe_build_pfx(F, args, layer, 8);
            pg8::Moe1Sched S; S.O.pfx = F.MISC + MW_PFX; S.O.NT = 8; S.O.G = F.G; S.O.c = (int)blockIdx.x; S.sdest = WSP(int, WS_SDEST);
            if (MOE_FP8) { S.X = WSP(unsigned char, WS_X1Q); S.W = WSP(unsigned char, WS_WGU_Q) + (size_t)layer * NE * 2048 * D; S.K = D / 2; S.hstepB = (size_t)1024 * D; }
            else { S.X = WSP(unsigned char, WS_X1B); S.W = WSP(unsigned char, WS_WGU_T) + (size_t)layer * NE * 2048 * D * 2; S.K = D; S.hstepB = (size_t)1024 * D * 2; }
            pg8::EpiMoe1 E{WSP(bf16, WS_ABUF), KIN(I_BGU) + (size_t)layer * NE * 2048, WSP(unsigned char, WS_ABUFQ)};
            pg8::gemm_phase<pg8::EpiMoe1, pg8::Moe1Sched>(F.lds, F.tid, S, E);
            } SEAM(pb + 6); TSTAMP(6);
        }
        if (PH_ON(7) && IN_(pb + 7)) { for (int rep_ = 0; rep_ < DUP_N(7); ++rep_) { frame_refresh(F);
            moe_build_pfx(F, args, layer, 4);
            pg8::Moe2Sched S; S.O.pfx = F.MISC + MW_PFX; S.O.NT = 4; S.O.G = F.G; S.O.c = (int)blockIdx.x; if (MOE2_FP8) { S.Ab = WSP(unsigned char, WS_ABUFQ); S.W = WSP(unsigned char, WS_WDN_Q) + (size_t)layer * NE * D * D; S.K = D / 2; S.hstepB = (size_t)128 * D; }
            else { S.Ab = WSP(unsigned char, WS_ABUF); S.W = WSP(unsigned char, WS_WDN_T) + (size_t)layer * NE * D * D * 2; S.K = D; S.hstepB = (size_t)128 * D * 2; }
            pg8::EpiMoe2 E{WSP(bf16, WS_YBUF), KIN(I_BDN) + (size_t)layer * NE * D, WSP(int, WS_SDEST), WSP(float, WS_SGATE)};
            pg8::gemm_phase<pg8::EpiMoe2, pg8::Moe2Sched>(F.lds, F.tid, S, E);
            } SEAM(pb + 7); TSTAMP(7);
        }
        if (PH_ON(8) && IN_(pb + 8)) { for (int rep_ = 0; rep_ < DUP_N(8); ++rep_) { frame_refresh(F); p9_combine(F, args); } SEAM(pb + 8); TSTAMP(8); }
        if (PH_ON(9) && IN_(pb + 9)) { for (int rep_ = 0; rep_ < DUP_N(9); ++rep_) { frame_refresh(F);
            pg8::DenseSched S; S.init(WSP(bf16, WS_HB), WSP(bf16, WS_WPG_T) + (size_t)layer * D * D, T, D, D, F.G, (int)blockIdx.x);
            pg8::EpiPle E{WSP(bf16, WS_H2), WSP(bf16, WS_HB), WSP(bf16, WS_PE)};
            pg8::gemm_phase<pg8::EpiPle, pg8::DenseSched>(F.lds, F.tid, S, E);
            } SEAM(pb + 9); TSTAMP(9);
        }
        if (PH_ON(10) && IN_(pb + 10)) { for (int rep_ = 0; rep_ < DUP_N(10); ++rep_) { frame_refresh(F); p11_ln2(F, args, layer); } SEAM(pb + 10); TSTAMP(10); }
    }
#ifdef DBG_TSEL
    if (hi - lo > 1) { xcd_barrier(bar);
        unsigned ticks = 0u;
        if (DBG_TSEL == 11) ticks = __hip_atomic_load(F.ctl + CW_DBG + 16, RLX_AGENT) - __hip_atomic_load(F.ctl + CW_DBG + 15, RLX_AGENT);
        else for (int l = 0; l < DEPTH; ++l) { const int pi = 1 + l * PH_PER_LAYER + DBG_TSEL; ticks += __hip_atomic_load(F.ctl + CW_DBG + 16 + pi, RLX_AGENT) - __hip_atomic_load(F.ctl + CW_DBG + 16 + pi - 1, RLX_AGENT); }
        const float us = floorf((float)ticks * 0.01f / DBG_TQ) * DBG_TQ; const float code = sqrtf(us * 0.05f);
        for (size_t i = (size_t)blockIdx.x * 512 + threadIdx.x; i < (size_t)T * D; i += (size_t)gridDim.x * 512) F.out[i] = code; }
#endif
#ifdef DBG_SEL
    if (hi - lo > 1) { xcd_barrier(bar);
        const unsigned mx = __hip_atomic_load(F.ctl + CW_DBG, RLX_AGENT), nf = __hip_atomic_load(F.ctl + CW_DBG + 1, RLX_AGENT);
        float code;
        { const float m = __uint_as_float(mx); int b = (m > 0.f) ? (int)floorf(log10f(m)) + 30 : 0; b = b < 0 ? 0 : (b > 60 ? 60 : b); if (nf) b += 100; code = sqrtf(10.0f * (float)(b + 1)); }
        for (size_t i = (size_t)blockIdx.x * 512 + threadIdx.x; i < (size_t)T * D; i += (size_t)gridDim.x * 512) F.out[i] = code; }
#endif
#undef IN_
#undef SEAM
}

extern "C" void kernel_launch(void* const* d_in, const int* in_sizes, int n_in, void* d_out, int out_size, void* d_ws, size_t ws_size, hipStream_t stream) {
    static int grid = 0;
    if (grid == 0) {
        if (n_in != N_IN || out_size != T * D || ws_size < WS_END) { fprintf(stderr, "kernel_launch: unexpected shapes (n_in %d, out %d, ws %zu < %zu); nothing launched\n", n_in, out_size, ws_size, (size_t)WS_END); grid = -1; return; }
        int dev = 0, cus = 0, per_cu = 0;
        if (hipGetDevice(&dev) != hipSuccess || hipDeviceGetAttribute(&cus, hipDeviceAttributeMultiprocessorCount, dev) != hipSuccess) { grid = -1; return; }
        if (hipFuncSetAttribute((const void*)fwd_kernel, hipFuncAttributeMaxDynamicSharedMemorySize, LDS_BYTES) != hipSuccess) { fprintf(stderr, "kernel_launch: hipFuncSetAttribute failed\n"); grid = -1; return; }
        if (hipOccupancyMaxActiveBlocksPerMultiprocessor(&per_cu, (const void*)fwd_kernel, NWAVES * 64, LDS_BYTES) != hipSuccess || per_cu < 1) { fprintf(stderr, "kernel_launch: occupancy query says %d blocks per CU\n", per_cu); }
        (void)hipGetLastError();
        grid = cus;
    }
    if (grid < 0) return;
    (void)hipMemsetAsync((char*)d_ws + WS_CTL, 0, CTL_ZERO_BYTES, stream);
    Args a{};
    for (int i = 0; i < N_IN; ++i) a.in[i] = (const float*)d_in[i];
    a.out = (float*)d_out; a.ws = (unsigned char*)d_ws;
#if MK_PER_PHASE_LAUNCH
    for (int ph = 0; ph < N_PHASES; ++ph) { a.ph_lo = ph; a.ph_hi = ph + 1; hipLaunchKernelGGL(fwd_kernel, dim3(grid), dim3(NWAVES * 64), LDS_BYTES, stream, a); }
#else
    a.ph_lo = 0; a.ph_hi = N_PHASES; hipLaunchKernelGGL(fwd_kernel, dim3(grid), dim3(NWAVES * 64), LDS_BYTES, stream, a);
#endif
    const hipError_t le = hipPeekAtLastError();
    if (le != hipSuccess) fprintf(stderr, "kernel_launch: launch failed: %s\n", hipGetErrorName(le));
}
```

```cpp
#include <hip/hip_runtime.h>
#include <cstdio>
#include <cstdint>

#define GAS __attribute__((address_space(1)))
#define LAS __attribute__((address_space(3)))
typedef unsigned short bf16;
typedef unsigned v4u __attribute__((ext_vector_type(4)));
typedef unsigned v2u __attribute__((ext_vector_type(2)));
typedef float f32x4 __attribute__((ext_vector_type(4)));
typedef float f32x2 __attribute__((ext_vector_type(2)));
typedef short bf16x8 __attribute__((ext_vector_type(8)));
typedef int v4i_t __attribute__((ext_vector_type(4)));
typedef int v8i_t __attribute__((ext_vector_type(8)));
typedef GAS unsigned gu32;
#define RLX_AGENT __ATOMIC_RELAXED, __HIP_MEMORY_SCOPE_AGENT
#define LDS_WAIT() asm volatile("s_waitcnt lgkmcnt(0)" ::: "memory")
#define VM_WAIT() asm volatile("s_waitcnt vmcnt(0)" ::: "memory")

constexpr int NWAVES = 8;
constexpr int DEPTH = 4, BATCH = 4, SEQ = 4096, D = 1024, T = BATCH * SEQ;
constexpr int NU = 3484, NUP = 3584;
constexpr int NE = 32, TOPK = 4, ECAP = 16384;
constexpr int NCH = SEQ / 64;
constexpr int U_SSD_Z = 0, U_SSD_X = 256, U_SSD_B = 512, U_SSD_C = 640, U_SSD_DT = 768;
constexpr int U_RW = 772, U_RW_R = 772, U_RW_K = 1028, U_RW_V = 1284, U_RW_LO = 1540;
constexpr int U_GL_Q = 1668, U_GL_K = 1796, U_GL_V = 1924, U_GL_G = 2180, U_GL_OG = 2196;
constexpr int U_ML_Q = 2452, U_ML_K = 2708, U_ML_V = 2964, U_ML_I = 3220, U_ML_F = 3224, U_ML_O = 3228;
constexpr float DN_ALPHA = 1.6817928305074290f;
constexpr float LN_EPS = 1e-5f, NORM_EPS = 1e-5f, RWKV_GN_EPS = 64e-5f;

enum { I_X = 0, I_P, I_WIN, I_WOUT, I_LN1G, I_LN1B, I_SCW, I_SCB, I_SALOG, I_SDTB, I_SD, I_SNG,
       I_RMU, I_RW0, I_RWUP, I_RA0, I_RAUP, I_RGUP, I_RKK, I_RKA, I_RRK, I_RLNG, I_RLNB,
       I_GGUP, I_GGB, I_GNG, I_MCW, I_MCB, I_MIB, I_MFB, I_MNG,
       I_RTW, I_RTB, I_WGU, I_BGU, I_WDN, I_BDN, I_PGW, I_PPJ, I_LN2G, I_LN2B, N_IN };

constexpr size_t MiB = 1u << 20;
constexpr size_t WS_CTL = 0, CTL_ZERO_BYTES = 1 * MiB;
constexpr size_t WS_WIN_T = 2 * MiB;
constexpr size_t WS_WOUT_T = WS_WIN_T + (size_t)DEPTH * NUP * D * 2;
constexpr size_t WS_WGU_T = WS_WOUT_T + (size_t)DEPTH * D * D * 2;
constexpr size_t WS_WDN_T = WS_WGU_T + (size_t)DEPTH * NE * 2048 * D * 2;
constexpr size_t WS_WPG_T = WS_WDN_T + (size_t)DEPTH * NE * D * D * 2;
constexpr size_t WS_WPP_T = WS_WPG_T + (size_t)DEPTH * D * D * 2;
constexpr size_t WS_RWT = WS_WPP_T + (size_t)DEPTH * D * 256 * 2;
constexpr size_t WS_PB = WS_RWT + (size_t)DEPTH * NE * D * 4;
constexpr size_t WS_XB = WS_PB + (size_t)DEPTH * T * 256 * 2;
constexpr size_t WS_U = WS_XB + (size_t)T * D * 2;
constexpr size_t WS_PE = WS_U + (size_t)T * NUP * 2;
constexpr size_t WS_MIX = WS_PE + (size_t)T * D * 4;
constexpr size_t WS_Y1 = WS_MIX + (size_t)T * D * 2;
constexpr size_t WS_X1 = WS_Y1 + (size_t)T * D * 4;
constexpr size_t WS_X1B = WS_X1 + (size_t)T * D * 4;
constexpr size_t WS_SDEST = WS_X1B + (size_t)T * D * 2;
constexpr size_t WS_SGATE = WS_SDEST + (size_t)NE * ECAP * 4;
constexpr size_t WS_ABUF = WS_SGATE + (size_t)NE * ECAP * 4;
constexpr size_t WS_YBUF = WS_ABUF + (size_t)NE * ECAP * D * 2;
constexpr size_t WS_H = WS_YBUF + (size_t)T * 4 * D * 2;
constexpr size_t WS_HB = WS_H + (size_t)T * D * 4;
constexpr size_t WS_H2 = WS_HB + (size_t)T * D * 2;
constexpr size_t WS_SSD_ST = WS_H2 + (size_t)T * D * 4;
constexpr size_t WS_SSD_DEC = WS_SSD_ST + (size_t)16 * NCH * 64 * 128 * 4;
constexpr size_t WS_GLA_ST = WS_SSD_DEC + 16 * NCH * 4;
constexpr size_t WS_GLA_DEC = WS_GLA_ST + (size_t)16 * NCH * 32 * 64 * 4;
constexpr size_t WS_ML_C = WS_GLA_DEC + (size_t)4 * NCH * 128 * 4;
constexpr size_t WS_ML_N = WS_ML_C + (size_t)16 * NCH * 64 * 64 * 4;
constexpr size_t WS_ML_BL = WS_ML_N + (size_t)16 * NCH * 64 * 4;
constexpr size_t WS_ML_ML = WS_ML_BL + 16 * NCH * 4;
constexpr size_t WS_ML_M = WS_ML_ML + 16 * NCH * 4;
constexpr size_t WS_RW = WS_ML_M + 16 * NCH * 4;
constexpr size_t WS_RW_G = WS_RW + (size_t)T * 3 * 256 * 4;
constexpr size_t WS_RW_RH = WS_RW_G + (size_t)T * 256 * 4;
constexpr size_t WS_RW_O0 = WS_RW_RH + (size_t)1024 * 4096 * 2;
constexpr size_t WS_RW_GF = WS_RW_O0 + (size_t)1024 * 4096 * 4;
constexpr size_t WS_RW_HT = WS_RW_GF + (size_t)1024 * 4096 * 2;
constexpr size_t WS_RW_PT = WS_RW_HT + (size_t)1024 * 4096 * 4;
constexpr size_t WS_LORA = WS_RW_PT + (size_t)1024 * 4096 * 2;
constexpr int LORA_PER_LAYER = 8192 + 8192 + 16384 + 2048;
constexpr size_t WS_WGU_Q = WS_LORA + (size_t)DEPTH * LORA_PER_LAYER * 4;
constexpr size_t WS_WDN_Q = WS_WGU_Q + (size_t)DEPTH * NE * 2048 * D;
constexpr size_t WS_X1Q = WS_WDN_Q + (size_t)DEPTH * NE * D * D;
constexpr size_t WS_ABUFQ = WS_X1Q + (size_t)T * D;
constexpr size_t WS_END = WS_ABUFQ + (size_t)NE * ECAP * D;
#ifndef MOE_FP8
#define MOE_FP8 1
#endif
#ifndef MOE2_FP8
#define MOE2_FP8 1
#endif
constexpr int CW_BAR = 4096;
constexpr int CW_DBG = 32768;
constexpr int CW_CNT = 16384;

constexpr int RING_BYTES = 147456;
constexpr int MISC_OFF = RING_BYTES;
constexpr int LDS_BYTES = RING_BYTES + 1024;
constexpr int MW_BAR = 8, MW_LCNT = 32, MW_LBASE = 64, MW_PFX = 96, MW_CNT = 136, MW_GAMC = 168;

typedef __bf16 bf16x2_t __attribute__((ext_vector_type(2)));
__device__ __forceinline__ unsigned cvt_pk_bf16(float lo, float hi) { const f32x2 v = {lo, hi}; const bf16x2_t b = __builtin_convertvector(v, bf16x2_t); return __builtin_bit_cast(unsigned, b); }
__device__ __forceinline__ unsigned cvt4_fp8(float a, float b, float c, float d) { int w = 0; w = __builtin_amdgcn_cvt_pk_fp8_f32(a, b, w, false); w = __builtin_amdgcn_cvt_pk_fp8_f32(c, d, w, true); return (unsigned)w; }
__device__ __forceinline__ float bf2f(unsigned short b) { return __uint_as_float(((unsigned)b) << 16); }
__device__ __forceinline__ float sigmoidf_(float x) { return 1.0f / (1.0f + __expf(-x)); }
__device__ __forceinline__ float siluf_(float x) { return x / (1.0f + __expf(-x)); }
__device__ __forceinline__ float softplusf_(float x) { return fmaxf(x, 0.f) + __logf(1.0f + __expf(-fabsf(x))); }
__device__ __forceinline__ float logsigmoidf_(float x) { return fminf(x, 0.f) - __logf(1.0f + __expf(-fabsf(x))); }
__device__ __forceinline__ float tanhf_(float x) { const float e = __expf(-2.0f * fabsf(x)); const float t = (1.0f - e) / (1.0f + e); return x < 0.f ? -t : t; }
__device__ __forceinline__ int lane_now() { int l = (int)__builtin_amdgcn_mbcnt_hi(~0u, __builtin_amdgcn_mbcnt_lo(~0u, 0u)); asm volatile("" : "+v"(l)); return l; }
__device__ __forceinline__ float my_shfl_idx(float v, int src) { return __builtin_bit_cast(float, __builtin_amdgcn_ds_bpermute(src << 2, __builtin_bit_cast(int, v))); }
__device__ __forceinline__ int my_shfl_idx(int v, int src) { return __builtin_amdgcn_ds_bpermute(src << 2, v); }
template <class V> __device__ __forceinline__ V my_shfl_xor(V v, int o) { return my_shfl_idx(v, lane_now() ^ o); }
template <class V> __device__ __forceinline__ V my_shfl_up(V v, int o) { const int l = lane_now(); return my_shfl_idx(v, l >= o ? l - o : l); }
#define __shfl_xor(v, o) my_shfl_xor(v, o)
#define __shfl_up(v, o) my_shfl_up(v, o)
#define __shfl(v, s) my_shfl_idx(v, s)
__device__ __forceinline__ float wave_sum(float v) {
#pragma unroll
    for (int o = 1; o < 64; o <<= 1) v += __shfl_xor(v, o);
    return v;
}
__device__ __forceinline__ float wave_max(float v) {
#pragma unroll
    for (int o = 1; o < 64; o <<= 1) v = fmaxf(v, __shfl_xor(v, o));
    return v;
}
__device__ __forceinline__ float wave_scan_add(float v, int lane) {
#pragma unroll
    for (int o = 1; o < 64; o <<= 1) { const float t = __shfl_up(v, o); if (lane >= o) v += t; }
    return v;
}
__device__ __forceinline__ float wave_scan_max(float v, int lane) {
#pragma unroll
    for (int o = 1; o < 64; o <<= 1) { const float t = __shfl_up(v, o); if (lane >= o) v = fmaxf(v, t); }
    return v;
}
__device__ __forceinline__ f32x4 mm16(const LAS unsigned char* A, int lda, const LAS unsigned char* B, int ldb, int K, f32x4 acc, int fr, int fq) {
    const LAS unsigned char* ap = A + fr * lda + fq * 16; const LAS unsigned char* bp = B + fr * ldb + fq * 16;
    for (int k = 0; k < K; k += 32) {
        const bf16x8 a = *(const LAS bf16x8*)(ap + k * 2); const bf16x8 b = *(const LAS bf16x8*)(bp + k * 2);
        acc = __builtin_amdgcn_mfma_f32_16x16x32_bf16(b, a, acc, 0, 0, 0);
    }
    return acc;
}
__device__ __forceinline__ f32x4 mm16_gB(const LAS unsigned char* A, int lda, const float* B, int ldb, int K, f32x4 acc, int fr, int fq) {
    const LAS unsigned char* ap = A + fr * lda + fq * 16; const float* bp = B + (size_t)fr * ldb + fq * 8;
    for (int k = 0; k < K; k += 32) {
        const bf16x8 a = *(const LAS bf16x8*)(ap + k * 2);
        const f32x4 b0 = *(const f32x4*)(bp + k), b1 = *(const f32x4*)(bp + k + 4);
        v4u bw; bw.x = cvt_pk_bf16(b0.x, b0.y); bw.y = cvt_pk_bf16(b0.z, b0.w); bw.z = cvt_pk_bf16(b1.x, b1.y); bw.w = cvt_pk_bf16(b1.z, b1.w);
        const bf16x8 b = __builtin_bit_cast(bf16x8, bw);
        acc = __builtin_amdgcn_mfma_f32_16x16x32_bf16(b, a, acc, 0, 0, 0);
    }
    return acc;
}
__device__ __forceinline__ f32x4 mm16_gAB(const bf16* A, int lda, const bf16* B, int ldb, int K, f32x4 acc, int fr, int fq) {
    const bf16* ap = A + (size_t)fr * lda + fq * 8; const bf16* bp = B + (size_t)fr * ldb + fq * 8;
    for (int k = 0; k < K; k += 32) { const bf16x8 a = *(const bf16x8*)(ap + k), b = *(const bf16x8*)(bp + k); acc = __builtin_amdgcn_mfma_f32_16x16x32_bf16(b, a, acc, 0, 0, 0); }
    return acc;
}
__device__ __forceinline__ bf16x8 ldfrag_f32(const float* p) { const f32x4 b0 = *(const f32x4*)p, b1 = *(const f32x4*)(p + 4);
    v4u bw; bw.x = cvt_pk_bf16(b0.x, b0.y); bw.y = cvt_pk_bf16(b0.z, b0.w); bw.z = cvt_pk_bf16(b1.x, b1.y); bw.w = cvt_pk_bf16(b1.z, b1.w); return __builtin_bit_cast(bf16x8, bw); }
template <int NK> __device__ __forceinline__ f32x4 mm16_rB(const LAS unsigned char* A, int lda, const bf16x8 (&b)[NK], f32x4 acc, int fr, int fq) {
    const LAS unsigned char* ap = A + fr * lda + fq * 16;
#pragma unroll
    for (int k = 0; k < NK; ++k) { const bf16x8 a = *(const LAS bf16x8*)(ap + k * 64); acc = __builtin_amdgcn_mfma_f32_16x16x32_bf16(b[k], a, acc, 0, 0, 0); }
    return acc;
}
__device__ __forceinline__ v4u pack8(const float (&v)[8]) { v4u o; o.x = cvt_pk_bf16(v[0], v[1]); o.y = cvt_pk_bf16(v[2], v[3]); o.z = cvt_pk_bf16(v[4], v[5]); o.w = cvt_pk_bf16(v[6], v[7]); return o; }

#define XB_TMO      128
#define XB_XCNT(j)  (256  + 64 * (j))
#define XB_XSUB(j)  (1280 + 64 * (j))
#define XB_XGEN(j)  (2304 + 64 * (j))
#define XB_TOP      3328
#define XB_TOPGEN   3392
#define XCD_BAR_WORDS 3456
#define XB_SPIN_CAP (1u << 18)
__device__ __forceinline__ unsigned xb_ld(unsigned* p)              { return __hip_atomic_load(p, __ATOMIC_RELAXED, __HIP_MEMORY_SCOPE_AGENT); }
__device__ __forceinline__ unsigned xb_add(unsigned* p, unsigned v) { return __hip_atomic_fetch_add(p, v, __ATOMIC_RELAXED, __HIP_MEMORY_SCOPE_AGENT); }
__device__ __forceinline__ unsigned xb_xcc_id() { return (unsigned)__builtin_amdgcn_s_getreg((3 << 11) | 20) & 0xFu; }
#define XB_SPIN(cond, bar) do { unsigned _sp = 0; while (cond) { __builtin_amdgcn_s_sleep(1); \
    if ((++_sp & 255u) == 0u) { if (xb_ld(&(bar)[XB_TMO])) break; if (_sp > XB_SPIN_CAP) { atomicAdd(&(bar)[XB_TMO], 1u); break; } } } } while (0)
struct XcdBarrier { unsigned* bar; unsigned x; volatile LAS unsigned* st; };
__device__ __forceinline__ XcdBarrier xcd_barrier_post(unsigned* bar, volatile LAS unsigned* st) {
    XcdBarrier b; b.bar = bar; b.x = xb_xcc_id(); b.st = st;
    if (threadIdx.x == 0) (void)xb_add(&bar[XB_XCNT(b.x)], 1u);
    return b;
}
__device__ __forceinline__ void xcd_barrier_complete(unsigned* bar, unsigned x, unsigned& nloc, unsigned& nx) {
    const unsigned G = gridDim.x * gridDim.y * gridDim.z;
    unsigned sum, cnt, mine, sp = 0u;
    for (;;) {
        sum = 0u; cnt = 0u; mine = 0u;
#pragma unroll
        for (unsigned j = 0; j < 16; ++j) { const unsigned c = xb_ld(&bar[XB_XCNT(j)]); sum += c; cnt += (c > 0u) ? 1u : 0u; mine = (j == x) ? c : mine; }
        if (sum == G) break;
        __builtin_amdgcn_s_sleep(1);
        if ((++sp & 255u) == 0u) { if (xb_ld(&bar[XB_TMO])) break; if (sp > XB_SPIN_CAP) { atomicAdd(&bar[XB_TMO], 1u); break; } }
    }
    nloc = mine > 0u ? mine : 1u; nx = cnt > 0u ? cnt : 1u;
}
__device__ __forceinline__ void xcd_barrier(const XcdBarrier& b) {
    asm volatile("s_waitcnt vmcnt(0)" ::: "memory");
    __syncthreads();
    if (threadIdx.x == 0) {
        unsigned* bar = b.bar;
        __builtin_amdgcn_s_waitcnt(0);
        unsigned nloc = b.st[0], nx = b.st[1];
        if (nloc == 0u) { xcd_barrier_complete(bar, b.x, nloc, nx); b.st[0] = nloc; b.st[1] = nx; }
        const unsigned old = xb_add(&bar[XB_XSUB(b.x)], 1u);
        const unsigned gen = old / nloc;
        if (old + 1u == (gen + 1u) * nloc) {
            __builtin_amdgcn_fence(__ATOMIC_RELEASE, "agent");
            asm volatile("s_waitcnt vmcnt(0)" ::: "memory");
            const unsigned og = xb_add(&bar[XB_TOP], 1u);
            const unsigned tg = og / nx;
            if (og + 1u == (tg + 1u) * nx) xb_add(&bar[XB_TOPGEN], 1u);
            else XB_SPIN(xb_ld(&bar[XB_TOPGEN]) == tg, bar);
            __builtin_amdgcn_fence(__ATOMIC_ACQUIRE, "agent");
            xb_add(&bar[XB_XGEN(b.x)], 1u);
            asm volatile("s_waitcnt vmcnt(0)" ::: "memory");
        } else {
            XB_SPIN(xb_ld(&bar[XB_XGEN(b.x)]) == gen, bar);
            __builtin_amdgcn_fence(__ATOMIC_ACQUIRE, "agent");
            asm volatile("s_waitcnt vmcnt(0)" ::: "memory");
        }
    }
    __syncthreads();
}

namespace pg8 {
constexpr int BM = 256, BK = 64, HALF = 128, HTB = HALF * BK * 2, STAGE_BYTES = 8 * HTB, NXCD = 8, WGM = 8;
__host__ __device__ __forceinline__ int lds_byte(int r, int c) { const int st = (r >> 4) * 2 + (c >> 5), rr = r & 15, cc = c & 31, ob = rr * 64 + cc * 2; return st * 1024 + (ob ^ (((ob >> 9) & 1) << 5)); }
__host__ __device__ __forceinline__ void stage_rc(int b, int& R, int& C) { const int st = b / 1024, sb = b % 1024, swz = sb ^ (((sb >> 9) & 1) << 5); R = (st >> 1) * 16 + swz / 64; C = (st & 1) * 32 + (swz % 64) / 2; }
__host__ __device__ __forceinline__ int perm32(int rho) { const int n = rho >> 4, i = rho & 15; return 8 * (i >> 2) + 4 * n + (i & 3); }

template <class Epi, class Sched>
__device__ __forceinline__ void gemm_phase(LAS unsigned char* lds, const int tid, const Sched& S, const Epi& E) {
    const int wid = __builtin_amdgcn_readfirstlane(tid >> 6), lane = tid & 63, wr = wid >> 2, wc = wid & 3, fr = lane & 15, fq = lane >> 4;
    const int K = S.K, nt = K / BK;
    unsigned voffB[2];
#pragma unroll
    for (int i = 0; i < 2; ++i) { int R, C; stage_rc(tid * 16 + i * 8192, R, C); const int Rb = Epi::PERM ? ((R & ~31) + perm32(R & 31)) : R; voffB[i] = (unsigned)(Rb * K + C) * 2u; }
    const size_t kstep = (size_t)(BK * 2);
    const size_t hstepB = S.hstepB;
    const unsigned ldsw = (unsigned)wid * 1024u;
    constexpr bool F8 = Sched::FP8;
    const int aoff = F8 ? lds_byte(wr * 64 + fr, fq * 16) : lds_byte(wr * 64 + fr, fq * 8), boff = F8 ? lds_byte(wc * 32 + fr, fq * 16) : lds_byte(wc * 32 + fr, fq * 8);
#define PG8_SA(b, h) (((b) * 2 + (h)) * HTB)
#define PG8_SB(b, h) ((4 + (b) * 2 + (h)) * HTB)
#define PG8_STAGE_B(bufoff, gbase) do { _Pragma("unroll") for (int _i = 0; _i < 2; ++_i) \
        __builtin_amdgcn_global_load_lds((const unsigned*)((const char*)(gbase) + voffB[_i]), (LAS unsigned*)(lds + (bufoff) + ldsw + _i * 8192), 16, 0, 0); } while (0)
#define PG8_STAGE_A(bufoff, gbase, v0, v1) do { \
        __builtin_amdgcn_global_load_lds((const unsigned*)((const char*)(gbase) + (v0)), (LAS unsigned*)(lds + (bufoff) + ldsw), 16, 0, 0); \
        __builtin_amdgcn_global_load_lds((const unsigned*)((const char*)(gbase) + (v1)), (LAS unsigned*)(lds + (bufoff) + ldsw + 8192), 16, 0, 0); } while (0)
#define PG8_FOFF(k) (F8 ? (k) * 16 : (k) * 1024)
#define PG8_LDA(dst, b, h) do { _Pragma("unroll") for (int m = 0; m < 4; ++m) { if constexpr (F8) dst##8[m] = *(const LAS v8i_t*)(lds + PG8_SA(b, h) + aoff + m * 2048); \
        else { _Pragma("unroll") for (int k = 0; k < 2; ++k) dst[m][k] = *(const LAS bf16x8*)(lds + PG8_SA(b, h) + aoff + m * 2048 + k * 1024); } } } while (0)
#define PG8_LDB(dst, b, h) do { _Pragma("unroll") for (int n = 0; n < 2; ++n) { if constexpr (F8) dst##8[n] = *(const LAS v8i_t*)(lds + PG8_SB(b, h) + boff + n * 2048); \
        else { _Pragma("unroll") for (int k = 0; k < 2; ++k) dst[n][k] = *(const LAS bf16x8*)(lds + PG8_SB(b, h) + boff + n * 2048 + k * 1024); } } } while (0)
#define PG8_CAT(x) __builtin_shufflevector(__builtin_bit_cast(v4i_t, x[0]), __builtin_bit_cast(v4i_t, x[1]), 0, 1, 2, 3, 4, 5, 6, 7)
#define PG8_MMA(ai, bj, At, Bt) do { __builtin_amdgcn_s_setprio(1); _Pragma("unroll") for (int m = 0; m < 4; ++m) _Pragma("unroll") for (int n = 0; n < 2; ++n) { \
        if constexpr (F8) acc[ai][bj][m][n] = __builtin_amdgcn_mfma_scale_f32_16x16x128_f8f6f4(Bt##8[n], At##8[m], acc[ai][bj][m][n], 0, 0, 0, S.scaleB, 0, S.scaleA); \
        else { _Pragma("unroll") for (int k = 0; k < 2; ++k) acc[ai][bj][m][n] = __builtin_amdgcn_mfma_f32_16x16x32_bf16(Bt[n][k], At[m][k], acc[ai][bj][m][n], 0, 0, 0); } } __builtin_amdgcn_s_setprio(0); } while (0)
#define PG8_WAIT_V(n) asm volatile("s_waitcnt vmcnt(" #n ")" ::: "memory")
#define PG8_WAIT_L(n) asm volatile("s_waitcnt lgkmcnt(" #n ")" ::: "memory")
#define PG8_BAR __builtin_amdgcn_s_barrier()
#define PG8_SCHED __builtin_amdgcn_sched_barrier(0)
    typename Sched::Unit cur, nxt; int ui = 0;
    if (!S.next(0, cur)) return;
    f32x4 acc[2][2][4][2];
#pragma unroll
    for (int a = 0; a < 2; ++a)
#pragma unroll
        for (int b = 0; b < 2; ++b)
#pragma unroll
            for (int m = 0; m < 4; ++m)
#pragma unroll
                for (int n = 0; n < 2; ++n) acc[a][b][m][n] = (f32x4){0.f, 0.f, 0.f, 0.f};
    bf16x8 At[4][2], B0[2][2], B1[2][2]; v8i_t At8[4], B08[2], B18[2];
    constexpr bool GA = Sched::GATHER;
    const size_t hstepA = GA ? (size_t)0 : (size_t)HALF * K * 2;
    unsigned vA[2][2];
    S.a_off(cur, tid, vA);
#define PG8_STAGE_AH(bufoff, base, vv, h) PG8_STAGE_A(bufoff, ((base) + (h) * hstepA), vv[GA ? (h) : 0][0], vv[GA ? (h) : 0][1])
    const char* cA = S.a_base(cur); const char* cB = S.b_base(cur);
    PG8_STAGE_B(PG8_SB(0, 0), cB); PG8_STAGE_B(PG8_SB(0, 1), cB + hstepB); PG8_STAGE_AH(PG8_SA(0, 0), cA, vA, 0); PG8_STAGE_AH(PG8_SA(0, 1), cA, vA, 1);
    if (wr == 1) PG8_BAR;
    PG8_WAIT_V(2); PG8_BAR;
    PG8_STAGE_B(PG8_SB(1, 0), cB + kstep); PG8_STAGE_AH(PG8_SA(1, 0), cA + kstep, vA, 0); PG8_STAGE_B(PG8_SB(1, 1), cB + hstepB + kstep);
    PG8_WAIT_V(6); PG8_BAR;
    for (;;) {
        const bool has_next = S.next(ui + 1, nxt);
        const char* nA = cA; const char* nB = cB;
        if (has_next) { nA = S.a_base(nxt); nB = S.b_base(nxt); }
        for (int t = 0; t < nt; t += 2) {
            const bool last = (t == nt - 2);
            const char* a1 = cA + (size_t)(t + 1) * kstep;
            const char* a2 = last ? nA : cA + (size_t)(t + 2) * kstep; const char* b2 = last ? nB : cB + (size_t)(t + 2) * kstep;
            const char* a3 = a2 + kstep; const char* b3 = b2 + kstep;
            PG8_LDB(B0, 0, 0); PG8_LDB(B1, 0, 1); PG8_SCHED; PG8_LDA(At, 0, 0); PG8_STAGE_AH(PG8_SA(1, 1), a1, vA, 1);
            if constexpr (GA) { if (last && has_next) S.a_off(nxt, tid, vA); }
            PG8_WAIT_V(8); PG8_WAIT_L(0); PG8_BAR; PG8_MMA(0, 0, At, B0); PG8_MMA(0, 1, At, B1); PG8_BAR; PG8_SCHED;
            PG8_LDA(At, 0, 1); PG8_STAGE_B(PG8_SB(0, 0), b2); PG8_STAGE_B(PG8_SB(0, 1), b2 + hstepB); PG8_STAGE_AH(PG8_SA(0, 0), a2, vA, 0);
            PG8_WAIT_V(8); PG8_WAIT_L(0); PG8_BAR; PG8_MMA(1, 0, At, B0); PG8_MMA(1, 1, At, B1); PG8_BAR; PG8_SCHED;
            PG8_LDB(B0, 1, 0); PG8_LDB(B1, 1, 1); PG8_SCHED; PG8_LDA(At, 1, 0); PG8_STAGE_AH(PG8_SA(0, 1), a2, vA, 1);
            PG8_WAIT_V(8); PG8_WAIT_L(0); PG8_BAR; PG8_MMA(0, 0, At, B0); PG8_MMA(0, 1, At, B1); PG8_BAR; PG8_SCHED;
            PG8_LDA(At, 1, 1); PG8_STAGE_B(PG8_SB(1, 0), b3); PG8_STAGE_B(PG8_SB(1, 1), b3 + hstepB); PG8_STAGE_AH(PG8_SA(1, 0), a3, vA, 0);
            PG8_WAIT_V(8); PG8_WAIT_L(0); PG8_BAR; PG8_MMA(1, 0, At, B0); PG8_MMA(1, 1, At, B1); PG8_BAR; PG8_SCHED;
        }
        if (wr == 0) PG8_BAR;
        { int fr_ = fr, fq_ = fq; asm volatile("" : "+v"(fr_), "+v"(fq_)); E(acc, cur, wr, wc, fr_, fq_); }
        if (!has_next) break;
#pragma unroll
        for (int a = 0; a < 2; ++a)
#pragma unroll
            for (int b = 0; b < 2; ++b)
#pragma unroll
                for (int m = 0; m < 4; ++m)
#pragma unroll
                    for (int n = 0; n < 2; ++n) acc[a][b][m][n] = (f32x4){0.f, 0.f, 0.f, 0.f};
        cur = nxt; cA = nA; cB = nB; ++ui;
        if (wr == 1) PG8_BAR;
    }
    PG8_WAIT_V(0);
    PG8_BAR;
#undef PG8_SA
#undef PG8_SB
#undef PG8_STAGE_A
#undef PG8_STAGE_AH
#undef PG8_STAGE_B
#undef PG8_LDA
#undef PG8_LDB
#undef PG8_MMA
#undef PG8_CAT
#undef PG8_FOFF
#undef PG8_WAIT_V
#undef PG8_WAIT_L
#undef PG8_BAR
#undef PG8_SCHED
}
}
struct Args { const float* in[N_IN]; float* out; unsigned char* ws; int ph_lo, ph_hi; };
typedef const __attribute__((address_space(4))) unsigned long long* karg_t;
struct Frame {
    karg_t ka;
    LAS unsigned char* lds;
    volatile LAS unsigned* MISC;
    gu32* ctl;
    unsigned char* ws;
    float* out;
    int tid, lane, wave, vcu, G;
};
#define WSP(T_, off) ((T_*)(F.ws + (off)))
#define KIN(k) ((const float*)F.ka[(k)])
#ifdef DBG_SEL
#define DBG_STAT(k, val) do { const float _v = (val); if ((k) == DBG_SEL) { if (fabsf(_v) < 3e38f) atomicMax((unsigned*)(F.ctl + CW_DBG), __float_as_uint(fabsf(_v))); else atomicAdd((unsigned*)(F.ctl + CW_DBG + 1), 1u); } } while (0)
#else
#define DBG_STAT(k, val) do { } while (0)
#endif
template <class P> __device__ __forceinline__ P launder_uniform(P p) {
    unsigned lo = (unsigned)(unsigned long long)p, hi = (unsigned)((unsigned long long)p >> 32);
    asm volatile("" : "+v"(lo), "+v"(hi));
    lo = __builtin_amdgcn_readfirstlane(lo); hi = __builtin_amdgcn_readfirstlane(hi);
    return (P)(((unsigned long long)hi << 32) | lo);
}
__device__ __forceinline__ void frame_refresh(Frame& F) {
    int t = F.tid; asm volatile("" : "+v"(t)); F.tid = t; F.lane = t & 63; F.wave = __builtin_amdgcn_readfirstlane(t >> 6);
    F.ws = launder_uniform(F.ws); F.ctl = (gu32*)(F.ws + WS_CTL);
    F.out = launder_uniform(F.out);
    F.ka = launder_uniform(F.ka);
}

namespace pg8 {
struct DenseSched {
    static constexpr bool GATHER = false, FP8 = false; static constexpr int scaleA = 0, scaleB = 0;
    struct Unit { int pm, pn; };
    const bf16* A; const bf16* Bt; int K; size_t hstepB; int nM, nN, nwg, G, c;
    __device__ __forceinline__ void init(const bf16* A_, const bf16* Bt_, int M, int N, int K_, int G_, int c_) { A = A_; Bt = Bt_; K = K_; hstepB = (size_t)HALF * K_ * 2; nM = M / BM; nN = N / BM; nwg = nM * nN; G = G_; c = c_; }
    __device__ __forceinline__ bool next(int i, Unit& u) const {
        const long L = (long)i * G + c; if (L >= nwg) return false;
        int wgid = (int)L; { const int q = nwg / NXCD, r = nwg % NXCD, xcd = wgid % NXCD, off = wgid / NXCD; wgid = (xcd < r ? xcd * (q + 1) : r * (q + 1) + (xcd - r) * q) + off; }
        const int nig = WGM * nN, gid = wgid / nig, fm = gid * WGM, gsz = (nM - fm) < WGM ? (nM - fm) : WGM;
        u.pm = fm + ((wgid % nig) % gsz); u.pn = (wgid % nig) / gsz; return true;
    }
    __device__ __forceinline__ const char* a_base(const Unit& u) const { return (const char*)A + (size_t)u.pm * BM * K * 2; }
    __device__ __forceinline__ const char* b_base(const Unit& u) const { return (const char*)Bt + (size_t)u.pn * BM * K * 2; }
    __device__ __forceinline__ void a_off(const Unit&, int tid, unsigned (&v)[2][2]) const {
#pragma unroll
        for (int i = 0; i < 2; ++i) { int R, C; stage_rc(tid * 16 + i * 8192, R, C); v[0][i] = (unsigned)(R * K + C) * 2u; v[1][i] = v[0][i]; }
    }
};
struct MoeUnit { int e, mt, nt, cnt; };
struct MoeOrder {
    const volatile LAS unsigned* pfx;
    int NT, G, c;
    __device__ __forceinline__ bool decode(int i, MoeUnit& u) const {
        const int nwg = (int)pfx[32]; const long L = (long)i * G + c; if (L >= nwg) return false;
        int wgid = (int)L; { const int q = nwg / NXCD, r = nwg % NXCD, xcd = wgid % NXCD, off = wgid / NXCD; wgid = (xcd < r ? xcd * (q + 1) : r * (q + 1) + (xcd - r) * q) + off; }
        int e = 0;
#pragma unroll
        for (int st = 16; st >= 1; st >>= 1) e += ((int)pfx[e + st] <= wgid) ? st : 0;
        const int j = wgid - (int)pfx[e];
        u.e = e; u.mt = j / NT; u.nt = j % NT; u.cnt = (int)pfx[40 + e]; return true;
    }
};
struct Moe1Sched {
    static constexpr bool GATHER = true, FP8 = (MOE_FP8 != 0); static constexpr int EB = FP8 ? 1 : 2; static constexpr int scaleA = 0x7F7F7F7F, scaleB = 0x7A7A7A7A;
    typedef MoeUnit Unit;
    MoeOrder O; const unsigned char* X; const unsigned char* W; const int* sdest; int K; size_t hstepB;
    __device__ __forceinline__ bool next(int i, Unit& u) const { return O.decode(i, u); }
    __device__ __forceinline__ const char* a_base(const Unit&) const { return (const char*)X; }
    __device__ __forceinline__ const char* b_base(const Unit& u) const { return (const char*)W + ((size_t)u.e * 2048 + (size_t)u.nt * 128) * 1024 * EB; }
    __device__ __forceinline__ void a_off(const Unit& u, int tid, unsigned (&v)[2][2]) const {
#pragma unroll
        for (int i = 0; i < 2; ++i) { int R, C; stage_rc(tid * 16 + i * 8192, R, C);
#pragma unroll
            for (int h = 0; h < 2; ++h) { const int slot = u.mt * 256 + h * HALF + R; int tok = 0; if (slot < u.cnt) tok = sdest[u.e * ECAP + slot] >> 2; v[h][i] = (unsigned)(tok * 1024 * EB + C * 2); } }
    }
};
struct Moe2Sched {
    static constexpr bool GATHER = true, FP8 = (MOE2_FP8 != 0); static constexpr int EB = FP8 ? 1 : 2; static constexpr int scaleA = 0x7F7F7F7F, scaleB = 0x79797979;
    typedef MoeUnit Unit;
    MoeOrder O; const unsigned char* Ab; const unsigned char* W; int K; size_t hstepB;
    __device__ __forceinline__ bool next(int i, Unit& u) const { return O.decode(i, u); }
    __device__ __forceinline__ const char* a_base(const Unit& u) const { return (const char*)Ab + ((size_t)u.e * ECAP + (size_t)u.mt * 256) * 1024 * EB; }
    __device__ __forceinline__ const char* b_base(const Unit& u) const { return (const char*)W + ((size_t)u.e * 1024 + (size_t)u.nt * 256) * 1024 * EB; }
    __device__ __forceinline__ void a_off(const Unit&, int tid, unsigned (&v)[2][2]) const {
        int t_ = tid; asm volatile("" : "+v"(t_));
#pragma unroll
        for (int i = 0; i < 2; ++i) { int R, C; stage_rc(t_ * 16 + i * 8192, R, C); v[0][i] = (unsigned)(R * 1024 * EB + C * 2); v[1][i] = v[0][i] + (unsigned)(HALF * 1024 * EB); }
    }
};

__device__ __forceinline__ void unpack8(const v4u w, f32x4& a, f32x4& b) {
    a = (f32x4){__uint_as_float(w.x << 16), __uint_as_float(w.x & 0xffff0000u), __uint_as_float(w.y << 16), __uint_as_float(w.y & 0xffff0000u)};
    b = (f32x4){__uint_as_float(w.z << 16), __uint_as_float(w.z & 0xffff0000u), __uint_as_float(w.w << 16), __uint_as_float(w.w & 0xffff0000u)}; }
struct EpiF32 {
    static constexpr bool PERM = false;
    float* C; int ldc; const float* base; float alpha;
    __device__ __forceinline__ void operator()(const f32x4 (&acc)[2][2][4][2], const DenseSched::Unit& u, int wr, int wc, int fr, int fq) const {
        const int row0 = u.pm * BM + wr * 64 + fr, col0 = u.pn * BM + wc * 32 + 4 * fq;
#pragma unroll
        for (int ai = 0; ai < 2; ++ai)
#pragma unroll
            for (int m = 0; m < 4; ++m) { const size_t ro = (size_t)(row0 + ai * HALF + m * 16) * ldc + col0;
#pragma unroll
                for (int bj = 0; bj < 2; ++bj)
#pragma unroll
                    for (int n = 0; n < 2; ++n) { f32x4 v = acc[ai][bj][m][n];
                        if (base) { const f32x4 b = *(const f32x4*)(base + ro + bj * HALF + n * 16); v = v + b * alpha; }
                        *(f32x4*)(C + ro + bj * HALF + n * 16) = v; } }
    }
};
struct EpiB16 {
    static constexpr bool PERM = true;
    bf16* O; int ldc; const bf16* base; float alpha;
    __device__ __forceinline__ void operator()(const f32x4 (&acc)[2][2][4][2], const DenseSched::Unit& u, int wr, int wc, int fr, int fq) const {
        const int row0 = u.pm * BM + wr * 64 + fr, col0 = u.pn * BM + wc * 32 + 8 * fq;
#pragma unroll
        for (int ai = 0; ai < 2; ++ai) {
            v4u bw[4][2];
            if (base) {
#pragma unroll
                for (int m = 0; m < 4; ++m)
#pragma unroll
                    for (int bj = 0; bj < 2; ++bj) bw[m][bj] = *(const v4u*)(base + (size_t)(row0 + ai * HALF + m * 16) * ldc + col0 + bj * HALF); }
#pragma unroll
            for (int m = 0; m < 4; ++m) { bf16* rowp = O + (size_t)(row0 + ai * HALF + m * 16) * ldc + col0;
#pragma unroll
                for (int bj = 0; bj < 2; ++bj) { f32x4 v0 = acc[ai][bj][m][0], v1 = acc[ai][bj][m][1];
                    if (base) { f32x4 b0, b1; unpack8(bw[m][bj], b0, b1); v0 = v0 + b0 * alpha; v1 = v1 + b1 * alpha; }
                    v4u w; w.x = cvt_pk_bf16(v0[0], v0[1]); w.y = cvt_pk_bf16(v0[2], v0[3]); w.z = cvt_pk_bf16(v1[0], v1[1]); w.w = cvt_pk_bf16(v1[2], v1[3]);
                    *(v4u*)(rowp + bj * HALF) = w; } } }
    }
};
struct EpiPle {
    static constexpr bool PERM = true;
    bf16* C; const bf16* hb; const bf16* pe;
    __device__ __forceinline__ void operator()(const f32x4 (&acc)[2][2][4][2], const DenseSched::Unit& u, int wr, int wc, int fr, int fq) const {
        const int row0 = u.pm * BM + wr * 64 + fr, col0 = u.pn * BM + wc * 32 + 8 * fq;
#pragma unroll
        for (int ai = 0; ai < 2; ++ai) {
            v4u hw[4][2], pw[4][2];
#pragma unroll
            for (int m = 0; m < 4; ++m)
#pragma unroll
                for (int bj = 0; bj < 2; ++bj) { const size_t ro = (size_t)(row0 + ai * HALF + m * 16) * 1024 + col0 + bj * HALF; hw[m][bj] = *(const v4u*)(hb + ro); pw[m][bj] = *(const v4u*)(pe + ro); }
#pragma unroll
            for (int m = 0; m < 4; ++m)
#pragma unroll
                for (int bj = 0; bj < 2; ++bj) { const size_t ro = (size_t)(row0 + ai * HALF + m * 16) * 1024 + col0 + bj * HALF;
                    f32x4 h0, h1, p0, p1; unpack8(hw[m][bj], h0, h1); unpack8(pw[m][bj], p0, p1); const f32x4 a0 = acc[ai][bj][m][0], a1 = acc[ai][bj][m][1];
                    f32x4 o0, o1;
#pragma unroll
                    for (int j = 0; j < 4; ++j) { o0[j] = h0[j] + sigmoidf_(a0[j]) * p0[j]; o1[j] = h1[j] + sigmoidf_(a1[j]) * p1[j]; }
                    v4u w; w.x = cvt_pk_bf16(o0[0], o0[1]); w.y = cvt_pk_bf16(o0[2], o0[3]); w.z = cvt_pk_bf16(o1[0], o1[1]); w.w = cvt_pk_bf16(o1[2], o1[3]);
                    *(v4u*)(C + ro) = w; } }
    }
};
struct EpiMoe1 {
    static constexpr bool PERM = true;
    bf16* Ab; const float* bgu; unsigned char* AbQ;
    __device__ __forceinline__ void operator()(const f32x4 (&acc)[2][2][4][2], const MoeUnit& u, int wr, int wc, int fr, int fq) const {
        const int col0 = u.nt * 128 + wc * 32 + 8 * fq;
        const float* bg = bgu + (size_t)u.e * 2048 + col0;
        const f32x4 bg0 = *(const f32x4*)(bg), bg1 = *(const f32x4*)(bg + 4), bl0 = *(const f32x4*)(bg + 1024), bl1 = *(const f32x4*)(bg + 1028);
#pragma unroll
        for (int ai = 0; ai < 2; ++ai)
#pragma unroll
            for (int m = 0; m < 4; ++m) { const int r = ai * HALF + wr * 64 + m * 16 + fr;
                bf16* rowp = Ab + ((size_t)u.e * ECAP + (size_t)u.mt * 256 + r) * 1024 + col0;
                float o[8];
#pragma unroll
                for (int n = 0; n < 2; ++n) { const f32x4 g4 = acc[ai][0][m][n] + (n ? bg1 : bg0), l4 = acc[ai][1][m][n] + (n ? bl1 : bl0);
#pragma unroll
                    for (int j = 0; j < 4; ++j) { const float g = fminf(g4[j], 7.0f), l = fminf(fmaxf(l4[j], -7.0f), 7.0f); o[n * 4 + j] = (l + 1.0f) * g * sigmoidf_(1.702f * g); } }
                if constexpr (MOE2_FP8) { v2u q; q.x = cvt4_fp8(o[0], o[1], o[2], o[3]); q.y = cvt4_fp8(o[4], o[5], o[6], o[7]); *(v2u*)((unsigned char*)AbQ + ((size_t)u.e * ECAP + (size_t)u.mt * 256 + r) * 1024 + col0) = q; }
                else *(v4u*)rowp = pack8(o); }
    }
};
struct EpiMoe2 {
    static constexpr bool PERM = true;
    bf16* Y; const float* bdn; const int* sdest; const float* sgate;
    __device__ __forceinline__ void operator()(const f32x4 (&acc)[2][2][4][2], const MoeUnit& u, int wr, int wc, int fr, int fq) const {
        const int col0 = u.nt * 256 + wc * 32 + 8 * fq;
        const float* bp = bdn + (size_t)u.e * 1024 + col0;
#pragma unroll
        for (int ai = 0; ai < 2; ++ai) {
            f32x4 bv[2][2];
#pragma unroll
            for (int bj = 0; bj < 2; ++bj)
#pragma unroll
                for (int n = 0; n < 2; ++n) bv[bj][n] = *(const f32x4*)(bp + bj * HALF + 4 * n);
            int dest[4]; float gate[4];
#pragma unroll
            for (int m = 0; m < 4; ++m) { const int slot = u.mt * 256 + ai * HALF + wr * 64 + m * 16 + fr; const bool ok = slot < u.cnt; const int si = u.e * ECAP + (ok ? slot : 0);
                dest[m] = ok ? sdest[si] : T * 4; gate[m] = sgate[si]; }
#pragma unroll
            for (int m = 0; m < 4; ++m) {
                { const float g = gate[m]; bf16* rowp = Y + (size_t)dest[m] * 1024 + col0;
#pragma unroll
                    for (int bj = 0; bj < 2; ++bj) { const f32x4 v0 = (acc[ai][bj][m][0] + bv[bj][0]) * g, v1 = (acc[ai][bj][m][1] + bv[bj][1]) * g;
                        v4u w; w.x = cvt_pk_bf16(v0[0], v0[1]); w.y = cvt_pk_bf16(v0[2], v0[3]); w.z = cvt_pk_bf16(v1[0], v1[1]); w.w = cvt_pk_bf16(v1[2], v1[3]);
                        *(v4u*)(rowp + bj * HALF) = w; } } } }
    }
};
}

__device__ __forceinline__ void p0_transpose_item(const float* W, int K, int N, int nblk, bf16* WT, int item, int lane) {
    const int kb = item / nblk, nb = item % nblk, k0 = 64 * kb, n = 64 * nb + lane;
    const bool ok = n < N; const float* src = W + (size_t)k0 * N + (ok ? n : 0);
    float x[64];
#pragma unroll
    for (int j = 0; j < 64; ++j) x[j] = __builtin_nontemporal_load(src + (size_t)j * N);
    bf16* dst = WT + (size_t)n * K + k0;
#pragma unroll
    for (int q = 0; q < 8; ++q) { v4u o; o.x = cvt_pk_bf16(x[8 * q], x[8 * q + 1]); o.y = cvt_pk_bf16(x[8 * q + 2], x[8 * q + 3]); o.z = cvt_pk_bf16(x[8 * q + 4], x[8 * q + 5]); o.w = cvt_pk_bf16(x[8 * q + 6], x[8 * q + 7]);
        if (!ok) o = (v4u){0u, 0u, 0u, 0u};
        *(v4u*)(dst + 8 * q) = o; }
}
__device__ __forceinline__ void cvt_rows(const float* src, bf16* dst, size_t n8, size_t i0, size_t stride) {
    for (size_t i = i0; i < n8; i += stride) { const f32x4 a = *(const f32x4*)(src + i * 8), b = *(const f32x4*)(src + i * 8 + 4);
        v4u o; o.x = cvt_pk_bf16(a.x, a.y); o.y = cvt_pk_bf16(a.z, a.w); o.z = cvt_pk_bf16(b.x, b.y); o.w = cvt_pk_bf16(b.z, b.w); *(v4u*)(dst + i * 8) = o; }
}
__device__ __forceinline__ void p0_prologue(Frame& F, const Args& A) {
    const int gw = F.vcu * NWAVES + F.wave, NGW = F.G * NWAVES;
    constexpr int I_IN = 16 * (NUP / 64), I_OUT = 16 * 16, I_GU = 16 * 32, I_DN = 16 * 16, I_PG = 16 * 16, I_PP = 4 * 16;
    constexpr int PER_LAYER = I_IN + I_OUT + NE * I_GU + NE * I_DN + I_PG + I_PP;
#pragma unroll 1
    for (int it = gw; it < DEPTH * PER_LAYER; it += NGW) {
        const int l = it / PER_LAYER; int r = it % PER_LAYER;
        const float* W; bf16* WT; int K = D, N = D, nblk = 16;
        if (r < I_IN) { W = KIN(I_WIN) + (size_t)l * D * NU; WT = WSP(bf16, WS_WIN_T) + (size_t)l * NUP * D; N = NU; nblk = NUP / 64; }
        else if ((r -= I_IN) < I_OUT) { W = KIN(I_WOUT) + (size_t)l * D * D; WT = WSP(bf16, WS_WOUT_T) + (size_t)l * D * D; }
        else if ((r -= I_OUT) < NE * I_GU) { if (MOE_FP8) continue; const int e = r / I_GU; r %= I_GU; W = KIN(I_WGU) + ((size_t)l * NE + e) * D * 2048; WT = WSP(bf16, WS_WGU_T) + ((size_t)l * NE + e) * 2048 * D; N = 2048; nblk = 32; }
        else if ((r -= NE * I_GU) < NE * I_DN) { if (MOE2_FP8) continue; const int e = r / I_DN; r %= I_DN; W = KIN(I_WDN) + ((size_t)l * NE + e) * D * D; WT = WSP(bf16, WS_WDN_T) + ((size_t)l * NE + e) * D * D; }
        else if ((r -= NE * I_DN) < I_PG) { W = KIN(I_PGW) + (size_t)l * D * D; WT = WSP(bf16, WS_WPG_T) + (size_t)l * D * D; }
        else { r -= I_PG; W = KIN(I_PPJ) + (size_t)l * 256 * D; WT = WSP(bf16, WS_WPP_T) + (size_t)l * D * 256; K = 256; }
        p0_transpose_item(W, K, N, nblk, WT, r, F.lane);
    }
#if MOE_FP8
    constexpr int Q_GU = 16 * 32, Q_DN = 16 * 16, Q_PER_LAYER = NE * (Q_GU + Q_DN);
#pragma unroll 1
    for (int it = gw; it < DEPTH * Q_PER_LAYER; it += NGW) {
        const int l = it / Q_PER_LAYER; int r = it % Q_PER_LAYER; const float* W; unsigned char* WQ; int N; float sc;
        if (r < NE * Q_GU) { const int e = r / Q_GU; r %= Q_GU; W = KIN(I_WGU) + ((size_t)l * NE + e) * D * 2048; WQ = WSP(unsigned char, WS_WGU_Q) + ((size_t)l * NE + e) * 2048 * D; N = 2048; sc = 32.0f; }
        else { if (!MOE2_FP8) continue; r -= NE * Q_GU; const int e = r / Q_DN; r %= Q_DN; W = KIN(I_WDN) + ((size_t)l * NE + e) * D * D; WQ = WSP(unsigned char, WS_WDN_Q) + ((size_t)l * NE + e) * D * D; N = D; sc = 64.0f; }
        const int nblk = N / 64, kb = r / nblk, nb = r % nblk, k0 = 64 * kb, n = 64 * nb + F.lane;
        const float* src = W + (size_t)k0 * N + n; float x[64];
#pragma unroll
        for (int j = 0; j < 64; ++j) x[j] = __builtin_nontemporal_load(src + (size_t)j * N) * sc;
        unsigned char* dst = WQ + (size_t)n * D + k0;
#pragma unroll
        for (int q = 0; q < 4; ++q) { v4u o; o.x = cvt4_fp8(x[16 * q], x[16 * q + 1], x[16 * q + 2], x[16 * q + 3]); o.y = cvt4_fp8(x[16 * q + 4], x[16 * q + 5], x[16 * q + 6], x[16 * q + 7]);
            o.z = cvt4_fp8(x[16 * q + 8], x[16 * q + 9], x[16 * q + 10], x[16 * q + 11]); o.w = cvt4_fp8(x[16 * q + 12], x[16 * q + 13], x[16 * q + 14], x[16 * q + 15]); *(v4u*)(dst + 16 * q) = o; }
    }
#endif
    const size_t gt = (size_t)F.vcu * (NWAVES * 64) + F.tid, NT_ = (size_t)F.G * NWAVES * 64;
    cvt_rows(KIN(I_P), WSP(bf16, WS_PB), (size_t)DEPTH * T * 256 / 8, gt, NT_);
    cvt_rows(KIN(I_X), WSP(bf16, WS_XB), (size_t)T * D / 8, gt, NT_);
    for (size_t i = gt; i < (size_t)DEPTH * LORA_PER_LAYER; i += NT_) { const int l = (int)(i / LORA_PER_LAYER); int r = (int)(i % LORA_PER_LAYER); float v;
        if (r < 8192) { const int ch = r >> 5, j = r & 31; v = KIN(I_RWUP)[(size_t)l * 8192 + j * 256 + ch]; }
        else if (r < 16384) { r -= 8192; const int ch = r >> 5, j = r & 31; v = KIN(I_RAUP)[(size_t)l * 8192 + j * 256 + ch]; }
        else if (r < 32768) { r -= 16384; const int ch = r >> 6, j = r & 63; v = KIN(I_RGUP)[(size_t)l * 16384 + j * 256 + ch]; }
        else { r -= 32768; const int d = r >> 4, j = r & 15; v = KIN(I_GGUP)[(size_t)l * 2048 + j * 128 + d]; }
        WSP(float, WS_LORA)[i] = v; }
    for (size_t i = gt; i < (size_t)DEPTH * NE * D; i += NT_) { const int l = (int)(i / (NE * D)), r = (int)(i % (NE * D)), e = r / D, k = r % D; WSP(float, WS_RWT)[i] = KIN(I_RTW)[(size_t)l * D * NE + (size_t)k * NE + e]; }
}

__device__ __forceinline__ void router_pick(float (&p)[32], int lane, float rbias, int& ek, float& gk) {
#pragma unroll
    for (int i = 0; i < 16; ++i) { const bool hi = (lane & 32) != 0; const float keep = hi ? p[i + 16] : p[i], send = hi ? p[i] : p[i + 16]; p[i] = keep + __shfl_xor(send, 32); }
#pragma unroll
    for (int i = 0; i < 8; ++i) { const bool hi = (lane & 16) != 0; const float keep = hi ? p[i + 8] : p[i], send = hi ? p[i] : p[i + 8]; p[i] = keep + __shfl_xor(send, 16); }
#pragma unroll
    for (int i = 0; i < 4; ++i) { const bool hi = (lane & 8) != 0; const float keep = hi ? p[i + 4] : p[i], send = hi ? p[i] : p[i + 4]; p[i] = keep + __shfl_xor(send, 8); }
#pragma unroll
    for (int i = 0; i < 2; ++i) { const bool hi = (lane & 4) != 0; const float keep = hi ? p[i + 2] : p[i], send = hi ? p[i] : p[i + 2]; p[i] = keep + __shfl_xor(send, 4); }
    { const bool hi = (lane & 2) != 0; const float keep = hi ? p[1] : p[0], send = hi ? p[0] : p[1]; p[0] = keep + __shfl_xor(send, 2); }
    const float logit = p[0] + __shfl_xor(p[0], 1) + rbias;
    const int me = lane >> 1; int rank = 0;
#pragma unroll
    for (int e = 0; e < 32; ++e) { const float le = __builtin_bit_cast(float, __builtin_amdgcn_readlane(__builtin_bit_cast(int, logit), 2 * e)); rank += (le > logit || (le == logit && e < me)) ? 1 : 0; }
    float tv[4]; int te[4];
#pragma unroll
    for (int k = 0; k < 4; ++k) { const unsigned long long m = __ballot(rank == k); const int src = (int)__builtin_ctzll(m);
        te[k] = src >> 1; tv[k] = __builtin_bit_cast(float, __builtin_amdgcn_readlane(__builtin_bit_cast(int, logit), src)); }
    const float e1 = __expf(tv[1] - tv[0]), e2 = __expf(tv[2] - tv[0]), e3 = __expf(tv[3] - tv[0]); const float inv = 1.0f / (1.0f + e1 + e2 + e3);
    const int kk = lane & 3;
    ek = kk == 0 ? te[0] : kk == 1 ? te[1] : kk == 2 ? te[2] : te[3];
    gk = (kk == 0 ? 1.0f : kk == 1 ? e1 : kk == 2 ? e2 : e3) * inv;
}
template <bool DRY> __device__ __forceinline__ void p6_ln1_router(Frame& F, const Args& A, int layer) {
    const bf16* y1 = WSP(bf16, WS_Y1); bf16* x1b = WSP(bf16, WS_X1B);
    const float* g = KIN(I_LN1G) + layer * D; const float* bb = KIN(I_LN1B) + layer * D;
    const float* rwt = WSP(float, WS_RWT) + (size_t)layer * NE * D; const float* rb = KIN(I_RTB) + layer * NE;
    int* sdest = WSP(int, WS_SDEST); float* sgate = WSP(float, WS_SGATE);
    unsigned* cnt = (unsigned*)(F.ctl + CW_CNT + layer * NE * 16);
    LAS float* RWT = (LAS float*)F.lds;
    volatile LAS unsigned* lcnt = F.MISC + MW_LCNT; volatile LAS unsigned* lbase = F.MISC + MW_LBASE;
    for (int i = F.tid; i < NE * D / 4; i += NWAVES * 64) ((LAS f32x4*)RWT)[i] = ((const f32x4*)rwt)[i];
    const int lane = F.lane;
    const float rbias = rb[lane >> 1];
    for (int blk = F.vcu; blk < T / 64; blk += F.G) {
        if (F.tid < 32) lcnt[F.tid] = 0u;
        __syncthreads();
        int my_e = 0; float my_g = 0.f; unsigned my_r = 0u;
#pragma unroll 1
        for (int ri = 0; ri < 8; ++ri) {
            int lo_ = lane; asm volatile("" : "+v"(lo_));
            const f32x4 gv[4] = { *(const f32x4*)(g + 4 * lo_), *(const f32x4*)(g + 256 + 4 * lo_), *(const f32x4*)(g + 512 + 4 * lo_), *(const f32x4*)(g + 768 + 4 * lo_) };
            const f32x4 bv[4] = { *(const f32x4*)(bb + 4 * lo_), *(const f32x4*)(bb + 256 + 4 * lo_), *(const f32x4*)(bb + 512 + 4 * lo_), *(const f32x4*)(bb + 768 + 4 * lo_) };
            f32x4 v[4];
            { const int row = blk * 64 + F.wave * 8 + ri; const bf16* yr = y1 + (size_t)row * D; float s = 0.f;
#pragma unroll
                for (int j = 0; j < 4; ++j) { const v2u w = *(const v2u*)(yr + 256 * j + 4 * lane); v[j] = (f32x4){__uint_as_float(w.x << 16), __uint_as_float(w.x & 0xffff0000u), __uint_as_float(w.y << 16), __uint_as_float(w.y & 0xffff0000u)}; s += (v[j].x + v[j].y) + (v[j].z + v[j].w); }
                const float mean = wave_sum(s) * (1.f / D); float s2 = 0.f;
#pragma unroll
                for (int j = 0; j < 4; ++j) { v[j] = v[j] - mean; s2 += (v[j].x * v[j].x + v[j].y * v[j].y) + (v[j].z * v[j].z + v[j].w * v[j].w); }
                const float rstd = 1.0f / sqrtf(wave_sum(s2) * (1.f / D) + LN_EPS);
#pragma unroll
                for (int j = 0; j < 4; ++j) { v[j] = v[j] * rstd * gv[j] + bv[j];
                    v2u o; o.x = cvt_pk_bf16(v[j].x, v[j].y); o.y = cvt_pk_bf16(v[j].z, v[j].w); *(v2u*)(x1b + (size_t)row * D + 256 * j + 4 * lane) = o;
                    if (MOE_FP8) *(unsigned*)(WSP(unsigned char, WS_X1Q) + (size_t)row * D + 256 * j + 4 * lane) = cvt4_fp8(v[j].x, v[j].y, v[j].z, v[j].w); } }
            float p0[32];
#pragma unroll
            for (int e = 0; e < 32; ++e) { float a0 = 0.f;
#pragma unroll
                for (int j = 0; j < 4; ++j) { const f32x4 w = *(const LAS f32x4*)(RWT + e * D + 256 * j + 4 * lane); a0 += (v[j].x * w.x + v[j].y * w.y) + (v[j].z * w.z + v[j].w * w.w); }
                p0[e] = a0; }
            int ek0; float gk0;
            router_pick(p0, lane, rbias, ek0, gk0);
            if ((lane >> 2) == ri) { my_e = ek0; my_g = gk0; my_r = DRY ? 0u : atomicAdd((unsigned*)&lcnt[ek0], 1u); }
        }
        __syncthreads();
        if (!DRY && F.tid < 32) { const unsigned n = lcnt[F.tid]; lbase[F.tid] = n ? __hip_atomic_fetch_add(cnt + F.tid * 16, n, RLX_AGENT) : 0u; }
        __syncthreads();
        if (!DRY && lane < 32) { const int row = blk * 64 + F.wave * 8 + (lane >> 2); const unsigned slot = (unsigned)my_e * ECAP + lbase[my_e] + my_r;
            sdest[slot] = row * 4 + (lane & 3); sgate[slot] = my_g; }
        __syncthreads();
    }
}
__device__ __forceinline__ void p9_combine(Frame& F, const Args& A) {
    const bf16* x1b = WSP(bf16, WS_X1B); const bf16* yb = WSP(bf16, WS_YBUF); bf16* hb = WSP(bf16, WS_HB);
    const int gw = F.vcu * NWAVES + F.wave, NGW = F.G * NWAVES, lane = F.lane;
    for (int row = gw; row < T; row += NGW) {
        v4u y[4][2], xw[2];
#pragma unroll
        for (int j = 0; j < 2; ++j) {
#pragma unroll
            for (int k = 0; k < 4; ++k) y[k][j] = *(const v4u*)(yb + ((size_t)row * 4 + k) * D + 512 * j + 8 * lane);
            xw[j] = *(const v4u*)(x1b + (size_t)row * D + 512 * j + 8 * lane); }
#pragma unroll
        for (int j = 0; j < 2; ++j) { f32x4 v0, v1; pg8::unpack8(xw[j], v0, v1); v0 = v0 * DN_ALPHA; v1 = v1 * DN_ALPHA;
#pragma unroll
            for (int k = 0; k < 4; ++k) { f32x4 a, b; pg8::unpack8(y[k][j], a, b); v0 = v0 + a; v1 = v1 + b; }
            v4u wv; wv.x = cvt_pk_bf16(v0.x, v0.y); wv.y = cvt_pk_bf16(v0.z, v0.w); wv.z = cvt_pk_bf16(v1.x, v1.y); wv.w = cvt_pk_bf16(v1.z, v1.w); *(v4u*)(hb + (size_t)row * D + 512 * j + 8 * lane) = wv; }
    }
}
__device__ __forceinline__ void p11_ln2(Frame& F, const Args& A, int layer) {
    const bf16* h2 = WSP(bf16, WS_H2); bf16* xb = WSP(bf16, WS_XB);
    const float* g = KIN(I_LN2G) + layer * D; const float* bb = KIN(I_LN2B) + layer * D;
    const int gw = F.vcu * NWAVES + F.wave, NGW = F.G * NWAVES, lane = F.lane;
    for (int row = gw; row < T; row += NGW) {
        const bf16* yr = h2 + (size_t)row * D; f32x4 v[4]; float s = 0.f;
#pragma unroll
        for (int j = 0; j < 4; ++j) { const v2u w = *(const v2u*)(yr + 256 * j + 4 * lane); v[j] = (f32x4){__uint_as_float(w.x << 16), __uint_as_float(w.x & 0xffff0000u), __uint_as_float(w.y << 16), __uint_as_float(w.y & 0xffff0000u)}; s += (v[j].x + v[j].y) + (v[j].z + v[j].w); }
        const float mean = wave_sum(s) * (1.f / D); float s2 = 0.f;
#pragma unroll
        for (int j = 0; j < 4; ++j) { v[j] = v[j] - mean; s2 += (v[j].x * v[j].x + v[j].y * v[j].y) + (v[j].z * v[j].z + v[j].w * v[j].w); }
        const float rstd = 1.0f / sqrtf(wave_sum(s2) * (1.f / D) + LN_EPS);
#pragma unroll
        for (int j = 0; j < 4; ++j) { const f32x4 gv = *(const f32x4*)(g + 256 * j + 4 * lane), bv = *(const f32x4*)(bb + 256 * j + 4 * lane);
            const f32x4 o = v[j] * rstd * gv + bv; const size_t off = (size_t)row * D + 256 * j + 4 * lane;
            if (layer == DEPTH - 1) *(f32x4*)(F.out + off) = o; v2u w; w.x = cvt_pk_bf16(o.x, o.y); w.y = cvt_pk_bf16(o.z, o.w); *(v2u*)(xb + off) = w; }
    }
}
__device__ __forceinline__ void moe_build_pfx(Frame& F, const Args& A, int layer, int NT) {
    volatile LAS unsigned* pfx = F.MISC + MW_PFX;
    __syncthreads();
    if (F.tid < 64) {
        const int e = F.tid & 31;
        const unsigned c = __hip_atomic_load(F.ctl + CW_CNT + (layer * NE + e) * 16, RLX_AGENT);
        const unsigned un = ((c + 255u) >> 8) * (unsigned)NT; unsigned inc = un;
#pragma unroll
        for (int o = 1; o < 32; o <<= 1) { const unsigned t = (unsigned)my_shfl_up((int)inc, o); if (e >= o) inc += t; }
        if (F.tid < 32) { pfx[e] = inc - un; pfx[40 + e] = c; if (e == 31) pfx[32] = inc; }
    }
    __syncthreads();
}
#define UU(t, col) bf2f(u[(size_t)(t) * NUP + (col)])
#define UU4(t, col) ldu4(u + (size_t)(t) * NUP + (col))
__device__ __forceinline__ f32x4 ldu4(const bf16* p) { const v2u w = *(const v2u*)p; return (f32x4){__uint_as_float(w.x << 16), __uint_as_float(w.x & 0xffff0000u), __uint_as_float(w.y << 16), __uint_as_float(w.y & 0xffff0000u)}; }
__device__ __forceinline__ void lds_st_bf16(LAS unsigned char* p, float v) { *(LAS unsigned short*)p = (unsigned short)(cvt_pk_bf16(v, 0.f) & 0xffffu); }
__device__ __forceinline__ void lds_st_bf16x4(LAS unsigned char* p, float a, float b, float c, float d) { v2u o; o.x = cvt_pk_bf16(a, b); o.y = cvt_pk_bf16(c, d); *(LAS v2u*)p = o; }

__device__ __forceinline__ void ssd_stage1(Frame& F, const Args& A, int layer, int b, int c) {
    const bf16* u = WSP(bf16, WS_U);
    LAS unsigned char* L = F.lds;
    LAS float* DT = (LAS float*)L; LAS float* AC = DT + 256;
    LAS unsigned char* BMT = L + 2048; LAS unsigned char* XCDT = BMT + 128 * 144;
    const int t0 = b * SEQ + c * 64, tid = F.tid, lane = F.lane, wave = F.wave;
    if (wave < 4) {
        const int hh = wave;
        const float dt = softplusf_(UU(t0 + lane, U_SSD_DT + hh) + KIN(I_SDTB)[layer * 4 + hh]);
        const float adt = -dt * __expf(KIN(I_SALOG)[layer * 4 + hh]);
        const float ac = wave_scan_add(adt, lane);
        DT[hh * 64 + lane] = dt; AC[hh * 64 + lane] = ac;
        if (lane == 63) WSP(float, WS_SSD_DEC)[(b * 4 + hh) * NCH + c] = __expf(ac);
    }
    __syncthreads();
    if (tid < 384) {
        const int cc = tid; const float* cw = KIN(I_SCW) + (size_t)layer * 2048 + cc; const float w0 = cw[0], w1 = cw[512], w2 = cw[1024], w3 = cw[1536], cb = KIN(I_SCB)[layer * 512 + cc];
        const bf16* up = u + (size_t)t0 * NUP + U_SSD_X + cc;
        float win0 = 0.f, win1 = 0.f, win2 = 0.f;
        if (c > 0) { win0 = bf2f(up[-3 * NUP]); win1 = bf2f(up[-2 * NUP]); win2 = bf2f(up[-1 * NUP]); }
        const int hh = (cc >> 6) & 3; const bool isx = cc < 256;
        LAS unsigned char* dst = isx ? XCDT + cc * 144 : BMT + (cc - 256) * 144;
        const float aclast = AC[hh * 64 + 63];
#pragma unroll 1
        for (int l0 = 0; l0 < 64; l0 += 32) {
            float xv[32];
#pragma unroll
            for (int j = 0; j < 32; ++j) xv[j] = bf2f(up[(l0 + j) * NUP]);
#pragma unroll
            for (int j8 = 0; j8 < 4; ++j8) { float o[8];
#pragma unroll
                for (int j = 0; j < 8; ++j) { const int l = l0 + j8 * 8 + j; const float x = xv[j8 * 8 + j]; const float y = cb + w0 * win0 + w1 * win1 + w2 * win2 + w3 * x; win0 = win1; win1 = win2; win2 = x;
                    float s = siluf_(y); if (isx) s *= DT[hh * 64 + l] * __expf(aclast - AC[hh * 64 + l]); o[j] = s; }
                *(LAS v4u*)(dst + (l0 + j8 * 8) * 2) = pack8(o); }
        }
    }
    __syncthreads();
    { const int fr = lane & 15, fq = lane >> 4; float* st = WSP(float, WS_SSD_ST);
#pragma unroll 1
      for (int i = 0; i < 2; ++i) { const int row0 = (2 * wave + i) * 16; const int hh = row0 >> 6, p = (row0 & 63) + fr;
          float* dstp = st + (((size_t)(b * 4 + hh) * NCH + c) * 64 + p) * 128;
#pragma unroll 1
          for (int ntl = 0; ntl < 8; ++ntl) { f32x4 acc = {0.f, 0.f, 0.f, 0.f}; acc = mm16(XCDT + row0 * 144, 144, BMT + ntl * 16 * 144, 144, 64, acc, fr, fq);
              *(f32x4*)(dstp + ntl * 16 + 4 * fq) = acc; } } }
    __syncthreads();
}
__device__ __forceinline__ void ssd_stage3(Frame& F, const Args& A, int layer, int b, int c) {
    const bf16* u = WSP(bf16, WS_U);
    LAS unsigned char* L = F.lds;
    LAS float* DT = (LAS float*)L; LAS float* AC = DT + 256;
    LAS unsigned char* CM = L + 2048; LAS unsigned char* BM = CM + 64 * 272; LAS unsigned char* XCT = BM + 64 * 272; LAS unsigned char* MM = XCT + 256 * 144;
    LAS unsigned char* YG = XCT;
    const int t0 = b * SEQ + c * 64, tid = F.tid, lane = F.lane, wave = F.wave, fr = lane & 15, fq = lane >> 4;
    if (wave < 4) {
        const int hh = wave;
        const float dt = softplusf_(UU(t0 + lane, U_SSD_DT + hh) + KIN(I_SDTB)[layer * 4 + hh]);
        const float adt = -dt * __expf(KIN(I_SALOG)[layer * 4 + hh]);
        DT[hh * 64 + lane] = dt; AC[hh * 64 + lane] = wave_scan_add(adt, lane);
    }
    __syncthreads();
    {
        const int cc = tid; const float* cw = KIN(I_SCW) + (size_t)layer * 2048 + cc; const float w0 = cw[0], w1 = cw[512], w2 = cw[1024], w3 = cw[1536], cb = KIN(I_SCB)[layer * 512 + cc];
        const bf16* up = u + (size_t)t0 * NUP + U_SSD_X + cc;
        float win0 = 0.f, win1 = 0.f, win2 = 0.f;
        if (c > 0) { win0 = bf2f(up[-3 * NUP]); win1 = bf2f(up[-2 * NUP]); win2 = bf2f(up[-1 * NUP]); }
        const int hh = (cc >> 6) & 3;
#pragma unroll 1
        for (int l0 = 0; l0 < 64; l0 += 32) {
            float xv[32];
#pragma unroll
            for (int j = 0; j < 32; ++j) xv[j] = bf2f(up[(l0 + j) * NUP]);
#pragma unroll
            for (int j8 = 0; j8 < 4; ++j8) { float o[8];
#pragma unroll
                for (int j = 0; j < 8; ++j) { const int l = l0 + j8 * 8 + j; const float x = xv[j8 * 8 + j]; const float y = cb + w0 * win0 + w1 * win1 + w2 * win2 + w3 * x; win0 = win1; win1 = win2; win2 = x;
                    float s = siluf_(y); if (cc < 256) s *= DT[hh * 64 + l]; o[j] = s; }
                if (cc < 256) *(LAS v4u*)(XCT + cc * 144 + (l0 + j8 * 8) * 2) = pack8(o);
                else { LAS unsigned char* d2 = (cc < 384 ? BM + (cc - 256) * 2 : CM + (cc - 384) * 2) + (l0 + j8 * 8) * 272;
#pragma unroll
                    for (int j = 0; j < 8; ++j) lds_st_bf16(d2 + j * 272, o[j]); } }
        }
    }
    __syncthreads();
#pragma unroll 1
    for (int i = 0; i < 2; ++i) { const int idx = 2 * wave + i, lt = idx >> 2, st = idx & 3;
        f32x4 acc = {0.f, 0.f, 0.f, 0.f}; acc = mm16(CM + lt * 16 * 272, 272, BM + st * 16 * 272, 272, 128, acc, fr, fq);
        const int l = lt * 16 + fr, s0 = st * 16 + 4 * fq;
#pragma unroll
        for (int hh = 0; hh < 4; ++hh) { const float al = AC[hh * 64 + l], dl = KIN(I_SD)[layer * 4 + hh] / DT[hh * 64 + l]; float o[4];
#pragma unroll
            for (int j = 0; j < 4; ++j) { const int s = s0 + j; float m = (l >= s) ? acc[j] * __expf(al - AC[hh * 64 + s]) : 0.f; if (l == s) m += dl; o[j] = m; }
            lds_st_bf16x4(MM + hh * 9216 + l * 144 + s0 * 2, o[0], o[1], o[2], o[3]); } }
    __syncthreads();
    f32x4 yv[2][4];
    { const int hh = wave >> 1; const float* prev = WSP(float, WS_SSD_ST) + ((size_t)(b * 4 + hh) * NCH + c) * 8192;
      bf16x8 pf[4][4];
#pragma unroll
      for (int pt = 0; pt < 4; ++pt)
#pragma unroll
          for (int ks = 0; ks < 4; ++ks) pf[pt][ks] = ldfrag_f32(prev + (size_t)(pt * 16 + fr) * 128 + ks * 32 + fq * 8);
#pragma unroll
      for (int i = 0; i < 2; ++i) { const int lt = 2 * (wave & 1) + i, l = lt * 16 + fr; const float ea = __expf(AC[hh * 64 + l]);
#pragma unroll
          for (int pt = 0; pt < 4; ++pt) { f32x4 ad = {0.f, 0.f, 0.f, 0.f}, ao = {0.f, 0.f, 0.f, 0.f};
              ad = mm16(MM + hh * 9216 + lt * 16 * 144, 144, XCT + (hh * 64 + pt * 16) * 144, 144, 64, ad, fr, fq);
              ao = mm16_rB<4>(CM + lt * 16 * 272, 272, pf[pt], ao, fr, fq);
              const f32x4 z = UU4(t0 + l, U_SSD_Z + hh * 64 + pt * 16 + 4 * fq);
              f32x4 y = ad + ao * ea; y.x *= siluf_(z.x); y.y *= siluf_(z.y); y.z *= siluf_(z.z); y.w *= siluf_(z.w); yv[i][pt] = y; } } }
    __syncthreads();
    { const int hh = wave >> 1;
#pragma unroll
      for (int i = 0; i < 2; ++i) { const int l = (2 * (wave & 1) + i) * 16 + fr;
#pragma unroll
          for (int pt = 0; pt < 4; ++pt) *(LAS f32x4*)(YG + l * 1040 + (hh * 64 + pt * 16 + 4 * fq) * 4) = yv[i][pt]; } }
    __syncthreads();
    { const f32x4 g = *(const f32x4*)(KIN(I_SNG) + layer * 256 + 4 * lane); bf16* mix = WSP(bf16, WS_MIX);
#pragma unroll 1
      for (int i = 0; i < 8; ++i) { const int l = wave * 8 + i; const f32x4 y = *(const LAS f32x4*)(YG + l * 1040 + lane * 16);
          const float ss = wave_sum((y.x * y.x + y.y * y.y) + (y.z * y.z + y.w * y.w)); const float r = 1.0f / sqrtf(ss * (1.f / 256.f) + NORM_EPS);
          v2u o; o.x = cvt_pk_bf16(y.x * r * g.x, y.y * r * g.y); o.y = cvt_pk_bf16(y.z * r * g.z, y.w * r * g.w);
          *(v2u*)(mix + (size_t)(t0 + l) * D + 4 * lane) = o; } }
    __syncthreads();
}

__device__ __forceinline__ void gla_bcum_all(Frame& F, const Args& A, int layer, const LAS float* GD, LAS float* BC) {
    const int d = F.tid & 127, lq = F.tid >> 7;
    float gup[16];
    { const f32x4* gp4 = (const f32x4*)(WSP(float, WS_LORA) + (size_t)layer * LORA_PER_LAYER + 32768 + d * 16);
#pragma unroll
      for (int i = 0; i < 4; ++i) { const f32x4 a = gp4[i]; gup[4 * i] = a.x; gup[4 * i + 1] = a.y; gup[4 * i + 2] = a.z; gup[4 * i + 3] = a.w; } }
    const float gb = KIN(I_GGB)[layer * 128 + d];
#pragma unroll 4
    for (int li = 0; li < 16; ++li) { const int l = lq * 16 + li; float x = gb;
#pragma unroll
        for (int i = 0; i < 4; ++i) { const f32x4 g4 = *(const LAS f32x4*)(GD + l * 16 + 4 * i); x += (g4.x * gup[4 * i] + g4.y * gup[4 * i + 1]) + (g4.z * gup[4 * i + 2] + g4.w * gup[4 * i + 3]); }
        BC[l * 128 + d] = logsigmoidf_(x) * 0.0625f; }
    __syncthreads();
    if (F.tid < 128) { float run = 0.f;
#pragma unroll 1
        for (int l0 = 0; l0 < 64; l0 += 16) { float v[16];
#pragma unroll
            for (int j = 0; j < 16; ++j) v[j] = BC[(l0 + j) * 128 + d];
#pragma unroll
            for (int j = 0; j < 16; ++j) { run += v[j]; BC[(l0 + j) * 128 + d] = run; } } }
}
__device__ __forceinline__ void gla_stage1(Frame& F, const Args& A, int layer, int b, int c) {
    const bf16* u = WSP(bf16, WS_U);
    LAS unsigned char* L = F.lds;
    LAS float* GD = (LAS float*)L; LAS float* BC = (LAS float*)(L + 4096);
    LAS unsigned char* KDT = L + 36864; LAS unsigned char* VT = KDT + 128 * 144;
    const int t0 = b * SEQ + c * 64, tid = F.tid, lane = F.lane, wave = F.wave, fr = lane & 15, fq = lane >> 4;
    if (tid < 256) { const int l = tid >> 2, q4 = tid & 3; *(LAS f32x4*)(GD + l * 16 + q4 * 4) = UU4(t0 + l, U_GL_G + 4 * q4); }
    __syncthreads();
    gla_bcum_all(F, A, layer, GD, BC);
    if (tid < 128) {
        const int d = tid; const float blast = BC[63 * 128 + d];
        WSP(float, WS_GLA_DEC)[(size_t)(b * NCH + c) * 128 + d] = __expf(blast);
        const bf16* up = u + (size_t)t0 * NUP + U_GL_K + d;
#pragma unroll 1
        for (int l0 = 0; l0 < 64; l0 += 32) { float xv[32];
#pragma unroll
            for (int j = 0; j < 32; ++j) xv[j] = bf2f(up[(l0 + j) * NUP]);
#pragma unroll
            for (int j8 = 0; j8 < 4; ++j8) { float o[8];
#pragma unroll
                for (int j = 0; j < 8; ++j) { const int l = l0 + j8 * 8 + j; o[j] = xv[j8 * 8 + j] * __expf(blast - BC[l * 128 + d]); }
                *(LAS v4u*)(KDT + d * 144 + (l0 + j8 * 8) * 2) = pack8(o); } }
    } else if (tid < 384) {
        const int vch = tid - 128; const bf16* up = u + (size_t)t0 * NUP + U_GL_V + vch;
#pragma unroll 1
        for (int l0 = 0; l0 < 64; l0 += 32) { float xv[32];
#pragma unroll
            for (int j = 0; j < 32; ++j) xv[j] = bf2f(up[(l0 + j) * NUP]);
#pragma unroll
            for (int j8 = 0; j8 < 4; ++j8) { float o[8];
#pragma unroll
                for (int j = 0; j < 8; ++j) o[j] = xv[j8 * 8 + j];
                *(LAS v4u*)(VT + vch * 144 + (l0 + j8 * 8) * 2) = pack8(o); } }
    }
    __syncthreads();
    { float* st = WSP(float, WS_GLA_ST);
#pragma unroll 1
      for (int i = 0; i < 4; ++i) { const int idx = 4 * wave + i, hh = idx >> 3, dtl = (idx >> 2) & 1, vt = idx & 3;
          f32x4 acc = {0.f, 0.f, 0.f, 0.f}; acc = mm16(KDT + (hh * 32 + dtl * 16) * 144, 144, VT + (hh * 64 + vt * 16) * 144, 144, 64, acc, fr, fq);
          *(f32x4*)(st + (((size_t)(b * 4 + hh) * NCH + c) * 32 + dtl * 16 + fr) * 64 + vt * 16 + 4 * fq) = acc; } }
    __syncthreads();
}
__device__ __forceinline__ void gla_stage3(Frame& F, const Args& A, int layer, int b, int c) {
    const bf16* u = WSP(bf16, WS_U);
    LAS unsigned char* L = F.lds;
    LAS float* GD = (LAS float*)L; LAS float* BC = (LAS float*)(L + 4096); LAS unsigned char* ATT = L + 4096;
    LAS unsigned char* QD = L + 40960; LAS unsigned char* KI = QD + 64 * 272; LAS unsigned char* VT = KI + 64 * 272; LAS unsigned char* PVT = VT + 256 * 144;
    const int t0 = b * SEQ + c * 64, tid = F.tid, lane = F.lane, wave = F.wave, fr = lane & 15, fq = lane >> 4;
    if (tid < 256) { const int l = tid >> 2, q4 = tid & 3; *(LAS f32x4*)(GD + l * 16 + q4 * 4) = UU4(t0 + l, U_GL_G + 4 * q4); }
    __syncthreads();
    gla_bcum_all(F, A, layer, GD, BC);
    if (tid < 128) {
        const int d = tid;
        const bf16* uq = u + (size_t)t0 * NUP + U_GL_Q + d; const bf16* uk = u + (size_t)t0 * NUP + U_GL_K + d;
#pragma unroll 1
        for (int l0 = 0; l0 < 64; l0 += 16) { float qv[16], kv[16];
#pragma unroll
            for (int j = 0; j < 16; ++j) { qv[j] = bf2f(uq[(l0 + j) * NUP]); kv[j] = bf2f(uk[(l0 + j) * NUP]); }
#pragma unroll
            for (int j = 0; j < 16; ++j) { const int l = l0 + j; const float bc = BC[l * 128 + d];
                lds_st_bf16(QD + l * 272 + d * 2, qv[j] * 0.17677669529663687f * __expf(bc)); lds_st_bf16(KI + l * 272 + d * 2, kv[j] * __expf(-bc)); } }
    } else if (tid < 384) {
        const int vch = tid - 128; const bf16* up = u + (size_t)t0 * NUP + U_GL_V + vch;
#pragma unroll 1
        for (int l0 = 0; l0 < 64; l0 += 32) { float xv[32];
#pragma unroll
            for (int j = 0; j < 32; ++j) xv[j] = bf2f(up[(l0 + j) * NUP]);
#pragma unroll
            for (int j8 = 0; j8 < 4; ++j8) { float o[8];
#pragma unroll
                for (int j = 0; j < 8; ++j) o[j] = xv[j8 * 8 + j];
                *(LAS v4u*)(VT + vch * 144 + (l0 + j8 * 8) * 2) = pack8(o); } }
    } else {
        const float* prev = WSP(float, WS_GLA_ST);
#pragma unroll 4
        for (int i = tid - 384; i < 8192; i += 128) { const int hh = i >> 11, dd = (i >> 6) & 31, vv = i & 63;
            lds_st_bf16(PVT + (hh * 64 + vv) * 80 + dd * 2, prev[((size_t)(b * 4 + hh) * NCH + c) * 2048 + dd * 64 + vv]); }
    }
    __syncthreads();
    const int hh = wave >> 1;
#pragma unroll 1
    for (int i = 0; i < 2; ++i) { const int tt = 2 * (wave & 1) + i, t = tt * 16 + fr;
#pragma unroll
        for (int st = 0; st < 4; ++st) { f32x4 acc = {0.f, 0.f, 0.f, 0.f}; acc = mm16(QD + tt * 16 * 272 + hh * 64, 272, KI + st * 16 * 272 + hh * 64, 272, 32, acc, fr, fq);
            const int s0 = st * 16 + 4 * fq;
            lds_st_bf16x4(ATT + hh * 9216 + t * 144 + s0 * 2, t >= s0 ? acc[0] : 0.f, t >= s0 + 1 ? acc[1] : 0.f, t >= s0 + 2 ? acc[2] : 0.f, t >= s0 + 3 ? acc[3] : 0.f); } }
    __syncthreads();
    { bf16* mix = WSP(bf16, WS_MIX); const float* ng = KIN(I_GNG) + layer * 256;
#pragma unroll 1
      for (int i = 0; i < 2; ++i) { const int tt = 2 * (wave & 1) + i, t = tt * 16 + fr; f32x4 ov[4]; float ss = 0.f;
#pragma unroll
          for (int vt = 0; vt < 4; ++vt) { f32x4 acc = {0.f, 0.f, 0.f, 0.f};
              acc = mm16(ATT + hh * 9216 + tt * 16 * 144, 144, VT + (hh * 64 + vt * 16) * 144, 144, 64, acc, fr, fq);
              acc = mm16(QD + tt * 16 * 272 + hh * 64, 272, PVT + (hh * 64 + vt * 16) * 80, 80, 32, acc, fr, fq);
              ov[vt] = acc; ss += (acc.x * acc.x + acc.y * acc.y) + (acc.z * acc.z + acc.w * acc.w); }
          ss += __shfl_xor(ss, 16); ss += __shfl_xor(ss, 32);
          const float r = 1.0f / sqrtf(ss * (1.f / 64.f) + NORM_EPS);
#pragma unroll
          for (int vt = 0; vt < 4; ++vt) { const int col = hh * 64 + vt * 16 + 4 * fq; const f32x4 g = *(const f32x4*)(ng + col); const f32x4 og = UU4(t0 + t, U_GL_OG + col);
              v2u o; o.x = cvt_pk_bf16(ov[vt].x * r * g.x * siluf_(og.x), ov[vt].y * r * g.y * siluf_(og.y)); o.y = cvt_pk_bf16(ov[vt].z * r * g.z * siluf_(og.z), ov[vt].w * r * g.w * siluf_(og.w));
              *(v2u*)(mix + (size_t)(t0 + t) * D + 512 + col) = o; } } }
    __syncthreads();
}

__device__ __forceinline__ void mlstm_stage1(Frame& F, const Args& A, int layer, int b, int c) {
    const bf16* u = WSP(bf16, WS_U);
    LAS unsigned char* L = F.lds;
    LAS float* WST = (LAS float*)L; LAS unsigned char* KT = L + 1024; LAS unsigned char* VWT = KT + 256 * 144;
    const int t0 = b * SEQ + c * 64, tid = F.tid, lane = F.lane, wave = F.wave, fr = lane & 15, fq = lane >> 4;
    if (wave < 4) {
        const int hh = wave;
        const float ig = UU(t0 + lane, U_ML_I + hh) + KIN(I_MIB)[layer * 4 + hh];
        const float lf = logsigmoidf_(UU(t0 + lane, U_ML_F + hh) + KIN(I_MFB)[layer * 4 + hh]);
        const float bc = wave_scan_add(lf, lane); const float blast = __shfl(bc, 63);
        const float ast = blast - bc + ig; const float mloc = wave_max(ast);
        WST[hh * 64 + lane] = __expf(ast - mloc);
        if (lane == 0) { WSP(float, WS_ML_BL)[(b * 4 + hh) * NCH + c] = blast; WSP(float, WS_ML_ML)[(b * 4 + hh) * NCH + c] = mloc; }
    } else {
        const int kch = tid - 256, cc = 256 + kch; const float* cw = KIN(I_MCW) + (size_t)layer * 2048 + cc; const float w0 = cw[0], w1 = cw[512], w2 = cw[1024], w3 = cw[1536], cb = KIN(I_MCB)[layer * 512 + cc];
        const bf16* up = u + (size_t)t0 * NUP + U_ML_K + kch;
        float win0 = 0.f, win1 = 0.f, win2 = 0.f;
        if (c > 0) { win0 = bf2f(up[-3 * NUP]); win1 = bf2f(up[-2 * NUP]); win2 = bf2f(up[-1 * NUP]); }
#pragma unroll 1
        for (int l0 = 0; l0 < 64; l0 += 32) { float xv[32];
#pragma unroll
            for (int j = 0; j < 32; ++j) xv[j] = bf2f(up[(l0 + j) * NUP]);
#pragma unroll
            for (int j8 = 0; j8 < 4; ++j8) { float o[8];
#pragma unroll
                for (int j = 0; j < 8; ++j) { const float x = xv[j8 * 8 + j]; const float y = cb + w0 * win0 + w1 * win1 + w2 * win2 + w3 * x; win0 = win1; win1 = win2; win2 = x; o[j] = siluf_(y); }
                *(LAS v4u*)(KT + kch * 144 + (l0 + j8 * 8) * 2) = pack8(o); } }
    }
    __syncthreads();
    if (tid < 256) {
        const int vch = tid, hh = vch >> 6; const bf16* up = u + (size_t)t0 * NUP + U_ML_V + vch;
#pragma unroll 1
        for (int l0 = 0; l0 < 64; l0 += 32) { float xv[32];
#pragma unroll
            for (int j = 0; j < 32; ++j) xv[j] = bf2f(up[(l0 + j) * NUP]);
#pragma unroll
            for (int j8 = 0; j8 < 4; ++j8) { float o[8];
#pragma unroll
                for (int j = 0; j < 8; ++j) o[j] = xv[j8 * 8 + j] * WST[hh * 64 + l0 + j8 * 8 + j];
                *(LAS v4u*)(VWT + vch * 144 + (l0 + j8 * 8) * 2) = pack8(o); } }
    } else {
        const int kch = tid - 256, hh = kch >> 6; float n = 0.f;
#pragma unroll 8
        for (int s = 0; s < 64; ++s) n += WST[hh * 64 + s] * bf2f(*(const LAS unsigned short*)(KT + kch * 144 + s * 2));
        WSP(float, WS_ML_N)[((size_t)(b * 4 + hh) * NCH + c) * 64 + (kch & 63)] = n;
    }
    __syncthreads();
    { float* cst = WSP(float, WS_ML_C); const int hh = wave >> 1;
#pragma unroll 1
      for (int i = 0; i < 2; ++i) { const int vt = 2 * (wave & 1) + i;
#pragma unroll 1
          for (int kt = 0; kt < 4; ++kt) { f32x4 acc = {0.f, 0.f, 0.f, 0.f}; acc = mm16(VWT + (hh * 64 + vt * 16) * 144, 144, KT + (hh * 64 + kt * 16) * 144, 144, 64, acc, fr, fq);
              *(f32x4*)(cst + (((size_t)(b * 4 + hh) * NCH + c) * 64 + vt * 16 + fr) * 64 + kt * 16 + 4 * fq) = acc; } } }
    __syncthreads();
}
__device__ __forceinline__ void mlstm_stage3(Frame& F, const Args& A, int layer, int b, int c) {
    const bf16* u = WSP(bf16, WS_U);
    LAS unsigned char* L = F.lds;
    LAS float* BCU = (LAS float*)L; LAS float* GG = BCU + 256; LAS float* MROW = BCU + 512; LAS float* WINT = BCU + 768; LAS float* NPV = BCU + 1024;
    LAS unsigned char* Q = L + 6144; LAS unsigned char* KK = Q + 64 * 528; LAS unsigned char* VT = KK + 64 * 528; LAS unsigned char* SC = VT + 256 * 144;
    const int t0 = b * SEQ + c * 64, tid = F.tid, lane = F.lane, wave = F.wave, fr = lane & 15, fq = lane >> 4;
    if (wave < 4) {
        const int hh = wave;
        const float ig = UU(t0 + lane, U_ML_I + hh) + KIN(I_MIB)[layer * 4 + hh];
        const float lf = logsigmoidf_(UU(t0 + lane, U_ML_F + hh) + KIN(I_MFB)[layer * 4 + hh]);
        const float bc = wave_scan_add(lf, lane); const float gg = ig - bc;
        const float mprev = WSP(float, WS_ML_M)[(b * 4 + hh) * NCH + c];
        const float minter = bc + mprev, mintra = bc + wave_scan_max(gg, lane), mrow = fmaxf(minter, mintra);
        BCU[hh * 64 + lane] = bc; GG[hh * 64 + lane] = gg; MROW[hh * 64 + lane] = mrow; WINT[hh * 64 + lane] = __expf(minter - mrow);
        NPV[hh * 64 + lane] = WSP(float, WS_ML_N)[((size_t)(b * 4 + hh) * NCH + c) * 64 + lane];
    }
    {
        const int cc = tid; const float* cw = KIN(I_MCW) + (size_t)layer * 2048 + cc; const float w0 = cw[0], w1 = cw[512], w2 = cw[1024], w3 = cw[1536], cb = KIN(I_MCB)[layer * 512 + cc];
        const bf16* up = u + (size_t)t0 * NUP + U_ML_Q + cc;
        float win0 = 0.f, win1 = 0.f, win2 = 0.f;
        if (c > 0) { win0 = bf2f(up[-3 * NUP]); win1 = bf2f(up[-2 * NUP]); win2 = bf2f(up[-1 * NUP]); }
        LAS unsigned char* dst = cc < 256 ? Q + cc * 2 : KK + (cc - 256) * 2; const float sc = cc < 256 ? 0.125f : 1.0f;
#pragma unroll 1
        for (int l0 = 0; l0 < 64; l0 += 32) { float xv[32];
#pragma unroll
            for (int j = 0; j < 32; ++j) xv[j] = bf2f(up[(l0 + j) * NUP]);
#pragma unroll
            for (int j = 0; j < 32; ++j) { const float x = xv[j]; const float y = cb + w0 * win0 + w1 * win1 + w2 * win2 + w3 * x; win0 = win1; win1 = win2; win2 = x; lds_st_bf16(dst + (l0 + j) * 528, siluf_(y) * sc); } }
        const int vch = tid & 255, lh = (tid >> 8) * 32; const bf16* uv = u + (size_t)(t0 + lh) * NUP + U_ML_V + vch;
        float xv[32];
#pragma unroll
        for (int j = 0; j < 32; ++j) xv[j] = bf2f(uv[j * NUP]);
#pragma unroll
        for (int j8 = 0; j8 < 4; ++j8) { float o[8];
#pragma unroll
            for (int j = 0; j < 8; ++j) o[j] = xv[j8 * 8 + j];
            *(LAS v4u*)(VT + vch * 144 + (lh + j8 * 8) * 2) = pack8(o); }
    }
    __syncthreads();
    { const int hh = wave >> 1; bf16* mix = WSP(bf16, WS_MIX); const float* ng = KIN(I_MNG) + layer * 256;
      const float* cprev = WSP(float, WS_ML_C) + ((size_t)(b * 4 + hh) * NCH + c) * 4096;
      bf16x8 cf[4][2];
#pragma unroll
      for (int vt = 0; vt < 4; ++vt)
#pragma unroll
          for (int ks = 0; ks < 2; ++ks) cf[vt][ks] = ldfrag_f32(cprev + (size_t)(vt * 16 + fr) * 64 + ks * 32 + fq * 8);
#pragma unroll 1
      for (int i = 0; i < 2; ++i) { const int tt = 2 * (wave & 1) + i, t = tt * 16 + fr;
          const float bt = BCU[hh * 64 + t] - MROW[hh * 64 + t]; float rs = 0.f;
#pragma unroll
          for (int st = 0; st < 4; ++st) { f32x4 acc = {0.f, 0.f, 0.f, 0.f}; acc = mm16(Q + tt * 16 * 528 + hh * 128, 528, KK + st * 16 * 528 + hh * 128, 528, 64, acc, fr, fq);
              const int s0 = st * 16 + 4 * fq; float o[4];
#pragma unroll
              for (int j = 0; j < 4; ++j) { const int s = s0 + j; const float v = (t >= s) ? acc[j] * __expf(bt + GG[hh * 64 + s]) : 0.f; o[j] = v; rs += v; }
              lds_st_bf16x4(SC + hh * 9216 + t * 144 + s0 * 2, o[0], o[1], o[2], o[3]); }
          rs += __shfl_xor(rs, 16); rs += __shfl_xor(rs, 32);
          float nq = 0.f;
#pragma unroll
          for (int j = 0; j < 16; ++j) nq += bf2f(*(const LAS unsigned short*)(Q + t * 528 + (hh * 64 + fq * 16 + j) * 2)) * NPV[hh * 64 + fq * 16 + j];
          nq += __shfl_xor(nq, 16); nq += __shfl_xor(nq, 32);
          const float wi = WINT[hh * 64 + t]; const float den = wi * nq + rs; const float dn = fmaxf(fabsf(den), __expf(-MROW[hh * 64 + t])); const float rdn = 1.0f / dn;
          LDS_WAIT();
          f32x4 hv[4]; float sm = 0.f;
#pragma unroll
          for (int vt = 0; vt < 4; ++vt) { f32x4 acc = {0.f, 0.f, 0.f, 0.f};
              acc = mm16_rB<2>(Q + tt * 16 * 528 + hh * 128, 528, cf[vt], acc, fr, fq);
              acc = acc * wi;
              acc = mm16(SC + hh * 9216 + tt * 16 * 144, 144, VT + (hh * 64 + vt * 16) * 144, 144, 64, acc, fr, fq);
              const f32x4 og = UU4(t0 + t, U_ML_O + hh * 64 + vt * 16 + 4 * fq);
              f32x4 h; h.x = acc.x * rdn * sigmoidf_(og.x); h.y = acc.y * rdn * sigmoidf_(og.y); h.z = acc.z * rdn * sigmoidf_(og.z); h.w = acc.w * rdn * sigmoidf_(og.w);
              hv[vt] = h; sm += (h.x + h.y) + (h.z + h.w); }
          sm += __shfl_xor(sm, 16); sm += __shfl_xor(sm, 32);
          const float mean = sm * (1.f / 64.f); float sq = 0.f;
#pragma unroll
          for (int vt = 0; vt < 4; ++vt) { hv[vt] = hv[vt] - mean; sq += (hv[vt].x * hv[vt].x + hv[vt].y * hv[vt].y) + (hv[vt].z * hv[vt].z + hv[vt].w * hv[vt].w); }
          sq += __shfl_xor(sq, 16); sq += __shfl_xor(sq, 32);
          const float r = 1.0f / sqrtf(sq * (1.f / 64.f) + NORM_EPS);
#pragma unroll
          for (int vt = 0; vt < 4; ++vt) { const int col = hh * 64 + vt * 16 + 4 * fq; const f32x4 g = *(const f32x4*)(ng + col);
              v2u o; o.x = cvt_pk_bf16(hv[vt].x * r * g.x, hv[vt].y * r * g.y); o.y = cvt_pk_bf16(hv[vt].z * r * g.z, hv[vt].w * r * g.w);
              *(v2u*)(mix + (size_t)(t0 + t) * D + 768 + col) = o; } } }
    __syncthreads();
}

__device__ __forceinline__ void rwkv_stage1(Frame& F, const Args& A, int layer, int ub) {
    const bf16* u = WSP(bf16, WS_U);
    LAS unsigned char* L = F.lds;
    LAS unsigned char* LOWA = L;
    LAS float* CUM = (LAS float*)(L + 16384);
    LAS float* AAB = CUM;
    LAS float* TOT = CUM;
    LAS unsigned char* M0 = L + 16384 + 16640;
#define RM(i) (M0 + (i) * 9216)
    LAS float* GAMC = (LAS float*)(F.MISC + MW_GAMC);
    const int t0 = ub * 64, c = ub & 63, tid = F.tid, lane = F.lane, wave = F.wave;
    const float* mu = KIN(I_RMU) + layer * 896;
#ifndef RW_DUP
#define RW_DUP -1
#endif
#define RW_REP(k) for (int rep__ = 0; rep__ < ((RW_DUP == (k)) ? 2 : 1); ++rep__)
    RW_REP(0) {
    {
        const int l = tid >> 3, jq = tid & 7, t = t0 + l; const bool has_prev = (t & (SEQ - 1)) != 0;
        f32x4 cur[4], prv[4];
#pragma unroll
        for (int q = 0; q < 4; ++q) { cur[q] = UU4(t, U_RW_LO + jq * 16 + 4 * q); prv[q] = has_prev ? UU4(t - 1, U_RW_LO + jq * 16 + 4 * q) : (f32x4){0.f, 0.f, 0.f, 0.f}; }
#pragma unroll
        for (int q = 0; q < 4; ++q) { const f32x4 m4 = *(const f32x4*)(mu + 768 + jq * 16 + 4 * q); const f32x4 xs = cur[q] + (prv[q] - cur[q]) * m4; const int j = jq * 16 + 4 * q;
            f32x4 o;
            if (j < 32) { o.x = tanhf_(xs.x); o.y = tanhf_(xs.y); o.z = tanhf_(xs.z); o.w = tanhf_(xs.w); } else if (j < 64) o = xs; else { o.x = sigmoidf_(xs.x); o.y = sigmoidf_(xs.y); o.z = sigmoidf_(xs.z); o.w = sigmoidf_(xs.w); }
            if (j < 64) lds_st_bf16x4(LOWA + l * 144 + j * 2, o.x, o.y, o.z, o.w); else lds_st_bf16x4(RM(0) + l * 144 + (j - 64) * 2, o.x, o.y, o.z, o.w); }
    }
    __syncthreads();
    {
        float* RG = WSP(float, WS_RW_G); const int lane_ = F.lane, fr_ = lane_ & 15, fq_ = lane_ >> 4;
        const float* gupT = WSP(float, WS_LORA) + (size_t)layer * LORA_PER_LAYER + 16384;
#pragma unroll
        for (int ci = 0; ci < 2; ++ci) { const int ct = 2 * wave + ci; bf16x8 bf[2];
#pragma unroll
            for (int ks = 0; ks < 2; ++ks) bf[ks] = ldfrag_f32(gupT + (size_t)(ct * 16 + fr_) * 64 + ks * 32 + fq_ * 8);
#pragma unroll
            for (int tt = 0; tt < 4; ++tt) { f32x4 acc = {0.f, 0.f, 0.f, 0.f}; acc = mm16_rB<2>(RM(0) + tt * 16 * 144, 144, bf, acc, fr_, fq_);
                *(f32x4*)(RG + (size_t)(t0 + tt * 16 + fr_) * 256 + ct * 16 + 4 * fq_) = acc; } }
    }
    __syncthreads();
    }
    const int b_ = ub >> 6;
#pragma unroll 1
    for (int hh = 0; hh < 4; ++hh) {
        int ch = lane, fr = lane & 15, fq = lane >> 4; asm volatile("" : "+v"(ch), "+v"(fr), "+v"(fq));
        const int tg = wave, cg = hh * 64 + ch; const size_t un = (size_t)(b_ * 4 + hh) * NCH + c;
        float rr[8], k2r[8], vr[8], ar[8], br[8], pl[8];
        LAS float* WPA = (LAS float*)RM(8);
        {
            const int mat = wave >> 2, ct = wave & 3;
            const float* wT = WSP(float, WS_LORA) + (size_t)layer * LORA_PER_LAYER + mat * 8192 + (size_t)(hh * 64 + ct * 16 + fr) * 32 + fq * 8;
            bf16x8 bfw[1]; bfw[0] = ldfrag_f32(wT);
#pragma unroll
            for (int tt = 0; tt < 4; ++tt) { f32x4 acc = {0.f, 0.f, 0.f, 0.f}; acc = mm16_rB<1>(LOWA + tt * 16 * 144 + mat * 64, 144, bfw, acc, fr, fq);
                *(LAS f32x4*)(WPA + mat * 4096 + (tt * 16 + fr) * 64 + ct * 16 + 4 * fq) = acc; }
        }
        __syncthreads();
        RW_REP(1) {
            const float w0 = KIN(I_RW0)[layer * 256 + cg], a0 = KIN(I_RA0)[layer * 256 + cg], kkc = KIN(I_RKK)[layer * 256 + cg], kac = KIN(I_RKA)[layer * 256 + cg];
            const float mur = mu[cg], muk = mu[256 + cg], muv = mu[512 + cg];
            const int tb = t0 + tg * 8; const bool nop = (c == 0) && (tg == 0);
            float rp = nop ? 0.f : UU(tb - 1, U_RW_R + cg), kp = nop ? 0.f : UU(tb - 1, U_RW_K + cg), vp = nop ? 0.f : UU(tb - 1, U_RW_V + cg);
            float rc[8], kc[8], vc[8];
#pragma unroll
            for (int j = 0; j < 8; ++j) { rc[j] = UU(tb + j, U_RW_R + cg); kc[j] = UU(tb + j, U_RW_K + cg); vc[j] = UU(tb + j, U_RW_V + cg); }
            float* RW = WSP(float, WS_RW);
            float kk[8], al[8], n2[8], run = 0.f;
#pragma unroll
            for (int j = 0; j < 8; ++j) { const int l = tg * 8 + j;
                const float r = rc[j] + (rp - rc[j]) * mur, k = kc[j] + (kp - kc[j]) * muk, v = vc[j] + (vp - vc[j]) * muv; rp = rc[j]; kp = kc[j]; vp = vc[j];
                const float wp = w0 + WPA[l * 64 + ch], ap = a0 + WPA[4096 + l * 64 + ch];
                const float w = -softplusf_(-wp) - 0.5f; run += -__expf(w); pl[j] = run; al[j] = sigmoidf_(ap);
                kk[j] = k * kkc; n2[j] = kk[j] * kk[j];
                k2r[j] = k * (1.0f + (al[j] - 1.0f) * kac); rr[j] = r; vr[j] = v;
                float* o = RW + (size_t)(tb + j) * 768 + cg; o[0] = r; o[256] = k2r[j]; o[512] = v; }
#pragma unroll
            for (int i = 0; i < 4; ++i) { const bool hi = (ch & 32) != 0; const float keep = hi ? n2[i + 4] : n2[i], send = hi ? n2[i] : n2[i + 4]; n2[i] = keep + __shfl_xor(send, 32); }
#pragma unroll
            for (int i = 0; i < 2; ++i) { const bool hi = (ch & 16) != 0; const float keep = hi ? n2[i + 2] : n2[i], send = hi ? n2[i] : n2[i + 2]; n2[i] = keep + __shfl_xor(send, 16); }
            { const bool hi = (ch & 8) != 0; const float keep = hi ? n2[1] : n2[0], send = hi ? n2[0] : n2[1]; n2[0] = keep + __shfl_xor(send, 8); }
            n2[0] += __shfl_xor(n2[0], 4); n2[0] += __shfl_xor(n2[0], 2); n2[0] += __shfl_xor(n2[0], 1);
#pragma unroll
            for (int j = 0; j < 8; ++j) { const float tot = __builtin_bit_cast(float, __builtin_amdgcn_readlane(__builtin_bit_cast(int, n2[0]), ((j & 4) ? 32 : 0) + ((j & 2) ? 16 : 0) + ((j & 1) ? 8 : 0)));
                const float kkn = kk[j] / fmaxf(sqrtf(tot), 1e-12f); ar[j] = -kkn; br[j] = kkn * al[j]; }
            TOT[tg * 64 + ch] = run;
        }
        __syncthreads();
        RW_REP(3) {
            float off = 0.f, gC = 0.f;
#pragma unroll
            for (int g = 0; g < 8; ++g) { const float tv = TOT[g * 64 + ch]; gC += tv; if (g < tg) off += tv; }
            float oat[8], obb[8], okb[8], ov[8];
#pragma unroll
            for (int j = 0; j < 8; ++j) { const int l = tg * 8 + j; const float gt = off + pl[j], gm = j > 0 ? off + pl[j - 1] : off;
                const float at = ar[j] * __expf(gm), rt = rr[j] * __expf(gt), en = __expf(-gt), ec = __expf(gC - gt);
                lds_st_bf16(RM(0) + l * 144 + ch * 2, at); lds_st_bf16(RM(1) + l * 144 + ch * 2, rt); lds_st_bf16(RM(2) + l * 144 + ch * 2, br[j] * en); lds_st_bf16(RM(3) + l * 144 + ch * 2, k2r[j] * en);
                oat[j] = at; obb[j] = br[j] * ec; okb[j] = k2r[j] * ec; ov[j] = vr[j]; }
            *(LAS v4u*)(RM(4) + ch * 144 + tg * 16) = pack8(oat); *(LAS v4u*)(RM(5) + ch * 144 + tg * 16) = pack8(obb); *(LAS v4u*)(RM(6) + ch * 144 + tg * 16) = pack8(okb); *(LAS v4u*)(RM(7) + ch * 144 + tg * 16) = pack8(ov);
            if (tg == 0) GAMC[ch] = __expf(gC);
        }
        __syncthreads();
        RW_REP(4) {
            const int which = wave >> 1; const LAS unsigned char* Aop = which < 2 ? RM(0) : RM(1); const LAS unsigned char* Bop = (which & 1) ? RM(3) : RM(2);
#pragma unroll 1
            for (int i2 = 0; i2 < 2; ++i2) { const int tt = 2 * (wave & 1) + i2, t = tt * 16 + fr;
#pragma unroll
                for (int it = 0; it < 4; ++it) { f32x4 acc = {0.f, 0.f, 0.f, 0.f}; acc = mm16(Aop + tt * 16 * 144, 144, Bop + it * 16 * 144, 144, 64, acc, fr, fq);
                    const int i0 = it * 16 + 4 * fq; const int lim = which < 2 ? t : t + 1;
                    const float o0 = (i0 < lim) ? acc[0] : 0.f, o1 = (i0 + 1 < lim) ? acc[1] : 0.f, o2 = (i0 + 2 < lim) ? acc[2] : 0.f, o3 = (i0 + 3 < lim) ? acc[3] : 0.f;
#ifdef RW_CLAMP_AAK
                    float q0 = o0, q1 = o1, q2 = o2, q3 = o3;
                    if (which == 1) { q0 = fabsf(o0) < 1e30f ? o0 : 0.f; q1 = fabsf(o1) < 1e30f ? o1 : 0.f; q2 = fabsf(o2) < 1e30f ? o2 : 0.f; q3 = fabsf(o3) < 1e30f ? o3 : 0.f; }
                    if (which == 0) *(LAS f32x4*)(AAB + t * 64 + i0) = (f32x4){o0, o1, o2, o3};
                    else lds_st_bf16x4(RM(7 + which) + t * 144 + i0 * 2, q0, q1, q2, q3);
                    continue;
#endif
                    if (which == 0) { DBG_STAT(11, o0); DBG_STAT(11, o1); DBG_STAT(11, o2); DBG_STAT(11, o3); } if (which == 1) { DBG_STAT(12, o0); DBG_STAT(12, o1); DBG_STAT(12, o2); DBG_STAT(12, o3); } if (which == 2) { DBG_STAT(13, o0); DBG_STAT(13, o3); } if (which == 3) { DBG_STAT(14, o0); DBG_STAT(14, o3); }
                    if (which == 0) *(LAS f32x4*)(AAB + t * 64 + i0) = (f32x4){o0, o1, o2, o3};
                    else lds_st_bf16x4(RM(7 + which) + t * 144 + i0 * 2, o0, o1, o2, o3); } }
        }
        __syncthreads();
        RW_REP(5) {
#pragma unroll 1
            for (int i2 = 0; i2 < 2; ++i2) { const int idx = wave * 2 + i2, vt = idx >> 2, tt = idx & 3; f32x4 acc = {0.f, 0.f, 0.f, 0.f};
                acc = mm16(RM(7) + vt * 16 * 144, 144, RM(8) + tt * 16 * 144, 144, 64, acc, fr, fq);
                DBG_STAT(15, acc[0]); DBG_STAT(15, acc[1]); DBG_STAT(15, acc[2]); DBG_STAT(15, acc[3]);
                lds_st_bf16x4(RM(0) + (vt * 16 + fr) * 144 + (tt * 16 + 4 * fq) * 2, acc[0], acc[1], acc[2], acc[3]); }
        }
        RW_REP(8) if (wave == 0) {
            float x[64]; f32x4 rowq[16];
#pragma unroll
            for (int t = 0; t < 64; ++t) {
                f32x4 cur[16];
#pragma unroll
                for (int i4 = 0; i4 < (t + 3) / 4; ++i4) cur[i4] = rowq[i4];
                if (t + 1 < 64) {
#pragma unroll
                    for (int i4 = 0; i4 < (t + 4) / 4; ++i4) rowq[i4] = *(const LAS f32x4*)(AAB + (t + 1) * 64 + 4 * i4); }
                float a0 = (t == ch) ? 1.0f : 0.f, a1 = 0.f, a2 = 0.f, a3 = 0.f;
#pragma unroll
                for (int i4 = 0; i4 < (t + 3) / 4; ++i4) { const f32x4 q = cur[i4];
                    a0 += q.x * x[4 * i4]; if (4 * i4 + 1 < t) a1 += q.y * x[4 * i4 + 1]; if (4 * i4 + 2 < t) a2 += q.z * x[4 * i4 + 2]; if (4 * i4 + 3 < t) a3 += q.w * x[4 * i4 + 3]; }
                const float acc = (a0 + a1) + (a2 + a3);
                x[t] = acc; lds_st_bf16(RM(11) + t * 144 + ch * 2, acc); }
        }
        __syncthreads();
        RW_REP(6) {
            const int rt = wave >> 1;
#pragma unroll
            for (int i2 = 0; i2 < 2; ++i2) { const int tt = 2 * (wave & 1) + i2;
                f32x4 acc = {0.f, 0.f, 0.f, 0.f}; acc = mm16(RM(4) + rt * 16 * 144, 144, RM(11) + tt * 16 * 144, 144, 64, acc, fr, fq);
                DBG_STAT(17, acc[0]); DBG_STAT(17, acc[1]); DBG_STAT(17, acc[2]); DBG_STAT(17, acc[3]);
                lds_st_bf16x4(RM(2) + (rt * 16 + fr) * 144 + (tt * 16 + 4 * fq) * 2, acc[0], acc[1], acc[2], acc[3]);
                f32x4 ac2 = {0.f, 0.f, 0.f, 0.f}; ac2 = mm16(RM(0) + rt * 16 * 144, 144, RM(11) + tt * 16 * 144, 144, 64, ac2, fr, fq);
                DBG_STAT(18, ac2[0]); DBG_STAT(18, ac2[1]); DBG_STAT(18, ac2[2]); DBG_STAT(18, ac2[3]);
                lds_st_bf16x4(RM(3) + (rt * 16 + fr) * 144 + (tt * 16 + 4 * fq) * 2, ac2[0], ac2[1], ac2[2], ac2[3]); }
        }
        __syncthreads();
        RW_REP(7) {
            const int which = wave >> 1;
#pragma unroll 1
            for (int i2 = 0; i2 < 2; ++i2) { const int rt = 2 * (wave & 1) + i2, row = rt * 16 + fr;
#pragma unroll
                for (int ct = 0; ct < 4; ++ct) { f32x4 acc = {0.f, 0.f, 0.f, 0.f}; const int c0 = ct * 16 + 4 * fq;
                    if (which == 0) { acc = mm16(RM(9) + rt * 16 * 144, 144, RM(2) + ct * 16 * 144, 144, 64, acc, fr, fq);
                        const v2u rw = *(const LAS v2u*)(RM(1) + row * 144 + c0 * 2);
                        acc[0] += __uint_as_float(rw.x << 16); acc[1] += __uint_as_float(rw.x & 0xffff0000u); acc[2] += __uint_as_float(rw.y << 16); acc[3] += __uint_as_float(rw.y & 0xffff0000u);
                        DBG_STAT(19, acc[0]); DBG_STAT(19, acc[1]); DBG_STAT(19, acc[2]); DBG_STAT(19, acc[3]);
                        v2u o; o.x = cvt_pk_bf16(acc[0], acc[1]); o.y = cvt_pk_bf16(acc[2], acc[3]); *(v2u*)(WSP(bf16, WS_RW_RH) + un * 4096 + row * 64 + c0) = o; }
                    else if (which == 1) {
#ifndef RW_NO_U0
                        acc = mm16(RM(9) + rt * 16 * 144, 144, RM(3) + ct * 16 * 144, 144, 64, acc, fr, fq);
#endif
                        acc = mm16(RM(10) + rt * 16 * 144, 144, RM(7) + ct * 16 * 144, 144, 64, acc, fr, fq);
                        DBG_STAT(20, acc[0]); DBG_STAT(20, acc[1]); DBG_STAT(20, acc[2]); DBG_STAT(20, acc[3]);
                        *(f32x4*)(WSP(float, WS_RW_O0) + un * 4096 + row * 64 + c0) = acc; }
                    else if (which == 2) { acc = mm16(RM(5) + rt * 16 * 144, 144, RM(2) + ct * 16 * 144, 144, 64, acc, fr, fq);
                        const float gd = GAMC[row]; if (row == c0) acc[0] += gd; if (row == c0 + 1) acc[1] += gd; if (row == c0 + 2) acc[2] += gd; if (row == c0 + 3) acc[3] += gd;
                        DBG_STAT(21, acc[0]); DBG_STAT(21, acc[1]); DBG_STAT(21, acc[2]); DBG_STAT(21, acc[3]);
                        v2u o; o.x = cvt_pk_bf16(acc[0], acc[1]); o.y = cvt_pk_bf16(acc[2], acc[3]);
                        *(v2u*)((unsigned char*)(WSP(bf16, WS_RW_GF) + un * 4096) + ((rt * 2 + (ct >> 1)) * 64 + ch) * 16 + (ct & 1) * 8) = o; }
                    else { acc = mm16(RM(3) + rt * 16 * 144, 144, RM(5) + ct * 16 * 144, 144, 64, acc, fr, fq); acc = mm16(RM(7) + rt * 16 * 144, 144, RM(6) + ct * 16 * 144, 144, 64, acc, fr, fq);
                        DBG_STAT(22, acc[0]); DBG_STAT(22, acc[1]); DBG_STAT(22, acc[2]); DBG_STAT(22, acc[3]);
                        *(f32x4*)(WSP(float, WS_RW_HT) + un * 4096 + row * 64 + c0) = acc; } } }
        }
        __syncthreads();
    }
#undef RM
}
__device__ __forceinline__ void rwkv_scan_wave(Frame& F, const Args& A, int wslot) {
    const int lane = F.lane, fr = lane & 15, fq = lane >> 4, bh = wslot >> 2, v0 = (wslot & 3) * 16;
    const bf16* GF = WSP(bf16, WS_RW_GF) + (size_t)bh * NCH * 4096; const float* HT = WSP(float, WS_RW_HT) + (size_t)bh * NCH * 4096 + (size_t)(v0 + fr) * 64 + 4 * fq;
    bf16* PT = WSP(bf16, WS_RW_PT) + (size_t)bh * NCH * 4096 + (size_t)(v0 + fr) * 64 + 4 * fq;
    f32x4 P[4] = {{0.f, 0.f, 0.f, 0.f}, {0.f, 0.f, 0.f, 0.f}, {0.f, 0.f, 0.f, 0.f}, {0.f, 0.f, 0.f, 0.f}};
    bf16x8 ga[4][2]; f32x4 hv[4];
#define RW2_LOAD(cc) do { _Pragma("unroll") for (int m = 0; m < 4; ++m) { hv[m] = *(const f32x4*)(HT + (size_t)(cc) * 4096 + 16 * m); \
        _Pragma("unroll") for (int s = 0; s < 2; ++s) ga[m][s] = *(const bf16x8*)(GF + (size_t)(cc) * 4096 + ((m * 2 + s) * 64 + lane) * 8); } } while (0)
    RW2_LOAD(0);
#pragma unroll 1
    for (int c = 0; c < NCH; ++c) {
        bf16x8 gc[4][2]; f32x4 acc[4];
#pragma unroll
        for (int m = 0; m < 4; ++m) { acc[m] = hv[m]; gc[m][0] = ga[m][0]; gc[m][1] = ga[m][1]; }
        if (c + 1 < NCH) RW2_LOAD(c + 1);
        v4u bs[2];
#pragma unroll
        for (int s = 0; s < 2; ++s) { bs[s].x = cvt_pk_bf16(P[2 * s][0], P[2 * s][1]); bs[s].y = cvt_pk_bf16(P[2 * s][2], P[2 * s][3]); bs[s].z = cvt_pk_bf16(P[2 * s + 1][0], P[2 * s + 1][1]); bs[s].w = cvt_pk_bf16(P[2 * s + 1][2], P[2 * s + 1][3]); }
        *(v2u*)(PT + (size_t)c * 4096) = (v2u){bs[0].x, bs[0].y}; *(v2u*)(PT + (size_t)c * 4096 + 16) = (v2u){bs[0].z, bs[0].w};
        *(v2u*)(PT + (size_t)c * 4096 + 32) = (v2u){bs[1].x, bs[1].y}; *(v2u*)(PT + (size_t)c * 4096 + 48) = (v2u){bs[1].z, bs[1].w};
#pragma unroll
        for (int m = 0; m < 4; ++m) { acc[m] = __builtin_amdgcn_mfma_f32_16x16x32_bf16(gc[m][0], __builtin_bit_cast(bf16x8, bs[0]), acc[m], 0, 0, 0);
            acc[m] = __builtin_amdgcn_mfma_f32_16x16x32_bf16(gc[m][1], __builtin_bit_cast(bf16x8, bs[1]), acc[m], 0, 0, 0); P[m] = acc[m]; DBG_STAT(23, acc[m][0]); DBG_STAT(23, acc[m][1]); DBG_STAT(23, acc[m][2]); DBG_STAT(23, acc[m][3]); }
    }
#undef RW2_LOAD
}
__device__ __forceinline__ void rwkv_stage3(Frame& F, const Args& A, int layer, int ub) {
    const int t0 = ub * 64, b_ = ub >> 6, c = ub & 63, lane = F.lane, wave = F.wave, fr = lane & 15, fq = lane >> 4, hh = wave >> 1;
    const size_t un = (size_t)(b_ * 4 + hh) * NCH + c;
    const bf16* RH = WSP(bf16, WS_RW_RH) + un * 4096; const bf16* PT = WSP(bf16, WS_RW_PT) + un * 4096; const float* O0 = WSP(float, WS_RW_O0) + un * 4096;
    const float* RW = WSP(float, WS_RW); const float* RG = WSP(float, WS_RW_G); bf16* mix = WSP(bf16, WS_MIX);
    const float* lg = KIN(I_RLNG) + layer * 256 + hh * 64; const float* lb = KIN(I_RLNB) + layer * 256 + hh * 64; const float* rk = KIN(I_RRK) + layer * 256 + hh * 64;
    bf16x8 pfr[4][2];
#pragma unroll
    for (int vt = 0; vt < 4; ++vt)
#pragma unroll
        for (int ks = 0; ks < 2; ++ks) pfr[vt][ks] = *(const bf16x8*)(PT + (size_t)(vt * 16 + fr) * 64 + ks * 32 + fq * 8);
#pragma unroll 1
    for (int i = 0; i < 2; ++i) { const int tt = 2 * (wave & 1) + i, tl = tt * 16 + fr, t = t0 + tl;
        const bf16x8 ra0 = *(const bf16x8*)(RH + (size_t)tl * 64 + fq * 8), ra1 = *(const bf16x8*)(RH + (size_t)tl * 64 + 32 + fq * 8);
        f32x4 ov[4]; float sm = 0.f;
#pragma unroll
        for (int vt = 0; vt < 4; ++vt) { f32x4 acc = *(const f32x4*)(O0 + tl * 64 + vt * 16 + 4 * fq);
            acc = __builtin_amdgcn_mfma_f32_16x16x32_bf16(pfr[vt][0], ra0, acc, 0, 0, 0); acc = __builtin_amdgcn_mfma_f32_16x16x32_bf16(pfr[vt][1], ra1, acc, 0, 0, 0);
            ov[vt] = acc; DBG_STAT(24, acc[0]); DBG_STAT(24, acc[1]); DBG_STAT(24, acc[2]); DBG_STAT(24, acc[3]); sm += (acc.x + acc.y) + (acc.z + acc.w); }
        sm += __shfl_xor(sm, 16); sm += __shfl_xor(sm, 32);
        const float mean = sm * (1.f / 64.f); float sq = 0.f;
#pragma unroll
        for (int vt = 0; vt < 4; ++vt) { ov[vt] = ov[vt] - mean; sq += (ov[vt].x * ov[vt].x + ov[vt].y * ov[vt].y) + (ov[vt].z * ov[vt].z + ov[vt].w * ov[vt].w); }
        sq += __shfl_xor(sq, 16); sq += __shfl_xor(sq, 32);
        const float rs = 1.0f / sqrtf(sq * (1.f / 64.f) + RWKV_GN_EPS);
        float bd = 0.f;
#pragma unroll
        for (int q = 0; q < 4; ++q) { const f32x4 r4 = *(const f32x4*)(RW + (size_t)t * 768 + hh * 64 + fq * 16 + 4 * q), k4 = *(const f32x4*)(RW + (size_t)t * 768 + 256 + hh * 64 + fq * 16 + 4 * q), c4 = *(const f32x4*)(rk + fq * 16 + 4 * q);
            bd += (r4.x * k4.x * c4.x + r4.y * k4.y * c4.y) + (r4.z * k4.z * c4.z + r4.w * k4.w * c4.w); }
        bd += __shfl_xor(bd, 16); bd += __shfl_xor(bd, 32);
#pragma unroll
        for (int vt = 0; vt < 4; ++vt) { const int col = vt * 16 + 4 * fq; const f32x4 g4 = *(const f32x4*)(lg + col), b4 = *(const f32x4*)(lb + col);
            const f32x4 v4 = *(const f32x4*)(RW + (size_t)t * 768 + 512 + hh * 64 + col), gg = *(const f32x4*)(RG + (size_t)t * 256 + hh * 64 + col);
            float e0 = (ov[vt].x * rs * g4.x + b4.x + bd * v4.x) * gg.x, e1 = (ov[vt].y * rs * g4.y + b4.y + bd * v4.y) * gg.y, e2 = (ov[vt].z * rs * g4.z + b4.z + bd * v4.z) * gg.z, e3 = (ov[vt].w * rs * g4.w + b4.w + bd * v4.w) * gg.w;
#ifdef RW_SANITIZE
            e0 = (fabsf(e0) < 1e30f) ? e0 : 0.f; e1 = (fabsf(e1) < 1e30f) ? e1 : 0.f; e2 = (fabsf(e2) < 1e30f) ? e2 : 0.f; e3 = (fabsf(e3) < 1e30f) ? e3 : 0.f;
#endif
            v2u o; o.x = cvt_pk_bf16(e0, e1); o.y = cvt_pk_bf16(e2, e3);
            *(v2u*)(mix + (size_t)t * D + 256 + hh * 64 + col) = o; } }
}

__device__ __forceinline__ void scans_elementwise(Frame& F, const Args& A) {
    const int nthr = F.G * 448, gt = F.vcu * 448 + (F.tid - 64);
    constexpr int N_SSD = 16 * 64 * 128, N_GLA = 16 * 32 * 64, N_MLC = 16 * 64 * 64, N_MLN = 16 * 64;
    for (int i = gt; i < N_SSD + N_GLA + N_MLC + N_MLN; i += nthr) {
        if (i < N_SSD) { const int bh = i >> 13, pn = i & 8191; float* base = WSP(float, WS_SSD_ST) + (size_t)bh * NCH * 8192 + pn; const float* dec = WSP(float, WS_SSD_DEC) + bh * NCH; float S = 0.f;
#pragma unroll 1
            for (int c0 = 0; c0 < NCH; c0 += 32) { float x[32], dd[32];
#pragma unroll
                for (int j = 0; j < 32; ++j) { x[j] = base[(size_t)(c0 + j) * 8192]; dd[j] = dec[c0 + j]; }
#pragma unroll
                for (int j = 0; j < 32; ++j) { base[(size_t)(c0 + j) * 8192] = S; S = dd[j] * S + x[j]; } }
        } else if (i < N_SSD + N_GLA) { const int k = i - N_SSD, bh = k >> 11, dv = k & 2047, dd_ = dv >> 6, b = bh >> 2, hh = bh & 3; float* base = WSP(float, WS_GLA_ST) + (size_t)bh * NCH * 2048 + dv; const float* dec = WSP(float, WS_GLA_DEC) + (size_t)b * NCH * 128 + hh * 32 + dd_; float S = 0.f;
#pragma unroll 1
            for (int c0 = 0; c0 < NCH; c0 += 32) { float x[32], dd[32];
#pragma unroll
                for (int j = 0; j < 32; ++j) { x[j] = base[(size_t)(c0 + j) * 2048]; dd[j] = dec[(c0 + j) * 128]; }
#pragma unroll
                for (int j = 0; j < 32; ++j) { base[(size_t)(c0 + j) * 2048] = S; S = dd[j] * S + x[j]; } }
        } else { const int k = i - N_SSD - N_GLA; const bool isn = k >= N_MLC; const int kk = isn ? k - N_MLC : k; const int bh = isn ? (kk >> 6) : (kk >> 12), e = isn ? (kk & 63) : (kk & 4095), str = isn ? 64 : 4096;
            float* base = (isn ? WSP(float, WS_ML_N) : WSP(float, WS_ML_C)) + (size_t)bh * NCH * str + e; const float* bl = WSP(float, WS_ML_BL) + bh * NCH; const float* ml = WSP(float, WS_ML_ML) + bh * NCH; float* mo = WSP(float, WS_ML_M) + bh * NCH;
            float S = 0.f, m = 0.f;
#pragma unroll 1
            for (int c0 = 0; c0 < NCH; c0 += 32) { float x[32], b8[32], m8[32];
#pragma unroll
                for (int j = 0; j < 32; ++j) { x[j] = base[(size_t)(c0 + j) * str]; b8[j] = bl[c0 + j]; m8[j] = ml[c0 + j]; }
#pragma unroll
                for (int j = 0; j < 32; ++j) { const float mn = fmaxf(b8[j] + m, m8[j]); const float so = __expf(b8[j] + m - mn), sn = __expf(m8[j] - mn);
                    base[(size_t)(c0 + j) * str] = S; if (!isn && e == 0) mo[c0 + j] = m; S = so * S + sn * x[j]; m = mn; } }
        }
    }
}
#ifndef MK_PER_PHASE_LAUNCH
#define MK_PER_PHASE_LAUNCH 0
#endif
#ifndef PH_MASK
#define PH_MASK 0xFFF
#endif
#ifndef ST_MASK
#define ST_MASK 0xF
#endif
#define ST_ON(k) (((ST_MASK) >> (k)) & 1)
#ifndef DUP_MASK
#define DUP_MASK 0
#endif
#define DUP_N(k) ((((DUP_MASK) >> (k)) & 1) ? 2 : 1)
#ifndef ST_DUP
#define ST_DUP 0
#endif
#define ST_REP(ty) ((((ST_DUP) >> (ty)) & 1) ? 2 : 1)
#define PH_ON(k) (((PH_MASK) >> (k)) & 1)
constexpr int PH_PER_LAYER = 11, N_PHASES = 1 + DEPTH * PH_PER_LAYER;
__global__ void __launch_bounds__(NWAVES * 64, 2) fwd_kernel(Args args) {
    extern __shared__ __attribute__((aligned(16))) unsigned char lds[];
    Frame F;
    F.lds = (LAS unsigned char*)lds;
    F.MISC = (volatile LAS unsigned*)(F.lds + MISC_OFF);
    F.tid = threadIdx.x; F.lane = F.tid & 63; F.wave = __builtin_amdgcn_readfirstlane(F.tid >> 6);
    F.G = gridDim.x; { const int bx = blockIdx.x; F.vcu = (F.G % 8 == 0) ? (bx % 8) * (F.G / 8) + bx / 8 : bx; }
    F.ka = (karg_t)__builtin_amdgcn_kernarg_segment_ptr(); F.ws = args.ws; F.ctl = (gu32*)(args.ws + WS_CTL); F.out = args.out;
    for (int i = F.tid; i < 256; i += NWAVES * 64) F.MISC[i] = 0u;
    __syncthreads();
    const int lo = args.ph_lo, hi = args.ph_hi;
#ifdef DBG_TSEL
    if (blockIdx.x == 0 && threadIdx.x == 0) __hip_atomic_store(F.ctl + CW_DBG + 15, (unsigned)__builtin_amdgcn_s_memrealtime(), RLX_AGENT);
#endif
    XcdBarrier bar; bar.bar = (unsigned*)(F.ctl + CW_BAR); bar.x = 0; bar.st = nullptr;
    if (hi - lo > 1) bar = xcd_barrier_post((unsigned*)(F.ctl + CW_BAR), F.MISC + MW_BAR);
#define IN_(k) (lo <= (k) && (k) < hi)
#ifdef DBG_TSEL
#ifndef DBG_TQ
#define DBG_TQ 50.0f
#endif
#define TSTAMP(k) do { if (blockIdx.x == 0 && threadIdx.x == 0) __hip_atomic_store(F.ctl + CW_DBG + 16 + ((k) == 11 ? 0 : 1 + layer_ * PH_PER_LAYER + (k)), (unsigned)__builtin_amdgcn_s_memrealtime(), RLX_AGENT); } while (0)
#else
#define TSTAMP(k) do { } while (0)
#endif
#ifdef BAR_DUP
#define SEAM(k) do { if (IN_(k) && IN_((k) + 1)) { xcd_barrier(bar); xcd_barrier(bar); } } while (0)
#else
#define SEAM(k) do { if (IN_(k) && IN_((k) + 1)) xcd_barrier(bar); } while (0)
#endif

    if (PH_ON(11) && IN_(0)) { for (int rep_ = 0; rep_ < DUP_N(11); ++rep_) { frame_refresh(F); p0_prologue(F, args); } SEAM(0); { const int layer_ = 0; TSTAMP(11); (void)layer_; } }
#pragma unroll 1
    for (int layer = 0; layer < DEPTH; ++layer) {
        const int pb = 1 + layer * PH_PER_LAYER; const int layer_ = layer; (void)layer_;
        if (PH_ON(0) && IN_(pb + 0)) { for (int rep_ = 0; rep_ < DUP_N(0); ++rep_) { frame_refresh(F);
            { pg8::DenseSched S; S.init(WSP(bf16, WS_XB), WSP(bf16, WS_WIN_T) + (size_t)layer * NUP * D, T, NUP, D, F.G, (int)blockIdx.x);
              pg8::EpiB16 E{WSP(bf16, WS_U), NUP, nullptr, 0.f};
              pg8::gemm_phase<pg8::EpiB16, pg8::DenseSched>(F.lds, F.tid, S, E); }
            { pg8::DenseSched S; S.init(WSP(bf16, WS_PB) + (size_t)layer * T * 256, WSP(bf16, WS_WPP_T) + (size_t)layer * D * 256, T, D, 256, F.G, (int)blockIdx.x);
              pg8::EpiB16 E{WSP(bf16, WS_PE), D, nullptr, 0.f};
              pg8::gemm_phase<pg8::EpiB16, pg8::DenseSched>(F.lds, F.tid, S, E); }
            } SEAM(pb + 0); TSTAMP(0);
        }
        if (PH_ON(1) && IN_(pb + 1)) { for (int rep_ = 0; rep_ < DUP_N(1); ++rep_) { frame_refresh(F);
            for (int un = F.vcu; un < 1024; un += F.G) { frame_refresh(F); const int ty = un >> 8, r = un & 255, b = r >> 6, c = r & 63;
                if (ty == 0) { ssd_stage1(F, args, layer, b, c); if (ST_DUP & 1) ssd_stage1(F, args, layer, b, c); } else if (ty == 1) { gla_stage1(F, args, layer, b, c); if (ST_DUP & 2) gla_stage1(F, args, layer, b, c); } else if (ty == 2) { mlstm_stage1(F, args, layer, b, c); if (ST_DUP & 4) mlstm_stage1(F, args, layer, b, c); } else { rwkv_stage1(F, args, layer, r); if (ST_DUP & 8) rwkv_stage1(F, args, layer, r); } }
            } SEAM(pb + 1); TSTAMP(1);
        }
        if (PH_ON(2) && IN_(pb + 2)) { for (int rep_ = 0; rep_ < DUP_N(2); ++rep_) { frame_refresh(F);
            if (F.wave == 0) { for (int ws_ = F.vcu; ws_ < 64; ws_ += F.G) rwkv_scan_wave(F, args, ws_); }
            else if (rep_ == 0) scans_elementwise(F, args);
            } SEAM(pb + 2); TSTAMP(2);
        }
        if (PH_ON(3) && IN_(pb + 3)) { for (int rep_ = 0; rep_ < DUP_N(3); ++rep_) { frame_refresh(F);
            for (int un = F.vcu; un < 1024; un += F.G) { frame_refresh(F); const int ty = un >> 8, r = un & 255, b = r >> 6, c = r & 63;
                if (ty == 0) { ssd_stage3(F, args, layer, b, c); if (ST_DUP & 16) ssd_stage3(F, args, layer, b, c); } else if (ty == 1) { gla_stage3(F, args, layer, b, c); if (ST_DUP & 32) gla_stage3(F, args, layer, b, c); } else if (ty == 2) { mlstm_stage3(F, args, layer, b, c); if (ST_DUP & 64) mlstm_stage3(F, args, layer, b, c); } else { rwkv_stage3(F, args, layer, r); if (ST_DUP & 128) rwkv_stage3(F, args, layer, r); } }
            } SEAM(pb + 3); TSTAMP(3);
        }
        if (PH_ON(4) && IN_(pb + 4)) { for (int rep_ = 0; rep_ < DUP_N(4); ++rep_) { frame_refresh(F);
            pg8::DenseSched S; S.init(WSP(bf16, WS_MIX), WSP(bf16, WS_WOUT_T) + (size_t)layer * D * D, T, D, D, F.G, (int)blockIdx.x);
            pg8::EpiB16 E{WSP(bf16, WS_Y1), D, WSP(bf16, WS_XB), DN_ALPHA};
            pg8::gemm_phase<pg8::EpiB16, pg8::DenseSched>(F.lds, F.tid, S, E);
            } SEAM(pb + 4); TSTAMP(4);
        }
        if (PH_ON(5) && IN_(pb + 5)) { if (DUP_N(5) == 2) { frame_refresh(F); p6_ln1_router<true>(F, args, layer); } frame_refresh(F); p6_ln1_router<false>(F, args, layer); SEAM(pb + 5); TSTAMP(5); }
        if (PH_ON(6) && IN_(pb + 6)) { for (int rep_ = 0; rep_ < DUP_N(6); ++rep_) { frame_refresh(F);
            moe_build_pfx(F, args, layer, 8);
            pg8::Moe1Sched S; S.O.pfx = F.MISC + MW_PFX; S.O.NT = 8; S.O.G = F.G; S.O.c = (int)blockIdx.x; S.sdest = WSP(int, WS_SDEST);
            if (MOE_FP8) { S.X = WSP(unsigned char, WS_X1Q); S.W = WSP(unsigned char, WS_WGU_Q) + (size_t)layer * NE * 2048 * D; S.K = D / 2; S.hstepB = (size_t)1024 * D; }
            else { S.X = WSP(unsigned char, WS_X1B); S.W = WSP(unsigned char, WS_WGU_T) + (size_t)layer * NE * 2048 * D * 2; S.K = D; S.hstepB = (size_t)1024 * D * 2; }
            pg8::EpiMoe1 E{WSP(bf16, WS_ABUF), KIN(I_BGU) + (size_t)layer * NE * 2048, WSP(unsigned char, WS_ABUFQ)};
            pg8::gemm_phase<pg8::EpiMoe1, pg8::Moe1Sched>(F.lds, F.tid, S, E);
            } SEAM(pb + 6); TSTAMP(6);
        }
        if (PH_ON(7) && IN_(pb + 7)) { for (int rep_ = 0; rep_ < DUP_N(7); ++rep_) { frame_refresh(F);
            moe_build_pfx(F, args, layer, 4);
            pg8::Moe2Sched S; S.O.pfx = F.MISC + MW_PFX; S.O.NT = 4; S.O.G = F.G; S.O.c = (int)blockIdx.x; if (MOE2_FP8) { S.Ab = WSP(unsigned char, WS_ABUFQ); S.W = WSP(unsigned char, WS_WDN_Q) + (size_t)layer * NE * D * D; S.K = D / 2; S.hstepB = (size_t)128 * D; }
            else { S.Ab = WSP(unsigned char, WS_ABUF); S.W = WSP(unsigned char, WS_WDN_T) + (size_t)layer * NE * D * D * 2; S.K = D; S.hstepB = (size_t)128 * D * 2; }
            pg8::EpiMoe2 E{WSP(bf16, WS_YBUF), KIN(I_BDN) + (size_t)layer * NE * D, WSP(int, WS_SDEST), WSP(float, WS_SGATE)};
            pg8::gemm_phase<pg8::EpiMoe2, pg8::Moe2Sched>(F.lds, F.tid, S, E);
            } SEAM(pb + 7); TSTAMP(7);
        }
        if (PH_ON(8) && IN_(pb + 8)) { for (int rep_ = 0; rep_ < DUP_N(8); ++rep_) { frame_refresh(F); p9_combine(F, args); } SEAM(pb + 8); TSTAMP(8); }
        if (PH_ON(9) && IN_(pb + 9)) { for (int rep_ = 0; rep_ < DUP_N(9); ++rep_) { frame_refresh(F);
            pg8::DenseSched S; S.init(WSP(bf16, WS_HB), WSP(bf16, WS_WPG_T) + (size_t)layer * D * D, T, D, D, F.G, (int)blockIdx.x);
            pg8::EpiPle E{WSP(bf16, WS_H2), WSP(bf16, WS_HB), WSP(bf16, WS_PE)};
            pg8::gemm_phase<pg8::EpiPle, pg8::DenseSched>(F.lds, F.tid, S, E);
            } SEAM(pb + 9); TSTAMP(9);
        }
        if (PH_ON(10) && IN_(pb + 10)) { for (int rep_ = 0; rep_ < DUP_N(10); ++rep_) { frame_refresh(F); p11_ln2(F, args, layer); } SEAM(pb + 10); TSTAMP(10); }
    }
#ifdef DBG_TSEL
    if (hi - lo > 1) { xcd_barrier(bar);
        unsigned ticks = 0u;
        if (DBG_TSEL == 11) ticks = __hip_atomic_load(F.ctl + CW_DBG + 16, RLX_AGENT) - __hip_atomic_load(F.ctl + CW_DBG + 15, RLX_AGENT);
        else for (int l = 0; l < DEPTH; ++l) { const int pi = 1 + l * PH_PER_LAYER + DBG_TSEL; ticks += __hip_atomic_load(F.ctl + CW_DBG + 16 + pi, RLX_AGENT) - __hip_atomic_load(F.ctl + CW_DBG + 16 + pi - 1, RLX_AGENT); }
        const float us = floorf((float)ticks * 0.01f / DBG_TQ) * DBG_TQ; const float code = sqrtf(us * 0.05f);
        for (size_t i = (size_t)blockIdx.x * 512 + threadIdx.x; i < (size_t)T * D; i += (size_t)gridDim.x * 512) F.out[i] = code; }
#endif
#ifdef DBG_SEL
    if (hi - lo > 1) { xcd_barrier(bar);
        const unsigned mx = __hip_atomic_load(F.ctl + CW_DBG, RLX_AGENT), nf = __hip_atomic_load(F.ctl + CW_DBG + 1, RLX_AGENT);
        float code;
        { const float m = __uint_as_float(mx); int b = (m > 0.f) ? (int)floorf(log10f(m)) + 30 : 0; b = b < 0 ? 0 : (b > 60 ? 60 : b); if (nf) b += 100; code = sqrtf(10.0f * (float)(b + 1)); }
        for (size_t i = (size_t)blockIdx.x * 512 + threadIdx.x; i < (size_t)T * D; i += (size_t)gridDim.x * 512) F.out[i] = code; }
#endif
#undef IN_
#undef SEAM
}

extern "C" void kernel_launch(void* const* d_in, const int* in_sizes, int n_in, void* d_out, int out_size, void* d_ws, size_t ws_size, hipStream_t stream) {
    static int grid = 0;
    if (grid == 0) {
        if (n_in != N_IN || out_size != T * D || ws_size < WS_END) { fprintf(stderr, "kernel_launch: unexpected shapes (n_in %d, out %d, ws %zu < %zu); nothing launched\n", n_in, out_size, ws_size, (size_t)WS_END); grid = -1; return; }
        int dev = 0, cus = 0, per_cu = 0;
        if (hipGetDevice(&dev) != hipSuccess || hipDeviceGetAttribute(&cus, hipDeviceAttributeMultiprocessorCount, dev) != hipSuccess) { grid = -1; return; }
        if (hipFuncSetAttribute((const void*)fwd_kernel, hipFuncAttributeMaxDynamicSharedMemorySize, LDS_BYTES) != hipSuccess) { fprintf(stderr, "kernel_launch: hipFuncSetAttribute failed\n"); grid = -1; return; }
        if (hipOccupancyMaxActiveBlocksPerMultiprocessor(&per_cu, (const void*)fwd_kernel, NWAVES * 64, LDS_BYTES) != hipSuccess || per_cu < 1) { fprintf(stderr, "kernel_launch: occupancy query says %d blocks per CU\n", per_cu); }
        (void)hipGetLastError();
        grid = cus;
    }
    if (grid < 0) return;
    (void)hipMemsetAsync((char*)d_ws + WS_CTL, 0, CTL_ZERO_BYTES, stream);
    Args a{};
    for (int i = 0; i < N_IN; ++i) a.in[i] = (const float*)d_in[i];
    a.out = (float*)d_out; a.ws = (unsigned char*)d_ws;
#if MK_PER_PHASE_LAUNCH
    for (int ph = 0; ph < N_PHASES; ++ph) { a.ph_lo = ph; a.ph_hi = ph + 1; hipLaunchKernelGGL(fwd_kernel, dim3(grid), dim3(NWAVES * 64), LDS_BYTES, stream, a); }
#else
    a.ph_lo = 0; a.ph_hi = N_PHASES; hipLaunchKernelGGL(fwd_kernel, dim3(grid), dim3(NWAVES * 64), LDS_BYTES, stream, a);
#endif
    const hipError_t le = hipPeekAtLastError();
    if (le != hipSuccess) fprintf(stderr, "kernel_launch: launch failed: %s\n", hipGetErrorName(le));
}
```

```cpp
#include <hip/hip_runtime.h>
#include <cstdio>
#include <cstdint>

#define GAS __attribute__((address_space(1)))
#define LAS __attribute__((address_space(3)))
typedef unsigned short bf16;
typedef unsigned v4u __attribute__((ext_vector_type(4)));
typedef unsigned v2u __attribute__((ext_vector_type(2)));
typedef float f32x4 __attribute__((ext_vector_type(4)));
typedef float f32x2 __attribute__((ext_vector_type(2)));
typedef short bf16x8 __attribute__((ext_vector_type(8)));
typedef int v4i_t __attribute__((ext_vector_type(4)));
typedef int v8i_t __attribute__((ext_vector_type(8)));
typedef GAS unsigned gu32;
#define RLX_AGENT __ATOMIC_RELAXED, __HIP_MEMORY_SCOPE_AGENT
#define LDS_WAIT() asm volatile("s_waitcnt lgkmcnt(0)" ::: "memory")
#define VM_WAIT() asm volatile("s_waitcnt vmcnt(0)" ::: "memory")

constexpr int NWAVES = 8;
constexpr int DEPTH = 4, BATCH = 4, SEQ = 4096, D = 1024, T = BATCH * SEQ;
constexpr int NU = 3484, NUP = 3584;
constexpr int NE = 32, TOPK = 4, ECAP = 16384;
constexpr int NCH = SEQ / 64;
constexpr int U_SSD_Z = 0, U_SSD_X = 256, U_SSD_B = 512, U_SSD_C = 640, U_SSD_DT = 768;
constexpr int U_RW = 772, U_RW_R = 772, U_RW_K = 1028, U_RW_V = 1284, U_RW_LO = 1540;
constexpr int U_GL_Q = 1668, U_GL_K = 1796, U_GL_V = 1924, U_GL_G = 2180, U_GL_OG = 2196;
constexpr int U_ML_Q = 2452, U_ML_K = 2708, U_ML_V = 2964, U_ML_I = 3220, U_ML_F = 3224, U_ML_O = 3228;
constexpr float DN_ALPHA = 1.6817928305074290f;
constexpr float LN_EPS = 1e-5f, NORM_EPS = 1e-5f, RWKV_GN_EPS = 64e-5f;

enum { I_X = 0, I_P, I_WIN, I_WOUT, I_LN1G, I_LN1B, I_SCW, I_SCB, I_SALOG, I_SDTB, I_SD, I_SNG,
       I_RMU, I_RW0, I_RWUP, I_RA0, I_RAUP, I_RGUP, I_RKK, I_RKA, I_RRK, I_RLNG, I_RLNB,
       I_GGUP, I_GGB, I_GNG, I_MCW, I_MCB, I_MIB, I_MFB, I_MNG,
       I_RTW, I_RTB, I_WGU, I_BGU, I_WDN, I_BDN, I_PGW, I_PPJ, I_LN2G, I_LN2B, N_IN };

constexpr size_t MiB = 1u << 20;
constexpr size_t WS_CTL = 0, CTL_ZERO_BYTES = 1 * MiB;
constexpr size_t WS_WIN_T = 2 * MiB;
constexpr size_t WS_WOUT_T = WS_WIN_T + (size_t)DEPTH * NUP * D * 2;
constexpr size_t WS_WGU_T = WS_WOUT_T + (size_t)DEPTH * D * D * 2;
constexpr size_t WS_WDN_T = WS_WGU_T + (size_t)DEPTH * NE * 2048 * D * 2;
constexpr size_t WS_WPG_T = WS_WDN_T + (size_t)DEPTH * NE * D * D * 2;
constexpr size_t WS_WPP_T = WS_WPG_T + (size_t)DEPTH * D * D * 2;
constexpr size_t WS_RWT = WS_WPP_T + (size_t)DEPTH * D * 256 * 2;
constexpr size_t WS_PB = WS_RWT + (size_t)DEPTH * NE * D * 4;
constexpr size_t WS_XB = WS_PB + (size_t)DEPTH * T * 256 * 2;
constexpr size_t WS_U = WS_XB + (size_t)T * D * 2;
constexpr size_t WS_PE = WS_U + (size_t)T * NUP * 2;
constexpr size_t WS_MIX = WS_PE + (size_t)T * D * 4;
constexpr size_t WS_Y1 = WS_MIX + (size_t)T * D * 2;
constexpr size_t WS_X1 = WS_Y1 + (size_t)T * D * 4;
constexpr size_t WS_X1B = WS_X1 + (size_t)T * D * 4;
constexpr size_t WS_SDEST = WS_X1B + (size_t)T * D * 2;
constexpr size_t WS_SGATE = WS_SDEST + (size_t)NE * ECAP * 4;
constexpr size_t WS_ABUF = WS_SGATE + (size_t)NE * ECAP * 4;
constexpr size_t WS_YBUF = WS_ABUF + (size_t)NE * ECAP * D * 2;
constexpr size_t WS_H = WS_YBUF + (size_t)T * 4 * D * 2;
constexpr size_t WS_HB = WS_H + (size_t)T * D * 4;
constexpr size_t WS_H2 = WS_HB + (size_t)T * D * 2;
constexpr size_t WS_SSD_ST = WS_H2 + (size_t)T * D * 4;
constexpr size_t WS_SSD_DEC = WS_SSD_ST + (size_t)16 * NCH * 64 * 128 * 4;
constexpr size_t WS_GLA_ST = WS_SSD_DEC + 16 * NCH * 4;
constexpr size_t WS_GLA_DEC = WS_GLA_ST + (size_t)16 * NCH * 32 * 64 * 4;
constexpr size_t WS_ML_C = WS_GLA_DEC + (size_t)4 * NCH * 128 * 4;
constexpr size_t WS_ML_N = WS_ML_C + (size_t)16 * NCH * 64 * 64 * 4;
constexpr size_t WS_ML_BL = WS_ML_N + (size_t)16 * NCH * 64 * 4;
constexpr size_t WS_ML_ML = WS_ML_BL + 16 * NCH * 4;
constexpr size_t WS_ML_M = WS_ML_ML + 16 * NCH * 4;
constexpr size_t WS_RW = WS_ML_M + 16 * NCH * 4;
constexpr size_t WS_RW_G = WS_RW + (size_t)T * 3 * 256 * 4;
constexpr size_t WS_RW_RH = WS_RW_G + (size_t)T * 256 * 4;
constexpr size_t WS_RW_O0 = WS_RW_RH + (size_t)1024 * 4096 * 2;
constexpr size_t WS_RW_GF = WS_RW_O0 + (size_t)1024 * 4096 * 4;
constexpr size_t WS_RW_HT = WS_RW_GF + (size_t)1024 * 4096 * 2;
constexpr size_t WS_RW_PT = WS_RW_HT + (size_t)1024 * 4096 * 4;
constexpr size_t WS_LORA = WS_RW_PT + (size_t)1024 * 4096 * 2;
constexpr int LORA_PER_LAYER = 8192 + 8192 + 16384 + 2048;
constexpr size_t WS_WGU_Q = WS_LORA + (size_t)DEPTH * LORA_PER_LAYER * 4;
constexpr size_t WS_WDN_Q = WS_WGU_Q + (size_t)DEPTH * NE * 2048 * D;
constexpr size_t WS_X1Q = WS_WDN_Q + (size_t)DEPTH * NE * D * D;
constexpr size_t WS_ABUFQ = WS_X1Q + (size_t)T * D;
constexpr size_t WS_END = WS_ABUFQ + (size_t)NE * ECAP * D;
#ifndef MOE_FP8
#define MOE_FP8 1
#endif
#ifndef MOE2_FP8
#define MOE2_FP8 1
#endif
constexpr int CW_BAR = 4096;
constexpr int CW_DBG = 32768;
constexpr int CW_CNT = 16384;

constexpr int RING_BYTES = 147456;
constexpr int MISC_OFF = RING_BYTES;
constexpr int LDS_BYTES = RING_BYTES + 1024;
constexpr int MW_BAR = 8, MW_LCNT = 32, MW_LBASE = 64, MW_PFX = 96, MW_CNT = 136, MW_GAMC = 168;

typedef __bf16 bf16x2_t __attribute__((ext_vector_type(2)));
__device__ __forceinline__ unsigned cvt_pk_bf16(float lo, float hi) { const f32x2 v = {lo, hi}; const bf16x2_t b = __builtin_convertvector(v, bf16x2_t); return __builtin_bit_cast(unsigned, b); }
__device__ __forceinline__ unsigned cvt4_fp8(float a, float b, float c, float d) { int w = 0; w = __builtin_amdgcn_cvt_pk_fp8_f32(a, b, w, false); w = __builtin_amdgcn_cvt_pk_fp8_f32(c, d, w, true); return (unsigned)w; }
__device__ __forceinline__ float bf2f(unsigned short b) { return __uint_as_float(((unsigned)b) << 16); }
__device__ __forceinline__ float sigmoidf_(float x) { return __builtin_amdgcn_rcpf(1.0f + __expf(-x)); }
__device__ __forceinline__ float siluf_(float x) { return x * __builtin_amdgcn_rcpf(1.0f + __expf(-x)); }
__device__ __forceinline__ float softplusf_(float x) { return fmaxf(x, 0.f) + __logf(1.0f + __expf(-fabsf(x))); }
__device__ __forceinline__ float logsigmoidf_(float x) { return fminf(x, 0.f) - __logf(1.0f + __expf(-fabsf(x))); }
__device__ __forceinline__ float tanhf_(float x) { const float e = __expf(-2.0f * fabsf(x)); const float t = (1.0f - e) * __builtin_amdgcn_rcpf(1.0f + e); return x < 0.f ? -t : t; }
__device__ __forceinline__ int lane_now() { int l = (int)__builtin_amdgcn_mbcnt_hi(~0u, __builtin_amdgcn_mbcnt_lo(~0u, 0u)); asm volatile("" : "+v"(l)); return l; }
__device__ __forceinline__ float my_shfl_idx(float v, int src) { return __builtin_bit_cast(float, __builtin_amdgcn_ds_bpermute(src << 2, __builtin_bit_cast(int, v))); }
__device__ __forceinline__ int my_shfl_idx(int v, int src) { return __builtin_amdgcn_ds_bpermute(src << 2, v); }
template <class V> __device__ __forceinline__ V my_shfl_xor(V v, int o) { return my_shfl_idx(v, lane_now() ^ o); }
template <class V> __device__ __forceinline__ V my_shfl_up(V v, int o) { const int l = lane_now(); return my_shfl_idx(v, l >= o ? l - o : l); }
#define __shfl_xor(v, o) my_shfl_xor(v, o)
#define __shfl_up(v, o) my_shfl_up(v, o)
#define __shfl(v, s) my_shfl_idx(v, s)
__device__ __forceinline__ float wave_sum(float v) {
#pragma unroll
    for (int o = 1; o < 64; o <<= 1) v += __shfl_xor(v, o);
    return v;
}
__device__ __forceinline__ float wave_max(float v) {
#pragma unroll
    for (int o = 1; o < 64; o <<= 1) v = fmaxf(v, __shfl_xor(v, o));
    return v;
}
__device__ __forceinline__ float wave_scan_add(float v, int lane) {
#pragma unroll
    for (int o = 1; o < 64; o <<= 1) { const float t = __shfl_up(v, o); if (lane >= o) v += t; }
    return v;
}
__device__ __forceinline__ float wave_scan_max(float v, int lane) {
#pragma unroll
    for (int o = 1; o < 64; o <<= 1) { const float t = __shfl_up(v, o); if (lane >= o) v = fmaxf(v, t); }
    return v;
}
__device__ __forceinline__ f32x4 mm16(const LAS unsigned char* A, int lda, const LAS unsigned char* B, int ldb, int K, f32x4 acc, int fr, int fq) {
    const LAS unsigned char* ap = A + fr * lda + fq * 16; const LAS unsigned char* bp = B + fr * ldb + fq * 16;
    for (int k = 0; k < K; k += 32) {
        const bf16x8 a = *(const LAS bf16x8*)(ap + k * 2); const bf16x8 b = *(const LAS bf16x8*)(bp + k * 2);
        acc = __builtin_amdgcn_mfma_f32_16x16x32_bf16(b, a, acc, 0, 0, 0);
    }
    return acc;
}
__device__ __forceinline__ f32x4 mm16_gB(const LAS unsigned char* A, int lda, const float* B, int ldb, int K, f32x4 acc, int fr, int fq) {
    const LAS unsigned char* ap = A + fr * lda + fq * 16; const float* bp = B + (size_t)fr * ldb + fq * 8;
    for (int k = 0; k < K; k += 32) {
        const bf16x8 a = *(const LAS bf16x8*)(ap + k * 2);
        const f32x4 b0 = *(const f32x4*)(bp + k), b1 = *(const f32x4*)(bp + k + 4);
        v4u bw; bw.x = cvt_pk_bf16(b0.x, b0.y); bw.y = cvt_pk_bf16(b0.z, b0.w); bw.z = cvt_pk_bf16(b1.x, b1.y); bw.w = cvt_pk_bf16(b1.z, b1.w);
        const bf16x8 b = __builtin_bit_cast(bf16x8, bw);
        acc = __builtin_amdgcn_mfma_f32_16x16x32_bf16(b, a, acc, 0, 0, 0);
    }
    return acc;
}
__device__ __forceinline__ f32x4 mm16_gAB(const bf16* A, int lda, const bf16* B, int ldb, int K, f32x4 acc, int fr, int fq) {
    const bf16* ap = A + (size_t)fr * lda + fq * 8; const bf16* bp = B + (size_t)fr * ldb + fq * 8;
    for (int k = 0; k < K; k += 32) { const bf16x8 a = *(const bf16x8*)(ap + k), b = *(const bf16x8*)(bp + k); acc = __builtin_amdgcn_mfma_f32_16x16x32_bf16(b, a, acc, 0, 0, 0); }
    return acc;
}
__device__ __forceinline__ bf16x8 ldfrag_f32(const float* p) { const f32x4 b0 = *(const f32x4*)p, b1 = *(const f32x4*)(p + 4);
    v4u bw; bw.x = cvt_pk_bf16(b0.x, b0.y); bw.y = cvt_pk_bf16(b0.z, b0.w); bw.z = cvt_pk_bf16(b1.x, b1.y); bw.w = cvt_pk_bf16(b1.z, b1.w); return __builtin_bit_cast(bf16x8, bw); }
template <int NK> __device__ __forceinline__ f32x4 mm16_rB(const LAS unsigned char* A, int lda, const bf16x8 (&b)[NK], f32x4 acc, int fr, int fq) {
    const LAS unsigned char* ap = A + fr * lda + fq * 16;
#pragma unroll
    for (int k = 0; k < NK; ++k) { const bf16x8 a = *(const LAS bf16x8*)(ap + k * 64); acc = __builtin_amdgcn_mfma_f32_16x16x32_bf16(b[k], a, acc, 0, 0, 0); }
    return acc;
}
__device__ __forceinline__ v4u pack8(const float (&v)[8]) { v4u o; o.x = cvt_pk_bf16(v[0], v[1]); o.y = cvt_pk_bf16(v[2], v[3]); o.z = cvt_pk_bf16(v[4], v[5]); o.w = cvt_pk_bf16(v[6], v[7]); return o; }

#define XB_TMO      128
#define XB_XCNT(j)  (256  + 64 * (j))
#define XB_XSUB(j)  (1280 + 64 * (j))
#define XB_XGEN(j)  (2304 + 64 * (j))
#define XB_TOP      3328
#define XB_TOPGEN   3392
#define XCD_BAR_WORDS 3456
#define XB_SPIN_CAP (1u << 18)
__device__ __forceinline__ unsigned xb_ld(unsigned* p)              { return __hip_atomic_load(p, __ATOMIC_RELAXED, __HIP_MEMORY_SCOPE_AGENT); }
__device__ __forceinline__ unsigned xb_add(unsigned* p, unsigned v) { return __hip_atomic_fetch_add(p, v, __ATOMIC_RELAXED, __HIP_MEMORY_SCOPE_AGENT); }
__device__ __forceinline__ unsigned xb_xcc_id() { return (unsigned)__builtin_amdgcn_s_getreg((3 << 11) | 20) & 0xFu; }
#define XB_SPIN(cond, bar) do { unsigned _sp = 0; while (cond) { __builtin_amdgcn_s_sleep(1); \
    if ((++_sp & 255u) == 0u) { if (xb_ld(&(bar)[XB_TMO])) break; if (_sp > XB_SPIN_CAP) { atomicAdd(&(bar)[XB_TMO], 1u); break; } } } } while (0)
struct XcdBarrier { unsigned* bar; unsigned x; volatile LAS unsigned* st; };
__device__ __forceinline__ XcdBarrier xcd_barrier_post(unsigned* bar, volatile LAS unsigned* st) {
    XcdBarrier b; b.bar = bar; b.x = xb_xcc_id(); b.st = st;
    if (threadIdx.x == 0) (void)xb_add(&bar[XB_XCNT(b.x)], 1u);
    return b;
}
__device__ __forceinline__ void xcd_barrier_complete(unsigned* bar, unsigned x, unsigned& nloc, unsigned& nx) {
    const unsigned G = gridDim.x * gridDim.y * gridDim.z;
    unsigned sum, cnt, mine, sp = 0u;
    for (;;) {
        sum = 0u; cnt = 0u; mine = 0u;
#pragma unroll
        for (unsigned j = 0; j < 16; ++j) { const unsigned c = xb_ld(&bar[XB_XCNT(j)]); sum += c; cnt += (c > 0u) ? 1u : 0u; mine = (j == x) ? c : mine; }
        if (sum == G) break;
        __builtin_amdgcn_s_sleep(1);
        if ((++sp & 255u) == 0u) { if (xb_ld(&bar[XB_TMO])) break; if (sp > XB_SPIN_CAP) { atomicAdd(&bar[XB_TMO], 1u); break; } }
    }
    nloc = mine > 0u ? mine : 1u; nx = cnt > 0u ? cnt : 1u;
}
__device__ __forceinline__ void xcd_barrier(const XcdBarrier& b) {
    asm volatile("s_waitcnt vmcnt(0)" ::: "memory");
    __syncthreads();
    if (threadIdx.x == 0) {
        unsigned* bar = b.bar;
        __builtin_amdgcn_s_waitcnt(0);
        unsigned nloc = b.st[0], nx = b.st[1];
        if (nloc == 0u) { xcd_barrier_complete(bar, b.x, nloc, nx); b.st[0] = nloc; b.st[1] = nx; }
        const unsigned old = xb_add(&bar[XB_XSUB(b.x)], 1u);
        const unsigned gen = old / nloc;
        if (old + 1u == (gen + 1u) * nloc) {
            __builtin_amdgcn_fence(__ATOMIC_RELEASE, "agent");
            asm volatile("s_waitcnt vmcnt(0)" ::: "memory");
            const unsigned og = xb_add(&bar[XB_TOP], 1u);
            const unsigned tg = og / nx;
            if (og + 1u == (tg + 1u) * nx) xb_add(&bar[XB_TOPGEN], 1u);
            else XB_SPIN(xb_ld(&bar[XB_TOPGEN]) == tg, bar);
            __builtin_amdgcn_fence(__ATOMIC_ACQUIRE, "agent");
            xb_add(&bar[XB_XGEN(b.x)], 1u);
            asm volatile("s_waitcnt vmcnt(0)" ::: "memory");
        } else {
            XB_SPIN(xb_ld(&bar[XB_XGEN(b.x)]) == gen, bar);
            __builtin_amdgcn_fence(__ATOMIC_ACQUIRE, "agent");
            asm volatile("s_waitcnt vmcnt(0)" ::: "memory");
        }
    }
    __syncthreads();
}

namespace pg8 {
constexpr int BM = 256, BK = 64, HALF = 128, HTB = HALF * BK * 2, STAGE_BYTES = 8 * HTB, NXCD = 8, WGM = 8;
__host__ __device__ __forceinline__ int lds_byte(int r, int c) { const int st = (r >> 4) * 2 + (c >> 5), rr = r & 15, cc = c & 31, ob = rr * 64 + cc * 2; return st * 1024 + (ob ^ (((ob >> 9) & 1) << 5)); }
__host__ __device__ __forceinline__ void stage_rc(int b, int& R, int& C) { const int st = b / 1024, sb = b % 1024, swz = sb ^ (((sb >> 9) & 1) << 5); R = (st >> 1) * 16 + swz / 64; C = (st & 1) * 32 + (swz % 64) / 2; }
__host__ __device__ __forceinline__ int perm32(int rho) { const int n = rho >> 4, i = rho & 15; return 8 * (i >> 2) + 4 * n + (i & 3); }

template <class Epi, class Sched>
__device__ __forceinline__ void gemm_phase(LAS unsigned char* lds, const int tid, const Sched& S, const Epi& E) {
    const int wid = __builtin_amdgcn_readfirstlane(tid >> 6), lane = tid & 63, wr = wid >> 2, wc = wid & 3, fr = lane & 15, fq = lane >> 4;
    const int K = S.K, nt = K / BK;
    unsigned voffB[2];
#pragma unroll
    for (int i = 0; i < 2; ++i) { int R, C; stage_rc(tid * 16 + i * 8192, R, C); const int Rb = Epi::PERM ? ((R & ~31) + perm32(R & 31)) : R; voffB[i] = (unsigned)(Rb * K + C) * 2u; }
    const size_t kstep = (size_t)(BK * 2);
    const size_t hstepB = S.hstepB;
    const unsigned ldsw = (unsigned)wid * 1024u;
    constexpr bool F8 = Sched::FP8;
    const int aoff = F8 ? lds_byte(wr * 64 + fr, fq * 16) : lds_byte(wr * 64 + fr, fq * 8), boff = F8 ? lds_byte(wc * 32 + fr, fq * 16) : lds_byte(wc * 32 + fr, fq * 8);
#define PG8_SA(b, h) (((b) * 2 + (h)) * HTB)
#define PG8_SB(b, h) ((4 + (b) * 2 + (h)) * HTB)
#define PG8_STAGE_B(bufoff, gbase) do { _Pragma("unroll") for (int _i = 0; _i < 2; ++_i) \
        __builtin_amdgcn_global_load_lds((const unsigned*)((const char*)(gbase) + voffB[_i]), (LAS unsigned*)(lds + (bufoff) + ldsw + _i * 8192), 16, 0, 0); } while (0)
#define PG8_STAGE_A(bufoff, gbase, v0, v1) do { \
        __builtin_amdgcn_global_load_lds((const unsigned*)((const char*)(gbase) + (v0)), (LAS unsigned*)(lds + (bufoff) + ldsw), 16, 0, 0); \
        __builtin_amdgcn_global_load_lds((const unsigned*)((const char*)(gbase) + (v1)), (LAS unsigned*)(lds + (bufoff) + ldsw + 8192), 16, 0, 0); } while (0)
#define PG8_FOFF(k) (F8 ? (k) * 16 : (k) * 1024)
#define PG8_LDA(dst, b, h) do { _Pragma("unroll") for (int m = 0; m < 4; ++m) { if constexpr (F8) dst##8[m] = *(const LAS v8i_t*)(lds + PG8_SA(b, h) + aoff + m * 2048); \
        else { _Pragma("unroll") for (int k = 0; k < 2; ++k) dst[m][k] = *(const LAS bf16x8*)(lds + PG8_SA(b, h) + aoff + m * 2048 + k * 1024); } } } while (0)
#define PG8_LDB(dst, b, h) do { _Pragma("unroll") for (int n = 0; n < 2; ++n) { if constexpr (F8) dst##8[n] = *(const LAS v8i_t*)(lds + PG8_SB(b, h) + boff + n * 2048); \
        else { _Pragma("unroll") for (int k = 0; k < 2; ++k) dst[n][k] = *(const LAS bf16x8*)(lds + PG8_SB(b, h) + boff + n * 2048 + k * 1024); } } } while (0)
#define PG8_CAT(x) __builtin_shufflevector(__builtin_bit_cast(v4i_t, x[0]), __builtin_bit_cast(v4i_t, x[1]), 0, 1, 2, 3, 4, 5, 6, 7)
#define PG8_MMA(ai, bj, At, Bt) do { __builtin_amdgcn_s_setprio(1); _Pragma("unroll") for (int m = 0; m < 4; ++m) _Pragma("unroll") for (int n = 0; n < 2; ++n) { \
        if constexpr (F8) acc[ai][bj][m][n] = __builtin_amdgcn_mfma_scale_f32_16x16x128_f8f6f4(Bt##8[n], At##8[m], acc[ai][bj][m][n], 0, 0, 0, S.scaleB, 0, S.scaleA); \
        else { _Pragma("unroll") for (int k = 0; k < 2; ++k) acc[ai][bj][m][n] = __builtin_amdgcn_mfma_f32_16x16x32_bf16(Bt[n][k], At[m][k], acc[ai][bj][m][n], 0, 0, 0); } } __builtin_amdgcn_s_setprio(0); } while (0)
#define PG8_WAIT_V(n) asm volatile("s_waitcnt vmcnt(" #n ")" ::: "memory")
#define PG8_WAIT_L(n) asm volatile("s_waitcnt lgkmcnt(" #n ")" ::: "memory")
#define PG8_BAR __builtin_amdgcn_s_barrier()
#define PG8_SCHED __builtin_amdgcn_sched_barrier(0)
    typename Sched::Unit cur, nxt; int ui = 0;
    if (!S.next(0, cur)) return;
    f32x4 acc[2][2][4][2];
#pragma unroll
    for (int a = 0; a < 2; ++a)
#pragma unroll
        for (int b = 0; b < 2; ++b)
#pragma unroll
            for (int m = 0; m < 4; ++m)
#pragma unroll
                for (int n = 0; n < 2; ++n) acc[a][b][m][n] = (f32x4){0.f, 0.f, 0.f, 0.f};
    bf16x8 At[4][2], B0[2][2], B1[2][2]; v8i_t At8[4], B08[2], B18[2];
    constexpr bool GA = Sched::GATHER;
    const size_t hstepA = GA ? (size_t)0 : (size_t)HALF * K * 2;
    unsigned vA[2][2];
    S.a_off(cur, tid, vA);
#define PG8_STAGE_AH(bufoff, base, vv, h) PG8_STAGE_A(bufoff, ((base) + (h) * hstepA), vv[GA ? (h) : 0][0], vv[GA ? (h) : 0][1])
    const char* cA = S.a_base(cur); const char* cB = S.b_base(cur);
    PG8_STAGE_B(PG8_SB(0, 0), cB); PG8_STAGE_B(PG8_SB(0, 1), cB + hstepB); PG8_STAGE_AH(PG8_SA(0, 0), cA, vA, 0); PG8_STAGE_AH(PG8_SA(0, 1), cA, vA, 1);
    if (wr == 1) PG8_BAR;
    PG8_WAIT_V(2); PG8_BAR;
    PG8_STAGE_B(PG8_SB(1, 0), cB + kstep); PG8_STAGE_AH(PG8_SA(1, 0), cA + kstep, vA, 0); PG8_STAGE_B(PG8_SB(1, 1), cB + hstepB + kstep);
    PG8_WAIT_V(6); PG8_BAR;
    for (;;) {
        const bool has_next = S.next(ui + 1, nxt);
        const char* nA = cA; const char* nB = cB;
        if (has_next) { nA = S.a_base(nxt); nB = S.b_base(nxt); }
        for (int t = 0; t < nt; t += 2) {
            const bool last = (t == nt - 2);
            const char* a1 = cA + (size_t)(t + 1) * kstep;
            const char* a2 = last ? nA : cA + (size_t)(t + 2) * kstep; const char* b2 = last ? nB : cB + (size_t)(t + 2) * kstep;
            const char* a3 = a2 + kstep; const char* b3 = b2 + kstep;
            PG8_LDB(B0, 0, 0); PG8_LDB(B1, 0, 1); PG8_SCHED; PG8_LDA(At, 0, 0); PG8_STAGE_AH(PG8_SA(1, 1), a1, vA, 1);
            if constexpr (GA) { if (last && has_next) S.a_off(nxt, tid, vA); }
            PG8_WAIT_V(8); PG8_WAIT_L(0); PG8_BAR; PG8_MMA(0, 0, At, B0); PG8_MMA(0, 1, At, B1); PG8_BAR; PG8_SCHED;
            PG8_LDA(At, 0, 1); PG8_STAGE_B(PG8_SB(0, 0), b2); PG8_STAGE_B(PG8_SB(0, 1), b2 + hstepB); PG8_STAGE_AH(PG8_SA(0, 0), a2, vA, 0);
            PG8_WAIT_V(8); PG8_WAIT_L(0); PG8_BAR; PG8_MMA(1, 0, At, B0); PG8_MMA(1, 1, At, B1); PG8_BAR; PG8_SCHED;
            PG8_LDB(B0, 1, 0); PG8_LDB(B1, 1, 1); PG8_SCHED; PG8_LDA(At, 1, 0); PG8_STAGE_AH(PG8_SA(0, 1), a2, vA, 1);
            PG8_WAIT_V(8); PG8_WAIT_L(0); PG8_BAR; PG8_MMA(0, 0, At, B0); PG8_MMA(0, 1, At, B1); PG8_BAR; PG8_SCHED;
            PG8_LDA(At, 1, 1); PG8_STAGE_B(PG8_SB(1, 0), b3); PG8_STAGE_B(PG8_SB(1, 1), b3 + hstepB); PG8_STAGE_AH(PG8_SA(1, 0), a3, vA, 0);
            PG8_WAIT_V(8); PG8_WAIT_L(0); PG8_BAR; PG8_MMA(1, 0, At, B0); PG8_MMA(1, 1, At, B1); PG8_BAR; PG8_SCHED;
        }
        if (wr == 0) PG8_BAR;
        { int fr_ = fr, fq_ = fq; asm volatile("" : "+v"(fr_), "+v"(fq_)); E(acc, cur, wr, wc, fr_, fq_); }
        if (!has_next) break;
#pragma unroll
        for (int a = 0; a < 2; ++a)
#pragma unroll
            for (int b = 0; b < 2; ++b)
#pragma unroll
                for (int m = 0; m < 4; ++m)
#pragma unroll
                    for (int n = 0; n < 2; ++n) acc[a][b][m][n] = (f32x4){0.f, 0.f, 0.f, 0.f};
        cur = nxt; cA = nA; cB = nB; ++ui;
        if (wr == 1) PG8_BAR;
    }
    PG8_WAIT_V(0);
    PG8_BAR;
#undef PG8_SA
#undef PG8_SB
#undef PG8_STAGE_A
#undef PG8_STAGE_AH
#undef PG8_STAGE_B
#undef PG8_LDA
#undef PG8_LDB
#undef PG8_MMA
#undef PG8_CAT
#undef PG8_FOFF
#undef PG8_WAIT_V
#undef PG8_WAIT_L
#undef PG8_BAR
#undef PG8_SCHED
}
}
struct Args { const float* in[N_IN]; float* out; unsigned char* ws; int ph_lo, ph_hi; };
typedef const __attribute__((address_space(4))) unsigned long long* karg_t;
struct Frame {
    karg_t ka;
    LAS unsigned char* lds;
    volatile LAS unsigned* MISC;
    gu32* ctl;
    unsigned char* ws;
    float* out;
    int tid, lane, wave, vcu, G;
};
#define WSP(T_, off) ((T_*)(F.ws + (off)))
#define KIN(k) ((const float*)F.ka[(k)])
#ifdef DBG_SEL
#define DBG_STAT(k, val) do { const float _v = (val); if ((k) == DBG_SEL) { if (fabsf(_v) < 3e38f) atomicMax((unsigned*)(F.ctl + CW_DBG), __float_as_uint(fabsf(_v))); else atomicAdd((unsigned*)(F.ctl + CW_DBG + 1), 1u); } } while (0)
#else
#define DBG_STAT(k, val) do { } while (0)
#endif
template <class P> __device__ __forceinline__ P launder_uniform(P p) {
    unsigned lo = (unsigned)(unsigned long long)p, hi = (unsigned)((unsigned long long)p >> 32);
    asm volatile("" : "+v"(lo), "+v"(hi));
    lo = __builtin_amdgcn_readfirstlane(lo); hi = __builtin_amdgcn_readfirstlane(hi);
    return (P)(((unsigned long long)hi << 32) | lo);
}
__device__ __forceinline__ void frame_refresh(Frame& F) {
    int t = F.tid; asm volatile("" : "+v"(t)); F.tid = t; F.lane = t & 63; F.wave = __builtin_amdgcn_readfirstlane(t >> 6);
    F.ws = launder_uniform(F.ws); F.ctl = (gu32*)(F.ws + WS_CTL);
    F.out = launder_uniform(F.out);
    F.ka = launder_uniform(F.ka);
}

namespace pg8 {
struct DenseSched {
    static constexpr bool GATHER = false, FP8 = false; static constexpr int scaleA = 0, scaleB = 0;
    struct Unit { int pm, pn; };
    const bf16* A; const bf16* Bt; int K; size_t hstepB; int nM, nN, nwg, G, c;
    __device__ __forceinline__ void init(const bf16* A_, const bf16* Bt_, int M, int N, int K_, int G_, int c_) { A = A_; Bt = Bt_; K = K_; hstepB = (size_t)HALF * K_ * 2; nM = M / BM; nN = N / BM; nwg = nM * nN; G = G_; c = c_; }
    __device__ __forceinline__ bool next(int i, Unit& u) const {
        const long L = (long)i * G + c; if (L >= nwg) return false;
        int wgid = (int)L; { const int q = nwg / NXCD, r = nwg % NXCD, xcd = wgid % NXCD, off = wgid / NXCD; wgid = (xcd < r ? xcd * (q + 1) : r * (q + 1) + (xcd - r) * q) + off; }
        const int nig = WGM * nN, gid = wgid / nig, fm = gid * WGM, gsz = (nM - fm) < WGM ? (nM - fm) : WGM;
        u.pm = fm + ((wgid % nig) % gsz); u.pn = (wgid % nig) / gsz; return true;
    }
    __device__ __forceinline__ const char* a_base(const Unit& u) const { return (const char*)A + (size_t)u.pm * BM * K * 2; }
    __device__ __forceinline__ const char* b_base(const Unit& u) const { return (const char*)Bt + (size_t)u.pn * BM * K * 2; }
    __device__ __forceinline__ void a_off(const Unit&, int tid, unsigned (&v)[2][2]) const {
#pragma unroll
        for (int i = 0; i < 2; ++i) { int R, C; stage_rc(tid * 16 + i * 8192, R, C); v[0][i] = (unsigned)(R * K + C) * 2u; v[1][i] = v[0][i]; }
    }
};
struct MoeUnit { int e, mt, nt, cnt; };
struct MoeOrder {
    const volatile LAS unsigned* pfx;
    int NT, G, c;
    __device__ __forceinline__ bool decode(int i, MoeUnit& u) const {
        const int nwg = (int)pfx[32]; const long L = (long)i * G + c; if (L >= nwg) return false;
        int wgid = (int)L; { const int q = nwg / NXCD, r = nwg % NXCD, xcd = wgid % NXCD, off = wgid / NXCD; wgid = (xcd < r ? xcd * (q + 1) : r * (q + 1) + (xcd - r) * q) + off; }
        int e = 0;
#pragma unroll
        for (int st = 16; st >= 1; st >>= 1) e += ((int)pfx[e + st] <= wgid) ? st : 0;
        const int j = wgid - (int)pfx[e];
        u.e = e; u.mt = j / NT; u.nt = j % NT; u.cnt = (int)pfx[40 + e]; return true;
    }
};
struct Moe1Sched {
    static constexpr bool GATHER = true, FP8 = (MOE_FP8 != 0); static constexpr int EB = FP8 ? 1 : 2; static constexpr int scaleA = 0x7F7F7F7F, scaleB = 0x7A7A7A7A;
    typedef MoeUnit Unit;
    MoeOrder O; const unsigned char* X; const unsigned char* W; const int* sdest; int K; size_t hstepB;
    __device__ __forceinline__ bool next(int i, Unit& u) const { return O.decode(i, u); }
    __device__ __forceinline__ const char* a_base(const Unit&) const { return (const char*)X; }
    __device__ __forceinline__ const char* b_base(const Unit& u) const { return (const char*)W + ((size_t)u.e * 2048 + (size_t)u.nt * 128) * 1024 * EB; }
    __device__ __forceinline__ void a_off(const Unit& u, int tid, unsigned (&v)[2][2]) const {
#pragma unroll
        for (int i = 0; i < 2; ++i) { int R, C; stage_rc(tid * 16 + i * 8192, R, C);
#pragma unroll
            for (int h = 0; h < 2; ++h) { const int slot = u.mt * 256 + h * HALF + R; int tok = 0; if (slot < u.cnt) tok = sdest[u.e * ECAP + slot] >> 2; v[h][i] = (unsigned)(tok * 1024 * EB + C * 2); } }
    }
};
struct Moe2Sched {
    static constexpr bool GATHER = true, FP8 = (MOE2_FP8 != 0); static constexpr int EB = FP8 ? 1 : 2; static constexpr int scaleA = 0x7F7F7F7F, scaleB = 0x79797979;
    typedef MoeUnit Unit;
    MoeOrder O; const unsigned char* Ab; const unsigned char* W; int K; size_t hstepB;
    __device__ __forceinline__ bool next(int i, Unit& u) const { return O.decode(i, u); }
    __device__ __forceinline__ const char* a_base(const Unit& u) const { return (const char*)Ab + ((size_t)u.e * ECAP + (size_t)u.mt * 256) * 1024 * EB; }
    __device__ __forceinline__ const char* b_base(const Unit& u) const { return (const char*)W + ((size_t)u.e * 1024 + (size_t)u.nt * 256) * 1024 * EB; }
    __device__ __forceinline__ void a_off(const Unit&, int tid, unsigned (&v)[2][2]) const {
        int t_ = tid; asm volatile("" : "+v"(t_));
#pragma unroll
        for (int i = 0; i < 2; ++i) { int R, C; stage_rc(t_ * 16 + i * 8192, R, C); v[0][i] = (unsigned)(R * 1024 * EB + C * 2); v[1][i] = v[0][i] + (unsigned)(HALF * 1024 * EB); }
    }
};

__device__ __forceinline__ void unpack8(const v4u w, f32x4& a, f32x4& b) {
    a = (f32x4){__uint_as_float(w.x << 16), __uint_as_float(w.x & 0xffff0000u), __uint_as_float(w.y << 16), __uint_as_float(w.y & 0xffff0000u)};
    b = (f32x4){__uint_as_float(w.z << 16), __uint_as_float(w.z & 0xffff0000u), __uint_as_float(w.w << 16), __uint_as_float(w.w & 0xffff0000u)}; }
struct EpiF32 {
    static constexpr bool PERM = false;
    float* C; int ldc; const float* base; float alpha;
    __device__ __forceinline__ void operator()(const f32x4 (&acc)[2][2][4][2], const DenseSched::Unit& u, int wr, int wc, int fr, int fq) const {
        const int row0 = u.pm * BM + wr * 64 + fr, col0 = u.pn * BM + wc * 32 + 4 * fq;
#pragma unroll
        for (int ai = 0; ai < 2; ++ai)
#pragma unroll
            for (int m = 0; m < 4; ++m) { const size_t ro = (size_t)(row0 + ai * HALF + m * 16) * ldc + col0;
#pragma unroll
                for (int bj = 0; bj < 2; ++bj)
#pragma unroll
                    for (int n = 0; n < 2; ++n) { f32x4 v = acc[ai][bj][m][n];
                        if (base) { const f32x4 b = *(const f32x4*)(base + ro + bj * HALF + n * 16); v = v + b * alpha; }
                        *(f32x4*)(C + ro + bj * HALF + n * 16) = v; } }
    }
};
struct EpiB16 {
    static constexpr bool PERM = true;
    bf16* O; int ldc; const bf16* base; float alpha;
    __device__ __forceinline__ void operator()(const f32x4 (&acc)[2][2][4][2], const DenseSched::Unit& u, int wr, int wc, int fr, int fq) const {
        const int row0 = u.pm * BM + wr * 64 + fr, col0 = u.pn * BM + wc * 32 + 8 * fq;
#pragma unroll
        for (int ai = 0; ai < 2; ++ai) {
            v4u bw[4][2];
            if (base) {
#pragma unroll
                for (int m = 0; m < 4; ++m)
#pragma unroll
                    for (int bj = 0; bj < 2; ++bj) bw[m][bj] = *(const v4u*)(base + (size_t)(row0 + ai * HALF + m * 16) * ldc + col0 + bj * HALF); }
#pragma unroll
            for (int m = 0; m < 4; ++m) { bf16* rowp = O + (size_t)(row0 + ai * HALF + m * 16) * ldc + col0;
#pragma unroll
                for (int bj = 0; bj < 2; ++bj) { f32x4 v0 = acc[ai][bj][m][0], v1 = acc[ai][bj][m][1];
                    if (base) { f32x4 b0, b1; unpack8(bw[m][bj], b0, b1); v0 = v0 + b0 * alpha; v1 = v1 + b1 * alpha; }
                    v4u w; w.x = cvt_pk_bf16(v0[0], v0[1]); w.y = cvt_pk_bf16(v0[2], v0[3]); w.z = cvt_pk_bf16(v1[0], v1[1]); w.w = cvt_pk_bf16(v1[2], v1[3]);
                    *(v4u*)(rowp + bj * HALF) = w; } } }
    }
};
struct EpiPle {
    static constexpr bool PERM = true;
    bf16* C; const bf16* hb; const bf16* pe;
    __device__ __forceinline__ void operator()(const f32x4 (&acc)[2][2][4][2], const DenseSched::Unit& u, int wr, int wc, int fr, int fq) const {
        const int row0 = u.pm * BM + wr * 64 + fr, col0 = u.pn * BM + wc * 32 + 8 * fq;
#pragma unroll
        for (int ai = 0; ai < 2; ++ai) {
            v4u hw[4][2], pw[4][2];
#pragma unroll
            for (int m = 0; m < 4; ++m)
#pragma unroll
                for (int bj = 0; bj < 2; ++bj) { const size_t ro = (size_t)(row0 + ai * HALF + m * 16) * 1024 + col0 + bj * HALF; hw[m][bj] = *(const v4u*)(hb + ro); pw[m][bj] = *(const v4u*)(pe + ro); }
#pragma unroll
            for (int m = 0; m < 4; ++m)
#pragma unroll
                for (int bj = 0; bj < 2; ++bj) { const size_t ro = (size_t)(row0 + ai * HALF + m * 16) * 1024 + col0 + bj * HALF;
                    f32x4 h0, h1, p0, p1; unpack8(hw[m][bj], h0, h1); unpack8(pw[m][bj], p0, p1); const f32x4 a0 = acc[ai][bj][m][0], a1 = acc[ai][bj][m][1];
                    f32x4 o0, o1;
#pragma unroll
                    for (int j = 0; j < 4; ++j) { o0[j] = h0[j] + sigmoidf_(a0[j]) * p0[j]; o1[j] = h1[j] + sigmoidf_(a1[j]) * p1[j]; }
                    v4u w; w.x = cvt_pk_bf16(o0[0], o0[1]); w.y = cvt_pk_bf16(o0[2], o0[3]); w.z = cvt_pk_bf16(o1[0], o1[1]); w.w = cvt_pk_bf16(o1[2], o1[3]);
                    *(v4u*)(C + ro) = w; } }
    }
};
struct EpiMoe1 {
    static constexpr bool PERM = true;
    bf16* Ab; const float* bgu; unsigned char* AbQ;
    __device__ __forceinline__ void operator()(const f32x4 (&acc)[2][2][4][2], const MoeUnit& u, int wr, int wc, int fr, int fq) const {
        const int col0 = u.nt * 128 + wc * 32 + 8 * fq;
        const float* bg = bgu + (size_t)u.e * 2048 + col0;
        const f32x4 bg0 = *(const f32x4*)(bg), bg1 = *(const f32x4*)(bg + 4), bl0 = *(const f32x4*)(bg + 1024), bl1 = *(const f32x4*)(bg + 1028);
#pragma unroll
        for (int ai = 0; ai < 2; ++ai)
#pragma unroll
            for (int m = 0; m < 4; ++m) { const int r = ai * HALF + wr * 64 + m * 16 + fr;
                bf16* rowp = Ab + ((size_t)u.e * ECAP + (size_t)u.mt * 256 + r) * 1024 + col0;
                float o[8];
#pragma unroll
                for (int n = 0; n < 2; ++n) { const f32x4 g4 = acc[ai][0][m][n] + (n ? bg1 : bg0), l4 = acc[ai][1][m][n] + (n ? bl1 : bl0);
#pragma unroll
                    for (int j = 0; j < 4; ++j) { const float g = fminf(g4[j], 7.0f), l = fminf(fmaxf(l4[j], -7.0f), 7.0f); o[n * 4 + j] = (l + 1.0f) * g * sigmoidf_(1.702f * g); } }
                if constexpr (MOE2_FP8) { v2u q; q.x = cvt4_fp8(o[0], o[1], o[2], o[3]); q.y = cvt4_fp8(o[4], o[5], o[6], o[7]); *(v2u*)((unsigned char*)AbQ + ((size_t)u.e * ECAP + (size_t)u.mt * 256 + r) * 1024 + col0) = q; }
                else *(v4u*)rowp = pack8(o); }
    }
};
struct EpiMoe2 {
    static constexpr bool PERM = true;
    bf16* Y; const float* bdn; const int* sdest; const float* sgate;
    __device__ __forceinline__ void operator()(const f32x4 (&acc)[2][2][4][2], const MoeUnit& u, int wr, int wc, int fr, int fq) const {
        const int col0 = u.nt * 256 + wc * 32 + 8 * fq;
        const float* bp = bdn + (size_t)u.e * 1024 + col0;
#pragma unroll
        for (int ai = 0; ai < 2; ++ai) {
            f32x4 bv[2][2];
#pragma unroll
            for (int bj = 0; bj < 2; ++bj)
#pragma unroll
                for (int n = 0; n < 2; ++n) bv[bj][n] = *(const f32x4*)(bp + bj * HALF + 4 * n);
            int dest[4]; float gate[4];
#pragma unroll
            for (int m = 0; m < 4; ++m) { const int slot = u.mt * 256 + ai * HALF + wr * 64 + m * 16 + fr; const bool ok = slot < u.cnt; const int si = u.e * ECAP + (ok ? slot : 0);
                dest[m] = ok ? sdest[si] : T * 4; gate[m] = sgate[si]; }
#pragma unroll
            for (int m = 0; m < 4; ++m) {
                { const float g = gate[m]; bf16* rowp = Y + (size_t)dest[m] * 1024 + col0;
#pragma unroll
                    for (int bj = 0; bj < 2; ++bj) { const f32x4 v0 = (acc[ai][bj][m][0] + bv[bj][0]) * g, v1 = (acc[ai][bj][m][1] + bv[bj][1]) * g;
                        v4u w; w.x = cvt_pk_bf16(v0[0], v0[1]); w.y = cvt_pk_bf16(v0[2], v0[3]); w.z = cvt_pk_bf16(v1[0], v1[1]); w.w = cvt_pk_bf16(v1[2], v1[3]);
                        *(v4u*)(rowp + bj * HALF) = w; } } } }
    }
};
}

__device__ __forceinline__ void p0_transpose_item(const float* W, int K, int N, int nblk, bf16* WT, int item, int lane) {
    const int kb = item / nblk, nb = item % nblk, k0 = 64 * kb, n = 64 * nb + lane;
    const bool ok = n < N; const float* src = W + (size_t)k0 * N + (ok ? n : 0);
    float x[64];
#pragma unroll
    for (int j = 0; j < 64; ++j) x[j] = __builtin_nontemporal_load(src + (size_t)j * N);
    bf16* dst = WT + (size_t)n * K + k0;
#pragma unroll
    for (int q = 0; q < 8; ++q) { v4u o; o.x = cvt_pk_bf16(x[8 * q], x[8 * q + 1]); o.y = cvt_pk_bf16(x[8 * q + 2], x[8 * q + 3]); o.z = cvt_pk_bf16(x[8 * q + 4], x[8 * q + 5]); o.w = cvt_pk_bf16(x[8 * q + 6], x[8 * q + 7]);
        if (!ok) o = (v4u){0u, 0u, 0u, 0u};
        *(v4u*)(dst + 8 * q) = o; }
}
__device__ __forceinline__ void cvt_rows(const float* src, bf16* dst, size_t n8, size_t i0, size_t stride) {
    for (size_t i = i0; i < n8; i += stride) { const f32x4 a = *(const f32x4*)(src + i * 8), b = *(const f32x4*)(src + i * 8 + 4);
        v4u o; o.x = cvt_pk_bf16(a.x, a.y); o.y = cvt_pk_bf16(a.z, a.w); o.z = cvt_pk_bf16(b.x, b.y); o.w = cvt_pk_bf16(b.z, b.w); *(v4u*)(dst + i * 8) = o; }
}
__device__ __forceinline__ void p0_prologue(Frame& F, const Args& A) {
    const int gw = F.vcu * NWAVES + F.wave, NGW = F.G * NWAVES;
    constexpr int I_IN = 16 * (NUP / 64), I_OUT = 16 * 16, I_GU = 16 * 32, I_DN = 16 * 16, I_PG = 16 * 16, I_PP = 4 * 16;
    constexpr int PER_LAYER = I_IN + I_OUT + NE * I_GU + NE * I_DN + I_PG + I_PP;
#pragma unroll 1
    for (int it = gw; it < DEPTH * PER_LAYER; it += NGW) {
        const int l = it / PER_LAYER; int r = it % PER_LAYER;
        const float* W; bf16* WT; int K = D, N = D, nblk = 16;
        if (r < I_IN) { W = KIN(I_WIN) + (size_t)l * D * NU; WT = WSP(bf16, WS_WIN_T) + (size_t)l * NUP * D; N = NU; nblk = NUP / 64; }
        else if ((r -= I_IN) < I_OUT) { W = KIN(I_WOUT) + (size_t)l * D * D; WT = WSP(bf16, WS_WOUT_T) + (size_t)l * D * D; }
        else if ((r -= I_OUT) < NE * I_GU) { if (MOE_FP8) continue; const int e = r / I_GU; r %= I_GU; W = KIN(I_WGU) + ((size_t)l * NE + e) * D * 2048; WT = WSP(bf16, WS_WGU_T) + ((size_t)l * NE + e) * 2048 * D; N = 2048; nblk = 32; }
        else if ((r -= NE * I_GU) < NE * I_DN) { if (MOE2_FP8) continue; const int e = r / I_DN; r %= I_DN; W = KIN(I_WDN) + ((size_t)l * NE + e) * D * D; WT = WSP(bf16, WS_WDN_T) + ((size_t)l * NE + e) * D * D; }
        else if ((r -= NE * I_DN) < I_PG) { W = KIN(I_PGW) + (size_t)l * D * D; WT = WSP(bf16, WS_WPG_T) + (size_t)l * D * D; }
        else { r -= I_PG; W = KIN(I_PPJ) + (size_t)l * 256 * D; WT = WSP(bf16, WS_WPP_T) + (size_t)l * D * 256; K = 256; }
        p0_transpose_item(W, K, N, nblk, WT, r, F.lane);
    }
#if MOE_FP8
    constexpr int Q_GU = 16 * 32, Q_DN = 16 * 16, Q_PER_LAYER = NE * (Q_GU + Q_DN);
#pragma unroll 1
    for (int it = gw; it < DEPTH * Q_PER_LAYER; it += NGW) {
        const int l = it / Q_PER_LAYER; int r = it % Q_PER_LAYER; const float* W; unsigned char* WQ; int N; float sc;
        if (r < NE * Q_GU) { const int e = r / Q_GU; r %= Q_GU; W = KIN(I_WGU) + ((size_t)l * NE + e) * D * 2048; WQ = WSP(unsigned char, WS_WGU_Q) + ((size_t)l * NE + e) * 2048 * D; N = 2048; sc = 32.0f; }
        else { if (!MOE2_FP8) continue; r -= NE * Q_GU; const int e = r / Q_DN; r %= Q_DN; W = KIN(I_WDN) + ((size_t)l * NE + e) * D * D; WQ = WSP(unsigned char, WS_WDN_Q) + ((size_t)l * NE + e) * D * D; N = D; sc = 64.0f; }
        const int nblk = N / 64, kb = r / nblk, nb = r % nblk, k0 = 64 * kb, n = 64 * nb + F.lane;
        const float* src = W + (size_t)k0 * N + n; float x[64];
#pragma unroll
        for (int j = 0; j < 64; ++j) x[j] = __builtin_nontemporal_load(src + (size_t)j * N) * sc;
        unsigned char* dst = WQ + (size_t)n * D + k0;
#pragma unroll
        for (int q = 0; q < 4; ++q) { v4u o; o.x = cvt4_fp8(x[16 * q], x[16 * q + 1], x[16 * q + 2], x[16 * q + 3]); o.y = cvt4_fp8(x[16 * q + 4], x[16 * q + 5], x[16 * q + 6], x[16 * q + 7]);
            o.z = cvt4_fp8(x[16 * q + 8], x[16 * q + 9], x[16 * q + 10], x[16 * q + 11]); o.w = cvt4_fp8(x[16 * q + 12], x[16 * q + 13], x[16 * q + 14], x[16 * q + 15]); *(v4u*)(dst + 16 * q) = o; }
    }
#endif
    const size_t gt = (size_t)F.vcu * (NWAVES * 64) + F.tid, NT_ = (size_t)F.G * NWAVES * 64;
    cvt_rows(KIN(I_P), WSP(bf16, WS_PB), (size_t)DEPTH * T * 256 / 8, gt, NT_);
    cvt_rows(KIN(I_X), WSP(bf16, WS_XB), (size_t)T * D / 8, gt, NT_);
    for (size_t i = gt; i < (size_t)DEPTH * LORA_PER_LAYER; i += NT_) { const int l = (int)(i / LORA_PER_LAYER); int r = (int)(i % LORA_PER_LAYER); float v;
        if (r < 8192) { const int ch = r >> 5, j = r & 31; v = KIN(I_RWUP)[(size_t)l * 8192 + j * 256 + ch]; }
        else if (r < 16384) { r -= 8192; const int ch = r >> 5, j = r & 31; v = KIN(I_RAUP)[(size_t)l * 8192 + j * 256 + ch]; }
        else if (r < 32768) { r -= 16384; const int ch = r >> 6, j = r & 63; v = KIN(I_RGUP)[(size_t)l * 16384 + j * 256 + ch]; }
        else { r -= 32768; const int d = r >> 4, j = r & 15; v = KIN(I_GGUP)[(size_t)l * 2048 + j * 128 + d]; }
        WSP(float, WS_LORA)[i] = v; }
    for (size_t i = gt; i < (size_t)DEPTH * NE * D; i += NT_) { const int l = (int)(i / (NE * D)), r = (int)(i % (NE * D)), e = r / D, k = r % D; WSP(float, WS_RWT)[i] = KIN(I_RTW)[(size_t)l * D * NE + (size_t)k * NE + e]; }
}

__device__ __forceinline__ void router_pick(float (&p)[32], int lane, float rbias, int& ek, float& gk) {
#pragma unroll
    for (int i = 0; i < 16; ++i) { const bool hi = (lane & 32) != 0; const float keep = hi ? p[i + 16] : p[i], send = hi ? p[i] : p[i + 16]; p[i] = keep + __shfl_xor(send, 32); }
#pragma unroll
    for (int i = 0; i < 8; ++i) { const bool hi = (lane & 16) != 0; const float keep = hi ? p[i + 8] : p[i], send = hi ? p[i] : p[i + 8]; p[i] = keep + __shfl_xor(send, 16); }
#pragma unroll
    for (int i = 0; i < 4; ++i) { const bool hi = (lane & 8) != 0; const float keep = hi ? p[i + 4] : p[i], send = hi ? p[i] : p[i + 4]; p[i] = keep + __shfl_xor(send, 8); }
#pragma unroll
    for (int i = 0; i < 2; ++i) { const bool hi = (lane & 4) != 0; const float keep = hi ? p[i + 2] : p[i], send = hi ? p[i] : p[i + 2]; p[i] = keep + __shfl_xor(send, 4); }
    { const bool hi = (lane & 2) != 0; const float keep = hi ? p[1] : p[0], send = hi ? p[0] : p[1]; p[0] = keep + __shfl_xor(send, 2); }
    const float logit = p[0] + __shfl_xor(p[0], 1) + rbias;
    const int me = lane >> 1; int rank = 0;
#pragma unroll
    for (int e = 0; e < 32; ++e) { const float le = __builtin_bit_cast(float, __builtin_amdgcn_readlane(__builtin_bit_cast(int, logit), 2 * e)); rank += (le > logit || (le == logit && e < me)) ? 1 : 0; }
    float tv[4]; int te[4];
#pragma unroll
    for (int k = 0; k < 4; ++k) { const unsigned long long m = __ballot(rank == k); const int src = (int)__builtin_ctzll(m);
        te[k] = src >> 1; tv[k] = __builtin_bit_cast(float, __builtin_amdgcn_readlane(__builtin_bit_cast(int, logit), src)); }
    const float e1 = __expf(tv[1] - tv[0]), e2 = __expf(tv[2] - tv[0]), e3 = __expf(tv[3] - tv[0]); const float inv = 1.0f / (1.0f + e1 + e2 + e3);
    const int kk = lane & 3;
    ek = kk == 0 ? te[0] : kk == 1 ? te[1] : kk == 2 ? te[2] : te[3];
    gk = (kk == 0 ? 1.0f : kk == 1 ? e1 : kk == 2 ? e2 : e3) * inv;
}
template <bool DRY> __device__ __forceinline__ void p6_ln1_router(Frame& F, const Args& A, int layer) {
    const bf16* y1 = WSP(bf16, WS_Y1); bf16* x1b = WSP(bf16, WS_X1B);
    const float* g = KIN(I_LN1G) + layer * D; const float* bb = KIN(I_LN1B) + layer * D;
    const float* rwt = WSP(float, WS_RWT) + (size_t)layer * NE * D; const float* rb = KIN(I_RTB) + layer * NE;
    int* sdest = WSP(int, WS_SDEST); float* sgate = WSP(float, WS_SGATE);
    unsigned* cnt = (unsigned*)(F.ctl + CW_CNT + layer * NE * 16);
    LAS float* RWT = (LAS float*)F.lds;
    volatile LAS unsigned* lcnt = F.MISC + MW_LCNT; volatile LAS unsigned* lbase = F.MISC + MW_LBASE;
    for (int i = F.tid; i < NE * D / 4; i += NWAVES * 64) ((LAS f32x4*)RWT)[i] = ((const f32x4*)rwt)[i];
    const int lane = F.lane;
    const float rbias = rb[lane >> 1];
    for (int blk = F.vcu; blk < T / 64; blk += F.G) {
        if (F.tid < 32) lcnt[F.tid] = 0u;
        __syncthreads();
        int my_e = 0; float my_g = 0.f; unsigned my_r = 0u;
#pragma unroll 1
        for (int ri = 0; ri < 8; ++ri) {
            int lo_ = lane; asm volatile("" : "+v"(lo_));
            const f32x4 gv[4] = { *(const f32x4*)(g + 4 * lo_), *(const f32x4*)(g + 256 + 4 * lo_), *(const f32x4*)(g + 512 + 4 * lo_), *(const f32x4*)(g + 768 + 4 * lo_) };
            const f32x4 bv[4] = { *(const f32x4*)(bb + 4 * lo_), *(const f32x4*)(bb + 256 + 4 * lo_), *(const f32x4*)(bb + 512 + 4 * lo_), *(const f32x4*)(bb + 768 + 4 * lo_) };
            f32x4 v[4];
            { const int row = blk * 64 + F.wave * 8 + ri; const bf16* yr = y1 + (size_t)row * D; float s = 0.f;
#pragma unroll
                for (int j = 0; j < 4; ++j) { const v2u w = *(const v2u*)(yr + 256 * j + 4 * lane); v[j] = (f32x4){__uint_as_float(w.x << 16), __uint_as_float(w.x & 0xffff0000u), __uint_as_float(w.y << 16), __uint_as_float(w.y & 0xffff0000u)}; s += (v[j].x + v[j].y) + (v[j].z + v[j].w); }
                const float mean = wave_sum(s) * (1.f / D); float s2 = 0.f;
#pragma unroll
                for (int j = 0; j < 4; ++j) { v[j] = v[j] - mean; s2 += (v[j].x * v[j].x + v[j].y * v[j].y) + (v[j].z * v[j].z + v[j].w * v[j].w); }
                const float rstd = __builtin_amdgcn_rsqf(wave_sum(s2) * (1.f / D) + LN_EPS);
#pragma unroll
                for (int j = 0; j < 4; ++j) { v[j] = v[j] * rstd * gv[j] + bv[j];
                    v2u o; o.x = cvt_pk_bf16(v[j].x, v[j].y); o.y = cvt_pk_bf16(v[j].z, v[j].w); *(v2u*)(x1b + (size_t)row * D + 256 * j + 4 * lane) = o;
                    if (MOE_FP8) *(unsigned*)(WSP(unsigned char, WS_X1Q) + (size_t)row * D + 256 * j + 4 * lane) = cvt4_fp8(v[j].x, v[j].y, v[j].z, v[j].w); } }
            float p0[32];
#pragma unroll
            for (int e = 0; e < 32; ++e) { float a0 = 0.f;
#pragma unroll
                for (int j = 0; j < 4; ++j) { const f32x4 w = *(const LAS f32x4*)(RWT + e * D + 256 * j + 4 * lane); a0 += (v[j].x * w.x + v[j].y * w.y) + (v[j].z * w.z + v[j].w * w.w); }
                p0[e] = a0; }
            int ek0; float gk0;
            router_pick(p0, lane, rbias, ek0, gk0);
            if ((lane >> 2) == ri) { my_e = ek0; my_g = gk0; my_r = DRY ? 0u : atomicAdd((unsigned*)&lcnt[ek0], 1u); }
        }
        __syncthreads();
        if (!DRY && F.tid < 32) { const unsigned n = lcnt[F.tid]; lbase[F.tid] = n ? __hip_atomic_fetch_add(cnt + F.tid * 16, n, RLX_AGENT) : 0u; }
        __syncthreads();
        if (!DRY && lane < 32) { const int row = blk * 64 + F.wave * 8 + (lane >> 2); const unsigned slot = (unsigned)my_e * ECAP + lbase[my_e] + my_r;
            sdest[slot] = row * 4 + (lane & 3); sgate[slot] = my_g; }
        __syncthreads();
    }
}
__device__ __forceinline__ void p9_combine(Frame& F, const Args& A) {
    const bf16* x1b = WSP(bf16, WS_X1B); const bf16* yb = WSP(bf16, WS_YBUF); bf16* hb = WSP(bf16, WS_HB);
    const int gw = F.vcu * NWAVES + F.wave, NGW = F.G * NWAVES, lane = F.lane;
    for (int row = gw; row < T; row += NGW) {
        v4u y[4][2], xw[2];
#pragma unroll
        for (int j = 0; j < 2; ++j) {
#pragma unroll
            for (int k = 0; k < 4; ++k) y[k][j] = *(const v4u*)(yb + ((size_t)row * 4 + k) * D + 512 * j + 8 * lane);
            xw[j] = *(const v4u*)(x1b + (size_t)row * D + 512 * j + 8 * lane); }
#pragma unroll
        for (int j = 0; j < 2; ++j) { f32x4 v0, v1; pg8::unpack8(xw[j], v0, v1); v0 = v0 * DN_ALPHA; v1 = v1 * DN_ALPHA;
#pragma unroll
            for (int k = 0; k < 4; ++k) { f32x4 a, b; pg8::unpack8(y[k][j], a, b); v0 = v0 + a; v1 = v1 + b; }
            v4u wv; wv.x = cvt_pk_bf16(v0.x, v0.y); wv.y = cvt_pk_bf16(v0.z, v0.w); wv.z = cvt_pk_bf16(v1.x, v1.y); wv.w = cvt_pk_bf16(v1.z, v1.w); *(v4u*)(hb + (size_t)row * D + 512 * j + 8 * lane) = wv; }
    }
}
__device__ __forceinline__ void p11_ln2(Frame& F, const Args& A, int layer) {
    const bf16* h2 = WSP(bf16, WS_H2); bf16* xb = WSP(bf16, WS_XB);
    const float* g = KIN(I_LN2G) + layer * D; const float* bb = KIN(I_LN2B) + layer * D;
    const int gw = F.vcu * NWAVES + F.wave, NGW = F.G * NWAVES, lane = F.lane;
    for (int row = gw; row < T; row += NGW) {
        const bf16* yr = h2 + (size_t)row * D; f32x4 v[4]; float s = 0.f;
#pragma unroll
        for (int j = 0; j < 4; ++j) { const v2u w = *(const v2u*)(yr + 256 * j + 4 * lane); v[j] = (f32x4){__uint_as_float(w.x << 16), __uint_as_float(w.x & 0xffff0000u), __uint_as_float(w.y << 16), __uint_as_float(w.y & 0xffff0000u)}; s += (v[j].x + v[j].y) + (v[j].z + v[j].w); }
        const float mean = wave_sum(s) * (1.f / D); float s2 = 0.f;
#pragma unroll
        for (int j = 0; j < 4; ++j) { v[j] = v[j] - mean; s2 += (v[j].x * v[j].x + v[j].y * v[j].y) + (v[j].z * v[j].z + v[j].w * v[j].w); }
        const float rstd = __builtin_amdgcn_rsqf(wave_sum(s2) * (1.f / D) + LN_EPS);
#pragma unroll
        for (int j = 0; j < 4; ++j) { const f32x4 gv = *(const f32x4*)(g + 256 * j + 4 * lane), bv = *(const f32x4*)(bb + 256 * j + 4 * lane);
            const f32x4 o = v[j] * rstd * gv + bv; const size_t off = (size_t)row * D + 256 * j + 4 * lane;
            if (layer == DEPTH - 1) *(f32x4*)(F.out + off) = o; v2u w; w.x = cvt_pk_bf16(o.x, o.y); w.y = cvt_pk_bf16(o.z, o.w); *(v2u*)(xb + off) = w; }
    }
}
__device__ __forceinline__ void moe_build_pfx(Frame& F, const Args& A, int layer, int NT) {
    volatile LAS unsigned* pfx = F.MISC + MW_PFX;
    __syncthreads();
    if (F.tid < 64) {
        const int e = F.tid & 31;
        const unsigned c = __hip_atomic_load(F.ctl + CW_CNT + (layer * NE + e) * 16, RLX_AGENT);
        const unsigned un = ((c + 255u) >> 8) * (unsigned)NT; unsigned inc = un;
#pragma unroll
        for (int o = 1; o < 32; o <<= 1) { const unsigned t = (unsigned)my_shfl_up((int)inc, o); if (e >= o) inc += t; }
        if (F.tid < 32) { pfx[e] = inc - un; pfx[40 + e] = c; if (e == 31) pfx[32] = inc; }
    }
    __syncthreads();
}
#define UU(t, col) bf2f(u[(size_t)(t) * NUP + (col)])
#define UU4(t, col) ldu4(u + (size_t)(t) * NUP + (col))
__device__ __forceinline__ f32x4 ldu4(const bf16* p) { const v2u w = *(const v2u*)p; return (f32x4){__uint_as_float(w.x << 16), __uint_as_float(w.x & 0xffff0000u), __uint_as_float(w.y << 16), __uint_as_float(w.y & 0xffff0000u)}; }
__device__ __forceinline__ f32x4 ldb4(const bf16* p) { const v2u w = *(const v2u*)p; return (f32x4){__uint_as_float(w.x << 16), __uint_as_float(w.x & 0xffff0000u), __uint_as_float(w.y << 16), __uint_as_float(w.y & 0xffff0000u)}; }
__device__ __forceinline__ void stb4(bf16* p, f32x4 v) { v2u o; o.x = cvt_pk_bf16(v.x, v.y); o.y = cvt_pk_bf16(v.z, v.w); *(v2u*)p = o; }
__device__ __forceinline__ void lds_st_bf16(LAS unsigned char* p, float v) { *(LAS unsigned short*)p = (unsigned short)(cvt_pk_bf16(v, 0.f) & 0xffffu); }
__device__ __forceinline__ void lds_st_bf16x4(LAS unsigned char* p, float a, float b, float c, float d) { v2u o; o.x = cvt_pk_bf16(a, b); o.y = cvt_pk_bf16(c, d); *(LAS v2u*)p = o; }

__device__ __forceinline__ void ssd_stage1(Frame& F, const Args& A, int layer, int b, int c) {
    const bf16* u = WSP(bf16, WS_U);
    LAS unsigned char* L = F.lds;
    LAS float* DT = (LAS float*)L; LAS float* AC = DT + 256;
    LAS unsigned char* BMT = L + 2048; LAS unsigned char* XCDT = BMT + 128 * 144;
    const int t0 = b * SEQ + c * 64, tid = F.tid, lane = F.lane, wave = F.wave;
    if (wave < 4) {
        const int hh = wave;
        const float dt = softplusf_(UU(t0 + lane, U_SSD_DT + hh) + KIN(I_SDTB)[layer * 4 + hh]);
        const float adt = -dt * __expf(KIN(I_SALOG)[layer * 4 + hh]);
        const float ac = wave_scan_add(adt, lane);
        DT[hh * 64 + lane] = dt; AC[hh * 64 + lane] = ac;
        if (lane == 63) WSP(float, WS_SSD_DEC)[(b * 4 + hh) * NCH + c] = __expf(ac);
    }
    __syncthreads();
    if (tid < 384) {
        const int cc = tid; const float* cw = KIN(I_SCW) + (size_t)layer * 2048 + cc; const float w0 = cw[0], w1 = cw[512], w2 = cw[1024], w3 = cw[1536], cb = KIN(I_SCB)[layer * 512 + cc];
        const bf16* up = u + (size_t)t0 * NUP + U_SSD_X + cc;
        float win0 = 0.f, win1 = 0.f, win2 = 0.f;
        if (c > 0) { win0 = bf2f(up[-3 * NUP]); win1 = bf2f(up[-2 * NUP]); win2 = bf2f(up[-1 * NUP]); }
        const int hh = (cc >> 6) & 3; const bool isx = cc < 256;
        LAS unsigned char* dst = isx ? XCDT + cc * 144 : BMT + (cc - 256) * 144;
        const float aclast = AC[hh * 64 + 63];
#pragma unroll 1
        for (int l0 = 0; l0 < 64; l0 += 32) {
            float xv[32];
#pragma unroll
            for (int j = 0; j < 32; ++j) xv[j] = bf2f(up[(l0 + j) * NUP]);
#pragma unroll
            for (int j8 = 0; j8 < 4; ++j8) { float o[8];
#pragma unroll
                for (int j = 0; j < 8; ++j) { const int l = l0 + j8 * 8 + j; const float x = xv[j8 * 8 + j]; const float y = cb + w0 * win0 + w1 * win1 + w2 * win2 + w3 * x; win0 = win1; win1 = win2; win2 = x;
                    float s = siluf_(y); if (isx) s *= DT[hh * 64 + l] * __expf(aclast - AC[hh * 64 + l]); o[j] = s; }
                *(LAS v4u*)(dst + (l0 + j8 * 8) * 2) = pack8(o); }
        }
    }
    __syncthreads();
    { const int fr = lane & 15, fq = lane >> 4; bf16* st = WSP(bf16, WS_SSD_ST);
#pragma unroll 1
      for (int i = 0; i < 2; ++i) { const int row0 = (2 * wave + i) * 16; const int hh = row0 >> 6, p = (row0 & 63) + fr;
          bf16* dstp = st + (((size_t)(b * 4 + hh) * NCH + c) * 64 + p) * 128;
#pragma unroll 1
          for (int ntl = 0; ntl < 8; ++ntl) { f32x4 acc = {0.f, 0.f, 0.f, 0.f}; acc = mm16(XCDT + row0 * 144, 144, BMT + ntl * 16 * 144, 144, 64, acc, fr, fq);
              stb4(dstp + ntl * 16 + 4 * fq, acc); } } }
    __syncthreads();
}
__device__ __forceinline__ void ssd_stage3(Frame& F, const Args& A, int layer, int b, int c) {
    const bf16* u = WSP(bf16, WS_U);
    LAS unsigned char* L = F.lds;
    LAS float* DT = (LAS float*)L; LAS float* AC = DT + 256;
    LAS unsigned char* CM = L + 2048; LAS unsigned char* BM = CM + 64 * 272; LAS unsigned char* XCT = BM + 64 * 272; LAS unsigned char* MM = XCT + 256 * 144;
    LAS unsigned char* YG = XCT;
    const int t0 = b * SEQ + c * 64, tid = F.tid, lane = F.lane, wave = F.wave, fr = lane & 15, fq = lane >> 4;
    if (wave < 4) {
        const int hh = wave;
        const float dt = softplusf_(UU(t0 + lane, U_SSD_DT + hh) + KIN(I_SDTB)[layer * 4 + hh]);
        const float adt = -dt * __expf(KIN(I_SALOG)[layer * 4 + hh]);
        DT[hh * 64 + lane] = dt; AC[hh * 64 + lane] = wave_scan_add(adt, lane);
    }
    __syncthreads();
    {
        const int cc = tid; const float* cw = KIN(I_SCW) + (size_t)layer * 2048 + cc; const float w0 = cw[0], w1 = cw[512], w2 = cw[1024], w3 = cw[1536], cb = KIN(I_SCB)[layer * 512 + cc];
        const bf16* up = u + (size_t)t0 * NUP + U_SSD_X + cc;
        float win0 = 0.f, win1 = 0.f, win2 = 0.f;
        if (c > 0) { win0 = bf2f(up[-3 * NUP]); win1 = bf2f(up[-2 * NUP]); win2 = bf2f(up[-1 * NUP]); }
        const int hh = (cc >> 6) & 3;
#pragma unroll 1
        for (int l0 = 0; l0 < 64; l0 += 32) {
            float xv[32];
#pragma unroll
            for (int j = 0; j < 32; ++j) xv[j] = bf2f(up[(l0 + j) * NUP]);
#pragma unroll
            for (int j8 = 0; j8 < 4; ++j8) { float o[8];
#pragma unroll
                for (int j = 0; j < 8; ++j) { const int l = l0 + j8 * 8 + j; const float x = xv[j8 * 8 + j]; const float y = cb + w0 * win0 + w1 * win1 + w2 * win2 + w3 * x; win0 = win1; win1 = win2; win2 = x;
                    float s = siluf_(y); if (cc < 256) s *= DT[hh * 64 + l]; o[j] = s; }
                if (cc < 256) *(LAS v4u*)(XCT + cc * 144 + (l0 + j8 * 8) * 2) = pack8(o);
                else { LAS unsigned char* d2 = (cc < 384 ? BM + (cc - 256) * 2 : CM + (cc - 384) * 2) + (l0 + j8 * 8) * 272;
#pragma unroll
                    for (int j = 0; j < 8; ++j) lds_st_bf16(d2 + j * 272, o[j]); } }
        }
    }
    __syncthreads();
#pragma unroll 1
    for (int i = 0; i < 2; ++i) { const int idx = 2 * wave + i, lt = idx >> 2, st = idx & 3;
        f32x4 acc = {0.f, 0.f, 0.f, 0.f}; acc = mm16(CM + lt * 16 * 272, 272, BM + st * 16 * 272, 272, 128, acc, fr, fq);
        const int l = lt * 16 + fr, s0 = st * 16 + 4 * fq;
#pragma unroll
        for (int hh = 0; hh < 4; ++hh) { const float al = AC[hh * 64 + l], dl = KIN(I_SD)[layer * 4 + hh] / DT[hh * 64 + l]; float o[4];
#pragma unroll
            for (int j = 0; j < 4; ++j) { const int s = s0 + j; float m = (l >= s) ? acc[j] * __expf(al - AC[hh * 64 + s]) : 0.f; if (l == s) m += dl; o[j] = m; }
            lds_st_bf16x4(MM + hh * 9216 + l * 144 + s0 * 2, o[0], o[1], o[2], o[3]); } }
    __syncthreads();
    f32x4 yv[2][4];
    { const int hh = wave >> 1; const bf16* prev = WSP(bf16, WS_SSD_ST) + ((size_t)(b * 4 + hh) * NCH + c) * 8192;
      bf16x8 pf[4][4];
#pragma unroll
      for (int pt = 0; pt < 4; ++pt)
#pragma unroll
          for (int ks = 0; ks < 4; ++ks) pf[pt][ks] = *(const bf16x8*)(prev + (size_t)(pt * 16 + fr) * 128 + ks * 32 + fq * 8);
#pragma unroll
      for (int i = 0; i < 2; ++i) { const int lt = 2 * (wave & 1) + i, l = lt * 16 + fr; const float ea = __expf(AC[hh * 64 + l]);
#pragma unroll
          for (int pt = 0; pt < 4; ++pt) { f32x4 ad = {0.f, 0.f, 0.f, 0.f}, ao = {0.f, 0.f, 0.f, 0.f};
              ad = mm16(MM + hh * 9216 + lt * 16 * 144, 144, XCT + (hh * 64 + pt * 16) * 144, 144, 64, ad, fr, fq);
              ao = mm16_rB<4>(CM + lt * 16 * 272, 272, pf[pt], ao, fr, fq);
              const f32x4 z = UU4(t0 + l, U_SSD_Z + hh * 64 + pt * 16 + 4 * fq);
              f32x4 y = ad + ao * ea; y.x *= siluf_(z.x); y.y *= siluf_(z.y); y.z *= siluf_(z.z); y.w *= siluf_(z.w); yv[i][pt] = y; } } }
    __syncthreads();
    { const int hh = wave >> 1;
#pragma unroll
      for (int i = 0; i < 2; ++i) { const int l = (2 * (wave & 1) + i) * 16 + fr;
#pragma unroll
          for (int pt = 0; pt < 4; ++pt) *(LAS f32x4*)(YG + l * 1040 + (hh * 64 + pt * 16 + 4 * fq) * 4) = yv[i][pt]; } }
    __syncthreads();
    { const f32x4 g = *(const f32x4*)(KIN(I_SNG) + layer * 256 + 4 * lane); bf16* mix = WSP(bf16, WS_MIX);
#pragma unroll 1
      for (int i = 0; i < 8; ++i) { const int l = wave * 8 + i; const f32x4 y = *(const LAS f32x4*)(YG + l * 1040 + lane * 16);
          const float ss = wave_sum((y.x * y.x + y.y * y.y) + (y.z * y.z + y.w * y.w)); const float r = __builtin_amdgcn_rsqf(ss * (1.f / 256.f) + NORM_EPS);
          v2u o; o.x = cvt_pk_bf16(y.x * r * g.x, y.y * r * g.y); o.y = cvt_pk_bf16(y.z * r * g.z, y.w * r * g.w);
          *(v2u*)(mix + (size_t)(t0 + l) * D + 4 * lane) = o; } }
    __syncthreads();
}

__device__ __forceinline__ void gla_bcum_all(Frame& F, const Args& A, int layer, const LAS float* GD, LAS float* BC) {
    const int d = F.tid & 127, lq = F.tid >> 7;
    float gup[16];
    { const f32x4* gp4 = (const f32x4*)(WSP(float, WS_LORA) + (size_t)layer * LORA_PER_LAYER + 32768 + d * 16);
#pragma unroll
      for (int i = 0; i < 4; ++i) { const f32x4 a = gp4[i]; gup[4 * i] = a.x; gup[4 * i + 1] = a.y; gup[4 * i + 2] = a.z; gup[4 * i + 3] = a.w; } }
    const float gb = KIN(I_GGB)[layer * 128 + d];
#pragma unroll 4
    for (int li = 0; li < 16; ++li) { const int l = lq * 16 + li; float x = gb;
#pragma unroll
        for (int i = 0; i < 4; ++i) { const f32x4 g4 = *(const LAS f32x4*)(GD + l * 16 + 4 * i); x += (g4.x * gup[4 * i] + g4.y * gup[4 * i + 1]) + (g4.z * gup[4 * i + 2] + g4.w * gup[4 * i + 3]); }
        BC[l * 128 + d] = logsigmoidf_(x) * 0.0625f; }
    __syncthreads();
    if (F.tid < 128) { float run = 0.f;
#pragma unroll 1
        for (int l0 = 0; l0 < 64; l0 += 16) { float v[16];
#pragma unroll
            for (int j = 0; j < 16; ++j) v[j] = BC[(l0 + j) * 128 + d];
#pragma unroll
            for (int j = 0; j < 16; ++j) { run += v[j]; BC[(l0 + j) * 128 + d] = run; } } }
}
__device__ __forceinline__ void gla_stage1(Frame& F, const Args& A, int layer, int b, int c) {
    const bf16* u = WSP(bf16, WS_U);
    LAS unsigned char* L = F.lds;
    LAS float* GD = (LAS float*)L; LAS float* BC = (LAS float*)(L + 4096);
    LAS unsigned char* KDT = L + 36864; LAS unsigned char* VT = KDT + 128 * 144;
    const int t0 = b * SEQ + c * 64, tid = F.tid, lane = F.lane, wave = F.wave, fr = lane & 15, fq = lane >> 4;
    if (tid < 256) { const int l = tid >> 2, q4 = tid & 3; *(LAS f32x4*)(GD + l * 16 + q4 * 4) = UU4(t0 + l, U_GL_G + 4 * q4); }
    __syncthreads();
    gla_bcum_all(F, A, layer, GD, BC);
    if (tid < 128) {
        const int d = tid; const float blast = BC[63 * 128 + d];
        WSP(float, WS_GLA_DEC)[(size_t)(b * NCH + c) * 128 + d] = __expf(blast);
        const bf16* up = u + (size_t)t0 * NUP + U_GL_K + d;
#pragma unroll 1
        for (int l0 = 0; l0 < 64; l0 += 32) { float xv[32];
#pragma unroll
            for (int j = 0; j < 32; ++j) xv[j] = bf2f(up[(l0 + j) * NUP]);
#pragma unroll
            for (int j8 = 0; j8 < 4; ++j8) { float o[8];
#pragma unroll
                for (int j = 0; j < 8; ++j) { const int l = l0 + j8 * 8 + j; o[j] = xv[j8 * 8 + j] * __expf(blast - BC[l * 128 + d]); }
                *(LAS v4u*)(KDT + d * 144 + (l0 + j8 * 8) * 2) = pack8(o); } }
    } else if (tid < 384) {
        const int vch = tid - 128; const bf16* up = u + (size_t)t0 * NUP + U_GL_V + vch;
#pragma unroll 1
        for (int l0 = 0; l0 < 64; l0 += 32) { float xv[32];
#pragma unroll
            for (int j = 0; j < 32; ++j) xv[j] = bf2f(up[(l0 + j) * NUP]);
#pragma unroll
            for (int j8 = 0; j8 < 4; ++j8) { float o[8];
#pragma unroll
                for (int j = 0; j < 8; ++j) o[j] = xv[j8 * 8 + j];
                *(LAS v4u*)(VT + vch * 144 + (l0 + j8 * 8) * 2) = pack8(o); } }
    }
    __syncthreads();
    { bf16* st = WSP(bf16, WS_GLA_ST);
#pragma unroll 1
      for (int i = 0; i < 4; ++i) { const int idx = 4 * wave + i, hh = idx >> 3, dtl = (idx >> 2) & 1, vt = idx & 3;
          f32x4 acc = {0.f, 0.f, 0.f, 0.f}; acc = mm16(KDT + (hh * 32 + dtl * 16) * 144, 144, VT + (hh * 64 + vt * 16) * 144, 144, 64, acc, fr, fq);
          stb4(st + (((size_t)(b * 4 + hh) * NCH + c) * 32 + dtl * 16 + fr) * 64 + vt * 16 + 4 * fq, acc); } }
    __syncthreads();
}
__device__ __forceinline__ void gla_stage3(Frame& F, const Args& A, int layer, int b, int c) {
    const bf16* u = WSP(bf16, WS_U);
    LAS unsigned char* L = F.lds;
    LAS float* GD = (LAS float*)L; LAS float* BC = (LAS float*)(L + 4096); LAS unsigned char* ATT = L + 4096;
    LAS unsigned char* QD = L + 40960; LAS unsigned char* KI = QD + 64 * 272; LAS unsigned char* VT = KI + 64 * 272; LAS unsigned char* PVT = VT + 256 * 144;
    const int t0 = b * SEQ + c * 64, tid = F.tid, lane = F.lane, wave = F.wave, fr = lane & 15, fq = lane >> 4;
    if (tid < 256) { const int l = tid >> 2, q4 = tid & 3; *(LAS f32x4*)(GD + l * 16 + q4 * 4) = UU4(t0 + l, U_GL_G + 4 * q4); }
    __syncthreads();
    gla_bcum_all(F, A, layer, GD, BC);
    if (tid < 128) {
        const int d = tid;
        const bf16* uq = u + (size_t)t0 * NUP + U_GL_Q + d; const bf16* uk = u + (size_t)t0 * NUP + U_GL_K + d;
#pragma unroll 1
        for (int l0 = 0; l0 < 64; l0 += 16) { float qv[16], kv[16];
#pragma unroll
            for (int j = 0; j < 16; ++j) { qv[j] = bf2f(uq[(l0 + j) * NUP]); kv[j] = bf2f(uk[(l0 + j) * NUP]); }
#pragma unroll
            for (int j = 0; j < 16; ++j) { const int l = l0 + j; const float bc = BC[l * 128 + d];
                lds_st_bf16(QD + l * 272 + d * 2, qv[j] * 0.17677669529663687f * __expf(bc)); lds_st_bf16(KI + l * 272 + d * 2, kv[j] * __expf(-bc)); } }
    } else if (tid < 384) {
        const int vch = tid - 128; const bf16* up = u + (size_t)t0 * NUP + U_GL_V + vch;
#pragma unroll 1
        for (int l0 = 0; l0 < 64; l0 += 32) { float xv[32];
#pragma unroll
            for (int j = 0; j < 32; ++j) xv[j] = bf2f(up[(l0 + j) * NUP]);
#pragma unroll
            for (int j8 = 0; j8 < 4; ++j8) { float o[8];
#pragma unroll
                for (int j = 0; j < 8; ++j) o[j] = xv[j8 * 8 + j];
                *(LAS v4u*)(VT + vch * 144 + (l0 + j8 * 8) * 2) = pack8(o); } }
    } else {
        const bf16* prev = WSP(bf16, WS_GLA_ST);
#pragma unroll 4
        for (int i = tid - 384; i < 8192; i += 128) { const int hh = i >> 11, dd = (i >> 6) & 31, vv = i & 63;
            *(LAS unsigned short*)(PVT + (hh * 64 + vv) * 80 + dd * 2) = prev[((size_t)(b * 4 + hh) * NCH + c) * 2048 + dd * 64 + vv]; }
    }
    __syncthreads();
    const int hh = wave >> 1;
#pragma unroll 1
    for (int i = 0; i < 2; ++i) { const int tt = 2 * (wave & 1) + i, t = tt * 16 + fr;
#pragma unroll
        for (int st = 0; st < 4; ++st) { f32x4 acc = {0.f, 0.f, 0.f, 0.f}; acc = mm16(QD + tt * 16 * 272 + hh * 64, 272, KI + st * 16 * 272 + hh * 64, 272, 32, acc, fr, fq);
            const int s0 = st * 16 + 4 * fq;
            lds_st_bf16x4(ATT + hh * 9216 + t * 144 + s0 * 2, t >= s0 ? acc[0] : 0.f, t >= s0 + 1 ? acc[1] : 0.f, t >= s0 + 2 ? acc[2] : 0.f, t >= s0 + 3 ? acc[3] : 0.f); } }
    __syncthreads();
    { bf16* mix = WSP(bf16, WS_MIX); const float* ng = KIN(I_GNG) + layer * 256;
#pragma unroll 1
      for (int i = 0; i < 2; ++i) { const int tt = 2 * (wave & 1) + i, t = tt * 16 + fr; f32x4 ov[4]; float ss = 0.f;
#pragma unroll
          for (int vt = 0; vt < 4; ++vt) { f32x4 acc = {0.f, 0.f, 0.f, 0.f};
              acc = mm16(ATT + hh * 9216 + tt * 16 * 144, 144, VT + (hh * 64 + vt * 16) * 144, 144, 64, acc, fr, fq);
              acc = mm16(QD + tt * 16 * 272 + hh * 64, 272, PVT + (hh * 64 + vt * 16) * 80, 80, 32, acc, fr, fq);
              ov[vt] = acc; ss += (acc.x * acc.x + acc.y * acc.y) + (acc.z * acc.z + acc.w * acc.w); }
          ss += __shfl_xor(ss, 16); ss += __shfl_xor(ss, 32);
          const float r = __builtin_amdgcn_rsqf(ss * (1.f / 64.f) + NORM_EPS);
#pragma unroll
          for (int vt = 0; vt < 4; ++vt) { const int col = hh * 64 + vt * 16 + 4 * fq; const f32x4 g = *(const f32x4*)(ng + col); const f32x4 og = UU4(t0 + t, U_GL_OG + col);
              v2u o; o.x = cvt_pk_bf16(ov[vt].x * r * g.x * siluf_(og.x), ov[vt].y * r * g.y * siluf_(og.y)); o.y = cvt_pk_bf16(ov[vt].z * r * g.z * siluf_(og.z), ov[vt].w * r * g.w * siluf_(og.w));
              *(v2u*)(mix + (size_t)(t0 + t) * D + 512 + col) = o; } } }
    __syncthreads();
}

__device__ __forceinline__ void mlstm_stage1(Frame& F, const Args& A, int layer, int b, int c) {
    const bf16* u = WSP(bf16, WS_U);
    LAS unsigned char* L = F.lds;
    LAS float* WST = (LAS float*)L; LAS unsigned char* KT = L + 1024; LAS unsigned char* VWT = KT + 256 * 144;
    const int t0 = b * SEQ + c * 64, tid = F.tid, lane = F.lane, wave = F.wave, fr = lane & 15, fq = lane >> 4;
    if (wave < 4) {
        const int hh = wave;
        const float ig = UU(t0 + lane, U_ML_I + hh) + KIN(I_MIB)[layer * 4 + hh];
        const float lf = logsigmoidf_(UU(t0 + lane, U_ML_F + hh) + KIN(I_MFB)[layer * 4 + hh]);
        const float bc = wave_scan_add(lf, lane); const float blast = __shfl(bc, 63);
        const float ast = blast - bc + ig; const float mloc = wave_max(ast);
        WST[hh * 64 + lane] = __expf(ast - mloc);
        if (lane == 0) { WSP(float, WS_ML_BL)[(b * 4 + hh) * NCH + c] = blast; WSP(float, WS_ML_ML)[(b * 4 + hh) * NCH + c] = mloc; }
    } else {
        const int kch = tid - 256, cc = 256 + kch; const float* cw = KIN(I_MCW) + (size_t)layer * 2048 + cc; const float w0 = cw[0], w1 = cw[512], w2 = cw[1024], w3 = cw[1536], cb = KIN(I_MCB)[layer * 512 + cc];
        const bf16* up = u + (size_t)t0 * NUP + U_ML_K + kch;
        float win0 = 0.f, win1 = 0.f, win2 = 0.f;
        if (c > 0) { win0 = bf2f(up[-3 * NUP]); win1 = bf2f(up[-2 * NUP]); win2 = bf2f(up[-1 * NUP]); }
#pragma unroll 1
        for (int l0 = 0; l0 < 64; l0 += 32) { float xv[32];
#pragma unroll
            for (int j = 0; j < 32; ++j) xv[j] = bf2f(up[(l0 + j) * NUP]);
#pragma unroll
            for (int j8 = 0; j8 < 4; ++j8) { float o[8];
#pragma unroll
                for (int j = 0; j < 8; ++j) { const float x = xv[j8 * 8 + j]; const float y = cb + w0 * win0 + w1 * win1 + w2 * win2 + w3 * x; win0 = win1; win1 = win2; win2 = x; o[j] = siluf_(y); }
                *(LAS v4u*)(KT + kch * 144 + (l0 + j8 * 8) * 2) = pack8(o); } }
    }
    __syncthreads();
    if (tid < 256) {
        const int vch = tid, hh = vch >> 6; const bf16* up = u + (size_t)t0 * NUP + U_ML_V + vch;
#pragma unroll 1
        for (int l0 = 0; l0 < 64; l0 += 32) { float xv[32];
#pragma unroll
            for (int j = 0; j < 32; ++j) xv[j] = bf2f(up[(l0 + j) * NUP]);
#pragma unroll
            for (int j8 = 0; j8 < 4; ++j8) { float o[8];
#pragma unroll
                for (int j = 0; j < 8; ++j) o[j] = xv[j8 * 8 + j] * WST[hh * 64 + l0 + j8 * 8 + j];
                *(LAS v4u*)(VWT + vch * 144 + (l0 + j8 * 8) * 2) = pack8(o); } }
    } else {
        const int kch = tid - 256, hh = kch >> 6; float n = 0.f;
#pragma unroll 8
        for (int s = 0; s < 64; ++s) n += WST[hh * 64 + s] * bf2f(*(const LAS unsigned short*)(KT + kch * 144 + s * 2));
        WSP(bf16, WS_ML_N)[((size_t)(b * 4 + hh) * NCH + c) * 64 + (kch & 63)] = (bf16)(cvt_pk_bf16(n, 0.f) & 0xffffu);
    }
    __syncthreads();
    { bf16* cst = WSP(bf16, WS_ML_C); const int hh = wave >> 1;
#pragma unroll 1
      for (int i = 0; i < 2; ++i) { const int vt = 2 * (wave & 1) + i;
#pragma unroll 1
          for (int kt = 0; kt < 4; ++kt) { f32x4 acc = {0.f, 0.f, 0.f, 0.f}; acc = mm16(VWT + (hh * 64 + vt * 16) * 144, 144, KT + (hh * 64 + kt * 16) * 144, 144, 64, acc, fr, fq);
              stb4(cst + (((size_t)(b * 4 + hh) * NCH + c) * 64 + vt * 16 + fr) * 64 + kt * 16 + 4 * fq, acc); } } }
    __syncthreads();
}
__device__ __forceinline__ void mlstm_stage3(Frame& F, const Args& A, int layer, int b, int c) {
    const bf16* u = WSP(bf16, WS_U);
    LAS unsigned char* L = F.lds;
    LAS float* BCU = (LAS float*)L; LAS float* GG = BCU + 256; LAS float* MROW = BCU + 512; LAS float* WINT = BCU + 768; LAS float* NPV = BCU + 1024;
    LAS unsigned char* Q = L + 6144; LAS unsigned char* KK = Q + 64 * 528; LAS unsigned char* VT = KK + 64 * 528; LAS unsigned char* SC = VT + 256 * 144;
    const int t0 = b * SEQ + c * 64, tid = F.tid, lane = F.lane, wave = F.wave, fr = lane & 15, fq = lane >> 4;
    if (wave < 4) {
        const int hh = wave;
        const float ig = UU(t0 + lane, U_ML_I + hh) + KIN(I_MIB)[layer * 4 + hh];
        const float lf = logsigmoidf_(UU(t0 + lane, U_ML_F + hh) + KIN(I_MFB)[layer * 4 + hh]);
        const float bc = wave_scan_add(lf, lane); const float gg = ig - bc;
        const float mprev = WSP(float, WS_ML_M)[(b * 4 + hh) * NCH + c];
        const float minter = bc + mprev, mintra = bc + wave_scan_max(gg, lane), mrow = fmaxf(minter, mintra);
        BCU[hh * 64 + lane] = bc; GG[hh * 64 + lane] = gg; MROW[hh * 64 + lane] = mrow; WINT[hh * 64 + lane] = __expf(minter - mrow);
        NPV[hh * 64 + lane] = bf2f(WSP(bf16, WS_ML_N)[((size_t)(b * 4 + hh) * NCH + c) * 64 + lane]);
    }
    {
        const int cc = tid; const float* cw = KIN(I_MCW) + (size_t)layer * 2048 + cc; const float w0 = cw[0], w1 = cw[512], w2 = cw[1024], w3 = cw[1536], cb = KIN(I_MCB)[layer * 512 + cc];
        const bf16* up = u + (size_t)t0 * NUP + U_ML_Q + cc;
        float win0 = 0.f, win1 = 0.f, win2 = 0.f;
        if (c > 0) { win0 = bf2f(up[-3 * NUP]); win1 = bf2f(up[-2 * NUP]); win2 = bf2f(up[-1 * NUP]); }
        LAS unsigned char* dst = cc < 256 ? Q + cc * 2 : KK + (cc - 256) * 2; const float sc = cc < 256 ? 0.125f : 1.0f;
#pragma unroll 1
        for (int l0 = 0; l0 < 64; l0 += 32) { float xv[32];
#pragma unroll
            for (int j = 0; j < 32; ++j) xv[j] = bf2f(up[(l0 + j) * NUP]);
#pragma unroll
            for (int j = 0; j < 32; ++j) { const float x = xv[j]; const float y = cb + w0 * win0 + w1 * win1 + w2 * win2 + w3 * x; win0 = win1; win1 = win2; win2 = x; lds_st_bf16(dst + (l0 + j) * 528, siluf_(y) * sc); } }
        const int vch = tid & 255, lh = (tid >> 8) * 32; const bf16* uv = u + (size_t)(t0 + lh) * NUP + U_ML_V + vch;
        float xv[32];
#pragma unroll
        for (int j = 0; j < 32; ++j) xv[j] = bf2f(uv[j * NUP]);
#pragma unroll
        for (int j8 = 0; j8 < 4; ++j8) { float o[8];
#pragma unroll
            for (int j = 0; j < 8; ++j) o[j] = xv[j8 * 8 + j];
            *(LAS v4u*)(VT + vch * 144 + (lh + j8 * 8) * 2) = pack8(o); }
    }
    __syncthreads();
    { const int hh = wave >> 1; bf16* mix = WSP(bf16, WS_MIX); const float* ng = KIN(I_MNG) + layer * 256;
      const bf16* cprev = WSP(bf16, WS_ML_C) + ((size_t)(b * 4 + hh) * NCH + c) * 4096;
      bf16x8 cf[4][2];
#pragma unroll
      for (int vt = 0; vt < 4; ++vt)
#pragma unroll
          for (int ks = 0; ks < 2; ++ks) cf[vt][ks] = *(const bf16x8*)(cprev + (size_t)(vt * 16 + fr) * 64 + ks * 32 + fq * 8);
#pragma unroll 1
      for (int i = 0; i < 2; ++i) { const int tt = 2 * (wave & 1) + i, t = tt * 16 + fr;
          const float bt = BCU[hh * 64 + t] - MROW[hh * 64 + t]; float rs = 0.f;
#pragma unroll
          for (int st = 0; st < 4; ++st) { f32x4 acc = {0.f, 0.f, 0.f, 0.f}; acc = mm16(Q + tt * 16 * 528 + hh * 128, 528, KK + st * 16 * 528 + hh * 128, 528, 64, acc, fr, fq);
              const int s0 = st * 16 + 4 * fq; float o[4];
#pragma unroll
              for (int j = 0; j < 4; ++j) { const int s = s0 + j; const float v = (t >= s) ? acc[j] * __expf(bt + GG[hh * 64 + s]) : 0.f; o[j] = v; rs += v; }
              lds_st_bf16x4(SC + hh * 9216 + t * 144 + s0 * 2, o[0], o[1], o[2], o[3]); }
          rs += __shfl_xor(rs, 16); rs += __shfl_xor(rs, 32);
          float nq = 0.f;
#pragma unroll
          for (int j = 0; j < 16; ++j) nq += bf2f(*(const LAS unsigned short*)(Q + t * 528 + (hh * 64 + fq * 16 + j) * 2)) * NPV[hh * 64 + fq * 16 + j];
          nq += __shfl_xor(nq, 16); nq += __shfl_xor(nq, 32);
          const float wi = WINT[hh * 64 + t]; const float den = wi * nq + rs; const float dn = fmaxf(fabsf(den), __expf(-MROW[hh * 64 + t])); const float rdn = 1.0f / dn;
          LDS_WAIT();
          f32x4 hv[4]; float sm = 0.f;
#pragma unroll
          for (int vt = 0; vt < 4; ++vt) { f32x4 acc = {0.f, 0.f, 0.f, 0.f};
              acc = mm16_rB<2>(Q + tt * 16 * 528 + hh * 128, 528, cf[vt], acc, fr, fq);
              acc = acc * wi;
              acc = mm16(SC + hh * 9216 + tt * 16 * 144, 144, VT + (hh * 64 + vt * 16) * 144, 144, 64, acc, fr, fq);
              const f32x4 og = UU4(t0 + t, U_ML_O + hh * 64 + vt * 16 + 4 * fq);
              f32x4 h; h.x = acc.x * rdn * sigmoidf_(og.x); h.y = acc.y * rdn * sigmoidf_(og.y); h.z = acc.z * rdn * sigmoidf_(og.z); h.w = acc.w * rdn * sigmoidf_(og.w);
              hv[vt] = h; sm += (h.x + h.y) + (h.z + h.w); }
          sm += __shfl_xor(sm, 16); sm += __shfl_xor(sm, 32);
          const float mean = sm * (1.f / 64.f); float sq = 0.f;
#pragma unroll
          for (int vt = 0; vt < 4; ++vt) { hv[vt] = hv[vt] - mean; sq += (hv[vt].x * hv[vt].x + hv[vt].y * hv[vt].y) + (hv[vt].z * hv[vt].z + hv[vt].w * hv[vt].w); }
          sq += __shfl_xor(sq, 16); sq += __shfl_xor(sq, 32);
          const float r = __builtin_amdgcn_rsqf(sq * (1.f / 64.f) + NORM_EPS);
#pragma unroll
          for (int vt = 0; vt < 4; ++vt) { const int col = hh * 64 + vt * 16 + 4 * fq; const f32x4 g = *(const f32x4*)(ng + col);
              v2u o; o.x = cvt_pk_bf16(hv[vt].x * r * g.x, hv[vt].y * r * g.y); o.y = cvt_pk_bf16(hv[vt].z * r * g.z, hv[vt].w * r * g.w);
              *(v2u*)(mix + (size_t)(t0 + t) * D + 768 + col) = o; } } }
    __syncthreads();
}

__device__ __forceinline__ void rwkv_stage1(Frame& F, const Args& A, int layer, int ub) {
    const bf16* u = WSP(bf16, WS_U);
    LAS unsigned char* L = F.lds;
    LAS unsigned char* LOWA = L;
    LAS float* CUM = (LAS float*)(L + 16384);
    LAS float* AAB = CUM;
    LAS float* TOT = CUM;
    LAS unsigned char* M0 = L + 16384 + 16640;
#define RM(i) (M0 + (i) * 9216)
    LAS float* GAMC = (LAS float*)(F.MISC + MW_GAMC);
    const int t0 = ub * 64, c = ub & 63, tid = F.tid, lane = F.lane, wave = F.wave;
    const float* mu = KIN(I_RMU) + layer * 896;
#ifndef RW_DUP
#define RW_DUP -1
#endif
#define RW_REP(k) for (int rep__ = 0; rep__ < ((RW_DUP == (k)) ? 2 : 1); ++rep__)
    RW_REP(0) {
    {
        const int l = tid >> 3, jq = tid & 7, t = t0 + l; const bool has_prev = (t & (SEQ - 1)) != 0;
        f32x4 cur[4], prv[4];
#pragma unroll
        for (int q = 0; q < 4; ++q) { cur[q] = UU4(t, U_RW_LO + jq * 16 + 4 * q); prv[q] = has_prev ? UU4(t - 1, U_RW_LO + jq * 16 + 4 * q) : (f32x4){0.f, 0.f, 0.f, 0.f}; }
#pragma unroll
        for (int q = 0; q < 4; ++q) { const f32x4 m4 = *(const f32x4*)(mu + 768 + jq * 16 + 4 * q); const f32x4 xs = cur[q] + (prv[q] - cur[q]) * m4; const int j = jq * 16 + 4 * q;
            f32x4 o;
            if (j < 32) { o.x = tanhf_(xs.x); o.y = tanhf_(xs.y); o.z = tanhf_(xs.z); o.w = tanhf_(xs.w); } else if (j < 64) o = xs; else { o.x = sigmoidf_(xs.x); o.y = sigmoidf_(xs.y); o.z = sigmoidf_(xs.z); o.w = sigmoidf_(xs.w); }
            if (j < 64) lds_st_bf16x4(LOWA + l * 144 + j * 2, o.x, o.y, o.z, o.w); else lds_st_bf16x4(RM(0) + l * 144 + (j - 64) * 2, o.x, o.y, o.z, o.w); }
    }
    __syncthreads();
    {
        bf16* RG = WSP(bf16, WS_RW_G); const int lane_ = F.lane, fr_ = lane_ & 15, fq_ = lane_ >> 4;
        const float* gupT = WSP(float, WS_LORA) + (size_t)layer * LORA_PER_LAYER + 16384;
#pragma unroll
        for (int ci = 0; ci < 2; ++ci) { const int ct = 2 * wave + ci; bf16x8 bf[2];
#pragma unroll
            for (int ks = 0; ks < 2; ++ks) bf[ks] = ldfrag_f32(gupT + (size_t)(ct * 16 + fr_) * 64 + ks * 32 + fq_ * 8);
#pragma unroll
            for (int tt = 0; tt < 4; ++tt) { f32x4 acc = {0.f, 0.f, 0.f, 0.f}; acc = mm16_rB<2>(RM(0) + tt * 16 * 144, 144, bf, acc, fr_, fq_);
                stb4(RG + (size_t)(t0 + tt * 16 + fr_) * 256 + ct * 16 + 4 * fq_, acc); } }
    }
    __syncthreads();
    }
    const int b_ = ub >> 6;
#pragma unroll 1
    for (int hh = 0; hh < 4; ++hh) {
        int ch = lane, fr = lane & 15, fq = lane >> 4; asm volatile("" : "+v"(ch), "+v"(fr), "+v"(fq));
        const int tg = wave, cg = hh * 64 + ch; const size_t un = (size_t)(b_ * 4 + hh) * NCH + c;
        float rr[8], k2r[8], vr[8], ar[8], br[8], pl[8];
        LAS float* WPA = (LAS float*)RM(8);
        {
            const int mat = wave >> 2, ct = wave & 3;
            const float* wT = WSP(float, WS_LORA) + (size_t)layer * LORA_PER_LAYER + mat * 8192 + (size_t)(hh * 64 + ct * 16 + fr) * 32 + fq * 8;
            bf16x8 bfw[1]; bfw[0] = ldfrag_f32(wT);
#pragma unroll
            for (int tt = 0; tt < 4; ++tt) { f32x4 acc = {0.f, 0.f, 0.f, 0.f}; acc = mm16_rB<1>(LOWA + tt * 16 * 144 + mat * 64, 144, bfw, acc, fr, fq);
                *(LAS f32x4*)(WPA + mat * 4096 + (tt * 16 + fr) * 64 + ct * 16 + 4 * fq) = acc; }
        }
        __syncthreads();
        RW_REP(1) {
            const float w0 = KIN(I_RW0)[layer * 256 + cg], a0 = KIN(I_RA0)[layer * 256 + cg], kkc = KIN(I_RKK)[layer * 256 + cg], kac = KIN(I_RKA)[layer * 256 + cg];
            const float mur = mu[cg], muk = mu[256 + cg], muv = mu[512 + cg];
            const int tb = t0 + tg * 8; const bool nop = (c == 0) && (tg == 0);
            float rp = nop ? 0.f : UU(tb - 1, U_RW_R + cg), kp = nop ? 0.f : UU(tb - 1, U_RW_K + cg), vp = nop ? 0.f : UU(tb - 1, U_RW_V + cg);
            float rc[8], kc[8], vc[8];
#pragma unroll
            for (int j = 0; j < 8; ++j) { rc[j] = UU(tb + j, U_RW_R + cg); kc[j] = UU(tb + j, U_RW_K + cg); vc[j] = UU(tb + j, U_RW_V + cg); }
            bf16* RW = WSP(bf16, WS_RW);
            float kk[8], al[8], n2[8], run = 0.f;
#pragma unroll
            for (int j = 0; j < 8; ++j) { const int l = tg * 8 + j;
                const float r = rc[j] + (rp - rc[j]) * mur, k = kc[j] + (kp - kc[j]) * muk, v = vc[j] + (vp - vc[j]) * muv; rp = rc[j]; kp = kc[j]; vp = vc[j];
                const float wp = w0 + WPA[l * 64 + ch], ap = a0 + WPA[4096 + l * 64 + ch];
                const float w = -softplusf_(-wp) - 0.5f; run += -__expf(w); pl[j] = run; al[j] = sigmoidf_(ap);
                kk[j] = k * kkc; n2[j] = kk[j] * kk[j];
                k2r[j] = k * (1.0f + (al[j] - 1.0f) * kac); rr[j] = r; vr[j] = v;
                bf16* o = RW + (size_t)(tb + j) * 768 + cg; o[0] = (bf16)(cvt_pk_bf16(r, 0.f) & 0xffffu); o[256] = (bf16)(cvt_pk_bf16(k2r[j], 0.f) & 0xffffu); o[512] = (bf16)(cvt_pk_bf16(v, 0.f) & 0xffffu); }
#pragma unroll
            for (int i = 0; i < 4; ++i) { const bool hi = (ch & 32) != 0; const float keep = hi ? n2[i + 4] : n2[i], send = hi ? n2[i] : n2[i + 4]; n2[i] = keep + __shfl_xor(send, 32); }
#pragma unroll
            for (int i = 0; i < 2; ++i) { const bool hi = (ch & 16) != 0; const float keep = hi ? n2[i + 2] : n2[i], send = hi ? n2[i] : n2[i + 2]; n2[i] = keep + __shfl_xor(send, 16); }
            { const bool hi = (ch & 8) != 0; const float keep = hi ? n2[1] : n2[0], send = hi ? n2[0] : n2[1]; n2[0] = keep + __shfl_xor(send, 8); }
            n2[0] += __shfl_xor(n2[0], 4); n2[0] += __shfl_xor(n2[0], 2); n2[0] += __shfl_xor(n2[0], 1);
#pragma unroll
            for (int j = 0; j < 8; ++j) { const float tot = __builtin_bit_cast(float, __builtin_amdgcn_readlane(__builtin_bit_cast(int, n2[0]), ((j & 4) ? 32 : 0) + ((j & 2) ? 16 : 0) + ((j & 1) ? 8 : 0)));
                const float kkn = kk[j] / fmaxf(sqrtf(tot), 1e-12f); ar[j] = -kkn; br[j] = kkn * al[j]; }
            TOT[tg * 64 + ch] = run;
        }
        __syncthreads();
        RW_REP(3) {
            float off = 0.f, gC = 0.f;
#pragma unroll
            for (int g = 0; g < 8; ++g) { const float tv = TOT[g * 64 + ch]; gC += tv; if (g < tg) off += tv; }
            float oat[8], obb[8], okb[8], ov[8];
#pragma unroll
            for (int j = 0; j < 8; ++j) { const int l = tg * 8 + j; const float gt = off + pl[j], gm = j > 0 ? off + pl[j - 1] : off;
                const float at = ar[j] * __expf(gm), rt = rr[j] * __expf(gt), en = __expf(-gt), ec = __expf(gC - gt);
                lds_st_bf16(RM(0) + l * 144 + ch * 2, at); lds_st_bf16(RM(1) + l * 144 + ch * 2, rt); lds_st_bf16(RM(2) + l * 144 + ch * 2, br[j] * en); lds_st_bf16(RM(3) + l * 144 + ch * 2, k2r[j] * en);
                oat[j] = at; obb[j] = br[j] * ec; okb[j] = k2r[j] * ec; ov[j] = vr[j]; }
            *(LAS v4u*)(RM(4) + ch * 144 + tg * 16) = pack8(oat); *(LAS v4u*)(RM(5) + ch * 144 + tg * 16) = pack8(obb); *(LAS v4u*)(RM(6) + ch * 144 + tg * 16) = pack8(okb); *(LAS v4u*)(RM(7) + ch * 144 + tg * 16) = pack8(ov);
            if (tg == 0) GAMC[ch] = __expf(gC);
        }
        __syncthreads();
        RW_REP(4) {
            const int which = wave >> 1; const LAS unsigned char* Aop = which < 2 ? RM(0) : RM(1); const LAS unsigned char* Bop = (which & 1) ? RM(3) : RM(2);
#pragma unroll 1
            for (int i2 = 0; i2 < 2; ++i2) { const int tt = 2 * (wave & 1) + i2, t = tt * 16 + fr;
#pragma unroll
                for (int it = 0; it < 4; ++it) { f32x4 acc = {0.f, 0.f, 0.f, 0.f}; acc = mm16(Aop + tt * 16 * 144, 144, Bop + it * 16 * 144, 144, 64, acc, fr, fq);
                    const int i0 = it * 16 + 4 * fq; const int lim = which < 2 ? t : t + 1;
                    const float o0 = (i0 < lim) ? acc[0] : 0.f, o1 = (i0 + 1 < lim) ? acc[1] : 0.f, o2 = (i0 + 2 < lim) ? acc[2] : 0.f, o3 = (i0 + 3 < lim) ? acc[3] : 0.f;
#ifdef RW_CLAMP_AAK
                    float q0 = o0, q1 = o1, q2 = o2, q3 = o3;
                    if (which == 1) { q0 = fabsf(o0) < 1e30f ? o0 : 0.f; q1 = fabsf(o1) < 1e30f ? o1 : 0.f; q2 = fabsf(o2) < 1e30f ? o2 : 0.f; q3 = fabsf(o3) < 1e30f ? o3 : 0.f; }
                    if (which == 0) *(LAS f32x4*)(AAB + t * 64 + i0) = (f32x4){o0, o1, o2, o3};
                    else lds_st_bf16x4(RM(7 + which) + t * 144 + i0 * 2, q0, q1, q2, q3);
                    continue;
#endif
                    if (which == 0) { DBG_STAT(11, o0); DBG_STAT(11, o1); DBG_STAT(11, o2); DBG_STAT(11, o3); } if (which == 1) { DBG_STAT(12, o0); DBG_STAT(12, o1); DBG_STAT(12, o2); DBG_STAT(12, o3); } if (which == 2) { DBG_STAT(13, o0); DBG_STAT(13, o3); } if (which == 3) { DBG_STAT(14, o0); DBG_STAT(14, o3); }
                    if (which == 0) *(LAS f32x4*)(AAB + t * 64 + i0) = (f32x4){o0, o1, o2, o3};
                    else lds_st_bf16x4(RM(7 + which) + t * 144 + i0 * 2, o0, o1, o2, o3); } }
        }
        __syncthreads();
        RW_REP(5) {
#pragma unroll 1
            for (int i2 = 0; i2 < 2; ++i2) { const int idx = wave * 2 + i2, vt = idx >> 2, tt = idx & 3; f32x4 acc = {0.f, 0.f, 0.f, 0.f};
                acc = mm16(RM(7) + vt * 16 * 144, 144, RM(8) + tt * 16 * 144, 144, 64, acc, fr, fq);
                DBG_STAT(15, acc[0]); DBG_STAT(15, acc[1]); DBG_STAT(15, acc[2]); DBG_STAT(15, acc[3]);
                lds_st_bf16x4(RM(0) + (vt * 16 + fr) * 144 + (tt * 16 + 4 * fq) * 2, acc[0], acc[1], acc[2], acc[3]); }
        }
        RW_REP(8) if (wave == 0) {
            float x[64]; f32x4 rowq[16];
#pragma unroll
            for (int t = 0; t < 64; ++t) {
                f32x4 cur[16];
#pragma unroll
                for (int i4 = 0; i4 < (t + 3) / 4; ++i4) cur[i4] = rowq[i4];
                if (t + 1 < 64) {
#pragma unroll
                    for (int i4 = 0; i4 < (t + 4) / 4; ++i4) rowq[i4] = *(const LAS f32x4*)(AAB + (t + 1) * 64 + 4 * i4); }
                float a0 = (t == ch) ? 1.0f : 0.f, a1 = 0.f, a2 = 0.f, a3 = 0.f;
#pragma unroll
                for (int i4 = 0; i4 < (t + 3) / 4; ++i4) { const f32x4 q = cur[i4];
                    a0 += q.x * x[4 * i4]; if (4 * i4 + 1 < t) a1 += q.y * x[4 * i4 + 1]; if (4 * i4 + 2 < t) a2 += q.z * x[4 * i4 + 2]; if (4 * i4 + 3 < t) a3 += q.w * x[4 * i4 + 3]; }
                const float acc = (a0 + a1) + (a2 + a3);
                x[t] = acc; lds_st_bf16(RM(11) + t * 144 + ch * 2, acc); }
        }
        __syncthreads();
        RW_REP(6) {
            const int rt = wave >> 1;
#pragma unroll
            for (int i2 = 0; i2 < 2; ++i2) { const int tt = 2 * (wave & 1) + i2;
                f32x4 acc = {0.f, 0.f, 0.f, 0.f}; acc = mm16(RM(4) + rt * 16 * 144, 144, RM(11) + tt * 16 * 144, 144, 64, acc, fr, fq);
                DBG_STAT(17, acc[0]); DBG_STAT(17, acc[1]); DBG_STAT(17, acc[2]); DBG_STAT(17, acc[3]);
                lds_st_bf16x4(RM(2) + (rt * 16 + fr) * 144 + (tt * 16 + 4 * fq) * 2, acc[0], acc[1], acc[2], acc[3]);
                f32x4 ac2 = {0.f, 0.f, 0.f, 0.f}; ac2 = mm16(RM(0) + rt * 16 * 144, 144, RM(11) + tt * 16 * 144, 144, 64, ac2, fr, fq);
                DBG_STAT(18, ac2[0]); DBG_STAT(18, ac2[1]); DBG_STAT(18, ac2[2]); DBG_STAT(18, ac2[3]);
                lds_st_bf16x4(RM(3) + (rt * 16 + fr) * 144 + (tt * 16 + 4 * fq) * 2, ac2[0], ac2[1], ac2[2], ac2[3]); }
        }
        __syncthreads();
        RW_REP(7) {
            const int which = wave >> 1;
#pragma unroll 1
            for (int i2 = 0; i2 < 2; ++i2) { const int rt = 2 * (wave & 1) + i2, row = rt * 16 + fr;
#pragma unroll
                for (int ct = 0; ct < 4; ++ct) { f32x4 acc = {0.f, 0.f, 0.f, 0.f}; const int c0 = ct * 16 + 4 * fq;
                    if (which == 0) { acc = mm16(RM(9) + rt * 16 * 144, 144, RM(2) + ct * 16 * 144, 144, 64, acc, fr, fq);
                        const v2u rw = *(const LAS v2u*)(RM(1) + row * 144 + c0 * 2);
                        acc[0] += __uint_as_float(rw.x << 16); acc[1] += __uint_as_float(rw.x & 0xffff0000u); acc[2] += __uint_as_float(rw.y << 16); acc[3] += __uint_as_float(rw.y & 0xffff0000u);
                        DBG_STAT(19, acc[0]); DBG_STAT(19, acc[1]); DBG_STAT(19, acc[2]); DBG_STAT(19, acc[3]);
                        v2u o; o.x = cvt_pk_bf16(acc[0], acc[1]); o.y = cvt_pk_bf16(acc[2], acc[3]); *(v2u*)(WSP(bf16, WS_RW_RH) + un * 4096 + row * 64 + c0) = o; }
                    else if (which == 1) {
#ifndef RW_NO_U0
                        acc = mm16(RM(9) + rt * 16 * 144, 144, RM(3) + ct * 16 * 144, 144, 64, acc, fr, fq);
#endif
                        acc = mm16(RM(10) + rt * 16 * 144, 144, RM(7) + ct * 16 * 144, 144, 64, acc, fr, fq);
                        DBG_STAT(20, acc[0]); DBG_STAT(20, acc[1]); DBG_STAT(20, acc[2]); DBG_STAT(20, acc[3]);
                        stb4(WSP(bf16, WS_RW_O0) + un * 4096 + row * 64 + c0, acc); }
                    else if (which == 2) { acc = mm16(RM(5) + rt * 16 * 144, 144, RM(2) + ct * 16 * 144, 144, 64, acc, fr, fq);
                        const float gd = GAMC[row]; if (row == c0) acc[0] += gd; if (row == c0 + 1) acc[1] += gd; if (row == c0 + 2) acc[2] += gd; if (row == c0 + 3) acc[3] += gd;
                        DBG_STAT(21, acc[0]); DBG_STAT(21, acc[1]); DBG_STAT(21, acc[2]); DBG_STAT(21, acc[3]);
                        v2u o; o.x = cvt_pk_bf16(acc[0], acc[1]); o.y = cvt_pk_bf16(acc[2], acc[3]);
                        *(v2u*)((unsigned char*)(WSP(bf16, WS_RW_GF) + un * 4096) + ((rt * 2 + (ct >> 1)) * 64 + ch) * 16 + (ct & 1) * 8) = o; }
                    else { acc = mm16(RM(3) + rt * 16 * 144, 144, RM(5) + ct * 16 * 144, 144, 64, acc, fr, fq); acc = mm16(RM(7) + rt * 16 * 144, 144, RM(6) + ct * 16 * 144, 144, 64, acc, fr, fq);
                        DBG_STAT(22, acc[0]); DBG_STAT(22, acc[1]); DBG_STAT(22, acc[2]); DBG_STAT(22, acc[3]);
                        *(f32x4*)(WSP(float, WS_RW_HT) + un * 4096 + row * 64 + c0) = acc; } } }
        }
        __syncthreads();
    }
#undef RM
}
__device__ __forceinline__ void rwkv_scan_wave(Frame& F, const Args& A, int wslot) {
    const int lane = F.lane, fr = lane & 15, fq = lane >> 4, bh = wslot >> 2, v0 = (wslot & 3) * 16;
    const bf16* GF = WSP(bf16, WS_RW_GF) + (size_t)bh * NCH * 4096; const float* HT = WSP(float, WS_RW_HT) + (size_t)bh * NCH * 4096 + (size_t)(v0 + fr) * 64 + 4 * fq;
    bf16* PT = WSP(bf16, WS_RW_PT) + (size_t)bh * NCH * 4096 + (size_t)(v0 + fr) * 64 + 4 * fq;
    f32x4 P[4] = {{0.f, 0.f, 0.f, 0.f}, {0.f, 0.f, 0.f, 0.f}, {0.f, 0.f, 0.f, 0.f}, {0.f, 0.f, 0.f, 0.f}};
    bf16x8 g0[4][2], g1[4][2], g2[4][2]; f32x4 h0[4], h1[4], h2[4];
#define RW2_LOAD(gx, hx, cc) do { _Pragma("unroll") for (int m = 0; m < 4; ++m) { hx[m] = *(const f32x4*)(HT + (size_t)(cc) * 4096 + 16 * m); \
        _Pragma("unroll") for (int s = 0; s < 2; ++s) gx[m][s] = *(const bf16x8*)(GF + (size_t)(cc) * 4096 + ((m * 2 + s) * 64 + lane) * 8); } } while (0)
#define RW2_STEP(gx, hx, cc) do { v4u bs[2]; \
        _Pragma("unroll") for (int s = 0; s < 2; ++s) { bs[s].x = cvt_pk_bf16(P[2 * s][0], P[2 * s][1]); bs[s].y = cvt_pk_bf16(P[2 * s][2], P[2 * s][3]); bs[s].z = cvt_pk_bf16(P[2 * s + 1][0], P[2 * s + 1][1]); bs[s].w = cvt_pk_bf16(P[2 * s + 1][2], P[2 * s + 1][3]); } \
        *(v2u*)(PT + (size_t)(cc) * 4096) = (v2u){bs[0].x, bs[0].y}; *(v2u*)(PT + (size_t)(cc) * 4096 + 16) = (v2u){bs[0].z, bs[0].w}; \
        *(v2u*)(PT + (size_t)(cc) * 4096 + 32) = (v2u){bs[1].x, bs[1].y}; *(v2u*)(PT + (size_t)(cc) * 4096 + 48) = (v2u){bs[1].z, bs[1].w}; \
        _Pragma("unroll") for (int m = 0; m < 4; ++m) { f32x4 acc = hx[m]; acc = __builtin_amdgcn_mfma_f32_16x16x32_bf16(gx[m][0], __builtin_bit_cast(bf16x8, bs[0]), acc, 0, 0, 0); \
            acc = __builtin_amdgcn_mfma_f32_16x16x32_bf16(gx[m][1], __builtin_bit_cast(bf16x8, bs[1]), acc, 0, 0, 0); P[m] = acc; } } while (0)
    RW2_LOAD(g0, h0, 0); RW2_LOAD(g1, h1, 1);
#pragma unroll 1
    for (int c = 0; c < 63; c += 3) {
        RW2_LOAD(g2, h2, c + 2); RW2_STEP(g0, h0, c);
        RW2_LOAD(g0, h0, c + 3); RW2_STEP(g1, h1, c + 1);
        if (c + 4 < NCH) RW2_LOAD(g1, h1, c + 4);
        RW2_STEP(g2, h2, c + 2);
    }
    RW2_STEP(g0, h0, 63);
#undef RW2_LOAD
#undef RW2_STEP
}
__device__ __forceinline__ void rwkv_stage3(Frame& F, const Args& A, int layer, int ub) {
    const int t0 = ub * 64, b_ = ub >> 6, c = ub & 63, lane = F.lane, wave = F.wave, fr = lane & 15, fq = lane >> 4, hh = wave >> 1;
    const size_t un = (size_t)(b_ * 4 + hh) * NCH + c;
    const bf16* RH = WSP(bf16, WS_RW_RH) + un * 4096; const bf16* PT = WSP(bf16, WS_RW_PT) + un * 4096; const bf16* O0 = WSP(bf16, WS_RW_O0) + un * 4096;
    const bf16* RW = WSP(bf16, WS_RW); const bf16* RG = WSP(bf16, WS_RW_G); bf16* mix = WSP(bf16, WS_MIX);
    const float* lg = KIN(I_RLNG) + layer * 256 + hh * 64; const float* lb = KIN(I_RLNB) + layer * 256 + hh * 64; const float* rk = KIN(I_RRK) + layer * 256 + hh * 64;
    bf16x8 pfr[4][2];
#pragma unroll
    for (int vt = 0; vt < 4; ++vt)
#pragma unroll
        for (int ks = 0; ks < 2; ++ks) pfr[vt][ks] = *(const bf16x8*)(PT + (size_t)(vt * 16 + fr) * 64 + ks * 32 + fq * 8);
#pragma unroll 1
    for (int i = 0; i < 2; ++i) { const int tt = 2 * (wave & 1) + i, tl = tt * 16 + fr, t = t0 + tl;
        const bf16x8 ra0 = *(const bf16x8*)(RH + (size_t)tl * 64 + fq * 8), ra1 = *(const bf16x8*)(RH + (size_t)tl * 64 + 32 + fq * 8);
        f32x4 ov[4]; float sm = 0.f;
#pragma unroll
        for (int vt = 0; vt < 4; ++vt) { f32x4 acc = ldb4(O0 + tl * 64 + vt * 16 + 4 * fq);
            acc = __builtin_amdgcn_mfma_f32_16x16x32_bf16(pfr[vt][0], ra0, acc, 0, 0, 0); acc = __builtin_amdgcn_mfma_f32_16x16x32_bf16(pfr[vt][1], ra1, acc, 0, 0, 0);
            ov[vt] = acc; DBG_STAT(24, acc[0]); DBG_STAT(24, acc[1]); DBG_STAT(24, acc[2]); DBG_STAT(24, acc[3]); sm += (acc.x + acc.y) + (acc.z + acc.w); }
        sm += __shfl_xor(sm, 16); sm += __shfl_xor(sm, 32);
        const float mean = sm * (1.f / 64.f); float sq = 0.f;
#pragma unroll
        for (int vt = 0; vt < 4; ++vt) { ov[vt] = ov[vt] - mean; sq += (ov[vt].x * ov[vt].x + ov[vt].y * ov[vt].y) + (ov[vt].z * ov[vt].z + ov[vt].w * ov[vt].w); }
        sq += __shfl_xor(sq, 16); sq += __shfl_xor(sq, 32);
        const float rs = __builtin_amdgcn_rsqf(sq * (1.f / 64.f) + RWKV_GN_EPS);
        float bd = 0.f;
#pragma unroll
        for (int q = 0; q < 4; ++q) { const f32x4 r4 = ldb4(RW + (size_t)t * 768 + hh * 64 + fq * 16 + 4 * q), k4 = ldb4(RW + (size_t)t * 768 + 256 + hh * 64 + fq * 16 + 4 * q), c4 = *(const f32x4*)(rk + fq * 16 + 4 * q);
            bd += (r4.x * k4.x * c4.x + r4.y * k4.y * c4.y) + (r4.z * k4.z * c4.z + r4.w * k4.w * c4.w); }
        bd += __shfl_xor(bd, 16); bd += __shfl_xor(bd, 32);
#pragma unroll
        for (int vt = 0; vt < 4; ++vt) { const int col = vt * 16 + 4 * fq; const f32x4 g4 = *(const f32x4*)(lg + col), b4 = *(const f32x4*)(lb + col);
            const f32x4 v4 = ldb4(RW + (size_t)t * 768 + 512 + hh * 64 + col), gg = ldb4(RG + (size_t)t * 256 + hh * 64 + col);
            float e0 = (ov[vt].x * rs * g4.x + b4.x + bd * v4.x) * gg.x, e1 = (ov[vt].y * rs * g4.y + b4.y + bd * v4.y) * gg.y, e2 = (ov[vt].z * rs * g4.z + b4.z + bd * v4.z) * gg.z, e3 = (ov[vt].w * rs * g4.w + b4.w + bd * v4.w) * gg.w;
#ifdef RW_SANITIZE
            e0 = (fabsf(e0) < 1e30f) ? e0 : 0.f; e1 = (fabsf(e1) < 1e30f) ? e1 : 0.f; e2 = (fabsf(e2) < 1e30f) ? e2 : 0.f; e3 = (fabsf(e3) < 1e30f) ? e3 : 0.f;
#endif
            v2u o; o.x = cvt_pk_bf16(e0, e1); o.y = cvt_pk_bf16(e2, e3);
            *(v2u*)(mix + (size_t)t * D + 256 + hh * 64 + col) = o; } }
}

__device__ __forceinline__ void scans_elementwise(Frame& F, const Args& A) {
    const int nthr = F.G * 448, gt = F.vcu * 448 + (F.tid - 64);
    constexpr int N_SSD = 16 * 64 * 128 / 2, N_GLA = 16 * 32 * 64 / 2, N_MLC = 16 * 64 * 64 / 2, N_MLN = 16 * 64 / 2;
    for (int i = gt; i < N_SSD + N_GLA + N_MLC + N_MLN; i += nthr) {
        if (i < N_SSD) { const int bh = i >> 12, pn = (i & 4095) * 2; unsigned* base = (unsigned*)(WSP(bf16, WS_SSD_ST) + (size_t)bh * NCH * 8192 + pn); const float* dec = WSP(float, WS_SSD_DEC) + bh * NCH; float S0 = 0.f, S1 = 0.f;
#pragma unroll 1
            for (int c0 = 0; c0 < NCH; c0 += 32) { unsigned x[32]; float dd[32];
#pragma unroll
                for (int j = 0; j < 32; ++j) { x[j] = base[(size_t)(c0 + j) * 4096]; dd[j] = dec[c0 + j]; }
#pragma unroll
                for (int j = 0; j < 32; ++j) { base[(size_t)(c0 + j) * 4096] = cvt_pk_bf16(S0, S1); S0 = dd[j] * S0 + __uint_as_float(x[j] << 16); S1 = dd[j] * S1 + __uint_as_float(x[j] & 0xffff0000u); } }
        } else if (i < N_SSD + N_GLA) { const int k = i - N_SSD, bh = k >> 10, dv = (k & 1023) * 2, dd_ = dv >> 6, b = bh >> 2, hh = bh & 3; unsigned* base = (unsigned*)(WSP(bf16, WS_GLA_ST) + (size_t)bh * NCH * 2048 + dv); const float* dec = WSP(float, WS_GLA_DEC) + (size_t)b * NCH * 128 + hh * 32 + dd_; float S0 = 0.f, S1 = 0.f;
#pragma unroll 1
            for (int c0 = 0; c0 < NCH; c0 += 32) { unsigned x[32]; float dd[32];
#pragma unroll
                for (int j = 0; j < 32; ++j) { x[j] = base[(size_t)(c0 + j) * 1024]; dd[j] = dec[(c0 + j) * 128]; }
#pragma unroll
                for (int j = 0; j < 32; ++j) { base[(size_t)(c0 + j) * 1024] = cvt_pk_bf16(S0, S1); S0 = dd[j] * S0 + __uint_as_float(x[j] << 16); S1 = dd[j] * S1 + __uint_as_float(x[j] & 0xffff0000u); } }
        } else { const int k = i - N_SSD - N_GLA; const bool isn = k >= N_MLC; const int kk = isn ? k - N_MLC : k; const int bh = isn ? (kk >> 5) : (kk >> 11), e = (isn ? (kk & 31) : (kk & 2047)) * 2, str = isn ? 32 : 2048;
            unsigned* base = (unsigned*)((isn ? WSP(bf16, WS_ML_N) : WSP(bf16, WS_ML_C)) + (size_t)bh * NCH * str * 2 + e); const float* bl = WSP(float, WS_ML_BL) + bh * NCH; const float* ml = WSP(float, WS_ML_ML) + bh * NCH; float* mo = WSP(float, WS_ML_M) + bh * NCH;
            float S0 = 0.f, S1 = 0.f, m = 0.f;
#pragma unroll 1
            for (int c0 = 0; c0 < NCH; c0 += 32) { unsigned x[32]; float b8[32], m8[32];
#pragma unroll
                for (int j = 0; j < 32; ++j) { x[j] = base[(size_t)(c0 + j) * str]; b8[j] = bl[c0 + j]; m8[j] = ml[c0 + j]; }
#pragma unroll
                for (int j = 0; j < 32; ++j) { const float mn = fmaxf(b8[j] + m, m8[j]); const float so = __expf(b8[j] + m - mn), sn = __expf(m8[j] - mn);
                    base[(size_t)(c0 + j) * str] = cvt_pk_bf16(S0, S1); if (!isn && e == 0) mo[c0 + j] = m; S0 = so * S0 + sn * __uint_as_float(x[j] << 16); S1 = so * S1 + sn * __uint_as_float(x[j] & 0xffff0000u); m = mn; } }
        }
    }
}
#ifndef MK_PER_PHASE_LAUNCH
#define MK_PER_PHASE_LAUNCH 0
#endif
#ifndef PH_MASK
#define PH_MASK 0xFFF
#endif
#ifndef ST_MASK
#define ST_MASK 0xF
#endif
#define ST_ON(k) (((ST_MASK) >> (k)) & 1)
#ifndef DUP_MASK
#define DUP_MASK 0
#endif
#define DUP_N(k) ((((DUP_MASK) >> (k)) & 1) ? 2 : 1)
#ifndef ST_DUP
#define ST_DUP 0
#endif
#define ST_REP(ty) ((((ST_DUP) >> (ty)) & 1) ? 2 : 1)
#define PH_ON(k) (((PH_MASK) >> (k)) & 1)
constexpr int PH_PER_LAYER = 11, N_PHASES = 1 + DEPTH * PH_PER_LAYER;
__global__ void __launch_bounds__(NWAVES * 64, 2) fwd_kernel(Args args) {
    extern __shared__ __attribute__((aligned(16))) unsigned char lds[];
    Frame F;
    F.lds = (LAS unsigned char*)lds;
    F.MISC = (volatile LAS unsigned*)(F.lds + MISC_OFF);
    F.tid = threadIdx.x; F.lane = F.tid & 63; F.wave = __builtin_amdgcn_readfirstlane(F.tid >> 6);
    F.G = gridDim.x; { const int bx = blockIdx.x; F.vcu = (F.G % 8 == 0) ? (bx % 8) * (F.G / 8) + bx / 8 : bx; }
    F.ka = (karg_t)__builtin_amdgcn_kernarg_segment_ptr(); F.ws = args.ws; F.ctl = (gu32*)(args.ws + WS_CTL); F.out = args.out;
    for (int i = F.tid; i < 256; i += NWAVES * 64) F.MISC[i] = 0u;
    __syncthreads();
    const int lo = args.ph_lo, hi = args.ph_hi;
#ifdef DBG_TSEL
    if (blockIdx.x == 0 && threadIdx.x == 0) __hip_atomic_store(F.ctl + CW_DBG + 15, (unsigned)__builtin_amdgcn_s_memrealtime(), RLX_AGENT);
#endif
    XcdBarrier bar; bar.bar = (unsigned*)(F.ctl + CW_BAR); bar.x = 0; bar.st = nullptr;
    if (hi - lo > 1) bar = xcd_barrier_post((unsigned*)(F.ctl + CW_BAR), F.MISC + MW_BAR);
#define IN_(k) (lo <= (k) && (k) < hi)
#ifdef DBG_TSEL
#ifndef DBG_TQ
#define DBG_TQ 50.0f
#endif
#define TSTAMP(k) do { if (blockIdx.x == 0 && threadIdx.x == 0) __hip_atomic_store(F.ctl + CW_DBG + 16 + ((k) == 11 ? 0 : 1 + layer_ * PH_PER_LAYER + (k)), (unsigned)__builtin_amdgcn_s_memrealtime(), RLX_AGENT); } while (0)
#else
#define TSTAMP(k) do { } while (0)
#endif
#ifdef BAR_DUP
#define SEAM(k) do { if (IN_(k) && IN_((k) + 1)) { xcd_barrier(bar); xcd_barrier(bar); } } while (0)
#else
#define SEAM(k) do { if (IN_(k) && IN_((k) + 1)) xcd_barrier(bar); } while (0)
#endif

    if (PH_ON(11) && IN_(0)) { for (int rep_ = 0; rep_ < DUP_N(11); ++rep_) { frame_refresh(F); p0_prologue(F, args); } SEAM(0); { const int layer_ = 0; TSTAMP(11); (void)layer_; } }
#pragma unroll 1
    for (int layer = 0; layer < DEPTH; ++layer) {
        const int pb = 1 + layer * PH_PER_LAYER; const int layer_ = layer; (void)layer_;
        if (PH_ON(0) && IN_(pb + 0)) { for (int rep_ = 0; rep_ < DUP_N(0); ++rep_) { frame_refresh(F);
            { pg8::DenseSched S; S.init(WSP(bf16, WS_XB), WSP(bf16, WS_WIN_T) + (size_t)layer * NUP * D, T, NUP, D, F.G, (int)blockIdx.x);
              pg8::EpiB16 E{WSP(bf16, WS_U), NUP, nullptr, 0.f};
              pg8::gemm_phase<pg8::EpiB16, pg8::DenseSched>(F.lds, F.tid, S, E); }
            if (F.G != 256 || blockIdx.x >= 128)
            { pg8::DenseSched S; if (F.G == 256) S.init(WSP(bf16, WS_PB) + (size_t)layer * T * 256, WSP(bf16, WS_WPP_T) + (size_t)layer * D * 256, T, D, 256, 128, (int)blockIdx.x - 128); else S.init(WSP(bf16, WS_PB) + (size_t)layer * T * 256, WSP(bf16, WS_WPP_T) + (size_t)layer * D * 256, T, D, 256, F.G, (int)blockIdx.x);
              pg8::EpiB16 E{WSP(bf16, WS_PE), D, nullptr, 0.f};
              pg8::gemm_phase<pg8::EpiB16, pg8::DenseSched>(F.lds, F.tid, S, E); }
            } SEAM(pb + 0); TSTAMP(0);
        }
        if (PH_ON(1) && IN_(pb + 1)) { for (int rep_ = 0; rep_ < DUP_N(1); ++rep_) { frame_refresh(F);
            for (int un = F.vcu; un < 1024; un += F.G) { frame_refresh(F); const int ty = un >> 8, r = un & 255, b = r >> 6, c = r & 63;
                if (ty == 0) { ssd_stage1(F, args, layer, b, c); if (ST_DUP & 1) ssd_stage1(F, args, layer, b, c); } else if (ty == 1) { gla_stage1(F, args, layer, b, c); if (ST_DUP & 2) gla_stage1(F, args, layer, b, c); } else if (ty == 2) { mlstm_stage1(F, args, layer, b, c); if (ST_DUP & 4) mlstm_stage1(F, args, layer, b, c); } else { rwkv_stage1(F, args, layer, r); if (ST_DUP & 8) rwkv_stage1(F, args, layer, r); } }
            } SEAM(pb + 1); TSTAMP(1);
        }
        if (PH_ON(2) && IN_(pb + 2)) { for (int rep_ = 0; rep_ < DUP_N(2); ++rep_) { frame_refresh(F);
            if (F.wave == 0) { for (int ws_ = F.vcu; ws_ < 64; ws_ += F.G) rwkv_scan_wave(F, args, ws_); }
            else if (rep_ == 0) scans_elementwise(F, args);
            } SEAM(pb + 2); TSTAMP(2);
        }
        if (PH_ON(3) && IN_(pb + 3)) { for (int rep_ = 0; rep_ < DUP_N(3); ++rep_) { frame_refresh(F);
            for (int un = F.vcu; un < 1024; un += F.G) { frame_refresh(F); const int ty = un >> 8, r = un & 255, b = r >> 6, c = r & 63;
                if (ty == 0) { ssd_stage3(F, args, layer, b, c); if (ST_DUP & 16) ssd_stage3(F, args, layer, b, c); } else if (ty == 1) { gla_stage3(F, args, layer, b, c); if (ST_DUP & 32) gla_stage3(F, args, layer, b, c); } else if (ty == 2) { mlstm_stage3(F, args, layer, b, c); if (ST_DUP & 64) mlstm_stage3(F, args, layer, b, c); } else { rwkv_stage3(F, args, layer, r); if (ST_DUP & 128) rwkv_stage3(F, args, layer, r); } }
            } SEAM(pb + 3); TSTAMP(3);
        }
        if (PH_ON(4) && IN_(pb + 4)) { for (int rep_ = 0; rep_ < DUP_N(4); ++rep_) { frame_refresh(F);
            pg8::DenseSched S; S.init(WSP(bf16, WS_MIX), WSP(bf16, WS_WOUT_T) + (size_t)layer * D * D, T, D, D, F.G, (int)blockIdx.x);
            pg8::EpiB16 E{WSP(bf16, WS_Y1), D, WSP(bf16, WS_XB), DN_ALPHA};
            pg8::gemm_phase<pg8::EpiB16, pg8::DenseSched>(F.lds, F.tid, S, E);
            } SEAM(pb + 4); TSTAMP(4);
        }
        if (PH_ON(5) && IN_(pb + 5)) { if (DUP_N(5) == 2) { frame_refresh(F); p6_ln1_router<true>(F, args, layer); } frame_refresh(F); p6_ln1_router<false>(F, args, layer); SEAM(pb + 5); TSTAMP(5); }
        if (PH_ON(6) && IN_(pb + 6)) { for (int rep_ = 0; rep_ < DUP_N(6); ++rep_) { frame_refresh(F);
            moe_build_pfx(F, args, layer, 8);
            pg8::Moe1Sched S; S.O.pfx = F.MISC + MW_PFX; S.O.NT = 8; S.O.G = F.G; S.O.c = (int)blockIdx.x; S.sdest = WSP(int, WS_SDEST);
            if (MOE_FP8) { S.X = WSP(unsigned char, WS_X1Q); S.W = WSP(unsigned char, WS_WGU_Q) + (size_t)layer * NE * 2048 * D; S.K = D / 2; S.hstepB = (size_t)1024 * D; }
            else { S.X = WSP(unsigned char, WS_X1B); S.W = WSP(unsigned char, WS_WGU_T) + (size_t)layer * NE * 2048 * D * 2; S.K = D; S.hstepB = (size_t)1024 * D * 2; }
            pg8::EpiMoe1 E{WSP(bf16, WS_ABUF), KIN(I_BGU) + (size_t)layer * NE * 2048, WSP(unsigned char, WS_ABUFQ)};
            pg8::gemm_phase<pg8::EpiMoe1, pg8::Moe1Sched>(F.lds, F.tid, S, E);
            } SEAM(pb + 6); TSTAMP(6);
        }
        if (PH_ON(7) && IN_(pb + 7)) { for (int rep_ = 0; rep_ < DUP_N(7); ++rep_) { frame_refresh(F);
            moe_build_pfx(F, args, layer, 4);
            pg8::Moe2Sched S; S.O.pfx = F.MISC + MW_PFX; S.O.NT = 4; S.O.G = F.G; S.O.c = (int)blockIdx.x; if (MOE2_FP8) { S.Ab = WSP(unsigned char, WS_ABUFQ); S.W = WSP(unsigned char, WS_WDN_Q) + (size_t)layer * NE * D * D; S.K = D / 2; S.hstepB = (size_t)128 * D; }
            else { S.Ab = WSP(unsigned char, WS_ABUF); S.W = WSP(unsigned char, WS_WDN_T) + (size_t)layer * NE * D * D * 2; S.K = D; S.hstepB = (size_t)128 * D * 2; }
            pg8::EpiMoe2 E{WSP(bf16, WS_YBUF), KIN(I_BDN) + (size_t)layer * NE * D, WSP(int, WS_SDEST), WSP(float, WS_SGATE)};
            pg8::gemm_phase<pg8::EpiMoe2, pg8::Moe2Sched>(F.lds, F.tid, S, E);
            } SEAM(pb + 7); TSTAMP(7);
        }
        if (PH_ON(8) && IN_(pb + 8)) { for (int rep_ = 0; rep_ < DUP_N(8); ++rep_) { frame_refresh(F); p9_combine(F, args); } SEAM(pb + 8); TSTAMP(8); }
        if (PH_ON(9) && IN_(pb + 9)) { for (int rep_ = 0; rep_ < DUP_N(9); ++rep_) { frame_refresh(F);
            pg8::DenseSched S; S.init(WSP(bf16, WS_HB), WSP(bf16, WS_WPG_T) + (size_t)layer * D * D, T, D, D, F.G, (int)blockIdx.x);
            pg8::EpiPle E{WSP(bf16, WS_H2), WSP(bf16, WS_HB), WSP(bf16, WS_PE)};
            pg8::gemm_phase<pg8::EpiPle, pg8::DenseSched>(F.lds, F.tid, S, E);
            } SEAM(pb + 9); TSTAMP(9);
        }
        if (PH_ON(10) && IN_(pb + 10)) { for (int rep_ = 0; rep_ < DUP_N(10); ++rep_) { frame_refresh(F); p11_ln2(F, args, layer); } SEAM(pb + 10); TSTAMP(10); }
    }
#ifdef DBG_TSEL
    if (hi - lo > 1) { xcd_barrier(bar);
        unsigned ticks = 0u;
        if (DBG_TSEL == 11) ticks = __hip_atomic_load(F.ctl + CW_DBG + 16, RLX_AGENT) - __hip_atomic_load(F.ctl + CW_DBG + 15, RLX_AGENT);
        else for (int l = 0; l < DEPTH; ++l) { const int pi = 1 + l * PH_PER_LAYER + DBG_TSEL; ticks += __hip_atomic_load(F.ctl + CW_DBG + 16 + pi, RLX_AGENT) - __hip_atomic_load(F.ctl + CW_DBG + 16 + pi - 1, RLX_AGENT); }
        const float us = floorf((float)ticks * 0.01f / DBG_TQ) * DBG_TQ; const float code = sqrtf(us * 0.05f);
        for (size_t i = (size_t)blockIdx.x * 512 + threadIdx.x; i < (size_t)T * D; i += (size_t)gridDim.x * 512) F.out[i] = code; }
#endif
#ifdef DBG_SEL
    if (hi - lo > 1) { xcd_barrier(bar);
        const unsigned mx = __hip_atomic_load(F.ctl + CW_DBG, RLX_AGENT), nf = __hip_atomic_load(F.ctl + CW_DBG + 1, RLX_AGENT);
        float code;
        { const float m = __uint_as_float(mx); int b = (m > 0.f) ? (int)floorf(log10f(m)) + 30 : 0; b = b < 0 ? 0 : (b > 60 ? 60 : b); if (nf) b += 100; code = sqrtf(10.0f * (float)(b + 1)); }
        for (size_t i = (size_t)blockIdx.x * 512 + threadIdx.x; i < (size_t)T * D; i += (size_t)gridDim.x * 512) F.out[i] = code; }
#endif
#undef IN_
#undef SEAM
}

extern "C" void kernel_launch(void* const* d_in, const int* in_sizes, int n_in, void* d_out, int out_size, void* d_ws, size_t ws_size, hipStream_t stream) {
    static int grid = 0;
    if (grid == 0) {
        if (n_in != N_IN || out_size != T * D || ws_size < WS_END) { fprintf(stderr, "kernel_launch: unexpected shapes (n_in %d, out %d, ws %zu < %zu); nothing launched\n", n_in, out_size, ws_size, (size_t)WS_END); grid = -1; return; }
        int dev = 0, cus = 0, per_cu = 0;
        if (hipGetDevice(&dev) != hipSuccess || hipDeviceGetAttribute(&cus, hipDeviceAttributeMultiprocessorCount, dev) != hipSuccess) { grid = -1; return; }
        if (hipFuncSetAttribute((const void*)fwd_kernel, hipFuncAttributeMaxDynamicSharedMemorySize, LDS_BYTES) != hipSuccess) { fprintf(stderr, "kernel_launch: hipFuncSetAttribute failed\n"); grid = -1; return; }
        if (hipOccupancyMaxActiveBlocksPerMultiprocessor(&per_cu, (const void*)fwd_kernel, NWAVES * 64, LDS_BYTES) != hipSuccess || per_cu < 1) { fprintf(stderr, "kernel_launch: occupancy query says %d blocks per CU\n", per_cu); }
        (void)hipGetLastError();
        grid = cus;
    }
    if (grid < 0) return;
    (void)hipMemsetAsync((char*)d_ws + WS_CTL, 0, CTL_ZERO_BYTES, stream);
    Args a{};
    for (int i = 0; i < N_IN; ++i) a.in[i] = (const float*)d_in[i];
    a.out = (float*)d_out; a.ws = (unsigned char*)d_ws;
#if MK_PER_PHASE_LAUNCH
    for (int ph = 0; ph < N_PHASES; ++ph) { a.ph_lo = ph; a.ph_hi = ph + 1; hipLaunchKernelGGL(fwd_kernel, dim3(grid), dim3(NWAVES * 64), LDS_BYTES, stream, a); }
#else
    a.ph_lo = 0; a.ph_hi = N_PHASES; hipLaunchKernelGGL(fwd_kernel, dim3(grid), dim3(NWAVES * 64), LDS_BYTES, stream, a);
#endif
    const hipError_t le = hipPeekAtLastError();
    if (le != hipSuccess) fprintf(stderr, "kernel_launch: launch failed: %s\n", hipGetErrorName(le));
}
```

```cpp
#include <hip/hip_runtime.h>
#include <cstdio>
#include <cstdint>

#define GAS __attribute__((address_space(1)))
#define LAS __attribute__((address_space(3)))
typedef unsigned short bf16;
typedef unsigned v4u __attribute__((ext_vector_type(4)));
typedef unsigned v2u __attribute__((ext_vector_type(2)));
typedef float f32x4 __attribute__((ext_vector_type(4)));
typedef float f32x2 __attribute__((ext_vector_type(2)));
typedef short bf16x8 __attribute__((ext_vector_type(8)));
typedef int v4i_t __attribute__((ext_vector_type(4)));
typedef int v8i_t __attribute__((ext_vector_type(8)));
typedef GAS unsigned gu32;
#define RLX_AGENT __ATOMIC_RELAXED, __HIP_MEMORY_SCOPE_AGENT
#define LDS_WAIT() asm volatile("s_waitcnt lgkmcnt(0)" ::: "memory")
#define VM_WAIT() asm volatile("s_waitcnt vmcnt(0)" ::: "memory")

constexpr int NWAVES = 8;
constexpr int DEPTH = 4, BATCH = 4, SEQ = 4096, D = 1024, T = BATCH * SEQ;
constexpr int NU = 3484, NUP = 3584;
constexpr int NE = 32, TOPK = 4, ECAP = 16384;
constexpr int NCH = SEQ / 64;
constexpr int U_SSD_Z = 0, U_SSD_X = 256, U_SSD_B = 512, U_SSD_C = 640, U_SSD_DT = 768;
constexpr int U_RW = 772, U_RW_R = 772, U_RW_K = 1028, U_RW_V = 1284, U_RW_LO = 1540;
constexpr int U_GL_Q = 1668, U_GL_K = 1796, U_GL_V = 1924, U_GL_G = 2180, U_GL_OG = 2196;
constexpr int U_ML_Q = 2452, U_ML_K = 2708, U_ML_V = 2964, U_ML_I = 3220, U_ML_F = 3224, U_ML_O = 3228;
constexpr float DN_ALPHA = 1.6817928305074290f;
constexpr float LN_EPS = 1e-5f, NORM_EPS = 1e-5f, RWKV_GN_EPS = 64e-5f;

enum { I_X = 0, I_P, I_WIN, I_WOUT, I_LN1G, I_LN1B, I_SCW, I_SCB, I_SALOG, I_SDTB, I_SD, I_SNG,
       I_RMU, I_RW0, I_RWUP, I_RA0, I_RAUP, I_RGUP, I_RKK, I_RKA, I_RRK, I_RLNG, I_RLNB,
       I_GGUP, I_GGB, I_GNG, I_MCW, I_MCB, I_MIB, I_MFB, I_MNG,
       I_RTW, I_RTB, I_WGU, I_BGU, I_WDN, I_BDN, I_PGW, I_PPJ, I_LN2G, I_LN2B, N_IN };

constexpr size_t MiB = 1u << 20;
constexpr size_t WS_CTL = 0, CTL_ZERO_BYTES = 1 * MiB;
constexpr size_t WS_WIN_T = 2 * MiB;
constexpr size_t WS_WOUT_T = WS_WIN_T + (size_t)DEPTH * NUP * D * 2;
constexpr size_t WS_WGU_T = WS_WOUT_T + (size_t)DEPTH * D * D * 2;
constexpr size_t WS_WDN_T = WS_WGU_T + (size_t)DEPTH * NE * 2048 * D * 2;
constexpr size_t WS_WPG_T = WS_WDN_T + (size_t)DEPTH * NE * D * D * 2;
constexpr size_t WS_WPP_T = WS_WPG_T + (size_t)DEPTH * D * D * 2;
constexpr size_t WS_RWT = WS_WPP_T + (size_t)DEPTH * D * 256 * 2;
constexpr size_t WS_PB = WS_RWT + (size_t)DEPTH * NE * D * 4;
constexpr size_t WS_XB = WS_PB + (size_t)DEPTH * T * 256 * 2;
constexpr size_t WS_U = WS_XB + (size_t)T * D * 2;
constexpr size_t WS_PE = WS_U + (size_t)T * NUP * 2;
constexpr size_t WS_MIX = WS_PE + (size_t)T * D * 4;
constexpr size_t WS_Y1 = WS_MIX + (size_t)T * D * 2;
constexpr size_t WS_X1 = WS_Y1 + (size_t)T * D * 4;
constexpr size_t WS_X1B = WS_X1 + (size_t)T * D * 4;
constexpr size_t WS_SDEST = WS_X1B + (size_t)T * D * 2;
constexpr size_t WS_SGATE = WS_SDEST + (size_t)NE * ECAP * 4;
constexpr size_t WS_ABUF = WS_SGATE + (size_t)NE * ECAP * 4;
constexpr size_t WS_YBUF = WS_ABUF + (size_t)NE * ECAP * D * 2;
constexpr size_t WS_H = WS_YBUF + (size_t)T * 4 * D * 2;
constexpr size_t WS_HB = WS_H + (size_t)T * D * 4;
constexpr size_t WS_H2 = WS_HB + (size_t)T * D * 2;
constexpr size_t WS_SSD_ST = WS_H2 + (size_t)T * D * 4;
constexpr size_t WS_SSD_DEC = WS_SSD_ST + (size_t)16 * NCH * 64 * 128 * 4;
constexpr size_t WS_GLA_ST = WS_SSD_DEC + 16 * NCH * 4;
constexpr size_t WS_GLA_DEC = WS_GLA_ST + (size_t)16 * NCH * 32 * 64 * 4;
constexpr size_t WS_ML_C = WS_GLA_DEC + (size_t)4 * NCH * 128 * 4;
constexpr size_t WS_ML_N = WS_ML_C + (size_t)16 * NCH * 64 * 64 * 4;
constexpr size_t WS_ML_BL = WS_ML_N + (size_t)16 * NCH * 64 * 4;
constexpr size_t WS_ML_ML = WS_ML_BL + 16 * NCH * 4;
constexpr size_t WS_ML_M = WS_ML_ML + 16 * NCH * 4;
constexpr size_t WS_RW = WS_ML_M + 16 * NCH * 4;
constexpr size_t WS_RW_G = WS_RW + (size_t)T * 3 * 256 * 4;
constexpr size_t WS_RW_RH = WS_RW_G + (size_t)T * 256 * 4;
constexpr size_t WS_RW_O0 = WS_RW_RH + (size_t)1024 * 4096 * 2;
constexpr size_t WS_RW_GF = WS_RW_O0 + (size_t)1024 * 4096 * 4;
constexpr size_t WS_RW_HT = WS_RW_GF + (size_t)1024 * 4096 * 2;
constexpr size_t WS_RW_PT = WS_RW_HT + (size_t)1024 * 4096 * 4;
constexpr size_t WS_LORA = WS_RW_PT + (size_t)1024 * 4096 * 2;
constexpr int LORA_PER_LAYER = 8192 + 8192 + 16384 + 2048;
constexpr size_t WS_WGU_Q = WS_LORA + (size_t)DEPTH * LORA_PER_LAYER * 4;
constexpr size_t WS_WDN_Q = WS_WGU_Q + (size_t)DEPTH * NE * 2048 * D;
constexpr size_t WS_X1Q = WS_WDN_Q + (size_t)DEPTH * NE * D * D;
constexpr size_t WS_ABUFQ = WS_X1Q + (size_t)T * D;
constexpr size_t WS_END = WS_ABUFQ + (size_t)NE * ECAP * D;
#ifndef MOE_FP8
#define MOE_FP8 1
#endif
#ifndef MOE2_FP8
#define MOE2_FP8 1
#endif
constexpr int CW_BAR = 4096;
constexpr int CW_DBG = 32768;
constexpr int CW_CNT = 16384;

constexpr int RING_BYTES = 147456;
constexpr int MISC_OFF = RING_BYTES;
constexpr int LDS_BYTES = RING_BYTES + 1024;
constexpr int MW_BAR = 8, MW_LCNT = 32, MW_LBASE = 64, MW_PFX = 96, MW_CNT = 136, MW_GAMC = 168;

typedef __bf16 bf16x2_t __attribute__((ext_vector_type(2)));
__device__ __forceinline__ unsigned cvt_pk_bf16(float lo, float hi) { const f32x2 v = {lo, hi}; const bf16x2_t b = __builtin_convertvector(v, bf16x2_t); return __builtin_bit_cast(unsigned, b); }
__device__ __forceinline__ unsigned cvt4_fp8(float a, float b, float c, float d) { int w = 0; w = __builtin_amdgcn_cvt_pk_fp8_f32(a, b, w, false); w = __builtin_amdgcn_cvt_pk_fp8_f32(c, d, w, true); return (unsigned)w; }
__device__ __forceinline__ float bf2f(unsigned short b) { return __uint_as_float(((unsigned)b) << 16); }
__device__ __forceinline__ float sigmoidf_(float x) { return __builtin_amdgcn_rcpf(1.0f + __expf(-x)); }
__device__ __forceinline__ float siluf_(float x) { return x * __builtin_amdgcn_rcpf(1.0f + __expf(-x)); }
__device__ __forceinline__ float softplusf_(float x) { return fmaxf(x, 0.f) + __logf(1.0f + __expf(-fabsf(x))); }
__device__ __forceinline__ float logsigmoidf_(float x) { return fminf(x, 0.f) - __logf(1.0f + __expf(-fabsf(x))); }
__device__ __forceinline__ float tanhf_(float x) { const float e = __expf(-2.0f * fabsf(x)); const float t = (1.0f - e) * __builtin_amdgcn_rcpf(1.0f + e); return x < 0.f ? -t : t; }
__device__ __forceinline__ int lane_now() { int l = (int)__builtin_amdgcn_mbcnt_hi(~0u, __builtin_amdgcn_mbcnt_lo(~0u, 0u)); asm volatile("" : "+v"(l)); return l; }
__device__ __forceinline__ float my_shfl_idx(float v, int src) { return __builtin_bit_cast(float, __builtin_amdgcn_ds_bpermute(src << 2, __builtin_bit_cast(int, v))); }
__device__ __forceinline__ int my_shfl_idx(int v, int src) { return __builtin_amdgcn_ds_bpermute(src << 2, v); }
template <class V> __device__ __forceinline__ V my_shfl_xor(V v, int o) { return my_shfl_idx(v, lane_now() ^ o); }
template <class V> __device__ __forceinline__ V my_shfl_up(V v, int o) { const int l = lane_now(); return my_shfl_idx(v, l >= o ? l - o : l); }
#define __shfl_xor(v, o) my_shfl_xor(v, o)
#define __shfl_up(v, o) my_shfl_up(v, o)
#define __shfl(v, s) my_shfl_idx(v, s)
__device__ __forceinline__ float wave_sum(float v) {
#pragma unroll
    for (int o = 1; o < 64; o <<= 1) v += __shfl_xor(v, o);
    return v;
}
__device__ __forceinline__ float wave_max(float v) {
#pragma unroll
    for (int o = 1; o < 64; o <<= 1) v = fmaxf(v, __shfl_xor(v, o));
    return v;
}
__device__ __forceinline__ float wave_scan_add(float v, int lane) {
#pragma unroll
    for (int o = 1; o < 64; o <<= 1) { const float t = __shfl_up(v, o); if (lane >= o) v += t; }
    return v;
}
__device__ __forceinline__ float wave_scan_max(float v, int lane) {
#pragma unroll
    for (int o = 1; o < 64; o <<= 1) { const float t = __shfl_up(v, o); if (lane >= o) v = fmaxf(v, t); }
    return v;
}
__device__ __forceinline__ f32x4 mm16(const LAS unsigned char* A, int lda, const LAS unsigned char* B, int ldb, int K, f32x4 acc, int fr, int fq) {
    const LAS unsigned char* ap = A + fr * lda + fq * 16; const LAS unsigned char* bp = B + fr * ldb + fq * 16;
    for (int k = 0; k < K; k += 32) {
        const bf16x8 a = *(const LAS bf16x8*)(ap + k * 2); const bf16x8 b = *(const LAS bf16x8*)(bp + k * 2);
        acc = __builtin_amdgcn_mfma_f32_16x16x32_bf16(b, a, acc, 0, 0, 0);
    }
    return acc;
}
__device__ __forceinline__ f32x4 mm16_gB(const LAS unsigned char* A, int lda, const float* B, int ldb, int K, f32x4 acc, int fr, int fq) {
    const LAS unsigned char* ap = A + fr * lda + fq * 16; const float* bp = B + (size_t)fr * ldb + fq * 8;
    for (int k = 0; k < K; k += 32) {
        const bf16x8 a = *(const LAS bf16x8*)(ap + k * 2);
        const f32x4 b0 = *(const f32x4*)(bp + k), b1 = *(const f32x4*)(bp + k + 4);
        v4u bw; bw.x = cvt_pk_bf16(b0.x, b0.y); bw.y = cvt_pk_bf16(b0.z, b0.w); bw.z = cvt_pk_bf16(b1.x, b1.y); bw.w = cvt_pk_bf16(b1.z, b1.w);
        const bf16x8 b = __builtin_bit_cast(bf16x8, bw);
        acc = __builtin_amdgcn_mfma_f32_16x16x32_bf16(b, a, acc, 0, 0, 0);
    }
    return acc;
}
__device__ __forceinline__ f32x4 mm16_gAB(const bf16* A, int lda, const bf16* B, int ldb, int K, f32x4 acc, int fr, int fq) {
    const bf16* ap = A + (size_t)fr * lda + fq * 8; const bf16* bp = B + (size_t)fr * ldb + fq * 8;
    for (int k = 0; k < K; k += 32) { const bf16x8 a = *(const bf16x8*)(ap + k), b = *(const bf16x8*)(bp + k); acc = __builtin_amdgcn_mfma_f32_16x16x32_bf16(b, a, acc, 0, 0, 0); }
    return acc;
}
__device__ __forceinline__ bf16x8 ldfrag_f32(const float* p) { const f32x4 b0 = *(const f32x4*)p, b1 = *(const f32x4*)(p + 4);
    v4u bw; bw.x = cvt_pk_bf16(b0.x, b0.y); bw.y = cvt_pk_bf16(b0.z, b0.w); bw.z = cvt_pk_bf16(b1.x, b1.y); bw.w = cvt_pk_bf16(b1.z, b1.w); return __builtin_bit_cast(bf16x8, bw); }
template <int NK> __device__ __forceinline__ f32x4 mm16_rB(const LAS unsigned char* A, int lda, const bf16x8 (&b)[NK], f32x4 acc, int fr, int fq) {
    const LAS unsigned char* ap = A + fr * lda + fq * 16;
#pragma unroll
    for (int k = 0; k < NK; ++k) { const bf16x8 a = *(const LAS bf16x8*)(ap + k * 64); acc = __builtin_amdgcn_mfma_f32_16x16x32_bf16(b[k], a, acc, 0, 0, 0); }
    return acc;
}
__device__ __forceinline__ v4u pack8(const float (&v)[8]) { v4u o; o.x = cvt_pk_bf16(v[0], v[1]); o.y = cvt_pk_bf16(v[2], v[3]); o.z = cvt_pk_bf16(v[4], v[5]); o.w = cvt_pk_bf16(v[6], v[7]); return o; }

#define XB_TMO      128
#define XB_XCNT(j)  (256  + 64 * (j))
#define XB_XSUB(j)  (1280 + 64 * (j))
#define XB_XGEN(j)  (2304 + 64 * (j))
#define XB_TOP      3328
#define XB_TOPGEN   3392
#define XCD_BAR_WORDS 3456
#define XB_SPIN_CAP (1u << 18)
__device__ __forceinline__ unsigned xb_ld(unsigned* p)              { return __hip_atomic_load(p, __ATOMIC_RELAXED, __HIP_MEMORY_SCOPE_AGENT); }
__device__ __forceinline__ unsigned xb_add(unsigned* p, unsigned v) { return __hip_atomic_fetch_add(p, v, __ATOMIC_RELAXED, __HIP_MEMORY_SCOPE_AGENT); }
__device__ __forceinline__ unsigned xb_xcc_id() { return (unsigned)__builtin_amdgcn_s_getreg((3 << 11) | 20) & 0xFu; }
#define XB_SPIN(cond, bar) do { unsigned _sp = 0; while (cond) { __builtin_amdgcn_s_sleep(1); \
    if ((++_sp & 255u) == 0u) { if (xb_ld(&(bar)[XB_TMO])) break; if (_sp > XB_SPIN_CAP) { atomicAdd(&(bar)[XB_TMO], 1u); break; } } } } while (0)
struct XcdBarrier { unsigned* bar; unsigned x; volatile LAS unsigned* st; };
__device__ __forceinline__ XcdBarrier xcd_barrier_post(unsigned* bar, volatile LAS unsigned* st) {
    XcdBarrier b; b.bar = bar; b.x = xb_xcc_id(); b.st = st;
    if (threadIdx.x == 0) (void)xb_add(&bar[XB_XCNT(b.x)], 1u);
    return b;
}
__device__ __forceinline__ void xcd_barrier_complete(unsigned* bar, unsigned x, unsigned& nloc, unsigned& nx) {
    const unsigned G = gridDim.x * gridDim.y * gridDim.z;
    unsigned sum, cnt, mine, sp = 0u;
    for (;;) {
        sum = 0u; cnt = 0u; mine = 0u;
#pragma unroll
        for (unsigned j = 0; j < 16; ++j) { const unsigned c = xb_ld(&bar[XB_XCNT(j)]); sum += c; cnt += (c > 0u) ? 1u : 0u; mine = (j == x) ? c : mine; }
        if (sum == G) break;
        __builtin_amdgcn_s_sleep(1);
        if ((++sp & 255u) == 0u) { if (xb_ld(&bar[XB_TMO])) break; if (sp > XB_SPIN_CAP) { atomicAdd(&bar[XB_TMO], 1u); break; } }
    }
    nloc = mine > 0u ? mine : 1u; nx = cnt > 0u ? cnt : 1u;
}
__device__ __forceinline__ void xcd_barrier(const XcdBarrier& b) {
    asm volatile("s_waitcnt vmcnt(0)" ::: "memory");
    __syncthreads();
    if (threadIdx.x == 0) {
        unsigned* bar = b.bar;
        __builtin_amdgcn_s_waitcnt(0);
        unsigned nloc = b.st[0], nx = b.st[1];
        if (nloc == 0u) { xcd_barrier_complete(bar, b.x, nloc, nx); b.st[0] = nloc; b.st[1] = nx; }
        const unsigned old = xb_add(&bar[XB_XSUB(b.x)], 1u);
        const unsigned gen = old / nloc;
        if (old + 1u == (gen + 1u) * nloc) {
            __builtin_amdgcn_fence(__ATOMIC_RELEASE, "agent");
            asm volatile("s_waitcnt vmcnt(0)" ::: "memory");
            const unsigned og = xb_add(&bar[XB_TOP], 1u);
            const unsigned tg = og / nx;
            if (og + 1u == (tg + 1u) * nx) xb_add(&bar[XB_TOPGEN], 1u);
            else XB_SPIN(xb_ld(&bar[XB_TOPGEN]) == tg, bar);
            __builtin_amdgcn_fence(__ATOMIC_ACQUIRE, "agent");
            xb_add(&bar[XB_XGEN(b.x)], 1u);
            asm volatile("s_waitcnt vmcnt(0)" ::: "memory");
        } else {
            XB_SPIN(xb_ld(&bar[XB_XGEN(b.x)]) == gen, bar);
            __builtin_amdgcn_fence(__ATOMIC_ACQUIRE, "agent");
            asm volatile("s_waitcnt vmcnt(0)" ::: "memory");
        }
    }
    __syncthreads();
}

namespace pg8 {
constexpr int BM = 256, BK = 64, HALF = 128, HTB = HALF * BK * 2, STAGE_BYTES = 8 * HTB, NXCD = 8, WGM = 8;
__host__ __device__ __forceinline__ int lds_byte(int r, int c) { const int st = (r >> 4) * 2 + (c >> 5), rr = r & 15, cc = c & 31, ob = rr * 64 + cc * 2; return st * 1024 + (ob ^ (((ob >> 9) & 1) << 5)); }
__host__ __device__ __forceinline__ void stage_rc(int b, int& R, int& C) { const int st = b / 1024, sb = b % 1024, swz = sb ^ (((sb >> 9) & 1) << 5); R = (st >> 1) * 16 + swz / 64; C = (st & 1) * 32 + (swz % 64) / 2; }
__host__ __device__ __forceinline__ int perm32(int rho) { const int n = rho >> 4, i = rho & 15; return 8 * (i >> 2) + 4 * n + (i & 3); }

template <class Epi, class Sched>
__device__ __forceinline__ void gemm_phase(LAS unsigned char* lds, const int tid, const Sched& S, const Epi& E) {
    const int wid = __builtin_amdgcn_readfirstlane(tid >> 6), lane = tid & 63, wr = wid >> 2, wc = wid & 3, fr = lane & 15, fq = lane >> 4;
    const int K = S.K, nt = K / BK;
    unsigned voffB[2];
#pragma unroll
    for (int i = 0; i < 2; ++i) { int R, C; stage_rc(tid * 16 + i * 8192, R, C); const int Rb = Epi::PERM ? ((R & ~31) + perm32(R & 31)) : R; voffB[i] = (unsigned)(Rb * K + C) * 2u; }
    const size_t kstep = (size_t)(BK * 2);
    const size_t hstepB = S.hstepB;
    const unsigned ldsw = (unsigned)wid * 1024u;
    constexpr bool F8 = Sched::FP8;
    const int aoff = F8 ? lds_byte(wr * 64 + fr, fq * 16) : lds_byte(wr * 64 + fr, fq * 8), boff = F8 ? lds_byte(wc * 32 + fr, fq * 16) : lds_byte(wc * 32 + fr, fq * 8);
#define PG8_SA(b, h) (((b) * 2 + (h)) * HTB)
#define PG8_SB(b, h) ((4 + (b) * 2 + (h)) * HTB)
#define PG8_STAGE_B(bufoff, gbase) do { _Pragma("unroll") for (int _i = 0; _i < 2; ++_i) \
        __builtin_amdgcn_global_load_lds((const unsigned*)((const char*)(gbase) + voffB[_i]), (LAS unsigned*)(lds + (bufoff) + ldsw + _i * 8192), 16, 0, 0); } while (0)
#define PG8_STAGE_A(bufoff, gbase, v0, v1) do { \
        __builtin_amdgcn_global_load_lds((const unsigned*)((const char*)(gbase) + (v0)), (LAS unsigned*)(lds + (bufoff) + ldsw), 16, 0, 0); \
        __builtin_amdgcn_global_load_lds((const unsigned*)((const char*)(gbase) + (v1)), (LAS unsigned*)(lds + (bufoff) + ldsw + 8192), 16, 0, 0); } while (0)
#define PG8_FOFF(k) (F8 ? (k) * 16 : (k) * 1024)
#define PG8_LDA(dst, b, h) do { _Pragma("unroll") for (int m = 0; m < 4; ++m) { if constexpr (F8) dst##8[m] = *(const LAS v8i_t*)(lds + PG8_SA(b, h) + aoff + m * 2048); \
        else { _Pragma("unroll") for (int k = 0; k < 2; ++k) dst[m][k] = *(const LAS bf16x8*)(lds + PG8_SA(b, h) + aoff + m * 2048 + k * 1024); } } } while (0)
#define PG8_LDB(dst, b, h) do { _Pragma("unroll") for (int n = 0; n < 2; ++n) { if constexpr (F8) dst##8[n] = *(const LAS v8i_t*)(lds + PG8_SB(b, h) + boff + n * 2048); \
        else { _Pragma("unroll") for (int k = 0; k < 2; ++k) dst[n][k] = *(const LAS bf16x8*)(lds + PG8_SB(b, h) + boff + n * 2048 + k * 1024); } } } while (0)
#define PG8_CAT(x) __builtin_shufflevector(__builtin_bit_cast(v4i_t, x[0]), __builtin_bit_cast(v4i_t, x[1]), 0, 1, 2, 3, 4, 5, 6, 7)
#define PG8_MMA(ai, bj, At, Bt) do { __builtin_amdgcn_s_setprio(1); _Pragma("unroll") for (int m = 0; m < 4; ++m) _Pragma("unroll") for (int n = 0; n < 2; ++n) { \
        if constexpr (F8) acc[ai][bj][m][n] = __builtin_amdgcn_mfma_scale_f32_16x16x128_f8f6f4(Bt##8[n], At##8[m], acc[ai][bj][m][n], 0, 0, 0, S.scaleB, 0, S.scaleA); \
        else { _Pragma("unroll") for (int k = 0; k < 2; ++k) acc[ai][bj][m][n] = __builtin_amdgcn_mfma_f32_16x16x32_bf16(Bt[n][k], At[m][k], acc[ai][bj][m][n], 0, 0, 0); } } __builtin_amdgcn_s_setprio(0); } while (0)
#define PG8_WAIT_V(n) asm volatile("s_waitcnt vmcnt(" #n ")" ::: "memory")
#define PG8_WAIT_L(n) asm volatile("s_waitcnt lgkmcnt(" #n ")" ::: "memory")
#define PG8_BAR __builtin_amdgcn_s_barrier()
#define PG8_SCHED __builtin_amdgcn_sched_barrier(0)
    typename Sched::Unit cur, nxt; int ui = 0;
    if (!S.next(0, cur)) return;
    f32x4 acc[2][2][4][2];
#pragma unroll
    for (int a = 0; a < 2; ++a)
#pragma unroll
        for (int b = 0; b < 2; ++b)
#pragma unroll
            for (int m = 0; m < 4; ++m)
#pragma unroll
                for (int n = 0; n < 2; ++n) acc[a][b][m][n] = (f32x4){0.f, 0.f, 0.f, 0.f};
    bf16x8 At[4][2], B0[2][2], B1[2][2]; v8i_t At8[4], B08[2], B18[2];
    constexpr bool GA = Sched::GATHER;
    const size_t hstepA = GA ? (size_t)0 : (size_t)HALF * K * 2;
    unsigned vA[2][2];
    S.a_off(cur, tid, vA);
#define PG8_STAGE_AH(bufoff, base, vv, h) PG8_STAGE_A(bufoff, ((base) + (h) * hstepA), vv[GA ? (h) : 0][0], vv[GA ? (h) : 0][1])
    const char* cA = S.a_base(cur); const char* cB = S.b_base(cur);
    PG8_STAGE_B(PG8_SB(0, 0), cB); PG8_STAGE_B(PG8_SB(0, 1), cB + hstepB); PG8_STAGE_AH(PG8_SA(0, 0), cA, vA, 0); PG8_STAGE_AH(PG8_SA(0, 1), cA, vA, 1);
    if (wr == 1) PG8_BAR;
    PG8_WAIT_V(2); PG8_BAR;
    PG8_STAGE_B(PG8_SB(1, 0), cB + kstep); PG8_STAGE_AH(PG8_SA(1, 0), cA + kstep, vA, 0); PG8_STAGE_B(PG8_SB(1, 1), cB + hstepB + kstep);
    PG8_WAIT_V(6); PG8_BAR;
    for (;;) {
        const bool has_next = S.next(ui + 1, nxt);
        const char* nA = cA; const char* nB = cB;
        if (has_next) { nA = S.a_base(nxt); nB = S.b_base(nxt); }
        for (int t = 0; t < nt; t += 2) {
            const bool last = (t == nt - 2);
            const char* a1 = cA + (size_t)(t + 1) * kstep;
            const char* a2 = last ? nA : cA + (size_t)(t + 2) * kstep; const char* b2 = last ? nB : cB + (size_t)(t + 2) * kstep;
            const char* a3 = a2 + kstep; const char* b3 = b2 + kstep;
            PG8_LDB(B0, 0, 0); PG8_LDB(B1, 0, 1); PG8_SCHED; PG8_LDA(At, 0, 0); PG8_STAGE_AH(PG8_SA(1, 1), a1, vA, 1);
            if constexpr (GA) { if (last && has_next) S.a_off(nxt, tid, vA); }
            PG8_WAIT_V(8); PG8_WAIT_L(0); PG8_BAR; PG8_MMA(0, 0, At, B0); PG8_MMA(0, 1, At, B1); PG8_BAR; PG8_SCHED;
            PG8_LDA(At, 0, 1); PG8_STAGE_B(PG8_SB(0, 0), b2); PG8_STAGE_B(PG8_SB(0, 1), b2 + hstepB); PG8_STAGE_AH(PG8_SA(0, 0), a2, vA, 0);
            PG8_WAIT_V(8); PG8_WAIT_L(0); PG8_BAR; PG8_MMA(1, 0, At, B0); PG8_MMA(1, 1, At, B1); PG8_BAR; PG8_SCHED;
            PG8_LDB(B0, 1, 0); PG8_LDB(B1, 1, 1); PG8_SCHED; PG8_LDA(At, 1, 0); PG8_STAGE_AH(PG8_SA(0, 1), a2, vA, 1);
            PG8_WAIT_V(8); PG8_WAIT_L(0); PG8_BAR; PG8_MMA(0, 0, At, B0); PG8_MMA(0, 1, At, B1); PG8_BAR; PG8_SCHED;
            PG8_LDA(At, 1, 1); PG8_STAGE_B(PG8_SB(1, 0), b3); PG8_STAGE_B(PG8_SB(1, 1), b3 + hstepB); PG8_STAGE_AH(PG8_SA(1, 0), a3, vA, 0);
            PG8_WAIT_V(8); PG8_WAIT_L(0); PG8_BAR; PG8_MMA(1, 0, At, B0); PG8_MMA(1, 1, At, B1); PG8_BAR; PG8_SCHED;
        }
        if (wr == 0) PG8_BAR;
        { int fr_ = fr, fq_ = fq; asm volatile("" : "+v"(fr_), "+v"(fq_)); E(acc, cur, wr, wc, fr_, fq_); }
        if (!has_next) break;
#pragma unroll
        for (int a = 0; a < 2; ++a)
#pragma unroll
            for (int b = 0; b < 2; ++b)
#pragma unroll
                for (int m = 0; m < 4; ++m)
#pragma unroll
                    for (int n = 0; n < 2; ++n) acc[a][b][m][n] = (f32x4){0.f, 0.f, 0.f, 0.f};
        cur = nxt; cA = nA; cB = nB; ++ui;
        if (wr == 1) PG8_BAR;
    }
    PG8_WAIT_V(0);
    PG8_BAR;
#undef PG8_SA
#undef PG8_SB
#undef PG8_STAGE_A
#undef PG8_STAGE_AH
#undef PG8_STAGE_B
#undef PG8_LDA
#undef PG8_LDB
#undef PG8_MMA
#undef PG8_CAT
#undef PG8_FOFF
#undef PG8_WAIT_V
#undef PG8_WAIT_L
#undef PG8_BAR
#undef PG8_SCHED
}
}
struct Args { const float* in[N_IN]; float* out; unsigned char* ws; int ph_lo, ph_hi; };
typedef const __attribute__((address_space(4))) unsigned long long* karg_t;
struct Frame {
    karg_t ka;
    LAS unsigned char* lds;
    volatile LAS unsigned* MISC;
    gu32* ctl;
    unsigned char* ws;
    float* out;
    int tid, lane, wave, vcu, G;
};
#define WSP(T_, off) ((T_*)(F.ws + (off)))
#define KIN(k) ((const float*)F.ka[(k)])
#ifdef DBG_SEL
#define DBG_STAT(k, val) do { const float _v = (val); if ((k) == DBG_SEL) { if (fabsf(_v) < 3e38f) atomicMax((unsigned*)(F.ctl + CW_DBG), __float_as_uint(fabsf(_v))); else atomicAdd((unsigned*)(F.ctl + CW_DBG + 1), 1u); } } while (0)
#else
#define DBG_STAT(k, val) do { } while (0)
#endif
template <class P> __device__ __forceinline__ P launder_uniform(P p) {
    unsigned lo = (unsigned)(unsigned long long)p, hi = (unsigned)((unsigned long long)p >> 32);
    asm volatile("" : "+v"(lo), "+v"(hi));
    lo = __builtin_amdgcn_readfirstlane(lo); hi = __builtin_amdgcn_readfirstlane(hi);
    return (P)(((unsigned long long)hi << 32) | lo);
}
__device__ __forceinline__ void frame_refresh(Frame& F) {
    int t = F.tid; asm volatile("" : "+v"(t)); F.tid = t; F.lane = t & 63; F.wave = __builtin_amdgcn_readfirstlane(t >> 6);
    F.ws = launder_uniform(F.ws); F.ctl = (gu32*)(F.ws + WS_CTL);
    F.out = launder_uniform(F.out);
    F.ka = launder_uniform(F.ka);
}

namespace pg8 {
struct DenseSched {
    static constexpr bool GATHER = false, FP8 = false; static constexpr int scaleA = 0, scaleB = 0;
    struct Unit { int pm, pn; };
    const bf16* A; const bf16* Bt; int K; size_t hstepB; int nM, nN, nwg, G, c;
    __device__ __forceinline__ void init(const bf16* A_, const bf16* Bt_, int M, int N, int K_, int G_, int c_) { A = A_; Bt = Bt_; K = K_; hstepB = (size_t)HALF * K_ * 2; nM = M / BM; nN = N / BM; nwg = nM * nN; G = G_; c = c_; }
    __device__ __forceinline__ bool next(int i, Unit& u) const {
        const long L = (long)i * G + c; if (L >= nwg) return false;
        int wgid = (int)L; { const int q = nwg / NXCD, r = nwg % NXCD, xcd = wgid % NXCD, off = wgid / NXCD; wgid = (xcd < r ? xcd * (q + 1) : r * (q + 1) + (xcd - r) * q) + off; }
        const int nig = WGM * nN, gid = wgid / nig, fm = gid * WGM, gsz = (nM - fm) < WGM ? (nM - fm) : WGM;
        u.pm = fm + ((wgid % nig) % gsz); u.pn = (wgid % nig) / gsz; return true;
    }
    __device__ __forceinline__ const char* a_base(const Unit& u) const { return (const char*)A + (size_t)u.pm * BM * K * 2; }
    __device__ __forceinline__ const char* b_base(const Unit& u) const { return (const char*)Bt + (size_t)u.pn * BM * K * 2; }
    __device__ __forceinline__ void a_off(const Unit&, int tid, unsigned (&v)[2][2]) const {
#pragma unroll
        for (int i = 0; i < 2; ++i) { int R, C; stage_rc(tid * 16 + i * 8192, R, C); v[0][i] = (unsigned)(R * K + C) * 2u; v[1][i] = v[0][i]; }
    }
};
struct MoeUnit { int e, mt, nt, cnt; };
struct MoeOrder {
    const volatile LAS unsigned* pfx;
    int NT, G, c;
    __device__ __forceinline__ bool decode(int i, MoeUnit& u) const {
        const int nwg = (int)pfx[32]; const long L = (long)i * G + c; if (L >= nwg) return false;
        int wgid = (int)L; { const int q = nwg / NXCD, r = nwg % NXCD, xcd = wgid % NXCD, off = wgid / NXCD; wgid = (xcd < r ? xcd * (q + 1) : r * (q + 1) + (xcd - r) * q) + off; }
        int e = 0;
#pragma unroll
        for (int st = 16; st >= 1; st >>= 1) e += ((int)pfx[e + st] <= wgid) ? st : 0;
        const int j = wgid - (int)pfx[e];
        u.e = e; u.mt = j / NT; u.nt = j % NT; u.cnt = (int)pfx[40 + e]; return true;
    }
};
struct Moe1Sched {
    static constexpr bool GATHER = true, FP8 = (MOE_FP8 != 0); static constexpr int EB = FP8 ? 1 : 2; static constexpr int scaleA = 0x7F7F7F7F, scaleB = 0x7A7A7A7A;
    typedef MoeUnit Unit;
    MoeOrder O; const unsigned char* X; const unsigned char* W; const int* sdest; int K; size_t hstepB;
    __device__ __forceinline__ bool next(int i, Unit& u) const { return O.decode(i, u); }
    __device__ __forceinline__ const char* a_base(const Unit&) const { return (const char*)X; }
    __device__ __forceinline__ const char* b_base(const Unit& u) const { return (const char*)W + ((size_t)u.e * 2048 + (size_t)u.nt * 128) * 1024 * EB; }
    __device__ __forceinline__ void a_off(const Unit& u, int tid, unsigned (&v)[2][2]) const {
#pragma unroll
        for (int i = 0; i < 2; ++i) { int R, C; stage_rc(tid * 16 + i * 8192, R, C);
#pragma unroll
            for (int h = 0; h < 2; ++h) { const int slot = u.mt * 256 + h * HALF + R; int tok = 0; if (slot < u.cnt) tok = sdest[u.e * ECAP + slot] >> 2; v[h][i] = (unsigned)(tok * 1024 * EB + C * 2); } }
    }
};
struct Moe2Sched {
    static constexpr bool GATHER = true, FP8 = (MOE2_FP8 != 0); static constexpr int EB = FP8 ? 1 : 2; static constexpr int scaleA = 0x7F7F7F7F, scaleB = 0x79797979;
    typedef MoeUnit Unit;
    MoeOrder O; const unsigned char* Ab; const unsigned char* W; int K; size_t hstepB;
    __device__ __forceinline__ bool next(int i, Unit& u) const { return O.decode(i, u); }
    __device__ __forceinline__ const char* a_base(const Unit& u) const { return (const char*)Ab + ((size_t)u.e * ECAP + (size_t)u.mt * 256) * 1024 * EB; }
    __device__ __forceinline__ const char* b_base(const Unit& u) const { return (const char*)W + ((size_t)u.e * 1024 + (size_t)u.nt * 256) * 1024 * EB; }
    __device__ __forceinline__ void a_off(const Unit&, int tid, unsigned (&v)[2][2]) const {
        int t_ = tid; asm volatile("" : "+v"(t_));
#pragma unroll
        for (int i = 0; i < 2; ++i) { int R, C; stage_rc(t_ * 16 + i * 8192, R, C); v[0][i] = (unsigned)(R * 1024 * EB + C * 2); v[1][i] = v[0][i] + (unsigned)(HALF * 1024 * EB); }
    }
};

__device__ __forceinline__ void unpack8(const v4u w, f32x4& a, f32x4& b) {
    a = (f32x4){__uint_as_float(w.x << 16), __uint_as_float(w.x & 0xffff0000u), __uint_as_float(w.y << 16), __uint_as_float(w.y & 0xffff0000u)};
    b = (f32x4){__uint_as_float(w.z << 16), __uint_as_float(w.z & 0xffff0000u), __uint_as_float(w.w << 16), __uint_as_float(w.w & 0xffff0000u)}; }
struct EpiF32 {
    static constexpr bool PERM = false;
    float* C; int ldc; const float* base; float alpha;
    __device__ __forceinline__ void operator()(const f32x4 (&acc)[2][2][4][2], const DenseSched::Unit& u, int wr, int wc, int fr, int fq) const {
        const int row0 = u.pm * BM + wr * 64 + fr, col0 = u.pn * BM + wc * 32 + 4 * fq;
#pragma unroll
        for (int ai = 0; ai < 2; ++ai)
#pragma unroll
            for (int m = 0; m < 4; ++m) { const size_t ro = (size_t)(row0 + ai * HALF + m * 16) * ldc + col0;
#pragma unroll
                for (int bj = 0; bj < 2; ++bj)
#pragma unroll
                    for (int n = 0; n < 2; ++n) { f32x4 v = acc[ai][bj][m][n];
                        if (base) { const f32x4 b = *(const f32x4*)(base + ro + bj * HALF + n * 16); v = v + b * alpha; }
                        *(f32x4*)(C + ro + bj * HALF + n * 16) = v; } }
    }
};
struct EpiB16 {
    static constexpr bool PERM = true;
    bf16* O; int ldc; const bf16* base; float alpha;
    __device__ __forceinline__ void operator()(const f32x4 (&acc)[2][2][4][2], const DenseSched::Unit& u, int wr, int wc, int fr, int fq) const {
        const int row0 = u.pm * BM + wr * 64 + fr, col0 = u.pn * BM + wc * 32 + 8 * fq;
#pragma unroll
        for (int ai = 0; ai < 2; ++ai) {
            v4u bw[4][2];
            if (base) {
#pragma unroll
                for (int m = 0; m < 4; ++m)
#pragma unroll
                    for (int bj = 0; bj < 2; ++bj) bw[m][bj] = *(const v4u*)(base + (size_t)(row0 + ai * HALF + m * 16) * ldc + col0 + bj * HALF); }
#pragma unroll
            for (int m = 0; m < 4; ++m) { bf16* rowp = O + (size_t)(row0 + ai * HALF + m * 16) * ldc + col0;
#pragma unroll
                for (int bj = 0; bj < 2; ++bj) { f32x4 v0 = acc[ai][bj][m][0], v1 = acc[ai][bj][m][1];
                    if (base) { f32x4 b0, b1; unpack8(bw[m][bj], b0, b1); v0 = v0 + b0 * alpha; v1 = v1 + b1 * alpha; }
                    v4u w; w.x = cvt_pk_bf16(v0[0], v0[1]); w.y = cvt_pk_bf16(v0[2], v0[3]); w.z = cvt_pk_bf16(v1[0], v1[1]); w.w = cvt_pk_bf16(v1[2], v1[3]);
                    *(v4u*)(rowp + bj * HALF) = w; } } }
    }
};
struct EpiPle {
    static constexpr bool PERM = true;
    bf16* C; const bf16* hb; const bf16* pe;
    __device__ __forceinline__ void operator()(const f32x4 (&acc)[2][2][4][2], const DenseSched::Unit& u, int wr, int wc, int fr, int fq) const {
        const int row0 = u.pm * BM + wr * 64 + fr, col0 = u.pn * BM + wc * 32 + 8 * fq;
#pragma unroll
        for (int ai = 0; ai < 2; ++ai) {
            v4u hw[4][2], pw[4][2];
#pragma unroll
            for (int m = 0; m < 4; ++m)
#pragma unroll
                for (int bj = 0; bj < 2; ++bj) { const size_t ro = (size_t)(row0 + ai * HALF + m * 16) * 1024 + col0 + bj * HALF; hw[m][bj] = *(const v4u*)(hb + ro); pw[m][bj] = *(const v4u*)(pe + ro); }
#pragma unroll
            for (int m = 0; m < 4; ++m)
#pragma unroll
                for (int bj = 0; bj < 2; ++bj) { const size_t ro = (size_t)(row0 + ai * HALF + m * 16) * 1024 + col0 + bj * HALF;
                    f32x4 h0, h1, p0, p1; unpack8(hw[m][bj], h0, h1); unpack8(pw[m][bj], p0, p1); const f32x4 a0 = acc[ai][bj][m][0], a1 = acc[ai][bj][m][1];
                    f32x4 o0, o1;
#pragma unroll
                    for (int j = 0; j < 4; ++j) { o0[j] = h0[j] + sigmoidf_(a0[j]) * p0[j]; o1[j] = h1[j] + sigmoidf_(a1[j]) * p1[j]; }
                    v4u w; w.x = cvt_pk_bf16(o0[0], o0[1]); w.y = cvt_pk_bf16(o0[2], o0[3]); w.z = cvt_pk_bf16(o1[0], o1[1]); w.w = cvt_pk_bf16(o1[2], o1[3]);
                    *(v4u*)(C + ro) = w; } }
    }
};
struct EpiMoe1 {
    static constexpr bool PERM = true;
    bf16* Ab; const float* bgu; unsigned char* AbQ;
    __device__ __forceinline__ void operator()(const f32x4 (&acc)[2][2][4][2], const MoeUnit& u, int wr, int wc, int fr, int fq) const {
        const int col0 = u.nt * 128 + wc * 32 + 8 * fq;
        const float* bg = bgu + (size_t)u.e * 2048 + col0;
        const f32x4 bg0 = *(const f32x4*)(bg), bg1 = *(const f32x4*)(bg + 4), bl0 = *(const f32x4*)(bg + 1024), bl1 = *(const f32x4*)(bg + 1028);
#pragma unroll
        for (int ai = 0; ai < 2; ++ai)
#pragma unroll
            for (int m = 0; m < 4; ++m) { const int r = ai * HALF + wr * 64 + m * 16 + fr;
                bf16* rowp = Ab + ((size_t)u.e * ECAP + (size_t)u.mt * 256 + r) * 1024 + col0;
                float o[8];
#pragma unroll
                for (int n = 0; n < 2; ++n) { const f32x4 g4 = acc[ai][0][m][n] + (n ? bg1 : bg0), l4 = acc[ai][1][m][n] + (n ? bl1 : bl0);
#pragma unroll
                    for (int j = 0; j < 4; ++j) { const float g = fminf(g4[j], 7.0f), l = fminf(fmaxf(l4[j], -7.0f), 7.0f); o[n * 4 + j] = (l + 1.0f) * g * sigmoidf_(1.702f * g); } }
                if constexpr (MOE2_FP8) { v2u q; q.x = cvt4_fp8(o[0], o[1], o[2], o[3]); q.y = cvt4_fp8(o[4], o[5], o[6], o[7]); *(v2u*)((unsigned char*)AbQ + ((size_t)u.e * ECAP + (size_t)u.mt * 256 + r) * 1024 + col0) = q; }
                else *(v4u*)rowp = pack8(o); }
    }
};
struct EpiMoe2 {
    static constexpr bool PERM = true;
    bf16* Y; const float* bdn; const int* sdest; const float* sgate;
    __device__ __forceinline__ void operator()(const f32x4 (&acc)[2][2][4][2], const MoeUnit& u, int wr, int wc, int fr, int fq) const {
        const int col0 = u.nt * 256 + wc * 32 + 8 * fq;
        const float* bp = bdn + (size_t)u.e * 1024 + col0;
#pragma unroll
        for (int ai = 0; ai < 2; ++ai) {
            f32x4 bv[2][2];
#pragma unroll
            for (int bj = 0; bj < 2; ++bj)
#pragma unroll
                for (int n = 0; n < 2; ++n) bv[bj][n] = *(const f32x4*)(bp + bj * HALF + 4 * n);
            int dest[4]; float gate[4];
#pragma unroll
            for (int m = 0; m < 4; ++m) { const int slot = u.mt * 256 + ai * HALF + wr * 64 + m * 16 + fr; const bool ok = slot < u.cnt; const int si = u.e * ECAP + (ok ? slot : 0);
                dest[m] = ok ? sdest[si] : T * 4; gate[m] = sgate[si]; }
#pragma unroll
            for (int m = 0; m < 4; ++m) {
                { const float g = gate[m]; bf16* rowp = Y + (size_t)dest[m] * 1024 + col0;
#pragma unroll
                    for (int bj = 0; bj < 2; ++bj) { const f32x4 v0 = (acc[ai][bj][m][0] + bv[bj][0]) * g, v1 = (acc[ai][bj][m][1] + bv[bj][1]) * g;
                        v4u w; w.x = cvt_pk_bf16(v0[0], v0[1]); w.y = cvt_pk_bf16(v0[2], v0[3]); w.z = cvt_pk_bf16(v1[0], v1[1]); w.w = cvt_pk_bf16(v1[2], v1[3]);
                        *(v4u*)(rowp + bj * HALF) = w; } } } }
    }
};
}

__device__ __forceinline__ void p0_transpose_item(const float* W, int K, int N, int nblk, bf16* WT, int item, int lane) {
    const int kb = item / nblk, nb = item % nblk, k0 = 64 * kb, n = 64 * nb + lane;
    const bool ok = n < N; const float* src = W + (size_t)k0 * N + (ok ? n : 0);
    float x[64];
#pragma unroll
    for (int j = 0; j < 64; ++j) x[j] = __builtin_nontemporal_load(src + (size_t)j * N);
    bf16* dst = WT + (size_t)n * K + k0;
#pragma unroll
    for (int q = 0; q < 8; ++q) { v4u o; o.x = cvt_pk_bf16(x[8 * q], x[8 * q + 1]); o.y = cvt_pk_bf16(x[8 * q + 2], x[8 * q + 3]); o.z = cvt_pk_bf16(x[8 * q + 4], x[8 * q + 5]); o.w = cvt_pk_bf16(x[8 * q + 6], x[8 * q + 7]);
        if (!ok) o = (v4u){0u, 0u, 0u, 0u};
        *(v4u*)(dst + 8 * q) = o; }
}
__device__ __forceinline__ void cvt_rows(const float* src, bf16* dst, size_t n8, size_t i0, size_t stride) {
    for (size_t i = i0; i < n8; i += stride) { const f32x4 a = *(const f32x4*)(src + i * 8), b = *(const f32x4*)(src + i * 8 + 4);
        v4u o; o.x = cvt_pk_bf16(a.x, a.y); o.y = cvt_pk_bf16(a.z, a.w); o.z = cvt_pk_bf16(b.x, b.y); o.w = cvt_pk_bf16(b.z, b.w); *(v4u*)(dst + i * 8) = o; }
}
__device__ __forceinline__ void p0_prologue(Frame& F, const Args& A) {
    const int gw = F.vcu * NWAVES + F.wave, NGW = F.G * NWAVES;
    constexpr int I_IN = 16 * (NUP / 64), I_OUT = 16 * 16, I_GU = 16 * 32, I_DN = 16 * 16, I_PG = 16 * 16, I_PP = 4 * 16;
    constexpr int PER_LAYER = I_IN + I_OUT + NE * I_GU + NE * I_DN + I_PG + I_PP;
#pragma unroll 1
    for (int it = gw; it < DEPTH * PER_LAYER; it += NGW) {
        const int l = it / PER_LAYER; int r = it % PER_LAYER;
        const float* W; bf16* WT; int K = D, N = D, nblk = 16;
        if (r < I_IN) { W = KIN(I_WIN) + (size_t)l * D * NU; WT = WSP(bf16, WS_WIN_T) + (size_t)l * NUP * D; N = NU; nblk = NUP / 64; }
        else if ((r -= I_IN) < I_OUT) { W = KIN(I_WOUT) + (size_t)l * D * D; WT = WSP(bf16, WS_WOUT_T) + (size_t)l * D * D; }
        else if ((r -= I_OUT) < NE * I_GU) { if (MOE_FP8) continue; const int e = r / I_GU; r %= I_GU; W = KIN(I_WGU) + ((size_t)l * NE + e) * D * 2048; WT = WSP(bf16, WS_WGU_T) + ((size_t)l * NE + e) * 2048 * D; N = 2048; nblk = 32; }
        else if ((r -= NE * I_GU) < NE * I_DN) { if (MOE2_FP8) continue; const int e = r / I_DN; r %= I_DN; W = KIN(I_WDN) + ((size_t)l * NE + e) * D * D; WT = WSP(bf16, WS_WDN_T) + ((size_t)l * NE + e) * D * D; }
        else if ((r -= NE * I_DN) < I_PG) { W = KIN(I_PGW) + (size_t)l * D * D; WT = WSP(bf16, WS_WPG_T) + (size_t)l * D * D; }
        else { r -= I_PG; W = KIN(I_PPJ) + (size_t)l * 256 * D; WT = WSP(bf16, WS_WPP_T) + (size_t)l * D * 256; K = 256; }
        p0_transpose_item(W, K, N, nblk, WT, r, F.lane);
    }
#if MOE_FP8
    constexpr int Q_GU = 16 * 32, Q_DN = 16 * 16, Q_PER_LAYER = NE * (Q_GU + Q_DN);
#pragma unroll 1
    for (int it = gw; it < DEPTH * Q_PER_LAYER; it += NGW) {
        const int l = it / Q_PER_LAYER; int r = it % Q_PER_LAYER; const float* W; unsigned char* WQ; int N; float sc;
        if (r < NE * Q_GU) { const int e = r / Q_GU; r %= Q_GU; W = KIN(I_WGU) + ((size_t)l * NE + e) * D * 2048; WQ = WSP(unsigned char, WS_WGU_Q) + ((size_t)l * NE + e) * 2048 * D; N = 2048; sc = 32.0f; }
        else { if (!MOE2_FP8) continue; r -= NE * Q_GU; const int e = r / Q_DN; r %= Q_DN; W = KIN(I_WDN) + ((size_t)l * NE + e) * D * D; WQ = WSP(unsigned char, WS_WDN_Q) + ((size_t)l * NE + e) * D * D; N = D; sc = 64.0f; }
        const int nblk = N / 64, kb = r / nblk, nb = r % nblk, k0 = 64 * kb, n = 64 * nb + F.lane;
        const float* src = W + (size_t)k0 * N + n; float x[64];
#pragma unroll
        for (int j = 0; j < 64; ++j) x[j] = __builtin_nontemporal_load(src + (size_t)j * N) * sc;
        unsigned char* dst = WQ + (size_t)n * D + k0;
#pragma unroll
        for (int q = 0; q < 4; ++q) { v4u o; o.x = cvt4_fp8(x[16 * q], x[16 * q + 1], x[16 * q + 2], x[16 * q + 3]); o.y = cvt4_fp8(x[16 * q + 4], x[16 * q + 5], x[16 * q + 6], x[16 * q + 7]);
            o.z = cvt4_fp8(x[16 * q + 8], x[16 * q + 9], x[16 * q + 10], x[16 * q + 11]); o.w = cvt4_fp8(x[16 * q + 12], x[16 * q + 13], x[16 * q + 14], x[16 * q + 15]); *(v4u*)(dst + 16 * q) = o; }
    }
#endif
    const size_t gt = (size_t)F.vcu * (NWAVES * 64) + F.tid, NT_ = (size_t)F.G * NWAVES * 64;
    cvt_rows(KIN(I_P), WSP(bf16, WS_PB), (size_t)DEPTH * T * 256 / 8, gt, NT_);
    cvt_rows(KIN(I_X), WSP(bf16, WS_XB), (size_t)T * D / 8, gt, NT_);
    for (size_t i = gt; i < (size_t)DEPTH * LORA_PER_LAYER; i += NT_) { const int l = (int)(i / LORA_PER_LAYER); int r = (int)(i % LORA_PER_LAYER); float v;
        if (r < 8192) { const int ch = r >> 5, j = r & 31; v = KIN(I_RWUP)[(size_t)l * 8192 + j * 256 + ch]; }
        else if (r < 16384) { r -= 8192; const int ch = r >> 5, j = r & 31; v = KIN(I_RAUP)[(size_t)l * 8192 + j * 256 + ch]; }
        else if (r < 32768) { r -= 16384; const int ch = r >> 6, j = r & 63; v = KIN(I_RGUP)[(size_t)l * 16384 + j * 256 + ch]; }
        else { r -= 32768; const int d = r >> 4, j = r & 15; v = KIN(I_GGUP)[(size_t)l * 2048 + j * 128 + d]; }
        WSP(float, WS_LORA)[i] = v; }
    for (size_t i = gt; i < (size_t)DEPTH * NE * D; i += NT_) { const int l = (int)(i / (NE * D)), r = (int)(i % (NE * D)), e = r / D, k = r % D; WSP(float, WS_RWT)[i] = KIN(I_RTW)[(size_t)l * D * NE + (size_t)k * NE + e]; }
}

template <bool DRY> __device__ __forceinline__ void p6_ln1_router(Frame& F, const Args& A, int layer) {
    const bf16* y1 = WSP(bf16, WS_Y1); bf16* x1b = WSP(bf16, WS_X1B);
    const float* g = KIN(I_LN1G) + layer * D; const float* bb = KIN(I_LN1B) + layer * D;
    const float* rwt = WSP(float, WS_RWT) + (size_t)layer * NE * D; const float* rb = KIN(I_RTB) + layer * NE;
    int* sdest = WSP(int, WS_SDEST); float* sgate = WSP(float, WS_SGATE);
    unsigned* cnt = (unsigned*)(F.ctl + CW_CNT + layer * NE * 16);
    LAS float* RWT = (LAS float*)F.lds;
    LAS float* TOPV = (LAS float*)(F.lds + 131072) + F.wave * 64;
    LAS int* TOPE = (LAS int*)(F.lds + 131072 + 2048) + F.wave * 64;
    volatile LAS unsigned* lcnt = F.MISC + MW_LCNT; volatile LAS unsigned* lbase = F.MISC + MW_LBASE;
    for (int i = F.tid; i < NE * D / 4; i += NWAVES * 64) ((LAS f32x4*)RWT)[i] = ((const f32x4*)rwt)[i];
    const int lane = F.lane, sub = lane & 15;
    for (int blk = F.vcu; blk < T / 64; blk += F.G) {
        if (F.tid < 32) lcnt[F.tid] = 0u;
        __syncthreads();
#pragma unroll 1
        for (int rg = 0; rg < 2; ++rg) {
            f32x4 v[4][4];
            { int lo_ = lane; asm volatile("" : "+v"(lo_));
              const f32x4 gv[4] = { *(const f32x4*)(g + 4 * lo_), *(const f32x4*)(g + 256 + 4 * lo_), *(const f32x4*)(g + 512 + 4 * lo_), *(const f32x4*)(g + 768 + 4 * lo_) };
              const f32x4 bv[4] = { *(const f32x4*)(bb + 4 * lo_), *(const f32x4*)(bb + 256 + 4 * lo_), *(const f32x4*)(bb + 512 + 4 * lo_), *(const f32x4*)(bb + 768 + 4 * lo_) };
#pragma unroll
              for (int r = 0; r < 4; ++r) { const int row = blk * 64 + F.wave * 8 + rg * 4 + r; const bf16* yr = y1 + (size_t)row * D; float s = 0.f;
#pragma unroll
                  for (int j = 0; j < 4; ++j) { const v2u w = *(const v2u*)(yr + 256 * j + 4 * lane); v[r][j] = (f32x4){__uint_as_float(w.x << 16), __uint_as_float(w.x & 0xffff0000u), __uint_as_float(w.y << 16), __uint_as_float(w.y & 0xffff0000u)}; s += (v[r][j].x + v[r][j].y) + (v[r][j].z + v[r][j].w); }
                  const float mean = wave_sum(s) * (1.f / D); float s2 = 0.f;
#pragma unroll
                  for (int j = 0; j < 4; ++j) { v[r][j] = v[r][j] - mean; s2 += (v[r][j].x * v[r][j].x + v[r][j].y * v[r][j].y) + (v[r][j].z * v[r][j].z + v[r][j].w * v[r][j].w); }
                  const float rstd = __builtin_amdgcn_rsqf(wave_sum(s2) * (1.f / D) + LN_EPS);
#pragma unroll
                  for (int j = 0; j < 4; ++j) { v[r][j] = v[r][j] * rstd * gv[j] + bv[j];
                      v2u o; o.x = cvt_pk_bf16(v[r][j].x, v[r][j].y); o.y = cvt_pk_bf16(v[r][j].z, v[r][j].w); *(v2u*)(x1b + (size_t)row * D + 256 * j + 4 * lane) = o;
                      if (MOE_FP8) *(unsigned*)(WSP(unsigned char, WS_X1Q) + (size_t)row * D + 256 * j + 4 * lane) = cvt4_fp8(v[r][j].x, v[r][j].y, v[r][j].z, v[r][j].w); } } }
            float lg[32];
#pragma unroll
            for (int e = 0; e < 32; ++e) { float p[4] = {0.f, 0.f, 0.f, 0.f};
#pragma unroll
                for (int j = 0; j < 4; ++j) { const f32x4 w = *(const LAS f32x4*)(RWT + e * D + 256 * j + 4 * lane);
#pragma unroll
                    for (int r = 0; r < 4; ++r) p[r] += (v[r][j].x * w.x + v[r][j].y * w.y) + (v[r][j].z * w.z + v[r][j].w * w.w); }
                { const bool hi = (lane & 32) != 0; const float k0 = hi ? p[2] : p[0], s0 = hi ? p[0] : p[2], k1 = hi ? p[3] : p[1], s1 = hi ? p[1] : p[3]; p[0] = k0 + __shfl_xor(s0, 32); p[1] = k1 + __shfl_xor(s1, 32); }
                { const bool hi = (lane & 16) != 0; const float k0 = hi ? p[1] : p[0], s0 = hi ? p[0] : p[1]; p[0] = k0 + __shfl_xor(s0, 16); }
                float t = p[0]; t += __shfl_xor(t, 8); t += __shfl_xor(t, 4); t += __shfl_xor(t, 2); t += __shfl_xor(t, 1);
                lg[e] = t + rb[e]; }
            float la = 0.f, lb_ = 0.f;
#pragma unroll
            for (int e = 0; e < 32; ++e) { if (e == 2 * sub) la = lg[e]; if (e == 2 * sub + 1) lb_ = lg[e]; }
            int ra = 0, rbk = 0;
#pragma unroll
            for (int e = 0; e < 32; ++e) { ra += (lg[e] > la || (lg[e] == la && e < 2 * sub)) ? 1 : 0; rbk += (lg[e] > lb_ || (lg[e] == lb_ && e < 2 * sub + 1)) ? 1 : 0; }
            const int rowl = rg * 4 + (lane >> 4);
            if (ra < 4) { TOPV[rowl * 4 + ra] = la; TOPE[rowl * 4 + ra] = 2 * sub; }
            if (rbk < 4) { TOPV[rowl * 4 + rbk] = lb_; TOPE[rowl * 4 + rbk] = 2 * sub + 1; }
        }
        LDS_WAIT();
        int my_e = 0; float my_g = 0.f; unsigned my_r = 0u;
        if (lane < 32) { const int ri = lane >> 2, k = lane & 3; const f32x4 tv = *(const LAS f32x4*)(TOPV + ri * 4);
            const float e1 = __expf(tv.y - tv.x), e2 = __expf(tv.z - tv.x), e3 = __expf(tv.w - tv.x); const float inv = __builtin_amdgcn_rcpf(1.0f + e1 + e2 + e3);
            my_e = TOPE[ri * 4 + k]; my_g = (k == 0 ? 1.0f : k == 1 ? e1 : k == 2 ? e2 : e3) * inv;
            my_r = DRY ? 0u : atomicAdd((unsigned*)&lcnt[my_e], 1u); }
        __syncthreads();
        if (!DRY && F.tid < 32) { const unsigned n = lcnt[F.tid]; lbase[F.tid] = n ? __hip_atomic_fetch_add(cnt + F.tid * 16, n, RLX_AGENT) : 0u; }
        __syncthreads();
        if (!DRY && lane < 32) { const int row = blk * 64 + F.wave * 8 + (lane >> 2); const unsigned slot = (unsigned)my_e * ECAP + lbase[my_e] + my_r;
            sdest[slot] = row * 4 + (lane & 3); sgate[slot] = my_g; }
        __syncthreads();
    }
}
__device__ __forceinline__ void p9_combine(Frame& F, const Args& A) {
    const bf16* x1b = WSP(bf16, WS_X1B); const bf16* yb = WSP(bf16, WS_YBUF); bf16* hb = WSP(bf16, WS_HB);
    const int gw = F.vcu * NWAVES + F.wave, NGW = F.G * NWAVES, lane = F.lane;
    for (int row = gw; row < T; row += NGW) {
        v4u y[4][2], xw[2];
#pragma unroll
        for (int j = 0; j < 2; ++j) {
#pragma unroll
            for (int k = 0; k < 4; ++k) y[k][j] = *(const v4u*)(yb + ((size_t)row * 4 + k) * D + 512 * j + 8 * lane);
            xw[j] = *(const v4u*)(x1b + (size_t)row * D + 512 * j + 8 * lane); }
#pragma unroll
        for (int j = 0; j < 2; ++j) { f32x4 v0, v1; pg8::unpack8(xw[j], v0, v1); v0 = v0 * DN_ALPHA; v1 = v1 * DN_ALPHA;
#pragma unroll
            for (int k = 0; k < 4; ++k) { f32x4 a, b; pg8::unpack8(y[k][j], a, b); v0 = v0 + a; v1 = v1 + b; }
            v4u wv; wv.x = cvt_pk_bf16(v0.x, v0.y); wv.y = cvt_pk_bf16(v0.z, v0.w); wv.z = cvt_pk_bf16(v1.x, v1.y); wv.w = cvt_pk_bf16(v1.z, v1.w); *(v4u*)(hb + (size_t)row * D + 512 * j + 8 * lane) = wv; }
    }
}
__device__ __forceinline__ void p11_ln2(Frame& F, const Args& A, int layer) {
    const bf16* h2 = WSP(bf16, WS_H2); bf16* xb = WSP(bf16, WS_XB);
    const float* g = KIN(I_LN2G) + layer * D; const float* bb = KIN(I_LN2B) + layer * D;
    const int gw = F.vcu * NWAVES + F.wave, NGW = F.G * NWAVES, lane = F.lane;
    for (int row = gw; row < T; row += NGW) {
        const bf16* yr = h2 + (size_t)row * D; f32x4 v[4]; float s = 0.f;
#pragma unroll
        for (int j = 0; j < 4; ++j) { const v2u w = *(const v2u*)(yr + 256 * j + 4 * lane); v[j] = (f32x4){__uint_as_float(w.x << 16), __uint_as_float(w.x & 0xffff0000u), __uint_as_float(w.y << 16), __uint_as_float(w.y & 0xffff0000u)}; s += (v[j].x + v[j].y) + (v[j].z + v[j].w); }
        const float mean = wave_sum(s) * (1.f / D); float s2 = 0.f;
#pragma unroll
        for (int j = 0; j < 4; ++j) { v[j] = v[j] - mean; s2 += (v[j].x * v[j].x + v[j].y * v[j].y) + (v[j].z * v[j].z + v[j].w * v[j].w); }
        const float rstd = __builtin_amdgcn_rsqf(wave_sum(s2) * (1.f / D) + LN_EPS);
#pragma unroll
        for (int j = 0; j < 4; ++j) { const f32x4 gv = *(const f32x4*)(g + 256 * j + 4 * lane), bv = *(const f32x4*)(bb + 256 * j + 4 * lane);
            const f32x4 o = v[j] * rstd * gv + bv; const size_t off = (size_t)row * D + 256 * j + 4 * lane;
            if (layer == DEPTH - 1) *(f32x4*)(F.out + off) = o; v2u w; w.x = cvt_pk_bf16(o.x, o.y); w.y = cvt_pk_bf16(o.z, o.w); *(v2u*)(xb + off) = w; }
    }
}
__device__ __forceinline__ void moe_build_pfx(Frame& F, const Args& A, int layer, int NT) {
    volatile LAS unsigned* pfx = F.MISC + MW_PFX;
    __syncthreads();
    if (F.tid < 64) {
        const int e = F.tid & 31;
        const unsigned c = __hip_atomic_load(F.ctl + CW_CNT + (layer * NE + e) * 16, RLX_AGENT);
        const unsigned un = ((c + 255u) >> 8) * (unsigned)NT; unsigned inc = un;
#pragma unroll
        for (int o = 1; o < 32; o <<= 1) { const unsigned t = (unsigned)my_shfl_up((int)inc, o); if (e >= o) inc += t; }
        if (F.tid < 32) { pfx[e] = inc - un; pfx[40 + e] = c; if (e == 31) pfx[32] = inc; }
    }
    __syncthreads();
}
#define UU(t, col) bf2f(u[(size_t)(t) * NUP + (col)])
#define UU4(t, col) ldu4(u + (size_t)(t) * NUP + (col))
__device__ __forceinline__ f32x4 ldu4(const bf16* p) { const v2u w = *(const v2u*)p; return (f32x4){__uint_as_float(w.x << 16), __uint_as_float(w.x & 0xffff0000u), __uint_as_float(w.y << 16), __uint_as_float(w.y & 0xffff0000u)}; }
__device__ __forceinline__ f32x4 ldb4(const bf16* p) { const v2u w = *(const v2u*)p; return (f32x4){__uint_as_float(w.x << 16), __uint_as_float(w.x & 0xffff0000u), __uint_as_float(w.y << 16), __uint_as_float(w.y & 0xffff0000u)}; }
__device__ __forceinline__ void stb4(bf16* p, f32x4 v) { v2u o; o.x = cvt_pk_bf16(v.x, v.y); o.y = cvt_pk_bf16(v.z, v.w); *(v2u*)p = o; }
__device__ __forceinline__ void lds_st_bf16(LAS unsigned char* p, float v) { *(LAS unsigned short*)p = (unsigned short)(cvt_pk_bf16(v, 0.f) & 0xffffu); }
__device__ __forceinline__ void lds_st_bf16x4(LAS unsigned char* p, float a, float b, float c, float d) { v2u o; o.x = cvt_pk_bf16(a, b); o.y = cvt_pk_bf16(c, d); *(LAS v2u*)p = o; }

__device__ __forceinline__ void ssd_stage1(Frame& F, const Args& A, int layer, int b, int c) {
    const bf16* u = WSP(bf16, WS_U);
    LAS unsigned char* L = F.lds;
    LAS float* DT = (LAS float*)L; LAS float* AC = DT + 256;
    LAS unsigned char* BMT = L + 2048; LAS unsigned char* XCDT = BMT + 128 * 144;
    const int t0 = b * SEQ + c * 64, tid = F.tid, lane = F.lane, wave = F.wave;
    if (wave < 4) {
        const int hh = wave;
        const float dt = softplusf_(UU(t0 + lane, U_SSD_DT + hh) + KIN(I_SDTB)[layer * 4 + hh]);
        const float adt = -dt * __expf(KIN(I_SALOG)[layer * 4 + hh]);
        const float ac = wave_scan_add(adt, lane);
        DT[hh * 64 + lane] = dt; AC[hh * 64 + lane] = ac;
        if (lane == 63) WSP(float, WS_SSD_DEC)[(b * 4 + hh) * NCH + c] = __expf(ac);
    }
    __syncthreads();
    if (tid < 384) {
        const int cc = tid; const float* cw = KIN(I_SCW) + (size_t)layer * 2048 + cc; const float w0 = cw[0], w1 = cw[512], w2 = cw[1024], w3 = cw[1536], cb = KIN(I_SCB)[layer * 512 + cc];
        const bf16* up = u + (size_t)t0 * NUP + U_SSD_X + cc;
        float win0 = 0.f, win1 = 0.f, win2 = 0.f;
        if (c > 0) { win0 = bf2f(up[-3 * NUP]); win1 = bf2f(up[-2 * NUP]); win2 = bf2f(up[-1 * NUP]); }
        const int hh = (cc >> 6) & 3; const bool isx = cc < 256;
        LAS unsigned char* dst = isx ? XCDT + cc * 144 : BMT + (cc - 256) * 144;
        const float aclast = AC[hh * 64 + 63];
#pragma unroll 1
        for (int l0 = 0; l0 < 64; l0 += 32) {
            float xv[32];
#pragma unroll
            for (int j = 0; j < 32; ++j) xv[j] = bf2f(up[(l0 + j) * NUP]);
#pragma unroll
            for (int j8 = 0; j8 < 4; ++j8) { float o[8];
#pragma unroll
                for (int j = 0; j < 8; ++j) { const int l = l0 + j8 * 8 + j; const float x = xv[j8 * 8 + j]; const float y = cb + w0 * win0 + w1 * win1 + w2 * win2 + w3 * x; win0 = win1; win1 = win2; win2 = x;
                    float s = siluf_(y); if (isx) s *= DT[hh * 64 + l] * __expf(aclast - AC[hh * 64 + l]); o[j] = s; }
                *(LAS v4u*)(dst + (l0 + j8 * 8) * 2) = pack8(o); }
        }
    }
    __syncthreads();
    { const int fr = lane & 15, fq = lane >> 4; bf16* st = WSP(bf16, WS_SSD_ST);
#pragma unroll 1
      for (int i = 0; i < 2; ++i) { const int row0 = (2 * wave + i) * 16; const int hh = row0 >> 6, p = (row0 & 63) + fr;
          bf16* dstp = st + (((size_t)(b * 4 + hh) * NCH + c) * 64 + p) * 128;
#pragma unroll 1
          for (int ntl = 0; ntl < 8; ++ntl) { f32x4 acc = {0.f, 0.f, 0.f, 0.f}; acc = mm16(XCDT + row0 * 144, 144, BMT + ntl * 16 * 144, 144, 64, acc, fr, fq);
              stb4(dstp + ntl * 16 + 4 * fq, acc); } } }
    __syncthreads();
}
__device__ __forceinline__ void ssd_stage3(Frame& F, const Args& A, int layer, int b, int c) {
    const bf16* u = WSP(bf16, WS_U);
    LAS unsigned char* L = F.lds;
    LAS float* DT = (LAS float*)L; LAS float* AC = DT + 256;
    LAS unsigned char* CM = L + 2048; LAS unsigned char* BM = CM + 64 * 272; LAS unsigned char* XCT = BM + 64 * 272; LAS unsigned char* MM = XCT + 256 * 144;
    LAS unsigned char* YG = XCT;
    const int t0 = b * SEQ + c * 64, tid = F.tid, lane = F.lane, wave = F.wave, fr = lane & 15, fq = lane >> 4;
    if (wave < 4) {
        const int hh = wave;
        const float dt = softplusf_(UU(t0 + lane, U_SSD_DT + hh) + KIN(I_SDTB)[layer * 4 + hh]);
        const float adt = -dt * __expf(KIN(I_SALOG)[layer * 4 + hh]);
        DT[hh * 64 + lane] = dt; AC[hh * 64 + lane] = wave_scan_add(adt, lane);
    }
    __syncthreads();
    {
        const int cc = tid; const float* cw = KIN(I_SCW) + (size_t)layer * 2048 + cc; const float w0 = cw[0], w1 = cw[512], w2 = cw[1024], w3 = cw[1536], cb = KIN(I_SCB)[layer * 512 + cc];
        const bf16* up = u + (size_t)t0 * NUP + U_SSD_X + cc;
        float win0 = 0.f, win1 = 0.f, win2 = 0.f;
        if (c > 0) { win0 = bf2f(up[-3 * NUP]); win1 = bf2f(up[-2 * NUP]); win2 = bf2f(up[-1 * NUP]); }
        const int hh = (cc >> 6) & 3;
#pragma unroll 1
        for (int l0 = 0; l0 < 64; l0 += 32) {
            float xv[32];
#pragma unroll
            for (int j = 0; j < 32; ++j) xv[j] = bf2f(up[(l0 + j) * NUP]);
#pragma unroll
            for (int j8 = 0; j8 < 4; ++j8) { float o[8];
#pragma unroll
                for (int j = 0; j < 8; ++j) { const int l = l0 + j8 * 8 + j; const float x = xv[j8 * 8 + j]; const float y = cb + w0 * win0 + w1 * win1 + w2 * win2 + w3 * x; win0 = win1; win1 = win2; win2 = x;
                    float s = siluf_(y); if (cc < 256) s *= DT[hh * 64 + l]; o[j] = s; }
                if (cc < 256) *(LAS v4u*)(XCT + cc * 144 + (l0 + j8 * 8) * 2) = pack8(o);
                else { LAS unsigned char* d2 = (cc < 384 ? BM + (cc - 256) * 2 : CM + (cc - 384) * 2) + (l0 + j8 * 8) * 272;
#pragma unroll
                    for (int j = 0; j < 8; ++j) lds_st_bf16(d2 + j * 272, o[j]); } }
        }
    }
    __syncthreads();
#pragma unroll 1
    for (int i = 0; i < 2; ++i) { const int idx = 2 * wave + i, lt = idx >> 2, st = idx & 3;
        f32x4 acc = {0.f, 0.f, 0.f, 0.f}; acc = mm16(CM + lt * 16 * 272, 272, BM + st * 16 * 272, 272, 128, acc, fr, fq);
        const int l = lt * 16 + fr, s0 = st * 16 + 4 * fq;
#pragma unroll
        for (int hh = 0; hh < 4; ++hh) { const float al = AC[hh * 64 + l], dl = KIN(I_SD)[layer * 4 + hh] / DT[hh * 64 + l]; float o[4];
#pragma unroll
            for (int j = 0; j < 4; ++j) { const int s = s0 + j; float m = (l >= s) ? acc[j] * __expf(al - AC[hh * 64 + s]) : 0.f; if (l == s) m += dl; o[j] = m; }
            lds_st_bf16x4(MM + hh * 9216 + l * 144 + s0 * 2, o[0], o[1], o[2], o[3]); } }
    __syncthreads();
    f32x4 yv[2][4];
    { const int hh = wave >> 1; const bf16* prev = WSP(bf16, WS_SSD_ST) + ((size_t)(b * 4 + hh) * NCH + c) * 8192;
      bf16x8 pf[4][4];
#pragma unroll
      for (int pt = 0; pt < 4; ++pt)
#pragma unroll
          for (int ks = 0; ks < 4; ++ks) pf[pt][ks] = *(const bf16x8*)(prev + (size_t)(pt * 16 + fr) * 128 + ks * 32 + fq * 8);
#pragma unroll
      for (int i = 0; i < 2; ++i) { const int lt = 2 * (wave & 1) + i, l = lt * 16 + fr; const float ea = __expf(AC[hh * 64 + l]);
#pragma unroll
          for (int pt = 0; pt < 4; ++pt) { f32x4 ad = {0.f, 0.f, 0.f, 0.f}, ao = {0.f, 0.f, 0.f, 0.f};
              ad = mm16(MM + hh * 9216 + lt * 16 * 144, 144, XCT + (hh * 64 + pt * 16) * 144, 144, 64, ad, fr, fq);
              ao = mm16_rB<4>(CM + lt * 16 * 272, 272, pf[pt], ao, fr, fq);
              const f32x4 z = UU4(t0 + l, U_SSD_Z + hh * 64 + pt * 16 + 4 * fq);
              f32x4 y = ad + ao * ea; y.x *= siluf_(z.x); y.y *= siluf_(z.y); y.z *= siluf_(z.z); y.w *= siluf_(z.w); yv[i][pt] = y; } } }
    __syncthreads();
    { const int hh = wave >> 1;
#pragma unroll
      for (int i = 0; i < 2; ++i) { const int l = (2 * (wave & 1) + i) * 16 + fr;
#pragma unroll
          for (int pt = 0; pt < 4; ++pt) *(LAS f32x4*)(YG + l * 1040 + (hh * 64 + pt * 16 + 4 * fq) * 4) = yv[i][pt]; } }
    __syncthreads();
    { const f32x4 g = *(const f32x4*)(KIN(I_SNG) + layer * 256 + 4 * lane); bf16* mix = WSP(bf16, WS_MIX);
#pragma unroll 1
      for (int i = 0; i < 8; ++i) { const int l = wave * 8 + i; const f32x4 y = *(const LAS f32x4*)(YG + l * 1040 + lane * 16);
          const float ss = wave_sum((y.x * y.x + y.y * y.y) + (y.z * y.z + y.w * y.w)); const float r = __builtin_amdgcn_rsqf(ss * (1.f / 256.f) + NORM_EPS);
          v2u o; o.x = cvt_pk_bf16(y.x * r * g.x, y.y * r * g.y); o.y = cvt_pk_bf16(y.z * r * g.z, y.w * r * g.w);
          *(v2u*)(mix + (size_t)(t0 + l) * D + 4 * lane) = o; } }
    __syncthreads();
}

__device__ __forceinline__ void gla_bcum_all(Frame& F, const Args& A, int layer, const LAS float* GD, LAS float* BC) {
    const int d = F.tid & 127, lq = F.tid >> 7;
    float gup[16];
    { const f32x4* gp4 = (const f32x4*)(WSP(float, WS_LORA) + (size_t)layer * LORA_PER_LAYER + 32768 + d * 16);
#pragma unroll
      for (int i = 0; i < 4; ++i) { const f32x4 a = gp4[i]; gup[4 * i] = a.x; gup[4 * i + 1] = a.y; gup[4 * i + 2] = a.z; gup[4 * i + 3] = a.w; } }
    const float gb = KIN(I_GGB)[layer * 128 + d];
#pragma unroll 4
    for (int li = 0; li < 16; ++li) { const int l = lq * 16 + li; float x = gb;
#pragma unroll
        for (int i = 0; i < 4; ++i) { const f32x4 g4 = *(const LAS f32x4*)(GD + l * 16 + 4 * i); x += (g4.x * gup[4 * i] + g4.y * gup[4 * i + 1]) + (g4.z * gup[4 * i + 2] + g4.w * gup[4 * i + 3]); }
        BC[l * 128 + d] = logsigmoidf_(x) * 0.0625f; }
    __syncthreads();
    if (F.tid < 128) { float run = 0.f;
#pragma unroll 1
        for (int l0 = 0; l0 < 64; l0 += 16) { float v[16];
#pragma unroll
            for (int j = 0; j < 16; ++j) v[j] = BC[(l0 + j) * 128 + d];
#pragma unroll
            for (int j = 0; j < 16; ++j) { run += v[j]; BC[(l0 + j) * 128 + d] = run; } } }
}
__device__ __forceinline__ void gla_stage1(Frame& F, const Args& A, int layer, int b, int c) {
    const bf16* u = WSP(bf16, WS_U);
    LAS unsigned char* L = F.lds;
    LAS float* GD = (LAS float*)L; LAS float* BC = (LAS float*)(L + 4096);
    LAS unsigned char* KDT = L + 36864; LAS unsigned char* VT = KDT + 128 * 144;
    const int t0 = b * SEQ + c * 64, tid = F.tid, lane = F.lane, wave = F.wave, fr = lane & 15, fq = lane >> 4;
    if (tid < 256) { const int l = tid >> 2, q4 = tid & 3; *(LAS f32x4*)(GD + l * 16 + q4 * 4) = UU4(t0 + l, U_GL_G + 4 * q4); }
    __syncthreads();
    gla_bcum_all(F, A, layer, GD, BC);
    if (tid < 128) {
        const int d = tid; const float blast = BC[63 * 128 + d];
        WSP(float, WS_GLA_DEC)[(size_t)(b * NCH + c) * 128 + d] = __expf(blast);
        const bf16* up = u + (size_t)t0 * NUP + U_GL_K + d;
#pragma unroll 1
        for (int l0 = 0; l0 < 64; l0 += 32) { float xv[32];
#pragma unroll
            for (int j = 0; j < 32; ++j) xv[j] = bf2f(up[(l0 + j) * NUP]);
#pragma unroll
            for (int j8 = 0; j8 < 4; ++j8) { float o[8];
#pragma unroll
                for (int j = 0; j < 8; ++j) { const int l = l0 + j8 * 8 + j; o[j] = xv[j8 * 8 + j] * __expf(blast - BC[l * 128 + d]); }
                *(LAS v4u*)(KDT + d * 144 + (l0 + j8 * 8) * 2) = pack8(o); } }
    } else if (tid < 384) {
        const int vch = tid - 128; const bf16* up = u + (size_t)t0 * NUP + U_GL_V + vch;
#pragma unroll 1
        for (int l0 = 0; l0 < 64; l0 += 32) { float xv[32];
#pragma unroll
            for (int j = 0; j < 32; ++j) xv[j] = bf2f(up[(l0 + j) * NUP]);
#pragma unroll
            for (int j8 = 0; j8 < 4; ++j8) { float o[8];
#pragma unroll
                for (int j = 0; j < 8; ++j) o[j] = xv[j8 * 8 + j];
                *(LAS v4u*)(VT + vch * 144 + (l0 + j8 * 8) * 2) = pack8(o); } }
    }
    __syncthreads();
    { bf16* st = WSP(bf16, WS_GLA_ST);
#pragma unroll 1
      for (int i = 0; i < 4; ++i) { const int idx = 4 * wave + i, hh = idx >> 3, dtl = (idx >> 2) & 1, vt = idx & 3;
          f32x4 acc = {0.f, 0.f, 0.f, 0.f}; acc = mm16(KDT + (hh * 32 + dtl * 16) * 144, 144, VT + (hh * 64 + vt * 16) * 144, 144, 64, acc, fr, fq);
          stb4(st + (((size_t)(b * 4 + hh) * NCH + c) * 32 + dtl * 16 + fr) * 64 + vt * 16 + 4 * fq, acc); } }
    __syncthreads();
}
__device__ __forceinline__ void gla_stage3(Frame& F, const Args& A, int layer, int b, int c) {
    const bf16* u = WSP(bf16, WS_U);
    LAS unsigned char* L = F.lds;
    LAS float* GD = (LAS float*)L; LAS float* BC = (LAS float*)(L + 4096); LAS unsigned char* ATT = L + 4096;
    LAS unsigned char* QD = L + 40960; LAS unsigned char* KI = QD + 64 * 272; LAS unsigned char* VT = KI + 64 * 272; LAS unsigned char* PVT = VT + 256 * 144;
    const int t0 = b * SEQ + c * 64, tid = F.tid, lane = F.lane, wave = F.wave, fr = lane & 15, fq = lane >> 4;
    if (tid < 256) { const int l = tid >> 2, q4 = tid & 3; *(LAS f32x4*)(GD + l * 16 + q4 * 4) = UU4(t0 + l, U_GL_G + 4 * q4); }
    __syncthreads();
    gla_bcum_all(F, A, layer, GD, BC);
    if (tid < 128) {
        const int d = tid;
        const bf16* uq = u + (size_t)t0 * NUP + U_GL_Q + d; const bf16* uk = u + (size_t)t0 * NUP + U_GL_K + d;
#pragma unroll 1
        for (int l0 = 0; l0 < 64; l0 += 16) { float qv[16], kv[16];
#pragma unroll
            for (int j = 0; j < 16; ++j) { qv[j] = bf2f(uq[(l0 + j) * NUP]); kv[j] = bf2f(uk[(l0 + j) * NUP]); }
#pragma unroll
            for (int j = 0; j < 16; ++j) { const int l = l0 + j; const float bc = BC[l * 128 + d];
                lds_st_bf16(QD + l * 272 + d * 2, qv[j] * 0.17677669529663687f * __expf(bc)); lds_st_bf16(KI + l * 272 + d * 2, kv[j] * __expf(-bc)); } }
    } else if (tid < 384) {
        const int vch = tid - 128; const bf16* up = u + (size_t)t0 * NUP + U_GL_V + vch;
#pragma unroll 1
        for (int l0 = 0; l0 < 64; l0 += 32) { float xv[32];
#pragma unroll
            for (int j = 0; j < 32; ++j) xv[j] = bf2f(up[(l0 + j) * NUP]);
#pragma unroll
            for (int j8 = 0; j8 < 4; ++j8) { float o[8];
#pragma unroll
                for (int j = 0; j < 8; ++j) o[j] = xv[j8 * 8 + j];
                *(LAS v4u*)(VT + vch * 144 + (l0 + j8 * 8) * 2) = pack8(o); } }
    } else {
        const bf16* prev = WSP(bf16, WS_GLA_ST);
#pragma unroll 4
        for (int i = tid - 384; i < 8192; i += 128) { const int hh = i >> 11, dd = (i >> 6) & 31, vv = i & 63;
            *(LAS unsigned short*)(PVT + (hh * 64 + vv) * 80 + dd * 2) = prev[((size_t)(b * 4 + hh) * NCH + c) * 2048 + dd * 64 + vv]; }
    }
    __syncthreads();
    const int hh = wave >> 1;
#pragma unroll 1
    for (int i = 0; i < 2; ++i) { const int tt = 2 * (wave & 1) + i, t = tt * 16 + fr;
#pragma unroll
        for (int st = 0; st < 4; ++st) { f32x4 acc = {0.f, 0.f, 0.f, 0.f}; acc = mm16(QD + tt * 16 * 272 + hh * 64, 272, KI + st * 16 * 272 + hh * 64, 272, 32, acc, fr, fq);
            const int s0 = st * 16 + 4 * fq;
            lds_st_bf16x4(ATT + hh * 9216 + t * 144 + s0 * 2, t >= s0 ? acc[0] : 0.f, t >= s0 + 1 ? acc[1] : 0.f, t >= s0 + 2 ? acc[2] : 0.f, t >= s0 + 3 ? acc[3] : 0.f); } }
    __syncthreads();
    { bf16* mix = WSP(bf16, WS_MIX); const float* ng = KIN(I_GNG) + layer * 256;
#pragma unroll 1
      for (int i = 0; i < 2; ++i) { const int tt = 2 * (wave & 1) + i, t = tt * 16 + fr; f32x4 ov[4]; float ss = 0.f;
#pragma unroll
          for (int vt = 0; vt < 4; ++vt) { f32x4 acc = {0.f, 0.f, 0.f, 0.f};
              acc = mm16(ATT + hh * 9216 + tt * 16 * 144, 144, VT + (hh * 64 + vt * 16) * 144, 144, 64, acc, fr, fq);
              acc = mm16(QD + tt * 16 * 272 + hh * 64, 272, PVT + (hh * 64 + vt * 16) * 80, 80, 32, acc, fr, fq);
              ov[vt] = acc; ss += (acc.x * acc.x + acc.y * acc.y) + (acc.z * acc.z + acc.w * acc.w); }
          ss += __shfl_xor(ss, 16); ss += __shfl_xor(ss, 32);
          const float r = __builtin_amdgcn_rsqf(ss * (1.f / 64.f) + NORM_EPS);
#pragma unroll
          for (int vt = 0; vt < 4; ++vt) { const int col = hh * 64 + vt * 16 + 4 * fq; const f32x4 g = *(const f32x4*)(ng + col); const f32x4 og = UU4(t0 + t, U_GL_OG + col);
              v2u o; o.x = cvt_pk_bf16(ov[vt].x * r * g.x * siluf_(og.x), ov[vt].y * r * g.y * siluf_(og.y)); o.y = cvt_pk_bf16(ov[vt].z * r * g.z * siluf_(og.z), ov[vt].w * r * g.w * siluf_(og.w));
              *(v2u*)(mix + (size_t)(t0 + t) * D + 512 + col) = o; } } }
    __syncthreads();
}

__device__ __forceinline__ void mlstm_stage1(Frame& F, const Args& A, int layer, int b, int c) {
    const bf16* u = WSP(bf16, WS_U);
    LAS unsigned char* L = F.lds;
    LAS float* WST = (LAS float*)L; LAS unsigned char* KT = L + 1024; LAS unsigned char* VWT = KT + 256 * 144;
    const int t0 = b * SEQ + c * 64, tid = F.tid, lane = F.lane, wave = F.wave, fr = lane & 15, fq = lane >> 4;
    if (wave < 4) {
        const int hh = wave;
        const float ig = UU(t0 + lane, U_ML_I + hh) + KIN(I_MIB)[layer * 4 + hh];
        const float lf = logsigmoidf_(UU(t0 + lane, U_ML_F + hh) + KIN(I_MFB)[layer * 4 + hh]);
        const float bc = wave_scan_add(lf, lane); const float blast = __shfl(bc, 63);
        const float ast = blast - bc + ig; const float mloc = wave_max(ast);
        WST[hh * 64 + lane] = __expf(ast - mloc);
        if (lane == 0) { WSP(float, WS_ML_BL)[(b * 4 + hh) * NCH + c] = blast; WSP(float, WS_ML_ML)[(b * 4 + hh) * NCH + c] = mloc; }
    } else {
        const int kch = tid - 256, cc = 256 + kch; const float* cw = KIN(I_MCW) + (size_t)layer * 2048 + cc; const float w0 = cw[0], w1 = cw[512], w2 = cw[1024], w3 = cw[1536], cb = KIN(I_MCB)[layer * 512 + cc];
        const bf16* up = u + (size_t)t0 * NUP + U_ML_K + kch;
        float win0 = 0.f, win1 = 0.f, win2 = 0.f;
        if (c > 0) { win0 = bf2f(up[-3 * NUP]); win1 = bf2f(up[-2 * NUP]); win2 = bf2f(up[-1 * NUP]); }
#pragma unroll 1
        for (int l0 = 0; l0 < 64; l0 += 32) { float xv[32];
#pragma unroll
            for (int j = 0; j < 32; ++j) xv[j] = bf2f(up[(l0 + j) * NUP]);
#pragma unroll
            for (int j8 = 0; j8 < 4; ++j8) { float o[8];
#pragma unroll
                for (int j = 0; j < 8; ++j) { const float x = xv[j8 * 8 + j]; const float y = cb + w0 * win0 + w1 * win1 + w2 * win2 + w3 * x; win0 = win1; win1 = win2; win2 = x; o[j] = siluf_(y); }
                *(LAS v4u*)(KT + kch * 144 + (l0 + j8 * 8) * 2) = pack8(o); } }
    }
    __syncthreads();
    if (tid < 256) {
        const int vch = tid, hh = vch >> 6; const bf16* up = u + (size_t)t0 * NUP + U_ML_V + vch;
#pragma unroll 1
        for (int l0 = 0; l0 < 64; l0 += 32) { float xv[32];
#pragma unroll
            for (int j = 0; j < 32; ++j) xv[j] = bf2f(up[(l0 + j) * NUP]);
#pragma unroll
            for (int j8 = 0; j8 < 4; ++j8) { float o[8];
#pragma unroll
                for (int j = 0; j < 8; ++j) o[j] = xv[j8 * 8 + j] * WST[hh * 64 + l0 + j8 * 8 + j];
                *(LAS v4u*)(VWT + vch * 144 + (l0 + j8 * 8) * 2) = pack8(o); } }
    } else {
        const int kch = tid - 256, hh = kch >> 6; float n = 0.f;
#pragma unroll 8
        for (int s = 0; s < 64; ++s) n += WST[hh * 64 + s] * bf2f(*(const LAS unsigned short*)(KT + kch * 144 + s * 2));
        WSP(bf16, WS_ML_N)[((size_t)(b * 4 + hh) * NCH + c) * 64 + (kch & 63)] = (bf16)(cvt_pk_bf16(n, 0.f) & 0xffffu);
    }
    __syncthreads();
    { bf16* cst = WSP(bf16, WS_ML_C); const int hh = wave >> 1;
#pragma unroll 1
      for (int i = 0; i < 2; ++i) { const int vt = 2 * (wave & 1) + i;
#pragma unroll 1
          for (int kt = 0; kt < 4; ++kt) { f32x4 acc = {0.f, 0.f, 0.f, 0.f}; acc = mm16(VWT + (hh * 64 + vt * 16) * 144, 144, KT + (hh * 64 + kt * 16) * 144, 144, 64, acc, fr, fq);
              stb4(cst + (((size_t)(b * 4 + hh) * NCH + c) * 64 + vt * 16 + fr) * 64 + kt * 16 + 4 * fq, acc); } } }
    __syncthreads();
}
__device__ __forceinline__ void mlstm_stage3(Frame& F, const Args& A, int layer, int b, int c) {
    const bf16* u = WSP(bf16, WS_U);
    LAS unsigned char* L = F.lds;
    LAS float* BCU = (LAS float*)L; LAS float* GG = BCU + 256; LAS float* MROW = BCU + 512; LAS float* WINT = BCU + 768; LAS float* NPV = BCU + 1024;
    LAS unsigned char* Q = L + 6144; LAS unsigned char* KK = Q + 64 * 528; LAS unsigned char* VT = KK + 64 * 528; LAS unsigned char* SC = VT + 256 * 144;
    const int t0 = b * SEQ + c * 64, tid = F.tid, lane = F.lane, wave = F.wave, fr = lane & 15, fq = lane >> 4;
    if (wave < 4) {
        const int hh = wave;
        const float ig = UU(t0 + lane, U_ML_I + hh) + KIN(I_MIB)[layer * 4 + hh];
        const float lf = logsigmoidf_(UU(t0 + lane, U_ML_F + hh) + KIN(I_MFB)[layer * 4 + hh]);
        const float bc = wave_scan_add(lf, lane); const float gg = ig - bc;
        const float mprev = WSP(float, WS_ML_M)[(b * 4 + hh) * NCH + c];
        const float minter = bc + mprev, mintra = bc + wave_scan_max(gg, lane), mrow = fmaxf(minter, mintra);
        BCU[hh * 64 + lane] = bc; GG[hh * 64 + lane] = gg; MROW[hh * 64 + lane] = mrow; WINT[hh * 64 + lane] = __expf(minter - mrow);
        NPV[hh * 64 + lane] = bf2f(WSP(bf16, WS_ML_N)[((size_t)(b * 4 + hh) * NCH + c) * 64 + lane]);
    }
    {
        const int cc = tid; const float* cw = KIN(I_MCW) + (size_t)layer * 2048 + cc; const float w0 = cw[0], w1 = cw[512], w2 = cw[1024], w3 = cw[1536], cb = KIN(I_MCB)[layer * 512 + cc];
        const bf16* up = u + (size_t)t0 * NUP + U_ML_Q + cc;
        float win0 = 0.f, win1 = 0.f, win2 = 0.f;
        if (c > 0) { win0 = bf2f(up[-3 * NUP]); win1 = bf2f(up[-2 * NUP]); win2 = bf2f(up[-1 * NUP]); }
        LAS unsigned char* dst = cc < 256 ? Q + cc * 2 : KK + (cc - 256) * 2; const float sc = cc < 256 ? 0.125f : 1.0f;
#pragma unroll 1
        for (int l0 = 0; l0 < 64; l0 += 32) { float xv[32];
#pragma unroll
            for (int j = 0; j < 32; ++j) xv[j] = bf2f(up[(l0 + j) * NUP]);
#pragma unroll
            for (int j = 0; j < 32; ++j) { const float x = xv[j]; const float y = cb + w0 * win0 + w1 * win1 + w2 * win2 + w3 * x; win0 = win1; win1 = win2; win2 = x; lds_st_bf16(dst + (l0 + j) * 528, siluf_(y) * sc); } }
        const int vch = tid & 255, lh = (tid >> 8) * 32; const bf16* uv = u + (size_t)(t0 + lh) * NUP + U_ML_V + vch;
        float xv[32];
#pragma unroll
        for (int j = 0; j < 32; ++j) xv[j] = bf2f(uv[j * NUP]);
#pragma unroll
        for (int j8 = 0; j8 < 4; ++j8) { float o[8];
#pragma unroll
            for (int j = 0; j < 8; ++j) o[j] = xv[j8 * 8 + j];
            *(LAS v4u*)(VT + vch * 144 + (lh + j8 * 8) * 2) = pack8(o); }
    }
    __syncthreads();
    { const int hh = wave >> 1; bf16* mix = WSP(bf16, WS_MIX); const float* ng = KIN(I_MNG) + layer * 256;
      const bf16* cprev = WSP(bf16, WS_ML_C) + ((size_t)(b * 4 + hh) * NCH + c) * 4096;
      bf16x8 cf[4][2];
#pragma unroll
      for (int vt = 0; vt < 4; ++vt)
#pragma unroll
          for (int ks = 0; ks < 2; ++ks) cf[vt][ks] = *(const bf16x8*)(cprev + (size_t)(vt * 16 + fr) * 64 + ks * 32 + fq * 8);
#pragma unroll 1
      for (int i = 0; i < 2; ++i) { const int tt = 2 * (wave & 1) + i, t = tt * 16 + fr;
          const float bt = BCU[hh * 64 + t] - MROW[hh * 64 + t]; float rs = 0.f;
#pragma unroll
          for (int st = 0; st < 4; ++st) { f32x4 acc = {0.f, 0.f, 0.f, 0.f}; acc = mm16(Q + tt * 16 * 528 + hh * 128, 528, KK + st * 16 * 528 + hh * 128, 528, 64, acc, fr, fq);
              const int s0 = st * 16 + 4 * fq; float o[4];
#pragma unroll
              for (int j = 0; j < 4; ++j) { const int s = s0 + j; const float v = (t >= s) ? acc[j] * __expf(bt + GG[hh * 64 + s]) : 0.f; o[j] = v; rs += v; }
              lds_st_bf16x4(SC + hh * 9216 + t * 144 + s0 * 2, o[0], o[1], o[2], o[3]); }
          rs += __shfl_xor(rs, 16); rs += __shfl_xor(rs, 32);
          float nq = 0.f;
#pragma unroll
          for (int j = 0; j < 16; ++j) nq += bf2f(*(const LAS unsigned short*)(Q + t * 528 + (hh * 64 + fq * 16 + j) * 2)) * NPV[hh * 64 + fq * 16 + j];
          nq += __shfl_xor(nq, 16); nq += __shfl_xor(nq, 32);
          const float wi = WINT[hh * 64 + t]; const float den = wi * nq + rs; const float dn = fmaxf(fabsf(den), __expf(-MROW[hh * 64 + t])); const float rdn = 1.0f / dn;
          LDS_WAIT();
          f32x4 hv[4]; float sm = 0.f;
#pragma unroll
          for (int vt = 0; vt < 4; ++vt) { f32x4 acc = {0.f, 0.f, 0.f, 0.f};
              acc = mm16_rB<2>(Q + tt * 16 * 528 + hh * 128, 528, cf[vt], acc, fr, fq);
              acc = acc * wi;
              acc = mm16(SC + hh * 9216 + tt * 16 * 144, 144, VT + (hh * 64 + vt * 16) * 144, 144, 64, acc, fr, fq);
              const f32x4 og = UU4(t0 + t, U_ML_O + hh * 64 + vt * 16 + 4 * fq);
              f32x4 h; h.x = acc.x * rdn * sigmoidf_(og.x); h.y = acc.y * rdn * sigmoidf_(og.y); h.z = acc.z * rdn * sigmoidf_(og.z); h.w = acc.w * rdn * sigmoidf_(og.w);
              hv[vt] = h; sm += (h.x + h.y) + (h.z + h.w); }
          sm += __shfl_xor(sm, 16); sm += __shfl_xor(sm, 32);
          const float mean = sm * (1.f / 64.f); float sq = 0.f;
#pragma unroll
          for (int vt = 0; vt < 4; ++vt) { hv[vt] = hv[vt] - mean; sq += (hv[vt].x * hv[vt].x + hv[vt].y * hv[vt].y) + (hv[vt].z * hv[vt].z + hv[vt].w * hv[vt].w); }
          sq += __shfl_xor(sq, 16); sq += __shfl_xor(sq, 32);
          const float r = __builtin_amdgcn_rsqf(sq * (1.f / 64.f) + NORM_EPS);
#pragma unroll
          for (int vt = 0; vt < 4; ++vt) { const int col = hh * 64 + vt * 16 + 4 * fq; const f32x4 g = *(const f32x4*)(ng + col);
              v2u o; o.x = cvt_pk_bf16(hv[vt].x * r * g.x, hv[vt].y * r * g.y); o.y = cvt_pk_bf16(hv[vt].z * r * g.z, hv[vt].w * r * g.w);
              *(v2u*)(mix + (size_t)(t0 + t) * D + 768 + col) = o; } } }
    __syncthreads();
}

__device__ __forceinline__ void rwkv_stage1(Frame& F, const Args& A, int layer, int ub) {
    const bf16* u = WSP(bf16, WS_U);
    LAS unsigned char* L = F.lds;
    LAS unsigned char* LOWA = L;
    LAS float* CUM = (LAS float*)(L + 16384);
    LAS float* AAB = CUM;
    LAS float* TOT = CUM;
    LAS unsigned char* M0 = L + 16384 + 16640;
#define RM(i) (M0 + (i) * 9216)
    LAS float* GAMC = (LAS float*)(F.MISC + MW_GAMC);
    const int t0 = ub * 64, c = ub & 63, tid = F.tid, lane = F.lane, wave = F.wave;
    const float* mu = KIN(I_RMU) + layer * 896;
#ifndef RW_DUP
#define RW_DUP -1
#endif
#define RW_REP(k) for (int rep__ = 0; rep__ < ((RW_DUP == (k)) ? 2 : 1); ++rep__)
    RW_REP(0) {
    {
        const int l = tid >> 3, jq = tid & 7, t = t0 + l; const bool has_prev = (t & (SEQ - 1)) != 0;
        f32x4 cur[4], prv[4];
#pragma unroll
        for (int q = 0; q < 4; ++q) { cur[q] = UU4(t, U_RW_LO + jq * 16 + 4 * q); prv[q] = has_prev ? UU4(t - 1, U_RW_LO + jq * 16 + 4 * q) : (f32x4){0.f, 0.f, 0.f, 0.f}; }
#pragma unroll
        for (int q = 0; q < 4; ++q) { const f32x4 m4 = *(const f32x4*)(mu + 768 + jq * 16 + 4 * q); const f32x4 xs = cur[q] + (prv[q] - cur[q]) * m4; const int j = jq * 16 + 4 * q;
            f32x4 o;
            if (j < 32) { o.x = tanhf_(xs.x); o.y = tanhf_(xs.y); o.z = tanhf_(xs.z); o.w = tanhf_(xs.w); } else if (j < 64) o = xs; else { o.x = sigmoidf_(xs.x); o.y = sigmoidf_(xs.y); o.z = sigmoidf_(xs.z); o.w = sigmoidf_(xs.w); }
            if (j < 64) lds_st_bf16x4(LOWA + l * 144 + j * 2, o.x, o.y, o.z, o.w); else lds_st_bf16x4(RM(0) + l * 144 + (j - 64) * 2, o.x, o.y, o.z, o.w); }
    }
    __syncthreads();
    {
        bf16* RG = WSP(bf16, WS_RW_G); const int lane_ = F.lane, fr_ = lane_ & 15, fq_ = lane_ >> 4;
        const float* gupT = WSP(float, WS_LORA) + (size_t)layer * LORA_PER_LAYER + 16384;
#pragma unroll
        for (int ci = 0; ci < 2; ++ci) { const int ct = 2 * wave + ci; bf16x8 bf[2];
#pragma unroll
            for (int ks = 0; ks < 2; ++ks) bf[ks] = ldfrag_f32(gupT + (size_t)(ct * 16 + fr_) * 64 + ks * 32 + fq_ * 8);
#pragma unroll
            for (int tt = 0; tt < 4; ++tt) { f32x4 acc = {0.f, 0.f, 0.f, 0.f}; acc = mm16_rB<2>(RM(0) + tt * 16 * 144, 144, bf, acc, fr_, fq_);
                stb4(RG + (size_t)(t0 + tt * 16 + fr_) * 256 + ct * 16 + 4 * fq_, acc); } }
    }
    __syncthreads();
    }
    const int b_ = ub >> 6;
#pragma unroll 1
    for (int hh = 0; hh < 4; ++hh) {
        int ch = lane, fr = lane & 15, fq = lane >> 4; asm volatile("" : "+v"(ch), "+v"(fr), "+v"(fq));
        const int tg = wave, cg = hh * 64 + ch; const size_t un = (size_t)(b_ * 4 + hh) * NCH + c;
        float rr[8], k2r[8], vr[8], ar[8], br[8], pl[8];
        LAS float* WPA = (LAS float*)RM(8);
        {
            const int mat = wave >> 2, ct = wave & 3;
            const float* wT = WSP(float, WS_LORA) + (size_t)layer * LORA_PER_LAYER + mat * 8192 + (size_t)(hh * 64 + ct * 16 + fr) * 32 + fq * 8;
            bf16x8 bfw[1]; bfw[0] = ldfrag_f32(wT);
#pragma unroll
            for (int tt = 0; tt < 4; ++tt) { f32x4 acc = {0.f, 0.f, 0.f, 0.f}; acc = mm16_rB<1>(LOWA + tt * 16 * 144 + mat * 64, 144, bfw, acc, fr, fq);
                *(LAS f32x4*)(WPA + mat * 4096 + (tt * 16 + fr) * 64 + ct * 16 + 4 * fq) = acc; }
        }
        __syncthreads();
        RW_REP(1) {
            const float w0 = KIN(I_RW0)[layer * 256 + cg], a0 = KIN(I_RA0)[layer * 256 + cg], kkc = KIN(I_RKK)[layer * 256 + cg], kac = KIN(I_RKA)[layer * 256 + cg];
            const float mur = mu[cg], muk = mu[256 + cg], muv = mu[512 + cg];
            const int tb = t0 + tg * 8; const bool nop = (c == 0) && (tg == 0);
            float rp = nop ? 0.f : UU(tb - 1, U_RW_R + cg), kp = nop ? 0.f : UU(tb - 1, U_RW_K + cg), vp = nop ? 0.f : UU(tb - 1, U_RW_V + cg);
            float rc[8], kc[8], vc[8];
#pragma unroll
            for (int j = 0; j < 8; ++j) { rc[j] = UU(tb + j, U_RW_R + cg); kc[j] = UU(tb + j, U_RW_K + cg); vc[j] = UU(tb + j, U_RW_V + cg); }
            bf16* RW = WSP(bf16, WS_RW);
            float kk[8], al[8], n2[8], run = 0.f;
#pragma unroll
            for (int j = 0; j < 8; ++j) { const int l = tg * 8 + j;
                const float r = rc[j] + (rp - rc[j]) * mur, k = kc[j] + (kp - kc[j]) * muk, v = vc[j] + (vp - vc[j]) * muv; rp = rc[j]; kp = kc[j]; vp = vc[j];
                const float wp = w0 + WPA[l * 64 + ch], ap = a0 + WPA[4096 + l * 64 + ch];
                const float w = -softplusf_(-wp) - 0.5f; run += -__expf(w); pl[j] = run; al[j] = sigmoidf_(ap);
                kk[j] = k * kkc; n2[j] = kk[j] * kk[j];
                k2r[j] = k * (1.0f + (al[j] - 1.0f) * kac); rr[j] = r; vr[j] = v;
                bf16* o = RW + (size_t)(tb + j) * 768 + cg; o[0] = (bf16)(cvt_pk_bf16(r, 0.f) & 0xffffu); o[256] = (bf16)(cvt_pk_bf16(k2r[j], 0.f) & 0xffffu); o[512] = (bf16)(cvt_pk_bf16(v, 0.f) & 0xffffu); }
#pragma unroll
            for (int i = 0; i < 4; ++i) { const bool hi = (ch & 32) != 0; const float keep = hi ? n2[i + 4] : n2[i], send = hi ? n2[i] : n2[i + 4]; n2[i] = keep + __shfl_xor(send, 32); }
#pragma unroll
            for (int i = 0; i < 2; ++i) { const bool hi = (ch & 16) != 0; const float keep = hi ? n2[i + 2] : n2[i], send = hi ? n2[i] : n2[i + 2]; n2[i] = keep + __shfl_xor(send, 16); }
            { const bool hi = (ch & 8) != 0; const float keep = hi ? n2[1] : n2[0], send = hi ? n2[0] : n2[1]; n2[0] = keep + __shfl_xor(send, 8); }
            n2[0] += __shfl_xor(n2[0], 4); n2[0] += __shfl_xor(n2[0], 2); n2[0] += __shfl_xor(n2[0], 1);
#pragma unroll
            for (int j = 0; j < 8; ++j) { const float tot = __builtin_bit_cast(float, __builtin_amdgcn_readlane(__builtin_bit_cast(int, n2[0]), ((j & 4) ? 32 : 0) + ((j & 2) ? 16 : 0) + ((j & 1) ? 8 : 0)));
                const float kkn = kk[j] / fmaxf(sqrtf(tot), 1e-12f); ar[j] = -kkn; br[j] = kkn * al[j]; }
            TOT[tg * 64 + ch] = run;
        }
        __syncthreads();
        RW_REP(3) {
            float off = 0.f, gC = 0.f;
#pragma unroll
            for (int g = 0; g < 8; ++g) { const float tv = TOT[g * 64 + ch]; gC += tv; if (g < tg) off += tv; }
            float oat[8], obb[8], okb[8], ov[8];
#pragma unroll
            for (int j = 0; j < 8; ++j) { const int l = tg * 8 + j; const float gt = off + pl[j], gm = j > 0 ? off + pl[j - 1] : off;
                const float at = ar[j] * __expf(gm), rt = rr[j] * __expf(gt), en = __expf(-gt), ec = __expf(gC - gt);
                lds_st_bf16(RM(0) + l * 144 + ch * 2, at); lds_st_bf16(RM(1) + l * 144 + ch * 2, rt); lds_st_bf16(RM(2) + l * 144 + ch * 2, br[j] * en); lds_st_bf16(RM(3) + l * 144 + ch * 2, k2r[j] * en);
                oat[j] = at; obb[j] = br[j] * ec; okb[j] = k2r[j] * ec; ov[j] = vr[j]; }
            *(LAS v4u*)(RM(4) + ch * 144 + tg * 16) = pack8(oat); *(LAS v4u*)(RM(5) + ch * 144 + tg * 16) = pack8(obb); *(LAS v4u*)(RM(6) + ch * 144 + tg * 16) = pack8(okb); *(LAS v4u*)(RM(7) + ch * 144 + tg * 16) = pack8(ov);
            if (tg == 0) GAMC[ch] = __expf(gC);
        }
        __syncthreads();
        RW_REP(4) {
            const int which = wave >> 1; const LAS unsigned char* Aop = which < 2 ? RM(0) : RM(1); const LAS unsigned char* Bop = (which & 1) ? RM(3) : RM(2);
#pragma unroll 1
            for (int i2 = 0; i2 < 2; ++i2) { const int tt = 2 * (wave & 1) + i2, t = tt * 16 + fr;
#pragma unroll
                for (int it = 0; it < 4; ++it) { f32x4 acc = {0.f, 0.f, 0.f, 0.f}; acc = mm16(Aop + tt * 16 * 144, 144, Bop + it * 16 * 144, 144, 64, acc, fr, fq);
                    const int i0 = it * 16 + 4 * fq; const int lim = which < 2 ? t : t + 1;
                    const float o0 = (i0 < lim) ? acc[0] : 0.f, o1 = (i0 + 1 < lim) ? acc[1] : 0.f, o2 = (i0 + 2 < lim) ? acc[2] : 0.f, o3 = (i0 + 3 < lim) ? acc[3] : 0.f;
#ifdef RW_CLAMP_AAK
                    float q0 = o0, q1 = o1, q2 = o2, q3 = o3;
                    if (which == 1) { q0 = fabsf(o0) < 1e30f ? o0 : 0.f; q1 = fabsf(o1) < 1e30f ? o1 : 0.f; q2 = fabsf(o2) < 1e30f ? o2 : 0.f; q3 = fabsf(o3) < 1e30f ? o3 : 0.f; }
                    if (which == 0) *(LAS f32x4*)(AAB + t * 64 + i0) = (f32x4){o0, o1, o2, o3};
                    else lds_st_bf16x4(RM(7 + which) + t * 144 + i0 * 2, q0, q1, q2, q3);
                    continue;
#endif
                    if (which == 0) { DBG_STAT(11, o0); DBG_STAT(11, o1); DBG_STAT(11, o2); DBG_STAT(11, o3); } if (which == 1) { DBG_STAT(12, o0); DBG_STAT(12, o1); DBG_STAT(12, o2); DBG_STAT(12, o3); } if (which == 2) { DBG_STAT(13, o0); DBG_STAT(13, o3); } if (which == 3) { DBG_STAT(14, o0); DBG_STAT(14, o3); }
                    if (which == 0) *(LAS f32x4*)(AAB + t * 64 + i0) = (f32x4){o0, o1, o2, o3};
                    else lds_st_bf16x4(RM(7 + which) + t * 144 + i0 * 2, o0, o1, o2, o3); } }
        }
        __syncthreads();
        RW_REP(5) {
#pragma unroll 1
            for (int i2 = 0; i2 < 2; ++i2) { const int idx = wave * 2 + i2, vt = idx >> 2, tt = idx & 3; f32x4 acc = {0.f, 0.f, 0.f, 0.f};
                acc = mm16(RM(7) + vt * 16 * 144, 144, RM(8) + tt * 16 * 144, 144, 64, acc, fr, fq);
                DBG_STAT(15, acc[0]); DBG_STAT(15, acc[1]); DBG_STAT(15, acc[2]); DBG_STAT(15, acc[3]);
                lds_st_bf16x4(RM(0) + (vt * 16 + fr) * 144 + (tt * 16 + 4 * fq) * 2, acc[0], acc[1], acc[2], acc[3]); }
        }
        RW_REP(8) if (wave == 0) {
            float x[64]; f32x4 rowq[16];
#pragma unroll
            for (int t = 0; t < 64; ++t) {
                f32x4 cur[16];
#pragma unroll
                for (int i4 = 0; i4 < (t + 3) / 4; ++i4) cur[i4] = rowq[i4];
                if (t + 1 < 64) {
#pragma unroll
                    for (int i4 = 0; i4 < (t + 4) / 4; ++i4) rowq[i4] = *(const LAS f32x4*)(AAB + (t + 1) * 64 + 4 * i4); }
                float a0 = (t == ch) ? 1.0f : 0.f, a1 = 0.f, a2 = 0.f, a3 = 0.f;
#pragma unroll
                for (int i4 = 0; i4 < (t + 3) / 4; ++i4) { const f32x4 q = cur[i4];
                    a0 += q.x * x[4 * i4]; if (4 * i4 + 1 < t) a1 += q.y * x[4 * i4 + 1]; if (4 * i4 + 2 < t) a2 += q.z * x[4 * i4 + 2]; if (4 * i4 + 3 < t) a3 += q.w * x[4 * i4 + 3]; }
                const float acc = (a0 + a1) + (a2 + a3);
                x[t] = acc; lds_st_bf16(RM(11) + t * 144 + ch * 2, acc); }
        }
        __syncthreads();
        RW_REP(6) {
            const int rt = wave >> 1;
#pragma unroll
            for (int i2 = 0; i2 < 2; ++i2) { const int tt = 2 * (wave & 1) + i2;
                f32x4 acc = {0.f, 0.f, 0.f, 0.f}; acc = mm16(RM(4) + rt * 16 * 144, 144, RM(11) + tt * 16 * 144, 144, 64, acc, fr, fq);
                DBG_STAT(17, acc[0]); DBG_STAT(17, acc[1]); DBG_STAT(17, acc[2]); DBG_STAT(17, acc[3]);
                lds_st_bf16x4(RM(2) + (rt * 16 + fr) * 144 + (tt * 16 + 4 * fq) * 2, acc[0], acc[1], acc[2], acc[3]);
                f32x4 ac2 = {0.f, 0.f, 0.f, 0.f}; ac2 = mm16(RM(0) + rt * 16 * 144, 144, RM(11) + tt * 16 * 144, 144, 64, ac2, fr, fq);
                DBG_STAT(18, ac2[0]); DBG_STAT(18, ac2[1]); DBG_STAT(18, ac2[2]); DBG_STAT(18, ac2[3]);
                lds_st_bf16x4(RM(3) + (rt * 16 + fr) * 144 + (tt * 16 + 4 * fq) * 2, ac2[0], ac2[1], ac2[2], ac2[3]); }
        }
        __syncthreads();
        RW_REP(7) {
            const int which = wave >> 1;
#pragma unroll 1
            for (int i2 = 0; i2 < 2; ++i2) { const int rt = 2 * (wave & 1) + i2, row = rt * 16 + fr;
#pragma unroll
                for (int ct = 0; ct < 4; ++ct) { f32x4 acc = {0.f, 0.f, 0.f, 0.f}; const int c0 = ct * 16 + 4 * fq;
                    if (which == 0) { acc = mm16(RM(9) + rt * 16 * 144, 144, RM(2) + ct * 16 * 144, 144, 64, acc, fr, fq);
                        const v2u rw = *(const LAS v2u*)(RM(1) + row * 144 + c0 * 2);
                        acc[0] += __uint_as_float(rw.x << 16); acc[1] += __uint_as_float(rw.x & 0xffff0000u); acc[2] += __uint_as_float(rw.y << 16); acc[3] += __uint_as_float(rw.y & 0xffff0000u);
                        DBG_STAT(19, acc[0]); DBG_STAT(19, acc[1]); DBG_STAT(19, acc[2]); DBG_STAT(19, acc[3]);
                        v2u o; o.x = cvt_pk_bf16(acc[0], acc[1]); o.y = cvt_pk_bf16(acc[2], acc[3]); *(v2u*)(WSP(bf16, WS_RW_RH) + un * 4096 + row * 64 + c0) = o; }
                    else if (which == 1) {
#ifndef RW_NO_U0
                        acc = mm16(RM(9) + rt * 16 * 144, 144, RM(3) + ct * 16 * 144, 144, 64, acc, fr, fq);
#endif
                        acc = mm16(RM(10) + rt * 16 * 144, 144, RM(7) + ct * 16 * 144, 144, 64, acc, fr, fq);
                        DBG_STAT(20, acc[0]); DBG_STAT(20, acc[1]); DBG_STAT(20, acc[2]); DBG_STAT(20, acc[3]);
                        stb4(WSP(bf16, WS_RW_O0) + un * 4096 + row * 64 + c0, acc); }
                    else if (which == 2) { acc = mm16(RM(5) + rt * 16 * 144, 144, RM(2) + ct * 16 * 144, 144, 64, acc, fr, fq);
                        const float gd = GAMC[row]; if (row == c0) acc[0] += gd; if (row == c0 + 1) acc[1] += gd; if (row == c0 + 2) acc[2] += gd; if (row == c0 + 3) acc[3] += gd;
                        DBG_STAT(21, acc[0]); DBG_STAT(21, acc[1]); DBG_STAT(21, acc[2]); DBG_STAT(21, acc[3]);
                        v2u o; o.x = cvt_pk_bf16(acc[0], acc[1]); o.y = cvt_pk_bf16(acc[2], acc[3]);
                        *(v2u*)((unsigned char*)(WSP(bf16, WS_RW_GF) + un * 4096) + ((rt * 2 + (ct >> 1)) * 64 + ch) * 16 + (ct & 1) * 8) = o; }
                    else { acc = mm16(RM(3) + rt * 16 * 144, 144, RM(5) + ct * 16 * 144, 144, 64, acc, fr, fq); acc = mm16(RM(7) + rt * 16 * 144, 144, RM(6) + ct * 16 * 144, 144, 64, acc, fr, fq);
                        DBG_STAT(22, acc[0]); DBG_STAT(22, acc[1]); DBG_STAT(22, acc[2]); DBG_STAT(22, acc[3]);
                        *(f32x4*)(WSP(float, WS_RW_HT) + un * 4096 + row * 64 + c0) = acc; } } }
        }
        __syncthreads();
    }
#undef RM
}
__device__ __forceinline__ void rwkv_scan_wave(Frame& F, const Args& A, int wslot) {
    const int lane = F.lane, fr = lane & 15, fq = lane >> 4, bh = wslot >> 2, v0 = (wslot & 3) * 16;
    const bf16* GF = WSP(bf16, WS_RW_GF) + (size_t)bh * NCH * 4096; const float* HT = WSP(float, WS_RW_HT) + (size_t)bh * NCH * 4096 + (size_t)(v0 + fr) * 64 + 4 * fq;
    bf16* PT = WSP(bf16, WS_RW_PT) + (size_t)bh * NCH * 4096 + (size_t)(v0 + fr) * 64 + 4 * fq;
    f32x4 P[4] = {{0.f, 0.f, 0.f, 0.f}, {0.f, 0.f, 0.f, 0.f}, {0.f, 0.f, 0.f, 0.f}, {0.f, 0.f, 0.f, 0.f}};
    bf16x8 g0[4][2], g1[4][2], g2[4][2]; f32x4 h0[4], h1[4], h2[4];
#define RW2_LOAD(gx, hx, cc) do { _Pragma("unroll") for (int m = 0; m < 4; ++m) { hx[m] = *(const f32x4*)(HT + (size_t)(cc) * 4096 + 16 * m); \
        _Pragma("unroll") for (int s = 0; s < 2; ++s) gx[m][s] = *(const bf16x8*)(GF + (size_t)(cc) * 4096 + ((m * 2 + s) * 64 + lane) * 8); } } while (0)
#define RW2_STEP(gx, hx, cc) do { v4u bs[2]; \
        _Pragma("unroll") for (int s = 0; s < 2; ++s) { bs[s].x = cvt_pk_bf16(P[2 * s][0], P[2 * s][1]); bs[s].y = cvt_pk_bf16(P[2 * s][2], P[2 * s][3]); bs[s].z = cvt_pk_bf16(P[2 * s + 1][0], P[2 * s + 1][1]); bs[s].w = cvt_pk_bf16(P[2 * s + 1][2], P[2 * s + 1][3]); } \
        *(v2u*)(PT + (size_t)(cc) * 4096) = (v2u){bs[0].x, bs[0].y}; *(v2u*)(PT + (size_t)(cc) * 4096 + 16) = (v2u){bs[0].z, bs[0].w}; \
        *(v2u*)(PT + (size_t)(cc) * 4096 + 32) = (v2u){bs[1].x, bs[1].y}; *(v2u*)(PT + (size_t)(cc) * 4096 + 48) = (v2u){bs[1].z, bs[1].w}; \
        _Pragma("unroll") for (int m = 0; m < 4; ++m) { f32x4 acc = hx[m]; acc = __builtin_amdgcn_mfma_f32_16x16x32_bf16(gx[m][0], __builtin_bit_cast(bf16x8, bs[0]), acc, 0, 0, 0); \
            acc = __builtin_amdgcn_mfma_f32_16x16x32_bf16(gx[m][1], __builtin_bit_cast(bf16x8, bs[1]), acc, 0, 0, 0); P[m] = acc; } } while (0)
    RW2_LOAD(g0, h0, 0); RW2_LOAD(g1, h1, 1);
#pragma unroll 1
    for (int c = 0; c < 63; c += 3) {
        RW2_LOAD(g2, h2, c + 2); RW2_STEP(g0, h0, c);
        RW2_LOAD(g0, h0, c + 3); RW2_STEP(g1, h1, c + 1);
        if (c + 4 < NCH) RW2_LOAD(g1, h1, c + 4);
        RW2_STEP(g2, h2, c + 2);
    }
    RW2_STEP(g0, h0, 63);
#undef RW2_LOAD
#undef RW2_STEP
}
__device__ __forceinline__ void rwkv_stage3(Frame& F, const Args& A, int layer, int ub) {
    const int t0 = ub * 64, b_ = ub >> 6, c = ub & 63, lane = F.lane, wave = F.wave, fr = lane & 15, fq = lane >> 4, hh = wave >> 1;
    const size_t un = (size_t)(b_ * 4 + hh) * NCH + c;
    const bf16* RH = WSP(bf16, WS_RW_RH) + un * 4096; const bf16* PT = WSP(bf16, WS_RW_PT) + un * 4096; const bf16* O0 = WSP(bf16, WS_RW_O0) + un * 4096;
    const bf16* RW = WSP(bf16, WS_RW); const bf16* RG = WSP(bf16, WS_RW_G); bf16* mix = WSP(bf16, WS_MIX);
    const float* lg = KIN(I_RLNG) + layer * 256 + hh * 64; const float* lb = KIN(I_RLNB) + layer * 256 + hh * 64; const float* rk = KIN(I_RRK) + layer * 256 + hh * 64;
    bf16x8 pfr[4][2];
#pragma unroll
    for (int vt = 0; vt < 4; ++vt)
#pragma unroll
        for (int ks = 0; ks < 2; ++ks) pfr[vt][ks] = *(const bf16x8*)(PT + (size_t)(vt * 16 + fr) * 64 + ks * 32 + fq * 8);
#pragma unroll 1
    for (int i = 0; i < 2; ++i) { const int tt = 2 * (wave & 1) + i, tl = tt * 16 + fr, t = t0 + tl;
        const bf16x8 ra0 = *(const bf16x8*)(RH + (size_t)tl * 64 + fq * 8), ra1 = *(const bf16x8*)(RH + (size_t)tl * 64 + 32 + fq * 8);
        f32x4 ov[4]; float sm = 0.f;
#pragma unroll
        for (int vt = 0; vt < 4; ++vt) { f32x4 acc = ldb4(O0 + tl * 64 + vt * 16 + 4 * fq);
            acc = __builtin_amdgcn_mfma_f32_16x16x32_bf16(pfr[vt][0], ra0, acc, 0, 0, 0); acc = __builtin_amdgcn_mfma_f32_16x16x32_bf16(pfr[vt][1], ra1, acc, 0, 0, 0);
            ov[vt] = acc; DBG_STAT(24, acc[0]); DBG_STAT(24, acc[1]); DBG_STAT(24, acc[2]); DBG_STAT(24, acc[3]); sm += (acc.x + acc.y) + (acc.z + acc.w); }
        sm += __shfl_xor(sm, 16); sm += __shfl_xor(sm, 32);
        const float mean = sm * (1.f / 64.f); float sq = 0.f;
#pragma unroll
        for (int vt = 0; vt < 4; ++vt) { ov[vt] = ov[vt] - mean; sq += (ov[vt].x * ov[vt].x + ov[vt].y * ov[vt].y) + (ov[vt].z * ov[vt].z + ov[vt].w * ov[vt].w); }
        sq += __shfl_xor(sq, 16); sq += __shfl_xor(sq, 32);
        const float rs = __builtin_amdgcn_rsqf(sq * (1.f / 64.f) + RWKV_GN_EPS);
        float bd = 0.f;
#pragma unroll
        for (int q = 0; q < 4; ++q) { const f32x4 r4 = ldb4(RW + (size_t)t * 768 + hh * 64 + fq * 16 + 4 * q), k4 = ldb4(RW + (size_t)t * 768 + 256 + hh * 64 + fq * 16 + 4 * q), c4 = *(const f32x4*)(rk + fq * 16 + 4 * q);
            bd += (r4.x * k4.x * c4.x + r4.y * k4.y * c4.y) + (r4.z * k4.z * c4.z + r4.w * k4.w * c4.w); }
        bd += __shfl_xor(bd, 16); bd += __shfl_xor(bd, 32);
#pragma unroll
        for (int vt = 0; vt < 4; ++vt) { const int col = vt * 16 + 4 * fq; const f32x4 g4 = *(const f32x4*)(lg + col), b4 = *(const f32x4*)(lb + col);
            const f32x4 v4 = ldb4(RW + (size_t)t * 768 + 512 + hh * 64 + col), gg = ldb4(RG + (size_t)t * 256 + hh * 64 + col);
            float e0 = (ov[vt].x * rs * g4.x + b4.x + bd * v4.x) * gg.x, e1 = (ov[vt].y * rs * g4.y + b4.y + bd * v4.y) * gg.y, e2 = (ov[vt].z * rs * g4.z + b4.z + bd * v4.z) * gg.z, e3 = (ov[vt].w * rs * g4.w + b4.w + bd * v4.w) * gg.w;
#ifdef RW_SANITIZE
            e0 = (fabsf(e0) < 1e30f) ? e0 : 0.f; e1 = (fabsf(e1) < 1e30f) ? e1 : 0.f; e2 = (fabsf(e2) < 1e30f) ? e2 : 0.f; e3 = (fabsf(e3) < 1e30f) ? e3 : 0.f;
#endif
            v2u o; o.x = cvt_pk_bf16(e0, e1); o.y = cvt_pk_bf16(e2, e3);
            *(v2u*)(mix + (size_t)t * D + 256 + hh * 64 + col) = o; } }
}

__device__ __forceinline__ void scans_elementwise(Frame& F, const Args& A) {
    const int nthr = F.G * 448, gt = F.vcu * 448 + (F.tid - 64);
    constexpr int N_SSD = 16 * 64 * 128 / 2, N_GLA = 16 * 32 * 64 / 2, N_MLC = 16 * 64 * 64 / 2, N_MLN = 16 * 64 / 2;
    for (int i = gt; i < N_SSD + N_GLA + N_MLC + N_MLN; i += nthr) {
        if (i < N_SSD) { const int bh = i >> 12, pn = (i & 4095) * 2; unsigned* base = (unsigned*)(WSP(bf16, WS_SSD_ST) + (size_t)bh * NCH * 8192 + pn); const float* dec = WSP(float, WS_SSD_DEC) + bh * NCH; float S0 = 0.f, S1 = 0.f;
#pragma unroll 1
            for (int c0 = 0; c0 < NCH; c0 += 32) { unsigned x[32]; float dd[32];
#pragma unroll
                for (int j = 0; j < 32; ++j) { x[j] = base[(size_t)(c0 + j) * 4096]; dd[j] = dec[c0 + j]; }
#pragma unroll
                for (int j = 0; j < 32; ++j) { base[(size_t)(c0 + j) * 4096] = cvt_pk_bf16(S0, S1); S0 = dd[j] * S0 + __uint_as_float(x[j] << 16); S1 = dd[j] * S1 + __uint_as_float(x[j] & 0xffff0000u); } }
        } else if (i < N_SSD + N_GLA) { const int k = i - N_SSD, bh = k >> 10, dv = (k & 1023) * 2, dd_ = dv >> 6, b = bh >> 2, hh = bh & 3; unsigned* base = (unsigned*)(WSP(bf16, WS_GLA_ST) + (size_t)bh * NCH * 2048 + dv); const float* dec = WSP(float, WS_GLA_DEC) + (size_t)b * NCH * 128 + hh * 32 + dd_; float S0 = 0.f, S1 = 0.f;
#pragma unroll 1
            for (int c0 = 0; c0 < NCH; c0 += 32) { unsigned x[32]; float dd[32];
#pragma unroll
                for (int j = 0; j < 32; ++j) { x[j] = base[(size_t)(c0 + j) * 1024]; dd[j] = dec[(c0 + j) * 128]; }
#pragma unroll
                for (int j = 0; j < 32; ++j) { base[(size_t)(c0 + j) * 1024] = cvt_pk_bf16(S0, S1); S0 = dd[j] * S0 + __uint_as_float(x[j] << 16); S1 = dd[j] * S1 + __uint_as_float(x[j] & 0xffff0000u); } }
        } else { const int k = i - N_SSD - N_GLA; const bool isn = k >= N_MLC; const int kk = isn ? k - N_MLC : k; const int bh = isn ? (kk >> 5) : (kk >> 11), e = (isn ? (kk & 31) : (kk & 2047)) * 2, str = isn ? 32 : 2048;
            unsigned* base = (unsigned*)((isn ? WSP(bf16, WS_ML_N) : WSP(bf16, WS_ML_C)) + (size_t)bh * NCH * str * 2 + e); const float* bl = WSP(float, WS_ML_BL) + bh * NCH; const float* ml = WSP(float, WS_ML_ML) + bh * NCH; float* mo = WSP(float, WS_ML_M) + bh * NCH;
            float S0 = 0.f, S1 = 0.f, m = 0.f;
#pragma unroll 1
            for (int c0 = 0; c0 < NCH; c0 += 32) { unsigned x[32]; float b8[32], m8[32];
#pragma unroll
                for (int j = 0; j < 32; ++j) { x[j] = base[(size_t)(c0 + j) * str]; b8[j] = bl[c0 + j]; m8[j] = ml[c0 + j]; }
#pragma unroll
                for (int j = 0; j < 32; ++j) { const float mn = fmaxf(b8[j] + m, m8[j]); const float so = __expf(b8[j] + m - mn), sn = __expf(m8[j] - mn);
                    base[(size_t)(c0 + j) * str] = cvt_pk_bf16(S0, S1); if (!isn && e == 0) mo[c0 + j] = m; S0 = so * S0 + sn * __uint_as_float(x[j] << 16); S1 = so * S1 + sn * __uint_as_float(x[j] & 0xffff0000u); m = mn; } }
        }
    }
}
#ifndef MK_PER_PHASE_LAUNCH
#define MK_PER_PHASE_LAUNCH 0
#endif
#ifndef PH_MASK
#define PH_MASK 0xFFF
#endif
#ifndef ST_MASK
#define ST_MASK 0xF
#endif
#define ST_ON(k) (((ST_MASK) >> (k)) & 1)
#ifndef DUP_MASK
#define DUP_MASK 0
#endif
#define DUP_N(k) ((((DUP_MASK) >> (k)) & 1) ? 2 : 1)
#ifndef ST_DUP
#define ST_DUP 0
#endif
#define ST_REP(ty) ((((ST_DUP) >> (ty)) & 1) ? 2 : 1)
#define PH_ON(k) (((PH_MASK) >> (k)) & 1)
constexpr int PH_PER_LAYER = 11, N_PHASES = 1 + DEPTH * PH_PER_LAYER;
__global__ void __launch_bounds__(NWAVES * 64, 2) fwd_kernel(Args args) {
    extern __shared__ __attribute__((aligned(16))) unsigned char lds[];
    Frame F;
    F.lds = (LAS unsigned char*)lds;
    F.MISC = (volatile LAS unsigned*)(F.lds + MISC_OFF);
    F.tid = threadIdx.x; F.lane = F.tid & 63; F.wave = __builtin_amdgcn_readfirstlane(F.tid >> 6);
    F.G = gridDim.x; { const int bx = blockIdx.x; F.vcu = (F.G % 8 == 0) ? (bx % 8) * (F.G / 8) + bx / 8 : bx; }
    F.ka = (karg_t)__builtin_amdgcn_kernarg_segment_ptr(); F.ws = args.ws; F.ctl = (gu32*)(args.ws + WS_CTL); F.out = args.out;
    for (int i = F.tid; i < 256; i += NWAVES * 64) F.MISC[i] = 0u;
    __syncthreads();
    const int lo = args.ph_lo, hi = args.ph_hi;
#ifdef DBG_TSEL
    if (blockIdx.x == 0 && threadIdx.x == 0) __hip_atomic_store(F.ctl + CW_DBG + 15, (unsigned)__builtin_amdgcn_s_memrealtime(), RLX_AGENT);
#endif
    XcdBarrier bar; bar.bar = (unsigned*)(F.ctl + CW_BAR); bar.x = 0; bar.st = nullptr;
    if (hi - lo > 1) bar = xcd_barrier_post((unsigned*)(F.ctl + CW_BAR), F.MISC + MW_BAR);
#define IN_(k) (lo <= (k) && (k) < hi)
#ifdef DBG_TSEL
#ifndef DBG_TQ
#define DBG_TQ 50.0f
#endif
#define TSTAMP(k) do { if (blockIdx.x == 0 && threadIdx.x == 0) __hip_atomic_store(F.ctl + CW_DBG + 16 + ((k) == 11 ? 0 : 1 + layer_ * PH_PER_LAYER + (k)), (unsigned)__builtin_amdgcn_s_memrealtime(), RLX_AGENT); } while (0)
#else
#define TSTAMP(k) do { } while (0)
#endif
#ifdef BAR_DUP
#define SEAM(k) do { if (IN_(k) && IN_((k) + 1)) { xcd_barrier(bar); xcd_barrier(bar); } } while (0)
#else
#define SEAM(k) do { if (IN_(k) && IN_((k) + 1)) xcd_barrier(bar); } while (0)
#endif

    if (PH_ON(11) && IN_(0)) { for (int rep_ = 0; rep_ < DUP_N(11); ++rep_) { frame_refresh(F); p0_prologue(F, args); } SEAM(0); { const int layer_ = 0; TSTAMP(11); (void)layer_; } }
#pragma unroll 1
    for (int layer = 0; layer < DEPTH; ++layer) {
        const int pb = 1 + layer * PH_PER_LAYER; const int layer_ = layer; (void)layer_;
        if (PH_ON(0) && IN_(pb + 0)) { for (int rep_ = 0; rep_ < DUP_N(0); ++rep_) { frame_refresh(F);
            { pg8::DenseSched S; S.init(WSP(bf16, WS_XB), WSP(bf16, WS_WIN_T) + (size_t)layer * NUP * D, T, NUP, D, F.G, (int)blockIdx.x);
              pg8::EpiB16 E{WSP(bf16, WS_U), NUP, nullptr, 0.f};
              pg8::gemm_phase<pg8::EpiB16, pg8::DenseSched>(F.lds, F.tid, S, E); }
            if (F.G != 256 || blockIdx.x >= 128)
            { pg8::DenseSched S; if (F.G == 256) S.init(WSP(bf16, WS_PB) + (size_t)layer * T * 256, WSP(bf16, WS_WPP_T) + (size_t)layer * D * 256, T, D, 256, 128, (int)blockIdx.x - 128); else S.init(WSP(bf16, WS_PB) + (size_t)layer * T * 256, WSP(bf16, WS_WPP_T) + (size_t)layer * D * 256, T, D, 256, F.G, (int)blockIdx.x);
              pg8::EpiB16 E{WSP(bf16, WS_PE), D, nullptr, 0.f};
              pg8::gemm_phase<pg8::EpiB16, pg8::DenseSched>(F.lds, F.tid, S, E); }
            } SEAM(pb + 0); TSTAMP(0);
        }
        if (PH_ON(1) && IN_(pb + 1)) { for (int rep_ = 0; rep_ < DUP_N(1); ++rep_) { frame_refresh(F);
            for (int un = F.vcu; un < 1024; un += F.G) { frame_refresh(F); const int ty = un >> 8, r = un & 255, b = r >> 6, c = r & 63;
                if (ty == 0) { ssd_stage1(F, args, layer, b, c); if (ST_DUP & 1) ssd_stage1(F, args, layer, b, c); } else if (ty == 1) { gla_stage1(F, args, layer, b, c); if (ST_DUP & 2) gla_stage1(F, args, layer, b, c); } else if (ty == 2) { mlstm_stage1(F, args, layer, b, c); if (ST_DUP & 4) mlstm_stage1(F, args, layer, b, c); } else { rwkv_stage1(F, args, layer, r); if (ST_DUP & 8) rwkv_stage1(F, args, layer, r); } }
            } SEAM(pb + 1); TSTAMP(1);
        }
        if (PH_ON(2) && IN_(pb + 2)) { for (int rep_ = 0; rep_ < DUP_N(2); ++rep_) { frame_refresh(F);
            if (F.wave == 0) { for (int ws_ = F.vcu; ws_ < 64; ws_ += F.G) rwkv_scan_wave(F, args, ws_); }
            else if (rep_ == 0) scans_elementwise(F, args);
            } SEAM(pb + 2); TSTAMP(2);
        }
        if (PH_ON(3) && IN_(pb + 3)) { for (int rep_ = 0; rep_ < DUP_N(3); ++rep_) { frame_refresh(F);
            for (int un = F.vcu; un < 1024; un += F.G) { frame_refresh(F); const int ty = un >> 8, r = un & 255, b = r >> 6, c = r & 63;
                if (ty == 0) { ssd_stage3(F, args, layer, b, c); if (ST_DUP & 16) ssd_stage3(F, args, layer, b, c); } else if (ty == 1) { gla_stage3(F, args, layer, b, c); if (ST_DUP & 32) gla_stage3(F, args, layer, b, c); } else if (ty == 2) { mlstm_stage3(F, args, layer, b, c); if (ST_DUP & 64) mlstm_stage3(F, args, layer, b, c); } else { rwkv_stage3(F, args, layer, r); if (ST_DUP & 128) rwkv_stage3(F, args, layer, r); } }
            } SEAM(pb + 3); TSTAMP(3);
        }
        if (PH_ON(4) && IN_(pb + 4)) { for (int rep_ = 0; rep_ < DUP_N(4); ++rep_) { frame_refresh(F);
            pg8::DenseSched S; S.init(WSP(bf16, WS_MIX), WSP(bf16, WS_WOUT_T) + (size_t)layer * D * D, T, D, D, F.G, (int)blockIdx.x);
            pg8::EpiB16 E{WSP(bf16, WS_Y1), D, WSP(bf16, WS_XB), DN_ALPHA};
            pg8::gemm_phase<pg8::EpiB16, pg8::DenseSched>(F.lds, F.tid, S, E);
            } SEAM(pb + 4); TSTAMP(4);
        }
        if (PH_ON(5) && IN_(pb + 5)) { if (DUP_N(5) == 2) { frame_refresh(F); p6_ln1_router<true>(F, args, layer); } frame_refresh(F); p6_ln1_router<false>(F, args, layer); SEAM(pb + 5); TSTAMP(5); }
        if (PH_ON(6) && IN_(pb + 6)) { for (int rep_ = 0; rep_ < DUP_N(6); ++rep_) { frame_refresh(F);
            moe_build_pfx(F, args, layer, 8);
            pg8::Moe1Sched S; S.O.pfx = F.MISC + MW_PFX; S.O.NT = 8; S.O.G = F.G; S.O.c = (int)blockIdx.x; S.sdest = WSP(int, WS_SDEST);
            if (MOE_FP8) { S.X = WSP(unsigned char, WS_X1Q); S.W = WSP(unsigned char, WS_WGU_Q) + (size_t)layer * NE * 2048 * D; S.K = D / 2; S.hstepB = (size_t)1024 * D; }
            else { S.X = WSP(unsigned char, WS_X1B); S.W = WSP(unsigned char, WS_WGU_T) + (size_t)layer * NE * 2048 * D * 2; S.K = D; S.hstepB = (size_t)1024 * D * 2; }
            pg8::EpiMoe1 E{WSP(bf16, WS_ABUF), KIN(I_BGU) + (size_t)layer * NE * 2048, WSP(unsigned char, WS_ABUFQ)};
            pg8::gemm_phase<pg8::EpiMoe1, pg8::Moe1Sched>(F.lds, F.tid, S, E);
            } SEAM(pb + 6); TSTAMP(6);
        }
        if (PH_ON(7) && IN_(pb + 7)) { for (int rep_ = 0; rep_ < DUP_N(7); ++rep_) { frame_refresh(F);
            moe_build_pfx(F, args, layer, 4);
            pg8::Moe2Sched S; S.O.pfx = F.MISC + MW_PFX; S.O.NT = 4; S.O.G = F.G; S.O.c = (int)blockIdx.x; if (MOE2_FP8) { S.Ab = WSP(unsigned char, WS_ABUFQ); S.W = WSP(unsigned char, WS_WDN_Q) + (size_t)layer * NE * D * D; S.K = D / 2; S.hstepB = (size_t)128 * D; }
            else { S.Ab = WSP(unsigned char, WS_ABUF); S.W = WSP(unsigned char, WS_WDN_T) + (size_t)layer * NE * D * D * 2; S.K = D; S.hstepB = (size_t)128 * D * 2; }
            pg8::EpiMoe2 E{WSP(bf16, WS_YBUF), KIN(I_BDN) + (size_t)layer * NE * D, WSP(int, WS_SDEST), WSP(float, WS_SGATE)};
            pg8::gemm_phase<pg8::EpiMoe2, pg8::Moe2Sched>(F.lds, F.tid, S, E);
            } SEAM(pb + 7); TSTAMP(7);
        }
        if (PH_ON(8) && IN_(pb + 8)) { for (int rep_ = 0; rep_ < DUP_N(8); ++rep_) { frame_refresh(F); p9_combine(F, args); } SEAM(pb + 8); TSTAMP(8); }
        if (PH_ON(9) && IN_(pb + 9)) { for (int rep_ = 0; rep_ < DUP_N(9); ++rep_) { frame_refresh(F);
            pg8::DenseSched S; S.init(WSP(bf16, WS_HB), WSP(bf16, WS_WPG_T) + (size_t)layer * D * D, T, D, D, F.G, (int)blockIdx.x);
            pg8::EpiPle E{WSP(bf16, WS_H2), WSP(bf16, WS_HB), WSP(bf16, WS_PE)};
            pg8::gemm_phase<pg8::EpiPle, pg8::DenseSched>(F.lds, F.tid, S, E);
            } SEAM(pb + 9); TSTAMP(9);
        }
        if (PH_ON(10) && IN_(pb + 10)) { for (int rep_ = 0; rep_ < DUP_N(10); ++rep_) { frame_refresh(F); p11_ln2(F, args, layer); } SEAM(pb + 10); TSTAMP(10); }
    }
#ifdef DBG_TSEL
    if (hi - lo > 1) { xcd_barrier(bar);
        unsigned ticks = 0u;
        if (DBG_TSEL == 11) ticks = __hip_atomic_load(F.ctl + CW_DBG + 16, RLX_AGENT) - __hip_atomic_load(F.ctl + CW_DBG + 15, RLX_AGENT);
        else for (int l = 0; l < DEPTH; ++l) { const int pi = 1 + l * PH_PER_LAYER + DBG_TSEL; ticks += __hip_atomic_load(F.ctl + CW_DBG + 16 + pi, RLX_AGENT) - __hip_atomic_load(F.ctl + CW_DBG + 16 + pi - 1, RLX_AGENT); }
        const float us = floorf((float)ticks * 0.01f / DBG_TQ) * DBG_TQ; const float code = sqrtf(us * 0.05f);
        for (size_t i = (size_t)blockIdx.x * 512 + threadIdx.x; i < (size_t)T * D; i += (size_t)gridDim.x * 512) F.out[i] = code; }
#endif
#ifdef DBG_SEL
    if (hi - lo > 1) { xcd_barrier(bar);
        const unsigned mx = __hip_atomic_load(F.ctl + CW_DBG, RLX_AGENT), nf = __hip_atomic_load(F.ctl + CW_DBG + 1, RLX_AGENT);
        float code;
        { const float m = __uint_as_float(mx); int b = (m > 0.f) ? (int)floorf(log10f(m)) + 30 : 0; b = b < 0 ? 0 : (b > 60 ? 60 : b); if (nf) b += 100; code = sqrtf(10.0f * (float)(b + 1)); }
        for (size_t i = (size_t)blockIdx.x * 512 + threadIdx.x; i < (size_t)T * D; i += (size_t)gridDim.x * 512) F.out[i] = code; }
#endif
#undef IN_
#undef SEAM
}

extern "C" void kernel_launch(void* const* d_in, const int* in_sizes, int n_in, void* d_out, int out_size, void* d_ws, size_t ws_size, hipStream_t stream) {
    static int grid = 0;
    if (grid == 0) {
        if (n_in != N_IN || out_size != T * D || ws_size < WS_END) { fprintf(stderr, "kernel_launch: unexpected shapes (n_in %d, out %d, ws %zu < %zu); nothing launched\n", n_in, out_size, ws_size, (size_t)WS_END); grid = -1; return; }
        int dev = 0, cus = 0, per_cu = 0;
        if (hipGetDevice(&dev) != hipSuccess || hipDeviceGetAttribute(&cus, hipDeviceAttributeMultiprocessorCount, dev) != hipSuccess) { grid = -1; return; }
        if (hipFuncSetAttribute((const void*)fwd_kernel, hipFuncAttributeMaxDynamicSharedMemorySize, LDS_BYTES) != hipSuccess) { fprintf(stderr, "kernel_launch: hipFuncSetAttribute failed\n"); grid = -1; return; }
        if (hipOccupancyMaxActiveBlocksPerMultiprocessor(&per_cu, (const void*)fwd_kernel, NWAVES * 64, LDS_BYTES) != hipSuccess || per_cu < 1) { fprintf(stderr, "kernel_launch: occupancy query says %d blocks per CU\n", per_cu); }
        (void)hipGetLastError();
        grid = cus;
    }
    if (grid < 0) return;
    (void)hipMemsetAsync((char*)d_ws + WS_CTL, 0, CTL_ZERO_BYTES, stream);
    Args a{};
    for (int i = 0; i < N_IN; ++i) a.in[i] = (const float*)d_in[i];
    a.out = (float*)d_out; a.ws = (unsigned char*)d_ws;
#if MK_PER_PHASE_LAUNCH
    for (int ph = 0; ph < N_PHASES; ++ph) { a.ph_lo = ph; a.ph_hi = ph + 1; hipLaunchKernelGGL(fwd_kernel, dim3(grid), dim3(NWAVES * 64), LDS_BYTES, stream, a); }
#else
    a.ph_lo = 0; a.ph_hi = N_PHASES; hipLaunchKernelGGL(fwd_kernel, dim3(grid), dim3(NWAVES * 64), LDS_BYTES, stream, a);
#endif
    const hipError_t le = hipPeekAtLastError();
    if (le != hipSuccess) fprintf(stderr, "kernel_launch: launch failed: %s\n", hipGetErrorName(le));
}
```

```cpp
#include <hip/hip_runtime.h>
#include <cstdio>
#include <cstdint>

#define GAS __attribute__((address_space(1)))
#define LAS __attribute__((address_space(3)))
typedef unsigned short bf16;
typedef unsigned v4u __attribute__((ext_vector_type(4)));
typedef unsigned v2u __attribute__((ext_vector_type(2)));
typedef float f32x4 __attribute__((ext_vector_type(4)));
typedef float f32x2 __attribute__((ext_vector_type(2)));
typedef short bf16x8 __attribute__((ext_vector_type(8)));
typedef int v4i_t __attribute__((ext_vector_type(4)));
typedef int v8i_t __attribute__((ext_vector_type(8)));
typedef GAS unsigned gu32;
#define RLX_AGENT __ATOMIC_RELAXED, __HIP_MEMORY_SCOPE_AGENT
#define LDS_WAIT() asm volatile("s_waitcnt lgkmcnt(0)" ::: "memory")
#define VM_WAIT() asm volatile("s_waitcnt vmcnt(0)" ::: "memory")

constexpr int NWAVES = 8;
constexpr int DEPTH = 4, BATCH = 4, SEQ = 4096, D = 1024, T = BATCH * SEQ;
constexpr int NU = 3484, NUP = 3584;
constexpr int NE = 32, TOPK = 4, ECAP = 16384;
constexpr int NCH = SEQ / 64;
constexpr int U_SSD_Z = 0, U_SSD_X = 256, U_SSD_B = 512, U_SSD_C = 640, U_SSD_DT = 768;
constexpr int U_RW = 772, U_RW_R = 772, U_RW_K = 1028, U_RW_V = 1284, U_RW_LO = 1540;
constexpr int U_GL_Q = 1668, U_GL_K = 1796, U_GL_V = 1924, U_GL_G = 2180, U_GL_OG = 2196;
constexpr int U_ML_Q = 2452, U_ML_K = 2708, U_ML_V = 2964, U_ML_I = 3220, U_ML_F = 3224, U_ML_O = 3228;
constexpr float DN_ALPHA = 1.6817928305074290f;
constexpr float LN_EPS = 1e-5f, NORM_EPS = 1e-5f, RWKV_GN_EPS = 64e-5f;

enum { I_X = 0, I_P, I_WIN, I_WOUT, I_LN1G, I_LN1B, I_SCW, I_SCB, I_SALOG, I_SDTB, I_SD, I_SNG,
       I_RMU, I_RW0, I_RWUP, I_RA0, I_RAUP, I_RGUP, I_RKK, I_RKA, I_RRK, I_RLNG, I_RLNB,
       I_GGUP, I_GGB, I_GNG, I_MCW, I_MCB, I_MIB, I_MFB, I_MNG,
       I_RTW, I_RTB, I_WGU, I_BGU, I_WDN, I_BDN, I_PGW, I_PPJ, I_LN2G, I_LN2B, N_IN };

constexpr size_t MiB = 1u << 20;
constexpr size_t WS_CTL = 0, CTL_ZERO_BYTES = 1 * MiB;
constexpr size_t WS_WIN_T = 2 * MiB;
constexpr size_t WS_WOUT_T = WS_WIN_T + (size_t)DEPTH * NUP * D * 2;
constexpr size_t WS_WGU_T = WS_WOUT_T + (size_t)DEPTH * D * D * 2;
constexpr size_t WS_WDN_T = WS_WGU_T + (size_t)DEPTH * NE * 2048 * D * 2;
constexpr size_t WS_WPG_T = WS_WDN_T + (size_t)DEPTH * NE * D * D * 2;
constexpr size_t WS_WPP_T = WS_WPG_T + (size_t)DEPTH * D * D * 2;
constexpr size_t WS_RWT = WS_WPP_T + (size_t)DEPTH * D * 256 * 2;
constexpr size_t WS_PB = WS_RWT + (size_t)DEPTH * NE * D * 4;
constexpr size_t WS_XB = WS_PB + (size_t)DEPTH * T * 256 * 2;
constexpr size_t WS_U = WS_XB + (size_t)T * D * 2;
constexpr size_t WS_PE = WS_U + (size_t)T * NUP * 2;
constexpr size_t WS_MIX = WS_PE + (size_t)T * D * 4;
constexpr size_t WS_Y1 = WS_MIX + (size_t)T * D * 2;
constexpr size_t WS_X1 = WS_Y1 + (size_t)T * D * 4;
constexpr size_t WS_X1B = WS_X1 + (size_t)T * D * 4;
constexpr size_t WS_SDEST = WS_X1B + (size_t)T * D * 2;
constexpr size_t WS_SGATE = WS_SDEST + (size_t)NE * ECAP * 4;
constexpr size_t WS_ABUF = WS_SGATE + (size_t)NE * ECAP * 4;
constexpr size_t WS_YBUF = WS_ABUF + (size_t)NE * ECAP * D * 2;
constexpr size_t WS_H = WS_YBUF + (size_t)T * 4 * D * 2;
constexpr size_t WS_HB = WS_H + (size_t)T * D * 4;
constexpr size_t WS_H2 = WS_HB + (size_t)T * D * 2;
constexpr size_t WS_SSD_ST = WS_H2 + (size_t)T * D * 4;
constexpr size_t WS_SSD_DEC = WS_SSD_ST + (size_t)16 * NCH * 64 * 128 * 4;
constexpr size_t WS_GLA_ST = WS_SSD_DEC + 16 * NCH * 4;
constexpr size_t WS_GLA_DEC = WS_GLA_ST + (size_t)16 * NCH * 32 * 64 * 4;
constexpr size_t WS_ML_C = WS_GLA_DEC + (size_t)4 * NCH * 128 * 4;
constexpr size_t WS_ML_N = WS_ML_C + (size_t)16 * NCH * 64 * 64 * 4;
constexpr size_t WS_ML_BL = WS_ML_N + (size_t)16 * NCH * 64 * 4;
constexpr size_t WS_ML_ML = WS_ML_BL + 16 * NCH * 4;
constexpr size_t WS_ML_M = WS_ML_ML + 16 * NCH * 4;
constexpr size_t WS_RW = WS_ML_M + 16 * NCH * 4;
constexpr size_t WS_RW_G = WS_RW + (size_t)T * 3 * 256 * 4;
constexpr size_t WS_RW_RH = WS_RW_G + (size_t)T * 256 * 4;
constexpr size_t WS_RW_O0 = WS_RW_RH + (size_t)1024 * 4096 * 2;
constexpr size_t WS_RW_GF = WS_RW_O0 + (size_t)1024 * 4096 * 4;
constexpr size_t WS_RW_HT = WS_RW_GF + (size_t)1024 * 4096 * 2;
constexpr size_t WS_RW_PT = WS_RW_HT + (size_t)1024 * 4096 * 4;
constexpr size_t WS_LORA = WS_RW_PT + (size_t)1024 * 4096 * 2;
constexpr int LORA_PER_LAYER = 8192 + 8192 + 16384 + 2048;
constexpr size_t WS_WGU_Q = WS_LORA + (size_t)DEPTH * LORA_PER_LAYER * 4;
constexpr size_t WS_WDN_Q = WS_WGU_Q + (size_t)DEPTH * NE * 2048 * D;
constexpr size_t WS_X1Q = WS_WDN_Q + (size_t)DEPTH * NE * D * D;
constexpr size_t WS_ABUFQ = WS_X1Q + (size_t)T * D;
constexpr size_t WS_END = WS_ABUFQ + (size_t)NE * ECAP * D;
#ifndef MOE_FP8
#define MOE_FP8 1
#endif
#ifndef MOE2_FP8
#define MOE2_FP8 1
#endif
constexpr int CW_BAR = 4096;
constexpr int CW_DBG = 32768;
constexpr int CW_CNT = 16384;

constexpr int RING_BYTES = 147456;
constexpr int MISC_OFF = RING_BYTES;
constexpr int LDS_BYTES = RING_BYTES + 1024;
constexpr int MW_BAR = 8, MW_LCNT = 32, MW_LBASE = 64, MW_PFX = 96, MW_CNT = 136, MW_GAMC = 168;

typedef __bf16 bf16x2_t __attribute__((ext_vector_type(2)));
__device__ __forceinline__ unsigned cvt_pk_bf16(float lo, float hi) { const f32x2 v = {lo, hi}; const bf16x2_t b = __builtin_convertvector(v, bf16x2_t); return __builtin_bit_cast(unsigned, b); }
__device__ __forceinline__ unsigned cvt4_fp8(float a, float b, float c, float d) { int w = 0; w = __builtin_amdgcn_cvt_pk_fp8_f32(a, b, w, false); w = __builtin_amdgcn_cvt_pk_fp8_f32(c, d, w, true); return (unsigned)w; }
__device__ __forceinline__ float bf2f(unsigned short b) { return __uint_as_float(((unsigned)b) << 16); }
__device__ __forceinline__ float sigmoidf_(float x) { return __builtin_amdgcn_rcpf(1.0f + __expf(-x)); }
__device__ __forceinline__ float siluf_(float x) { return x * __builtin_amdgcn_rcpf(1.0f + __expf(-x)); }
__device__ __forceinline__ float softplusf_(float x) { return fmaxf(x, 0.f) + __logf(1.0f + __expf(-fabsf(x))); }
__device__ __forceinline__ float logsigmoidf_(float x) { return fminf(x, 0.f) - __logf(1.0f + __expf(-fabsf(x))); }
__device__ __forceinline__ float tanhf_(float x) { const float e = __expf(-2.0f * fabsf(x)); const float t = (1.0f - e) * __builtin_amdgcn_rcpf(1.0f + e); return x < 0.f ? -t : t; }
__device__ __forceinline__ int lane_now() { int l = (int)__builtin_amdgcn_mbcnt_hi(~0u, __builtin_amdgcn_mbcnt_lo(~0u, 0u)); asm volatile("" : "+v"(l)); return l; }
__device__ __forceinline__ float my_shfl_idx(float v, int src) { return __builtin_bit_cast(float, __builtin_amdgcn_ds_bpermute(src << 2, __builtin_bit_cast(int, v))); }
__device__ __forceinline__ int my_shfl_idx(int v, int src) { return __builtin_amdgcn_ds_bpermute(src << 2, v); }
template <class V> __device__ __forceinline__ V my_shfl_xor(V v, int o) { return my_shfl_idx(v, lane_now() ^ o); }
template <class V> __device__ __forceinline__ V my_shfl_up(V v, int o) { const int l = lane_now(); return my_shfl_idx(v, l >= o ? l - o : l); }
#define __shfl_xor(v, o) my_shfl_xor(v, o)
#define __shfl_up(v, o) my_shfl_up(v, o)
#define __shfl(v, s) my_shfl_idx(v, s)
__device__ __forceinline__ float wave_sum(float v) {
#pragma unroll
    for (int o = 1; o < 64; o <<= 1) v += __shfl_xor(v, o);
    return v;
}
__device__ __forceinline__ float wave_max(float v) {
#pragma unroll
    for (int o = 1; o < 64; o <<= 1) v = fmaxf(v, __shfl_xor(v, o));
    return v;
}
__device__ __forceinline__ float wave_scan_add(float v, int lane) {
#pragma unroll
    for (int o = 1; o < 64; o <<= 1) { const float t = __shfl_up(v, o); if (lane >= o) v += t; }
    return v;
}
__device__ __forceinline__ float wave_scan_max(float v, int lane) {
#pragma unroll
    for (int o = 1; o < 64; o <<= 1) { const float t = __shfl_up(v, o); if (lane >= o) v = fmaxf(v, t); }
    return v;
}
__device__ __forceinline__ f32x4 mm16(const LAS unsigned char* A, int lda, const LAS unsigned char* B, int ldb, int K, f32x4 acc, int fr, int fq) {
    const LAS unsigned char* ap = A + fr * lda + fq * 16; const LAS unsigned char* bp = B + fr * ldb + fq * 16;
    for (int k = 0; k < K; k += 32) {
        const bf16x8 a = *(const LAS bf16x8*)(ap + k * 2); const bf16x8 b = *(const LAS bf16x8*)(bp + k * 2);
        acc = __builtin_amdgcn_mfma_f32_16x16x32_bf16(b, a, acc, 0, 0, 0);
    }
    return acc;
}
__device__ __forceinline__ f32x4 mm16_gB(const LAS unsigned char* A, int lda, const float* B, int ldb, int K, f32x4 acc, int fr, int fq) {
    const LAS unsigned char* ap = A + fr * lda + fq * 16; const float* bp = B + (size_t)fr * ldb + fq * 8;
    for (int k = 0; k < K; k += 32) {
        const bf16x8 a = *(const LAS bf16x8*)(ap + k * 2);
        const f32x4 b0 = *(const f32x4*)(bp + k), b1 = *(const f32x4*)(bp + k + 4);
        v4u bw; bw.x = cvt_pk_bf16(b0.x, b0.y); bw.y = cvt_pk_bf16(b0.z, b0.w); bw.z = cvt_pk_bf16(b1.x, b1.y); bw.w = cvt_pk_bf16(b1.z, b1.w);
        const bf16x8 b = __builtin_bit_cast(bf16x8, bw);
        acc = __builtin_amdgcn_mfma_f32_16x16x32_bf16(b, a, acc, 0, 0, 0);
    }
    return acc;
}
__device__ __forceinline__ f32x4 mm16_gAB(const bf16* A, int lda, const bf16* B, int ldb, int K, f32x4 acc, int fr, int fq) {
    const bf16* ap = A + (size_t)fr * lda + fq * 8; const bf16* bp = B + (size_t)fr * ldb + fq * 8;
    for (int k = 0; k < K; k += 32) { const bf16x8 a = *(const bf16x8*)(ap + k), b = *(const bf16x8*)(bp + k); acc = __builtin_amdgcn_mfma_f32_16x16x32_bf16(b, a, acc, 0, 0, 0); }
    return acc;
}
__device__ __forceinline__ bf16x8 ldfrag_f32(const float* p) { const f32x4 b0 = *(const f32x4*)p, b1 = *(const f32x4*)(p + 4);
    v4u bw; bw.x = cvt_pk_bf16(b0.x, b0.y); bw.y = cvt_pk_bf16(b0.z, b0.w); bw.z = cvt_pk_bf16(b1.x, b1.y); bw.w = cvt_pk_bf16(b1.z, b1.w); return __builtin_bit_cast(bf16x8, bw); }
template <int NK> __device__ __forceinline__ f32x4 mm16_rB(const LAS unsigned char* A, int lda, const bf16x8 (&b)[NK], f32x4 acc, int fr, int fq) {
    const LAS unsigned char* ap = A + fr * lda + fq * 16;
#pragma unroll
    for (int k = 0; k < NK; ++k) { const bf16x8 a = *(const LAS bf16x8*)(ap + k * 64); acc = __builtin_amdgcn_mfma_f32_16x16x32_bf16(b[k], a, acc, 0, 0, 0); }
    return acc;
}
__device__ __forceinline__ v4u pack8(const float (&v)[8]) { v4u o; o.x = cvt_pk_bf16(v[0], v[1]); o.y = cvt_pk_bf16(v[2], v[3]); o.z = cvt_pk_bf16(v[4], v[5]); o.w = cvt_pk_bf16(v[6], v[7]); return o; }

#define XB_TMO      128
#define XB_XCNT(j)  (256  + 64 * (j))
#define XB_XSUB(j)  (1280 + 64 * (j))
#define XB_XGEN(j)  (2304 + 64 * (j))
#define XB_TOP      3328
#define XB_TOPGEN   3392
#define XCD_BAR_WORDS 3456
#define XB_SPIN_CAP (1u << 18)
__device__ __forceinline__ unsigned xb_ld(unsigned* p)              { return __hip_atomic_load(p, __ATOMIC_RELAXED, __HIP_MEMORY_SCOPE_AGENT); }
__device__ __forceinline__ unsigned xb_add(unsigned* p, unsigned v) { return __hip_atomic_fetch_add(p, v, __ATOMIC_RELAXED, __HIP_MEMORY_SCOPE_AGENT); }
__device__ __forceinline__ unsigned xb_xcc_id() { return (unsigned)__builtin_amdgcn_s_getreg((3 << 11) | 20) & 0xFu; }
#define XB_SPIN(cond, bar) do { unsigned _sp = 0; while (cond) { __builtin_amdgcn_s_sleep(1); \
    if ((++_sp & 255u) == 0u) { if (xb_ld(&(bar)[XB_TMO])) break; if (_sp > XB_SPIN_CAP) { atomicAdd(&(bar)[XB_TMO], 1u); break; } } } } while (0)
struct XcdBarrier { unsigned* bar; unsigned x; volatile LAS unsigned* st; };
__device__ __forceinline__ XcdBarrier xcd_barrier_post(unsigned* bar, volatile LAS unsigned* st) {
    XcdBarrier b; b.bar = bar; b.x = xb_xcc_id(); b.st = st;
    if (threadIdx.x == 0) (void)xb_add(&bar[XB_XCNT(b.x)], 1u);
    return b;
}
__device__ __forceinline__ void xcd_barrier_complete(unsigned* bar, unsigned x, unsigned& nloc, unsigned& nx) {
    const unsigned G = gridDim.x * gridDim.y * gridDim.z;
    unsigned sum, cnt, mine, sp = 0u;
    for (;;) {
        sum = 0u; cnt = 0u; mine = 0u;
#pragma unroll
        for (unsigned j = 0; j < 16; ++j) { const unsigned c = xb_ld(&bar[XB_XCNT(j)]); sum += c; cnt += (c > 0u) ? 1u : 0u; mine = (j == x) ? c : mine; }
        if (sum == G) break;
        __builtin_amdgcn_s_sleep(1);
        if ((++sp & 255u) == 0u) { if (xb_ld(&bar[XB_TMO])) break; if (sp > XB_SPIN_CAP) { atomicAdd(&bar[XB_TMO], 1u); break; } }
    }
    nloc = mine > 0u ? mine : 1u; nx = cnt > 0u ? cnt : 1u;
}
__device__ __forceinline__ void xcd_barrier(const XcdBarrier& b) {
    asm volatile("s_waitcnt vmcnt(0)" ::: "memory");
    __syncthreads();
    if (threadIdx.x == 0) {
        unsigned* bar = b.bar;
        __builtin_amdgcn_s_waitcnt(0);
        unsigned nloc = b.st[0], nx = b.st[1];
        if (nloc == 0u) { xcd_barrier_complete(bar, b.x, nloc, nx); b.st[0] = nloc; b.st[1] = nx; }
        const unsigned old = xb_add(&bar[XB_XSUB(b.x)], 1u);
        const unsigned gen = old / nloc;
        if (old + 1u == (gen + 1u) * nloc) {
            __builtin_amdgcn_fence(__ATOMIC_RELEASE, "agent");
            asm volatile("s_waitcnt vmcnt(0)" ::: "memory");
            const unsigned og = xb_add(&bar[XB_TOP], 1u);
            const unsigned tg = og / nx;
            if (og + 1u == (tg + 1u) * nx) xb_add(&bar[XB_TOPGEN], 1u);
            else XB_SPIN(xb_ld(&bar[XB_TOPGEN]) == tg, bar);
            __builtin_amdgcn_fence(__ATOMIC_ACQUIRE, "agent");
            xb_add(&bar[XB_XGEN(b.x)], 1u);
            asm volatile("s_waitcnt vmcnt(0)" ::: "memory");
        } else {
            XB_SPIN(xb_ld(&bar[XB_XGEN(b.x)]) == gen, bar);
            __builtin_amdgcn_fence(__ATOMIC_ACQUIRE, "agent");
            asm volatile("s_waitcnt vmcnt(0)" ::: "memory");
        }
    }
    __syncthreads();
}

namespace pg8 {
constexpr int BM = 256, BK = 64, HALF = 128, HTB = HALF * BK * 2, STAGE_BYTES = 8 * HTB, NXCD = 8, WGM = 8;
__host__ __device__ __forceinline__ int lds_byte(int r, int c) { const int st = (r >> 4) * 2 + (c >> 5), rr = r & 15, cc = c & 31, ob = rr * 64 + cc * 2; return st * 1024 + (ob ^ (((ob >> 9) & 1) << 5)); }
__host__ __device__ __forceinline__ void stage_rc(int b, int& R, int& C) { const int st = b / 1024, sb = b % 1024, swz = sb ^ (((sb >> 9) & 1) << 5); R = (st >> 1) * 16 + swz / 64; C = (st & 1) * 32 + (swz % 64) / 2; }
__host__ __device__ __forceinline__ int perm32(int rho) { const int n = rho >> 4, i = rho & 15; return 8 * (i >> 2) + 4 * n + (i & 3); }

template <class Epi, class Sched>
__device__ __forceinline__ void gemm_phase(LAS unsigned char* lds, const int tid, const Sched& S, const Epi& E) {
    const int wid = __builtin_amdgcn_readfirstlane(tid >> 6), lane = tid & 63, wr = wid >> 2, wc = wid & 3, fr = lane & 15, fq = lane >> 4;
    const int K = S.K, nt = K / BK;
    unsigned voffB[2];
#pragma unroll
    for (int i = 0; i < 2; ++i) { int R, C; stage_rc(tid * 16 + i * 8192, R, C); const int Rb = Epi::PERM ? ((R & ~31) + perm32(R & 31)) : R; voffB[i] = (unsigned)(Rb * K + C) * 2u; }
    const size_t kstep = (size_t)(BK * 2);
    const size_t hstepB = S.hstepB;
    const unsigned ldsw = (unsigned)wid * 1024u;
    constexpr bool F8 = Sched::FP8;
    const int aoff = F8 ? lds_byte(wr * 64 + fr, fq * 16) : lds_byte(wr * 64 + fr, fq * 8), boff = F8 ? lds_byte(wc * 32 + fr, fq * 16) : lds_byte(wc * 32 + fr, fq * 8);
#define PG8_SA(b, h) (((b) * 2 + (h)) * HTB)
#define PG8_SB(b, h) ((4 + (b) * 2 + (h)) * HTB)
#define PG8_STAGE_B(bufoff, gbase) do { _Pragma("unroll") for (int _i = 0; _i < 2; ++_i) \
        __builtin_amdgcn_global_load_lds((const unsigned*)((const char*)(gbase) + voffB[_i]), (LAS unsigned*)(lds + (bufoff) + ldsw + _i * 8192), 16, 0, 0); } while (0)
#define PG8_STAGE_A(bufoff, gbase, v0, v1) do { \
        __builtin_amdgcn_global_load_lds((const unsigned*)((const char*)(gbase) + (v0)), (LAS unsigned*)(lds + (bufoff) + ldsw), 16, 0, 0); \
        __builtin_amdgcn_global_load_lds((const unsigned*)((const char*)(gbase) + (v1)), (LAS unsigned*)(lds + (bufoff) + ldsw + 8192), 16, 0, 0); } while (0)
#define PG8_FOFF(k) (F8 ? (k) * 16 : (k) * 1024)
#define PG8_LDA(dst, b, h) do { _Pragma("unroll") for (int m = 0; m < 4; ++m) { if constexpr (F8) dst##8[m] = *(const LAS v8i_t*)(lds + PG8_SA(b, h) + aoff + m * 2048); \
        else { _Pragma("unroll") for (int k = 0; k < 2; ++k) dst[m][k] = *(const LAS bf16x8*)(lds + PG8_SA(b, h) + aoff + m * 2048 + k * 1024); } } } while (0)
#define PG8_LDB(dst, b, h) do { _Pragma("unroll") for (int n = 0; n < 2; ++n) { if constexpr (F8) dst##8[n] = *(const LAS v8i_t*)(lds + PG8_SB(b, h) + boff + n * 2048); \
        else { _Pragma("unroll") for (int k = 0; k < 2; ++k) dst[n][k] = *(const LAS bf16x8*)(lds + PG8_SB(b, h) + boff + n * 2048 + k * 1024); } } } while (0)
#define PG8_CAT(x) __builtin_shufflevector(__builtin_bit_cast(v4i_t, x[0]), __builtin_bit_cast(v4i_t, x[1]), 0, 1, 2, 3, 4, 5, 6, 7)
#define PG8_MMA(ai, bj, At, Bt) do { __builtin_amdgcn_s_setprio(1); _Pragma("unroll") for (int m = 0; m < 4; ++m) _Pragma("unroll") for (int n = 0; n < 2; ++n) { \
        if constexpr (F8) acc[ai][bj][m][n] = __builtin_amdgcn_mfma_scale_f32_16x16x128_f8f6f4(Bt##8[n], At##8[m], acc[ai][bj][m][n], 0, 0, 0, S.scaleB, 0, S.scaleA); \
        else { _Pragma("unroll") for (int k = 0; k < 2; ++k) acc[ai][bj][m][n] = __builtin_amdgcn_mfma_f32_16x16x32_bf16(Bt[n][k], At[m][k], acc[ai][bj][m][n], 0, 0, 0); } } __builtin_amdgcn_s_setprio(0); } while (0)
#define PG8_WAIT_V(n) asm volatile("s_waitcnt vmcnt(" #n ")" ::: "memory")
#define PG8_WAIT_L(n) asm volatile("s_waitcnt lgkmcnt(" #n ")" ::: "memory")
#define PG8_BAR __builtin_amdgcn_s_barrier()
#define PG8_SCHED __builtin_amdgcn_sched_barrier(0)
    typename Sched::Unit cur, nxt; int ui = 0;
    if (!S.next(0, cur)) return;
    f32x4 acc[2][2][4][2];
#pragma unroll
    for (int a = 0; a < 2; ++a)
#pragma unroll
        for (int b = 0; b < 2; ++b)
#pragma unroll
            for (int m = 0; m < 4; ++m)
#pragma unroll
                for (int n = 0; n < 2; ++n) acc[a][b][m][n] = (f32x4){0.f, 0.f, 0.f, 0.f};
    bf16x8 At[4][2], B0[2][2], B1[2][2]; v8i_t At8[4], B08[2], B18[2];
    constexpr bool GA = Sched::GATHER;
    const size_t hstepA = GA ? (size_t)0 : (size_t)HALF * K * 2;
    unsigned vA[2][2];
    LAS unsigned char* hdr = lds + STAGE_BYTES;
    if constexpr (Sched::HDR) { if (wid == 0) S.hdr_issue(cur, hdr, lane); PG8_WAIT_V(0); PG8_BAR; }
    S.a_off(cur, tid, vA, hdr);
#define PG8_STAGE_AH(bufoff, base, vv, h) PG8_STAGE_A(bufoff, ((base) + (h) * hstepA), vv[GA ? (h) : 0][0], vv[GA ? (h) : 0][1])
    const char* cA = S.a_base(cur); const char* cB = S.b_base(cur);
    PG8_STAGE_B(PG8_SB(0, 0), cB); PG8_STAGE_B(PG8_SB(0, 1), cB + hstepB); PG8_STAGE_AH(PG8_SA(0, 0), cA, vA, 0); PG8_STAGE_AH(PG8_SA(0, 1), cA, vA, 1);
    if (wr == 1) PG8_BAR;
    PG8_WAIT_V(2); PG8_BAR;
    PG8_STAGE_B(PG8_SB(1, 0), cB + kstep); PG8_STAGE_AH(PG8_SA(1, 0), cA + kstep, vA, 0); PG8_STAGE_B(PG8_SB(1, 1), cB + hstepB + kstep);
    PG8_WAIT_V(6); PG8_BAR;
    int hc = 0;
    for (;;) {
        const bool has_next = S.next(ui + 1, nxt); const int hn = (hc == 2) ? 0 : hc + 1;
        const char* nA = cA; const char* nB = cB;
        if (has_next) { nA = S.a_base(nxt); nB = S.b_base(nxt); if constexpr (Sched::HDR) { if (wid == 0) S.hdr_issue(nxt, hdr + hn * 4096, lane); } }
        for (int t = 0; t < nt; t += 2) {
            const bool last = (t == nt - 2);
            const char* a1 = cA + (size_t)(t + 1) * kstep;
            const char* a2 = last ? nA : cA + (size_t)(t + 2) * kstep; const char* b2 = last ? nB : cB + (size_t)(t + 2) * kstep;
            const char* a3 = a2 + kstep; const char* b3 = b2 + kstep;
            PG8_LDB(B0, 0, 0); PG8_LDB(B1, 0, 1); PG8_SCHED; PG8_LDA(At, 0, 0); PG8_STAGE_AH(PG8_SA(1, 1), a1, vA, 1);
            if constexpr (GA) { if (last && has_next) S.a_off(nxt, tid, vA, hdr + hn * 4096); }
            PG8_WAIT_V(8); PG8_WAIT_L(0); PG8_BAR; PG8_MMA(0, 0, At, B0); PG8_MMA(0, 1, At, B1); PG8_BAR; PG8_SCHED;
            PG8_LDA(At, 0, 1); PG8_STAGE_B(PG8_SB(0, 0), b2); PG8_STAGE_B(PG8_SB(0, 1), b2 + hstepB); PG8_STAGE_AH(PG8_SA(0, 0), a2, vA, 0);
            PG8_WAIT_V(8); PG8_WAIT_L(0); PG8_BAR; PG8_MMA(1, 0, At, B0); PG8_MMA(1, 1, At, B1); PG8_BAR; PG8_SCHED;
            PG8_LDB(B0, 1, 0); PG8_LDB(B1, 1, 1); PG8_SCHED; PG8_LDA(At, 1, 0); PG8_STAGE_AH(PG8_SA(0, 1), a2, vA, 1);
            PG8_WAIT_V(8); PG8_WAIT_L(0); PG8_BAR; PG8_MMA(0, 0, At, B0); PG8_MMA(0, 1, At, B1); PG8_BAR; PG8_SCHED;
            PG8_LDA(At, 1, 1); PG8_STAGE_B(PG8_SB(1, 0), b3); PG8_STAGE_B(PG8_SB(1, 1), b3 + hstepB); PG8_STAGE_AH(PG8_SA(1, 0), a3, vA, 0);
            PG8_WAIT_V(8); PG8_WAIT_L(0); PG8_BAR; PG8_MMA(1, 0, At, B0); PG8_MMA(1, 1, At, B1); PG8_BAR; PG8_SCHED;
        }
        if (wr == 0) PG8_BAR;
        { int fr_ = fr, fq_ = fq; asm volatile("" : "+v"(fr_), "+v"(fq_)); E(acc, cur, wr, wc, fr_, fq_, hdr + hc * 4096); }
        if (!has_next) break;
#pragma unroll
        for (int a = 0; a < 2; ++a)
#pragma unroll
            for (int b = 0; b < 2; ++b)
#pragma unroll
                for (int m = 0; m < 4; ++m)
#pragma unroll
                    for (int n = 0; n < 2; ++n) acc[a][b][m][n] = (f32x4){0.f, 0.f, 0.f, 0.f};
        cur = nxt; cA = nA; cB = nB; ++ui; hc = hn;
        if (wr == 1) PG8_BAR;
    }
    PG8_WAIT_V(0);
    PG8_BAR;
#undef PG8_SA
#undef PG8_SB
#undef PG8_STAGE_A
#undef PG8_STAGE_AH
#undef PG8_STAGE_B
#undef PG8_LDA
#undef PG8_LDB
#undef PG8_MMA
#undef PG8_CAT
#undef PG8_FOFF
#undef PG8_WAIT_V
#undef PG8_WAIT_L
#undef PG8_BAR
#undef PG8_SCHED
}
}
struct Args { const float* in[N_IN]; float* out; unsigned char* ws; int ph_lo, ph_hi; };
typedef const __attribute__((address_space(4))) unsigned long long* karg_t;
struct Frame {
    karg_t ka;
    LAS unsigned char* lds;
    volatile LAS unsigned* MISC;
    gu32* ctl;
    unsigned char* ws;
    float* out;
    int tid, lane, wave, vcu, G;
};
#define WSP(T_, off) ((T_*)(F.ws + (off)))
#define KIN(k) ((const float*)F.ka[(k)])
#ifdef DBG_SEL
#define DBG_STAT(k, val) do { const float _v = (val); if ((k) == DBG_SEL) { if (fabsf(_v) < 3e38f) atomicMax((unsigned*)(F.ctl + CW_DBG), __float_as_uint(fabsf(_v))); else atomicAdd((unsigned*)(F.ctl + CW_DBG + 1), 1u); } } while (0)
#else
#define DBG_STAT(k, val) do { } while (0)
#endif
template <class P> __device__ __forceinline__ P launder_uniform(P p) {
    unsigned lo = (unsigned)(unsigned long long)p, hi = (unsigned)((unsigned long long)p >> 32);
    asm volatile("" : "+v"(lo), "+v"(hi));
    lo = __builtin_amdgcn_readfirstlane(lo); hi = __builtin_amdgcn_readfirstlane(hi);
    return (P)(((unsigned long long)hi << 32) | lo);
}
__device__ __forceinline__ void frame_refresh(Frame& F) {
    int t = F.tid; asm volatile("" : "+v"(t)); F.tid = t; F.lane = t & 63; F.wave = __builtin_amdgcn_readfirstlane(t >> 6);
    F.ws = launder_uniform(F.ws); F.ctl = (gu32*)(F.ws + WS_CTL);
    F.out = launder_uniform(F.out);
    F.ka = launder_uniform(F.ka);
}

namespace pg8 {
struct DenseSched {
    static constexpr bool GATHER = false, FP8 = false, HDR = false; static constexpr int scaleA = 0, scaleB = 0;
    struct Unit { int pm, pn; };
    __device__ __forceinline__ void hdr_issue(const Unit&, LAS unsigned char*, int) const {}
    const bf16* A; const bf16* Bt; int K; size_t hstepB; int nM, nN, nwg, G, c;
    __device__ __forceinline__ void init(const bf16* A_, const bf16* Bt_, int M, int N, int K_, int G_, int c_) { A = A_; Bt = Bt_; K = K_; hstepB = (size_t)HALF * K_ * 2; nM = M / BM; nN = N / BM; nwg = nM * nN; G = G_; c = c_; }
    __device__ __forceinline__ bool next(int i, Unit& u) const {
        const long L = (long)i * G + c; if (L >= nwg) return false;
        int wgid = (int)L; { const int q = nwg / NXCD, r = nwg % NXCD, xcd = wgid % NXCD, off = wgid / NXCD; wgid = (xcd < r ? xcd * (q + 1) : r * (q + 1) + (xcd - r) * q) + off; }
        const int nig = WGM * nN, gid = wgid / nig, fm = gid * WGM, gsz = (nM - fm) < WGM ? (nM - fm) : WGM;
        u.pm = fm + ((wgid % nig) % gsz); u.pn = (wgid % nig) / gsz; return true;
    }
    __device__ __forceinline__ const char* a_base(const Unit& u) const { return (const char*)A + (size_t)u.pm * BM * K * 2; }
    __device__ __forceinline__ const char* b_base(const Unit& u) const { return (const char*)Bt + (size_t)u.pn * BM * K * 2; }
    __device__ __forceinline__ void a_off(const Unit&, int tid, unsigned (&v)[2][2], const LAS unsigned char*) const {
#pragma unroll
        for (int i = 0; i < 2; ++i) { int R, C; stage_rc(tid * 16 + i * 8192, R, C); v[0][i] = (unsigned)(R * K + C) * 2u; v[1][i] = v[0][i]; }
    }
};
struct MoeUnit { int e, mt, nt, cnt; };
struct MoeOrder {
    const volatile LAS unsigned* pfx;
    int NT, G, c;
    __device__ __forceinline__ bool decode(int i, MoeUnit& u) const {
        const int nwg = (int)pfx[32]; const long L = (long)i * G + c; if (L >= nwg) return false;
        int wgid = (int)L; { const int q = nwg / NXCD, r = nwg % NXCD, xcd = wgid % NXCD, off = wgid / NXCD; wgid = (xcd < r ? xcd * (q + 1) : r * (q + 1) + (xcd - r) * q) + off; }
        int e = 0;
#pragma unroll
        for (int st = 16; st >= 1; st >>= 1) e += ((int)pfx[e + st] <= wgid) ? st : 0;
        const int j = wgid - (int)pfx[e];
        u.e = e; u.mt = j / NT; u.nt = j % NT; u.cnt = (int)pfx[40 + e]; return true;
    }
};
#ifndef HDR_AOFF
#define HDR_AOFF 1
#endif
struct Moe1Sched {
    static constexpr bool GATHER = true, FP8 = (MOE_FP8 != 0), HDR = true; static constexpr int EB = FP8 ? 1 : 2; static constexpr int scaleA = 0x7F7F7F7F, scaleB = 0x7A7A7A7A;
    typedef MoeUnit Unit;
    MoeOrder O; const unsigned char* X; const unsigned char* W; const int* sdest; const float* bgu; int K; size_t hstepB;
    __device__ __forceinline__ void hdr_issue(const Unit& u, LAS unsigned char* hdr, int lane) const {
        __builtin_amdgcn_global_load_lds((const unsigned*)(sdest + (size_t)u.e * ECAP + (size_t)u.mt * 256 + lane * 4), (LAS unsigned*)hdr, 16, 0, 0);
        const float* bp = bgu + (size_t)u.e * 2048 + u.nt * 128 + (lane < 32 ? lane * 4 : 1024 + (lane - 32) * 4);
        __builtin_amdgcn_global_load_lds((const unsigned*)bp, (LAS unsigned*)(hdr + 1024), 16, 0, 0);
    }
    __device__ __forceinline__ bool next(int i, Unit& u) const { return O.decode(i, u); }
    __device__ __forceinline__ const char* a_base(const Unit&) const { return (const char*)X; }
    __device__ __forceinline__ const char* b_base(const Unit& u) const { return (const char*)W + ((size_t)u.e * 2048 + (size_t)u.nt * 128) * 1024 * EB; }
    __device__ __forceinline__ void a_off(const Unit& u, int tid, unsigned (&v)[2][2], const LAS unsigned char* hdr) const {
#pragma unroll
        for (int i = 0; i < 2; ++i) { int R, C; stage_rc(tid * 16 + i * 8192, R, C);
#pragma unroll
            for (int h = 0; h < 2; ++h) { const int sl = h * HALF + R; int tok = 0; if (u.mt * 256 + sl < u.cnt) tok = HDR_AOFF ? (((const LAS int*)hdr)[sl] >> 2) : (sdest[u.e * ECAP + u.mt * 256 + sl] >> 2); v[h][i] = (unsigned)(tok * 1024 * EB + C * 2); } }
    }
};
struct Moe2Sched {
    static constexpr bool GATHER = true, FP8 = (MOE2_FP8 != 0), HDR = true; static constexpr int EB = FP8 ? 1 : 2; static constexpr int scaleA = 0x7F7F7F7F, scaleB = 0x79797979;
    typedef MoeUnit Unit;
    MoeOrder O; const unsigned char* Ab; const unsigned char* W; const int* sdest; const float* sgate; const float* bdn; int K; size_t hstepB;
    __device__ __forceinline__ void hdr_issue(const Unit& u, LAS unsigned char* hdr, int lane) const {
        const size_t so = (size_t)u.e * ECAP + (size_t)u.mt * 256 + lane * 4;
        __builtin_amdgcn_global_load_lds((const unsigned*)(sdest + so), (LAS unsigned*)hdr, 16, 0, 0);
        __builtin_amdgcn_global_load_lds((const unsigned*)(sgate + so), (LAS unsigned*)(hdr + 1024), 16, 0, 0);
        __builtin_amdgcn_global_load_lds((const unsigned*)(bdn + (size_t)u.e * 1024 + u.nt * 256 + lane * 4), (LAS unsigned*)(hdr + 2048), 16, 0, 0);
    }
    __device__ __forceinline__ bool next(int i, Unit& u) const { return O.decode(i, u); }
    __device__ __forceinline__ const char* a_base(const Unit& u) const { return (const char*)Ab + ((size_t)u.e * ECAP + (size_t)u.mt * 256) * 1024 * EB; }
    __device__ __forceinline__ const char* b_base(const Unit& u) const { return (const char*)W + ((size_t)u.e * 1024 + (size_t)u.nt * 256) * 1024 * EB; }
    __device__ __forceinline__ void a_off(const Unit&, int tid, unsigned (&v)[2][2], const LAS unsigned char*) const {
        int t_ = tid; asm volatile("" : "+v"(t_));
#pragma unroll
        for (int i = 0; i < 2; ++i) { int R, C; stage_rc(t_ * 16 + i * 8192, R, C); v[0][i] = (unsigned)(R * 1024 * EB + C * 2); v[1][i] = v[0][i] + (unsigned)(HALF * 1024 * EB); }
    }
};

__device__ __forceinline__ void unpack8(const v4u w, f32x4& a, f32x4& b) {
    a = (f32x4){__uint_as_float(w.x << 16), __uint_as_float(w.x & 0xffff0000u), __uint_as_float(w.y << 16), __uint_as_float(w.y & 0xffff0000u)};
    b = (f32x4){__uint_as_float(w.z << 16), __uint_as_float(w.z & 0xffff0000u), __uint_as_float(w.w << 16), __uint_as_float(w.w & 0xffff0000u)}; }
struct EpiF32 {
    static constexpr bool PERM = false;
    float* C; int ldc; const float* base; float alpha;
    __device__ __forceinline__ void operator()(const f32x4 (&acc)[2][2][4][2], const DenseSched::Unit& u, int wr, int wc, int fr, int fq, const LAS unsigned char* hdr) const {
        const int row0 = u.pm * BM + wr * 64 + fr, col0 = u.pn * BM + wc * 32 + 4 * fq;
#pragma unroll
        for (int ai = 0; ai < 2; ++ai)
#pragma unroll
            for (int m = 0; m < 4; ++m) { const size_t ro = (size_t)(row0 + ai * HALF + m * 16) * ldc + col0;
#pragma unroll
                for (int bj = 0; bj < 2; ++bj)
#pragma unroll
                    for (int n = 0; n < 2; ++n) { f32x4 v = acc[ai][bj][m][n];
                        if (base) { const f32x4 b = *(const f32x4*)(base + ro + bj * HALF + n * 16); v = v + b * alpha; }
                        *(f32x4*)(C + ro + bj * HALF + n * 16) = v; } }
    }
};
struct EpiB16 {
    static constexpr bool PERM = true;
    bf16* O; int ldc; const bf16* base; float alpha;
    __device__ __forceinline__ void operator()(const f32x4 (&acc)[2][2][4][2], const DenseSched::Unit& u, int wr, int wc, int fr, int fq, const LAS unsigned char* hdr) const {
        const int row0 = u.pm * BM + wr * 64 + fr, col0 = u.pn * BM + wc * 32 + 8 * fq;
#pragma unroll
        for (int ai = 0; ai < 2; ++ai) {
            v4u bw[4][2];
            if (base) {
#pragma unroll
                for (int m = 0; m < 4; ++m)
#pragma unroll
                    for (int bj = 0; bj < 2; ++bj) bw[m][bj] = *(const v4u*)(base + (size_t)(row0 + ai * HALF + m * 16) * ldc + col0 + bj * HALF); }
#pragma unroll
            for (int m = 0; m < 4; ++m) { bf16* rowp = O + (size_t)(row0 + ai * HALF + m * 16) * ldc + col0;
#pragma unroll
                for (int bj = 0; bj < 2; ++bj) { f32x4 v0 = acc[ai][bj][m][0], v1 = acc[ai][bj][m][1];
                    if (base) { f32x4 b0, b1; unpack8(bw[m][bj], b0, b1); v0 = v0 + b0 * alpha; v1 = v1 + b1 * alpha; }
                    v4u w; w.x = cvt_pk_bf16(v0[0], v0[1]); w.y = cvt_pk_bf16(v0[2], v0[3]); w.z = cvt_pk_bf16(v1[0], v1[1]); w.w = cvt_pk_bf16(v1[2], v1[3]);
                    *(v4u*)(rowp + bj * HALF) = w; } } }
    }
};
struct EpiPle {
    static constexpr bool PERM = true;
    bf16* C; const bf16* hb; const bf16* pe;
    __device__ __forceinline__ void operator()(const f32x4 (&acc)[2][2][4][2], const DenseSched::Unit& u, int wr, int wc, int fr, int fq, const LAS unsigned char* hdr) const {
        const int row0 = u.pm * BM + wr * 64 + fr, col0 = u.pn * BM + wc * 32 + 8 * fq;
#pragma unroll
        for (int ai = 0; ai < 2; ++ai) {
            v4u hw[4][2], pw[4][2];
#pragma unroll
            for (int m = 0; m < 4; ++m)
#pragma unroll
                for (int bj = 0; bj < 2; ++bj) { const size_t ro = (size_t)(row0 + ai * HALF + m * 16) * 1024 + col0 + bj * HALF; hw[m][bj] = *(const v4u*)(hb + ro); pw[m][bj] = *(const v4u*)(pe + ro); }
#pragma unroll
            for (int m = 0; m < 4; ++m)
#pragma unroll
                for (int bj = 0; bj < 2; ++bj) { const size_t ro = (size_t)(row0 + ai * HALF + m * 16) * 1024 + col0 + bj * HALF;
                    f32x4 h0, h1, p0, p1; unpack8(hw[m][bj], h0, h1); unpack8(pw[m][bj], p0, p1); const f32x4 a0 = acc[ai][bj][m][0], a1 = acc[ai][bj][m][1];
                    f32x4 o0, o1;
#pragma unroll
                    for (int j = 0; j < 4; ++j) { o0[j] = h0[j] + sigmoidf_(a0[j]) * p0[j]; o1[j] = h1[j] + sigmoidf_(a1[j]) * p1[j]; }
                    v4u w; w.x = cvt_pk_bf16(o0[0], o0[1]); w.y = cvt_pk_bf16(o0[2], o0[3]); w.z = cvt_pk_bf16(o1[0], o1[1]); w.w = cvt_pk_bf16(o1[2], o1[3]);
                    *(v4u*)(C + ro) = w; } }
    }
};
struct EpiMoe1 {
    static constexpr bool PERM = true;
    bf16* Ab; const float* bgu; unsigned char* AbQ;
    __device__ __forceinline__ void operator()(const f32x4 (&acc)[2][2][4][2], const MoeUnit& u, int wr, int wc, int fr, int fq, const LAS unsigned char* hdr) const {
        const int col0 = u.nt * 128 + wc * 32 + 8 * fq;
        const LAS float* bh = (const LAS float*)(hdr + 1024) + wc * 32 + 8 * fq;
        const f32x4 bg0 = *(const LAS f32x4*)(bh), bg1 = *(const LAS f32x4*)(bh + 4), bl0 = *(const LAS f32x4*)(bh + 128), bl1 = *(const LAS f32x4*)(bh + 132);
#pragma unroll
        for (int ai = 0; ai < 2; ++ai)
#pragma unroll
            for (int m = 0; m < 4; ++m) { const int r = ai * HALF + wr * 64 + m * 16 + fr;
                bf16* rowp = Ab + ((size_t)u.e * ECAP + (size_t)u.mt * 256 + r) * 1024 + col0;
                float o[8];
#pragma unroll
                for (int n = 0; n < 2; ++n) { const f32x4 g4 = acc[ai][0][m][n] + (n ? bg1 : bg0), l4 = acc[ai][1][m][n] + (n ? bl1 : bl0);
#pragma unroll
                    for (int j = 0; j < 4; ++j) { const float g = fminf(g4[j], 7.0f), l = fminf(fmaxf(l4[j], -7.0f), 7.0f); o[n * 4 + j] = (l + 1.0f) * g * sigmoidf_(1.702f * g); } }
                if constexpr (MOE2_FP8) { v2u q; q.x = cvt4_fp8(o[0], o[1], o[2], o[3]); q.y = cvt4_fp8(o[4], o[5], o[6], o[7]); *(v2u*)((unsigned char*)AbQ + ((size_t)u.e * ECAP + (size_t)u.mt * 256 + r) * 1024 + col0) = q; }
                else *(v4u*)rowp = pack8(o); }
    }
};
struct EpiMoe2 {
    static constexpr bool PERM = true;
    bf16* Y; const float* bdn; const int* sdest; const float* sgate;
    __device__ __forceinline__ void operator()(const f32x4 (&acc)[2][2][4][2], const MoeUnit& u, int wr, int wc, int fr, int fq, const LAS unsigned char* hdr) const {
        const int col0 = u.nt * 256 + wc * 32 + 8 * fq;
        const LAS float* bp = (const LAS float*)(hdr + 2048) + wc * 32 + 8 * fq;
#pragma unroll
        for (int ai = 0; ai < 2; ++ai) {
            f32x4 bv[2][2];
#pragma unroll
            for (int bj = 0; bj < 2; ++bj)
#pragma unroll
                for (int n = 0; n < 2; ++n) bv[bj][n] = *(const LAS f32x4*)(bp + bj * HALF + 4 * n);
            int dest[4]; float gate[4];
#pragma unroll
            for (int m = 0; m < 4; ++m) { const int sl = ai * HALF + wr * 64 + m * 16 + fr; const bool ok = u.mt * 256 + sl < u.cnt;
                dest[m] = ok ? ((const LAS int*)hdr)[sl] : T * 4; gate[m] = ok ? ((const LAS float*)(hdr + 1024))[sl] : 0.f; }
#pragma unroll
            for (int m = 0; m < 4; ++m) {
                { const float g = gate[m]; bf16* rowp = Y + (size_t)dest[m] * 1024 + col0;
#pragma unroll
                    for (int bj = 0; bj < 2; ++bj) { const f32x4 v0 = (acc[ai][bj][m][0] + bv[bj][0]) * g, v1 = (acc[ai][bj][m][1] + bv[bj][1]) * g;
                        v4u w; w.x = cvt_pk_bf16(v0[0], v0[1]); w.y = cvt_pk_bf16(v0[2], v0[3]); w.z = cvt_pk_bf16(v1[0], v1[1]); w.w = cvt_pk_bf16(v1[2], v1[3]);
                        *(v4u*)(rowp + bj * HALF) = w; } } } }
    }
};
}

__device__ __forceinline__ void p0_transpose_item(const float* W, int K, int N, int nblk, bf16* WT, int item, int lane) {
    const int kb = item / nblk, nb = item % nblk, k0 = 64 * kb, n = 64 * nb + lane;
    const bool ok = n < N; const float* src = W + (size_t)k0 * N + (ok ? n : 0);
    float x[64];
#pragma unroll
    for (int j = 0; j < 64; ++j) x[j] = __builtin_nontemporal_load(src + (size_t)j * N);
    bf16* dst = WT + (size_t)n * K + k0;
#pragma unroll
    for (int q = 0; q < 8; ++q) { v4u o; o.x = cvt_pk_bf16(x[8 * q], x[8 * q + 1]); o.y = cvt_pk_bf16(x[8 * q + 2], x[8 * q + 3]); o.z = cvt_pk_bf16(x[8 * q + 4], x[8 * q + 5]); o.w = cvt_pk_bf16(x[8 * q + 6], x[8 * q + 7]);
        if (!ok) o = (v4u){0u, 0u, 0u, 0u};
        *(v4u*)(dst + 8 * q) = o; }
}
__device__ __forceinline__ void cvt_rows(const float* src, bf16* dst, size_t n8, size_t i0, size_t stride) {
    for (size_t i = i0; i < n8; i += stride) { const f32x4 a = *(const f32x4*)(src + i * 8), b = *(const f32x4*)(src + i * 8 + 4);
        v4u o; o.x = cvt_pk_bf16(a.x, a.y); o.y = cvt_pk_bf16(a.z, a.w); o.z = cvt_pk_bf16(b.x, b.y); o.w = cvt_pk_bf16(b.z, b.w); *(v4u*)(dst + i * 8) = o; }
}
__device__ __forceinline__ void p0_prologue(Frame& F, const Args& A) {
    const int gw = F.vcu * NWAVES + F.wave, NGW = F.G * NWAVES;
    constexpr int I_IN = 16 * (NUP / 64), I_OUT = 16 * 16, I_GU = 16 * 32, I_DN = 16 * 16, I_PG = 16 * 16, I_PP = 4 * 16;
    constexpr int PER_LAYER = I_IN + I_OUT + NE * I_GU + NE * I_DN + I_PG + I_PP;
#pragma unroll 1
    for (int it = gw; it < DEPTH * PER_LAYER; it += NGW) {
        const int l = it / PER_LAYER; int r = it % PER_LAYER;
        const float* W; bf16* WT; int K = D, N = D, nblk = 16;
        if (r < I_IN) { W = KIN(I_WIN) + (size_t)l * D * NU; WT = WSP(bf16, WS_WIN_T) + (size_t)l * NUP * D; N = NU; nblk = NUP / 64; }
        else if ((r -= I_IN) < I_OUT) { W = KIN(I_WOUT) + (size_t)l * D * D; WT = WSP(bf16, WS_WOUT_T) + (size_t)l * D * D; }
        else if ((r -= I_OUT) < NE * I_GU) { if (MOE_FP8) continue; const int e = r / I_GU; r %= I_GU; W = KIN(I_WGU) + ((size_t)l * NE + e) * D * 2048; WT = WSP(bf16, WS_WGU_T) + ((size_t)l * NE + e) * 2048 * D; N = 2048; nblk = 32; }
        else if ((r -= NE * I_GU) < NE * I_DN) { if (MOE2_FP8) continue; const int e = r / I_DN; r %= I_DN; W = KIN(I_WDN) + ((size_t)l * NE + e) * D * D; WT = WSP(bf16, WS_WDN_T) + ((size_t)l * NE + e) * D * D; }
        else if ((r -= NE * I_DN) < I_PG) { W = KIN(I_PGW) + (size_t)l * D * D; WT = WSP(bf16, WS_WPG_T) + (size_t)l * D * D; }
        else { r -= I_PG; W = KIN(I_PPJ) + (size_t)l * 256 * D; WT = WSP(bf16, WS_WPP_T) + (size_t)l * D * 256; K = 256; }
        p0_transpose_item(W, K, N, nblk, WT, r, F.lane);
    }
#if MOE_FP8
    constexpr int Q_GU = 16 * 32, Q_DN = 16 * 16, Q_PER_LAYER = NE * (Q_GU + Q_DN);
#pragma unroll 1
    for (int it = gw; it < DEPTH * Q_PER_LAYER; it += NGW) {
        const int l = it / Q_PER_LAYER; int r = it % Q_PER_LAYER; const float* W; unsigned char* WQ; int N; float sc;
        if (r < NE * Q_GU) { const int e = r / Q_GU; r %= Q_GU; W = KIN(I_WGU) + ((size_t)l * NE + e) * D * 2048; WQ = WSP(unsigned char, WS_WGU_Q) + ((size_t)l * NE + e) * 2048 * D; N = 2048; sc = 32.0f; }
        else { if (!MOE2_FP8) continue; r -= NE * Q_GU; const int e = r / Q_DN; r %= Q_DN; W = KIN(I_WDN) + ((size_t)l * NE + e) * D * D; WQ = WSP(unsigned char, WS_WDN_Q) + ((size_t)l * NE + e) * D * D; N = D; sc = 64.0f; }
        const int nblk = N / 64, kb = r / nblk, nb = r % nblk, k0 = 64 * kb, n = 64 * nb + F.lane;
        const float* src = W + (size_t)k0 * N + n; float x[64];
#pragma unroll
        for (int j = 0; j < 64; ++j) x[j] = __builtin_nontemporal_load(src + (size_t)j * N) * sc;
        unsigned char* dst = WQ + (size_t)n * D + k0;
#pragma unroll
        for (int q = 0; q < 4; ++q) { v4u o; o.x = cvt4_fp8(x[16 * q], x[16 * q + 1], x[16 * q + 2], x[16 * q + 3]); o.y = cvt4_fp8(x[16 * q + 4], x[16 * q + 5], x[16 * q + 6], x[16 * q + 7]);
            o.z = cvt4_fp8(x[16 * q + 8], x[16 * q + 9], x[16 * q + 10], x[16 * q + 11]); o.w = cvt4_fp8(x[16 * q + 12], x[16 * q + 13], x[16 * q + 14], x[16 * q + 15]); *(v4u*)(dst + 16 * q) = o; }
    }
#endif
    const size_t gt = (size_t)F.vcu * (NWAVES * 64) + F.tid, NT_ = (size_t)F.G * NWAVES * 64;
    cvt_rows(KIN(I_P), WSP(bf16, WS_PB), (size_t)DEPTH * T * 256 / 8, gt, NT_);
    cvt_rows(KIN(I_X), WSP(bf16, WS_XB), (size_t)T * D / 8, gt, NT_);
    for (size_t i = gt; i < (size_t)DEPTH * LORA_PER_LAYER; i += NT_) { const int l = (int)(i / LORA_PER_LAYER); int r = (int)(i % LORA_PER_LAYER); float v;
        if (r < 8192) { const int ch = r >> 5, j = r & 31; v = KIN(I_RWUP)[(size_t)l * 8192 + j * 256 + ch]; }
        else if (r < 16384) { r -= 8192; const int ch = r >> 5, j = r & 31; v = KIN(I_RAUP)[(size_t)l * 8192 + j * 256 + ch]; }
        else if (r < 32768) { r -= 16384; const int ch = r >> 6, j = r & 63; v = KIN(I_RGUP)[(size_t)l * 16384 + j * 256 + ch]; }
        else { r -= 32768; const int d = r >> 4, j = r & 15; v = KIN(I_GGUP)[(size_t)l * 2048 + j * 128 + d]; }
        WSP(float, WS_LORA)[i] = v; }
    for (size_t i = gt; i < (size_t)DEPTH * NE * D; i += NT_) { const int l = (int)(i / (NE * D)), r = (int)(i % (NE * D)), e = r / D, k = r % D; WSP(float, WS_RWT)[i] = KIN(I_RTW)[(size_t)l * D * NE + (size_t)k * NE + e]; }
}

template <bool DRY> __device__ __forceinline__ void p6_ln1_router(Frame& F, const Args& A, int layer) {
    const bf16* y1 = WSP(bf16, WS_Y1); bf16* x1b = WSP(bf16, WS_X1B);
    const float* g = KIN(I_LN1G) + layer * D; const float* bb = KIN(I_LN1B) + layer * D;
    const float* rwt = WSP(float, WS_RWT) + (size_t)layer * NE * D; const float* rb = KIN(I_RTB) + layer * NE;
    int* sdest = WSP(int, WS_SDEST); float* sgate = WSP(float, WS_SGATE);
    unsigned* cnt = (unsigned*)(F.ctl + CW_CNT + layer * NE * 16);
    LAS float* RWT = (LAS float*)F.lds;
    LAS float* TOPV = (LAS float*)(F.lds + 131072) + F.wave * 64;
    LAS int* TOPE = (LAS int*)(F.lds + 131072 + 2048) + F.wave * 64;
    volatile LAS unsigned* lcnt = F.MISC + MW_LCNT; volatile LAS unsigned* lbase = F.MISC + MW_LBASE;
    for (int i = F.tid; i < NE * D / 4; i += NWAVES * 64) ((LAS f32x4*)RWT)[i] = ((const f32x4*)rwt)[i];
    const int lane = F.lane, sub = lane & 15;
    for (int blk = F.vcu; blk < T / 64; blk += F.G) {
        if (F.tid < 32) lcnt[F.tid] = 0u;
        __syncthreads();
#pragma unroll 1
        for (int rg = 0; rg < 2; ++rg) {
            f32x4 v[4][4];
            { int lo_ = lane; asm volatile("" : "+v"(lo_));
              const f32x4 gv[4] = { *(const f32x4*)(g + 4 * lo_), *(const f32x4*)(g + 256 + 4 * lo_), *(const f32x4*)(g + 512 + 4 * lo_), *(const f32x4*)(g + 768 + 4 * lo_) };
              const f32x4 bv[4] = { *(const f32x4*)(bb + 4 * lo_), *(const f32x4*)(bb + 256 + 4 * lo_), *(const f32x4*)(bb + 512 + 4 * lo_), *(const f32x4*)(bb + 768 + 4 * lo_) };
#pragma unroll
              for (int r = 0; r < 4; ++r) { const int row = blk * 64 + F.wave * 8 + rg * 4 + r; const bf16* yr = y1 + (size_t)row * D; float s = 0.f;
#pragma unroll
                  for (int j = 0; j < 4; ++j) { const v2u w = *(const v2u*)(yr + 256 * j + 4 * lane); v[r][j] = (f32x4){__uint_as_float(w.x << 16), __uint_as_float(w.x & 0xffff0000u), __uint_as_float(w.y << 16), __uint_as_float(w.y & 0xffff0000u)}; s += (v[r][j].x + v[r][j].y) + (v[r][j].z + v[r][j].w); }
                  const float mean = wave_sum(s) * (1.f / D); float s2 = 0.f;
#pragma unroll
                  for (int j = 0; j < 4; ++j) { v[r][j] = v[r][j] - mean; s2 += (v[r][j].x * v[r][j].x + v[r][j].y * v[r][j].y) + (v[r][j].z * v[r][j].z + v[r][j].w * v[r][j].w); }
                  const float rstd = __builtin_amdgcn_rsqf(wave_sum(s2) * (1.f / D) + LN_EPS);
#pragma unroll
                  for (int j = 0; j < 4; ++j) { v[r][j] = v[r][j] * rstd * gv[j] + bv[j];
                      v2u o; o.x = cvt_pk_bf16(v[r][j].x, v[r][j].y); o.y = cvt_pk_bf16(v[r][j].z, v[r][j].w); *(v2u*)(x1b + (size_t)row * D + 256 * j + 4 * lane) = o;
                      if (MOE_FP8) *(unsigned*)(WSP(unsigned char, WS_X1Q) + (size_t)row * D + 256 * j + 4 * lane) = cvt4_fp8(v[r][j].x, v[r][j].y, v[r][j].z, v[r][j].w); } } }
            float lg[32];
#pragma unroll
            for (int e = 0; e < 32; ++e) { float p[4] = {0.f, 0.f, 0.f, 0.f};
#pragma unroll
                for (int j = 0; j < 4; ++j) { const f32x4 w = *(const LAS f32x4*)(RWT + e * D + 256 * j + 4 * lane);
#pragma unroll
                    for (int r = 0; r < 4; ++r) p[r] += (v[r][j].x * w.x + v[r][j].y * w.y) + (v[r][j].z * w.z + v[r][j].w * w.w); }
                { const bool hi = (lane & 32) != 0; const float k0 = hi ? p[2] : p[0], s0 = hi ? p[0] : p[2], k1 = hi ? p[3] : p[1], s1 = hi ? p[1] : p[3]; p[0] = k0 + __shfl_xor(s0, 32); p[1] = k1 + __shfl_xor(s1, 32); }
                { const bool hi = (lane & 16) != 0; const float k0 = hi ? p[1] : p[0], s0 = hi ? p[0] : p[1]; p[0] = k0 + __shfl_xor(s0, 16); }
                float t = p[0]; t += __shfl_xor(t, 8); t += __shfl_xor(t, 4); t += __shfl_xor(t, 2); t += __shfl_xor(t, 1);
                lg[e] = t + rb[e]; }
            float la = 0.f, lb_ = 0.f;
#pragma unroll
            for (int e = 0; e < 32; ++e) { if (e == 2 * sub) la = lg[e]; if (e == 2 * sub + 1) lb_ = lg[e]; }
            int ra = 0, rbk = 0;
#pragma unroll
            for (int e = 0; e < 32; ++e) { ra += (lg[e] > la || (lg[e] == la && e < 2 * sub)) ? 1 : 0; rbk += (lg[e] > lb_ || (lg[e] == lb_ && e < 2 * sub + 1)) ? 1 : 0; }
            const int rowl = rg * 4 + (lane >> 4);
            if (ra < 4) { TOPV[rowl * 4 + ra] = la; TOPE[rowl * 4 + ra] = 2 * sub; }
            if (rbk < 4) { TOPV[rowl * 4 + rbk] = lb_; TOPE[rowl * 4 + rbk] = 2 * sub + 1; }
        }
        LDS_WAIT();
        int my_e = 0; float my_g = 0.f; unsigned my_r = 0u;
        if (lane < 32) { const int ri = lane >> 2, k = lane & 3; const f32x4 tv = *(const LAS f32x4*)(TOPV + ri * 4);
            const float e1 = __expf(tv.y - tv.x), e2 = __expf(tv.z - tv.x), e3 = __expf(tv.w - tv.x); const float inv = __builtin_amdgcn_rcpf(1.0f + e1 + e2 + e3);
            my_e = TOPE[ri * 4 + k]; my_g = (k == 0 ? 1.0f : k == 1 ? e1 : k == 2 ? e2 : e3) * inv;
            my_r = DRY ? 0u : atomicAdd((unsigned*)&lcnt[my_e], 1u); }
        __syncthreads();
        if (!DRY && F.tid < 32) { const unsigned n = lcnt[F.tid]; lbase[F.tid] = n ? __hip_atomic_fetch_add(cnt + F.tid * 16, n, RLX_AGENT) : 0u; }
        __syncthreads();
        if (!DRY && lane < 32) { const int row = blk * 64 + F.wave * 8 + (lane >> 2); const unsigned slot = (unsigned)my_e * ECAP + lbase[my_e] + my_r;
            sdest[slot] = row * 4 + (lane & 3); sgate[slot] = my_g; }
        __syncthreads();
    }
}
__device__ __forceinline__ void p9_combine(Frame& F, const Args& A) {
    const bf16* x1b = WSP(bf16, WS_X1B); const bf16* yb = WSP(bf16, WS_YBUF); bf16* hb = WSP(bf16, WS_HB);
    const int gw = F.vcu * NWAVES + F.wave, NGW = F.G * NWAVES, lane = F.lane;
    for (int row = gw; row < T; row += NGW) {
        v4u y[4][2], xw[2];
#pragma unroll
        for (int j = 0; j < 2; ++j) {
#pragma unroll
            for (int k = 0; k < 4; ++k) y[k][j] = *(const v4u*)(yb + ((size_t)row * 4 + k) * D + 512 * j + 8 * lane);
            xw[j] = *(const v4u*)(x1b + (size_t)row * D + 512 * j + 8 * lane); }
#pragma unroll
        for (int j = 0; j < 2; ++j) { f32x4 v0, v1; pg8::unpack8(xw[j], v0, v1); v0 = v0 * DN_ALPHA; v1 = v1 * DN_ALPHA;
#pragma unroll
            for (int k = 0; k < 4; ++k) { f32x4 a, b; pg8::unpack8(y[k][j], a, b); v0 = v0 + a; v1 = v1 + b; }
            v4u wv; wv.x = cvt_pk_bf16(v0.x, v0.y); wv.y = cvt_pk_bf16(v0.z, v0.w); wv.z = cvt_pk_bf16(v1.x, v1.y); wv.w = cvt_pk_bf16(v1.z, v1.w); *(v4u*)(hb + (size_t)row * D + 512 * j + 8 * lane) = wv; }
    }
}
__device__ __forceinline__ void p11_ln2(Frame& F, const Args& A, int layer) {
    const bf16* h2 = WSP(bf16, WS_H2); bf16* xb = WSP(bf16, WS_XB);
    const float* g = KIN(I_LN2G) + layer * D; const float* bb = KIN(I_LN2B) + layer * D;
    const int gw = F.vcu * NWAVES + F.wave, NGW = F.G * NWAVES, lane = F.lane;
    for (int row = gw; row < T; row += NGW) {
        const bf16* yr = h2 + (size_t)row * D; f32x4 v[4]; float s = 0.f;
#pragma unroll
        for (int j = 0; j < 4; ++j) { const v2u w = *(const v2u*)(yr + 256 * j + 4 * lane); v[j] = (f32x4){__uint_as_float(w.x << 16), __uint_as_float(w.x & 0xffff0000u), __uint_as_float(w.y << 16), __uint_as_float(w.y & 0xffff0000u)}; s += (v[j].x + v[j].y) + (v[j].z + v[j].w); }
        const float mean = wave_sum(s) * (1.f / D); float s2 = 0.f;
#pragma unroll
        for (int j = 0; j < 4; ++j) { v[j] = v[j] - mean; s2 += (v[j].x * v[j].x + v[j].y * v[j].y) + (v[j].z * v[j].z + v[j].w * v[j].w); }
        const float rstd = __builtin_amdgcn_rsqf(wave_sum(s2) * (1.f / D) + LN_EPS);
#pragma unroll
        for (int j = 0; j < 4; ++j) { const f32x4 gv = *(const f32x4*)(g + 256 * j + 4 * lane), bv = *(const f32x4*)(bb + 256 * j + 4 * lane);
            const f32x4 o = v[j] * rstd * gv + bv; const size_t off = (size_t)row * D + 256 * j + 4 * lane;
            if (layer == DEPTH - 1) *(f32x4*)(F.out + off) = o; v2u w; w.x = cvt_pk_bf16(o.x, o.y); w.y = cvt_pk_bf16(o.z, o.w); *(v2u*)(xb + off) = w; }
    }
}
__device__ __forceinline__ void moe_build_pfx(Frame& F, const Args& A, int layer, int NT) {
    volatile LAS unsigned* pfx = F.MISC + MW_PFX;
    __syncthreads();
    if (F.tid < 64) {
        const int e = F.tid & 31;
        const unsigned c = __hip_atomic_load(F.ctl + CW_CNT + (layer * NE + e) * 16, RLX_AGENT);
        const unsigned un = ((c + 255u) >> 8) * (unsigned)NT; unsigned inc = un;
#pragma unroll
        for (int o = 1; o < 32; o <<= 1) { const unsigned t = (unsigned)my_shfl_up((int)inc, o); if (e >= o) inc += t; }
        if (F.tid < 32) { pfx[e] = inc - un; pfx[40 + e] = c; if (e == 31) pfx[32] = inc; }
    }
    __syncthreads();
}
#define UU(t, col) bf2f(u[(size_t)(t) * NUP + (col)])
#define UU4(t, col) ldu4(u + (size_t)(t) * NUP + (col))
__device__ __forceinline__ f32x4 ldu4(const bf16* p) { const v2u w = *(const v2u*)p; return (f32x4){__uint_as_float(w.x << 16), __uint_as_float(w.x & 0xffff0000u), __uint_as_float(w.y << 16), __uint_as_float(w.y & 0xffff0000u)}; }
__device__ __forceinline__ f32x4 ldb4(const bf16* p) { const v2u w = *(const v2u*)p; return (f32x4){__uint_as_float(w.x << 16), __uint_as_float(w.x & 0xffff0000u), __uint_as_float(w.y << 16), __uint_as_float(w.y & 0xffff0000u)}; }
__device__ __forceinline__ void stb4(bf16* p, f32x4 v) { v2u o; o.x = cvt_pk_bf16(v.x, v.y); o.y = cvt_pk_bf16(v.z, v.w); *(v2u*)p = o; }
__device__ __forceinline__ void lds_st_bf16(LAS unsigned char* p, float v) { *(LAS unsigned short*)p = (unsigned short)(cvt_pk_bf16(v, 0.f) & 0xffffu); }
__device__ __forceinline__ void lds_st_bf16x4(LAS unsigned char* p, float a, float b, float c, float d) { v2u o; o.x = cvt_pk_bf16(a, b); o.y = cvt_pk_bf16(c, d); *(LAS v2u*)p = o; }

__device__ __forceinline__ void ssd_stage1(Frame& F, const Args& A, int layer, int b, int c) {
    const bf16* u = WSP(bf16, WS_U);
    LAS unsigned char* L = F.lds;
    LAS float* DT = (LAS float*)L; LAS float* AC = DT + 256;
    LAS unsigned char* BMT = L + 2048; LAS unsigned char* XCDT = BMT + 128 * 144;
    const int t0 = b * SEQ + c * 64, tid = F.tid, lane = F.lane, wave = F.wave;
    if (wave < 4) {
        const int hh = wave;
        const float dt = softplusf_(UU(t0 + lane, U_SSD_DT + hh) + KIN(I_SDTB)[layer * 4 + hh]);
        const float adt = -dt * __expf(KIN(I_SALOG)[layer * 4 + hh]);
        const float ac = wave_scan_add(adt, lane);
        DT[hh * 64 + lane] = dt; AC[hh * 64 + lane] = ac;
        if (lane == 63) WSP(float, WS_SSD_DEC)[(b * 4 + hh) * NCH + c] = __expf(ac);
    }
    __syncthreads();
    if (tid < 384) {
        const int cc = tid; const float* cw = KIN(I_SCW) + (size_t)layer * 2048 + cc; const float w0 = cw[0], w1 = cw[512], w2 = cw[1024], w3 = cw[1536], cb = KIN(I_SCB)[layer * 512 + cc];
        const bf16* up = u + (size_t)t0 * NUP + U_SSD_X + cc;
        float win0 = 0.f, win1 = 0.f, win2 = 0.f;
        if (c > 0) { win0 = bf2f(up[-3 * NUP]); win1 = bf2f(up[-2 * NUP]); win2 = bf2f(up[-1 * NUP]); }
        const int hh = (cc >> 6) & 3; const bool isx = cc < 256;
        LAS unsigned char* dst = isx ? XCDT + cc * 144 : BMT + (cc - 256) * 144;
        const float aclast = AC[hh * 64 + 63];
#pragma unroll 1
        for (int l0 = 0; l0 < 64; l0 += 32) {
            float xv[32];
#pragma unroll
            for (int j = 0; j < 32; ++j) xv[j] = bf2f(up[(l0 + j) * NUP]);
#pragma unroll
            for (int j8 = 0; j8 < 4; ++j8) { float o[8];
#pragma unroll
                for (int j = 0; j < 8; ++j) { const int l = l0 + j8 * 8 + j; const float x = xv[j8 * 8 + j]; const float y = cb + w0 * win0 + w1 * win1 + w2 * win2 + w3 * x; win0 = win1; win1 = win2; win2 = x;
                    float s = siluf_(y); if (isx) s *= DT[hh * 64 + l] * __expf(aclast - AC[hh * 64 + l]); o[j] = s; }
                *(LAS v4u*)(dst + (l0 + j8 * 8) * 2) = pack8(o); }
        }
    }
    __syncthreads();
    { const int fr = lane & 15, fq = lane >> 4; bf16* st = WSP(bf16, WS_SSD_ST);
#pragma unroll 1
      for (int i = 0; i < 2; ++i) { const int row0 = (2 * wave + i) * 16; const int hh = row0 >> 6, p = (row0 & 63) + fr;
          bf16* dstp = st + (((size_t)(b * 4 + hh) * NCH + c) * 64 + p) * 128;
#pragma unroll 1
          for (int ntl = 0; ntl < 8; ++ntl) { f32x4 acc = {0.f, 0.f, 0.f, 0.f}; acc = mm16(XCDT + row0 * 144, 144, BMT + ntl * 16 * 144, 144, 64, acc, fr, fq);
              stb4(dstp + ntl * 16 + 4 * fq, acc); } } }
    __syncthreads();
}
__device__ __forceinline__ void ssd_stage3(Frame& F, const Args& A, int layer, int b, int c) {
    const bf16* u = WSP(bf16, WS_U);
    LAS unsigned char* L = F.lds;
    LAS float* DT = (LAS float*)L; LAS float* AC = DT + 256;
    LAS unsigned char* CM = L + 2048; LAS unsigned char* BM = CM + 64 * 272; LAS unsigned char* XCT = BM + 64 * 272; LAS unsigned char* MM = XCT + 256 * 144;
    LAS unsigned char* YG = XCT;
    const int t0 = b * SEQ + c * 64, tid = F.tid, lane = F.lane, wave = F.wave, fr = lane & 15, fq = lane >> 4;
    if (wave < 4) {
        const int hh = wave;
        const float dt = softplusf_(UU(t0 + lane, U_SSD_DT + hh) + KIN(I_SDTB)[layer * 4 + hh]);
        const float adt = -dt * __expf(KIN(I_SALOG)[layer * 4 + hh]);
        DT[hh * 64 + lane] = dt; AC[hh * 64 + lane] = wave_scan_add(adt, lane);
    }
    __syncthreads();
    {
        const int cc = tid; const float* cw = KIN(I_SCW) + (size_t)layer * 2048 + cc; const float w0 = cw[0], w1 = cw[512], w2 = cw[1024], w3 = cw[1536], cb = KIN(I_SCB)[layer * 512 + cc];
        const bf16* up = u + (size_t)t0 * NUP + U_SSD_X + cc;
        float win0 = 0.f, win1 = 0.f, win2 = 0.f;
        if (c > 0) { win0 = bf2f(up[-3 * NUP]); win1 = bf2f(up[-2 * NUP]); win2 = bf2f(up[-1 * NUP]); }
        const int hh = (cc >> 6) & 3;
#pragma unroll 1
        for (int l0 = 0; l0 < 64; l0 += 32) {
            float xv[32];
#pragma unroll
            for (int j = 0; j < 32; ++j) xv[j] = bf2f(up[(l0 + j) * NUP]);
#pragma unroll
            for (int j8 = 0; j8 < 4; ++j8) { float o[8];
#pragma unroll
                for (int j = 0; j < 8; ++j) { const int l = l0 + j8 * 8 + j; const float x = xv[j8 * 8 + j]; const float y = cb + w0 * win0 + w1 * win1 + w2 * win2 + w3 * x; win0 = win1; win1 = win2; win2 = x;
                    float s = siluf_(y); if (cc < 256) s *= DT[hh * 64 + l]; o[j] = s; }
                if (cc < 256) *(LAS v4u*)(XCT + cc * 144 + (l0 + j8 * 8) * 2) = pack8(o);
                else { LAS unsigned char* d2 = (cc < 384 ? BM + (cc - 256) * 2 : CM + (cc - 384) * 2) + (l0 + j8 * 8) * 272;
#pragma unroll
                    for (int j = 0; j < 8; ++j) lds_st_bf16(d2 + j * 272, o[j]); } }
        }
    }
    __syncthreads();
#pragma unroll 1
    for (int i = 0; i < 2; ++i) { const int idx = 2 * wave + i, lt = idx >> 2, st = idx & 3;
        f32x4 acc = {0.f, 0.f, 0.f, 0.f}; acc = mm16(CM + lt * 16 * 272, 272, BM + st * 16 * 272, 272, 128, acc, fr, fq);
        const int l = lt * 16 + fr, s0 = st * 16 + 4 * fq;
#pragma unroll
        for (int hh = 0; hh < 4; ++hh) { const float al = AC[hh * 64 + l], dl = KIN(I_SD)[layer * 4 + hh] / DT[hh * 64 + l]; float o[4];
#pragma unroll
            for (int j = 0; j < 4; ++j) { const int s = s0 + j; float m = (l >= s) ? acc[j] * __expf(al - AC[hh * 64 + s]) : 0.f; if (l == s) m += dl; o[j] = m; }
            lds_st_bf16x4(MM + hh * 9216 + l * 144 + s0 * 2, o[0], o[1], o[2], o[3]); } }
    __syncthreads();
    f32x4 yv[2][4];
    { const int hh = wave >> 1; const bf16* prev = WSP(bf16, WS_SSD_ST) + ((size_t)(b * 4 + hh) * NCH + c) * 8192;
      bf16x8 pf[4][4];
#pragma unroll
      for (int pt = 0; pt < 4; ++pt)
#pragma unroll
          for (int ks = 0; ks < 4; ++ks) pf[pt][ks] = *(const bf16x8*)(prev + (size_t)(pt * 16 + fr) * 128 + ks * 32 + fq * 8);
#pragma unroll
      for (int i = 0; i < 2; ++i) { const int lt = 2 * (wave & 1) + i, l = lt * 16 + fr; const float ea = __expf(AC[hh * 64 + l]);
#pragma unroll
          for (int pt = 0; pt < 4; ++pt) { f32x4 ad = {0.f, 0.f, 0.f, 0.f}, ao = {0.f, 0.f, 0.f, 0.f};
              ad = mm16(MM + hh * 9216 + lt * 16 * 144, 144, XCT + (hh * 64 + pt * 16) * 144, 144, 64, ad, fr, fq);
              ao = mm16_rB<4>(CM + lt * 16 * 272, 272, pf[pt], ao, fr, fq);
              const f32x4 z = UU4(t0 + l, U_SSD_Z + hh * 64 + pt * 16 + 4 * fq);
              f32x4 y = ad + ao * ea; y.x *= siluf_(z.x); y.y *= siluf_(z.y); y.z *= siluf_(z.z); y.w *= siluf_(z.w); yv[i][pt] = y; } } }
    __syncthreads();
    { const int hh = wave >> 1;
#pragma unroll
      for (int i = 0; i < 2; ++i) { const int l = (2 * (wave & 1) + i) * 16 + fr;
#pragma unroll
          for (int pt = 0; pt < 4; ++pt) *(LAS f32x4*)(YG + l * 1040 + (hh * 64 + pt * 16 + 4 * fq) * 4) = yv[i][pt]; } }
    __syncthreads();
    { const f32x4 g = *(const f32x4*)(KIN(I_SNG) + layer * 256 + 4 * lane); bf16* mix = WSP(bf16, WS_MIX);
#pragma unroll 1
      for (int i = 0; i < 8; ++i) { const int l = wave * 8 + i; const f32x4 y = *(const LAS f32x4*)(YG + l * 1040 + lane * 16);
          const float ss = wave_sum((y.x * y.x + y.y * y.y) + (y.z * y.z + y.w * y.w)); const float r = __builtin_amdgcn_rsqf(ss * (1.f / 256.f) + NORM_EPS);
          v2u o; o.x = cvt_pk_bf16(y.x * r * g.x, y.y * r * g.y); o.y = cvt_pk_bf16(y.z * r * g.z, y.w * r * g.w);
          *(v2u*)(mix + (size_t)(t0 + l) * D + 4 * lane) = o; } }
    __syncthreads();
}

__device__ __forceinline__ void gla_bcum_all(Frame& F, const Args& A, int layer, const LAS float* GD, LAS float* BC) {
    const int d = F.tid & 127, lq = F.tid >> 7;
    float gup[16];
    { const f32x4* gp4 = (const f32x4*)(WSP(float, WS_LORA) + (size_t)layer * LORA_PER_LAYER + 32768 + d * 16);
#pragma unroll
      for (int i = 0; i < 4; ++i) { const f32x4 a = gp4[i]; gup[4 * i] = a.x; gup[4 * i + 1] = a.y; gup[4 * i + 2] = a.z; gup[4 * i + 3] = a.w; } }
    const float gb = KIN(I_GGB)[layer * 128 + d];
#pragma unroll 4
    for (int li = 0; li < 16; ++li) { const int l = lq * 16 + li; float x = gb;
#pragma unroll
        for (int i = 0; i < 4; ++i) { const f32x4 g4 = *(const LAS f32x4*)(GD + l * 16 + 4 * i); x += (g4.x * gup[4 * i] + g4.y * gup[4 * i + 1]) + (g4.z * gup[4 * i + 2] + g4.w * gup[4 * i + 3]); }
        BC[l * 128 + d] = logsigmoidf_(x) * 0.0625f; }
    __syncthreads();
    if (F.tid < 128) { float run = 0.f;
#pragma unroll 1
        for (int l0 = 0; l0 < 64; l0 += 16) { float v[16];
#pragma unroll
            for (int j = 0; j < 16; ++j) v[j] = BC[(l0 + j) * 128 + d];
#pragma unroll
            for (int j = 0; j < 16; ++j) { run += v[j]; BC[(l0 + j) * 128 + d] = run; } } }
}
__device__ __forceinline__ void gla_stage1(Frame& F, const Args& A, int layer, int b, int c) {
    const bf16* u = WSP(bf16, WS_U);
    LAS unsigned char* L = F.lds;
    LAS float* GD = (LAS float*)L; LAS float* BC = (LAS float*)(L + 4096);
    LAS unsigned char* KDT = L + 36864; LAS unsigned char* VT = KDT + 128 * 144;
    const int t0 = b * SEQ + c * 64, tid = F.tid, lane = F.lane, wave = F.wave, fr = lane & 15, fq = lane >> 4;
    if (tid < 256) { const int l = tid >> 2, q4 = tid & 3; *(LAS f32x4*)(GD + l * 16 + q4 * 4) = UU4(t0 + l, U_GL_G + 4 * q4); }
    __syncthreads();
    gla_bcum_all(F, A, layer, GD, BC);
    if (tid < 128) {
        const int d = tid; const float blast = BC[63 * 128 + d];
        WSP(float, WS_GLA_DEC)[(size_t)(b * NCH + c) * 128 + d] = __expf(blast);
        const bf16* up = u + (size_t)t0 * NUP + U_GL_K + d;
#pragma unroll 1
        for (int l0 = 0; l0 < 64; l0 += 32) { float xv[32];
#pragma unroll
            for (int j = 0; j < 32; ++j) xv[j] = bf2f(up[(l0 + j) * NUP]);
#pragma unroll
            for (int j8 = 0; j8 < 4; ++j8) { float o[8];
#pragma unroll
                for (int j = 0; j < 8; ++j) { const int l = l0 + j8 * 8 + j; o[j] = xv[j8 * 8 + j] * __expf(blast - BC[l * 128 + d]); }
                *(LAS v4u*)(KDT + d * 144 + (l0 + j8 * 8) * 2) = pack8(o); } }
    } else if (tid < 384) {
        const int vch = tid - 128; const bf16* up = u + (size_t)t0 * NUP + U_GL_V + vch;
#pragma unroll 1
        for (int l0 = 0; l0 < 64; l0 += 32) { float xv[32];
#pragma unroll
            for (int j = 0; j < 32; ++j) xv[j] = bf2f(up[(l0 + j) * NUP]);
#pragma unroll
            for (int j8 = 0; j8 < 4; ++j8) { float o[8];
#pragma unroll
                for (int j = 0; j < 8; ++j) o[j] = xv[j8 * 8 + j];
                *(LAS v4u*)(VT + vch * 144 + (l0 + j8 * 8) * 2) = pack8(o); } }
    }
    __syncthreads();
    { bf16* st = WSP(bf16, WS_GLA_ST);
#pragma unroll 1
      for (int i = 0; i < 4; ++i) { const int idx = 4 * wave + i, hh = idx >> 3, dtl = (idx >> 2) & 1, vt = idx & 3;
          f32x4 acc = {0.f, 0.f, 0.f, 0.f}; acc = mm16(KDT + (hh * 32 + dtl * 16) * 144, 144, VT + (hh * 64 + vt * 16) * 144, 144, 64, acc, fr, fq);
          stb4(st + (((size_t)(b * 4 + hh) * NCH + c) * 32 + dtl * 16 + fr) * 64 + vt * 16 + 4 * fq, acc); } }
    __syncthreads();
}
__device__ __forceinline__ void gla_stage3(Frame& F, const Args& A, int layer, int b, int c) {
    const bf16* u = WSP(bf16, WS_U);
    LAS unsigned char* L = F.lds;
    LAS float* GD = (LAS float*)L; LAS float* BC = (LAS float*)(L + 4096); LAS unsigned char* ATT = L + 4096;
    LAS unsigned char* QD = L + 40960; LAS unsigned char* KI = QD + 64 * 272; LAS unsigned char* VT = KI + 64 * 272; LAS unsigned char* PVT = VT + 256 * 144;
    const int t0 = b * SEQ + c * 64, tid = F.tid, lane = F.lane, wave = F.wave, fr = lane & 15, fq = lane >> 4;
    if (tid < 256) { const int l = tid >> 2, q4 = tid & 3; *(LAS f32x4*)(GD + l * 16 + q4 * 4) = UU4(t0 + l, U_GL_G + 4 * q4); }
    __syncthreads();
    gla_bcum_all(F, A, layer, GD, BC);
    if (tid < 128) {
        const int d = tid;
        const bf16* uq = u + (size_t)t0 * NUP + U_GL_Q + d; const bf16* uk = u + (size_t)t0 * NUP + U_GL_K + d;
#pragma unroll 1
        for (int l0 = 0; l0 < 64; l0 += 16) { float qv[16], kv[16];
#pragma unroll
            for (int j = 0; j < 16; ++j) { qv[j] = bf2f(uq[(l0 + j) * NUP]); kv[j] = bf2f(uk[(l0 + j) * NUP]); }
#pragma unroll
            for (int j = 0; j < 16; ++j) { const int l = l0 + j; const float bc = BC[l * 128 + d];
                lds_st_bf16(QD + l * 272 + d * 2, qv[j] * 0.17677669529663687f * __expf(bc)); lds_st_bf16(KI + l * 272 + d * 2, kv[j] * __expf(-bc)); } }
    } else if (tid < 384) {
        const int vch = tid - 128; const bf16* up = u + (size_t)t0 * NUP + U_GL_V + vch;
#pragma unroll 1
        for (int l0 = 0; l0 < 64; l0 += 32) { float xv[32];
#pragma unroll
            for (int j = 0; j < 32; ++j) xv[j] = bf2f(up[(l0 + j) * NUP]);
#pragma unroll
            for (int j8 = 0; j8 < 4; ++j8) { float o[8];
#pragma unroll
                for (int j = 0; j < 8; ++j) o[j] = xv[j8 * 8 + j];
                *(LAS v4u*)(VT + vch * 144 + (l0 + j8 * 8) * 2) = pack8(o); } }
    } else {
        const bf16* prev = WSP(bf16, WS_GLA_ST);
#pragma unroll 4
        for (int i = tid - 384; i < 8192; i += 128) { const int hh = i >> 11, dd = (i >> 6) & 31, vv = i & 63;
            *(LAS unsigned short*)(PVT + (hh * 64 + vv) * 80 + dd * 2) = prev[((size_t)(b * 4 + hh) * NCH + c) * 2048 + dd * 64 + vv]; }
    }
    __syncthreads();
    const int hh = wave >> 1;
#pragma unroll 1
    for (int i = 0; i < 2; ++i) { const int tt = 2 * (wave & 1) + i, t = tt * 16 + fr;
#pragma unroll
        for (int st = 0; st < 4; ++st) { f32x4 acc = {0.f, 0.f, 0.f, 0.f}; acc = mm16(QD + tt * 16 * 272 + hh * 64, 272, KI + st * 16 * 272 + hh * 64, 272, 32, acc, fr, fq);
            const int s0 = st * 16 + 4 * fq;
            lds_st_bf16x4(ATT + hh * 9216 + t * 144 + s0 * 2, t >= s0 ? acc[0] : 0.f, t >= s0 + 1 ? acc[1] : 0.f, t >= s0 + 2 ? acc[2] : 0.f, t >= s0 + 3 ? acc[3] : 0.f); } }
    __syncthreads();
    { bf16* mix = WSP(bf16, WS_MIX); const float* ng = KIN(I_GNG) + layer * 256;
#pragma unroll 1
      for (int i = 0; i < 2; ++i) { const int tt = 2 * (wave & 1) + i, t = tt * 16 + fr; f32x4 ov[4]; float ss = 0.f;
#pragma unroll
          for (int vt = 0; vt < 4; ++vt) { f32x4 acc = {0.f, 0.f, 0.f, 0.f};
              acc = mm16(ATT + hh * 9216 + tt * 16 * 144, 144, VT + (hh * 64 + vt * 16) * 144, 144, 64, acc, fr, fq);
              acc = mm16(QD + tt * 16 * 272 + hh * 64, 272, PVT + (hh * 64 + vt * 16) * 80, 80, 32, acc, fr, fq);
              ov[vt] = acc; ss += (acc.x * acc.x + acc.y * acc.y) + (acc.z * acc.z + acc.w * acc.w); }
          ss += __shfl_xor(ss, 16); ss += __shfl_xor(ss, 32);
          const float r = __builtin_amdgcn_rsqf(ss * (1.f / 64.f) + NORM_EPS);
#pragma unroll
          for (int vt = 0; vt < 4; ++vt) { const int col = hh * 64 + vt * 16 + 4 * fq; const f32x4 g = *(const f32x4*)(ng + col); const f32x4 og = UU4(t0 + t, U_GL_OG + col);
              v2u o; o.x = cvt_pk_bf16(ov[vt].x * r * g.x * siluf_(og.x), ov[vt].y * r * g.y * siluf_(og.y)); o.y = cvt_pk_bf16(ov[vt].z * r * g.z * siluf_(og.z), ov[vt].w * r * g.w * siluf_(og.w));
              *(v2u*)(mix + (size_t)(t0 + t) * D + 512 + col) = o; } } }
    __syncthreads();
}

__device__ __forceinline__ void mlstm_stage1(Frame& F, const Args& A, int layer, int b, int c) {
    const bf16* u = WSP(bf16, WS_U);
    LAS unsigned char* L = F.lds;
    LAS float* WST = (LAS float*)L; LAS unsigned char* KT = L + 1024; LAS unsigned char* VWT = KT + 256 * 144;
    const int t0 = b * SEQ + c * 64, tid = F.tid, lane = F.lane, wave = F.wave, fr = lane & 15, fq = lane >> 4;
    if (wave < 4) {
        const int hh = wave;
        const float ig = UU(t0 + lane, U_ML_I + hh) + KIN(I_MIB)[layer * 4 + hh];
        const float lf = logsigmoidf_(UU(t0 + lane, U_ML_F + hh) + KIN(I_MFB)[layer * 4 + hh]);
        const float bc = wave_scan_add(lf, lane); const float blast = __shfl(bc, 63);
        const float ast = blast - bc + ig; const float mloc = wave_max(ast);
        WST[hh * 64 + lane] = __expf(ast - mloc);
        if (lane == 0) { WSP(float, WS_ML_BL)[(b * 4 + hh) * NCH + c] = blast; WSP(float, WS_ML_ML)[(b * 4 + hh) * NCH + c] = mloc; }
    } else {
        const int kch = tid - 256, cc = 256 + kch; const float* cw = KIN(I_MCW) + (size_t)layer * 2048 + cc; const float w0 = cw[0], w1 = cw[512], w2 = cw[1024], w3 = cw[1536], cb = KIN(I_MCB)[layer * 512 + cc];
        const bf16* up = u + (size_t)t0 * NUP + U_ML_K + kch;
        float win0 = 0.f, win1 = 0.f, win2 = 0.f;
        if (c > 0) { win0 = bf2f(up[-3 * NUP]); win1 = bf2f(up[-2 * NUP]); win2 = bf2f(up[-1 * NUP]); }
#pragma unroll 1
        for (int l0 = 0; l0 < 64; l0 += 32) { float xv[32];
#pragma unroll
            for (int j = 0; j < 32; ++j) xv[j] = bf2f(up[(l0 + j) * NUP]);
#pragma unroll
            for (int j8 = 0; j8 < 4; ++j8) { float o[8];
#pragma unroll
                for (int j = 0; j < 8; ++j) { const float x = xv[j8 * 8 + j]; const float y = cb + w0 * win0 + w1 * win1 + w2 * win2 + w3 * x; win0 = win1; win1 = win2; win2 = x; o[j] = siluf_(y); }
                *(LAS v4u*)(KT + kch * 144 + (l0 + j8 * 8) * 2) = pack8(o); } }
    }
    __syncthreads();
    if (tid < 256) {
        const int vch = tid, hh = vch >> 6; const bf16* up = u + (size_t)t0 * NUP + U_ML_V + vch;
#pragma unroll 1
        for (int l0 = 0; l0 < 64; l0 += 32) { float xv[32];
#pragma unroll
            for (int j = 0; j < 32; ++j) xv[j] = bf2f(up[(l0 + j) * NUP]);
#pragma unroll
            for (int j8 = 0; j8 < 4; ++j8) { float o[8];
#pragma unroll
                for (int j = 0; j < 8; ++j) o[j] = xv[j8 * 8 + j] * WST[hh * 64 + l0 + j8 * 8 + j];
                *(LAS v4u*)(VWT + vch * 144 + (l0 + j8 * 8) * 2) = pack8(o); } }
    } else {
        const int kch = tid - 256, hh = kch >> 6; float n = 0.f;
#pragma unroll 8
        for (int s = 0; s < 64; ++s) n += WST[hh * 64 + s] * bf2f(*(const LAS unsigned short*)(KT + kch * 144 + s * 2));
        WSP(bf16, WS_ML_N)[((size_t)(b * 4 + hh) * NCH + c) * 64 + (kch & 63)] = (bf16)(cvt_pk_bf16(n, 0.f) & 0xffffu);
    }
    __syncthreads();
    { bf16* cst = WSP(bf16, WS_ML_C); const int hh = wave >> 1;
#pragma unroll 1
      for (int i = 0; i < 2; ++i) { const int vt = 2 * (wave & 1) + i;
#pragma unroll 1
          for (int kt = 0; kt < 4; ++kt) { f32x4 acc = {0.f, 0.f, 0.f, 0.f}; acc = mm16(VWT + (hh * 64 + vt * 16) * 144, 144, KT + (hh * 64 + kt * 16) * 144, 144, 64, acc, fr, fq);
              stb4(cst + (((size_t)(b * 4 + hh) * NCH + c) * 64 + vt * 16 + fr) * 64 + kt * 16 + 4 * fq, acc); } } }
    __syncthreads();
}
__device__ __forceinline__ void mlstm_stage3(Frame& F, const Args& A, int layer, int b, int c) {
    const bf16* u = WSP(bf16, WS_U);
    LAS unsigned char* L = F.lds;
    LAS float* BCU = (LAS float*)L; LAS float* GG = BCU + 256; LAS float* MROW = BCU + 512; LAS float* WINT = BCU + 768; LAS float* NPV = BCU + 1024;
    LAS unsigned char* Q = L + 6144; LAS unsigned char* KK = Q + 64 * 528; LAS unsigned char* VT = KK + 64 * 528; LAS unsigned char* SC = VT + 256 * 144;
    const int t0 = b * SEQ + c * 64, tid = F.tid, lane = F.lane, wave = F.wave, fr = lane & 15, fq = lane >> 4;
    if (wave < 4) {
        const int hh = wave;
        const float ig = UU(t0 + lane, U_ML_I + hh) + KIN(I_MIB)[layer * 4 + hh];
        const float lf = logsigmoidf_(UU(t0 + lane, U_ML_F + hh) + KIN(I_MFB)[layer * 4 + hh]);
        const float bc = wave_scan_add(lf, lane); const float gg = ig - bc;
        const float mprev = WSP(float, WS_ML_M)[(b * 4 + hh) * NCH + c];
        const float minter = bc + mprev, mintra = bc + wave_scan_max(gg, lane), mrow = fmaxf(minter, mintra);
        BCU[hh * 64 + lane] = bc; GG[hh * 64 + lane] = gg; MROW[hh * 64 + lane] = mrow; WINT[hh * 64 + lane] = __expf(minter - mrow);
        NPV[hh * 64 + lane] = bf2f(WSP(bf16, WS_ML_N)[((size_t)(b * 4 + hh) * NCH + c) * 64 + lane]);
    }
    {
        const int cc = tid; const float* cw = KIN(I_MCW) + (size_t)layer * 2048 + cc; const float w0 = cw[0], w1 = cw[512], w2 = cw[1024], w3 = cw[1536], cb = KIN(I_MCB)[layer * 512 + cc];
        const bf16* up = u + (size_t)t0 * NUP + U_ML_Q + cc;
        float win0 = 0.f, win1 = 0.f, win2 = 0.f;
        if (c > 0) { win0 = bf2f(up[-3 * NUP]); win1 = bf2f(up[-2 * NUP]); win2 = bf2f(up[-1 * NUP]); }
        LAS unsigned char* dst = cc < 256 ? Q + cc * 2 : KK + (cc - 256) * 2; const float sc = cc < 256 ? 0.125f : 1.0f;
#pragma unroll 1
        for (int l0 = 0; l0 < 64; l0 += 32) { float xv[32];
#pragma unroll
            for (int j = 0; j < 32; ++j) xv[j] = bf2f(up[(l0 + j) * NUP]);
#pragma unroll
            for (int j = 0; j < 32; ++j) { const float x = xv[j]; const float y = cb + w0 * win0 + w1 * win1 + w2 * win2 + w3 * x; win0 = win1; win1 = win2; win2 = x; lds_st_bf16(dst + (l0 + j) * 528, siluf_(y) * sc); } }
        const int vch = tid & 255, lh = (tid >> 8) * 32; const bf16* uv = u + (size_t)(t0 + lh) * NUP + U_ML_V + vch;
        float xv[32];
#pragma unroll
        for (int j = 0; j < 32; ++j) xv[j] = bf2f(uv[j * NUP]);
#pragma unroll
        for (int j8 = 0; j8 < 4; ++j8) { float o[8];
#pragma unroll
            for (int j = 0; j < 8; ++j) o[j] = xv[j8 * 8 + j];
            *(LAS v4u*)(VT + vch * 144 + (lh + j8 * 8) * 2) = pack8(o); }
    }
    __syncthreads();
    { const int hh = wave >> 1; bf16* mix = WSP(bf16, WS_MIX); const float* ng = KIN(I_MNG) + layer * 256;
      const bf16* cprev = WSP(bf16, WS_ML_C) + ((size_t)(b * 4 + hh) * NCH + c) * 4096;
      bf16x8 cf[4][2];
#pragma unroll
      for (int vt = 0; vt < 4; ++vt)
#pragma unroll
          for (int ks = 0; ks < 2; ++ks) cf[vt][ks] = *(const bf16x8*)(cprev + (size_t)(vt * 16 + fr) * 64 + ks * 32 + fq * 8);
#pragma unroll 1
      for (int i = 0; i < 2; ++i) { const int tt = 2 * (wave & 1) + i, t = tt * 16 + fr;
          const float bt = BCU[hh * 64 + t] - MROW[hh * 64 + t]; float rs = 0.f;
#pragma unroll
          for (int st = 0; st < 4; ++st) { f32x4 acc = {0.f, 0.f, 0.f, 0.f}; acc = mm16(Q + tt * 16 * 528 + hh * 128, 528, KK + st * 16 * 528 + hh * 128, 528, 64, acc, fr, fq);
              const int s0 = st * 16 + 4 * fq; float o[4];
#pragma unroll
              for (int j = 0; j < 4; ++j) { const int s = s0 + j; const float v = (t >= s) ? acc[j] * __expf(bt + GG[hh * 64 + s]) : 0.f; o[j] = v; rs += v; }
              lds_st_bf16x4(SC + hh * 9216 + t * 144 + s0 * 2, o[0], o[1], o[2], o[3]); }
          rs += __shfl_xor(rs, 16); rs += __shfl_xor(rs, 32);
          float nq = 0.f;
#pragma unroll
          for (int j = 0; j < 16; ++j) nq += bf2f(*(const LAS unsigned short*)(Q + t * 528 + (hh * 64 + fq * 16 + j) * 2)) * NPV[hh * 64 + fq * 16 + j];
          nq += __shfl_xor(nq, 16); nq += __shfl_xor(nq, 32);
          const float wi = WINT[hh * 64 + t]; const float den = wi * nq + rs; const float dn = fmaxf(fabsf(den), __expf(-MROW[hh * 64 + t])); const float rdn = 1.0f / dn;
          LDS_WAIT();
          f32x4 hv[4]; float sm = 0.f;
#pragma unroll
          for (int vt = 0; vt < 4; ++vt) { f32x4 acc = {0.f, 0.f, 0.f, 0.f};
              acc = mm16_rB<2>(Q + tt * 16 * 528 + hh * 128, 528, cf[vt], acc, fr, fq);
              acc = acc * wi;
              acc = mm16(SC + hh * 9216 + tt * 16 * 144, 144, VT + (hh * 64 + vt * 16) * 144, 144, 64, acc, fr, fq);
              const f32x4 og = UU4(t0 + t, U_ML_O + hh * 64 + vt * 16 + 4 * fq);
              f32x4 h; h.x = acc.x * rdn * sigmoidf_(og.x); h.y = acc.y * rdn * sigmoidf_(og.y); h.z = acc.z * rdn * sigmoidf_(og.z); h.w = acc.w * rdn * sigmoidf_(og.w);
              hv[vt] = h; sm += (h.x + h.y) + (h.z + h.w); }
          sm += __shfl_xor(sm, 16); sm += __shfl_xor(sm, 32);
          const float mean = sm * (1.f / 64.f); float sq = 0.f;
#pragma unroll
          for (int vt = 0; vt < 4; ++vt) { hv[vt] = hv[vt] - mean; sq += (hv[vt].x * hv[vt].x + hv[vt].y * hv[vt].y) + (hv[vt].z * hv[vt].z + hv[vt].w * hv[vt].w); }
          sq += __shfl_xor(sq, 16); sq += __shfl_xor(sq, 32);
          const float r = __builtin_amdgcn_rsqf(sq * (1.f / 64.f) + NORM_EPS);
#pragma unroll
          for (int vt = 0; vt < 4; ++vt) { const int col = hh * 64 + vt * 16 + 4 * fq; const f32x4 g = *(const f32x4*)(ng + col);
              v2u o; o.x = cvt_pk_bf16(hv[vt].x * r * g.x, hv[vt].y * r * g.y); o.y = cvt_pk_bf16(hv[vt].z * r * g.z, hv[vt].w * r * g.w);
              *(v2u*)(mix + (size_t)(t0 + t) * D + 768 + col) = o; } } }
    __syncthreads();
}

__device__ __forceinline__ void rwkv_stage1(Frame& F, const Args& A, int layer, int ub) {
    const bf16* u = WSP(bf16, WS_U);
    LAS unsigned char* L = F.lds;
    LAS unsigned char* LOWA = L;
    LAS float* CUM = (LAS float*)(L + 16384);
    LAS float* AAB = CUM;
    LAS float* TOT = CUM;
    LAS unsigned char* M0 = L + 16384 + 16640;
#define RM(i) (M0 + (i) * 9216)
    LAS float* GAMC = (LAS float*)(F.MISC + MW_GAMC);
    const int t0 = ub * 64, c = ub & 63, tid = F.tid, lane = F.lane, wave = F.wave;
    const float* mu = KIN(I_RMU) + layer * 896;
#ifndef RW_DUP
#define RW_DUP -1
#endif
#define RW_REP(k) for (int rep__ = 0; rep__ < ((RW_DUP == (k)) ? 2 : 1); ++rep__)
    RW_REP(0) {
    {
        const int l = tid >> 3, jq = tid & 7, t = t0 + l; const bool has_prev = (t & (SEQ - 1)) != 0;
        f32x4 cur[4], prv[4];
#pragma unroll
        for (int q = 0; q < 4; ++q) { cur[q] = UU4(t, U_RW_LO + jq * 16 + 4 * q); prv[q] = has_prev ? UU4(t - 1, U_RW_LO + jq * 16 + 4 * q) : (f32x4){0.f, 0.f, 0.f, 0.f}; }
#pragma unroll
        for (int q = 0; q < 4; ++q) { const f32x4 m4 = *(const f32x4*)(mu + 768 + jq * 16 + 4 * q); const f32x4 xs = cur[q] + (prv[q] - cur[q]) * m4; const int j = jq * 16 + 4 * q;
            f32x4 o;
            if (j < 32) { o.x = tanhf_(xs.x); o.y = tanhf_(xs.y); o.z = tanhf_(xs.z); o.w = tanhf_(xs.w); } else if (j < 64) o = xs; else { o.x = sigmoidf_(xs.x); o.y = sigmoidf_(xs.y); o.z = sigmoidf_(xs.z); o.w = sigmoidf_(xs.w); }
            if (j < 64) lds_st_bf16x4(LOWA + l * 144 + j * 2, o.x, o.y, o.z, o.w); else lds_st_bf16x4(RM(0) + l * 144 + (j - 64) * 2, o.x, o.y, o.z, o.w); }
    }
    __syncthreads();
    {
        bf16* RG = WSP(bf16, WS_RW_G); const int lane_ = F.lane, fr_ = lane_ & 15, fq_ = lane_ >> 4;
        const float* gupT = WSP(float, WS_LORA) + (size_t)layer * LORA_PER_LAYER + 16384;
#pragma unroll
        for (int ci = 0; ci < 2; ++ci) { const int ct = 2 * wave + ci; bf16x8 bf[2];
#pragma unroll
            for (int ks = 0; ks < 2; ++ks) bf[ks] = ldfrag_f32(gupT + (size_t)(ct * 16 + fr_) * 64 + ks * 32 + fq_ * 8);
#pragma unroll
            for (int tt = 0; tt < 4; ++tt) { f32x4 acc = {0.f, 0.f, 0.f, 0.f}; acc = mm16_rB<2>(RM(0) + tt * 16 * 144, 144, bf, acc, fr_, fq_);
                stb4(RG + (size_t)(t0 + tt * 16 + fr_) * 256 + ct * 16 + 4 * fq_, acc); } }
    }
    __syncthreads();
    }
    const int b_ = ub >> 6;
#pragma unroll 1
    for (int hh = 0; hh < 4; ++hh) {
        int ch = lane, fr = lane & 15, fq = lane >> 4; asm volatile("" : "+v"(ch), "+v"(fr), "+v"(fq));
        const int tg = wave, cg = hh * 64 + ch; const size_t un = (size_t)(b_ * 4 + hh) * NCH + c;
        float rr[8], k2r[8], vr[8], ar[8], br[8], pl[8];
        LAS float* WPA = (LAS float*)RM(8);
        {
            const int mat = wave >> 2, ct = wave & 3;
            const float* wT = WSP(float, WS_LORA) + (size_t)layer * LORA_PER_LAYER + mat * 8192 + (size_t)(hh * 64 + ct * 16 + fr) * 32 + fq * 8;
            bf16x8 bfw[1]; bfw[0] = ldfrag_f32(wT);
#pragma unroll
            for (int tt = 0; tt < 4; ++tt) { f32x4 acc = {0.f, 0.f, 0.f, 0.f}; acc = mm16_rB<1>(LOWA + tt * 16 * 144 + mat * 64, 144, bfw, acc, fr, fq);
                *(LAS f32x4*)(WPA + mat * 4096 + (tt * 16 + fr) * 64 + ct * 16 + 4 * fq) = acc; }
        }
        __syncthreads();
        RW_REP(1) {
            const float w0 = KIN(I_RW0)[layer * 256 + cg], a0 = KIN(I_RA0)[layer * 256 + cg], kkc = KIN(I_RKK)[layer * 256 + cg], kac = KIN(I_RKA)[layer * 256 + cg];
            const float mur = mu[cg], muk = mu[256 + cg], muv = mu[512 + cg];
            const int tb = t0 + tg * 8; const bool nop = (c == 0) && (tg == 0);
            float rp = nop ? 0.f : UU(tb - 1, U_RW_R + cg), kp = nop ? 0.f : UU(tb - 1, U_RW_K + cg), vp = nop ? 0.f : UU(tb - 1, U_RW_V + cg);
            float rc[8], kc[8], vc[8];
#pragma unroll
            for (int j = 0; j < 8; ++j) { rc[j] = UU(tb + j, U_RW_R + cg); kc[j] = UU(tb + j, U_RW_K + cg); vc[j] = UU(tb + j, U_RW_V + cg); }
            bf16* RW = WSP(bf16, WS_RW);
            float kk[8], al[8], n2[8], run = 0.f;
#pragma unroll
            for (int j = 0; j < 8; ++j) { const int l = tg * 8 + j;
                const float r = rc[j] + (rp - rc[j]) * mur, k = kc[j] + (kp - kc[j]) * muk, v = vc[j] + (vp - vc[j]) * muv; rp = rc[j]; kp = kc[j]; vp = vc[j];
                const float wp = w0 + WPA[l * 64 + ch], ap = a0 + WPA[4096 + l * 64 + ch];
                const float w = -softplusf_(-wp) - 0.5f; run += -__expf(w); pl[j] = run; al[j] = sigmoidf_(ap);
                kk[j] = k * kkc; n2[j] = kk[j] * kk[j];
                k2r[j] = k * (1.0f + (al[j] - 1.0f) * kac); rr[j] = r; vr[j] = v;
                bf16* o = RW + (size_t)(tb + j) * 768 + cg; o[0] = (bf16)(cvt_pk_bf16(r, 0.f) & 0xffffu); o[256] = (bf16)(cvt_pk_bf16(k2r[j], 0.f) & 0xffffu); o[512] = (bf16)(cvt_pk_bf16(v, 0.f) & 0xffffu); }
#pragma unroll
            for (int i = 0; i < 4; ++i) { const bool hi = (ch & 32) != 0; const float keep = hi ? n2[i + 4] : n2[i], send = hi ? n2[i] : n2[i + 4]; n2[i] = keep + __shfl_xor(send, 32); }
#pragma unroll
            for (int i = 0; i < 2; ++i) { const bool hi = (ch & 16) != 0; const float keep = hi ? n2[i + 2] : n2[i], send = hi ? n2[i] : n2[i + 2]; n2[i] = keep + __shfl_xor(send, 16); }
            { const bool hi = (ch & 8) != 0; const float keep = hi ? n2[1] : n2[0], send = hi ? n2[0] : n2[1]; n2[0] = keep + __shfl_xor(send, 8); }
            n2[0] += __shfl_xor(n2[0], 4); n2[0] += __shfl_xor(n2[0], 2); n2[0] += __shfl_xor(n2[0], 1);
#pragma unroll
            for (int j = 0; j < 8; ++j) { const float tot = __builtin_bit_cast(float, __builtin_amdgcn_readlane(__builtin_bit_cast(int, n2[0]), ((j & 4) ? 32 : 0) + ((j & 2) ? 16 : 0) + ((j & 1) ? 8 : 0)));
                const float kkn = kk[j] / fmaxf(sqrtf(tot), 1e-12f); ar[j] = -kkn; br[j] = kkn * al[j]; }
            TOT[tg * 64 + ch] = run;
        }
        __syncthreads();
        RW_REP(3) {
            float off = 0.f, gC = 0.f;
#pragma unroll
            for (int g = 0; g < 8; ++g) { const float tv = TOT[g * 64 + ch]; gC += tv; if (g < tg) off += tv; }
            float oat[8], obb[8], okb[8], ov[8];
#pragma unroll
            for (int j = 0; j < 8; ++j) { const int l = tg * 8 + j; const float gt = off + pl[j], gm = j > 0 ? off + pl[j - 1] : off;
                const float at = ar[j] * __expf(gm), rt = rr[j] * __expf(gt), en = __expf(-gt), ec = __expf(gC - gt);
                lds_st_bf16(RM(0) + l * 144 + ch * 2, at); lds_st_bf16(RM(1) + l * 144 + ch * 2, rt); lds_st_bf16(RM(2) + l * 144 + ch * 2, br[j] * en); lds_st_bf16(RM(3) + l * 144 + ch * 2, k2r[j] * en);
                oat[j] = at; obb[j] = br[j] * ec; okb[j] = k2r[j] * ec; ov[j] = vr[j]; }
            *(LAS v4u*)(RM(4) + ch * 144 + tg * 16) = pack8(oat); *(LAS v4u*)(RM(5) + ch * 144 + tg * 16) = pack8(obb); *(LAS v4u*)(RM(6) + ch * 144 + tg * 16) = pack8(okb); *(LAS v4u*)(RM(7) + ch * 144 + tg * 16) = pack8(ov);
            if (tg == 0) GAMC[ch] = __expf(gC);
        }
        __syncthreads();
        RW_REP(4) {
            const int which = wave >> 1; const LAS unsigned char* Aop = which < 2 ? RM(0) : RM(1); const LAS unsigned char* Bop = (which & 1) ? RM(3) : RM(2);
#pragma unroll 1
            for (int i2 = 0; i2 < 2; ++i2) { const int tt = 2 * (wave & 1) + i2, t = tt * 16 + fr;
#pragma unroll
                for (int it = 0; it < 4; ++it) { f32x4 acc = {0.f, 0.f, 0.f, 0.f}; acc = mm16(Aop + tt * 16 * 144, 144, Bop + it * 16 * 144, 144, 64, acc, fr, fq);
                    const int i0 = it * 16 + 4 * fq; const int lim = which < 2 ? t : t + 1;
                    const float o0 = (i0 < lim) ? acc[0] : 0.f, o1 = (i0 + 1 < lim) ? acc[1] : 0.f, o2 = (i0 + 2 < lim) ? acc[2] : 0.f, o3 = (i0 + 3 < lim) ? acc[3] : 0.f;
#ifdef RW_CLAMP_AAK
                    float q0 = o0, q1 = o1, q2 = o2, q3 = o3;
                    if (which == 1) { q0 = fabsf(o0) < 1e30f ? o0 : 0.f; q1 = fabsf(o1) < 1e30f ? o1 : 0.f; q2 = fabsf(o2) < 1e30f ? o2 : 0.f; q3 = fabsf(o3) < 1e30f ? o3 : 0.f; }
                    if (which == 0) *(LAS f32x4*)(AAB + t * 64 + i0) = (f32x4){o0, o1, o2, o3};
                    else lds_st_bf16x4(RM(7 + which) + t * 144 + i0 * 2, q0, q1, q2, q3);
                    continue;
#endif
                    if (which == 0) { DBG_STAT(11, o0); DBG_STAT(11, o1); DBG_STAT(11, o2); DBG_STAT(11, o3); } if (which == 1) { DBG_STAT(12, o0); DBG_STAT(12, o1); DBG_STAT(12, o2); DBG_STAT(12, o3); } if (which == 2) { DBG_STAT(13, o0); DBG_STAT(13, o3); } if (which == 3) { DBG_STAT(14, o0); DBG_STAT(14, o3); }
                    if (which == 0) *(LAS f32x4*)(AAB + t * 64 + i0) = (f32x4){o0, o1, o2, o3};
                    else lds_st_bf16x4(RM(7 + which) + t * 144 + i0 * 2, o0, o1, o2, o3); } }
        }
        __syncthreads();
        RW_REP(5) {
#pragma unroll 1
            for (int i2 = 0; i2 < 2; ++i2) { const int idx = wave * 2 + i2, vt = idx >> 2, tt = idx & 3; f32x4 acc = {0.f, 0.f, 0.f, 0.f};
                acc = mm16(RM(7) + vt * 16 * 144, 144, RM(8) + tt * 16 * 144, 144, 64, acc, fr, fq);
                DBG_STAT(15, acc[0]); DBG_STAT(15, acc[1]); DBG_STAT(15, acc[2]); DBG_STAT(15, acc[3]);
                lds_st_bf16x4(RM(0) + (vt * 16 + fr) * 144 + (tt * 16 + 4 * fq) * 2, acc[0], acc[1], acc[2], acc[3]); }
        }
        RW_REP(8) if (wave == 0) {
            float x[64]; f32x4 rowq[16];
#pragma unroll
            for (int t = 0; t < 64; ++t) {
                f32x4 cur[16];
#pragma unroll
                for (int i4 = 0; i4 < (t + 3) / 4; ++i4) cur[i4] = rowq[i4];
                if (t + 1 < 64) {
#pragma unroll
                    for (int i4 = 0; i4 < (t + 4) / 4; ++i4) rowq[i4] = *(const LAS f32x4*)(AAB + (t + 1) * 64 + 4 * i4); }
                float a0 = (t == ch) ? 1.0f : 0.f, a1 = 0.f, a2 = 0.f, a3 = 0.f;
#pragma unroll
                for (int i4 = 0; i4 < (t + 3) / 4; ++i4) { const f32x4 q = cur[i4];
                    a0 += q.x * x[4 * i4]; if (4 * i4 + 1 < t) a1 += q.y * x[4 * i4 + 1]; if (4 * i4 + 2 < t) a2 += q.z * x[4 * i4 + 2]; if (4 * i4 + 3 < t) a3 += q.w * x[4 * i4 + 3]; }
                const float acc = (a0 + a1) + (a2 + a3);
                x[t] = acc; lds_st_bf16(RM(11) + t * 144 + ch * 2, acc); }
        }
        __syncthreads();
        RW_REP(6) {
            const int rt = wave >> 1;
#pragma unroll
            for (int i2 = 0; i2 < 2; ++i2) { const int tt = 2 * (wave & 1) + i2;
                f32x4 acc = {0.f, 0.f, 0.f, 0.f}; acc = mm16(RM(4) + rt * 16 * 144, 144, RM(11) + tt * 16 * 144, 144, 64, acc, fr, fq);
                DBG_STAT(17, acc[0]); DBG_STAT(17, acc[1]); DBG_STAT(17, acc[2]); DBG_STAT(17, acc[3]);
                lds_st_bf16x4(RM(2) + (rt * 16 + fr) * 144 + (tt * 16 + 4 * fq) * 2, acc[0], acc[1], acc[2], acc[3]);
                f32x4 ac2 = {0.f, 0.f, 0.f, 0.f}; ac2 = mm16(RM(0) + rt * 16 * 144, 144, RM(11) + tt * 16 * 144, 144, 64, ac2, fr, fq);
                DBG_STAT(18, ac2[0]); DBG_STAT(18, ac2[1]); DBG_STAT(18, ac2[2]); DBG_STAT(18, ac2[3]);
                lds_st_bf16x4(RM(3) + (rt * 16 + fr) * 144 + (tt * 16 + 4 * fq) * 2, ac2[0], ac2[1], ac2[2], ac2[3]); }
        }
        __syncthreads();
        RW_REP(7) {
            const int which = wave >> 1;
#pragma unroll 1
            for (int i2 = 0; i2 < 2; ++i2) { const int rt = 2 * (wave & 1) + i2, row = rt * 16 + fr;
#pragma unroll
                for (int ct = 0; ct < 4; ++ct) { f32x4 acc = {0.f, 0.f, 0.f, 0.f}; const int c0 = ct * 16 + 4 * fq;
                    if (which == 0) { acc = mm16(RM(9) + rt * 16 * 144, 144, RM(2) + ct * 16 * 144, 144, 64, acc, fr, fq);
                        const v2u rw = *(const LAS v2u*)(RM(1) + row * 144 + c0 * 2);
                        acc[0] += __uint_as_float(rw.x << 16); acc[1] += __uint_as_float(rw.x & 0xffff0000u); acc[2] += __uint_as_float(rw.y << 16); acc[3] += __uint_as_float(rw.y & 0xffff0000u);
                        DBG_STAT(19, acc[0]); DBG_STAT(19, acc[1]); DBG_STAT(19, acc[2]); DBG_STAT(19, acc[3]);
                        v2u o; o.x = cvt_pk_bf16(acc[0], acc[1]); o.y = cvt_pk_bf16(acc[2], acc[3]); *(v2u*)(WSP(bf16, WS_RW_RH) + un * 4096 + row * 64 + c0) = o; }
                    else if (which == 1) {
#ifndef RW_NO_U0
                        acc = mm16(RM(9) + rt * 16 * 144, 144, RM(3) + ct * 16 * 144, 144, 64, acc, fr, fq);
#endif
                        acc = mm16(RM(10) + rt * 16 * 144, 144, RM(7) + ct * 16 * 144, 144, 64, acc, fr, fq);
                        DBG_STAT(20, acc[0]); DBG_STAT(20, acc[1]); DBG_STAT(20, acc[2]); DBG_STAT(20, acc[3]);
                        stb4(WSP(bf16, WS_RW_O0) + un * 4096 + row * 64 + c0, acc); }
                    else if (which == 2) { acc = mm16(RM(5) + rt * 16 * 144, 144, RM(2) + ct * 16 * 144, 144, 64, acc, fr, fq);
                        const float gd = GAMC[row]; if (row == c0) acc[0] += gd; if (row == c0 + 1) acc[1] += gd; if (row == c0 + 2) acc[2] += gd; if (row == c0 + 3) acc[3] += gd;
                        DBG_STAT(21, acc[0]); DBG_STAT(21, acc[1]); DBG_STAT(21, acc[2]); DBG_STAT(21, acc[3]);
                        v2u o; o.x = cvt_pk_bf16(acc[0], acc[1]); o.y = cvt_pk_bf16(acc[2], acc[3]);
                        *(v2u*)((unsigned char*)(WSP(bf16, WS_RW_GF) + un * 4096) + ((rt * 2 + (ct >> 1)) * 64 + ch) * 16 + (ct & 1) * 8) = o; }
                    else { acc = mm16(RM(3) + rt * 16 * 144, 144, RM(5) + ct * 16 * 144, 144, 64, acc, fr, fq); acc = mm16(RM(7) + rt * 16 * 144, 144, RM(6) + ct * 16 * 144, 144, 64, acc, fr, fq);
                        DBG_STAT(22, acc[0]); DBG_STAT(22, acc[1]); DBG_STAT(22, acc[2]); DBG_STAT(22, acc[3]);
                        *(f32x4*)(WSP(float, WS_RW_HT) + un * 4096 + row * 64 + c0) = acc; } } }
        }
        __syncthreads();
    }
#undef RM
}
__device__ __forceinline__ void rwkv_scan_wave(Frame& F, const Args& A, int wslot) {
    const int lane = F.lane, fr = lane & 15, fq = lane >> 4, bh = wslot >> 2, v0 = (wslot & 3) * 16;
    const bf16* GF = WSP(bf16, WS_RW_GF) + (size_t)bh * NCH * 4096; const float* HT = WSP(float, WS_RW_HT) + (size_t)bh * NCH * 4096 + (size_t)(v0 + fr) * 64 + 4 * fq;
    bf16* PT = WSP(bf16, WS_RW_PT) + (size_t)bh * NCH * 4096 + (size_t)(v0 + fr) * 64 + 4 * fq;
    f32x4 P[4] = {{0.f, 0.f, 0.f, 0.f}, {0.f, 0.f, 0.f, 0.f}, {0.f, 0.f, 0.f, 0.f}, {0.f, 0.f, 0.f, 0.f}};
    bf16x8 g0[4][2], g1[4][2], g2[4][2]; f32x4 h0[4], h1[4], h2[4];
#define RW2_LOAD(gx, hx, cc) do { _Pragma("unroll") for (int m = 0; m < 4; ++m) { hx[m] = *(const f32x4*)(HT + (size_t)(cc) * 4096 + 16 * m); \
        _Pragma("unroll") for (int s = 0; s < 2; ++s) gx[m][s] = *(const bf16x8*)(GF + (size_t)(cc) * 4096 + ((m * 2 + s) * 64 + lane) * 8); } } while (0)
#define RW2_STEP(gx, hx, cc) do { v4u bs[2]; \
        _Pragma("unroll") for (int s = 0; s < 2; ++s) { bs[s].x = cvt_pk_bf16(P[2 * s][0], P[2 * s][1]); bs[s].y = cvt_pk_bf16(P[2 * s][2], P[2 * s][3]); bs[s].z = cvt_pk_bf16(P[2 * s + 1][0], P[2 * s + 1][1]); bs[s].w = cvt_pk_bf16(P[2 * s + 1][2], P[2 * s + 1][3]); } \
        *(v2u*)(PT + (size_t)(cc) * 4096) = (v2u){bs[0].x, bs[0].y}; *(v2u*)(PT + (size_t)(cc) * 4096 + 16) = (v2u){bs[0].z, bs[0].w}; \
        *(v2u*)(PT + (size_t)(cc) * 4096 + 32) = (v2u){bs[1].x, bs[1].y}; *(v2u*)(PT + (size_t)(cc) * 4096 + 48) = (v2u){bs[1].z, bs[1].w}; \
        _Pragma("unroll") for (int m = 0; m < 4; ++m) { f32x4 acc = hx[m]; acc = __builtin_amdgcn_mfma_f32_16x16x32_bf16(gx[m][0], __builtin_bit_cast(bf16x8, bs[0]), acc, 0, 0, 0); \
            acc = __builtin_amdgcn_mfma_f32_16x16x32_bf16(gx[m][1], __builtin_bit_cast(bf16x8, bs[1]), acc, 0, 0, 0); P[m] = acc; } } while (0)
    RW2_LOAD(g0, h0, 0); RW2_LOAD(g1, h1, 1);
#pragma unroll 1
    for (int c = 0; c < 63; c += 3) {
        RW2_LOAD(g2, h2, c + 2); RW2_STEP(g0, h0, c);
        RW2_LOAD(g0, h0, c + 3); RW2_STEP(g1, h1, c + 1);
        if (c + 4 < NCH) RW2_LOAD(g1, h1, c + 4);
        RW2_STEP(g2, h2, c + 2);
    }
    RW2_STEP(g0, h0, 63);
#undef RW2_LOAD
#undef RW2_STEP
}
__device__ __forceinline__ void rwkv_stage3(Frame& F, const Args& A, int layer, int ub) {
    const int t0 = ub * 64, b_ = ub >> 6, c = ub & 63, lane = F.lane, wave = F.wave, fr = lane & 15, fq = lane >> 4, hh = wave >> 1;
    const size_t un = (size_t)(b_ * 4 + hh) * NCH + c;
    const bf16* RH = WSP(bf16, WS_RW_RH) + un * 4096; const bf16* PT = WSP(bf16, WS_RW_PT) + un * 4096; const bf16* O0 = WSP(bf16, WS_RW_O0) + un * 4096;
    const bf16* RW = WSP(bf16, WS_RW); const bf16* RG = WSP(bf16, WS_RW_G); bf16* mix = WSP(bf16, WS_MIX);
    const float* lg = KIN(I_RLNG) + layer * 256 + hh * 64; const float* lb = KIN(I_RLNB) + layer * 256 + hh * 64; const float* rk = KIN(I_RRK) + layer * 256 + hh * 64;
    bf16x8 pfr[4][2];
#pragma unroll
    for (int vt = 0; vt < 4; ++vt)
#pragma unroll
        for (int ks = 0; ks < 2; ++ks) pfr[vt][ks] = *(const bf16x8*)(PT + (size_t)(vt * 16 + fr) * 64 + ks * 32 + fq * 8);
#pragma unroll 1
    for (int i = 0; i < 2; ++i) { const int tt = 2 * (wave & 1) + i, tl = tt * 16 + fr, t = t0 + tl;
        const bf16x8 ra0 = *(const bf16x8*)(RH + (size_t)tl * 64 + fq * 8), ra1 = *(const bf16x8*)(RH + (size_t)tl * 64 + 32 + fq * 8);
        f32x4 ov[4]; float sm = 0.f;
#pragma unroll
        for (int vt = 0; vt < 4; ++vt) { f32x4 acc = ldb4(O0 + tl * 64 + vt * 16 + 4 * fq);
            acc = __builtin_amdgcn_mfma_f32_16x16x32_bf16(pfr[vt][0], ra0, acc, 0, 0, 0); acc = __builtin_amdgcn_mfma_f32_16x16x32_bf16(pfr[vt][1], ra1, acc, 0, 0, 0);
            ov[vt] = acc; DBG_STAT(24, acc[0]); DBG_STAT(24, acc[1]); DBG_STAT(24, acc[2]); DBG_STAT(24, acc[3]); sm += (acc.x + acc.y) + (acc.z + acc.w); }
        sm += __shfl_xor(sm, 16); sm += __shfl_xor(sm, 32);
        const float mean = sm * (1.f / 64.f); float sq = 0.f;
#pragma unroll
        for (int vt = 0; vt < 4; ++vt) { ov[vt] = ov[vt] - mean; sq += (ov[vt].x * ov[vt].x + ov[vt].y * ov[vt].y) + (ov[vt].z * ov[vt].z + ov[vt].w * ov[vt].w); }
        sq += __shfl_xor(sq, 16); sq += __shfl_xor(sq, 32);
        const float rs = __builtin_amdgcn_rsqf(sq * (1.f / 64.f) + RWKV_GN_EPS);
        float bd = 0.f;
#pragma unroll
        for (int q = 0; q < 4; ++q) { const f32x4 r4 = ldb4(RW + (size_t)t * 768 + hh * 64 + fq * 16 + 4 * q), k4 = ldb4(RW + (size_t)t * 768 + 256 + hh * 64 + fq * 16 + 4 * q), c4 = *(const f32x4*)(rk + fq * 16 + 4 * q);
            bd += (r4.x * k4.x * c4.x + r4.y * k4.y * c4.y) + (r4.z * k4.z * c4.z + r4.w * k4.w * c4.w); }
        bd += __shfl_xor(bd, 16); bd += __shfl_xor(bd, 32);
#pragma unroll
        for (int vt = 0; vt < 4; ++vt) { const int col = vt * 16 + 4 * fq; const f32x4 g4 = *(const f32x4*)(lg + col), b4 = *(const f32x4*)(lb + col);
            const f32x4 v4 = ldb4(RW + (size_t)t * 768 + 512 + hh * 64 + col), gg = ldb4(RG + (size_t)t * 256 + hh * 64 + col);
            float e0 = (ov[vt].x * rs * g4.x + b4.x + bd * v4.x) * gg.x, e1 = (ov[vt].y * rs * g4.y + b4.y + bd * v4.y) * gg.y, e2 = (ov[vt].z * rs * g4.z + b4.z + bd * v4.z) * gg.z, e3 = (ov[vt].w * rs * g4.w + b4.w + bd * v4.w) * gg.w;
#ifdef RW_SANITIZE
            e0 = (fabsf(e0) < 1e30f) ? e0 : 0.f; e1 = (fabsf(e1) < 1e30f) ? e1 : 0.f; e2 = (fabsf(e2) < 1e30f) ? e2 : 0.f; e3 = (fabsf(e3) < 1e30f) ? e3 : 0.f;
#endif
            v2u o; o.x = cvt_pk_bf16(e0, e1); o.y = cvt_pk_bf16(e2, e3);
            *(v2u*)(mix + (size_t)t * D + 256 + hh * 64 + col) = o; } }
}

__device__ __forceinline__ void scans_elementwise(Frame& F, const Args& A) {
    const int nthr = F.G * 448, gt = F.vcu * 448 + (F.tid - 64);
    constexpr int N_SSD = 16 * 64 * 128 / 2, N_GLA = 16 * 32 * 64 / 2, N_MLC = 16 * 64 * 64 / 2, N_MLN = 16 * 64 / 2;
    for (int i = gt; i < N_SSD + N_GLA + N_MLC + N_MLN; i += nthr) {
        if (i < N_SSD) { const int bh = i >> 12, pn = (i & 4095) * 2; unsigned* base = (unsigned*)(WSP(bf16, WS_SSD_ST) + (size_t)bh * NCH * 8192 + pn); const float* dec = WSP(float, WS_SSD_DEC) + bh * NCH; float S0 = 0.f, S1 = 0.f;
#pragma unroll 1
            for (int c0 = 0; c0 < NCH; c0 += 32) { unsigned x[32]; float dd[32];
#pragma unroll
                for (int j = 0; j < 32; ++j) { x[j] = base[(size_t)(c0 + j) * 4096]; dd[j] = dec[c0 + j]; }
#pragma unroll
                for (int j = 0; j < 32; ++j) { base[(size_t)(c0 + j) * 4096] = cvt_pk_bf16(S0, S1); S0 = dd[j] * S0 + __uint_as_float(x[j] << 16); S1 = dd[j] * S1 + __uint_as_float(x[j] & 0xffff0000u); } }
        } else if (i < N_SSD + N_GLA) { const int k = i - N_SSD, bh = k >> 10, dv = (k & 1023) * 2, dd_ = dv >> 6, b = bh >> 2, hh = bh & 3; unsigned* base = (unsigned*)(WSP(bf16, WS_GLA_ST) + (size_t)bh * NCH * 2048 + dv); const float* dec = WSP(float, WS_GLA_DEC) + (size_t)b * NCH * 128 + hh * 32 + dd_; float S0 = 0.f, S1 = 0.f;
#pragma unroll 1
            for (int c0 = 0; c0 < NCH; c0 += 32) { unsigned x[32]; float dd[32];
#pragma unroll
                for (int j = 0; j < 32; ++j) { x[j] = base[(size_t)(c0 + j) * 1024]; dd[j] = dec[(c0 + j) * 128]; }
#pragma unroll
                for (int j = 0; j < 32; ++j) { base[(size_t)(c0 + j) * 1024] = cvt_pk_bf16(S0, S1); S0 = dd[j] * S0 + __uint_as_float(x[j] << 16); S1 = dd[j] * S1 + __uint_as_float(x[j] & 0xffff0000u); } }
        } else { const int k = i - N_SSD - N_GLA; const bool isn = k >= N_MLC; const int kk = isn ? k - N_MLC : k; const int bh = isn ? (kk >> 5) : (kk >> 11), e = (isn ? (kk & 31) : (kk & 2047)) * 2, str = isn ? 32 : 2048;
            unsigned* base = (unsigned*)((isn ? WSP(bf16, WS_ML_N) : WSP(bf16, WS_ML_C)) + (size_t)bh * NCH * str * 2 + e); const float* bl = WSP(float, WS_ML_BL) + bh * NCH; const float* ml = WSP(float, WS_ML_ML) + bh * NCH; float* mo = WSP(float, WS_ML_M) + bh * NCH;
            float S0 = 0.f, S1 = 0.f, m = 0.f;
#pragma unroll 1
            for (int c0 = 0; c0 < NCH; c0 += 32) { unsigned x[32]; float b8[32], m8[32];
#pragma unroll
                for (int j = 0; j < 32; ++j) { x[j] = base[(size_t)(c0 + j) * str]; b8[j] = bl[c0 + j]; m8[j] = ml[c0 + j]; }
#pragma unroll
                for (int j = 0; j < 32; ++j) { const float mn = fmaxf(b8[j] + m, m8[j]); const float so = __expf(b8[j] + m - mn), sn = __expf(m8[j] - mn);
                    base[(size_t)(c0 + j) * str] = cvt_pk_bf16(S0, S1); if (!isn && e == 0) mo[c0 + j] = m; S0 = so * S0 + sn * __uint_as_float(x[j] << 16); S1 = so * S1 + sn * __uint_as_float(x[j] & 0xffff0000u); m = mn; } }
        }
    }
}
#ifndef MK_PER_PHASE_LAUNCH
#define MK_PER_PHASE_LAUNCH 0
#endif
#ifndef PH_MASK
#define PH_MASK 0xFFF
#endif
#ifndef ST_MASK
#define ST_MASK 0xF
#endif
#define ST_ON(k) (((ST_MASK) >> (k)) & 1)
#ifndef DUP_MASK
#define DUP_MASK 0
#endif
#define DUP_N(k) ((((DUP_MASK) >> (k)) & 1) ? 2 : 1)
#ifndef ST_DUP
#define ST_DUP 0
#endif
#define ST_REP(ty) ((((ST_DUP) >> (ty)) & 1) ? 2 : 1)
#define PH_ON(k) (((PH_MASK) >> (k)) & 1)
constexpr int PH_PER_LAYER = 11, N_PHASES = 1 + DEPTH * PH_PER_LAYER;
__global__ void __launch_bounds__(NWAVES * 64, 2) fwd_kernel(Args args) {
    extern __shared__ __attribute__((aligned(16))) unsigned char lds[];
    Frame F;
    F.lds = (LAS unsigned char*)lds;
    F.MISC = (volatile LAS unsigned*)(F.lds + MISC_OFF);
    F.tid = threadIdx.x; F.lane = F.tid & 63; F.wave = __builtin_amdgcn_readfirstlane(F.tid >> 6);
    F.G = gridDim.x; { const int bx = blockIdx.x; F.vcu = (F.G % 8 == 0) ? (bx % 8) * (F.G / 8) + bx / 8 : bx; }
    F.ka = (karg_t)__builtin_amdgcn_kernarg_segment_ptr(); F.ws = args.ws; F.ctl = (gu32*)(args.ws + WS_CTL); F.out = args.out;
    for (int i = F.tid; i < 256; i += NWAVES * 64) F.MISC[i] = 0u;
    __syncthreads();
    const int lo = args.ph_lo, hi = args.ph_hi;
#ifdef DBG_TSEL
    if (blockIdx.x == 0 && threadIdx.x == 0) __hip_atomic_store(F.ctl + CW_DBG + 15, (unsigned)__builtin_amdgcn_s_memrealtime(), RLX_AGENT);
#endif
    XcdBarrier bar; bar.bar = (unsigned*)(F.ctl + CW_BAR); bar.x = 0; bar.st = nullptr;
    if (hi - lo > 1) bar = xcd_barrier_post((unsigned*)(F.ctl + CW_BAR), F.MISC + MW_BAR);
#define IN_(k) (lo <= (k) && (k) < hi)
#ifdef DBG_TSEL
#ifndef DBG_TQ
#define DBG_TQ 50.0f
#endif
#define TSTAMP(k) do { if (blockIdx.x == 0 && threadIdx.x == 0) __hip_atomic_store(F.ctl + CW_DBG + 16 + ((k) == 11 ? 0 : 1 + layer_ * PH_PER_LAYER + (k)), (unsigned)__builtin_amdgcn_s_memrealtime(), RLX_AGENT); } while (0)
#else
#define TSTAMP(k) do { } while (0)
#endif
#ifdef BAR_DUP
#define SEAM(k) do { if (IN_(k) && IN_((k) + 1)) { xcd_barrier(bar); xcd_barrier(bar); } } while (0)
#else
#define SEAM(k) do { if (IN_(k) && IN_((k) + 1)) xcd_barrier(bar); } while (0)
#endif

    if (PH_ON(11) && IN_(0)) { for (int rep_ = 0; rep_ < DUP_N(11); ++rep_) { frame_refresh(F); p0_prologue(F, args); } SEAM(0); { const int layer_ = 0; TSTAMP(11); (void)layer_; } }
#pragma unroll 1
    for (int layer = 0; layer < DEPTH; ++layer) {
        const int pb = 1 + layer * PH_PER_LAYER; const int layer_ = layer; (void)layer_;
        if (PH_ON(0) && IN_(pb + 0)) { for (int rep_ = 0; rep_ < DUP_N(0); ++rep_) { frame_refresh(F);
            { pg8::DenseSched S; S.init(WSP(bf16, WS_XB), WSP(bf16, WS_WIN_T) + (size_t)layer * NUP * D, T, NUP, D, F.G, (int)blockIdx.x);
              pg8::EpiB16 E{WSP(bf16, WS_U), NUP, nullptr, 0.f};
              pg8::gemm_phase<pg8::EpiB16, pg8::DenseSched>(F.lds, F.tid, S, E); }
            if (F.G != 256 || blockIdx.x >= 128)
            { pg8::DenseSched S; if (F.G == 256) S.init(WSP(bf16, WS_PB) + (size_t)layer * T * 256, WSP(bf16, WS_WPP_T) + (size_t)layer * D * 256, T, D, 256, 128, (int)blockIdx.x - 128); else S.init(WSP(bf16, WS_PB) + (size_t)layer * T * 256, WSP(bf16, WS_WPP_T) + (size_t)layer * D * 256, T, D, 256, F.G, (int)blockIdx.x);
              pg8::EpiB16 E{WSP(bf16, WS_PE), D, nullptr, 0.f};
              pg8::gemm_phase<pg8::EpiB16, pg8::DenseSched>(F.lds, F.tid, S, E); }
            } SEAM(pb + 0); TSTAMP(0);
        }
        if (PH_ON(1) && IN_(pb + 1)) { for (int rep_ = 0; rep_ < DUP_N(1); ++rep_) { frame_refresh(F);
            for (int un = F.vcu; un < 1024; un += F.G) { frame_refresh(F); const int ty = un >> 8, r = un & 255, b = r >> 6, c = r & 63;
                if (ty == 0) { ssd_stage1(F, args, layer, b, c); if (ST_DUP & 1) ssd_stage1(F, args, layer, b, c); } else if (ty == 1) { gla_stage1(F, args, layer, b, c); if (ST_DUP & 2) gla_stage1(F, args, layer, b, c); } else if (ty == 2) { mlstm_stage1(F, args, layer, b, c); if (ST_DUP & 4) mlstm_stage1(F, args, layer, b, c); } else { rwkv_stage1(F, args, layer, r); if (ST_DUP & 8) rwkv_stage1(F, args, layer, r); } }
            } SEAM(pb + 1); TSTAMP(1);
        }
        if (PH_ON(2) && IN_(pb + 2)) { for (int rep_ = 0; rep_ < DUP_N(2); ++rep_) { frame_refresh(F);
            if (F.wave == 0) { for (int ws_ = F.vcu; ws_ < 64; ws_ += F.G) rwkv_scan_wave(F, args, ws_); }
            else if (rep_ == 0) scans_elementwise(F, args);
            } SEAM(pb + 2); TSTAMP(2);
        }
        if (PH_ON(3) && IN_(pb + 3)) { for (int rep_ = 0; rep_ < DUP_N(3); ++rep_) { frame_refresh(F);
            for (int un = F.vcu; un < 1024; un += F.G) { frame_refresh(F); const int ty = un >> 8, r = un & 255, b = r >> 6, c = r & 63;
                if (ty == 0) { ssd_stage3(F, args, layer, b, c); if (ST_DUP & 16) ssd_stage3(F, args, layer, b, c); } else if (ty == 1) { gla_stage3(F, args, layer, b, c); if (ST_DUP & 32) gla_stage3(F, args, layer, b, c); } else if (ty == 2) { mlstm_stage3(F, args, layer, b, c); if (ST_DUP & 64) mlstm_stage3(F, args, layer, b, c); } else { rwkv_stage3(F, args, layer, r); if (ST_DUP & 128) rwkv_stage3(F, args, layer, r); } }
            } SEAM(pb + 3); TSTAMP(3);
        }
        if (PH_ON(4) && IN_(pb + 4)) { for (int rep_ = 0; rep_ < DUP_N(4); ++rep_) { frame_refresh(F);
            pg8::DenseSched S; S.init(WSP(bf16, WS_MIX), WSP(bf16, WS_WOUT_T) + (size_t)layer * D * D, T, D, D, F.G, (int)blockIdx.x);
            pg8::EpiB16 E{WSP(bf16, WS_Y1), D, WSP(bf16, WS_XB), DN_ALPHA};
            pg8::gemm_phase<pg8::EpiB16, pg8::DenseSched>(F.lds, F.tid, S, E);
            } SEAM(pb + 4); TSTAMP(4);
        }
        if (PH_ON(5) && IN_(pb + 5)) { if (DUP_N(5) == 2) { frame_refresh(F); p6_ln1_router<true>(F, args, layer); } frame_refresh(F); p6_ln1_router<false>(F, args, layer); SEAM(pb + 5); TSTAMP(5); }
        if (PH_ON(6) && IN_(pb + 6)) { for (int rep_ = 0; rep_ < DUP_N(6); ++rep_) { frame_refresh(F);
            moe_build_pfx(F, args, layer, 8);
            pg8::Moe1Sched S; S.O.pfx = F.MISC + MW_PFX; S.O.NT = 8; S.O.G = F.G; S.O.c = (int)blockIdx.x; S.sdest = WSP(int, WS_SDEST); S.bgu = KIN(I_BGU) + (size_t)layer * NE * 2048;
            if (MOE_FP8) { S.X = WSP(unsigned char, WS_X1Q); S.W = WSP(unsigned char, WS_WGU_Q) + (size_t)layer * NE * 2048 * D; S.K = D / 2; S.hstepB = (size_t)1024 * D; }
            else { S.X = WSP(unsigned char, WS_X1B); S.W = WSP(unsigned char, WS_WGU_T) + (size_t)layer * NE * 2048 * D * 2; S.K = D; S.hstepB = (size_t)1024 * D * 2; }
            pg8::EpiMoe1 E{WSP(bf16, WS_ABUF), KIN(I_BGU) + (size_t)layer * NE * 2048, WSP(unsigned char, WS_ABUFQ)};
            pg8::gemm_phase<pg8::EpiMoe1, pg8::Moe1Sched>(F.lds, F.tid, S, E);
            } SEAM(pb + 6); TSTAMP(6);
        }
        if (PH_ON(7) && IN_(pb + 7)) { for (int rep_ = 0; rep_ < DUP_N(7); ++rep_) { frame_refresh(F);
            moe_build_pfx(F, args, layer, 4);
            pg8::Moe2Sched S; S.O.pfx = F.MISC + MW_PFX; S.O.NT = 4; S.O.G = F.G; S.O.c = (int)blockIdx.x; S.sdest = WSP(int, WS_SDEST); S.sgate = WSP(float, WS_SGATE); S.bdn = KIN(I_BDN) + (size_t)layer * NE * D; if (MOE2_FP8) { S.Ab = WSP(unsigned char, WS_ABUFQ); S.W = WSP(unsigned char, WS_WDN_Q) + (size_t)layer * NE * D * D; S.K = D / 2; S.hstepB = (size_t)128 * D; }
            else { S.Ab = WSP(unsigned char, WS_ABUF); S.W = WSP(unsigned char, WS_WDN_T) + (size_t)layer * NE * D * D * 2; S.K = D; S.hstepB = (size_t)128 * D * 2; }
            pg8::EpiMoe2 E{WSP(bf16, WS_YBUF), KIN(I_BDN) + (size_t)layer * NE * D, WSP(int, WS_SDEST), WSP(float, WS_SGATE)};
            pg8::gemm_phase<pg8::EpiMoe2, pg8::Moe2Sched>(F.lds, F.tid, S, E);
            } SEAM(pb + 7); TSTAMP(7);
        }
        if (PH_ON(8) && IN_(pb + 8)) { for (int rep_ = 0; rep_ < DUP_N(8); ++rep_) { frame_refresh(F); p9_combine(F, args); } SEAM(pb + 8); TSTAMP(8); }
        if (PH_ON(9) && IN_(pb + 9)) { for (int rep_ = 0; rep_ < DUP_N(9); ++rep_) { frame_refresh(F);
            pg8::DenseSched S; S.init(WSP(bf16, WS_HB), WSP(bf16, WS_WPG_T) + (size_t)layer * D * D, T, D, D, F.G, (int)blockIdx.x);
            pg8::EpiPle E{WSP(bf16, WS_H2), WSP(bf16, WS_HB), WSP(bf16, WS_PE)};
            pg8::gemm_phase<pg8::EpiPle, pg8::DenseSched>(F.lds, F.tid, S, E);
            } SEAM(pb + 9); TSTAMP(9);
        }
        if (PH_ON(10) && IN_(pb + 10)) { for (int rep_ = 0; rep_ < DUP_N(10); ++rep_) { frame_refresh(F); p11_ln2(F, args, layer); } SEAM(pb + 10); TSTAMP(10); }
    }
#ifdef DBG_TSEL
    if (hi - lo > 1) { xcd_barrier(bar);
        unsigned ticks = 0u;
        if (DBG_TSEL == 11) ticks = __hip_atomic_load(F.ctl + CW_DBG + 16, RLX_AGENT) - __hip_atomic_load(F.ctl + CW_DBG + 15, RLX_AGENT);
        else for (int l = 0; l < DEPTH; ++l) { const int pi = 1 + l * PH_PER_LAYER + DBG_TSEL; ticks += __hip_atomic_load(F.ctl + CW_DBG + 16 + pi, RLX_AGENT) - __hip_atomic_load(F.ctl + CW_DBG + 16 + pi - 1, RLX_AGENT); }
        const float us = floorf((float)ticks * 0.01f / DBG_TQ) * DBG_TQ; const float code = sqrtf(us * 0.05f);
        for (size_t i = (size_t)blockIdx.x * 512 + threadIdx.x; i < (size_t)T * D; i += (size_t)gridDim.x * 512) F.out[i] = code; }
#endif
#ifdef DBG_SEL
    if (hi - lo > 1) { xcd_barrier(bar);
        const unsigned mx = __hip_atomic_load(F.ctl + CW_DBG, RLX_AGENT), nf = __hip_atomic_load(F.ctl + CW_DBG + 1, RLX_AGENT);
        float code;
        { const float m = __uint_as_float(mx); int b = (m > 0.f) ? (int)floorf(log10f(m)) + 30 : 0; b = b < 0 ? 0 : (b > 60 ? 60 : b); if (nf) b += 100; code = sqrtf(10.0f * (float)(b + 1)); }
        for (size_t i = (size_t)blockIdx.x * 512 + threadIdx.x; i < (size_t)T * D; i += (size_t)gridDim.x * 512) F.out[i] = code; }
#endif
#undef IN_
#undef SEAM
}

extern "C" void kernel_launch(void* const* d_in, const int* in_sizes, int n_in, void* d_out, int out_size, void* d_ws, size_t ws_size, hipStream_t stream) {
    static int grid = 0;
    if (grid == 0) {
        if (n_in != N_IN || out_size != T * D || ws_size < WS_END) { fprintf(stderr, "kernel_launch: unexpected shapes (n_in %d, out %d, ws %zu < %zu); nothing launched\n", n_in, out_size, ws_size, (size_t)WS_END); grid = -1; return; }
        int dev = 0, cus = 0, per_cu = 0;
        if (hipGetDevice(&dev) != hipSuccess || hipDeviceGetAttribute(&cus, hipDeviceAttributeMultiprocessorCount, dev) != hipSuccess) { grid = -1; return; }
        if (hipFuncSetAttribute((const void*)fwd_kernel, hipFuncAttributeMaxDynamicSharedMemorySize, LDS_BYTES) != hipSuccess) { fprintf(stderr, "kernel_launch: hipFuncSetAttribute failed\n"); grid = -1; return; }
        if (hipOccupancyMaxActiveBlocksPerMultiprocessor(&per_cu, (const void*)fwd_kernel, NWAVES * 64, LDS_BYTES) != hipSuccess || per_cu < 1) { fprintf(stderr, "kernel_launch: occupancy query says %d blocks per CU\n", per_cu); }
        (void)hipGetLastError();
        grid = cus;
    }
    if (grid < 0) return;
    (void)hipMemsetAsync((char*)d_ws + WS_CTL, 0, CTL_ZERO_BYTES, stream);
    Args a{};
    for (int i = 0; i < N_IN; ++i) a.in[i] = (const float*)d_in[i];
    a.out = (float*)d_out; a.ws = (unsigned char*)d_ws;
#if MK_PER_PHASE_LAUNCH
    for (int ph = 0; ph < N_PHASES; ++ph) { a.ph_lo = ph; a.ph_hi = ph + 1; hipLaunchKernelGGL(fwd_kernel, dim3(grid), dim3(NWAVES * 64), LDS_BYTES, stream, a); }
#else
    a.ph_lo = 0; a.ph_hi = N_PHASES; hipLaunchKernelGGL(fwd_kernel, dim3(grid), dim3(NWAVES * 64), LDS_BYTES, stream, a);
#endif
    const hipError_t le = hipPeekAtLastError();
    if (le != hipSuccess) fprintf(stderr, "kernel_launch: launch failed: %s\n", hipGetErrorName(le));
}
```

```cpp
#include <hip/hip_runtime.h>
#include <cstdio>
#include <cstdint>

#define GAS __attribute__((address_space(1)))
#define LAS __attribute__((address_space(3)))
typedef unsigned short bf16;
typedef unsigned v4u __attribute__((ext_vector_type(4)));
typedef unsigned v2u __attribute__((ext_vector_type(2)));
typedef float f32x4 __attribute__((ext_vector_type(4)));
typedef float f32x2 __attribute__((ext_vector_type(2)));
typedef short bf16x8 __attribute__((ext_vector_type(8)));
typedef int v4i_t __attribute__((ext_vector_type(4)));
typedef int v8i_t __attribute__((ext_vector_type(8)));
typedef GAS unsigned gu32;
#define RLX_AGENT __ATOMIC_RELAXED, __HIP_MEMORY_SCOPE_AGENT
#define LDS_WAIT() asm volatile("s_waitcnt lgkmcnt(0)" ::: "memory")
#define VM_WAIT() asm volatile("s_waitcnt vmcnt(0)" ::: "memory")

constexpr int NWAVES = 8;
constexpr int DEPTH = 4, BATCH = 4, SEQ = 4096, D = 1024, T = BATCH * SEQ;
constexpr int NU = 3484, NUP = 3584;
constexpr int NE = 32, TOPK = 4, ECAP = 16384;
constexpr int NCH = SEQ / 64;
constexpr int U_SSD_Z = 0, U_SSD_X = 256, U_SSD_B = 512, U_SSD_C = 640, U_SSD_DT = 768;
constexpr int U_RW = 772, U_RW_R = 772, U_RW_K = 1028, U_RW_V = 1284, U_RW_LO = 1540;
constexpr int U_GL_Q = 1668, U_GL_K = 1796, U_GL_V = 1924, U_GL_G = 2180, U_GL_OG = 2196;
constexpr int U_ML_Q = 2452, U_ML_K = 2708, U_ML_V = 2964, U_ML_I = 3220, U_ML_F = 3224, U_ML_O = 3228;
constexpr float DN_ALPHA = 1.6817928305074290f;
constexpr float LN_EPS = 1e-5f, NORM_EPS = 1e-5f, RWKV_GN_EPS = 64e-5f;

enum { I_X = 0, I_P, I_WIN, I_WOUT, I_LN1G, I_LN1B, I_SCW, I_SCB, I_SALOG, I_SDTB, I_SD, I_SNG,
       I_RMU, I_RW0, I_RWUP, I_RA0, I_RAUP, I_RGUP, I_RKK, I_RKA, I_RRK, I_RLNG, I_RLNB,
       I_GGUP, I_GGB, I_GNG, I_MCW, I_MCB, I_MIB, I_MFB, I_MNG,
       I_RTW, I_RTB, I_WGU, I_BGU, I_WDN, I_BDN, I_PGW, I_PPJ, I_LN2G, I_LN2B, N_IN };

constexpr size_t MiB = 1u << 20;
constexpr size_t WS_CTL = 0, CTL_ZERO_BYTES = 1 * MiB;
constexpr size_t WS_WIN_T = 2 * MiB;
constexpr size_t WS_WOUT_T = WS_WIN_T + (size_t)DEPTH * NUP * D * 2;
constexpr size_t WS_WGU_T = WS_WOUT_T + (size_t)DEPTH * D * D * 2;
constexpr size_t WS_WDN_T = WS_WGU_T + (size_t)DEPTH * NE * 2048 * D * 2;
constexpr size_t WS_WPG_T = WS_WDN_T + (size_t)DEPTH * NE * D * D * 2;
constexpr size_t WS_WPP_T = WS_WPG_T + (size_t)DEPTH * D * D * 2;
constexpr size_t WS_RWT = WS_WPP_T + (size_t)DEPTH * D * 256 * 2;
constexpr size_t WS_PB = WS_RWT + (size_t)DEPTH * NE * D * 4;
constexpr size_t WS_XB = WS_PB + (size_t)DEPTH * T * 256 * 2;
constexpr size_t WS_U = WS_XB + (size_t)T * D * 2;
constexpr size_t WS_PE = WS_U + (size_t)T * NUP * 2;
constexpr size_t WS_MIX = WS_PE + (size_t)T * D * 4;
constexpr size_t WS_Y1 = WS_MIX + (size_t)T * D * 2;
constexpr size_t WS_X1 = WS_Y1 + (size_t)T * D * 4;
constexpr size_t WS_X1B = WS_X1 + (size_t)T * D * 4;
constexpr size_t WS_SDEST = WS_X1B + (size_t)T * D * 2;
constexpr size_t WS_SGATE = WS_SDEST + (size_t)NE * ECAP * 4;
constexpr size_t WS_ABUF = WS_SGATE + (size_t)NE * ECAP * 4;
constexpr size_t WS_YBUF = WS_ABUF + (size_t)NE * ECAP * D * 2;
constexpr size_t WS_H = WS_YBUF + (size_t)T * 4 * D * 2;
constexpr size_t WS_HB = WS_H + (size_t)T * D * 4;
constexpr size_t WS_H2 = WS_HB + (size_t)T * D * 2;
constexpr size_t WS_SSD_ST = WS_H2 + (size_t)T * D * 4;
constexpr size_t WS_SSD_DEC = WS_SSD_ST + (size_t)16 * NCH * 64 * 128 * 4;
constexpr size_t WS_GLA_ST = WS_SSD_DEC + 16 * NCH * 4;
constexpr size_t WS_GLA_DEC = WS_GLA_ST + (size_t)16 * NCH * 32 * 64 * 4;
constexpr size_t WS_ML_C = WS_GLA_DEC + (size_t)4 * NCH * 128 * 4;
constexpr size_t WS_ML_N = WS_ML_C + (size_t)16 * NCH * 64 * 64 * 4;
constexpr size_t WS_ML_BL = WS_ML_N + (size_t)16 * NCH * 64 * 4;
constexpr size_t WS_ML_ML = WS_ML_BL + 16 * NCH * 4;
constexpr size_t WS_ML_M = WS_ML_ML + 16 * NCH * 4;
constexpr size_t WS_RW = WS_ML_M + 16 * NCH * 4;
constexpr size_t WS_RW_G = WS_RW + (size_t)T * 3 * 256 * 4;
constexpr size_t WS_RW_RH = WS_RW_G + (size_t)T * 256 * 4;
constexpr size_t WS_RW_O0 = WS_RW_RH + (size_t)1024 * 4096 * 2;
constexpr size_t WS_RW_GF = WS_RW_O0 + (size_t)1024 * 4096 * 4;
constexpr size_t WS_RW_HT = WS_RW_GF + (size_t)1024 * 4096 * 2;
constexpr size_t WS_RW_PT = WS_RW_HT + (size_t)1024 * 4096 * 4;
constexpr size_t WS_LORA = WS_RW_PT + (size_t)1024 * 4096 * 2;
constexpr int LORA_PER_LAYER = 8192 + 8192 + 16384 + 2048;
constexpr size_t WS_WGU_Q = WS_LORA + (size_t)DEPTH * LORA_PER_LAYER * 4;
constexpr size_t WS_WDN_Q = WS_WGU_Q + (size_t)DEPTH * NE * 2048 * D;
constexpr size_t WS_X1Q = WS_WDN_Q + (size_t)DEPTH * NE * D * D;
constexpr size_t WS_ABUFQ = WS_X1Q + (size_t)T * D;
constexpr size_t WS_WPG_Q = WS_ABUFQ + (size_t)NE * ECAP * D;
constexpr size_t WS_HQ = WS_WPG_Q + (size_t)DEPTH * D * D;
constexpr size_t WS_WOUT_Q = WS_HQ + (size_t)T * D;
constexpr size_t WS_END = WS_WOUT_Q + (size_t)DEPTH * D * D;
#ifndef MOE_FP8
#define MOE_FP8 1
#endif
#ifndef MOE2_FP8
#define MOE2_FP8 1
#ifndef OUT_FP8
#define OUT_FP8 1
#endif
#ifndef PLE_FP8
#define PLE_FP8 1
#endif
#endif
constexpr int CW_BAR = 4096;
constexpr int CW_DBG = 32768;
constexpr int CW_CNT = 16384;

constexpr int RING_BYTES = 147456;
constexpr int MISC_OFF = RING_BYTES;
constexpr int LDS_BYTES = RING_BYTES + 1024;
constexpr int MW_BAR = 8, MW_LCNT = 32, MW_LBASE = 64, MW_PFX = 96, MW_CNT = 136, MW_GAMC = 168;

typedef __bf16 bf16x2_t __attribute__((ext_vector_type(2)));
__device__ __forceinline__ unsigned cvt_pk_bf16(float lo, float hi) { const f32x2 v = {lo, hi}; const bf16x2_t b = __builtin_convertvector(v, bf16x2_t); return __builtin_bit_cast(unsigned, b); }
__device__ __forceinline__ unsigned cvt4_fp8(float a, float b, float c, float d) { int w = 0; w = __builtin_amdgcn_cvt_pk_fp8_f32(a, b, w, false); w = __builtin_amdgcn_cvt_pk_fp8_f32(c, d, w, true); return (unsigned)w; }
__device__ __forceinline__ float bf2f(unsigned short b) { return __uint_as_float(((unsigned)b) << 16); }
__device__ __forceinline__ float sigmoidf_(float x) { return __builtin_amdgcn_rcpf(1.0f + __expf(-x)); }
__device__ __forceinline__ float siluf_(float x) { return x * __builtin_amdgcn_rcpf(1.0f + __expf(-x)); }
__device__ __forceinline__ float softplusf_(float x) { return fmaxf(x, 0.f) + __logf(1.0f + __expf(-fabsf(x))); }
__device__ __forceinline__ float logsigmoidf_(float x) { return fminf(x, 0.f) - __logf(1.0f + __expf(-fabsf(x))); }
__device__ __forceinline__ float tanhf_(float x) { const float e = __expf(-2.0f * fabsf(x)); const float t = (1.0f - e) * __builtin_amdgcn_rcpf(1.0f + e); return x < 0.f ? -t : t; }
__device__ __forceinline__ int lane_now() { int l = (int)__builtin_amdgcn_mbcnt_hi(~0u, __builtin_amdgcn_mbcnt_lo(~0u, 0u)); asm volatile("" : "+v"(l)); return l; }
__device__ __forceinline__ float my_shfl_idx(float v, int src) { return __builtin_bit_cast(float, __builtin_amdgcn_ds_bpermute(src << 2, __builtin_bit_cast(int, v))); }
__device__ __forceinline__ int my_shfl_idx(int v, int src) { return __builtin_amdgcn_ds_bpermute(src << 2, v); }
template <class V> __device__ __forceinline__ V my_shfl_xor(V v, int o) { return my_shfl_idx(v, lane_now() ^ o); }
template <class V> __device__ __forceinline__ V my_shfl_up(V v, int o) { const int l = lane_now(); return my_shfl_idx(v, l >= o ? l - o : l); }
#define __shfl_xor(v, o) my_shfl_xor(v, o)
#define __shfl_up(v, o) my_shfl_up(v, o)
#define __shfl(v, s) my_shfl_idx(v, s)
__device__ __forceinline__ float wave_sum(float v) {
#pragma unroll
    for (int o = 1; o < 64; o <<= 1) v += __shfl_xor(v, o);
    return v;
}
__device__ __forceinline__ float wave_max(float v) {
#pragma unroll
    for (int o = 1; o < 64; o <<= 1) v = fmaxf(v, __shfl_xor(v, o));
    return v;
}
__device__ __forceinline__ float wave_scan_add(float v, int lane) {
#pragma unroll
    for (int o = 1; o < 64; o <<= 1) { const float t = __shfl_up(v, o); if (lane >= o) v += t; }
    return v;
}
__device__ __forceinline__ float wave_scan_max(float v, int lane) {
#pragma unroll
    for (int o = 1; o < 64; o <<= 1) { const float t = __shfl_up(v, o); if (lane >= o) v = fmaxf(v, t); }
    return v;
}
__device__ __forceinline__ f32x4 mm16(const LAS unsigned char* A, int lda, const LAS unsigned char* B, int ldb, int K, f32x4 acc, int fr, int fq) {
    const LAS unsigned char* ap = A + fr * lda + fq * 16; const LAS unsigned char* bp = B + fr * ldb + fq * 16;
    for (int k = 0; k < K; k += 32) {
        const bf16x8 a = *(const LAS bf16x8*)(ap + k * 2); const bf16x8 b = *(const LAS bf16x8*)(bp + k * 2);
        acc = __builtin_amdgcn_mfma_f32_16x16x32_bf16(b, a, acc, 0, 0, 0);
    }
    return acc;
}
__device__ __forceinline__ f32x4 mm16_gB(const LAS unsigned char* A, int lda, const float* B, int ldb, int K, f32x4 acc, int fr, int fq) {
    const LAS unsigned char* ap = A + fr * lda + fq * 16; const float* bp = B + (size_t)fr * ldb + fq * 8;
    for (int k = 0; k < K; k += 32) {
        const bf16x8 a = *(const LAS bf16x8*)(ap + k * 2);
        const f32x4 b0 = *(const f32x4*)(bp + k), b1 = *(const f32x4*)(bp + k + 4);
        v4u bw; bw.x = cvt_pk_bf16(b0.x, b0.y); bw.y = cvt_pk_bf16(b0.z, b0.w); bw.z = cvt_pk_bf16(b1.x, b1.y); bw.w = cvt_pk_bf16(b1.z, b1.w);
        const bf16x8 b = __builtin_bit_cast(bf16x8, bw);
        acc = __builtin_amdgcn_mfma_f32_16x16x32_bf16(b, a, acc, 0, 0, 0);
    }
    return acc;
}
__device__ __forceinline__ f32x4 mm16_gAB(const bf16* A, int lda, const bf16* B, int ldb, int K, f32x4 acc, int fr, int fq) {
    const bf16* ap = A + (size_t)fr * lda + fq * 8; const bf16* bp = B + (size_t)fr * ldb + fq * 8;
    for (int k = 0; k < K; k += 32) { const bf16x8 a = *(const bf16x8*)(ap + k), b = *(const bf16x8*)(bp + k); acc = __builtin_amdgcn_mfma_f32_16x16x32_bf16(b, a, acc, 0, 0, 0); }
    return acc;
}
__device__ __forceinline__ bf16x8 ldfrag_f32(const float* p) { const f32x4 b0 = *(const f32x4*)p, b1 = *(const f32x4*)(p + 4);
    v4u bw; bw.x = cvt_pk_bf16(b0.x, b0.y); bw.y = cvt_pk_bf16(b0.z, b0.w); bw.z = cvt_pk_bf16(b1.x, b1.y); bw.w = cvt_pk_bf16(b1.z, b1.w); return __builtin_bit_cast(bf16x8, bw); }
template <int NK> __device__ __forceinline__ f32x4 mm16_rB(const LAS unsigned char* A, int lda, const bf16x8 (&b)[NK], f32x4 acc, int fr, int fq) {
    const LAS unsigned char* ap = A + fr * lda + fq * 16;
#pragma unroll
    for (int k = 0; k < NK; ++k) { const bf16x8 a = *(const LAS bf16x8*)(ap + k * 64); acc = __builtin_amdgcn_mfma_f32_16x16x32_bf16(b[k], a, acc, 0, 0, 0); }
    return acc;
}
__device__ __forceinline__ v4u pack8(const float (&v)[8]) { v4u o; o.x = cvt_pk_bf16(v[0], v[1]); o.y = cvt_pk_bf16(v[2], v[3]); o.z = cvt_pk_bf16(v[4], v[5]); o.w = cvt_pk_bf16(v[6], v[7]); return o; }

#define XB_TMO      128
#define XB_XCNT(j)  (256  + 64 * (j))
#define XB_XSUB(j)  (1280 + 64 * (j))
#define XB_XGEN(j)  (2304 + 64 * (j))
#define XB_TOP      3328
#define XB_TOPGEN   3392
#define XCD_BAR_WORDS 3456
#define XB_SPIN_CAP (1u << 18)
__device__ __forceinline__ unsigned xb_ld(unsigned* p)              { return __hip_atomic_load(p, __ATOMIC_RELAXED, __HIP_MEMORY_SCOPE_AGENT); }
__device__ __forceinline__ unsigned xb_add(unsigned* p, unsigned v) { return __hip_atomic_fetch_add(p, v, __ATOMIC_RELAXED, __HIP_MEMORY_SCOPE_AGENT); }
__device__ __forceinline__ unsigned xb_xcc_id() { return (unsigned)__builtin_amdgcn_s_getreg((3 << 11) | 20) & 0xFu; }
#define XB_SPIN(cond, bar) do { unsigned _sp = 0; while (cond) { __builtin_amdgcn_s_sleep(1); \
    if ((++_sp & 255u) == 0u) { if (xb_ld(&(bar)[XB_TMO])) break; if (_sp > XB_SPIN_CAP) { atomicAdd(&(bar)[XB_TMO], 1u); break; } } } } while (0)
struct XcdBarrier { unsigned* bar; unsigned x; volatile LAS unsigned* st; };
__device__ __forceinline__ XcdBarrier xcd_barrier_post(unsigned* bar, volatile LAS unsigned* st) {
    XcdBarrier b; b.bar = bar; b.x = xb_xcc_id(); b.st = st;
    if (threadIdx.x == 0) (void)xb_add(&bar[XB_XCNT(b.x)], 1u);
    return b;
}
__device__ __forceinline__ void xcd_barrier_complete(unsigned* bar, unsigned x, unsigned& nloc, unsigned& nx) {
    const unsigned G = gridDim.x * gridDim.y * gridDim.z;
    unsigned sum, cnt, mine, sp = 0u;
    for (;;) {
        sum = 0u; cnt = 0u; mine = 0u;
#pragma unroll
        for (unsigned j = 0; j < 16; ++j) { const unsigned c = xb_ld(&bar[XB_XCNT(j)]); sum += c; cnt += (c > 0u) ? 1u : 0u; mine = (j == x) ? c : mine; }
        if (sum == G) break;
        __builtin_amdgcn_s_sleep(1);
        if ((++sp & 255u) == 0u) { if (xb_ld(&bar[XB_TMO])) break; if (sp > XB_SPIN_CAP) { atomicAdd(&bar[XB_TMO], 1u); break; } }
    }
    nloc = mine > 0u ? mine : 1u; nx = cnt > 0u ? cnt : 1u;
}
__device__ __forceinline__ void xcd_barrier(const XcdBarrier& b) {
    asm volatile("s_waitcnt vmcnt(0)" ::: "memory");
    __syncthreads();
    if (threadIdx.x == 0) {
        unsigned* bar = b.bar;
        __builtin_amdgcn_s_waitcnt(0);
        unsigned nloc = b.st[0], nx = b.st[1];
        if (nloc == 0u) { xcd_barrier_complete(bar, b.x, nloc, nx); b.st[0] = nloc; b.st[1] = nx; }
        const unsigned old = xb_add(&bar[XB_XSUB(b.x)], 1u);
        const unsigned gen = old / nloc;
        if (old + 1u == (gen + 1u) * nloc) {
            __builtin_amdgcn_fence(__ATOMIC_RELEASE, "agent");
            asm volatile("s_waitcnt vmcnt(0)" ::: "memory");
            const unsigned og = xb_add(&bar[XB_TOP], 1u);
            const unsigned tg = og / nx;
            if (og + 1u == (tg + 1u) * nx) xb_add(&bar[XB_TOPGEN], 1u);
            else XB_SPIN(xb_ld(&bar[XB_TOPGEN]) == tg, bar);
            __builtin_amdgcn_fence(__ATOMIC_ACQUIRE, "agent");
            xb_add(&bar[XB_XGEN(b.x)], 1u);
            asm volatile("s_waitcnt vmcnt(0)" ::: "memory");
        } else {
            XB_SPIN(xb_ld(&bar[XB_XGEN(b.x)]) == gen, bar);
            __builtin_amdgcn_fence(__ATOMIC_ACQUIRE, "agent");
            asm volatile("s_waitcnt vmcnt(0)" ::: "memory");
        }
    }
    __syncthreads();
}

namespace pg8 {
constexpr int BM = 256, BK = 64, HALF = 128, HTB = HALF * BK * 2, STAGE_BYTES = 8 * HTB, NXCD = 8, WGM = 8;
__host__ __device__ __forceinline__ int lds_byte(int r, int c) { const int st = (r >> 4) * 2 + (c >> 5), rr = r & 15, cc = c & 31, ob = rr * 64 + cc * 2; return st * 1024 + (ob ^ (((ob >> 9) & 1) << 5)); }
__host__ __device__ __forceinline__ void stage_rc(int b, int& R, int& C) { const int st = b / 1024, sb = b % 1024, swz = sb ^ (((sb >> 9) & 1) << 5); R = (st >> 1) * 16 + swz / 64; C = (st & 1) * 32 + (swz % 64) / 2; }
__host__ __device__ __forceinline__ int perm32(int rho) { const int n = rho >> 4, i = rho & 15; return 8 * (i >> 2) + 4 * n + (i & 3); }

template <class Epi, class Sched>
__device__ __forceinline__ void gemm_phase(LAS unsigned char* lds, const int tid, const Sched& S, const Epi& E) {
    const int wid = __builtin_amdgcn_readfirstlane(tid >> 6), lane = tid & 63, wr = wid >> 2, wc = wid & 3, fr = lane & 15, fq = lane >> 4;
    const int K = S.K, nt = K / BK;
    unsigned voffB[2];
#pragma unroll
    for (int i = 0; i < 2; ++i) { int R, C; stage_rc(tid * 16 + i * 8192, R, C); const int Rb = Epi::PERM ? ((R & ~31) + perm32(R & 31)) : R; voffB[i] = (unsigned)(Rb * K + C) * 2u; }
    const size_t kstep = (size_t)(BK * 2);
    const size_t hstepB = S.hstepB;
    const unsigned ldsw = (unsigned)wid * 1024u;
    constexpr bool F8 = Sched::FP8;
    const int aoff = F8 ? lds_byte(wr * 64 + fr, fq * 16) : lds_byte(wr * 64 + fr, fq * 8), boff = F8 ? lds_byte(wc * 32 + fr, fq * 16) : lds_byte(wc * 32 + fr, fq * 8);
#define PG8_SA(b, h) (((b) * 2 + (h)) * HTB)
#define PG8_SB(b, h) ((4 + (b) * 2 + (h)) * HTB)
#define PG8_STAGE_B(bufoff, gbase) do { _Pragma("unroll") for (int _i = 0; _i < 2; ++_i) \
        __builtin_amdgcn_global_load_lds((const unsigned*)((const char*)(gbase) + voffB[_i]), (LAS unsigned*)(lds + (bufoff) + ldsw + _i * 8192), 16, 0, 0); } while (0)
#define PG8_STAGE_A(bufoff, gbase, v0, v1) do { \
        __builtin_amdgcn_global_load_lds((const unsigned*)((const char*)(gbase) + (v0)), (LAS unsigned*)(lds + (bufoff) + ldsw), 16, 0, 0); \
        __builtin_amdgcn_global_load_lds((const unsigned*)((const char*)(gbase) + (v1)), (LAS unsigned*)(lds + (bufoff) + ldsw + 8192), 16, 0, 0); } while (0)
#define PG8_FOFF(k) (F8 ? (k) * 16 : (k) * 1024)
#define PG8_LDA(dst, b, h) do { _Pragma("unroll") for (int m = 0; m < 4; ++m) { if constexpr (F8) dst##8[m] = *(const LAS v8i_t*)(lds + PG8_SA(b, h) + aoff + m * 2048); \
        else { _Pragma("unroll") for (int k = 0; k < 2; ++k) dst[m][k] = *(const LAS bf16x8*)(lds + PG8_SA(b, h) + aoff + m * 2048 + k * 1024); } } } while (0)
#define PG8_LDB(dst, b, h) do { _Pragma("unroll") for (int n = 0; n < 2; ++n) { if constexpr (F8) dst##8[n] = *(const LAS v8i_t*)(lds + PG8_SB(b, h) + boff + n * 2048); \
        else { _Pragma("unroll") for (int k = 0; k < 2; ++k) dst[n][k] = *(const LAS bf16x8*)(lds + PG8_SB(b, h) + boff + n * 2048 + k * 1024); } } } while (0)
#define PG8_CAT(x) __builtin_shufflevector(__builtin_bit_cast(v4i_t, x[0]), __builtin_bit_cast(v4i_t, x[1]), 0, 1, 2, 3, 4, 5, 6, 7)
#define PG8_MMA(ai, bj, At, Bt) do { __builtin_amdgcn_s_setprio(1); _Pragma("unroll") for (int m = 0; m < 4; ++m) _Pragma("unroll") for (int n = 0; n < 2; ++n) { \
        if constexpr (F8) acc[ai][bj][m][n] = __builtin_amdgcn_mfma_scale_f32_16x16x128_f8f6f4(Bt##8[n], At##8[m], acc[ai][bj][m][n], 0, 0, 0, S.scaleB, 0, S.scaleA); \
        else { _Pragma("unroll") for (int k = 0; k < 2; ++k) acc[ai][bj][m][n] = __builtin_amdgcn_mfma_f32_16x16x32_bf16(Bt[n][k], At[m][k], acc[ai][bj][m][n], 0, 0, 0); } } __builtin_amdgcn_s_setprio(0); } while (0)
#define PG8_WAIT_V(n) asm volatile("s_waitcnt vmcnt(" #n ")" ::: "memory")
#define PG8_WAIT_L(n) asm volatile("s_waitcnt lgkmcnt(" #n ")" ::: "memory")
#define PG8_BAR __builtin_amdgcn_s_barrier()
#define PG8_SCHED __builtin_amdgcn_sched_barrier(0)
    typename Sched::Unit cur, nxt; int ui = 0;
    if (!S.next(0, cur)) return;
    f32x4 acc[2][2][4][2];
#pragma unroll
    for (int a = 0; a < 2; ++a)
#pragma unroll
        for (int b = 0; b < 2; ++b)
#pragma unroll
            for (int m = 0; m < 4; ++m)
#pragma unroll
                for (int n = 0; n < 2; ++n) acc[a][b][m][n] = (f32x4){0.f, 0.f, 0.f, 0.f};
    bf16x8 At[4][2], B0[2][2], B1[2][2]; v8i_t At8[4], B08[2], B18[2];
    constexpr bool GA = Sched::GATHER;
    const size_t hstepA = GA ? (size_t)0 : (size_t)HALF * K * 2;
    unsigned vA[2][2];
    LAS unsigned char* hdr = lds + STAGE_BYTES;
    if constexpr (Sched::HDR) { if (wid == 0) S.hdr_issue(cur, hdr, lane); PG8_WAIT_V(0); PG8_BAR; }
    S.a_off(cur, tid, vA, hdr);
#define PG8_STAGE_AH(bufoff, base, vv, h) PG8_STAGE_A(bufoff, ((base) + (h) * hstepA), vv[GA ? (h) : 0][0], vv[GA ? (h) : 0][1])
    const char* cA = S.a_base(cur); const char* cB = S.b_base(cur);
    PG8_STAGE_B(PG8_SB(0, 0), cB); PG8_STAGE_B(PG8_SB(0, 1), cB + hstepB); PG8_STAGE_AH(PG8_SA(0, 0), cA, vA, 0); PG8_STAGE_AH(PG8_SA(0, 1), cA, vA, 1);
    if (wr == 1) PG8_BAR;
    PG8_WAIT_V(2); PG8_BAR;
    PG8_STAGE_B(PG8_SB(1, 0), cB + kstep); PG8_STAGE_AH(PG8_SA(1, 0), cA + kstep, vA, 0); PG8_STAGE_B(PG8_SB(1, 1), cB + hstepB + kstep);
    PG8_WAIT_V(6); PG8_BAR;
    int hc = 0;
    for (;;) {
        const bool has_next = S.next(ui + 1, nxt); const int hn = (hc == 2) ? 0 : hc + 1;
        const char* nA = cA; const char* nB = cB;
        if (has_next) { nA = S.a_base(nxt); nB = S.b_base(nxt); if constexpr (Sched::HDR) { if (wid == 0) S.hdr_issue(nxt, hdr + hn * 4096, lane); } }
        for (int t = 0; t < nt; t += 2) {
            const bool last = (t == nt - 2);
            const char* a1 = cA + (size_t)(t + 1) * kstep;
            const char* a2 = last ? nA : cA + (size_t)(t + 2) * kstep; const char* b2 = last ? nB : cB + (size_t)(t + 2) * kstep;
            const char* a3 = a2 + kstep; const char* b3 = b2 + kstep;
            PG8_LDB(B0, 0, 0); PG8_LDB(B1, 0, 1); PG8_SCHED; PG8_LDA(At, 0, 0); PG8_STAGE_AH(PG8_SA(1, 1), a1, vA, 1);
            if constexpr (GA) { if (last && has_next) S.a_off(nxt, tid, vA, hdr + hn * 4096); }
            PG8_WAIT_V(8); PG8_WAIT_L(0); PG8_BAR; PG8_MMA(0, 0, At, B0); PG8_MMA(0, 1, At, B1); PG8_BAR; PG8_SCHED;
            PG8_LDA(At, 0, 1); PG8_STAGE_B(PG8_SB(0, 0), b2); PG8_STAGE_B(PG8_SB(0, 1), b2 + hstepB); PG8_STAGE_AH(PG8_SA(0, 0), a2, vA, 0);
            PG8_WAIT_V(8); PG8_WAIT_L(0); PG8_BAR; PG8_MMA(1, 0, At, B0); PG8_MMA(1, 1, At, B1); PG8_BAR; PG8_SCHED;
            PG8_LDB(B0, 1, 0); PG8_LDB(B1, 1, 1); PG8_SCHED; PG8_LDA(At, 1, 0); PG8_STAGE_AH(PG8_SA(0, 1), a2, vA, 1);
            PG8_WAIT_V(8); PG8_WAIT_L(0); PG8_BAR; PG8_MMA(0, 0, At, B0); PG8_MMA(0, 1, At, B1); PG8_BAR; PG8_SCHED;
            PG8_LDA(At, 1, 1); PG8_STAGE_B(PG8_SB(1, 0), b3); PG8_STAGE_B(PG8_SB(1, 1), b3 + hstepB); PG8_STAGE_AH(PG8_SA(1, 0), a3, vA, 0);
            PG8_WAIT_V(8); PG8_WAIT_L(0); PG8_BAR; PG8_MMA(1, 0, At, B0); PG8_MMA(1, 1, At, B1); PG8_BAR; PG8_SCHED;
        }
        if (wr == 0) PG8_BAR;
        { int fr_ = fr, fq_ = fq; asm volatile("" : "+v"(fr_), "+v"(fq_)); E(acc, cur, wr, wc, fr_, fq_, hdr + hc * 4096); }
        if (!has_next) break;
#pragma unroll
        for (int a = 0; a < 2; ++a)
#pragma unroll
            for (int b = 0; b < 2; ++b)
#pragma unroll
                for (int m = 0; m < 4; ++m)
#pragma unroll
                    for (int n = 0; n < 2; ++n) acc[a][b][m][n] = (f32x4){0.f, 0.f, 0.f, 0.f};
        cur = nxt; cA = nA; cB = nB; ++ui; hc = hn;
        if (wr == 1) PG8_BAR;
    }
    PG8_WAIT_V(0);
    PG8_BAR;
#undef PG8_SA
#undef PG8_SB
#undef PG8_STAGE_A
#undef PG8_STAGE_AH
#undef PG8_STAGE_B
#undef PG8_LDA
#undef PG8_LDB
#undef PG8_MMA
#undef PG8_CAT
#undef PG8_FOFF
#undef PG8_WAIT_V
#undef PG8_WAIT_L
#undef PG8_BAR
#undef PG8_SCHED
}
}
struct Args { const float* in[N_IN]; float* out; unsigned char* ws; int ph_lo, ph_hi; };
typedef const __attribute__((address_space(4))) unsigned long long* karg_t;
struct Frame {
    karg_t ka;
    LAS unsigned char* lds;
    volatile LAS unsigned* MISC;
    gu32* ctl;
    unsigned char* ws;
    float* out;
    int tid, lane, wave, vcu, G;
};
#define WSP(T_, off) ((T_*)(F.ws + (off)))
#define KIN(k) ((const float*)F.ka[(k)])
#ifdef DBG_SEL
#define DBG_STAT(k, val) do { const float _v = (val); if ((k) == DBG_SEL) { if (fabsf(_v) < 3e38f) atomicMax((unsigned*)(F.ctl + CW_DBG), __float_as_uint(fabsf(_v))); else atomicAdd((unsigned*)(F.ctl + CW_DBG + 1), 1u); } } while (0)
#else
#define DBG_STAT(k, val) do { } while (0)
#endif
template <class P> __device__ __forceinline__ P launder_uniform(P p) {
    unsigned lo = (unsigned)(unsigned long long)p, hi = (unsigned)((unsigned long long)p >> 32);
    asm volatile("" : "+v"(lo), "+v"(hi));
    lo = __builtin_amdgcn_readfirstlane(lo); hi = __builtin_amdgcn_readfirstlane(hi);
    return (P)(((unsigned long long)hi << 32) | lo);
}
__device__ __forceinline__ void frame_refresh(Frame& F) {
    int t = F.tid; asm volatile("" : "+v"(t)); F.tid = t; F.lane = t & 63; F.wave = __builtin_amdgcn_readfirstlane(t >> 6);
    F.ws = launder_uniform(F.ws); F.ctl = (gu32*)(F.ws + WS_CTL);
    F.out = launder_uniform(F.out);
    F.ka = launder_uniform(F.ka);
}

namespace pg8 {
struct DenseSched {
    static constexpr bool GATHER = false, FP8 = false, HDR = false; static constexpr int scaleA = 0, scaleB = 0;
    struct Unit { int pm, pn; };
    __device__ __forceinline__ void hdr_issue(const Unit&, LAS unsigned char*, int) const {}
    const bf16* A; const bf16* Bt; int K; size_t hstepB; int nM, nN, nwg, G, c;
    __device__ __forceinline__ void init(const bf16* A_, const bf16* Bt_, int M, int N, int K_, int G_, int c_) { A = A_; Bt = Bt_; K = K_; hstepB = (size_t)HALF * K_ * 2; nM = M / BM; nN = N / BM; nwg = nM * nN; G = G_; c = c_; }
    __device__ __forceinline__ bool next(int i, Unit& u) const {
        const long L = (long)i * G + c; if (L >= nwg) return false;
        int wgid = (int)L; { const int q = nwg / NXCD, r = nwg % NXCD, xcd = wgid % NXCD, off = wgid / NXCD; wgid = (xcd < r ? xcd * (q + 1) : r * (q + 1) + (xcd - r) * q) + off; }
        const int nig = WGM * nN, gid = wgid / nig, fm = gid * WGM, gsz = (nM - fm) < WGM ? (nM - fm) : WGM;
        u.pm = fm + ((wgid % nig) % gsz); u.pn = (wgid % nig) / gsz; return true;
    }
    __device__ __forceinline__ const char* a_base(const Unit& u) const { return (const char*)A + (size_t)u.pm * BM * K * 2; }
    __device__ __forceinline__ const char* b_base(const Unit& u) const { return (const char*)Bt + (size_t)u.pn * BM * K * 2; }
    __device__ __forceinline__ void a_off(const Unit&, int tid, unsigned (&v)[2][2], const LAS unsigned char*) const {
#pragma unroll
        for (int i = 0; i < 2; ++i) { int R, C; stage_rc(tid * 16 + i * 8192, R, C); v[0][i] = (unsigned)(R * K + C) * 2u; v[1][i] = v[0][i]; }
    }
};
template <int SB> struct DenseSched8T : DenseSched { static constexpr bool GATHER = true, FP8 = true; static constexpr int scaleA = 0x7F7F7F7F, scaleB = SB;
    __device__ __forceinline__ void a_off(const Unit&, int tid, unsigned (&v)[2][2], const LAS unsigned char*) const {
        int t_ = tid; asm volatile("" : "+v"(t_));
#pragma unroll
        for (int i = 0; i < 2; ++i) { int R, C; stage_rc(t_ * 16 + i * 8192, R, C); v[0][i] = (unsigned)(R * K + C) * 2u; v[1][i] = v[0][i] + (unsigned)(HALF * K * 2); }
    }
};
typedef DenseSched8T<0x7A7A7A7A> DenseSched8;
typedef DenseSched8T<0x79797979> DenseSched8b;
struct MoeUnit { int e, mt, nt, cnt; };
struct MoeOrder {
    const volatile LAS unsigned* pfx;
    int NT, G, c;
    __device__ __forceinline__ bool decode(int i, MoeUnit& u) const {
        const int nwg = (int)pfx[32]; const long L = (long)i * G + c; if (L >= nwg) return false;
        int wgid = (int)L; { const int q = nwg / NXCD, r = nwg % NXCD, xcd = wgid % NXCD, off = wgid / NXCD; wgid = (xcd < r ? xcd * (q + 1) : r * (q + 1) + (xcd - r) * q) + off; }
        int e = 0;
#pragma unroll
        for (int st = 16; st >= 1; st >>= 1) e += ((int)pfx[e + st] <= wgid) ? st : 0;
        const int j = wgid - (int)pfx[e];
        u.e = e; u.mt = j / NT; u.nt = j % NT; u.cnt = (int)pfx[40 + e]; return true;
    }
};
#ifndef HDR_AOFF
#define HDR_AOFF 1
#endif
struct Moe1Sched {
    static constexpr bool GATHER = true, FP8 = (MOE_FP8 != 0), HDR = true; static constexpr int EB = FP8 ? 1 : 2; static constexpr int scaleA = 0x7F7F7F7F, scaleB = 0x7A7A7A7A;
    typedef MoeUnit Unit;
    MoeOrder O; const unsigned char* X; const unsigned char* W; const int* sdest; const float* bgu; int K; size_t hstepB;
    __device__ __forceinline__ void hdr_issue(const Unit& u, LAS unsigned char* hdr, int lane) const {
        __builtin_amdgcn_global_load_lds((const unsigned*)(sdest + (size_t)u.e * ECAP + (size_t)u.mt * 256 + lane * 4), (LAS unsigned*)hdr, 16, 0, 0);
        const float* bp = bgu + (size_t)u.e * 2048 + u.nt * 128 + (lane < 32 ? lane * 4 : 1024 + (lane - 32) * 4);
        __builtin_amdgcn_global_load_lds((const unsigned*)bp, (LAS unsigned*)(hdr + 1024), 16, 0, 0);
    }
    __device__ __forceinline__ bool next(int i, Unit& u) const { return O.decode(i, u); }
    __device__ __forceinline__ const char* a_base(const Unit&) const { return (const char*)X; }
    __device__ __forceinline__ const char* b_base(const Unit& u) const { return (const char*)W + ((size_t)u.e * 2048 + (size_t)u.nt * 128) * 1024 * EB; }
    __device__ __forceinline__ void a_off(const Unit& u, int tid, unsigned (&v)[2][2], const LAS unsigned char* hdr) const {
#pragma unroll
        for (int i = 0; i < 2; ++i) { int R, C; stage_rc(tid * 16 + i * 8192, R, C);
#pragma unroll
            for (int h = 0; h < 2; ++h) { const int sl = h * HALF + R; int tok = 0; if (u.mt * 256 + sl < u.cnt) tok = HDR_AOFF ? (((const LAS int*)hdr)[sl] >> 2) : (sdest[u.e * ECAP + u.mt * 256 + sl] >> 2); v[h][i] = (unsigned)(tok * 1024 * EB + C * 2); } }
    }
};
struct Moe2Sched {
    static constexpr bool GATHER = true, FP8 = (MOE2_FP8 != 0), HDR = true; static constexpr int EB = FP8 ? 1 : 2; static constexpr int scaleA = 0x7F7F7F7F, scaleB = 0x79797979;
    typedef MoeUnit Unit;
    MoeOrder O; const unsigned char* Ab; const unsigned char* W; const int* sdest; const float* sgate; const float* bdn; int K; size_t hstepB;
    __device__ __forceinline__ void hdr_issue(const Unit& u, LAS unsigned char* hdr, int lane) const {
        const size_t so = (size_t)u.e * ECAP + (size_t)u.mt * 256 + lane * 4;
        __builtin_amdgcn_global_load_lds((const unsigned*)(sdest + so), (LAS unsigned*)hdr, 16, 0, 0);
        __builtin_amdgcn_global_load_lds((const unsigned*)(sgate + so), (LAS unsigned*)(hdr + 1024), 16, 0, 0);
        __builtin_amdgcn_global_load_lds((const unsigned*)(bdn + (size_t)u.e * 1024 + u.nt * 256 + lane * 4), (LAS unsigned*)(hdr + 2048), 16, 0, 0);
    }
    __device__ __forceinline__ bool next(int i, Unit& u) const { return O.decode(i, u); }
    __device__ __forceinline__ const char* a_base(const Unit& u) const { return (const char*)Ab + ((size_t)u.e * ECAP + (size_t)u.mt * 256) * 1024 * EB; }
    __device__ __forceinline__ const char* b_base(const Unit& u) const { return (const char*)W + ((size_t)u.e * 1024 + (size_t)u.nt * 256) * 1024 * EB; }
    __device__ __forceinline__ void a_off(const Unit&, int tid, unsigned (&v)[2][2], const LAS unsigned char*) const {
        int t_ = tid; asm volatile("" : "+v"(t_));
#pragma unroll
        for (int i = 0; i < 2; ++i) { int R, C; stage_rc(t_ * 16 + i * 8192, R, C); v[0][i] = (unsigned)(R * 1024 * EB + C * 2); v[1][i] = v[0][i] + (unsigned)(HALF * 1024 * EB); }
    }
};

__device__ __forceinline__ void unpack8(const v4u w, f32x4& a, f32x4& b) {
    a = (f32x4){__uint_as_float(w.x << 16), __uint_as_float(w.x & 0xffff0000u), __uint_as_float(w.y << 16), __uint_as_float(w.y & 0xffff0000u)};
    b = (f32x4){__uint_as_float(w.z << 16), __uint_as_float(w.z & 0xffff0000u), __uint_as_float(w.w << 16), __uint_as_float(w.w & 0xffff0000u)}; }
struct EpiF32 {
    static constexpr bool PERM = false;
    float* C; int ldc; const float* base; float alpha;
    __device__ __forceinline__ void operator()(const f32x4 (&acc)[2][2][4][2], const DenseSched::Unit& u, int wr, int wc, int fr, int fq, const LAS unsigned char* hdr) const {
        const int row0 = u.pm * BM + wr * 64 + fr, col0 = u.pn * BM + wc * 32 + 4 * fq;
#pragma unroll
        for (int ai = 0; ai < 2; ++ai)
#pragma unroll
            for (int m = 0; m < 4; ++m) { const size_t ro = (size_t)(row0 + ai * HALF + m * 16) * ldc + col0;
#pragma unroll
                for (int bj = 0; bj < 2; ++bj)
#pragma unroll
                    for (int n = 0; n < 2; ++n) { f32x4 v = acc[ai][bj][m][n];
                        if (base) { const f32x4 b = *(const f32x4*)(base + ro + bj * HALF + n * 16); v = v + b * alpha; }
                        *(f32x4*)(C + ro + bj * HALF + n * 16) = v; } }
    }
};
struct EpiB16 {
    static constexpr bool PERM = true;
    bf16* O; int ldc; const bf16* base; float alpha;
    __device__ __forceinline__ void operator()(const f32x4 (&acc)[2][2][4][2], const DenseSched::Unit& u, int wr, int wc, int fr, int fq, const LAS unsigned char* hdr) const {
        const int row0 = u.pm * BM + wr * 64 + fr, col0 = u.pn * BM + wc * 32 + 8 * fq;
#pragma unroll
        for (int ai = 0; ai < 2; ++ai) {
            v4u bw[4][2];
            if (base) {
#pragma unroll
                for (int m = 0; m < 4; ++m)
#pragma unroll
                    for (int bj = 0; bj < 2; ++bj) bw[m][bj] = *(const v4u*)(base + (size_t)(row0 + ai * HALF + m * 16) * ldc + col0 + bj * HALF); }
#pragma unroll
            for (int m = 0; m < 4; ++m) { bf16* rowp = O + (size_t)(row0 + ai * HALF + m * 16) * ldc + col0;
#pragma unroll
                for (int bj = 0; bj < 2; ++bj) { f32x4 v0 = acc[ai][bj][m][0], v1 = acc[ai][bj][m][1];
                    if (base) { f32x4 b0, b1; unpack8(bw[m][bj], b0, b1); v0 = v0 + b0 * alpha; v1 = v1 + b1 * alpha; }
                    v4u w; w.x = cvt_pk_bf16(v0[0], v0[1]); w.y = cvt_pk_bf16(v0[2], v0[3]); w.z = cvt_pk_bf16(v1[0], v1[1]); w.w = cvt_pk_bf16(v1[2], v1[3]);
                    *(v4u*)(rowp + bj * HALF) = w; } } }
    }
};
struct EpiPle {
    static constexpr bool PERM = true;
    bf16* C; const bf16* hb; const bf16* pe;
    __device__ __forceinline__ void operator()(const f32x4 (&acc)[2][2][4][2], const DenseSched::Unit& u, int wr, int wc, int fr, int fq, const LAS unsigned char* hdr) const {
        const int row0 = u.pm * BM + wr * 64 + fr, col0 = u.pn * BM + wc * 32 + 8 * fq;
#pragma unroll
        for (int ai = 0; ai < 2; ++ai) {
            v4u hw[4][2], pw[4][2];
#pragma unroll
            for (int m = 0; m < 4; ++m)
#pragma unroll
                for (int bj = 0; bj < 2; ++bj) { const size_t ro = (size_t)(row0 + ai * HALF + m * 16) * 1024 + col0 + bj * HALF; hw[m][bj] = *(const v4u*)(hb + ro); pw[m][bj] = *(const v4u*)(pe + ro); }
#pragma unroll
            for (int m = 0; m < 4; ++m)
#pragma unroll
                for (int bj = 0; bj < 2; ++bj) { const size_t ro = (size_t)(row0 + ai * HALF + m * 16) * 1024 + col0 + bj * HALF;
                    f32x4 h0, h1, p0, p1; unpack8(hw[m][bj], h0, h1); unpack8(pw[m][bj], p0, p1); const f32x4 a0 = acc[ai][bj][m][0], a1 = acc[ai][bj][m][1];
                    f32x4 o0, o1;
#pragma unroll
                    for (int j = 0; j < 4; ++j) { o0[j] = h0[j] + sigmoidf_(a0[j]) * p0[j]; o1[j] = h1[j] + sigmoidf_(a1[j]) * p1[j]; }
                    v4u w; w.x = cvt_pk_bf16(o0[0], o0[1]); w.y = cvt_pk_bf16(o0[2], o0[3]); w.z = cvt_pk_bf16(o1[0], o1[1]); w.w = cvt_pk_bf16(o1[2], o1[3]);
                    *(v4u*)(C + ro) = w; } }
    }
};
struct EpiMoe1 {
    static constexpr bool PERM = true;
    bf16* Ab; const float* bgu; unsigned char* AbQ;
    __device__ __forceinline__ void operator()(const f32x4 (&acc)[2][2][4][2], const MoeUnit& u, int wr, int wc, int fr, int fq, const LAS unsigned char* hdr) const {
        const int col0 = u.nt * 128 + wc * 32 + 8 * fq;
        const LAS float* bh = (const LAS float*)(hdr + 1024) + wc * 32 + 8 * fq;
        const f32x4 bg0 = *(const LAS f32x4*)(bh), bg1 = *(const LAS f32x4*)(bh + 4), bl0 = *(const LAS f32x4*)(bh + 128), bl1 = *(const LAS f32x4*)(bh + 132);
#pragma unroll
        for (int ai = 0; ai < 2; ++ai)
#pragma unroll
            for (int m = 0; m < 4; ++m) { const int r = ai * HALF + wr * 64 + m * 16 + fr;
                bf16* rowp = Ab + ((size_t)u.e * ECAP + (size_t)u.mt * 256 + r) * 1024 + col0;
                float o[8];
#pragma unroll
                for (int n = 0; n < 2; ++n) { const f32x4 g4 = acc[ai][0][m][n] + (n ? bg1 : bg0), l4 = acc[ai][1][m][n] + (n ? bl1 : bl0);
#pragma unroll
                    for (int j = 0; j < 4; ++j) { const float g = fminf(g4[j], 7.0f), l = fminf(fmaxf(l4[j], -7.0f), 7.0f); o[n * 4 + j] = (l + 1.0f) * g * sigmoidf_(1.702f * g); } }
                if constexpr (MOE2_FP8) { v2u q; q.x = cvt4_fp8(o[0], o[1], o[2], o[3]); q.y = cvt4_fp8(o[4], o[5], o[6], o[7]); *(v2u*)((unsigned char*)AbQ + ((size_t)u.e * ECAP + (size_t)u.mt * 256 + r) * 1024 + col0) = q; }
                else *(v4u*)rowp = pack8(o); }
    }
};
struct EpiMoe2 {
    static constexpr bool PERM = true;
    bf16* Y; const float* bdn; const int* sdest; const float* sgate;
    __device__ __forceinline__ void operator()(const f32x4 (&acc)[2][2][4][2], const MoeUnit& u, int wr, int wc, int fr, int fq, const LAS unsigned char* hdr) const {
        const int col0 = u.nt * 256 + wc * 32 + 8 * fq;
        const LAS float* bp = (const LAS float*)(hdr + 2048) + wc * 32 + 8 * fq;
#pragma unroll
        for (int ai = 0; ai < 2; ++ai) {
            f32x4 bv[2][2];
#pragma unroll
            for (int bj = 0; bj < 2; ++bj)
#pragma unroll
                for (int n = 0; n < 2; ++n) bv[bj][n] = *(const LAS f32x4*)(bp + bj * HALF + 4 * n);
            int dest[4]; float gate[4];
#pragma unroll
            for (int m = 0; m < 4; ++m) { const int sl = ai * HALF + wr * 64 + m * 16 + fr; const bool ok = u.mt * 256 + sl < u.cnt;
                dest[m] = ok ? ((const LAS int*)hdr)[sl] : T * 4; gate[m] = ok ? ((const LAS float*)(hdr + 1024))[sl] : 0.f; }
#pragma unroll
            for (int m = 0; m < 4; ++m) {
                { const float g = gate[m]; bf16* rowp = Y + (size_t)dest[m] * 1024 + col0;
#pragma unroll
                    for (int bj = 0; bj < 2; ++bj) { const f32x4 v0 = (acc[ai][bj][m][0] + bv[bj][0]) * g, v1 = (acc[ai][bj][m][1] + bv[bj][1]) * g;
                        v4u w; w.x = cvt_pk_bf16(v0[0], v0[1]); w.y = cvt_pk_bf16(v0[2], v0[3]); w.z = cvt_pk_bf16(v1[0], v1[1]); w.w = cvt_pk_bf16(v1[2], v1[3]);
                        *(v4u*)(rowp + bj * HALF) = w; } } } }
    }
};
}

__device__ __forceinline__ void p0_transpose_item(const float* W, int K, int N, int nblk, bf16* WT, int item, int lane) {
    const int kb = item / nblk, nb = item % nblk, k0 = 64 * kb, n = 64 * nb + lane;
    const bool ok = n < N; const float* src = W + (size_t)k0 * N + (ok ? n : 0);
    float x[64];
#pragma unroll
    for (int j = 0; j < 64; ++j) x[j] = __builtin_nontemporal_load(src + (size_t)j * N);
    bf16* dst = WT + (size_t)n * K + k0;
#pragma unroll
    for (int q = 0; q < 8; ++q) { v4u o; o.x = cvt_pk_bf16(x[8 * q], x[8 * q + 1]); o.y = cvt_pk_bf16(x[8 * q + 2], x[8 * q + 3]); o.z = cvt_pk_bf16(x[8 * q + 4], x[8 * q + 5]); o.w = cvt_pk_bf16(x[8 * q + 6], x[8 * q + 7]);
        if (!ok) o = (v4u){0u, 0u, 0u, 0u};
        *(v4u*)(dst + 8 * q) = o; }
}
__device__ __forceinline__ void cvt_rows(const float* src, bf16* dst, size_t n8, size_t i0, size_t stride) {
    for (size_t i = i0; i < n8; i += stride) { const f32x4 a = *(const f32x4*)(src + i * 8), b = *(const f32x4*)(src + i * 8 + 4);
        v4u o; o.x = cvt_pk_bf16(a.x, a.y); o.y = cvt_pk_bf16(a.z, a.w); o.z = cvt_pk_bf16(b.x, b.y); o.w = cvt_pk_bf16(b.z, b.w); *(v4u*)(dst + i * 8) = o; }
}
__device__ __forceinline__ void p0_prologue(Frame& F, const Args& A) {
    const int gw = F.vcu * NWAVES + F.wave, NGW = F.G * NWAVES;
    constexpr int I_IN = 16 * (NUP / 64), I_OUT = 16 * 16, I_GU = 16 * 32, I_DN = 16 * 16, I_PG = 16 * 16, I_PP = 4 * 16;
    constexpr int PER_LAYER = I_IN + I_OUT + NE * I_GU + NE * I_DN + I_PG + I_PP;
#pragma unroll 1
    for (int it = gw; it < DEPTH * PER_LAYER; it += NGW) {
        const int l = it / PER_LAYER; int r = it % PER_LAYER;
        const float* W; bf16* WT; int K = D, N = D, nblk = 16;
        if (r < I_IN) { W = KIN(I_WIN) + (size_t)l * D * NU; WT = WSP(bf16, WS_WIN_T) + (size_t)l * NUP * D; N = NU; nblk = NUP / 64; }
        else if ((r -= I_IN) < I_OUT) { if (OUT_FP8) continue; W = KIN(I_WOUT) + (size_t)l * D * D; WT = WSP(bf16, WS_WOUT_T) + (size_t)l * D * D; }
        else if ((r -= I_OUT) < NE * I_GU) { if (MOE_FP8) continue; const int e = r / I_GU; r %= I_GU; W = KIN(I_WGU) + ((size_t)l * NE + e) * D * 2048; WT = WSP(bf16, WS_WGU_T) + ((size_t)l * NE + e) * 2048 * D; N = 2048; nblk = 32; }
        else if ((r -= NE * I_GU) < NE * I_DN) { if (MOE2_FP8) continue; const int e = r / I_DN; r %= I_DN; W = KIN(I_WDN) + ((size_t)l * NE + e) * D * D; WT = WSP(bf16, WS_WDN_T) + ((size_t)l * NE + e) * D * D; }
        else if ((r -= NE * I_DN) < I_PG) { if (PLE_FP8) continue; W = KIN(I_PGW) + (size_t)l * D * D; WT = WSP(bf16, WS_WPG_T) + (size_t)l * D * D; }
        else { r -= I_PG; W = KIN(I_PPJ) + (size_t)l * 256 * D; WT = WSP(bf16, WS_WPP_T) + (size_t)l * D * 256; K = 256; }
        p0_transpose_item(W, K, N, nblk, WT, r, F.lane);
    }
#if MOE_FP8
    constexpr int Q_GU = 16 * 32, Q_DN = 16 * 16, Q_PG = PLE_FP8 ? 16 * 16 : 0, Q_OUT = OUT_FP8 ? 16 * 16 : 0, Q_PER_LAYER = NE * (Q_GU + Q_DN) + Q_PG + Q_OUT;
#pragma unroll 1
    for (int it = gw; it < DEPTH * Q_PER_LAYER; it += NGW) {
        const int l = it / Q_PER_LAYER; int r = it % Q_PER_LAYER; const float* W; unsigned char* WQ; int N; float sc;
        if (r < NE * Q_GU) { const int e = r / Q_GU; r %= Q_GU; W = KIN(I_WGU) + ((size_t)l * NE + e) * D * 2048; WQ = WSP(unsigned char, WS_WGU_Q) + ((size_t)l * NE + e) * 2048 * D; N = 2048; sc = 32.0f; }
        else if (r >= NE * (Q_GU + Q_DN) + Q_PG) { r -= NE * (Q_GU + Q_DN) + Q_PG; W = KIN(I_WOUT) + (size_t)l * D * D; WQ = WSP(unsigned char, WS_WOUT_Q) + (size_t)l * D * D; N = D; sc = 64.0f; }
        else if (r >= NE * (Q_GU + Q_DN)) { r -= NE * (Q_GU + Q_DN); W = KIN(I_PGW) + (size_t)l * D * D; WQ = WSP(unsigned char, WS_WPG_Q) + (size_t)l * D * D; N = D; sc = 32.0f; }
        else { if (!MOE2_FP8) continue; r -= NE * Q_GU; const int e = r / Q_DN; r %= Q_DN; W = KIN(I_WDN) + ((size_t)l * NE + e) * D * D; WQ = WSP(unsigned char, WS_WDN_Q) + ((size_t)l * NE + e) * D * D; N = D; sc = 64.0f; }
        const int nblk = N / 64, kb = r / nblk, nb = r % nblk, k0 = 64 * kb, n = 64 * nb + F.lane;
        const float* src = W + (size_t)k0 * N + n; float x[64];
#pragma unroll
        for (int j = 0; j < 64; ++j) x[j] = __builtin_nontemporal_load(src + (size_t)j * N) * sc;
        unsigned char* dst = WQ + (size_t)n * D + k0;
#pragma unroll
        for (int q = 0; q < 4; ++q) { v4u o; o.x = cvt4_fp8(x[16 * q], x[16 * q + 1], x[16 * q + 2], x[16 * q + 3]); o.y = cvt4_fp8(x[16 * q + 4], x[16 * q + 5], x[16 * q + 6], x[16 * q + 7]);
            o.z = cvt4_fp8(x[16 * q + 8], x[16 * q + 9], x[16 * q + 10], x[16 * q + 11]); o.w = cvt4_fp8(x[16 * q + 12], x[16 * q + 13], x[16 * q + 14], x[16 * q + 15]); *(v4u*)(dst + 16 * q) = o; }
    }
#endif
    const size_t gt = (size_t)F.vcu * (NWAVES * 64) + F.tid, NT_ = (size_t)F.G * NWAVES * 64;
    cvt_rows(KIN(I_P), WSP(bf16, WS_PB), (size_t)DEPTH * T * 256 / 8, gt, NT_);
    cvt_rows(KIN(I_X), WSP(bf16, WS_XB), (size_t)T * D / 8, gt, NT_);
    for (size_t i = gt; i < (size_t)DEPTH * LORA_PER_LAYER; i += NT_) { const int l = (int)(i / LORA_PER_LAYER); int r = (int)(i % LORA_PER_LAYER); float v;
        if (r < 8192) { const int ch = r >> 5, j = r & 31; v = KIN(I_RWUP)[(size_t)l * 8192 + j * 256 + ch]; }
        else if (r < 16384) { r -= 8192; const int ch = r >> 5, j = r & 31; v = KIN(I_RAUP)[(size_t)l * 8192 + j * 256 + ch]; }
        else if (r < 32768) { r -= 16384; const int ch = r >> 6, j = r & 63; v = KIN(I_RGUP)[(size_t)l * 16384 + j * 256 + ch]; }
        else { r -= 32768; const int d = r >> 4, j = r & 15; v = KIN(I_GGUP)[(size_t)l * 2048 + j * 128 + d]; }
        WSP(float, WS_LORA)[i] = v; }
    for (size_t i = gt; i < (size_t)DEPTH * NE * D; i += NT_) { const int l = (int)(i / (NE * D)), r = (int)(i % (NE * D)), e = r / D, k = r % D; WSP(float, WS_RWT)[i] = KIN(I_RTW)[(size_t)l * D * NE + (size_t)k * NE + e]; }
}

template <bool DRY> __device__ __forceinline__ void p6_ln1_router(Frame& F, const Args& A, int layer) {
    const bf16* y1 = WSP(bf16, WS_Y1); bf16* x1b = WSP(bf16, WS_X1B);
    const float* g = KIN(I_LN1G) + layer * D; const float* bb = KIN(I_LN1B) + layer * D;
    const float* rwt = WSP(float, WS_RWT) + (size_t)layer * NE * D; const float* rb = KIN(I_RTB) + layer * NE;
    int* sdest = WSP(int, WS_SDEST); float* sgate = WSP(float, WS_SGATE);
    unsigned* cnt = (unsigned*)(F.ctl + CW_CNT + layer * NE * 16);
    LAS float* RWT = (LAS float*)F.lds;
    LAS float* TOPV = (LAS float*)(F.lds + 131072) + F.wave * 64;
    LAS int* TOPE = (LAS int*)(F.lds + 131072 + 2048) + F.wave * 64;
    volatile LAS unsigned* lcnt = F.MISC + MW_LCNT; volatile LAS unsigned* lbase = F.MISC + MW_LBASE;
    for (int i = F.tid; i < NE * D / 4; i += NWAVES * 64) ((LAS f32x4*)RWT)[i] = ((const f32x4*)rwt)[i];
    const int lane = F.lane, sub = lane & 15;
    for (int blk = F.vcu; blk < T / 64; blk += F.G) {
        if (F.tid < 32) lcnt[F.tid] = 0u;
        __syncthreads();
#pragma unroll 1
        for (int rg = 0; rg < 2; ++rg) {
            f32x4 v[4][4];
            { int lo_ = lane; asm volatile("" : "+v"(lo_));
              const f32x4 gv[4] = { *(const f32x4*)(g + 4 * lo_), *(const f32x4*)(g + 256 + 4 * lo_), *(const f32x4*)(g + 512 + 4 * lo_), *(const f32x4*)(g + 768 + 4 * lo_) };
              const f32x4 bv[4] = { *(const f32x4*)(bb + 4 * lo_), *(const f32x4*)(bb + 256 + 4 * lo_), *(const f32x4*)(bb + 512 + 4 * lo_), *(const f32x4*)(bb + 768 + 4 * lo_) };
#pragma unroll
              for (int r = 0; r < 4; ++r) { const int row = blk * 64 + F.wave * 8 + rg * 4 + r; const bf16* yr = y1 + (size_t)row * D; float s = 0.f;
#pragma unroll
                  for (int j = 0; j < 4; ++j) { const v2u w = *(const v2u*)(yr + 256 * j + 4 * lane); v[r][j] = (f32x4){__uint_as_float(w.x << 16), __uint_as_float(w.x & 0xffff0000u), __uint_as_float(w.y << 16), __uint_as_float(w.y & 0xffff0000u)}; s += (v[r][j].x + v[r][j].y) + (v[r][j].z + v[r][j].w); }
                  const float mean = wave_sum(s) * (1.f / D); float s2 = 0.f;
#pragma unroll
                  for (int j = 0; j < 4; ++j) { v[r][j] = v[r][j] - mean; s2 += (v[r][j].x * v[r][j].x + v[r][j].y * v[r][j].y) + (v[r][j].z * v[r][j].z + v[r][j].w * v[r][j].w); }
                  const float rstd = __builtin_amdgcn_rsqf(wave_sum(s2) * (1.f / D) + LN_EPS);
#pragma unroll
                  for (int j = 0; j < 4; ++j) { v[r][j] = v[r][j] * rstd * gv[j] + bv[j];
                      v2u o; o.x = cvt_pk_bf16(v[r][j].x, v[r][j].y); o.y = cvt_pk_bf16(v[r][j].z, v[r][j].w); *(v2u*)(x1b + (size_t)row * D + 256 * j + 4 * lane) = o;
                      if (MOE_FP8) *(unsigned*)(WSP(unsigned char, WS_X1Q) + (size_t)row * D + 256 * j + 4 * lane) = cvt4_fp8(v[r][j].x, v[r][j].y, v[r][j].z, v[r][j].w); } } }
            float lg[32];
#pragma unroll
            for (int e = 0; e < 32; ++e) { f32x2 p2[4] = {(f32x2){0.f, 0.f}, (f32x2){0.f, 0.f}, (f32x2){0.f, 0.f}, (f32x2){0.f, 0.f}};
#pragma unroll
                for (int j = 0; j < 4; ++j) { const f32x4 w = *(const LAS f32x4*)(RWT + e * D + 256 * j + 4 * lane);
#pragma unroll
                    for (int r = 0; r < 4; ++r) { p2[r] = v[r][j].xy * w.xy + p2[r]; p2[r] = v[r][j].zw * w.zw + p2[r]; } }
                float p[4] = {p2[0].x + p2[0].y, p2[1].x + p2[1].y, p2[2].x + p2[2].y, p2[3].x + p2[3].y};
                { const bool hi = (lane & 32) != 0; const float k0 = hi ? p[2] : p[0], s0 = hi ? p[0] : p[2], k1 = hi ? p[3] : p[1], s1 = hi ? p[1] : p[3]; p[0] = k0 + __shfl_xor(s0, 32); p[1] = k1 + __shfl_xor(s1, 32); }
                { const bool hi = (lane & 16) != 0; const float k0 = hi ? p[1] : p[0], s0 = hi ? p[0] : p[1]; p[0] = k0 + __shfl_xor(s0, 16); }
                float t = p[0]; t += __shfl_xor(t, 8); t += __shfl_xor(t, 4); t += __shfl_xor(t, 2); t += __shfl_xor(t, 1);
                lg[e] = t + rb[e]; }
            float la = 0.f, lb_ = 0.f;
#pragma unroll
            for (int e = 0; e < 32; ++e) { if (e == 2 * sub) la = lg[e]; if (e == 2 * sub + 1) lb_ = lg[e]; }
            int ra = 0, rbk = 0;
#pragma unroll
            for (int e = 0; e < 32; ++e) { ra += (lg[e] > la || (lg[e] == la && e < 2 * sub)) ? 1 : 0; rbk += (lg[e] > lb_ || (lg[e] == lb_ && e < 2 * sub + 1)) ? 1 : 0; }
            const int rowl = rg * 4 + (lane >> 4);
            if (ra < 4) { TOPV[rowl * 4 + ra] = la; TOPE[rowl * 4 + ra] = 2 * sub; }
            if (rbk < 4) { TOPV[rowl * 4 + rbk] = lb_; TOPE[rowl * 4 + rbk] = 2 * sub + 1; }
        }
        LDS_WAIT();
        int my_e = 0; float my_g = 0.f; unsigned my_r = 0u;
        if (lane < 32) { const int ri = lane >> 2, k = lane & 3; const f32x4 tv = *(const LAS f32x4*)(TOPV + ri * 4);
            const float e1 = __expf(tv.y - tv.x), e2 = __expf(tv.z - tv.x), e3 = __expf(tv.w - tv.x); const float inv = __builtin_amdgcn_rcpf(1.0f + e1 + e2 + e3);
            my_e = TOPE[ri * 4 + k]; my_g = (k == 0 ? 1.0f : k == 1 ? e1 : k == 2 ? e2 : e3) * inv;
            my_r = DRY ? 0u : atomicAdd((unsigned*)&lcnt[my_e], 1u); }
        __syncthreads();
        if (!DRY && F.tid < 32) { const unsigned n = lcnt[F.tid]; lbase[F.tid] = n ? __hip_atomic_fetch_add(cnt + F.tid * 16, n, RLX_AGENT) : 0u; }
        __syncthreads();
        if (!DRY && lane < 32) { const int row = blk * 64 + F.wave * 8 + (lane >> 2); const unsigned slot = (unsigned)my_e * ECAP + lbase[my_e] + my_r;
            sdest[slot] = row * 4 + (lane & 3); sgate[slot] = my_g; }
        __syncthreads();
    }
}
__device__ __forceinline__ void p9_combine(Frame& F, const Args& A) {
    const bf16* x1b = WSP(bf16, WS_X1B); const bf16* yb = WSP(bf16, WS_YBUF); bf16* hb = WSP(bf16, WS_HB);
    const int gw = F.vcu * NWAVES + F.wave, NGW = F.G * NWAVES, lane = F.lane;
    for (int row = gw; row < T; row += NGW) {
        v4u y[4][2], xw[2];
#pragma unroll
        for (int j = 0; j < 2; ++j) {
#pragma unroll
            for (int k = 0; k < 4; ++k) y[k][j] = *(const v4u*)(yb + ((size_t)row * 4 + k) * D + 512 * j + 8 * lane);
            xw[j] = *(const v4u*)(x1b + (size_t)row * D + 512 * j + 8 * lane); }
#pragma unroll
        for (int j = 0; j < 2; ++j) { f32x4 v0, v1; pg8::unpack8(xw[j], v0, v1); v0 = v0 * DN_ALPHA; v1 = v1 * DN_ALPHA;
#pragma unroll
            for (int k = 0; k < 4; ++k) { f32x4 a, b; pg8::unpack8(y[k][j], a, b); v0 = v0 + a; v1 = v1 + b; }
            v4u wv; wv.x = cvt_pk_bf16(v0.x, v0.y); wv.y = cvt_pk_bf16(v0.z, v0.w); wv.z = cvt_pk_bf16(v1.x, v1.y); wv.w = cvt_pk_bf16(v1.z, v1.w); *(v4u*)(hb + (size_t)row * D + 512 * j + 8 * lane) = wv;
            if (PLE_FP8) { v2u q; q.x = cvt4_fp8(v0.x, v0.y, v0.z, v0.w); q.y = cvt4_fp8(v1.x, v1.y, v1.z, v1.w); *(v2u*)(WSP(unsigned char, WS_HQ) + (size_t)row * D + 512 * j + 8 * lane) = q; } }
    }
}
__device__ __forceinline__ void p11_ln2(Frame& F, const Args& A, int layer) {
    const bf16* h2 = WSP(bf16, WS_H2); bf16* xb = WSP(bf16, WS_XB);
    const float* g = KIN(I_LN2G) + layer * D; const float* bb = KIN(I_LN2B) + layer * D;
    const int gw = F.vcu * NWAVES + F.wave, NGW = F.G * NWAVES, lane = F.lane;
    for (int row = gw; row < T; row += NGW) {
        const bf16* yr = h2 + (size_t)row * D; f32x4 v[4]; float s = 0.f;
#pragma unroll
        for (int j = 0; j < 4; ++j) { const v2u w = *(const v2u*)(yr + 256 * j + 4 * lane); v[j] = (f32x4){__uint_as_float(w.x << 16), __uint_as_float(w.x & 0xffff0000u), __uint_as_float(w.y << 16), __uint_as_float(w.y & 0xffff0000u)}; s += (v[j].x + v[j].y) + (v[j].z + v[j].w); }
        const float mean = wave_sum(s) * (1.f / D); float s2 = 0.f;
#pragma unroll
        for (int j = 0; j < 4; ++j) { v[j] = v[j] - mean; s2 += (v[j].x * v[j].x + v[j].y * v[j].y) + (v[j].z * v[j].z + v[j].w * v[j].w); }
        const float rstd = __builtin_amdgcn_rsqf(wave_sum(s2) * (1.f / D) + LN_EPS);
#pragma unroll
        for (int j = 0; j < 4; ++j) { const f32x4 gv = *(const f32x4*)(g + 256 * j + 4 * lane), bv = *(const f32x4*)(bb + 256 * j + 4 * lane);
            const f32x4 o = v[j] * rstd * gv + bv; const size_t off = (size_t)row * D + 256 * j + 4 * lane;
            if (layer == DEPTH - 1) *(f32x4*)(F.out + off) = o; v2u w; w.x = cvt_pk_bf16(o.x, o.y); w.y = cvt_pk_bf16(o.z, o.w); *(v2u*)(xb + off) = w; }
    }
}
__device__ __forceinline__ void moe_build_pfx(Frame& F, const Args& A, int layer, int NT) {
    volatile LAS unsigned* pfx = F.MISC + MW_PFX;
    __syncthreads();
    if (F.tid < 64) {
        const int e = F.tid & 31;
        const unsigned c = __hip_atomic_load(F.ctl + CW_CNT + (layer * NE + e) * 16, RLX_AGENT);
        const unsigned un = ((c + 255u) >> 8) * (unsigned)NT; unsigned inc = un;
#pragma unroll
        for (int o = 1; o < 32; o <<= 1) { const unsigned t = (unsigned)my_shfl_up((int)inc, o); if (e >= o) inc += t; }
        if (F.tid < 32) { pfx[e] = inc - un; pfx[40 + e] = c; if (e == 31) pfx[32] = inc; }
    }
    __syncthreads();
}
#define UU(t, col) bf2f(u[(size_t)(t) * NUP + (col)])
#define UU4(t, col) ldu4(u + (size_t)(t) * NUP + (col))
__device__ __forceinline__ f32x4 ldu4(const bf16* p) { const v2u w = *(const v2u*)p; return (f32x4){__uint_as_float(w.x << 16), __uint_as_float(w.x & 0xffff0000u), __uint_as_float(w.y << 16), __uint_as_float(w.y & 0xffff0000u)}; }
__device__ __forceinline__ f32x4 ldb4(const bf16* p) { const v2u w = *(const v2u*)p; return (f32x4){__uint_as_float(w.x << 16), __uint_as_float(w.x & 0xffff0000u), __uint_as_float(w.y << 16), __uint_as_float(w.y & 0xffff0000u)}; }
__device__ __forceinline__ void stb4(bf16* p, f32x4 v) { v2u o; o.x = cvt_pk_bf16(v.x, v.y); o.y = cvt_pk_bf16(v.z, v.w); *(v2u*)p = o; }
__device__ __forceinline__ void lds_st_bf16(LAS unsigned char* p, float v) { *(LAS unsigned short*)p = (unsigned short)(cvt_pk_bf16(v, 0.f) & 0xffffu); }
__device__ __forceinline__ void lds_st_bf16x4(LAS unsigned char* p, float a, float b, float c, float d) { v2u o; o.x = cvt_pk_bf16(a, b); o.y = cvt_pk_bf16(c, d); *(LAS v2u*)p = o; }

#if OUT_FP8
#define MIX_ST4(mix, idx, a, b, c, d) (*(unsigned*)((unsigned char*)(mix) + (idx)) = cvt4_fp8(a, b, c, d))
#else
#define MIX_ST4(mix, idx, a, b, c, d) do { v2u o_; o_.x = cvt_pk_bf16(a, b); o_.y = cvt_pk_bf16(c, d); *(v2u*)((mix) + (idx)) = o_; } while (0)
#endif
__device__ __forceinline__ void ssd_stage1(Frame& F, const Args& A, int layer, int b, int c) {
    const bf16* u = WSP(bf16, WS_U);
    LAS unsigned char* L = F.lds;
    LAS float* DT = (LAS float*)L; LAS float* AC = DT + 256;
    LAS unsigned char* BMT = L + 2048; LAS unsigned char* XCDT = BMT + 128 * 144;
    const int t0 = b * SEQ + c * 64, tid = F.tid, lane = F.lane, wave = F.wave;
    if (wave < 4) {
        const int hh = wave;
        const float dt = softplusf_(UU(t0 + lane, U_SSD_DT + hh) + KIN(I_SDTB)[layer * 4 + hh]);
        const float adt = -dt * __expf(KIN(I_SALOG)[layer * 4 + hh]);
        const float ac = wave_scan_add(adt, lane);
        DT[hh * 64 + lane] = dt; AC[hh * 64 + lane] = ac;
        if (lane == 63) WSP(float, WS_SSD_DEC)[(b * 4 + hh) * NCH + c] = __expf(ac);
    }
    __syncthreads();
    if (tid < 384) {
        const int cc = tid; const float* cw = KIN(I_SCW) + (size_t)layer * 2048 + cc; const float w0 = cw[0], w1 = cw[512], w2 = cw[1024], w3 = cw[1536], cb = KIN(I_SCB)[layer * 512 + cc];
        const bf16* up = u + (size_t)t0 * NUP + U_SSD_X + cc;
        float win0 = 0.f, win1 = 0.f, win2 = 0.f;
        if (c > 0) { win0 = bf2f(up[-3 * NUP]); win1 = bf2f(up[-2 * NUP]); win2 = bf2f(up[-1 * NUP]); }
        const int hh = (cc >> 6) & 3; const bool isx = cc < 256;
        LAS unsigned char* dst = isx ? XCDT + cc * 144 : BMT + (cc - 256) * 144;
        const float aclast = AC[hh * 64 + 63];
#pragma unroll 1
        for (int l0 = 0; l0 < 64; l0 += 32) {
            float xv[32];
#pragma unroll
            for (int j = 0; j < 32; ++j) xv[j] = bf2f(up[(l0 + j) * NUP]);
#pragma unroll
            for (int j8 = 0; j8 < 4; ++j8) { float o[8];
#pragma unroll
                for (int j = 0; j < 8; ++j) { const int l = l0 + j8 * 8 + j; const float x = xv[j8 * 8 + j]; const float y = cb + w0 * win0 + w1 * win1 + w2 * win2 + w3 * x; win0 = win1; win1 = win2; win2 = x;
                    float s = siluf_(y); if (isx) s *= DT[hh * 64 + l] * __expf(aclast - AC[hh * 64 + l]); o[j] = s; }
                *(LAS v4u*)(dst + (l0 + j8 * 8) * 2) = pack8(o); }
        }
    }
    __syncthreads();
    { const int fr = lane & 15, fq = lane >> 4; bf16* st = WSP(bf16, WS_SSD_ST);
#pragma unroll 1
      for (int i = 0; i < 2; ++i) { const int row0 = (2 * wave + i) * 16; const int hh = row0 >> 6, p = (row0 & 63) + fr;
          bf16* dstp = st + (((size_t)(b * 4 + hh) * NCH + c) * 64 + p) * 128;
#pragma unroll 1
          for (int ntl = 0; ntl < 8; ++ntl) { f32x4 acc = {0.f, 0.f, 0.f, 0.f}; acc = mm16(XCDT + row0 * 144, 144, BMT + ntl * 16 * 144, 144, 64, acc, fr, fq);
              stb4(dstp + ntl * 16 + 4 * fq, acc); } } }
    __syncthreads();
}
__device__ __forceinline__ void ssd_stage3(Frame& F, const Args& A, int layer, int b, int c) {
    const bf16* u = WSP(bf16, WS_U);
    LAS unsigned char* L = F.lds;
    LAS float* DT = (LAS float*)L; LAS float* AC = DT + 256;
    LAS unsigned char* CM = L + 2048; LAS unsigned char* BM = CM + 64 * 272; LAS unsigned char* XCT = BM + 64 * 272; LAS unsigned char* MM = XCT + 256 * 144;
    LAS unsigned char* YG = XCT;
    const int t0 = b * SEQ + c * 64, tid = F.tid, lane = F.lane, wave = F.wave, fr = lane & 15, fq = lane >> 4;
    if (wave < 4) {
        const int hh = wave;
        const float dt = softplusf_(UU(t0 + lane, U_SSD_DT + hh) + KIN(I_SDTB)[layer * 4 + hh]);
        const float adt = -dt * __expf(KIN(I_SALOG)[layer * 4 + hh]);
        DT[hh * 64 + lane] = dt; AC[hh * 64 + lane] = wave_scan_add(adt, lane);
    }
    __syncthreads();
    {
        const int cc = tid; const float* cw = KIN(I_SCW) + (size_t)layer * 2048 + cc; const float w0 = cw[0], w1 = cw[512], w2 = cw[1024], w3 = cw[1536], cb = KIN(I_SCB)[layer * 512 + cc];
        const bf16* up = u + (size_t)t0 * NUP + U_SSD_X + cc;
        float win0 = 0.f, win1 = 0.f, win2 = 0.f;
        if (c > 0) { win0 = bf2f(up[-3 * NUP]); win1 = bf2f(up[-2 * NUP]); win2 = bf2f(up[-1 * NUP]); }
        const int hh = (cc >> 6) & 3;
#pragma unroll 1
        for (int l0 = 0; l0 < 64; l0 += 32) {
            float xv[32];
#pragma unroll
            for (int j = 0; j < 32; ++j) xv[j] = bf2f(up[(l0 + j) * NUP]);
#pragma unroll
            for (int j8 = 0; j8 < 4; ++j8) { float o[8];
#pragma unroll
                for (int j = 0; j < 8; ++j) { const int l = l0 + j8 * 8 + j; const float x = xv[j8 * 8 + j]; const float y = cb + w0 * win0 + w1 * win1 + w2 * win2 + w3 * x; win0 = win1; win1 = win2; win2 = x;
                    float s = siluf_(y); if (cc < 256) s *= DT[hh * 64 + l]; o[j] = s; }
                if (cc < 256) *(LAS v4u*)(XCT + cc * 144 + (l0 + j8 * 8) * 2) = pack8(o);
                else { LAS unsigned char* d2 = (cc < 384 ? BM + (cc - 256) * 2 : CM + (cc - 384) * 2) + (l0 + j8 * 8) * 272;
#pragma unroll
                    for (int j = 0; j < 8; ++j) lds_st_bf16(d2 + j * 272, o[j]); } }
        }
    }
    __syncthreads();
#pragma unroll 1
    for (int i = 0; i < 2; ++i) { const int idx = 2 * wave + i, lt = idx >> 2, st = idx & 3;
        f32x4 acc = {0.f, 0.f, 0.f, 0.f}; acc = mm16(CM + lt * 16 * 272, 272, BM + st * 16 * 272, 272, 128, acc, fr, fq);
        const int l = lt * 16 + fr, s0 = st * 16 + 4 * fq;
#pragma unroll
        for (int hh = 0; hh < 4; ++hh) { const float al = AC[hh * 64 + l], dl = KIN(I_SD)[layer * 4 + hh] / DT[hh * 64 + l]; float o[4];
#pragma unroll
            for (int j = 0; j < 4; ++j) { const int s = s0 + j; float m = (l >= s) ? acc[j] * __expf(al - AC[hh * 64 + s]) : 0.f; if (l == s) m += dl; o[j] = m; }
            lds_st_bf16x4(MM + hh * 9216 + l * 144 + s0 * 2, o[0], o[1], o[2], o[3]); } }
    __syncthreads();
    f32x4 yv[2][4];
    { const int hh = wave >> 1; const bf16* prev = WSP(bf16, WS_SSD_ST) + ((size_t)(b * 4 + hh) * NCH + c) * 8192;
      bf16x8 pf[4][4];
#pragma unroll
      for (int pt = 0; pt < 4; ++pt)
#pragma unroll
          for (int ks = 0; ks < 4; ++ks) pf[pt][ks] = *(const bf16x8*)(prev + (size_t)(pt * 16 + fr) * 128 + ks * 32 + fq * 8);
#pragma unroll
      for (int i = 0; i < 2; ++i) { const int lt = 2 * (wave & 1) + i, l = lt * 16 + fr; const float ea = __expf(AC[hh * 64 + l]);
#pragma unroll
          for (int pt = 0; pt < 4; ++pt) { f32x4 ad = {0.f, 0.f, 0.f, 0.f}, ao = {0.f, 0.f, 0.f, 0.f};
              ad = mm16(MM + hh * 9216 + lt * 16 * 144, 144, XCT + (hh * 64 + pt * 16) * 144, 144, 64, ad, fr, fq);
              ao = mm16_rB<4>(CM + lt * 16 * 272, 272, pf[pt], ao, fr, fq);
              const f32x4 z = UU4(t0 + l, U_SSD_Z + hh * 64 + pt * 16 + 4 * fq);
              f32x4 y = ad + ao * ea; y.x *= siluf_(z.x); y.y *= siluf_(z.y); y.z *= siluf_(z.z); y.w *= siluf_(z.w); yv[i][pt] = y; } } }
    __syncthreads();
    { const int hh = wave >> 1;
#pragma unroll
      for (int i = 0; i < 2; ++i) { const int l = (2 * (wave & 1) + i) * 16 + fr;
#pragma unroll
          for (int pt = 0; pt < 4; ++pt) *(LAS f32x4*)(YG + l * 1040 + (hh * 64 + pt * 16 + 4 * fq) * 4) = yv[i][pt]; } }
    __syncthreads();
    { const f32x4 g = *(const f32x4*)(KIN(I_SNG) + layer * 256 + 4 * lane); bf16* mix = WSP(bf16, WS_MIX);
#pragma unroll 1
      for (int i = 0; i < 8; ++i) { const int l = wave * 8 + i; const f32x4 y = *(const LAS f32x4*)(YG + l * 1040 + lane * 16);
          const float ss = wave_sum((y.x * y.x + y.y * y.y) + (y.z * y.z + y.w * y.w)); const float r = __builtin_amdgcn_rsqf(ss * (1.f / 256.f) + NORM_EPS);
          MIX_ST4(mix, (size_t)(t0 + l) * D + 4 * lane, y.x * r * g.x, y.y * r * g.y, y.z * r * g.z, y.w * r * g.w); } }
    __syncthreads();
}

__device__ __forceinline__ void gla_bcum_all(Frame& F, const Args& A, int layer, const LAS float* GD, LAS float* BC) {
    const int d = F.tid & 127, lq = F.tid >> 7;
    float gup[16];
    { const f32x4* gp4 = (const f32x4*)(WSP(float, WS_LORA) + (size_t)layer * LORA_PER_LAYER + 32768 + d * 16);
#pragma unroll
      for (int i = 0; i < 4; ++i) { const f32x4 a = gp4[i]; gup[4 * i] = a.x; gup[4 * i + 1] = a.y; gup[4 * i + 2] = a.z; gup[4 * i + 3] = a.w; } }
    const float gb = KIN(I_GGB)[layer * 128 + d];
#pragma unroll 4
    for (int li = 0; li < 16; ++li) { const int l = lq * 16 + li; float x = gb;
#pragma unroll
        for (int i = 0; i < 4; ++i) { const f32x4 g4 = *(const LAS f32x4*)(GD + l * 16 + 4 * i); x += (g4.x * gup[4 * i] + g4.y * gup[4 * i + 1]) + (g4.z * gup[4 * i + 2] + g4.w * gup[4 * i + 3]); }
        BC[l * 128 + d] = logsigmoidf_(x) * 0.0625f; }
    __syncthreads();
    if (F.tid < 128) { float run = 0.f;
#pragma unroll 1
        for (int l0 = 0; l0 < 64; l0 += 16) { float v[16];
#pragma unroll
            for (int j = 0; j < 16; ++j) v[j] = BC[(l0 + j) * 128 + d];
#pragma unroll
            for (int j = 0; j < 16; ++j) { run += v[j]; BC[(l0 + j) * 128 + d] = run; } } }
}
__device__ __forceinline__ void gla_stage1(Frame& F, const Args& A, int layer, int b, int c) {
    const bf16* u = WSP(bf16, WS_U);
    LAS unsigned char* L = F.lds;
    LAS float* GD = (LAS float*)L; LAS float* BC = (LAS float*)(L + 4096);
    LAS unsigned char* KDT = L + 36864; LAS unsigned char* VT = KDT + 128 * 144;
    const int t0 = b * SEQ + c * 64, tid = F.tid, lane = F.lane, wave = F.wave, fr = lane & 15, fq = lane >> 4;
    if (tid < 256) { const int l = tid >> 2, q4 = tid & 3; *(LAS f32x4*)(GD + l * 16 + q4 * 4) = UU4(t0 + l, U_GL_G + 4 * q4); }
    __syncthreads();
    gla_bcum_all(F, A, layer, GD, BC);
    if (tid < 128) {
        const int d = tid; const float blast = BC[63 * 128 + d];
        WSP(float, WS_GLA_DEC)[(size_t)(b * NCH + c) * 128 + d] = __expf(blast);
        const bf16* up = u + (size_t)t0 * NUP + U_GL_K + d;
#pragma unroll 1
        for (int l0 = 0; l0 < 64; l0 += 32) { float xv[32];
#pragma unroll
            for (int j = 0; j < 32; ++j) xv[j] = bf2f(up[(l0 + j) * NUP]);
#pragma unroll
            for (int j8 = 0; j8 < 4; ++j8) { float o[8];
#pragma unroll
                for (int j = 0; j < 8; ++j) { const int l = l0 + j8 * 8 + j; o[j] = xv[j8 * 8 + j] * __expf(blast - BC[l * 128 + d]); }
                *(LAS v4u*)(KDT + d * 144 + (l0 + j8 * 8) * 2) = pack8(o); } }
    } else if (tid < 384) {
        const int vch = tid - 128; const bf16* up = u + (size_t)t0 * NUP + U_GL_V + vch;
#pragma unroll 1
        for (int l0 = 0; l0 < 64; l0 += 32) { float xv[32];
#pragma unroll
            for (int j = 0; j < 32; ++j) xv[j] = bf2f(up[(l0 + j) * NUP]);
#pragma unroll
            for (int j8 = 0; j8 < 4; ++j8) { float o[8];
#pragma unroll
                for (int j = 0; j < 8; ++j) o[j] = xv[j8 * 8 + j];
                *(LAS v4u*)(VT + vch * 144 + (l0 + j8 * 8) * 2) = pack8(o); } }
    }
    __syncthreads();
    { bf16* st = WSP(bf16, WS_GLA_ST);
#pragma unroll 1
      for (int i = 0; i < 4; ++i) { const int idx = 4 * wave + i, hh = idx >> 3, dtl = (idx >> 2) & 1, vt = idx & 3;
          f32x4 acc = {0.f, 0.f, 0.f, 0.f}; acc = mm16(KDT + (hh * 32 + dtl * 16) * 144, 144, VT + (hh * 64 + vt * 16) * 144, 144, 64, acc, fr, fq);
          stb4(st + (((size_t)(b * 4 + hh) * NCH + c) * 32 + dtl * 16 + fr) * 64 + vt * 16 + 4 * fq, acc); } }
    __syncthreads();
}
__device__ __forceinline__ void gla_stage3(Frame& F, const Args& A, int layer, int b, int c) {
    const bf16* u = WSP(bf16, WS_U);
    LAS unsigned char* L = F.lds;
    LAS float* GD = (LAS float*)L; LAS float* BC = (LAS float*)(L + 4096); LAS unsigned char* ATT = L + 4096;
    LAS unsigned char* QD = L + 40960; LAS unsigned char* KI = QD + 64 * 272; LAS unsigned char* VT = KI + 64 * 272; LAS unsigned char* PVT = VT + 256 * 144;
    const int t0 = b * SEQ + c * 64, tid = F.tid, lane = F.lane, wave = F.wave, fr = lane & 15, fq = lane >> 4;
    if (tid < 256) { const int l = tid >> 2, q4 = tid & 3; *(LAS f32x4*)(GD + l * 16 + q4 * 4) = UU4(t0 + l, U_GL_G + 4 * q4); }
    __syncthreads();
    gla_bcum_all(F, A, layer, GD, BC);
    if (tid < 128) {
        const int d = tid;
        const bf16* uq = u + (size_t)t0 * NUP + U_GL_Q + d; const bf16* uk = u + (size_t)t0 * NUP + U_GL_K + d;
#pragma unroll 1
        for (int l0 = 0; l0 < 64; l0 += 16) { float qv[16], kv[16];
#pragma unroll
            for (int j = 0; j < 16; ++j) { qv[j] = bf2f(uq[(l0 + j) * NUP]); kv[j] = bf2f(uk[(l0 + j) * NUP]); }
#pragma unroll
            for (int j = 0; j < 16; ++j) { const int l = l0 + j; const float bc = BC[l * 128 + d];
                lds_st_bf16(QD + l * 272 + d * 2, qv[j] * 0.17677669529663687f * __expf(bc)); lds_st_bf16(KI + l * 272 + d * 2, kv[j] * __expf(-bc)); } }
    } else if (tid < 384) {
        const int vch = tid - 128; const bf16* up = u + (size_t)t0 * NUP + U_GL_V + vch;
#pragma unroll 1
        for (int l0 = 0; l0 < 64; l0 += 32) { float xv[32];
#pragma unroll
            for (int j = 0; j < 32; ++j) xv[j] = bf2f(up[(l0 + j) * NUP]);
#pragma unroll
            for (int j8 = 0; j8 < 4; ++j8) { float o[8];
#pragma unroll
                for (int j = 0; j < 8; ++j) o[j] = xv[j8 * 8 + j];
                *(LAS v4u*)(VT + vch * 144 + (l0 + j8 * 8) * 2) = pack8(o); } }
    } else {
        const bf16* prev = WSP(bf16, WS_GLA_ST);
#pragma unroll 4
        for (int i = tid - 384; i < 8192; i += 128) { const int hh = i >> 11, dd = (i >> 6) & 31, vv = i & 63;
            *(LAS unsigned short*)(PVT + (hh * 64 + vv) * 80 + dd * 2) = prev[((size_t)(b * 4 + hh) * NCH + c) * 2048 + dd * 64 + vv]; }
    }
    __syncthreads();
    const int hh = wave >> 1;
#pragma unroll 1
    for (int i = 0; i < 2; ++i) { const int tt = 2 * (wave & 1) + i, t = tt * 16 + fr;
#pragma unroll
        for (int st = 0; st < 4; ++st) { f32x4 acc = {0.f, 0.f, 0.f, 0.f}; acc = mm16(QD + tt * 16 * 272 + hh * 64, 272, KI + st * 16 * 272 + hh * 64, 272, 32, acc, fr, fq);
            const int s0 = st * 16 + 4 * fq;
            lds_st_bf16x4(ATT + hh * 9216 + t * 144 + s0 * 2, t >= s0 ? acc[0] : 0.f, t >= s0 + 1 ? acc[1] : 0.f, t >= s0 + 2 ? acc[2] : 0.f, t >= s0 + 3 ? acc[3] : 0.f); } }
    __syncthreads();
    { bf16* mix = WSP(bf16, WS_MIX); const float* ng = KIN(I_GNG) + layer * 256;
#pragma unroll 1
      for (int i = 0; i < 2; ++i) { const int tt = 2 * (wave & 1) + i, t = tt * 16 + fr; f32x4 ov[4]; float ss = 0.f;
#pragma unroll
          for (int vt = 0; vt < 4; ++vt) { f32x4 acc = {0.f, 0.f, 0.f, 0.f};
              acc = mm16(ATT + hh * 9216 + tt * 16 * 144, 144, VT + (hh * 64 + vt * 16) * 144, 144, 64, acc, fr, fq);
              acc = mm16(QD + tt * 16 * 272 + hh * 64, 272, PVT + (hh * 64 + vt * 16) * 80, 80, 32, acc, fr, fq);
              ov[vt] = acc; ss += (acc.x * acc.x + acc.y * acc.y) + (acc.z * acc.z + acc.w * acc.w); }
          ss += __shfl_xor(ss, 16); ss += __shfl_xor(ss, 32);
          const float r = __builtin_amdgcn_rsqf(ss * (1.f / 64.f) + NORM_EPS);
#pragma unroll
          for (int vt = 0; vt < 4; ++vt) { const int col = hh * 64 + vt * 16 + 4 * fq; const f32x4 g = *(const f32x4*)(ng + col); const f32x4 og = UU4(t0 + t, U_GL_OG + col);
              MIX_ST4(mix, (size_t)(t0 + t) * D + 512 + col, ov[vt].x * r * g.x * siluf_(og.x), ov[vt].y * r * g.y * siluf_(og.y), ov[vt].z * r * g.z * siluf_(og.z), ov[vt].w * r * g.w * siluf_(og.w)); } } }
    __syncthreads();
}

__device__ __forceinline__ void mlstm_stage1(Frame& F, const Args& A, int layer, int b, int c) {
    const bf16* u = WSP(bf16, WS_U);
    LAS unsigned char* L = F.lds;
    LAS float* WST = (LAS float*)L; LAS unsigned char* KT = L + 1024; LAS unsigned char* VWT = KT + 256 * 144;
    const int t0 = b * SEQ + c * 64, tid = F.tid, lane = F.lane, wave = F.wave, fr = lane & 15, fq = lane >> 4;
    if (wave < 4) {
        const int hh = wave;
        const float ig = UU(t0 + lane, U_ML_I + hh) + KIN(I_MIB)[layer * 4 + hh];
        const float lf = logsigmoidf_(UU(t0 + lane, U_ML_F + hh) + KIN(I_MFB)[layer * 4 + hh]);
        const float bc = wave_scan_add(lf, lane); const float blast = __shfl(bc, 63);
        const float ast = blast - bc + ig; const float mloc = wave_max(ast);
        WST[hh * 64 + lane] = __expf(ast - mloc);
        if (lane == 0) { WSP(float, WS_ML_BL)[(b * 4 + hh) * NCH + c] = blast; WSP(float, WS_ML_ML)[(b * 4 + hh) * NCH + c] = mloc; }
    } else {
        const int kch = tid - 256, cc = 256 + kch; const float* cw = KIN(I_MCW) + (size_t)layer * 2048 + cc; const float w0 = cw[0], w1 = cw[512], w2 = cw[1024], w3 = cw[1536], cb = KIN(I_MCB)[layer * 512 + cc];
        const bf16* up = u + (size_t)t0 * NUP + U_ML_K + kch;
        float win0 = 0.f, win1 = 0.f, win2 = 0.f;
        if (c > 0) { win0 = bf2f(up[-3 * NUP]); win1 = bf2f(up[-2 * NUP]); win2 = bf2f(up[-1 * NUP]); }
#pragma unroll 1
        for (int l0 = 0; l0 < 64; l0 += 32) { float xv[32];
#pragma unroll
            for (int j = 0; j < 32; ++j) xv[j] = bf2f(up[(l0 + j) * NUP]);
#pragma unroll
            for (int j8 = 0; j8 < 4; ++j8) { float o[8];
#pragma unroll
                for (int j = 0; j < 8; ++j) { const float x = xv[j8 * 8 + j]; const float y = cb + w0 * win0 + w1 * win1 + w2 * win2 + w3 * x; win0 = win1; win1 = win2; win2 = x; o[j] = siluf_(y); }
                *(LAS v4u*)(KT + kch * 144 + (l0 + j8 * 8) * 2) = pack8(o); } }
    }
    __syncthreads();
    if (tid < 256) {
        const int vch = tid, hh = vch >> 6; const bf16* up = u + (size_t)t0 * NUP + U_ML_V + vch;
#pragma unroll 1
        for (int l0 = 0; l0 < 64; l0 += 32) { float xv[32];
#pragma unroll
            for (int j = 0; j < 32; ++j) xv[j] = bf2f(up[(l0 + j) * NUP]);
#pragma unroll
            for (int j8 = 0; j8 < 4; ++j8) { float o[8];
#pragma unroll
                for (int j = 0; j < 8; ++j) o[j] = xv[j8 * 8 + j] * WST[hh * 64 + l0 + j8 * 8 + j];
                *(LAS v4u*)(VWT + vch * 144 + (l0 + j8 * 8) * 2) = pack8(o); } }
    } else {
        const int kch = tid - 256, hh = kch >> 6; float n = 0.f;
#pragma unroll 8
        for (int s = 0; s < 64; ++s) n += WST[hh * 64 + s] * bf2f(*(const LAS unsigned short*)(KT + kch * 144 + s * 2));
        WSP(bf16, WS_ML_N)[((size_t)(b * 4 + hh) * NCH + c) * 64 + (kch & 63)] = (bf16)(cvt_pk_bf16(n, 0.f) & 0xffffu);
    }
    __syncthreads();
    { bf16* cst = WSP(bf16, WS_ML_C); const int hh = wave >> 1;
#pragma unroll 1
      for (int i = 0; i < 2; ++i) { const int vt = 2 * (wave & 1) + i;
#pragma unroll 1
          for (int kt = 0; kt < 4; ++kt) { f32x4 acc = {0.f, 0.f, 0.f, 0.f}; acc = mm16(VWT + (hh * 64 + vt * 16) * 144, 144, KT + (hh * 64 + kt * 16) * 144, 144, 64, acc, fr, fq);
              stb4(cst + (((size_t)(b * 4 + hh) * NCH + c) * 64 + vt * 16 + fr) * 64 + kt * 16 + 4 * fq, acc); } } }
    __syncthreads();
}
__device__ __forceinline__ void mlstm_stage3(Frame& F, const Args& A, int layer, int b, int c) {
    const bf16* u = WSP(bf16, WS_U);
    LAS unsigned char* L = F.lds;
    LAS float* BCU = (LAS float*)L; LAS float* GG = BCU + 256; LAS float* MROW = BCU + 512; LAS float* WINT = BCU + 768; LAS float* NPV = BCU + 1024;
    LAS unsigned char* Q = L + 6144; LAS unsigned char* KK = Q + 64 * 528; LAS unsigned char* VT = KK + 64 * 528; LAS unsigned char* SC = VT + 256 * 144;
    const int t0 = b * SEQ + c * 64, tid = F.tid, lane = F.lane, wave = F.wave, fr = lane & 15, fq = lane >> 4;
    if (wave < 4) {
        const int hh = wave;
        const float ig = UU(t0 + lane, U_ML_I + hh) + KIN(I_MIB)[layer * 4 + hh];
        const float lf = logsigmoidf_(UU(t0 + lane, U_ML_F + hh) + KIN(I_MFB)[layer * 4 + hh]);
        const float bc = wave_scan_add(lf, lane); const float gg = ig - bc;
        const float mprev = WSP(float, WS_ML_M)[(b * 4 + hh) * NCH + c];
        const float minter = bc + mprev, mintra = bc + wave_scan_max(gg, lane), mrow = fmaxf(minter, mintra);
        BCU[hh * 64 + lane] = bc; GG[hh * 64 + lane] = gg; MROW[hh * 64 + lane] = mrow; WINT[hh * 64 + lane] = __expf(minter - mrow);
        NPV[hh * 64 + lane] = bf2f(WSP(bf16, WS_ML_N)[((size_t)(b * 4 + hh) * NCH + c) * 64 + lane]);
    }
    {
        const int cc = tid; const float* cw = KIN(I_MCW) + (size_t)layer * 2048 + cc; const float w0 = cw[0], w1 = cw[512], w2 = cw[1024], w3 = cw[1536], cb = KIN(I_MCB)[layer * 512 + cc];
        const bf16* up = u + (size_t)t0 * NUP + U_ML_Q + cc;
        float win0 = 0.f, win1 = 0.f, win2 = 0.f;
        if (c > 0) { win0 = bf2f(up[-3 * NUP]); win1 = bf2f(up[-2 * NUP]); win2 = bf2f(up[-1 * NUP]); }
        LAS unsigned char* dst = cc < 256 ? Q + cc * 2 : KK + (cc - 256) * 2; const float sc = cc < 256 ? 0.125f : 1.0f;
#pragma unroll 1
        for (int l0 = 0; l0 < 64; l0 += 32) { float xv[32];
#pragma unroll
            for (int j = 0; j < 32; ++j) xv[j] = bf2f(up[(l0 + j) * NUP]);
#pragma unroll
            for (int j = 0; j < 32; ++j) { const float x = xv[j]; const float y = cb + w0 * win0 + w1 * win1 + w2 * win2 + w3 * x; win0 = win1; win1 = win2; win2 = x; lds_st_bf16(dst + (l0 + j) * 528, siluf_(y) * sc); } }
        const int vch = tid & 255, lh = (tid >> 8) * 32; const bf16* uv = u + (size_t)(t0 + lh) * NUP + U_ML_V + vch;
        float xv[32];
#pragma unroll
        for (int j = 0; j < 32; ++j) xv[j] = bf2f(uv[j * NUP]);
#pragma unroll
        for (int j8 = 0; j8 < 4; ++j8) { float o[8];
#pragma unroll
            for (int j = 0; j < 8; ++j) o[j] = xv[j8 * 8 + j];
            *(LAS v4u*)(VT + vch * 144 + (lh + j8 * 8) * 2) = pack8(o); }
    }
    __syncthreads();
    { const int hh = wave >> 1; bf16* mix = WSP(bf16, WS_MIX); const float* ng = KIN(I_MNG) + layer * 256;
      const bf16* cprev = WSP(bf16, WS_ML_C) + ((size_t)(b * 4 + hh) * NCH + c) * 4096;
      bf16x8 cf[4][2];
#pragma unroll
      for (int vt = 0; vt < 4; ++vt)
#pragma unroll
          for (int ks = 0; ks < 2; ++ks) cf[vt][ks] = *(const bf16x8*)(cprev + (size_t)(vt * 16 + fr) * 64 + ks * 32 + fq * 8);
#pragma unroll 1
      for (int i = 0; i < 2; ++i) { const int tt = 2 * (wave & 1) + i, t = tt * 16 + fr;
          const float bt = BCU[hh * 64 + t] - MROW[hh * 64 + t]; float rs = 0.f;
#pragma unroll
          for (int st = 0; st < 4; ++st) { f32x4 acc = {0.f, 0.f, 0.f, 0.f}; acc = mm16(Q + tt * 16 * 528 + hh * 128, 528, KK + st * 16 * 528 + hh * 128, 528, 64, acc, fr, fq);
              const int s0 = st * 16 + 4 * fq; float o[4];
#pragma unroll
              for (int j = 0; j < 4; ++j) { const int s = s0 + j; const float v = (t >= s) ? acc[j] * __expf(bt + GG[hh * 64 + s]) : 0.f; o[j] = v; rs += v; }
              lds_st_bf16x4(SC + hh * 9216 + t * 144 + s0 * 2, o[0], o[1], o[2], o[3]); }
          rs += __shfl_xor(rs, 16); rs += __shfl_xor(rs, 32);
          float nq = 0.f;
#pragma unroll
          for (int j = 0; j < 16; ++j) nq += bf2f(*(const LAS unsigned short*)(Q + t * 528 + (hh * 64 + fq * 16 + j) * 2)) * NPV[hh * 64 + fq * 16 + j];
          nq += __shfl_xor(nq, 16); nq += __shfl_xor(nq, 32);
          const float wi = WINT[hh * 64 + t]; const float den = wi * nq + rs; const float dn = fmaxf(fabsf(den), __expf(-MROW[hh * 64 + t])); const float rdn = 1.0f / dn;
          LDS_WAIT();
          f32x4 hv[4]; float sm = 0.f;
#pragma unroll
          for (int vt = 0; vt < 4; ++vt) { f32x4 acc = {0.f, 0.f, 0.f, 0.f};
              acc = mm16_rB<2>(Q + tt * 16 * 528 + hh * 128, 528, cf[vt], acc, fr, fq);
              acc = acc * wi;
              acc = mm16(SC + hh * 9216 + tt * 16 * 144, 144, VT + (hh * 64 + vt * 16) * 144, 144, 64, acc, fr, fq);
              const f32x4 og = UU4(t0 + t, U_ML_O + hh * 64 + vt * 16 + 4 * fq);
              f32x4 h; h.x = acc.x * rdn * sigmoidf_(og.x); h.y = acc.y * rdn * sigmoidf_(og.y); h.z = acc.z * rdn * sigmoidf_(og.z); h.w = acc.w * rdn * sigmoidf_(og.w);
              hv[vt] = h; sm += (h.x + h.y) + (h.z + h.w); }
          sm += __shfl_xor(sm, 16); sm += __shfl_xor(sm, 32);
          const float mean = sm * (1.f / 64.f); float sq = 0.f;
#pragma unroll
          for (int vt = 0; vt < 4; ++vt) { hv[vt] = hv[vt] - mean; sq += (hv[vt].x * hv[vt].x + hv[vt].y * hv[vt].y) + (hv[vt].z * hv[vt].z + hv[vt].w * hv[vt].w); }
          sq += __shfl_xor(sq, 16); sq += __shfl_xor(sq, 32);
          const float r = __builtin_amdgcn_rsqf(sq * (1.f / 64.f) + NORM_EPS);
#pragma unroll
          for (int vt = 0; vt < 4; ++vt) { const int col = hh * 64 + vt * 16 + 4 * fq; const f32x4 g = *(const f32x4*)(ng + col);
              MIX_ST4(mix, (size_t)(t0 + t) * D + 768 + col, hv[vt].x * r * g.x, hv[vt].y * r * g.y, hv[vt].z * r * g.z, hv[vt].w * r * g.w); } } }
    __syncthreads();
}

__device__ __forceinline__ void rwkv_stage1(Frame& F, const Args& A, int layer, int ub) {
    const bf16* u = WSP(bf16, WS_U);
    LAS unsigned char* L = F.lds;
    LAS unsigned char* LOWA = L;
    LAS float* CUM = (LAS float*)(L + 16384);
    LAS float* AAB = CUM;
    LAS float* TOT = CUM;
    LAS unsigned char* M0 = L + 16384 + 16640;
#define RM(i) (M0 + (i) * 9216)
    LAS float* GAMC = (LAS float*)(F.MISC + MW_GAMC);
    const int t0 = ub * 64, c = ub & 63, tid = F.tid, lane = F.lane, wave = F.wave;
    const float* mu = KIN(I_RMU) + layer * 896;
#ifndef RW_DUP
#define RW_DUP -1
#endif
#define RW_REP(k) for (int rep__ = 0; rep__ < ((RW_DUP == (k)) ? 2 : 1); ++rep__)
    RW_REP(0) {
    {
        const int l = tid >> 3, jq = tid & 7, t = t0 + l; const bool has_prev = (t & (SEQ - 1)) != 0;
        f32x4 cur[4], prv[4];
#pragma unroll
        for (int q = 0; q < 4; ++q) { cur[q] = UU4(t, U_RW_LO + jq * 16 + 4 * q); prv[q] = has_prev ? UU4(t - 1, U_RW_LO + jq * 16 + 4 * q) : (f32x4){0.f, 0.f, 0.f, 0.f}; }
#pragma unroll
        for (int q = 0; q < 4; ++q) { const f32x4 m4 = *(const f32x4*)(mu + 768 + jq * 16 + 4 * q); const f32x4 xs = cur[q] + (prv[q] - cur[q]) * m4; const int j = jq * 16 + 4 * q;
            f32x4 o;
            if (j < 32) { o.x = tanhf_(xs.x); o.y = tanhf_(xs.y); o.z = tanhf_(xs.z); o.w = tanhf_(xs.w); } else if (j < 64) o = xs; else { o.x = sigmoidf_(xs.x); o.y = sigmoidf_(xs.y); o.z = sigmoidf_(xs.z); o.w = sigmoidf_(xs.w); }
            if (j < 64) lds_st_bf16x4(LOWA + l * 144 + j * 2, o.x, o.y, o.z, o.w); else lds_st_bf16x4(RM(0) + l * 144 + (j - 64) * 2, o.x, o.y, o.z, o.w); }
    }
    __syncthreads();
    {
        bf16* RG = WSP(bf16, WS_RW_G); const int lane_ = F.lane, fr_ = lane_ & 15, fq_ = lane_ >> 4;
        const float* gupT = WSP(float, WS_LORA) + (size_t)layer * LORA_PER_LAYER + 16384;
#pragma unroll
        for (int ci = 0; ci < 2; ++ci) { const int ct = 2 * wave + ci; bf16x8 bf[2];
#pragma unroll
            for (int ks = 0; ks < 2; ++ks) bf[ks] = ldfrag_f32(gupT + (size_t)(ct * 16 + fr_) * 64 + ks * 32 + fq_ * 8);
#pragma unroll
            for (int tt = 0; tt < 4; ++tt) { f32x4 acc = {0.f, 0.f, 0.f, 0.f}; acc = mm16_rB<2>(RM(0) + tt * 16 * 144, 144, bf, acc, fr_, fq_);
                stb4(RG + (size_t)(t0 + tt * 16 + fr_) * 256 + ct * 16 + 4 * fq_, acc); } }
    }
    __syncthreads();
    }
    const int b_ = ub >> 6;
#pragma unroll 1
    for (int hh = 0; hh < 4; ++hh) {
        int ch = lane, fr = lane & 15, fq = lane >> 4; asm volatile("" : "+v"(ch), "+v"(fr), "+v"(fq));
        const int tg = wave, cg = hh * 64 + ch; const size_t un = (size_t)(b_ * 4 + hh) * NCH + c;
        float rr[8], k2r[8], vr[8], ar[8], br[8], pl[8];
        LAS float* WPA = (LAS float*)RM(8);
        {
            const int mat = wave >> 2, ct = wave & 3;
            const float* wT = WSP(float, WS_LORA) + (size_t)layer * LORA_PER_LAYER + mat * 8192 + (size_t)(hh * 64 + ct * 16 + fr) * 32 + fq * 8;
            bf16x8 bfw[1]; bfw[0] = ldfrag_f32(wT);
#pragma unroll
            for (int tt = 0; tt < 4; ++tt) { f32x4 acc = {0.f, 0.f, 0.f, 0.f}; acc = mm16_rB<1>(LOWA + tt * 16 * 144 + mat * 64, 144, bfw, acc, fr, fq);
                *(LAS f32x4*)(WPA + mat * 4096 + (tt * 16 + fr) * 64 + ct * 16 + 4 * fq) = acc; }
        }
        __syncthreads();
        RW_REP(1) {
            const float w0 = KIN(I_RW0)[layer * 256 + cg], a0 = KIN(I_RA0)[layer * 256 + cg], kkc = KIN(I_RKK)[layer * 256 + cg], kac = KIN(I_RKA)[layer * 256 + cg];
            const float mur = mu[cg], muk = mu[256 + cg], muv = mu[512 + cg];
            const int tb = t0 + tg * 8; const bool nop = (c == 0) && (tg == 0);
            float rp = nop ? 0.f : UU(tb - 1, U_RW_R + cg), kp = nop ? 0.f : UU(tb - 1, U_RW_K + cg), vp = nop ? 0.f : UU(tb - 1, U_RW_V + cg);
            float rc[8], kc[8], vc[8];
#pragma unroll
            for (int j = 0; j < 8; ++j) { rc[j] = UU(tb + j, U_RW_R + cg); kc[j] = UU(tb + j, U_RW_K + cg); vc[j] = UU(tb + j, U_RW_V + cg); }
            bf16* RW = WSP(bf16, WS_RW);
            float kk[8], al[8], n2[8], run = 0.f;
#pragma unroll
            for (int j = 0; j < 8; ++j) { const int l = tg * 8 + j;
                const float r = rc[j] + (rp - rc[j]) * mur, k = kc[j] + (kp - kc[j]) * muk, v = vc[j] + (vp - vc[j]) * muv; rp = rc[j]; kp = kc[j]; vp = vc[j];
                const float wp = w0 + WPA[l * 64 + ch], ap = a0 + WPA[4096 + l * 64 + ch];
                const float w = -softplusf_(-wp) - 0.5f; run += -__expf(w); pl[j] = run; al[j] = sigmoidf_(ap);
                kk[j] = k * kkc; n2[j] = kk[j] * kk[j];
                k2r[j] = k * (1.0f + (al[j] - 1.0f) * kac); rr[j] = r; vr[j] = v;
                bf16* o = RW + (size_t)(tb + j) * 768 + cg; o[0] = (bf16)(cvt_pk_bf16(r, 0.f) & 0xffffu); o[256] = (bf16)(cvt_pk_bf16(k2r[j], 0.f) & 0xffffu); o[512] = (bf16)(cvt_pk_bf16(v, 0.f) & 0xffffu); }
#pragma unroll
            for (int i = 0; i < 4; ++i) { const bool hi = (ch & 32) != 0; const float keep = hi ? n2[i + 4] : n2[i], send = hi ? n2[i] : n2[i + 4]; n2[i] = keep + __shfl_xor(send, 32); }
#pragma unroll
            for (int i = 0; i < 2; ++i) { const bool hi = (ch & 16) != 0; const float keep = hi ? n2[i + 2] : n2[i], send = hi ? n2[i] : n2[i + 2]; n2[i] = keep + __shfl_xor(send, 16); }
            { const bool hi = (ch & 8) != 0; const float keep = hi ? n2[1] : n2[0], send = hi ? n2[0] : n2[1]; n2[0] = keep + __shfl_xor(send, 8); }
            n2[0] += __shfl_xor(n2[0], 4); n2[0] += __shfl_xor(n2[0], 2); n2[0] += __shfl_xor(n2[0], 1);
#pragma unroll
            for (int j = 0; j < 8; ++j) { const float tot = __builtin_bit_cast(float, __builtin_amdgcn_readlane(__builtin_bit_cast(int, n2[0]), ((j & 4) ? 32 : 0) + ((j & 2) ? 16 : 0) + ((j & 1) ? 8 : 0)));
                const float kkn = kk[j] / fmaxf(sqrtf(tot), 1e-12f); ar[j] = -kkn; br[j] = kkn * al[j]; }
            TOT[tg * 64 + ch] = run;
        }
        __syncthreads();
        RW_REP(3) {
            float off = 0.f, gC = 0.f;
#pragma unroll
            for (int g = 0; g < 8; ++g) { const float tv = TOT[g * 64 + ch]; gC += tv; if (g < tg) off += tv; }
            float oat[8], obb[8], okb[8], ov[8];
#pragma unroll
            for (int j = 0; j < 8; ++j) { const int l = tg * 8 + j; const float gt = off + pl[j], gm = j > 0 ? off + pl[j - 1] : off;
                const float at = ar[j] * __expf(gm), rt = rr[j] * __expf(gt), en = __expf(-gt), ec = __expf(gC - gt);
                lds_st_bf16(RM(0) + l * 144 + ch * 2, at); lds_st_bf16(RM(1) + l * 144 + ch * 2, rt); lds_st_bf16(RM(2) + l * 144 + ch * 2, br[j] * en); lds_st_bf16(RM(3) + l * 144 + ch * 2, k2r[j] * en);
                oat[j] = at; obb[j] = br[j] * ec; okb[j] = k2r[j] * ec; ov[j] = vr[j]; }
            *(LAS v4u*)(RM(4) + ch * 144 + tg * 16) = pack8(oat); *(LAS v4u*)(RM(5) + ch * 144 + tg * 16) = pack8(obb); *(LAS v4u*)(RM(6) + ch * 144 + tg * 16) = pack8(okb); *(LAS v4u*)(RM(7) + ch * 144 + tg * 16) = pack8(ov);
            if (tg == 0) GAMC[ch] = __expf(gC);
        }
        __syncthreads();
        RW_REP(4) {
            const int which = wave >> 1; const LAS unsigned char* Aop = which < 2 ? RM(0) : RM(1); const LAS unsigned char* Bop = (which & 1) ? RM(3) : RM(2);
#pragma unroll 1
            for (int i2 = 0; i2 < 2; ++i2) { const int tt = 2 * (wave & 1) + i2, t = tt * 16 + fr;
#pragma unroll
                for (int it = 0; it < 4; ++it) { f32x4 acc = {0.f, 0.f, 0.f, 0.f}; acc = mm16(Aop + tt * 16 * 144, 144, Bop + it * 16 * 144, 144, 64, acc, fr, fq);
                    const int i0 = it * 16 + 4 * fq; const int lim = which < 2 ? t : t + 1;
                    const float o0 = (i0 < lim) ? acc[0] : 0.f, o1 = (i0 + 1 < lim) ? acc[1] : 0.f, o2 = (i0 + 2 < lim) ? acc[2] : 0.f, o3 = (i0 + 3 < lim) ? acc[3] : 0.f;
#ifdef RW_CLAMP_AAK
                    float q0 = o0, q1 = o1, q2 = o2, q3 = o3;
                    if (which == 1) { q0 = fabsf(o0) < 1e30f ? o0 : 0.f; q1 = fabsf(o1) < 1e30f ? o1 : 0.f; q2 = fabsf(o2) < 1e30f ? o2 : 0.f; q3 = fabsf(o3) < 1e30f ? o3 : 0.f; }
                    if (which == 0) *(LAS f32x4*)(AAB + t * 64 + i0) = (f32x4){o0, o1, o2, o3};
                    else lds_st_bf16x4(RM(7 + which) + t * 144 + i0 * 2, q0, q1, q2, q3);
                    continue;
#endif
                    if (which == 0) { DBG_STAT(11, o0); DBG_STAT(11, o1); DBG_STAT(11, o2); DBG_STAT(11, o3); } if (which == 1) { DBG_STAT(12, o0); DBG_STAT(12, o1); DBG_STAT(12, o2); DBG_STAT(12, o3); } if (which == 2) { DBG_STAT(13, o0); DBG_STAT(13, o3); } if (which == 3) { DBG_STAT(14, o0); DBG_STAT(14, o3); }
                    if (which == 0) *(LAS f32x4*)(AAB + t * 64 + i0) = (f32x4){o0, o1, o2, o3};
                    else lds_st_bf16x4(RM(7 + which) + t * 144 + i0 * 2, o0, o1, o2, o3); } }
        }
        __syncthreads();
        RW_REP(5) {
#pragma unroll 1
            for (int i2 = 0; i2 < 2; ++i2) { const int idx = wave * 2 + i2, vt = idx >> 2, tt = idx & 3; f32x4 acc = {0.f, 0.f, 0.f, 0.f};
                acc = mm16(RM(7) + vt * 16 * 144, 144, RM(8) + tt * 16 * 144, 144, 64, acc, fr, fq);
                DBG_STAT(15, acc[0]); DBG_STAT(15, acc[1]); DBG_STAT(15, acc[2]); DBG_STAT(15, acc[3]);
                lds_st_bf16x4(RM(0) + (vt * 16 + fr) * 144 + (tt * 16 + 4 * fq) * 2, acc[0], acc[1], acc[2], acc[3]); }
        }
        RW_REP(8) if (wave == 0) {
            float x[64]; f32x4 rowq[16];
#pragma unroll
            for (int t = 0; t < 64; ++t) {
                f32x4 cur[16];
#pragma unroll
                for (int i4 = 0; i4 < (t + 3) / 4; ++i4) cur[i4] = rowq[i4];
                if (t + 1 < 64) {
#pragma unroll
                    for (int i4 = 0; i4 < (t + 4) / 4; ++i4) rowq[i4] = *(const LAS f32x4*)(AAB + (t + 1) * 64 + 4 * i4); }
                float a0 = (t == ch) ? 1.0f : 0.f, a1 = 0.f, a2 = 0.f, a3 = 0.f;
#pragma unroll
                for (int i4 = 0; i4 < (t + 3) / 4; ++i4) { const f32x4 q = cur[i4];
                    a0 += q.x * x[4 * i4]; if (4 * i4 + 1 < t) a1 += q.y * x[4 * i4 + 1]; if (4 * i4 + 2 < t) a2 += q.z * x[4 * i4 + 2]; if (4 * i4 + 3 < t) a3 += q.w * x[4 * i4 + 3]; }
                const float acc = (a0 + a1) + (a2 + a3);
                x[t] = acc; lds_st_bf16(RM(11) + t * 144 + ch * 2, acc); }
        }
        __syncthreads();
        RW_REP(6) {
            const int rt = wave >> 1;
#pragma unroll
            for (int i2 = 0; i2 < 2; ++i2) { const int tt = 2 * (wave & 1) + i2;
                f32x4 acc = {0.f, 0.f, 0.f, 0.f}; acc = mm16(RM(4) + rt * 16 * 144, 144, RM(11) + tt * 16 * 144, 144, 64, acc, fr, fq);
                DBG_STAT(17, acc[0]); DBG_STAT(17, acc[1]); DBG_STAT(17, acc[2]); DBG_STAT(17, acc[3]);
                lds_st_bf16x4(RM(2) + (rt * 16 + fr) * 144 + (tt * 16 + 4 * fq) * 2, acc[0], acc[1], acc[2], acc[3]);
                f32x4 ac2 = {0.f, 0.f, 0.f, 0.f}; ac2 = mm16(RM(0) + rt * 16 * 144, 144, RM(11) + tt * 16 * 144, 144, 64, ac2, fr, fq);
                DBG_STAT(18, ac2[0]); DBG_STAT(18, ac2[1]); DBG_STAT(18, ac2[2]); DBG_STAT(18, ac2[3]);
                lds_st_bf16x4(RM(3) + (rt * 16 + fr) * 144 + (tt * 16 + 4 * fq) * 2, ac2[0], ac2[1], ac2[2], ac2[3]); }
        }
        __syncthreads();
        RW_REP(7) {
            const int which = wave >> 1;
#pragma unroll 1
            for (int i2 = 0; i2 < 2; ++i2) { const int rt = 2 * (wave & 1) + i2, row = rt * 16 + fr;
#pragma unroll
                for (int ct = 0; ct < 4; ++ct) { f32x4 acc = {0.f, 0.f, 0.f, 0.f}; const int c0 = ct * 16 + 4 * fq;
                    if (which == 0) { acc = mm16(RM(9) + rt * 16 * 144, 144, RM(2) + ct * 16 * 144, 144, 64, acc, fr, fq);
                        const v2u rw = *(const LAS v2u*)(RM(1) + row * 144 + c0 * 2);
                        acc[0] += __uint_as_float(rw.x << 16); acc[1] += __uint_as_float(rw.x & 0xffff0000u); acc[2] += __uint_as_float(rw.y << 16); acc[3] += __uint_as_float(rw.y & 0xffff0000u);
                        DBG_STAT(19, acc[0]); DBG_STAT(19, acc[1]); DBG_STAT(19, acc[2]); DBG_STAT(19, acc[3]);
                        v2u o; o.x = cvt_pk_bf16(acc[0], acc[1]); o.y = cvt_pk_bf16(acc[2], acc[3]); *(v2u*)(WSP(bf16, WS_RW_RH) + un * 4096 + row * 64 + c0) = o; }
                    else if (which == 1) {
#ifndef RW_NO_U0
                        acc = mm16(RM(9) + rt * 16 * 144, 144, RM(3) + ct * 16 * 144, 144, 64, acc, fr, fq);
#endif
                        acc = mm16(RM(10) + rt * 16 * 144, 144, RM(7) + ct * 16 * 144, 144, 64, acc, fr, fq);
                        DBG_STAT(20, acc[0]); DBG_STAT(20, acc[1]); DBG_STAT(20, acc[2]); DBG_STAT(20, acc[3]);
                        stb4(WSP(bf16, WS_RW_O0) + un * 4096 + row * 64 + c0, acc); }
                    else if (which == 2) { acc = mm16(RM(5) + rt * 16 * 144, 144, RM(2) + ct * 16 * 144, 144, 64, acc, fr, fq);
                        const float gd = GAMC[row]; if (row == c0) acc[0] += gd; if (row == c0 + 1) acc[1] += gd; if (row == c0 + 2) acc[2] += gd; if (row == c0 + 3) acc[3] += gd;
                        DBG_STAT(21, acc[0]); DBG_STAT(21, acc[1]); DBG_STAT(21, acc[2]); DBG_STAT(21, acc[3]);
                        v2u o; o.x = cvt_pk_bf16(acc[0], acc[1]); o.y = cvt_pk_bf16(acc[2], acc[3]);
                        *(v2u*)((unsigned char*)(WSP(bf16, WS_RW_GF) + un * 4096) + ((rt * 2 + (ct >> 1)) * 64 + ch) * 16 + (ct & 1) * 8) = o; }
                    else { acc = mm16(RM(3) + rt * 16 * 144, 144, RM(5) + ct * 16 * 144, 144, 64, acc, fr, fq); acc = mm16(RM(7) + rt * 16 * 144, 144, RM(6) + ct * 16 * 144, 144, 64, acc, fr, fq);
                        DBG_STAT(22, acc[0]); DBG_STAT(22, acc[1]); DBG_STAT(22, acc[2]); DBG_STAT(22, acc[3]);
                        *(f32x4*)(WSP(float, WS_RW_HT) + un * 4096 + row * 64 + c0) = acc; } } }
        }
        __syncthreads();
    }
#undef RM
}
__device__ __forceinline__ void rwkv_scan_wave(Frame& F, const Args& A, int wslot) {
    const int lane = F.lane, fr = lane & 15, fq = lane >> 4, bh = wslot >> 2, v0 = (wslot & 3) * 16;
    const bf16* GF = WSP(bf16, WS_RW_GF) + (size_t)bh * NCH * 4096; const float* HT = WSP(float, WS_RW_HT) + (size_t)bh * NCH * 4096 + (size_t)(v0 + fr) * 64 + 4 * fq;
    bf16* PT = WSP(bf16, WS_RW_PT) + (size_t)bh * NCH * 4096 + (size_t)(v0 + fr) * 64 + 4 * fq;
    f32x4 P[4] = {{0.f, 0.f, 0.f, 0.f}, {0.f, 0.f, 0.f, 0.f}, {0.f, 0.f, 0.f, 0.f}, {0.f, 0.f, 0.f, 0.f}};
    bf16x8 g0[4][2], g1[4][2], g2[4][2]; f32x4 h0[4], h1[4], h2[4];
#define RW2_LOAD(gx, hx, cc) do { _Pragma("unroll") for (int m = 0; m < 4; ++m) { hx[m] = *(const f32x4*)(HT + (size_t)(cc) * 4096 + 16 * m); \
        _Pragma("unroll") for (int s = 0; s < 2; ++s) gx[m][s] = *(const bf16x8*)(GF + (size_t)(cc) * 4096 + ((m * 2 + s) * 64 + lane) * 8); } } while (0)
#define RW2_STEP(gx, hx, cc) do { v4u bs[2]; \
        _Pragma("unroll") for (int s = 0; s < 2; ++s) { bs[s].x = cvt_pk_bf16(P[2 * s][0], P[2 * s][1]); bs[s].y = cvt_pk_bf16(P[2 * s][2], P[2 * s][3]); bs[s].z = cvt_pk_bf16(P[2 * s + 1][0], P[2 * s + 1][1]); bs[s].w = cvt_pk_bf16(P[2 * s + 1][2], P[2 * s + 1][3]); } \
        *(v2u*)(PT + (size_t)(cc) * 4096) = (v2u){bs[0].x, bs[0].y}; *(v2u*)(PT + (size_t)(cc) * 4096 + 16) = (v2u){bs[0].z, bs[0].w}; \
        *(v2u*)(PT + (size_t)(cc) * 4096 + 32) = (v2u){bs[1].x, bs[1].y}; *(v2u*)(PT + (size_t)(cc) * 4096 + 48) = (v2u){bs[1].z, bs[1].w}; \
        _Pragma("unroll") for (int m = 0; m < 4; ++m) { f32x4 acc = hx[m]; acc = __builtin_amdgcn_mfma_f32_16x16x32_bf16(gx[m][0], __builtin_bit_cast(bf16x8, bs[0]), acc, 0, 0, 0); \
            acc = __builtin_amdgcn_mfma_f32_16x16x32_bf16(gx[m][1], __builtin_bit_cast(bf16x8, bs[1]), acc, 0, 0, 0); P[m] = acc; } } while (0)
    RW2_LOAD(g0, h0, 0); RW2_LOAD(g1, h1, 1);
#pragma unroll 1
    for (int c = 0; c < 63; c += 3) {
        RW2_LOAD(g2, h2, c + 2); RW2_STEP(g0, h0, c);
        RW2_LOAD(g0, h0, c + 3); RW2_STEP(g1, h1, c + 1);
        if (c + 4 < NCH) RW2_LOAD(g1, h1, c + 4);
        RW2_STEP(g2, h2, c + 2);
    }
    RW2_STEP(g0, h0, 63);
#undef RW2_LOAD
#undef RW2_STEP
}
__device__ __forceinline__ void rwkv_stage3(Frame& F, const Args& A, int layer, int ub) {
    const int t0 = ub * 64, b_ = ub >> 6, c = ub & 63, lane = F.lane, wave = F.wave, fr = lane & 15, fq = lane >> 4, hh = wave >> 1;
    const size_t un = (size_t)(b_ * 4 + hh) * NCH + c;
    const bf16* RH = WSP(bf16, WS_RW_RH) + un * 4096; const bf16* PT = WSP(bf16, WS_RW_PT) + un * 4096; const bf16* O0 = WSP(bf16, WS_RW_O0) + un * 4096;
    const bf16* RW = WSP(bf16, WS_RW); const bf16* RG = WSP(bf16, WS_RW_G); bf16* mix = WSP(bf16, WS_MIX);
    const float* lg = KIN(I_RLNG) + layer * 256 + hh * 64; const float* lb = KIN(I_RLNB) + layer * 256 + hh * 64; const float* rk = KIN(I_RRK) + layer * 256 + hh * 64;
    bf16x8 pfr[4][2];
#pragma unroll
    for (int vt = 0; vt < 4; ++vt)
#pragma unroll
        for (int ks = 0; ks < 2; ++ks) pfr[vt][ks] = *(const bf16x8*)(PT + (size_t)(vt * 16 + fr) * 64 + ks * 32 + fq * 8);
#pragma unroll 1
    for (int i = 0; i < 2; ++i) { const int tt = 2 * (wave & 1) + i, tl = tt * 16 + fr, t = t0 + tl;
        const bf16x8 ra0 = *(const bf16x8*)(RH + (size_t)tl * 64 + fq * 8), ra1 = *(const bf16x8*)(RH + (size_t)tl * 64 + 32 + fq * 8);
        f32x4 ov[4]; float sm = 0.f;
#pragma unroll
        for (int vt = 0; vt < 4; ++vt) { f32x4 acc = ldb4(O0 + tl * 64 + vt * 16 + 4 * fq);
            acc = __builtin_amdgcn_mfma_f32_16x16x32_bf16(pfr[vt][0], ra0, acc, 0, 0, 0); acc = __builtin_amdgcn_mfma_f32_16x16x32_bf16(pfr[vt][1], ra1, acc, 0, 0, 0);
            ov[vt] = acc; DBG_STAT(24, acc[0]); DBG_STAT(24, acc[1]); DBG_STAT(24, acc[2]); DBG_STAT(24, acc[3]); sm += (acc.x + acc.y) + (acc.z + acc.w); }
        sm += __shfl_xor(sm, 16); sm += __shfl_xor(sm, 32);
        const float mean = sm * (1.f / 64.f); float sq = 0.f;
#pragma unroll
        for (int vt = 0; vt < 4; ++vt) { ov[vt] = ov[vt] - mean; sq += (ov[vt].x * ov[vt].x + ov[vt].y * ov[vt].y) + (ov[vt].z * ov[vt].z + ov[vt].w * ov[vt].w); }
        sq += __shfl_xor(sq, 16); sq += __shfl_xor(sq, 32);
        const float rs = __builtin_amdgcn_rsqf(sq * (1.f / 64.f) + RWKV_GN_EPS);
        float bd = 0.f;
#pragma unroll
        for (int q = 0; q < 4; ++q) { const f32x4 r4 = ldb4(RW + (size_t)t * 768 + hh * 64 + fq * 16 + 4 * q), k4 = ldb4(RW + (size_t)t * 768 + 256 + hh * 64 + fq * 16 + 4 * q), c4 = *(const f32x4*)(rk + fq * 16 + 4 * q);
            bd += (r4.x * k4.x * c4.x + r4.y * k4.y * c4.y) + (r4.z * k4.z * c4.z + r4.w * k4.w * c4.w); }
        bd += __shfl_xor(bd, 16); bd += __shfl_xor(bd, 32);
#pragma unroll
        for (int vt = 0; vt < 4; ++vt) { const int col = vt * 16 + 4 * fq; const f32x4 g4 = *(const f32x4*)(lg + col), b4 = *(const f32x4*)(lb + col);
            const f32x4 v4 = ldb4(RW + (size_t)t * 768 + 512 + hh * 64 + col), gg = ldb4(RG + (size_t)t * 256 + hh * 64 + col);
            float e0 = (ov[vt].x * rs * g4.x + b4.x + bd * v4.x) * gg.x, e1 = (ov[vt].y * rs * g4.y + b4.y + bd * v4.y) * gg.y, e2 = (ov[vt].z * rs * g4.z + b4.z + bd * v4.z) * gg.z, e3 = (ov[vt].w * rs * g4.w + b4.w + bd * v4.w) * gg.w;
#ifdef RW_SANITIZE
            e0 = (fabsf(e0) < 1e30f) ? e0 : 0.f; e1 = (fabsf(e1) < 1e30f) ? e1 : 0.f; e2 = (fabsf(e2) < 1e30f) ? e2 : 0.f; e3 = (fabsf(e3) < 1e30f) ? e3 : 0.f;
#endif
            MIX_ST4(mix, (size_t)t * D + 256 + hh * 64 + col, e0, e1, e2, e3); } }
}

__device__ __forceinline__ void scans_elementwise(Frame& F, const Args& A) {
    const int nthr = F.G * 448, gt = F.vcu * 448 + (F.tid - 64);
    constexpr int N_SSD = 16 * 64 * 128 / 2, N_GLA = 16 * 32 * 64 / 2, N_MLC = 16 * 64 * 64 / 2, N_MLN = 16 * 64 / 2;
    for (int i = gt; i < N_SSD + N_GLA + N_MLC + N_MLN; i += nthr) {
        if (i < N_SSD) { const int bh = i >> 12, pn = (i & 4095) * 2; unsigned* base = (unsigned*)(WSP(bf16, WS_SSD_ST) + (size_t)bh * NCH * 8192 + pn); const float* dec = WSP(float, WS_SSD_DEC) + bh * NCH; float S0 = 0.f, S1 = 0.f;
#pragma unroll 1
            for (int c0 = 0; c0 < NCH; c0 += 32) { unsigned x[32]; float dd[32];
#pragma unroll
                for (int j = 0; j < 32; ++j) { x[j] = base[(size_t)(c0 + j) * 4096]; dd[j] = dec[c0 + j]; }
#pragma unroll
                for (int j = 0; j < 32; ++j) { base[(size_t)(c0 + j) * 4096] = cvt_pk_bf16(S0, S1); S0 = dd[j] * S0 + __uint_as_float(x[j] << 16); S1 = dd[j] * S1 + __uint_as_float(x[j] & 0xffff0000u); } }
        } else if (i < N_SSD + N_GLA) { const int k = i - N_SSD, bh = k >> 10, dv = (k & 1023) * 2, dd_ = dv >> 6, b = bh >> 2, hh = bh & 3; unsigned* base = (unsigned*)(WSP(bf16, WS_GLA_ST) + (size_t)bh * NCH * 2048 + dv); const float* dec = WSP(float, WS_GLA_DEC) + (size_t)b * NCH * 128 + hh * 32 + dd_; float S0 = 0.f, S1 = 0.f;
#pragma unroll 1
            for (int c0 = 0; c0 < NCH; c0 += 32) { unsigned x[32]; float dd[32];
#pragma unroll
                for (int j = 0; j < 32; ++j) { x[j] = base[(size_t)(c0 + j) * 1024]; dd[j] = dec[(c0 + j) * 128]; }
#pragma unroll
                for (int j = 0; j < 32; ++j) { base[(size_t)(c0 + j) * 1024] = cvt_pk_bf16(S0, S1); S0 = dd[j] * S0 + __uint_as_float(x[j] << 16); S1 = dd[j] * S1 + __uint_as_float(x[j] & 0xffff0000u); } }
        } else { const int k = i - N_SSD - N_GLA; const bool isn = k >= N_MLC; const int kk = isn ? k - N_MLC : k; const int bh = isn ? (kk >> 5) : (kk >> 11), e = (isn ? (kk & 31) : (kk & 2047)) * 2, str = isn ? 32 : 2048;
            unsigned* base = (unsigned*)((isn ? WSP(bf16, WS_ML_N) : WSP(bf16, WS_ML_C)) + (size_t)bh * NCH * str * 2 + e); const float* bl = WSP(float, WS_ML_BL) + bh * NCH; const float* ml = WSP(float, WS_ML_ML) + bh * NCH; float* mo = WSP(float, WS_ML_M) + bh * NCH;
            float S0 = 0.f, S1 = 0.f, m = 0.f;
#pragma unroll 1
            for (int c0 = 0; c0 < NCH; c0 += 32) { unsigned x[32]; float b8[32], m8[32];
#pragma unroll
                for (int j = 0; j < 32; ++j) { x[j] = base[(size_t)(c0 + j) * str]; b8[j] = bl[c0 + j]; m8[j] = ml[c0 + j]; }
#pragma unroll
                for (int j = 0; j < 32; ++j) { const float mn = fmaxf(b8[j] + m, m8[j]); const float so = __expf(b8[j] + m - mn), sn = __expf(m8[j] - mn);
                    base[(size_t)(c0 + j) * str] = cvt_pk_bf16(S0, S1); if (!isn && e == 0) mo[c0 + j] = m; S0 = so * S0 + sn * __uint_as_float(x[j] << 16); S1 = so * S1 + sn * __uint_as_float(x[j] & 0xffff0000u); m = mn; } }
        }
    }
}
#ifndef MK_PER_PHASE_LAUNCH
#define MK_PER_PHASE_LAUNCH 0
#endif
#ifndef PH_MASK
#define PH_MASK 0xFFF
#endif
#ifndef ST_MASK
#define ST_MASK 0xF
#endif
#define ST_ON(k) (((ST_MASK) >> (k)) & 1)
#ifndef DUP_MASK
#define DUP_MASK 0
#endif
#define DUP_N(k) ((((DUP_MASK) >> (k)) & 1) ? 2 : 1)
#ifndef ST_DUP
#define ST_DUP 0
#endif
#define ST_REP(ty) ((((ST_DUP) >> (ty)) & 1) ? 2 : 1)
#define PH_ON(k) (((PH_MASK) >> (k)) & 1)
constexpr int PH_PER_LAYER = 11, N_PHASES = 1 + DEPTH * PH_PER_LAYER;
__global__ void __launch_bounds__(NWAVES * 64, 2) fwd_kernel(Args args) {
    extern __shared__ __attribute__((aligned(16))) unsigned char lds[];
    Frame F;
    F.lds = (LAS unsigned char*)lds;
    F.MISC = (volatile LAS unsigned*)(F.lds + MISC_OFF);
    F.tid = threadIdx.x; F.lane = F.tid & 63; F.wave = __builtin_amdgcn_readfirstlane(F.tid >> 6);
    F.G = gridDim.x; { const int bx = blockIdx.x; F.vcu = (F.G % 8 == 0) ? (bx % 8) * (F.G / 8) + bx / 8 : bx; }
    F.ka = (karg_t)__builtin_amdgcn_kernarg_segment_ptr(); F.ws = args.ws; F.ctl = (gu32*)(args.ws + WS_CTL); F.out = args.out;
    for (int i = F.tid; i < 256; i += NWAVES * 64) F.MISC[i] = 0u;
    __syncthreads();
    const int lo = args.ph_lo, hi = args.ph_hi;
#ifdef DBG_TSEL
    if (blockIdx.x == 0 && threadIdx.x == 0) __hip_atomic_store(F.ctl + CW_DBG + 15, (unsigned)__builtin_amdgcn_s_memrealtime(), RLX_AGENT);
#endif
    XcdBarrier bar; bar.bar = (unsigned*)(F.ctl + CW_BAR); bar.x = 0; bar.st = nullptr;
    if (hi - lo > 1) bar = xcd_barrier_post((unsigned*)(F.ctl + CW_BAR), F.MISC + MW_BAR);
#define IN_(k) (lo <= (k) && (k) < hi)
#ifdef DBG_TSEL
#ifndef DBG_TQ
#define DBG_TQ 50.0f
#endif
#define TSTAMP(k) do { if (blockIdx.x == 0 && threadIdx.x == 0) __hip_atomic_store(F.ctl + CW_DBG + 16 + ((k) == 11 ? 0 : 1 + layer_ * PH_PER_LAYER + (k)), (unsigned)__builtin_amdgcn_s_memrealtime(), RLX_AGENT); } while (0)
#else
#define TSTAMP(k) do { } while (0)
#endif
#ifdef BAR_DUP
#define SEAM(k) do { if (IN_(k) && IN_((k) + 1)) { xcd_barrier(bar); xcd_barrier(bar); } } while (0)
#else
#define SEAM(k) do { if (IN_(k) && IN_((k) + 1)) xcd_barrier(bar); } while (0)
#endif

    if (PH_ON(11) && IN_(0)) { for (int rep_ = 0; rep_ < DUP_N(11); ++rep_) { frame_refresh(F); p0_prologue(F, args); } SEAM(0); { const int layer_ = 0; TSTAMP(11); (void)layer_; } }
#pragma unroll 1
    for (int layer = 0; layer < DEPTH; ++layer) {
        const int pb = 1 + layer * PH_PER_LAYER; const int layer_ = layer; (void)layer_;
        if (PH_ON(0) && IN_(pb + 0)) { for (int rep_ = 0; rep_ < DUP_N(0); ++rep_) { frame_refresh(F);
            { pg8::DenseSched S; S.init(WSP(bf16, WS_XB), WSP(bf16, WS_WIN_T) + (size_t)layer * NUP * D, T, NUP, D, F.G, (int)blockIdx.x);
              pg8::EpiB16 E{WSP(bf16, WS_U), NUP, nullptr, 0.f};
              pg8::gemm_phase<pg8::EpiB16, pg8::DenseSched>(F.lds, F.tid, S, E); }
            if (F.G != 256 || blockIdx.x >= 128)
            { pg8::DenseSched S; if (F.G == 256) S.init(WSP(bf16, WS_PB) + (size_t)layer * T * 256, WSP(bf16, WS_WPP_T) + (size_t)layer * D * 256, T, D, 256, 128, (int)blockIdx.x - 128); else S.init(WSP(bf16, WS_PB) + (size_t)layer * T * 256, WSP(bf16, WS_WPP_T) + (size_t)layer * D * 256, T, D, 256, F.G, (int)blockIdx.x);
              pg8::EpiB16 E{WSP(bf16, WS_PE), D, nullptr, 0.f};
              pg8::gemm_phase<pg8::EpiB16, pg8::DenseSched>(F.lds, F.tid, S, E); }
            } SEAM(pb + 0); TSTAMP(0);
        }
        if (PH_ON(1) && IN_(pb + 1)) { for (int rep_ = 0; rep_ < DUP_N(1); ++rep_) { frame_refresh(F);
            for (int un = F.vcu; un < 1024; un += F.G) { frame_refresh(F); const int ty = un >> 8, r = un & 255, b = r >> 6, c = r & 63;
                if (ty == 0) { ssd_stage1(F, args, layer, b, c); if (ST_DUP & 1) ssd_stage1(F, args, layer, b, c); } else if (ty == 1) { gla_stage1(F, args, layer, b, c); if (ST_DUP & 2) gla_stage1(F, args, layer, b, c); } else if (ty == 2) { mlstm_stage1(F, args, layer, b, c); if (ST_DUP & 4) mlstm_stage1(F, args, layer, b, c); } else { rwkv_stage1(F, args, layer, r); if (ST_DUP & 8) rwkv_stage1(F, args, layer, r); } }
            } SEAM(pb + 1); TSTAMP(1);
        }
        if (PH_ON(2) && IN_(pb + 2)) { for (int rep_ = 0; rep_ < DUP_N(2); ++rep_) { frame_refresh(F);
            if (F.wave == 0) { for (int ws_ = F.vcu; ws_ < 64; ws_ += F.G) rwkv_scan_wave(F, args, ws_); }
            else if (rep_ == 0) scans_elementwise(F, args);
            } SEAM(pb + 2); TSTAMP(2);
        }
        if (PH_ON(3) && IN_(pb + 3)) { for (int rep_ = 0; rep_ < DUP_N(3); ++rep_) { frame_refresh(F);
            for (int un = F.vcu; un < 1024; un += F.G) { frame_refresh(F); const int ty = un >> 8, r = un & 255, b = r >> 6, c = r & 63;
                if (ty == 0) { ssd_stage3(F, args, layer, b, c); if (ST_DUP & 16) ssd_stage3(F, args, layer, b, c); } else if (ty == 1) { gla_stage3(F, args, layer, b, c); if (ST_DUP & 32) gla_stage3(F, args, layer, b, c); } else if (ty == 2) { mlstm_stage3(F, args, layer, b, c); if (ST_DUP & 64) mlstm_stage3(F, args, layer, b, c); } else { rwkv_stage3(F, args, layer, r); if (ST_DUP & 128) rwkv_stage3(F, args, layer, r); } }
            } SEAM(pb + 3); TSTAMP(3);
        }
        if (PH_ON(4) && IN_(pb + 4)) { for (int rep_ = 0; rep_ < DUP_N(4); ++rep_) { frame_refresh(F);
            pg8::EpiB16 E{WSP(bf16, WS_Y1), D, WSP(bf16, WS_XB), DN_ALPHA};
#if OUT_FP8
            pg8::DenseSched8b S; S.init(WSP(bf16, WS_MIX), (const bf16*)(WSP(unsigned char, WS_WOUT_Q) + (size_t)layer * D * D), T, D, D / 2, F.G, (int)blockIdx.x);
            pg8::gemm_phase<pg8::EpiB16, pg8::DenseSched8b>(F.lds, F.tid, S, E);
#else
            pg8::DenseSched S; S.init(WSP(bf16, WS_MIX), WSP(bf16, WS_WOUT_T) + (size_t)layer * D * D, T, D, D, F.G, (int)blockIdx.x);
            pg8::gemm_phase<pg8::EpiB16, pg8::DenseSched>(F.lds, F.tid, S, E);
#endif
            } SEAM(pb + 4); TSTAMP(4);
        }
        if (PH_ON(5) && IN_(pb + 5)) { if (DUP_N(5) == 2) { frame_refresh(F); p6_ln1_router<true>(F, args, layer); } frame_refresh(F); p6_ln1_router<false>(F, args, layer); SEAM(pb + 5); TSTAMP(5); }
        if (PH_ON(6) && IN_(pb + 6)) { for (int rep_ = 0; rep_ < DUP_N(6); ++rep_) { frame_refresh(F);
            moe_build_pfx(F, args, layer, 8);
            pg8::Moe1Sched S; S.O.pfx = F.MISC + MW_PFX; S.O.NT = 8; S.O.G = F.G; S.O.c = (int)blockIdx.x; S.sdest = WSP(int, WS_SDEST); S.bgu = KIN(I_BGU) + (size_t)layer * NE * 2048;
            if (MOE_FP8) { S.X = WSP(unsigned char, WS_X1Q); S.W = WSP(unsigned char, WS_WGU_Q) + (size_t)layer * NE * 2048 * D; S.K = D / 2; S.hstepB = (size_t)1024 * D; }
            else { S.X = WSP(unsigned char, WS_X1B); S.W = WSP(unsigned char, WS_WGU_T) + (size_t)layer * NE * 2048 * D * 2; S.K = D; S.hstepB = (size_t)1024 * D * 2; }
            pg8::EpiMoe1 E{WSP(bf16, WS_ABUF), KIN(I_BGU) + (size_t)layer * NE * 2048, WSP(unsigned char, WS_ABUFQ)};
            pg8::gemm_phase<pg8::EpiMoe1, pg8::Moe1Sched>(F.lds, F.tid, S, E);
            } SEAM(pb + 6); TSTAMP(6);
        }
        if (PH_ON(7) && IN_(pb + 7)) { for (int rep_ = 0; rep_ < DUP_N(7); ++rep_) { frame_refresh(F);
            moe_build_pfx(F, args, layer, 4);
            pg8::Moe2Sched S; S.O.pfx = F.MISC + MW_PFX; S.O.NT = 4; S.O.G = F.G; S.O.c = (int)blockIdx.x; S.sdest = WSP(int, WS_SDEST); S.sgate = WSP(float, WS_SGATE); S.bdn = KIN(I_BDN) + (size_t)layer * NE * D; if (MOE2_FP8) { S.Ab = WSP(unsigned char, WS_ABUFQ); S.W = WSP(unsigned char, WS_WDN_Q) + (size_t)layer * NE * D * D; S.K = D / 2; S.hstepB = (size_t)128 * D; }
            else { S.Ab = WSP(unsigned char, WS_ABUF); S.W = WSP(unsigned char, WS_WDN_T) + (size_t)layer * NE * D * D * 2; S.K = D; S.hstepB = (size_t)128 * D * 2; }
            pg8::EpiMoe2 E{WSP(bf16, WS_YBUF), KIN(I_BDN) + (size_t)layer * NE * D, WSP(int, WS_SDEST), WSP(float, WS_SGATE)};
            pg8::gemm_phase<pg8::EpiMoe2, pg8::Moe2Sched>(F.lds, F.tid, S, E);
            } SEAM(pb + 7); TSTAMP(7);
        }
        if (PH_ON(8) && IN_(pb + 8)) { for (int rep_ = 0; rep_ < DUP_N(8); ++rep_) { frame_refresh(F); p9_combine(F, args); } SEAM(pb + 8); TSTAMP(8); }
        if (PH_ON(9) && IN_(pb + 9)) { for (int rep_ = 0; rep_ < DUP_N(9); ++rep_) { frame_refresh(F);
            pg8::EpiPle E{WSP(bf16, WS_H2), WSP(bf16, WS_HB), WSP(bf16, WS_PE)};
#if PLE_FP8
            pg8::DenseSched8 S; S.init((const bf16*)WSP(unsigned char, WS_HQ), (const bf16*)(WSP(unsigned char, WS_WPG_Q) + (size_t)layer * D * D), T, D, D / 2, F.G, (int)blockIdx.x);
            pg8::gemm_phase<pg8::EpiPle, pg8::DenseSched8>(F.lds, F.tid, S, E);
#else
            pg8::DenseSched S; S.init(WSP(bf16, WS_HB), WSP(bf16, WS_WPG_T) + (size_t)layer * D * D, T, D, D, F.G, (int)blockIdx.x);
            pg8::gemm_phase<pg8::EpiPle, pg8::DenseSched>(F.lds, F.tid, S, E);
#endif
            } SEAM(pb + 9); TSTAMP(9);
        }
        if (PH_ON(10) && IN_(pb + 10)) { for (int rep_ = 0; rep_ < DUP_N(10); ++rep_) { frame_refresh(F); p11_ln2(F, args, layer); } SEAM(pb + 10); TSTAMP(10); }
    }
#ifdef DBG_TSEL
    if (hi - lo > 1) { xcd_barrier(bar);
        unsigned ticks = 0u;
        if (DBG_TSEL == 11) ticks = __hip_atomic_load(F.ctl + CW_DBG + 16, RLX_AGENT) - __hip_atomic_load(F.ctl + CW_DBG + 15, RLX_AGENT);
        else for (int l = 0; l < DEPTH; ++l) { const int pi = 1 + l * PH_PER_LAYER + DBG_TSEL; ticks += __hip_atomic_load(F.ctl + CW_DBG + 16 + pi, RLX_AGENT) - __hip_atomic_load(F.ctl + CW_DBG + 16 + pi - 1, RLX_AGENT); }
        const float us = floorf((float)ticks * 0.01f / DBG_TQ) * DBG_TQ; const float code = sqrtf(us * 0.05f);
        for (size_t i = (size_t)blockIdx.x * 512 + threadIdx.x; i < (size_t)T * D; i += (size_t)gridDim.x * 512) F.out[i] = code; }
#endif
#ifdef DBG_SEL
    if (hi - lo > 1) { xcd_barrier(bar);
        const unsigned mx = __hip_atomic_load(F.ctl + CW_DBG, RLX_AGENT), nf = __hip_atomic_load(F.ctl + CW_DBG + 1, RLX_AGENT);
        float code;
        { const float m = __uint_as_float(mx); int b = (m > 0.f) ? (int)floorf(log10f(m)) + 30 : 0; b = b < 0 ? 0 : (b > 60 ? 60 : b); if (nf) b += 100; code = sqrtf(10.0f * (float)(b + 1)); }
        for (size_t i = (size_t)blockIdx.x * 512 + threadIdx.x; i < (size_t)T * D; i += (size_t)gridDim.x * 512) F.out[i] = code; }
#endif
#undef IN_
#undef SEAM
}

extern "C" void kernel_launch(void* const* d_in, const int* in_sizes, int n_in, void* d_out, int out_size, void* d_ws, size_t ws_size, hipStream_t stream) {
    static int grid = 0;
    if (grid == 0) {
        if (n_in != N_IN || out_size != T * D || ws_size < WS_END) { fprintf(stderr, "kernel_launch: unexpected shapes (n_in %d, out %d, ws %zu < %zu); nothing launched\n", n_in, out_size, ws_size, (size_t)WS_END); grid = -1; return; }
        int dev = 0, cus = 0, per_cu = 0;
        if (hipGetDevice(&dev) != hipSuccess || hipDeviceGetAttribute(&cus, hipDeviceAttributeMultiprocessorCount, dev) != hipSuccess) { grid = -1; return; }
        if (hipFuncSetAttribute((const void*)fwd_kernel, hipFuncAttributeMaxDynamicSharedMemorySize, LDS_BYTES) != hipSuccess) { fprintf(stderr, "kernel_launch: hipFuncSetAttribute failed\n"); grid = -1; return; }
        if (hipOccupancyMaxActiveBlocksPerMultiprocessor(&per_cu, (const void*)fwd_kernel, NWAVES * 64, LDS_BYTES) != hipSuccess || per_cu < 1) { fprintf(stderr, "kernel_launch: occupancy query says %d blocks per CU\n", per_cu); }
        (void)hipGetLastError();
        grid = cus;
    }
    if (grid < 0) return;
    (void)hipMemsetAsync((char*)d_ws + WS_CTL, 0, CTL_ZERO_BYTES, stream);
    Args a{};
    for (int i = 0; i < N_IN; ++i) a.in[i] = (const float*)d_in[i];
    a.out = (float*)d_out; a.ws = (unsigned char*)d_ws;
#if MK_PER_PHASE_LAUNCH
    for (int ph = 0; ph < N_PHASES; ++ph) { a.ph_lo = ph; a.ph_hi = ph + 1; hipLaunchKernelGGL(fwd_kernel, dim3(grid), dim3(NWAVES * 64), LDS_BYTES, stream, a); }
#else
    a.ph_lo = 0; a.ph_hi = N_PHASES; hipLaunchKernelGGL(fwd_kernel, dim3(grid), dim3(NWAVES * 64), LDS_BYTES, stream, a);
#endif
    const hipError_t le = hipPeekAtLastError();
    if (le != hipSuccess) fprintf(stderr, "kernel_launch: launch failed: %s\n", hipGetErrorName(le));
}
```

```cpp
#include <hip/hip_runtime.h>
#include <cstdio>
#include <cstdint>

#define GAS __attribute__((address_space(1)))
#define LAS __attribute__((address_space(3)))
typedef unsigned short bf16;
typedef unsigned v4u __attribute__((ext_vector_type(4)));
typedef unsigned v2u __attribute__((ext_vector_type(2)));
typedef float f32x4 __attribute__((ext_vector_type(4)));
typedef float f32x2 __attribute__((ext_vector_type(2)));
typedef short bf16x8 __attribute__((ext_vector_type(8)));
typedef int v4i_t __attribute__((ext_vector_type(4)));
typedef int v8i_t __attribute__((ext_vector_type(8)));
typedef GAS unsigned gu32;
#define RLX_AGENT __ATOMIC_RELAXED, __HIP_MEMORY_SCOPE_AGENT
#define LDS_WAIT() asm volatile("s_waitcnt lgkmcnt(0)" ::: "memory")
#define VM_WAIT() asm volatile("s_waitcnt vmcnt(0)" ::: "memory")

constexpr int NWAVES = 8;
constexpr int DEPTH = 4, BATCH = 4, SEQ = 4096, D = 1024, T = BATCH * SEQ;
constexpr int NU = 3484, NUP = 3584;
constexpr int NE = 32, TOPK = 4, ECAP = 16384;
constexpr int NCH = SEQ / 64;
constexpr int U_SSD_Z = 0, U_SSD_X = 256, U_SSD_B = 512, U_SSD_C = 640, U_SSD_DT = 768;
constexpr int U_RW = 772, U_RW_R = 772, U_RW_K = 1028, U_RW_V = 1284, U_RW_LO = 1540;
constexpr int U_GL_Q = 1668, U_GL_K = 1796, U_GL_V = 1924, U_GL_G = 2180, U_GL_OG = 2196;
constexpr int U_ML_Q = 2452, U_ML_K = 2708, U_ML_V = 2964, U_ML_I = 3220, U_ML_F = 3224, U_ML_O = 3228;
constexpr float DN_ALPHA = 1.6817928305074290f;
constexpr float LN_EPS = 1e-5f, NORM_EPS = 1e-5f, RWKV_GN_EPS = 64e-5f;

enum { I_X = 0, I_P, I_WIN, I_WOUT, I_LN1G, I_LN1B, I_SCW, I_SCB, I_SALOG, I_SDTB, I_SD, I_SNG,
       I_RMU, I_RW0, I_RWUP, I_RA0, I_RAUP, I_RGUP, I_RKK, I_RKA, I_RRK, I_RLNG, I_RLNB,
       I_GGUP, I_GGB, I_GNG, I_MCW, I_MCB, I_MIB, I_MFB, I_MNG,
       I_RTW, I_RTB, I_WGU, I_BGU, I_WDN, I_BDN, I_PGW, I_PPJ, I_LN2G, I_LN2B, N_IN };

constexpr size_t MiB = 1u << 20;
constexpr size_t WS_CTL = 0, CTL_ZERO_BYTES = 1 * MiB;
constexpr size_t WS_WIN_T = 2 * MiB;
constexpr size_t WS_WOUT_T = WS_WIN_T + (size_t)DEPTH * NUP * D * 2;
constexpr size_t WS_WGU_T = WS_WOUT_T + (size_t)DEPTH * D * D * 2;
constexpr size_t WS_WDN_T = WS_WGU_T + (size_t)DEPTH * NE * 2048 * D * 2;
constexpr size_t WS_WPG_T = WS_WDN_T + (size_t)DEPTH * NE * D * D * 2;
constexpr size_t WS_WPP_T = WS_WPG_T + (size_t)DEPTH * D * D * 2;
constexpr size_t WS_RWT = WS_WPP_T + (size_t)DEPTH * D * 256 * 2;
constexpr size_t WS_PB = WS_RWT + (size_t)DEPTH * NE * D * 4;
constexpr size_t WS_XB = WS_PB + (size_t)DEPTH * T * 256 * 2;
constexpr size_t WS_U = WS_XB + (size_t)T * D * 2;
constexpr size_t WS_PE = WS_U + (size_t)T * NUP * 2;
constexpr size_t WS_MIX = WS_PE + (size_t)T * D * 4;
constexpr size_t WS_Y1 = WS_MIX + (size_t)T * D * 2;
constexpr size_t WS_X1 = WS_Y1 + (size_t)T * D * 4;
constexpr size_t WS_X1B = WS_X1 + (size_t)T * D * 4;
constexpr size_t WS_SDEST = WS_X1B + (size_t)T * D * 2;
constexpr size_t WS_SGATE = WS_SDEST + (size_t)NE * ECAP * 4;
constexpr size_t WS_ABUF = WS_SGATE + (size_t)NE * ECAP * 4;
constexpr size_t WS_YBUF = WS_ABUF + (size_t)NE * ECAP * D * 2;
constexpr size_t WS_H = WS_YBUF + (size_t)T * 4 * D * 2;
constexpr size_t WS_HB = WS_H + (size_t)T * D * 4;
constexpr size_t WS_H2 = WS_HB + (size_t)T * D * 2;
constexpr size_t WS_SSD_ST = WS_H2 + (size_t)T * D * 4;
constexpr size_t WS_SSD_DEC = WS_SSD_ST + (size_t)16 * NCH * 64 * 128 * 4;
constexpr size_t WS_GLA_ST = WS_SSD_DEC + 16 * NCH * 4;
constexpr size_t WS_GLA_DEC = WS_GLA_ST + (size_t)16 * NCH * 32 * 64 * 4;
constexpr size_t WS_ML_C = WS_GLA_DEC + (size_t)4 * NCH * 128 * 4;
constexpr size_t WS_ML_N = WS_ML_C + (size_t)16 * NCH * 64 * 64 * 4;
constexpr size_t WS_ML_BL = WS_ML_N + (size_t)16 * NCH * 64 * 4;
constexpr size_t WS_ML_ML = WS_ML_BL + 16 * NCH * 4;
constexpr size_t WS_ML_M = WS_ML_ML + 16 * NCH * 4;
constexpr size_t WS_RW = WS_ML_M + 16 * NCH * 4;
constexpr size_t WS_RW_G = WS_RW + (size_t)T * 3 * 256 * 4;
constexpr size_t WS_RW_RH = WS_RW_G + (size_t)T * 256 * 4;
constexpr size_t WS_RW_O0 = WS_RW_RH + (size_t)1024 * 4096 * 2;
constexpr size_t WS_RW_GF = WS_RW_O0 + (size_t)1024 * 4096 * 4;
constexpr size_t WS_RW_HT = WS_RW_GF + (size_t)1024 * 4096 * 2;
constexpr size_t WS_RW_PT = WS_RW_HT + (size_t)1024 * 4096 * 4;
constexpr size_t WS_LORA = WS_RW_PT + (size_t)1024 * 4096 * 2;
constexpr int LORA_PER_LAYER = 8192 + 8192 + 16384 + 2048;
constexpr size_t WS_WGU_Q = WS_LORA + (size_t)DEPTH * LORA_PER_LAYER * 4;
constexpr size_t WS_WDN_Q = WS_WGU_Q + (size_t)DEPTH * NE * 2048 * D;
constexpr size_t WS_X1Q = WS_WDN_Q + (size_t)DEPTH * NE * D * D;
constexpr size_t WS_ABUFQ = WS_X1Q + (size_t)T * D;
constexpr size_t WS_WPG_Q = WS_ABUFQ + (size_t)NE * ECAP * D;
constexpr size_t WS_HQ = WS_WPG_Q + (size_t)DEPTH * D * D;
constexpr size_t WS_WOUT_Q = WS_HQ + (size_t)T * D;
constexpr size_t WS_END = WS_WOUT_Q + (size_t)DEPTH * D * D;
#ifndef MOE_FP8
#define MOE_FP8 1
#endif
#ifndef MOE2_FP8
#define MOE2_FP8 1
#ifndef P6_MFMA
#define P6_MFMA 1
#endif
#ifndef OUT_FP8
#define OUT_FP8 1
#endif
#ifndef PLE_FP8
#define PLE_FP8 1
#endif
#endif
constexpr int CW_BAR = 4096;
constexpr int CW_DBG = 32768;
constexpr int CW_CNT = 16384;

constexpr int RING_BYTES = 147456;
constexpr int MISC_OFF = RING_BYTES;
constexpr int LDS_BYTES = RING_BYTES + 1024;
constexpr int MW_BAR = 8, MW_LCNT = 32, MW_LBASE = 64, MW_PFX = 96, MW_CNT = 136, MW_GAMC = 168;

typedef __bf16 bf16x2_t __attribute__((ext_vector_type(2)));
__device__ __forceinline__ unsigned cvt_pk_bf16(float lo, float hi) { const f32x2 v = {lo, hi}; const bf16x2_t b = __builtin_convertvector(v, bf16x2_t); return __builtin_bit_cast(unsigned, b); }
__device__ __forceinline__ unsigned cvt4_fp8(float a, float b, float c, float d) { int w = 0; w = __builtin_amdgcn_cvt_pk_fp8_f32(a, b, w, false); w = __builtin_amdgcn_cvt_pk_fp8_f32(c, d, w, true); return (unsigned)w; }
__device__ __forceinline__ float bf2f(unsigned short b) { return __uint_as_float(((unsigned)b) << 16); }
__device__ __forceinline__ float sigmoidf_(float x) { return __builtin_amdgcn_rcpf(1.0f + __expf(-x)); }
__device__ __forceinline__ float siluf_(float x) { return x * __builtin_amdgcn_rcpf(1.0f + __expf(-x)); }
__device__ __forceinline__ float softplusf_(float x) { return fmaxf(x, 0.f) + __logf(1.0f + __expf(-fabsf(x))); }
__device__ __forceinline__ float logsigmoidf_(float x) { return fminf(x, 0.f) - __logf(1.0f + __expf(-fabsf(x))); }
__device__ __forceinline__ float tanhf_(float x) { const float e = __expf(-2.0f * fabsf(x)); const float t = (1.0f - e) * __builtin_amdgcn_rcpf(1.0f + e); return x < 0.f ? -t : t; }
__device__ __forceinline__ int lane_now() { int l = (int)__builtin_amdgcn_mbcnt_hi(~0u, __builtin_amdgcn_mbcnt_lo(~0u, 0u)); asm volatile("" : "+v"(l)); return l; }
__device__ __forceinline__ float my_shfl_idx(float v, int src) { return __builtin_bit_cast(float, __builtin_amdgcn_ds_bpermute(src << 2, __builtin_bit_cast(int, v))); }
__device__ __forceinline__ int my_shfl_idx(int v, int src) { return __builtin_amdgcn_ds_bpermute(src << 2, v); }
template <class V> __device__ __forceinline__ V my_shfl_xor(V v, int o) { return my_shfl_idx(v, lane_now() ^ o); }
template <class V> __device__ __forceinline__ V my_shfl_up(V v, int o) { const int l = lane_now(); return my_shfl_idx(v, l >= o ? l - o : l); }
#define __shfl_xor(v, o) my_shfl_xor(v, o)
#define __shfl_up(v, o) my_shfl_up(v, o)
#define __shfl(v, s) my_shfl_idx(v, s)
__device__ __forceinline__ float wave_sum(float v) {
#pragma unroll
    for (int o = 1; o < 64; o <<= 1) v += __shfl_xor(v, o);
    return v;
}
__device__ __forceinline__ float wave_max(float v) {
#pragma unroll
    for (int o = 1; o < 64; o <<= 1) v = fmaxf(v, __shfl_xor(v, o));
    return v;
}
__device__ __forceinline__ float wave_scan_add(float v, int lane) {
#pragma unroll
    for (int o = 1; o < 64; o <<= 1) { const float t = __shfl_up(v, o); if (lane >= o) v += t; }
    return v;
}
__device__ __forceinline__ float wave_scan_max(float v, int lane) {
#pragma unroll
    for (int o = 1; o < 64; o <<= 1) { const float t = __shfl_up(v, o); if (lane >= o) v = fmaxf(v, t); }
    return v;
}
__device__ __forceinline__ f32x4 mm16(const LAS unsigned char* A, int lda, const LAS unsigned char* B, int ldb, int K, f32x4 acc, int fr, int fq) {
    const LAS unsigned char* ap = A + fr * lda + fq * 16; const LAS unsigned char* bp = B + fr * ldb + fq * 16;
    for (int k = 0; k < K; k += 32) {
        const bf16x8 a = *(const LAS bf16x8*)(ap + k * 2); const bf16x8 b = *(const LAS bf16x8*)(bp + k * 2);
        acc = __builtin_amdgcn_mfma_f32_16x16x32_bf16(b, a, acc, 0, 0, 0);
    }
    return acc;
}
__device__ __forceinline__ f32x4 mm16_gB(const LAS unsigned char* A, int lda, const float* B, int ldb, int K, f32x4 acc, int fr, int fq) {
    const LAS unsigned char* ap = A + fr * lda + fq * 16; const float* bp = B + (size_t)fr * ldb + fq * 8;
    for (int k = 0; k < K; k += 32) {
        const bf16x8 a = *(const LAS bf16x8*)(ap + k * 2);
        const f32x4 b0 = *(const f32x4*)(bp + k), b1 = *(const f32x4*)(bp + k + 4);
        v4u bw; bw.x = cvt_pk_bf16(b0.x, b0.y); bw.y = cvt_pk_bf16(b0.z, b0.w); bw.z = cvt_pk_bf16(b1.x, b1.y); bw.w = cvt_pk_bf16(b1.z, b1.w);
        const bf16x8 b = __builtin_bit_cast(bf16x8, bw);
        acc = __builtin_amdgcn_mfma_f32_16x16x32_bf16(b, a, acc, 0, 0, 0);
    }
    return acc;
}
__device__ __forceinline__ f32x4 mm16_gAB(const bf16* A, int lda, const bf16* B, int ldb, int K, f32x4 acc, int fr, int fq) {
    const bf16* ap = A + (size_t)fr * lda + fq * 8; const bf16* bp = B + (size_t)fr * ldb + fq * 8;
    for (int k = 0; k < K; k += 32) { const bf16x8 a = *(const bf16x8*)(ap + k), b = *(const bf16x8*)(bp + k); acc = __builtin_amdgcn_mfma_f32_16x16x32_bf16(b, a, acc, 0, 0, 0); }
    return acc;
}
__device__ __forceinline__ bf16x8 ldfrag_f32(const float* p) { const f32x4 b0 = *(const f32x4*)p, b1 = *(const f32x4*)(p + 4);
    v4u bw; bw.x = cvt_pk_bf16(b0.x, b0.y); bw.y = cvt_pk_bf16(b0.z, b0.w); bw.z = cvt_pk_bf16(b1.x, b1.y); bw.w = cvt_pk_bf16(b1.z, b1.w); return __builtin_bit_cast(bf16x8, bw); }
template <int NK> __device__ __forceinline__ f32x4 mm16_rB(const LAS unsigned char* A, int lda, const bf16x8 (&b)[NK], f32x4 acc, int fr, int fq) {
    const LAS unsigned char* ap = A + fr * lda + fq * 16;
#pragma unroll
    for (int k = 0; k < NK; ++k) { const bf16x8 a = *(const LAS bf16x8*)(ap + k * 64); acc = __builtin_amdgcn_mfma_f32_16x16x32_bf16(b[k], a, acc, 0, 0, 0); }
    return acc;
}
__device__ __forceinline__ v4u pack8(const float (&v)[8]) { v4u o; o.x = cvt_pk_bf16(v[0], v[1]); o.y = cvt_pk_bf16(v[2], v[3]); o.z = cvt_pk_bf16(v[4], v[5]); o.w = cvt_pk_bf16(v[6], v[7]); return o; }

#define XB_TMO      128
#define XB_XCNT(j)  (256  + 64 * (j))
#define XB_XSUB(j)  (1280 + 64 * (j))
#define XB_XGEN(j)  (2304 + 64 * (j))
#define XB_TOP      3328
#define XB_TOPGEN   3392
#define XCD_BAR_WORDS 3456
#define XB_SPIN_CAP (1u << 18)
__device__ __forceinline__ unsigned xb_ld(unsigned* p)              { return __hip_atomic_load(p, __ATOMIC_RELAXED, __HIP_MEMORY_SCOPE_AGENT); }
__device__ __forceinline__ unsigned xb_add(unsigned* p, unsigned v) { return __hip_atomic_fetch_add(p, v, __ATOMIC_RELAXED, __HIP_MEMORY_SCOPE_AGENT); }
__device__ __forceinline__ unsigned xb_xcc_id() { return (unsigned)__builtin_amdgcn_s_getreg((3 << 11) | 20) & 0xFu; }
#define XB_SPIN(cond, bar) do { unsigned _sp = 0; while (cond) { __builtin_amdgcn_s_sleep(1); \
    if ((++_sp & 255u) == 0u) { if (xb_ld(&(bar)[XB_TMO])) break; if (_sp > XB_SPIN_CAP) { atomicAdd(&(bar)[XB_TMO], 1u); break; } } } } while (0)
struct XcdBarrier { unsigned* bar; unsigned x; volatile LAS unsigned* st; };
__device__ __forceinline__ XcdBarrier xcd_barrier_post(unsigned* bar, volatile LAS unsigned* st) {
    XcdBarrier b; b.bar = bar; b.x = xb_xcc_id(); b.st = st;
    if (threadIdx.x == 0) (void)xb_add(&bar[XB_XCNT(b.x)], 1u);
    return b;
}
__device__ __forceinline__ void xcd_barrier_complete(unsigned* bar, unsigned x, unsigned& nloc, unsigned& nx) {
    const unsigned G = gridDim.x * gridDim.y * gridDim.z;
    unsigned sum, cnt, mine, sp = 0u;
    for (;;) {
        sum = 0u; cnt = 0u; mine = 0u;
#pragma unroll
        for (unsigned j = 0; j < 16; ++j) { const unsigned c = xb_ld(&bar[XB_XCNT(j)]); sum += c; cnt += (c > 0u) ? 1u : 0u; mine = (j == x) ? c : mine; }
        if (sum == G) break;
        __builtin_amdgcn_s_sleep(1);
        if ((++sp & 255u) == 0u) { if (xb_ld(&bar[XB_TMO])) break; if (sp > XB_SPIN_CAP) { atomicAdd(&bar[XB_TMO], 1u); break; } }
    }
    nloc = mine > 0u ? mine : 1u; nx = cnt > 0u ? cnt : 1u;
}
__device__ __forceinline__ void xcd_barrier(const XcdBarrier& b) {
    asm volatile("s_waitcnt vmcnt(0)" ::: "memory");
    __syncthreads();
    if (threadIdx.x == 0) {
        unsigned* bar = b.bar;
        __builtin_amdgcn_s_waitcnt(0);
        unsigned nloc = b.st[0], nx = b.st[1];
        if (nloc == 0u) { xcd_barrier_complete(bar, b.x, nloc, nx); b.st[0] = nloc; b.st[1] = nx; }
        const unsigned old = xb_add(&bar[XB_XSUB(b.x)], 1u);
        const unsigned gen = old / nloc;
        if (old + 1u == (gen + 1u) * nloc) {
            __builtin_amdgcn_fence(__ATOMIC_RELEASE, "agent");
            asm volatile("s_waitcnt vmcnt(0)" ::: "memory");
            const unsigned og = xb_add(&bar[XB_TOP], 1u);
            const unsigned tg = og / nx;
            if (og + 1u == (tg + 1u) * nx) xb_add(&bar[XB_TOPGEN], 1u);
            else XB_SPIN(xb_ld(&bar[XB_TOPGEN]) == tg, bar);
            __builtin_amdgcn_fence(__ATOMIC_ACQUIRE, "agent");
            xb_add(&bar[XB_XGEN(b.x)], 1u);
            asm volatile("s_waitcnt vmcnt(0)" ::: "memory");
        } else {
            XB_SPIN(xb_ld(&bar[XB_XGEN(b.x)]) == gen, bar);
            __builtin_amdgcn_fence(__ATOMIC_ACQUIRE, "agent");
            asm volatile("s_waitcnt vmcnt(0)" ::: "memory");
        }
    }
    __syncthreads();
}

namespace pg8 {
constexpr int BM = 256, BK = 64, HALF = 128, HTB = HALF * BK * 2, STAGE_BYTES = 8 * HTB, NXCD = 8, WGM = 8;
__host__ __device__ __forceinline__ int lds_byte(int r, int c) { const int st = (r >> 4) * 2 + (c >> 5), rr = r & 15, cc = c & 31, ob = rr * 64 + cc * 2; return st * 1024 + (ob ^ (((ob >> 9) & 1) << 5)); }
__host__ __device__ __forceinline__ void stage_rc(int b, int& R, int& C) { const int st = b / 1024, sb = b % 1024, swz = sb ^ (((sb >> 9) & 1) << 5); R = (st >> 1) * 16 + swz / 64; C = (st & 1) * 32 + (swz % 64) / 2; }
__host__ __device__ __forceinline__ int perm32(int rho) { const int n = rho >> 4, i = rho & 15; return 8 * (i >> 2) + 4 * n + (i & 3); }

template <class Epi, class Sched>
__device__ __forceinline__ void gemm_phase(LAS unsigned char* lds, const int tid, const Sched& S, const Epi& E) {
    const int wid = __builtin_amdgcn_readfirstlane(tid >> 6), lane = tid & 63, wr = wid >> 2, wc = wid & 3, fr = lane & 15, fq = lane >> 4;
    const int K = S.K, nt = K / BK;
    unsigned voffB[2];
#pragma unroll
    for (int i = 0; i < 2; ++i) { int R, C; stage_rc(tid * 16 + i * 8192, R, C); const int Rb = Epi::PERM ? ((R & ~31) + perm32(R & 31)) : R; voffB[i] = (unsigned)(Rb * K + C) * 2u; }
    const size_t kstep = (size_t)(BK * 2);
    const size_t hstepB = S.hstepB;
    const unsigned ldsw = (unsigned)wid * 1024u;
    constexpr bool F8 = Sched::FP8;
    const int aoff = F8 ? lds_byte(wr * 64 + fr, fq * 16) : lds_byte(wr * 64 + fr, fq * 8), boff = F8 ? lds_byte(wc * 32 + fr, fq * 16) : lds_byte(wc * 32 + fr, fq * 8);
#define PG8_SA(b, h) (((b) * 2 + (h)) * HTB)
#define PG8_SB(b, h) ((4 + (b) * 2 + (h)) * HTB)
#define PG8_STAGE_B(bufoff, gbase) do { _Pragma("unroll") for (int _i = 0; _i < 2; ++_i) \
        __builtin_amdgcn_global_load_lds((const unsigned*)((const char*)(gbase) + voffB[_i]), (LAS unsigned*)(lds + (bufoff) + ldsw + _i * 8192), 16, 0, 0); } while (0)
#define PG8_STAGE_A(bufoff, gbase, v0, v1) do { \
        __builtin_amdgcn_global_load_lds((const unsigned*)((const char*)(gbase) + (v0)), (LAS unsigned*)(lds + (bufoff) + ldsw), 16, 0, 0); \
        __builtin_amdgcn_global_load_lds((const unsigned*)((const char*)(gbase) + (v1)), (LAS unsigned*)(lds + (bufoff) + ldsw + 8192), 16, 0, 0); } while (0)
#define PG8_FOFF(k) (F8 ? (k) * 16 : (k) * 1024)
#define PG8_LDA(dst, b, h) do { _Pragma("unroll") for (int m = 0; m < 4; ++m) { if constexpr (F8) dst##8[m] = *(const LAS v8i_t*)(lds + PG8_SA(b, h) + aoff + m * 2048); \
        else { _Pragma("unroll") for (int k = 0; k < 2; ++k) dst[m][k] = *(const LAS bf16x8*)(lds + PG8_SA(b, h) + aoff + m * 2048 + k * 1024); } } } while (0)
#define PG8_LDB(dst, b, h) do { _Pragma("unroll") for (int n = 0; n < 2; ++n) { if constexpr (F8) dst##8[n] = *(const LAS v8i_t*)(lds + PG8_SB(b, h) + boff + n * 2048); \
        else { _Pragma("unroll") for (int k = 0; k < 2; ++k) dst[n][k] = *(const LAS bf16x8*)(lds + PG8_SB(b, h) + boff + n * 2048 + k * 1024); } } } while (0)
#define PG8_CAT(x) __builtin_shufflevector(__builtin_bit_cast(v4i_t, x[0]), __builtin_bit_cast(v4i_t, x[1]), 0, 1, 2, 3, 4, 5, 6, 7)
#define PG8_MMA(ai, bj, At, Bt) do { __builtin_amdgcn_s_setprio(1); _Pragma("unroll") for (int m = 0; m < 4; ++m) _Pragma("unroll") for (int n = 0; n < 2; ++n) { \
        if constexpr (F8) acc[ai][bj][m][n] = __builtin_amdgcn_mfma_scale_f32_16x16x128_f8f6f4(Bt##8[n], At##8[m], acc[ai][bj][m][n], 0, 0, 0, S.scaleB, 0, S.scaleA); \
        else { _Pragma("unroll") for (int k = 0; k < 2; ++k) acc[ai][bj][m][n] = __builtin_amdgcn_mfma_f32_16x16x32_bf16(Bt[n][k], At[m][k], acc[ai][bj][m][n], 0, 0, 0); } } __builtin_amdgcn_s_setprio(0); } while (0)
#define PG8_WAIT_V(n) asm volatile("s_waitcnt vmcnt(" #n ")" ::: "memory")
#define PG8_WAIT_L(n) asm volatile("s_waitcnt lgkmcnt(" #n ")" ::: "memory")
#define PG8_BAR __builtin_amdgcn_s_barrier()
#define PG8_SCHED __builtin_amdgcn_sched_barrier(0)
    typename Sched::Unit cur, nxt; int ui = 0;
    if (!S.next(0, cur)) return;
    f32x4 acc[2][2][4][2];
#pragma unroll
    for (int a = 0; a < 2; ++a)
#pragma unroll
        for (int b = 0; b < 2; ++b)
#pragma unroll
            for (int m = 0; m < 4; ++m)
#pragma unroll
                for (int n = 0; n < 2; ++n) acc[a][b][m][n] = (f32x4){0.f, 0.f, 0.f, 0.f};
    bf16x8 At[4][2], B0[2][2], B1[2][2]; v8i_t At8[4], B08[2], B18[2];
    constexpr bool GA = Sched::GATHER;
    const size_t hstepA = GA ? (size_t)0 : (size_t)HALF * K * 2;
    unsigned vA[2][2];
    LAS unsigned char* hdr = lds + STAGE_BYTES;
    if constexpr (Sched::HDR) { if (wid == 0) S.hdr_issue(cur, hdr, lane); PG8_WAIT_V(0); PG8_BAR; }
    S.a_off(cur, tid, vA, hdr);
#define PG8_STAGE_AH(bufoff, base, vv, h) PG8_STAGE_A(bufoff, ((base) + (h) * hstepA), vv[GA ? (h) : 0][0], vv[GA ? (h) : 0][1])
    const char* cA = S.a_base(cur); const char* cB = S.b_base(cur);
    PG8_STAGE_B(PG8_SB(0, 0), cB); PG8_STAGE_B(PG8_SB(0, 1), cB + hstepB); PG8_STAGE_AH(PG8_SA(0, 0), cA, vA, 0); PG8_STAGE_AH(PG8_SA(0, 1), cA, vA, 1);
    if (wr == 1) PG8_BAR;
    PG8_WAIT_V(2); PG8_BAR;
    PG8_STAGE_B(PG8_SB(1, 0), cB + kstep); PG8_STAGE_AH(PG8_SA(1, 0), cA + kstep, vA, 0); PG8_STAGE_B(PG8_SB(1, 1), cB + hstepB + kstep);
    PG8_WAIT_V(6); PG8_BAR;
    int hc = 0;
    for (;;) {
        const bool has_next = S.next(ui + 1, nxt); const int hn = (hc == 2) ? 0 : hc + 1;
        const char* nA = cA; const char* nB = cB;
        if (has_next) { nA = S.a_base(nxt); nB = S.b_base(nxt); if constexpr (Sched::HDR) { if (wid == 0) S.hdr_issue(nxt, hdr + hn * 4096, lane); } }
        for (int t = 0; t < nt; t += 2) {
            const bool last = (t == nt - 2);
            const char* a1 = cA + (size_t)(t + 1) * kstep;
            const char* a2 = last ? nA : cA + (size_t)(t + 2) * kstep; const char* b2 = last ? nB : cB + (size_t)(t + 2) * kstep;
            const char* a3 = a2 + kstep; const char* b3 = b2 + kstep;
            PG8_LDB(B0, 0, 0); PG8_LDB(B1, 0, 1); PG8_SCHED; PG8_LDA(At, 0, 0); PG8_STAGE_AH(PG8_SA(1, 1), a1, vA, 1);
            if constexpr (GA) { if (last && has_next) S.a_off(nxt, tid, vA, hdr + hn * 4096); }
            PG8_WAIT_V(8); PG8_WAIT_L(0); PG8_BAR; PG8_MMA(0, 0, At, B0); PG8_MMA(0, 1, At, B1); PG8_BAR; PG8_SCHED;
            PG8_LDA(At, 0, 1); PG8_STAGE_B(PG8_SB(0, 0), b2); PG8_STAGE_B(PG8_SB(0, 1), b2 + hstepB); PG8_STAGE_AH(PG8_SA(0, 0), a2, vA, 0);
            PG8_WAIT_V(8); PG8_WAIT_L(0); PG8_BAR; PG8_MMA(1, 0, At, B0); PG8_MMA(1, 1, At, B1); PG8_BAR; PG8_SCHED;
            PG8_LDB(B0, 1, 0); PG8_LDB(B1, 1, 1); PG8_SCHED; PG8_LDA(At, 1, 0); PG8_STAGE_AH(PG8_SA(0, 1), a2, vA, 1);
            PG8_WAIT_V(8); PG8_WAIT_L(0); PG8_BAR; PG8_MMA(0, 0, At, B0); PG8_MMA(0, 1, At, B1); PG8_BAR; PG8_SCHED;
            PG8_LDA(At, 1, 1); PG8_STAGE_B(PG8_SB(1, 0), b3); PG8_STAGE_B(PG8_SB(1, 1), b3 + hstepB); PG8_STAGE_AH(PG8_SA(1, 0), a3, vA, 0);
            PG8_WAIT_V(8); PG8_WAIT_L(0); PG8_BAR; PG8_MMA(1, 0, At, B0); PG8_MMA(1, 1, At, B1); PG8_BAR; PG8_SCHED;
        }
        if (wr == 0) PG8_BAR;
        { int fr_ = fr, fq_ = fq; asm volatile("" : "+v"(fr_), "+v"(fq_)); E(acc, cur, wr, wc, fr_, fq_, hdr + hc * 4096); }
        if (!has_next) break;
#pragma unroll
        for (int a = 0; a < 2; ++a)
#pragma unroll
            for (int b = 0; b < 2; ++b)
#pragma unroll
                for (int m = 0; m < 4; ++m)
#pragma unroll
                    for (int n = 0; n < 2; ++n) acc[a][b][m][n] = (f32x4){0.f, 0.f, 0.f, 0.f};
        cur = nxt; cA = nA; cB = nB; ++ui; hc = hn;
        if (wr == 1) PG8_BAR;
    }
    PG8_WAIT_V(0);
    PG8_BAR;
#undef PG8_SA
#undef PG8_SB
#undef PG8_STAGE_A
#undef PG8_STAGE_AH
#undef PG8_STAGE_B
#undef PG8_LDA
#undef PG8_LDB
#undef PG8_MMA
#undef PG8_CAT
#undef PG8_FOFF
#undef PG8_WAIT_V
#undef PG8_WAIT_L
#undef PG8_BAR
#undef PG8_SCHED
}
}
struct Args { const float* in[N_IN]; float* out; unsigned char* ws; int ph_lo, ph_hi; };
typedef const __attribute__((address_space(4))) unsigned long long* karg_t;
struct Frame {
    karg_t ka;
    LAS unsigned char* lds;
    volatile LAS unsigned* MISC;
    gu32* ctl;
    unsigned char* ws;
    float* out;
    int tid, lane, wave, vcu, G;
};
#define WSP(T_, off) ((T_*)(F.ws + (off)))
#define KIN(k) ((const float*)F.ka[(k)])
#ifdef DBG_SEL
#define DBG_STAT(k, val) do { const float _v = (val); if ((k) == DBG_SEL) { if (fabsf(_v) < 3e38f) atomicMax((unsigned*)(F.ctl + CW_DBG), __float_as_uint(fabsf(_v))); else atomicAdd((unsigned*)(F.ctl + CW_DBG + 1), 1u); } } while (0)
#else
#define DBG_STAT(k, val) do { } while (0)
#endif
template <class P> __device__ __forceinline__ P launder_uniform(P p) {
    unsigned lo = (unsigned)(unsigned long long)p, hi = (unsigned)((unsigned long long)p >> 32);
    asm volatile("" : "+v"(lo), "+v"(hi));
    lo = __builtin_amdgcn_readfirstlane(lo); hi = __builtin_amdgcn_readfirstlane(hi);
    return (P)(((unsigned long long)hi << 32) | lo);
}
__device__ __forceinline__ void frame_refresh(Frame& F) {
    int t = F.tid; asm volatile("" : "+v"(t)); F.tid = t; F.lane = t & 63; F.wave = __builtin_amdgcn_readfirstlane(t >> 6);
    F.ws = launder_uniform(F.ws); F.ctl = (gu32*)(F.ws + WS_CTL);
    F.out = launder_uniform(F.out);
    F.ka = launder_uniform(F.ka);
}

namespace pg8 {
struct DenseSched {
    static constexpr bool GATHER = false, FP8 = false, HDR = false; static constexpr int scaleA = 0, scaleB = 0;
    struct Unit { int pm, pn; };
    __device__ __forceinline__ void hdr_issue(const Unit&, LAS unsigned char*, int) const {}
    const bf16* A; const bf16* Bt; int K; size_t hstepB; int nM, nN, nwg, G, c;
    __device__ __forceinline__ void init(const bf16* A_, const bf16* Bt_, int M, int N, int K_, int G_, int c_) { A = A_; Bt = Bt_; K = K_; hstepB = (size_t)HALF * K_ * 2; nM = M / BM; nN = N / BM; nwg = nM * nN; G = G_; c = c_; }
    __device__ __forceinline__ bool next(int i, Unit& u) const {
        const long L = (long)i * G + c; if (L >= nwg) return false;
        int wgid = (int)L; { const int q = nwg / NXCD, r = nwg % NXCD, xcd = wgid % NXCD, off = wgid / NXCD; wgid = (xcd < r ? xcd * (q + 1) : r * (q + 1) + (xcd - r) * q) + off; }
        const int nig = WGM * nN, gid = wgid / nig, fm = gid * WGM, gsz = (nM - fm) < WGM ? (nM - fm) : WGM;
        u.pm = fm + ((wgid % nig) % gsz); u.pn = (wgid % nig) / gsz; return true;
    }
    __device__ __forceinline__ const char* a_base(const Unit& u) const { return (const char*)A + (size_t)u.pm * BM * K * 2; }
    __device__ __forceinline__ const char* b_base(const Unit& u) const { return (const char*)Bt + (size_t)u.pn * BM * K * 2; }
    __device__ __forceinline__ void a_off(const Unit&, int tid, unsigned (&v)[2][2], const LAS unsigned char*) const {
#pragma unroll
        for (int i = 0; i < 2; ++i) { int R, C; stage_rc(tid * 16 + i * 8192, R, C); v[0][i] = (unsigned)(R * K + C) * 2u; v[1][i] = v[0][i]; }
    }
};
template <int SB> struct DenseSched8T : DenseSched { static constexpr bool GATHER = true, FP8 = true; static constexpr int scaleA = 0x7F7F7F7F, scaleB = SB;
    __device__ __forceinline__ void a_off(const Unit&, int tid, unsigned (&v)[2][2], const LAS unsigned char*) const {
        int t_ = tid; asm volatile("" : "+v"(t_));
#pragma unroll
        for (int i = 0; i < 2; ++i) { int R, C; stage_rc(t_ * 16 + i * 8192, R, C); v[0][i] = (unsigned)(R * K + C) * 2u; v[1][i] = v[0][i] + (unsigned)(HALF * K * 2); }
    }
};
typedef DenseSched8T<0x7A7A7A7A> DenseSched8;
typedef DenseSched8T<0x79797979> DenseSched8b;
struct MoeUnit { int e, mt, nt, cnt; };
struct MoeOrder {
    const volatile LAS unsigned* pfx;
    int NT, G, c;
    __device__ __forceinline__ bool decode(int i, MoeUnit& u) const {
        const int nwg = (int)pfx[32]; const long L = (long)i * G + c; if (L >= nwg) return false;
        int wgid = (int)L; { const int q = nwg / NXCD, r = nwg % NXCD, xcd = wgid % NXCD, off = wgid / NXCD; wgid = (xcd < r ? xcd * (q + 1) : r * (q + 1) + (xcd - r) * q) + off; }
        int e = 0;
#pragma unroll
        for (int st = 16; st >= 1; st >>= 1) e += ((int)pfx[e + st] <= wgid) ? st : 0;
        const int j = wgid - (int)pfx[e];
        u.e = e; u.mt = j / NT; u.nt = j % NT; u.cnt = (int)pfx[40 + e]; return true;
    }
};
#ifndef HDR_AOFF
#define HDR_AOFF 1
#endif
struct Moe1Sched {
    static constexpr bool GATHER = true, FP8 = (MOE_FP8 != 0), HDR = true; static constexpr int EB = FP8 ? 1 : 2; static constexpr int scaleA = 0x7F7F7F7F, scaleB = 0x7A7A7A7A;
    typedef MoeUnit Unit;
    MoeOrder O; const unsigned char* X; const unsigned char* W; const int* sdest; const float* bgu; int K; size_t hstepB;
    __device__ __forceinline__ void hdr_issue(const Unit& u, LAS unsigned char* hdr, int lane) const {
        __builtin_amdgcn_global_load_lds((const unsigned*)(sdest + (size_t)u.e * ECAP + (size_t)u.mt * 256 + lane * 4), (LAS unsigned*)hdr, 16, 0, 0);
        const float* bp = bgu + (size_t)u.e * 2048 + u.nt * 128 + (lane < 32 ? lane * 4 : 1024 + (lane - 32) * 4);
        __builtin_amdgcn_global_load_lds((const unsigned*)bp, (LAS unsigned*)(hdr + 1024), 16, 0, 0);
    }
    __device__ __forceinline__ bool next(int i, Unit& u) const { return O.decode(i, u); }
    __device__ __forceinline__ const char* a_base(const Unit&) const { return (const char*)X; }
    __device__ __forceinline__ const char* b_base(const Unit& u) const { return (const char*)W + ((size_t)u.e * 2048 + (size_t)u.nt * 128) * 1024 * EB; }
    __device__ __forceinline__ void a_off(const Unit& u, int tid, unsigned (&v)[2][2], const LAS unsigned char* hdr) const {
#pragma unroll
        for (int i = 0; i < 2; ++i) { int R, C; stage_rc(tid * 16 + i * 8192, R, C);
#pragma unroll
            for (int h = 0; h < 2; ++h) { const int sl = h * HALF + R; int tok = 0; if (u.mt * 256 + sl < u.cnt) tok = HDR_AOFF ? (((const LAS int*)hdr)[sl] >> 2) : (sdest[u.e * ECAP + u.mt * 256 + sl] >> 2); v[h][i] = (unsigned)(tok * 1024 * EB + C * 2); } }
    }
};
struct Moe2Sched {
    static constexpr bool GATHER = true, FP8 = (MOE2_FP8 != 0), HDR = true; static constexpr int EB = FP8 ? 1 : 2; static constexpr int scaleA = 0x7F7F7F7F, scaleB = 0x79797979;
    typedef MoeUnit Unit;
    MoeOrder O; const unsigned char* Ab; const unsigned char* W; const int* sdest; const float* sgate; const float* bdn; int K; size_t hstepB;
    __device__ __forceinline__ void hdr_issue(const Unit& u, LAS unsigned char* hdr, int lane) const {
        const size_t so = (size_t)u.e * ECAP + (size_t)u.mt * 256 + lane * 4;
        __builtin_amdgcn_global_load_lds((const unsigned*)(sdest + so), (LAS unsigned*)hdr, 16, 0, 0);
        __builtin_amdgcn_global_load_lds((const unsigned*)(sgate + so), (LAS unsigned*)(hdr + 1024), 16, 0, 0);
        __builtin_amdgcn_global_load_lds((const unsigned*)(bdn + (size_t)u.e * 1024 + u.nt * 256 + lane * 4), (LAS unsigned*)(hdr + 2048), 16, 0, 0);
    }
    __device__ __forceinline__ bool next(int i, Unit& u) const { return O.decode(i, u); }
    __device__ __forceinline__ const char* a_base(const Unit& u) const { return (const char*)Ab + ((size_t)u.e * ECAP + (size_t)u.mt * 256) * 1024 * EB; }
    __device__ __forceinline__ const char* b_base(const Unit& u) const { return (const char*)W + ((size_t)u.e * 1024 + (size_t)u.nt * 256) * 1024 * EB; }
    __device__ __forceinline__ void a_off(const Unit&, int tid, unsigned (&v)[2][2], const LAS unsigned char*) const {
        int t_ = tid; asm volatile("" : "+v"(t_));
#pragma unroll
        for (int i = 0; i < 2; ++i) { int R, C; stage_rc(t_ * 16 + i * 8192, R, C); v[0][i] = (unsigned)(R * 1024 * EB + C * 2); v[1][i] = v[0][i] + (unsigned)(HALF * 1024 * EB); }
    }
};

__device__ __forceinline__ void unpack8(const v4u w, f32x4& a, f32x4& b) {
    a = (f32x4){__uint_as_float(w.x << 16), __uint_as_float(w.x & 0xffff0000u), __uint_as_float(w.y << 16), __uint_as_float(w.y & 0xffff0000u)};
    b = (f32x4){__uint_as_float(w.z << 16), __uint_as_float(w.z & 0xffff0000u), __uint_as_float(w.w << 16), __uint_as_float(w.w & 0xffff0000u)}; }
struct EpiF32 {
    static constexpr bool PERM = false;
    float* C; int ldc; const float* base; float alpha;
    __device__ __forceinline__ void operator()(const f32x4 (&acc)[2][2][4][2], const DenseSched::Unit& u, int wr, int wc, int fr, int fq, const LAS unsigned char* hdr) const {
        const int row0 = u.pm * BM + wr * 64 + fr, col0 = u.pn * BM + wc * 32 + 4 * fq;
#pragma unroll
        for (int ai = 0; ai < 2; ++ai)
#pragma unroll
            for (int m = 0; m < 4; ++m) { const size_t ro = (size_t)(row0 + ai * HALF + m * 16) * ldc + col0;
#pragma unroll
                for (int bj = 0; bj < 2; ++bj)
#pragma unroll
                    for (int n = 0; n < 2; ++n) { f32x4 v = acc[ai][bj][m][n];
                        if (base) { const f32x4 b = *(const f32x4*)(base + ro + bj * HALF + n * 16); v = v + b * alpha; }
                        *(f32x4*)(C + ro + bj * HALF + n * 16) = v; } }
    }
};
struct EpiB16 {
    static constexpr bool PERM = true;
    bf16* O; int ldc; const bf16* base; float alpha;
    __device__ __forceinline__ void operator()(const f32x4 (&acc)[2][2][4][2], const DenseSched::Unit& u, int wr, int wc, int fr, int fq, const LAS unsigned char* hdr) const {
        const int row0 = u.pm * BM + wr * 64 + fr, col0 = u.pn * BM + wc * 32 + 8 * fq;
#pragma unroll
        for (int ai = 0; ai < 2; ++ai) {
            v4u bw[4][2];
            if (base) {
#pragma unroll
                for (int m = 0; m < 4; ++m)
#pragma unroll
                    for (int bj = 0; bj < 2; ++bj) bw[m][bj] = *(const v4u*)(base + (size_t)(row0 + ai * HALF + m * 16) * ldc + col0 + bj * HALF); }
#pragma unroll
            for (int m = 0; m < 4; ++m) { bf16* rowp = O + (size_t)(row0 + ai * HALF + m * 16) * ldc + col0;
#pragma unroll
                for (int bj = 0; bj < 2; ++bj) { f32x4 v0 = acc[ai][bj][m][0], v1 = acc[ai][bj][m][1];
                    if (base) { f32x4 b0, b1; unpack8(bw[m][bj], b0, b1); v0 = v0 + b0 * alpha; v1 = v1 + b1 * alpha; }
                    v4u w; w.x = cvt_pk_bf16(v0[0], v0[1]); w.y = cvt_pk_bf16(v0[2], v0[3]); w.z = cvt_pk_bf16(v1[0], v1[1]); w.w = cvt_pk_bf16(v1[2], v1[3]);
                    *(v4u*)(rowp + bj * HALF) = w; } } }
    }
};
struct EpiPle {
    static constexpr bool PERM = true;
    bf16* C; const bf16* hb; const bf16* pe;
    __device__ __forceinline__ void operator()(const f32x4 (&acc)[2][2][4][2], const DenseSched::Unit& u, int wr, int wc, int fr, int fq, const LAS unsigned char* hdr) const {
        const int row0 = u.pm * BM + wr * 64 + fr, col0 = u.pn * BM + wc * 32 + 8 * fq;
#pragma unroll
        for (int ai = 0; ai < 2; ++ai) {
            v4u hw[4][2], pw[4][2];
#pragma unroll
            for (int m = 0; m < 4; ++m)
#pragma unroll
                for (int bj = 0; bj < 2; ++bj) { const size_t ro = (size_t)(row0 + ai * HALF + m * 16) * 1024 + col0 + bj * HALF; hw[m][bj] = *(const v4u*)(hb + ro); pw[m][bj] = *(const v4u*)(pe + ro); }
#pragma unroll
            for (int m = 0; m < 4; ++m)
#pragma unroll
                for (int bj = 0; bj < 2; ++bj) { const size_t ro = (size_t)(row0 + ai * HALF + m * 16) * 1024 + col0 + bj * HALF;
                    f32x4 h0, h1, p0, p1; unpack8(hw[m][bj], h0, h1); unpack8(pw[m][bj], p0, p1); const f32x4 a0 = acc[ai][bj][m][0], a1 = acc[ai][bj][m][1];
                    f32x4 o0, o1;
#pragma unroll
                    for (int j = 0; j < 4; ++j) { o0[j] = h0[j] + sigmoidf_(a0[j]) * p0[j]; o1[j] = h1[j] + sigmoidf_(a1[j]) * p1[j]; }
                    v4u w; w.x = cvt_pk_bf16(o0[0], o0[1]); w.y = cvt_pk_bf16(o0[2], o0[3]); w.z = cvt_pk_bf16(o1[0], o1[1]); w.w = cvt_pk_bf16(o1[2], o1[3]);
                    *(v4u*)(C + ro) = w; } }
    }
};
struct EpiMoe1 {
    static constexpr bool PERM = true;
    bf16* Ab; const float* bgu; unsigned char* AbQ;
    __device__ __forceinline__ void operator()(const f32x4 (&acc)[2][2][4][2], const MoeUnit& u, int wr, int wc, int fr, int fq, const LAS unsigned char* hdr) const {
        const int col0 = u.nt * 128 + wc * 32 + 8 * fq;
        const LAS float* bh = (const LAS float*)(hdr + 1024) + wc * 32 + 8 * fq;
        const f32x4 bg0 = *(const LAS f32x4*)(bh), bg1 = *(const LAS f32x4*)(bh + 4), bl0 = *(const LAS f32x4*)(bh + 128), bl1 = *(const LAS f32x4*)(bh + 132);
#pragma unroll
        for (int ai = 0; ai < 2; ++ai)
#pragma unroll
            for (int m = 0; m < 4; ++m) { const int r = ai * HALF + wr * 64 + m * 16 + fr;
                bf16* rowp = Ab + ((size_t)u.e * ECAP + (size_t)u.mt * 256 + r) * 1024 + col0;
                float o[8];
#pragma unroll
                for (int n = 0; n < 2; ++n) { const f32x4 g4 = acc[ai][0][m][n] + (n ? bg1 : bg0), l4 = acc[ai][1][m][n] + (n ? bl1 : bl0);
#pragma unroll
                    for (int j = 0; j < 4; ++j) { const float g = fminf(g4[j], 7.0f), l = fminf(fmaxf(l4[j], -7.0f), 7.0f); o[n * 4 + j] = (l + 1.0f) * g * sigmoidf_(1.702f * g); } }
                if constexpr (MOE2_FP8) { v2u q; q.x = cvt4_fp8(o[0], o[1], o[2], o[3]); q.y = cvt4_fp8(o[4], o[5], o[6], o[7]); *(v2u*)((unsigned char*)AbQ + ((size_t)u.e * ECAP + (size_t)u.mt * 256 + r) * 1024 + col0) = q; }
                else *(v4u*)rowp = pack8(o); }
    }
};
struct EpiMoe2 {
    static constexpr bool PERM = true;
    bf16* Y; const float* bdn; const int* sdest; const float* sgate;
    __device__ __forceinline__ void operator()(const f32x4 (&acc)[2][2][4][2], const MoeUnit& u, int wr, int wc, int fr, int fq, const LAS unsigned char* hdr) const {
        const int col0 = u.nt * 256 + wc * 32 + 8 * fq;
        const LAS float* bp = (const LAS float*)(hdr + 2048) + wc * 32 + 8 * fq;
#pragma unroll
        for (int ai = 0; ai < 2; ++ai) {
            f32x4 bv[2][2];
#pragma unroll
            for (int bj = 0; bj < 2; ++bj)
#pragma unroll
                for (int n = 0; n < 2; ++n) bv[bj][n] = *(const LAS f32x4*)(bp + bj * HALF + 4 * n);
            int dest[4]; float gate[4];
#pragma unroll
            for (int m = 0; m < 4; ++m) { const int sl = ai * HALF + wr * 64 + m * 16 + fr; const bool ok = u.mt * 256 + sl < u.cnt;
                dest[m] = ok ? ((const LAS int*)hdr)[sl] : T * 4; gate[m] = ok ? ((const LAS float*)(hdr + 1024))[sl] : 0.f; }
#pragma unroll
            for (int m = 0; m < 4; ++m) {
                { const float g = gate[m]; bf16* rowp = Y + (size_t)dest[m] * 1024 + col0;
#pragma unroll
                    for (int bj = 0; bj < 2; ++bj) { const f32x4 v0 = (acc[ai][bj][m][0] + bv[bj][0]) * g, v1 = (acc[ai][bj][m][1] + bv[bj][1]) * g;
                        v4u w; w.x = cvt_pk_bf16(v0[0], v0[1]); w.y = cvt_pk_bf16(v0[2], v0[3]); w.z = cvt_pk_bf16(v1[0], v1[1]); w.w = cvt_pk_bf16(v1[2], v1[3]);
                        *(v4u*)(rowp + bj * HALF) = w; } } } }
    }
};
}

__device__ __forceinline__ void p0_transpose_item(const float* W, int K, int N, int nblk, bf16* WT, int item, int lane) {
    const int kb = item / nblk, nb = item % nblk, k0 = 64 * kb, n = 64 * nb + lane;
    const bool ok = n < N; const float* src = W + (size_t)k0 * N + (ok ? n : 0);
    float x[64];
#pragma unroll
    for (int j = 0; j < 64; ++j) x[j] = __builtin_nontemporal_load(src + (size_t)j * N);
    bf16* dst = WT + (size_t)n * K + k0;
#pragma unroll
    for (int q = 0; q < 8; ++q) { v4u o; o.x = cvt_pk_bf16(x[8 * q], x[8 * q + 1]); o.y = cvt_pk_bf16(x[8 * q + 2], x[8 * q + 3]); o.z = cvt_pk_bf16(x[8 * q + 4], x[8 * q + 5]); o.w = cvt_pk_bf16(x[8 * q + 6], x[8 * q + 7]);
        if (!ok) o = (v4u){0u, 0u, 0u, 0u};
        *(v4u*)(dst + 8 * q) = o; }
}
__device__ __forceinline__ void cvt_rows(const float* src, bf16* dst, size_t n8, size_t i0, size_t stride) {
    for (size_t i = i0; i < n8; i += stride) { const f32x4 a = *(const f32x4*)(src + i * 8), b = *(const f32x4*)(src + i * 8 + 4);
        v4u o; o.x = cvt_pk_bf16(a.x, a.y); o.y = cvt_pk_bf16(a.z, a.w); o.z = cvt_pk_bf16(b.x, b.y); o.w = cvt_pk_bf16(b.z, b.w); *(v4u*)(dst + i * 8) = o; }
}
__device__ __forceinline__ void p0_prologue(Frame& F, const Args& A) {
    const int gw = F.vcu * NWAVES + F.wave, NGW = F.G * NWAVES;
    constexpr int I_IN = 16 * (NUP / 64), I_OUT = 16 * 16, I_GU = 16 * 32, I_DN = 16 * 16, I_PG = 16 * 16, I_PP = 4 * 16;
    constexpr int PER_LAYER = I_IN + I_OUT + NE * I_GU + NE * I_DN + I_PG + I_PP;
#pragma unroll 1
    for (int it = gw; it < DEPTH * PER_LAYER; it += NGW) {
        const int l = it / PER_LAYER; int r = it % PER_LAYER;
        const float* W; bf16* WT; int K = D, N = D, nblk = 16;
        if (r < I_IN) { W = KIN(I_WIN) + (size_t)l * D * NU; WT = WSP(bf16, WS_WIN_T) + (size_t)l * NUP * D; N = NU; nblk = NUP / 64; }
        else if ((r -= I_IN) < I_OUT) { if (OUT_FP8) continue; W = KIN(I_WOUT) + (size_t)l * D * D; WT = WSP(bf16, WS_WOUT_T) + (size_t)l * D * D; }
        else if ((r -= I_OUT) < NE * I_GU) { if (MOE_FP8) continue; const int e = r / I_GU; r %= I_GU; W = KIN(I_WGU) + ((size_t)l * NE + e) * D * 2048; WT = WSP(bf16, WS_WGU_T) + ((size_t)l * NE + e) * 2048 * D; N = 2048; nblk = 32; }
        else if ((r -= NE * I_GU) < NE * I_DN) { if (MOE2_FP8) continue; const int e = r / I_DN; r %= I_DN; W = KIN(I_WDN) + ((size_t)l * NE + e) * D * D; WT = WSP(bf16, WS_WDN_T) + ((size_t)l * NE + e) * D * D; }
        else if ((r -= NE * I_DN) < I_PG) { if (PLE_FP8) continue; W = KIN(I_PGW) + (size_t)l * D * D; WT = WSP(bf16, WS_WPG_T) + (size_t)l * D * D; }
        else { r -= I_PG; W = KIN(I_PPJ) + (size_t)l * 256 * D; WT = WSP(bf16, WS_WPP_T) + (size_t)l * D * 256; K = 256; }
        p0_transpose_item(W, K, N, nblk, WT, r, F.lane);
    }
#if MOE_FP8
    constexpr int Q_GU = 16 * 32, Q_DN = 16 * 16, Q_PG = PLE_FP8 ? 16 * 16 : 0, Q_OUT = OUT_FP8 ? 16 * 16 : 0, Q_PER_LAYER = NE * (Q_GU + Q_DN) + Q_PG + Q_OUT;
#pragma unroll 1
    for (int it = gw; it < DEPTH * Q_PER_LAYER; it += NGW) {
        const int l = it / Q_PER_LAYER; int r = it % Q_PER_LAYER; const float* W; unsigned char* WQ; int N; float sc;
        if (r < NE * Q_GU) { const int e = r / Q_GU; r %= Q_GU; W = KIN(I_WGU) + ((size_t)l * NE + e) * D * 2048; WQ = WSP(unsigned char, WS_WGU_Q) + ((size_t)l * NE + e) * 2048 * D; N = 2048; sc = 32.0f; }
        else if (r >= NE * (Q_GU + Q_DN) + Q_PG) { r -= NE * (Q_GU + Q_DN) + Q_PG; W = KIN(I_WOUT) + (size_t)l * D * D; WQ = WSP(unsigned char, WS_WOUT_Q) + (size_t)l * D * D; N = D; sc = 64.0f; }
        else if (r >= NE * (Q_GU + Q_DN)) { r -= NE * (Q_GU + Q_DN); W = KIN(I_PGW) + (size_t)l * D * D; WQ = WSP(unsigned char, WS_WPG_Q) + (size_t)l * D * D; N = D; sc = 32.0f; }
        else { if (!MOE2_FP8) continue; r -= NE * Q_GU; const int e = r / Q_DN; r %= Q_DN; W = KIN(I_WDN) + ((size_t)l * NE + e) * D * D; WQ = WSP(unsigned char, WS_WDN_Q) + ((size_t)l * NE + e) * D * D; N = D; sc = 64.0f; }
        const int nblk = N / 64, kb = r / nblk, nb = r % nblk, k0 = 64 * kb, n = 64 * nb + F.lane;
        const float* src = W + (size_t)k0 * N + n; float x[64];
#pragma unroll
        for (int j = 0; j < 64; ++j) x[j] = __builtin_nontemporal_load(src + (size_t)j * N) * sc;
        unsigned char* dst = WQ + (size_t)n * D + k0;
#pragma unroll
        for (int q = 0; q < 4; ++q) { v4u o; o.x = cvt4_fp8(x[16 * q], x[16 * q + 1], x[16 * q + 2], x[16 * q + 3]); o.y = cvt4_fp8(x[16 * q + 4], x[16 * q + 5], x[16 * q + 6], x[16 * q + 7]);
            o.z = cvt4_fp8(x[16 * q + 8], x[16 * q + 9], x[16 * q + 10], x[16 * q + 11]); o.w = cvt4_fp8(x[16 * q + 12], x[16 * q + 13], x[16 * q + 14], x[16 * q + 15]); *(v4u*)(dst + 16 * q) = o; }
    }
#endif
    const size_t gt = (size_t)F.vcu * (NWAVES * 64) + F.tid, NT_ = (size_t)F.G * NWAVES * 64;
    cvt_rows(KIN(I_P), WSP(bf16, WS_PB), (size_t)DEPTH * T * 256 / 8, gt, NT_);
    cvt_rows(KIN(I_X), WSP(bf16, WS_XB), (size_t)T * D / 8, gt, NT_);
    for (size_t i = gt; i < (size_t)DEPTH * LORA_PER_LAYER; i += NT_) { const int l = (int)(i / LORA_PER_LAYER); int r = (int)(i % LORA_PER_LAYER); float v;
        if (r < 8192) { const int ch = r >> 5, j = r & 31; v = KIN(I_RWUP)[(size_t)l * 8192 + j * 256 + ch]; }
        else if (r < 16384) { r -= 8192; const int ch = r >> 5, j = r & 31; v = KIN(I_RAUP)[(size_t)l * 8192 + j * 256 + ch]; }
        else if (r < 32768) { r -= 16384; const int ch = r >> 6, j = r & 63; v = KIN(I_RGUP)[(size_t)l * 16384 + j * 256 + ch]; }
        else { r -= 32768; const int d = r >> 4, j = r & 15; v = KIN(I_GGUP)[(size_t)l * 2048 + j * 128 + d]; }
        WSP(float, WS_LORA)[i] = v; }
#if P6_MFMA
    for (size_t i = gt; i < (size_t)DEPTH * 32768; i += NT_) { const int l = (int)(i >> 15), r = (int)(i & 32767), c = r >> 8, e = (r >> 3) & 31, k = 8 * c + (r & 7);
        const float v = KIN(I_RTW)[(size_t)l * D * NE + (size_t)k * NE + e]; const unsigned h = cvt_pk_bf16(v, 0.f) & 0xffffu; const unsigned lo = cvt_pk_bf16(v - __uint_as_float(h << 16), 0.f) & 0xffffu;
        unsigned short* dst = WSP(unsigned short, WS_RWT) + (size_t)l * 65536 + r; dst[0] = (unsigned short)h; dst[32768] = (unsigned short)lo; }
#else
    for (size_t i = gt; i < (size_t)DEPTH * NE * D; i += NT_) { const int l = (int)(i / (NE * D)), r = (int)(i % (NE * D)), e = r / D, k = r % D; WSP(float, WS_RWT)[i] = KIN(I_RTW)[(size_t)l * D * NE + (size_t)k * NE + e]; }
#endif
}

#if P6_MFMA
template <bool DRY> __device__ __forceinline__ void p6_ln1_router(Frame& F, const Args& A, int layer) {
    const bf16* y1 = WSP(bf16, WS_Y1); bf16* x1b = WSP(bf16, WS_X1B);
    const float* gam = KIN(I_LN1G) + layer * D; const float* bet = KIN(I_LN1B) + layer * D;
    const unsigned char* rwq = WSP(unsigned char, WS_RWT) + (size_t)layer * 131072; const float* rb = KIN(I_RTB) + layer * NE;
    int* sdest = WSP(int, WS_SDEST); float* sgate = WSP(float, WS_SGATE);
    unsigned* cnt = (unsigned*)(F.ctl + CW_CNT + layer * NE * 16);
    LAS unsigned char* WL = F.lds;
    LAS float* LG = (LAS float*)(F.lds + 131072);
    LAS float* TOPV = (LAS float*)(F.lds + 139264) + F.wave * 64;
    LAS int* TOPE = (LAS int*)(F.lds + 139264 + 2048) + F.wave * 64;
    LAS float* STAT = (LAS float*)(F.lds + 143360);
    volatile LAS unsigned* lcnt = F.MISC + MW_LCNT; volatile LAS unsigned* lbase = F.MISC + MW_LBASE;
    { const int l0 = F.lane;
#pragma unroll
      for (int i = 0; i < 16; ++i) { const int off = (F.wave * 16 + i) * 1024; __builtin_amdgcn_global_load_lds((const unsigned*)(rwq + off + l0 * 16), (LAS unsigned*)(WL + off), 16, 0, 0); } }
    const int lane = F.lane, m = lane & 15, g = lane >> 4, rq = F.wave & 3, kh = F.wave >> 2;
    for (int blk = F.vcu; blk < T / 64; blk += F.G) {
        if (F.tid < 32) lcnt[F.tid] = 0u;
        const int row = blk * 64 + rq * 16 + m; const size_t ro = (size_t)row * D + 512 * kh + 8 * g;
        v4u yw[16];
#pragma unroll
        for (int kk = 0; kk < 16; ++kk) yw[kk] = *(const v4u*)(y1 + ro + 32 * kk);
        float s = 0.f, s2 = 0.f;
#pragma unroll
        for (int kk = 0; kk < 16; ++kk) { f32x4 a, b; pg8::unpack8(yw[kk], a, b); s += ((a.x + a.y) + (a.z + a.w)) + ((b.x + b.y) + (b.z + b.w));
            s2 += ((a.x * a.x + a.y * a.y) + (a.z * a.z + a.w * a.w)) + ((b.x * b.x + b.y * b.y) + (b.z * b.z + b.w * b.w)); }
        s += __shfl_xor(s, 16); s += __shfl_xor(s, 32); s2 += __shfl_xor(s2, 16); s2 += __shfl_xor(s2, 32);
        if (g == 0) { STAT[(kh * 64 + rq * 16 + m) * 2] = s; STAT[(kh * 64 + rq * 16 + m) * 2 + 1] = s2; }
        asm volatile("s_waitcnt vmcnt(0)" ::: "memory");
        __syncthreads();
        const float st = STAT[(rq * 16 + m) * 2] + STAT[(64 + rq * 16 + m) * 2], st2 = STAT[(rq * 16 + m) * 2 + 1] + STAT[(64 + rq * 16 + m) * 2 + 1];
        const float mean = st * (1.f / D); const float rstd = __builtin_amdgcn_rsqf(fmaxf(st2 * (1.f / D) - mean * mean, 0.f) + LN_EPS);
        f32x4 acc[2] = {(f32x4){0.f, 0.f, 0.f, 0.f}, (f32x4){0.f, 0.f, 0.f, 0.f}}; const float* gp = gam; const float* bp = bet;
#pragma unroll
        for (int kk = 0; kk < 16; ++kk) { const int k0 = 512 * kh + 32 * kk + 8 * g;
            if ((kk & 3) == 0) { gp = launder_uniform(gp); bp = launder_uniform(bp); }
            const f32x4 ga = *(const f32x4*)(gp + k0), gb = *(const f32x4*)(gp + k0 + 4), ba = *(const f32x4*)(bp + k0), bb = *(const f32x4*)(bp + k0 + 4);
            f32x4 a, b; { v4u yk = yw[kk]; asm volatile("" : "+v"(yk)); pg8::unpack8(yk, a, b); }
            a = (a - mean) * rstd * ga + ba; b = (b - mean) * rstd * gb + bb;
            v4u hw; hw.x = cvt_pk_bf16(a.x, a.y); hw.y = cvt_pk_bf16(a.z, a.w); hw.z = cvt_pk_bf16(b.x, b.y); hw.w = cvt_pk_bf16(b.z, b.w);
            *(v4u*)(x1b + (size_t)row * D + k0) = hw;
            if (MOE_FP8) { v2u q; q.x = cvt4_fp8(a.x, a.y, a.z, a.w); q.y = cvt4_fp8(b.x, b.y, b.z, b.w); *(v2u*)(WSP(unsigned char, WS_X1Q) + (size_t)row * D + k0) = q; }
            f32x4 ha, hb_; pg8::unpack8(hw, ha, hb_); a = a - ha; b = b - hb_;
            v4u lw; lw.x = cvt_pk_bf16(a.x, a.y); lw.y = cvt_pk_bf16(a.z, a.w); lw.z = cvt_pk_bf16(b.x, b.y); lw.w = cvt_pk_bf16(b.z, b.w);
            const bf16x8 xh = __builtin_bit_cast(bf16x8, hw), xl = __builtin_bit_cast(bf16x8, lw);
            const int c = kh * 64 + kk * 4 + g;
#pragma unroll
            for (int nt = 0; nt < 2; ++nt) { const bf16x8 wh = *(const LAS bf16x8*)(WL + (c * 32 + nt * 16 + m) * 16), wl = *(const LAS bf16x8*)(WL + 65536 + (c * 32 + nt * 16 + m) * 16);
                acc[nt] = __builtin_amdgcn_mfma_f32_16x16x32_bf16(wh, xh, acc[nt], 0, 0, 0);
                acc[nt] = __builtin_amdgcn_mfma_f32_16x16x32_bf16(wl, xh, acc[nt], 0, 0, 0);
                acc[nt] = __builtin_amdgcn_mfma_f32_16x16x32_bf16(wh, xl, acc[nt], 0, 0, 0); } }
        if (kh == 1) {
#pragma unroll
            for (int nt = 0; nt < 2; ++nt) *(LAS f32x4*)(LG + (rq * 16 + m) * 32 + nt * 16 + 4 * g) = acc[nt]; }
        __syncthreads();
        if (kh == 0) {
#pragma unroll
            for (int nt = 0; nt < 2; ++nt) { const f32x4 o = *(const LAS f32x4*)(LG + (rq * 16 + m) * 32 + nt * 16 + 4 * g); const f32x4 rbv = *(const f32x4*)(rb + nt * 16 + 4 * g);
                *(LAS f32x4*)(LG + (rq * 16 + m) * 32 + nt * 16 + 4 * g) = o + acc[nt] + rbv; } }
        __syncthreads();
        int lane2 = lane; asm volatile("" : "+v"(lane2)); const int sub = lane2 & 15;
#pragma unroll 1
        for (int rg = 0; rg < 2; ++rg) {
            float lg[32];
            { const LAS float* lr = LG + (F.wave * 8 + rg * 4 + (lane2 >> 4)) * 32;
#pragma unroll
              for (int q = 0; q < 8; ++q) { const f32x4 t4 = *(const LAS f32x4*)(lr + 4 * q); lg[4 * q] = t4.x; lg[4 * q + 1] = t4.y; lg[4 * q + 2] = t4.z; lg[4 * q + 3] = t4.w; } }
            float la = 0.f, lb_ = 0.f;
#pragma unroll
            for (int e = 0; e < 32; ++e) { if (e == 2 * sub) la = lg[e]; if (e == 2 * sub + 1) lb_ = lg[e]; }
            int ra = 0, rbk = 0;
#pragma unroll
            for (int e = 0; e < 32; ++e) { ra += (lg[e] > la || (lg[e] == la && e < 2 * sub)) ? 1 : 0; rbk += (lg[e] > lb_ || (lg[e] == lb_ && e < 2 * sub + 1)) ? 1 : 0; }
            const int rowl = rg * 4 + (lane2 >> 4);
            if (ra < 4) { TOPV[rowl * 4 + ra] = la; TOPE[rowl * 4 + ra] = 2 * sub; }
            if (rbk < 4) { TOPV[rowl * 4 + rbk] = lb_; TOPE[rowl * 4 + rbk] = 2 * sub + 1; }
        }
        LDS_WAIT();
        int my_e = 0; float my_g = 0.f; unsigned my_r = 0u;
        if (lane2 < 32) { const int ri = lane2 >> 2, k = lane2 & 3; const f32x4 tv = *(const LAS f32x4*)(TOPV + ri * 4);
            const float e1 = __expf(tv.y - tv.x), e2 = __expf(tv.z - tv.x), e3 = __expf(tv.w - tv.x); const float inv = __builtin_amdgcn_rcpf(1.0f + e1 + e2 + e3);
            my_e = TOPE[ri * 4 + k]; my_g = (k == 0 ? 1.0f : k == 1 ? e1 : k == 2 ? e2 : e3) * inv;
            my_r = DRY ? 0u : atomicAdd((unsigned*)&lcnt[my_e], 1u); }
        __syncthreads();
        if (!DRY && F.wave == 0 && lane2 < 32) { const unsigned n = lcnt[lane2]; lbase[lane2] = n ? __hip_atomic_fetch_add(cnt + lane2 * 16, n, RLX_AGENT) : 0u; }
        __syncthreads();
        if (!DRY && lane2 < 32) { const int rw = blk * 64 + F.wave * 8 + (lane2 >> 2); const unsigned slot = (unsigned)my_e * ECAP + lbase[my_e] + my_r;
            sdest[slot] = rw * 4 + (lane2 & 3); sgate[slot] = my_g; }
        __syncthreads();
    }
}
#else
template <bool DRY> __device__ __forceinline__ void p6_ln1_router(Frame& F, const Args& A, int layer) {
    const bf16* y1 = WSP(bf16, WS_Y1); bf16* x1b = WSP(bf16, WS_X1B);
    const float* g = KIN(I_LN1G) + layer * D; const float* bb = KIN(I_LN1B) + layer * D;
    const float* rwt = WSP(float, WS_RWT) + (size_t)layer * NE * D; const float* rb = KIN(I_RTB) + layer * NE;
    int* sdest = WSP(int, WS_SDEST); float* sgate = WSP(float, WS_SGATE);
    unsigned* cnt = (unsigned*)(F.ctl + CW_CNT + layer * NE * 16);
    LAS float* RWT = (LAS float*)F.lds;
    LAS float* TOPV = (LAS float*)(F.lds + 131072) + F.wave * 64;
    LAS int* TOPE = (LAS int*)(F.lds + 131072 + 2048) + F.wave * 64;
    volatile LAS unsigned* lcnt = F.MISC + MW_LCNT; volatile LAS unsigned* lbase = F.MISC + MW_LBASE;
    for (int i = F.tid; i < NE * D / 4; i += NWAVES * 64) ((LAS f32x4*)RWT)[i] = ((const f32x4*)rwt)[i];
    const int lane = F.lane, sub = lane & 15;
    for (int blk = F.vcu; blk < T / 64; blk += F.G) {
        if (F.tid < 32) lcnt[F.tid] = 0u;
        __syncthreads();
#pragma unroll 1
        for (int rg = 0; rg < 2; ++rg) {
            f32x4 v[4][4];
            { int lo_ = lane; asm volatile("" : "+v"(lo_));
              const f32x4 gv[4] = { *(const f32x4*)(g + 4 * lo_), *(const f32x4*)(g + 256 + 4 * lo_), *(const f32x4*)(g + 512 + 4 * lo_), *(const f32x4*)(g + 768 + 4 * lo_) };
              const f32x4 bv[4] = { *(const f32x4*)(bb + 4 * lo_), *(const f32x4*)(bb + 256 + 4 * lo_), *(const f32x4*)(bb + 512 + 4 * lo_), *(const f32x4*)(bb + 768 + 4 * lo_) };
#pragma unroll
              for (int r = 0; r < 4; ++r) { const int row = blk * 64 + F.wave * 8 + rg * 4 + r; const bf16* yr = y1 + (size_t)row * D; float s = 0.f;
#pragma unroll
                  for (int j = 0; j < 4; ++j) { const v2u w = *(const v2u*)(yr + 256 * j + 4 * lane); v[r][j] = (f32x4){__uint_as_float(w.x << 16), __uint_as_float(w.x & 0xffff0000u), __uint_as_float(w.y << 16), __uint_as_float(w.y & 0xffff0000u)}; s += (v[r][j].x + v[r][j].y) + (v[r][j].z + v[r][j].w); }
                  const float mean = wave_sum(s) * (1.f / D); float s2 = 0.f;
#pragma unroll
                  for (int j = 0; j < 4; ++j) { v[r][j] = v[r][j] - mean; s2 += (v[r][j].x * v[r][j].x + v[r][j].y * v[r][j].y) + (v[r][j].z * v[r][j].z + v[r][j].w * v[r][j].w); }
                  const float rstd = __builtin_amdgcn_rsqf(wave_sum(s2) * (1.f / D) + LN_EPS);
#pragma unroll
                  for (int j = 0; j < 4; ++j) { v[r][j] = v[r][j] * rstd * gv[j] + bv[j];
                      v2u o; o.x = cvt_pk_bf16(v[r][j].x, v[r][j].y); o.y = cvt_pk_bf16(v[r][j].z, v[r][j].w); *(v2u*)(x1b + (size_t)row * D + 256 * j + 4 * lane) = o;
                      if (MOE_FP8) *(unsigned*)(WSP(unsigned char, WS_X1Q) + (size_t)row * D + 256 * j + 4 * lane) = cvt4_fp8(v[r][j].x, v[r][j].y, v[r][j].z, v[r][j].w); } } }
            float lg[32];
#pragma unroll
            for (int e = 0; e < 32; ++e) { f32x2 p2[4] = {(f32x2){0.f, 0.f}, (f32x2){0.f, 0.f}, (f32x2){0.f, 0.f}, (f32x2){0.f, 0.f}};
#pragma unroll
                for (int j = 0; j < 4; ++j) { const f32x4 w = *(const LAS f32x4*)(RWT + e * D + 256 * j + 4 * lane);
#pragma unroll
                    for (int r = 0; r < 4; ++r) { p2[r] = v[r][j].xy * w.xy + p2[r]; p2[r] = v[r][j].zw * w.zw + p2[r]; } }
                float p[4] = {p2[0].x + p2[0].y, p2[1].x + p2[1].y, p2[2].x + p2[2].y, p2[3].x + p2[3].y};
                { const bool hi = (lane & 32) != 0; const float k0 = hi ? p[2] : p[0], s0 = hi ? p[0] : p[2], k1 = hi ? p[3] : p[1], s1 = hi ? p[1] : p[3]; p[0] = k0 + __shfl_xor(s0, 32); p[1] = k1 + __shfl_xor(s1, 32); }
                { const bool hi = (lane & 16) != 0; const float k0 = hi ? p[1] : p[0], s0 = hi ? p[0] : p[1]; p[0] = k0 + __shfl_xor(s0, 16); }
                float t = p[0]; t += __shfl_xor(t, 8); t += __shfl_xor(t, 4); t += __shfl_xor(t, 2); t += __shfl_xor(t, 1);
                lg[e] = t + rb[e]; }
            float la = 0.f, lb_ = 0.f;
#pragma unroll
            for (int e = 0; e < 32; ++e) { if (e == 2 * sub) la = lg[e]; if (e == 2 * sub + 1) lb_ = lg[e]; }
            int ra = 0, rbk = 0;
#pragma unroll
            for (int e = 0; e < 32; ++e) { ra += (lg[e] > la || (lg[e] == la && e < 2 * sub)) ? 1 : 0; rbk += (lg[e] > lb_ || (lg[e] == lb_ && e < 2 * sub + 1)) ? 1 : 0; }
            const int rowl = rg * 4 + (lane >> 4);
            if (ra < 4) { TOPV[rowl * 4 + ra] = la; TOPE[rowl * 4 + ra] = 2 * sub; }
            if (rbk < 4) { TOPV[rowl * 4 + rbk] = lb_; TOPE[rowl * 4 + rbk] = 2 * sub + 1; }
        }
        LDS_WAIT();
        int my_e = 0; float my_g = 0.f; unsigned my_r = 0u;
        if (lane < 32) { const int ri = lane >> 2, k = lane & 3; const f32x4 tv = *(const LAS f32x4*)(TOPV + ri * 4);
            const float e1 = __expf(tv.y - tv.x), e2 = __expf(tv.z - tv.x), e3 = __expf(tv.w - tv.x); const float inv = __builtin_amdgcn_rcpf(1.0f + e1 + e2 + e3);
            my_e = TOPE[ri * 4 + k]; my_g = (k == 0 ? 1.0f : k == 1 ? e1 : k == 2 ? e2 : e3) * inv;
            my_r = DRY ? 0u : atomicAdd((unsigned*)&lcnt[my_e], 1u); }
        __syncthreads();
        if (!DRY && F.tid < 32) { const unsigned n = lcnt[F.tid]; lbase[F.tid] = n ? __hip_atomic_fetch_add(cnt + F.tid * 16, n, RLX_AGENT) : 0u; }
        __syncthreads();
        if (!DRY && lane < 32) { const int row = blk * 64 + F.wave * 8 + (lane >> 2); const unsigned slot = (unsigned)my_e * ECAP + lbase[my_e] + my_r;
            sdest[slot] = row * 4 + (lane & 3); sgate[slot] = my_g; }
        __syncthreads();
    }
}
#endif
__device__ __forceinline__ void p9_combine(Frame& F, const Args& A) {
    const bf16* x1b = WSP(bf16, WS_X1B); const bf16* yb = WSP(bf16, WS_YBUF); bf16* hb = WSP(bf16, WS_HB);
    const int gw = F.vcu * NWAVES + F.wave, NGW = F.G * NWAVES, lane = F.lane;
    for (int row = gw; row < T; row += NGW) {
        v4u y[4][2], xw[2];
#pragma unroll
        for (int j = 0; j < 2; ++j) {
#pragma unroll
            for (int k = 0; k < 4; ++k) y[k][j] = *(const v4u*)(yb + ((size_t)row * 4 + k) * D + 512 * j + 8 * lane);
            xw[j] = *(const v4u*)(x1b + (size_t)row * D + 512 * j + 8 * lane); }
#pragma unroll
        for (int j = 0; j < 2; ++j) { f32x4 v0, v1; pg8::unpack8(xw[j], v0, v1); v0 = v0 * DN_ALPHA; v1 = v1 * DN_ALPHA;
#pragma unroll
            for (int k = 0; k < 4; ++k) { f32x4 a, b; pg8::unpack8(y[k][j], a, b); v0 = v0 + a; v1 = v1 + b; }
            v4u wv; wv.x = cvt_pk_bf16(v0.x, v0.y); wv.y = cvt_pk_bf16(v0.z, v0.w); wv.z = cvt_pk_bf16(v1.x, v1.y); wv.w = cvt_pk_bf16(v1.z, v1.w); *(v4u*)(hb + (size_t)row * D + 512 * j + 8 * lane) = wv;
            if (PLE_FP8) { v2u q; q.x = cvt4_fp8(v0.x, v0.y, v0.z, v0.w); q.y = cvt4_fp8(v1.x, v1.y, v1.z, v1.w); *(v2u*)(WSP(unsigned char, WS_HQ) + (size_t)row * D + 512 * j + 8 * lane) = q; } }
    }
}
__device__ __forceinline__ void p11_ln2(Frame& F, const Args& A, int layer) {
    const bf16* h2 = WSP(bf16, WS_H2); bf16* xb = WSP(bf16, WS_XB);
    const float* g = KIN(I_LN2G) + layer * D; const float* bb = KIN(I_LN2B) + layer * D;
    const int gw = F.vcu * NWAVES + F.wave, NGW = F.G * NWAVES, lane = F.lane;
    for (int row = gw; row < T; row += NGW) {
        const bf16* yr = h2 + (size_t)row * D; f32x4 v[4]; float s = 0.f;
#pragma unroll
        for (int j = 0; j < 4; ++j) { const v2u w = *(const v2u*)(yr + 256 * j + 4 * lane); v[j] = (f32x4){__uint_as_float(w.x << 16), __uint_as_float(w.x & 0xffff0000u), __uint_as_float(w.y << 16), __uint_as_float(w.y & 0xffff0000u)}; s += (v[j].x + v[j].y) + (v[j].z + v[j].w); }
        const float mean = wave_sum(s) * (1.f / D); float s2 = 0.f;
#pragma unroll
        for (int j = 0; j < 4; ++j) { v[j] = v[j] - mean; s2 += (v[j].x * v[j].x + v[j].y * v[j].y) + (v[j].z * v[j].z + v[j].w * v[j].w); }
        const float rstd = __builtin_amdgcn_rsqf(wave_sum(s2) * (1.f / D) + LN_EPS);
#pragma unroll
        for (int j = 0; j < 4; ++j) { const f32x4 gv = *(const f32x4*)(g + 256 * j + 4 * lane), bv = *(const f32x4*)(bb + 256 * j + 4 * lane);
            const f32x4 o = v[j] * rstd * gv + bv; const size_t off = (size_t)row * D + 256 * j + 4 * lane;
            if (layer == DEPTH - 1) *(f32x4*)(F.out + off) = o; v2u w; w.x = cvt_pk_bf16(o.x, o.y); w.y = cvt_pk_bf16(o.z, o.w); *(v2u*)(xb + off) = w; }
    }
}
__device__ __forceinline__ void moe_build_pfx(Frame& F, const Args& A, int layer, int NT) {
    volatile LAS unsigned* pfx = F.MISC + MW_PFX;
    __syncthreads();
    if (F.tid < 64) {
        const int e = F.tid & 31;
        const unsigned c = __hip_atomic_load(F.ctl + CW_CNT + (layer * NE + e) * 16, RLX_AGENT);
        const unsigned un = ((c + 255u) >> 8) * (unsigned)NT; unsigned inc = un;
#pragma unroll
        for (int o = 1; o < 32; o <<= 1) { const unsigned t = (unsigned)my_shfl_up((int)inc, o); if (e >= o) inc += t; }
        if (F.tid < 32) { pfx[e] = inc - un; pfx[40 + e] = c; if (e == 31) pfx[32] = inc; }
    }
    __syncthreads();
}
#define UU(t, col) bf2f(u[(size_t)(t) * NUP + (col)])
#define UU4(t, col) ldu4(u + (size_t)(t) * NUP + (col))
__device__ __forceinline__ f32x4 ldu4(const bf16* p) { const v2u w = *(const v2u*)p; return (f32x4){__uint_as_float(w.x << 16), __uint_as_float(w.x & 0xffff0000u), __uint_as_float(w.y << 16), __uint_as_float(w.y & 0xffff0000u)}; }
__device__ __forceinline__ f32x4 ldb4(const bf16* p) { const v2u w = *(const v2u*)p; return (f32x4){__uint_as_float(w.x << 16), __uint_as_float(w.x & 0xffff0000u), __uint_as_float(w.y << 16), __uint_as_float(w.y & 0xffff0000u)}; }
__device__ __forceinline__ void stb4(bf16* p, f32x4 v) { v2u o; o.x = cvt_pk_bf16(v.x, v.y); o.y = cvt_pk_bf16(v.z, v.w); *(v2u*)p = o; }
__device__ __forceinline__ void lds_st_bf16(LAS unsigned char* p, float v) { *(LAS unsigned short*)p = (unsigned short)(cvt_pk_bf16(v, 0.f) & 0xffffu); }
__device__ __forceinline__ void lds_st_bf16x4(LAS unsigned char* p, float a, float b, float c, float d) { v2u o; o.x = cvt_pk_bf16(a, b); o.y = cvt_pk_bf16(c, d); *(LAS v2u*)p = o; }

#if OUT_FP8
#define MIX_ST4(mix, idx, a, b, c, d) (*(unsigned*)((unsigned char*)(mix) + (idx)) = cvt4_fp8(a, b, c, d))
#else
#define MIX_ST4(mix, idx, a, b, c, d) do { v2u o_; o_.x = cvt_pk_bf16(a, b); o_.y = cvt_pk_bf16(c, d); *(v2u*)((mix) + (idx)) = o_; } while (0)
#endif
__device__ __forceinline__ void ssd_stage1(Frame& F, const Args& A, int layer, int b, int c) {
    const bf16* u = WSP(bf16, WS_U);
    LAS unsigned char* L = F.lds;
    LAS float* DT = (LAS float*)L; LAS float* AC = DT + 256;
    LAS unsigned char* BMT = L + 2048; LAS unsigned char* XCDT = BMT + 128 * 144;
    const int t0 = b * SEQ + c * 64, tid = F.tid, lane = F.lane, wave = F.wave;
    if (wave < 4) {
        const int hh = wave;
        const float dt = softplusf_(UU(t0 + lane, U_SSD_DT + hh) + KIN(I_SDTB)[layer * 4 + hh]);
        const float adt = -dt * __expf(KIN(I_SALOG)[layer * 4 + hh]);
        const float ac = wave_scan_add(adt, lane);
        DT[hh * 64 + lane] = dt; AC[hh * 64 + lane] = ac;
        if (lane == 63) WSP(float, WS_SSD_DEC)[(b * 4 + hh) * NCH + c] = __expf(ac);
    }
    __syncthreads();
    if (tid < 384) {
        const int cc = tid; const float* cw = KIN(I_SCW) + (size_t)layer * 2048 + cc; const float w0 = cw[0], w1 = cw[512], w2 = cw[1024], w3 = cw[1536], cb = KIN(I_SCB)[layer * 512 + cc];
        const bf16* up = u + (size_t)t0 * NUP + U_SSD_X + cc;
        float win0 = 0.f, win1 = 0.f, win2 = 0.f;
        if (c > 0) { win0 = bf2f(up[-3 * NUP]); win1 = bf2f(up[-2 * NUP]); win2 = bf2f(up[-1 * NUP]); }
        const int hh = (cc >> 6) & 3; const bool isx = cc < 256;
        LAS unsigned char* dst = isx ? XCDT + cc * 144 : BMT + (cc - 256) * 144;
        const float aclast = AC[hh * 64 + 63];
#pragma unroll 1
        for (int l0 = 0; l0 < 64; l0 += 32) {
            float xv[32];
#pragma unroll
            for (int j = 0; j < 32; ++j) xv[j] = bf2f(up[(l0 + j) * NUP]);
#pragma unroll
            for (int j8 = 0; j8 < 4; ++j8) { float o[8];
#pragma unroll
                for (int j = 0; j < 8; ++j) { const int l = l0 + j8 * 8 + j; const float x = xv[j8 * 8 + j]; const float y = cb + w0 * win0 + w1 * win1 + w2 * win2 + w3 * x; win0 = win1; win1 = win2; win2 = x;
                    float s = siluf_(y); if (isx) s *= DT[hh * 64 + l] * __expf(aclast - AC[hh * 64 + l]); o[j] = s; }
                *(LAS v4u*)(dst + (l0 + j8 * 8) * 2) = pack8(o); }
        }
    }
    __syncthreads();
    { const int fr = lane & 15, fq = lane >> 4; bf16* st = WSP(bf16, WS_SSD_ST);
#pragma unroll 1
      for (int i = 0; i < 2; ++i) { const int row0 = (2 * wave + i) * 16; const int hh = row0 >> 6, p = (row0 & 63) + fr;
          bf16* dstp = st + (((size_t)(b * 4 + hh) * NCH + c) * 64 + p) * 128;
#pragma unroll 1
          for (int ntl = 0; ntl < 8; ++ntl) { f32x4 acc = {0.f, 0.f, 0.f, 0.f}; acc = mm16(XCDT + row0 * 144, 144, BMT + ntl * 16 * 144, 144, 64, acc, fr, fq);
              stb4(dstp + ntl * 16 + 4 * fq, acc); } } }
    __syncthreads();
}
__device__ __forceinline__ void ssd_stage3(Frame& F, const Args& A, int layer, int b, int c) {
    const bf16* u = WSP(bf16, WS_U);
    LAS unsigned char* L = F.lds;
    LAS float* DT = (LAS float*)L; LAS float* AC = DT + 256;
    LAS unsigned char* CM = L + 2048; LAS unsigned char* BM = CM + 64 * 272; LAS unsigned char* XCT = BM + 64 * 272; LAS unsigned char* MM = XCT + 256 * 144;
    LAS unsigned char* YG = XCT;
    const int t0 = b * SEQ + c * 64, tid = F.tid, lane = F.lane, wave = F.wave, fr = lane & 15, fq = lane >> 4;
    if (wave < 4) {
        const int hh = wave;
        const float dt = softplusf_(UU(t0 + lane, U_SSD_DT + hh) + KIN(I_SDTB)[layer * 4 + hh]);
        const float adt = -dt * __expf(KIN(I_SALOG)[layer * 4 + hh]);
        DT[hh * 64 + lane] = dt; AC[hh * 64 + lane] = wave_scan_add(adt, lane);
    }
    __syncthreads();
    {
        const int cc = tid; const float* cw = KIN(I_SCW) + (size_t)layer * 2048 + cc; const float w0 = cw[0], w1 = cw[512], w2 = cw[1024], w3 = cw[1536], cb = KIN(I_SCB)[layer * 512 + cc];
        const bf16* up = u + (size_t)t0 * NUP + U_SSD_X + cc;
        float win0 = 0.f, win1 = 0.f, win2 = 0.f;
        if (c > 0) { win0 = bf2f(up[-3 * NUP]); win1 = bf2f(up[-2 * NUP]); win2 = bf2f(up[-1 * NUP]); }
        const int hh = (cc >> 6) & 3;
#pragma unroll 1
        for (int l0 = 0; l0 < 64; l0 += 32) {
            float xv[32];
#pragma unroll
            for (int j = 0; j < 32; ++j) xv[j] = bf2f(up[(l0 + j) * NUP]);
#pragma unroll
            for (int j8 = 0; j8 < 4; ++j8) { float o[8];
#pragma unroll
                for (int j = 0; j < 8; ++j) { const int l = l0 + j8 * 8 + j; const float x = xv[j8 * 8 + j]; const float y = cb + w0 * win0 + w1 * win1 + w2 * win2 + w3 * x; win0 = win1; win1 = win2; win2 = x;
                    float s = siluf_(y); if (cc < 256) s *= DT[hh * 64 + l]; o[j] = s; }
                if (cc < 256) *(LAS v4u*)(XCT + cc * 144 + (l0 + j8 * 8) * 2) = pack8(o);
                else { LAS unsigned char* d2 = (cc < 384 ? BM + (cc - 256) * 2 : CM + (cc - 384) * 2) + (l0 + j8 * 8) * 272;
#pragma unroll
                    for (int j = 0; j < 8; ++j) lds_st_bf16(d2 + j * 272, o[j]); } }
        }
    }
    __syncthreads();
#pragma unroll 1
    for (int i = 0; i < 2; ++i) { const int idx = 2 * wave + i, lt = idx >> 2, st = idx & 3;
        f32x4 acc = {0.f, 0.f, 0.f, 0.f}; acc = mm16(CM + lt * 16 * 272, 272, BM + st * 16 * 272, 272, 128, acc, fr, fq);
        const int l = lt * 16 + fr, s0 = st * 16 + 4 * fq;
#pragma unroll
        for (int hh = 0; hh < 4; ++hh) { const float al = AC[hh * 64 + l], dl = KIN(I_SD)[layer * 4 + hh] / DT[hh * 64 + l]; float o[4];
#pragma unroll
            for (int j = 0; j < 4; ++j) { const int s = s0 + j; float m = (l >= s) ? acc[j] * __expf(al - AC[hh * 64 + s]) : 0.f; if (l == s) m += dl; o[j] = m; }
            lds_st_bf16x4(MM + hh * 9216 + l * 144 + s0 * 2, o[0], o[1], o[2], o[3]); } }
    __syncthreads();
    f32x4 yv[2][4];
    { const int hh = wave >> 1; const bf16* prev = WSP(bf16, WS_SSD_ST) + ((size_t)(b * 4 + hh) * NCH + c) * 8192;
      bf16x8 pf[4][4];
#pragma unroll
      for (int pt = 0; pt < 4; ++pt)
#pragma unroll
          for (int ks = 0; ks < 4; ++ks) pf[pt][ks] = *(const bf16x8*)(prev + (size_t)(pt * 16 + fr) * 128 + ks * 32 + fq * 8);
#pragma unroll
      for (int i = 0; i < 2; ++i) { const int lt = 2 * (wave & 1) + i, l = lt * 16 + fr; const float ea = __expf(AC[hh * 64 + l]);
#pragma unroll
          for (int pt = 0; pt < 4; ++pt) { f32x4 ad = {0.f, 0.f, 0.f, 0.f}, ao = {0.f, 0.f, 0.f, 0.f};
              ad = mm16(MM + hh * 9216 + lt * 16 * 144, 144, XCT + (hh * 64 + pt * 16) * 144, 144, 64, ad, fr, fq);
              ao = mm16_rB<4>(CM + lt * 16 * 272, 272, pf[pt], ao, fr, fq);
              const f32x4 z = UU4(t0 + l, U_SSD_Z + hh * 64 + pt * 16 + 4 * fq);
              f32x4 y = ad + ao * ea; y.x *= siluf_(z.x); y.y *= siluf_(z.y); y.z *= siluf_(z.z); y.w *= siluf_(z.w); yv[i][pt] = y; } } }
    __syncthreads();
    { const int hh = wave >> 1;
#pragma unroll
      for (int i = 0; i < 2; ++i) { const int l = (2 * (wave & 1) + i) * 16 + fr;
#pragma unroll
          for (int pt = 0; pt < 4; ++pt) *(LAS f32x4*)(YG + l * 1040 + (hh * 64 + pt * 16 + 4 * fq) * 4) = yv[i][pt]; } }
    __syncthreads();
    { const f32x4 g = *(const f32x4*)(KIN(I_SNG) + layer * 256 + 4 * lane); bf16* mix = WSP(bf16, WS_MIX);
#pragma unroll 1
      for (int i = 0; i < 8; ++i) { const int l = wave * 8 + i; const f32x4 y = *(const LAS f32x4*)(YG + l * 1040 + lane * 16);
          const float ss = wave_sum((y.x * y.x + y.y * y.y) + (y.z * y.z + y.w * y.w)); const float r = __builtin_amdgcn_rsqf(ss * (1.f / 256.f) + NORM_EPS);
          MIX_ST4(mix, (size_t)(t0 + l) * D + 4 * lane, y.x * r * g.x, y.y * r * g.y, y.z * r * g.z, y.w * r * g.w); } }
    __syncthreads();
}

__device__ __forceinline__ void gla_bcum_all(Frame& F, const Args& A, int layer, const LAS float* GD, LAS float* BC) {
    const int d = F.tid & 127, lq = F.tid >> 7;
    float gup[16];
    { const f32x4* gp4 = (const f32x4*)(WSP(float, WS_LORA) + (size_t)layer * LORA_PER_LAYER + 32768 + d * 16);
#pragma unroll
      for (int i = 0; i < 4; ++i) { const f32x4 a = gp4[i]; gup[4 * i] = a.x; gup[4 * i + 1] = a.y; gup[4 * i + 2] = a.z; gup[4 * i + 3] = a.w; } }
    const float gb = KIN(I_GGB)[layer * 128 + d];
#pragma unroll 4
    for (int li = 0; li < 16; ++li) { const int l = lq * 16 + li; float x = gb;
#pragma unroll
        for (int i = 0; i < 4; ++i) { const f32x4 g4 = *(const LAS f32x4*)(GD + l * 16 + 4 * i); x += (g4.x * gup[4 * i] + g4.y * gup[4 * i + 1]) + (g4.z * gup[4 * i + 2] + g4.w * gup[4 * i + 3]); }
        BC[l * 128 + d] = logsigmoidf_(x) * 0.0625f; }
    __syncthreads();
    if (F.tid < 128) { float run = 0.f;
#pragma unroll 1
        for (int l0 = 0; l0 < 64; l0 += 16) { float v[16];
#pragma unroll
            for (int j = 0; j < 16; ++j) v[j] = BC[(l0 + j) * 128 + d];
#pragma unroll
            for (int j = 0; j < 16; ++j) { run += v[j]; BC[(l0 + j) * 128 + d] = run; } } }
}
__device__ __forceinline__ void gla_stage1(Frame& F, const Args& A, int layer, int b, int c) {
    const bf16* u = WSP(bf16, WS_U);
    LAS unsigned char* L = F.lds;
    LAS float* GD = (LAS float*)L; LAS float* BC = (LAS float*)(L + 4096);
    LAS unsigned char* KDT = L + 36864; LAS unsigned char* VT = KDT + 128 * 144;
    const int t0 = b * SEQ + c * 64, tid = F.tid, lane = F.lane, wave = F.wave, fr = lane & 15, fq = lane >> 4;
    if (tid < 256) { const int l = tid >> 2, q4 = tid & 3; *(LAS f32x4*)(GD + l * 16 + q4 * 4) = UU4(t0 + l, U_GL_G + 4 * q4); }
    __syncthreads();
    gla_bcum_all(F, A, layer, GD, BC);
    if (tid < 128) {
        const int d = tid; const float blast = BC[63 * 128 + d];
        WSP(float, WS_GLA_DEC)[(size_t)(b * NCH + c) * 128 + d] = __expf(blast);
        const bf16* up = u + (size_t)t0 * NUP + U_GL_K + d;
#pragma unroll 1
        for (int l0 = 0; l0 < 64; l0 += 32) { float xv[32];
#pragma unroll
            for (int j = 0; j < 32; ++j) xv[j] = bf2f(up[(l0 + j) * NUP]);
#pragma unroll
            for (int j8 = 0; j8 < 4; ++j8) { float o[8];
#pragma unroll
                for (int j = 0; j < 8; ++j) { const int l = l0 + j8 * 8 + j; o[j] = xv[j8 * 8 + j] * __expf(blast - BC[l * 128 + d]); }
                *(LAS v4u*)(KDT + d * 144 + (l0 + j8 * 8) * 2) = pack8(o); } }
    } else if (tid < 384) {
        const int vch = tid - 128; const bf16* up = u + (size_t)t0 * NUP + U_GL_V + vch;
#pragma unroll 1
        for (int l0 = 0; l0 < 64; l0 += 32) { float xv[32];
#pragma unroll
            for (int j = 0; j < 32; ++j) xv[j] = bf2f(up[(l0 + j) * NUP]);
#pragma unroll
            for (int j8 = 0; j8 < 4; ++j8) { float o[8];
#pragma unroll
                for (int j = 0; j < 8; ++j) o[j] = xv[j8 * 8 + j];
                *(LAS v4u*)(VT + vch * 144 + (l0 + j8 * 8) * 2) = pack8(o); } }
    }
    __syncthreads();
    { bf16* st = WSP(bf16, WS_GLA_ST);
#pragma unroll 1
      for (int i = 0; i < 4; ++i) { const int idx = 4 * wave + i, hh = idx >> 3, dtl = (idx >> 2) & 1, vt = idx & 3;
          f32x4 acc = {0.f, 0.f, 0.f, 0.f}; acc = mm16(KDT + (hh * 32 + dtl * 16) * 144, 144, VT + (hh * 64 + vt * 16) * 144, 144, 64, acc, fr, fq);
          stb4(st + (((size_t)(b * 4 + hh) * NCH + c) * 32 + dtl * 16 + fr) * 64 + vt * 16 + 4 * fq, acc); } }
    __syncthreads();
}
__device__ __forceinline__ void gla_stage3(Frame& F, const Args& A, int layer, int b, int c) {
    const bf16* u = WSP(bf16, WS_U);
    LAS unsigned char* L = F.lds;
    LAS float* GD = (LAS float*)L; LAS float* BC = (LAS float*)(L + 4096); LAS unsigned char* ATT = L + 4096;
    LAS unsigned char* QD = L + 40960; LAS unsigned char* KI = QD + 64 * 272; LAS unsigned char* VT = KI + 64 * 272; LAS unsigned char* PVT = VT + 256 * 144;
    const int t0 = b * SEQ + c * 64, tid = F.tid, lane = F.lane, wave = F.wave, fr = lane & 15, fq = lane >> 4;
    if (tid < 256) { const int l = tid >> 2, q4 = tid & 3; *(LAS f32x4*)(GD + l * 16 + q4 * 4) = UU4(t0 + l, U_GL_G + 4 * q4); }
    __syncthreads();
    gla_bcum_all(F, A, layer, GD, BC);
    if (tid < 128) {
        const int d = tid;
        const bf16* uq = u + (size_t)t0 * NUP + U_GL_Q + d; const bf16* uk = u + (size_t)t0 * NUP + U_GL_K + d;
#pragma unroll 1
        for (int l0 = 0; l0 < 64; l0 += 16) { float qv[16], kv[16];
#pragma unroll
            for (int j = 0; j < 16; ++j) { qv[j] = bf2f(uq[(l0 + j) * NUP]); kv[j] = bf2f(uk[(l0 + j) * NUP]); }
#pragma unroll
            for (int j = 0; j < 16; ++j) { const int l = l0 + j; const float bc = BC[l * 128 + d];
                lds_st_bf16(QD + l * 272 + d * 2, qv[j] * 0.17677669529663687f * __expf(bc)); lds_st_bf16(KI + l * 272 + d * 2, kv[j] * __expf(-bc)); } }
    } else if (tid < 384) {
        const int vch = tid - 128; const bf16* up = u + (size_t)t0 * NUP + U_GL_V + vch;
#pragma unroll 1
        for (int l0 = 0; l0 < 64; l0 += 32) { float xv[32];
#pragma unroll
            for (int j = 0; j < 32; ++j) xv[j] = bf2f(up[(l0 + j) * NUP]);
#pragma unroll
            for (int j8 = 0; j8 < 4; ++j8) { float o[8];
#pragma unroll
                for (int j = 0; j < 8; ++j) o[j] = xv[j8 * 8 + j];
                *(LAS v4u*)(VT + vch * 144 + (l0 + j8 * 8) * 2) = pack8(o); } }
    } else {
        const bf16* prev = WSP(bf16, WS_GLA_ST);
#pragma unroll 4
        for (int i = tid - 384; i < 8192; i += 128) { const int hh = i >> 11, dd = (i >> 6) & 31, vv = i & 63;
            *(LAS unsigned short*)(PVT + (hh * 64 + vv) * 80 + dd * 2) = prev[((size_t)(b * 4 + hh) * NCH + c) * 2048 + dd * 64 + vv]; }
    }
    __syncthreads();
    const int hh = wave >> 1;
#pragma unroll 1
    for (int i = 0; i < 2; ++i) { const int tt = 2 * (wave & 1) + i, t = tt * 16 + fr;
#pragma unroll
        for (int st = 0; st < 4; ++st) { f32x4 acc = {0.f, 0.f, 0.f, 0.f}; acc = mm16(QD + tt * 16 * 272 + hh * 64, 272, KI + st * 16 * 272 + hh * 64, 272, 32, acc, fr, fq);
            const int s0 = st * 16 + 4 * fq;
            lds_st_bf16x4(ATT + hh * 9216 + t * 144 + s0 * 2, t >= s0 ? acc[0] : 0.f, t >= s0 + 1 ? acc[1] : 0.f, t >= s0 + 2 ? acc[2] : 0.f, t >= s0 + 3 ? acc[3] : 0.f); } }
    __syncthreads();
    { bf16* mix = WSP(bf16, WS_MIX); const float* ng = KIN(I_GNG) + layer * 256;
#pragma unroll 1
      for (int i = 0; i < 2; ++i) { const int tt = 2 * (wave & 1) + i, t = tt * 16 + fr; f32x4 ov[4]; float ss = 0.f;
#pragma unroll
          for (int vt = 0; vt < 4; ++vt) { f32x4 acc = {0.f, 0.f, 0.f, 0.f};
              acc = mm16(ATT + hh * 9216 + tt * 16 * 144, 144, VT + (hh * 64 + vt * 16) * 144, 144, 64, acc, fr, fq);
              acc = mm16(QD + tt * 16 * 272 + hh * 64, 272, PVT + (hh * 64 + vt * 16) * 80, 80, 32, acc, fr, fq);
              ov[vt] = acc; ss += (acc.x * acc.x + acc.y * acc.y) + (acc.z * acc.z + acc.w * acc.w); }
          ss += __shfl_xor(ss, 16); ss += __shfl_xor(ss, 32);
          const float r = __builtin_amdgcn_rsqf(ss * (1.f / 64.f) + NORM_EPS);
#pragma unroll
          for (int vt = 0; vt < 4; ++vt) { const int col = hh * 64 + vt * 16 + 4 * fq; const f32x4 g = *(const f32x4*)(ng + col); const f32x4 og = UU4(t0 + t, U_GL_OG + col);
              MIX_ST4(mix, (size_t)(t0 + t) * D + 512 + col, ov[vt].x * r * g.x * siluf_(og.x), ov[vt].y * r * g.y * siluf_(og.y), ov[vt].z * r * g.z * siluf_(og.z), ov[vt].w * r * g.w * siluf_(og.w)); } } }
    __syncthreads();
}

__device__ __forceinline__ void mlstm_stage1(Frame& F, const Args& A, int layer, int b, int c) {
    const bf16* u = WSP(bf16, WS_U);
    LAS unsigned char* L = F.lds;
    LAS float* WST = (LAS float*)L; LAS unsigned char* KT = L + 1024; LAS unsigned char* VWT = KT + 256 * 144;
    const int t0 = b * SEQ + c * 64, tid = F.tid, lane = F.lane, wave = F.wave, fr = lane & 15, fq = lane >> 4;
    if (wave < 4) {
        const int hh = wave;
        const float ig = UU(t0 + lane, U_ML_I + hh) + KIN(I_MIB)[layer * 4 + hh];
        const float lf = logsigmoidf_(UU(t0 + lane, U_ML_F + hh) + KIN(I_MFB)[layer * 4 + hh]);
        const float bc = wave_scan_add(lf, lane); const float blast = __shfl(bc, 63);
        const float ast = blast - bc + ig; const float mloc = wave_max(ast);
        WST[hh * 64 + lane] = __expf(ast - mloc);
        if (lane == 0) { WSP(float, WS_ML_BL)[(b * 4 + hh) * NCH + c] = blast; WSP(float, WS_ML_ML)[(b * 4 + hh) * NCH + c] = mloc; }
    } else {
        const int kch = tid - 256, cc = 256 + kch; const float* cw = KIN(I_MCW) + (size_t)layer * 2048 + cc; const float w0 = cw[0], w1 = cw[512], w2 = cw[1024], w3 = cw[1536], cb = KIN(I_MCB)[layer * 512 + cc];
        const bf16* up = u + (size_t)t0 * NUP + U_ML_K + kch;
        float win0 = 0.f, win1 = 0.f, win2 = 0.f;
        if (c > 0) { win0 = bf2f(up[-3 * NUP]); win1 = bf2f(up[-2 * NUP]); win2 = bf2f(up[-1 * NUP]); }
#pragma unroll 1
        for (int l0 = 0; l0 < 64; l0 += 32) { float xv[32];
#pragma unroll
            for (int j = 0; j < 32; ++j) xv[j] = bf2f(up[(l0 + j) * NUP]);
#pragma unroll
            for (int j8 = 0; j8 < 4; ++j8) { float o[8];
#pragma unroll
                for (int j = 0; j < 8; ++j) { const float x = xv[j8 * 8 + j]; const float y = cb + w0 * win0 + w1 * win1 + w2 * win2 + w3 * x; win0 = win1; win1 = win2; win2 = x; o[j] = siluf_(y); }
                *(LAS v4u*)(KT + kch * 144 + (l0 + j8 * 8) * 2) = pack8(o); } }
    }
    __syncthreads();
    if (tid < 256) {
        const int vch = tid, hh = vch >> 6; const bf16* up = u + (size_t)t0 * NUP + U_ML_V + vch;
#pragma unroll 1
        for (int l0 = 0; l0 < 64; l0 += 32) { float xv[32];
#pragma unroll
            for (int j = 0; j < 32; ++j) xv[j] = bf2f(up[(l0 + j) * NUP]);
#pragma unroll
            for (int j8 = 0; j8 < 4; ++j8) { float o[8];
#pragma unroll
                for (int j = 0; j < 8; ++j) o[j] = xv[j8 * 8 + j] * WST[hh * 64 + l0 + j8 * 8 + j];
                *(LAS v4u*)(VWT + vch * 144 + (l0 + j8 * 8) * 2) = pack8(o); } }
    } else {
        const int kch = tid - 256, hh = kch >> 6; float n = 0.f;
#pragma unroll 8
        for (int s = 0; s < 64; ++s) n += WST[hh * 64 + s] * bf2f(*(const LAS unsigned short*)(KT + kch * 144 + s * 2));
        WSP(bf16, WS_ML_N)[((size_t)(b * 4 + hh) * NCH + c) * 64 + (kch & 63)] = (bf16)(cvt_pk_bf16(n, 0.f) & 0xffffu);
    }
    __syncthreads();
    { bf16* cst = WSP(bf16, WS_ML_C); const int hh = wave >> 1;
#pragma unroll 1
      for (int i = 0; i < 2; ++i) { const int vt = 2 * (wave & 1) + i;
#pragma unroll 1
          for (int kt = 0; kt < 4; ++kt) { f32x4 acc = {0.f, 0.f, 0.f, 0.f}; acc = mm16(VWT + (hh * 64 + vt * 16) * 144, 144, KT + (hh * 64 + kt * 16) * 144, 144, 64, acc, fr, fq);
              stb4(cst + (((size_t)(b * 4 + hh) * NCH + c) * 64 + vt * 16 + fr) * 64 + kt * 16 + 4 * fq, acc); } } }
    __syncthreads();
}
__device__ __forceinline__ void mlstm_stage3(Frame& F, const Args& A, int layer, int b, int c) {
    const bf16* u = WSP(bf16, WS_U);
    LAS unsigned char* L = F.lds;
    LAS float* BCU = (LAS float*)L; LAS float* GG = BCU + 256; LAS float* MROW = BCU + 512; LAS float* WINT = BCU + 768; LAS float* NPV = BCU + 1024;
    LAS unsigned char* Q = L + 6144; LAS unsigned char* KK = Q + 64 * 528; LAS unsigned char* VT = KK + 64 * 528; LAS unsigned char* SC = VT + 256 * 144;
    const int t0 = b * SEQ + c * 64, tid = F.tid, lane = F.lane, wave = F.wave, fr = lane & 15, fq = lane >> 4;
    if (wave < 4) {
        const int hh = wave;
        const float ig = UU(t0 + lane, U_ML_I + hh) + KIN(I_MIB)[layer * 4 + hh];
        const float lf = logsigmoidf_(UU(t0 + lane, U_ML_F + hh) + KIN(I_MFB)[layer * 4 + hh]);
        const float bc = wave_scan_add(lf, lane); const float gg = ig - bc;
        const float mprev = WSP(float, WS_ML_M)[(b * 4 + hh) * NCH + c];
        const float minter = bc + mprev, mintra = bc + wave_scan_max(gg, lane), mrow = fmaxf(minter, mintra);
        BCU[hh * 64 + lane] = bc; GG[hh * 64 + lane] = gg; MROW[hh * 64 + lane] = mrow; WINT[hh * 64 + lane] = __expf(minter - mrow);
        NPV[hh * 64 + lane] = bf2f(WSP(bf16, WS_ML_N)[((size_t)(b * 4 + hh) * NCH + c) * 64 + lane]);
    }
    {
        const int cc = tid; const float* cw = KIN(I_MCW) + (size_t)layer * 2048 + cc; const float w0 = cw[0], w1 = cw[512], w2 = cw[1024], w3 = cw[1536], cb = KIN(I_MCB)[layer * 512 + cc];
        const bf16* up = u + (size_t)t0 * NUP + U_ML_Q + cc;
        float win0 = 0.f, win1 = 0.f, win2 = 0.f;
        if (c > 0) { win0 = bf2f(up[-3 * NUP]); win1 = bf2f(up[-2 * NUP]); win2 = bf2f(up[-1 * NUP]); }
        LAS unsigned char* dst = cc < 256 ? Q + cc * 2 : KK + (cc - 256) * 2; const float sc = cc < 256 ? 0.125f : 1.0f;
#pragma unroll 1
        for (int l0 = 0; l0 < 64; l0 += 32) { float xv[32];
#pragma unroll
            for (int j = 0; j < 32; ++j) xv[j] = bf2f(up[(l0 + j) * NUP]);
#pragma unroll
            for (int j = 0; j < 32; ++j) { const float x = xv[j]; const float y = cb + w0 * win0 + w1 * win1 + w2 * win2 + w3 * x; win0 = win1; win1 = win2; win2 = x; lds_st_bf16(dst + (l0 + j) * 528, siluf_(y) * sc); } }
        const int vch = tid & 255, lh = (tid >> 8) * 32; const bf16* uv = u + (size_t)(t0 + lh) * NUP + U_ML_V + vch;
        float xv[32];
#pragma unroll
        for (int j = 0; j < 32; ++j) xv[j] = bf2f(uv[j * NUP]);
#pragma unroll
        for (int j8 = 0; j8 < 4; ++j8) { float o[8];
#pragma unroll
            for (int j = 0; j < 8; ++j) o[j] = xv[j8 * 8 + j];
            *(LAS v4u*)(VT + vch * 144 + (lh + j8 * 8) * 2) = pack8(o); }
    }
    __syncthreads();
    { const int hh = wave >> 1; bf16* mix = WSP(bf16, WS_MIX); const float* ng = KIN(I_MNG) + layer * 256;
      const bf16* cprev = WSP(bf16, WS_ML_C) + ((size_t)(b * 4 + hh) * NCH + c) * 4096;
      bf16x8 cf[4][2];
#pragma unroll
      for (int vt = 0; vt < 4; ++vt)
#pragma unroll
          for (int ks = 0; ks < 2; ++ks) cf[vt][ks] = *(const bf16x8*)(cprev + (size_t)(vt * 16 + fr) * 64 + ks * 32 + fq * 8);
#pragma unroll 1
      for (int i = 0; i < 2; ++i) { const int tt = 2 * (wave & 1) + i, t = tt * 16 + fr;
          const float bt = BCU[hh * 64 + t] - MROW[hh * 64 + t]; float rs = 0.f;
#pragma unroll
          for (int st = 0; st < 4; ++st) { f32x4 acc = {0.f, 0.f, 0.f, 0.f}; acc = mm16(Q + tt * 16 * 528 + hh * 128, 528, KK + st * 16 * 528 + hh * 128, 528, 64, acc, fr, fq);
              const int s0 = st * 16 + 4 * fq; float o[4];
#pragma unroll
              for (int j = 0; j < 4; ++j) { const int s = s0 + j; const float v = (t >= s) ? acc[j] * __expf(bt + GG[hh * 64 + s]) : 0.f; o[j] = v; rs += v; }
              lds_st_bf16x4(SC + hh * 9216 + t * 144 + s0 * 2, o[0], o[1], o[2], o[3]); }
          rs += __shfl_xor(rs, 16); rs += __shfl_xor(rs, 32);
          float nq = 0.f;
#pragma unroll
          for (int j = 0; j < 16; ++j) nq += bf2f(*(const LAS unsigned short*)(Q + t * 528 + (hh * 64 + fq * 16 + j) * 2)) * NPV[hh * 64 + fq * 16 + j];
          nq += __shfl_xor(nq, 16); nq += __shfl_xor(nq, 32);
          const float wi = WINT[hh * 64 + t]; const float den = wi * nq + rs; const float dn = fmaxf(fabsf(den), __expf(-MROW[hh * 64 + t])); const float rdn = 1.0f / dn;
          LDS_WAIT();
          f32x4 hv[4]; float sm = 0.f;
#pragma unroll
          for (int vt = 0; vt < 4; ++vt) { f32x4 acc = {0.f, 0.f, 0.f, 0.f};
              acc = mm16_rB<2>(Q + tt * 16 * 528 + hh * 128, 528, cf[vt], acc, fr, fq);
              acc = acc * wi;
              acc = mm16(SC + hh * 9216 + tt * 16 * 144, 144, VT + (hh * 64 + vt * 16) * 144, 144, 64, acc, fr, fq);
              const f32x4 og = UU4(t0 + t, U_ML_O + hh * 64 + vt * 16 + 4 * fq);
              f32x4 h; h.x = acc.x * rdn * sigmoidf_(og.x); h.y = acc.y * rdn * sigmoidf_(og.y); h.z = acc.z * rdn * sigmoidf_(og.z); h.w = acc.w * rdn * sigmoidf_(og.w);
              hv[vt] = h; sm += (h.x + h.y) + (h.z + h.w); }
          sm += __shfl_xor(sm, 16); sm += __shfl_xor(sm, 32);
          const float mean = sm * (1.f / 64.f); float sq = 0.f;
#pragma unroll
          for (int vt = 0; vt < 4; ++vt) { hv[vt] = hv[vt] - mean; sq += (hv[vt].x * hv[vt].x + hv[vt].y * hv[vt].y) + (hv[vt].z * hv[vt].z + hv[vt].w * hv[vt].w); }
          sq += __shfl_xor(sq, 16); sq += __shfl_xor(sq, 32);
          const float r = __builtin_amdgcn_rsqf(sq * (1.f / 64.f) + NORM_EPS);
#pragma unroll
          for (int vt = 0; vt < 4; ++vt) { const int col = hh * 64 + vt * 16 + 4 * fq; const f32x4 g = *(const f32x4*)(ng + col);
              MIX_ST4(mix, (size_t)(t0 + t) * D + 768 + col, hv[vt].x * r * g.x, hv[vt].y * r * g.y, hv[vt].z * r * g.z, hv[vt].w * r * g.w); } } }
    __syncthreads();
}

__device__ __forceinline__ void rwkv_stage1(Frame& F, const Args& A, int layer, int ub) {
    const bf16* u = WSP(bf16, WS_U);
    LAS unsigned char* L = F.lds;
    LAS unsigned char* LOWA = L;
    LAS float* CUM = (LAS float*)(L + 16384);
    LAS float* AAB = CUM;
    LAS float* TOT = CUM;
    LAS unsigned char* M0 = L + 16384 + 16640;
#define RM(i) (M0 + (i) * 9216)
    LAS float* GAMC = (LAS float*)(F.MISC + MW_GAMC);
    const int t0 = ub * 64, c = ub & 63, tid = F.tid, lane = F.lane, wave = F.wave;
    const float* mu = KIN(I_RMU) + layer * 896;
#ifndef RW_DUP
#define RW_DUP -1
#endif
#define RW_REP(k) for (int rep__ = 0; rep__ < ((RW_DUP == (k)) ? 2 : 1); ++rep__)
    RW_REP(0) {
    {
        const int l = tid >> 3, jq = tid & 7, t = t0 + l; const bool has_prev = (t & (SEQ - 1)) != 0;
        f32x4 cur[4], prv[4];
#pragma unroll
        for (int q = 0; q < 4; ++q) { cur[q] = UU4(t, U_RW_LO + jq * 16 + 4 * q); prv[q] = has_prev ? UU4(t - 1, U_RW_LO + jq * 16 + 4 * q) : (f32x4){0.f, 0.f, 0.f, 0.f}; }
#pragma unroll
        for (int q = 0; q < 4; ++q) { const f32x4 m4 = *(const f32x4*)(mu + 768 + jq * 16 + 4 * q); const f32x4 xs = cur[q] + (prv[q] - cur[q]) * m4; const int j = jq * 16 + 4 * q;
            f32x4 o;
            if (j < 32) { o.x = tanhf_(xs.x); o.y = tanhf_(xs.y); o.z = tanhf_(xs.z); o.w = tanhf_(xs.w); } else if (j < 64) o = xs; else { o.x = sigmoidf_(xs.x); o.y = sigmoidf_(xs.y); o.z = sigmoidf_(xs.z); o.w = sigmoidf_(xs.w); }
            if (j < 64) lds_st_bf16x4(LOWA + l * 144 + j * 2, o.x, o.y, o.z, o.w); else lds_st_bf16x4(RM(0) + l * 144 + (j - 64) * 2, o.x, o.y, o.z, o.w); }
    }
    __syncthreads();
    {
        bf16* RG = WSP(bf16, WS_RW_G); const int lane_ = F.lane, fr_ = lane_ & 15, fq_ = lane_ >> 4;
        const float* gupT = WSP(float, WS_LORA) + (size_t)layer * LORA_PER_LAYER + 16384;
#pragma unroll
        for (int ci = 0; ci < 2; ++ci) { const int ct = 2 * wave + ci; bf16x8 bf[2];
#pragma unroll
            for (int ks = 0; ks < 2; ++ks) bf[ks] = ldfrag_f32(gupT + (size_t)(ct * 16 + fr_) * 64 + ks * 32 + fq_ * 8);
#pragma unroll
            for (int tt = 0; tt < 4; ++tt) { f32x4 acc = {0.f, 0.f, 0.f, 0.f}; acc = mm16_rB<2>(RM(0) + tt * 16 * 144, 144, bf, acc, fr_, fq_);
                stb4(RG + (size_t)(t0 + tt * 16 + fr_) * 256 + ct * 16 + 4 * fq_, acc); } }
    }
    __syncthreads();
    }
    const int b_ = ub >> 6;
#pragma unroll 1
    for (int hh = 0; hh < 4; ++hh) {
        int ch = lane, fr = lane & 15, fq = lane >> 4; asm volatile("" : "+v"(ch), "+v"(fr), "+v"(fq));
        const int tg = wave, cg = hh * 64 + ch; const size_t un = (size_t)(b_ * 4 + hh) * NCH + c;
        float rr[8], k2r[8], vr[8], ar[8], br[8], pl[8];
        LAS float* WPA = (LAS float*)RM(8);
        {
            const int mat = wave >> 2, ct = wave & 3;
            const float* wT = WSP(float, WS_LORA) + (size_t)layer * LORA_PER_LAYER + mat * 8192 + (size_t)(hh * 64 + ct * 16 + fr) * 32 + fq * 8;
            bf16x8 bfw[1]; bfw[0] = ldfrag_f32(wT);
#pragma unroll
            for (int tt = 0; tt < 4; ++tt) { f32x4 acc = {0.f, 0.f, 0.f, 0.f}; acc = mm16_rB<1>(LOWA + tt * 16 * 144 + mat * 64, 144, bfw, acc, fr, fq);
                *(LAS f32x4*)(WPA + mat * 4096 + (tt * 16 + fr) * 64 + ct * 16 + 4 * fq) = acc; }
        }
        __syncthreads();
        RW_REP(1) {
            const float w0 = KIN(I_RW0)[layer * 256 + cg], a0 = KIN(I_RA0)[layer * 256 + cg], kkc = KIN(I_RKK)[layer * 256 + cg], kac = KIN(I_RKA)[layer * 256 + cg];
            const float mur = mu[cg], muk = mu[256 + cg], muv = mu[512 + cg];
            const int tb = t0 + tg * 8; const bool nop = (c == 0) && (tg == 0);
            float rp = nop ? 0.f : UU(tb - 1, U_RW_R + cg), kp = nop ? 0.f : UU(tb - 1, U_RW_K + cg), vp = nop ? 0.f : UU(tb - 1, U_RW_V + cg);
            float rc[8], kc[8], vc[8];
#pragma unroll
            for (int j = 0; j < 8; ++j) { rc[j] = UU(tb + j, U_RW_R + cg); kc[j] = UU(tb + j, U_RW_K + cg); vc[j] = UU(tb + j, U_RW_V + cg); }
            bf16* RW = WSP(bf16, WS_RW);
            float kk[8], al[8], n2[8], run = 0.f;
#pragma unroll
            for (int j = 0; j < 8; ++j) { const int l = tg * 8 + j;
                const float r = rc[j] + (rp - rc[j]) * mur, k = kc[j] + (kp - kc[j]) * muk, v = vc[j] + (vp - vc[j]) * muv; rp = rc[j]; kp = kc[j]; vp = vc[j];
                const float wp = w0 + WPA[l * 64 + ch], ap = a0 + WPA[4096 + l * 64 + ch];
                const float w = -softplusf_(-wp) - 0.5f; run += -__expf(w); pl[j] = run; al[j] = sigmoidf_(ap);
                kk[j] = k * kkc; n2[j] = kk[j] * kk[j];
                k2r[j] = k * (1.0f + (al[j] - 1.0f) * kac); rr[j] = r; vr[j] = v;
                bf16* o = RW + (size_t)(tb + j) * 768 + cg; o[0] = (bf16)(cvt_pk_bf16(r, 0.f) & 0xffffu); o[256] = (bf16)(cvt_pk_bf16(k2r[j], 0.f) & 0xffffu); o[512] = (bf16)(cvt_pk_bf16(v, 0.f) & 0xffffu); }
#pragma unroll
            for (int i = 0; i < 4; ++i) { const bool hi = (ch & 32) != 0; const float keep = hi ? n2[i + 4] : n2[i], send = hi ? n2[i] : n2[i + 4]; n2[i] = keep + __shfl_xor(send, 32); }
#pragma unroll
            for (int i = 0; i < 2; ++i) { const bool hi = (ch & 16) != 0; const float keep = hi ? n2[i + 2] : n2[i], send = hi ? n2[i] : n2[i + 2]; n2[i] = keep + __shfl_xor(send, 16); }
            { const bool hi = (ch & 8) != 0; const float keep = hi ? n2[1] : n2[0], send = hi ? n2[0] : n2[1]; n2[0] = keep + __shfl_xor(send, 8); }
            n2[0] += __shfl_xor(n2[0], 4); n2[0] += __shfl_xor(n2[0], 2); n2[0] += __shfl_xor(n2[0], 1);
#pragma unroll
            for (int j = 0; j < 8; ++j) { const float tot = __builtin_bit_cast(float, __builtin_amdgcn_readlane(__builtin_bit_cast(int, n2[0]), ((j & 4) ? 32 : 0) + ((j & 2) ? 16 : 0) + ((j & 1) ? 8 : 0)));
                const float kkn = kk[j] / fmaxf(sqrtf(tot), 1e-12f); ar[j] = -kkn; br[j] = kkn * al[j]; }
            TOT[tg * 64 + ch] = run;
        }
        __syncthreads();
        RW_REP(3) {
            float off = 0.f, gC = 0.f;
#pragma unroll
            for (int g = 0; g < 8; ++g) { const float tv = TOT[g * 64 + ch]; gC += tv; if (g < tg) off += tv; }
            float oat[8], obb[8], okb[8], ov[8];
#pragma unroll
            for (int j = 0; j < 8; ++j) { const int l = tg * 8 + j; const float gt = off + pl[j], gm = j > 0 ? off + pl[j - 1] : off;
                const float at = ar[j] * __expf(gm), rt = rr[j] * __expf(gt), en = __expf(-gt), ec = __expf(gC - gt);
                lds_st_bf16(RM(0) + l * 144 + ch * 2, at); lds_st_bf16(RM(1) + l * 144 + ch * 2, rt); lds_st_bf16(RM(2) + l * 144 + ch * 2, br[j] * en); lds_st_bf16(RM(3) + l * 144 + ch * 2, k2r[j] * en);
                oat[j] = at; obb[j] = br[j] * ec; okb[j] = k2r[j] * ec; ov[j] = vr[j]; }
            *(LAS v4u*)(RM(4) + ch * 144 + tg * 16) = pack8(oat); *(LAS v4u*)(RM(5) + ch * 144 + tg * 16) = pack8(obb); *(LAS v4u*)(RM(6) + ch * 144 + tg * 16) = pack8(okb); *(LAS v4u*)(RM(7) + ch * 144 + tg * 16) = pack8(ov);
            if (tg == 0) GAMC[ch] = __expf(gC);
        }
        __syncthreads();
        RW_REP(4) {
            const int which = wave >> 1; const LAS unsigned char* Aop = which < 2 ? RM(0) : RM(1); const LAS unsigned char* Bop = (which & 1) ? RM(3) : RM(2);
#pragma unroll 1
            for (int i2 = 0; i2 < 2; ++i2) { const int tt = 2 * (wave & 1) + i2, t = tt * 16 + fr;
#pragma unroll
                for (int it = 0; it < 4; ++it) { f32x4 acc = {0.f, 0.f, 0.f, 0.f}; acc = mm16(Aop + tt * 16 * 144, 144, Bop + it * 16 * 144, 144, 64, acc, fr, fq);
                    const int i0 = it * 16 + 4 * fq; const int lim = which < 2 ? t : t + 1;
                    const float o0 = (i0 < lim) ? acc[0] : 0.f, o1 = (i0 + 1 < lim) ? acc[1] : 0.f, o2 = (i0 + 2 < lim) ? acc[2] : 0.f, o3 = (i0 + 3 < lim) ? acc[3] : 0.f;
#ifdef RW_CLAMP_AAK
                    float q0 = o0, q1 = o1, q2 = o2, q3 = o3;
                    if (which == 1) { q0 = fabsf(o0) < 1e30f ? o0 : 0.f; q1 = fabsf(o1) < 1e30f ? o1 : 0.f; q2 = fabsf(o2) < 1e30f ? o2 : 0.f; q3 = fabsf(o3) < 1e30f ? o3 : 0.f; }
                    if (which == 0) *(LAS f32x4*)(AAB + t * 64 + i0) = (f32x4){o0, o1, o2, o3};
                    else lds_st_bf16x4(RM(7 + which) + t * 144 + i0 * 2, q0, q1, q2, q3);
                    continue;
#endif
                    if (which == 0) { DBG_STAT(11, o0); DBG_STAT(11, o1); DBG_STAT(11, o2); DBG_STAT(11, o3); } if (which == 1) { DBG_STAT(12, o0); DBG_STAT(12, o1); DBG_STAT(12, o2); DBG_STAT(12, o3); } if (which == 2) { DBG_STAT(13, o0); DBG_STAT(13, o3); } if (which == 3) { DBG_STAT(14, o0); DBG_STAT(14, o3); }
                    if (which == 0) *(LAS f32x4*)(AAB + t * 64 + i0) = (f32x4){o0, o1, o2, o3};
                    else lds_st_bf16x4(RM(7 + which) + t * 144 + i0 * 2, o0, o1, o2, o3); } }
        }
        __syncthreads();
        RW_REP(5) {
#pragma unroll 1
            for (int i2 = 0; i2 < 2; ++i2) { const int idx = wave * 2 + i2, vt = idx >> 2, tt = idx & 3; f32x4 acc = {0.f, 0.f, 0.f, 0.f};
                acc = mm16(RM(7) + vt * 16 * 144, 144, RM(8) + tt * 16 * 144, 144, 64, acc, fr, fq);
                DBG_STAT(15, acc[0]); DBG_STAT(15, acc[1]); DBG_STAT(15, acc[2]); DBG_STAT(15, acc[3]);
                lds_st_bf16x4(RM(0) + (vt * 16 + fr) * 144 + (tt * 16 + 4 * fq) * 2, acc[0], acc[1], acc[2], acc[3]); }
        }
        RW_REP(8) if (wave == 0) {
            float x[64]; f32x4 rowq[16];
#pragma unroll
            for (int t = 0; t < 64; ++t) {
                f32x4 cur[16];
#pragma unroll
                for (int i4 = 0; i4 < (t + 3) / 4; ++i4) cur[i4] = rowq[i4];
                if (t + 1 < 64) {
#pragma unroll
                    for (int i4 = 0; i4 < (t + 4) / 4; ++i4) rowq[i4] = *(const LAS f32x4*)(AAB + (t + 1) * 64 + 4 * i4); }
                float a0 = (t == ch) ? 1.0f : 0.f, a1 = 0.f, a2 = 0.f, a3 = 0.f;
#pragma unroll
                for (int i4 = 0; i4 < (t + 3) / 4; ++i4) { const f32x4 q = cur[i4];
                    a0 += q.x * x[4 * i4]; if (4 * i4 + 1 < t) a1 += q.y * x[4 * i4 + 1]; if (4 * i4 + 2 < t) a2 += q.z * x[4 * i4 + 2]; if (4 * i4 + 3 < t) a3 += q.w * x[4 * i4 + 3]; }
                const float acc = (a0 + a1) + (a2 + a3);
                x[t] = acc; lds_st_bf16(RM(11) + t * 144 + ch * 2, acc); }
        }
        __syncthreads();
        RW_REP(6) {
            const int rt = wave >> 1;
#pragma unroll
            for (int i2 = 0; i2 < 2; ++i2) { const int tt = 2 * (wave & 1) + i2;
                f32x4 acc = {0.f, 0.f, 0.f, 0.f}; acc = mm16(RM(4) + rt * 16 * 144, 144, RM(11) + tt * 16 * 144, 144, 64, acc, fr, fq);
                DBG_STAT(17, acc[0]); DBG_STAT(17, acc[1]); DBG_STAT(17, acc[2]); DBG_STAT(17, acc[3]);
                lds_st_bf16x4(RM(2) + (rt * 16 + fr) * 144 + (tt * 16 + 4 * fq) * 2, acc[0], acc[1], acc[2], acc[3]);
                f32x4 ac2 = {0.f, 0.f, 0.f, 0.f}; ac2 = mm16(RM(0) + rt * 16 * 144, 144, RM(11) + tt * 16 * 144, 144, 64, ac2, fr, fq);
                DBG_STAT(18, ac2[0]); DBG_STAT(18, ac2[1]); DBG_STAT(18, ac2[2]); DBG_STAT(18, ac2[3]);
                lds_st_bf16x4(RM(3) + (rt * 16 + fr) * 144 + (tt * 16 + 4 * fq) * 2, ac2[0], ac2[1], ac2[2], ac2[3]); }
        }
        __syncthreads();
        RW_REP(7) {
            const int which = wave >> 1;
#pragma unroll 1
            for (int i2 = 0; i2 < 2; ++i2) { const int rt = 2 * (wave & 1) + i2, row = rt * 16 + fr;
#pragma unroll
                for (int ct = 0; ct < 4; ++ct) { f32x4 acc = {0.f, 0.f, 0.f, 0.f}; const int c0 = ct * 16 + 4 * fq;
                    if (which == 0) { acc = mm16(RM(9) + rt * 16 * 144, 144, RM(2) + ct * 16 * 144, 144, 64, acc, fr, fq);
                        const v2u rw = *(const LAS v2u*)(RM(1) + row * 144 + c0 * 2);
                        acc[0] += __uint_as_float(rw.x << 16); acc[1] += __uint_as_float(rw.x & 0xffff0000u); acc[2] += __uint_as_float(rw.y << 16); acc[3] += __uint_as_float(rw.y & 0xffff0000u);
                        DBG_STAT(19, acc[0]); DBG_STAT(19, acc[1]); DBG_STAT(19, acc[2]); DBG_STAT(19, acc[3]);
                        v2u o; o.x = cvt_pk_bf16(acc[0], acc[1]); o.y = cvt_pk_bf16(acc[2], acc[3]); *(v2u*)(WSP(bf16, WS_RW_RH) + un * 4096 + row * 64 + c0) = o; }
                    else if (which == 1) {
#ifndef RW_NO_U0
                        acc = mm16(RM(9) + rt * 16 * 144, 144, RM(3) + ct * 16 * 144, 144, 64, acc, fr, fq);
#endif
                        acc = mm16(RM(10) + rt * 16 * 144, 144, RM(7) + ct * 16 * 144, 144, 64, acc, fr, fq);
                        DBG_STAT(20, acc[0]); DBG_STAT(20, acc[1]); DBG_STAT(20, acc[2]); DBG_STAT(20, acc[3]);
                        stb4(WSP(bf16, WS_RW_O0) + un * 4096 + row * 64 + c0, acc); }
                    else if (which == 2) { acc = mm16(RM(5) + rt * 16 * 144, 144, RM(2) + ct * 16 * 144, 144, 64, acc, fr, fq);
                        const float gd = GAMC[row]; if (row == c0) acc[0] += gd; if (row == c0 + 1) acc[1] += gd; if (row == c0 + 2) acc[2] += gd; if (row == c0 + 3) acc[3] += gd;
                        DBG_STAT(21, acc[0]); DBG_STAT(21, acc[1]); DBG_STAT(21, acc[2]); DBG_STAT(21, acc[3]);
                        v2u o; o.x = cvt_pk_bf16(acc[0], acc[1]); o.y = cvt_pk_bf16(acc[2], acc[3]);
                        *(v2u*)((unsigned char*)(WSP(bf16, WS_RW_GF) + un * 4096) + ((rt * 2 + (ct >> 1)) * 64 + ch) * 16 + (ct & 1) * 8) = o; }
                    else { acc = mm16(RM(3) + rt * 16 * 144, 144, RM(5) + ct * 16 * 144, 144, 64, acc, fr, fq); acc = mm16(RM(7) + rt * 16 * 144, 144, RM(6) + ct * 16 * 144, 144, 64, acc, fr, fq);
                        DBG_STAT(22, acc[0]); DBG_STAT(22, acc[1]); DBG_STAT(22, acc[2]); DBG_STAT(22, acc[3]);
                        *(f32x4*)(WSP(float, WS_RW_HT) + un * 4096 + row * 64 + c0) = acc; } } }
        }
        __syncthreads();
    }
#undef RM
}
__device__ __forceinline__ void rwkv_scan_wave(Frame& F, const Args& A, int wslot) {
    const int lane = F.lane, fr = lane & 15, fq = lane >> 4, bh = wslot >> 2, v0 = (wslot & 3) * 16;
    const bf16* GF = WSP(bf16, WS_RW_GF) + (size_t)bh * NCH * 4096; const float* HT = WSP(float, WS_RW_HT) + (size_t)bh * NCH * 4096 + (size_t)(v0 + fr) * 64 + 4 * fq;
    bf16* PT = WSP(bf16, WS_RW_PT) + (size_t)bh * NCH * 4096 + (size_t)(v0 + fr) * 64 + 4 * fq;
    f32x4 P[4] = {{0.f, 0.f, 0.f, 0.f}, {0.f, 0.f, 0.f, 0.f}, {0.f, 0.f, 0.f, 0.f}, {0.f, 0.f, 0.f, 0.f}};
    bf16x8 g0[4][2], g1[4][2], g2[4][2]; f32x4 h0[4], h1[4], h2[4];
#define RW2_LOAD(gx, hx, cc) do { _Pragma("unroll") for (int m = 0; m < 4; ++m) { hx[m] = *(const f32x4*)(HT + (size_t)(cc) * 4096 + 16 * m); \
        _Pragma("unroll") for (int s = 0; s < 2; ++s) gx[m][s] = *(const bf16x8*)(GF + (size_t)(cc) * 4096 + ((m * 2 + s) * 64 + lane) * 8); } } while (0)
#define RW2_STEP(gx, hx, cc) do { v4u bs[2]; \
        _Pragma("unroll") for (int s = 0; s < 2; ++s) { bs[s].x = cvt_pk_bf16(P[2 * s][0], P[2 * s][1]); bs[s].y = cvt_pk_bf16(P[2 * s][2], P[2 * s][3]); bs[s].z = cvt_pk_bf16(P[2 * s + 1][0], P[2 * s + 1][1]); bs[s].w = cvt_pk_bf16(P[2 * s + 1][2], P[2 * s + 1][3]); } \
        *(v2u*)(PT + (size_t)(cc) * 4096) = (v2u){bs[0].x, bs[0].y}; *(v2u*)(PT + (size_t)(cc) * 4096 + 16) = (v2u){bs[0].z, bs[0].w}; \
        *(v2u*)(PT + (size_t)(cc) * 4096 + 32) = (v2u){bs[1].x, bs[1].y}; *(v2u*)(PT + (size_t)(cc) * 4096 + 48) = (v2u){bs[1].z, bs[1].w}; \
        _Pragma("unroll") for (int m = 0; m < 4; ++m) { f32x4 acc = hx[m]; acc = __builtin_amdgcn_mfma_f32_16x16x32_bf16(gx[m][0], __builtin_bit_cast(bf16x8, bs[0]), acc, 0, 0, 0); \
            acc = __builtin_amdgcn_mfma_f32_16x16x32_bf16(gx[m][1], __builtin_bit_cast(bf16x8, bs[1]), acc, 0, 0, 0); P[m] = acc; } } while (0)
    RW2_LOAD(g0, h0, 0); RW2_LOAD(g1, h1, 1);
#pragma unroll 1
    for (int c = 0; c < 63; c += 3) {
        RW2_LOAD(g2, h2, c + 2); RW2_STEP(g0, h0, c);
        RW2_LOAD(g0, h0, c + 3); RW2_STEP(g1, h1, c + 1);
        if (c + 4 < NCH) RW2_LOAD(g1, h1, c + 4);
        RW2_STEP(g2, h2, c + 2);
    }
    RW2_STEP(g0, h0, 63);
#undef RW2_LOAD
#undef RW2_STEP
}
__device__ __forceinline__ void rwkv_stage3(Frame& F, const Args& A, int layer, int ub) {
    const int t0 = ub * 64, b_ = ub >> 6, c = ub & 63, lane = F.lane, wave = F.wave, fr = lane & 15, fq = lane >> 4, hh = wave >> 1;
    const size_t un = (size_t)(b_ * 4 + hh) * NCH + c;
    const bf16* RH = WSP(bf16, WS_RW_RH) + un * 4096; const bf16* PT = WSP(bf16, WS_RW_PT) + un * 4096; const bf16* O0 = WSP(bf16, WS_RW_O0) + un * 4096;
    const bf16* RW = WSP(bf16, WS_RW); const bf16* RG = WSP(bf16, WS_RW_G); bf16* mix = WSP(bf16, WS_MIX);
    const float* lg = KIN(I_RLNG) + layer * 256 + hh * 64; const float* lb = KIN(I_RLNB) + layer * 256 + hh * 64; const float* rk = KIN(I_RRK) + layer * 256 + hh * 64;
    bf16x8 pfr[4][2];
#pragma unroll
    for (int vt = 0; vt < 4; ++vt)
#pragma unroll
        for (int ks = 0; ks < 2; ++ks) pfr[vt][ks] = *(const bf16x8*)(PT + (size_t)(vt * 16 + fr) * 64 + ks * 32 + fq * 8);
#pragma unroll 1
    for (int i = 0; i < 2; ++i) { const int tt = 2 * (wave & 1) + i, tl = tt * 16 + fr, t = t0 + tl;
        const bf16x8 ra0 = *(const bf16x8*)(RH + (size_t)tl * 64 + fq * 8), ra1 = *(const bf16x8*)(RH + (size_t)tl * 64 + 32 + fq * 8);
        f32x4 ov[4]; float sm = 0.f;
#pragma unroll
        for (int vt = 0; vt < 4; ++vt) { f32x4 acc = ldb4(O0 + tl * 64 + vt * 16 + 4 * fq);
            acc = __builtin_amdgcn_mfma_f32_16x16x32_bf16(pfr[vt][0], ra0, acc, 0, 0, 0); acc = __builtin_amdgcn_mfma_f32_16x16x32_bf16(pfr[vt][1], ra1, acc, 0, 0, 0);
            ov[vt] = acc; DBG_STAT(24, acc[0]); DBG_STAT(24, acc[1]); DBG_STAT(24, acc[2]); DBG_STAT(24, acc[3]); sm += (acc.x + acc.y) + (acc.z + acc.w); }
        sm += __shfl_xor(sm, 16); sm += __shfl_xor(sm, 32);
        const float mean = sm * (1.f / 64.f); float sq = 0.f;
#pragma unroll
        for (int vt = 0; vt < 4; ++vt) { ov[vt] = ov[vt] - mean; sq += (ov[vt].x * ov[vt].x + ov[vt].y * ov[vt].y) + (ov[vt].z * ov[vt].z + ov[vt].w * ov[vt].w); }
        sq += __shfl_xor(sq, 16); sq += __shfl_xor(sq, 32);
        const float rs = __builtin_amdgcn_rsqf(sq * (1.f / 64.f) + RWKV_GN_EPS);
        float bd = 0.f;
#pragma unroll
        for (int q = 0; q < 4; ++q) { const f32x4 r4 = ldb4(RW + (size_t)t * 768 + hh * 64 + fq * 16 + 4 * q), k4 = ldb4(RW + (size_t)t * 768 + 256 + hh * 64 + fq * 16 + 4 * q), c4 = *(const f32x4*)(rk + fq * 16 + 4 * q);
            bd += (r4.x * k4.x * c4.x + r4.y * k4.y * c4.y) + (r4.z * k4.z * c4.z + r4.w * k4.w * c4.w); }
        bd += __shfl_xor(bd, 16); bd += __shfl_xor(bd, 32);
#pragma unroll
        for (int vt = 0; vt < 4; ++vt) { const int col = vt * 16 + 4 * fq; const f32x4 g4 = *(const f32x4*)(lg + col), b4 = *(const f32x4*)(lb + col);
            const f32x4 v4 = ldb4(RW + (size_t)t * 768 + 512 + hh * 64 + col), gg = ldb4(RG + (size_t)t * 256 + hh * 64 + col);
            float e0 = (ov[vt].x * rs * g4.x + b4.x + bd * v4.x) * gg.x, e1 = (ov[vt].y * rs * g4.y + b4.y + bd * v4.y) * gg.y, e2 = (ov[vt].z * rs * g4.z + b4.z + bd * v4.z) * gg.z, e3 = (ov[vt].w * rs * g4.w + b4.w + bd * v4.w) * gg.w;
#ifdef RW_SANITIZE
            e0 = (fabsf(e0) < 1e30f) ? e0 : 0.f; e1 = (fabsf(e1) < 1e30f) ? e1 : 0.f; e2 = (fabsf(e2) < 1e30f) ? e2 : 0.f; e3 = (fabsf(e3) < 1e30f) ? e3 : 0.f;
#endif
            MIX_ST4(mix, (size_t)t * D + 256 + hh * 64 + col, e0, e1, e2, e3); } }
}

__device__ __forceinline__ void scans_elementwise(Frame& F, const Args& A) {
    const int nthr = F.G * 448, gt = F.vcu * 448 + (F.tid - 64);
    constexpr int N_SSD = 16 * 64 * 128 / 2, N_GLA = 16 * 32 * 64 / 2, N_MLC = 16 * 64 * 64 / 2, N_MLN = 16 * 64 / 2;
    for (int i = gt; i < N_SSD + N_GLA + N_MLC + N_MLN; i += nthr) {
        if (i < N_SSD) { const int bh = i >> 12, pn = (i & 4095) * 2; unsigned* base = (unsigned*)(WSP(bf16, WS_SSD_ST) + (size_t)bh * NCH * 8192 + pn); const float* dec = WSP(float, WS_SSD_DEC) + bh * NCH; float S0 = 0.f, S1 = 0.f;
#pragma unroll 1
            for (int c0 = 0; c0 < NCH; c0 += 32) { unsigned x[32]; float dd[32];
#pragma unroll
                for (int j = 0; j < 32; ++j) { x[j] = base[(size_t)(c0 + j) * 4096]; dd[j] = dec[c0 + j]; }
#pragma unroll
                for (int j = 0; j < 32; ++j) { base[(size_t)(c0 + j) * 4096] = cvt_pk_bf16(S0, S1); S0 = dd[j] * S0 + __uint_as_float(x[j] << 16); S1 = dd[j] * S1 + __uint_as_float(x[j] & 0xffff0000u); } }
        } else if (i < N_SSD + N_GLA) { const int k = i - N_SSD, bh = k >> 10, dv = (k & 1023) * 2, dd_ = dv >> 6, b = bh >> 2, hh = bh & 3; unsigned* base = (unsigned*)(WSP(bf16, WS_GLA_ST) + (size_t)bh * NCH * 2048 + dv); const float* dec = WSP(float, WS_GLA_DEC) + (size_t)b * NCH * 128 + hh * 32 + dd_; float S0 = 0.f, S1 = 0.f;
#pragma unroll 1
            for (int c0 = 0; c0 < NCH; c0 += 32) { unsigned x[32]; float dd[32];
#pragma unroll
                for (int j = 0; j < 32; ++j) { x[j] = base[(size_t)(c0 + j) * 1024]; dd[j] = dec[(c0 + j) * 128]; }
#pragma unroll
                for (int j = 0; j < 32; ++j) { base[(size_t)(c0 + j) * 1024] = cvt_pk_bf16(S0, S1); S0 = dd[j] * S0 + __uint_as_float(x[j] << 16); S1 = dd[j] * S1 + __uint_as_float(x[j] & 0xffff0000u); } }
        } else { const int k = i - N_SSD - N_GLA; const bool isn = k >= N_MLC; const int kk = isn ? k - N_MLC : k; const int bh = isn ? (kk >> 5) : (kk >> 11), e = (isn ? (kk & 31) : (kk & 2047)) * 2, str = isn ? 32 : 2048;
            unsigned* base = (unsigned*)((isn ? WSP(bf16, WS_ML_N) : WSP(bf16, WS_ML_C)) + (size_t)bh * NCH * str * 2 + e); const float* bl = WSP(float, WS_ML_BL) + bh * NCH; const float* ml = WSP(float, WS_ML_ML) + bh * NCH; float* mo = WSP(float, WS_ML_M) + bh * NCH;
            float S0 = 0.f, S1 = 0.f, m = 0.f;
#pragma unroll 1
            for (int c0 = 0; c0 < NCH; c0 += 32) { unsigned x[32]; float b8[32], m8[32];
#pragma unroll
                for (int j = 0; j < 32; ++j) { x[j] = base[(size_t)(c0 + j) * str]; b8[j] = bl[c0 + j]; m8[j] = ml[c0 + j]; }
#pragma unroll
                for (int j = 0; j < 32; ++j) { const float mn = fmaxf(b8[j] + m, m8[j]); const float so = __expf(b8[j] + m - mn), sn = __expf(m8[j] - mn);
                    base[(size_t)(c0 + j) * str] = cvt_pk_bf16(S0, S1); if (!isn && e == 0) mo[c0 + j] = m; S0 = so * S0 + sn * __uint_as_float(x[j] << 16); S1 = so * S1 + sn * __uint_as_float(x[j] & 0xffff0000u); m = mn; } }
        }
    }
}
#ifndef MK_PER_PHASE_LAUNCH
#define MK_PER_PHASE_LAUNCH 0
#endif
#ifndef PH_MASK
#define PH_MASK 0xFFF
#endif
#ifndef ST_MASK
#define ST_MASK 0xF
#endif
#define ST_ON(k) (((ST_MASK) >> (k)) & 1)
#ifndef DUP_MASK
#define DUP_MASK 0
#endif
#define DUP_N(k) ((((DUP_MASK) >> (k)) & 1) ? 2 : 1)
#ifndef ST_DUP
#define ST_DUP 0
#endif
#define ST_REP(ty) ((((ST_DUP) >> (ty)) & 1) ? 2 : 1)
#define PH_ON(k) (((PH_MASK) >> (k)) & 1)
constexpr int PH_PER_LAYER = 11, N_PHASES = 1 + DEPTH * PH_PER_LAYER;
__global__ void __launch_bounds__(NWAVES * 64, 2) fwd_kernel(Args args) {
    extern __shared__ __attribute__((aligned(16))) unsigned char lds[];
    Frame F;
    F.lds = (LAS unsigned char*)lds;
    F.MISC = (volatile LAS unsigned*)(F.lds + MISC_OFF);
    F.tid = threadIdx.x; F.lane = F.tid & 63; F.wave = __builtin_amdgcn_readfirstlane(F.tid >> 6);
    F.G = gridDim.x; { const int bx = blockIdx.x; F.vcu = (F.G % 8 == 0) ? (bx % 8) * (F.G / 8) + bx / 8 : bx; }
    F.ka = (karg_t)__builtin_amdgcn_kernarg_segment_ptr(); F.ws = args.ws; F.ctl = (gu32*)(args.ws + WS_CTL); F.out = args.out;
    for (int i = F.tid; i < 256; i += NWAVES * 64) F.MISC[i] = 0u;
    __syncthreads();
    const int lo = args.ph_lo, hi = args.ph_hi;
#ifdef DBG_TSEL
    if (blockIdx.x == 0 && threadIdx.x == 0) __hip_atomic_store(F.ctl + CW_DBG + 15, (unsigned)__builtin_amdgcn_s_memrealtime(), RLX_AGENT);
#endif
    XcdBarrier bar; bar.bar = (unsigned*)(F.ctl + CW_BAR); bar.x = 0; bar.st = nullptr;
    if (hi - lo > 1) bar = xcd_barrier_post((unsigned*)(F.ctl + CW_BAR), F.MISC + MW_BAR);
#define IN_(k) (lo <= (k) && (k) < hi)
#ifdef DBG_TSEL
#ifndef DBG_TQ
#define DBG_TQ 50.0f
#endif
#define TSTAMP(k) do { if (blockIdx.x == 0 && threadIdx.x == 0) __hip_atomic_store(F.ctl + CW_DBG + 16 + ((k) == 11 ? 0 : 1 + layer_ * PH_PER_LAYER + (k)), (unsigned)__builtin_amdgcn_s_memrealtime(), RLX_AGENT); } while (0)
#else
#define TSTAMP(k) do { } while (0)
#endif
#ifdef BAR_DUP
#define SEAM(k) do { if (IN_(k) && IN_((k) + 1)) { xcd_barrier(bar); xcd_barrier(bar); } } while (0)
#else
#define SEAM(k) do { if (IN_(k) && IN_((k) + 1)) xcd_barrier(bar); } while (0)
#endif

    if (PH_ON(11) && IN_(0)) { for (int rep_ = 0; rep_ < DUP_N(11); ++rep_) { frame_refresh(F); p0_prologue(F, args); } SEAM(0); { const int layer_ = 0; TSTAMP(11); (void)layer_; } }
#pragma unroll 1
    for (int layer = 0; layer < DEPTH; ++layer) {
        const int pb = 1 + layer * PH_PER_LAYER; const int layer_ = layer; (void)layer_;
        if (PH_ON(0) && IN_(pb + 0)) { for (int rep_ = 0; rep_ < DUP_N(0); ++rep_) { frame_refresh(F);
            { pg8::DenseSched S; S.init(WSP(bf16, WS_XB), WSP(bf16, WS_WIN_T) + (size_t)layer * NUP * D, T, NUP, D, F.G, (int)blockIdx.x);
              pg8::EpiB16 E{WSP(bf16, WS_U), NUP, nullptr, 0.f};
              pg8::gemm_phase<pg8::EpiB16, pg8::DenseSched>(F.lds, F.tid, S, E); }
            if (F.G != 256 || blockIdx.x >= 128)
            { pg8::DenseSched S; if (F.G == 256) S.init(WSP(bf16, WS_PB) + (size_t)layer * T * 256, WSP(bf16, WS_WPP_T) + (size_t)layer * D * 256, T, D, 256, 128, (int)blockIdx.x - 128); else S.init(WSP(bf16, WS_PB) + (size_t)layer * T * 256, WSP(bf16, WS_WPP_T) + (size_t)layer * D * 256, T, D, 256, F.G, (int)blockIdx.x);
              pg8::EpiB16 E{WSP(bf16, WS_PE), D, nullptr, 0.f};
              pg8::gemm_phase<pg8::EpiB16, pg8::DenseSched>(F.lds, F.tid, S, E); }
            } SEAM(pb + 0); TSTAMP(0);
        }
        if (PH_ON(1) && IN_(pb + 1)) { for (int rep_ = 0; rep_ < DUP_N(1); ++rep_) { frame_refresh(F);
            for (int un = F.vcu; un < 1024; un += F.G) { frame_refresh(F); const int ty = un >> 8, r = un & 255, b = r >> 6, c = r & 63;
                if (ty == 0) { ssd_stage1(F, args, layer, b, c); if (ST_DUP & 1) ssd_stage1(F, args, layer, b, c); } else if (ty == 1) { gla_stage1(F, args, layer, b, c); if (ST_DUP & 2) gla_stage1(F, args, layer, b, c); } else if (ty == 2) { mlstm_stage1(F, args, layer, b, c); if (ST_DUP & 4) mlstm_stage1(F, args, layer, b, c); } else { rwkv_stage1(F, args, layer, r); if (ST_DUP & 8) rwkv_stage1(F, args, layer, r); } }
            } SEAM(pb + 1); TSTAMP(1);
        }
        if (PH_ON(2) && IN_(pb + 2)) { for (int rep_ = 0; rep_ < DUP_N(2); ++rep_) { frame_refresh(F);
            if (F.wave == 0) { for (int ws_ = F.vcu; ws_ < 64; ws_ += F.G) rwkv_scan_wave(F, args, ws_); }
            else if (rep_ == 0) scans_elementwise(F, args);
            } SEAM(pb + 2); TSTAMP(2);
        }
        if (PH_ON(3) && IN_(pb + 3)) { for (int rep_ = 0; rep_ < DUP_N(3); ++rep_) { frame_refresh(F);
            for (int un = F.vcu; un < 1024; un += F.G) { frame_refresh(F); const int ty = un >> 8, r = un & 255, b = r >> 6, c = r & 63;
                if (ty == 0) { ssd_stage3(F, args, layer, b, c); if (ST_DUP & 16) ssd_stage3(F, args, layer, b, c); } else if (ty == 1) { gla_stage3(F, args, layer, b, c); if (ST_DUP & 32) gla_stage3(F, args, layer, b, c); } else if (ty == 2) { mlstm_stage3(F, args, layer, b, c); if (ST_DUP & 64) mlstm_stage3(F, args, layer, b, c); } else { rwkv_stage3(F, args, layer, r); if (ST_DUP & 128) rwkv_stage3(F, args, layer, r); } }
            } SEAM(pb + 3); TSTAMP(3);
        }
        if (PH_ON(4) && IN_(pb + 4)) { for (int rep_ = 0; rep_ < DUP_N(4); ++rep_) { frame_refresh(F);
            pg8::EpiB16 E{WSP(bf16, WS_Y1), D, WSP(bf16, WS_XB), DN_ALPHA};
#if OUT_FP8
            pg8::DenseSched8b S; S.init(WSP(bf16, WS_MIX), (const bf16*)(WSP(unsigned char, WS_WOUT_Q) + (size_t)layer * D * D), T, D, D / 2, F.G, (int)blockIdx.x);
            pg8::gemm_phase<pg8::EpiB16, pg8::DenseSched8b>(F.lds, F.tid, S, E);
#else
            pg8::DenseSched S; S.init(WSP(bf16, WS_MIX), WSP(bf16, WS_WOUT_T) + (size_t)layer * D * D, T, D, D, F.G, (int)blockIdx.x);
            pg8::gemm_phase<pg8::EpiB16, pg8::DenseSched>(F.lds, F.tid, S, E);
#endif
            } SEAM(pb + 4); TSTAMP(4);
        }
        if (PH_ON(5) && IN_(pb + 5)) { if (DUP_N(5) == 2) { frame_refresh(F); p6_ln1_router<true>(F, args, layer); } frame_refresh(F); p6_ln1_router<false>(F, args, layer); SEAM(pb + 5); TSTAMP(5); }
        if (PH_ON(6) && IN_(pb + 6)) { for (int rep_ = 0; rep_ < DUP_N(6); ++rep_) { frame_refresh(F);
            moe_build_pfx(F, args, layer, 8);
            pg8::Moe1Sched S; S.O.pfx = F.MISC + MW_PFX; S.O.NT = 8; S.O.G = F.G; S.O.c = (int)blockIdx.x; S.sdest = WSP(int, WS_SDEST); S.bgu = KIN(I_BGU) + (size_t)layer * NE * 2048;
            if (MOE_FP8) { S.X = WSP(unsigned char, WS_X1Q); S.W = WSP(unsigned char, WS_WGU_Q) + (size_t)layer * NE * 2048 * D; S.K = D / 2; S.hstepB = (size_t)1024 * D; }
            else { S.X = WSP(unsigned char, WS_X1B); S.W = WSP(unsigned char, WS_WGU_T) + (size_t)layer * NE * 2048 * D * 2; S.K = D; S.hstepB = (size_t)1024 * D * 2; }
            pg8::EpiMoe1 E{WSP(bf16, WS_ABUF), KIN(I_BGU) + (size_t)layer * NE * 2048, WSP(unsigned char, WS_ABUFQ)};
            pg8::gemm_phase<pg8::EpiMoe1, pg8::Moe1Sched>(F.lds, F.tid, S, E);
            } SEAM(pb + 6); TSTAMP(6);
        }
        if (PH_ON(7) && IN_(pb + 7)) { for (int rep_ = 0; rep_ < DUP_N(7); ++rep_) { frame_refresh(F);
            moe_build_pfx(F, args, layer, 4);
            pg8::Moe2Sched S; S.O.pfx = F.MISC + MW_PFX; S.O.NT = 4; S.O.G = F.G; S.O.c = (int)blockIdx.x; S.sdest = WSP(int, WS_SDEST); S.sgate = WSP(float, WS_SGATE); S.bdn = KIN(I_BDN) + (size_t)layer * NE * D; if (MOE2_FP8) { S.Ab = WSP(unsigned char, WS_ABUFQ); S.W = WSP(unsigned char, WS_WDN_Q) + (size_t)layer * NE * D * D; S.K = D / 2; S.hstepB = (size_t)128 * D; }
            else { S.Ab = WSP(unsigned char, WS_ABUF); S.W = WSP(unsigned char, WS_WDN_T) + (size_t)layer * NE * D * D * 2; S.K = D; S.hstepB = (size_t)128 * D * 2; }
            pg8::EpiMoe2 E{WSP(bf16, WS_YBUF), KIN(I_BDN) + (size_t)layer * NE * D, WSP(int, WS_SDEST), WSP(float, WS_SGATE)};
            pg8::gemm_phase<pg8::EpiMoe2, pg8::Moe2Sched>(F.lds, F.tid, S, E);
            } SEAM(pb + 7); TSTAMP(7);
        }
        if (PH_ON(8) && IN_(pb + 8)) { for (int rep_ = 0; rep_ < DUP_N(8); ++rep_) { frame_refresh(F); p9_combine(F, args); } SEAM(pb + 8); TSTAMP(8); }
        if (PH_ON(9) && IN_(pb + 9)) { for (int rep_ = 0; rep_ < DUP_N(9); ++rep_) { frame_refresh(F);
            pg8::EpiPle E{WSP(bf16, WS_H2), WSP(bf16, WS_HB), WSP(bf16, WS_PE)};
#if PLE_FP8
            pg8::DenseSched8 S; S.init((const bf16*)WSP(unsigned char, WS_HQ), (const bf16*)(WSP(unsigned char, WS_WPG_Q) + (size_t)layer * D * D), T, D, D / 2, F.G, (int)blockIdx.x);
            pg8::gemm_phase<pg8::EpiPle, pg8::DenseSched8>(F.lds, F.tid, S, E);
#else
            pg8::DenseSched S; S.init(WSP(bf16, WS_HB), WSP(bf16, WS_WPG_T) + (size_t)layer * D * D, T, D, D, F.G, (int)blockIdx.x);
            pg8::gemm_phase<pg8::EpiPle, pg8::DenseSched>(F.lds, F.tid, S, E);
#endif
            } SEAM(pb + 9); TSTAMP(9);
        }
        if (PH_ON(10) && IN_(pb + 10)) { for (int rep_ = 0; rep_ < DUP_N(10); ++rep_) { frame_refresh(F); p11_ln2(F, args, layer); } SEAM(pb + 10); TSTAMP(10); }
    }
#ifdef DBG_TSEL
    if (hi - lo > 1) { xcd_barrier(bar);
        unsigned ticks = 0u;
        if (DBG_TSEL == 11) ticks = __hip_atomic_load(F.ctl + CW_DBG + 16, RLX_AGENT) - __hip_atomic_load(F.ctl + CW_DBG + 15, RLX_AGENT);
        else for (int l = 0; l < DEPTH; ++l) { const int pi = 1 + l * PH_PER_LAYER + DBG_TSEL; ticks += __hip_atomic_load(F.ctl + CW_DBG + 16 + pi, RLX_AGENT) - __hip_atomic_load(F.ctl + CW_DBG + 16 + pi - 1, RLX_AGENT); }
        const float us = floorf((float)ticks * 0.01f / DBG_TQ) * DBG_TQ; const float code = sqrtf(us * 0.05f);
        for (size_t i = (size_t)blockIdx.x * 512 + threadIdx.x; i < (size_t)T * D; i += (size_t)gridDim.x * 512) F.out[i] = code; }
#endif
#ifdef DBG_SEL
    if (hi - lo > 1) { xcd_barrier(bar);
        const unsigned mx = __hip_atomic_load(F.ctl + CW_DBG, RLX_AGENT), nf = __hip_atomic_load(F.ctl + CW_DBG + 1, RLX_AGENT);
        float code;
        { const float m = __uint_as_float(mx); int b = (m > 0.f) ? (int)floorf(log10f(m)) + 30 : 0; b = b < 0 ? 0 : (b > 60 ? 60 : b); if (nf) b += 100; code = sqrtf(10.0f * (float)(b + 1)); }
        for (size_t i = (size_t)blockIdx.x * 512 + threadIdx.x; i < (size_t)T * D; i += (size_t)gridDim.x * 512) F.out[i] = code; }
#endif
#undef IN_
#undef SEAM
}

extern "C" void kernel_launch(void* const* d_in, const int* in_sizes, int n_in, void* d_out, int out_size, void* d_ws, size_t ws_size, hipStream_t stream) {
    static int grid = 0;
    if (grid == 0) {
        if (n_in != N_IN || out_size != T * D || ws_size < WS_END) { fprintf(stderr, "kernel_launch: unexpected shapes (n_in %d, out %d, ws %zu < %zu); nothing launched\n", n_in, out_size, ws_size, (size_t)WS_END); grid = -1; return; }
        int dev = 0, cus = 0, per_cu = 0;
        if (hipGetDevice(&dev) != hipSuccess || hipDeviceGetAttribute(&cus, hipDeviceAttributeMultiprocessorCount, dev) != hipSuccess) { grid = -1; return; }
        if (hipFuncSetAttribute((const void*)fwd_kernel, hipFuncAttributeMaxDynamicSharedMemorySize, LDS_BYTES) != hipSuccess) { fprintf(stderr, "kernel_launch: hipFuncSetAttribute failed\n"); grid = -1; return; }
        if (hipOccupancyMaxActiveBlocksPerMultiprocessor(&per_cu, (const void*)fwd_kernel, NWAVES * 64, LDS_BYTES) != hipSuccess || per_cu < 1) { fprintf(stderr, "kernel_launch: occupancy query says %d blocks per CU\n", per_cu); }
        (void)hipGetLastError();
        grid = cus;
    }
    if (grid < 0) return;
    (void)hipMemsetAsync((char*)d_ws + WS_CTL, 0, CTL_ZERO_BYTES, stream);
    Args a{};
    for (int i = 0; i < N_IN; ++i) a.in[i] = (const float*)d_in[i];
    a.out = (float*)d_out; a.ws = (unsigned char*)d_ws;
#if MK_PER_PHASE_LAUNCH
    for (int ph = 0; ph < N_PHASES; ++ph) { a.ph_lo = ph; a.ph_hi = ph + 1; hipLaunchKernelGGL(fwd_kernel, dim3(grid), dim3(NWAVES * 64), LDS_BYTES, stream, a); }
#else
    a.ph_lo = 0; a.ph_hi = N_PHASES; hipLaunchKernelGGL(fwd_kernel, dim3(grid), dim3(NWAVES * 64), LDS_BYTES, stream, a);
#endif
    const hipError_t le = hipPeekAtLastError();
    if (le != hipSuccess) fprintf(stderr, "kernel_launch: launch failed: %s\n", hipGetErrorName(le));
}
```

```cpp
#include <hip/hip_runtime.h>
#include <cstdio>
#include <cstdint>

#define GAS __attribute__((address_space(1)))
#define LAS __attribute__((address_space(3)))
typedef unsigned short bf16;
typedef unsigned v4u __attribute__((ext_vector_type(4)));
typedef unsigned v2u __attribute__((ext_vector_type(2)));
typedef float f32x4 __attribute__((ext_vector_type(4)));
typedef float f32x2 __attribute__((ext_vector_type(2)));
typedef short bf16x8 __attribute__((ext_vector_type(8)));
typedef int v4i_t __attribute__((ext_vector_type(4)));
typedef int v8i_t __attribute__((ext_vector_type(8)));
typedef GAS unsigned gu32;
#define RLX_AGENT __ATOMIC_RELAXED, __HIP_MEMORY_SCOPE_AGENT
#define LDS_WAIT() asm volatile("s_waitcnt lgkmcnt(0)" ::: "memory")
#define VM_WAIT() asm volatile("s_waitcnt vmcnt(0)" ::: "memory")

constexpr int NWAVES = 8;
constexpr int DEPTH = 4, BATCH = 4, SEQ = 4096, D = 1024, T = BATCH * SEQ;
constexpr int NU = 3484, NUP = 3584;
constexpr int NE = 32, TOPK = 4, ECAP = 16384;
constexpr int NCH = SEQ / 64;
constexpr int U_SSD_Z = 0, U_SSD_X = 256, U_SSD_B = 512, U_SSD_C = 640, U_SSD_DT = 768;
constexpr int U_RW = 772, U_RW_R = 772, U_RW_K = 1028, U_RW_V = 1284, U_RW_LO = 1540;
constexpr int U_GL_Q = 1668, U_GL_K = 1796, U_GL_V = 1924, U_GL_G = 2180, U_GL_OG = 2196;
constexpr int U_ML_Q = 2452, U_ML_K = 2708, U_ML_V = 2964, U_ML_I = 3220, U_ML_F = 3224, U_ML_O = 3228;
constexpr float DN_ALPHA = 1.6817928305074290f;
constexpr float LN_EPS = 1e-5f, NORM_EPS = 1e-5f, RWKV_GN_EPS = 64e-5f;

enum { I_X = 0, I_P, I_WIN, I_WOUT, I_LN1G, I_LN1B, I_SCW, I_SCB, I_SALOG, I_SDTB, I_SD, I_SNG,
       I_RMU, I_RW0, I_RWUP, I_RA0, I_RAUP, I_RGUP, I_RKK, I_RKA, I_RRK, I_RLNG, I_RLNB,
       I_GGUP, I_GGB, I_GNG, I_MCW, I_MCB, I_MIB, I_MFB, I_MNG,
       I_RTW, I_RTB, I_WGU, I_BGU, I_WDN, I_BDN, I_PGW, I_PPJ, I_LN2G, I_LN2B, N_IN };

constexpr size_t MiB = 1u << 20;
constexpr size_t WS_CTL = 0, CTL_ZERO_BYTES = 1 * MiB;
constexpr size_t WS_WIN_T = 2 * MiB;
constexpr size_t WS_WOUT_T = WS_WIN_T + (size_t)DEPTH * NUP * D * 2;
constexpr size_t WS_WGU_T = WS_WOUT_T + (size_t)DEPTH * D * D * 2;
constexpr size_t WS_WDN_T = WS_WGU_T + (size_t)DEPTH * NE * 2048 * D * 2;
constexpr size_t WS_WPG_T = WS_WDN_T + (size_t)DEPTH * NE * D * D * 2;
constexpr size_t WS_WPP_T = WS_WPG_T + (size_t)DEPTH * D * D * 2;
constexpr size_t WS_RWT = WS_WPP_T + (size_t)DEPTH * D * 256 * 2;
constexpr size_t WS_PB = WS_RWT + (size_t)DEPTH * NE * D * 4;
constexpr size_t WS_XB = WS_PB + (size_t)DEPTH * T * 256 * 2;
constexpr size_t WS_U = WS_XB + (size_t)T * D * 2;
constexpr size_t WS_PE = WS_U + (size_t)T * NUP * 2;
constexpr size_t WS_MIX = WS_PE + (size_t)T * D * 4;
constexpr size_t WS_Y1 = WS_MIX + (size_t)T * D * 2;
constexpr size_t WS_X1 = WS_Y1 + (size_t)T * D * 4;
constexpr size_t WS_X1B = WS_X1 + (size_t)T * D * 4;
constexpr size_t WS_SDEST = WS_X1B + (size_t)T * D * 2;
constexpr size_t WS_SGATE = WS_SDEST + (size_t)NE * ECAP * 4;
constexpr size_t WS_ABUF = WS_SGATE + (size_t)NE * ECAP * 4;
constexpr size_t WS_YBUF = WS_ABUF + (size_t)NE * ECAP * D * 2;
constexpr size_t WS_H = WS_YBUF + (size_t)T * 4 * D * 2;
constexpr size_t WS_HB = WS_H + (size_t)T * D * 4;
constexpr size_t WS_H2 = WS_HB + (size_t)T * D * 2;
constexpr size_t WS_SSD_ST = WS_H2 + (size_t)T * D * 4;
constexpr size_t WS_SSD_DEC = WS_SSD_ST + (size_t)16 * NCH * 64 * 128 * 4;
constexpr size_t WS_GLA_ST = WS_SSD_DEC + 16 * NCH * 4;
constexpr size_t WS_GLA_DEC = WS_GLA_ST + (size_t)16 * NCH * 32 * 64 * 4;
constexpr size_t WS_ML_C = WS_GLA_DEC + (size_t)4 * NCH * 128 * 4;
constexpr size_t WS_ML_N = WS_ML_C + (size_t)16 * NCH * 64 * 64 * 4;
constexpr size_t WS_ML_BL = WS_ML_N + (size_t)16 * NCH * 64 * 4;
constexpr size_t WS_ML_ML = WS_ML_BL + 16 * NCH * 4;
constexpr size_t WS_ML_M = WS_ML_ML + 16 * NCH * 4;
constexpr size_t WS_RW = WS_ML_M + 16 * NCH * 4;
constexpr size_t WS_RW_G = WS_RW + (size_t)T * 3 * 256 * 4;
constexpr size_t WS_RW_RH = WS_RW_G + (size_t)T * 256 * 4;
constexpr size_t WS_RW_O0 = WS_RW_RH + (size_t)1024 * 4096 * 2;
constexpr size_t WS_RW_GF = WS_RW_O0 + (size_t)1024 * 4096 * 4;
constexpr size_t WS_RW_HT = WS_RW_GF + (size_t)1024 * 4096 * 2;
constexpr size_t WS_RW_PT = WS_RW_HT + (size_t)1024 * 4096 * 4;
constexpr size_t WS_LORA = WS_RW_PT + (size_t)1024 * 4096 * 2;
constexpr int LORA_PER_LAYER = 8192 + 8192 + 16384 + 2048;
constexpr size_t WS_WGU_Q = WS_LORA + (size_t)DEPTH * LORA_PER_LAYER * 4;
constexpr size_t WS_WDN_Q = WS_WGU_Q + (size_t)DEPTH * NE * 2048 * D;
constexpr size_t WS_X1Q = WS_WDN_Q + (size_t)DEPTH * NE * D * D;
constexpr size_t WS_ABUFQ = WS_X1Q + (size_t)T * D;
constexpr size_t WS_WPG_Q = WS_ABUFQ + (size_t)NE * ECAP * D;
constexpr size_t WS_HQ = WS_WPG_Q + (size_t)DEPTH * D * D;
constexpr size_t WS_WOUT_Q = WS_HQ + (size_t)T * D;
constexpr size_t WS_END = WS_WOUT_Q + (size_t)DEPTH * D * D;
#ifndef MOE_FP8
#define MOE_FP8 1
#endif
#ifndef MOE2_FP8
#define MOE2_FP8 1
#ifndef RW_SCAN_DMA
#define RW_SCAN_DMA 1
#endif
#ifndef P6_MFMA
#define P6_MFMA 1
#endif
#ifndef OUT_FP8
#define OUT_FP8 1
#endif
#ifndef PLE_FP8
#define PLE_FP8 1
#endif
#endif
constexpr int CW_BAR = 4096;
constexpr int CW_DBG = 32768;
constexpr int CW_CNT = 16384;

constexpr int RING_BYTES = 147456;
constexpr int MISC_OFF = RING_BYTES;
constexpr int LDS_BYTES = RING_BYTES + 1024;
constexpr int MW_BAR = 8, MW_LCNT = 32, MW_LBASE = 64, MW_PFX = 96, MW_CNT = 136, MW_GAMC = 168;

typedef __bf16 bf16x2_t __attribute__((ext_vector_type(2)));
__device__ __forceinline__ unsigned cvt_pk_bf16(float lo, float hi) { const f32x2 v = {lo, hi}; const bf16x2_t b = __builtin_convertvector(v, bf16x2_t); return __builtin_bit_cast(unsigned, b); }
__device__ __forceinline__ unsigned cvt4_fp8(float a, float b, float c, float d) { int w = 0; w = __builtin_amdgcn_cvt_pk_fp8_f32(a, b, w, false); w = __builtin_amdgcn_cvt_pk_fp8_f32(c, d, w, true); return (unsigned)w; }
__device__ __forceinline__ float bf2f(unsigned short b) { return __uint_as_float(((unsigned)b) << 16); }
__device__ __forceinline__ float sigmoidf_(float x) { return __builtin_amdgcn_rcpf(1.0f + __expf(-x)); }
__device__ __forceinline__ float siluf_(float x) { return x * __builtin_amdgcn_rcpf(1.0f + __expf(-x)); }
__device__ __forceinline__ float softplusf_(float x) { return fmaxf(x, 0.f) + __logf(1.0f + __expf(-fabsf(x))); }
__device__ __forceinline__ float logsigmoidf_(float x) { return fminf(x, 0.f) - __logf(1.0f + __expf(-fabsf(x))); }
__device__ __forceinline__ float tanhf_(float x) { const float e = __expf(-2.0f * fabsf(x)); const float t = (1.0f - e) * __builtin_amdgcn_rcpf(1.0f + e); return x < 0.f ? -t : t; }
__device__ __forceinline__ int lane_now() { int l = (int)__builtin_amdgcn_mbcnt_hi(~0u, __builtin_amdgcn_mbcnt_lo(~0u, 0u)); asm volatile("" : "+v"(l)); return l; }
__device__ __forceinline__ float my_shfl_idx(float v, int src) { return __builtin_bit_cast(float, __builtin_amdgcn_ds_bpermute(src << 2, __builtin_bit_cast(int, v))); }
__device__ __forceinline__ int my_shfl_idx(int v, int src) { return __builtin_amdgcn_ds_bpermute(src << 2, v); }
template <class V> __device__ __forceinline__ V my_shfl_xor(V v, int o) { return my_shfl_idx(v, lane_now() ^ o); }
template <class V> __device__ __forceinline__ V my_shfl_up(V v, int o) { const int l = lane_now(); return my_shfl_idx(v, l >= o ? l - o : l); }
#define __shfl_xor(v, o) my_shfl_xor(v, o)
#define __shfl_up(v, o) my_shfl_up(v, o)
#define __shfl(v, s) my_shfl_idx(v, s)
__device__ __forceinline__ float wave_sum(float v) {
#pragma unroll
    for (int o = 1; o < 64; o <<= 1) v += __shfl_xor(v, o);
    return v;
}
__device__ __forceinline__ float wave_max(float v) {
#pragma unroll
    for (int o = 1; o < 64; o <<= 1) v = fmaxf(v, __shfl_xor(v, o));
    return v;
}
__device__ __forceinline__ float wave_scan_add(float v, int lane) {
#pragma unroll
    for (int o = 1; o < 64; o <<= 1) { const float t = __shfl_up(v, o); if (lane >= o) v += t; }
    return v;
}
__device__ __forceinline__ float wave_scan_max(float v, int lane) {
#pragma unroll
    for (int o = 1; o < 64; o <<= 1) { const float t = __shfl_up(v, o); if (lane >= o) v = fmaxf(v, t); }
    return v;
}
__device__ __forceinline__ f32x4 mm16(const LAS unsigned char* A, int lda, const LAS unsigned char* B, int ldb, int K, f32x4 acc, int fr, int fq) {
    const LAS unsigned char* ap = A + fr * lda + fq * 16; const LAS unsigned char* bp = B + fr * ldb + fq * 16;
    for (int k = 0; k < K; k += 32) {
        const bf16x8 a = *(const LAS bf16x8*)(ap + k * 2); const bf16x8 b = *(const LAS bf16x8*)(bp + k * 2);
        acc = __builtin_amdgcn_mfma_f32_16x16x32_bf16(b, a, acc, 0, 0, 0);
    }
    return acc;
}
__device__ __forceinline__ f32x4 mm16_gB(const LAS unsigned char* A, int lda, const float* B, int ldb, int K, f32x4 acc, int fr, int fq) {
    const LAS unsigned char* ap = A + fr * lda + fq * 16; const float* bp = B + (size_t)fr * ldb + fq * 8;
    for (int k = 0; k < K; k += 32) {
        const bf16x8 a = *(const LAS bf16x8*)(ap + k * 2);
        const f32x4 b0 = *(const f32x4*)(bp + k), b1 = *(const f32x4*)(bp + k + 4);
        v4u bw; bw.x = cvt_pk_bf16(b0.x, b0.y); bw.y = cvt_pk_bf16(b0.z, b0.w); bw.z = cvt_pk_bf16(b1.x, b1.y); bw.w = cvt_pk_bf16(b1.z, b1.w);
        const bf16x8 b = __builtin_bit_cast(bf16x8, bw);
        acc = __builtin_amdgcn_mfma_f32_16x16x32_bf16(b, a, acc, 0, 0, 0);
    }
    return acc;
}
__device__ __forceinline__ f32x4 mm16_gAB(const bf16* A, int lda, const bf16* B, int ldb, int K, f32x4 acc, int fr, int fq) {
    const bf16* ap = A + (size_t)fr * lda + fq * 8; const bf16* bp = B + (size_t)fr * ldb + fq * 8;
    for (int k = 0; k < K; k += 32) { const bf16x8 a = *(const bf16x8*)(ap + k), b = *(const bf16x8*)(bp + k); acc = __builtin_amdgcn_mfma_f32_16x16x32_bf16(b, a, acc, 0, 0, 0); }
    return acc;
}
__device__ __forceinline__ bf16x8 ldfrag_f32(const float* p) { const f32x4 b0 = *(const f32x4*)p, b1 = *(const f32x4*)(p + 4);
    v4u bw; bw.x = cvt_pk_bf16(b0.x, b0.y); bw.y = cvt_pk_bf16(b0.z, b0.w); bw.z = cvt_pk_bf16(b1.x, b1.y); bw.w = cvt_pk_bf16(b1.z, b1.w); return __builtin_bit_cast(bf16x8, bw); }
template <int NK> __device__ __forceinline__ f32x4 mm16_rB(const LAS unsigned char* A, int lda, const bf16x8 (&b)[NK], f32x4 acc, int fr, int fq) {
    const LAS unsigned char* ap = A + fr * lda + fq * 16;
#pragma unroll
    for (int k = 0; k < NK; ++k) { const bf16x8 a = *(const LAS bf16x8*)(ap + k * 64); acc = __builtin_amdgcn_mfma_f32_16x16x32_bf16(b[k], a, acc, 0, 0, 0); }
    return acc;
}
__device__ __forceinline__ v4u pack8(const float (&v)[8]) { v4u o; o.x = cvt_pk_bf16(v[0], v[1]); o.y = cvt_pk_bf16(v[2], v[3]); o.z = cvt_pk_bf16(v[4], v[5]); o.w = cvt_pk_bf16(v[6], v[7]); return o; }

#define XB_TMO      128
#define XB_XCNT(j)  (256  + 64 * (j))
#define XB_XSUB(j)  (1280 + 64 * (j))
#define XB_XGEN(j)  (2304 + 64 * (j))
#define XB_TOP      3328
#define XB_TOPGEN   3392
#define XCD_BAR_WORDS 3456
#define XB_SPIN_CAP (1u << 18)
__device__ __forceinline__ unsigned xb_ld(unsigned* p)              { return __hip_atomic_load(p, __ATOMIC_RELAXED, __HIP_MEMORY_SCOPE_AGENT); }
__device__ __forceinline__ unsigned xb_add(unsigned* p, unsigned v) { return __hip_atomic_fetch_add(p, v, __ATOMIC_RELAXED, __HIP_MEMORY_SCOPE_AGENT); }
__device__ __forceinline__ unsigned xb_xcc_id() { return (unsigned)__builtin_amdgcn_s_getreg((3 << 11) | 20) & 0xFu; }
#define XB_SPIN(cond, bar) do { unsigned _sp = 0; while (cond) { __builtin_amdgcn_s_sleep(1); \
    if ((++_sp & 255u) == 0u) { if (xb_ld(&(bar)[XB_TMO])) break; if (_sp > XB_SPIN_CAP) { atomicAdd(&(bar)[XB_TMO], 1u); break; } } } } while (0)
struct XcdBarrier { unsigned* bar; unsigned x; volatile LAS unsigned* st; };
__device__ __forceinline__ XcdBarrier xcd_barrier_post(unsigned* bar, volatile LAS unsigned* st) {
    XcdBarrier b; b.bar = bar; b.x = xb_xcc_id(); b.st = st;
    if (threadIdx.x == 0) (void)xb_add(&bar[XB_XCNT(b.x)], 1u);
    return b;
}
__device__ __forceinline__ void xcd_barrier_complete(unsigned* bar, unsigned x, unsigned& nloc, unsigned& nx) {
    const unsigned G = gridDim.x * gridDim.y * gridDim.z;
    unsigned sum, cnt, mine, sp = 0u;
    for (;;) {
        sum = 0u; cnt = 0u; mine = 0u;
#pragma unroll
        for (unsigned j = 0; j < 16; ++j) { const unsigned c = xb_ld(&bar[XB_XCNT(j)]); sum += c; cnt += (c > 0u) ? 1u : 0u; mine = (j == x) ? c : mine; }
        if (sum == G) break;
        __builtin_amdgcn_s_sleep(1);
        if ((++sp & 255u) == 0u) { if (xb_ld(&bar[XB_TMO])) break; if (sp > XB_SPIN_CAP) { atomicAdd(&bar[XB_TMO], 1u); break; } }
    }
    nloc = mine > 0u ? mine : 1u; nx = cnt > 0u ? cnt : 1u;
}
__device__ __forceinline__ void xcd_barrier(const XcdBarrier& b) {
    asm volatile("s_waitcnt vmcnt(0)" ::: "memory");
    __syncthreads();
    if (threadIdx.x == 0) {
        unsigned* bar = b.bar;
        __builtin_amdgcn_s_waitcnt(0);
        unsigned nloc = b.st[0], nx = b.st[1];
        if (nloc == 0u) { xcd_barrier_complete(bar, b.x, nloc, nx); b.st[0] = nloc; b.st[1] = nx; }
        const unsigned old = xb_add(&bar[XB_XSUB(b.x)], 1u);
        const unsigned gen = old / nloc;
        if (old + 1u == (gen + 1u) * nloc) {
            __builtin_amdgcn_fence(__ATOMIC_RELEASE, "agent");
            asm volatile("s_waitcnt vmcnt(0)" ::: "memory");
            const unsigned og = xb_add(&bar[XB_TOP], 1u);
            const unsigned tg = og / nx;
            if (og + 1u == (tg + 1u) * nx) xb_add(&bar[XB_TOPGEN], 1u);
            else XB_SPIN(xb_ld(&bar[XB_TOPGEN]) == tg, bar);
            __builtin_amdgcn_fence(__ATOMIC_ACQUIRE, "agent");
            xb_add(&bar[XB_XGEN(b.x)], 1u);
            asm volatile("s_waitcnt vmcnt(0)" ::: "memory");
        } else {
            XB_SPIN(xb_ld(&bar[XB_XGEN(b.x)]) == gen, bar);
            __builtin_amdgcn_fence(__ATOMIC_ACQUIRE, "agent");
            asm volatile("s_waitcnt vmcnt(0)" ::: "memory");
        }
    }
    __syncthreads();
}

namespace pg8 {
constexpr int BM = 256, BK = 64, HALF = 128, HTB = HALF * BK * 2, STAGE_BYTES = 8 * HTB, NXCD = 8, WGM = 8;
__host__ __device__ __forceinline__ int lds_byte(int r, int c) { const int st = (r >> 4) * 2 + (c >> 5), rr = r & 15, cc = c & 31, ob = rr * 64 + cc * 2; return st * 1024 + (ob ^ (((ob >> 9) & 1) << 5)); }
__host__ __device__ __forceinline__ void stage_rc(int b, int& R, int& C) { const int st = b / 1024, sb = b % 1024, swz = sb ^ (((sb >> 9) & 1) << 5); R = (st >> 1) * 16 + swz / 64; C = (st & 1) * 32 + (swz % 64) / 2; }
__host__ __device__ __forceinline__ int perm32(int rho) { const int n = rho >> 4, i = rho & 15; return 8 * (i >> 2) + 4 * n + (i & 3); }

template <class Epi, class Sched>
__device__ __forceinline__ void gemm_phase(LAS unsigned char* lds, const int tid, const Sched& S, const Epi& E) {
    const int wid = __builtin_amdgcn_readfirstlane(tid >> 6), lane = tid & 63, wr = wid >> 2, wc = wid & 3, fr = lane & 15, fq = lane >> 4;
    const int K = S.K, nt = K / BK;
    unsigned voffB[2];
#pragma unroll
    for (int i = 0; i < 2; ++i) { int R, C; stage_rc(tid * 16 + i * 8192, R, C); const int Rb = Epi::PERM ? ((R & ~31) + perm32(R & 31)) : R; voffB[i] = (unsigned)(Rb * K + C) * 2u; }
    const size_t kstep = (size_t)(BK * 2);
    const size_t hstepB = S.hstepB;
    const unsigned ldsw = (unsigned)wid * 1024u;
    constexpr bool F8 = Sched::FP8;
    const int aoff = F8 ? lds_byte(wr * 64 + fr, fq * 16) : lds_byte(wr * 64 + fr, fq * 8), boff = F8 ? lds_byte(wc * 32 + fr, fq * 16) : lds_byte(wc * 32 + fr, fq * 8);
#define PG8_SA(b, h) (((b) * 2 + (h)) * HTB)
#define PG8_SB(b, h) ((4 + (b) * 2 + (h)) * HTB)
#define PG8_STAGE_B(bufoff, gbase) do { _Pragma("unroll") for (int _i = 0; _i < 2; ++_i) \
        __builtin_amdgcn_global_load_lds((const unsigned*)((const char*)(gbase) + voffB[_i]), (LAS unsigned*)(lds + (bufoff) + ldsw + _i * 8192), 16, 0, 0); } while (0)
#define PG8_STAGE_A(bufoff, gbase, v0, v1) do { \
        __builtin_amdgcn_global_load_lds((const unsigned*)((const char*)(gbase) + (v0)), (LAS unsigned*)(lds + (bufoff) + ldsw), 16, 0, 0); \
        __builtin_amdgcn_global_load_lds((const unsigned*)((const char*)(gbase) + (v1)), (LAS unsigned*)(lds + (bufoff) + ldsw + 8192), 16, 0, 0); } while (0)
#define PG8_FOFF(k) (F8 ? (k) * 16 : (k) * 1024)
#define PG8_LDA(dst, b, h) do { _Pragma("unroll") for (int m = 0; m < 4; ++m) { if constexpr (F8) dst##8[m] = *(const LAS v8i_t*)(lds + PG8_SA(b, h) + aoff + m * 2048); \
        else { _Pragma("unroll") for (int k = 0; k < 2; ++k) dst[m][k] = *(const LAS bf16x8*)(lds + PG8_SA(b, h) + aoff + m * 2048 + k * 1024); } } } while (0)
#define PG8_LDB(dst, b, h) do { _Pragma("unroll") for (int n = 0; n < 2; ++n) { if constexpr (F8) dst##8[n] = *(const LAS v8i_t*)(lds + PG8_SB(b, h) + boff + n * 2048); \
        else { _Pragma("unroll") for (int k = 0; k < 2; ++k) dst[n][k] = *(const LAS bf16x8*)(lds + PG8_SB(b, h) + boff + n * 2048 + k * 1024); } } } while (0)
#define PG8_CAT(x) __builtin_shufflevector(__builtin_bit_cast(v4i_t, x[0]), __builtin_bit_cast(v4i_t, x[1]), 0, 1, 2, 3, 4, 5, 6, 7)
#define PG8_MMA(ai, bj, At, Bt) do { __builtin_amdgcn_s_setprio(1); _Pragma("unroll") for (int m = 0; m < 4; ++m) _Pragma("unroll") for (int n = 0; n < 2; ++n) { \
        if constexpr (F8) acc[ai][bj][m][n] = __builtin_amdgcn_mfma_scale_f32_16x16x128_f8f6f4(Bt##8[n], At##8[m], acc[ai][bj][m][n], 0, 0, 0, S.scaleB, 0, S.scaleA); \
        else { _Pragma("unroll") for (int k = 0; k < 2; ++k) acc[ai][bj][m][n] = __builtin_amdgcn_mfma_f32_16x16x32_bf16(Bt[n][k], At[m][k], acc[ai][bj][m][n], 0, 0, 0); } } __builtin_amdgcn_s_setprio(0); } while (0)
#define PG8_WAIT_V(n) asm volatile("s_waitcnt vmcnt(" #n ")" ::: "memory")
#define PG8_WAIT_L(n) asm volatile("s_waitcnt lgkmcnt(" #n ")" ::: "memory")
#define PG8_BAR __builtin_amdgcn_s_barrier()
#define PG8_SCHED __builtin_amdgcn_sched_barrier(0)
    typename Sched::Unit cur, nxt; int ui = 0;
    if (!S.next(0, cur)) return;
    f32x4 acc[2][2][4][2];
#pragma unroll
    for (int a = 0; a < 2; ++a)
#pragma unroll
        for (int b = 0; b < 2; ++b)
#pragma unroll
            for (int m = 0; m < 4; ++m)
#pragma unroll
                for (int n = 0; n < 2; ++n) acc[a][b][m][n] = (f32x4){0.f, 0.f, 0.f, 0.f};
    bf16x8 At[4][2], B0[2][2], B1[2][2]; v8i_t At8[4], B08[2], B18[2];
    constexpr bool GA = Sched::GATHER;
    const size_t hstepA = GA ? (size_t)0 : (size_t)HALF * K * 2;
    unsigned vA[2][2];
    LAS unsigned char* hdr = lds + STAGE_BYTES;
    if constexpr (Sched::HDR) { if (wid == 0) S.hdr_issue(cur, hdr, lane); PG8_WAIT_V(0); PG8_BAR; }
    S.a_off(cur, tid, vA, hdr);
#define PG8_STAGE_AH(bufoff, base, vv, h) PG8_STAGE_A(bufoff, ((base) + (h) * hstepA), vv[GA ? (h) : 0][0], vv[GA ? (h) : 0][1])
    const char* cA = S.a_base(cur); const char* cB = S.b_base(cur);
    PG8_STAGE_B(PG8_SB(0, 0), cB); PG8_STAGE_B(PG8_SB(0, 1), cB + hstepB); PG8_STAGE_AH(PG8_SA(0, 0), cA, vA, 0); PG8_STAGE_AH(PG8_SA(0, 1), cA, vA, 1);
    if (wr == 1) PG8_BAR;
    PG8_WAIT_V(2); PG8_BAR;
    PG8_STAGE_B(PG8_SB(1, 0), cB + kstep); PG8_STAGE_AH(PG8_SA(1, 0), cA + kstep, vA, 0); PG8_STAGE_B(PG8_SB(1, 1), cB + hstepB + kstep);
    PG8_WAIT_V(6); PG8_BAR;
    int hc = 0;
    for (;;) {
        const bool has_next = S.next(ui + 1, nxt); const int hn = (hc == 2) ? 0 : hc + 1;
        const char* nA = cA; const char* nB = cB;
        if (has_next) { nA = S.a_base(nxt); nB = S.b_base(nxt); if constexpr (Sched::HDR) { if (wid == 0) S.hdr_issue(nxt, hdr + hn * 4096, lane); } }
        for (int t = 0; t < nt; t += 2) {
            const bool last = (t == nt - 2);
            const char* a1 = cA + (size_t)(t + 1) * kstep;
            const char* a2 = last ? nA : cA + (size_t)(t + 2) * kstep; const char* b2 = last ? nB : cB + (size_t)(t + 2) * kstep;
            const char* a3 = a2 + kstep; const char* b3 = b2 + kstep;
            PG8_LDB(B0, 0, 0); PG8_LDB(B1, 0, 1); PG8_SCHED; PG8_LDA(At, 0, 0); PG8_STAGE_AH(PG8_SA(1, 1), a1, vA, 1);
            if constexpr (GA) { if (last && has_next) S.a_off(nxt, tid, vA, hdr + hn * 4096); }
            PG8_WAIT_V(8); PG8_WAIT_L(0); PG8_BAR; PG8_MMA(0, 0, At, B0); PG8_MMA(0, 1, At, B1); PG8_BAR; PG8_SCHED;
            PG8_LDA(At, 0, 1); PG8_STAGE_B(PG8_SB(0, 0), b2); PG8_STAGE_B(PG8_SB(0, 1), b2 + hstepB); PG8_STAGE_AH(PG8_SA(0, 0), a2, vA, 0);
            PG8_WAIT_V(8); PG8_WAIT_L(0); PG8_BAR; PG8_MMA(1, 0, At, B0); PG8_MMA(1, 1, At, B1); PG8_BAR; PG8_SCHED;
            PG8_LDB(B0, 1, 0); PG8_LDB(B1, 1, 1); PG8_SCHED; PG8_LDA(At, 1, 0); PG8_STAGE_AH(PG8_SA(0, 1), a2, vA, 1);
            PG8_WAIT_V(8); PG8_WAIT_L(0); PG8_BAR; PG8_MMA(0, 0, At, B0); PG8_MMA(0, 1, At, B1); PG8_BAR; PG8_SCHED;
            PG8_LDA(At, 1, 1); PG8_STAGE_B(PG8_SB(1, 0), b3); PG8_STAGE_B(PG8_SB(1, 1), b3 + hstepB); PG8_STAGE_AH(PG8_SA(1, 0), a3, vA, 0);
            PG8_WAIT_V(8); PG8_WAIT_L(0); PG8_BAR; PG8_MMA(1, 0, At, B0); PG8_MMA(1, 1, At, B1); PG8_BAR; PG8_SCHED;
        }
        if (wr == 0) PG8_BAR;
        { int fr_ = fr, fq_ = fq; asm volatile("" : "+v"(fr_), "+v"(fq_)); E(acc, cur, wr, wc, fr_, fq_, hdr + hc * 4096); }
        if (!has_next) break;
#pragma unroll
        for (int a = 0; a < 2; ++a)
#pragma unroll
            for (int b = 0; b < 2; ++b)
#pragma unroll
                for (int m = 0; m < 4; ++m)
#pragma unroll
                    for (int n = 0; n < 2; ++n) acc[a][b][m][n] = (f32x4){0.f, 0.f, 0.f, 0.f};
        cur = nxt; cA = nA; cB = nB; ++ui; hc = hn;
        if (wr == 1) PG8_BAR;
    }
    PG8_WAIT_V(0);
    PG8_BAR;
#undef PG8_SA
#undef PG8_SB
#undef PG8_STAGE_A
#undef PG8_STAGE_AH
#undef PG8_STAGE_B
#undef PG8_LDA
#undef PG8_LDB
#undef PG8_MMA
#undef PG8_CAT
#undef PG8_FOFF
#undef PG8_WAIT_V
#undef PG8_WAIT_L
#undef PG8_BAR
#undef PG8_SCHED
}
}
struct Args { const float* in[N_IN]; float* out; unsigned char* ws; int ph_lo, ph_hi; };
typedef const __attribute__((address_space(4))) unsigned long long* karg_t;
struct Frame {
    karg_t ka;
    LAS unsigned char* lds;
    volatile LAS unsigned* MISC;
    gu32* ctl;
    unsigned char* ws;
    float* out;
    int tid, lane, wave, vcu, G;
};
#define WSP(T_, off) ((T_*)(F.ws + (off)))
#define KIN(k) ((const float*)F.ka[(k)])
#ifdef DBG_SEL
#define DBG_STAT(k, val) do { const float _v = (val); if ((k) == DBG_SEL) { if (fabsf(_v) < 3e38f) atomicMax((unsigned*)(F.ctl + CW_DBG), __float_as_uint(fabsf(_v))); else atomicAdd((unsigned*)(F.ctl + CW_DBG + 1), 1u); } } while (0)
#else
#define DBG_STAT(k, val) do { } while (0)
#endif
template <class P> __device__ __forceinline__ P launder_uniform(P p) {
    unsigned lo = (unsigned)(unsigned long long)p, hi = (unsigned)((unsigned long long)p >> 32);
    asm volatile("" : "+v"(lo), "+v"(hi));
    lo = __builtin_amdgcn_readfirstlane(lo); hi = __builtin_amdgcn_readfirstlane(hi);
    return (P)(((unsigned long long)hi << 32) | lo);
}
__device__ __forceinline__ void frame_refresh(Frame& F) {
    int t = F.tid; asm volatile("" : "+v"(t)); F.tid = t; F.lane = t & 63; F.wave = __builtin_amdgcn_readfirstlane(t >> 6);
    F.ws = launder_uniform(F.ws); F.ctl = (gu32*)(F.ws + WS_CTL);
    F.out = launder_uniform(F.out);
    F.ka = launder_uniform(F.ka);
}

namespace pg8 {
struct DenseSched {
    static constexpr bool GATHER = false, FP8 = false, HDR = false; static constexpr int scaleA = 0, scaleB = 0;
    struct Unit { int pm, pn; };
    __device__ __forceinline__ void hdr_issue(const Unit&, LAS unsigned char*, int) const {}
    const bf16* A; const bf16* Bt; int K; size_t hstepB; int nM, nN, nwg, G, c;
    __device__ __forceinline__ void init(const bf16* A_, const bf16* Bt_, int M, int N, int K_, int G_, int c_) { A = A_; Bt = Bt_; K = K_; hstepB = (size_t)HALF * K_ * 2; nM = M / BM; nN = N / BM; nwg = nM * nN; G = G_; c = c_; }
    __device__ __forceinline__ bool next(int i, Unit& u) const {
        const long L = (long)i * G + c; if (L >= nwg) return false;
        int wgid = (int)L; { const int q = nwg / NXCD, r = nwg % NXCD, xcd = wgid % NXCD, off = wgid / NXCD; wgid = (xcd < r ? xcd * (q + 1) : r * (q + 1) + (xcd - r) * q) + off; }
        const int nig = WGM * nN, gid = wgid / nig, fm = gid * WGM, gsz = (nM - fm) < WGM ? (nM - fm) : WGM;
        u.pm = fm + ((wgid % nig) % gsz); u.pn = (wgid % nig) / gsz; return true;
    }
    __device__ __forceinline__ const char* a_base(const Unit& u) const { return (const char*)A + (size_t)u.pm * BM * K * 2; }
    __device__ __forceinline__ const char* b_base(const Unit& u) const { return (const char*)Bt + (size_t)u.pn * BM * K * 2; }
    __device__ __forceinline__ void a_off(const Unit&, int tid, unsigned (&v)[2][2], const LAS unsigned char*) const {
#pragma unroll
        for (int i = 0; i < 2; ++i) { int R, C; stage_rc(tid * 16 + i * 8192, R, C); v[0][i] = (unsigned)(R * K + C) * 2u; v[1][i] = v[0][i]; }
    }
};
template <int SB> struct DenseSched8T : DenseSched { static constexpr bool GATHER = true, FP8 = true; static constexpr int scaleA = 0x7F7F7F7F, scaleB = SB;
    __device__ __forceinline__ void a_off(const Unit&, int tid, unsigned (&v)[2][2], const LAS unsigned char*) const {
        int t_ = tid; asm volatile("" : "+v"(t_));
#pragma unroll
        for (int i = 0; i < 2; ++i) { int R, C; stage_rc(t_ * 16 + i * 8192, R, C); v[0][i] = (unsigned)(R * K + C) * 2u; v[1][i] = v[0][i] + (unsigned)(HALF * K * 2); }
    }
};
typedef DenseSched8T<0x7A7A7A7A> DenseSched8;
typedef DenseSched8T<0x79797979> DenseSched8b;
struct MoeUnit { int e, mt, nt, cnt; };
struct MoeOrder {
    const volatile LAS unsigned* pfx;
    int NT, G, c;
    __device__ __forceinline__ bool decode(int i, MoeUnit& u) const {
        const int nwg = (int)pfx[32]; const long L = (long)i * G + c; if (L >= nwg) return false;
        int wgid = (int)L; { const int q = nwg / NXCD, r = nwg % NXCD, xcd = wgid % NXCD, off = wgid / NXCD; wgid = (xcd < r ? xcd * (q + 1) : r * (q + 1) + (xcd - r) * q) + off; }
        int e = 0;
#pragma unroll
        for (int st = 16; st >= 1; st >>= 1) e += ((int)pfx[e + st] <= wgid) ? st : 0;
        const int j = wgid - (int)pfx[e];
        u.e = e; u.mt = j / NT; u.nt = j % NT; u.cnt = (int)pfx[40 + e]; return true;
    }
};
#ifndef HDR_AOFF
#define HDR_AOFF 1
#endif
struct Moe1Sched {
    static constexpr bool GATHER = true, FP8 = (MOE_FP8 != 0), HDR = true; static constexpr int EB = FP8 ? 1 : 2; static constexpr int scaleA = 0x7F7F7F7F, scaleB = 0x7A7A7A7A;
    typedef MoeUnit Unit;
    MoeOrder O; const unsigned char* X; const unsigned char* W; const int* sdest; const float* bgu; int K; size_t hstepB;
    __device__ __forceinline__ void hdr_issue(const Unit& u, LAS unsigned char* hdr, int lane) const {
        __builtin_amdgcn_global_load_lds((const unsigned*)(sdest + (size_t)u.e * ECAP + (size_t)u.mt * 256 + lane * 4), (LAS unsigned*)hdr, 16, 0, 0);
        const float* bp = bgu + (size_t)u.e * 2048 + u.nt * 128 + (lane < 32 ? lane * 4 : 1024 + (lane - 32) * 4);
        __builtin_amdgcn_global_load_lds((const unsigned*)bp, (LAS unsigned*)(hdr + 1024), 16, 0, 0);
    }
    __device__ __forceinline__ bool next(int i, Unit& u) const { return O.decode(i, u); }
    __device__ __forceinline__ const char* a_base(const Unit&) const { return (const char*)X; }
    __device__ __forceinline__ const char* b_base(const Unit& u) const { return (const char*)W + ((size_t)u.e * 2048 + (size_t)u.nt * 128) * 1024 * EB; }
    __device__ __forceinline__ void a_off(const Unit& u, int tid, unsigned (&v)[2][2], const LAS unsigned char* hdr) const {
#pragma unroll
        for (int i = 0; i < 2; ++i) { int R, C; stage_rc(tid * 16 + i * 8192, R, C);
#pragma unroll
            for (int h = 0; h < 2; ++h) { const int sl = h * HALF + R; int tok = 0; if (u.mt * 256 + sl < u.cnt) tok = HDR_AOFF ? (((const LAS int*)hdr)[sl] >> 2) : (sdest[u.e * ECAP + u.mt * 256 + sl] >> 2); v[h][i] = (unsigned)(tok * 1024 * EB + C * 2); } }
    }
};
struct Moe2Sched {
    static constexpr bool GATHER = true, FP8 = (MOE2_FP8 != 0), HDR = true; static constexpr int EB = FP8 ? 1 : 2; static constexpr int scaleA = 0x7F7F7F7F, scaleB = 0x79797979;
    typedef MoeUnit Unit;
    MoeOrder O; const unsigned char* Ab; const unsigned char* W; const int* sdest; const float* sgate; const float* bdn; int K; size_t hstepB;
    __device__ __forceinline__ void hdr_issue(const Unit& u, LAS unsigned char* hdr, int lane) const {
        const size_t so = (size_t)u.e * ECAP + (size_t)u.mt * 256 + lane * 4;
        __builtin_amdgcn_global_load_lds((const unsigned*)(sdest + so), (LAS unsigned*)hdr, 16, 0, 0);
        __builtin_amdgcn_global_load_lds((const unsigned*)(sgate + so), (LAS unsigned*)(hdr + 1024), 16, 0, 0);
        __builtin_amdgcn_global_load_lds((const unsigned*)(bdn + (size_t)u.e * 1024 + u.nt * 256 + lane * 4), (LAS unsigned*)(hdr + 2048), 16, 0, 0);
    }
    __device__ __forceinline__ bool next(int i, Unit& u) const { return O.decode(i, u); }
    __device__ __forceinline__ const char* a_base(const Unit& u) const { return (const char*)Ab + ((size_t)u.e * ECAP + (size_t)u.mt * 256) * 1024 * EB; }
    __device__ __forceinline__ const char* b_base(const Unit& u) const { return (const char*)W + ((size_t)u.e * 1024 + (size_t)u.nt * 256) * 1024 * EB; }
    __device__ __forceinline__ void a_off(const Unit&, int tid, unsigned (&v)[2][2], const LAS unsigned char*) const {
        int t_ = tid; asm volatile("" : "+v"(t_));
#pragma unroll
        for (int i = 0; i < 2; ++i) { int R, C; stage_rc(t_ * 16 + i * 8192, R, C); v[0][i] = (unsigned)(R * 1024 * EB + C * 2); v[1][i] = v[0][i] + (unsigned)(HALF * 1024 * EB); }
    }
};

__device__ __forceinline__ void unpack8(const v4u w, f32x4& a, f32x4& b) {
    a = (f32x4){__uint_as_float(w.x << 16), __uint_as_float(w.x & 0xffff0000u), __uint_as_float(w.y << 16), __uint_as_float(w.y & 0xffff0000u)};
    b = (f32x4){__uint_as_float(w.z << 16), __uint_as_float(w.z & 0xffff0000u), __uint_as_float(w.w << 16), __uint_as_float(w.w & 0xffff0000u)}; }
struct EpiF32 {
    static constexpr bool PERM = false;
    float* C; int ldc; const float* base; float alpha;
    __device__ __forceinline__ void operator()(const f32x4 (&acc)[2][2][4][2], const DenseSched::Unit& u, int wr, int wc, int fr, int fq, const LAS unsigned char* hdr) const {
        const int row0 = u.pm * BM + wr * 64 + fr, col0 = u.pn * BM + wc * 32 + 4 * fq;
#pragma unroll
        for (int ai = 0; ai < 2; ++ai)
#pragma unroll
            for (int m = 0; m < 4; ++m) { const size_t ro = (size_t)(row0 + ai * HALF + m * 16) * ldc + col0;
#pragma unroll
                for (int bj = 0; bj < 2; ++bj)
#pragma unroll
                    for (int n = 0; n < 2; ++n) { f32x4 v = acc[ai][bj][m][n];
                        if (base) { const f32x4 b = *(const f32x4*)(base + ro + bj * HALF + n * 16); v = v + b * alpha; }
                        *(f32x4*)(C + ro + bj * HALF + n * 16) = v; } }
    }
};
struct EpiB16 {
    static constexpr bool PERM = true;
    bf16* O; int ldc; const bf16* base; float alpha;
    __device__ __forceinline__ void operator()(const f32x4 (&acc)[2][2][4][2], const DenseSched::Unit& u, int wr, int wc, int fr, int fq, const LAS unsigned char* hdr) const {
        const int row0 = u.pm * BM + wr * 64 + fr, col0 = u.pn * BM + wc * 32 + 8 * fq;
#pragma unroll
        for (int ai = 0; ai < 2; ++ai) {
            v4u bw[4][2];
            if (base) {
#pragma unroll
                for (int m = 0; m < 4; ++m)
#pragma unroll
                    for (int bj = 0; bj < 2; ++bj) bw[m][bj] = *(const v4u*)(base + (size_t)(row0 + ai * HALF + m * 16) * ldc + col0 + bj * HALF); }
#pragma unroll
            for (int m = 0; m < 4; ++m) { bf16* rowp = O + (size_t)(row0 + ai * HALF + m * 16) * ldc + col0;
#pragma unroll
                for (int bj = 0; bj < 2; ++bj) { f32x4 v0 = acc[ai][bj][m][0], v1 = acc[ai][bj][m][1];
                    if (base) { f32x4 b0, b1; unpack8(bw[m][bj], b0, b1); v0 = v0 + b0 * alpha; v1 = v1 + b1 * alpha; }
                    v4u w; w.x = cvt_pk_bf16(v0[0], v0[1]); w.y = cvt_pk_bf16(v0[2], v0[3]); w.z = cvt_pk_bf16(v1[0], v1[1]); w.w = cvt_pk_bf16(v1[2], v1[3]);
                    *(v4u*)(rowp + bj * HALF) = w; } } }
    }
};
struct EpiPle {
    static constexpr bool PERM = true;
    bf16* C; const bf16* hb; const bf16* pe;
    __device__ __forceinline__ void operator()(const f32x4 (&acc)[2][2][4][2], const DenseSched::Unit& u, int wr, int wc, int fr, int fq, const LAS unsigned char* hdr) const {
        const int row0 = u.pm * BM + wr * 64 + fr, col0 = u.pn * BM + wc * 32 + 8 * fq;
#pragma unroll
        for (int ai = 0; ai < 2; ++ai) {
            v4u hw[4][2], pw[4][2];
#pragma unroll
            for (int m = 0; m < 4; ++m)
#pragma unroll
                for (int bj = 0; bj < 2; ++bj) { const size_t ro = (size_t)(row0 + ai * HALF + m * 16) * 1024 + col0 + bj * HALF; hw[m][bj] = *(const v4u*)(hb + ro); pw[m][bj] = *(const v4u*)(pe + ro); }
#pragma unroll
            for (int m = 0; m < 4; ++m)
#pragma unroll
                for (int bj = 0; bj < 2; ++bj) { const size_t ro = (size_t)(row0 + ai * HALF + m * 16) * 1024 + col0 + bj * HALF;
                    f32x4 h0, h1, p0, p1; unpack8(hw[m][bj], h0, h1); unpack8(pw[m][bj], p0, p1); const f32x4 a0 = acc[ai][bj][m][0], a1 = acc[ai][bj][m][1];
                    f32x4 o0, o1;
#pragma unroll
                    for (int j = 0; j < 4; ++j) { o0[j] = h0[j] + sigmoidf_(a0[j]) * p0[j]; o1[j] = h1[j] + sigmoidf_(a1[j]) * p1[j]; }
                    v4u w; w.x = cvt_pk_bf16(o0[0], o0[1]); w.y = cvt_pk_bf16(o0[2], o0[3]); w.z = cvt_pk_bf16(o1[0], o1[1]); w.w = cvt_pk_bf16(o1[2], o1[3]);
                    *(v4u*)(C + ro) = w; } }
    }
};
struct EpiMoe1 {
    static constexpr bool PERM = true;
    bf16* Ab; const float* bgu; unsigned char* AbQ;
    __device__ __forceinline__ void operator()(const f32x4 (&acc)[2][2][4][2], const MoeUnit& u, int wr, int wc, int fr, int fq, const LAS unsigned char* hdr) const {
        const int col0 = u.nt * 128 + wc * 32 + 8 * fq;
        const LAS float* bh = (const LAS float*)(hdr + 1024) + wc * 32 + 8 * fq;
        const f32x4 bg0 = *(const LAS f32x4*)(bh), bg1 = *(const LAS f32x4*)(bh + 4), bl0 = *(const LAS f32x4*)(bh + 128), bl1 = *(const LAS f32x4*)(bh + 132);
#pragma unroll
        for (int ai = 0; ai < 2; ++ai)
#pragma unroll
            for (int m = 0; m < 4; ++m) { const int r = ai * HALF + wr * 64 + m * 16 + fr;
                bf16* rowp = Ab + ((size_t)u.e * ECAP + (size_t)u.mt * 256 + r) * 1024 + col0;
                float o[8];
#pragma unroll
                for (int n = 0; n < 2; ++n) { const f32x4 g4 = acc[ai][0][m][n] + (n ? bg1 : bg0), l4 = acc[ai][1][m][n] + (n ? bl1 : bl0);
#pragma unroll
                    for (int j = 0; j < 4; ++j) { const float g = fminf(g4[j], 7.0f), l = fminf(fmaxf(l4[j], -7.0f), 7.0f); o[n * 4 + j] = (l + 1.0f) * g * sigmoidf_(1.702f * g); } }
                if constexpr (MOE2_FP8) { v2u q; q.x = cvt4_fp8(o[0], o[1], o[2], o[3]); q.y = cvt4_fp8(o[4], o[5], o[6], o[7]); *(v2u*)((unsigned char*)AbQ + ((size_t)u.e * ECAP + (size_t)u.mt * 256 + r) * 1024 + col0) = q; }
                else *(v4u*)rowp = pack8(o); }
    }
};
struct EpiMoe2 {
    static constexpr bool PERM = true;
    bf16* Y; const float* bdn; const int* sdest; const float* sgate;
    __device__ __forceinline__ void operator()(const f32x4 (&acc)[2][2][4][2], const MoeUnit& u, int wr, int wc, int fr, int fq, const LAS unsigned char* hdr) const {
        const int col0 = u.nt * 256 + wc * 32 + 8 * fq;
        const LAS float* bp = (const LAS float*)(hdr + 2048) + wc * 32 + 8 * fq;
#pragma unroll
        for (int ai = 0; ai < 2; ++ai) {
            f32x4 bv[2][2];
#pragma unroll
            for (int bj = 0; bj < 2; ++bj)
#pragma unroll
                for (int n = 0; n < 2; ++n) bv[bj][n] = *(const LAS f32x4*)(bp + bj * HALF + 4 * n);
            int dest[4]; float gate[4];
#pragma unroll
            for (int m = 0; m < 4; ++m) { const int sl = ai * HALF + wr * 64 + m * 16 + fr; const bool ok = u.mt * 256 + sl < u.cnt;
                dest[m] = ok ? ((const LAS int*)hdr)[sl] : T * 4; gate[m] = ok ? ((const LAS float*)(hdr + 1024))[sl] : 0.f; }
#pragma unroll
            for (int m = 0; m < 4; ++m) {
                { const float g = gate[m]; bf16* rowp = Y + (size_t)dest[m] * 1024 + col0;
#pragma unroll
                    for (int bj = 0; bj < 2; ++bj) { const f32x4 v0 = (acc[ai][bj][m][0] + bv[bj][0]) * g, v1 = (acc[ai][bj][m][1] + bv[bj][1]) * g;
                        v4u w; w.x = cvt_pk_bf16(v0[0], v0[1]); w.y = cvt_pk_bf16(v0[2], v0[3]); w.z = cvt_pk_bf16(v1[0], v1[1]); w.w = cvt_pk_bf16(v1[2], v1[3]);
                        *(v4u*)(rowp + bj * HALF) = w; } } } }
    }
};
}

__device__ __forceinline__ void p0_transpose_item(const float* W, int K, int N, int nblk, bf16* WT, int item, int lane) {
    const int kb = item / nblk, nb = item % nblk, k0 = 64 * kb, n = 64 * nb + lane;
    const bool ok = n < N; const float* src = W + (size_t)k0 * N + (ok ? n : 0);
    float x[64];
#pragma unroll
    for (int j = 0; j < 64; ++j) x[j] = __builtin_nontemporal_load(src + (size_t)j * N);
    bf16* dst = WT + (size_t)n * K + k0;
#pragma unroll
    for (int q = 0; q < 8; ++q) { v4u o; o.x = cvt_pk_bf16(x[8 * q], x[8 * q + 1]); o.y = cvt_pk_bf16(x[8 * q + 2], x[8 * q + 3]); o.z = cvt_pk_bf16(x[8 * q + 4], x[8 * q + 5]); o.w = cvt_pk_bf16(x[8 * q + 6], x[8 * q + 7]);
        if (!ok) o = (v4u){0u, 0u, 0u, 0u};
        *(v4u*)(dst + 8 * q) = o; }
}
__device__ __forceinline__ void cvt_rows(const float* src, bf16* dst, size_t n8, size_t i0, size_t stride) {
    for (size_t i = i0; i < n8; i += stride) { const f32x4 a = *(const f32x4*)(src + i * 8), b = *(const f32x4*)(src + i * 8 + 4);
        v4u o; o.x = cvt_pk_bf16(a.x, a.y); o.y = cvt_pk_bf16(a.z, a.w); o.z = cvt_pk_bf16(b.x, b.y); o.w = cvt_pk_bf16(b.z, b.w); *(v4u*)(dst + i * 8) = o; }
}
__device__ __forceinline__ void p0_prologue(Frame& F, const Args& A) {
    const int gw = F.vcu * NWAVES + F.wave, NGW = F.G * NWAVES;
    constexpr int I_IN = 16 * (NUP / 64), I_OUT = 16 * 16, I_GU = 16 * 32, I_DN = 16 * 16, I_PG = 16 * 16, I_PP = 4 * 16;
    constexpr int PER_LAYER = I_IN + I_OUT + NE * I_GU + NE * I_DN + I_PG + I_PP;
#pragma unroll 1
    for (int it = gw; it < DEPTH * PER_LAYER; it += NGW) {
        const int l = it / PER_LAYER; int r = it % PER_LAYER;
        const float* W; bf16* WT; int K = D, N = D, nblk = 16;
        if (r < I_IN) { W = KIN(I_WIN) + (size_t)l * D * NU; WT = WSP(bf16, WS_WIN_T) + (size_t)l * NUP * D; N = NU; nblk = NUP / 64; }
        else if ((r -= I_IN) < I_OUT) { if (OUT_FP8) continue; W = KIN(I_WOUT) + (size_t)l * D * D; WT = WSP(bf16, WS_WOUT_T) + (size_t)l * D * D; }
        else if ((r -= I_OUT) < NE * I_GU) { if (MOE_FP8) continue; const int e = r / I_GU; r %= I_GU; W = KIN(I_WGU) + ((size_t)l * NE + e) * D * 2048; WT = WSP(bf16, WS_WGU_T) + ((size_t)l * NE + e) * 2048 * D; N = 2048; nblk = 32; }
        else if ((r -= NE * I_GU) < NE * I_DN) { if (MOE2_FP8) continue; const int e = r / I_DN; r %= I_DN; W = KIN(I_WDN) + ((size_t)l * NE + e) * D * D; WT = WSP(bf16, WS_WDN_T) + ((size_t)l * NE + e) * D * D; }
        else if ((r -= NE * I_DN) < I_PG) { if (PLE_FP8) continue; W = KIN(I_PGW) + (size_t)l * D * D; WT = WSP(bf16, WS_WPG_T) + (size_t)l * D * D; }
        else { r -= I_PG; W = KIN(I_PPJ) + (size_t)l * 256 * D; WT = WSP(bf16, WS_WPP_T) + (size_t)l * D * 256; K = 256; }
        p0_transpose_item(W, K, N, nblk, WT, r, F.lane);
    }
#if MOE_FP8
    constexpr int Q_GU = 16 * 32, Q_DN = 16 * 16, Q_PG = PLE_FP8 ? 16 * 16 : 0, Q_OUT = OUT_FP8 ? 16 * 16 : 0, Q_PER_LAYER = NE * (Q_GU + Q_DN) + Q_PG + Q_OUT;
#pragma unroll 1
    for (int it = gw; it < DEPTH * Q_PER_LAYER; it += NGW) {
        const int l = it / Q_PER_LAYER; int r = it % Q_PER_LAYER; const float* W; unsigned char* WQ; int N; float sc;
        if (r < NE * Q_GU) { const int e = r / Q_GU; r %= Q_GU; W = KIN(I_WGU) + ((size_t)l * NE + e) * D * 2048; WQ = WSP(unsigned char, WS_WGU_Q) + ((size_t)l * NE + e) * 2048 * D; N = 2048; sc = 32.0f; }
        else if (r >= NE * (Q_GU + Q_DN) + Q_PG) { r -= NE * (Q_GU + Q_DN) + Q_PG; W = KIN(I_WOUT) + (size_t)l * D * D; WQ = WSP(unsigned char, WS_WOUT_Q) + (size_t)l * D * D; N = D; sc = 64.0f; }
        else if (r >= NE * (Q_GU + Q_DN)) { r -= NE * (Q_GU + Q_DN); W = KIN(I_PGW) + (size_t)l * D * D; WQ = WSP(unsigned char, WS_WPG_Q) + (size_t)l * D * D; N = D; sc = 32.0f; }
        else { if (!MOE2_FP8) continue; r -= NE * Q_GU; const int e = r / Q_DN; r %= Q_DN; W = KIN(I_WDN) + ((size_t)l * NE + e) * D * D; WQ = WSP(unsigned char, WS_WDN_Q) + ((size_t)l * NE + e) * D * D; N = D; sc = 64.0f; }
        const int nblk = N / 64, kb = r / nblk, nb = r % nblk, k0 = 64 * kb, n = 64 * nb + F.lane;
        const float* src = W + (size_t)k0 * N + n; float x[64];
#pragma unroll
        for (int j = 0; j < 64; ++j) x[j] = __builtin_nontemporal_load(src + (size_t)j * N) * sc;
        unsigned char* dst = WQ + (size_t)n * D + k0;
#pragma unroll
        for (int q = 0; q < 4; ++q) { v4u o; o.x = cvt4_fp8(x[16 * q], x[16 * q + 1], x[16 * q + 2], x[16 * q + 3]); o.y = cvt4_fp8(x[16 * q + 4], x[16 * q + 5], x[16 * q + 6], x[16 * q + 7]);
            o.z = cvt4_fp8(x[16 * q + 8], x[16 * q + 9], x[16 * q + 10], x[16 * q + 11]); o.w = cvt4_fp8(x[16 * q + 12], x[16 * q + 13], x[16 * q + 14], x[16 * q + 15]); *(v4u*)(dst + 16 * q) = o; }
    }
#endif
    const size_t gt = (size_t)F.vcu * (NWAVES * 64) + F.tid, NT_ = (size_t)F.G * NWAVES * 64;
    cvt_rows(KIN(I_P), WSP(bf16, WS_PB), (size_t)DEPTH * T * 256 / 8, gt, NT_);
    cvt_rows(KIN(I_X), WSP(bf16, WS_XB), (size_t)T * D / 8, gt, NT_);
    for (size_t i = gt; i < (size_t)DEPTH * LORA_PER_LAYER; i += NT_) { const int l = (int)(i / LORA_PER_LAYER); int r = (int)(i % LORA_PER_LAYER); float v;
        if (r < 8192) { const int ch = r >> 5, j = r & 31; v = KIN(I_RWUP)[(size_t)l * 8192 + j * 256 + ch]; }
        else if (r < 16384) { r -= 8192; const int ch = r >> 5, j = r & 31; v = KIN(I_RAUP)[(size_t)l * 8192 + j * 256 + ch]; }
        else if (r < 32768) { r -= 16384; const int ch = r >> 6, j = r & 63; v = KIN(I_RGUP)[(size_t)l * 16384 + j * 256 + ch]; }
        else { r -= 32768; const int d = r >> 4, j = r & 15; v = KIN(I_GGUP)[(size_t)l * 2048 + j * 128 + d]; }
        WSP(float, WS_LORA)[i] = v; }
#if P6_MFMA
    for (size_t i = gt; i < (size_t)DEPTH * 32768; i += NT_) { const int l = (int)(i >> 15), r = (int)(i & 32767), c = r >> 8, e = (r >> 3) & 31, k = 8 * c + (r & 7);
        const float v = KIN(I_RTW)[(size_t)l * D * NE + (size_t)k * NE + e]; const unsigned h = cvt_pk_bf16(v, 0.f) & 0xffffu; const unsigned lo = cvt_pk_bf16(v - __uint_as_float(h << 16), 0.f) & 0xffffu;
        unsigned short* dst = WSP(unsigned short, WS_RWT) + (size_t)l * 65536 + r; dst[0] = (unsigned short)h; dst[32768] = (unsigned short)lo; }
#else
    for (size_t i = gt; i < (size_t)DEPTH * NE * D; i += NT_) { const int l = (int)(i / (NE * D)), r = (int)(i % (NE * D)), e = r / D, k = r % D; WSP(float, WS_RWT)[i] = KIN(I_RTW)[(size_t)l * D * NE + (size_t)k * NE + e]; }
#endif
}

#if P6_MFMA
template <bool DRY> __device__ __forceinline__ void p6_ln1_router(Frame& F, const Args& A, int layer) {
    const bf16* y1 = WSP(bf16, WS_Y1); bf16* x1b = WSP(bf16, WS_X1B);
    const float* gam = KIN(I_LN1G) + layer * D; const float* bet = KIN(I_LN1B) + layer * D;
    const unsigned char* rwq = WSP(unsigned char, WS_RWT) + (size_t)layer * 131072; const float* rb = KIN(I_RTB) + layer * NE;
    int* sdest = WSP(int, WS_SDEST); float* sgate = WSP(float, WS_SGATE);
    unsigned* cnt = (unsigned*)(F.ctl + CW_CNT + layer * NE * 16);
    LAS unsigned char* WL = F.lds;
    LAS float* LG = (LAS float*)(F.lds + 131072);
    LAS float* TOPV = (LAS float*)(F.lds + 139264) + F.wave * 64;
    LAS int* TOPE = (LAS int*)(F.lds + 139264 + 2048) + F.wave * 64;
    LAS float* STAT = (LAS float*)(F.lds + 143360);
    volatile LAS unsigned* lcnt = F.MISC + MW_LCNT; volatile LAS unsigned* lbase = F.MISC + MW_LBASE;
    { const int l0 = F.lane;
#pragma unroll
      for (int i = 0; i < 16; ++i) { const int off = (F.wave * 16 + i) * 1024; __builtin_amdgcn_global_load_lds((const unsigned*)(rwq + off + l0 * 16), (LAS unsigned*)(WL + off), 16, 0, 0); } }
    const int lane = F.lane, m = lane & 15, g = lane >> 4, rq = F.wave & 3, kh = F.wave >> 2;
    for (int blk = F.vcu; blk < T / 64; blk += F.G) {
        if (F.tid < 32) lcnt[F.tid] = 0u;
        const int row = blk * 64 + rq * 16 + m; const size_t ro = (size_t)row * D + 512 * kh + 8 * g;
        v4u yw[16];
#pragma unroll
        for (int kk = 0; kk < 16; ++kk) yw[kk] = *(const v4u*)(y1 + ro + 32 * kk);
        float s = 0.f, s2 = 0.f;
#pragma unroll
        for (int kk = 0; kk < 16; ++kk) { f32x4 a, b; pg8::unpack8(yw[kk], a, b); s += ((a.x + a.y) + (a.z + a.w)) + ((b.x + b.y) + (b.z + b.w));
            s2 += ((a.x * a.x + a.y * a.y) + (a.z * a.z + a.w * a.w)) + ((b.x * b.x + b.y * b.y) + (b.z * b.z + b.w * b.w)); }
        s += __shfl_xor(s, 16); s += __shfl_xor(s, 32); s2 += __shfl_xor(s2, 16); s2 += __shfl_xor(s2, 32);
        if (g == 0) { STAT[(kh * 64 + rq * 16 + m) * 2] = s; STAT[(kh * 64 + rq * 16 + m) * 2 + 1] = s2; }
        asm volatile("s_waitcnt vmcnt(0)" ::: "memory");
        __syncthreads();
        const float st = STAT[(rq * 16 + m) * 2] + STAT[(64 + rq * 16 + m) * 2], st2 = STAT[(rq * 16 + m) * 2 + 1] + STAT[(64 + rq * 16 + m) * 2 + 1];
        const float mean = st * (1.f / D); const float rstd = __builtin_amdgcn_rsqf(fmaxf(st2 * (1.f / D) - mean * mean, 0.f) + LN_EPS);
        f32x4 acc[2] = {(f32x4){0.f, 0.f, 0.f, 0.f}, (f32x4){0.f, 0.f, 0.f, 0.f}}; const float* gp = gam; const float* bp = bet;
#pragma unroll
        for (int kk = 0; kk < 16; ++kk) { const int k0 = 512 * kh + 32 * kk + 8 * g;
            if ((kk & 3) == 0) { gp = launder_uniform(gp); bp = launder_uniform(bp); }
            const f32x4 ga = *(const f32x4*)(gp + k0), gb = *(const f32x4*)(gp + k0 + 4), ba = *(const f32x4*)(bp + k0), bb = *(const f32x4*)(bp + k0 + 4);
            f32x4 a, b; { v4u yk = yw[kk]; asm volatile("" : "+v"(yk)); pg8::unpack8(yk, a, b); }
            a = (a - mean) * rstd * ga + ba; b = (b - mean) * rstd * gb + bb;
            v4u hw; hw.x = cvt_pk_bf16(a.x, a.y); hw.y = cvt_pk_bf16(a.z, a.w); hw.z = cvt_pk_bf16(b.x, b.y); hw.w = cvt_pk_bf16(b.z, b.w);
            *(v4u*)(x1b + (size_t)row * D + k0) = hw;
            if (MOE_FP8) { v2u q; q.x = cvt4_fp8(a.x, a.y, a.z, a.w); q.y = cvt4_fp8(b.x, b.y, b.z, b.w); *(v2u*)(WSP(unsigned char, WS_X1Q) + (size_t)row * D + k0) = q; }
            f32x4 ha, hb_; pg8::unpack8(hw, ha, hb_); a = a - ha; b = b - hb_;
            v4u lw; lw.x = cvt_pk_bf16(a.x, a.y); lw.y = cvt_pk_bf16(a.z, a.w); lw.z = cvt_pk_bf16(b.x, b.y); lw.w = cvt_pk_bf16(b.z, b.w);
            const bf16x8 xh = __builtin_bit_cast(bf16x8, hw), xl = __builtin_bit_cast(bf16x8, lw);
            const int c = kh * 64 + kk * 4 + g;
#pragma unroll
            for (int nt = 0; nt < 2; ++nt) { const bf16x8 wh = *(const LAS bf16x8*)(WL + (c * 32 + nt * 16 + m) * 16), wl = *(const LAS bf16x8*)(WL + 65536 + (c * 32 + nt * 16 + m) * 16);
                acc[nt] = __builtin_amdgcn_mfma_f32_16x16x32_bf16(wh, xh, acc[nt], 0, 0, 0);
                acc[nt] = __builtin_amdgcn_mfma_f32_16x16x32_bf16(wl, xh, acc[nt], 0, 0, 0);
                acc[nt] = __builtin_amdgcn_mfma_f32_16x16x32_bf16(wh, xl, acc[nt], 0, 0, 0); } }
        if (kh == 1) {
#pragma unroll
            for (int nt = 0; nt < 2; ++nt) *(LAS f32x4*)(LG + (rq * 16 + m) * 32 + nt * 16 + 4 * g) = acc[nt]; }
        __syncthreads();
        if (kh == 0) {
#pragma unroll
            for (int nt = 0; nt < 2; ++nt) { const f32x4 o = *(const LAS f32x4*)(LG + (rq * 16 + m) * 32 + nt * 16 + 4 * g); const f32x4 rbv = *(const f32x4*)(rb + nt * 16 + 4 * g);
                *(LAS f32x4*)(LG + (rq * 16 + m) * 32 + nt * 16 + 4 * g) = o + acc[nt] + rbv; } }
        __syncthreads();
        int lane2 = lane; asm volatile("" : "+v"(lane2)); const int sub = lane2 & 15;
#pragma unroll 1
        for (int rg = 0; rg < 2; ++rg) {
            float lg[32];
            { const LAS float* lr = LG + (F.wave * 8 + rg * 4 + (lane2 >> 4)) * 32;
#pragma unroll
              for (int q = 0; q < 8; ++q) { const f32x4 t4 = *(const LAS f32x4*)(lr + 4 * q); lg[4 * q] = t4.x; lg[4 * q + 1] = t4.y; lg[4 * q + 2] = t4.z; lg[4 * q + 3] = t4.w; } }
            float la = 0.f, lb_ = 0.f;
#pragma unroll
            for (int e = 0; e < 32; ++e) { if (e == 2 * sub) la = lg[e]; if (e == 2 * sub + 1) lb_ = lg[e]; }
            int ra = 0, rbk = 0;
#pragma unroll
            for (int e = 0; e < 32; ++e) { ra += (lg[e] > la || (lg[e] == la && e < 2 * sub)) ? 1 : 0; rbk += (lg[e] > lb_ || (lg[e] == lb_ && e < 2 * sub + 1)) ? 1 : 0; }
            const int rowl = rg * 4 + (lane2 >> 4);
            if (ra < 4) { TOPV[rowl * 4 + ra] = la; TOPE[rowl * 4 + ra] = 2 * sub; }
            if (rbk < 4) { TOPV[rowl * 4 + rbk] = lb_; TOPE[rowl * 4 + rbk] = 2 * sub + 1; }
        }
        LDS_WAIT();
        int my_e = 0; float my_g = 0.f; unsigned my_r = 0u;
        if (lane2 < 32) { const int ri = lane2 >> 2, k = lane2 & 3; const f32x4 tv = *(const LAS f32x4*)(TOPV + ri * 4);
            const float e1 = __expf(tv.y - tv.x), e2 = __expf(tv.z - tv.x), e3 = __expf(tv.w - tv.x); const float inv = __builtin_amdgcn_rcpf(1.0f + e1 + e2 + e3);
            my_e = TOPE[ri * 4 + k]; my_g = (k == 0 ? 1.0f : k == 1 ? e1 : k == 2 ? e2 : e3) * inv;
            my_r = DRY ? 0u : atomicAdd((unsigned*)&lcnt[my_e], 1u); }
        __syncthreads();
        if (!DRY && F.wave == 0 && lane2 < 32) { const unsigned n = lcnt[lane2]; lbase[lane2] = n ? __hip_atomic_fetch_add(cnt + lane2 * 16, n, RLX_AGENT) : 0u; }
        __syncthreads();
        if (!DRY && lane2 < 32) { const int rw = blk * 64 + F.wave * 8 + (lane2 >> 2); const unsigned slot = (unsigned)my_e * ECAP + lbase[my_e] + my_r;
            sdest[slot] = rw * 4 + (lane2 & 3); sgate[slot] = my_g; }
        __syncthreads();
    }
}
#else
template <bool DRY> __device__ __forceinline__ void p6_ln1_router(Frame& F, const Args& A, int layer) {
    const bf16* y1 = WSP(bf16, WS_Y1); bf16* x1b = WSP(bf16, WS_X1B);
    const float* g = KIN(I_LN1G) + layer * D; const float* bb = KIN(I_LN1B) + layer * D;
    const float* rwt = WSP(float, WS_RWT) + (size_t)layer * NE * D; const float* rb = KIN(I_RTB) + layer * NE;
    int* sdest = WSP(int, WS_SDEST); float* sgate = WSP(float, WS_SGATE);
    unsigned* cnt = (unsigned*)(F.ctl + CW_CNT + layer * NE * 16);
    LAS float* RWT = (LAS float*)F.lds;
    LAS float* TOPV = (LAS float*)(F.lds + 131072) + F.wave * 64;
    LAS int* TOPE = (LAS int*)(F.lds + 131072 + 2048) + F.wave * 64;
    volatile LAS unsigned* lcnt = F.MISC + MW_LCNT; volatile LAS unsigned* lbase = F.MISC + MW_LBASE;
    for (int i = F.tid; i < NE * D / 4; i += NWAVES * 64) ((LAS f32x4*)RWT)[i] = ((const f32x4*)rwt)[i];
    const int lane = F.lane, sub = lane & 15;
    for (int blk = F.vcu; blk < T / 64; blk += F.G) {
        if (F.tid < 32) lcnt[F.tid] = 0u;
        __syncthreads();
#pragma unroll 1
        for (int rg = 0; rg < 2; ++rg) {
            f32x4 v[4][4];
            { int lo_ = lane; asm volatile("" : "+v"(lo_));
              const f32x4 gv[4] = { *(const f32x4*)(g + 4 * lo_), *(const f32x4*)(g + 256 + 4 * lo_), *(const f32x4*)(g + 512 + 4 * lo_), *(const f32x4*)(g + 768 + 4 * lo_) };
              const f32x4 bv[4] = { *(const f32x4*)(bb + 4 * lo_), *(const f32x4*)(bb + 256 + 4 * lo_), *(const f32x4*)(bb + 512 + 4 * lo_), *(const f32x4*)(bb + 768 + 4 * lo_) };
#pragma unroll
              for (int r = 0; r < 4; ++r) { const int row = blk * 64 + F.wave * 8 + rg * 4 + r; const bf16* yr = y1 + (size_t)row * D; float s = 0.f;
#pragma unroll
                  for (int j = 0; j < 4; ++j) { const v2u w = *(const v2u*)(yr + 256 * j + 4 * lane); v[r][j] = (f32x4){__uint_as_float(w.x << 16), __uint_as_float(w.x & 0xffff0000u), __uint_as_float(w.y << 16), __uint_as_float(w.y & 0xffff0000u)}; s += (v[r][j].x + v[r][j].y) + (v[r][j].z + v[r][j].w); }
                  const float mean = wave_sum(s) * (1.f / D); float s2 = 0.f;
#pragma unroll
                  for (int j = 0; j < 4; ++j) { v[r][j] = v[r][j] - mean; s2 += (v[r][j].x * v[r][j].x + v[r][j].y * v[r][j].y) + (v[r][j].z * v[r][j].z + v[r][j].w * v[r][j].w); }
                  const float rstd = __builtin_amdgcn_rsqf(wave_sum(s2) * (1.f / D) + LN_EPS);
#pragma unroll
                  for (int j = 0; j < 4; ++j) { v[r][j] = v[r][j] * rstd * gv[j] + bv[j];
                      v2u o; o.x = cvt_pk_bf16(v[r][j].x, v[r][j].y); o.y = cvt_pk_bf16(v[r][j].z, v[r][j].w); *(v2u*)(x1b + (size_t)row * D + 256 * j + 4 * lane) = o;
                      if (MOE_FP8) *(unsigned*)(WSP(unsigned char, WS_X1Q) + (size_t)row * D + 256 * j + 4 * lane) = cvt4_fp8(v[r][j].x, v[r][j].y, v[r][j].z, v[r][j].w); } } }
            float lg[32];
#pragma unroll
            for (int e = 0; e < 32; ++e) { f32x2 p2[4] = {(f32x2){0.f, 0.f}, (f32x2){0.f, 0.f}, (f32x2){0.f, 0.f}, (f32x2){0.f, 0.f}};
#pragma unroll
                for (int j = 0; j < 4; ++j) { const f32x4 w = *(const LAS f32x4*)(RWT + e * D + 256 * j + 4 * lane);
#pragma unroll
                    for (int r = 0; r < 4; ++r) { p2[r] = v[r][j].xy * w.xy + p2[r]; p2[r] = v[r][j].zw * w.zw + p2[r]; } }
                float p[4] = {p2[0].x + p2[0].y, p2[1].x + p2[1].y, p2[2].x + p2[2].y, p2[3].x + p2[3].y};
                { const bool hi = (lane & 32) != 0; const float k0 = hi ? p[2] : p[0], s0 = hi ? p[0] : p[2], k1 = hi ? p[3] : p[1], s1 = hi ? p[1] : p[3]; p[0] = k0 + __shfl_xor(s0, 32); p[1] = k1 + __shfl_xor(s1, 32); }
                { const bool hi = (lane & 16) != 0; const float k0 = hi ? p[1] : p[0], s0 = hi ? p[0] : p[1]; p[0] = k0 + __shfl_xor(s0, 16); }
                float t = p[0]; t += __shfl_xor(t, 8); t += __shfl_xor(t, 4); t += __shfl_xor(t, 2); t += __shfl_xor(t, 1);
                lg[e] = t + rb[e]; }
            float la = 0.f, lb_ = 0.f;
#pragma unroll
            for (int e = 0; e < 32; ++e) { if (e == 2 * sub) la = lg[e]; if (e == 2 * sub + 1) lb_ = lg[e]; }
            int ra = 0, rbk = 0;
#pragma unroll
            for (int e = 0; e < 32; ++e) { ra += (lg[e] > la || (lg[e] == la && e < 2 * sub)) ? 1 : 0; rbk += (lg[e] > lb_ || (lg[e] == lb_ && e < 2 * sub + 1)) ? 1 : 0; }
            const int rowl = rg * 4 + (lane >> 4);
            if (ra < 4) { TOPV[rowl * 4 + ra] = la; TOPE[rowl * 4 + ra] = 2 * sub; }
            if (rbk < 4) { TOPV[rowl * 4 + rbk] = lb_; TOPE[rowl * 4 + rbk] = 2 * sub + 1; }
        }
        LDS_WAIT();
        int my_e = 0; float my_g = 0.f; unsigned my_r = 0u;
        if (lane < 32) { const int ri = lane >> 2, k = lane & 3; const f32x4 tv = *(const LAS f32x4*)(TOPV + ri * 4);
            const float e1 = __expf(tv.y - tv.x), e2 = __expf(tv.z - tv.x), e3 = __expf(tv.w - tv.x); const float inv = __builtin_amdgcn_rcpf(1.0f + e1 + e2 + e3);
            my_e = TOPE[ri * 4 + k]; my_g = (k == 0 ? 1.0f : k == 1 ? e1 : k == 2 ? e2 : e3) * inv;
            my_r = DRY ? 0u : atomicAdd((unsigned*)&lcnt[my_e], 1u); }
        __syncthreads();
        if (!DRY && F.tid < 32) { const unsigned n = lcnt[F.tid]; lbase[F.tid] = n ? __hip_atomic_fetch_add(cnt + F.tid * 16, n, RLX_AGENT) : 0u; }
        __syncthreads();
        if (!DRY && lane < 32) { const int row = blk * 64 + F.wave * 8 + (lane >> 2); const unsigned slot = (unsigned)my_e * ECAP + lbase[my_e] + my_r;
            sdest[slot] = row * 4 + (lane & 3); sgate[slot] = my_g; }
        __syncthreads();
    }
}
#endif
__device__ __forceinline__ void p9_combine(Frame& F, const Args& A) {
    const bf16* x1b = WSP(bf16, WS_X1B); const bf16* yb = WSP(bf16, WS_YBUF); bf16* hb = WSP(bf16, WS_HB);
    const int gw = F.vcu * NWAVES + F.wave, NGW = F.G * NWAVES, lane = F.lane;
    for (int row = gw; row < T; row += NGW) {
        v4u y[4][2], xw[2];
#pragma unroll
        for (int j = 0; j < 2; ++j) {
#pragma unroll
            for (int k = 0; k < 4; ++k) y[k][j] = *(const v4u*)(yb + ((size_t)row * 4 + k) * D + 512 * j + 8 * lane);
            xw[j] = *(const v4u*)(x1b + (size_t)row * D + 512 * j + 8 * lane); }
#pragma unroll
        for (int j = 0; j < 2; ++j) { f32x4 v0, v1; pg8::unpack8(xw[j], v0, v1); v0 = v0 * DN_ALPHA; v1 = v1 * DN_ALPHA;
#pragma unroll
            for (int k = 0; k < 4; ++k) { f32x4 a, b; pg8::unpack8(y[k][j], a, b); v0 = v0 + a; v1 = v1 + b; }
            v4u wv; wv.x = cvt_pk_bf16(v0.x, v0.y); wv.y = cvt_pk_bf16(v0.z, v0.w); wv.z = cvt_pk_bf16(v1.x, v1.y); wv.w = cvt_pk_bf16(v1.z, v1.w); *(v4u*)(hb + (size_t)row * D + 512 * j + 8 * lane) = wv;
            if (PLE_FP8) { v2u q; q.x = cvt4_fp8(v0.x, v0.y, v0.z, v0.w); q.y = cvt4_fp8(v1.x, v1.y, v1.z, v1.w); *(v2u*)(WSP(unsigned char, WS_HQ) + (size_t)row * D + 512 * j + 8 * lane) = q; } }
    }
}
__device__ __forceinline__ void p11_ln2(Frame& F, const Args& A, int layer) {
    const bf16* h2 = WSP(bf16, WS_H2); bf16* xb = WSP(bf16, WS_XB);
    const float* g = KIN(I_LN2G) + layer * D; const float* bb = KIN(I_LN2B) + layer * D;
    const int gw = F.vcu * NWAVES + F.wave, NGW = F.G * NWAVES, lane = F.lane;
    for (int row = gw; row < T; row += NGW) {
        const bf16* yr = h2 + (size_t)row * D; f32x4 v[4]; float s = 0.f;
#pragma unroll
        for (int j = 0; j < 4; ++j) { const v2u w = *(const v2u*)(yr + 256 * j + 4 * lane); v[j] = (f32x4){__uint_as_float(w.x << 16), __uint_as_float(w.x & 0xffff0000u), __uint_as_float(w.y << 16), __uint_as_float(w.y & 0xffff0000u)}; s += (v[j].x + v[j].y) + (v[j].z + v[j].w); }
        const float mean = wave_sum(s) * (1.f / D); float s2 = 0.f;
#pragma unroll
        for (int j = 0; j < 4; ++j) { v[j] = v[j] - mean; s2 += (v[j].x * v[j].x + v[j].y * v[j].y) + (v[j].z * v[j].z + v[j].w * v[j].w); }
        const float rstd = __builtin_amdgcn_rsqf(wave_sum(s2) * (1.f / D) + LN_EPS);
#pragma unroll
        for (int j = 0; j < 4; ++j) { const f32x4 gv = *(const f32x4*)(g + 256 * j + 4 * lane), bv = *(const f32x4*)(bb + 256 * j + 4 * lane);
            const f32x4 o = v[j] * rstd * gv + bv; const size_t off = (size_t)row * D + 256 * j + 4 * lane;
            if (layer == DEPTH - 1) *(f32x4*)(F.out + off) = o; v2u w; w.x = cvt_pk_bf16(o.x, o.y); w.y = cvt_pk_bf16(o.z, o.w); *(v2u*)(xb + off) = w; }
    }
}
__device__ __forceinline__ void moe_build_pfx(Frame& F, const Args& A, int layer, int NT) {
    volatile LAS unsigned* pfx = F.MISC + MW_PFX;
    __syncthreads();
    if (F.tid < 64) {
        const int e = F.tid & 31;
        const unsigned c = __hip_atomic_load(F.ctl + CW_CNT + (layer * NE + e) * 16, RLX_AGENT);
        const unsigned un = ((c + 255u) >> 8) * (unsigned)NT; unsigned inc = un;
#pragma unroll
        for (int o = 1; o < 32; o <<= 1) { const unsigned t = (unsigned)my_shfl_up((int)inc, o); if (e >= o) inc += t; }
        if (F.tid < 32) { pfx[e] = inc - un; pfx[40 + e] = c; if (e == 31) pfx[32] = inc; }
    }
    __syncthreads();
}
#define UU(t, col) bf2f(u[(size_t)(t) * NUP + (col)])
#define UU4(t, col) ldu4(u + (size_t)(t) * NUP + (col))
__device__ __forceinline__ f32x4 ldu4(const bf16* p) { const v2u w = *(const v2u*)p; return (f32x4){__uint_as_float(w.x << 16), __uint_as_float(w.x & 0xffff0000u), __uint_as_float(w.y << 16), __uint_as_float(w.y & 0xffff0000u)}; }
__device__ __forceinline__ f32x4 ldb4(const bf16* p) { const v2u w = *(const v2u*)p; return (f32x4){__uint_as_float(w.x << 16), __uint_as_float(w.x & 0xffff0000u), __uint_as_float(w.y << 16), __uint_as_float(w.y & 0xffff0000u)}; }
__device__ __forceinline__ void stb4(bf16* p, f32x4 v) { v2u o; o.x = cvt_pk_bf16(v.x, v.y); o.y = cvt_pk_bf16(v.z, v.w); *(v2u*)p = o; }
__device__ __forceinline__ void lds_st_bf16(LAS unsigned char* p, float v) { *(LAS unsigned short*)p = (unsigned short)(cvt_pk_bf16(v, 0.f) & 0xffffu); }
__device__ __forceinline__ void lds_st_bf16x4(LAS unsigned char* p, float a, float b, float c, float d) { v2u o; o.x = cvt_pk_bf16(a, b); o.y = cvt_pk_bf16(c, d); *(LAS v2u*)p = o; }

#if OUT_FP8
#define MIX_ST4(mix, idx, a, b, c, d) (*(unsigned*)((unsigned char*)(mix) + (idx)) = cvt4_fp8(a, b, c, d))
#else
#define MIX_ST4(mix, idx, a, b, c, d) do { v2u o_; o_.x = cvt_pk_bf16(a, b); o_.y = cvt_pk_bf16(c, d); *(v2u*)((mix) + (idx)) = o_; } while (0)
#endif
__device__ __forceinline__ void ssd_stage1(Frame& F, const Args& A, int layer, int b, int c) {
    const bf16* u = WSP(bf16, WS_U);
    LAS unsigned char* L = F.lds;
    LAS float* DT = (LAS float*)L; LAS float* AC = DT + 256;
    LAS unsigned char* BMT = L + 2048; LAS unsigned char* XCDT = BMT + 128 * 144;
    const int t0 = b * SEQ + c * 64, tid = F.tid, lane = F.lane, wave = F.wave;
    if (wave < 4) {
        const int hh = wave;
        const float dt = softplusf_(UU(t0 + lane, U_SSD_DT + hh) + KIN(I_SDTB)[layer * 4 + hh]);
        const float adt = -dt * __expf(KIN(I_SALOG)[layer * 4 + hh]);
        const float ac = wave_scan_add(adt, lane);
        DT[hh * 64 + lane] = dt; AC[hh * 64 + lane] = ac;
        if (lane == 63) WSP(float, WS_SSD_DEC)[(b * 4 + hh) * NCH + c] = __expf(ac);
    }
    __syncthreads();
    if (tid < 384) {
        const int cc = tid; const float* cw = KIN(I_SCW) + (size_t)layer * 2048 + cc; const float w0 = cw[0], w1 = cw[512], w2 = cw[1024], w3 = cw[1536], cb = KIN(I_SCB)[layer * 512 + cc];
        const bf16* up = u + (size_t)t0 * NUP + U_SSD_X + cc;
        float win0 = 0.f, win1 = 0.f, win2 = 0.f;
        if (c > 0) { win0 = bf2f(up[-3 * NUP]); win1 = bf2f(up[-2 * NUP]); win2 = bf2f(up[-1 * NUP]); }
        const int hh = (cc >> 6) & 3; const bool isx = cc < 256;
        LAS unsigned char* dst = isx ? XCDT + cc * 144 : BMT + (cc - 256) * 144;
        const float aclast = AC[hh * 64 + 63];
#pragma unroll 1
        for (int l0 = 0; l0 < 64; l0 += 32) {
            float xv[32];
#pragma unroll
            for (int j = 0; j < 32; ++j) xv[j] = bf2f(up[(l0 + j) * NUP]);
#pragma unroll
            for (int j8 = 0; j8 < 4; ++j8) { float o[8];
#pragma unroll
                for (int j = 0; j < 8; ++j) { const int l = l0 + j8 * 8 + j; const float x = xv[j8 * 8 + j]; const float y = cb + w0 * win0 + w1 * win1 + w2 * win2 + w3 * x; win0 = win1; win1 = win2; win2 = x;
                    float s = siluf_(y); if (isx) s *= DT[hh * 64 + l] * __expf(aclast - AC[hh * 64 + l]); o[j] = s; }
                *(LAS v4u*)(dst + (l0 + j8 * 8) * 2) = pack8(o); }
        }
    }
    __syncthreads();
    { const int fr = lane & 15, fq = lane >> 4; bf16* st = WSP(bf16, WS_SSD_ST);
#pragma unroll 1
      for (int i = 0; i < 2; ++i) { const int row0 = (2 * wave + i) * 16; const int hh = row0 >> 6, p = (row0 & 63) + fr;
          bf16* dstp = st + (((size_t)(b * 4 + hh) * NCH + c) * 64 + p) * 128;
#pragma unroll 1
          for (int ntl = 0; ntl < 8; ++ntl) { f32x4 acc = {0.f, 0.f, 0.f, 0.f}; acc = mm16(XCDT + row0 * 144, 144, BMT + ntl * 16 * 144, 144, 64, acc, fr, fq);
              stb4(dstp + ntl * 16 + 4 * fq, acc); } } }
    __syncthreads();
}
__device__ __forceinline__ void ssd_stage3(Frame& F, const Args& A, int layer, int b, int c) {
    const bf16* u = WSP(bf16, WS_U);
    LAS unsigned char* L = F.lds;
    LAS float* DT = (LAS float*)L; LAS float* AC = DT + 256;
    LAS unsigned char* CM = L + 2048; LAS unsigned char* BM = CM + 64 * 272; LAS unsigned char* XCT = BM + 64 * 272; LAS unsigned char* MM = XCT + 256 * 144;
    LAS unsigned char* YG = XCT;
    const int t0 = b * SEQ + c * 64, tid = F.tid, lane = F.lane, wave = F.wave, fr = lane & 15, fq = lane >> 4;
    if (wave < 4) {
        const int hh = wave;
        const float dt = softplusf_(UU(t0 + lane, U_SSD_DT + hh) + KIN(I_SDTB)[layer * 4 + hh]);
        const float adt = -dt * __expf(KIN(I_SALOG)[layer * 4 + hh]);
        DT[hh * 64 + lane] = dt; AC[hh * 64 + lane] = wave_scan_add(adt, lane);
    }
    __syncthreads();
    {
        const int cc = tid; const float* cw = KIN(I_SCW) + (size_t)layer * 2048 + cc; const float w0 = cw[0], w1 = cw[512], w2 = cw[1024], w3 = cw[1536], cb = KIN(I_SCB)[layer * 512 + cc];
        const bf16* up = u + (size_t)t0 * NUP + U_SSD_X + cc;
        float win0 = 0.f, win1 = 0.f, win2 = 0.f;
        if (c > 0) { win0 = bf2f(up[-3 * NUP]); win1 = bf2f(up[-2 * NUP]); win2 = bf2f(up[-1 * NUP]); }
        const int hh = (cc >> 6) & 3;
#pragma unroll 1
        for (int l0 = 0; l0 < 64; l0 += 32) {
            float xv[32];
#pragma unroll
            for (int j = 0; j < 32; ++j) xv[j] = bf2f(up[(l0 + j) * NUP]);
#pragma unroll
            for (int j8 = 0; j8 < 4; ++j8) { float o[8];
#pragma unroll
                for (int j = 0; j < 8; ++j) { const int l = l0 + j8 * 8 + j; const float x = xv[j8 * 8 + j]; const float y = cb + w0 * win0 + w1 * win1 + w2 * win2 + w3 * x; win0 = win1; win1 = win2; win2 = x;
                    float s = siluf_(y); if (cc < 256) s *= DT[hh * 64 + l]; o[j] = s; }
                if (cc < 256) *(LAS v4u*)(XCT + cc * 144 + (l0 + j8 * 8) * 2) = pack8(o);
                else { LAS unsigned char* d2 = (cc < 384 ? BM + (cc - 256) * 2 : CM + (cc - 384) * 2) + (l0 + j8 * 8) * 272;
#pragma unroll
                    for (int j = 0; j < 8; ++j) lds_st_bf16(d2 + j * 272, o[j]); } }
        }
    }
    __syncthreads();
#pragma unroll 1
    for (int i = 0; i < 2; ++i) { const int idx = 2 * wave + i, lt = idx >> 2, st = idx & 3;
        f32x4 acc = {0.f, 0.f, 0.f, 0.f}; acc = mm16(CM + lt * 16 * 272, 272, BM + st * 16 * 272, 272, 128, acc, fr, fq);
        const int l = lt * 16 + fr, s0 = st * 16 + 4 * fq;
#pragma unroll
        for (int hh = 0; hh < 4; ++hh) { const float al = AC[hh * 64 + l], dl = KIN(I_SD)[layer * 4 + hh] / DT[hh * 64 + l]; float o[4];
#pragma unroll
            for (int j = 0; j < 4; ++j) { const int s = s0 + j; float m = (l >= s) ? acc[j] * __expf(al - AC[hh * 64 + s]) : 0.f; if (l == s) m += dl; o[j] = m; }
            lds_st_bf16x4(MM + hh * 9216 + l * 144 + s0 * 2, o[0], o[1], o[2], o[3]); } }
    __syncthreads();
    f32x4 yv[2][4];
    { const int hh = wave >> 1; const bf16* prev = WSP(bf16, WS_SSD_ST) + ((size_t)(b * 4 + hh) * NCH + c) * 8192;
      bf16x8 pf[4][4];
#pragma unroll
      for (int pt = 0; pt < 4; ++pt)
#pragma unroll
          for (int ks = 0; ks < 4; ++ks) pf[pt][ks] = *(const bf16x8*)(prev + (size_t)(pt * 16 + fr) * 128 + ks * 32 + fq * 8);
#pragma unroll
      for (int i = 0; i < 2; ++i) { const int lt = 2 * (wave & 1) + i, l = lt * 16 + fr; const float ea = __expf(AC[hh * 64 + l]);
#pragma unroll
          for (int pt = 0; pt < 4; ++pt) { f32x4 ad = {0.f, 0.f, 0.f, 0.f}, ao = {0.f, 0.f, 0.f, 0.f};
              ad = mm16(MM + hh * 9216 + lt * 16 * 144, 144, XCT + (hh * 64 + pt * 16) * 144, 144, 64, ad, fr, fq);
              ao = mm16_rB<4>(CM + lt * 16 * 272, 272, pf[pt], ao, fr, fq);
              const f32x4 z = UU4(t0 + l, U_SSD_Z + hh * 64 + pt * 16 + 4 * fq);
              f32x4 y = ad + ao * ea; y.x *= siluf_(z.x); y.y *= siluf_(z.y); y.z *= siluf_(z.z); y.w *= siluf_(z.w); yv[i][pt] = y; } } }
    __syncthreads();
    { const int hh = wave >> 1;
#pragma unroll
      for (int i = 0; i < 2; ++i) { const int l = (2 * (wave & 1) + i) * 16 + fr;
#pragma unroll
          for (int pt = 0; pt < 4; ++pt) *(LAS f32x4*)(YG + l * 1040 + (hh * 64 + pt * 16 + 4 * fq) * 4) = yv[i][pt]; } }
    __syncthreads();
    { const f32x4 g = *(const f32x4*)(KIN(I_SNG) + layer * 256 + 4 * lane); bf16* mix = WSP(bf16, WS_MIX);
#pragma unroll 1
      for (int i = 0; i < 8; ++i) { const int l = wave * 8 + i; const f32x4 y = *(const LAS f32x4*)(YG + l * 1040 + lane * 16);
          const float ss = wave_sum((y.x * y.x + y.y * y.y) + (y.z * y.z + y.w * y.w)); const float r = __builtin_amdgcn_rsqf(ss * (1.f / 256.f) + NORM_EPS);
          MIX_ST4(mix, (size_t)(t0 + l) * D + 4 * lane, y.x * r * g.x, y.y * r * g.y, y.z * r * g.z, y.w * r * g.w); } }
    __syncthreads();
}

__device__ __forceinline__ void gla_bcum_all(Frame& F, const Args& A, int layer, const LAS float* GD, LAS float* BC) {
    const int d = F.tid & 127, lq = F.tid >> 7;
    float gup[16];
    { const f32x4* gp4 = (const f32x4*)(WSP(float, WS_LORA) + (size_t)layer * LORA_PER_LAYER + 32768 + d * 16);
#pragma unroll
      for (int i = 0; i < 4; ++i) { const f32x4 a = gp4[i]; gup[4 * i] = a.x; gup[4 * i + 1] = a.y; gup[4 * i + 2] = a.z; gup[4 * i + 3] = a.w; } }
    const float gb = KIN(I_GGB)[layer * 128 + d];
#pragma unroll 4
    for (int li = 0; li < 16; ++li) { const int l = lq * 16 + li; float x = gb;
#pragma unroll
        for (int i = 0; i < 4; ++i) { const f32x4 g4 = *(const LAS f32x4*)(GD + l * 16 + 4 * i); x += (g4.x * gup[4 * i] + g4.y * gup[4 * i + 1]) + (g4.z * gup[4 * i + 2] + g4.w * gup[4 * i + 3]); }
        BC[l * 128 + d] = logsigmoidf_(x) * 0.0625f; }
    __syncthreads();
    if (F.tid < 128) { float run = 0.f;
#pragma unroll 1
        for (int l0 = 0; l0 < 64; l0 += 16) { float v[16];
#pragma unroll
            for (int j = 0; j < 16; ++j) v[j] = BC[(l0 + j) * 128 + d];
#pragma unroll
            for (int j = 0; j < 16; ++j) { run += v[j]; BC[(l0 + j) * 128 + d] = run; } } }
}
__device__ __forceinline__ void gla_stage1(Frame& F, const Args& A, int layer, int b, int c) {
    const bf16* u = WSP(bf16, WS_U);
    LAS unsigned char* L = F.lds;
    LAS float* GD = (LAS float*)L; LAS float* BC = (LAS float*)(L + 4096);
    LAS unsigned char* KDT = L + 36864; LAS unsigned char* VT = KDT + 128 * 144;
    const int t0 = b * SEQ + c * 64, tid = F.tid, lane = F.lane, wave = F.wave, fr = lane & 15, fq = lane >> 4;
    if (tid < 256) { const int l = tid >> 2, q4 = tid & 3; *(LAS f32x4*)(GD + l * 16 + q4 * 4) = UU4(t0 + l, U_GL_G + 4 * q4); }
    __syncthreads();
    gla_bcum_all(F, A, layer, GD, BC);
    if (tid < 128) {
        const int d = tid; const float blast = BC[63 * 128 + d];
        WSP(float, WS_GLA_DEC)[(size_t)(b * NCH + c) * 128 + d] = __expf(blast);
        const bf16* up = u + (size_t)t0 * NUP + U_GL_K + d;
#pragma unroll 1
        for (int l0 = 0; l0 < 64; l0 += 32) { float xv[32];
#pragma unroll
            for (int j = 0; j < 32; ++j) xv[j] = bf2f(up[(l0 + j) * NUP]);
#pragma unroll
            for (int j8 = 0; j8 < 4; ++j8) { float o[8];
#pragma unroll
                for (int j = 0; j < 8; ++j) { const int l = l0 + j8 * 8 + j; o[j] = xv[j8 * 8 + j] * __expf(blast - BC[l * 128 + d]); }
                *(LAS v4u*)(KDT + d * 144 + (l0 + j8 * 8) * 2) = pack8(o); } }
    } else if (tid < 384) {
        const int vch = tid - 128; const bf16* up = u + (size_t)t0 * NUP + U_GL_V + vch;
#pragma unroll 1
        for (int l0 = 0; l0 < 64; l0 += 32) { float xv[32];
#pragma unroll
            for (int j = 0; j < 32; ++j) xv[j] = bf2f(up[(l0 + j) * NUP]);
#pragma unroll
            for (int j8 = 0; j8 < 4; ++j8) { float o[8];
#pragma unroll
                for (int j = 0; j < 8; ++j) o[j] = xv[j8 * 8 + j];
                *(LAS v4u*)(VT + vch * 144 + (l0 + j8 * 8) * 2) = pack8(o); } }
    }
    __syncthreads();
    { bf16* st = WSP(bf16, WS_GLA_ST);
#pragma unroll 1
      for (int i = 0; i < 4; ++i) { const int idx = 4 * wave + i, hh = idx >> 3, dtl = (idx >> 2) & 1, vt = idx & 3;
          f32x4 acc = {0.f, 0.f, 0.f, 0.f}; acc = mm16(KDT + (hh * 32 + dtl * 16) * 144, 144, VT + (hh * 64 + vt * 16) * 144, 144, 64, acc, fr, fq);
          stb4(st + (((size_t)(b * 4 + hh) * NCH + c) * 32 + dtl * 16 + fr) * 64 + vt * 16 + 4 * fq, acc); } }
    __syncthreads();
}
__device__ __forceinline__ void gla_stage3(Frame& F, const Args& A, int layer, int b, int c) {
    const bf16* u = WSP(bf16, WS_U);
    LAS unsigned char* L = F.lds;
    LAS float* GD = (LAS float*)L; LAS float* BC = (LAS float*)(L + 4096); LAS unsigned char* ATT = L + 4096;
    LAS unsigned char* QD = L + 40960; LAS unsigned char* KI = QD + 64 * 272; LAS unsigned char* VT = KI + 64 * 272; LAS unsigned char* PVT = VT + 256 * 144;
    const int t0 = b * SEQ + c * 64, tid = F.tid, lane = F.lane, wave = F.wave, fr = lane & 15, fq = lane >> 4;
    if (tid < 256) { const int l = tid >> 2, q4 = tid & 3; *(LAS f32x4*)(GD + l * 16 + q4 * 4) = UU4(t0 + l, U_GL_G + 4 * q4); }
    __syncthreads();
    gla_bcum_all(F, A, layer, GD, BC);
    if (tid < 128) {
        const int d = tid;
        const bf16* uq = u + (size_t)t0 * NUP + U_GL_Q + d; const bf16* uk = u + (size_t)t0 * NUP + U_GL_K + d;
#pragma unroll 1
        for (int l0 = 0; l0 < 64; l0 += 16) { float qv[16], kv[16];
#pragma unroll
            for (int j = 0; j < 16; ++j) { qv[j] = bf2f(uq[(l0 + j) * NUP]); kv[j] = bf2f(uk[(l0 + j) * NUP]); }
#pragma unroll
            for (int j = 0; j < 16; ++j) { const int l = l0 + j; const float bc = BC[l * 128 + d];
                lds_st_bf16(QD + l * 272 + d * 2, qv[j] * 0.17677669529663687f * __expf(bc)); lds_st_bf16(KI + l * 272 + d * 2, kv[j] * __expf(-bc)); } }
    } else if (tid < 384) {
        const int vch = tid - 128; const bf16* up = u + (size_t)t0 * NUP + U_GL_V + vch;
#pragma unroll 1
        for (int l0 = 0; l0 < 64; l0 += 32) { float xv[32];
#pragma unroll
            for (int j = 0; j < 32; ++j) xv[j] = bf2f(up[(l0 + j) * NUP]);
#pragma unroll
            for (int j8 = 0; j8 < 4; ++j8) { float o[8];
#pragma unroll
                for (int j = 0; j < 8; ++j) o[j] = xv[j8 * 8 + j];
                *(LAS v4u*)(VT + vch * 144 + (l0 + j8 * 8) * 2) = pack8(o); } }
    } else {
        const bf16* prev = WSP(bf16, WS_GLA_ST);
#pragma unroll 4
        for (int i = tid - 384; i < 8192; i += 128) { const int hh = i >> 11, dd = (i >> 6) & 31, vv = i & 63;
            *(LAS unsigned short*)(PVT + (hh * 64 + vv) * 80 + dd * 2) = prev[((size_t)(b * 4 + hh) * NCH + c) * 2048 + dd * 64 + vv]; }
    }
    __syncthreads();
    const int hh = wave >> 1;
#pragma unroll 1
    for (int i = 0; i < 2; ++i) { const int tt = 2 * (wave & 1) + i, t = tt * 16 + fr;
#pragma unroll
        for (int st = 0; st < 4; ++st) { f32x4 acc = {0.f, 0.f, 0.f, 0.f}; acc = mm16(QD + tt * 16 * 272 + hh * 64, 272, KI + st * 16 * 272 + hh * 64, 272, 32, acc, fr, fq);
            const int s0 = st * 16 + 4 * fq;
            lds_st_bf16x4(ATT + hh * 9216 + t * 144 + s0 * 2, t >= s0 ? acc[0] : 0.f, t >= s0 + 1 ? acc[1] : 0.f, t >= s0 + 2 ? acc[2] : 0.f, t >= s0 + 3 ? acc[3] : 0.f); } }
    __syncthreads();
    { bf16* mix = WSP(bf16, WS_MIX); const float* ng = KIN(I_GNG) + layer * 256;
#pragma unroll 1
      for (int i = 0; i < 2; ++i) { const int tt = 2 * (wave & 1) + i, t = tt * 16 + fr; f32x4 ov[4]; float ss = 0.f;
#pragma unroll
          for (int vt = 0; vt < 4; ++vt) { f32x4 acc = {0.f, 0.f, 0.f, 0.f};
              acc = mm16(ATT + hh * 9216 + tt * 16 * 144, 144, VT + (hh * 64 + vt * 16) * 144, 144, 64, acc, fr, fq);
              acc = mm16(QD + tt * 16 * 272 + hh * 64, 272, PVT + (hh * 64 + vt * 16) * 80, 80, 32, acc, fr, fq);
              ov[vt] = acc; ss += (acc.x * acc.x + acc.y * acc.y) + (acc.z * acc.z + acc.w * acc.w); }
          ss += __shfl_xor(ss, 16); ss += __shfl_xor(ss, 32);
          const float r = __builtin_amdgcn_rsqf(ss * (1.f / 64.f) + NORM_EPS);
#pragma unroll
          for (int vt = 0; vt < 4; ++vt) { const int col = hh * 64 + vt * 16 + 4 * fq; const f32x4 g = *(const f32x4*)(ng + col); const f32x4 og = UU4(t0 + t, U_GL_OG + col);
              MIX_ST4(mix, (size_t)(t0 + t) * D + 512 + col, ov[vt].x * r * g.x * siluf_(og.x), ov[vt].y * r * g.y * siluf_(og.y), ov[vt].z * r * g.z * siluf_(og.z), ov[vt].w * r * g.w * siluf_(og.w)); } } }
    __syncthreads();
}

__device__ __forceinline__ void mlstm_stage1(Frame& F, const Args& A, int layer, int b, int c) {
    const bf16* u = WSP(bf16, WS_U);
    LAS unsigned char* L = F.lds;
    LAS float* WST = (LAS float*)L; LAS unsigned char* KT = L + 1024; LAS unsigned char* VWT = KT + 256 * 144;
    const int t0 = b * SEQ + c * 64, tid = F.tid, lane = F.lane, wave = F.wave, fr = lane & 15, fq = lane >> 4;
    if (wave < 4) {
        const int hh = wave;
        const float ig = UU(t0 + lane, U_ML_I + hh) + KIN(I_MIB)[layer * 4 + hh];
        const float lf = logsigmoidf_(UU(t0 + lane, U_ML_F + hh) + KIN(I_MFB)[layer * 4 + hh]);
        const float bc = wave_scan_add(lf, lane); const float blast = __shfl(bc, 63);
        const float ast = blast - bc + ig; const float mloc = wave_max(ast);
        WST[hh * 64 + lane] = __expf(ast - mloc);
        if (lane == 0) { WSP(float, WS_ML_BL)[(b * 4 + hh) * NCH + c] = blast; WSP(float, WS_ML_ML)[(b * 4 + hh) * NCH + c] = mloc; }
    } else {
        const int kch = tid - 256, cc = 256 + kch; const float* cw = KIN(I_MCW) + (size_t)layer * 2048 + cc; const float w0 = cw[0], w1 = cw[512], w2 = cw[1024], w3 = cw[1536], cb = KIN(I_MCB)[layer * 512 + cc];
        const bf16* up = u + (size_t)t0 * NUP + U_ML_K + kch;
        float win0 = 0.f, win1 = 0.f, win2 = 0.f;
        if (c > 0) { win0 = bf2f(up[-3 * NUP]); win1 = bf2f(up[-2 * NUP]); win2 = bf2f(up[-1 * NUP]); }
#pragma unroll 1
        for (int l0 = 0; l0 < 64; l0 += 32) { float xv[32];
#pragma unroll
            for (int j = 0; j < 32; ++j) xv[j] = bf2f(up[(l0 + j) * NUP]);
#pragma unroll
            for (int j8 = 0; j8 < 4; ++j8) { float o[8];
#pragma unroll
                for (int j = 0; j < 8; ++j) { const float x = xv[j8 * 8 + j]; const float y = cb + w0 * win0 + w1 * win1 + w2 * win2 + w3 * x; win0 = win1; win1 = win2; win2 = x; o[j] = siluf_(y); }
                *(LAS v4u*)(KT + kch * 144 + (l0 + j8 * 8) * 2) = pack8(o); } }
    }
    __syncthreads();
    if (tid < 256) {
        const int vch = tid, hh = vch >> 6; const bf16* up = u + (size_t)t0 * NUP + U_ML_V + vch;
#pragma unroll 1
        for (int l0 = 0; l0 < 64; l0 += 32) { float xv[32];
#pragma unroll
            for (int j = 0; j < 32; ++j) xv[j] = bf2f(up[(l0 + j) * NUP]);
#pragma unroll
            for (int j8 = 0; j8 < 4; ++j8) { float o[8];
#pragma unroll
                for (int j = 0; j < 8; ++j) o[j] = xv[j8 * 8 + j] * WST[hh * 64 + l0 + j8 * 8 + j];
                *(LAS v4u*)(VWT + vch * 144 + (l0 + j8 * 8) * 2) = pack8(o); } }
    } else {
        const int kch = tid - 256, hh = kch >> 6; float n = 0.f;
#pragma unroll 8
        for (int s = 0; s < 64; ++s) n += WST[hh * 64 + s] * bf2f(*(const LAS unsigned short*)(KT + kch * 144 + s * 2));
        WSP(bf16, WS_ML_N)[((size_t)(b * 4 + hh) * NCH + c) * 64 + (kch & 63)] = (bf16)(cvt_pk_bf16(n, 0.f) & 0xffffu);
    }
    __syncthreads();
    { bf16* cst = WSP(bf16, WS_ML_C); const int hh = wave >> 1;
#pragma unroll 1
      for (int i = 0; i < 2; ++i) { const int vt = 2 * (wave & 1) + i;
#pragma unroll 1
          for (int kt = 0; kt < 4; ++kt) { f32x4 acc = {0.f, 0.f, 0.f, 0.f}; acc = mm16(VWT + (hh * 64 + vt * 16) * 144, 144, KT + (hh * 64 + kt * 16) * 144, 144, 64, acc, fr, fq);
              stb4(cst + (((size_t)(b * 4 + hh) * NCH + c) * 64 + vt * 16 + fr) * 64 + kt * 16 + 4 * fq, acc); } } }
    __syncthreads();
}
__device__ __forceinline__ void mlstm_stage3(Frame& F, const Args& A, int layer, int b, int c) {
    const bf16* u = WSP(bf16, WS_U);
    LAS unsigned char* L = F.lds;
    LAS float* BCU = (LAS float*)L; LAS float* GG = BCU + 256; LAS float* MROW = BCU + 512; LAS float* WINT = BCU + 768; LAS float* NPV = BCU + 1024;
    LAS unsigned char* Q = L + 6144; LAS unsigned char* KK = Q + 64 * 528; LAS unsigned char* VT = KK + 64 * 528; LAS unsigned char* SC = VT + 256 * 144;
    const int t0 = b * SEQ + c * 64, tid = F.tid, lane = F.lane, wave = F.wave, fr = lane & 15, fq = lane >> 4;
    if (wave < 4) {
        const int hh = wave;
        const float ig = UU(t0 + lane, U_ML_I + hh) + KIN(I_MIB)[layer * 4 + hh];
        const float lf = logsigmoidf_(UU(t0 + lane, U_ML_F + hh) + KIN(I_MFB)[layer * 4 + hh]);
        const float bc = wave_scan_add(lf, lane); const float gg = ig - bc;
        const float mprev = WSP(float, WS_ML_M)[(b * 4 + hh) * NCH + c];
        const float minter = bc + mprev, mintra = bc + wave_scan_max(gg, lane), mrow = fmaxf(minter, mintra);
        BCU[hh * 64 + lane] = bc; GG[hh * 64 + lane] = gg; MROW[hh * 64 + lane] = mrow; WINT[hh * 64 + lane] = __expf(minter - mrow);
        NPV[hh * 64 + lane] = bf2f(WSP(bf16, WS_ML_N)[((size_t)(b * 4 + hh) * NCH + c) * 64 + lane]);
    }
    {
        const int cc = tid; const float* cw = KIN(I_MCW) + (size_t)layer * 2048 + cc; const float w0 = cw[0], w1 = cw[512], w2 = cw[1024], w3 = cw[1536], cb = KIN(I_MCB)[layer * 512 + cc];
        const bf16* up = u + (size_t)t0 * NUP + U_ML_Q + cc;
        float win0 = 0.f, win1 = 0.f, win2 = 0.f;
        if (c > 0) { win0 = bf2f(up[-3 * NUP]); win1 = bf2f(up[-2 * NUP]); win2 = bf2f(up[-1 * NUP]); }
        LAS unsigned char* dst = cc < 256 ? Q + cc * 2 : KK + (cc - 256) * 2; const float sc = cc < 256 ? 0.125f : 1.0f;
#pragma unroll 1
        for (int l0 = 0; l0 < 64; l0 += 32) { float xv[32];
#pragma unroll
            for (int j = 0; j < 32; ++j) xv[j] = bf2f(up[(l0 + j) * NUP]);
#pragma unroll
            for (int j = 0; j < 32; ++j) { const float x = xv[j]; const float y = cb + w0 * win0 + w1 * win1 + w2 * win2 + w3 * x; win0 = win1; win1 = win2; win2 = x; lds_st_bf16(dst + (l0 + j) * 528, siluf_(y) * sc); } }
        const int vch = tid & 255, lh = (tid >> 8) * 32; const bf16* uv = u + (size_t)(t0 + lh) * NUP + U_ML_V + vch;
        float xv[32];
#pragma unroll
        for (int j = 0; j < 32; ++j) xv[j] = bf2f(uv[j * NUP]);
#pragma unroll
        for (int j8 = 0; j8 < 4; ++j8) { float o[8];
#pragma unroll
            for (int j = 0; j < 8; ++j) o[j] = xv[j8 * 8 + j];
            *(LAS v4u*)(VT + vch * 144 + (lh + j8 * 8) * 2) = pack8(o); }
    }
    __syncthreads();
    { const int hh = wave >> 1; bf16* mix = WSP(bf16, WS_MIX); const float* ng = KIN(I_MNG) + layer * 256;
      const bf16* cprev = WSP(bf16, WS_ML_C) + ((size_t)(b * 4 + hh) * NCH + c) * 4096;
      bf16x8 cf[4][2];
#pragma unroll
      for (int vt = 0; vt < 4; ++vt)
#pragma unroll
          for (int ks = 0; ks < 2; ++ks) cf[vt][ks] = *(const bf16x8*)(cprev + (size_t)(vt * 16 + fr) * 64 + ks * 32 + fq * 8);
#pragma unroll 1
      for (int i = 0; i < 2; ++i) { const int tt = 2 * (wave & 1) + i, t = tt * 16 + fr;
          const float bt = BCU[hh * 64 + t] - MROW[hh * 64 + t]; float rs = 0.f;
#pragma unroll
          for (int st = 0; st < 4; ++st) { f32x4 acc = {0.f, 0.f, 0.f, 0.f}; acc = mm16(Q + tt * 16 * 528 + hh * 128, 528, KK + st * 16 * 528 + hh * 128, 528, 64, acc, fr, fq);
              const int s0 = st * 16 + 4 * fq; float o[4];
#pragma unroll
              for (int j = 0; j < 4; ++j) { const int s = s0 + j; const float v = (t >= s) ? acc[j] * __expf(bt + GG[hh * 64 + s]) : 0.f; o[j] = v; rs += v; }
              lds_st_bf16x4(SC + hh * 9216 + t * 144 + s0 * 2, o[0], o[1], o[2], o[3]); }
          rs += __shfl_xor(rs, 16); rs += __shfl_xor(rs, 32);
          float nq = 0.f;
#pragma unroll
          for (int j = 0; j < 16; ++j) nq += bf2f(*(const LAS unsigned short*)(Q + t * 528 + (hh * 64 + fq * 16 + j) * 2)) * NPV[hh * 64 + fq * 16 + j];
          nq += __shfl_xor(nq, 16); nq += __shfl_xor(nq, 32);
          const float wi = WINT[hh * 64 + t]; const float den = wi * nq + rs; const float dn = fmaxf(fabsf(den), __expf(-MROW[hh * 64 + t])); const float rdn = 1.0f / dn;
          LDS_WAIT();
          f32x4 hv[4]; float sm = 0.f;
#pragma unroll
          for (int vt = 0; vt < 4; ++vt) { f32x4 acc = {0.f, 0.f, 0.f, 0.f};
              acc = mm16_rB<2>(Q + tt * 16 * 528 + hh * 128, 528, cf[vt], acc, fr, fq);
              acc = acc * wi;
              acc = mm16(SC + hh * 9216 + tt * 16 * 144, 144, VT + (hh * 64 + vt * 16) * 144, 144, 64, acc, fr, fq);
              const f32x4 og = UU4(t0 + t, U_ML_O + hh * 64 + vt * 16 + 4 * fq);
              f32x4 h; h.x = acc.x * rdn * sigmoidf_(og.x); h.y = acc.y * rdn * sigmoidf_(og.y); h.z = acc.z * rdn * sigmoidf_(og.z); h.w = acc.w * rdn * sigmoidf_(og.w);
              hv[vt] = h; sm += (h.x + h.y) + (h.z + h.w); }
          sm += __shfl_xor(sm, 16); sm += __shfl_xor(sm, 32);
          const float mean = sm * (1.f / 64.f); float sq = 0.f;
#pragma unroll
          for (int vt = 0; vt < 4; ++vt) { hv[vt] = hv[vt] - mean; sq += (hv[vt].x * hv[vt].x + hv[vt].y * hv[vt].y) + (hv[vt].z * hv[vt].z + hv[vt].w * hv[vt].w); }
          sq += __shfl_xor(sq, 16); sq += __shfl_xor(sq, 32);
          const float r = __builtin_amdgcn_rsqf(sq * (1.f / 64.f) + NORM_EPS);
#pragma unroll
          for (int vt = 0; vt < 4; ++vt) { const int col = hh * 64 + vt * 16 + 4 * fq; const f32x4 g = *(const f32x4*)(ng + col);
              MIX_ST4(mix, (size_t)(t0 + t) * D + 768 + col, hv[vt].x * r * g.x, hv[vt].y * r * g.y, hv[vt].z * r * g.z, hv[vt].w * r * g.w); } } }
    __syncthreads();
}

__device__ __forceinline__ void rwkv_stage1(Frame& F, const Args& A, int layer, int ub) {
    const bf16* u = WSP(bf16, WS_U);
    LAS unsigned char* L = F.lds;
    LAS unsigned char* LOWA = L;
    LAS float* CUM = (LAS float*)(L + 16384);
    LAS float* AAB = CUM;
    LAS float* TOT = CUM;
    LAS unsigned char* M0 = L + 16384 + 16640;
#define RM(i) (M0 + (i) * 9216)
    LAS float* GAMC = (LAS float*)(F.MISC + MW_GAMC);
    const int t0 = ub * 64, c = ub & 63, tid = F.tid, lane = F.lane, wave = F.wave;
    const float* mu = KIN(I_RMU) + layer * 896;
#ifndef RW_DUP
#define RW_DUP -1
#endif
#define RW_REP(k) for (int rep__ = 0; rep__ < ((RW_DUP == (k)) ? 2 : 1); ++rep__)
    RW_REP(0) {
    {
        const int l = tid >> 3, jq = tid & 7, t = t0 + l; const bool has_prev = (t & (SEQ - 1)) != 0;
        f32x4 cur[4], prv[4];
#pragma unroll
        for (int q = 0; q < 4; ++q) { cur[q] = UU4(t, U_RW_LO + jq * 16 + 4 * q); prv[q] = has_prev ? UU4(t - 1, U_RW_LO + jq * 16 + 4 * q) : (f32x4){0.f, 0.f, 0.f, 0.f}; }
#pragma unroll
        for (int q = 0; q < 4; ++q) { const f32x4 m4 = *(const f32x4*)(mu + 768 + jq * 16 + 4 * q); const f32x4 xs = cur[q] + (prv[q] - cur[q]) * m4; const int j = jq * 16 + 4 * q;
            f32x4 o;
            if (j < 32) { o.x = tanhf_(xs.x); o.y = tanhf_(xs.y); o.z = tanhf_(xs.z); o.w = tanhf_(xs.w); } else if (j < 64) o = xs; else { o.x = sigmoidf_(xs.x); o.y = sigmoidf_(xs.y); o.z = sigmoidf_(xs.z); o.w = sigmoidf_(xs.w); }
            if (j < 64) lds_st_bf16x4(LOWA + l * 144 + j * 2, o.x, o.y, o.z, o.w); else lds_st_bf16x4(RM(0) + l * 144 + (j - 64) * 2, o.x, o.y, o.z, o.w); }
    }
    __syncthreads();
    {
        bf16* RG = WSP(bf16, WS_RW_G); const int lane_ = F.lane, fr_ = lane_ & 15, fq_ = lane_ >> 4;
        const float* gupT = WSP(float, WS_LORA) + (size_t)layer * LORA_PER_LAYER + 16384;
#pragma unroll
        for (int ci = 0; ci < 2; ++ci) { const int ct = 2 * wave + ci; bf16x8 bf[2];
#pragma unroll
            for (int ks = 0; ks < 2; ++ks) bf[ks] = ldfrag_f32(gupT + (size_t)(ct * 16 + fr_) * 64 + ks * 32 + fq_ * 8);
#pragma unroll
            for (int tt = 0; tt < 4; ++tt) { f32x4 acc = {0.f, 0.f, 0.f, 0.f}; acc = mm16_rB<2>(RM(0) + tt * 16 * 144, 144, bf, acc, fr_, fq_);
                stb4(RG + (size_t)(t0 + tt * 16 + fr_) * 256 + ct * 16 + 4 * fq_, acc); } }
    }
    __syncthreads();
    }
    const int b_ = ub >> 6;
#pragma unroll 1
    for (int hh = 0; hh < 4; ++hh) {
        int ch = lane, fr = lane & 15, fq = lane >> 4; asm volatile("" : "+v"(ch), "+v"(fr), "+v"(fq));
        const int tg = wave, cg = hh * 64 + ch; const size_t un = (size_t)(b_ * 4 + hh) * NCH + c;
        float rr[8], k2r[8], vr[8], ar[8], br[8], pl[8];
        LAS float* WPA = (LAS float*)RM(8);
        {
            const int mat = wave >> 2, ct = wave & 3;
            const float* wT = WSP(float, WS_LORA) + (size_t)layer * LORA_PER_LAYER + mat * 8192 + (size_t)(hh * 64 + ct * 16 + fr) * 32 + fq * 8;
            bf16x8 bfw[1]; bfw[0] = ldfrag_f32(wT);
#pragma unroll
            for (int tt = 0; tt < 4; ++tt) { f32x4 acc = {0.f, 0.f, 0.f, 0.f}; acc = mm16_rB<1>(LOWA + tt * 16 * 144 + mat * 64, 144, bfw, acc, fr, fq);
                *(LAS f32x4*)(WPA + mat * 4096 + (tt * 16 + fr) * 64 + ct * 16 + 4 * fq) = acc; }
        }
        __syncthreads();
        RW_REP(1) {
            const float w0 = KIN(I_RW0)[layer * 256 + cg], a0 = KIN(I_RA0)[layer * 256 + cg], kkc = KIN(I_RKK)[layer * 256 + cg], kac = KIN(I_RKA)[layer * 256 + cg];
            const float mur = mu[cg], muk = mu[256 + cg], muv = mu[512 + cg];
            const int tb = t0 + tg * 8; const bool nop = (c == 0) && (tg == 0);
            float rp = nop ? 0.f : UU(tb - 1, U_RW_R + cg), kp = nop ? 0.f : UU(tb - 1, U_RW_K + cg), vp = nop ? 0.f : UU(tb - 1, U_RW_V + cg);
            float rc[8], kc[8], vc[8];
#pragma unroll
            for (int j = 0; j < 8; ++j) { rc[j] = UU(tb + j, U_RW_R + cg); kc[j] = UU(tb + j, U_RW_K + cg); vc[j] = UU(tb + j, U_RW_V + cg); }
            bf16* RW = WSP(bf16, WS_RW);
            float kk[8], al[8], n2[8], run = 0.f;
#pragma unroll
            for (int j = 0; j < 8; ++j) { const int l = tg * 8 + j;
                const float r = rc[j] + (rp - rc[j]) * mur, k = kc[j] + (kp - kc[j]) * muk, v = vc[j] + (vp - vc[j]) * muv; rp = rc[j]; kp = kc[j]; vp = vc[j];
                const float wp = w0 + WPA[l * 64 + ch], ap = a0 + WPA[4096 + l * 64 + ch];
                const float w = -softplusf_(-wp) - 0.5f; run += -__expf(w); pl[j] = run; al[j] = sigmoidf_(ap);
                kk[j] = k * kkc; n2[j] = kk[j] * kk[j];
                k2r[j] = k * (1.0f + (al[j] - 1.0f) * kac); rr[j] = r; vr[j] = v;
                bf16* o = RW + (size_t)(tb + j) * 768 + cg; o[0] = (bf16)(cvt_pk_bf16(r, 0.f) & 0xffffu); o[256] = (bf16)(cvt_pk_bf16(k2r[j], 0.f) & 0xffffu); o[512] = (bf16)(cvt_pk_bf16(v, 0.f) & 0xffffu); }
#pragma unroll
            for (int i = 0; i < 4; ++i) { const bool hi = (ch & 32) != 0; const float keep = hi ? n2[i + 4] : n2[i], send = hi ? n2[i] : n2[i + 4]; n2[i] = keep + __shfl_xor(send, 32); }
#pragma unroll
            for (int i = 0; i < 2; ++i) { const bool hi = (ch & 16) != 0; const float keep = hi ? n2[i + 2] : n2[i], send = hi ? n2[i] : n2[i + 2]; n2[i] = keep + __shfl_xor(send, 16); }
            { const bool hi = (ch & 8) != 0; const float keep = hi ? n2[1] : n2[0], send = hi ? n2[0] : n2[1]; n2[0] = keep + __shfl_xor(send, 8); }
            n2[0] += __shfl_xor(n2[0], 4); n2[0] += __shfl_xor(n2[0], 2); n2[0] += __shfl_xor(n2[0], 1);
#pragma unroll
            for (int j = 0; j < 8; ++j) { const float tot = __builtin_bit_cast(float, __builtin_amdgcn_readlane(__builtin_bit_cast(int, n2[0]), ((j & 4) ? 32 : 0) + ((j & 2) ? 16 : 0) + ((j & 1) ? 8 : 0)));
                const float kkn = kk[j] / fmaxf(sqrtf(tot), 1e-12f); ar[j] = -kkn; br[j] = kkn * al[j]; }
            TOT[tg * 64 + ch] = run;
        }
        __syncthreads();
        RW_REP(3) {
            float off = 0.f, gC = 0.f;
#pragma unroll
            for (int g = 0; g < 8; ++g) { const float tv = TOT[g * 64 + ch]; gC += tv; if (g < tg) off += tv; }
            float oat[8], obb[8], okb[8], ov[8];
#pragma unroll
            for (int j = 0; j < 8; ++j) { const int l = tg * 8 + j; const float gt = off + pl[j], gm = j > 0 ? off + pl[j - 1] : off;
                const float at = ar[j] * __expf(gm), rt = rr[j] * __expf(gt), en = __expf(-gt), ec = __expf(gC - gt);
                lds_st_bf16(RM(0) + l * 144 + ch * 2, at); lds_st_bf16(RM(1) + l * 144 + ch * 2, rt); lds_st_bf16(RM(2) + l * 144 + ch * 2, br[j] * en); lds_st_bf16(RM(3) + l * 144 + ch * 2, k2r[j] * en);
                oat[j] = at; obb[j] = br[j] * ec; okb[j] = k2r[j] * ec; ov[j] = vr[j]; }
            *(LAS v4u*)(RM(4) + ch * 144 + tg * 16) = pack8(oat); *(LAS v4u*)(RM(5) + ch * 144 + tg * 16) = pack8(obb); *(LAS v4u*)(RM(6) + ch * 144 + tg * 16) = pack8(okb); *(LAS v4u*)(RM(7) + ch * 144 + tg * 16) = pack8(ov);
            if (tg == 0) GAMC[ch] = __expf(gC);
        }
        __syncthreads();
        RW_REP(4) {
            const int which = wave >> 1; const LAS unsigned char* Aop = which < 2 ? RM(0) : RM(1); const LAS unsigned char* Bop = (which & 1) ? RM(3) : RM(2);
#pragma unroll 1
            for (int i2 = 0; i2 < 2; ++i2) { const int tt = 2 * (wave & 1) + i2, t = tt * 16 + fr;
#pragma unroll
                for (int it = 0; it < 4; ++it) { f32x4 acc = {0.f, 0.f, 0.f, 0.f}; acc = mm16(Aop + tt * 16 * 144, 144, Bop + it * 16 * 144, 144, 64, acc, fr, fq);
                    const int i0 = it * 16 + 4 * fq; const int lim = which < 2 ? t : t + 1;
                    const float o0 = (i0 < lim) ? acc[0] : 0.f, o1 = (i0 + 1 < lim) ? acc[1] : 0.f, o2 = (i0 + 2 < lim) ? acc[2] : 0.f, o3 = (i0 + 3 < lim) ? acc[3] : 0.f;
#ifdef RW_CLAMP_AAK
                    float q0 = o0, q1 = o1, q2 = o2, q3 = o3;
                    if (which == 1) { q0 = fabsf(o0) < 1e30f ? o0 : 0.f; q1 = fabsf(o1) < 1e30f ? o1 : 0.f; q2 = fabsf(o2) < 1e30f ? o2 : 0.f; q3 = fabsf(o3) < 1e30f ? o3 : 0.f; }
                    if (which == 0) *(LAS f32x4*)(AAB + t * 64 + i0) = (f32x4){o0, o1, o2, o3};
                    else lds_st_bf16x4(RM(7 + which) + t * 144 + i0 * 2, q0, q1, q2, q3);
                    continue;
#endif
                    if (which == 0) { DBG_STAT(11, o0); DBG_STAT(11, o1); DBG_STAT(11, o2); DBG_STAT(11, o3); } if (which == 1) { DBG_STAT(12, o0); DBG_STAT(12, o1); DBG_STAT(12, o2); DBG_STAT(12, o3); } if (which == 2) { DBG_STAT(13, o0); DBG_STAT(13, o3); } if (which == 3) { DBG_STAT(14, o0); DBG_STAT(14, o3); }
                    if (which == 0) *(LAS f32x4*)(AAB + t * 64 + i0) = (f32x4){o0, o1, o2, o3};
                    else lds_st_bf16x4(RM(7 + which) + t * 144 + i0 * 2, o0, o1, o2, o3); } }
        }
        __syncthreads();
        RW_REP(5) {
#pragma unroll 1
            for (int i2 = 0; i2 < 2; ++i2) { const int idx = wave * 2 + i2, vt = idx >> 2, tt = idx & 3; f32x4 acc = {0.f, 0.f, 0.f, 0.f};
                acc = mm16(RM(7) + vt * 16 * 144, 144, RM(8) + tt * 16 * 144, 144, 64, acc, fr, fq);
                DBG_STAT(15, acc[0]); DBG_STAT(15, acc[1]); DBG_STAT(15, acc[2]); DBG_STAT(15, acc[3]);
                lds_st_bf16x4(RM(0) + (vt * 16 + fr) * 144 + (tt * 16 + 4 * fq) * 2, acc[0], acc[1], acc[2], acc[3]); }
        }
        RW_REP(8) if (wave == 0) {
            float x[64]; f32x4 rowq[16];
#pragma unroll
            for (int t = 0; t < 64; ++t) {
                f32x4 cur[16];
#pragma unroll
                for (int i4 = 0; i4 < (t + 3) / 4; ++i4) cur[i4] = rowq[i4];
                if (t + 1 < 64) {
#pragma unroll
                    for (int i4 = 0; i4 < (t + 4) / 4; ++i4) rowq[i4] = *(const LAS f32x4*)(AAB + (t + 1) * 64 + 4 * i4); }
                float a0 = (t == ch) ? 1.0f : 0.f, a1 = 0.f, a2 = 0.f, a3 = 0.f;
#pragma unroll
                for (int i4 = 0; i4 < (t + 3) / 4; ++i4) { const f32x4 q = cur[i4];
                    a0 += q.x * x[4 * i4]; if (4 * i4 + 1 < t) a1 += q.y * x[4 * i4 + 1]; if (4 * i4 + 2 < t) a2 += q.z * x[4 * i4 + 2]; if (4 * i4 + 3 < t) a3 += q.w * x[4 * i4 + 3]; }
                const float acc = (a0 + a1) + (a2 + a3);
                x[t] = acc; lds_st_bf16(RM(11) + t * 144 + ch * 2, acc); }
        }
        __syncthreads();
        RW_REP(6) {
            const int rt = wave >> 1;
#pragma unroll
            for (int i2 = 0; i2 < 2; ++i2) { const int tt = 2 * (wave & 1) + i2;
                f32x4 acc = {0.f, 0.f, 0.f, 0.f}; acc = mm16(RM(4) + rt * 16 * 144, 144, RM(11) + tt * 16 * 144, 144, 64, acc, fr, fq);
                DBG_STAT(17, acc[0]); DBG_STAT(17, acc[1]); DBG_STAT(17, acc[2]); DBG_STAT(17, acc[3]);
                lds_st_bf16x4(RM(2) + (rt * 16 + fr) * 144 + (tt * 16 + 4 * fq) * 2, acc[0], acc[1], acc[2], acc[3]);
                f32x4 ac2 = {0.f, 0.f, 0.f, 0.f}; ac2 = mm16(RM(0) + rt * 16 * 144, 144, RM(11) + tt * 16 * 144, 144, 64, ac2, fr, fq);
                DBG_STAT(18, ac2[0]); DBG_STAT(18, ac2[1]); DBG_STAT(18, ac2[2]); DBG_STAT(18, ac2[3]);
                lds_st_bf16x4(RM(3) + (rt * 16 + fr) * 144 + (tt * 16 + 4 * fq) * 2, ac2[0], ac2[1], ac2[2], ac2[3]); }
        }
        __syncthreads();
        RW_REP(7) {
            const int which = wave >> 1;
#pragma unroll 1
            for (int i2 = 0; i2 < 2; ++i2) { const int rt = 2 * (wave & 1) + i2, row = rt * 16 + fr;
#pragma unroll
                for (int ct = 0; ct < 4; ++ct) { f32x4 acc = {0.f, 0.f, 0.f, 0.f}; const int c0 = ct * 16 + 4 * fq;
                    if (which == 0) { acc = mm16(RM(9) + rt * 16 * 144, 144, RM(2) + ct * 16 * 144, 144, 64, acc, fr, fq);
                        const v2u rw = *(const LAS v2u*)(RM(1) + row * 144 + c0 * 2);
                        acc[0] += __uint_as_float(rw.x << 16); acc[1] += __uint_as_float(rw.x & 0xffff0000u); acc[2] += __uint_as_float(rw.y << 16); acc[3] += __uint_as_float(rw.y & 0xffff0000u);
                        DBG_STAT(19, acc[0]); DBG_STAT(19, acc[1]); DBG_STAT(19, acc[2]); DBG_STAT(19, acc[3]);
                        v2u o; o.x = cvt_pk_bf16(acc[0], acc[1]); o.y = cvt_pk_bf16(acc[2], acc[3]); *(v2u*)(WSP(bf16, WS_RW_RH) + un * 4096 + row * 64 + c0) = o; }
                    else if (which == 1) {
#ifndef RW_NO_U0
                        acc = mm16(RM(9) + rt * 16 * 144, 144, RM(3) + ct * 16 * 144, 144, 64, acc, fr, fq);
#endif
                        acc = mm16(RM(10) + rt * 16 * 144, 144, RM(7) + ct * 16 * 144, 144, 64, acc, fr, fq);
                        DBG_STAT(20, acc[0]); DBG_STAT(20, acc[1]); DBG_STAT(20, acc[2]); DBG_STAT(20, acc[3]);
                        stb4(WSP(bf16, WS_RW_O0) + un * 4096 + row * 64 + c0, acc); }
                    else if (which == 2) { acc = mm16(RM(5) + rt * 16 * 144, 144, RM(2) + ct * 16 * 144, 144, 64, acc, fr, fq);
                        const float gd = GAMC[row]; if (row == c0) acc[0] += gd; if (row == c0 + 1) acc[1] += gd; if (row == c0 + 2) acc[2] += gd; if (row == c0 + 3) acc[3] += gd;
                        DBG_STAT(21, acc[0]); DBG_STAT(21, acc[1]); DBG_STAT(21, acc[2]); DBG_STAT(21, acc[3]);
                        v2u o; o.x = cvt_pk_bf16(acc[0], acc[1]); o.y = cvt_pk_bf16(acc[2], acc[3]);
                        *(v2u*)((unsigned char*)(WSP(bf16, WS_RW_GF) + un * 4096) + ((rt * 2 + (ct >> 1)) * 64 + ch) * 16 + (ct & 1) * 8) = o; }
                    else { acc = mm16(RM(3) + rt * 16 * 144, 144, RM(5) + ct * 16 * 144, 144, 64, acc, fr, fq); acc = mm16(RM(7) + rt * 16 * 144, 144, RM(6) + ct * 16 * 144, 144, 64, acc, fr, fq);
                        DBG_STAT(22, acc[0]); DBG_STAT(22, acc[1]); DBG_STAT(22, acc[2]); DBG_STAT(22, acc[3]);
                        *(f32x4*)(WSP(float, WS_RW_HT) + un * 4096 + row * 64 + c0) = acc; } } }
        }
        __syncthreads();
    }
#undef RM
}
#if RW_SCAN_DMA
__device__ __forceinline__ void rwkv_scan_wave(Frame& F, const Args& A, int wslot) {
    const int lane = F.lane, fr = lane & 15, fq = lane >> 4, bh = wslot >> 2, v0 = (wslot & 3) * 16;
    const unsigned char* GFb = (const unsigned char*)(WSP(bf16, WS_RW_GF) + (size_t)bh * NCH * 4096) + lane * 16;
    const unsigned char* HTb = (const unsigned char*)(WSP(float, WS_RW_HT) + (size_t)bh * NCH * 4096 + (size_t)(v0 + fr) * 64 + 4 * fq);
    bf16* PT = WSP(bf16, WS_RW_PT) + (size_t)bh * NCH * 4096 + (size_t)(v0 + fr) * 64 + 4 * fq;
    LAS unsigned char* ring = F.lds;
    f32x4 P[4] = {{0.f, 0.f, 0.f, 0.f}, {0.f, 0.f, 0.f, 0.f}, {0.f, 0.f, 0.f, 0.f}, {0.f, 0.f, 0.f, 0.f}};
#define RW2_ISSUE(cc, sl) do { _Pragma("unroll") for (int f_ = 0; f_ < 8; ++f_) __builtin_amdgcn_global_load_lds((const unsigned*)(GFb + (size_t)(cc) * 8192 + f_ * 1024), (LAS unsigned*)(ring + (sl) * 12288 + f_ * 1024), 16, 0, 0); \
        _Pragma("unroll") for (int m_ = 0; m_ < 4; ++m_) __builtin_amdgcn_global_load_lds((const unsigned*)(HTb + (size_t)(cc) * 16384 + m_ * 64), (LAS unsigned*)(ring + (sl) * 12288 + 8192 + m_ * 1024), 16, 0, 0); } while (0)
#define RW2_STEP(cc, sl, NW) do { asm volatile("s_waitcnt vmcnt(" #NW ")" ::: "memory"); \
        const LAS unsigned char* sp_ = ring + (sl) * 12288 + lane * 16; bf16x8 gx[4][2]; f32x4 hx[4]; \
        _Pragma("unroll") for (int m = 0; m < 4; ++m) { hx[m] = *(const LAS f32x4*)(sp_ + 8192 + m * 1024); _Pragma("unroll") for (int s = 0; s < 2; ++s) gx[m][s] = *(const LAS bf16x8*)(sp_ + (m * 2 + s) * 1024); } \
        v4u bs[2]; \
        _Pragma("unroll") for (int s = 0; s < 2; ++s) { bs[s].x = cvt_pk_bf16(P[2 * s][0], P[2 * s][1]); bs[s].y = cvt_pk_bf16(P[2 * s][2], P[2 * s][3]); bs[s].z = cvt_pk_bf16(P[2 * s + 1][0], P[2 * s + 1][1]); bs[s].w = cvt_pk_bf16(P[2 * s + 1][2], P[2 * s + 1][3]); } \
        *(v2u*)(PT + (size_t)(cc) * 4096) = (v2u){bs[0].x, bs[0].y}; *(v2u*)(PT + (size_t)(cc) * 4096 + 16) = (v2u){bs[0].z, bs[0].w}; \
        *(v2u*)(PT + (size_t)(cc) * 4096 + 32) = (v2u){bs[1].x, bs[1].y}; *(v2u*)(PT + (size_t)(cc) * 4096 + 48) = (v2u){bs[1].z, bs[1].w}; \
        _Pragma("unroll") for (int m = 0; m < 4; ++m) { f32x4 acc = hx[m]; acc = __builtin_amdgcn_mfma_f32_16x16x32_bf16(gx[m][0], __builtin_bit_cast(bf16x8, bs[0]), acc, 0, 0, 0); \
            acc = __builtin_amdgcn_mfma_f32_16x16x32_bf16(gx[m][1], __builtin_bit_cast(bf16x8, bs[1]), acc, 0, 0, 0); P[m] = acc; } \
        asm volatile("s_waitcnt lgkmcnt(0)" ::: "memory"); } while (0)
    RW2_ISSUE(0, 0); RW2_ISSUE(1, 1); RW2_ISSUE(2, 2);
    RW2_ISSUE(3, 3); RW2_STEP(0, 0, 36); RW2_ISSUE(4, 0); RW2_STEP(1, 1, 40); RW2_ISSUE(5, 1); RW2_STEP(2, 2, 44); RW2_ISSUE(6, 2); RW2_STEP(3, 3, 48);
#pragma unroll 1
    for (int c = 4; c < 60; c += 4) {
        RW2_ISSUE(c + 3, 3); RW2_STEP(c, 0, 48); RW2_ISSUE(c + 4, 0); RW2_STEP(c + 1, 1, 48); RW2_ISSUE(c + 5, 1); RW2_STEP(c + 2, 2, 48); RW2_ISSUE(c + 6, 2); RW2_STEP(c + 3, 3, 48);
    }
    RW2_ISSUE(63, 3); RW2_STEP(60, 0, 48); RW2_STEP(61, 1, 36); RW2_STEP(62, 2, 24); RW2_STEP(63, 3, 12);
#undef RW2_ISSUE
#undef RW2_STEP
}
#else
__device__ __forceinline__ void rwkv_scan_wave(Frame& F, const Args& A, int wslot) {
    const int lane = F.lane, fr = lane & 15, fq = lane >> 4, bh = wslot >> 2, v0 = (wslot & 3) * 16;
    const bf16* GF = WSP(bf16, WS_RW_GF) + (size_t)bh * NCH * 4096; const float* HT = WSP(float, WS_RW_HT) + (size_t)bh * NCH * 4096 + (size_t)(v0 + fr) * 64 + 4 * fq;
    bf16* PT = WSP(bf16, WS_RW_PT) + (size_t)bh * NCH * 4096 + (size_t)(v0 + fr) * 64 + 4 * fq;
    f32x4 P[4] = {{0.f, 0.f, 0.f, 0.f}, {0.f, 0.f, 0.f, 0.f}, {0.f, 0.f, 0.f, 0.f}, {0.f, 0.f, 0.f, 0.f}};
    bf16x8 g0[4][2], g1[4][2], g2[4][2]; f32x4 h0[4], h1[4], h2[4];
#define RW2_LOAD(gx, hx, cc) do { _Pragma("unroll") for (int m = 0; m < 4; ++m) { hx[m] = *(const f32x4*)(HT + (size_t)(cc) * 4096 + 16 * m); \
        _Pragma("unroll") for (int s = 0; s < 2; ++s) gx[m][s] = *(const bf16x8*)(GF + (size_t)(cc) * 4096 + ((m * 2 + s) * 64 + lane) * 8); } } while (0)
#define RW2_STEP(gx, hx, cc) do { v4u bs[2]; \
        _Pragma("unroll") for (int s = 0; s < 2; ++s) { bs[s].x = cvt_pk_bf16(P[2 * s][0], P[2 * s][1]); bs[s].y = cvt_pk_bf16(P[2 * s][2], P[2 * s][3]); bs[s].z = cvt_pk_bf16(P[2 * s + 1][0], P[2 * s + 1][1]); bs[s].w = cvt_pk_bf16(P[2 * s + 1][2], P[2 * s + 1][3]); } \
        *(v2u*)(PT + (size_t)(cc) * 4096) = (v2u){bs[0].x, bs[0].y}; *(v2u*)(PT + (size_t)(cc) * 4096 + 16) = (v2u){bs[0].z, bs[0].w}; \
        *(v2u*)(PT + (size_t)(cc) * 4096 + 32) = (v2u){bs[1].x, bs[1].y}; *(v2u*)(PT + (size_t)(cc) * 4096 + 48) = (v2u){bs[1].z, bs[1].w}; \
        _Pragma("unroll") for (int m = 0; m < 4; ++m) { f32x4 acc = hx[m]; acc = __builtin_amdgcn_mfma_f32_16x16x32_bf16(gx[m][0], __builtin_bit_cast(bf16x8, bs[0]), acc, 0, 0, 0); \
            acc = __builtin_amdgcn_mfma_f32_16x16x32_bf16(gx[m][1], __builtin_bit_cast(bf16x8, bs[1]), acc, 0, 0, 0); P[m] = acc; } } while (0)
    RW2_LOAD(g0, h0, 0); RW2_LOAD(g1, h1, 1);
#pragma unroll 1
    for (int c = 0; c < 63; c += 3) {
        RW2_LOAD(g2, h2, c + 2); RW2_STEP(g0, h0, c);
        RW2_LOAD(g0, h0, c + 3); RW2_STEP(g1, h1, c + 1);
        if (c + 4 < NCH) RW2_LOAD(g1, h1, c + 4);
        RW2_STEP(g2, h2, c + 2);
    }
    RW2_STEP(g0, h0, 63);
#undef RW2_LOAD
#undef RW2_STEP
}
#endif
__device__ __forceinline__ void rwkv_stage3(Frame& F, const Args& A, int layer, int ub) {
    const int t0 = ub * 64, b_ = ub >> 6, c = ub & 63, lane = F.lane, wave = F.wave, fr = lane & 15, fq = lane >> 4, hh = wave >> 1;
    const size_t un = (size_t)(b_ * 4 + hh) * NCH + c;
    const bf16* RH = WSP(bf16, WS_RW_RH) + un * 4096; const bf16* PT = WSP(bf16, WS_RW_PT) + un * 4096; const bf16* O0 = WSP(bf16, WS_RW_O0) + un * 4096;
    const bf16* RW = WSP(bf16, WS_RW); const bf16* RG = WSP(bf16, WS_RW_G); bf16* mix = WSP(bf16, WS_MIX);
    const float* lg = KIN(I_RLNG) + layer * 256 + hh * 64; const float* lb = KIN(I_RLNB) + layer * 256 + hh * 64; const float* rk = KIN(I_RRK) + layer * 256 + hh * 64;
    bf16x8 pfr[4][2];
#pragma unroll
    for (int vt = 0; vt < 4; ++vt)
#pragma unroll
        for (int ks = 0; ks < 2; ++ks) pfr[vt][ks] = *(const bf16x8*)(PT + (size_t)(vt * 16 + fr) * 64 + ks * 32 + fq * 8);
#pragma unroll 1
    for (int i = 0; i < 2; ++i) { const int tt = 2 * (wave & 1) + i, tl = tt * 16 + fr, t = t0 + tl;
        const bf16x8 ra0 = *(const bf16x8*)(RH + (size_t)tl * 64 + fq * 8), ra1 = *(const bf16x8*)(RH + (size_t)tl * 64 + 32 + fq * 8);
        f32x4 ov[4]; float sm = 0.f;
#pragma unroll
        for (int vt = 0; vt < 4; ++vt) { f32x4 acc = ldb4(O0 + tl * 64 + vt * 16 + 4 * fq);
            acc = __builtin_amdgcn_mfma_f32_16x16x32_bf16(pfr[vt][0], ra0, acc, 0, 0, 0); acc = __builtin_amdgcn_mfma_f32_16x16x32_bf16(pfr[vt][1], ra1, acc, 0, 0, 0);
            ov[vt] = acc; DBG_STAT(24, acc[0]); DBG_STAT(24, acc[1]); DBG_STAT(24, acc[2]); DBG_STAT(24, acc[3]); sm += (acc.x + acc.y) + (acc.z + acc.w); }
        sm += __shfl_xor(sm, 16); sm += __shfl_xor(sm, 32);
        const float mean = sm * (1.f / 64.f); float sq = 0.f;
#pragma unroll
        for (int vt = 0; vt < 4; ++vt) { ov[vt] = ov[vt] - mean; sq += (ov[vt].x * ov[vt].x + ov[vt].y * ov[vt].y) + (ov[vt].z * ov[vt].z + ov[vt].w * ov[vt].w); }
        sq += __shfl_xor(sq, 16); sq += __shfl_xor(sq, 32);
        const float rs = __builtin_amdgcn_rsqf(sq * (1.f / 64.f) + RWKV_GN_EPS);
        float bd = 0.f;
#pragma unroll
        for (int q = 0; q < 4; ++q) { const f32x4 r4 = ldb4(RW + (size_t)t * 768 + hh * 64 + fq * 16 + 4 * q), k4 = ldb4(RW + (size_t)t * 768 + 256 + hh * 64 + fq * 16 + 4 * q), c4 = *(const f32x4*)(rk + fq * 16 + 4 * q);
            bd += (r4.x * k4.x * c4.x + r4.y * k4.y * c4.y) + (r4.z * k4.z * c4.z + r4.w * k4.w * c4.w); }
        bd += __shfl_xor(bd, 16); bd += __shfl_xor(bd, 32);
#pragma unroll
        for (int vt = 0; vt < 4; ++vt) { const int col = vt * 16 + 4 * fq; const f32x4 g4 = *(const f32x4*)(lg + col), b4 = *(const f32x4*)(lb + col);
            const f32x4 v4 = ldb4(RW + (size_t)t * 768 + 512 + hh * 64 + col), gg = ldb4(RG + (size_t)t * 256 + hh * 64 + col);
            float e0 = (ov[vt].x * rs * g4.x + b4.x + bd * v4.x) * gg.x, e1 = (ov[vt].y * rs * g4.y + b4.y + bd * v4.y) * gg.y, e2 = (ov[vt].z * rs * g4.z + b4.z + bd * v4.z) * gg.z, e3 = (ov[vt].w * rs * g4.w + b4.w + bd * v4.w) * gg.w;
#ifdef RW_SANITIZE
            e0 = (fabsf(e0) < 1e30f) ? e0 : 0.f; e1 = (fabsf(e1) < 1e30f) ? e1 : 0.f; e2 = (fabsf(e2) < 1e30f) ? e2 : 0.f; e3 = (fabsf(e3) < 1e30f) ? e3 : 0.f;
#endif
            MIX_ST4(mix, (size_t)t * D + 256 + hh * 64 + col, e0, e1, e2, e3); } }
}

__device__ __forceinline__ void scans_elementwise(Frame& F, const Args& A) {
    const int nthr = F.G * 448, gt = F.vcu * 448 + (F.tid - 64);
    constexpr int N_SSD = 16 * 64 * 128 / 2, N_GLA = 16 * 32 * 64 / 2, N_MLC = 16 * 64 * 64 / 2, N_MLN = 16 * 64 / 2;
    for (int i = gt; i < N_SSD + N_GLA + N_MLC + N_MLN; i += nthr) {
        if (i < N_SSD) { const int bh = i >> 12, pn = (i & 4095) * 2; unsigned* base = (unsigned*)(WSP(bf16, WS_SSD_ST) + (size_t)bh * NCH * 8192 + pn); const float* dec = WSP(float, WS_SSD_DEC) + bh * NCH; float S0 = 0.f, S1 = 0.f;
#pragma unroll 1
            for (int c0 = 0; c0 < NCH; c0 += 32) { unsigned x[32]; float dd[32];
#pragma unroll
                for (int j = 0; j < 32; ++j) { x[j] = base[(size_t)(c0 + j) * 4096]; dd[j] = dec[c0 + j]; }
#pragma unroll
                for (int j = 0; j < 32; ++j) { base[(size_t)(c0 + j) * 4096] = cvt_pk_bf16(S0, S1); S0 = dd[j] * S0 + __uint_as_float(x[j] << 16); S1 = dd[j] * S1 + __uint_as_float(x[j] & 0xffff0000u); } }
        } else if (i < N_SSD + N_GLA) { const int k = i - N_SSD, bh = k >> 10, dv = (k & 1023) * 2, dd_ = dv >> 6, b = bh >> 2, hh = bh & 3; unsigned* base = (unsigned*)(WSP(bf16, WS_GLA_ST) + (size_t)bh * NCH * 2048 + dv); const float* dec = WSP(float, WS_GLA_DEC) + (size_t)b * NCH * 128 + hh * 32 + dd_; float S0 = 0.f, S1 = 0.f;
#pragma unroll 1
            for (int c0 = 0; c0 < NCH; c0 += 32) { unsigned x[32]; float dd[32];
#pragma unroll
                for (int j = 0; j < 32; ++j) { x[j] = base[(size_t)(c0 + j) * 1024]; dd[j] = dec[(c0 + j) * 128]; }
#pragma unroll
                for (int j = 0; j < 32; ++j) { base[(size_t)(c0 + j) * 1024] = cvt_pk_bf16(S0, S1); S0 = dd[j] * S0 + __uint_as_float(x[j] << 16); S1 = dd[j] * S1 + __uint_as_float(x[j] & 0xffff0000u); } }
        } else { const int k = i - N_SSD - N_GLA; const bool isn = k >= N_MLC; const int kk = isn ? k - N_MLC : k; const int bh = isn ? (kk >> 5) : (kk >> 11), e = (isn ? (kk & 31) : (kk & 2047)) * 2, str = isn ? 32 : 2048;
            unsigned* base = (unsigned*)((isn ? WSP(bf16, WS_ML_N) : WSP(bf16, WS_ML_C)) + (size_t)bh * NCH * str * 2 + e); const float* bl = WSP(float, WS_ML_BL) + bh * NCH; const float* ml = WSP(float, WS_ML_ML) + bh * NCH; float* mo = WSP(float, WS_ML_M) + bh * NCH;
            float S0 = 0.f, S1 = 0.f, m = 0.f;
#pragma unroll 1
            for (int c0 = 0; c0 < NCH; c0 += 32) { unsigned x[32]; float b8[32], m8[32];
#pragma unroll
                for (int j = 0; j < 32; ++j) { x[j] = base[(size_t)(c0 + j) * str]; b8[j] = bl[c0 + j]; m8[j] = ml[c0 + j]; }
#pragma unroll
                for (int j = 0; j < 32; ++j) { const float mn = fmaxf(b8[j] + m, m8[j]); const float so = __expf(b8[j] + m - mn), sn = __expf(m8[j] - mn);
                    base[(size_t)(c0 + j) * str] = cvt_pk_bf16(S0, S1); if (!isn && e == 0) mo[c0 + j] = m; S0 = so * S0 + sn * __uint_as_float(x[j] << 16); S1 = so * S1 + sn * __uint_as_float(x[j] & 0xffff0000u); m = mn; } }
        }
    }
}
#ifndef MK_PER_PHASE_LAUNCH
#define MK_PER_PHASE_LAUNCH 0
#endif
#ifndef PH_MASK
#define PH_MASK 0xFFF
#endif
#ifndef ST_MASK
#define ST_MASK 0xF
#endif
#define ST_ON(k) (((ST_MASK) >> (k)) & 1)
#ifndef DUP_MASK
#define DUP_MASK 0
#endif
#define DUP_N(k) ((((DUP_MASK) >> (k)) & 1) ? 2 : 1)
#ifndef ST_DUP
#define ST_DUP 0
#endif
#define ST_REP(ty) ((((ST_DUP) >> (ty)) & 1) ? 2 : 1)
#define PH_ON(k) (((PH_MASK) >> (k)) & 1)
constexpr int PH_PER_LAYER = 11, N_PHASES = 1 + DEPTH * PH_PER_LAYER;
__global__ void __launch_bounds__(NWAVES * 64, 2) fwd_kernel(Args args) {
    extern __shared__ __attribute__((aligned(16))) unsigned char lds[];
    Frame F;
    F.lds = (LAS unsigned char*)lds;
    F.MISC = (volatile LAS unsigned*)(F.lds + MISC_OFF);
    F.tid = threadIdx.x; F.lane = F.tid & 63; F.wave = __builtin_amdgcn_readfirstlane(F.tid >> 6);
    F.G = gridDim.x; { const int bx = blockIdx.x; F.vcu = (F.G % 8 == 0) ? (bx % 8) * (F.G / 8) + bx / 8 : bx; }
    F.ka = (karg_t)__builtin_amdgcn_kernarg_segment_ptr(); F.ws = args.ws; F.ctl = (gu32*)(args.ws + WS_CTL); F.out = args.out;
    for (int i = F.tid; i < 256; i += NWAVES * 64) F.MISC[i] = 0u;
    __syncthreads();
    const int lo = args.ph_lo, hi = args.ph_hi;
#ifdef DBG_TSEL
    if (blockIdx.x == 0 && threadIdx.x == 0) __hip_atomic_store(F.ctl + CW_DBG + 15, (unsigned)__builtin_amdgcn_s_memrealtime(), RLX_AGENT);
#endif
    XcdBarrier bar; bar.bar = (unsigned*)(F.ctl + CW_BAR); bar.x = 0; bar.st = nullptr;
    if (hi - lo > 1) bar = xcd_barrier_post((unsigned*)(F.ctl + CW_BAR), F.MISC + MW_BAR);
#define IN_(k) (lo <= (k) && (k) < hi)
#ifdef DBG_TSEL
#ifndef DBG_TQ
#define DBG_TQ 50.0f
#endif
#define TSTAMP(k) do { if (blockIdx.x == 0 && threadIdx.x == 0) __hip_atomic_store(F.ctl + CW_DBG + 16 + ((k) == 11 ? 0 : 1 + layer_ * PH_PER_LAYER + (k)), (unsigned)__builtin_amdgcn_s_memrealtime(), RLX_AGENT); } while (0)
#else
#define TSTAMP(k) do { } while (0)
#endif
#ifdef BAR_DUP
#define SEAM(k) do { if (IN_(k) && IN_((k) + 1)) { xcd_barrier(bar); xcd_barrier(bar); } } while (0)
#else
#define SEAM(k) do { if (IN_(k) && IN_((k) + 1)) xcd_barrier(bar); } while (0)
#endif

    if (PH_ON(11) && IN_(0)) { for (int rep_ = 0; rep_ < DUP_N(11); ++rep_) { frame_refresh(F); p0_prologue(F, args); } SEAM(0); { const int layer_ = 0; TSTAMP(11); (void)layer_; } }
#pragma unroll 1
    for (int layer = 0; layer < DEPTH; ++layer) {
        const int pb = 1 + layer * PH_PER_LAYER; const int layer_ = layer; (void)layer_;
        if (PH_ON(0) && IN_(pb + 0)) { for (int rep_ = 0; rep_ < DUP_N(0); ++rep_) { frame_refresh(F);
            { pg8::DenseSched S; S.init(WSP(bf16, WS_XB), WSP(bf16, WS_WIN_T) + (size_t)layer * NUP * D, T, NUP, D, F.G, (int)blockIdx.x);
              pg8::EpiB16 E{WSP(bf16, WS_U), NUP, nullptr, 0.f};
              pg8::gemm_phase<pg8::EpiB16, pg8::DenseSched>(F.lds, F.tid, S, E); }
            if (F.G != 256 || blockIdx.x >= 128)
            { pg8::DenseSched S; if (F.G == 256) S.init(WSP(bf16, WS_PB) + (size_t)layer * T * 256, WSP(bf16, WS_WPP_T) + (size_t)layer * D * 256, T, D, 256, 128, (int)blockIdx.x - 128); else S.init(WSP(bf16, WS_PB) + (size_t)layer * T * 256, WSP(bf16, WS_WPP_T) + (size_t)layer * D * 256, T, D, 256, F.G, (int)blockIdx.x);
              pg8::EpiB16 E{WSP(bf16, WS_PE), D, nullptr, 0.f};
              pg8::gemm_phase<pg8::EpiB16, pg8::DenseSched>(F.lds, F.tid, S, E); }
            } SEAM(pb + 0); TSTAMP(0);
        }
        if (PH_ON(1) && IN_(pb + 1)) { for (int rep_ = 0; rep_ < DUP_N(1); ++rep_) { frame_refresh(F);
            for (int un = F.vcu; un < 1024; un += F.G) { frame_refresh(F); const int ty = un >> 8, r = un & 255, b = r >> 6, c = r & 63;
                if (ty == 0) { ssd_stage1(F, args, layer, b, c); if (ST_DUP & 1) ssd_stage1(F, args, layer, b, c); } else if (ty == 1) { gla_stage1(F, args, layer, b, c); if (ST_DUP & 2) gla_stage1(F, args, layer, b, c); } else if (ty == 2) { mlstm_stage1(F, args, layer, b, c); if (ST_DUP & 4) mlstm_stage1(F, args, layer, b, c); } else { rwkv_stage1(F, args, layer, r); if (ST_DUP & 8) rwkv_stage1(F, args, layer, r); } }
            } SEAM(pb + 1); TSTAMP(1);
        }
        if (PH_ON(2) && IN_(pb + 2)) { for (int rep_ = 0; rep_ < DUP_N(2); ++rep_) { frame_refresh(F);
            if (F.wave == 0) { for (int ws_ = F.vcu; ws_ < 64; ws_ += F.G) rwkv_scan_wave(F, args, ws_); }
            else if (rep_ == 0) scans_elementwise(F, args);
            } SEAM(pb + 2); TSTAMP(2);
        }
        if (PH_ON(3) && IN_(pb + 3)) { for (int rep_ = 0; rep_ < DUP_N(3); ++rep_) { frame_refresh(F);
            for (int un = F.vcu; un < 1024; un += F.G) { frame_refresh(F); const int ty = un >> 8, r = un & 255, b = r >> 6, c = r & 63;
                if (ty == 0) { ssd_stage3(F, args, layer, b, c); if (ST_DUP & 16) ssd_stage3(F, args, layer, b, c); } else if (ty == 1) { gla_stage3(F, args, layer, b, c); if (ST_DUP & 32) gla_stage3(F, args, layer, b, c); } else if (ty == 2) { mlstm_stage3(F, args, layer, b, c); if (ST_DUP & 64) mlstm_stage3(F, args, layer, b, c); } else { rwkv_stage3(F, args, layer, r); if (ST_DUP & 128) rwkv_stage3(F, args, layer, r); } }
            } SEAM(pb + 3); TSTAMP(3);
        }
        if (PH_ON(4) && IN_(pb + 4)) { for (int rep_ = 0; rep_ < DUP_N(4); ++rep_) { frame_refresh(F);
            pg8::EpiB16 E{WSP(bf16, WS_Y1), D, WSP(bf16, WS_XB), DN_ALPHA};
#if OUT_FP8
            pg8::DenseSched8b S; S.init(WSP(bf16, WS_MIX), (const bf16*)(WSP(unsigned char, WS_WOUT_Q) + (size_t)layer * D * D), T, D, D / 2, F.G, (int)blockIdx.x);
            pg8::gemm_phase<pg8::EpiB16, pg8::DenseSched8b>(F.lds, F.tid, S, E);
#else
            pg8::DenseSched S; S.init(WSP(bf16, WS_MIX), WSP(bf16, WS_WOUT_T) + (size_t)layer * D * D, T, D, D, F.G, (int)blockIdx.x);
            pg8::gemm_phase<pg8::EpiB16, pg8::DenseSched>(F.lds, F.tid, S, E);
#endif
            } SEAM(pb + 4); TSTAMP(4);
        }
        if (PH_ON(5) && IN_(pb + 5)) { if (DUP_N(5) == 2) { frame_refresh(F); p6_ln1_router<true>(F, args, layer); } frame_refresh(F); p6_ln1_router<false>(F, args, layer); SEAM(pb + 5); TSTAMP(5); }
        if (PH_ON(6) && IN_(pb + 6)) { for (int rep_ = 0; rep_ < DUP_N(6); ++rep_) { frame_refresh(F);
            moe_build_pfx(F, args, layer, 8);
            pg8::Moe1Sched S; S.O.pfx = F.MISC + MW_PFX; S.O.NT = 8; S.O.G = F.G; S.O.c = (int)blockIdx.x; S.sdest = WSP(int, WS_SDEST); S.bgu = KIN(I_BGU) + (size_t)layer * NE * 2048;
            if (MOE_FP8) { S.X = WSP(unsigned char, WS_X1Q); S.W = WSP(unsigned char, WS_WGU_Q) + (size_t)layer * NE * 2048 * D; S.K = D / 2; S.hstepB = (size_t)1024 * D; }
            else { S.X = WSP(unsigned char, WS_X1B); S.W = WSP(unsigned char, WS_WGU_T) + (size_t)layer * NE * 2048 * D * 2; S.K = D; S.hstepB = (size_t)1024 * D * 2; }
            pg8::EpiMoe1 E{WSP(bf16, WS_ABUF), KIN(I_BGU) + (size_t)layer * NE * 2048, WSP(unsigned char, WS_ABUFQ)};
            pg8::gemm_phase<pg8::EpiMoe1, pg8::Moe1Sched>(F.lds, F.tid, S, E);
            } SEAM(pb + 6); TSTAMP(6);
        }
        if (PH_ON(7) && IN_(pb + 7)) { for (int rep_ = 0; rep_ < DUP_N(7); ++rep_) { frame_refresh(F);
            moe_build_pfx(F, args, layer, 4);
            pg8::Moe2Sched S; S.O.pfx = F.MISC + MW_PFX; S.O.NT = 4; S.O.G = F.G; S.O.c = (int)blockIdx.x; S.sdest = WSP(int, WS_SDEST); S.sgate = WSP(float, WS_SGATE); S.bdn = KIN(I_BDN) + (size_t)layer * NE * D; if (MOE2_FP8) { S.Ab = WSP(unsigned char, WS_ABUFQ); S.W = WSP(unsigned char, WS_WDN_Q) + (size_t)layer * NE * D * D; S.K = D / 2; S.hstepB = (size_t)128 * D; }
            else { S.Ab = WSP(unsigned char, WS_ABUF); S.W = WSP(unsigned char, WS_WDN_T) + (size_t)layer * NE * D * D * 2; S.K = D; S.hstepB = (size_t)128 * D * 2; }
            pg8::EpiMoe2 E{WSP(bf16, WS_YBUF), KIN(I_BDN) + (size_t)layer * NE * D, WSP(int, WS_SDEST), WSP(float, WS_SGATE)};
            pg8::gemm_phase<pg8::EpiMoe2, pg8::Moe2Sched>(F.lds, F.tid, S, E);
            } SEAM(pb + 7); TSTAMP(7);
        }
        if (PH_ON(8) && IN_(pb + 8)) { for (int rep_ = 0; rep_ < DUP_N(8); ++rep_) { frame_refresh(F); p9_combine(F, args); } SEAM(pb + 8); TSTAMP(8); }
        if (PH_ON(9) && IN_(pb + 9)) { for (int rep_ = 0; rep_ < DUP_N(9); ++rep_) { frame_refresh(F);
            pg8::EpiPle E{WSP(bf16, WS_H2), WSP(bf16, WS_HB), WSP(bf16, WS_PE)};
#if PLE_FP8
            pg8::DenseSched8 S; S.init((const bf16*)WSP(unsigned char, WS_HQ), (const bf16*)(WSP(unsigned char, WS_WPG_Q) + (size_t)layer * D * D), T, D, D / 2, F.G, (int)blockIdx.x);
            pg8::gemm_phase<pg8::EpiPle, pg8::DenseSched8>(F.lds, F.tid, S, E);
#else
            pg8::DenseSched S; S.init(WSP(bf16, WS_HB), WSP(bf16, WS_WPG_T) + (size_t)layer * D * D, T, D, D, F.G, (int)blockIdx.x);
            pg8::gemm_phase<pg8::EpiPle, pg8::DenseSched>(F.lds, F.tid, S, E);
#endif
            } SEAM(pb + 9); TSTAMP(9);
        }
        if (PH_ON(10) && IN_(pb + 10)) { for (int rep_ = 0; rep_ < DUP_N(10); ++rep_) { frame_refresh(F); p11_ln2(F, args, layer); } SEAM(pb + 10); TSTAMP(10); }
    }
#ifdef DBG_TSEL
    if (hi - lo > 1) { xcd_barrier(bar);
        unsigned ticks = 0u;
        if (DBG_TSEL == 11) ticks = __hip_atomic_load(F.ctl + CW_DBG + 16, RLX_AGENT) - __hip_atomic_load(F.ctl + CW_DBG + 15, RLX_AGENT);
        else for (int l = 0; l < DEPTH; ++l) { const int pi = 1 + l * PH_PER_LAYER + DBG_TSEL; ticks += __hip_atomic_load(F.ctl + CW_DBG + 16 + pi, RLX_AGENT) - __hip_atomic_load(F.ctl + CW_DBG + 16 + pi - 1, RLX_AGENT); }
        const float us = floorf((float)ticks * 0.01f / DBG_TQ) * DBG_TQ; const float code = sqrtf(us * 0.05f);
        for (size_t i = (size_t)blockIdx.x * 512 + threadIdx.x; i < (size_t)T * D; i += (size_t)gridDim.x * 512) F.out[i] = code; }
#endif
#ifdef DBG_SEL
    if (hi - lo > 1) { xcd_barrier(bar);
        const unsigned mx = __hip_atomic_load(F.ctl + CW_DBG, RLX_AGENT), nf = __hip_atomic_load(F.ctl + CW_DBG + 1, RLX_AGENT);
        float code;
        { const float m = __uint_as_float(mx); int b = (m > 0.f) ? (int)floorf(log10f(m)) + 30 : 0; b = b < 0 ? 0 : (b > 60 ? 60 : b); if (nf) b += 100; code = sqrtf(10.0f * (float)(b + 1)); }
        for (size_t i = (size_t)blockIdx.x * 512 + threadIdx.x; i < (size_t)T * D; i += (size_t)gridDim.x * 512) F.out[i] = code; }
#endif
#undef IN_
#undef SEAM
}

extern "C" void kernel_launch(void* const* d_in, const int* in_sizes, int n_in, void* d_out, int out_size, void* d_ws, size_t ws_size, hipStream_t stream) {
    static int grid = 0;
    if (grid == 0) {
        if (n_in != N_IN || out_size != T * D || ws_size < WS_END) { fprintf(stderr, "kernel_launch: unexpected shapes (n_in %d, out %d, ws %zu < %zu); nothing launched\n", n_in, out_size, ws_size, (size_t)WS_END); grid = -1; return; }
        int dev = 0, cus = 0, per_cu = 0;
        if (hipGetDevice(&dev) != hipSuccess || hipDeviceGetAttribute(&cus, hipDeviceAttributeMultiprocessorCount, dev) != hipSuccess) { grid = -1; return; }
        if (hipFuncSetAttribute((const void*)fwd_kernel, hipFuncAttributeMaxDynamicSharedMemorySize, LDS_BYTES) != hipSuccess) { fprintf(stderr, "kernel_launch: hipFuncSetAttribute failed\n"); grid = -1; return; }
        if (hipOccupancyMaxActiveBlocksPerMultiprocessor(&per_cu, (const void*)fwd_kernel, NWAVES * 64, LDS_BYTES) != hipSuccess || per_cu < 1) { fprintf(stderr, "kernel_launch: occupancy query says %d blocks per CU\n", per_cu); }
        (void)hipGetLastError();
        grid = cus;
    }
    if (grid < 0) return;
    (void)hipMemsetAsync((char*)d_ws + WS_CTL, 0, CTL_ZERO_BYTES, stream);
    Args a{};
    for (int i = 0; i < N_IN; ++i) a.in[i] = (const float*)d_in[i];
    a.out = (float*)d_out; a.ws = (unsigned char*)d_ws;
#if MK_PER_PHASE_LAUNCH
    for (int ph = 0; ph < N_PHASES; ++ph) { a.ph_lo = ph; a.ph_hi = ph + 1; hipLaunchKernelGGL(fwd_kernel, dim3(grid), dim3(NWAVES * 64), LDS_BYTES, stream, a); }
#else
    a.ph_lo = 0; a.ph_hi = N_PHASES; hipLaunchKernelGGL(fwd_kernel, dim3(grid), dim3(NWAVES * 64), LDS_BYTES, stream, a);
#endif
    const hipError_t le = hipPeekAtLastError();
    if (le != hipSuccess) fprintf(stderr, "kernel_launch: launch failed: %s\n", hipGetErrorName(le));
}
```

```cpp
#include <hip/hip_runtime.h>
#include <cstdio>
#include <cstdint>

#define GAS __attribute__((address_space(1)))
#define LAS __attribute__((address_space(3)))
typedef unsigned short bf16;
typedef unsigned v4u __attribute__((ext_vector_type(4)));
typedef unsigned v2u __attribute__((ext_vector_type(2)));
typedef float f32x4 __attribute__((ext_vector_type(4)));
typedef float f32x2 __attribute__((ext_vector_type(2)));
typedef short bf16x8 __attribute__((ext_vector_type(8)));
typedef int v4i_t __attribute__((ext_vector_type(4)));
typedef int v8i_t __attribute__((ext_vector_type(8)));
typedef GAS unsigned gu32;
#define RLX_AGENT __ATOMIC_RELAXED, __HIP_MEMORY_SCOPE_AGENT
#define LDS_WAIT() asm volatile("s_waitcnt lgkmcnt(0)" ::: "memory")
#define VM_WAIT() asm volatile("s_waitcnt vmcnt(0)" ::: "memory")

constexpr int NWAVES = 8;
constexpr int DEPTH = 4, BATCH = 4, SEQ = 4096, D = 1024, T = BATCH * SEQ;
constexpr int NU = 3484, NUP = 3584;
constexpr int NE = 32, TOPK = 4, ECAP = 16384;
constexpr int NCH = SEQ / 64;
constexpr int U_SSD_Z = 0, U_SSD_X = 256, U_SSD_B = 512, U_SSD_C = 640, U_SSD_DT = 768;
constexpr int U_RW = 772, U_RW_R = 772, U_RW_K = 1028, U_RW_V = 1284, U_RW_LO = 1540;
constexpr int U_GL_Q = 1668, U_GL_K = 1796, U_GL_V = 1924, U_GL_G = 2180, U_GL_OG = 2196;
constexpr int U_ML_Q = 2452, U_ML_K = 2708, U_ML_V = 2964, U_ML_I = 3220, U_ML_F = 3224, U_ML_O = 3228;
constexpr float DN_ALPHA = 1.6817928305074290f;
constexpr float LN_EPS = 1e-5f, NORM_EPS = 1e-5f, RWKV_GN_EPS = 64e-5f;

enum { I_X = 0, I_P, I_WIN, I_WOUT, I_LN1G, I_LN1B, I_SCW, I_SCB, I_SALOG, I_SDTB, I_SD, I_SNG,
       I_RMU, I_RW0, I_RWUP, I_RA0, I_RAUP, I_RGUP, I_RKK, I_RKA, I_RRK, I_RLNG, I_RLNB,
       I_GGUP, I_GGB, I_GNG, I_MCW, I_MCB, I_MIB, I_MFB, I_MNG,
       I_RTW, I_RTB, I_WGU, I_BGU, I_WDN, I_BDN, I_PGW, I_PPJ, I_LN2G, I_LN2B, N_IN };

constexpr size_t MiB = 1u << 20;
constexpr size_t WS_CTL = 0, CTL_ZERO_BYTES = 1 * MiB;
constexpr size_t WS_WIN_T = 2 * MiB;
constexpr size_t WS_WOUT_T = WS_WIN_T + (size_t)DEPTH * NUP * D * 2;
constexpr size_t WS_WGU_T = WS_WOUT_T + (size_t)DEPTH * D * D * 2;
constexpr size_t WS_WDN_T = WS_WGU_T + (size_t)DEPTH * NE * 2048 * D * 2;
constexpr size_t WS_WPG_T = WS_WDN_T + (size_t)DEPTH * NE * D * D * 2;
constexpr size_t WS_WPP_T = WS_WPG_T + (size_t)DEPTH * D * D * 2;
constexpr size_t WS_RWT = WS_WPP_T + (size_t)DEPTH * D * 256 * 2;
constexpr size_t WS_PB = WS_RWT + (size_t)DEPTH * NE * D * 4;
constexpr size_t WS_XB = WS_PB + (size_t)DEPTH * T * 256 * 2;
constexpr size_t WS_U = WS_XB + (size_t)T * D * 2;
constexpr size_t WS_PE = WS_U + (size_t)T * NUP * 2;
constexpr size_t WS_MIX = WS_PE + (size_t)T * D * 4;
constexpr size_t WS_Y1 = WS_MIX + (size_t)T * D * 2;
constexpr size_t WS_X1 = WS_Y1 + (size_t)T * D * 4;
constexpr size_t WS_X1B = WS_X1 + (size_t)T * D * 4;
constexpr size_t WS_SDEST = WS_X1B + (size_t)T * D * 2;
constexpr size_t WS_SGATE = WS_SDEST + (size_t)NE * ECAP * 4;
constexpr size_t WS_ABUF = WS_SGATE + (size_t)NE * ECAP * 4;
constexpr size_t WS_YBUF = WS_ABUF + (size_t)NE * ECAP * D * 2;
constexpr size_t WS_H = WS_YBUF + (size_t)T * 4 * D * 2;
constexpr size_t WS_HB = WS_H + (size_t)T * D * 4;
constexpr size_t WS_H2 = WS_HB + (size_t)T * D * 2;
constexpr size_t WS_SSD_ST = WS_H2 + (size_t)T * D * 4;
constexpr size_t WS_SSD_DEC = WS_SSD_ST + (size_t)16 * NCH * 64 * 128 * 4;
constexpr size_t WS_GLA_ST = WS_SSD_DEC + 16 * NCH * 4;
constexpr size_t WS_GLA_DEC = WS_GLA_ST + (size_t)16 * NCH * 32 * 64 * 4;
constexpr size_t WS_ML_C = WS_GLA_DEC + (size_t)4 * NCH * 128 * 4;
constexpr size_t WS_ML_N = WS_ML_C + (size_t)16 * NCH * 64 * 64 * 4;
constexpr size_t WS_ML_BL = WS_ML_N + (size_t)16 * NCH * 64 * 4;
constexpr size_t WS_ML_ML = WS_ML_BL + 16 * NCH * 4;
constexpr size_t WS_ML_M = WS_ML_ML + 16 * NCH * 4;
constexpr size_t WS_RW = WS_ML_M + 16 * NCH * 4;
constexpr size_t WS_RW_G = WS_RW + (size_t)T * 3 * 256 * 4;
constexpr size_t WS_RW_RH = WS_RW_G + (size_t)T * 256 * 4;
constexpr size_t WS_RW_O0 = WS_RW_RH + (size_t)1024 * 4096 * 2;
constexpr size_t WS_RW_GF = WS_RW_O0 + (size_t)1024 * 4096 * 4;
constexpr size_t WS_RW_HT = WS_RW_GF + (size_t)1024 * 4096 * 2;
constexpr size_t WS_RW_PT = WS_RW_HT + (size_t)1024 * 4096 * 4;
constexpr size_t WS_LORA = WS_RW_PT + (size_t)1024 * 4096 * 2;
constexpr int LORA_PER_LAYER = 8192 + 8192 + 16384 + 2048;
constexpr size_t WS_WGU_Q = WS_LORA + (size_t)DEPTH * LORA_PER_LAYER * 4;
constexpr size_t WS_WDN_Q = WS_WGU_Q + (size_t)DEPTH * NE * 2048 * D;
constexpr size_t WS_X1Q = WS_WDN_Q + (size_t)DEPTH * NE * D * D;
constexpr size_t WS_ABUFQ = WS_X1Q + (size_t)T * D;
constexpr size_t WS_WPG_Q = WS_ABUFQ + (size_t)NE * ECAP * D;
constexpr size_t WS_HQ = WS_WPG_Q + (size_t)DEPTH * D * D;
constexpr size_t WS_WOUT_Q = WS_HQ + (size_t)T * D;
constexpr size_t WS_END = WS_WOUT_Q + (size_t)DEPTH * D * D;
#ifndef MOE_FP8
#define MOE_FP8 1
#endif
#ifndef MOE2_FP8
#define MOE2_FP8 1
#ifndef RW_SOLVE_BLK
#define RW_SOLVE_BLK 1
#endif
#ifndef RW_SCAN_DMA
#define RW_SCAN_DMA 1
#endif
#ifndef P6_MFMA
#define P6_MFMA 1
#endif
#ifndef OUT_FP8
#define OUT_FP8 1
#endif
#ifndef PLE_FP8
#define PLE_FP8 1
#endif
#endif
constexpr int CW_BAR = 4096;
constexpr int CW_DBG = 32768;
constexpr int CW_CNT = 16384;

constexpr int RING_BYTES = 147456;
constexpr int MISC_OFF = RING_BYTES;
constexpr int LDS_BYTES = RING_BYTES + 1024;
constexpr int MW_BAR = 8, MW_LCNT = 32, MW_LBASE = 64, MW_PFX = 96, MW_CNT = 136, MW_GAMC = 168;

typedef __bf16 bf16x2_t __attribute__((ext_vector_type(2)));
__device__ __forceinline__ unsigned cvt_pk_bf16(float lo, float hi) { const f32x2 v = {lo, hi}; const bf16x2_t b = __builtin_convertvector(v, bf16x2_t); return __builtin_bit_cast(unsigned, b); }
__device__ __forceinline__ unsigned cvt4_fp8(float a, float b, float c, float d) { int w = 0; w = __builtin_amdgcn_cvt_pk_fp8_f32(a, b, w, false); w = __builtin_amdgcn_cvt_pk_fp8_f32(c, d, w, true); return (unsigned)w; }
__device__ __forceinline__ float bf2f(unsigned short b) { return __uint_as_float(((unsigned)b) << 16); }
__device__ __forceinline__ float sigmoidf_(float x) { return __builtin_amdgcn_rcpf(1.0f + __expf(-x)); }
__device__ __forceinline__ float siluf_(float x) { return x * __builtin_amdgcn_rcpf(1.0f + __expf(-x)); }
__device__ __forceinline__ float softplusf_(float x) { return fmaxf(x, 0.f) + __logf(1.0f + __expf(-fabsf(x))); }
__device__ __forceinline__ float logsigmoidf_(float x) { return fminf(x, 0.f) - __logf(1.0f + __expf(-fabsf(x))); }
__device__ __forceinline__ float tanhf_(float x) { const float e = __expf(-2.0f * fabsf(x)); const float t = (1.0f - e) * __builtin_amdgcn_rcpf(1.0f + e); return x < 0.f ? -t : t; }
__device__ __forceinline__ int lane_now() { int l = (int)__builtin_amdgcn_mbcnt_hi(~0u, __builtin_amdgcn_mbcnt_lo(~0u, 0u)); asm volatile("" : "+v"(l)); return l; }
__device__ __forceinline__ float my_shfl_idx(float v, int src) { return __builtin_bit_cast(float, __builtin_amdgcn_ds_bpermute(src << 2, __builtin_bit_cast(int, v))); }
__device__ __forceinline__ int my_shfl_idx(int v, int src) { return __builtin_amdgcn_ds_bpermute(src << 2, v); }
template <class V> __device__ __forceinline__ V my_shfl_xor(V v, int o) { return my_shfl_idx(v, lane_now() ^ o); }
template <class V> __device__ __forceinline__ V my_shfl_up(V v, int o) { const int l = lane_now(); return my_shfl_idx(v, l >= o ? l - o : l); }
#define __shfl_xor(v, o) my_shfl_xor(v, o)
#define __shfl_up(v, o) my_shfl_up(v, o)
#define __shfl(v, s) my_shfl_idx(v, s)
__device__ __forceinline__ float wave_sum(float v) {
#pragma unroll
    for (int o = 1; o < 64; o <<= 1) v += __shfl_xor(v, o);
    return v;
}
__device__ __forceinline__ float wave_max(float v) {
#pragma unroll
    for (int o = 1; o < 64; o <<= 1) v = fmaxf(v, __shfl_xor(v, o));
    return v;
}
__device__ __forceinline__ float wave_scan_add(float v, int lane) {
#pragma unroll
    for (int o = 1; o < 64; o <<= 1) { const float t = __shfl_up(v, o); if (lane >= o) v += t; }
    return v;
}
__device__ __forceinline__ float wave_scan_max(float v, int lane) {
#pragma unroll
    for (int o = 1; o < 64; o <<= 1) { const float t = __shfl_up(v, o); if (lane >= o) v = fmaxf(v, t); }
    return v;
}
__device__ __forceinline__ f32x4 mm16(const LAS unsigned char* A, int lda, const LAS unsigned char* B, int ldb, int K, f32x4 acc, int fr, int fq) {
    const LAS unsigned char* ap = A + fr * lda + fq * 16; const LAS unsigned char* bp = B + fr * ldb + fq * 16;
    for (int k = 0; k < K; k += 32) {
        const bf16x8 a = *(const LAS bf16x8*)(ap + k * 2); const bf16x8 b = *(const LAS bf16x8*)(bp + k * 2);
        acc = __builtin_amdgcn_mfma_f32_16x16x32_bf16(b, a, acc, 0, 0, 0);
    }
    return acc;
}
__device__ __forceinline__ f32x4 mm16_gB(const LAS unsigned char* A, int lda, const float* B, int ldb, int K, f32x4 acc, int fr, int fq) {
    const LAS unsigned char* ap = A + fr * lda + fq * 16; const float* bp = B + (size_t)fr * ldb + fq * 8;
    for (int k = 0; k < K; k += 32) {
        const bf16x8 a = *(const LAS bf16x8*)(ap + k * 2);
        const f32x4 b0 = *(const f32x4*)(bp + k), b1 = *(const f32x4*)(bp + k + 4);
        v4u bw; bw.x = cvt_pk_bf16(b0.x, b0.y); bw.y = cvt_pk_bf16(b0.z, b0.w); bw.z = cvt_pk_bf16(b1.x, b1.y); bw.w = cvt_pk_bf16(b1.z, b1.w);
        const bf16x8 b = __builtin_bit_cast(bf16x8, bw);
        acc = __builtin_amdgcn_mfma_f32_16x16x32_bf16(b, a, acc, 0, 0, 0);
    }
    return acc;
}
__device__ __forceinline__ f32x4 mm16_gAB(const bf16* A, int lda, const bf16* B, int ldb, int K, f32x4 acc, int fr, int fq) {
    const bf16* ap = A + (size_t)fr * lda + fq * 8; const bf16* bp = B + (size_t)fr * ldb + fq * 8;
    for (int k = 0; k < K; k += 32) { const bf16x8 a = *(const bf16x8*)(ap + k), b = *(const bf16x8*)(bp + k); acc = __builtin_amdgcn_mfma_f32_16x16x32_bf16(b, a, acc, 0, 0, 0); }
    return acc;
}
__device__ __forceinline__ bf16x8 ldfrag_f32(const float* p) { const f32x4 b0 = *(const f32x4*)p, b1 = *(const f32x4*)(p + 4);
    v4u bw; bw.x = cvt_pk_bf16(b0.x, b0.y); bw.y = cvt_pk_bf16(b0.z, b0.w); bw.z = cvt_pk_bf16(b1.x, b1.y); bw.w = cvt_pk_bf16(b1.z, b1.w); return __builtin_bit_cast(bf16x8, bw); }
template <int NK> __device__ __forceinline__ f32x4 mm16_rB(const LAS unsigned char* A, int lda, const bf16x8 (&b)[NK], f32x4 acc, int fr, int fq) {
    const LAS unsigned char* ap = A + fr * lda + fq * 16;
#pragma unroll
    for (int k = 0; k < NK; ++k) { const bf16x8 a = *(const LAS bf16x8*)(ap + k * 64); acc = __builtin_amdgcn_mfma_f32_16x16x32_bf16(b[k], a, acc, 0, 0, 0); }
    return acc;
}
__device__ __forceinline__ v4u pack8(const float (&v)[8]) { v4u o; o.x = cvt_pk_bf16(v[0], v[1]); o.y = cvt_pk_bf16(v[2], v[3]); o.z = cvt_pk_bf16(v[4], v[5]); o.w = cvt_pk_bf16(v[6], v[7]); return o; }

#define XB_TMO      128
#define XB_XCNT(j)  (256  + 64 * (j))
#define XB_XSUB(j)  (1280 + 64 * (j))
#define XB_XGEN(j)  (2304 + 64 * (j))
#define XB_TOP      3328
#define XB_TOPGEN   3392
#define XCD_BAR_WORDS 3456
#define XB_SPIN_CAP (1u << 18)
__device__ __forceinline__ unsigned xb_ld(unsigned* p)              { return __hip_atomic_load(p, __ATOMIC_RELAXED, __HIP_MEMORY_SCOPE_AGENT); }
__device__ __forceinline__ unsigned xb_add(unsigned* p, unsigned v) { return __hip_atomic_fetch_add(p, v, __ATOMIC_RELAXED, __HIP_MEMORY_SCOPE_AGENT); }
__device__ __forceinline__ unsigned xb_xcc_id() { return (unsigned)__builtin_amdgcn_s_getreg((3 << 11) | 20) & 0xFu; }
#define XB_SPIN(cond, bar) do { unsigned _sp = 0; while (cond) { __builtin_amdgcn_s_sleep(1); \
    if ((++_sp & 255u) == 0u) { if (xb_ld(&(bar)[XB_TMO])) break; if (_sp > XB_SPIN_CAP) { atomicAdd(&(bar)[XB_TMO], 1u); break; } } } } while (0)
struct XcdBarrier { unsigned* bar; unsigned x; volatile LAS unsigned* st; };
__device__ __forceinline__ XcdBarrier xcd_barrier_post(unsigned* bar, volatile LAS unsigned* st) {
    XcdBarrier b; b.bar = bar; b.x = xb_xcc_id(); b.st = st;
    if (threadIdx.x == 0) (void)xb_add(&bar[XB_XCNT(b.x)], 1u);
    return b;
}
__device__ __forceinline__ void xcd_barrier_complete(unsigned* bar, unsigned x, unsigned& nloc, unsigned& nx) {
    const unsigned G = gridDim.x * gridDim.y * gridDim.z;
    unsigned sum, cnt, mine, sp = 0u;
    for (;;) {
        sum = 0u; cnt = 0u; mine = 0u;
#pragma unroll
        for (unsigned j = 0; j < 16; ++j) { const unsigned c = xb_ld(&bar[XB_XCNT(j)]); sum += c; cnt += (c > 0u) ? 1u : 0u; mine = (j == x) ? c : mine; }
        if (sum == G) break;
        __builtin_amdgcn_s_sleep(1);
        if ((++sp & 255u) == 0u) { if (xb_ld(&bar[XB_TMO])) break; if (sp > XB_SPIN_CAP) { atomicAdd(&bar[XB_TMO], 1u); break; } }
    }
    nloc = mine > 0u ? mine : 1u; nx = cnt > 0u ? cnt : 1u;
}
__device__ __forceinline__ void xcd_barrier(const XcdBarrier& b) {
    asm volatile("s_waitcnt vmcnt(0)" ::: "memory");
    __syncthreads();
    if (threadIdx.x == 0) {
        unsigned* bar = b.bar;
        __builtin_amdgcn_s_waitcnt(0);
        unsigned nloc = b.st[0], nx = b.st[1];
        if (nloc == 0u) { xcd_barrier_complete(bar, b.x, nloc, nx); b.st[0] = nloc; b.st[1] = nx; }
        const unsigned old = xb_add(&bar[XB_XSUB(b.x)], 1u);
        const unsigned gen = old / nloc;
        if (old + 1u == (gen + 1u) * nloc) {
            __builtin_amdgcn_fence(__ATOMIC_RELEASE, "agent");
            asm volatile("s_waitcnt vmcnt(0)" ::: "memory");
            const unsigned og = xb_add(&bar[XB_TOP], 1u);
            const unsigned tg = og / nx;
            if (og + 1u == (tg + 1u) * nx) xb_add(&bar[XB_TOPGEN], 1u);
            else XB_SPIN(xb_ld(&bar[XB_TOPGEN]) == tg, bar);
            __builtin_amdgcn_fence(__ATOMIC_ACQUIRE, "agent");
            xb_add(&bar[XB_XGEN(b.x)], 1u);
            asm volatile("s_waitcnt vmcnt(0)" ::: "memory");
        } else {
            XB_SPIN(xb_ld(&bar[XB_XGEN(b.x)]) == gen, bar);
            __builtin_amdgcn_fence(__ATOMIC_ACQUIRE, "agent");
            asm volatile("s_waitcnt vmcnt(0)" ::: "memory");
        }
    }
    __syncthreads();
}

namespace pg8 {
constexpr int BM = 256, BK = 64, HALF = 128, HTB = HALF * BK * 2, STAGE_BYTES = 8 * HTB, NXCD = 8, WGM = 8;
__host__ __device__ __forceinline__ int lds_byte(int r, int c) { const int st = (r >> 4) * 2 + (c >> 5), rr = r & 15, cc = c & 31, ob = rr * 64 + cc * 2; return st * 1024 + (ob ^ (((ob >> 9) & 1) << 5)); }
__host__ __device__ __forceinline__ void stage_rc(int b, int& R, int& C) { const int st = b / 1024, sb = b % 1024, swz = sb ^ (((sb >> 9) & 1) << 5); R = (st >> 1) * 16 + swz / 64; C = (st & 1) * 32 + (swz % 64) / 2; }
__host__ __device__ __forceinline__ int perm32(int rho) { const int n = rho >> 4, i = rho & 15; return 8 * (i >> 2) + 4 * n + (i & 3); }

template <class Epi, class Sched>
__device__ __forceinline__ void gemm_phase(LAS unsigned char* lds, const int tid, const Sched& S, const Epi& E) {
    const int wid = __builtin_amdgcn_readfirstlane(tid >> 6), lane = tid & 63, wr = wid >> 2, wc = wid & 3, fr = lane & 15, fq = lane >> 4;
    const int K = S.K, nt = K / BK;
    unsigned voffB[2];
#pragma unroll
    for (int i = 0; i < 2; ++i) { int R, C; stage_rc(tid * 16 + i * 8192, R, C); const int Rb = Epi::PERM ? ((R & ~31) + perm32(R & 31)) : R; voffB[i] = (unsigned)(Rb * K + C) * 2u; }
    const size_t kstep = (size_t)(BK * 2);
    const size_t hstepB = S.hstepB;
    const unsigned ldsw = (unsigned)wid * 1024u;
    constexpr bool F8 = Sched::FP8;
    const int aoff = F8 ? lds_byte(wr * 64 + fr, fq * 16) : lds_byte(wr * 64 + fr, fq * 8), boff = F8 ? lds_byte(wc * 32 + fr, fq * 16) : lds_byte(wc * 32 + fr, fq * 8);
#define PG8_SA(b, h) (((b) * 2 + (h)) * HTB)
#define PG8_SB(b, h) ((4 + (b) * 2 + (h)) * HTB)
#define PG8_STAGE_B(bufoff, gbase) do { _Pragma("unroll") for (int _i = 0; _i < 2; ++_i) \
        __builtin_amdgcn_global_load_lds((const unsigned*)((const char*)(gbase) + voffB[_i]), (LAS unsigned*)(lds + (bufoff) + ldsw + _i * 8192), 16, 0, 0); } while (0)
#define PG8_STAGE_A(bufoff, gbase, v0, v1) do { \
        __builtin_amdgcn_global_load_lds((const unsigned*)((const char*)(gbase) + (v0)), (LAS unsigned*)(lds + (bufoff) + ldsw), 16, 0, 0); \
        __builtin_amdgcn_global_load_lds((const unsigned*)((const char*)(gbase) + (v1)), (LAS unsigned*)(lds + (bufoff) + ldsw + 8192), 16, 0, 0); } while (0)
#define PG8_FOFF(k) (F8 ? (k) * 16 : (k) * 1024)
#define PG8_LDA(dst, b, h) do { _Pragma("unroll") for (int m = 0; m < 4; ++m) { if constexpr (F8) dst##8[m] = *(const LAS v8i_t*)(lds + PG8_SA(b, h) + aoff + m * 2048); \
        else { _Pragma("unroll") for (int k = 0; k < 2; ++k) dst[m][k] = *(const LAS bf16x8*)(lds + PG8_SA(b, h) + aoff + m * 2048 + k * 1024); } } } while (0)
#define PG8_LDB(dst, b, h) do { _Pragma("unroll") for (int n = 0; n < 2; ++n) { if constexpr (F8) dst##8[n] = *(const LAS v8i_t*)(lds + PG8_SB(b, h) + boff + n * 2048); \
        else { _Pragma("unroll") for (int k = 0; k < 2; ++k) dst[n][k] = *(const LAS bf16x8*)(lds + PG8_SB(b, h) + boff + n * 2048 + k * 1024); } } } while (0)
#define PG8_CAT(x) __builtin_shufflevector(__builtin_bit_cast(v4i_t, x[0]), __builtin_bit_cast(v4i_t, x[1]), 0, 1, 2, 3, 4, 5, 6, 7)
#define PG8_MMA(ai, bj, At, Bt) do { __builtin_amdgcn_s_setprio(1); _Pragma("unroll") for (int m = 0; m < 4; ++m) _Pragma("unroll") for (int n = 0; n < 2; ++n) { \
        if constexpr (F8) acc[ai][bj][m][n] = __builtin_amdgcn_mfma_scale_f32_16x16x128_f8f6f4(Bt##8[n], At##8[m], acc[ai][bj][m][n], 0, 0, 0, S.scaleB, 0, S.scaleA); \
        else { _Pragma("unroll") for (int k = 0; k < 2; ++k) acc[ai][bj][m][n] = __builtin_amdgcn_mfma_f32_16x16x32_bf16(Bt[n][k], At[m][k], acc[ai][bj][m][n], 0, 0, 0); } } __builtin_amdgcn_s_setprio(0); } while (0)
#define PG8_WAIT_V(n) asm volatile("s_waitcnt vmcnt(" #n ")" ::: "memory")
#define PG8_WAIT_L(n) asm volatile("s_waitcnt lgkmcnt(" #n ")" ::: "memory")
#define PG8_BAR __builtin_amdgcn_s_barrier()
#define PG8_SCHED __builtin_amdgcn_sched_barrier(0)
    typename Sched::Unit cur, nxt; int ui = 0;
    if (!S.next(0, cur)) return;
    f32x4 acc[2][2][4][2];
#pragma unroll
    for (int a = 0; a < 2; ++a)
#pragma unroll
        for (int b = 0; b < 2; ++b)
#pragma unroll
            for (int m = 0; m < 4; ++m)
#pragma unroll
                for (int n = 0; n < 2; ++n) acc[a][b][m][n] = (f32x4){0.f, 0.f, 0.f, 0.f};
    bf16x8 At[4][2], B0[2][2], B1[2][2]; v8i_t At8[4], B08[2], B18[2];
    constexpr bool GA = Sched::GATHER;
    const size_t hstepA = GA ? (size_t)0 : (size_t)HALF * K * 2;
    unsigned vA[2][2];
    LAS unsigned char* hdr = lds + STAGE_BYTES;
    if constexpr (Sched::HDR) { if (wid == 0) S.hdr_issue(cur, hdr, lane); PG8_WAIT_V(0); PG8_BAR; }
    S.a_off(cur, tid, vA, hdr);
#define PG8_STAGE_AH(bufoff, base, vv, h) PG8_STAGE_A(bufoff, ((base) + (h) * hstepA), vv[GA ? (h) : 0][0], vv[GA ? (h) : 0][1])
    const char* cA = S.a_base(cur); const char* cB = S.b_base(cur);
    PG8_STAGE_B(PG8_SB(0, 0), cB); PG8_STAGE_B(PG8_SB(0, 1), cB + hstepB); PG8_STAGE_AH(PG8_SA(0, 0), cA, vA, 0); PG8_STAGE_AH(PG8_SA(0, 1), cA, vA, 1);
    if (wr == 1) PG8_BAR;
    PG8_WAIT_V(2); PG8_BAR;
    PG8_STAGE_B(PG8_SB(1, 0), cB + kstep); PG8_STAGE_AH(PG8_SA(1, 0), cA + kstep, vA, 0); PG8_STAGE_B(PG8_SB(1, 1), cB + hstepB + kstep);
    PG8_WAIT_V(6); PG8_BAR;
    int hc = 0;
    for (;;) {
        const bool has_next = S.next(ui + 1, nxt); const int hn = (hc == 2) ? 0 : hc + 1;
        const char* nA = cA; const char* nB = cB;
        if (has_next) { nA = S.a_base(nxt); nB = S.b_base(nxt); if constexpr (Sched::HDR) { if (wid == 0) S.hdr_issue(nxt, hdr + hn * 4096, lane); } }
        for (int t = 0; t < nt; t += 2) {
            const bool last = (t == nt - 2);
            const char* a1 = cA + (size_t)(t + 1) * kstep;
            const char* a2 = last ? nA : cA + (size_t)(t + 2) * kstep; const char* b2 = last ? nB : cB + (size_t)(t + 2) * kstep;
            const char* a3 = a2 + kstep; const char* b3 = b2 + kstep;
            PG8_LDB(B0, 0, 0); PG8_LDB(B1, 0, 1); PG8_SCHED; PG8_LDA(At, 0, 0); PG8_STAGE_AH(PG8_SA(1, 1), a1, vA, 1);
            if constexpr (GA) { if (last && has_next) S.a_off(nxt, tid, vA, hdr + hn * 4096); }
            PG8_WAIT_V(8); PG8_WAIT_L(0); PG8_BAR; PG8_MMA(0, 0, At, B0); PG8_MMA(0, 1, At, B1); PG8_BAR; PG8_SCHED;
            PG8_LDA(At, 0, 1); PG8_STAGE_B(PG8_SB(0, 0), b2); PG8_STAGE_B(PG8_SB(0, 1), b2 + hstepB); PG8_STAGE_AH(PG8_SA(0, 0), a2, vA, 0);
            PG8_WAIT_V(8); PG8_WAIT_L(0); PG8_BAR; PG8_MMA(1, 0, At, B0); PG8_MMA(1, 1, At, B1); PG8_BAR; PG8_SCHED;
            PG8_LDB(B0, 1, 0); PG8_LDB(B1, 1, 1); PG8_SCHED; PG8_LDA(At, 1, 0); PG8_STAGE_AH(PG8_SA(0, 1), a2, vA, 1);
            PG8_WAIT_V(8); PG8_WAIT_L(0); PG8_BAR; PG8_MMA(0, 0, At, B0); PG8_MMA(0, 1, At, B1); PG8_BAR; PG8_SCHED;
            PG8_LDA(At, 1, 1); PG8_STAGE_B(PG8_SB(1, 0), b3); PG8_STAGE_B(PG8_SB(1, 1), b3 + hstepB); PG8_STAGE_AH(PG8_SA(1, 0), a3, vA, 0);
            PG8_WAIT_V(8); PG8_WAIT_L(0); PG8_BAR; PG8_MMA(1, 0, At, B0); PG8_MMA(1, 1, At, B1); PG8_BAR; PG8_SCHED;
        }
        if (wr == 0) PG8_BAR;
        { int fr_ = fr, fq_ = fq; asm volatile("" : "+v"(fr_), "+v"(fq_)); E(acc, cur, wr, wc, fr_, fq_, hdr + hc * 4096); }
        if (!has_next) break;
#pragma unroll
        for (int a = 0; a < 2; ++a)
#pragma unroll
            for (int b = 0; b < 2; ++b)
#pragma unroll
                for (int m = 0; m < 4; ++m)
#pragma unroll
                    for (int n = 0; n < 2; ++n) acc[a][b][m][n] = (f32x4){0.f, 0.f, 0.f, 0.f};
        cur = nxt; cA = nA; cB = nB; ++ui; hc = hn;
        if (wr == 1) PG8_BAR;
    }
    PG8_WAIT_V(0);
    PG8_BAR;
#undef PG8_SA
#undef PG8_SB
#undef PG8_STAGE_A
#undef PG8_STAGE_AH
#undef PG8_STAGE_B
#undef PG8_LDA
#undef PG8_LDB
#undef PG8_MMA
#undef PG8_CAT
#undef PG8_FOFF
#undef PG8_WAIT_V
#undef PG8_WAIT_L
#undef PG8_BAR
#undef PG8_SCHED
}
}
struct Args { const float* in[N_IN]; float* out; unsigned char* ws; int ph_lo, ph_hi; };
typedef const __attribute__((address_space(4))) unsigned long long* karg_t;
struct Frame {
    karg_t ka;
    LAS unsigned char* lds;
    volatile LAS unsigned* MISC;
    gu32* ctl;
    unsigned char* ws;
    float* out;
    int tid, lane, wave, vcu, G;
};
#define WSP(T_, off) ((T_*)(F.ws + (off)))
#define KIN(k) ((const float*)F.ka[(k)])
#ifdef DBG_SEL
#define DBG_STAT(k, val) do { const float _v = (val); if ((k) == DBG_SEL) { if (fabsf(_v) < 3e38f) atomicMax((unsigned*)(F.ctl + CW_DBG), __float_as_uint(fabsf(_v))); else atomicAdd((unsigned*)(F.ctl + CW_DBG + 1), 1u); } } while (0)
#else
#define DBG_STAT(k, val) do { } while (0)
#endif
template <class P> __device__ __forceinline__ P launder_uniform(P p) {
    unsigned lo = (unsigned)(unsigned long long)p, hi = (unsigned)((unsigned long long)p >> 32);
    asm volatile("" : "+v"(lo), "+v"(hi));
    lo = __builtin_amdgcn_readfirstlane(lo); hi = __builtin_amdgcn_readfirstlane(hi);
    return (P)(((unsigned long long)hi << 32) | lo);
}
__device__ __forceinline__ void frame_refresh(Frame& F) {
    int t = F.tid; asm volatile("" : "+v"(t)); F.tid = t; F.lane = t & 63; F.wave = __builtin_amdgcn_readfirstlane(t >> 6);
    F.ws = launder_uniform(F.ws); F.ctl = (gu32*)(F.ws + WS_CTL);
    F.out = launder_uniform(F.out);
    F.ka = launder_uniform(F.ka);
}

namespace pg8 {
struct DenseSched {
    static constexpr bool GATHER = false, FP8 = false, HDR = false; static constexpr int scaleA = 0, scaleB = 0;
    struct Unit { int pm, pn; };
    __device__ __forceinline__ void hdr_issue(const Unit&, LAS unsigned char*, int) const {}
    const bf16* A; const bf16* Bt; int K; size_t hstepB; int nM, nN, nwg, G, c;
    __device__ __forceinline__ void init(const bf16* A_, const bf16* Bt_, int M, int N, int K_, int G_, int c_) { A = A_; Bt = Bt_; K = K_; hstepB = (size_t)HALF * K_ * 2; nM = M / BM; nN = N / BM; nwg = nM * nN; G = G_; c = c_; }
    __device__ __forceinline__ bool next(int i, Unit& u) const {
        const long L = (long)i * G + c; if (L >= nwg) return false;
        int wgid = (int)L; { const int q = nwg / NXCD, r = nwg % NXCD, xcd = wgid % NXCD, off = wgid / NXCD; wgid = (xcd < r ? xcd * (q + 1) : r * (q + 1) + (xcd - r) * q) + off; }
        const int nig = WGM * nN, gid = wgid / nig, fm = gid * WGM, gsz = (nM - fm) < WGM ? (nM - fm) : WGM;
        u.pm = fm + ((wgid % nig) % gsz); u.pn = (wgid % nig) / gsz; return true;
    }
    __device__ __forceinline__ const char* a_base(const Unit& u) const { return (const char*)A + (size_t)u.pm * BM * K * 2; }
    __device__ __forceinline__ const char* b_base(const Unit& u) const { return (const char*)Bt + (size_t)u.pn * BM * K * 2; }
    __device__ __forceinline__ void a_off(const Unit&, int tid, unsigned (&v)[2][2], const LAS unsigned char*) const {
#pragma unroll
        for (int i = 0; i < 2; ++i) { int R, C; stage_rc(tid * 16 + i * 8192, R, C); v[0][i] = (unsigned)(R * K + C) * 2u; v[1][i] = v[0][i]; }
    }
};
template <int SB> struct DenseSched8T : DenseSched { static constexpr bool GATHER = true, FP8 = true; static constexpr int scaleA = 0x7F7F7F7F, scaleB = SB;
    __device__ __forceinline__ void a_off(const Unit&, int tid, unsigned (&v)[2][2], const LAS unsigned char*) const {
        int t_ = tid; asm volatile("" : "+v"(t_));
#pragma unroll
        for (int i = 0; i < 2; ++i) { int R, C; stage_rc(t_ * 16 + i * 8192, R, C); v[0][i] = (unsigned)(R * K + C) * 2u; v[1][i] = v[0][i] + (unsigned)(HALF * K * 2); }
    }
};
typedef DenseSched8T<0x7A7A7A7A> DenseSched8;
typedef DenseSched8T<0x79797979> DenseSched8b;
struct MoeUnit { int e, mt, nt, cnt; };
struct MoeOrder {
    const volatile LAS unsigned* pfx;
    int NT, G, c;
    __device__ __forceinline__ bool decode(int i, MoeUnit& u) const {
        const int nwg = (int)pfx[32]; const long L = (long)i * G + c; if (L >= nwg) return false;
        int wgid = (int)L; { const int q = nwg / NXCD, r = nwg % NXCD, xcd = wgid % NXCD, off = wgid / NXCD; wgid = (xcd < r ? xcd * (q + 1) : r * (q + 1) + (xcd - r) * q) + off; }
        int e = 0;
#pragma unroll
        for (int st = 16; st >= 1; st >>= 1) e += ((int)pfx[e + st] <= wgid) ? st : 0;
        const int j = wgid - (int)pfx[e];
        u.e = e; u.mt = j / NT; u.nt = j % NT; u.cnt = (int)pfx[40 + e]; return true;
    }
};
#ifndef HDR_AOFF
#define HDR_AOFF 1
#endif
struct Moe1Sched {
    static constexpr bool GATHER = true, FP8 = (MOE_FP8 != 0), HDR = true; static constexpr int EB = FP8 ? 1 : 2; static constexpr int scaleA = 0x7F7F7F7F, scaleB = 0x7A7A7A7A;
    typedef MoeUnit Unit;
    MoeOrder O; const unsigned char* X; const unsigned char* W; const int* sdest; const float* bgu; int K; size_t hstepB;
    __device__ __forceinline__ void hdr_issue(const Unit& u, LAS unsigned char* hdr, int lane) const {
        __builtin_amdgcn_global_load_lds((const unsigned*)(sdest + (size_t)u.e * ECAP + (size_t)u.mt * 256 + lane * 4), (LAS unsigned*)hdr, 16, 0, 0);
        const float* bp = bgu + (size_t)u.e * 2048 + u.nt * 128 + (lane < 32 ? lane * 4 : 1024 + (lane - 32) * 4);
        __builtin_amdgcn_global_load_lds((const unsigned*)bp, (LAS unsigned*)(hdr + 1024), 16, 0, 0);
    }
    __device__ __forceinline__ bool next(int i, Unit& u) const { return O.decode(i, u); }
    __device__ __forceinline__ const char* a_base(const Unit&) const { return (const char*)X; }
    __device__ __forceinline__ const char* b_base(const Unit& u) const { return (const char*)W + ((size_t)u.e * 2048 + (size_t)u.nt * 128) * 1024 * EB; }
    __device__ __forceinline__ void a_off(const Unit& u, int tid, unsigned (&v)[2][2], const LAS unsigned char* hdr) const {
#pragma unroll
        for (int i = 0; i < 2; ++i) { int R, C; stage_rc(tid * 16 + i * 8192, R, C);
#pragma unroll
            for (int h = 0; h < 2; ++h) { const int sl = h * HALF + R; int tok = 0; if (u.mt * 256 + sl < u.cnt) tok = HDR_AOFF ? (((const LAS int*)hdr)[sl] >> 2) : (sdest[u.e * ECAP + u.mt * 256 + sl] >> 2); v[h][i] = (unsigned)(tok * 1024 * EB + C * 2); } }
    }
};
struct Moe2Sched {
    static constexpr bool GATHER = true, FP8 = (MOE2_FP8 != 0), HDR = true; static constexpr int EB = FP8 ? 1 : 2; static constexpr int scaleA = 0x7F7F7F7F, scaleB = 0x79797979;
    typedef MoeUnit Unit;
    MoeOrder O; const unsigned char* Ab; const unsigned char* W; const int* sdest; const float* sgate; const float* bdn; int K; size_t hstepB;
    __device__ __forceinline__ void hdr_issue(const Unit& u, LAS unsigned char* hdr, int lane) const {
        const size_t so = (size_t)u.e * ECAP + (size_t)u.mt * 256 + lane * 4;
        __builtin_amdgcn_global_load_lds((const unsigned*)(sdest + so), (LAS unsigned*)hdr, 16, 0, 0);
        __builtin_amdgcn_global_load_lds((const unsigned*)(sgate + so), (LAS unsigned*)(hdr + 1024), 16, 0, 0);
        __builtin_amdgcn_global_load_lds((const unsigned*)(bdn + (size_t)u.e * 1024 + u.nt * 256 + lane * 4), (LAS unsigned*)(hdr + 2048), 16, 0, 0);
    }
    __device__ __forceinline__ bool next(int i, Unit& u) const { return O.decode(i, u); }
    __device__ __forceinline__ const char* a_base(const Unit& u) const { return (const char*)Ab + ((size_t)u.e * ECAP + (size_t)u.mt * 256) * 1024 * EB; }
    __device__ __forceinline__ const char* b_base(const Unit& u) const { return (const char*)W + ((size_t)u.e * 1024 + (size_t)u.nt * 256) * 1024 * EB; }
    __device__ __forceinline__ void a_off(const Unit&, int tid, unsigned (&v)[2][2], const LAS unsigned char*) const {
        int t_ = tid; asm volatile("" : "+v"(t_));
#pragma unroll
        for (int i = 0; i < 2; ++i) { int R, C; stage_rc(t_ * 16 + i * 8192, R, C); v[0][i] = (unsigned)(R * 1024 * EB + C * 2); v[1][i] = v[0][i] + (unsigned)(HALF * 1024 * EB); }
    }
};

__device__ __forceinline__ void unpack8(const v4u w, f32x4& a, f32x4& b) {
    a = (f32x4){__uint_as_float(w.x << 16), __uint_as_float(w.x & 0xffff0000u), __uint_as_float(w.y << 16), __uint_as_float(w.y & 0xffff0000u)};
    b = (f32x4){__uint_as_float(w.z << 16), __uint_as_float(w.z & 0xffff0000u), __uint_as_float(w.w << 16), __uint_as_float(w.w & 0xffff0000u)}; }
struct EpiF32 {
    static constexpr bool PERM = false;
    float* C; int ldc; const float* base; float alpha;
    __device__ __forceinline__ void operator()(const f32x4 (&acc)[2][2][4][2], const DenseSched::Unit& u, int wr, int wc, int fr, int fq, const LAS unsigned char* hdr) const {
        const int row0 = u.pm * BM + wr * 64 + fr, col0 = u.pn * BM + wc * 32 + 4 * fq;
#pragma unroll
        for (int ai = 0; ai < 2; ++ai)
#pragma unroll
            for (int m = 0; m < 4; ++m) { const size_t ro = (size_t)(row0 + ai * HALF + m * 16) * ldc + col0;
#pragma unroll
                for (int bj = 0; bj < 2; ++bj)
#pragma unroll
                    for (int n = 0; n < 2; ++n) { f32x4 v = acc[ai][bj][m][n];
                        if (base) { const f32x4 b = *(const f32x4*)(base + ro + bj * HALF + n * 16); v = v + b * alpha; }
                        *(f32x4*)(C + ro + bj * HALF + n * 16) = v; } }
    }
};
struct EpiB16 {
    static constexpr bool PERM = true;
    bf16* O; int ldc; const bf16* base; float alpha;
    __device__ __forceinline__ void operator()(const f32x4 (&acc)[2][2][4][2], const DenseSched::Unit& u, int wr, int wc, int fr, int fq, const LAS unsigned char* hdr) const {
        const int row0 = u.pm * BM + wr * 64 + fr, col0 = u.pn * BM + wc * 32 + 8 * fq;
#pragma unroll
        for (int ai = 0; ai < 2; ++ai) {
            v4u bw[4][2];
            if (base) {
#pragma unroll
                for (int m = 0; m < 4; ++m)
#pragma unroll
                    for (int bj = 0; bj < 2; ++bj) bw[m][bj] = *(const v4u*)(base + (size_t)(row0 + ai * HALF + m * 16) * ldc + col0 + bj * HALF); }
#pragma unroll
            for (int m = 0; m < 4; ++m) { bf16* rowp = O + (size_t)(row0 + ai * HALF + m * 16) * ldc + col0;
#pragma unroll
                for (int bj = 0; bj < 2; ++bj) { f32x4 v0 = acc[ai][bj][m][0], v1 = acc[ai][bj][m][1];
                    if (base) { f32x4 b0, b1; unpack8(bw[m][bj], b0, b1); v0 = v0 + b0 * alpha; v1 = v1 + b1 * alpha; }
                    v4u w; w.x = cvt_pk_bf16(v0[0], v0[1]); w.y = cvt_pk_bf16(v0[2], v0[3]); w.z = cvt_pk_bf16(v1[0], v1[1]); w.w = cvt_pk_bf16(v1[2], v1[3]);
                    *(v4u*)(rowp + bj * HALF) = w; } } }
    }
};
struct EpiPle {
    static constexpr bool PERM = true;
    bf16* C; const bf16* hb; const bf16* pe;
    __device__ __forceinline__ void operator()(const f32x4 (&acc)[2][2][4][2], const DenseSched::Unit& u, int wr, int wc, int fr, int fq, const LAS unsigned char* hdr) const {
        const int row0 = u.pm * BM + wr * 64 + fr, col0 = u.pn * BM + wc * 32 + 8 * fq;
#pragma unroll
        for (int ai = 0; ai < 2; ++ai) {
            v4u hw[4][2], pw[4][2];
#pragma unroll
            for (int m = 0; m < 4; ++m)
#pragma unroll
                for (int bj = 0; bj < 2; ++bj) { const size_t ro = (size_t)(row0 + ai * HALF + m * 16) * 1024 + col0 + bj * HALF; hw[m][bj] = *(const v4u*)(hb + ro); pw[m][bj] = *(const v4u*)(pe + ro); }
#pragma unroll
            for (int m = 0; m < 4; ++m)
#pragma unroll
                for (int bj = 0; bj < 2; ++bj) { const size_t ro = (size_t)(row0 + ai * HALF + m * 16) * 1024 + col0 + bj * HALF;
                    f32x4 h0, h1, p0, p1; unpack8(hw[m][bj], h0, h1); unpack8(pw[m][bj], p0, p1); const f32x4 a0 = acc[ai][bj][m][0], a1 = acc[ai][bj][m][1];
                    f32x4 o0, o1;
#pragma unroll
                    for (int j = 0; j < 4; ++j) { o0[j] = h0[j] + sigmoidf_(a0[j]) * p0[j]; o1[j] = h1[j] + sigmoidf_(a1[j]) * p1[j]; }
                    v4u w; w.x = cvt_pk_bf16(o0[0], o0[1]); w.y = cvt_pk_bf16(o0[2], o0[3]); w.z = cvt_pk_bf16(o1[0], o1[1]); w.w = cvt_pk_bf16(o1[2], o1[3]);
                    *(v4u*)(C + ro) = w; } }
    }
};
struct EpiMoe1 {
    static constexpr bool PERM = true;
    bf16* Ab; const float* bgu; unsigned char* AbQ;
    __device__ __forceinline__ void operator()(const f32x4 (&acc)[2][2][4][2], const MoeUnit& u, int wr, int wc, int fr, int fq, const LAS unsigned char* hdr) const {
        const int col0 = u.nt * 128 + wc * 32 + 8 * fq;
        const LAS float* bh = (const LAS float*)(hdr + 1024) + wc * 32 + 8 * fq;
        const f32x4 bg0 = *(const LAS f32x4*)(bh), bg1 = *(const LAS f32x4*)(bh + 4), bl0 = *(const LAS f32x4*)(bh + 128), bl1 = *(const LAS f32x4*)(bh + 132);
#pragma unroll
        for (int ai = 0; ai < 2; ++ai)
#pragma unroll
            for (int m = 0; m < 4; ++m) { const int r = ai * HALF + wr * 64 + m * 16 + fr;
                bf16* rowp = Ab + ((size_t)u.e * ECAP + (size_t)u.mt * 256 + r) * 1024 + col0;
                float o[8];
#pragma unroll
                for (int n = 0; n < 2; ++n) { const f32x4 g4 = acc[ai][0][m][n] + (n ? bg1 : bg0), l4 = acc[ai][1][m][n] + (n ? bl1 : bl0);
#pragma unroll
                    for (int j = 0; j < 4; ++j) { const float g = fminf(g4[j], 7.0f), l = fminf(fmaxf(l4[j], -7.0f), 7.0f); o[n * 4 + j] = (l + 1.0f) * g * sigmoidf_(1.702f * g); } }
                if constexpr (MOE2_FP8) { v2u q; q.x = cvt4_fp8(o[0], o[1], o[2], o[3]); q.y = cvt4_fp8(o[4], o[5], o[6], o[7]); *(v2u*)((unsigned char*)AbQ + ((size_t)u.e * ECAP + (size_t)u.mt * 256 + r) * 1024 + col0) = q; }
                else *(v4u*)rowp = pack8(o); }
    }
};
struct EpiMoe2 {
    static constexpr bool PERM = true;
    bf16* Y; const float* bdn; const int* sdest; const float* sgate;
    __device__ __forceinline__ void operator()(const f32x4 (&acc)[2][2][4][2], const MoeUnit& u, int wr, int wc, int fr, int fq, const LAS unsigned char* hdr) const {
        const int col0 = u.nt * 256 + wc * 32 + 8 * fq;
        const LAS float* bp = (const LAS float*)(hdr + 2048) + wc * 32 + 8 * fq;
#pragma unroll
        for (int ai = 0; ai < 2; ++ai) {
            f32x4 bv[2][2];
#pragma unroll
            for (int bj = 0; bj < 2; ++bj)
#pragma unroll
                for (int n = 0; n < 2; ++n) bv[bj][n] = *(const LAS f32x4*)(bp + bj * HALF + 4 * n);
            int dest[4]; float gate[4];
#pragma unroll
            for (int m = 0; m < 4; ++m) { const int sl = ai * HALF + wr * 64 + m * 16 + fr; const bool ok = u.mt * 256 + sl < u.cnt;
                dest[m] = ok ? ((const LAS int*)hdr)[sl] : T * 4; gate[m] = ok ? ((const LAS float*)(hdr + 1024))[sl] : 0.f; }
#pragma unroll
            for (int m = 0; m < 4; ++m) {
                { const float g = gate[m]; bf16* rowp = Y + (size_t)dest[m] * 1024 + col0;
#pragma unroll
                    for (int bj = 0; bj < 2; ++bj) { const f32x4 v0 = (acc[ai][bj][m][0] + bv[bj][0]) * g, v1 = (acc[ai][bj][m][1] + bv[bj][1]) * g;
                        v4u w; w.x = cvt_pk_bf16(v0[0], v0[1]); w.y = cvt_pk_bf16(v0[2], v0[3]); w.z = cvt_pk_bf16(v1[0], v1[1]); w.w = cvt_pk_bf16(v1[2], v1[3]);
                        *(v4u*)(rowp + bj * HALF) = w; } } } }
    }
};
}

__device__ __forceinline__ void p0_transpose_item(const float* W, int K, int N, int nblk, bf16* WT, int item, int lane) {
    const int kb = item / nblk, nb = item % nblk, k0 = 64 * kb, n = 64 * nb + lane;
    const bool ok = n < N; const float* src = W + (size_t)k0 * N + (ok ? n : 0);
    float x[64];
#pragma unroll
    for (int j = 0; j < 64; ++j) x[j] = __builtin_nontemporal_load(src + (size_t)j * N);
    bf16* dst = WT + (size_t)n * K + k0;
#pragma unroll
    for (int q = 0; q < 8; ++q) { v4u o; o.x = cvt_pk_bf16(x[8 * q], x[8 * q + 1]); o.y = cvt_pk_bf16(x[8 * q + 2], x[8 * q + 3]); o.z = cvt_pk_bf16(x[8 * q + 4], x[8 * q + 5]); o.w = cvt_pk_bf16(x[8 * q + 6], x[8 * q + 7]);
        if (!ok) o = (v4u){0u, 0u, 0u, 0u};
        *(v4u*)(dst + 8 * q) = o; }
}
__device__ __forceinline__ void cvt_rows(const float* src, bf16* dst, size_t n8, size_t i0, size_t stride) {
    for (size_t i = i0; i < n8; i += stride) { const f32x4 a = *(const f32x4*)(src + i * 8), b = *(const f32x4*)(src + i * 8 + 4);
        v4u o; o.x = cvt_pk_bf16(a.x, a.y); o.y = cvt_pk_bf16(a.z, a.w); o.z = cvt_pk_bf16(b.x, b.y); o.w = cvt_pk_bf16(b.z, b.w); *(v4u*)(dst + i * 8) = o; }
}
__device__ __forceinline__ void p0_prologue(Frame& F, const Args& A) {
    const int gw = F.vcu * NWAVES + F.wave, NGW = F.G * NWAVES;
    constexpr int I_IN = 16 * (NUP / 64), I_OUT = 16 * 16, I_GU = 16 * 32, I_DN = 16 * 16, I_PG = 16 * 16, I_PP = 4 * 16;
    constexpr int PER_LAYER = I_IN + I_OUT + NE * I_GU + NE * I_DN + I_PG + I_PP;
#pragma unroll 1
    for (int it = gw; it < DEPTH * PER_LAYER; it += NGW) {
        const int l = it / PER_LAYER; int r = it % PER_LAYER;
        const float* W; bf16* WT; int K = D, N = D, nblk = 16;
        if (r < I_IN) { W = KIN(I_WIN) + (size_t)l * D * NU; WT = WSP(bf16, WS_WIN_T) + (size_t)l * NUP * D; N = NU; nblk = NUP / 64; }
        else if ((r -= I_IN) < I_OUT) { if (OUT_FP8) continue; W = KIN(I_WOUT) + (size_t)l * D * D; WT = WSP(bf16, WS_WOUT_T) + (size_t)l * D * D; }
        else if ((r -= I_OUT) < NE * I_GU) { if (MOE_FP8) continue; const int e = r / I_GU; r %= I_GU; W = KIN(I_WGU) + ((size_t)l * NE + e) * D * 2048; WT = WSP(bf16, WS_WGU_T) + ((size_t)l * NE + e) * 2048 * D; N = 2048; nblk = 32; }
        else if ((r -= NE * I_GU) < NE * I_DN) { if (MOE2_FP8) continue; const int e = r / I_DN; r %= I_DN; W = KIN(I_WDN) + ((size_t)l * NE + e) * D * D; WT = WSP(bf16, WS_WDN_T) + ((size_t)l * NE + e) * D * D; }
        else if ((r -= NE * I_DN) < I_PG) { if (PLE_FP8) continue; W = KIN(I_PGW) + (size_t)l * D * D; WT = WSP(bf16, WS_WPG_T) + (size_t)l * D * D; }
        else { r -= I_PG; W = KIN(I_PPJ) + (size_t)l * 256 * D; WT = WSP(bf16, WS_WPP_T) + (size_t)l * D * 256; K = 256; }
        p0_transpose_item(W, K, N, nblk, WT, r, F.lane);
    }
#if MOE_FP8
    constexpr int Q_GU = 16 * 32, Q_DN = 16 * 16, Q_PG = PLE_FP8 ? 16 * 16 : 0, Q_OUT = OUT_FP8 ? 16 * 16 : 0, Q_PER_LAYER = NE * (Q_GU + Q_DN) + Q_PG + Q_OUT;
#pragma unroll 1
    for (int it = gw; it < DEPTH * Q_PER_LAYER; it += NGW) {
        const int l = it / Q_PER_LAYER; int r = it % Q_PER_LAYER; const float* W; unsigned char* WQ; int N; float sc;
        if (r < NE * Q_GU) { const int e = r / Q_GU; r %= Q_GU; W = KIN(I_WGU) + ((size_t)l * NE + e) * D * 2048; WQ = WSP(unsigned char, WS_WGU_Q) + ((size_t)l * NE + e) * 2048 * D; N = 2048; sc = 32.0f; }
        else if (r >= NE * (Q_GU + Q_DN) + Q_PG) { r -= NE * (Q_GU + Q_DN) + Q_PG; W = KIN(I_WOUT) + (size_t)l * D * D; WQ = WSP(unsigned char, WS_WOUT_Q) + (size_t)l * D * D; N = D; sc = 64.0f; }
        else if (r >= NE * (Q_GU + Q_DN)) { r -= NE * (Q_GU + Q_DN); W = KIN(I_PGW) + (size_t)l * D * D; WQ = WSP(unsigned char, WS_WPG_Q) + (size_t)l * D * D; N = D; sc = 32.0f; }
        else { if (!MOE2_FP8) continue; r -= NE * Q_GU; const int e = r / Q_DN; r %= Q_DN; W = KIN(I_WDN) + ((size_t)l * NE + e) * D * D; WQ = WSP(unsigned char, WS_WDN_Q) + ((size_t)l * NE + e) * D * D; N = D; sc = 64.0f; }
        const int nblk = N / 64, kb = r / nblk, nb = r % nblk, k0 = 64 * kb, n = 64 * nb + F.lane;
        const float* src = W + (size_t)k0 * N + n; float x[64];
#pragma unroll
        for (int j = 0; j < 64; ++j) x[j] = __builtin_nontemporal_load(src + (size_t)j * N) * sc;
        unsigned char* dst = WQ + (size_t)n * D + k0;
#pragma unroll
        for (int q = 0; q < 4; ++q) { v4u o; o.x = cvt4_fp8(x[16 * q], x[16 * q + 1], x[16 * q + 2], x[16 * q + 3]); o.y = cvt4_fp8(x[16 * q + 4], x[16 * q + 5], x[16 * q + 6], x[16 * q + 7]);
            o.z = cvt4_fp8(x[16 * q + 8], x[16 * q + 9], x[16 * q + 10], x[16 * q + 11]); o.w = cvt4_fp8(x[16 * q + 12], x[16 * q + 13], x[16 * q + 14], x[16 * q + 15]); *(v4u*)(dst + 16 * q) = o; }
    }
#endif
    const size_t gt = (size_t)F.vcu * (NWAVES * 64) + F.tid, NT_ = (size_t)F.G * NWAVES * 64;
    cvt_rows(KIN(I_P), WSP(bf16, WS_PB), (size_t)DEPTH * T * 256 / 8, gt, NT_);
    cvt_rows(KIN(I_X), WSP(bf16, WS_XB), (size_t)T * D / 8, gt, NT_);
    for (size_t i = gt; i < (size_t)DEPTH * LORA_PER_LAYER; i += NT_) { const int l = (int)(i / LORA_PER_LAYER); int r = (int)(i % LORA_PER_LAYER); float v;
        if (r < 8192) { const int ch = r >> 5, j = r & 31; v = KIN(I_RWUP)[(size_t)l * 8192 + j * 256 + ch]; }
        else if (r < 16384) { r -= 8192; const int ch = r >> 5, j = r & 31; v = KIN(I_RAUP)[(size_t)l * 8192 + j * 256 + ch]; }
        else if (r < 32768) { r -= 16384; const int ch = r >> 6, j = r & 63; v = KIN(I_RGUP)[(size_t)l * 16384 + j * 256 + ch]; }
        else { r -= 32768; const int d = r >> 4, j = r & 15; v = KIN(I_GGUP)[(size_t)l * 2048 + j * 128 + d]; }
        WSP(float, WS_LORA)[i] = v; }
#if P6_MFMA
    for (size_t i = gt; i < (size_t)DEPTH * 32768; i += NT_) { const int l = (int)(i >> 15), r = (int)(i & 32767), c = r >> 8, e = (r >> 3) & 31, k = 8 * c + (r & 7);
        const float v = KIN(I_RTW)[(size_t)l * D * NE + (size_t)k * NE + e]; const unsigned h = cvt_pk_bf16(v, 0.f) & 0xffffu; const unsigned lo = cvt_pk_bf16(v - __uint_as_float(h << 16), 0.f) & 0xffffu;
        unsigned short* dst = WSP(unsigned short, WS_RWT) + (size_t)l * 65536 + r; dst[0] = (unsigned short)h; dst[32768] = (unsigned short)lo; }
#else
    for (size_t i = gt; i < (size_t)DEPTH * NE * D; i += NT_) { const int l = (int)(i / (NE * D)), r = (int)(i % (NE * D)), e = r / D, k = r % D; WSP(float, WS_RWT)[i] = KIN(I_RTW)[(size_t)l * D * NE + (size_t)k * NE + e]; }
#endif
}

#if P6_MFMA
template <bool DRY> __device__ __forceinline__ void p6_ln1_router(Frame& F, const Args& A, int layer) {
    const bf16* y1 = WSP(bf16, WS_Y1); bf16* x1b = WSP(bf16, WS_X1B);
    const float* gam = KIN(I_LN1G) + layer * D; const float* bet = KIN(I_LN1B) + layer * D;
    const unsigned char* rwq = WSP(unsigned char, WS_RWT) + (size_t)layer * 131072; const float* rb = KIN(I_RTB) + layer * NE;
    int* sdest = WSP(int, WS_SDEST); float* sgate = WSP(float, WS_SGATE);
    unsigned* cnt = (unsigned*)(F.ctl + CW_CNT + layer * NE * 16);
    LAS unsigned char* WL = F.lds;
    LAS float* LG = (LAS float*)(F.lds + 131072);
    LAS float* TOPV = (LAS float*)(F.lds + 139264) + F.wave * 64;
    LAS int* TOPE = (LAS int*)(F.lds + 139264 + 2048) + F.wave * 64;
    LAS float* STAT = (LAS float*)(F.lds + 143360);
    volatile LAS unsigned* lcnt = F.MISC + MW_LCNT; volatile LAS unsigned* lbase = F.MISC + MW_LBASE;
    { const int l0 = F.lane;
#pragma unroll
      for (int i = 0; i < 16; ++i) { const int off = (F.wave * 16 + i) * 1024; __builtin_amdgcn_global_load_lds((const unsigned*)(rwq + off + l0 * 16), (LAS unsigned*)(WL + off), 16, 0, 0); } }
    const int lane = F.lane, m = lane & 15, g = lane >> 4, rq = F.wave & 3, kh = F.wave >> 2;
    for (int blk = F.vcu; blk < T / 64; blk += F.G) {
        if (F.tid < 32) lcnt[F.tid] = 0u;
        const int row = blk * 64 + rq * 16 + m; const size_t ro = (size_t)row * D + 512 * kh + 8 * g;
        v4u yw[16];
#pragma unroll
        for (int kk = 0; kk < 16; ++kk) yw[kk] = *(const v4u*)(y1 + ro + 32 * kk);
        float s = 0.f, s2 = 0.f;
#pragma unroll
        for (int kk = 0; kk < 16; ++kk) { f32x4 a, b; pg8::unpack8(yw[kk], a, b); s += ((a.x + a.y) + (a.z + a.w)) + ((b.x + b.y) + (b.z + b.w));
            s2 += ((a.x * a.x + a.y * a.y) + (a.z * a.z + a.w * a.w)) + ((b.x * b.x + b.y * b.y) + (b.z * b.z + b.w * b.w)); }
        s += __shfl_xor(s, 16); s += __shfl_xor(s, 32); s2 += __shfl_xor(s2, 16); s2 += __shfl_xor(s2, 32);
        if (g == 0) { STAT[(kh * 64 + rq * 16 + m) * 2] = s; STAT[(kh * 64 + rq * 16 + m) * 2 + 1] = s2; }
        asm volatile("s_waitcnt vmcnt(0)" ::: "memory");
        __syncthreads();
        const float st = STAT[(rq * 16 + m) * 2] + STAT[(64 + rq * 16 + m) * 2], st2 = STAT[(rq * 16 + m) * 2 + 1] + STAT[(64 + rq * 16 + m) * 2 + 1];
        const float mean = st * (1.f / D); const float rstd = __builtin_amdgcn_rsqf(fmaxf(st2 * (1.f / D) - mean * mean, 0.f) + LN_EPS);
        f32x4 acc[2] = {(f32x4){0.f, 0.f, 0.f, 0.f}, (f32x4){0.f, 0.f, 0.f, 0.f}}; const float* gp = gam; const float* bp = bet;
#pragma unroll
        for (int kk = 0; kk < 16; ++kk) { const int k0 = 512 * kh + 32 * kk + 8 * g;
            if ((kk & 3) == 0) { gp = launder_uniform(gp); bp = launder_uniform(bp); }
            const f32x4 ga = *(const f32x4*)(gp + k0), gb = *(const f32x4*)(gp + k0 + 4), ba = *(const f32x4*)(bp + k0), bb = *(const f32x4*)(bp + k0 + 4);
            f32x4 a, b; { v4u yk = yw[kk]; asm volatile("" : "+v"(yk)); pg8::unpack8(yk, a, b); }
            a = (a - mean) * rstd * ga + ba; b = (b - mean) * rstd * gb + bb;
            v4u hw; hw.x = cvt_pk_bf16(a.x, a.y); hw.y = cvt_pk_bf16(a.z, a.w); hw.z = cvt_pk_bf16(b.x, b.y); hw.w = cvt_pk_bf16(b.z, b.w);
            *(v4u*)(x1b + (size_t)row * D + k0) = hw;
            if (MOE_FP8) { v2u q; q.x = cvt4_fp8(a.x, a.y, a.z, a.w); q.y = cvt4_fp8(b.x, b.y, b.z, b.w); *(v2u*)(WSP(unsigned char, WS_X1Q) + (size_t)row * D + k0) = q; }
            f32x4 ha, hb_; pg8::unpack8(hw, ha, hb_); a = a - ha; b = b - hb_;
            v4u lw; lw.x = cvt_pk_bf16(a.x, a.y); lw.y = cvt_pk_bf16(a.z, a.w); lw.z = cvt_pk_bf16(b.x, b.y); lw.w = cvt_pk_bf16(b.z, b.w);
            const bf16x8 xh = __builtin_bit_cast(bf16x8, hw), xl = __builtin_bit_cast(bf16x8, lw);
            const int c = kh * 64 + kk * 4 + g;
#pragma unroll
            for (int nt = 0; nt < 2; ++nt) { const bf16x8 wh = *(const LAS bf16x8*)(WL + (c * 32 + nt * 16 + m) * 16), wl = *(const LAS bf16x8*)(WL + 65536 + (c * 32 + nt * 16 + m) * 16);
                acc[nt] = __builtin_amdgcn_mfma_f32_16x16x32_bf16(wh, xh, acc[nt], 0, 0, 0);
                acc[nt] = __builtin_amdgcn_mfma_f32_16x16x32_bf16(wl, xh, acc[nt], 0, 0, 0);
                acc[nt] = __builtin_amdgcn_mfma_f32_16x16x32_bf16(wh, xl, acc[nt], 0, 0, 0); } }
        if (kh == 1) {
#pragma unroll
            for (int nt = 0; nt < 2; ++nt) *(LAS f32x4*)(LG + (rq * 16 + m) * 32 + nt * 16 + 4 * g) = acc[nt]; }
        __syncthreads();
        if (kh == 0) {
#pragma unroll
            for (int nt = 0; nt < 2; ++nt) { const f32x4 o = *(const LAS f32x4*)(LG + (rq * 16 + m) * 32 + nt * 16 + 4 * g); const f32x4 rbv = *(const f32x4*)(rb + nt * 16 + 4 * g);
                *(LAS f32x4*)(LG + (rq * 16 + m) * 32 + nt * 16 + 4 * g) = o + acc[nt] + rbv; } }
        __syncthreads();
        int lane2 = lane; asm volatile("" : "+v"(lane2)); const int sub = lane2 & 15;
#pragma unroll 1
        for (int rg = 0; rg < 2; ++rg) {
            float lg[32];
            { const LAS float* lr = LG + (F.wave * 8 + rg * 4 + (lane2 >> 4)) * 32;
#pragma unroll
              for (int q = 0; q < 8; ++q) { const f32x4 t4 = *(const LAS f32x4*)(lr + 4 * q); lg[4 * q] = t4.x; lg[4 * q + 1] = t4.y; lg[4 * q + 2] = t4.z; lg[4 * q + 3] = t4.w; } }
            float la = 0.f, lb_ = 0.f;
#pragma unroll
            for (int e = 0; e < 32; ++e) { if (e == 2 * sub) la = lg[e]; if (e == 2 * sub + 1) lb_ = lg[e]; }
            int ra = 0, rbk = 0;
#pragma unroll
            for (int e = 0; e < 32; ++e) { ra += (lg[e] > la || (lg[e] == la && e < 2 * sub)) ? 1 : 0; rbk += (lg[e] > lb_ || (lg[e] == lb_ && e < 2 * sub + 1)) ? 1 : 0; }
            const int rowl = rg * 4 + (lane2 >> 4);
            if (ra < 4) { TOPV[rowl * 4 + ra] = la; TOPE[rowl * 4 + ra] = 2 * sub; }
            if (rbk < 4) { TOPV[rowl * 4 + rbk] = lb_; TOPE[rowl * 4 + rbk] = 2 * sub + 1; }
        }
        LDS_WAIT();
        int my_e = 0; float my_g = 0.f; unsigned my_r = 0u;
        if (lane2 < 32) { const int ri = lane2 >> 2, k = lane2 & 3; const f32x4 tv = *(const LAS f32x4*)(TOPV + ri * 4);
            const float e1 = __expf(tv.y - tv.x), e2 = __expf(tv.z - tv.x), e3 = __expf(tv.w - tv.x); const float inv = __builtin_amdgcn_rcpf(1.0f + e1 + e2 + e3);
            my_e = TOPE[ri * 4 + k]; my_g = (k == 0 ? 1.0f : k == 1 ? e1 : k == 2 ? e2 : e3) * inv;
            my_r = DRY ? 0u : atomicAdd((unsigned*)&lcnt[my_e], 1u); }
        __syncthreads();
        if (!DRY && F.wave == 0 && lane2 < 32) { const unsigned n = lcnt[lane2]; lbase[lane2] = n ? __hip_atomic_fetch_add(cnt + lane2 * 16, n, RLX_AGENT) : 0u; }
        __syncthreads();
        if (!DRY && lane2 < 32) { const int rw = blk * 64 + F.wave * 8 + (lane2 >> 2); const unsigned slot = (unsigned)my_e * ECAP + lbase[my_e] + my_r;
            sdest[slot] = rw * 4 + (lane2 & 3); sgate[slot] = my_g; }
        __syncthreads();
    }
}
#else
template <bool DRY> __device__ __forceinline__ void p6_ln1_router(Frame& F, const Args& A, int layer) {
    const bf16* y1 = WSP(bf16, WS_Y1); bf16* x1b = WSP(bf16, WS_X1B);
    const float* g = KIN(I_LN1G) + layer * D; const float* bb = KIN(I_LN1B) + layer * D;
    const float* rwt = WSP(float, WS_RWT) + (size_t)layer * NE * D; const float* rb = KIN(I_RTB) + layer * NE;
    int* sdest = WSP(int, WS_SDEST); float* sgate = WSP(float, WS_SGATE);
    unsigned* cnt = (unsigned*)(F.ctl + CW_CNT + layer * NE * 16);
    LAS float* RWT = (LAS float*)F.lds;
    LAS float* TOPV = (LAS float*)(F.lds + 131072) + F.wave * 64;
    LAS int* TOPE = (LAS int*)(F.lds + 131072 + 2048) + F.wave * 64;
    volatile LAS unsigned* lcnt = F.MISC + MW_LCNT; volatile LAS unsigned* lbase = F.MISC + MW_LBASE;
    for (int i = F.tid; i < NE * D / 4; i += NWAVES * 64) ((LAS f32x4*)RWT)[i] = ((const f32x4*)rwt)[i];
    const int lane = F.lane, sub = lane & 15;
    for (int blk = F.vcu; blk < T / 64; blk += F.G) {
        if (F.tid < 32) lcnt[F.tid] = 0u;
        __syncthreads();
#pragma unroll 1
        for (int rg = 0; rg < 2; ++rg) {
            f32x4 v[4][4];
            { int lo_ = lane; asm volatile("" : "+v"(lo_));
              const f32x4 gv[4] = { *(const f32x4*)(g + 4 * lo_), *(const f32x4*)(g + 256 + 4 * lo_), *(const f32x4*)(g + 512 + 4 * lo_), *(const f32x4*)(g + 768 + 4 * lo_) };
              const f32x4 bv[4] = { *(const f32x4*)(bb + 4 * lo_), *(const f32x4*)(bb + 256 + 4 * lo_), *(const f32x4*)(bb + 512 + 4 * lo_), *(const f32x4*)(bb + 768 + 4 * lo_) };
#pragma unroll
              for (int r = 0; r < 4; ++r) { const int row = blk * 64 + F.wave * 8 + rg * 4 + r; const bf16* yr = y1 + (size_t)row * D; float s = 0.f;
#pragma unroll
                  for (int j = 0; j < 4; ++j) { const v2u w = *(const v2u*)(yr + 256 * j + 4 * lane); v[r][j] = (f32x4){__uint_as_float(w.x << 16), __uint_as_float(w.x & 0xffff0000u), __uint_as_float(w.y << 16), __uint_as_float(w.y & 0xffff0000u)}; s += (v[r][j].x + v[r][j].y) + (v[r][j].z + v[r][j].w); }
                  const float mean = wave_sum(s) * (1.f / D); float s2 = 0.f;
#pragma unroll
                  for (int j = 0; j < 4; ++j) { v[r][j] = v[r][j] - mean; s2 += (v[r][j].x * v[r][j].x + v[r][j].y * v[r][j].y) + (v[r][j].z * v[r][j].z + v[r][j].w * v[r][j].w); }
                  const float rstd = __builtin_amdgcn_rsqf(wave_sum(s2) * (1.f / D) + LN_EPS);
#pragma unroll
                  for (int j = 0; j < 4; ++j) { v[r][j] = v[r][j] * rstd * gv[j] + bv[j];
                      v2u o; o.x = cvt_pk_bf16(v[r][j].x, v[r][j].y); o.y = cvt_pk_bf16(v[r][j].z, v[r][j].w); *(v2u*)(x1b + (size_t)row * D + 256 * j + 4 * lane) = o;
                      if (MOE_FP8) *(unsigned*)(WSP(unsigned char, WS_X1Q) + (size_t)row * D + 256 * j + 4 * lane) = cvt4_fp8(v[r][j].x, v[r][j].y, v[r][j].z, v[r][j].w); } } }
            float lg[32];
#pragma unroll
            for (int e = 0; e < 32; ++e) { f32x2 p2[4] = {(f32x2){0.f, 0.f}, (f32x2){0.f, 0.f}, (f32x2){0.f, 0.f}, (f32x2){0.f, 0.f}};
#pragma unroll
                for (int j = 0; j < 4; ++j) { const f32x4 w = *(const LAS f32x4*)(RWT + e * D + 256 * j + 4 * lane);
#pragma unroll
                    for (int r = 0; r < 4; ++r) { p2[r] = v[r][j].xy * w.xy + p2[r]; p2[r] = v[r][j].zw * w.zw + p2[r]; } }
                float p[4] = {p2[0].x + p2[0].y, p2[1].x + p2[1].y, p2[2].x + p2[2].y, p2[3].x + p2[3].y};
                { const bool hi = (lane & 32) != 0; const float k0 = hi ? p[2] : p[0], s0 = hi ? p[0] : p[2], k1 = hi ? p[3] : p[1], s1 = hi ? p[1] : p[3]; p[0] = k0 + __shfl_xor(s0, 32); p[1] = k1 + __shfl_xor(s1, 32); }
                { const bool hi = (lane & 16) != 0; const float k0 = hi ? p[1] : p[0], s0 = hi ? p[0] : p[1]; p[0] = k0 + __shfl_xor(s0, 16); }
                float t = p[0]; t += __shfl_xor(t, 8); t += __shfl_xor(t, 4); t += __shfl_xor(t, 2); t += __shfl_xor(t, 1);
                lg[e] = t + rb[e]; }
            float la = 0.f, lb_ = 0.f;
#pragma unroll
            for (int e = 0; e < 32; ++e) { if (e == 2 * sub) la = lg[e]; if (e == 2 * sub + 1) lb_ = lg[e]; }
            int ra = 0, rbk = 0;
#pragma unroll
            for (int e = 0; e < 32; ++e) { ra += (lg[e] > la || (lg[e] == la && e < 2 * sub)) ? 1 : 0; rbk += (lg[e] > lb_ || (lg[e] == lb_ && e < 2 * sub + 1)) ? 1 : 0; }
            const int rowl = rg * 4 + (lane >> 4);
            if (ra < 4) { TOPV[rowl * 4 + ra] = la; TOPE[rowl * 4 + ra] = 2 * sub; }
            if (rbk < 4) { TOPV[rowl * 4 + rbk] = lb_; TOPE[rowl * 4 + rbk] = 2 * sub + 1; }
        }
        LDS_WAIT();
        int my_e = 0; float my_g = 0.f; unsigned my_r = 0u;
        if (lane < 32) { const int ri = lane >> 2, k = lane & 3; const f32x4 tv = *(const LAS f32x4*)(TOPV + ri * 4);
            const float e1 = __expf(tv.y - tv.x), e2 = __expf(tv.z - tv.x), e3 = __expf(tv.w - tv.x); const float inv = __builtin_amdgcn_rcpf(1.0f + e1 + e2 + e3);
            my_e = TOPE[ri * 4 + k]; my_g = (k == 0 ? 1.0f : k == 1 ? e1 : k == 2 ? e2 : e3) * inv;
            my_r = DRY ? 0u : atomicAdd((unsigned*)&lcnt[my_e], 1u); }
        __syncthreads();
        if (!DRY && F.tid < 32) { const unsigned n = lcnt[F.tid]; lbase[F.tid] = n ? __hip_atomic_fetch_add(cnt + F.tid * 16, n, RLX_AGENT) : 0u; }
        __syncthreads();
        if (!DRY && lane < 32) { const int row = blk * 64 + F.wave * 8 + (lane >> 2); const unsigned slot = (unsigned)my_e * ECAP + lbase[my_e] + my_r;
            sdest[slot] = row * 4 + (lane & 3); sgate[slot] = my_g; }
        __syncthreads();
    }
}
#endif
__device__ __forceinline__ void p9_combine(Frame& F, const Args& A) {
    const bf16* x1b = WSP(bf16, WS_X1B); const bf16* yb = WSP(bf16, WS_YBUF); bf16* hb = WSP(bf16, WS_HB);
    const int gw = F.vcu * NWAVES + F.wave, NGW = F.G * NWAVES, lane = F.lane;
    for (int row = gw; row < T; row += NGW) {
        v4u y[4][2], xw[2];
#pragma unroll
        for (int j = 0; j < 2; ++j) {
#pragma unroll
            for (int k = 0; k < 4; ++k) y[k][j] = *(const v4u*)(yb + ((size_t)row * 4 + k) * D + 512 * j + 8 * lane);
            xw[j] = *(const v4u*)(x1b + (size_t)row * D + 512 * j + 8 * lane); }
#pragma unroll
        for (int j = 0; j < 2; ++j) { f32x4 v0, v1; pg8::unpack8(xw[j], v0, v1); v0 = v0 * DN_ALPHA; v1 = v1 * DN_ALPHA;
#pragma unroll
            for (int k = 0; k < 4; ++k) { f32x4 a, b; pg8::unpack8(y[k][j], a, b); v0 = v0 + a; v1 = v1 + b; }
            v4u wv; wv.x = cvt_pk_bf16(v0.x, v0.y); wv.y = cvt_pk_bf16(v0.z, v0.w); wv.z = cvt_pk_bf16(v1.x, v1.y); wv.w = cvt_pk_bf16(v1.z, v1.w); *(v4u*)(hb + (size_t)row * D + 512 * j + 8 * lane) = wv;
            if (PLE_FP8) { v2u q; q.x = cvt4_fp8(v0.x, v0.y, v0.z, v0.w); q.y = cvt4_fp8(v1.x, v1.y, v1.z, v1.w); *(v2u*)(WSP(unsigned char, WS_HQ) + (size_t)row * D + 512 * j + 8 * lane) = q; } }
    }
}
__device__ __forceinline__ void p11_ln2(Frame& F, const Args& A, int layer) {
    const bf16* h2 = WSP(bf16, WS_H2); bf16* xb = WSP(bf16, WS_XB);
    const float* g = KIN(I_LN2G) + layer * D; const float* bb = KIN(I_LN2B) + layer * D;
    const int gw = F.vcu * NWAVES + F.wave, NGW = F.G * NWAVES, lane = F.lane;
    for (int row = gw; row < T; row += NGW) {
        const bf16* yr = h2 + (size_t)row * D; f32x4 v[4]; float s = 0.f;
#pragma unroll
        for (int j = 0; j < 4; ++j) { const v2u w = *(const v2u*)(yr + 256 * j + 4 * lane); v[j] = (f32x4){__uint_as_float(w.x << 16), __uint_as_float(w.x & 0xffff0000u), __uint_as_float(w.y << 16), __uint_as_float(w.y & 0xffff0000u)}; s += (v[j].x + v[j].y) + (v[j].z + v[j].w); }
        const float mean = wave_sum(s) * (1.f / D); float s2 = 0.f;
#pragma unroll
        for (int j = 0; j < 4; ++j) { v[j] = v[j] - mean; s2 += (v[j].x * v[j].x + v[j].y * v[j].y) + (v[j].z * v[j].z + v[j].w * v[j].w); }
        const float rstd = __builtin_amdgcn_rsqf(wave_sum(s2) * (1.f / D) + LN_EPS);
#pragma unroll
        for (int j = 0; j < 4; ++j) { const f32x4 gv = *(const f32x4*)(g + 256 * j + 4 * lane), bv = *(const f32x4*)(bb + 256 * j + 4 * lane);
            const f32x4 o = v[j] * rstd * gv + bv; const size_t off = (size_t)row * D + 256 * j + 4 * lane;
            if (layer == DEPTH - 1) *(f32x4*)(F.out + off) = o; v2u w; w.x = cvt_pk_bf16(o.x, o.y); w.y = cvt_pk_bf16(o.z, o.w); *(v2u*)(xb + off) = w; }
    }
}
__device__ __forceinline__ void moe_build_pfx(Frame& F, const Args& A, int layer, int NT) {
    volatile LAS unsigned* pfx = F.MISC + MW_PFX;
    __syncthreads();
    if (F.tid < 64) {
        const int e = F.tid & 31;
        const unsigned c = __hip_atomic_load(F.ctl + CW_CNT + (layer * NE + e) * 16, RLX_AGENT);
        const unsigned un = ((c + 255u) >> 8) * (unsigned)NT; unsigned inc = un;
#pragma unroll
        for (int o = 1; o < 32; o <<= 1) { const unsigned t = (unsigned)my_shfl_up((int)inc, o); if (e >= o) inc += t; }
        if (F.tid < 32) { pfx[e] = inc - un; pfx[40 + e] = c; if (e == 31) pfx[32] = inc; }
    }
    __syncthreads();
}
#define UU(t, col) bf2f(u[(size_t)(t) * NUP + (col)])
#define UU4(t, col) ldu4(u + (size_t)(t) * NUP + (col))
__device__ __forceinline__ f32x4 ldu4(const bf16* p) { const v2u w = *(const v2u*)p; return (f32x4){__uint_as_float(w.x << 16), __uint_as_float(w.x & 0xffff0000u), __uint_as_float(w.y << 16), __uint_as_float(w.y & 0xffff0000u)}; }
__device__ __forceinline__ f32x4 ldb4(const bf16* p) { const v2u w = *(const v2u*)p; return (f32x4){__uint_as_float(w.x << 16), __uint_as_float(w.x & 0xffff0000u), __uint_as_float(w.y << 16), __uint_as_float(w.y & 0xffff0000u)}; }
__device__ __forceinline__ void stb4(bf16* p, f32x4 v) { v2u o; o.x = cvt_pk_bf16(v.x, v.y); o.y = cvt_pk_bf16(v.z, v.w); *(v2u*)p = o; }
__device__ __forceinline__ void lds_st_bf16(LAS unsigned char* p, float v) { *(LAS unsigned short*)p = (unsigned short)(cvt_pk_bf16(v, 0.f) & 0xffffu); }
__device__ __forceinline__ void lds_st_bf16x4(LAS unsigned char* p, float a, float b, float c, float d) { v2u o; o.x = cvt_pk_bf16(a, b); o.y = cvt_pk_bf16(c, d); *(LAS v2u*)p = o; }

#if OUT_FP8
#define MIX_ST4(mix, idx, a, b, c, d) (*(unsigned*)((unsigned char*)(mix) + (idx)) = cvt4_fp8(a, b, c, d))
#else
#define MIX_ST4(mix, idx, a, b, c, d) do { v2u o_; o_.x = cvt_pk_bf16(a, b); o_.y = cvt_pk_bf16(c, d); *(v2u*)((mix) + (idx)) = o_; } while (0)
#endif
__device__ __forceinline__ void ssd_stage1(Frame& F, const Args& A, int layer, int b, int c) {
    const bf16* u = WSP(bf16, WS_U);
    LAS unsigned char* L = F.lds;
    LAS float* DT = (LAS float*)L; LAS float* AC = DT + 256;
    LAS unsigned char* BMT = L + 2048; LAS unsigned char* XCDT = BMT + 128 * 144;
    const int t0 = b * SEQ + c * 64, tid = F.tid, lane = F.lane, wave = F.wave;
    if (wave < 4) {
        const int hh = wave;
        const float dt = softplusf_(UU(t0 + lane, U_SSD_DT + hh) + KIN(I_SDTB)[layer * 4 + hh]);
        const float adt = -dt * __expf(KIN(I_SALOG)[layer * 4 + hh]);
        const float ac = wave_scan_add(adt, lane);
        DT[hh * 64 + lane] = dt; AC[hh * 64 + lane] = ac;
        if (lane == 63) WSP(float, WS_SSD_DEC)[(b * 4 + hh) * NCH + c] = __expf(ac);
    }
    __syncthreads();
    if (tid < 384) {
        const int cc = tid; const float* cw = KIN(I_SCW) + (size_t)layer * 2048 + cc; const float w0 = cw[0], w1 = cw[512], w2 = cw[1024], w3 = cw[1536], cb = KIN(I_SCB)[layer * 512 + cc];
        const bf16* up = u + (size_t)t0 * NUP + U_SSD_X + cc;
        float win0 = 0.f, win1 = 0.f, win2 = 0.f;
        if (c > 0) { win0 = bf2f(up[-3 * NUP]); win1 = bf2f(up[-2 * NUP]); win2 = bf2f(up[-1 * NUP]); }
        const int hh = (cc >> 6) & 3; const bool isx = cc < 256;
        LAS unsigned char* dst = isx ? XCDT + cc * 144 : BMT + (cc - 256) * 144;
        const float aclast = AC[hh * 64 + 63];
#pragma unroll 1
        for (int l0 = 0; l0 < 64; l0 += 32) {
            float xv[32];
#pragma unroll
            for (int j = 0; j < 32; ++j) xv[j] = bf2f(up[(l0 + j) * NUP]);
#pragma unroll
            for (int j8 = 0; j8 < 4; ++j8) { float o[8];
#pragma unroll
                for (int j = 0; j < 8; ++j) { const int l = l0 + j8 * 8 + j; const float x = xv[j8 * 8 + j]; const float y = cb + w0 * win0 + w1 * win1 + w2 * win2 + w3 * x; win0 = win1; win1 = win2; win2 = x;
                    float s = siluf_(y); if (isx) s *= DT[hh * 64 + l] * __expf(aclast - AC[hh * 64 + l]); o[j] = s; }
                *(LAS v4u*)(dst + (l0 + j8 * 8) * 2) = pack8(o); }
        }
    }
    __syncthreads();
    { const int fr = lane & 15, fq = lane >> 4; bf16* st = WSP(bf16, WS_SSD_ST);
#pragma unroll 1
      for (int i = 0; i < 2; ++i) { const int row0 = (2 * wave + i) * 16; const int hh = row0 >> 6, p = (row0 & 63) + fr;
          bf16* dstp = st + (((size_t)(b * 4 + hh) * NCH + c) * 64 + p) * 128;
#pragma unroll 1
          for (int ntl = 0; ntl < 8; ++ntl) { f32x4 acc = {0.f, 0.f, 0.f, 0.f}; acc = mm16(XCDT + row0 * 144, 144, BMT + ntl * 16 * 144, 144, 64, acc, fr, fq);
              stb4(dstp + ntl * 16 + 4 * fq, acc); } } }
    __syncthreads();
}
__device__ __forceinline__ void ssd_stage3(Frame& F, const Args& A, int layer, int b, int c) {
    const bf16* u = WSP(bf16, WS_U);
    LAS unsigned char* L = F.lds;
    LAS float* DT = (LAS float*)L; LAS float* AC = DT + 256;
    LAS unsigned char* CM = L + 2048; LAS unsigned char* BM = CM + 64 * 272; LAS unsigned char* XCT = BM + 64 * 272; LAS unsigned char* MM = XCT + 256 * 144;
    LAS unsigned char* YG = XCT;
    const int t0 = b * SEQ + c * 64, tid = F.tid, lane = F.lane, wave = F.wave, fr = lane & 15, fq = lane >> 4;
    if (wave < 4) {
        const int hh = wave;
        const float dt = softplusf_(UU(t0 + lane, U_SSD_DT + hh) + KIN(I_SDTB)[layer * 4 + hh]);
        const float adt = -dt * __expf(KIN(I_SALOG)[layer * 4 + hh]);
        DT[hh * 64 + lane] = dt; AC[hh * 64 + lane] = wave_scan_add(adt, lane);
    }
    __syncthreads();
    {
        const int cc = tid; const float* cw = KIN(I_SCW) + (size_t)layer * 2048 + cc; const float w0 = cw[0], w1 = cw[512], w2 = cw[1024], w3 = cw[1536], cb = KIN(I_SCB)[layer * 512 + cc];
        const bf16* up = u + (size_t)t0 * NUP + U_SSD_X + cc;
        float win0 = 0.f, win1 = 0.f, win2 = 0.f;
        if (c > 0) { win0 = bf2f(up[-3 * NUP]); win1 = bf2f(up[-2 * NUP]); win2 = bf2f(up[-1 * NUP]); }
        const int hh = (cc >> 6) & 3;
#pragma unroll 1
        for (int l0 = 0; l0 < 64; l0 += 32) {
            float xv[32];
#pragma unroll
            for (int j = 0; j < 32; ++j) xv[j] = bf2f(up[(l0 + j) * NUP]);
#pragma unroll
            for (int j8 = 0; j8 < 4; ++j8) { float o[8];
#pragma unroll
                for (int j = 0; j < 8; ++j) { const int l = l0 + j8 * 8 + j; const float x = xv[j8 * 8 + j]; const float y = cb + w0 * win0 + w1 * win1 + w2 * win2 + w3 * x; win0 = win1; win1 = win2; win2 = x;
                    float s = siluf_(y); if (cc < 256) s *= DT[hh * 64 + l]; o[j] = s; }
                if (cc < 256) *(LAS v4u*)(XCT + cc * 144 + (l0 + j8 * 8) * 2) = pack8(o);
                else { LAS unsigned char* d2 = (cc < 384 ? BM + (cc - 256) * 2 : CM + (cc - 384) * 2) + (l0 + j8 * 8) * 272;
#pragma unroll
                    for (int j = 0; j < 8; ++j) lds_st_bf16(d2 + j * 272, o[j]); } }
        }
    }
    __syncthreads();
#pragma unroll 1
    for (int i = 0; i < 2; ++i) { const int idx = 2 * wave + i, lt = idx >> 2, st = idx & 3;
        f32x4 acc = {0.f, 0.f, 0.f, 0.f}; acc = mm16(CM + lt * 16 * 272, 272, BM + st * 16 * 272, 272, 128, acc, fr, fq);
        const int l = lt * 16 + fr, s0 = st * 16 + 4 * fq;
#pragma unroll
        for (int hh = 0; hh < 4; ++hh) { const float al = AC[hh * 64 + l], dl = KIN(I_SD)[layer * 4 + hh] / DT[hh * 64 + l]; float o[4];
#pragma unroll
            for (int j = 0; j < 4; ++j) { const int s = s0 + j; float m = (l >= s) ? acc[j] * __expf(al - AC[hh * 64 + s]) : 0.f; if (l == s) m += dl; o[j] = m; }
            lds_st_bf16x4(MM + hh * 9216 + l * 144 + s0 * 2, o[0], o[1], o[2], o[3]); } }
    __syncthreads();
    f32x4 yv[2][4];
    { const int hh = wave >> 1; const bf16* prev = WSP(bf16, WS_SSD_ST) + ((size_t)(b * 4 + hh) * NCH + c) * 8192;
      bf16x8 pf[4][4];
#pragma unroll
      for (int pt = 0; pt < 4; ++pt)
#pragma unroll
          for (int ks = 0; ks < 4; ++ks) pf[pt][ks] = *(const bf16x8*)(prev + (size_t)(pt * 16 + fr) * 128 + ks * 32 + fq * 8);
#pragma unroll
      for (int i = 0; i < 2; ++i) { const int lt = 2 * (wave & 1) + i, l = lt * 16 + fr; const float ea = __expf(AC[hh * 64 + l]);
#pragma unroll
          for (int pt = 0; pt < 4; ++pt) { f32x4 ad = {0.f, 0.f, 0.f, 0.f}, ao = {0.f, 0.f, 0.f, 0.f};
              ad = mm16(MM + hh * 9216 + lt * 16 * 144, 144, XCT + (hh * 64 + pt * 16) * 144, 144, 64, ad, fr, fq);
              ao = mm16_rB<4>(CM + lt * 16 * 272, 272, pf[pt], ao, fr, fq);
              const f32x4 z = UU4(t0 + l, U_SSD_Z + hh * 64 + pt * 16 + 4 * fq);
              f32x4 y = ad + ao * ea; y.x *= siluf_(z.x); y.y *= siluf_(z.y); y.z *= siluf_(z.z); y.w *= siluf_(z.w); yv[i][pt] = y; } } }
    __syncthreads();
    { const int hh = wave >> 1;
#pragma unroll
      for (int i = 0; i < 2; ++i) { const int l = (2 * (wave & 1) + i) * 16 + fr;
#pragma unroll
          for (int pt = 0; pt < 4; ++pt) *(LAS f32x4*)(YG + l * 1040 + (hh * 64 + pt * 16 + 4 * fq) * 4) = yv[i][pt]; } }
    __syncthreads();
    { const f32x4 g = *(const f32x4*)(KIN(I_SNG) + layer * 256 + 4 * lane); bf16* mix = WSP(bf16, WS_MIX);
#pragma unroll 1
      for (int i = 0; i < 8; ++i) { const int l = wave * 8 + i; const f32x4 y = *(const LAS f32x4*)(YG + l * 1040 + lane * 16);
          const float ss = wave_sum((y.x * y.x + y.y * y.y) + (y.z * y.z + y.w * y.w)); const float r = __builtin_amdgcn_rsqf(ss * (1.f / 256.f) + NORM_EPS);
          MIX_ST4(mix, (size_t)(t0 + l) * D + 4 * lane, y.x * r * g.x, y.y * r * g.y, y.z * r * g.z, y.w * r * g.w); } }
    __syncthreads();
}

__device__ __forceinline__ void gla_bcum_all(Frame& F, const Args& A, int layer, const LAS float* GD, LAS float* BC) {
    const int d = F.tid & 127, lq = F.tid >> 7;
    float gup[16];
    { const f32x4* gp4 = (const f32x4*)(WSP(float, WS_LORA) + (size_t)layer * LORA_PER_LAYER + 32768 + d * 16);
#pragma unroll
      for (int i = 0; i < 4; ++i) { const f32x4 a = gp4[i]; gup[4 * i] = a.x; gup[4 * i + 1] = a.y; gup[4 * i + 2] = a.z; gup[4 * i + 3] = a.w; } }
    const float gb = KIN(I_GGB)[layer * 128 + d];
#pragma unroll 4
    for (int li = 0; li < 16; ++li) { const int l = lq * 16 + li; float x = gb;
#pragma unroll
        for (int i = 0; i < 4; ++i) { const f32x4 g4 = *(const LAS f32x4*)(GD + l * 16 + 4 * i); x += (g4.x * gup[4 * i] + g4.y * gup[4 * i + 1]) + (g4.z * gup[4 * i + 2] + g4.w * gup[4 * i + 3]); }
        BC[l * 128 + d] = logsigmoidf_(x) * 0.0625f; }
    __syncthreads();
    if (F.tid < 128) { float run = 0.f;
#pragma unroll 1
        for (int l0 = 0; l0 < 64; l0 += 16) { float v[16];
#pragma unroll
            for (int j = 0; j < 16; ++j) v[j] = BC[(l0 + j) * 128 + d];
#pragma unroll
            for (int j = 0; j < 16; ++j) { run += v[j]; BC[(l0 + j) * 128 + d] = run; } } }
}
__device__ __forceinline__ void gla_stage1(Frame& F, const Args& A, int layer, int b, int c) {
    const bf16* u = WSP(bf16, WS_U);
    LAS unsigned char* L = F.lds;
    LAS float* GD = (LAS float*)L; LAS float* BC = (LAS float*)(L + 4096);
    LAS unsigned char* KDT = L + 36864; LAS unsigned char* VT = KDT + 128 * 144;
    const int t0 = b * SEQ + c * 64, tid = F.tid, lane = F.lane, wave = F.wave, fr = lane & 15, fq = lane >> 4;
    if (tid < 256) { const int l = tid >> 2, q4 = tid & 3; *(LAS f32x4*)(GD + l * 16 + q4 * 4) = UU4(t0 + l, U_GL_G + 4 * q4); }
    __syncthreads();
    gla_bcum_all(F, A, layer, GD, BC);
    if (tid < 128) {
        const int d = tid; const float blast = BC[63 * 128 + d];
        WSP(float, WS_GLA_DEC)[(size_t)(b * NCH + c) * 128 + d] = __expf(blast);
        const bf16* up = u + (size_t)t0 * NUP + U_GL_K + d;
#pragma unroll 1
        for (int l0 = 0; l0 < 64; l0 += 32) { float xv[32];
#pragma unroll
            for (int j = 0; j < 32; ++j) xv[j] = bf2f(up[(l0 + j) * NUP]);
#pragma unroll
            for (int j8 = 0; j8 < 4; ++j8) { float o[8];
#pragma unroll
                for (int j = 0; j < 8; ++j) { const int l = l0 + j8 * 8 + j; o[j] = xv[j8 * 8 + j] * __expf(blast - BC[l * 128 + d]); }
                *(LAS v4u*)(KDT + d * 144 + (l0 + j8 * 8) * 2) = pack8(o); } }
    } else if (tid < 384) {
        const int vch = tid - 128; const bf16* up = u + (size_t)t0 * NUP + U_GL_V + vch;
#pragma unroll 1
        for (int l0 = 0; l0 < 64; l0 += 32) { float xv[32];
#pragma unroll
            for (int j = 0; j < 32; ++j) xv[j] = bf2f(up[(l0 + j) * NUP]);
#pragma unroll
            for (int j8 = 0; j8 < 4; ++j8) { float o[8];
#pragma unroll
                for (int j = 0; j < 8; ++j) o[j] = xv[j8 * 8 + j];
                *(LAS v4u*)(VT + vch * 144 + (l0 + j8 * 8) * 2) = pack8(o); } }
    }
    __syncthreads();
    { bf16* st = WSP(bf16, WS_GLA_ST);
#pragma unroll 1
      for (int i = 0; i < 4; ++i) { const int idx = 4 * wave + i, hh = idx >> 3, dtl = (idx >> 2) & 1, vt = idx & 3;
          f32x4 acc = {0.f, 0.f, 0.f, 0.f}; acc = mm16(KDT + (hh * 32 + dtl * 16) * 144, 144, VT + (hh * 64 + vt * 16) * 144, 144, 64, acc, fr, fq);
          stb4(st + (((size_t)(b * 4 + hh) * NCH + c) * 32 + dtl * 16 + fr) * 64 + vt * 16 + 4 * fq, acc); } }
    __syncthreads();
}
__device__ __forceinline__ void gla_stage3(Frame& F, const Args& A, int layer, int b, int c) {
    const bf16* u = WSP(bf16, WS_U);
    LAS unsigned char* L = F.lds;
    LAS float* GD = (LAS float*)L; LAS float* BC = (LAS float*)(L + 4096); LAS unsigned char* ATT = L + 4096;
    LAS unsigned char* QD = L + 40960; LAS unsigned char* KI = QD + 64 * 272; LAS unsigned char* VT = KI + 64 * 272; LAS unsigned char* PVT = VT + 256 * 144;
    const int t0 = b * SEQ + c * 64, tid = F.tid, lane = F.lane, wave = F.wave, fr = lane & 15, fq = lane >> 4;
    if (tid < 256) { const int l = tid >> 2, q4 = tid & 3; *(LAS f32x4*)(GD + l * 16 + q4 * 4) = UU4(t0 + l, U_GL_G + 4 * q4); }
    __syncthreads();
    gla_bcum_all(F, A, layer, GD, BC);
    if (tid < 128) {
        const int d = tid;
        const bf16* uq = u + (size_t)t0 * NUP + U_GL_Q + d; const bf16* uk = u + (size_t)t0 * NUP + U_GL_K + d;
#pragma unroll 1
        for (int l0 = 0; l0 < 64; l0 += 16) { float qv[16], kv[16];
#pragma unroll
            for (int j = 0; j < 16; ++j) { qv[j] = bf2f(uq[(l0 + j) * NUP]); kv[j] = bf2f(uk[(l0 + j) * NUP]); }
#pragma unroll
            for (int j = 0; j < 16; ++j) { const int l = l0 + j; const float bc = BC[l * 128 + d];
                lds_st_bf16(QD + l * 272 + d * 2, qv[j] * 0.17677669529663687f * __expf(bc)); lds_st_bf16(KI + l * 272 + d * 2, kv[j] * __expf(-bc)); } }
    } else if (tid < 384) {
        const int vch = tid - 128; const bf16* up = u + (size_t)t0 * NUP + U_GL_V + vch;
#pragma unroll 1
        for (int l0 = 0; l0 < 64; l0 += 32) { float xv[32];
#pragma unroll
            for (int j = 0; j < 32; ++j) xv[j] = bf2f(up[(l0 + j) * NUP]);
#pragma unroll
            for (int j8 = 0; j8 < 4; ++j8) { float o[8];
#pragma unroll
                for (int j = 0; j < 8; ++j) o[j] = xv[j8 * 8 + j];
                *(LAS v4u*)(VT + vch * 144 + (l0 + j8 * 8) * 2) = pack8(o); } }
    } else {
        const bf16* prev = WSP(bf16, WS_GLA_ST);
#pragma unroll 4
        for (int i = tid - 384; i < 8192; i += 128) { const int hh = i >> 11, dd = (i >> 6) & 31, vv = i & 63;
            *(LAS unsigned short*)(PVT + (hh * 64 + vv) * 80 + dd * 2) = prev[((size_t)(b * 4 + hh) * NCH + c) * 2048 + dd * 64 + vv]; }
    }
    __syncthreads();
    const int hh = wave >> 1;
#pragma unroll 1
    for (int i = 0; i < 2; ++i) { const int tt = 2 * (wave & 1) + i, t = tt * 16 + fr;
#pragma unroll
        for (int st = 0; st < 4; ++st) { f32x4 acc = {0.f, 0.f, 0.f, 0.f}; acc = mm16(QD + tt * 16 * 272 + hh * 64, 272, KI + st * 16 * 272 + hh * 64, 272, 32, acc, fr, fq);
            const int s0 = st * 16 + 4 * fq;
            lds_st_bf16x4(ATT + hh * 9216 + t * 144 + s0 * 2, t >= s0 ? acc[0] : 0.f, t >= s0 + 1 ? acc[1] : 0.f, t >= s0 + 2 ? acc[2] : 0.f, t >= s0 + 3 ? acc[3] : 0.f); } }
    __syncthreads();
    { bf16* mix = WSP(bf16, WS_MIX); const float* ng = KIN(I_GNG) + layer * 256;
#pragma unroll 1
      for (int i = 0; i < 2; ++i) { const int tt = 2 * (wave & 1) + i, t = tt * 16 + fr; f32x4 ov[4]; float ss = 0.f;
#pragma unroll
          for (int vt = 0; vt < 4; ++vt) { f32x4 acc = {0.f, 0.f, 0.f, 0.f};
              acc = mm16(ATT + hh * 9216 + tt * 16 * 144, 144, VT + (hh * 64 + vt * 16) * 144, 144, 64, acc, fr, fq);
              acc = mm16(QD + tt * 16 * 272 + hh * 64, 272, PVT + (hh * 64 + vt * 16) * 80, 80, 32, acc, fr, fq);
              ov[vt] = acc; ss += (acc.x * acc.x + acc.y * acc.y) + (acc.z * acc.z + acc.w * acc.w); }
          ss += __shfl_xor(ss, 16); ss += __shfl_xor(ss, 32);
          const float r = __builtin_amdgcn_rsqf(ss * (1.f / 64.f) + NORM_EPS);
#pragma unroll
          for (int vt = 0; vt < 4; ++vt) { const int col = hh * 64 + vt * 16 + 4 * fq; const f32x4 g = *(const f32x4*)(ng + col); const f32x4 og = UU4(t0 + t, U_GL_OG + col);
              MIX_ST4(mix, (size_t)(t0 + t) * D + 512 + col, ov[vt].x * r * g.x * siluf_(og.x), ov[vt].y * r * g.y * siluf_(og.y), ov[vt].z * r * g.z * siluf_(og.z), ov[vt].w * r * g.w * siluf_(og.w)); } } }
    __syncthreads();
}

__device__ __forceinline__ void mlstm_stage1(Frame& F, const Args& A, int layer, int b, int c) {
    const bf16* u = WSP(bf16, WS_U);
    LAS unsigned char* L = F.lds;
    LAS float* WST = (LAS float*)L; LAS unsigned char* KT = L + 1024; LAS unsigned char* VWT = KT + 256 * 144;
    const int t0 = b * SEQ + c * 64, tid = F.tid, lane = F.lane, wave = F.wave, fr = lane & 15, fq = lane >> 4;
    if (wave < 4) {
        const int hh = wave;
        const float ig = UU(t0 + lane, U_ML_I + hh) + KIN(I_MIB)[layer * 4 + hh];
        const float lf = logsigmoidf_(UU(t0 + lane, U_ML_F + hh) + KIN(I_MFB)[layer * 4 + hh]);
        const float bc = wave_scan_add(lf, lane); const float blast = __shfl(bc, 63);
        const float ast = blast - bc + ig; const float mloc = wave_max(ast);
        WST[hh * 64 + lane] = __expf(ast - mloc);
        if (lane == 0) { WSP(float, WS_ML_BL)[(b * 4 + hh) * NCH + c] = blast; WSP(float, WS_ML_ML)[(b * 4 + hh) * NCH + c] = mloc; }
    } else {
        const int kch = tid - 256, cc = 256 + kch; const float* cw = KIN(I_MCW) + (size_t)layer * 2048 + cc; const float w0 = cw[0], w1 = cw[512], w2 = cw[1024], w3 = cw[1536], cb = KIN(I_MCB)[layer * 512 + cc];
        const bf16* up = u + (size_t)t0 * NUP + U_ML_K + kch;
        float win0 = 0.f, win1 = 0.f, win2 = 0.f;
        if (c > 0) { win0 = bf2f(up[-3 * NUP]); win1 = bf2f(up[-2 * NUP]); win2 = bf2f(up[-1 * NUP]); }
#pragma unroll 1
        for (int l0 = 0; l0 < 64; l0 += 32) { float xv[32];
#pragma unroll
            for (int j = 0; j < 32; ++j) xv[j] = bf2f(up[(l0 + j) * NUP]);
#pragma unroll
            for (int j8 = 0; j8 < 4; ++j8) { float o[8];
#pragma unroll
                for (int j = 0; j < 8; ++j) { const float x = xv[j8 * 8 + j]; const float y = cb + w0 * win0 + w1 * win1 + w2 * win2 + w3 * x; win0 = win1; win1 = win2; win2 = x; o[j] = siluf_(y); }
                *(LAS v4u*)(KT + kch * 144 + (l0 + j8 * 8) * 2) = pack8(o); } }
    }
    __syncthreads();
    if (tid < 256) {
        const int vch = tid, hh = vch >> 6; const bf16* up = u + (size_t)t0 * NUP + U_ML_V + vch;
#pragma unroll 1
        for (int l0 = 0; l0 < 64; l0 += 32) { float xv[32];
#pragma unroll
            for (int j = 0; j < 32; ++j) xv[j] = bf2f(up[(l0 + j) * NUP]);
#pragma unroll
            for (int j8 = 0; j8 < 4; ++j8) { float o[8];
#pragma unroll
                for (int j = 0; j < 8; ++j) o[j] = xv[j8 * 8 + j] * WST[hh * 64 + l0 + j8 * 8 + j];
                *(LAS v4u*)(VWT + vch * 144 + (l0 + j8 * 8) * 2) = pack8(o); } }
    } else {
        const int kch = tid - 256, hh = kch >> 6; float n = 0.f;
#pragma unroll 8
        for (int s = 0; s < 64; ++s) n += WST[hh * 64 + s] * bf2f(*(const LAS unsigned short*)(KT + kch * 144 + s * 2));
        WSP(bf16, WS_ML_N)[((size_t)(b * 4 + hh) * NCH + c) * 64 + (kch & 63)] = (bf16)(cvt_pk_bf16(n, 0.f) & 0xffffu);
    }
    __syncthreads();
    { bf16* cst = WSP(bf16, WS_ML_C); const int hh = wave >> 1;
#pragma unroll 1
      for (int i = 0; i < 2; ++i) { const int vt = 2 * (wave & 1) + i;
#pragma unroll 1
          for (int kt = 0; kt < 4; ++kt) { f32x4 acc = {0.f, 0.f, 0.f, 0.f}; acc = mm16(VWT + (hh * 64 + vt * 16) * 144, 144, KT + (hh * 64 + kt * 16) * 144, 144, 64, acc, fr, fq);
              stb4(cst + (((size_t)(b * 4 + hh) * NCH + c) * 64 + vt * 16 + fr) * 64 + kt * 16 + 4 * fq, acc); } } }
    __syncthreads();
}
__device__ __forceinline__ void mlstm_stage3(Frame& F, const Args& A, int layer, int b, int c) {
    const bf16* u = WSP(bf16, WS_U);
    LAS unsigned char* L = F.lds;
    LAS float* BCU = (LAS float*)L; LAS float* GG = BCU + 256; LAS float* MROW = BCU + 512; LAS float* WINT = BCU + 768; LAS float* NPV = BCU + 1024;
    LAS unsigned char* Q = L + 6144; LAS unsigned char* KK = Q + 64 * 528; LAS unsigned char* VT = KK + 64 * 528; LAS unsigned char* SC = VT + 256 * 144;
    const int t0 = b * SEQ + c * 64, tid = F.tid, lane = F.lane, wave = F.wave, fr = lane & 15, fq = lane >> 4;
    if (wave < 4) {
        const int hh = wave;
        const float ig = UU(t0 + lane, U_ML_I + hh) + KIN(I_MIB)[layer * 4 + hh];
        const float lf = logsigmoidf_(UU(t0 + lane, U_ML_F + hh) + KIN(I_MFB)[layer * 4 + hh]);
        const float bc = wave_scan_add(lf, lane); const float gg = ig - bc;
        const float mprev = WSP(float, WS_ML_M)[(b * 4 + hh) * NCH + c];
        const float minter = bc + mprev, mintra = bc + wave_scan_max(gg, lane), mrow = fmaxf(minter, mintra);
        BCU[hh * 64 + lane] = bc; GG[hh * 64 + lane] = gg; MROW[hh * 64 + lane] = mrow; WINT[hh * 64 + lane] = __expf(minter - mrow);
        NPV[hh * 64 + lane] = bf2f(WSP(bf16, WS_ML_N)[((size_t)(b * 4 + hh) * NCH + c) * 64 + lane]);
    }
    {
        const int cc = tid; const float* cw = KIN(I_MCW) + (size_t)layer * 2048 + cc; const float w0 = cw[0], w1 = cw[512], w2 = cw[1024], w3 = cw[1536], cb = KIN(I_MCB)[layer * 512 + cc];
        const bf16* up = u + (size_t)t0 * NUP + U_ML_Q + cc;
        float win0 = 0.f, win1 = 0.f, win2 = 0.f;
        if (c > 0) { win0 = bf2f(up[-3 * NUP]); win1 = bf2f(up[-2 * NUP]); win2 = bf2f(up[-1 * NUP]); }
        LAS unsigned char* dst = cc < 256 ? Q + cc * 2 : KK + (cc - 256) * 2; const float sc = cc < 256 ? 0.125f : 1.0f;
#pragma unroll 1
        for (int l0 = 0; l0 < 64; l0 += 32) { float xv[32];
#pragma unroll
            for (int j = 0; j < 32; ++j) xv[j] = bf2f(up[(l0 + j) * NUP]);
#pragma unroll
            for (int j = 0; j < 32; ++j) { const float x = xv[j]; const float y = cb + w0 * win0 + w1 * win1 + w2 * win2 + w3 * x; win0 = win1; win1 = win2; win2 = x; lds_st_bf16(dst + (l0 + j) * 528, siluf_(y) * sc); } }
        const int vch = tid & 255, lh = (tid >> 8) * 32; const bf16* uv = u + (size_t)(t0 + lh) * NUP + U_ML_V + vch;
        float xv[32];
#pragma unroll
        for (int j = 0; j < 32; ++j) xv[j] = bf2f(uv[j * NUP]);
#pragma unroll
        for (int j8 = 0; j8 < 4; ++j8) { float o[8];
#pragma unroll
            for (int j = 0; j < 8; ++j) o[j] = xv[j8 * 8 + j];
            *(LAS v4u*)(VT + vch * 144 + (lh + j8 * 8) * 2) = pack8(o); }
    }
    __syncthreads();
    { const int hh = wave >> 1; bf16* mix = WSP(bf16, WS_MIX); const float* ng = KIN(I_MNG) + layer * 256;
      const bf16* cprev = WSP(bf16, WS_ML_C) + ((size_t)(b * 4 + hh) * NCH + c) * 4096;
      bf16x8 cf[4][2];
#pragma unroll
      for (int vt = 0; vt < 4; ++vt)
#pragma unroll
          for (int ks = 0; ks < 2; ++ks) cf[vt][ks] = *(const bf16x8*)(cprev + (size_t)(vt * 16 + fr) * 64 + ks * 32 + fq * 8);
#pragma unroll 1
      for (int i = 0; i < 2; ++i) { const int tt = 2 * (wave & 1) + i, t = tt * 16 + fr;
          const float bt = BCU[hh * 64 + t] - MROW[hh * 64 + t]; float rs = 0.f;
#pragma unroll
          for (int st = 0; st < 4; ++st) { f32x4 acc = {0.f, 0.f, 0.f, 0.f}; acc = mm16(Q + tt * 16 * 528 + hh * 128, 528, KK + st * 16 * 528 + hh * 128, 528, 64, acc, fr, fq);
              const int s0 = st * 16 + 4 * fq; float o[4];
#pragma unroll
              for (int j = 0; j < 4; ++j) { const int s = s0 + j; const float v = (t >= s) ? acc[j] * __expf(bt + GG[hh * 64 + s]) : 0.f; o[j] = v; rs += v; }
              lds_st_bf16x4(SC + hh * 9216 + t * 144 + s0 * 2, o[0], o[1], o[2], o[3]); }
          rs += __shfl_xor(rs, 16); rs += __shfl_xor(rs, 32);
          float nq = 0.f;
#pragma unroll
          for (int j = 0; j < 16; ++j) nq += bf2f(*(const LAS unsigned short*)(Q + t * 528 + (hh * 64 + fq * 16 + j) * 2)) * NPV[hh * 64 + fq * 16 + j];
          nq += __shfl_xor(nq, 16); nq += __shfl_xor(nq, 32);
          const float wi = WINT[hh * 64 + t]; const float den = wi * nq + rs; const float dn = fmaxf(fabsf(den), __expf(-MROW[hh * 64 + t])); const float rdn = 1.0f / dn;
          LDS_WAIT();
          f32x4 hv[4]; float sm = 0.f;
#pragma unroll
          for (int vt = 0; vt < 4; ++vt) { f32x4 acc = {0.f, 0.f, 0.f, 0.f};
              acc = mm16_rB<2>(Q + tt * 16 * 528 + hh * 128, 528, cf[vt], acc, fr, fq);
              acc = acc * wi;
              acc = mm16(SC + hh * 9216 + tt * 16 * 144, 144, VT + (hh * 64 + vt * 16) * 144, 144, 64, acc, fr, fq);
              const f32x4 og = UU4(t0 + t, U_ML_O + hh * 64 + vt * 16 + 4 * fq);
              f32x4 h; h.x = acc.x * rdn * sigmoidf_(og.x); h.y = acc.y * rdn * sigmoidf_(og.y); h.z = acc.z * rdn * sigmoidf_(og.z); h.w = acc.w * rdn * sigmoidf_(og.w);
              hv[vt] = h; sm += (h.x + h.y) + (h.z + h.w); }
          sm += __shfl_xor(sm, 16); sm += __shfl_xor(sm, 32);
          const float mean = sm * (1.f / 64.f); float sq = 0.f;
#pragma unroll
          for (int vt = 0; vt < 4; ++vt) { hv[vt] = hv[vt] - mean; sq += (hv[vt].x * hv[vt].x + hv[vt].y * hv[vt].y) + (hv[vt].z * hv[vt].z + hv[vt].w * hv[vt].w); }
          sq += __shfl_xor(sq, 16); sq += __shfl_xor(sq, 32);
          const float r = __builtin_amdgcn_rsqf(sq * (1.f / 64.f) + NORM_EPS);
#pragma unroll
          for (int vt = 0; vt < 4; ++vt) { const int col = hh * 64 + vt * 16 + 4 * fq; const f32x4 g = *(const f32x4*)(ng + col);
              MIX_ST4(mix, (size_t)(t0 + t) * D + 768 + col, hv[vt].x * r * g.x, hv[vt].y * r * g.y, hv[vt].z * r * g.z, hv[vt].w * r * g.w); } } }
    __syncthreads();
}

__device__ __forceinline__ void rwkv_stage1(Frame& F, const Args& A, int layer, int ub) {
    const bf16* u = WSP(bf16, WS_U);
    LAS unsigned char* L = F.lds;
    LAS unsigned char* LOWA = L;
    LAS float* CUM = (LAS float*)(L + 16384);
    LAS float* AAB = CUM;
    LAS float* TOT = CUM;
    LAS unsigned char* M0 = L + 16384 + 16640;
#define RM(i) (M0 + (i) * 9216)
    LAS float* GAMC = (LAS float*)(F.MISC + MW_GAMC);
    const int t0 = ub * 64, c = ub & 63, tid = F.tid, lane = F.lane, wave = F.wave;
    const float* mu = KIN(I_RMU) + layer * 896;
#ifndef RW_DUP
#define RW_DUP -1
#endif
#define RW_REP(k) for (int rep__ = 0; rep__ < ((RW_DUP == (k)) ? 2 : 1); ++rep__)
    RW_REP(0) {
    {
        const int l = tid >> 3, jq = tid & 7, t = t0 + l; const bool has_prev = (t & (SEQ - 1)) != 0;
        f32x4 cur[4], prv[4];
#pragma unroll
        for (int q = 0; q < 4; ++q) { cur[q] = UU4(t, U_RW_LO + jq * 16 + 4 * q); prv[q] = has_prev ? UU4(t - 1, U_RW_LO + jq * 16 + 4 * q) : (f32x4){0.f, 0.f, 0.f, 0.f}; }
#pragma unroll
        for (int q = 0; q < 4; ++q) { const f32x4 m4 = *(const f32x4*)(mu + 768 + jq * 16 + 4 * q); const f32x4 xs = cur[q] + (prv[q] - cur[q]) * m4; const int j = jq * 16 + 4 * q;
            f32x4 o;
            if (j < 32) { o.x = tanhf_(xs.x); o.y = tanhf_(xs.y); o.z = tanhf_(xs.z); o.w = tanhf_(xs.w); } else if (j < 64) o = xs; else { o.x = sigmoidf_(xs.x); o.y = sigmoidf_(xs.y); o.z = sigmoidf_(xs.z); o.w = sigmoidf_(xs.w); }
            if (j < 64) lds_st_bf16x4(LOWA + l * 144 + j * 2, o.x, o.y, o.z, o.w); else lds_st_bf16x4(RM(0) + l * 144 + (j - 64) * 2, o.x, o.y, o.z, o.w); }
    }
    __syncthreads();
    {
        bf16* RG = WSP(bf16, WS_RW_G); const int lane_ = F.lane, fr_ = lane_ & 15, fq_ = lane_ >> 4;
        const float* gupT = WSP(float, WS_LORA) + (size_t)layer * LORA_PER_LAYER + 16384;
#pragma unroll
        for (int ci = 0; ci < 2; ++ci) { const int ct = 2 * wave + ci; bf16x8 bf[2];
#pragma unroll
            for (int ks = 0; ks < 2; ++ks) bf[ks] = ldfrag_f32(gupT + (size_t)(ct * 16 + fr_) * 64 + ks * 32 + fq_ * 8);
#pragma unroll
            for (int tt = 0; tt < 4; ++tt) { f32x4 acc = {0.f, 0.f, 0.f, 0.f}; acc = mm16_rB<2>(RM(0) + tt * 16 * 144, 144, bf, acc, fr_, fq_);
                stb4(RG + (size_t)(t0 + tt * 16 + fr_) * 256 + ct * 16 + 4 * fq_, acc); } }
    }
    __syncthreads();
    }
    const int b_ = ub >> 6;
#pragma unroll 1
    for (int hh = 0; hh < 4; ++hh) {
        int ch = lane, fr = lane & 15, fq = lane >> 4; asm volatile("" : "+v"(ch), "+v"(fr), "+v"(fq));
        const int tg = wave, cg = hh * 64 + ch; const size_t un = (size_t)(b_ * 4 + hh) * NCH + c;
        float rr[8], k2r[8], vr[8], ar[8], br[8], pl[8];
        LAS float* WPA = (LAS float*)RM(8);
        {
            const int mat = wave >> 2, ct = wave & 3;
            const float* wT = WSP(float, WS_LORA) + (size_t)layer * LORA_PER_LAYER + mat * 8192 + (size_t)(hh * 64 + ct * 16 + fr) * 32 + fq * 8;
            bf16x8 bfw[1]; bfw[0] = ldfrag_f32(wT);
#pragma unroll
            for (int tt = 0; tt < 4; ++tt) { f32x4 acc = {0.f, 0.f, 0.f, 0.f}; acc = mm16_rB<1>(LOWA + tt * 16 * 144 + mat * 64, 144, bfw, acc, fr, fq);
                *(LAS f32x4*)(WPA + mat * 4096 + (tt * 16 + fr) * 64 + ct * 16 + 4 * fq) = acc; }
        }
        __syncthreads();
        RW_REP(1) {
            const float w0 = KIN(I_RW0)[layer * 256 + cg], a0 = KIN(I_RA0)[layer * 256 + cg], kkc = KIN(I_RKK)[layer * 256 + cg], kac = KIN(I_RKA)[layer * 256 + cg];
            const float mur = mu[cg], muk = mu[256 + cg], muv = mu[512 + cg];
            const int tb = t0 + tg * 8; const bool nop = (c == 0) && (tg == 0);
            float rp = nop ? 0.f : UU(tb - 1, U_RW_R + cg), kp = nop ? 0.f : UU(tb - 1, U_RW_K + cg), vp = nop ? 0.f : UU(tb - 1, U_RW_V + cg);
            float rc[8], kc[8], vc[8];
#pragma unroll
            for (int j = 0; j < 8; ++j) { rc[j] = UU(tb + j, U_RW_R + cg); kc[j] = UU(tb + j, U_RW_K + cg); vc[j] = UU(tb + j, U_RW_V + cg); }
            bf16* RW = WSP(bf16, WS_RW);
            float kk[8], al[8], n2[8], run = 0.f;
#pragma unroll
            for (int j = 0; j < 8; ++j) { const int l = tg * 8 + j;
                const float r = rc[j] + (rp - rc[j]) * mur, k = kc[j] + (kp - kc[j]) * muk, v = vc[j] + (vp - vc[j]) * muv; rp = rc[j]; kp = kc[j]; vp = vc[j];
                const float wp = w0 + WPA[l * 64 + ch], ap = a0 + WPA[4096 + l * 64 + ch];
                const float w = -softplusf_(-wp) - 0.5f; run += -__expf(w); pl[j] = run; al[j] = sigmoidf_(ap);
                kk[j] = k * kkc; n2[j] = kk[j] * kk[j];
                k2r[j] = k * (1.0f + (al[j] - 1.0f) * kac); rr[j] = r; vr[j] = v;
                bf16* o = RW + (size_t)(tb + j) * 768 + cg; o[0] = (bf16)(cvt_pk_bf16(r, 0.f) & 0xffffu); o[256] = (bf16)(cvt_pk_bf16(k2r[j], 0.f) & 0xffffu); o[512] = (bf16)(cvt_pk_bf16(v, 0.f) & 0xffffu); }
#pragma unroll
            for (int i = 0; i < 4; ++i) { const bool hi = (ch & 32) != 0; const float keep = hi ? n2[i + 4] : n2[i], send = hi ? n2[i] : n2[i + 4]; n2[i] = keep + __shfl_xor(send, 32); }
#pragma unroll
            for (int i = 0; i < 2; ++i) { const bool hi = (ch & 16) != 0; const float keep = hi ? n2[i + 2] : n2[i], send = hi ? n2[i] : n2[i + 2]; n2[i] = keep + __shfl_xor(send, 16); }
            { const bool hi = (ch & 8) != 0; const float keep = hi ? n2[1] : n2[0], send = hi ? n2[0] : n2[1]; n2[0] = keep + __shfl_xor(send, 8); }
            n2[0] += __shfl_xor(n2[0], 4); n2[0] += __shfl_xor(n2[0], 2); n2[0] += __shfl_xor(n2[0], 1);
#pragma unroll
            for (int j = 0; j < 8; ++j) { const float tot = __builtin_bit_cast(float, __builtin_amdgcn_readlane(__builtin_bit_cast(int, n2[0]), ((j & 4) ? 32 : 0) + ((j & 2) ? 16 : 0) + ((j & 1) ? 8 : 0)));
                const float kkn = kk[j] / fmaxf(sqrtf(tot), 1e-12f); ar[j] = -kkn; br[j] = kkn * al[j]; }
            TOT[tg * 64 + ch] = run;
        }
        __syncthreads();
        RW_REP(3) {
            float off = 0.f, gC = 0.f;
#pragma unroll
            for (int g = 0; g < 8; ++g) { const float tv = TOT[g * 64 + ch]; gC += tv; if (g < tg) off += tv; }
            float oat[8], obb[8], okb[8], ov[8];
#pragma unroll
            for (int j = 0; j < 8; ++j) { const int l = tg * 8 + j; const float gt = off + pl[j], gm = j > 0 ? off + pl[j - 1] : off;
                const float at = ar[j] * __expf(gm), rt = rr[j] * __expf(gt), en = __expf(-gt), ec = __expf(gC - gt);
                lds_st_bf16(RM(0) + l * 144 + ch * 2, at); lds_st_bf16(RM(1) + l * 144 + ch * 2, rt); lds_st_bf16(RM(2) + l * 144 + ch * 2, br[j] * en); lds_st_bf16(RM(3) + l * 144 + ch * 2, k2r[j] * en);
                oat[j] = at; obb[j] = br[j] * ec; okb[j] = k2r[j] * ec; ov[j] = vr[j]; }
            *(LAS v4u*)(RM(4) + ch * 144 + tg * 16) = pack8(oat); *(LAS v4u*)(RM(5) + ch * 144 + tg * 16) = pack8(obb); *(LAS v4u*)(RM(6) + ch * 144 + tg * 16) = pack8(okb); *(LAS v4u*)(RM(7) + ch * 144 + tg * 16) = pack8(ov);
            if (tg == 0) GAMC[ch] = __expf(gC);
        }
        __syncthreads();
        RW_REP(4) {
            const int which = wave >> 1; const LAS unsigned char* Aop = which < 2 ? RM(0) : RM(1); const LAS unsigned char* Bop = (which & 1) ? RM(3) : RM(2);
#pragma unroll 1
            for (int i2 = 0; i2 < 2; ++i2) { const int tt = 2 * (wave & 1) + i2, t = tt * 16 + fr;
#pragma unroll
                for (int it = 0; it < 4; ++it) { f32x4 acc = {0.f, 0.f, 0.f, 0.f}; acc = mm16(Aop + tt * 16 * 144, 144, Bop + it * 16 * 144, 144, 64, acc, fr, fq);
                    const int i0 = it * 16 + 4 * fq; const int lim = which < 2 ? t : t + 1;
                    const float o0 = (i0 < lim) ? acc[0] : 0.f, o1 = (i0 + 1 < lim) ? acc[1] : 0.f, o2 = (i0 + 2 < lim) ? acc[2] : 0.f, o3 = (i0 + 3 < lim) ? acc[3] : 0.f;
#ifdef RW_CLAMP_AAK
                    float q0 = o0, q1 = o1, q2 = o2, q3 = o3;
                    if (which == 1) { q0 = fabsf(o0) < 1e30f ? o0 : 0.f; q1 = fabsf(o1) < 1e30f ? o1 : 0.f; q2 = fabsf(o2) < 1e30f ? o2 : 0.f; q3 = fabsf(o3) < 1e30f ? o3 : 0.f; }
                    if (which == 0) *(LAS f32x4*)(AAB + t * 64 + i0) = (f32x4){o0, o1, o2, o3};
                    else lds_st_bf16x4(RM(7 + which) + t * 144 + i0 * 2, q0, q1, q2, q3);
                    continue;
#endif
                    if (which == 0) { DBG_STAT(11, o0); DBG_STAT(11, o1); DBG_STAT(11, o2); DBG_STAT(11, o3); } if (which == 1) { DBG_STAT(12, o0); DBG_STAT(12, o1); DBG_STAT(12, o2); DBG_STAT(12, o3); } if (which == 2) { DBG_STAT(13, o0); DBG_STAT(13, o3); } if (which == 3) { DBG_STAT(14, o0); DBG_STAT(14, o3); }
                    if (which == 0) *(LAS f32x4*)(AAB + t * 64 + i0) = (f32x4){o0, o1, o2, o3};
                    else lds_st_bf16x4(RM(7 + which) + t * 144 + i0 * 2, o0, o1, o2, o3); } }
        }
        __syncthreads();
        RW_REP(5) {
#pragma unroll 1
            for (int i2 = 0; i2 < 2; ++i2) { const int idx = wave * 2 + i2, vt = idx >> 2, tt = idx & 3; f32x4 acc = {0.f, 0.f, 0.f, 0.f};
                acc = mm16(RM(7) + vt * 16 * 144, 144, RM(8) + tt * 16 * 144, 144, 64, acc, fr, fq);
                DBG_STAT(15, acc[0]); DBG_STAT(15, acc[1]); DBG_STAT(15, acc[2]); DBG_STAT(15, acc[3]);
                lds_st_bf16x4(RM(0) + (vt * 16 + fr) * 144 + (tt * 16 + 4 * fq) * 2, acc[0], acc[1], acc[2], acc[3]); }
        }
#if RW_SOLVE_BLK
        LAS unsigned char* T11T = L + 143616;
        LAS unsigned char* YT = RM(8);
        RW_REP(8) if (wave < 2) {
            const int R0 = wave * 32; float x[32]; f32x4 rowq[8];
#pragma unroll
            for (int tl = 0; tl < 32; ++tl) {
                f32x4 cur[8];
#pragma unroll
                for (int i4 = 0; i4 < (tl + 3) / 4; ++i4) cur[i4] = rowq[i4];
                if (tl + 1 < 32) {
#pragma unroll
                    for (int i4 = 0; i4 < (tl + 4) / 4; ++i4) rowq[i4] = *(const LAS f32x4*)(AAB + (R0 + tl + 1) * 64 + R0 + 4 * i4); }
                float a0 = (R0 + tl == ch) ? 1.0f : 0.f, a1 = 0.f, a2 = 0.f, a3 = 0.f;
#pragma unroll
                for (int i4 = 0; i4 < (tl + 3) / 4; ++i4) { const f32x4 q = cur[i4];
                    a0 += q.x * x[4 * i4]; if (4 * i4 + 1 < tl) a1 += q.y * x[4 * i4 + 1]; if (4 * i4 + 2 < tl) a2 += q.z * x[4 * i4 + 2]; if (4 * i4 + 3 < tl) a3 += q.w * x[4 * i4 + 3]; }
                const float acc = (a0 + a1) + (a2 + a3);
                x[tl] = acc; if (wave == 0 || ch >= 32) lds_st_bf16(RM(11) + (R0 + tl) * 144 + ch * 2, acc); }
            if (wave == 0 && ch < 32) {
#pragma unroll
                for (int q = 0; q < 4; ++q) { const float xv[8] = {x[8 * q], x[8 * q + 1], x[8 * q + 2], x[8 * q + 3], x[8 * q + 4], x[8 * q + 5], x[8 * q + 6], x[8 * q + 7]}; *(LAS v4u*)(T11T + ch * 80 + q * 16) = pack8(xv); } }
        }
        __syncthreads();
        if (wave < 4) {
            const int jt = wave >> 1, it = wave & 1; bf16x8 bfa[1];
            { const LAS float* ap = AAB + (32 + it * 16 + fr) * 64 + 8 * fq; const f32x4 p0 = *(const LAS f32x4*)ap, p1 = *(const LAS f32x4*)(ap + 4);
              v4u w; w.x = cvt_pk_bf16(p0.x, p0.y); w.y = cvt_pk_bf16(p0.z, p0.w); w.z = cvt_pk_bf16(p1.x, p1.y); w.w = cvt_pk_bf16(p1.z, p1.w); bfa[0] = __builtin_bit_cast(bf16x8, w); }
            f32x4 acc = {0.f, 0.f, 0.f, 0.f}; acc = mm16_rB<1>(T11T + jt * 16 * 80, 80, bfa, acc, fr, fq);
            lds_st_bf16x4(YT + (jt * 16 + fr) * 80 + (it * 16 + 4 * fq) * 2, acc[0], acc[1], acc[2], acc[3]);
        }
        __syncthreads();
        if (wave < 4) {
            const int it = wave >> 1, jt = wave & 1;
            f32x4 acc = {0.f, 0.f, 0.f, 0.f}; acc = mm16(RM(11) + (32 + it * 16) * 144 + 64, 144, YT + jt * 16 * 80, 80, 32, acc, fr, fq);
            lds_st_bf16x4(RM(11) + (32 + it * 16 + fr) * 144 + (jt * 16 + 4 * fq) * 2, acc[0], acc[1], acc[2], acc[3]);
        }
        __syncthreads();
#else
        RW_REP(8) if (wave == 0) {
            float x[64]; f32x4 rowq[16];
#pragma unroll
            for (int t = 0; t < 64; ++t) {
                f32x4 cur[16];
#pragma unroll
                for (int i4 = 0; i4 < (t + 3) / 4; ++i4) cur[i4] = rowq[i4];
                if (t + 1 < 64) {
#pragma unroll
                    for (int i4 = 0; i4 < (t + 4) / 4; ++i4) rowq[i4] = *(const LAS f32x4*)(AAB + (t + 1) * 64 + 4 * i4); }
                float a0 = (t == ch) ? 1.0f : 0.f, a1 = 0.f, a2 = 0.f, a3 = 0.f;
#pragma unroll
                for (int i4 = 0; i4 < (t + 3) / 4; ++i4) { const f32x4 q = cur[i4];
                    a0 += q.x * x[4 * i4]; if (4 * i4 + 1 < t) a1 += q.y * x[4 * i4 + 1]; if (4 * i4 + 2 < t) a2 += q.z * x[4 * i4 + 2]; if (4 * i4 + 3 < t) a3 += q.w * x[4 * i4 + 3]; }
                const float acc = (a0 + a1) + (a2 + a3);
                x[t] = acc; lds_st_bf16(RM(11) + t * 144 + ch * 2, acc); }
        }
        __syncthreads();
#endif
        RW_REP(6) {
            const int rt = wave >> 1;
#pragma unroll
            for (int i2 = 0; i2 < 2; ++i2) { const int tt = 2 * (wave & 1) + i2;
                f32x4 acc = {0.f, 0.f, 0.f, 0.f}; acc = mm16(RM(4) + rt * 16 * 144, 144, RM(11) + tt * 16 * 144, 144, 64, acc, fr, fq);
                DBG_STAT(17, acc[0]); DBG_STAT(17, acc[1]); DBG_STAT(17, acc[2]); DBG_STAT(17, acc[3]);
                lds_st_bf16x4(RM(2) + (rt * 16 + fr) * 144 + (tt * 16 + 4 * fq) * 2, acc[0], acc[1], acc[2], acc[3]);
                f32x4 ac2 = {0.f, 0.f, 0.f, 0.f}; ac2 = mm16(RM(0) + rt * 16 * 144, 144, RM(11) + tt * 16 * 144, 144, 64, ac2, fr, fq);
                DBG_STAT(18, ac2[0]); DBG_STAT(18, ac2[1]); DBG_STAT(18, ac2[2]); DBG_STAT(18, ac2[3]);
                lds_st_bf16x4(RM(3) + (rt * 16 + fr) * 144 + (tt * 16 + 4 * fq) * 2, ac2[0], ac2[1], ac2[2], ac2[3]); }
        }
        __syncthreads();
        RW_REP(7) {
            const int which = wave >> 1;
#pragma unroll 1
            for (int i2 = 0; i2 < 2; ++i2) { const int rt = 2 * (wave & 1) + i2, row = rt * 16 + fr;
#pragma unroll
                for (int ct = 0; ct < 4; ++ct) { f32x4 acc = {0.f, 0.f, 0.f, 0.f}; const int c0 = ct * 16 + 4 * fq;
                    if (which == 0) { acc = mm16(RM(9) + rt * 16 * 144, 144, RM(2) + ct * 16 * 144, 144, 64, acc, fr, fq);
                        const v2u rw = *(const LAS v2u*)(RM(1) + row * 144 + c0 * 2);
                        acc[0] += __uint_as_float(rw.x << 16); acc[1] += __uint_as_float(rw.x & 0xffff0000u); acc[2] += __uint_as_float(rw.y << 16); acc[3] += __uint_as_float(rw.y & 0xffff0000u);
                        DBG_STAT(19, acc[0]); DBG_STAT(19, acc[1]); DBG_STAT(19, acc[2]); DBG_STAT(19, acc[3]);
                        v2u o; o.x = cvt_pk_bf16(acc[0], acc[1]); o.y = cvt_pk_bf16(acc[2], acc[3]); *(v2u*)(WSP(bf16, WS_RW_RH) + un * 4096 + row * 64 + c0) = o; }
                    else if (which == 1) {
#ifndef RW_NO_U0
                        acc = mm16(RM(9) + rt * 16 * 144, 144, RM(3) + ct * 16 * 144, 144, 64, acc, fr, fq);
#endif
                        acc = mm16(RM(10) + rt * 16 * 144, 144, RM(7) + ct * 16 * 144, 144, 64, acc, fr, fq);
                        DBG_STAT(20, acc[0]); DBG_STAT(20, acc[1]); DBG_STAT(20, acc[2]); DBG_STAT(20, acc[3]);
                        stb4(WSP(bf16, WS_RW_O0) + un * 4096 + row * 64 + c0, acc); }
                    else if (which == 2) { acc = mm16(RM(5) + rt * 16 * 144, 144, RM(2) + ct * 16 * 144, 144, 64, acc, fr, fq);
                        const float gd = GAMC[row]; if (row == c0) acc[0] += gd; if (row == c0 + 1) acc[1] += gd; if (row == c0 + 2) acc[2] += gd; if (row == c0 + 3) acc[3] += gd;
                        DBG_STAT(21, acc[0]); DBG_STAT(21, acc[1]); DBG_STAT(21, acc[2]); DBG_STAT(21, acc[3]);
                        v2u o; o.x = cvt_pk_bf16(acc[0], acc[1]); o.y = cvt_pk_bf16(acc[2], acc[3]);
                        *(v2u*)((unsigned char*)(WSP(bf16, WS_RW_GF) + un * 4096) + ((rt * 2 + (ct >> 1)) * 64 + ch) * 16 + (ct & 1) * 8) = o; }
                    else { acc = mm16(RM(3) + rt * 16 * 144, 144, RM(5) + ct * 16 * 144, 144, 64, acc, fr, fq); acc = mm16(RM(7) + rt * 16 * 144, 144, RM(6) + ct * 16 * 144, 144, 64, acc, fr, fq);
                        DBG_STAT(22, acc[0]); DBG_STAT(22, acc[1]); DBG_STAT(22, acc[2]); DBG_STAT(22, acc[3]);
                        *(f32x4*)(WSP(float, WS_RW_HT) + un * 4096 + row * 64 + c0) = acc; } } }
        }
        __syncthreads();
    }
#undef RM
}
#if RW_SCAN_DMA
__device__ __forceinline__ void rwkv_scan_wave(Frame& F, const Args& A, int wslot) {
    const int lane = F.lane, fr = lane & 15, fq = lane >> 4, bh = wslot >> 2, v0 = (wslot & 3) * 16;
    const unsigned char* GFb = (const unsigned char*)(WSP(bf16, WS_RW_GF) + (size_t)bh * NCH * 4096) + lane * 16;
    const unsigned char* HTb = (const unsigned char*)(WSP(float, WS_RW_HT) + (size_t)bh * NCH * 4096 + (size_t)(v0 + fr) * 64 + 4 * fq);
    bf16* PT = WSP(bf16, WS_RW_PT) + (size_t)bh * NCH * 4096 + (size_t)(v0 + fr) * 64 + 4 * fq;
    LAS unsigned char* ring = F.lds;
    f32x4 P[4] = {{0.f, 0.f, 0.f, 0.f}, {0.f, 0.f, 0.f, 0.f}, {0.f, 0.f, 0.f, 0.f}, {0.f, 0.f, 0.f, 0.f}};
#define RW2_ISSUE(cc, sl) do { _Pragma("unroll") for (int f_ = 0; f_ < 8; ++f_) __builtin_amdgcn_global_load_lds((const unsigned*)(GFb + (size_t)(cc) * 8192 + f_ * 1024), (LAS unsigned*)(ring + (sl) * 12288 + f_ * 1024), 16, 0, 0); \
        _Pragma("unroll") for (int m_ = 0; m_ < 4; ++m_) __builtin_amdgcn_global_load_lds((const unsigned*)(HTb + (size_t)(cc) * 16384 + m_ * 64), (LAS unsigned*)(ring + (sl) * 12288 + 8192 + m_ * 1024), 16, 0, 0); } while (0)
#define RW2_STEP(cc, sl, NW) do { asm volatile("s_waitcnt vmcnt(" #NW ")" ::: "memory"); \
        const LAS unsigned char* sp_ = ring + (sl) * 12288 + lane * 16; bf16x8 gx[4][2]; f32x4 hx[4]; \
        _Pragma("unroll") for (int m = 0; m < 4; ++m) { hx[m] = *(const LAS f32x4*)(sp_ + 8192 + m * 1024); _Pragma("unroll") for (int s = 0; s < 2; ++s) gx[m][s] = *(const LAS bf16x8*)(sp_ + (m * 2 + s) * 1024); } \
        v4u bs[2]; \
        _Pragma("unroll") for (int s = 0; s < 2; ++s) { bs[s].x = cvt_pk_bf16(P[2 * s][0], P[2 * s][1]); bs[s].y = cvt_pk_bf16(P[2 * s][2], P[2 * s][3]); bs[s].z = cvt_pk_bf16(P[2 * s + 1][0], P[2 * s + 1][1]); bs[s].w = cvt_pk_bf16(P[2 * s + 1][2], P[2 * s + 1][3]); } \
        *(v2u*)(PT + (size_t)(cc) * 4096) = (v2u){bs[0].x, bs[0].y}; *(v2u*)(PT + (size_t)(cc) * 4096 + 16) = (v2u){bs[0].z, bs[0].w}; \
        *(v2u*)(PT + (size_t)(cc) * 4096 + 32) = (v2u){bs[1].x, bs[1].y}; *(v2u*)(PT + (size_t)(cc) * 4096 + 48) = (v2u){bs[1].z, bs[1].w}; \
        _Pragma("unroll") for (int m = 0; m < 4; ++m) { f32x4 acc = hx[m]; acc = __builtin_amdgcn_mfma_f32_16x16x32_bf16(gx[m][0], __builtin_bit_cast(bf16x8, bs[0]), acc, 0, 0, 0); \
            acc = __builtin_amdgcn_mfma_f32_16x16x32_bf16(gx[m][1], __builtin_bit_cast(bf16x8, bs[1]), acc, 0, 0, 0); P[m] = acc; } \
        asm volatile("s_waitcnt lgkmcnt(0)" ::: "memory"); } while (0)
    RW2_ISSUE(0, 0); RW2_ISSUE(1, 1); RW2_ISSUE(2, 2);
    RW2_ISSUE(3, 3); RW2_STEP(0, 0, 36); RW2_ISSUE(4, 0); RW2_STEP(1, 1, 40); RW2_ISSUE(5, 1); RW2_STEP(2, 2, 44); RW2_ISSUE(6, 2); RW2_STEP(3, 3, 48);
#pragma unroll 1
    for (int c = 4; c < 60; c += 4) {
        RW2_ISSUE(c + 3, 3); RW2_STEP(c, 0, 48); RW2_ISSUE(c + 4, 0); RW2_STEP(c + 1, 1, 48); RW2_ISSUE(c + 5, 1); RW2_STEP(c + 2, 2, 48); RW2_ISSUE(c + 6, 2); RW2_STEP(c + 3, 3, 48);
    }
    RW2_ISSUE(63, 3); RW2_STEP(60, 0, 48); RW2_STEP(61, 1, 36); RW2_STEP(62, 2, 24); RW2_STEP(63, 3, 12);
#undef RW2_ISSUE
#undef RW2_STEP
}
#else
__device__ __forceinline__ void rwkv_scan_wave(Frame& F, const Args& A, int wslot) {
    const int lane = F.lane, fr = lane & 15, fq = lane >> 4, bh = wslot >> 2, v0 = (wslot & 3) * 16;
    const bf16* GF = WSP(bf16, WS_RW_GF) + (size_t)bh * NCH * 4096; const float* HT = WSP(float, WS_RW_HT) + (size_t)bh * NCH * 4096 + (size_t)(v0 + fr) * 64 + 4 * fq;
    bf16* PT = WSP(bf16, WS_RW_PT) + (size_t)bh * NCH * 4096 + (size_t)(v0 + fr) * 64 + 4 * fq;
    f32x4 P[4] = {{0.f, 0.f, 0.f, 0.f}, {0.f, 0.f, 0.f, 0.f}, {0.f, 0.f, 0.f, 0.f}, {0.f, 0.f, 0.f, 0.f}};
    bf16x8 g0[4][2], g1[4][2], g2[4][2]; f32x4 h0[4], h1[4], h2[4];
#define RW2_LOAD(gx, hx, cc) do { _Pragma("unroll") for (int m = 0; m < 4; ++m) { hx[m] = *(const f32x4*)(HT + (size_t)(cc) * 4096 + 16 * m); \
        _Pragma("unroll") for (int s = 0; s < 2; ++s) gx[m][s] = *(const bf16x8*)(GF + (size_t)(cc) * 4096 + ((m * 2 + s) * 64 + lane) * 8); } } while (0)
#define RW2_STEP(gx, hx, cc) do { v4u bs[2]; \
        _Pragma("unroll") for (int s = 0; s < 2; ++s) { bs[s].x = cvt_pk_bf16(P[2 * s][0], P[2 * s][1]); bs[s].y = cvt_pk_bf16(P[2 * s][2], P[2 * s][3]); bs[s].z = cvt_pk_bf16(P[2 * s + 1][0], P[2 * s + 1][1]); bs[s].w = cvt_pk_bf16(P[2 * s + 1][2], P[2 * s + 1][3]); } \
        *(v2u*)(PT + (size_t)(cc) * 4096) = (v2u){bs[0].x, bs[0].y}; *(v2u*)(PT + (size_t)(cc) * 4096 + 16) = (v2u){bs[0].z, bs[0].w}; \
        *(v2u*)(PT + (size_t)(cc) * 4096 + 32) = (v2u){bs[1].x, bs[1].y}; *(v2u*)(PT + (size_t)(cc) * 4096 + 48) = (v2u){bs[1].z, bs[1].w}; \
        _Pragma("unroll") for (int m = 0; m < 4; ++m) { f32x4 acc = hx[m]; acc = __builtin_amdgcn_mfma_f32_16x16x32_bf16(gx[m][0], __builtin_bit_cast(bf16x8, bs[0]), acc, 0, 0, 0); \
            acc = __builtin_amdgcn_mfma_f32_16x16x32_bf16(gx[m][1], __builtin_bit_cast(bf16x8, bs[1]), acc, 0, 0, 0); P[m] = acc; } } while (0)
    RW2_LOAD(g0, h0, 0); RW2_LOAD(g1, h1, 1);
#pragma unroll 1
    for (int c = 0; c < 63; c += 3) {
        RW2_LOAD(g2, h2, c + 2); RW2_STEP(g0, h0, c);
        RW2_LOAD(g0, h0, c + 3); RW2_STEP(g1, h1, c + 1);
        if (c + 4 < NCH) RW2_LOAD(g1, h1, c + 4);
        RW2_STEP(g2, h2, c + 2);
    }
    RW2_STEP(g0, h0, 63);
#undef RW2_LOAD
#undef RW2_STEP
}
#endif
__device__ __forceinline__ void rwkv_stage3(Frame& F, const Args& A, int layer, int ub) {
    const int t0 = ub * 64, b_ = ub >> 6, c = ub & 63, lane = F.lane, wave = F.wave, fr = lane & 15, fq = lane >> 4, hh = wave >> 1;
    const size_t un = (size_t)(b_ * 4 + hh) * NCH + c;
    const bf16* RH = WSP(bf16, WS_RW_RH) + un * 4096; const bf16* PT = WSP(bf16, WS_RW_PT) + un * 4096; const bf16* O0 = WSP(bf16, WS_RW_O0) + un * 4096;
    const bf16* RW = WSP(bf16, WS_RW); const bf16* RG = WSP(bf16, WS_RW_G); bf16* mix = WSP(bf16, WS_MIX);
    const float* lg = KIN(I_RLNG) + layer * 256 + hh * 64; const float* lb = KIN(I_RLNB) + layer * 256 + hh * 64; const float* rk = KIN(I_RRK) + layer * 256 + hh * 64;
    bf16x8 pfr[4][2];
#pragma unroll
    for (int vt = 0; vt < 4; ++vt)
#pragma unroll
        for (int ks = 0; ks < 2; ++ks) pfr[vt][ks] = *(const bf16x8*)(PT + (size_t)(vt * 16 + fr) * 64 + ks * 32 + fq * 8);
#pragma unroll 1
    for (int i = 0; i < 2; ++i) { const int tt = 2 * (wave & 1) + i, tl = tt * 16 + fr, t = t0 + tl;
        const bf16x8 ra0 = *(const bf16x8*)(RH + (size_t)tl * 64 + fq * 8), ra1 = *(const bf16x8*)(RH + (size_t)tl * 64 + 32 + fq * 8);
        f32x4 ov[4]; float sm = 0.f;
#pragma unroll
        for (int vt = 0; vt < 4; ++vt) { f32x4 acc = ldb4(O0 + tl * 64 + vt * 16 + 4 * fq);
            acc = __builtin_amdgcn_mfma_f32_16x16x32_bf16(pfr[vt][0], ra0, acc, 0, 0, 0); acc = __builtin_amdgcn_mfma_f32_16x16x32_bf16(pfr[vt][1], ra1, acc, 0, 0, 0);
            ov[vt] = acc; DBG_STAT(24, acc[0]); DBG_STAT(24, acc[1]); DBG_STAT(24, acc[2]); DBG_STAT(24, acc[3]); sm += (acc.x + acc.y) + (acc.z + acc.w); }
        sm += __shfl_xor(sm, 16); sm += __shfl_xor(sm, 32);
        const float mean = sm * (1.f / 64.f); float sq = 0.f;
#pragma unroll
        for (int vt = 0; vt < 4; ++vt) { ov[vt] = ov[vt] - mean; sq += (ov[vt].x * ov[vt].x + ov[vt].y * ov[vt].y) + (ov[vt].z * ov[vt].z + ov[vt].w * ov[vt].w); }
        sq += __shfl_xor(sq, 16); sq += __shfl_xor(sq, 32);
        const float rs = __builtin_amdgcn_rsqf(sq * (1.f / 64.f) + RWKV_GN_EPS);
        float bd = 0.f;
#pragma unroll
        for (int q = 0; q < 4; ++q) { const f32x4 r4 = ldb4(RW + (size_t)t * 768 + hh * 64 + fq * 16 + 4 * q), k4 = ldb4(RW + (size_t)t * 768 + 256 + hh * 64 + fq * 16 + 4 * q), c4 = *(const f32x4*)(rk + fq * 16 + 4 * q);
            bd += (r4.x * k4.x * c4.x + r4.y * k4.y * c4.y) + (r4.z * k4.z * c4.z + r4.w * k4.w * c4.w); }
        bd += __shfl_xor(bd, 16); bd += __shfl_xor(bd, 32);
#pragma unroll
        for (int vt = 0; vt < 4; ++vt) { const int col = vt * 16 + 4 * fq; const f32x4 g4 = *(const f32x4*)(lg + col), b4 = *(const f32x4*)(lb + col);
            const f32x4 v4 = ldb4(RW + (size_t)t * 768 + 512 + hh * 64 + col), gg = ldb4(RG + (size_t)t * 256 + hh * 64 + col);
            float e0 = (ov[vt].x * rs * g4.x + b4.x + bd * v4.x) * gg.x, e1 = (ov[vt].y * rs * g4.y + b4.y + bd * v4.y) * gg.y, e2 = (ov[vt].z * rs * g4.z + b4.z + bd * v4.z) * gg.z, e3 = (ov[vt].w * rs * g4.w + b4.w + bd * v4.w) * gg.w;
#ifdef RW_SANITIZE
            e0 = (fabsf(e0) < 1e30f) ? e0 : 0.f; e1 = (fabsf(e1) < 1e30f) ? e1 : 0.f; e2 = (fabsf(e2) < 1e30f) ? e2 : 0.f; e3 = (fabsf(e3) < 1e30f) ? e3 : 0.f;
#endif
            MIX_ST4(mix, (size_t)t * D + 256 + hh * 64 + col, e0, e1, e2, e3); } }
}

constexpr int SCAN_N_MAIN = 16 * 64 * 128 / 2 + 16 * 32 * 64 / 2 + 16 * 64 * 64 / 2, SCAN_N_ALL = SCAN_N_MAIN + 16 * 64 / 2;
__device__ __forceinline__ void scans_elementwise(Frame& F, const Args& A, int gt, int nthr, int lo, int hi) {
    constexpr int N_SSD = 16 * 64 * 128 / 2, N_GLA = 16 * 32 * 64 / 2, N_MLC = 16 * 64 * 64 / 2, N_MLN = 16 * 64 / 2;
    for (int i = lo + gt; i < hi; i += nthr) {
        if (i < N_SSD) { const int bh = i >> 12, pn = (i & 4095) * 2; unsigned* base = (unsigned*)(WSP(bf16, WS_SSD_ST) + (size_t)bh * NCH * 8192 + pn); const float* dec = WSP(float, WS_SSD_DEC) + bh * NCH; float S0 = 0.f, S1 = 0.f;
#pragma unroll 1
            for (int c0 = 0; c0 < NCH; c0 += 32) { unsigned x[32]; float dd[32];
#pragma unroll
                for (int j = 0; j < 32; ++j) { x[j] = base[(size_t)(c0 + j) * 4096]; dd[j] = dec[c0 + j]; }
#pragma unroll
                for (int j = 0; j < 32; ++j) { base[(size_t)(c0 + j) * 4096] = cvt_pk_bf16(S0, S1); S0 = dd[j] * S0 + __uint_as_float(x[j] << 16); S1 = dd[j] * S1 + __uint_as_float(x[j] & 0xffff0000u); } }
        } else if (i < N_SSD + N_GLA) { const int k = i - N_SSD, bh = k >> 10, dv = (k & 1023) * 2, dd_ = dv >> 6, b = bh >> 2, hh = bh & 3; unsigned* base = (unsigned*)(WSP(bf16, WS_GLA_ST) + (size_t)bh * NCH * 2048 + dv); const float* dec = WSP(float, WS_GLA_DEC) + (size_t)b * NCH * 128 + hh * 32 + dd_; float S0 = 0.f, S1 = 0.f;
#pragma unroll 1
            for (int c0 = 0; c0 < NCH; c0 += 32) { unsigned x[32]; float dd[32];
#pragma unroll
                for (int j = 0; j < 32; ++j) { x[j] = base[(size_t)(c0 + j) * 1024]; dd[j] = dec[(c0 + j) * 128]; }
#pragma unroll
                for (int j = 0; j < 32; ++j) { base[(size_t)(c0 + j) * 1024] = cvt_pk_bf16(S0, S1); S0 = dd[j] * S0 + __uint_as_float(x[j] << 16); S1 = dd[j] * S1 + __uint_as_float(x[j] & 0xffff0000u); } }
        } else { const int k = i - N_SSD - N_GLA; const bool isn = k >= N_MLC; const int kk = isn ? k - N_MLC : k; const int bh = isn ? (kk >> 5) : (kk >> 11), e = (isn ? (kk & 31) : (kk & 2047)) * 2, str = isn ? 32 : 2048;
            unsigned* base = (unsigned*)((isn ? WSP(bf16, WS_ML_N) : WSP(bf16, WS_ML_C)) + (size_t)bh * NCH * str * 2 + e); const float* bl = WSP(float, WS_ML_BL) + bh * NCH; const float* ml = WSP(float, WS_ML_ML) + bh * NCH; float* mo = WSP(float, WS_ML_M) + bh * NCH;
            float S0 = 0.f, S1 = 0.f, m = 0.f;
#pragma unroll 1
            for (int c0 = 0; c0 < NCH; c0 += 32) { unsigned x[32]; float b8[32], m8[32];
#pragma unroll
                for (int j = 0; j < 32; ++j) { x[j] = base[(size_t)(c0 + j) * str]; b8[j] = bl[c0 + j]; m8[j] = ml[c0 + j]; }
#pragma unroll
                for (int j = 0; j < 32; ++j) { const float mn = fmaxf(b8[j] + m, m8[j]); const float so = __expf(b8[j] + m - mn), sn = __expf(m8[j] - mn);
                    base[(size_t)(c0 + j) * str] = cvt_pk_bf16(S0, S1); if (!isn && e == 0) mo[c0 + j] = m; S0 = so * S0 + sn * __uint_as_float(x[j] << 16); S1 = so * S1 + sn * __uint_as_float(x[j] & 0xffff0000u); m = mn; } }
        }
    }
}
#ifndef MK_PER_PHASE_LAUNCH
#define MK_PER_PHASE_LAUNCH 0
#endif
#ifndef PH_MASK
#define PH_MASK 0xFFF
#endif
#ifndef ST_MASK
#define ST_MASK 0xF
#endif
#define ST_ON(k) (((ST_MASK) >> (k)) & 1)
#ifndef DUP_MASK
#define DUP_MASK 0
#endif
#define DUP_N(k) ((((DUP_MASK) >> (k)) & 1) ? 2 : 1)
#ifndef ST_DUP
#define ST_DUP 0
#endif
#define ST_REP(ty) ((((ST_DUP) >> (ty)) & 1) ? 2 : 1)
#define PH_ON(k) (((PH_MASK) >> (k)) & 1)
constexpr int PH_PER_LAYER = 11, N_PHASES = 1 + DEPTH * PH_PER_LAYER;
__global__ void __launch_bounds__(NWAVES * 64, 2) fwd_kernel(Args args) {
    extern __shared__ __attribute__((aligned(16))) unsigned char lds[];
    Frame F;
    F.lds = (LAS unsigned char*)lds;
    F.MISC = (volatile LAS unsigned*)(F.lds + MISC_OFF);
    F.tid = threadIdx.x; F.lane = F.tid & 63; F.wave = __builtin_amdgcn_readfirstlane(F.tid >> 6);
    F.G = gridDim.x; { const int bx = blockIdx.x; F.vcu = (F.G % 8 == 0) ? (bx % 8) * (F.G / 8) + bx / 8 : bx; }
    F.ka = (karg_t)__builtin_amdgcn_kernarg_segment_ptr(); F.ws = args.ws; F.ctl = (gu32*)(args.ws + WS_CTL); F.out = args.out;
    for (int i = F.tid; i < 256; i += NWAVES * 64) F.MISC[i] = 0u;
    __syncthreads();
    const int lo = args.ph_lo, hi = args.ph_hi;
#ifdef DBG_TSEL
    if (blockIdx.x == 0 && threadIdx.x == 0) __hip_atomic_store(F.ctl + CW_DBG + 15, (unsigned)__builtin_amdgcn_s_memrealtime(), RLX_AGENT);
#endif
    XcdBarrier bar; bar.bar = (unsigned*)(F.ctl + CW_BAR); bar.x = 0; bar.st = nullptr;
    if (hi - lo > 1) bar = xcd_barrier_post((unsigned*)(F.ctl + CW_BAR), F.MISC + MW_BAR);
#define IN_(k) (lo <= (k) && (k) < hi)
#ifdef DBG_TSEL
#ifndef DBG_TQ
#define DBG_TQ 50.0f
#endif
#define TSTAMP(k) do { if (blockIdx.x == 0 && threadIdx.x == 0) __hip_atomic_store(F.ctl + CW_DBG + 16 + ((k) == 11 ? 0 : 1 + layer_ * PH_PER_LAYER + (k)), (unsigned)__builtin_amdgcn_s_memrealtime(), RLX_AGENT); } while (0)
#else
#define TSTAMP(k) do { } while (0)
#endif
#ifdef BAR_DUP
#define SEAM(k) do { if (IN_(k) && IN_((k) + 1)) { xcd_barrier(bar); xcd_barrier(bar); } } while (0)
#else
#define SEAM(k) do { if (IN_(k) && IN_((k) + 1)) xcd_barrier(bar); } while (0)
#endif

    if (PH_ON(11) && IN_(0)) { for (int rep_ = 0; rep_ < DUP_N(11); ++rep_) { frame_refresh(F); p0_prologue(F, args); } SEAM(0); { const int layer_ = 0; TSTAMP(11); (void)layer_; } }
#pragma unroll 1
    for (int layer = 0; layer < DEPTH; ++layer) {
        const int pb = 1 + layer * PH_PER_LAYER; const int layer_ = layer; (void)layer_;
        if (PH_ON(0) && IN_(pb + 0)) { for (int rep_ = 0; rep_ < DUP_N(0); ++rep_) { frame_refresh(F);
            { pg8::DenseSched S; S.init(WSP(bf16, WS_XB), WSP(bf16, WS_WIN_T) + (size_t)layer * NUP * D, T, NUP, D, F.G, (int)blockIdx.x);
              pg8::EpiB16 E{WSP(bf16, WS_U), NUP, nullptr, 0.f};
              pg8::gemm_phase<pg8::EpiB16, pg8::DenseSched>(F.lds, F.tid, S, E); }
            if (F.G != 256 || blockIdx.x >= 128)
            { pg8::DenseSched S; if (F.G == 256) S.init(WSP(bf16, WS_PB) + (size_t)layer * T * 256, WSP(bf16, WS_WPP_T) + (size_t)layer * D * 256, T, D, 256, 128, (int)blockIdx.x - 128); else S.init(WSP(bf16, WS_PB) + (size_t)layer * T * 256, WSP(bf16, WS_WPP_T) + (size_t)layer * D * 256, T, D, 256, F.G, (int)blockIdx.x);
              pg8::EpiB16 E{WSP(bf16, WS_PE), D, nullptr, 0.f};
              pg8::gemm_phase<pg8::EpiB16, pg8::DenseSched>(F.lds, F.tid, S, E); }
            } SEAM(pb + 0); TSTAMP(0);
        }
        if (PH_ON(1) && IN_(pb + 1)) { for (int rep_ = 0; rep_ < DUP_N(1); ++rep_) { frame_refresh(F);
            for (int un = F.vcu; un < 1024; un += F.G) { frame_refresh(F); const int ty = un >> 8, r = un & 255, b = r >> 6, c = r & 63;
                if (ty == 0) { ssd_stage1(F, args, layer, b, c); if (ST_DUP & 1) ssd_stage1(F, args, layer, b, c); } else if (ty == 1) { gla_stage1(F, args, layer, b, c); if (ST_DUP & 2) gla_stage1(F, args, layer, b, c); } else if (ty == 2) { mlstm_stage1(F, args, layer, b, c); if (ST_DUP & 4) mlstm_stage1(F, args, layer, b, c); } else { rwkv_stage1(F, args, layer, r); if (ST_DUP & 8) rwkv_stage1(F, args, layer, r); } }
            } SEAM(pb + 1); TSTAMP(1);
        }
        if (PH_ON(2) && IN_(pb + 2)) { for (int rep_ = 0; rep_ < DUP_N(2); ++rep_) { frame_refresh(F);
            if (F.wave == 0) { for (int ws_ = F.vcu; ws_ < 64; ws_ += F.G) rwkv_scan_wave(F, args, ws_);
                if (rep_ == 0) { if (F.G > 64) { if (F.vcu >= 64) scans_elementwise(F, args, (F.vcu - 64) * 64 + F.lane, (F.G - 64) * 64, SCAN_N_MAIN, SCAN_N_ALL); } else scans_elementwise(F, args, F.vcu * 64 + F.lane, F.G * 64, SCAN_N_MAIN, SCAN_N_ALL); } }
            else if (rep_ == 0) scans_elementwise(F, args, F.vcu * 448 + (F.tid - 64), F.G * 448, 0, SCAN_N_MAIN);
            } SEAM(pb + 2); TSTAMP(2);
        }
        if (PH_ON(3) && IN_(pb + 3)) { for (int rep_ = 0; rep_ < DUP_N(3); ++rep_) { frame_refresh(F);
            for (int un = F.vcu; un < 1024; un += F.G) { frame_refresh(F); const int ty = un >> 8, r = un & 255, b = r >> 6, c = r & 63;
                if (ty == 0) { ssd_stage3(F, args, layer, b, c); if (ST_DUP & 16) ssd_stage3(F, args, layer, b, c); } else if (ty == 1) { gla_stage3(F, args, layer, b, c); if (ST_DUP & 32) gla_stage3(F, args, layer, b, c); } else if (ty == 2) { mlstm_stage3(F, args, layer, b, c); if (ST_DUP & 64) mlstm_stage3(F, args, layer, b, c); } else { rwkv_stage3(F, args, layer, r); if (ST_DUP & 128) rwkv_stage3(F, args, layer, r); } }
            } SEAM(pb + 3); TSTAMP(3);
        }
        if (PH_ON(4) && IN_(pb + 4)) { for (int rep_ = 0; rep_ < DUP_N(4); ++rep_) { frame_refresh(F);
            pg8::EpiB16 E{WSP(bf16, WS_Y1), D, WSP(bf16, WS_XB), DN_ALPHA};
#if OUT_FP8
            pg8::DenseSched8b S; S.init(WSP(bf16, WS_MIX), (const bf16*)(WSP(unsigned char, WS_WOUT_Q) + (size_t)layer * D * D), T, D, D / 2, F.G, (int)blockIdx.x);
            pg8::gemm_phase<pg8::EpiB16, pg8::DenseSched8b>(F.lds, F.tid, S, E);
#else
            pg8::DenseSched S; S.init(WSP(bf16, WS_MIX), WSP(bf16, WS_WOUT_T) + (size_t)layer * D * D, T, D, D, F.G, (int)blockIdx.x);
            pg8::gemm_phase<pg8::EpiB16, pg8::DenseSched>(F.lds, F.tid, S, E);
#endif
            } SEAM(pb + 4); TSTAMP(4);
        }
        if (PH_ON(5) && IN_(pb + 5)) { if (DUP_N(5) == 2) { frame_refresh(F); p6_ln1_router<true>(F, args, layer); } frame_refresh(F); p6_ln1_router<false>(F, args, layer); SEAM(pb + 5); TSTAMP(5); }
        if (PH_ON(6) && IN_(pb + 6)) { for (int rep_ = 0; rep_ < DUP_N(6); ++rep_) { frame_refresh(F);
            moe_build_pfx(F, args, layer, 8);
            pg8::Moe1Sched S; S.O.pfx = F.MISC + MW_PFX; S.O.NT = 8; S.O.G = F.G; S.O.c = (int)blockIdx.x; S.sdest = WSP(int, WS_SDEST); S.bgu = KIN(I_BGU) + (size_t)layer * NE * 2048;
            if (MOE_FP8) { S.X = WSP(unsigned char, WS_X1Q); S.W = WSP(unsigned char, WS_WGU_Q) + (size_t)layer * NE * 2048 * D; S.K = D / 2; S.hstepB = (size_t)1024 * D; }
            else { S.X = WSP(unsigned char, WS_X1B); S.W = WSP(unsigned char, WS_WGU_T) + (size_t)layer * NE * 2048 * D * 2; S.K = D; S.hstepB = (size_t)1024 * D * 2; }
            pg8::EpiMoe1 E{WSP(bf16, WS_ABUF), KIN(I_BGU) + (size_t)layer * NE * 2048, WSP(unsigned char, WS_ABUFQ)};
            pg8::gemm_phase<pg8::EpiMoe1, pg8::Moe1Sched>(F.lds, F.tid, S, E);
            } SEAM(pb + 6); TSTAMP(6);
        }
        if (PH_ON(7) && IN_(pb + 7)) { for (int rep_ = 0; rep_ < DUP_N(7); ++rep_) { frame_refresh(F);
            moe_build_pfx(F, args, layer, 4);
            pg8::Moe2Sched S; S.O.pfx = F.MISC + MW_PFX; S.O.NT = 4; S.O.G = F.G; S.O.c = (int)blockIdx.x; S.sdest = WSP(int, WS_SDEST); S.sgate = WSP(float, WS_SGATE); S.bdn = KIN(I_BDN) + (size_t)layer * NE * D; if (MOE2_FP8) { S.Ab = WSP(unsigned char, WS_ABUFQ); S.W = WSP(unsigned char, WS_WDN_Q) + (size_t)layer * NE * D * D; S.K = D / 2; S.hstepB = (size_t)128 * D; }
            else { S.Ab = WSP(unsigned char, WS_ABUF); S.W = WSP(unsigned char, WS_WDN_T) + (size_t)layer * NE * D * D * 2; S.K = D; S.hstepB = (size_t)128 * D * 2; }
            pg8::EpiMoe2 E{WSP(bf16, WS_YBUF), KIN(I_BDN) + (size_t)layer * NE * D, WSP(int, WS_SDEST), WSP(float, WS_SGATE)};
            pg8::gemm_phase<pg8::EpiMoe2, pg8::Moe2Sched>(F.lds, F.tid, S, E);
            } SEAM(pb + 7); TSTAMP(7);
        }
        if (PH_ON(8) && IN_(pb + 8)) { for (int rep_ = 0; rep_ < DUP_N(8); ++rep_) { frame_refresh(F); p9_combine(F, args); } SEAM(pb + 8); TSTAMP(8); }
        if (PH_ON(9) && IN_(pb + 9)) { for (int rep_ = 0; rep_ < DUP_N(9); ++rep_) { frame_refresh(F);
            pg8::EpiPle E{WSP(bf16, WS_H2), WSP(bf16, WS_HB), WSP(bf16, WS_PE)};
#if PLE_FP8
            pg8::DenseSched8 S; S.init((const bf16*)WSP(unsigned char, WS_HQ), (const bf16*)(WSP(unsigned char, WS_WPG_Q) + (size_t)layer * D * D), T, D, D / 2, F.G, (int)blockIdx.x);
            pg8::gemm_phase<pg8::EpiPle, pg8::DenseSched8>(F.lds, F.tid, S, E);
#else
            pg8::DenseSched S; S.init(WSP(bf16, WS_HB), WSP(bf16, WS_WPG_T) + (size_t)layer * D * D, T, D, D, F.G, (int)blockIdx.x);
            pg8::gemm_phase<pg8::EpiPle, pg8::DenseSched>(F.lds, F.tid, S, E);
#endif
            } SEAM(pb + 9); TSTAMP(9);
        }
        if (PH_ON(10) && IN_(pb + 10)) { for (int rep_ = 0; rep_ < DUP_N(10); ++rep_) { frame_refresh(F); p11_ln2(F, args, layer); } SEAM(pb + 10); TSTAMP(10); }
    }
#ifdef DBG_TSEL
    if (hi - lo > 1) { xcd_barrier(bar);
        unsigned ticks = 0u;
        if (DBG_TSEL == 11) ticks = __hip_atomic_load(F.ctl + CW_DBG + 16, RLX_AGENT) - __hip_atomic_load(F.ctl + CW_DBG + 15, RLX_AGENT);
        else for (int l = 0; l < DEPTH; ++l) { const int pi = 1 + l * PH_PER_LAYER + DBG_TSEL; ticks += __hip_atomic_load(F.ctl + CW_DBG + 16 + pi, RLX_AGENT) - __hip_atomic_load(F.ctl + CW_DBG + 16 + pi - 1, RLX_AGENT); }
        const float us = floorf((float)ticks * 0.01f / DBG_TQ) * DBG_TQ; const float code = sqrtf(us * 0.05f);
        for (size_t i = (size_t)blockIdx.x * 512 + threadIdx.x; i < (size_t)T * D; i += (size_t)gridDim.x * 512) F.out[i] = code; }
#endif
#ifdef DBG_SEL
    if (hi - lo > 1) { xcd_barrier(bar);
        const unsigned mx = __hip_atomic_load(F.ctl + CW_DBG, RLX_AGENT), nf = __hip_atomic_load(F.ctl + CW_DBG + 1, RLX_AGENT);
        float code;
        { const float m = __uint_as_float(mx); int b = (m > 0.f) ? (int)floorf(log10f(m)) + 30 : 0; b = b < 0 ? 0 : (b > 60 ? 60 : b); if (nf) b += 100; code = sqrtf(10.0f * (float)(b + 1)); }
        for (size_t i = (size_t)blockIdx.x * 512 + threadIdx.x; i < (size_t)T * D; i += (size_t)gridDim.x * 512) F.out[i] = code; }
#endif
#undef IN_
#undef SEAM
}

extern "C" void kernel_launch(void* const* d_in, const int* in_sizes, int n_in, void* d_out, int out_size, void* d_ws, size_t ws_size, hipStream_t stream) {
    static int grid = 0;
    if (grid == 0) {
        if (n_in != N_IN || out_size != T * D || ws_size < WS_END) { fprintf(stderr, "kernel_launch: unexpected shapes (n_in %d, out %d, ws %zu < %zu); nothing launched\n", n_in, out_size, ws_size, (size_t)WS_END); grid = -1; return; }
        int dev = 0, cus = 0, per_cu = 0;
        if (hipGetDevice(&dev) != hipSuccess || hipDeviceGetAttribute(&cus, hipDeviceAttributeMultiprocessorCount, dev) != hipSuccess) { grid = -1; return; }
        if (hipFuncSetAttribute((const void*)fwd_kernel, hipFuncAttributeMaxDynamicSharedMemorySize, LDS_BYTES) != hipSuccess) { fprintf(stderr, "kernel_launch: hipFuncSetAttribute failed\n"); grid = -1; return; }
        if (hipOccupancyMaxActiveBlocksPerMultiprocessor(&per_cu, (const void*)fwd_kernel, NWAVES * 64, LDS_BYTES) != hipSuccess || per_cu < 1) { fprintf(stderr, "kernel_launch: occupancy query says %d blocks per CU\n", per_cu); }
        (void)hipGetLastError();
        grid = cus;
    }
    if (grid < 0) return;
    (void)hipMemsetAsync((char*)d_ws + WS_CTL, 0, CTL_ZERO_BYTES, stream);
    Args a{};
    for (int i = 0; i < N_IN; ++i) a.in[i] = (const float*)d_in[i];
    a.out = (float*)d_out; a.ws = (unsigned char*)d_ws;
#if MK_PER_PHASE_LAUNCH
    for (int ph = 0; ph < N_PHASES; ++ph) { a.ph_lo = ph; a.ph_hi = ph + 1; hipLaunchKernelGGL(fwd_kernel, dim3(grid), dim3(NWAVES * 64), LDS_BYTES, stream, a); }
#else
    a.ph_lo = 0; a.ph_hi = N_PHASES; hipLaunchKernelGGL(fwd_kernel, dim3(grid), dim3(NWAVES * 64), LDS_BYTES, stream, a);
#endif
    const hipError_t le = hipPeekAtLastError();
    if (le != hipSuccess) fprintf(stderr, "kernel_launch: launch failed: %s\n", hipGetErrorName(le));
}
```

```cpp
#include <hip/hip_runtime.h>
#include <cstdio>
#include <cstdint>

#define GAS __attribute__((address_space(1)))
#define LAS __attribute__((address_space(3)))
typedef unsigned short bf16;
typedef unsigned v4u __attribute__((ext_vector_type(4)));
typedef unsigned v2u __attribute__((ext_vector_type(2)));
typedef float f32x4 __attribute__((ext_vector_type(4)));
typedef float f32x2 __attribute__((ext_vector_type(2)));
typedef short bf16x8 __attribute__((ext_vector_type(8)));
typedef int v4i_t __attribute__((ext_vector_type(4)));
typedef int v8i_t __attribute__((ext_vector_type(8)));
typedef GAS unsigned gu32;
#define RLX_AGENT __ATOMIC_RELAXED, __HIP_MEMORY_SCOPE_AGENT
#define LDS_WAIT() asm volatile("s_waitcnt lgkmcnt(0)" ::: "memory")
#define VM_WAIT() asm volatile("s_waitcnt vmcnt(0)" ::: "memory")

constexpr int NWAVES = 8;
constexpr int DEPTH = 4, BATCH = 4, SEQ = 4096, D = 1024, T = BATCH * SEQ;
constexpr int NU = 3484, NUP = 3584;
constexpr int NE = 32, TOPK = 4, ECAP = 16384;
constexpr int NCH = SEQ / 64;
constexpr int U_SSD_Z = 0, U_SSD_X = 256, U_SSD_B = 512, U_SSD_C = 640, U_SSD_DT = 768;
constexpr int U_RW = 772, U_RW_R = 772, U_RW_K = 1028, U_RW_V = 1284, U_RW_LO = 1540;
constexpr int U_GL_Q = 1668, U_GL_K = 1796, U_GL_V = 1924, U_GL_G = 2180, U_GL_OG = 2196;
constexpr int U_ML_Q = 2452, U_ML_K = 2708, U_ML_V = 2964, U_ML_I = 3220, U_ML_F = 3224, U_ML_O = 3228;
constexpr float DN_ALPHA = 1.6817928305074290f;
constexpr float LN_EPS = 1e-5f, NORM_EPS = 1e-5f, RWKV_GN_EPS = 64e-5f;

enum { I_X = 0, I_P, I_WIN, I_WOUT, I_LN1G, I_LN1B, I_SCW, I_SCB, I_SALOG, I_SDTB, I_SD, I_SNG,
       I_RMU, I_RW0, I_RWUP, I_RA0, I_RAUP, I_RGUP, I_RKK, I_RKA, I_RRK, I_RLNG, I_RLNB,
       I_GGUP, I_GGB, I_GNG, I_MCW, I_MCB, I_MIB, I_MFB, I_MNG,
       I_RTW, I_RTB, I_WGU, I_BGU, I_WDN, I_BDN, I_PGW, I_PPJ, I_LN2G, I_LN2B, N_IN };

constexpr size_t MiB = 1u << 20;
constexpr size_t WS_CTL = 0, CTL_ZERO_BYTES = 1 * MiB;
constexpr size_t WS_WIN_T = 2 * MiB;
constexpr size_t WS_WOUT_T = WS_WIN_T + (size_t)DEPTH * NUP * D * 2;
constexpr size_t WS_WGU_T = WS_WOUT_T + (size_t)DEPTH * D * D * 2;
constexpr size_t WS_WDN_T = WS_WGU_T + (size_t)DEPTH * NE * 2048 * D * 2;
constexpr size_t WS_WPG_T = WS_WDN_T + (size_t)DEPTH * NE * D * D * 2;
constexpr size_t WS_WPP_T = WS_WPG_T + (size_t)DEPTH * D * D * 2;
constexpr size_t WS_RWT = WS_WPP_T + (size_t)DEPTH * D * 256 * 2;
constexpr size_t WS_PB = WS_RWT + (size_t)DEPTH * NE * D * 4;
constexpr size_t WS_XB = WS_PB + (size_t)DEPTH * T * 256 * 2;
constexpr size_t WS_U = WS_XB + (size_t)T * D * 2;
constexpr size_t WS_PE = WS_U + (size_t)T * NUP * 2;
constexpr size_t WS_MIX = WS_PE + (size_t)T * D * 4;
constexpr size_t WS_Y1 = WS_MIX + (size_t)T * D * 2;
constexpr size_t WS_X1 = WS_Y1 + (size_t)T * D * 4;
constexpr size_t WS_X1B = WS_X1 + (size_t)T * D * 4;
constexpr size_t WS_SDEST = WS_X1B + (size_t)T * D * 2;
constexpr size_t WS_SGATE = WS_SDEST + (size_t)NE * ECAP * 4;
constexpr size_t WS_ABUF = WS_SGATE + (size_t)NE * ECAP * 4;
constexpr size_t WS_YBUF = WS_ABUF + (size_t)NE * ECAP * D * 2;
constexpr size_t WS_H = WS_YBUF + (size_t)T * 4 * D * 2;
constexpr size_t WS_HB = WS_H + (size_t)T * D * 4;
constexpr size_t WS_H2 = WS_HB + (size_t)T * D * 2;
constexpr size_t WS_SSD_ST = WS_H2 + (size_t)T * D * 4;
constexpr size_t WS_SSD_DEC = WS_SSD_ST + (size_t)16 * NCH * 64 * 128 * 4;
constexpr size_t WS_GLA_ST = WS_SSD_DEC + 16 * NCH * 4;
constexpr size_t WS_GLA_DEC = WS_GLA_ST + (size_t)16 * NCH * 32 * 64 * 4;
constexpr size_t WS_ML_C = WS_GLA_DEC + (size_t)4 * NCH * 128 * 4;
constexpr size_t WS_ML_N = WS_ML_C + (size_t)16 * NCH * 64 * 64 * 4;
constexpr size_t WS_ML_BL = WS_ML_N + (size_t)16 * NCH * 64 * 4;
constexpr size_t WS_ML_ML = WS_ML_BL + 16 * NCH * 4;
constexpr size_t WS_ML_M = WS_ML_ML + 16 * NCH * 4;
constexpr size_t WS_RW = WS_ML_M + 16 * NCH * 4;
constexpr size_t WS_RW_G = WS_RW + (size_t)T * 3 * 256 * 4;
constexpr size_t WS_RW_RH = WS_RW_G + (size_t)T * 256 * 4;
constexpr size_t WS_RW_O0 = WS_RW_RH + (size_t)1024 * 4096 * 2;
constexpr size_t WS_RW_GF = WS_RW_O0 + (size_t)1024 * 4096 * 4;
constexpr size_t WS_RW_HT = WS_RW_GF + (size_t)1024 * 4096 * 2;
constexpr size_t WS_RW_PT = WS_RW_HT + (size_t)1024 * 4096 * 4;
constexpr size_t WS_LORA = WS_RW_PT + (size_t)1024 * 4096 * 2;
constexpr int LORA_PER_LAYER = 8192 + 8192 + 16384 + 2048;
constexpr size_t WS_WGU_Q = WS_LORA + (size_t)DEPTH * LORA_PER_LAYER * 4;
constexpr size_t WS_WDN_Q = WS_WGU_Q + (size_t)DEPTH * NE * 2048 * D;
constexpr size_t WS_X1Q = WS_WDN_Q + (size_t)DEPTH * NE * D * D;
constexpr size_t WS_ABUFQ = WS_X1Q + (size_t)T * D;
constexpr size_t WS_WPG_Q = WS_ABUFQ + (size_t)NE * ECAP * D;
constexpr size_t WS_HQ = WS_WPG_Q + (size_t)DEPTH * D * D;
constexpr size_t WS_WOUT_Q = WS_HQ + (size_t)T * D;
constexpr size_t WS_END = WS_WOUT_Q + (size_t)DEPTH * D * D;
#ifndef MOE_FP8
#define MOE_FP8 1
#endif
#ifndef MOE2_FP8
#define MOE2_FP8 1
#ifndef RW_SOLVE_BLK
#define RW_SOLVE_BLK 1
#endif
#ifndef RW_SCAN_DMA
#define RW_SCAN_DMA 1
#endif
#ifndef P6_MFMA
#define P6_MFMA 1
#endif
#ifndef OUT_FP8
#define OUT_FP8 1
#endif
#ifndef PLE_FP8
#define PLE_FP8 1
#endif
#endif
constexpr int CW_BAR = 4096;
constexpr int CW_DBG = 32768;
constexpr int CW_CNT = 16384;

constexpr int RING_BYTES = 147456;
constexpr int MISC_OFF = RING_BYTES;
constexpr int LDS_BYTES = RING_BYTES + 1024;
constexpr int MW_BAR = 8, MW_LCNT = 32, MW_LBASE = 64, MW_PFX = 96, MW_CNT = 136, MW_GAMC = 168;

typedef __bf16 bf16x2_t __attribute__((ext_vector_type(2)));
__device__ __forceinline__ unsigned cvt_pk_bf16(float lo, float hi) { const f32x2 v = {lo, hi}; const bf16x2_t b = __builtin_convertvector(v, bf16x2_t); return __builtin_bit_cast(unsigned, b); }
__device__ __forceinline__ unsigned cvt4_fp8(float a, float b, float c, float d) { int w = 0; w = __builtin_amdgcn_cvt_pk_fp8_f32(a, b, w, false); w = __builtin_amdgcn_cvt_pk_fp8_f32(c, d, w, true); return (unsigned)w; }
__device__ __forceinline__ float bf2f(unsigned short b) { return __uint_as_float(((unsigned)b) << 16); }
__device__ __forceinline__ float sigmoidf_(float x) { return __builtin_amdgcn_rcpf(1.0f + __expf(-x)); }
__device__ __forceinline__ float siluf_(float x) { return x * __builtin_amdgcn_rcpf(1.0f + __expf(-x)); }
__device__ __forceinline__ float softplusf_(float x) { return fmaxf(x, 0.f) + __logf(1.0f + __expf(-fabsf(x))); }
__device__ __forceinline__ float logsigmoidf_(float x) { return fminf(x, 0.f) - __logf(1.0f + __expf(-fabsf(x))); }
__device__ __forceinline__ float tanhf_(float x) { const float e = __expf(-2.0f * fabsf(x)); const float t = (1.0f - e) * __builtin_amdgcn_rcpf(1.0f + e); return x < 0.f ? -t : t; }
__device__ __forceinline__ int lane_now() { int l = (int)__builtin_amdgcn_mbcnt_hi(~0u, __builtin_amdgcn_mbcnt_lo(~0u, 0u)); asm volatile("" : "+v"(l)); return l; }
__device__ __forceinline__ float my_shfl_idx(float v, int src) { return __builtin_bit_cast(float, __builtin_amdgcn_ds_bpermute(src << 2, __builtin_bit_cast(int, v))); }
__device__ __forceinline__ int my_shfl_idx(int v, int src) { return __builtin_amdgcn_ds_bpermute(src << 2, v); }
template <class V> __device__ __forceinline__ V my_shfl_xor(V v, int o) { return my_shfl_idx(v, lane_now() ^ o); }
template <class V> __device__ __forceinline__ V my_shfl_up(V v, int o) { const int l = lane_now(); return my_shfl_idx(v, l >= o ? l - o : l); }
#define __shfl_xor(v, o) my_shfl_xor(v, o)
#define __shfl_up(v, o) my_shfl_up(v, o)
#define __shfl(v, s) my_shfl_idx(v, s)
__device__ __forceinline__ float wave_sum(float v) {
#pragma unroll
    for (int o = 1; o < 64; o <<= 1) v += __shfl_xor(v, o);
    return v;
}
__device__ __forceinline__ float wave_max(float v) {
#pragma unroll
    for (int o = 1; o < 64; o <<= 1) v = fmaxf(v, __shfl_xor(v, o));
    return v;
}
__device__ __forceinline__ float wave_scan_add(float v, int lane) {
#pragma unroll
    for (int o = 1; o < 64; o <<= 1) { const float t = __shfl_up(v, o); if (lane >= o) v += t; }
    return v;
}
__device__ __forceinline__ float wave_scan_max(float v, int lane) {
#pragma unroll
    for (int o = 1; o < 64; o <<= 1) { const float t = __shfl_up(v, o); if (lane >= o) v = fmaxf(v, t); }
    return v;
}
__device__ __forceinline__ f32x4 mm16(const LAS unsigned char* A, int lda, const LAS unsigned char* B, int ldb, int K, f32x4 acc, int fr, int fq) {
    const LAS unsigned char* ap = A + fr * lda + fq * 16; const LAS unsigned char* bp = B + fr * ldb + fq * 16;
    for (int k = 0; k < K; k += 32) {
        const bf16x8 a = *(const LAS bf16x8*)(ap + k * 2); const bf16x8 b = *(const LAS bf16x8*)(bp + k * 2);
        acc = __builtin_amdgcn_mfma_f32_16x16x32_bf16(b, a, acc, 0, 0, 0);
    }
    return acc;
}
__device__ __forceinline__ f32x4 mm16_gB(const LAS unsigned char* A, int lda, const float* B, int ldb, int K, f32x4 acc, int fr, int fq) {
    const LAS unsigned char* ap = A + fr * lda + fq * 16; const float* bp = B + (size_t)fr * ldb + fq * 8;
    for (int k = 0; k < K; k += 32) {
        const bf16x8 a = *(const LAS bf16x8*)(ap + k * 2);
        const f32x4 b0 = *(const f32x4*)(bp + k), b1 = *(const f32x4*)(bp + k + 4);
        v4u bw; bw.x = cvt_pk_bf16(b0.x, b0.y); bw.y = cvt_pk_bf16(b0.z, b0.w); bw.z = cvt_pk_bf16(b1.x, b1.y); bw.w = cvt_pk_bf16(b1.z, b1.w);
        const bf16x8 b = __builtin_bit_cast(bf16x8, bw);
        acc = __builtin_amdgcn_mfma_f32_16x16x32_bf16(b, a, acc, 0, 0, 0);
    }
    return acc;
}
__device__ __forceinline__ f32x4 mm16_gAB(const bf16* A, int lda, const bf16* B, int ldb, int K, f32x4 acc, int fr, int fq) {
    const bf16* ap = A + (size_t)fr * lda + fq * 8; const bf16* bp = B + (size_t)fr * ldb + fq * 8;
    for (int k = 0; k < K; k += 32) { const bf16x8 a = *(const bf16x8*)(ap + k), b = *(const bf16x8*)(bp + k); acc = __builtin_amdgcn_mfma_f32_16x16x32_bf16(b, a, acc, 0, 0, 0); }
    return acc;
}
__device__ __forceinline__ bf16x8 ldfrag_f32(const float* p) { const f32x4 b0 = *(const f32x4*)p, b1 = *(const f32x4*)(p + 4);
    v4u bw; bw.x = cvt_pk_bf16(b0.x, b0.y); bw.y = cvt_pk_bf16(b0.z, b0.w); bw.z = cvt_pk_bf16(b1.x, b1.y); bw.w = cvt_pk_bf16(b1.z, b1.w); return __builtin_bit_cast(bf16x8, bw); }
template <int NK> __device__ __forceinline__ f32x4 mm16_rB(const LAS unsigned char* A, int lda, const bf16x8 (&b)[NK], f32x4 acc, int fr, int fq) {
    const LAS unsigned char* ap = A + fr * lda + fq * 16;
#pragma unroll
    for (int k = 0; k < NK; ++k) { const bf16x8 a = *(const LAS bf16x8*)(ap + k * 64); acc = __builtin_amdgcn_mfma_f32_16x16x32_bf16(b[k], a, acc, 0, 0, 0); }
    return acc;
}
__device__ __forceinline__ v4u pack8(const float (&v)[8]) { v4u o; o.x = cvt_pk_bf16(v[0], v[1]); o.y = cvt_pk_bf16(v[2], v[3]); o.z = cvt_pk_bf16(v[4], v[5]); o.w = cvt_pk_bf16(v[6], v[7]); return o; }

#define XB_TMO      128
#define XB_XCNT(j)  (256  + 64 * (j))
#define XB_XSUB(j)  (1280 + 64 * (j))
#define XB_XGEN(j)  (2304 + 64 * (j))
#define XB_TOP      3328
#define XB_TOPGEN   3392
#define XCD_BAR_WORDS 3456
#define XB_SPIN_CAP (1u << 18)
__device__ __forceinline__ unsigned xb_ld(unsigned* p)              { return __hip_atomic_load(p, __ATOMIC_RELAXED, __HIP_MEMORY_SCOPE_AGENT); }
__device__ __forceinline__ unsigned xb_add(unsigned* p, unsigned v) { return __hip_atomic_fetch_add(p, v, __ATOMIC_RELAXED, __HIP_MEMORY_SCOPE_AGENT); }
__device__ __forceinline__ unsigned xb_xcc_id() { return (unsigned)__builtin_amdgcn_s_getreg((3 << 11) | 20) & 0xFu; }
#define XB_SPIN(cond, bar) do { unsigned _sp = 0; while (cond) { __builtin_amdgcn_s_sleep(1); \
    if ((++_sp & 255u) == 0u) { if (xb_ld(&(bar)[XB_TMO])) break; if (_sp > XB_SPIN_CAP) { atomicAdd(&(bar)[XB_TMO], 1u); break; } } } } while (0)
struct XcdBarrier { unsigned* bar; unsigned x; volatile LAS unsigned* st; };
__device__ __forceinline__ XcdBarrier xcd_barrier_post(unsigned* bar, volatile LAS unsigned* st) {
    XcdBarrier b; b.bar = bar; b.x = xb_xcc_id(); b.st = st;
    if (threadIdx.x == 0) (void)xb_add(&bar[XB_XCNT(b.x)], 1u);
    return b;
}
__device__ __forceinline__ void xcd_barrier_complete(unsigned* bar, unsigned x, unsigned& nloc, unsigned& nx) {
    const unsigned G = gridDim.x * gridDim.y * gridDim.z;
    unsigned sum, cnt, mine, sp = 0u;
    for (;;) {
        sum = 0u; cnt = 0u; mine = 0u;
#pragma unroll
        for (unsigned j = 0; j < 16; ++j) { const unsigned c = xb_ld(&bar[XB_XCNT(j)]); sum += c; cnt += (c > 0u) ? 1u : 0u; mine = (j == x) ? c : mine; }
        if (sum == G) break;
        __builtin_amdgcn_s_sleep(1);
        if ((++sp & 255u) == 0u) { if (xb_ld(&bar[XB_TMO])) break; if (sp > XB_SPIN_CAP) { atomicAdd(&bar[XB_TMO], 1u); break; } }
    }
    nloc = mine > 0u ? mine : 1u; nx = cnt > 0u ? cnt : 1u;
}
__device__ __forceinline__ void xcd_barrier(const XcdBarrier& b) {
    asm volatile("s_waitcnt vmcnt(0)" ::: "memory");
    __syncthreads();
    if (threadIdx.x == 0) {
        unsigned* bar = b.bar;
        __builtin_amdgcn_s_waitcnt(0);
        unsigned nloc = b.st[0], nx = b.st[1];
        if (nloc == 0u) { xcd_barrier_complete(bar, b.x, nloc, nx); b.st[0] = nloc; b.st[1] = nx; }
        const unsigned k = b.st[2]; b.st[2] = k + 1u;
        const unsigned old = xb_add(&bar[XB_XSUB(b.x)], 1u);
        if (old + 1u == (k + 1u) * nloc) {
            __builtin_amdgcn_fence(__ATOMIC_RELEASE, "agent");
            asm volatile("s_waitcnt vmcnt(0)" ::: "memory");
            (void)xb_add(&bar[XB_TOP], 1u);
        }
        const unsigned target = (k + 1u) * nx;
        XB_SPIN(xb_ld(&bar[XB_TOP]) < target, bar);
        __builtin_amdgcn_fence(__ATOMIC_ACQUIRE, "agent");
        asm volatile("s_waitcnt vmcnt(0)" ::: "memory");
    }
    __syncthreads();
}

namespace pg8 {
constexpr int BM = 256, BK = 64, HALF = 128, HTB = HALF * BK * 2, STAGE_BYTES = 8 * HTB, NXCD = 8, WGM = 8;
__host__ __device__ __forceinline__ int lds_byte(int r, int c) { const int st = (r >> 4) * 2 + (c >> 5), rr = r & 15, cc = c & 31, ob = rr * 64 + cc * 2; return st * 1024 + (ob ^ (((ob >> 9) & 1) << 5)); }
__host__ __device__ __forceinline__ void stage_rc(int b, int& R, int& C) { const int st = b / 1024, sb = b % 1024, swz = sb ^ (((sb >> 9) & 1) << 5); R = (st >> 1) * 16 + swz / 64; C = (st & 1) * 32 + (swz % 64) / 2; }
__host__ __device__ __forceinline__ int perm32(int rho) { const int n = rho >> 4, i = rho & 15; return 8 * (i >> 2) + 4 * n + (i & 3); }

template <class Epi, class Sched>
__device__ __forceinline__ void gemm_phase(LAS unsigned char* lds, const int tid, const Sched& S, const Epi& E) {
    const int wid = __builtin_amdgcn_readfirstlane(tid >> 6), lane = tid & 63, wr = wid >> 2, wc = wid & 3, fr = lane & 15, fq = lane >> 4;
    const int K = S.K, nt = K / BK;
    unsigned voffB[2];
#pragma unroll
    for (int i = 0; i < 2; ++i) { int R, C; stage_rc(tid * 16 + i * 8192, R, C); const int Rb = Epi::PERM ? ((R & ~31) + perm32(R & 31)) : R; voffB[i] = (unsigned)(Rb * K + C) * 2u; }
    const size_t kstep = (size_t)(BK * 2);
    const size_t hstepB = S.hstepB;
    const unsigned ldsw = (unsigned)wid * 1024u;
    constexpr bool F8 = Sched::FP8;
    const int aoff = F8 ? lds_byte(wr * 64 + fr, fq * 16) : lds_byte(wr * 64 + fr, fq * 8), boff = F8 ? lds_byte(wc * 32 + fr, fq * 16) : lds_byte(wc * 32 + fr, fq * 8);
#define PG8_SA(b, h) (((b) * 2 + (h)) * HTB)
#define PG8_SB(b, h) ((4 + (b) * 2 + (h)) * HTB)
#define PG8_STAGE_B(bufoff, gbase) do { _Pragma("unroll") for (int _i = 0; _i < 2; ++_i) \
        __builtin_amdgcn_global_load_lds((const unsigned*)((const char*)(gbase) + voffB[_i]), (LAS unsigned*)(lds + (bufoff) + ldsw + _i * 8192), 16, 0, 0); } while (0)
#define PG8_STAGE_A(bufoff, gbase, v0, v1) do { \
        __builtin_amdgcn_global_load_lds((const unsigned*)((const char*)(gbase) + (v0)), (LAS unsigned*)(lds + (bufoff) + ldsw), 16, 0, 0); \
        __builtin_amdgcn_global_load_lds((const unsigned*)((const char*)(gbase) + (v1)), (LAS unsigned*)(lds + (bufoff) + ldsw + 8192), 16, 0, 0); } while (0)
#define PG8_FOFF(k) (F8 ? (k) * 16 : (k) * 1024)
#define PG8_LDA(dst, b, h) do { _Pragma("unroll") for (int m = 0; m < 4; ++m) { if constexpr (F8) dst##8[m] = *(const LAS v8i_t*)(lds + PG8_SA(b, h) + aoff + m * 2048); \
        else { _Pragma("unroll") for (int k = 0; k < 2; ++k) dst[m][k] = *(const LAS bf16x8*)(lds + PG8_SA(b, h) + aoff + m * 2048 + k * 1024); } } } while (0)
#define PG8_LDB(dst, b, h) do { _Pragma("unroll") for (int n = 0; n < 2; ++n) { if constexpr (F8) dst##8[n] = *(const LAS v8i_t*)(lds + PG8_SB(b, h) + boff + n * 2048); \
        else { _Pragma("unroll") for (int k = 0; k < 2; ++k) dst[n][k] = *(const LAS bf16x8*)(lds + PG8_SB(b, h) + boff + n * 2048 + k * 1024); } } } while (0)
#define PG8_CAT(x) __builtin_shufflevector(__builtin_bit_cast(v4i_t, x[0]), __builtin_bit_cast(v4i_t, x[1]), 0, 1, 2, 3, 4, 5, 6, 7)
#define PG8_MMA(ai, bj, At, Bt) do { __builtin_amdgcn_s_setprio(1); _Pragma("unroll") for (int m = 0; m < 4; ++m) _Pragma("unroll") for (int n = 0; n < 2; ++n) { \
        if constexpr (F8) acc[ai][bj][m][n] = __builtin_amdgcn_mfma_scale_f32_16x16x128_f8f6f4(Bt##8[n], At##8[m], acc[ai][bj][m][n], 0, 0, 0, S.scaleB, 0, S.scaleA); \
        else { _Pragma("unroll") for (int k = 0; k < 2; ++k) acc[ai][bj][m][n] = __builtin_amdgcn_mfma_f32_16x16x32_bf16(Bt[n][k], At[m][k], acc[ai][bj][m][n], 0, 0, 0); } } __builtin_amdgcn_s_setprio(0); } while (0)
#define PG8_WAIT_V(n) asm volatile("s_waitcnt vmcnt(" #n ")" ::: "memory")
#define PG8_WAIT_L(n) asm volatile("s_waitcnt lgkmcnt(" #n ")" ::: "memory")
#define PG8_BAR __builtin_amdgcn_s_barrier()
#define PG8_SCHED __builtin_amdgcn_sched_barrier(0)
    typename Sched::Unit cur, nxt; int ui = 0;
    if (!S.next(0, cur)) return;
    f32x4 acc[2][2][4][2];
#pragma unroll
    for (int a = 0; a < 2; ++a)
#pragma unroll
        for (int b = 0; b < 2; ++b)
#pragma unroll
            for (int m = 0; m < 4; ++m)
#pragma unroll
                for (int n = 0; n < 2; ++n) acc[a][b][m][n] = (f32x4){0.f, 0.f, 0.f, 0.f};
    bf16x8 At[4][2], B0[2][2], B1[2][2]; v8i_t At8[4], B08[2], B18[2];
    constexpr bool GA = Sched::GATHER;
    const size_t hstepA = GA ? (size_t)0 : (size_t)HALF * K * 2;
    unsigned vA[2][2];
    LAS unsigned char* hdr = lds + STAGE_BYTES;
    if constexpr (Sched::HDR) { if (wid == 0) S.hdr_issue(cur, hdr, lane); PG8_WAIT_V(0); PG8_BAR; }
    S.a_off(cur, tid, vA, hdr);
#define PG8_STAGE_AH(bufoff, base, vv, h) PG8_STAGE_A(bufoff, ((base) + (h) * hstepA), vv[GA ? (h) : 0][0], vv[GA ? (h) : 0][1])
    const char* cA = S.a_base(cur); const char* cB = S.b_base(cur);
    PG8_STAGE_B(PG8_SB(0, 0), cB); PG8_STAGE_B(PG8_SB(0, 1), cB + hstepB); PG8_STAGE_AH(PG8_SA(0, 0), cA, vA, 0); PG8_STAGE_AH(PG8_SA(0, 1), cA, vA, 1);
    if (wr == 1) PG8_BAR;
    PG8_WAIT_V(2); PG8_BAR;
    PG8_STAGE_B(PG8_SB(1, 0), cB + kstep); PG8_STAGE_AH(PG8_SA(1, 0), cA + kstep, vA, 0); PG8_STAGE_B(PG8_SB(1, 1), cB + hstepB + kstep);
    PG8_WAIT_V(6); PG8_BAR;
    int hc = 0;
    for (;;) {
        const bool has_next = S.next(ui + 1, nxt); const int hn = (hc == 2) ? 0 : hc + 1;
        const char* nA = cA; const char* nB = cB;
        if (has_next) { nA = S.a_base(nxt); nB = S.b_base(nxt); if constexpr (Sched::HDR) { if (wid == 0) S.hdr_issue(nxt, hdr + hn * 4096, lane); } }
        for (int t = 0; t < nt; t += 2) {
            const bool last = (t == nt - 2);
            const char* a1 = cA + (size_t)(t + 1) * kstep;
            const char* a2 = last ? nA : cA + (size_t)(t + 2) * kstep; const char* b2 = last ? nB : cB + (size_t)(t + 2) * kstep;
            const char* a3 = a2 + kstep; const char* b3 = b2 + kstep;
            PG8_LDB(B0, 0, 0); PG8_LDB(B1, 0, 1); PG8_SCHED; PG8_LDA(At, 0, 0); PG8_STAGE_AH(PG8_SA(1, 1), a1, vA, 1);
            if constexpr (GA) { if (last && has_next) S.a_off(nxt, tid, vA, hdr + hn * 4096); }
            PG8_WAIT_V(8); PG8_WAIT_L(0); PG8_BAR; PG8_MMA(0, 0, At, B0); PG8_MMA(0, 1, At, B1); PG8_BAR; PG8_SCHED;
            PG8_LDA(At, 0, 1); PG8_STAGE_B(PG8_SB(0, 0), b2); PG8_STAGE_B(PG8_SB(0, 1), b2 + hstepB); PG8_STAGE_AH(PG8_SA(0, 0), a2, vA, 0);
            PG8_WAIT_V(8); PG8_WAIT_L(0); PG8_BAR; PG8_MMA(1, 0, At, B0); PG8_MMA(1, 1, At, B1); PG8_BAR; PG8_SCHED;
            PG8_LDB(B0, 1, 0); PG8_LDB(B1, 1, 1); PG8_SCHED; PG8_LDA(At, 1, 0); PG8_STAGE_AH(PG8_SA(0, 1), a2, vA, 1);
            PG8_WAIT_V(8); PG8_WAIT_L(0); PG8_BAR; PG8_MMA(0, 0, At, B0); PG8_MMA(0, 1, At, B1); PG8_BAR; PG8_SCHED;
            PG8_LDA(At, 1, 1); PG8_STAGE_B(PG8_SB(1, 0), b3); PG8_STAGE_B(PG8_SB(1, 1), b3 + hstepB); PG8_STAGE_AH(PG8_SA(1, 0), a3, vA, 0);
            PG8_WAIT_V(8); PG8_WAIT_L(0); PG8_BAR; PG8_MMA(1, 0, At, B0); PG8_MMA(1, 1, At, B1); PG8_BAR; PG8_SCHED;
        }
        if (wr == 0) PG8_BAR;
        { int fr_ = fr, fq_ = fq; asm volatile("" : "+v"(fr_), "+v"(fq_)); E(acc, cur, wr, wc, fr_, fq_, hdr + hc * 4096); }
        if (!has_next) break;
#pragma unroll
        for (int a = 0; a < 2; ++a)
#pragma unroll
            for (int b = 0; b < 2; ++b)
#pragma unroll
                for (int m = 0; m < 4; ++m)
#pragma unroll
                    for (int n = 0; n < 2; ++n) acc[a][b][m][n] = (f32x4){0.f, 0.f, 0.f, 0.f};
        cur = nxt; cA = nA; cB = nB; ++ui; hc = hn;
        if (wr == 1) PG8_BAR;
    }
    PG8_WAIT_V(0);
    PG8_BAR;
#undef PG8_SA
#undef PG8_SB
#undef PG8_STAGE_A
#undef PG8_STAGE_AH
#undef PG8_STAGE_B
#undef PG8_LDA
#undef PG8_LDB
#undef PG8_MMA
#undef PG8_CAT
#undef PG8_FOFF
#undef PG8_WAIT_V
#undef PG8_WAIT_L
#undef PG8_BAR
#undef PG8_SCHED
}
}
struct Args { const float* in[N_IN]; float* out; unsigned char* ws; int ph_lo, ph_hi; };
typedef const __attribute__((address_space(4))) unsigned long long* karg_t;
struct Frame {
    karg_t ka;
    LAS unsigned char* lds;
    volatile LAS unsigned* MISC;
    gu32* ctl;
    unsigned char* ws;
    float* out;
    int tid, lane, wave, vcu, G;
};
#define WSP(T_, off) ((T_*)(F.ws + (off)))
#define KIN(k) ((const float*)F.ka[(k)])
#ifdef DBG_SEL
#define DBG_STAT(k, val) do { const float _v = (val); if ((k) == DBG_SEL) { if (fabsf(_v) < 3e38f) atomicMax((unsigned*)(F.ctl + CW_DBG), __float_as_uint(fabsf(_v))); else atomicAdd((unsigned*)(F.ctl + CW_DBG + 1), 1u); } } while (0)
#else
#define DBG_STAT(k, val) do { } while (0)
#endif
template <class P> __device__ __forceinline__ P launder_uniform(P p) {
    unsigned lo = (unsigned)(unsigned long long)p, hi = (unsigned)((unsigned long long)p >> 32);
    asm volatile("" : "+v"(lo), "+v"(hi));
    lo = __builtin_amdgcn_readfirstlane(lo); hi = __builtin_amdgcn_readfirstlane(hi);
    return (P)(((unsigned long long)hi << 32) | lo);
}
__device__ __forceinline__ void frame_refresh(Frame& F) {
    int t = F.tid; asm volatile("" : "+v"(t)); F.tid = t; F.lane = t & 63; F.wave = __builtin_amdgcn_readfirstlane(t >> 6);
    F.ws = launder_uniform(F.ws); F.ctl = (gu32*)(F.ws + WS_CTL);
    F.out = launder_uniform(F.out);
    F.ka = launder_uniform(F.ka);
}

namespace pg8 {
struct DenseSched {
    static constexpr bool GATHER = false, FP8 = false, HDR = false; static constexpr int scaleA = 0, scaleB = 0;
    struct Unit { int pm, pn; };
    __device__ __forceinline__ void hdr_issue(const Unit&, LAS unsigned char*, int) const {}
    const bf16* A; const bf16* Bt; int K; size_t hstepB; int nM, nN, nwg, G, c;
    __device__ __forceinline__ void init(const bf16* A_, const bf16* Bt_, int M, int N, int K_, int G_, int c_) { A = A_; Bt = Bt_; K = K_; hstepB = (size_t)HALF * K_ * 2; nM = M / BM; nN = N / BM; nwg = nM * nN; G = G_; c = c_; }
    __device__ __forceinline__ bool next(int i, Unit& u) const {
        const long L = (long)i * G + c; if (L >= nwg) return false;
        int wgid = (int)L; { const int q = nwg / NXCD, r = nwg % NXCD, xcd = wgid % NXCD, off = wgid / NXCD; wgid = (xcd < r ? xcd * (q + 1) : r * (q + 1) + (xcd - r) * q) + off; }
        const int nig = WGM * nN, gid = wgid / nig, fm = gid * WGM, gsz = (nM - fm) < WGM ? (nM - fm) : WGM;
        u.pm = fm + ((wgid % nig) % gsz); u.pn = (wgid % nig) / gsz; return true;
    }
    __device__ __forceinline__ const char* a_base(const Unit& u) const { return (const char*)A + (size_t)u.pm * BM * K * 2; }
    __device__ __forceinline__ const char* b_base(const Unit& u) const { return (const char*)Bt + (size_t)u.pn * BM * K * 2; }
    __device__ __forceinline__ void a_off(const Unit&, int tid, unsigned (&v)[2][2], const LAS unsigned char*) const {
#pragma unroll
        for (int i = 0; i < 2; ++i) { int R, C; stage_rc(tid * 16 + i * 8192, R, C); v[0][i] = (unsigned)(R * K + C) * 2u; v[1][i] = v[0][i]; }
    }
};
template <int SB> struct DenseSched8T : DenseSched { static constexpr bool GATHER = true, FP8 = true; static constexpr int scaleA = 0x7F7F7F7F, scaleB = SB;
    __device__ __forceinline__ void a_off(const Unit&, int tid, unsigned (&v)[2][2], const LAS unsigned char*) const {
        int t_ = tid; asm volatile("" : "+v"(t_));
#pragma unroll
        for (int i = 0; i < 2; ++i) { int R, C; stage_rc(t_ * 16 + i * 8192, R, C); v[0][i] = (unsigned)(R * K + C) * 2u; v[1][i] = v[0][i] + (unsigned)(HALF * K * 2); }
    }
};
typedef DenseSched8T<0x7A7A7A7A> DenseSched8;
typedef DenseSched8T<0x79797979> DenseSched8b;
struct MoeUnit { int e, mt, nt, cnt; };
struct MoeOrder {
    const volatile LAS unsigned* pfx;
    int NT, G, c;
    __device__ __forceinline__ bool decode(int i, MoeUnit& u) const {
        const int nwg = (int)pfx[32]; const long L = (long)i * G + c; if (L >= nwg) return false;
        int wgid = (int)L; { const int q = nwg / NXCD, r = nwg % NXCD, xcd = wgid % NXCD, off = wgid / NXCD; wgid = (xcd < r ? xcd * (q + 1) : r * (q + 1) + (xcd - r) * q) + off; }
        int e = 0;
#pragma unroll
        for (int st = 16; st >= 1; st >>= 1) e += ((int)pfx[e + st] <= wgid) ? st : 0;
        const int j = wgid - (int)pfx[e];
        u.e = e; u.mt = j / NT; u.nt = j % NT; u.cnt = (int)pfx[40 + e]; return true;
    }
};
#ifndef HDR_AOFF
#define HDR_AOFF 1
#endif
struct Moe1Sched {
    static constexpr bool GATHER = true, FP8 = (MOE_FP8 != 0), HDR = true; static constexpr int EB = FP8 ? 1 : 2; static constexpr int scaleA = 0x7F7F7F7F, scaleB = 0x7A7A7A7A;
    typedef MoeUnit Unit;
    MoeOrder O; const unsigned char* X; const unsigned char* W; const int* sdest; const float* bgu; int K; size_t hstepB;
    __device__ __forceinline__ void hdr_issue(const Unit& u, LAS unsigned char* hdr, int lane) const {
        __builtin_amdgcn_global_load_lds((const unsigned*)(sdest + (size_t)u.e * ECAP + (size_t)u.mt * 256 + lane * 4), (LAS unsigned*)hdr, 16, 0, 0);
        const float* bp = bgu + (size_t)u.e * 2048 + u.nt * 128 + (lane < 32 ? lane * 4 : 1024 + (lane - 32) * 4);
        __builtin_amdgcn_global_load_lds((const unsigned*)bp, (LAS unsigned*)(hdr + 1024), 16, 0, 0);
    }
    __device__ __forceinline__ bool next(int i, Unit& u) const { return O.decode(i, u); }
    __device__ __forceinline__ const char* a_base(const Unit&) const { return (const char*)X; }
    __device__ __forceinline__ const char* b_base(const Unit& u) const { return (const char*)W + ((size_t)u.e * 2048 + (size_t)u.nt * 128) * 1024 * EB; }
    __device__ __forceinline__ void a_off(const Unit& u, int tid, unsigned (&v)[2][2], const LAS unsigned char* hdr) const {
#pragma unroll
        for (int i = 0; i < 2; ++i) { int R, C; stage_rc(tid * 16 + i * 8192, R, C);
#pragma unroll
            for (int h = 0; h < 2; ++h) { const int sl = h * HALF + R; int tok = 0; if (u.mt * 256 + sl < u.cnt) tok = HDR_AOFF ? (((const LAS int*)hdr)[sl] >> 2) : (sdest[u.e * ECAP + u.mt * 256 + sl] >> 2); v[h][i] = (unsigned)(tok * 1024 * EB + C * 2); } }
    }
};
struct Moe2Sched {
    static constexpr bool GATHER = true, FP8 = (MOE2_FP8 != 0), HDR = true; static constexpr int EB = FP8 ? 1 : 2; static constexpr int scaleA = 0x7F7F7F7F, scaleB = 0x79797979;
    typedef MoeUnit Unit;
    MoeOrder O; const unsigned char* Ab; const unsigned char* W; const int* sdest; const float* sgate; const float* bdn; int K; size_t hstepB;
    __device__ __forceinline__ void hdr_issue(const Unit& u, LAS unsigned char* hdr, int lane) const {
        const size_t so = (size_t)u.e * ECAP + (size_t)u.mt * 256 + lane * 4;
        __builtin_amdgcn_global_load_lds((const unsigned*)(sdest + so), (LAS unsigned*)hdr, 16, 0, 0);
        __builtin_amdgcn_global_load_lds((const unsigned*)(sgate + so), (LAS unsigned*)(hdr + 1024), 16, 0, 0);
        __builtin_amdgcn_global_load_lds((const unsigned*)(bdn + (size_t)u.e * 1024 + u.nt * 256 + lane * 4), (LAS unsigned*)(hdr + 2048), 16, 0, 0);
    }
    __device__ __forceinline__ bool next(int i, Unit& u) const { return O.decode(i, u); }
    __device__ __forceinline__ const char* a_base(const Unit& u) const { return (const char*)Ab + ((size_t)u.e * ECAP + (size_t)u.mt * 256) * 1024 * EB; }
    __device__ __forceinline__ const char* b_base(const Unit& u) const { return (const char*)W + ((size_t)u.e * 1024 + (size_t)u.nt * 256) * 1024 * EB; }
    __device__ __forceinline__ void a_off(const Unit&, int tid, unsigned (&v)[2][2], const LAS unsigned char*) const {
        int t_ = tid; asm volatile("" : "+v"(t_));
#pragma unroll
        for (int i = 0; i < 2; ++i) { int R, C; stage_rc(t_ * 16 + i * 8192, R, C); v[0][i] = (unsigned)(R * 1024 * EB + C * 2); v[1][i] = v[0][i] + (unsigned)(HALF * 1024 * EB); }
    }
};

__device__ __forceinline__ void unpack8(const v4u w, f32x4& a, f32x4& b) {
    a = (f32x4){__uint_as_float(w.x << 16), __uint_as_float(w.x & 0xffff0000u), __uint_as_float(w.y << 16), __uint_as_float(w.y & 0xffff0000u)};
    b = (f32x4){__uint_as_float(w.z << 16), __uint_as_float(w.z & 0xffff0000u), __uint_as_float(w.w << 16), __uint_as_float(w.w & 0xffff0000u)}; }
struct EpiF32 {
    static constexpr bool PERM = false;
    float* C; int ldc; const float* base; float alpha;
    __device__ __forceinline__ void operator()(const f32x4 (&acc)[2][2][4][2], const DenseSched::Unit& u, int wr, int wc, int fr, int fq, const LAS unsigned char* hdr) const {
        const int row0 = u.pm * BM + wr * 64 + fr, col0 = u.pn * BM + wc * 32 + 4 * fq;
#pragma unroll
        for (int ai = 0; ai < 2; ++ai)
#pragma unroll
            for (int m = 0; m < 4; ++m) { const size_t ro = (size_t)(row0 + ai * HALF + m * 16) * ldc + col0;
#pragma unroll
                for (int bj = 0; bj < 2; ++bj)
#pragma unroll
                    for (int n = 0; n < 2; ++n) { f32x4 v = acc[ai][bj][m][n];
                        if (base) { const f32x4 b = *(const f32x4*)(base + ro + bj * HALF + n * 16); v = v + b * alpha; }
                        *(f32x4*)(C + ro + bj * HALF + n * 16) = v; } }
    }
};
struct EpiB16 {
    static constexpr bool PERM = true;
    bf16* O; int ldc; const bf16* base; float alpha;
    __device__ __forceinline__ void operator()(const f32x4 (&acc)[2][2][4][2], const DenseSched::Unit& u, int wr, int wc, int fr, int fq, const LAS unsigned char* hdr) const {
        const int row0 = u.pm * BM + wr * 64 + fr, col0 = u.pn * BM + wc * 32 + 8 * fq;
#pragma unroll
        for (int ai = 0; ai < 2; ++ai) {
            v4u bw[4][2];
            if (base) {
#pragma unroll
                for (int m = 0; m < 4; ++m)
#pragma unroll
                    for (int bj = 0; bj < 2; ++bj) bw[m][bj] = *(const v4u*)(base + (size_t)(row0 + ai * HALF + m * 16) * ldc + col0 + bj * HALF); }
#pragma unroll
            for (int m = 0; m < 4; ++m) { bf16* rowp = O + (size_t)(row0 + ai * HALF + m * 16) * ldc + col0;
#pragma unroll
                for (int bj = 0; bj < 2; ++bj) { f32x4 v0 = acc[ai][bj][m][0], v1 = acc[ai][bj][m][1];
                    if (base) { f32x4 b0, b1; unpack8(bw[m][bj], b0, b1); v0 = v0 + b0 * alpha; v1 = v1 + b1 * alpha; }
                    v4u w; w.x = cvt_pk_bf16(v0[0], v0[1]); w.y = cvt_pk_bf16(v0[2], v0[3]); w.z = cvt_pk_bf16(v1[0], v1[1]); w.w = cvt_pk_bf16(v1[2], v1[3]);
                    *(v4u*)(rowp + bj * HALF) = w; } } }
    }
};
struct EpiPle {
    static constexpr bool PERM = true;
    bf16* C; const bf16* hb; const bf16* pe;
    __device__ __forceinline__ void operator()(const f32x4 (&acc)[2][2][4][2], const DenseSched::Unit& u, int wr, int wc, int fr, int fq, const LAS unsigned char* hdr) const {
        const int row0 = u.pm * BM + wr * 64 + fr, col0 = u.pn * BM + wc * 32 + 8 * fq;
#pragma unroll
        for (int ai = 0; ai < 2; ++ai) {
            v4u hw[4][2], pw[4][2];
#pragma unroll
            for (int m = 0; m < 4; ++m)
#pragma unroll
                for (int bj = 0; bj < 2; ++bj) { const size_t ro = (size_t)(row0 + ai * HALF + m * 16) * 1024 + col0 + bj * HALF; hw[m][bj] = *(const v4u*)(hb + ro); pw[m][bj] = *(const v4u*)(pe + ro); }
#pragma unroll
            for (int m = 0; m < 4; ++m)
#pragma unroll
                for (int bj = 0; bj < 2; ++bj) { const size_t ro = (size_t)(row0 + ai * HALF + m * 16) * 1024 + col0 + bj * HALF;
                    f32x4 h0, h1, p0, p1; unpack8(hw[m][bj], h0, h1); unpack8(pw[m][bj], p0, p1); const f32x4 a0 = acc[ai][bj][m][0], a1 = acc[ai][bj][m][1];
                    f32x4 o0, o1;
#pragma unroll
                    for (int j = 0; j < 4; ++j) { o0[j] = h0[j] + sigmoidf_(a0[j]) * p0[j]; o1[j] = h1[j] + sigmoidf_(a1[j]) * p1[j]; }
                    v4u w; w.x = cvt_pk_bf16(o0[0], o0[1]); w.y = cvt_pk_bf16(o0[2], o0[3]); w.z = cvt_pk_bf16(o1[0], o1[1]); w.w = cvt_pk_bf16(o1[2], o1[3]);
                    *(v4u*)(C + ro) = w; } }
    }
};
struct EpiMoe1 {
    static constexpr bool PERM = true;
    bf16* Ab; const float* bgu; unsigned char* AbQ;
    __device__ __forceinline__ void operator()(const f32x4 (&acc)[2][2][4][2], const MoeUnit& u, int wr, int wc, int fr, int fq, const LAS unsigned char* hdr) const {
        const int col0 = u.nt * 128 + wc * 32 + 8 * fq;
        const LAS float* bh = (const LAS float*)(hdr + 1024) + wc * 32 + 8 * fq;
        const f32x4 bg0 = *(const LAS f32x4*)(bh), bg1 = *(const LAS f32x4*)(bh + 4), bl0 = *(const LAS f32x4*)(bh + 128), bl1 = *(const LAS f32x4*)(bh + 132);
#pragma unroll
        for (int ai = 0; ai < 2; ++ai)
#pragma unroll
            for (int m = 0; m < 4; ++m) { const int r = ai * HALF + wr * 64 + m * 16 + fr;
                bf16* rowp = Ab + ((size_t)u.e * ECAP + (size_t)u.mt * 256 + r) * 1024 + col0;
                float o[8];
#pragma unroll
                for (int n = 0; n < 2; ++n) { const f32x4 g4 = acc[ai][0][m][n] + (n ? bg1 : bg0), l4 = acc[ai][1][m][n] + (n ? bl1 : bl0);
#pragma unroll
                    for (int j = 0; j < 4; ++j) { const float g = fminf(g4[j], 7.0f), l = fminf(fmaxf(l4[j], -7.0f), 7.0f); o[n * 4 + j] = (l + 1.0f) * g * sigmoidf_(1.702f * g); } }
                if constexpr (MOE2_FP8) { v2u q; q.x = cvt4_fp8(o[0], o[1], o[2], o[3]); q.y = cvt4_fp8(o[4], o[5], o[6], o[7]); *(v2u*)((unsigned char*)AbQ + ((size_t)u.e * ECAP + (size_t)u.mt * 256 + r) * 1024 + col0) = q; }
                else *(v4u*)rowp = pack8(o); }
    }
};
struct EpiMoe2 {
    static constexpr bool PERM = true;
    bf16* Y; const float* bdn; const int* sdest; const float* sgate;
    __device__ __forceinline__ void operator()(const f32x4 (&acc)[2][2][4][2], const MoeUnit& u, int wr, int wc, int fr, int fq, const LAS unsigned char* hdr) const {
        const int col0 = u.nt * 256 + wc * 32 + 8 * fq;
        const LAS float* bp = (const LAS float*)(hdr + 2048) + wc * 32 + 8 * fq;
#pragma unroll
        for (int ai = 0; ai < 2; ++ai) {
            f32x4 bv[2][2];
#pragma unroll
            for (int bj = 0; bj < 2; ++bj)
#pragma unroll
                for (int n = 0; n < 2; ++n) bv[bj][n] = *(const LAS f32x4*)(bp + bj * HALF + 4 * n);
            int dest[4]; float gate[4];
#pragma unroll
            for (int m = 0; m < 4; ++m) { const int sl = ai * HALF + wr * 64 + m * 16 + fr; const bool ok = u.mt * 256 + sl < u.cnt;
                dest[m] = ok ? ((const LAS int*)hdr)[sl] : T * 4; gate[m] = ok ? ((const LAS float*)(hdr + 1024))[sl] : 0.f; }
#pragma unroll
            for (int m = 0; m < 4; ++m) {
                { const float g = gate[m]; bf16* rowp = Y + (size_t)dest[m] * 1024 + col0;
#pragma unroll
                    for (int bj = 0; bj < 2; ++bj) { const f32x4 v0 = (acc[ai][bj][m][0] + bv[bj][0]) * g, v1 = (acc[ai][bj][m][1] + bv[bj][1]) * g;
                        v4u w; w.x = cvt_pk_bf16(v0[0], v0[1]); w.y = cvt_pk_bf16(v0[2], v0[3]); w.z = cvt_pk_bf16(v1[0], v1[1]); w.w = cvt_pk_bf16(v1[2], v1[3]);
                        *(v4u*)(rowp + bj * HALF) = w; } } } }
    }
};
}

__device__ __forceinline__ void p0_transpose_item(const float* W, int K, int N, int nblk, bf16* WT, int item, int lane) {
    const int kb = item / nblk, nb = item % nblk, k0 = 64 * kb, n = 64 * nb + lane;
    const bool ok = n < N; const float* src = W + (size_t)k0 * N + (ok ? n : 0);
    float x[64];
#pragma unroll
    for (int j = 0; j < 64; ++j) x[j] = __builtin_nontemporal_load(src + (size_t)j * N);
    bf16* dst = WT + (size_t)n * K + k0;
#pragma unroll
    for (int q = 0; q < 8; ++q) { v4u o; o.x = cvt_pk_bf16(x[8 * q], x[8 * q + 1]); o.y = cvt_pk_bf16(x[8 * q + 2], x[8 * q + 3]); o.z = cvt_pk_bf16(x[8 * q + 4], x[8 * q + 5]); o.w = cvt_pk_bf16(x[8 * q + 6], x[8 * q + 7]);
        if (!ok) o = (v4u){0u, 0u, 0u, 0u};
        *(v4u*)(dst + 8 * q) = o; }
}
__device__ __forceinline__ void cvt_rows(const float* src, bf16* dst, size_t n8, size_t i0, size_t stride) {
    for (size_t i = i0; i < n8; i += stride) { const f32x4 a = *(const f32x4*)(src + i * 8), b = *(const f32x4*)(src + i * 8 + 4);
        v4u o; o.x = cvt_pk_bf16(a.x, a.y); o.y = cvt_pk_bf16(a.z, a.w); o.z = cvt_pk_bf16(b.x, b.y); o.w = cvt_pk_bf16(b.z, b.w); *(v4u*)(dst + i * 8) = o; }
}
__device__ __forceinline__ void p0_prologue(Frame& F, const Args& A) {
    const int gw = F.vcu * NWAVES + F.wave, NGW = F.G * NWAVES;
    constexpr int I_IN = 16 * (NUP / 64), I_OUT = 16 * 16, I_GU = 16 * 32, I_DN = 16 * 16, I_PG = 16 * 16, I_PP = 4 * 16;
    constexpr int PER_LAYER = I_IN + I_OUT + NE * I_GU + NE * I_DN + I_PG + I_PP;
#pragma unroll 1
    for (int it = gw; it < DEPTH * PER_LAYER; it += NGW) {
        const int l = it / PER_LAYER; int r = it % PER_LAYER;
        const float* W; bf16* WT; int K = D, N = D, nblk = 16;
        if (r < I_IN) { W = KIN(I_WIN) + (size_t)l * D * NU; WT = WSP(bf16, WS_WIN_T) + (size_t)l * NUP * D; N = NU; nblk = NUP / 64; }
        else if ((r -= I_IN) < I_OUT) { if (OUT_FP8) continue; W = KIN(I_WOUT) + (size_t)l * D * D; WT = WSP(bf16, WS_WOUT_T) + (size_t)l * D * D; }
        else if ((r -= I_OUT) < NE * I_GU) { if (MOE_FP8) continue; const int e = r / I_GU; r %= I_GU; W = KIN(I_WGU) + ((size_t)l * NE + e) * D * 2048; WT = WSP(bf16, WS_WGU_T) + ((size_t)l * NE + e) * 2048 * D; N = 2048; nblk = 32; }
        else if ((r -= NE * I_GU) < NE * I_DN) { if (MOE2_FP8) continue; const int e = r / I_DN; r %= I_DN; W = KIN(I_WDN) + ((size_t)l * NE + e) * D * D; WT = WSP(bf16, WS_WDN_T) + ((size_t)l * NE + e) * D * D; }
        else if ((r -= NE * I_DN) < I_PG) { if (PLE_FP8) continue; W = KIN(I_PGW) + (size_t)l * D * D; WT = WSP(bf16, WS_WPG_T) + (size_t)l * D * D; }
        else { r -= I_PG; W = KIN(I_PPJ) + (size_t)l * 256 * D; WT = WSP(bf16, WS_WPP_T) + (size_t)l * D * 256; K = 256; }
        p0_transpose_item(W, K, N, nblk, WT, r, F.lane);
    }
#if MOE_FP8
    constexpr int Q_GU = 16 * 32, Q_DN = 16 * 16, Q_PG = PLE_FP8 ? 16 * 16 : 0, Q_OUT = OUT_FP8 ? 16 * 16 : 0, Q_PER_LAYER = NE * (Q_GU + Q_DN) + Q_PG + Q_OUT;
#pragma unroll 1
    for (int it = gw; it < DEPTH * Q_PER_LAYER; it += NGW) {
        const int l = it / Q_PER_LAYER; int r = it % Q_PER_LAYER; const float* W; unsigned char* WQ; int N; float sc;
        if (r < NE * Q_GU) { const int e = r / Q_GU; r %= Q_GU; W = KIN(I_WGU) + ((size_t)l * NE + e) * D * 2048; WQ = WSP(unsigned char, WS_WGU_Q) + ((size_t)l * NE + e) * 2048 * D; N = 2048; sc = 32.0f; }
        else if (r >= NE * (Q_GU + Q_DN) + Q_PG) { r -= NE * (Q_GU + Q_DN) + Q_PG; W = KIN(I_WOUT) + (size_t)l * D * D; WQ = WSP(unsigned char, WS_WOUT_Q) + (size_t)l * D * D; N = D; sc = 64.0f; }
        else if (r >= NE * (Q_GU + Q_DN)) { r -= NE * (Q_GU + Q_DN); W = KIN(I_PGW) + (size_t)l * D * D; WQ = WSP(unsigned char, WS_WPG_Q) + (size_t)l * D * D; N = D; sc = 32.0f; }
        else { if (!MOE2_FP8) continue; r -= NE * Q_GU; const int e = r / Q_DN; r %= Q_DN; W = KIN(I_WDN) + ((size_t)l * NE + e) * D * D; WQ = WSP(unsigned char, WS_WDN_Q) + ((size_t)l * NE + e) * D * D; N = D; sc = 64.0f; }
        const int nblk = N / 64, kb = r / nblk, nb = r % nblk, k0 = 64 * kb, n = 64 * nb + F.lane;
        const float* src = W + (size_t)k0 * N + n; float x[64];
#pragma unroll
        for (int j = 0; j < 64; ++j) x[j] = __builtin_nontemporal_load(src + (size_t)j * N) * sc;
        unsigned char* dst = WQ + (size_t)n * D + k0;
#pragma unroll
        for (int q = 0; q < 4; ++q) { v4u o; o.x = cvt4_fp8(x[16 * q], x[16 * q + 1], x[16 * q + 2], x[16 * q + 3]); o.y = cvt4_fp8(x[16 * q + 4], x[16 * q + 5], x[16 * q + 6], x[16 * q + 7]);
            o.z = cvt4_fp8(x[16 * q + 8], x[16 * q + 9], x[16 * q + 10], x[16 * q + 11]); o.w = cvt4_fp8(x[16 * q + 12], x[16 * q + 13], x[16 * q + 14], x[16 * q + 15]); *(v4u*)(dst + 16 * q) = o; }
    }
#endif
    const size_t gt = (size_t)F.vcu * (NWAVES * 64) + F.tid, NT_ = (size_t)F.G * NWAVES * 64;
    cvt_rows(KIN(I_P), WSP(bf16, WS_PB), (size_t)DEPTH * T * 256 / 8, gt, NT_);
    cvt_rows(KIN(I_X), WSP(bf16, WS_XB), (size_t)T * D / 8, gt, NT_);
    for (size_t i = gt; i < (size_t)DEPTH * LORA_PER_LAYER; i += NT_) { const int l = (int)(i / LORA_PER_LAYER); int r = (int)(i % LORA_PER_LAYER); float v;
        if (r < 8192) { const int ch = r >> 5, j = r & 31; v = KIN(I_RWUP)[(size_t)l * 8192 + j * 256 + ch]; }
        else if (r < 16384) { r -= 8192; const int ch = r >> 5, j = r & 31; v = KIN(I_RAUP)[(size_t)l * 8192 + j * 256 + ch]; }
        else if (r < 32768) { r -= 16384; const int ch = r >> 6, j = r & 63; v = KIN(I_RGUP)[(size_t)l * 16384 + j * 256 + ch]; }
        else { r -= 32768; const int d = r >> 4, j = r & 15; v = KIN(I_GGUP)[(size_t)l * 2048 + j * 128 + d]; }
        WSP(float, WS_LORA)[i] = v; }
#if P6_MFMA
    for (size_t i = gt; i < (size_t)DEPTH * 32768; i += NT_) { const int l = (int)(i >> 15), r = (int)(i & 32767), c = r >> 8, e = (r >> 3) & 31, k = 8 * c + (r & 7);
        const float v = KIN(I_RTW)[(size_t)l * D * NE + (size_t)k * NE + e]; const unsigned h = cvt_pk_bf16(v, 0.f) & 0xffffu; const unsigned lo = cvt_pk_bf16(v - __uint_as_float(h << 16), 0.f) & 0xffffu;
        unsigned short* dst = WSP(unsigned short, WS_RWT) + (size_t)l * 65536 + r; dst[0] = (unsigned short)h; dst[32768] = (unsigned short)lo; }
#else
    for (size_t i = gt; i < (size_t)DEPTH * NE * D; i += NT_) { const int l = (int)(i / (NE * D)), r = (int)(i % (NE * D)), e = r / D, k = r % D; WSP(float, WS_RWT)[i] = KIN(I_RTW)[(size_t)l * D * NE + (size_t)k * NE + e]; }
#endif
}

#if P6_MFMA
template <bool DRY> __device__ __forceinline__ void p6_ln1_router(Frame& F, const Args& A, int layer) {
    const bf16* y1 = WSP(bf16, WS_Y1); bf16* x1b = WSP(bf16, WS_X1B);
    const float* gam = KIN(I_LN1G) + layer * D; const float* bet = KIN(I_LN1B) + layer * D;
    const unsigned char* rwq = WSP(unsigned char, WS_RWT) + (size_t)layer * 131072; const float* rb = KIN(I_RTB) + layer * NE;
    int* sdest = WSP(int, WS_SDEST); float* sgate = WSP(float, WS_SGATE);
    unsigned* cnt = (unsigned*)(F.ctl + CW_CNT + layer * NE * 16);
    LAS unsigned char* WL = F.lds;
    LAS float* LG = (LAS float*)(F.lds + 131072);
    LAS float* TOPV = (LAS float*)(F.lds + 139264) + F.wave * 64;
    LAS int* TOPE = (LAS int*)(F.lds + 139264 + 2048) + F.wave * 64;
    LAS float* STAT = (LAS float*)(F.lds + 143360);
    volatile LAS unsigned* lcnt = F.MISC + MW_LCNT; volatile LAS unsigned* lbase = F.MISC + MW_LBASE;
    { const int l0 = F.lane;
#pragma unroll
      for (int i = 0; i < 16; ++i) { const int off = (F.wave * 16 + i) * 1024; __builtin_amdgcn_global_load_lds((const unsigned*)(rwq + off + l0 * 16), (LAS unsigned*)(WL + off), 16, 0, 0); } }
    const int lane = F.lane, m = lane & 15, g = lane >> 4, rq = F.wave & 3, kh = F.wave >> 2;
    for (int blk = F.vcu; blk < T / 64; blk += F.G) {
        if (F.tid < 32) lcnt[F.tid] = 0u;
        const int row = blk * 64 + rq * 16 + m; const size_t ro = (size_t)row * D + 512 * kh + 8 * g;
        v4u yw[16];
#pragma unroll
        for (int kk = 0; kk < 16; ++kk) yw[kk] = *(const v4u*)(y1 + ro + 32 * kk);
        float s = 0.f, s2 = 0.f;
#pragma unroll
        for (int kk = 0; kk < 16; ++kk) { f32x4 a, b; pg8::unpack8(yw[kk], a, b); s += ((a.x + a.y) + (a.z + a.w)) + ((b.x + b.y) + (b.z + b.w));
            s2 += ((a.x * a.x + a.y * a.y) + (a.z * a.z + a.w * a.w)) + ((b.x * b.x + b.y * b.y) + (b.z * b.z + b.w * b.w)); }
        s += __shfl_xor(s, 16); s += __shfl_xor(s, 32); s2 += __shfl_xor(s2, 16); s2 += __shfl_xor(s2, 32);
        if (g == 0) { STAT[(kh * 64 + rq * 16 + m) * 2] = s; STAT[(kh * 64 + rq * 16 + m) * 2 + 1] = s2; }
        asm volatile("s_waitcnt vmcnt(0)" ::: "memory");
        __syncthreads();
        const float st = STAT[(rq * 16 + m) * 2] + STAT[(64 + rq * 16 + m) * 2], st2 = STAT[(rq * 16 + m) * 2 + 1] + STAT[(64 + rq * 16 + m) * 2 + 1];
        const float mean = st * (1.f / D); const float rstd = __builtin_amdgcn_rsqf(fmaxf(st2 * (1.f / D) - mean * mean, 0.f) + LN_EPS);
        f32x4 acc[2] = {(f32x4){0.f, 0.f, 0.f, 0.f}, (f32x4){0.f, 0.f, 0.f, 0.f}}; const float* gp = gam; const float* bp = bet;
#pragma unroll
        for (int kk = 0; kk < 16; ++kk) { const int k0 = 512 * kh + 32 * kk + 8 * g;
            if ((kk & 3) == 0) { gp = launder_uniform(gp); bp = launder_uniform(bp); }
            const f32x4 ga = *(const f32x4*)(gp + k0), gb = *(const f32x4*)(gp + k0 + 4), ba = *(const f32x4*)(bp + k0), bb = *(const f32x4*)(bp + k0 + 4);
            f32x4 a, b; { v4u yk = yw[kk]; asm volatile("" : "+v"(yk)); pg8::unpack8(yk, a, b); }
            a = (a - mean) * rstd * ga + ba; b = (b - mean) * rstd * gb + bb;
            v4u hw; hw.x = cvt_pk_bf16(a.x, a.y); hw.y = cvt_pk_bf16(a.z, a.w); hw.z = cvt_pk_bf16(b.x, b.y); hw.w = cvt_pk_bf16(b.z, b.w);
            *(v4u*)(x1b + (size_t)row * D + k0) = hw;
            if (MOE_FP8) { v2u q; q.x = cvt4_fp8(a.x, a.y, a.z, a.w); q.y = cvt4_fp8(b.x, b.y, b.z, b.w); *(v2u*)(WSP(unsigned char, WS_X1Q) + (size_t)row * D + k0) = q; }
            f32x4 ha, hb_; pg8::unpack8(hw, ha, hb_); a = a - ha; b = b - hb_;
            v4u lw; lw.x = cvt_pk_bf16(a.x, a.y); lw.y = cvt_pk_bf16(a.z, a.w); lw.z = cvt_pk_bf16(b.x, b.y); lw.w = cvt_pk_bf16(b.z, b.w);
            const bf16x8 xh = __builtin_bit_cast(bf16x8, hw), xl = __builtin_bit_cast(bf16x8, lw);
            const int c = kh * 64 + kk * 4 + g;
#pragma unroll
            for (int nt = 0; nt < 2; ++nt) { const bf16x8 wh = *(const LAS bf16x8*)(WL + (c * 32 + nt * 16 + m) * 16), wl = *(const LAS bf16x8*)(WL + 65536 + (c * 32 + nt * 16 + m) * 16);
                acc[nt] = __builtin_amdgcn_mfma_f32_16x16x32_bf16(wh, xh, acc[nt], 0, 0, 0);
                acc[nt] = __builtin_amdgcn_mfma_f32_16x16x32_bf16(wl, xh, acc[nt], 0, 0, 0);
                acc[nt] = __builtin_amdgcn_mfma_f32_16x16x32_bf16(wh, xl, acc[nt], 0, 0, 0); } }
        if (kh == 1) {
#pragma unroll
            for (int nt = 0; nt < 2; ++nt) *(LAS f32x4*)(LG + (rq * 16 + m) * 32 + nt * 16 + 4 * g) = acc[nt]; }
        __syncthreads();
        if (kh == 0) {
#pragma unroll
            for (int nt = 0; nt < 2; ++nt) { const f32x4 o = *(const LAS f32x4*)(LG + (rq * 16 + m) * 32 + nt * 16 + 4 * g); const f32x4 rbv = *(const f32x4*)(rb + nt * 16 + 4 * g);
                *(LAS f32x4*)(LG + (rq * 16 + m) * 32 + nt * 16 + 4 * g) = o + acc[nt] + rbv; } }
        __syncthreads();
        int lane2 = lane; asm volatile("" : "+v"(lane2)); const int sub = lane2 & 15;
#pragma unroll 1
        for (int rg = 0; rg < 2; ++rg) {
            float lg[32];
            { const LAS float* lr = LG + (F.wave * 8 + rg * 4 + (lane2 >> 4)) * 32;
#pragma unroll
              for (int q = 0; q < 8; ++q) { const f32x4 t4 = *(const LAS f32x4*)(lr + 4 * q); lg[4 * q] = t4.x; lg[4 * q + 1] = t4.y; lg[4 * q + 2] = t4.z; lg[4 * q + 3] = t4.w; } }
            float la = 0.f, lb_ = 0.f;
#pragma unroll
            for (int e = 0; e < 32; ++e) { if (e == 2 * sub) la = lg[e]; if (e == 2 * sub + 1) lb_ = lg[e]; }
            int ra = 0, rbk = 0;
#pragma unroll
            for (int e = 0; e < 32; ++e) { ra += (lg[e] > la || (lg[e] == la && e < 2 * sub)) ? 1 : 0; rbk += (lg[e] > lb_ || (lg[e] == lb_ && e < 2 * sub + 1)) ? 1 : 0; }
            const int rowl = rg * 4 + (lane2 >> 4);
            if (ra < 4) { TOPV[rowl * 4 + ra] = la; TOPE[rowl * 4 + ra] = 2 * sub; }
            if (rbk < 4) { TOPV[rowl * 4 + rbk] = lb_; TOPE[rowl * 4 + rbk] = 2 * sub + 1; }
        }
        LDS_WAIT();
        int my_e = 0; float my_g = 0.f; unsigned my_r = 0u;
        if (lane2 < 32) { const int ri = lane2 >> 2, k = lane2 & 3; const f32x4 tv = *(const LAS f32x4*)(TOPV + ri * 4);
            const float e1 = __expf(tv.y - tv.x), e2 = __expf(tv.z - tv.x), e3 = __expf(tv.w - tv.x); const float inv = __builtin_amdgcn_rcpf(1.0f + e1 + e2 + e3);
            my_e = TOPE[ri * 4 + k]; my_g = (k == 0 ? 1.0f : k == 1 ? e1 : k == 2 ? e2 : e3) * inv;
            my_r = DRY ? 0u : atomicAdd((unsigned*)&lcnt[my_e], 1u); }
        __syncthreads();
        if (!DRY && F.wave == 0 && lane2 < 32) { const unsigned n = lcnt[lane2]; lbase[lane2] = n ? __hip_atomic_fetch_add(cnt + lane2 * 16, n, RLX_AGENT) : 0u; }
        __syncthreads();
        if (!DRY && lane2 < 32) { const int rw = blk * 64 + F.wave * 8 + (lane2 >> 2); const unsigned slot = (unsigned)my_e * ECAP + lbase[my_e] + my_r;
            sdest[slot] = rw * 4 + (lane2 & 3); sgate[slot] = my_g; }
        __syncthreads();
    }
}
#else
template <bool DRY> __device__ __forceinline__ void p6_ln1_router(Frame& F, const Args& A, int layer) {
    const bf16* y1 = WSP(bf16, WS_Y1); bf16* x1b = WSP(bf16, WS_X1B);
    const float* g = KIN(I_LN1G) + layer * D; const float* bb = KIN(I_LN1B) + layer * D;
    const float* rwt = WSP(float, WS_RWT) + (size_t)layer * NE * D; const float* rb = KIN(I_RTB) + layer * NE;
    int* sdest = WSP(int, WS_SDEST); float* sgate = WSP(float, WS_SGATE);
    unsigned* cnt = (unsigned*)(F.ctl + CW_CNT + layer * NE * 16);
    LAS float* RWT = (LAS float*)F.lds;
    LAS float* TOPV = (LAS float*)(F.lds + 131072) + F.wave * 64;
    LAS int* TOPE = (LAS int*)(F.lds + 131072 + 2048) + F.wave * 64;
    volatile LAS unsigned* lcnt = F.MISC + MW_LCNT; volatile LAS unsigned* lbase = F.MISC + MW_LBASE;
    for (int i = F.tid; i < NE * D / 4; i += NWAVES * 64) ((LAS f32x4*)RWT)[i] = ((const f32x4*)rwt)[i];
    const int lane = F.lane, sub = lane & 15;
    for (int blk = F.vcu; blk < T / 64; blk += F.G) {
        if (F.tid < 32) lcnt[F.tid] = 0u;
        __syncthreads();
#pragma unroll 1
        for (int rg = 0; rg < 2; ++rg) {
            f32x4 v[4][4];
            { int lo_ = lane; asm volatile("" : "+v"(lo_));
              const f32x4 gv[4] = { *(const f32x4*)(g + 4 * lo_), *(const f32x4*)(g + 256 + 4 * lo_), *(const f32x4*)(g + 512 + 4 * lo_), *(const f32x4*)(g + 768 + 4 * lo_) };
              const f32x4 bv[4] = { *(const f32x4*)(bb + 4 * lo_), *(const f32x4*)(bb + 256 + 4 * lo_), *(const f32x4*)(bb + 512 + 4 * lo_), *(const f32x4*)(bb + 768 + 4 * lo_) };
#pragma unroll
              for (int r = 0; r < 4; ++r) { const int row = blk * 64 + F.wave * 8 + rg * 4 + r; const bf16* yr = y1 + (size_t)row * D; float s = 0.f;
#pragma unroll
                  for (int j = 0; j < 4; ++j) { const v2u w = *(const v2u*)(yr + 256 * j + 4 * lane); v[r][j] = (f32x4){__uint_as_float(w.x << 16), __uint_as_float(w.x & 0xffff0000u), __uint_as_float(w.y << 16), __uint_as_float(w.y & 0xffff0000u)}; s += (v[r][j].x + v[r][j].y) + (v[r][j].z + v[r][j].w); }
                  const float mean = wave_sum(s) * (1.f / D); float s2 = 0.f;
#pragma unroll
                  for (int j = 0; j < 4; ++j) { v[r][j] = v[r][j] - mean; s2 += (v[r][j].x * v[r][j].x + v[r][j].y * v[r][j].y) + (v[r][j].z * v[r][j].z + v[r][j].w * v[r][j].w); }
                  const float rstd = __builtin_amdgcn_rsqf(wave_sum(s2) * (1.f / D) + LN_EPS);
#pragma unroll
                  for (int j = 0; j < 4; ++j) { v[r][j] = v[r][j] * rstd * gv[j] + bv[j];
                      v2u o; o.x = cvt_pk_bf16(v[r][j].x, v[r][j].y); o.y = cvt_pk_bf16(v[r][j].z, v[r][j].w); *(v2u*)(x1b + (size_t)row * D + 256 * j + 4 * lane) = o;
                      if (MOE_FP8) *(unsigned*)(WSP(unsigned char, WS_X1Q) + (size_t)row * D + 256 * j + 4 * lane) = cvt4_fp8(v[r][j].x, v[r][j].y, v[r][j].z, v[r][j].w); } } }
            float lg[32];
#pragma unroll
            for (int e = 0; e < 32; ++e) { f32x2 p2[4] = {(f32x2){0.f, 0.f}, (f32x2){0.f, 0.f}, (f32x2){0.f, 0.f}, (f32x2){0.f, 0.f}};
#pragma unroll
                for (int j = 0; j < 4; ++j) { const f32x4 w = *(const LAS f32x4*)(RWT + e * D + 256 * j + 4 * lane);
#pragma unroll
                    for (int r = 0; r < 4; ++r) { p2[r] = v[r][j].xy * w.xy + p2[r]; p2[r] = v[r][j].zw * w.zw + p2[r]; } }
                float p[4] = {p2[0].x + p2[0].y, p2[1].x + p2[1].y, p2[2].x + p2[2].y, p2[3].x + p2[3].y};
                { const bool hi = (lane & 32) != 0; const float k0 = hi ? p[2] : p[0], s0 = hi ? p[0] : p[2], k1 = hi ? p[3] : p[1], s1 = hi ? p[1] : p[3]; p[0] = k0 + __shfl_xor(s0, 32); p[1] = k1 + __shfl_xor(s1, 32); }
                { const bool hi = (lane & 16) != 0; const float k0 = hi ? p[1] : p[0], s0 = hi ? p[0] : p[1]; p[0] = k0 + __shfl_xor(s0, 16); }
                float t = p[0]; t += __shfl_xor(t, 8); t += __shfl_xor(t, 4); t += __shfl_xor(t, 2); t += __shfl_xor(t, 1);
                lg[e] = t + rb[e]; }
            float la = 0.f, lb_ = 0.f;
#pragma unroll
            for (int e = 0; e < 32; ++e) { if (e == 2 * sub) la = lg[e]; if (e == 2 * sub + 1) lb_ = lg[e]; }
            int ra = 0, rbk = 0;
#pragma unroll
            for (int e = 0; e < 32; ++e) { ra += (lg[e] > la || (lg[e] == la && e < 2 * sub)) ? 1 : 0; rbk += (lg[e] > lb_ || (lg[e] == lb_ && e < 2 * sub + 1)) ? 1 : 0; }
            const int rowl = rg * 4 + (lane >> 4);
            if (ra < 4) { TOPV[rowl * 4 + ra] = la; TOPE[rowl * 4 + ra] = 2 * sub; }
            if (rbk < 4) { TOPV[rowl * 4 + rbk] = lb_; TOPE[rowl * 4 + rbk] = 2 * sub + 1; }
        }
        LDS_WAIT();
        int my_e = 0; float my_g = 0.f; unsigned my_r = 0u;
        if (lane < 32) { const int ri = lane >> 2, k = lane & 3; const f32x4 tv = *(const LAS f32x4*)(TOPV + ri * 4);
            const float e1 = __expf(tv.y - tv.x), e2 = __expf(tv.z - tv.x), e3 = __expf(tv.w - tv.x); const float inv = __builtin_amdgcn_rcpf(1.0f + e1 + e2 + e3);
            my_e = TOPE[ri * 4 + k]; my_g = (k == 0 ? 1.0f : k == 1 ? e1 : k == 2 ? e2 : e3) * inv;
            my_r = DRY ? 0u : atomicAdd((unsigned*)&lcnt[my_e], 1u); }
        __syncthreads();
        if (!DRY && F.tid < 32) { const unsigned n = lcnt[F.tid]; lbase[F.tid] = n ? __hip_atomic_fetch_add(cnt + F.tid * 16, n, RLX_AGENT) : 0u; }
        __syncthreads();
        if (!DRY && lane < 32) { const int row = blk * 64 + F.wave * 8 + (lane >> 2); const unsigned slot = (unsigned)my_e * ECAP + lbase[my_e] + my_r;
            sdest[slot] = row * 4 + (lane & 3); sgate[slot] = my_g; }
        __syncthreads();
    }
}
#endif
__device__ __forceinline__ void p9_combine(Frame& F, const Args& A) {
    const bf16* x1b = WSP(bf16, WS_X1B); const bf16* yb = WSP(bf16, WS_YBUF); bf16* hb = WSP(bf16, WS_HB);
    const int gw = F.vcu * NWAVES + F.wave, NGW = F.G * NWAVES, lane = F.lane;
    for (int row = gw; row < T; row += NGW) {
        v4u y[4][2], xw[2];
#pragma unroll
        for (int j = 0; j < 2; ++j) {
#pragma unroll
            for (int k = 0; k < 4; ++k) y[k][j] = *(const v4u*)(yb + ((size_t)row * 4 + k) * D + 512 * j + 8 * lane);
            xw[j] = *(const v4u*)(x1b + (size_t)row * D + 512 * j + 8 * lane); }
#pragma unroll
        for (int j = 0; j < 2; ++j) { f32x4 v0, v1; pg8::unpack8(xw[j], v0, v1); v0 = v0 * DN_ALPHA; v1 = v1 * DN_ALPHA;
#pragma unroll
            for (int k = 0; k < 4; ++k) { f32x4 a, b; pg8::unpack8(y[k][j], a, b); v0 = v0 + a; v1 = v1 + b; }
            v4u wv; wv.x = cvt_pk_bf16(v0.x, v0.y); wv.y = cvt_pk_bf16(v0.z, v0.w); wv.z = cvt_pk_bf16(v1.x, v1.y); wv.w = cvt_pk_bf16(v1.z, v1.w); *(v4u*)(hb + (size_t)row * D + 512 * j + 8 * lane) = wv;
            if (PLE_FP8) { v2u q; q.x = cvt4_fp8(v0.x, v0.y, v0.z, v0.w); q.y = cvt4_fp8(v1.x, v1.y, v1.z, v1.w); *(v2u*)(WSP(unsigned char, WS_HQ) + (size_t)row * D + 512 * j + 8 * lane) = q; } }
    }
}
__device__ __forceinline__ void p11_ln2(Frame& F, const Args& A, int layer) {
    const bf16* h2 = WSP(bf16, WS_H2); bf16* xb = WSP(bf16, WS_XB);
    const float* g = KIN(I_LN2G) + layer * D; const float* bb = KIN(I_LN2B) + layer * D;
    const int gw = F.vcu * NWAVES + F.wave, NGW = F.G * NWAVES, lane = F.lane;
    for (int row = gw; row < T; row += NGW) {
        const bf16* yr = h2 + (size_t)row * D; f32x4 v[4]; float s = 0.f;
#pragma unroll
        for (int j = 0; j < 4; ++j) { const v2u w = *(const v2u*)(yr + 256 * j + 4 * lane); v[j] = (f32x4){__uint_as_float(w.x << 16), __uint_as_float(w.x & 0xffff0000u), __uint_as_float(w.y << 16), __uint_as_float(w.y & 0xffff0000u)}; s += (v[j].x + v[j].y) + (v[j].z + v[j].w); }
        const float mean = wave_sum(s) * (1.f / D); float s2 = 0.f;
#pragma unroll
        for (int j = 0; j < 4; ++j) { v[j] = v[j] - mean; s2 += (v[j].x * v[j].x + v[j].y * v[j].y) + (v[j].z * v[j].z + v[j].w * v[j].w); }
        const float rstd = __builtin_amdgcn_rsqf(wave_sum(s2) * (1.f / D) + LN_EPS);
#pragma unroll
        for (int j = 0; j < 4; ++j) { const f32x4 gv = *(const f32x4*)(g + 256 * j + 4 * lane), bv = *(const f32x4*)(bb + 256 * j + 4 * lane);
            const f32x4 o = v[j] * rstd * gv + bv; const size_t off = (size_t)row * D + 256 * j + 4 * lane;
            if (layer == DEPTH - 1) *(f32x4*)(F.out + off) = o; v2u w; w.x = cvt_pk_bf16(o.x, o.y); w.y = cvt_pk_bf16(o.z, o.w); *(v2u*)(xb + off) = w; }
    }
}
__device__ __forceinline__ void moe_build_pfx(Frame& F, const Args& A, int layer, int NT) {
    volatile LAS unsigned* pfx = F.MISC + MW_PFX;
    __syncthreads();
    if (F.tid < 64) {
        const int e = F.tid & 31;
        const unsigned c = __hip_atomic_load(F.ctl + CW_CNT + (layer * NE + e) * 16, RLX_AGENT);
        const unsigned un = ((c + 255u) >> 8) * (unsigned)NT; unsigned inc = un;
#pragma unroll
        for (int o = 1; o < 32; o <<= 1) { const unsigned t = (unsigned)my_shfl_up((int)inc, o); if (e >= o) inc += t; }
        if (F.tid < 32) { pfx[e] = inc - un; pfx[40 + e] = c; if (e == 31) pfx[32] = inc; }
    }
    __syncthreads();
}
#define UU(t, col) bf2f(u[(size_t)(t) * NUP + (col)])
#define UU4(t, col) ldu4(u + (size_t)(t) * NUP + (col))
__device__ __forceinline__ f32x4 ldu4(const bf16* p) { const v2u w = *(const v2u*)p; return (f32x4){__uint_as_float(w.x << 16), __uint_as_float(w.x & 0xffff0000u), __uint_as_float(w.y << 16), __uint_as_float(w.y & 0xffff0000u)}; }
__device__ __forceinline__ f32x4 ldb4(const bf16* p) { const v2u w = *(const v2u*)p; return (f32x4){__uint_as_float(w.x << 16), __uint_as_float(w.x & 0xffff0000u), __uint_as_float(w.y << 16), __uint_as_float(w.y & 0xffff0000u)}; }
__device__ __forceinline__ void stb4(bf16* p, f32x4 v) { v2u o; o.x = cvt_pk_bf16(v.x, v.y); o.y = cvt_pk_bf16(v.z, v.w); *(v2u*)p = o; }
__device__ __forceinline__ void lds_st_bf16(LAS unsigned char* p, float v) { *(LAS unsigned short*)p = (unsigned short)(cvt_pk_bf16(v, 0.f) & 0xffffu); }
__device__ __forceinline__ void lds_st_bf16x4(LAS unsigned char* p, float a, float b, float c, float d) { v2u o; o.x = cvt_pk_bf16(a, b); o.y = cvt_pk_bf16(c, d); *(LAS v2u*)p = o; }

#if OUT_FP8
#define MIX_ST4(mix, idx, a, b, c, d) (*(unsigned*)((unsigned char*)(mix) + (idx)) = cvt4_fp8(a, b, c, d))
#else
#define MIX_ST4(mix, idx, a, b, c, d) do { v2u o_; o_.x = cvt_pk_bf16(a, b); o_.y = cvt_pk_bf16(c, d); *(v2u*)((mix) + (idx)) = o_; } while (0)
#endif
__device__ __forceinline__ void ssd_stage1(Frame& F, const Args& A, int layer, int b, int c) {
    const bf16* u = WSP(bf16, WS_U);
    LAS unsigned char* L = F.lds;
    LAS float* DT = (LAS float*)L; LAS float* AC = DT + 256;
    LAS unsigned char* BMT = L + 2048; LAS unsigned char* XCDT = BMT + 128 * 144;
    const int t0 = b * SEQ + c * 64, tid = F.tid, lane = F.lane, wave = F.wave;
    if (wave < 4) {
        const int hh = wave;
        const float dt = softplusf_(UU(t0 + lane, U_SSD_DT + hh) + KIN(I_SDTB)[layer * 4 + hh]);
        const float adt = -dt * __expf(KIN(I_SALOG)[layer * 4 + hh]);
        const float ac = wave_scan_add(adt, lane);
        DT[hh * 64 + lane] = dt; AC[hh * 64 + lane] = ac;
        if (lane == 63) WSP(float, WS_SSD_DEC)[(b * 4 + hh) * NCH + c] = __expf(ac);
    }
    __syncthreads();
    if (tid < 384) {
        const int cc = tid; const float* cw = KIN(I_SCW) + (size_t)layer * 2048 + cc; const float w0 = cw[0], w1 = cw[512], w2 = cw[1024], w3 = cw[1536], cb = KIN(I_SCB)[layer * 512 + cc];
        const bf16* up = u + (size_t)t0 * NUP + U_SSD_X + cc;
        float win0 = 0.f, win1 = 0.f, win2 = 0.f;
        if (c > 0) { win0 = bf2f(up[-3 * NUP]); win1 = bf2f(up[-2 * NUP]); win2 = bf2f(up[-1 * NUP]); }
        const int hh = (cc >> 6) & 3; const bool isx = cc < 256;
        LAS unsigned char* dst = isx ? XCDT + cc * 144 : BMT + (cc - 256) * 144;
        const float aclast = AC[hh * 64 + 63];
#pragma unroll 1
        for (int l0 = 0; l0 < 64; l0 += 32) {
            float xv[32];
#pragma unroll
            for (int j = 0; j < 32; ++j) xv[j] = bf2f(up[(l0 + j) * NUP]);
#pragma unroll
            for (int j8 = 0; j8 < 4; ++j8) { float o[8];
#pragma unroll
                for (int j = 0; j < 8; ++j) { const int l = l0 + j8 * 8 + j; const float x = xv[j8 * 8 + j]; const float y = cb + w0 * win0 + w1 * win1 + w2 * win2 + w3 * x; win0 = win1; win1 = win2; win2 = x;
                    float s = siluf_(y); if (isx) s *= DT[hh * 64 + l] * __expf(aclast - AC[hh * 64 + l]); o[j] = s; }
                *(LAS v4u*)(dst + (l0 + j8 * 8) * 2) = pack8(o); }
        }
    }
    __syncthreads();
    { const int fr = lane & 15, fq = lane >> 4; bf16* st = WSP(bf16, WS_SSD_ST);
#pragma unroll 1
      for (int i = 0; i < 2; ++i) { const int row0 = (2 * wave + i) * 16; const int hh = row0 >> 6, p = (row0 & 63) + fr;
          bf16* dstp = st + (((size_t)(b * 4 + hh) * NCH + c) * 64 + p) * 128;
#pragma unroll 1
          for (int ntl = 0; ntl < 8; ++ntl) { f32x4 acc = {0.f, 0.f, 0.f, 0.f}; acc = mm16(XCDT + row0 * 144, 144, BMT + ntl * 16 * 144, 144, 64, acc, fr, fq);
              stb4(dstp + ntl * 16 + 4 * fq, acc); } } }
    __syncthreads();
}
__device__ __forceinline__ void ssd_stage3(Frame& F, const Args& A, int layer, int b, int c) {
    const bf16* u = WSP(bf16, WS_U);
    LAS unsigned char* L = F.lds;
    LAS float* DT = (LAS float*)L; LAS float* AC = DT + 256;
    LAS unsigned char* CM = L + 2048; LAS unsigned char* BM = CM + 64 * 272; LAS unsigned char* XCT = BM + 64 * 272; LAS unsigned char* MM = XCT + 256 * 144;
    LAS unsigned char* YG = XCT;
    const int t0 = b * SEQ + c * 64, tid = F.tid, lane = F.lane, wave = F.wave, fr = lane & 15, fq = lane >> 4;
    if (wave < 4) {
        const int hh = wave;
        const float dt = softplusf_(UU(t0 + lane, U_SSD_DT + hh) + KIN(I_SDTB)[layer * 4 + hh]);
        const float adt = -dt * __expf(KIN(I_SALOG)[layer * 4 + hh]);
        DT[hh * 64 + lane] = dt; AC[hh * 64 + lane] = wave_scan_add(adt, lane);
    }
    __syncthreads();
    {
        const int cc = tid; const float* cw = KIN(I_SCW) + (size_t)layer * 2048 + cc; const float w0 = cw[0], w1 = cw[512], w2 = cw[1024], w3 = cw[1536], cb = KIN(I_SCB)[layer * 512 + cc];
        const bf16* up = u + (size_t)t0 * NUP + U_SSD_X + cc;
        float win0 = 0.f, win1 = 0.f, win2 = 0.f;
        if (c > 0) { win0 = bf2f(up[-3 * NUP]); win1 = bf2f(up[-2 * NUP]); win2 = bf2f(up[-1 * NUP]); }
        const int hh = (cc >> 6) & 3;
#pragma unroll 1
        for (int l0 = 0; l0 < 64; l0 += 32) {
            float xv[32];
#pragma unroll
            for (int j = 0; j < 32; ++j) xv[j] = bf2f(up[(l0 + j) * NUP]);
#pragma unroll
            for (int j8 = 0; j8 < 4; ++j8) { float o[8];
#pragma unroll
                for (int j = 0; j < 8; ++j) { const int l = l0 + j8 * 8 + j; const float x = xv[j8 * 8 + j]; const float y = cb + w0 * win0 + w1 * win1 + w2 * win2 + w3 * x; win0 = win1; win1 = win2; win2 = x;
                    float s = siluf_(y); if (cc < 256) s *= DT[hh * 64 + l]; o[j] = s; }
                if (cc < 256) *(LAS v4u*)(XCT + cc * 144 + (l0 + j8 * 8) * 2) = pack8(o);
                else { LAS unsigned char* d2 = (cc < 384 ? BM + (cc - 256) * 2 : CM + (cc - 384) * 2) + (l0 + j8 * 8) * 272;
#pragma unroll
                    for (int j = 0; j < 8; ++j) lds_st_bf16(d2 + j * 272, o[j]); } }
        }
    }
    __syncthreads();
#pragma unroll 1
    for (int i = 0; i < 2; ++i) { const int idx = 2 * wave + i, lt = idx >> 2, st = idx & 3;
        f32x4 acc = {0.f, 0.f, 0.f, 0.f}; acc = mm16(CM + lt * 16 * 272, 272, BM + st * 16 * 272, 272, 128, acc, fr, fq);
        const int l = lt * 16 + fr, s0 = st * 16 + 4 * fq;
#pragma unroll
        for (int hh = 0; hh < 4; ++hh) { const float al = AC[hh * 64 + l], dl = KIN(I_SD)[layer * 4 + hh] / DT[hh * 64 + l]; float o[4];
#pragma unroll
            for (int j = 0; j < 4; ++j) { const int s = s0 + j; float m = (l >= s) ? acc[j] * __expf(al - AC[hh * 64 + s]) : 0.f; if (l == s) m += dl; o[j] = m; }
            lds_st_bf16x4(MM + hh * 9216 + l * 144 + s0 * 2, o[0], o[1], o[2], o[3]); } }
    __syncthreads();
    f32x4 yv[2][4];
    { const int hh = wave >> 1; const bf16* prev = WSP(bf16, WS_SSD_ST) + ((size_t)(b * 4 + hh) * NCH + c) * 8192;
      bf16x8 pf[4][4];
#pragma unroll
      for (int pt = 0; pt < 4; ++pt)
#pragma unroll
          for (int ks = 0; ks < 4; ++ks) pf[pt][ks] = *(const bf16x8*)(prev + (size_t)(pt * 16 + fr) * 128 + ks * 32 + fq * 8);
#pragma unroll
      for (int i = 0; i < 2; ++i) { const int lt = 2 * (wave & 1) + i, l = lt * 16 + fr; const float ea = __expf(AC[hh * 64 + l]);
#pragma unroll
          for (int pt = 0; pt < 4; ++pt) { f32x4 ad = {0.f, 0.f, 0.f, 0.f}, ao = {0.f, 0.f, 0.f, 0.f};
              ad = mm16(MM + hh * 9216 + lt * 16 * 144, 144, XCT + (hh * 64 + pt * 16) * 144, 144, 64, ad, fr, fq);
              ao = mm16_rB<4>(CM + lt * 16 * 272, 272, pf[pt], ao, fr, fq);
              const f32x4 z = UU4(t0 + l, U_SSD_Z + hh * 64 + pt * 16 + 4 * fq);
              f32x4 y = ad + ao * ea; y.x *= siluf_(z.x); y.y *= siluf_(z.y); y.z *= siluf_(z.z); y.w *= siluf_(z.w); yv[i][pt] = y; } } }
    __syncthreads();
    { const int hh = wave >> 1;
#pragma unroll
      for (int i = 0; i < 2; ++i) { const int l = (2 * (wave & 1) + i) * 16 + fr;
#pragma unroll
          for (int pt = 0; pt < 4; ++pt) *(LAS f32x4*)(YG + l * 1040 + (hh * 64 + pt * 16 + 4 * fq) * 4) = yv[i][pt]; } }
    __syncthreads();
    { const f32x4 g = *(const f32x4*)(KIN(I_SNG) + layer * 256 + 4 * lane); bf16* mix = WSP(bf16, WS_MIX);
#pragma unroll 1
      for (int i = 0; i < 8; ++i) { const int l = wave * 8 + i; const f32x4 y = *(const LAS f32x4*)(YG + l * 1040 + lane * 16);
          const float ss = wave_sum((y.x * y.x + y.y * y.y) + (y.z * y.z + y.w * y.w)); const float r = __builtin_amdgcn_rsqf(ss * (1.f / 256.f) + NORM_EPS);
          MIX_ST4(mix, (size_t)(t0 + l) * D + 4 * lane, y.x * r * g.x, y.y * r * g.y, y.z * r * g.z, y.w * r * g.w); } }
    __syncthreads();
}

__device__ __forceinline__ void gla_bcum_all(Frame& F, const Args& A, int layer, const LAS float* GD, LAS float* BC) {
    const int d = F.tid & 127, lq = F.tid >> 7;
    float gup[16];
    { const f32x4* gp4 = (const f32x4*)(WSP(float, WS_LORA) + (size_t)layer * LORA_PER_LAYER + 32768 + d * 16);
#pragma unroll
      for (int i = 0; i < 4; ++i) { const f32x4 a = gp4[i]; gup[4 * i] = a.x; gup[4 * i + 1] = a.y; gup[4 * i + 2] = a.z; gup[4 * i + 3] = a.w; } }
    const float gb = KIN(I_GGB)[layer * 128 + d];
#pragma unroll 4
    for (int li = 0; li < 16; ++li) { const int l = lq * 16 + li; float x = gb;
#pragma unroll
        for (int i = 0; i < 4; ++i) { const f32x4 g4 = *(const LAS f32x4*)(GD + l * 16 + 4 * i); x += (g4.x * gup[4 * i] + g4.y * gup[4 * i + 1]) + (g4.z * gup[4 * i + 2] + g4.w * gup[4 * i + 3]); }
        BC[l * 128 + d] = logsigmoidf_(x) * 0.0625f; }
    __syncthreads();
    if (F.tid < 128) { float run = 0.f;
#pragma unroll 1
        for (int l0 = 0; l0 < 64; l0 += 16) { float v[16];
#pragma unroll
            for (int j = 0; j < 16; ++j) v[j] = BC[(l0 + j) * 128 + d];
#pragma unroll
            for (int j = 0; j < 16; ++j) { run += v[j]; BC[(l0 + j) * 128 + d] = run; } } }
}
__device__ __forceinline__ void gla_stage1(Frame& F, const Args& A, int layer, int b, int c) {
    const bf16* u = WSP(bf16, WS_U);
    LAS unsigned char* L = F.lds;
    LAS float* GD = (LAS float*)L; LAS float* BC = (LAS float*)(L + 4096);
    LAS unsigned char* KDT = L + 36864; LAS unsigned char* VT = KDT + 128 * 144;
    const int t0 = b * SEQ + c * 64, tid = F.tid, lane = F.lane, wave = F.wave, fr = lane & 15, fq = lane >> 4;
    if (tid < 256) { const int l = tid >> 2, q4 = tid & 3; *(LAS f32x4*)(GD + l * 16 + q4 * 4) = UU4(t0 + l, U_GL_G + 4 * q4); }
    __syncthreads();
    gla_bcum_all(F, A, layer, GD, BC);
    if (tid < 128) {
        const int d = tid; const float blast = BC[63 * 128 + d];
        WSP(float, WS_GLA_DEC)[(size_t)(b * NCH + c) * 128 + d] = __expf(blast);
        const bf16* up = u + (size_t)t0 * NUP + U_GL_K + d;
#pragma unroll 1
        for (int l0 = 0; l0 < 64; l0 += 32) { float xv[32];
#pragma unroll
            for (int j = 0; j < 32; ++j) xv[j] = bf2f(up[(l0 + j) * NUP]);
#pragma unroll
            for (int j8 = 0; j8 < 4; ++j8) { float o[8];
#pragma unroll
                for (int j = 0; j < 8; ++j) { const int l = l0 + j8 * 8 + j; o[j] = xv[j8 * 8 + j] * __expf(blast - BC[l * 128 + d]); }
                *(LAS v4u*)(KDT + d * 144 + (l0 + j8 * 8) * 2) = pack8(o); } }
    } else if (tid < 384) {
        const int vch = tid - 128; const bf16* up = u + (size_t)t0 * NUP + U_GL_V + vch;
#pragma unroll 1
        for (int l0 = 0; l0 < 64; l0 += 32) { float xv[32];
#pragma unroll
            for (int j = 0; j < 32; ++j) xv[j] = bf2f(up[(l0 + j) * NUP]);
#pragma unroll
            for (int j8 = 0; j8 < 4; ++j8) { float o[8];
#pragma unroll
                for (int j = 0; j < 8; ++j) o[j] = xv[j8 * 8 + j];
                *(LAS v4u*)(VT + vch * 144 + (l0 + j8 * 8) * 2) = pack8(o); } }
    }
    __syncthreads();
    { bf16* st = WSP(bf16, WS_GLA_ST);
#pragma unroll 1
      for (int i = 0; i < 4; ++i) { const int idx = 4 * wave + i, hh = idx >> 3, dtl = (idx >> 2) & 1, vt = idx & 3;
          f32x4 acc = {0.f, 0.f, 0.f, 0.f}; acc = mm16(KDT + (hh * 32 + dtl * 16) * 144, 144, VT + (hh * 64 + vt * 16) * 144, 144, 64, acc, fr, fq);
          stb4(st + (((size_t)(b * 4 + hh) * NCH + c) * 32 + dtl * 16 + fr) * 64 + vt * 16 + 4 * fq, acc); } }
    __syncthreads();
}
__device__ __forceinline__ void gla_stage3(Frame& F, const Args& A, int layer, int b, int c) {
    const bf16* u = WSP(bf16, WS_U);
    LAS unsigned char* L = F.lds;
    LAS float* GD = (LAS float*)L; LAS float* BC = (LAS float*)(L + 4096); LAS unsigned char* ATT = L + 4096;
    LAS unsigned char* QD = L + 40960; LAS unsigned char* KI = QD + 64 * 272; LAS unsigned char* VT = KI + 64 * 272; LAS unsigned char* PVT = VT + 256 * 144;
    const int t0 = b * SEQ + c * 64, tid = F.tid, lane = F.lane, wave = F.wave, fr = lane & 15, fq = lane >> 4;
    if (tid < 256) { const int l = tid >> 2, q4 = tid & 3; *(LAS f32x4*)(GD + l * 16 + q4 * 4) = UU4(t0 + l, U_GL_G + 4 * q4); }
    __syncthreads();
    gla_bcum_all(F, A, layer, GD, BC);
    if (tid < 128) {
        const int d = tid;
        const bf16* uq = u + (size_t)t0 * NUP + U_GL_Q + d; const bf16* uk = u + (size_t)t0 * NUP + U_GL_K + d;
#pragma unroll 1
        for (int l0 = 0; l0 < 64; l0 += 16) { float qv[16], kv[16];
#pragma unroll
            for (int j = 0; j < 16; ++j) { qv[j] = bf2f(uq[(l0 + j) * NUP]); kv[j] = bf2f(uk[(l0 + j) * NUP]); }
#pragma unroll
            for (int j = 0; j < 16; ++j) { const int l = l0 + j; const float bc = BC[l * 128 + d];
                lds_st_bf16(QD + l * 272 + d * 2, qv[j] * 0.17677669529663687f * __expf(bc)); lds_st_bf16(KI + l * 272 + d * 2, kv[j] * __expf(-bc)); } }
    } else if (tid < 384) {
        const int vch = tid - 128; const bf16* up = u + (size_t)t0 * NUP + U_GL_V + vch;
#pragma unroll 1
        for (int l0 = 0; l0 < 64; l0 += 32) { float xv[32];
#pragma unroll
            for (int j = 0; j < 32; ++j) xv[j] = bf2f(up[(l0 + j) * NUP]);
#pragma unroll
            for (int j8 = 0; j8 < 4; ++j8) { float o[8];
#pragma unroll
                for (int j = 0; j < 8; ++j) o[j] = xv[j8 * 8 + j];
                *(LAS v4u*)(VT + vch * 144 + (l0 + j8 * 8) * 2) = pack8(o); } }
    } else {
        const bf16* prev = WSP(bf16, WS_GLA_ST);
#pragma unroll 4
        for (int i = tid - 384; i < 8192; i += 128) { const int hh = i >> 11, dd = (i >> 6) & 31, vv = i & 63;
            *(LAS unsigned short*)(PVT + (hh * 64 + vv) * 80 + dd * 2) = prev[((size_t)(b * 4 + hh) * NCH + c) * 2048 + dd * 64 + vv]; }
    }
    __syncthreads();
    const int hh = wave >> 1;
#pragma unroll 1
    for (int i = 0; i < 2; ++i) { const int tt = 2 * (wave & 1) + i, t = tt * 16 + fr;
#pragma unroll
        for (int st = 0; st < 4; ++st) { f32x4 acc = {0.f, 0.f, 0.f, 0.f}; acc = mm16(QD + tt * 16 * 272 + hh * 64, 272, KI + st * 16 * 272 + hh * 64, 272, 32, acc, fr, fq);
            const int s0 = st * 16 + 4 * fq;
            lds_st_bf16x4(ATT + hh * 9216 + t * 144 + s0 * 2, t >= s0 ? acc[0] : 0.f, t >= s0 + 1 ? acc[1] : 0.f, t >= s0 + 2 ? acc[2] : 0.f, t >= s0 + 3 ? acc[3] : 0.f); } }
    __syncthreads();
    { bf16* mix = WSP(bf16, WS_MIX); const float* ng = KIN(I_GNG) + layer * 256;
#pragma unroll 1
      for (int i = 0; i < 2; ++i) { const int tt = 2 * (wave & 1) + i, t = tt * 16 + fr; f32x4 ov[4]; float ss = 0.f;
#pragma unroll
          for (int vt = 0; vt < 4; ++vt) { f32x4 acc = {0.f, 0.f, 0.f, 0.f};
              acc = mm16(ATT + hh * 9216 + tt * 16 * 144, 144, VT + (hh * 64 + vt * 16) * 144, 144, 64, acc, fr, fq);
              acc = mm16(QD + tt * 16 * 272 + hh * 64, 272, PVT + (hh * 64 + vt * 16) * 80, 80, 32, acc, fr, fq);
              ov[vt] = acc; ss += (acc.x * acc.x + acc.y * acc.y) + (acc.z * acc.z + acc.w * acc.w); }
          ss += __shfl_xor(ss, 16); ss += __shfl_xor(ss, 32);
          const float r = __builtin_amdgcn_rsqf(ss * (1.f / 64.f) + NORM_EPS);
#pragma unroll
          for (int vt = 0; vt < 4; ++vt) { const int col = hh * 64 + vt * 16 + 4 * fq; const f32x4 g = *(const f32x4*)(ng + col); const f32x4 og = UU4(t0 + t, U_GL_OG + col);
              MIX_ST4(mix, (size_t)(t0 + t) * D + 512 + col, ov[vt].x * r * g.x * siluf_(og.x), ov[vt].y * r * g.y * siluf_(og.y), ov[vt].z * r * g.z * siluf_(og.z), ov[vt].w * r * g.w * siluf_(og.w)); } } }
    __syncthreads();
}

__device__ __forceinline__ void mlstm_stage1(Frame& F, const Args& A, int layer, int b, int c) {
    const bf16* u = WSP(bf16, WS_U);
    LAS unsigned char* L = F.lds;
    LAS float* WST = (LAS float*)L; LAS unsigned char* KT = L + 1024; LAS unsigned char* VWT = KT + 256 * 144;
    const int t0 = b * SEQ + c * 64, tid = F.tid, lane = F.lane, wave = F.wave, fr = lane & 15, fq = lane >> 4;
    if (wave < 4) {
        const int hh = wave;
        const float ig = UU(t0 + lane, U_ML_I + hh) + KIN(I_MIB)[layer * 4 + hh];
        const float lf = logsigmoidf_(UU(t0 + lane, U_ML_F + hh) + KIN(I_MFB)[layer * 4 + hh]);
        const float bc = wave_scan_add(lf, lane); const float blast = __shfl(bc, 63);
        const float ast = blast - bc + ig; const float mloc = wave_max(ast);
        WST[hh * 64 + lane] = __expf(ast - mloc);
        if (lane == 0) { WSP(float, WS_ML_BL)[(b * 4 + hh) * NCH + c] = blast; WSP(float, WS_ML_ML)[(b * 4 + hh) * NCH + c] = mloc; }
    } else {
        const int kch = tid - 256, cc = 256 + kch; const float* cw = KIN(I_MCW) + (size_t)layer * 2048 + cc; const float w0 = cw[0], w1 = cw[512], w2 = cw[1024], w3 = cw[1536], cb = KIN(I_MCB)[layer * 512 + cc];
        const bf16* up = u + (size_t)t0 * NUP + U_ML_K + kch;
        float win0 = 0.f, win1 = 0.f, win2 = 0.f;
        if (c > 0) { win0 = bf2f(up[-3 * NUP]); win1 = bf2f(up[-2 * NUP]); win2 = bf2f(up[-1 * NUP]); }
#pragma unroll 1
        for (int l0 = 0; l0 < 64; l0 += 32) { float xv[32];
#pragma unroll
            for (int j = 0; j < 32; ++j) xv[j] = bf2f(up[(l0 + j) * NUP]);
#pragma unroll
            for (int j8 = 0; j8 < 4; ++j8) { float o[8];
#pragma unroll
                for (int j = 0; j < 8; ++j) { const float x = xv[j8 * 8 + j]; const float y = cb + w0 * win0 + w1 * win1 + w2 * win2 + w3 * x; win0 = win1; win1 = win2; win2 = x; o[j] = siluf_(y); }
                *(LAS v4u*)(KT + kch * 144 + (l0 + j8 * 8) * 2) = pack8(o); } }
    }
    __syncthreads();
    if (tid < 256) {
        const int vch = tid, hh = vch >> 6; const bf16* up = u + (size_t)t0 * NUP + U_ML_V + vch;
#pragma unroll 1
        for (int l0 = 0; l0 < 64; l0 += 32) { float xv[32];
#pragma unroll
            for (int j = 0; j < 32; ++j) xv[j] = bf2f(up[(l0 + j) * NUP]);
#pragma unroll
            for (int j8 = 0; j8 < 4; ++j8) { float o[8];
#pragma unroll
                for (int j = 0; j < 8; ++j) o[j] = xv[j8 * 8 + j] * WST[hh * 64 + l0 + j8 * 8 + j];
                *(LAS v4u*)(VWT + vch * 144 + (l0 + j8 * 8) * 2) = pack8(o); } }
    } else {
        const int kch = tid - 256, hh = kch >> 6; float n = 0.f;
#pragma unroll 8
        for (int s = 0; s < 64; ++s) n += WST[hh * 64 + s] * bf2f(*(const LAS unsigned short*)(KT + kch * 144 + s * 2));
        WSP(bf16, WS_ML_N)[((size_t)(b * 4 + hh) * NCH + c) * 64 + (kch & 63)] = (bf16)(cvt_pk_bf16(n, 0.f) & 0xffffu);
    }
    __syncthreads();
    { bf16* cst = WSP(bf16, WS_ML_C); const int hh = wave >> 1;
#pragma unroll 1
      for (int i = 0; i < 2; ++i) { const int vt = 2 * (wave & 1) + i;
#pragma unroll 1
          for (int kt = 0; kt < 4; ++kt) { f32x4 acc = {0.f, 0.f, 0.f, 0.f}; acc = mm16(VWT + (hh * 64 + vt * 16) * 144, 144, KT + (hh * 64 + kt * 16) * 144, 144, 64, acc, fr, fq);
              stb4(cst + (((size_t)(b * 4 + hh) * NCH + c) * 64 + vt * 16 + fr) * 64 + kt * 16 + 4 * fq, acc); } } }
    __syncthreads();
}
__device__ __forceinline__ void mlstm_stage3(Frame& F, const Args& A, int layer, int b, int c) {
    const bf16* u = WSP(bf16, WS_U);
    LAS unsigned char* L = F.lds;
    LAS float* BCU = (LAS float*)L; LAS float* GG = BCU + 256; LAS float* MROW = BCU + 512; LAS float* WINT = BCU + 768; LAS float* NPV = BCU + 1024;
    LAS unsigned char* Q = L + 6144; LAS unsigned char* KK = Q + 64 * 528; LAS unsigned char* VT = KK + 64 * 528; LAS unsigned char* SC = VT + 256 * 144;
    const int t0 = b * SEQ + c * 64, tid = F.tid, lane = F.lane, wave = F.wave, fr = lane & 15, fq = lane >> 4;
    if (wave < 4) {
        const int hh = wave;
        const float ig = UU(t0 + lane, U_ML_I + hh) + KIN(I_MIB)[layer * 4 + hh];
        const float lf = logsigmoidf_(UU(t0 + lane, U_ML_F + hh) + KIN(I_MFB)[layer * 4 + hh]);
        const float bc = wave_scan_add(lf, lane); const float gg = ig - bc;
        const float mprev = WSP(float, WS_ML_M)[(b * 4 + hh) * NCH + c];
        const float minter = bc + mprev, mintra = bc + wave_scan_max(gg, lane), mrow = fmaxf(minter, mintra);
        BCU[hh * 64 + lane] = bc; GG[hh * 64 + lane] = gg; MROW[hh * 64 + lane] = mrow; WINT[hh * 64 + lane] = __expf(minter - mrow);
        NPV[hh * 64 + lane] = bf2f(WSP(bf16, WS_ML_N)[((size_t)(b * 4 + hh) * NCH + c) * 64 + lane]);
    }
    {
        const int cc = tid; const float* cw = KIN(I_MCW) + (size_t)layer * 2048 + cc; const float w0 = cw[0], w1 = cw[512], w2 = cw[1024], w3 = cw[1536], cb = KIN(I_MCB)[layer * 512 + cc];
        const bf16* up = u + (size_t)t0 * NUP + U_ML_Q + cc;
        float win0 = 0.f, win1 = 0.f, win2 = 0.f;
        if (c > 0) { win0 = bf2f(up[-3 * NUP]); win1 = bf2f(up[-2 * NUP]); win2 = bf2f(up[-1 * NUP]); }
        LAS unsigned char* dst = cc < 256 ? Q + cc * 2 : KK + (cc - 256) * 2; const float sc = cc < 256 ? 0.125f : 1.0f;
#pragma unroll 1
        for (int l0 = 0; l0 < 64; l0 += 32) { float xv[32];
#pragma unroll
            for (int j = 0; j < 32; ++j) xv[j] = bf2f(up[(l0 + j) * NUP]);
#pragma unroll
            for (int j = 0; j < 32; ++j) { const float x = xv[j]; const float y = cb + w0 * win0 + w1 * win1 + w2 * win2 + w3 * x; win0 = win1; win1 = win2; win2 = x; lds_st_bf16(dst + (l0 + j) * 528, siluf_(y) * sc); } }
        const int vch = tid & 255, lh = (tid >> 8) * 32; const bf16* uv = u + (size_t)(t0 + lh) * NUP + U_ML_V + vch;
        float xv[32];
#pragma unroll
        for (int j = 0; j < 32; ++j) xv[j] = bf2f(uv[j * NUP]);
#pragma unroll
        for (int j8 = 0; j8 < 4; ++j8) { float o[8];
#pragma unroll
            for (int j = 0; j < 8; ++j) o[j] = xv[j8 * 8 + j];
            *(LAS v4u*)(VT + vch * 144 + (lh + j8 * 8) * 2) = pack8(o); }
    }
    __syncthreads();
    { const int hh = wave >> 1; bf16* mix = WSP(bf16, WS_MIX); const float* ng = KIN(I_MNG) + layer * 256;
      const bf16* cprev = WSP(bf16, WS_ML_C) + ((size_t)(b * 4 + hh) * NCH + c) * 4096;
      bf16x8 cf[4][2];
#pragma unroll
      for (int vt = 0; vt < 4; ++vt)
#pragma unroll
          for (int ks = 0; ks < 2; ++ks) cf[vt][ks] = *(const bf16x8*)(cprev + (size_t)(vt * 16 + fr) * 64 + ks * 32 + fq * 8);
#pragma unroll 1
      for (int i = 0; i < 2; ++i) { const int tt = 2 * (wave & 1) + i, t = tt * 16 + fr;
          const float bt = BCU[hh * 64 + t] - MROW[hh * 64 + t]; float rs = 0.f;
#pragma unroll
          for (int st = 0; st < 4; ++st) { f32x4 acc = {0.f, 0.f, 0.f, 0.f}; acc = mm16(Q + tt * 16 * 528 + hh * 128, 528, KK + st * 16 * 528 + hh * 128, 528, 64, acc, fr, fq);
              const int s0 = st * 16 + 4 * fq; float o[4];
#pragma unroll
              for (int j = 0; j < 4; ++j) { const int s = s0 + j; const float v = (t >= s) ? acc[j] * __expf(bt + GG[hh * 64 + s]) : 0.f; o[j] = v; rs += v; }
              lds_st_bf16x4(SC + hh * 9216 + t * 144 + s0 * 2, o[0], o[1], o[2], o[3]); }
          rs += __shfl_xor(rs, 16); rs += __shfl_xor(rs, 32);
          float nq = 0.f;
#pragma unroll
          for (int j = 0; j < 16; ++j) nq += bf2f(*(const LAS unsigned short*)(Q + t * 528 + (hh * 64 + fq * 16 + j) * 2)) * NPV[hh * 64 + fq * 16 + j];
          nq += __shfl_xor(nq, 16); nq += __shfl_xor(nq, 32);
          const float wi = WINT[hh * 64 + t]; const float den = wi * nq + rs; const float dn = fmaxf(fabsf(den), __expf(-MROW[hh * 64 + t])); const float rdn = 1.0f / dn;
          LDS_WAIT();
          f32x4 hv[4]; float sm = 0.f;
#pragma unroll
          for (int vt = 0; vt < 4; ++vt) { f32x4 acc = {0.f, 0.f, 0.f, 0.f};
              acc = mm16_rB<2>(Q + tt * 16 * 528 + hh * 128, 528, cf[vt], acc, fr, fq);
              acc = acc * wi;
              acc = mm16(SC + hh * 9216 + tt * 16 * 144, 144, VT + (hh * 64 + vt * 16) * 144, 144, 64, acc, fr, fq);
              const f32x4 og = UU4(t0 + t, U_ML_O + hh * 64 + vt * 16 + 4 * fq);
              f32x4 h; h.x = acc.x * rdn * sigmoidf_(og.x); h.y = acc.y * rdn * sigmoidf_(og.y); h.z = acc.z * rdn * sigmoidf_(og.z); h.w = acc.w * rdn * sigmoidf_(og.w);
              hv[vt] = h; sm += (h.x + h.y) + (h.z + h.w); }
          sm += __shfl_xor(sm, 16); sm += __shfl_xor(sm, 32);
          const float mean = sm * (1.f / 64.f); float sq = 0.f;
#pragma unroll
          for (int vt = 0; vt < 4; ++vt) { hv[vt] = hv[vt] - mean; sq += (hv[vt].x * hv[vt].x + hv[vt].y * hv[vt].y) + (hv[vt].z * hv[vt].z + hv[vt].w * hv[vt].w); }
          sq += __shfl_xor(sq, 16); sq += __shfl_xor(sq, 32);
          const float r = __builtin_amdgcn_rsqf(sq * (1.f / 64.f) + NORM_EPS);
#pragma unroll
          for (int vt = 0; vt < 4; ++vt) { const int col = hh * 64 + vt * 16 + 4 * fq; const f32x4 g = *(const f32x4*)(ng + col);
              MIX_ST4(mix, (size_t)(t0 + t) * D + 768 + col, hv[vt].x * r * g.x, hv[vt].y * r * g.y, hv[vt].z * r * g.z, hv[vt].w * r * g.w); } } }
    __syncthreads();
}

__device__ __forceinline__ void rwkv_stage1(Frame& F, const Args& A, int layer, int ub) {
    const bf16* u = WSP(bf16, WS_U);
    LAS unsigned char* L = F.lds;
    LAS unsigned char* LOWA = L;
    LAS float* CUM = (LAS float*)(L + 16384);
    LAS float* AAB = CUM;
    LAS float* TOT = CUM;
    LAS unsigned char* M0 = L + 16384 + 16640;
#define RM(i) (M0 + (i) * 9216)
    LAS float* GAMC = (LAS float*)(F.MISC + MW_GAMC);
    const int t0 = ub * 64, c = ub & 63, tid = F.tid, lane = F.lane, wave = F.wave;
    const float* mu = KIN(I_RMU) + layer * 896;
#ifndef RW_DUP
#define RW_DUP -1
#endif
#define RW_REP(k) for (int rep__ = 0; rep__ < ((RW_DUP == (k)) ? 2 : 1); ++rep__)
    RW_REP(0) {
    {
        const int l = tid >> 3, jq = tid & 7, t = t0 + l; const bool has_prev = (t & (SEQ - 1)) != 0;
        f32x4 cur[4], prv[4];
#pragma unroll
        for (int q = 0; q < 4; ++q) { cur[q] = UU4(t, U_RW_LO + jq * 16 + 4 * q); prv[q] = has_prev ? UU4(t - 1, U_RW_LO + jq * 16 + 4 * q) : (f32x4){0.f, 0.f, 0.f, 0.f}; }
#pragma unroll
        for (int q = 0; q < 4; ++q) { const f32x4 m4 = *(const f32x4*)(mu + 768 + jq * 16 + 4 * q); const f32x4 xs = cur[q] + (prv[q] - cur[q]) * m4; const int j = jq * 16 + 4 * q;
            f32x4 o;
            if (j < 32) { o.x = tanhf_(xs.x); o.y = tanhf_(xs.y); o.z = tanhf_(xs.z); o.w = tanhf_(xs.w); } else if (j < 64) o = xs; else { o.x = sigmoidf_(xs.x); o.y = sigmoidf_(xs.y); o.z = sigmoidf_(xs.z); o.w = sigmoidf_(xs.w); }
            if (j < 64) lds_st_bf16x4(LOWA + l * 144 + j * 2, o.x, o.y, o.z, o.w); else lds_st_bf16x4(RM(0) + l * 144 + (j - 64) * 2, o.x, o.y, o.z, o.w); }
    }
    __syncthreads();
    {
        bf16* RG = WSP(bf16, WS_RW_G); const int lane_ = F.lane, fr_ = lane_ & 15, fq_ = lane_ >> 4;
        const float* gupT = WSP(float, WS_LORA) + (size_t)layer * LORA_PER_LAYER + 16384;
#pragma unroll
        for (int ci = 0; ci < 2; ++ci) { const int ct = 2 * wave + ci; bf16x8 bf[2];
#pragma unroll
            for (int ks = 0; ks < 2; ++ks) bf[ks] = ldfrag_f32(gupT + (size_t)(ct * 16 + fr_) * 64 + ks * 32 + fq_ * 8);
#pragma unroll
            for (int tt = 0; tt < 4; ++tt) { f32x4 acc = {0.f, 0.f, 0.f, 0.f}; acc = mm16_rB<2>(RM(0) + tt * 16 * 144, 144, bf, acc, fr_, fq_);
                stb4(RG + (size_t)(t0 + tt * 16 + fr_) * 256 + ct * 16 + 4 * fq_, acc); } }
    }
    __syncthreads();
    }
    const int b_ = ub >> 6;
#pragma unroll 1
    for (int hh = 0; hh < 4; ++hh) {
        int ch = lane, fr = lane & 15, fq = lane >> 4; asm volatile("" : "+v"(ch), "+v"(fr), "+v"(fq));
        const int tg = wave, cg = hh * 64 + ch; const size_t un = (size_t)(b_ * 4 + hh) * NCH + c;
        float rr[8], k2r[8], vr[8], ar[8], br[8], pl[8];
        LAS float* WPA = (LAS float*)RM(8);
        {
            const int mat = wave >> 2, ct = wave & 3;
            const float* wT = WSP(float, WS_LORA) + (size_t)layer * LORA_PER_LAYER + mat * 8192 + (size_t)(hh * 64 + ct * 16 + fr) * 32 + fq * 8;
            bf16x8 bfw[1]; bfw[0] = ldfrag_f32(wT);
#pragma unroll
            for (int tt = 0; tt < 4; ++tt) { f32x4 acc = {0.f, 0.f, 0.f, 0.f}; acc = mm16_rB<1>(LOWA + tt * 16 * 144 + mat * 64, 144, bfw, acc, fr, fq);
                *(LAS f32x4*)(WPA + mat * 4096 + (tt * 16 + fr) * 64 + ct * 16 + 4 * fq) = acc; }
        }
        __syncthreads();
        RW_REP(1) {
            const float w0 = KIN(I_RW0)[layer * 256 + cg], a0 = KIN(I_RA0)[layer * 256 + cg], kkc = KIN(I_RKK)[layer * 256 + cg], kac = KIN(I_RKA)[layer * 256 + cg];
            const float mur = mu[cg], muk = mu[256 + cg], muv = mu[512 + cg];
            const int tb = t0 + tg * 8; const bool nop = (c == 0) && (tg == 0);
            float rp = nop ? 0.f : UU(tb - 1, U_RW_R + cg), kp = nop ? 0.f : UU(tb - 1, U_RW_K + cg), vp = nop ? 0.f : UU(tb - 1, U_RW_V + cg);
            float rc[8], kc[8], vc[8];
#pragma unroll
            for (int j = 0; j < 8; ++j) { rc[j] = UU(tb + j, U_RW_R + cg); kc[j] = UU(tb + j, U_RW_K + cg); vc[j] = UU(tb + j, U_RW_V + cg); }
            bf16* RW = WSP(bf16, WS_RW);
            float kk[8], al[8], n2[8], run = 0.f;
#pragma unroll
            for (int j = 0; j < 8; ++j) { const int l = tg * 8 + j;
                const float r = rc[j] + (rp - rc[j]) * mur, k = kc[j] + (kp - kc[j]) * muk, v = vc[j] + (vp - vc[j]) * muv; rp = rc[j]; kp = kc[j]; vp = vc[j];
                const float wp = w0 + WPA[l * 64 + ch], ap = a0 + WPA[4096 + l * 64 + ch];
                const float w = -softplusf_(-wp) - 0.5f; run += -__expf(w); pl[j] = run; al[j] = sigmoidf_(ap);
                kk[j] = k * kkc; n2[j] = kk[j] * kk[j];
                k2r[j] = k * (1.0f + (al[j] - 1.0f) * kac); rr[j] = r; vr[j] = v;
                bf16* o = RW + (size_t)(tb + j) * 768 + cg; o[0] = (bf16)(cvt_pk_bf16(r, 0.f) & 0xffffu); o[256] = (bf16)(cvt_pk_bf16(k2r[j], 0.f) & 0xffffu); o[512] = (bf16)(cvt_pk_bf16(v, 0.f) & 0xffffu); }
#pragma unroll
            for (int i = 0; i < 4; ++i) { const bool hi = (ch & 32) != 0; const float keep = hi ? n2[i + 4] : n2[i], send = hi ? n2[i] : n2[i + 4]; n2[i] = keep + __shfl_xor(send, 32); }
#pragma unroll
            for (int i = 0; i < 2; ++i) { const bool hi = (ch & 16) != 0; const float keep = hi ? n2[i + 2] : n2[i], send = hi ? n2[i] : n2[i + 2]; n2[i] = keep + __shfl_xor(send, 16); }
            { const bool hi = (ch & 8) != 0; const float keep = hi ? n2[1] : n2[0], send = hi ? n2[0] : n2[1]; n2[0] = keep + __shfl_xor(send, 8); }
            n2[0] += __shfl_xor(n2[0], 4); n2[0] += __shfl_xor(n2[0], 2); n2[0] += __shfl_xor(n2[0], 1);
#pragma unroll
            for (int j = 0; j < 8; ++j) { const float tot = __builtin_bit_cast(float, __builtin_amdgcn_readlane(__builtin_bit_cast(int, n2[0]), ((j & 4) ? 32 : 0) + ((j & 2) ? 16 : 0) + ((j & 1) ? 8 : 0)));
                const float kkn = kk[j] / fmaxf(sqrtf(tot), 1e-12f); ar[j] = -kkn; br[j] = kkn * al[j]; }
            TOT[tg * 64 + ch] = run;
        }
        __syncthreads();
        RW_REP(3) {
            float off = 0.f, gC = 0.f;
#pragma unroll
            for (int g = 0; g < 8; ++g) { const float tv = TOT[g * 64 + ch]; gC += tv; if (g < tg) off += tv; }
            float oat[8], obb[8], okb[8], ov[8];
#pragma unroll
            for (int j = 0; j < 8; ++j) { const int l = tg * 8 + j; const float gt = off + pl[j], gm = j > 0 ? off + pl[j - 1] : off;
                const float at = ar[j] * __expf(gm), rt = rr[j] * __expf(gt), en = __expf(-gt), ec = __expf(gC - gt);
                lds_st_bf16(RM(0) + l * 144 + ch * 2, at); lds_st_bf16(RM(1) + l * 144 + ch * 2, rt); lds_st_bf16(RM(2) + l * 144 + ch * 2, br[j] * en); lds_st_bf16(RM(3) + l * 144 + ch * 2, k2r[j] * en);
                oat[j] = at; obb[j] = br[j] * ec; okb[j] = k2r[j] * ec; ov[j] = vr[j]; }
            *(LAS v4u*)(RM(4) + ch * 144 + tg * 16) = pack8(oat); *(LAS v4u*)(RM(5) + ch * 144 + tg * 16) = pack8(obb); *(LAS v4u*)(RM(6) + ch * 144 + tg * 16) = pack8(okb); *(LAS v4u*)(RM(7) + ch * 144 + tg * 16) = pack8(ov);
            if (tg == 0) GAMC[ch] = __expf(gC);
        }
        __syncthreads();
        RW_REP(4) {
            const int which = wave >> 1; const LAS unsigned char* Aop = which < 2 ? RM(0) : RM(1); const LAS unsigned char* Bop = (which & 1) ? RM(3) : RM(2);
#pragma unroll 1
            for (int i2 = 0; i2 < 2; ++i2) { const int tt = 2 * (wave & 1) + i2, t = tt * 16 + fr;
#pragma unroll
                for (int it = 0; it < 4; ++it) { f32x4 acc = {0.f, 0.f, 0.f, 0.f}; acc = mm16(Aop + tt * 16 * 144, 144, Bop + it * 16 * 144, 144, 64, acc, fr, fq);
                    const int i0 = it * 16 + 4 * fq; const int lim = which < 2 ? t : t + 1;
                    const float o0 = (i0 < lim) ? acc[0] : 0.f, o1 = (i0 + 1 < lim) ? acc[1] : 0.f, o2 = (i0 + 2 < lim) ? acc[2] : 0.f, o3 = (i0 + 3 < lim) ? acc[3] : 0.f;
#ifdef RW_CLAMP_AAK
                    float q0 = o0, q1 = o1, q2 = o2, q3 = o3;
                    if (which == 1) { q0 = fabsf(o0) < 1e30f ? o0 : 0.f; q1 = fabsf(o1) < 1e30f ? o1 : 0.f; q2 = fabsf(o2) < 1e30f ? o2 : 0.f; q3 = fabsf(o3) < 1e30f ? o3 : 0.f; }
                    if (which == 0) *(LAS f32x4*)(AAB + t * 64 + i0) = (f32x4){o0, o1, o2, o3};
                    else lds_st_bf16x4(RM(7 + which) + t * 144 + i0 * 2, q0, q1, q2, q3);
                    continue;
#endif
                    if (which == 0) { DBG_STAT(11, o0); DBG_STAT(11, o1); DBG_STAT(11, o2); DBG_STAT(11, o3); } if (which == 1) { DBG_STAT(12, o0); DBG_STAT(12, o1); DBG_STAT(12, o2); DBG_STAT(12, o3); } if (which == 2) { DBG_STAT(13, o0); DBG_STAT(13, o3); } if (which == 3) { DBG_STAT(14, o0); DBG_STAT(14, o3); }
                    if (which == 0) *(LAS f32x4*)(AAB + t * 64 + i0) = (f32x4){o0, o1, o2, o3};
                    else lds_st_bf16x4(RM(7 + which) + t * 144 + i0 * 2, o0, o1, o2, o3); } }
        }
        __syncthreads();
        RW_REP(5) {
#pragma unroll 1
            for (int i2 = 0; i2 < 2; ++i2) { const int idx = wave * 2 + i2, vt = idx >> 2, tt = idx & 3; f32x4 acc = {0.f, 0.f, 0.f, 0.f};
                acc = mm16(RM(7) + vt * 16 * 144, 144, RM(8) + tt * 16 * 144, 144, 64, acc, fr, fq);
                DBG_STAT(15, acc[0]); DBG_STAT(15, acc[1]); DBG_STAT(15, acc[2]); DBG_STAT(15, acc[3]);
                lds_st_bf16x4(RM(0) + (vt * 16 + fr) * 144 + (tt * 16 + 4 * fq) * 2, acc[0], acc[1], acc[2], acc[3]); }
        }
#if RW_SOLVE_BLK
        LAS unsigned char* T11T = L + 143616;
        LAS unsigned char* YT = RM(8);
        RW_REP(8) if (wave < 2) {
            const int R0 = wave * 32; float x[32]; f32x4 rowq[8];
#pragma unroll
            for (int tl = 0; tl < 32; ++tl) {
                f32x4 cur[8];
#pragma unroll
                for (int i4 = 0; i4 < (tl + 3) / 4; ++i4) cur[i4] = rowq[i4];
                if (tl + 1 < 32) {
#pragma unroll
                    for (int i4 = 0; i4 < (tl + 4) / 4; ++i4) rowq[i4] = *(const LAS f32x4*)(AAB + (R0 + tl + 1) * 64 + R0 + 4 * i4); }
                float a0 = (R0 + tl == ch) ? 1.0f : 0.f, a1 = 0.f, a2 = 0.f, a3 = 0.f;
#pragma unroll
                for (int i4 = 0; i4 < (tl + 3) / 4; ++i4) { const f32x4 q = cur[i4];
                    a0 += q.x * x[4 * i4]; if (4 * i4 + 1 < tl) a1 += q.y * x[4 * i4 + 1]; if (4 * i4 + 2 < tl) a2 += q.z * x[4 * i4 + 2]; if (4 * i4 + 3 < tl) a3 += q.w * x[4 * i4 + 3]; }
                const float acc = (a0 + a1) + (a2 + a3);
                x[tl] = acc; if (wave == 0 || ch >= 32) lds_st_bf16(RM(11) + (R0 + tl) * 144 + ch * 2, acc); }
            if (wave == 0 && ch < 32) {
#pragma unroll
                for (int q = 0; q < 4; ++q) { const float xv[8] = {x[8 * q], x[8 * q + 1], x[8 * q + 2], x[8 * q + 3], x[8 * q + 4], x[8 * q + 5], x[8 * q + 6], x[8 * q + 7]}; *(LAS v4u*)(T11T + ch * 80 + q * 16) = pack8(xv); } }
        }
        __syncthreads();
        if (wave < 4) {
            const int jt = wave >> 1, it = wave & 1; bf16x8 bfa[1];
            { const LAS float* ap = AAB + (32 + it * 16 + fr) * 64 + 8 * fq; const f32x4 p0 = *(const LAS f32x4*)ap, p1 = *(const LAS f32x4*)(ap + 4);
              v4u w; w.x = cvt_pk_bf16(p0.x, p0.y); w.y = cvt_pk_bf16(p0.z, p0.w); w.z = cvt_pk_bf16(p1.x, p1.y); w.w = cvt_pk_bf16(p1.z, p1.w); bfa[0] = __builtin_bit_cast(bf16x8, w); }
            f32x4 acc = {0.f, 0.f, 0.f, 0.f}; acc = mm16_rB<1>(T11T + jt * 16 * 80, 80, bfa, acc, fr, fq);
            lds_st_bf16x4(YT + (jt * 16 + fr) * 80 + (it * 16 + 4 * fq) * 2, acc[0], acc[1], acc[2], acc[3]);
        }
        __syncthreads();
        if (wave < 4) {
            const int it = wave >> 1, jt = wave & 1;
            f32x4 acc = {0.f, 0.f, 0.f, 0.f}; acc = mm16(RM(11) + (32 + it * 16) * 144 + 64, 144, YT + jt * 16 * 80, 80, 32, acc, fr, fq);
            lds_st_bf16x4(RM(11) + (32 + it * 16 + fr) * 144 + (jt * 16 + 4 * fq) * 2, acc[0], acc[1], acc[2], acc[3]);
        }
        __syncthreads();
#else
        RW_REP(8) if (wave == 0) {
            float x[64]; f32x4 rowq[16];
#pragma unroll
            for (int t = 0; t < 64; ++t) {
                f32x4 cur[16];
#pragma unroll
                for (int i4 = 0; i4 < (t + 3) / 4; ++i4) cur[i4] = rowq[i4];
                if (t + 1 < 64) {
#pragma unroll
                    for (int i4 = 0; i4 < (t + 4) / 4; ++i4) rowq[i4] = *(const LAS f32x4*)(AAB + (t + 1) * 64 + 4 * i4); }
                float a0 = (t == ch) ? 1.0f : 0.f, a1 = 0.f, a2 = 0.f, a3 = 0.f;
#pragma unroll
                for (int i4 = 0; i4 < (t + 3) / 4; ++i4) { const f32x4 q = cur[i4];
                    a0 += q.x * x[4 * i4]; if (4 * i4 + 1 < t) a1 += q.y * x[4 * i4 + 1]; if (4 * i4 + 2 < t) a2 += q.z * x[4 * i4 + 2]; if (4 * i4 + 3 < t) a3 += q.w * x[4 * i4 + 3]; }
                const float acc = (a0 + a1) + (a2 + a3);
                x[t] = acc; lds_st_bf16(RM(11) + t * 144 + ch * 2, acc); }
        }
        __syncthreads();
#endif
        RW_REP(6) {
            const int rt = wave >> 1;
#pragma unroll
            for (int i2 = 0; i2 < 2; ++i2) { const int tt = 2 * (wave & 1) + i2;
                f32x4 acc = {0.f, 0.f, 0.f, 0.f}; acc = mm16(RM(4) + rt * 16 * 144, 144, RM(11) + tt * 16 * 144, 144, 64, acc, fr, fq);
                DBG_STAT(17, acc[0]); DBG_STAT(17, acc[1]); DBG_STAT(17, acc[2]); DBG_STAT(17, acc[3]);
                lds_st_bf16x4(RM(2) + (rt * 16 + fr) * 144 + (tt * 16 + 4 * fq) * 2, acc[0], acc[1], acc[2], acc[3]);
                f32x4 ac2 = {0.f, 0.f, 0.f, 0.f}; ac2 = mm16(RM(0) + rt * 16 * 144, 144, RM(11) + tt * 16 * 144, 144, 64, ac2, fr, fq);
                DBG_STAT(18, ac2[0]); DBG_STAT(18, ac2[1]); DBG_STAT(18, ac2[2]); DBG_STAT(18, ac2[3]);
                lds_st_bf16x4(RM(3) + (rt * 16 + fr) * 144 + (tt * 16 + 4 * fq) * 2, ac2[0], ac2[1], ac2[2], ac2[3]); }
        }
        __syncthreads();
        RW_REP(7) {
            const int which = wave >> 1;
#pragma unroll 1
            for (int i2 = 0; i2 < 2; ++i2) { const int rt = 2 * (wave & 1) + i2, row = rt * 16 + fr;
#pragma unroll
                for (int ct = 0; ct < 4; ++ct) { f32x4 acc = {0.f, 0.f, 0.f, 0.f}; const int c0 = ct * 16 + 4 * fq;
                    if (which == 0) { acc = mm16(RM(9) + rt * 16 * 144, 144, RM(2) + ct * 16 * 144, 144, 64, acc, fr, fq);
                        const v2u rw = *(const LAS v2u*)(RM(1) + row * 144 + c0 * 2);
                        acc[0] += __uint_as_float(rw.x << 16); acc[1] += __uint_as_float(rw.x & 0xffff0000u); acc[2] += __uint_as_float(rw.y << 16); acc[3] += __uint_as_float(rw.y & 0xffff0000u);
                        DBG_STAT(19, acc[0]); DBG_STAT(19, acc[1]); DBG_STAT(19, acc[2]); DBG_STAT(19, acc[3]);
                        v2u o; o.x = cvt_pk_bf16(acc[0], acc[1]); o.y = cvt_pk_bf16(acc[2], acc[3]); *(v2u*)(WSP(bf16, WS_RW_RH) + un * 4096 + row * 64 + c0) = o; }
                    else if (which == 1) {
#ifndef RW_NO_U0
                        acc = mm16(RM(9) + rt * 16 * 144, 144, RM(3) + ct * 16 * 144, 144, 64, acc, fr, fq);
#endif
                        acc = mm16(RM(10) + rt * 16 * 144, 144, RM(7) + ct * 16 * 144, 144, 64, acc, fr, fq);
                        DBG_STAT(20, acc[0]); DBG_STAT(20, acc[1]); DBG_STAT(20, acc[2]); DBG_STAT(20, acc[3]);
                        stb4(WSP(bf16, WS_RW_O0) + un * 4096 + row * 64 + c0, acc); }
                    else if (which == 2) { acc = mm16(RM(5) + rt * 16 * 144, 144, RM(2) + ct * 16 * 144, 144, 64, acc, fr, fq);
                        const float gd = GAMC[row]; if (row == c0) acc[0] += gd; if (row == c0 + 1) acc[1] += gd; if (row == c0 + 2) acc[2] += gd; if (row == c0 + 3) acc[3] += gd;
                        DBG_STAT(21, acc[0]); DBG_STAT(21, acc[1]); DBG_STAT(21, acc[2]); DBG_STAT(21, acc[3]);
                        v2u o; o.x = cvt_pk_bf16(acc[0], acc[1]); o.y = cvt_pk_bf16(acc[2], acc[3]);
                        *(v2u*)((unsigned char*)(WSP(bf16, WS_RW_GF) + un * 4096) + ((rt * 2 + (ct >> 1)) * 64 + ch) * 16 + (ct & 1) * 8) = o; }
                    else { acc = mm16(RM(3) + rt * 16 * 144, 144, RM(5) + ct * 16 * 144, 144, 64, acc, fr, fq); acc = mm16(RM(7) + rt * 16 * 144, 144, RM(6) + ct * 16 * 144, 144, 64, acc, fr, fq);
                        DBG_STAT(22, acc[0]); DBG_STAT(22, acc[1]); DBG_STAT(22, acc[2]); DBG_STAT(22, acc[3]);
                        *(f32x4*)(WSP(float, WS_RW_HT) + un * 4096 + row * 64 + c0) = acc; } } }
        }
        __syncthreads();
    }
#undef RM
}
#if RW_SCAN_DMA
__device__ __forceinline__ void rwkv_scan_wave(Frame& F, const Args& A, int wslot) {
    const int lane = F.lane, fr = lane & 15, fq = lane >> 4, bh = wslot >> 2, v0 = (wslot & 3) * 16;
    const unsigned char* GFb = (const unsigned char*)(WSP(bf16, WS_RW_GF) + (size_t)bh * NCH * 4096) + lane * 16;
    const unsigned char* HTb = (const unsigned char*)(WSP(float, WS_RW_HT) + (size_t)bh * NCH * 4096 + (size_t)(v0 + fr) * 64 + 4 * fq);
    bf16* PT = WSP(bf16, WS_RW_PT) + (size_t)bh * NCH * 4096 + (size_t)(v0 + fr) * 64 + 4 * fq;
    LAS unsigned char* ring = F.lds;
    f32x4 P[4] = {{0.f, 0.f, 0.f, 0.f}, {0.f, 0.f, 0.f, 0.f}, {0.f, 0.f, 0.f, 0.f}, {0.f, 0.f, 0.f, 0.f}};
#define RW2_ISSUE(cc, sl) do { _Pragma("unroll") for (int f_ = 0; f_ < 8; ++f_) __builtin_amdgcn_global_load_lds((const unsigned*)(GFb + (size_t)(cc) * 8192 + f_ * 1024), (LAS unsigned*)(ring + (sl) * 12288 + f_ * 1024), 16, 0, 0); \
        _Pragma("unroll") for (int m_ = 0; m_ < 4; ++m_) __builtin_amdgcn_global_load_lds((const unsigned*)(HTb + (size_t)(cc) * 16384 + m_ * 64), (LAS unsigned*)(ring + (sl) * 12288 + 8192 + m_ * 1024), 16, 0, 0); } while (0)
#define RW2_STEP(cc, sl, NW) do { asm volatile("s_waitcnt vmcnt(" #NW ")" ::: "memory"); \
        const LAS unsigned char* sp_ = ring + (sl) * 12288 + lane * 16; bf16x8 gx[4][2]; f32x4 hx[4]; \
        _Pragma("unroll") for (int m = 0; m < 4; ++m) { hx[m] = *(const LAS f32x4*)(sp_ + 8192 + m * 1024); _Pragma("unroll") for (int s = 0; s < 2; ++s) gx[m][s] = *(const LAS bf16x8*)(sp_ + (m * 2 + s) * 1024); } \
        v4u bs[2]; \
        _Pragma("unroll") for (int s = 0; s < 2; ++s) { bs[s].x = cvt_pk_bf16(P[2 * s][0], P[2 * s][1]); bs[s].y = cvt_pk_bf16(P[2 * s][2], P[2 * s][3]); bs[s].z = cvt_pk_bf16(P[2 * s + 1][0], P[2 * s + 1][1]); bs[s].w = cvt_pk_bf16(P[2 * s + 1][2], P[2 * s + 1][3]); } \
        *(v2u*)(PT + (size_t)(cc) * 4096) = (v2u){bs[0].x, bs[0].y}; *(v2u*)(PT + (size_t)(cc) * 4096 + 16) = (v2u){bs[0].z, bs[0].w}; \
        *(v2u*)(PT + (size_t)(cc) * 4096 + 32) = (v2u){bs[1].x, bs[1].y}; *(v2u*)(PT + (size_t)(cc) * 4096 + 48) = (v2u){bs[1].z, bs[1].w}; \
        _Pragma("unroll") for (int m = 0; m < 4; ++m) { f32x4 acc = hx[m]; acc = __builtin_amdgcn_mfma_f32_16x16x32_bf16(gx[m][0], __builtin_bit_cast(bf16x8, bs[0]), acc, 0, 0, 0); \
            acc = __builtin_amdgcn_mfma_f32_16x16x32_bf16(gx[m][1], __builtin_bit_cast(bf16x8, bs[1]), acc, 0, 0, 0); P[m] = acc; } \
        asm volatile("s_waitcnt lgkmcnt(0)" ::: "memory"); } while (0)
    RW2_ISSUE(0, 0); RW2_ISSUE(1, 1); RW2_ISSUE(2, 2);
    RW2_ISSUE(3, 3); RW2_STEP(0, 0, 36); RW2_ISSUE(4, 0); RW2_STEP(1, 1, 40); RW2_ISSUE(5, 1); RW2_STEP(2, 2, 44); RW2_ISSUE(6, 2); RW2_STEP(3, 3, 48);
#pragma unroll 1
    for (int c = 4; c < 60; c += 4) {
        RW2_ISSUE(c + 3, 3); RW2_STEP(c, 0, 48); RW2_ISSUE(c + 4, 0); RW2_STEP(c + 1, 1, 48); RW2_ISSUE(c + 5, 1); RW2_STEP(c + 2, 2, 48); RW2_ISSUE(c + 6, 2); RW2_STEP(c + 3, 3, 48);
    }
    RW2_ISSUE(63, 3); RW2_STEP(60, 0, 48); RW2_STEP(61, 1, 36); RW2_STEP(62, 2, 24); RW2_STEP(63, 3, 12);
#undef RW2_ISSUE
#undef RW2_STEP
}
#else
__device__ __forceinline__ void rwkv_scan_wave(Frame& F, const Args& A, int wslot) {
    const int lane = F.lane, fr = lane & 15, fq = lane >> 4, bh = wslot >> 2, v0 = (wslot & 3) * 16;
    const bf16* GF = WSP(bf16, WS_RW_GF) + (size_t)bh * NCH * 4096; const float* HT = WSP(float, WS_RW_HT) + (size_t)bh * NCH * 4096 + (size_t)(v0 + fr) * 64 + 4 * fq;
    bf16* PT = WSP(bf16, WS_RW_PT) + (size_t)bh * NCH * 4096 + (size_t)(v0 + fr) * 64 + 4 * fq;
    f32x4 P[4] = {{0.f, 0.f, 0.f, 0.f}, {0.f, 0.f, 0.f, 0.f}, {0.f, 0.f, 0.f, 0.f}, {0.f, 0.f, 0.f, 0.f}};
    bf16x8 g0[4][2], g1[4][2], g2[4][2]; f32x4 h0[4], h1[4], h2[4];
#define RW2_LOAD(gx, hx, cc) do { _Pragma("unroll") for (int m = 0; m < 4; ++m) { hx[m] = *(const f32x4*)(HT + (size_t)(cc) * 4096 + 16 * m); \
        _Pragma("unroll") for (int s = 0; s < 2; ++s) gx[m][s] = *(const bf16x8*)(GF + (size_t)(cc) * 4096 + ((m * 2 + s) * 64 + lane) * 8); } } while (0)
#define RW2_STEP(gx, hx, cc) do { v4u bs[2]; \
        _Pragma("unroll") for (int s = 0; s < 2; ++s) { bs[s].x = cvt_pk_bf16(P[2 * s][0], P[2 * s][1]); bs[s].y = cvt_pk_bf16(P[2 * s][2], P[2 * s][3]); bs[s].z = cvt_pk_bf16(P[2 * s + 1][0], P[2 * s + 1][1]); bs[s].w = cvt_pk_bf16(P[2 * s + 1][2], P[2 * s + 1][3]); } \
        *(v2u*)(PT + (size_t)(cc) * 4096) = (v2u){bs[0].x, bs[0].y}; *(v2u*)(PT + (size_t)(cc) * 4096 + 16) = (v2u){bs[0].z, bs[0].w}; \
        *(v2u*)(PT + (size_t)(cc) * 4096 + 32) = (v2u){bs[1].x, bs[1].y}; *(v2u*)(PT + (size_t)(cc) * 4096 + 48) = (v2u){bs[1].z, bs[1].w}; \
        _Pragma("unroll") for (int m = 0; m < 4; ++m) { f32x4 acc = hx[m]; acc = __builtin_amdgcn_mfma_f32_16x16x32_bf16(gx[m][0], __builtin_bit_cast(bf16x8, bs[0]), acc, 0, 0, 0); \
            acc = __builtin_amdgcn_mfma_f32_16x16x32_bf16(gx[m][1], __builtin_bit_cast(bf16x8, bs[1]), acc, 0, 0, 0); P[m] = acc; } } while (0)
    RW2_LOAD(g0, h0, 0); RW2_LOAD(g1, h1, 1);
#pragma unroll 1
    for (int c = 0; c < 63; c += 3) {
        RW2_LOAD(g2, h2, c + 2); RW2_STEP(g0, h0, c);
        RW2_LOAD(g0, h0, c + 3); RW2_STEP(g1, h1, c + 1);
        if (c + 4 < NCH) RW2_LOAD(g1, h1, c + 4);
        RW2_STEP(g2, h2, c + 2);
    }
    RW2_STEP(g0, h0, 63);
#undef RW2_LOAD
#undef RW2_STEP
}
#endif
__device__ __forceinline__ void rwkv_stage3(Frame& F, const Args& A, int layer, int ub) {
    const int t0 = ub * 64, b_ = ub >> 6, c = ub & 63, lane = F.lane, wave = F.wave, fr = lane & 15, fq = lane >> 4, hh = wave >> 1;
    const size_t un = (size_t)(b_ * 4 + hh) * NCH + c;
    const bf16* RH = WSP(bf16, WS_RW_RH) + un * 4096; const bf16* PT = WSP(bf16, WS_RW_PT) + un * 4096; const bf16* O0 = WSP(bf16, WS_RW_O0) + un * 4096;
    const bf16* RW = WSP(bf16, WS_RW); const bf16* RG = WSP(bf16, WS_RW_G); bf16* mix = WSP(bf16, WS_MIX);
    const float* lg = KIN(I_RLNG) + layer * 256 + hh * 64; const float* lb = KIN(I_RLNB) + layer * 256 + hh * 64; const float* rk = KIN(I_RRK) + layer * 256 + hh * 64;
    bf16x8 pfr[4][2];
#pragma unroll
    for (int vt = 0; vt < 4; ++vt)
#pragma unroll
        for (int ks = 0; ks < 2; ++ks) pfr[vt][ks] = *(const bf16x8*)(PT + (size_t)(vt * 16 + fr) * 64 + ks * 32 + fq * 8);
#pragma unroll 1
    for (int i = 0; i < 2; ++i) { const int tt = 2 * (wave & 1) + i, tl = tt * 16 + fr, t = t0 + tl;
        const bf16x8 ra0 = *(const bf16x8*)(RH + (size_t)tl * 64 + fq * 8), ra1 = *(const bf16x8*)(RH + (size_t)tl * 64 + 32 + fq * 8);
        f32x4 ov[4]; float sm = 0.f;
#pragma unroll
        for (int vt = 0; vt < 4; ++vt) { f32x4 acc = ldb4(O0 + tl * 64 + vt * 16 + 4 * fq);
            acc = __builtin_amdgcn_mfma_f32_16x16x32_bf16(pfr[vt][0], ra0, acc, 0, 0, 0); acc = __builtin_amdgcn_mfma_f32_16x16x32_bf16(pfr[vt][1], ra1, acc, 0, 0, 0);
            ov[vt] = acc; DBG_STAT(24, acc[0]); DBG_STAT(24, acc[1]); DBG_STAT(24, acc[2]); DBG_STAT(24, acc[3]); sm += (acc.x + acc.y) + (acc.z + acc.w); }
        sm += __shfl_xor(sm, 16); sm += __shfl_xor(sm, 32);
        const float mean = sm * (1.f / 64.f); float sq = 0.f;
#pragma unroll
        for (int vt = 0; vt < 4; ++vt) { ov[vt] = ov[vt] - mean; sq += (ov[vt].x * ov[vt].x + ov[vt].y * ov[vt].y) + (ov[vt].z * ov[vt].z + ov[vt].w * ov[vt].w); }
        sq += __shfl_xor(sq, 16); sq += __shfl_xor(sq, 32);
        const float rs = __builtin_amdgcn_rsqf(sq * (1.f / 64.f) + RWKV_GN_EPS);
        float bd = 0.f;
#pragma unroll
        for (int q = 0; q < 4; ++q) { const f32x4 r4 = ldb4(RW + (size_t)t * 768 + hh * 64 + fq * 16 + 4 * q), k4 = ldb4(RW + (size_t)t * 768 + 256 + hh * 64 + fq * 16 + 4 * q), c4 = *(const f32x4*)(rk + fq * 16 + 4 * q);
            bd += (r4.x * k4.x * c4.x + r4.y * k4.y * c4.y) + (r4.z * k4.z * c4.z + r4.w * k4.w * c4.w); }
        bd += __shfl_xor(bd, 16); bd += __shfl_xor(bd, 32);
#pragma unroll
        for (int vt = 0; vt < 4; ++vt) { const int col = vt * 16 + 4 * fq; const f32x4 g4 = *(const f32x4*)(lg + col), b4 = *(const f32x4*)(lb + col);
            const f32x4 v4 = ldb4(RW + (size_t)t * 768 + 512 + hh * 64 + col), gg = ldb4(RG + (size_t)t * 256 + hh * 64 + col);
            float e0 = (ov[vt].x * rs * g4.x + b4.x + bd * v4.x) * gg.x, e1 = (ov[vt].y * rs * g4.y + b4.y + bd * v4.y) * gg.y, e2 = (ov[vt].z * rs * g4.z + b4.z + bd * v4.z) * gg.z, e3 = (ov[vt].w * rs * g4.w + b4.w + bd * v4.w) * gg.w;
#ifdef RW_SANITIZE
            e0 = (fabsf(e0) < 1e30f) ? e0 : 0.f; e1 = (fabsf(e1) < 1e30f) ? e1 : 0.f; e2 = (fabsf(e2) < 1e30f) ? e2 : 0.f; e3 = (fabsf(e3) < 1e30f) ? e3 : 0.f;
#endif
            MIX_ST4(mix, (size_t)t * D + 256 + hh * 64 + col, e0, e1, e2, e3); } }
}

constexpr int SCAN_N_MAIN = 16 * 64 * 128 / 2 + 16 * 32 * 64 / 2 + 16 * 64 * 64 / 2, SCAN_N_ALL = SCAN_N_MAIN + 16 * 64 / 2;
__device__ __forceinline__ void scans_elementwise(Frame& F, const Args& A, int gt, int nthr, int lo, int hi) {
    constexpr int N_SSD = 16 * 64 * 128 / 2, N_GLA = 16 * 32 * 64 / 2, N_MLC = 16 * 64 * 64 / 2, N_MLN = 16 * 64 / 2;
    for (int i = lo + gt; i < hi; i += nthr) {
        if (i < N_SSD) { const int bh = i >> 12, pn = (i & 4095) * 2; unsigned* base = (unsigned*)(WSP(bf16, WS_SSD_ST) + (size_t)bh * NCH * 8192 + pn); const float* dec = WSP(float, WS_SSD_DEC) + bh * NCH; float S0 = 0.f, S1 = 0.f;
#pragma unroll 1
            for (int c0 = 0; c0 < NCH; c0 += 32) { unsigned x[32]; float dd[32];
#pragma unroll
                for (int j = 0; j < 32; ++j) { x[j] = base[(size_t)(c0 + j) * 4096]; dd[j] = dec[c0 + j]; }
#pragma unroll
                for (int j = 0; j < 32; ++j) { base[(size_t)(c0 + j) * 4096] = cvt_pk_bf16(S0, S1); S0 = dd[j] * S0 + __uint_as_float(x[j] << 16); S1 = dd[j] * S1 + __uint_as_float(x[j] & 0xffff0000u); } }
        } else if (i < N_SSD + N_GLA) { const int k = i - N_SSD, bh = k >> 10, dv = (k & 1023) * 2, dd_ = dv >> 6, b = bh >> 2, hh = bh & 3; unsigned* base = (unsigned*)(WSP(bf16, WS_GLA_ST) + (size_t)bh * NCH * 2048 + dv); const float* dec = WSP(float, WS_GLA_DEC) + (size_t)b * NCH * 128 + hh * 32 + dd_; float S0 = 0.f, S1 = 0.f;
#pragma unroll 1
            for (int c0 = 0; c0 < NCH; c0 += 32) { unsigned x[32]; float dd[32];
#pragma unroll
                for (int j = 0; j < 32; ++j) { x[j] = base[(size_t)(c0 + j) * 1024]; dd[j] = dec[(c0 + j) * 128]; }
#pragma unroll
                for (int j = 0; j < 32; ++j) { base[(size_t)(c0 + j) * 1024] = cvt_pk_bf16(S0, S1); S0 = dd[j] * S0 + __uint_as_float(x[j] << 16); S1 = dd[j] * S1 + __uint_as_float(x[j] & 0xffff0000u); } }
        } else { const int k = i - N_SSD - N_GLA; const bool isn = k >= N_MLC; const int kk = isn ? k - N_MLC : k; const int bh = isn ? (kk >> 5) : (kk >> 11), e = (isn ? (kk & 31) : (kk & 2047)) * 2, str = isn ? 32 : 2048;
            unsigned* base = (unsigned*)((isn ? WSP(bf16, WS_ML_N) : WSP(bf16, WS_ML_C)) + (size_t)bh * NCH * str * 2 + e); const float* bl = WSP(float, WS_ML_BL) + bh * NCH; const float* ml = WSP(float, WS_ML_ML) + bh * NCH; float* mo = WSP(float, WS_ML_M) + bh * NCH;
            float S0 = 0.f, S1 = 0.f, m = 0.f;
#pragma unroll 1
            for (int c0 = 0; c0 < NCH; c0 += 32) { unsigned x[32]; float b8[32], m8[32];
#pragma unroll
                for (int j = 0; j < 32; ++j) { x[j] = base[(size_t)(c0 + j) * str]; b8[j] = bl[c0 + j]; m8[j] = ml[c0 + j]; }
#pragma unroll
                for (int j = 0; j < 32; ++j) { const float mn = fmaxf(b8[j] + m, m8[j]); const float so = __expf(b8[j] + m - mn), sn = __expf(m8[j] - mn);
                    base[(size_t)(c0 + j) * str] = cvt_pk_bf16(S0, S1); if (!isn && e == 0) mo[c0 + j] = m; S0 = so * S0 + sn * __uint_as_float(x[j] << 16); S1 = so * S1 + sn * __uint_as_float(x[j] & 0xffff0000u); m = mn; } }
        }
    }
}
#ifndef MK_PER_PHASE_LAUNCH
#define MK_PER_PHASE_LAUNCH 0
#endif
#ifndef PH_MASK
#define PH_MASK 0xFFF
#endif
#ifndef ST_MASK
#define ST_MASK 0xF
#endif
#define ST_ON(k) (((ST_MASK) >> (k)) & 1)
#ifndef DUP_MASK
#define DUP_MASK 0
#endif
#define DUP_N(k) ((((DUP_MASK) >> (k)) & 1) ? 2 : 1)
#ifndef ST_DUP
#define ST_DUP 0
#endif
#define ST_REP(ty) ((((ST_DUP) >> (ty)) & 1) ? 2 : 1)
#define PH_ON(k) (((PH_MASK) >> (k)) & 1)
constexpr int PH_PER_LAYER = 11, N_PHASES = 1 + DEPTH * PH_PER_LAYER;
__global__ void __launch_bounds__(NWAVES * 64, 2) fwd_kernel(Args args) {
    extern __shared__ __attribute__((aligned(16))) unsigned char lds[];
    Frame F;
    F.lds = (LAS unsigned char*)lds;
    F.MISC = (volatile LAS unsigned*)(F.lds + MISC_OFF);
    F.tid = threadIdx.x; F.lane = F.tid & 63; F.wave = __builtin_amdgcn_readfirstlane(F.tid >> 6);
    F.G = gridDim.x; { const int bx = blockIdx.x; F.vcu = (F.G % 8 == 0) ? (bx % 8) * (F.G / 8) + bx / 8 : bx; }
    F.ka = (karg_t)__builtin_amdgcn_kernarg_segment_ptr(); F.ws = args.ws; F.ctl = (gu32*)(args.ws + WS_CTL); F.out = args.out;
    for (int i = F.tid; i < 256; i += NWAVES * 64) F.MISC[i] = 0u;
    __syncthreads();
    const int lo = args.ph_lo, hi = args.ph_hi;
#ifdef DBG_TSEL
    if (blockIdx.x == 0 && threadIdx.x == 0) __hip_atomic_store(F.ctl + CW_DBG + 15, (unsigned)__builtin_amdgcn_s_memrealtime(), RLX_AGENT);
#endif
    XcdBarrier bar; bar.bar = (unsigned*)(F.ctl + CW_BAR); bar.x = 0; bar.st = nullptr;
    if (hi - lo > 1) bar = xcd_barrier_post((unsigned*)(F.ctl + CW_BAR), F.MISC + MW_BAR);
#define IN_(k) (lo <= (k) && (k) < hi)
#ifdef DBG_TSEL
#ifndef DBG_TQ
#define DBG_TQ 50.0f
#endif
#define TSTAMP(k) do { if (blockIdx.x == 0 && threadIdx.x == 0) __hip_atomic_store(F.ctl + CW_DBG + 16 + ((k) == 11 ? 0 : 1 + layer_ * PH_PER_LAYER + (k)), (unsigned)__builtin_amdgcn_s_memrealtime(), RLX_AGENT); } while (0)
#else
#define TSTAMP(k) do { } while (0)
#endif
#ifdef BAR_DUP
#define SEAM(k) do { if (IN_(k) && IN_((k) + 1)) { xcd_barrier(bar); xcd_barrier(bar); } } while (0)
#else
#define SEAM(k) do { if (IN_(k) && IN_((k) + 1)) xcd_barrier(bar); } while (0)
#endif

    if (PH_ON(11) && IN_(0)) { for (int rep_ = 0; rep_ < DUP_N(11); ++rep_) { frame_refresh(F); p0_prologue(F, args); } SEAM(0); { const int layer_ = 0; TSTAMP(11); (void)layer_; } }
#pragma unroll 1
    for (int layer = 0; layer < DEPTH; ++layer) {
        const int pb = 1 + layer * PH_PER_LAYER; const int layer_ = layer; (void)layer_;
        if (PH_ON(0) && IN_(pb + 0)) { for (int rep_ = 0; rep_ < DUP_N(0); ++rep_) { frame_refresh(F);
            { pg8::DenseSched S; S.init(WSP(bf16, WS_XB), WSP(bf16, WS_WIN_T) + (size_t)layer * NUP * D, T, NUP, D, F.G, (int)blockIdx.x);
              pg8::EpiB16 E{WSP(bf16, WS_U), NUP, nullptr, 0.f};
              pg8::gemm_phase<pg8::EpiB16, pg8::DenseSched>(F.lds, F.tid, S, E); }
            if (F.G != 256 || blockIdx.x >= 128)
            { pg8::DenseSched S; if (F.G == 256) S.init(WSP(bf16, WS_PB) + (size_t)layer * T * 256, WSP(bf16, WS_WPP_T) + (size_t)layer * D * 256, T, D, 256, 128, (int)blockIdx.x - 128); else S.init(WSP(bf16, WS_PB) + (size_t)layer * T * 256, WSP(bf16, WS_WPP_T) + (size_t)layer * D * 256, T, D, 256, F.G, (int)blockIdx.x);
              pg8::EpiB16 E{WSP(bf16, WS_PE), D, nullptr, 0.f};
              pg8::gemm_phase<pg8::EpiB16, pg8::DenseSched>(F.lds, F.tid, S, E); }
            } SEAM(pb + 0); TSTAMP(0);
        }
        if (PH_ON(1) && IN_(pb + 1)) { for (int rep_ = 0; rep_ < DUP_N(1); ++rep_) { frame_refresh(F);
            for (int un = F.vcu; un < 1024; un += F.G) { frame_refresh(F); const int ty = un >> 8, r = un & 255, b = r >> 6, c = r & 63;
                if (ty == 0) { ssd_stage1(F, args, layer, b, c); if (ST_DUP & 1) ssd_stage1(F, args, layer, b, c); } else if (ty == 1) { gla_stage1(F, args, layer, b, c); if (ST_DUP & 2) gla_stage1(F, args, layer, b, c); } else if (ty == 2) { mlstm_stage1(F, args, layer, b, c); if (ST_DUP & 4) mlstm_stage1(F, args, layer, b, c); } else { rwkv_stage1(F, args, layer, r); if (ST_DUP & 8) rwkv_stage1(F, args, layer, r); } }
            } SEAM(pb + 1); TSTAMP(1);
        }
        if (PH_ON(2) && IN_(pb + 2)) { for (int rep_ = 0; rep_ < DUP_N(2); ++rep_) { frame_refresh(F);
            if (F.wave == 0) { for (int ws_ = F.vcu; ws_ < 64; ws_ += F.G) rwkv_scan_wave(F, args, ws_);
                if (rep_ == 0) { if (F.G > 64) { if (F.vcu >= 64) scans_elementwise(F, args, (F.vcu - 64) * 64 + F.lane, (F.G - 64) * 64, SCAN_N_MAIN, SCAN_N_ALL); } else scans_elementwise(F, args, F.vcu * 64 + F.lane, F.G * 64, SCAN_N_MAIN, SCAN_N_ALL); } }
            else if (rep_ == 0) scans_elementwise(F, args, F.vcu * 448 + (F.tid - 64), F.G * 448, 0, SCAN_N_MAIN);
            } SEAM(pb + 2); TSTAMP(2);
        }
        if (PH_ON(3) && IN_(pb + 3)) { for (int rep_ = 0; rep_ < DUP_N(3); ++rep_) { frame_refresh(F);
            for (int un = F.vcu; un < 1024; un += F.G) { frame_refresh(F); const int ty = un >> 8, r = un & 255, b = r >> 6, c = r & 63;
                if (ty == 0) { ssd_stage3(F, args, layer, b, c); if (ST_DUP & 16) ssd_stage3(F, args, layer, b, c); } else if (ty == 1) { gla_stage3(F, args, layer, b, c); if (ST_DUP & 32) gla_stage3(F, args, layer, b, c); } else if (ty == 2) { mlstm_stage3(F, args, layer, b, c); if (ST_DUP & 64) mlstm_stage3(F, args, layer, b, c); } else { rwkv_stage3(F, args, layer, r); if (ST_DUP & 128) rwkv_stage3(F, args, layer, r); } }
            } SEAM(pb + 3); TSTAMP(3);
        }
        if (PH_ON(4) && IN_(pb + 4)) { for (int rep_ = 0; rep_ < DUP_N(4); ++rep_) { frame_refresh(F);
            pg8::EpiB16 E{WSP(bf16, WS_Y1), D, WSP(bf16, WS_XB), DN_ALPHA};
#if OUT_FP8
            pg8::DenseSched8b S; S.init(WSP(bf16, WS_MIX), (const bf16*)(WSP(unsigned char, WS_WOUT_Q) + (size_t)layer * D * D), T, D, D / 2, F.G, (int)blockIdx.x);
            pg8::gemm_phase<pg8::EpiB16, pg8::DenseSched8b>(F.lds, F.tid, S, E);
#else
            pg8::DenseSched S; S.init(WSP(bf16, WS_MIX), WSP(bf16, WS_WOUT_T) + (size_t)layer * D * D, T, D, D, F.G, (int)blockIdx.x);
            pg8::gemm_phase<pg8::EpiB16, pg8::DenseSched>(F.lds, F.tid, S, E);
#endif
            } SEAM(pb + 4); TSTAMP(4);
        }
        if (PH_ON(5) && IN_(pb + 5)) { if (DUP_N(5) == 2) { frame_refresh(F); p6_ln1_router<true>(F, args, layer); } frame_refresh(F); p6_ln1_router<false>(F, args, layer); SEAM(pb + 5); TSTAMP(5); }
        if (PH_ON(6) && IN_(pb + 6)) { for (int rep_ = 0; rep_ < DUP_N(6); ++rep_) { frame_refresh(F);
            moe_build_pfx(F, args, layer, 8);
            pg8::Moe1Sched S; S.O.pfx = F.MISC + MW_PFX; S.O.NT = 8; S.O.G = F.G; S.O.c = (int)blockIdx.x; S.sdest = WSP(int, WS_SDEST); S.bgu = KIN(I_BGU) + (size_t)layer * NE * 2048;
            if (MOE_FP8) { S.X = WSP(unsigned char, WS_X1Q); S.W = WSP(unsigned char, WS_WGU_Q) + (size_t)layer * NE * 2048 * D; S.K = D / 2; S.hstepB = (size_t)1024 * D; }
            else { S.X = WSP(unsigned char, WS_X1B); S.W = WSP(unsigned char, WS_WGU_T) + (size_t)layer * NE * 2048 * D * 2; S.K = D; S.hstepB = (size_t)1024 * D * 2; }
            pg8::EpiMoe1 E{WSP(bf16, WS_ABUF), KIN(I_BGU) + (size_t)layer * NE * 2048, WSP(unsigned char, WS_ABUFQ)};
            pg8::gemm_phase<pg8::EpiMoe1, pg8::Moe1Sched>(F.lds, F.tid, S, E);
            } SEAM(pb + 6); TSTAMP(6);
        }
        if (PH_ON(7) && IN_(pb + 7)) { for (int rep_ = 0; rep_ < DUP_N(7); ++rep_) { frame_refresh(F);
            moe_build_pfx(F, args, layer, 4);
            pg8::Moe2Sched S; S.O.pfx = F.MISC + MW_PFX; S.O.NT = 4; S.O.G = F.G; S.O.c = (int)blockIdx.x; S.sdest = WSP(int, WS_SDEST); S.sgate = WSP(float, WS_SGATE); S.bdn = KIN(I_BDN) + (size_t)layer * NE * D; if (MOE2_FP8) { S.Ab = WSP(unsigned char, WS_ABUFQ); S.W = WSP(unsigned char, WS_WDN_Q) + (size_t)layer * NE * D * D; S.K = D / 2; S.hstepB = (size_t)128 * D; }
            else { S.Ab = WSP(unsigned char, WS_ABUF); S.W = WSP(unsigned char, WS_WDN_T) + (size_t)layer * NE * D * D * 2; S.K = D; S.hstepB = (size_t)128 * D * 2; }
            pg8::EpiMoe2 E{WSP(bf16, WS_YBUF), KIN(I_BDN) + (size_t)layer * NE * D, WSP(int, WS_SDEST), WSP(float, WS_SGATE)};
            pg8::gemm_phase<pg8::EpiMoe2, pg8::Moe2Sched>(F.lds, F.tid, S, E);
            } SEAM(pb + 7); TSTAMP(7);
        }
        if (PH_ON(8) && IN_(pb + 8)) { for (int rep_ = 0; rep_ < DUP_N(8); ++rep_) { frame_refresh(F); p9_combine(F, args); } SEAM(pb + 8); TSTAMP(8); }
        if (PH_ON(9) && IN_(pb + 9)) { for (int rep_ = 0; rep_ < DUP_N(9); ++rep_) { frame_refresh(F);
            pg8::EpiPle E{WSP(bf16, WS_H2), WSP(bf16, WS_HB), WSP(bf16, WS_PE)};
#if PLE_FP8
            pg8::DenseSched8 S; S.init((const bf16*)WSP(unsigned char, WS_HQ), (const bf16*)(WSP(unsigned char, WS_WPG_Q) + (size_t)layer * D * D), T, D, D / 2, F.G, (int)blockIdx.x);
            pg8::gemm_phase<pg8::EpiPle, pg8::DenseSched8>(F.lds, F.tid, S, E);
#else
            pg8::DenseSched S; S.init(WSP(bf16, WS_HB), WSP(bf16, WS_WPG_T) + (size_t)layer * D * D, T, D, D, F.G, (int)blockIdx.x);
            pg8::gemm_phase<pg8::EpiPle, pg8::DenseSched>(F.lds, F.tid, S, E);
#endif
            } SEAM(pb + 9); TSTAMP(9);
        }
        if (PH_ON(10) && IN_(pb + 10)) { for (int rep_ = 0; rep_ < DUP_N(10); ++rep_) { frame_refresh(F); p11_ln2(F, args, layer); } SEAM(pb + 10); TSTAMP(10); }
    }
#ifdef DBG_TSEL
    if (hi - lo > 1) { xcd_barrier(bar);
        unsigned ticks = 0u;
        if (DBG_TSEL == 11) ticks = __hip_atomic_load(F.ctl + CW_DBG + 16, RLX_AGENT) - __hip_atomic_load(F.ctl + CW_DBG + 15, RLX_AGENT);
        else for (int l = 0; l < DEPTH; ++l) { const int pi = 1 + l * PH_PER_LAYER + DBG_TSEL; ticks += __hip_atomic_load(F.ctl + CW_DBG + 16 + pi, RLX_AGENT) - __hip_atomic_load(F.ctl + CW_DBG + 16 + pi - 1, RLX_AGENT); }
        const float us = floorf((float)ticks * 0.01f / DBG_TQ) * DBG_TQ; const float code = sqrtf(us * 0.05f);
        for (size_t i = (size_t)blockIdx.x * 512 + threadIdx.x; i < (size_t)T * D; i += (size_t)gridDim.x * 512) F.out[i] = code; }
#endif
#ifdef DBG_SEL
    if (hi - lo > 1) { xcd_barrier(bar);
        const unsigned mx = __hip_atomic_load(F.ctl + CW_DBG, RLX_AGENT), nf = __hip_atomic_load(F.ctl + CW_DBG + 1, RLX_AGENT);
        float code;
        { const float m = __uint_as_float(mx); int b = (m > 0.f) ? (int)floorf(log10f(m)) + 30 : 0; b = b < 0 ? 0 : (b > 60 ? 60 : b); if (nf) b += 100; code = sqrtf(10.0f * (float)(b + 1)); }
        for (size_t i = (size_t)blockIdx.x * 512 + threadIdx.x; i < (size_t)T * D; i += (size_t)gridDim.x * 512) F.out[i] = code; }
#endif
#undef IN_
#undef SEAM
}

extern "C" void kernel_launch(void* const* d_in, const int* in_sizes, int n_in, void* d_out, int out_size, void* d_ws, size_t ws_size, hipStream_t stream) {
    static int grid = 0;
    if (grid == 0) {
        if (n_in != N_IN || out_size != T * D || ws_size < WS_END) { fprintf(stderr, "kernel_launch: unexpected shapes (n_in %d, out %d, ws %zu < %zu); nothing launched\n", n_in, out_size, ws_size, (size_t)WS_END); grid = -1; return; }
        int dev = 0, cus = 0, per_cu = 0;
        if (hipGetDevice(&dev) != hipSuccess || hipDeviceGetAttribute(&cus, hipDeviceAttributeMultiprocessorCount, dev) != hipSuccess) { grid = -1; return; }
        if (hipFuncSetAttribute((const void*)fwd_kernel, hipFuncAttributeMaxDynamicSharedMemorySize, LDS_BYTES) != hipSuccess) { fprintf(stderr, "kernel_launch: hipFuncSetAttribute failed\n"); grid = -1; return; }
        if (hipOccupancyMaxActiveBlocksPerMultiprocessor(&per_cu, (const void*)fwd_kernel, NWAVES * 64, LDS_BYTES) != hipSuccess || per_cu < 1) { fprintf(stderr, "kernel_launch: occupancy query says %d blocks per CU\n", per_cu); }
        (void)hipGetLastError();
        grid = cus;
    }
    if (grid < 0) return;
    (void)hipMemsetAsync((char*)d_ws + WS_CTL, 0, CTL_ZERO_BYTES, stream);
    Args a{};
    for (int i = 0; i < N_IN; ++i) a.in[i] = (const float*)d_in[i];
    a.out = (float*)d_out; a.ws = (unsigned char*)d_ws;
#if MK_PER_PHASE_LAUNCH
    for (int ph = 0; ph < N_PHASES; ++ph) { a.ph_lo = ph; a.ph_hi = ph + 1; hipLaunchKernelGGL(fwd_kernel, dim3(grid), dim3(NWAVES * 64), LDS_BYTES, stream, a); }
#else
    a.ph_lo = 0; a.ph_hi = N_PHASES; hipLaunchKernelGGL(fwd_kernel, dim3(grid), dim3(NWAVES * 64), LDS_BYTES, stream, a);
#endif
    const hipError_t le = hipPeekAtLastError();
    if (le != hipSuccess) fprintf(stderr, "kernel_launch: launch failed: %s\n", hipGetErrorName(le));
}
```

```cpp
#include <hip/hip_runtime.h>
#include <cstdio>
#include <cstdint>

#define GAS __attribute__((address_space(1)))
#define LAS __attribute__((address_space(3)))
typedef unsigned short bf16;
typedef unsigned v4u __attribute__((ext_vector_type(4)));
typedef unsigned v2u __attribute__((ext_vector_type(2)));
typedef float f32x4 __attribute__((ext_vector_type(4)));
typedef float f32x2 __attribute__((ext_vector_type(2)));
typedef short bf16x8 __attribute__((ext_vector_type(8)));
typedef int v4i_t __attribute__((ext_vector_type(4)));
typedef int v8i_t __attribute__((ext_vector_type(8)));
typedef GAS unsigned gu32;
#define RLX_AGENT __ATOMIC_RELAXED, __HIP_MEMORY_SCOPE_AGENT
#define LDS_WAIT() asm volatile("s_waitcnt lgkmcnt(0)" ::: "memory")
#define VM_WAIT() asm volatile("s_waitcnt vmcnt(0)" ::: "memory")

constexpr int NWAVES = 8;
constexpr int DEPTH = 4, BATCH = 4, SEQ = 4096, D = 1024, T = BATCH * SEQ;
constexpr int NU = 3484, NUP = 3584;
constexpr int NE = 32, TOPK = 4, ECAP = 16384;
constexpr int NCH = SEQ / 64;
constexpr int U_SSD_Z = 0, U_SSD_X = 256, U_SSD_B = 512, U_SSD_C = 640, U_SSD_DT = 768;
constexpr int U_RW = 772, U_RW_R = 772, U_RW_K = 1028, U_RW_V = 1284, U_RW_LO = 1540;
constexpr int U_GL_Q = 1668, U_GL_K = 1796, U_GL_V = 1924, U_GL_G = 2180, U_GL_OG = 2196;
constexpr int U_ML_Q = 2452, U_ML_K = 2708, U_ML_V = 2964, U_ML_I = 3220, U_ML_F = 3224, U_ML_O = 3228;
constexpr float DN_ALPHA = 1.6817928305074290f;
constexpr float LN_EPS = 1e-5f, NORM_EPS = 1e-5f, RWKV_GN_EPS = 64e-5f;

enum { I_X = 0, I_P, I_WIN, I_WOUT, I_LN1G, I_LN1B, I_SCW, I_SCB, I_SALOG, I_SDTB, I_SD, I_SNG,
       I_RMU, I_RW0, I_RWUP, I_RA0, I_RAUP, I_RGUP, I_RKK, I_RKA, I_RRK, I_RLNG, I_RLNB,
       I_GGUP, I_GGB, I_GNG, I_MCW, I_MCB, I_MIB, I_MFB, I_MNG,
       I_RTW, I_RTB, I_WGU, I_BGU, I_WDN, I_BDN, I_PGW, I_PPJ, I_LN2G, I_LN2B, N_IN };

constexpr size_t MiB = 1u << 20;
constexpr size_t WS_CTL = 0, CTL_ZERO_BYTES = 1 * MiB;
constexpr size_t WS_WIN_T = 2 * MiB;
constexpr size_t WS_WOUT_T = WS_WIN_T + (size_t)DEPTH * NUP * D * 2;
constexpr size_t WS_WGU_T = WS_WOUT_T + (size_t)DEPTH * D * D * 2;
constexpr size_t WS_WDN_T = WS_WGU_T + (size_t)DEPTH * NE * 2048 * D * 2;
constexpr size_t WS_WPG_T = WS_WDN_T + (size_t)DEPTH * NE * D * D * 2;
constexpr size_t WS_WPP_T = WS_WPG_T + (size_t)DEPTH * D * D * 2;
constexpr size_t WS_RWT = WS_WPP_T + (size_t)DEPTH * D * 256 * 2;
constexpr size_t WS_PB = WS_RWT + (size_t)DEPTH * NE * D * 4;
constexpr size_t WS_XB = WS_PB + (size_t)DEPTH * T * 256 * 2;
constexpr size_t WS_U = WS_XB + (size_t)T * D * 2;
constexpr size_t WS_PE = WS_U + (size_t)T * NUP * 2;
constexpr size_t WS_MIX = WS_PE + (size_t)T * D * 4;
constexpr size_t WS_Y1 = WS_MIX + (size_t)T * D * 2;
constexpr size_t WS_X1 = WS_Y1 + (size_t)T * D * 4;
constexpr size_t WS_X1B = WS_X1 + (size_t)T * D * 4;
constexpr size_t WS_SDEST = WS_X1B + (size_t)T * D * 2;
constexpr size_t WS_SGATE = WS_SDEST + (size_t)NE * ECAP * 4;
constexpr size_t WS_ABUF = WS_SGATE + (size_t)NE * ECAP * 4;
constexpr size_t WS_YBUF = WS_ABUF + (size_t)NE * ECAP * D * 2;
constexpr size_t WS_H = WS_YBUF + (size_t)T * 4 * D * 2;
constexpr size_t WS_HB = WS_H + (size_t)T * D * 4;
constexpr size_t WS_H2 = WS_HB + (size_t)T * D * 2;
constexpr size_t WS_SSD_ST = WS_H2 + (size_t)T * D * 4;
constexpr size_t WS_SSD_DEC = WS_SSD_ST + (size_t)16 * NCH * 64 * 128 * 4;
constexpr size_t WS_GLA_ST = WS_SSD_DEC + 16 * NCH * 4;
constexpr size_t WS_GLA_DEC = WS_GLA_ST + (size_t)16 * NCH * 32 * 64 * 4;
constexpr size_t WS_ML_C = WS_GLA_DEC + (size_t)4 * NCH * 128 * 4;
constexpr size_t WS_ML_N = WS_ML_C + (size_t)16 * NCH * 64 * 64 * 4;
constexpr size_t WS_ML_BL = WS_ML_N + (size_t)16 * NCH * 64 * 4;
constexpr size_t WS_ML_ML = WS_ML_BL + 16 * NCH * 4;
constexpr size_t WS_ML_M = WS_ML_ML + 16 * NCH * 4;
constexpr size_t WS_RW = WS_ML_M + 16 * NCH * 4;
constexpr size_t WS_RW_G = WS_RW + (size_t)T * 3 * 256 * 4;
constexpr size_t WS_RW_RH = WS_RW_G + (size_t)T * 256 * 4;
constexpr size_t WS_RW_O0 = WS_RW_RH + (size_t)1024 * 4096 * 2;
constexpr size_t WS_RW_GF = WS_RW_O0 + (size_t)1024 * 4096 * 4;
constexpr size_t WS_RW_HT = WS_RW_GF + (size_t)1024 * 4096 * 2;
constexpr size_t WS_RW_PT = WS_RW_HT + (size_t)1024 * 4096 * 4;
constexpr size_t WS_LORA = WS_RW_PT + (size_t)1024 * 4096 * 2;
constexpr int LORA_PER_LAYER = 8192 + 8192 + 16384 + 2048;
constexpr size_t WS_WGU_Q = WS_LORA + (size_t)DEPTH * LORA_PER_LAYER * 4;
constexpr size_t WS_WDN_Q = WS_WGU_Q + (size_t)DEPTH * NE * 2048 * D;
constexpr size_t WS_X1Q = WS_WDN_Q + (size_t)DEPTH * NE * D * D;
constexpr size_t WS_ABUFQ = WS_X1Q + (size_t)T * D;
constexpr size_t WS_WPG_Q = WS_ABUFQ + (size_t)NE * ECAP * D;
constexpr size_t WS_HQ = WS_WPG_Q + (size_t)DEPTH * D * D;
constexpr size_t WS_WOUT_Q = WS_HQ + (size_t)T * D;
constexpr size_t WS_END = WS_WOUT_Q + (size_t)DEPTH * D * D;
#ifndef MOE_FP8
#define MOE_FP8 1
#endif
#ifndef MOE2_FP8
#define MOE2_FP8 1
#ifndef MOE_CHAIN
#define MOE_CHAIN 1
#endif
#ifndef RW_SOLVE_BLK
#define RW_SOLVE_BLK 1
#endif
#ifndef RW_SCAN_DMA
#define RW_SCAN_DMA 1
#endif
#ifndef P6_MFMA
#define P6_MFMA 1
#endif
#ifndef OUT_FP8
#define OUT_FP8 1
#endif
#ifndef PLE_FP8
#define PLE_FP8 1
#endif
#endif
constexpr int CW_BAR = 4096;
constexpr int CW_DBG = 32768;
constexpr int CW_PAN = 65536;
constexpr int CW_CNT = 16384;

constexpr int RING_BYTES = 147456;
constexpr int MISC_OFF = RING_BYTES;
constexpr int LDS_BYTES = RING_BYTES + 1024;
constexpr int MW_BAR = 8, MW_LCNT = 32, MW_LBASE = 64, MW_PFX = 96, MW_CNT = 136, MW_GAMC = 168;

typedef __bf16 bf16x2_t __attribute__((ext_vector_type(2)));
__device__ __forceinline__ unsigned cvt_pk_bf16(float lo, float hi) { const f32x2 v = {lo, hi}; const bf16x2_t b = __builtin_convertvector(v, bf16x2_t); return __builtin_bit_cast(unsigned, b); }
__device__ __forceinline__ unsigned cvt4_fp8(float a, float b, float c, float d) { int w = 0; w = __builtin_amdgcn_cvt_pk_fp8_f32(a, b, w, false); w = __builtin_amdgcn_cvt_pk_fp8_f32(c, d, w, true); return (unsigned)w; }
__device__ __forceinline__ float bf2f(unsigned short b) { return __uint_as_float(((unsigned)b) << 16); }
__device__ __forceinline__ float sigmoidf_(float x) { return __builtin_amdgcn_rcpf(1.0f + __expf(-x)); }
__device__ __forceinline__ float siluf_(float x) { return x * __builtin_amdgcn_rcpf(1.0f + __expf(-x)); }
__device__ __forceinline__ float softplusf_(float x) { return fmaxf(x, 0.f) + __logf(1.0f + __expf(-fabsf(x))); }
__device__ __forceinline__ float logsigmoidf_(float x) { return fminf(x, 0.f) - __logf(1.0f + __expf(-fabsf(x))); }
__device__ __forceinline__ float tanhf_(float x) { const float e = __expf(-2.0f * fabsf(x)); const float t = (1.0f - e) * __builtin_amdgcn_rcpf(1.0f + e); return x < 0.f ? -t : t; }
__device__ __forceinline__ int lane_now() { int l = (int)__builtin_amdgcn_mbcnt_hi(~0u, __builtin_amdgcn_mbcnt_lo(~0u, 0u)); asm volatile("" : "+v"(l)); return l; }
__device__ __forceinline__ float my_shfl_idx(float v, int src) { return __builtin_bit_cast(float, __builtin_amdgcn_ds_bpermute(src << 2, __builtin_bit_cast(int, v))); }
__device__ __forceinline__ int my_shfl_idx(int v, int src) { return __builtin_amdgcn_ds_bpermute(src << 2, v); }
template <class V> __device__ __forceinline__ V my_shfl_xor(V v, int o) { return my_shfl_idx(v, lane_now() ^ o); }
template <class V> __device__ __forceinline__ V my_shfl_up(V v, int o) { const int l = lane_now(); return my_shfl_idx(v, l >= o ? l - o : l); }
#define __shfl_xor(v, o) my_shfl_xor(v, o)
#define __shfl_up(v, o) my_shfl_up(v, o)
#define __shfl(v, s) my_shfl_idx(v, s)
__device__ __forceinline__ float wave_sum(float v) {
#pragma unroll
    for (int o = 1; o < 64; o <<= 1) v += __shfl_xor(v, o);
    return v;
}
__device__ __forceinline__ float wave_max(float v) {
#pragma unroll
    for (int o = 1; o < 64; o <<= 1) v = fmaxf(v, __shfl_xor(v, o));
    return v;
}
__device__ __forceinline__ float wave_scan_add(float v, int lane) {
#pragma unroll
    for (int o = 1; o < 64; o <<= 1) { const float t = __shfl_up(v, o); if (lane >= o) v += t; }
    return v;
}
__device__ __forceinline__ float wave_scan_max(float v, int lane) {
#pragma unroll
    for (int o = 1; o < 64; o <<= 1) { const float t = __shfl_up(v, o); if (lane >= o) v = fmaxf(v, t); }
    return v;
}
__device__ __forceinline__ f32x4 mm16(const LAS unsigned char* A, int lda, const LAS unsigned char* B, int ldb, int K, f32x4 acc, int fr, int fq) {
    const LAS unsigned char* ap = A + fr * lda + fq * 16; const LAS unsigned char* bp = B + fr * ldb + fq * 16;
    for (int k = 0; k < K; k += 32) {
        const bf16x8 a = *(const LAS bf16x8*)(ap + k * 2); const bf16x8 b = *(const LAS bf16x8*)(bp + k * 2);
        acc = __builtin_amdgcn_mfma_f32_16x16x32_bf16(b, a, acc, 0, 0, 0);
    }
    return acc;
}
__device__ __forceinline__ f32x4 mm16_gB(const LAS unsigned char* A, int lda, const float* B, int ldb, int K, f32x4 acc, int fr, int fq) {
    const LAS unsigned char* ap = A + fr * lda + fq * 16; const float* bp = B + (size_t)fr * ldb + fq * 8;
    for (int k = 0; k < K; k += 32) {
        const bf16x8 a = *(const LAS bf16x8*)(ap + k * 2);
        const f32x4 b0 = *(const f32x4*)(bp + k), b1 = *(const f32x4*)(bp + k + 4);
        v4u bw; bw.x = cvt_pk_bf16(b0.x, b0.y); bw.y = cvt_pk_bf16(b0.z, b0.w); bw.z = cvt_pk_bf16(b1.x, b1.y); bw.w = cvt_pk_bf16(b1.z, b1.w);
        const bf16x8 b = __builtin_bit_cast(bf16x8, bw);
        acc = __builtin_amdgcn_mfma_f32_16x16x32_bf16(b, a, acc, 0, 0, 0);
    }
    return acc;
}
__device__ __forceinline__ f32x4 mm16_gAB(const bf16* A, int lda, const bf16* B, int ldb, int K, f32x4 acc, int fr, int fq) {
    const bf16* ap = A + (size_t)fr * lda + fq * 8; const bf16* bp = B + (size_t)fr * ldb + fq * 8;
    for (int k = 0; k < K; k += 32) { const bf16x8 a = *(const bf16x8*)(ap + k), b = *(const bf16x8*)(bp + k); acc = __builtin_amdgcn_mfma_f32_16x16x32_bf16(b, a, acc, 0, 0, 0); }
    return acc;
}
__device__ __forceinline__ bf16x8 ldfrag_f32(const float* p) { const f32x4 b0 = *(const f32x4*)p, b1 = *(const f32x4*)(p + 4);
    v4u bw; bw.x = cvt_pk_bf16(b0.x, b0.y); bw.y = cvt_pk_bf16(b0.z, b0.w); bw.z = cvt_pk_bf16(b1.x, b1.y); bw.w = cvt_pk_bf16(b1.z, b1.w); return __builtin_bit_cast(bf16x8, bw); }
template <int NK> __device__ __forceinline__ f32x4 mm16_rB(const LAS unsigned char* A, int lda, const bf16x8 (&b)[NK], f32x4 acc, int fr, int fq) {
    const LAS unsigned char* ap = A + fr * lda + fq * 16;
#pragma unroll
    for (int k = 0; k < NK; ++k) { const bf16x8 a = *(const LAS bf16x8*)(ap + k * 64); acc = __builtin_amdgcn_mfma_f32_16x16x32_bf16(b[k], a, acc, 0, 0, 0); }
    return acc;
}
__device__ __forceinline__ v4u pack8(const float (&v)[8]) { v4u o; o.x = cvt_pk_bf16(v[0], v[1]); o.y = cvt_pk_bf16(v[2], v[3]); o.z = cvt_pk_bf16(v[4], v[5]); o.w = cvt_pk_bf16(v[6], v[7]); return o; }

#define XB_TMO      128
#define XB_XCNT(j)  (256  + 64 * (j))
#define XB_XSUB(j)  (1280 + 64 * (j))
#define XB_XGEN(j)  (2304 + 64 * (j))
#define XB_TOP      3328
#define XB_TOPGEN   3392
#define XCD_BAR_WORDS 3456
#define XB_SPIN_CAP (1u << 18)
__device__ __forceinline__ unsigned xb_ld(unsigned* p)              { return __hip_atomic_load(p, __ATOMIC_RELAXED, __HIP_MEMORY_SCOPE_AGENT); }
__device__ __forceinline__ unsigned xb_add(unsigned* p, unsigned v) { return __hip_atomic_fetch_add(p, v, __ATOMIC_RELAXED, __HIP_MEMORY_SCOPE_AGENT); }
__device__ __forceinline__ unsigned xb_xcc_id() { return (unsigned)__builtin_amdgcn_s_getreg((3 << 11) | 20) & 0xFu; }
#define XB_SPIN(cond, bar) do { unsigned _sp = 0; while (cond) { __builtin_amdgcn_s_sleep(1); \
    if ((++_sp & 255u) == 0u) { if (xb_ld(&(bar)[XB_TMO])) break; if (_sp > XB_SPIN_CAP) { atomicAdd(&(bar)[XB_TMO], 1u); break; } } } } while (0)
struct XcdBarrier { unsigned* bar; unsigned x; volatile LAS unsigned* st; };
__device__ __forceinline__ XcdBarrier xcd_barrier_post(unsigned* bar, volatile LAS unsigned* st) {
    XcdBarrier b; b.bar = bar; b.x = xb_xcc_id(); b.st = st;
    if (threadIdx.x == 0) (void)xb_add(&bar[XB_XCNT(b.x)], 1u);
    return b;
}
__device__ __forceinline__ void xcd_barrier_complete(unsigned* bar, unsigned x, unsigned& nloc, unsigned& nx) {
    const unsigned G = gridDim.x * gridDim.y * gridDim.z;
    unsigned sum, cnt, mine, sp = 0u;
    for (;;) {
        sum = 0u; cnt = 0u; mine = 0u;
#pragma unroll
        for (unsigned j = 0; j < 16; ++j) { const unsigned c = xb_ld(&bar[XB_XCNT(j)]); sum += c; cnt += (c > 0u) ? 1u : 0u; mine = (j == x) ? c : mine; }
        if (sum == G) break;
        __builtin_amdgcn_s_sleep(1);
        if ((++sp & 255u) == 0u) { if (xb_ld(&bar[XB_TMO])) break; if (sp > XB_SPIN_CAP) { atomicAdd(&bar[XB_TMO], 1u); break; } }
    }
    nloc = mine > 0u ? mine : 1u; nx = cnt > 0u ? cnt : 1u;
}
__device__ __forceinline__ void xcd_barrier(const XcdBarrier& b) {
    asm volatile("s_waitcnt vmcnt(0)" ::: "memory");
    __syncthreads();
    if (threadIdx.x == 0) {
        unsigned* bar = b.bar;
        __builtin_amdgcn_s_waitcnt(0);
        unsigned nloc = b.st[0], nx = b.st[1];
        if (nloc == 0u) { xcd_barrier_complete(bar, b.x, nloc, nx); b.st[0] = nloc; b.st[1] = nx; }
        const unsigned k = b.st[2]; b.st[2] = k + 1u;
        const unsigned old = xb_add(&bar[XB_XSUB(b.x)], 1u);
        if (old + 1u == (k + 1u) * nloc) {
            __builtin_amdgcn_fence(__ATOMIC_RELEASE, "agent");
            asm volatile("s_waitcnt vmcnt(0)" ::: "memory");
            (void)xb_add(&bar[XB_TOP], 1u);
        }
        const unsigned target = (k + 1u) * nx;
        XB_SPIN(xb_ld(&bar[XB_TOP]) < target, bar);
        __builtin_amdgcn_fence(__ATOMIC_ACQUIRE, "agent");
        asm volatile("s_waitcnt vmcnt(0)" ::: "memory");
    }
    __syncthreads();
}

namespace pg8 {
constexpr int BM = 256, BK = 64, HALF = 128, HTB = HALF * BK * 2, STAGE_BYTES = 8 * HTB, NXCD = 8, WGM = 8;
__host__ __device__ __forceinline__ int lds_byte(int r, int c) { const int st = (r >> 4) * 2 + (c >> 5), rr = r & 15, cc = c & 31, ob = rr * 64 + cc * 2; return st * 1024 + (ob ^ (((ob >> 9) & 1) << 5)); }
__host__ __device__ __forceinline__ void stage_rc(int b, int& R, int& C) { const int st = b / 1024, sb = b % 1024, swz = sb ^ (((sb >> 9) & 1) << 5); R = (st >> 1) * 16 + swz / 64; C = (st & 1) * 32 + (swz % 64) / 2; }
__host__ __device__ __forceinline__ int perm32(int rho) { const int n = rho >> 4, i = rho & 15; return 8 * (i >> 2) + 4 * n + (i & 3); }

template <class Epi, class Sched>
__device__ __forceinline__ void gemm_phase(LAS unsigned char* lds, const int tid, const Sched& S, const Epi& E) {
    const int wid = __builtin_amdgcn_readfirstlane(tid >> 6), lane = tid & 63, wr = wid >> 2, wc = wid & 3, fr = lane & 15, fq = lane >> 4;
    const int K = S.K, nt = K / BK;
    unsigned voffB[2];
#pragma unroll
    for (int i = 0; i < 2; ++i) { int R, C; stage_rc(tid * 16 + i * 8192, R, C); const int Rb = Epi::PERM ? ((R & ~31) + perm32(R & 31)) : R; voffB[i] = (unsigned)(Rb * K + C) * 2u; }
    const size_t kstep = (size_t)(BK * 2);
    const size_t hstepB = S.hstepB;
    const unsigned ldsw = (unsigned)wid * 1024u;
    constexpr bool F8 = Sched::FP8;
    const int aoff = F8 ? lds_byte(wr * 64 + fr, fq * 16) : lds_byte(wr * 64 + fr, fq * 8), boff = F8 ? lds_byte(wc * 32 + fr, fq * 16) : lds_byte(wc * 32 + fr, fq * 8);
#define PG8_SA(b, h) (((b) * 2 + (h)) * HTB)
#define PG8_SB(b, h) ((4 + (b) * 2 + (h)) * HTB)
#define PG8_STAGE_B(bufoff, gbase) do { _Pragma("unroll") for (int _i = 0; _i < 2; ++_i) \
        __builtin_amdgcn_global_load_lds((const unsigned*)((const char*)(gbase) + voffB[_i]), (LAS unsigned*)(lds + (bufoff) + ldsw + _i * 8192), 16, 0, 0); } while (0)
#define PG8_STAGE_A(bufoff, gbase, v0, v1) do { \
        __builtin_amdgcn_global_load_lds((const unsigned*)((const char*)(gbase) + (v0)), (LAS unsigned*)(lds + (bufoff) + ldsw), 16, 0, 0); \
        __builtin_amdgcn_global_load_lds((const unsigned*)((const char*)(gbase) + (v1)), (LAS unsigned*)(lds + (bufoff) + ldsw + 8192), 16, 0, 0); } while (0)
#define PG8_FOFF(k) (F8 ? (k) * 16 : (k) * 1024)
#define PG8_LDA(dst, b, h) do { _Pragma("unroll") for (int m = 0; m < 4; ++m) { if constexpr (F8) dst##8[m] = *(const LAS v8i_t*)(lds + PG8_SA(b, h) + aoff + m * 2048); \
        else { _Pragma("unroll") for (int k = 0; k < 2; ++k) dst[m][k] = *(const LAS bf16x8*)(lds + PG8_SA(b, h) + aoff + m * 2048 + k * 1024); } } } while (0)
#define PG8_LDB(dst, b, h) do { _Pragma("unroll") for (int n = 0; n < 2; ++n) { if constexpr (F8) dst##8[n] = *(const LAS v8i_t*)(lds + PG8_SB(b, h) + boff + n * 2048); \
        else { _Pragma("unroll") for (int k = 0; k < 2; ++k) dst[n][k] = *(const LAS bf16x8*)(lds + PG8_SB(b, h) + boff + n * 2048 + k * 1024); } } } while (0)
#define PG8_CAT(x) __builtin_shufflevector(__builtin_bit_cast(v4i_t, x[0]), __builtin_bit_cast(v4i_t, x[1]), 0, 1, 2, 3, 4, 5, 6, 7)
#define PG8_MMA(ai, bj, At, Bt) do { __builtin_amdgcn_s_setprio(1); _Pragma("unroll") for (int m = 0; m < 4; ++m) _Pragma("unroll") for (int n = 0; n < 2; ++n) { \
        if constexpr (F8) acc[ai][bj][m][n] = __builtin_amdgcn_mfma_scale_f32_16x16x128_f8f6f4(Bt##8[n], At##8[m], acc[ai][bj][m][n], 0, 0, 0, S.scaleB, 0, S.scaleA); \
        else { _Pragma("unroll") for (int k = 0; k < 2; ++k) acc[ai][bj][m][n] = __builtin_amdgcn_mfma_f32_16x16x32_bf16(Bt[n][k], At[m][k], acc[ai][bj][m][n], 0, 0, 0); } } __builtin_amdgcn_s_setprio(0); } while (0)
#define PG8_WAIT_V(n) asm volatile("s_waitcnt vmcnt(" #n ")" ::: "memory")
#define PG8_WAIT_L(n) asm volatile("s_waitcnt lgkmcnt(" #n ")" ::: "memory")
#define PG8_BAR __builtin_amdgcn_s_barrier()
#define PG8_SCHED __builtin_amdgcn_sched_barrier(0)
    typename Sched::Unit cur, nxt, prv; int ui = 0;
    if (!S.next(0, cur)) return;
    prv = cur; unsigned pre = 0u;
    f32x4 acc[2][2][4][2];
#pragma unroll
    for (int a = 0; a < 2; ++a)
#pragma unroll
        for (int b = 0; b < 2; ++b)
#pragma unroll
            for (int m = 0; m < 4; ++m)
#pragma unroll
                for (int n = 0; n < 2; ++n) acc[a][b][m][n] = (f32x4){0.f, 0.f, 0.f, 0.f};
    bf16x8 At[4][2], B0[2][2], B1[2][2]; v8i_t At8[4], B08[2], B18[2];
    constexpr bool GA = Sched::GATHER;
    const size_t hstepA = GA ? (size_t)0 : (size_t)HALF * K * 2;
    unsigned vA[2][2];
    LAS unsigned char* hdr = lds + STAGE_BYTES;
    if constexpr (Sched::HDR) { if (wid == 0) S.hdr_issue(cur, hdr, lane); PG8_WAIT_V(0); PG8_BAR; }
    S.a_off(cur, tid, vA, hdr);
#define PG8_STAGE_AH(bufoff, base, vv, h) PG8_STAGE_A(bufoff, ((base) + (h) * hstepA), vv[GA ? (h) : 0][0], vv[GA ? (h) : 0][1])
    const char* cA = S.a_base(cur); const char* cB = S.b_base(cur);
    if constexpr (Sched::COUNTED) { if (wid == 0) pre = S.peek(cur); S.a_ready(cur, wid, pre); }
    PG8_STAGE_B(PG8_SB(0, 0), cB); PG8_STAGE_B(PG8_SB(0, 1), cB + hstepB); PG8_STAGE_AH(PG8_SA(0, 0), cA, vA, 0); PG8_STAGE_AH(PG8_SA(0, 1), cA, vA, 1);
    if (wr == 1) PG8_BAR;
    PG8_WAIT_V(2); PG8_BAR;
    PG8_STAGE_B(PG8_SB(1, 0), cB + kstep); PG8_STAGE_AH(PG8_SA(1, 0), cA + kstep, vA, 0); PG8_STAGE_B(PG8_SB(1, 1), cB + hstepB + kstep);
    PG8_WAIT_V(6); PG8_BAR;
    int hc = 0;
    for (;;) {
        const bool has_next = S.next(ui + 1, nxt); const int hn = (hc == 2) ? 0 : hc + 1;
        const char* nA = cA; const char* nB = cB;
        if (has_next) { nA = S.a_base(nxt); nB = S.b_base(nxt); if constexpr (Sched::HDR) { if (wid == 0) S.hdr_issue(nxt, hdr + hn * 4096, lane); } if constexpr (Sched::COUNTED) { if (wid == 0) pre = S.peek(nxt); } }
        for (int t = 0; t < nt; t += 2) {
            const bool last = (t == nt - 2);
            const char* a1 = cA + (size_t)(t + 1) * kstep;
            const char* a2 = last ? nA : cA + (size_t)(t + 2) * kstep; const char* b2 = last ? nB : cB + (size_t)(t + 2) * kstep;
            const char* a3 = a2 + kstep; const char* b3 = b2 + kstep;
            PG8_LDB(B0, 0, 0); PG8_LDB(B1, 0, 1); PG8_SCHED; PG8_LDA(At, 0, 0); PG8_STAGE_AH(PG8_SA(1, 1), a1, vA, 1);
            if constexpr (Sched::COUNTED) { if (last && has_next) S.a_ready(nxt, wid, pre); }
            if constexpr (GA) { if (last && has_next) S.a_off(nxt, tid, vA, hdr + hn * 4096); }
            PG8_WAIT_V(8); PG8_WAIT_L(0); PG8_BAR; PG8_MMA(0, 0, At, B0); PG8_MMA(0, 1, At, B1); PG8_BAR; PG8_SCHED;
            PG8_LDA(At, 0, 1); PG8_STAGE_B(PG8_SB(0, 0), b2); PG8_STAGE_B(PG8_SB(0, 1), b2 + hstepB); PG8_STAGE_AH(PG8_SA(0, 0), a2, vA, 0);
            PG8_WAIT_V(8); PG8_WAIT_L(0); PG8_BAR; PG8_MMA(1, 0, At, B0); PG8_MMA(1, 1, At, B1); PG8_BAR; PG8_SCHED;
            PG8_LDB(B0, 1, 0); PG8_LDB(B1, 1, 1); PG8_SCHED; PG8_LDA(At, 1, 0); PG8_STAGE_AH(PG8_SA(0, 1), a2, vA, 1);
            PG8_WAIT_V(8); PG8_WAIT_L(0); PG8_BAR; PG8_MMA(0, 0, At, B0); PG8_MMA(0, 1, At, B1); PG8_BAR; PG8_SCHED;
            PG8_LDA(At, 1, 1); PG8_STAGE_B(PG8_SB(1, 0), b3); PG8_STAGE_B(PG8_SB(1, 1), b3 + hstepB); PG8_STAGE_AH(PG8_SA(1, 0), a3, vA, 0);
            PG8_WAIT_V(8); PG8_WAIT_L(0); PG8_BAR; PG8_MMA(1, 0, At, B0); PG8_MMA(1, 1, At, B1); PG8_BAR; PG8_SCHED;
        }
        if (wr == 0) PG8_BAR;
        if constexpr (Sched::PUBLISH) { if (ui > 0) S.publish(prv, lane); }
        { int fr_ = fr, fq_ = fq; asm volatile("" : "+v"(fr_), "+v"(fq_)); E(acc, cur, wr, wc, fr_, fq_, hdr + hc * 4096); }
        if (!has_next) break;
#pragma unroll
        for (int a = 0; a < 2; ++a)
#pragma unroll
            for (int b = 0; b < 2; ++b)
#pragma unroll
                for (int m = 0; m < 4; ++m)
#pragma unroll
                    for (int n = 0; n < 2; ++n) acc[a][b][m][n] = (f32x4){0.f, 0.f, 0.f, 0.f};
        prv = cur; cur = nxt; cA = nA; cB = nB; ++ui; hc = hn;
        if (wr == 1) PG8_BAR;
    }
    PG8_WAIT_V(0);
    if constexpr (Sched::PUBLISH) S.publish(cur, lane);
    PG8_BAR;
#undef PG8_SA
#undef PG8_SB
#undef PG8_STAGE_A
#undef PG8_STAGE_AH
#undef PG8_STAGE_B
#undef PG8_LDA
#undef PG8_LDB
#undef PG8_MMA
#undef PG8_CAT
#undef PG8_FOFF
#undef PG8_WAIT_V
#undef PG8_WAIT_L
#undef PG8_BAR
#undef PG8_SCHED
}
}
struct Args { const float* in[N_IN]; float* out; unsigned char* ws; int ph_lo, ph_hi; };
typedef const __attribute__((address_space(4))) unsigned long long* karg_t;
struct Frame {
    karg_t ka;
    LAS unsigned char* lds;
    volatile LAS unsigned* MISC;
    gu32* ctl;
    unsigned char* ws;
    float* out;
    int tid, lane, wave, vcu, G;
};
#define WSP(T_, off) ((T_*)(F.ws + (off)))
#define KIN(k) ((const float*)F.ka[(k)])
#ifdef DBG_SEL
#define DBG_STAT(k, val) do { const float _v = (val); if ((k) == DBG_SEL) { if (fabsf(_v) < 3e38f) atomicMax((unsigned*)(F.ctl + CW_DBG), __float_as_uint(fabsf(_v))); else atomicAdd((unsigned*)(F.ctl + CW_DBG + 1), 1u); } } while (0)
#else
#define DBG_STAT(k, val) do { } while (0)
#endif
template <class P> __device__ __forceinline__ P launder_uniform(P p) {
    unsigned lo = (unsigned)(unsigned long long)p, hi = (unsigned)((unsigned long long)p >> 32);
    asm volatile("" : "+v"(lo), "+v"(hi));
    lo = __builtin_amdgcn_readfirstlane(lo); hi = __builtin_amdgcn_readfirstlane(hi);
    return (P)(((unsigned long long)hi << 32) | lo);
}
__device__ __forceinline__ void frame_refresh(Frame& F) {
    int t = F.tid; asm volatile("" : "+v"(t)); F.tid = t; F.lane = t & 63; F.wave = __builtin_amdgcn_readfirstlane(t >> 6);
    F.ws = launder_uniform(F.ws); F.ctl = (gu32*)(F.ws + WS_CTL);
    F.out = launder_uniform(F.out);
    F.ka = launder_uniform(F.ka);
}

namespace pg8 {
struct DenseSched {
    static constexpr bool GATHER = false, FP8 = false, HDR = false, COUNTED = false, PUBLISH = false; static constexpr int scaleA = 0, scaleB = 0;
    struct Unit { int pm, pn; };
    __device__ __forceinline__ void hdr_issue(const Unit&, LAS unsigned char*, int) const {}
    const bf16* A; const bf16* Bt; int K; size_t hstepB; int nM, nN, nwg, G, c;
    __device__ __forceinline__ void init(const bf16* A_, const bf16* Bt_, int M, int N, int K_, int G_, int c_) { A = A_; Bt = Bt_; K = K_; hstepB = (size_t)HALF * K_ * 2; nM = M / BM; nN = N / BM; nwg = nM * nN; G = G_; c = c_; }
    __device__ __forceinline__ bool next(int i, Unit& u) const {
        const long L = (long)i * G + c; if (L >= nwg) return false;
        int wgid = (int)L; { const int q = nwg / NXCD, r = nwg % NXCD, xcd = wgid % NXCD, off = wgid / NXCD; wgid = (xcd < r ? xcd * (q + 1) : r * (q + 1) + (xcd - r) * q) + off; }
        const int nig = WGM * nN, gid = wgid / nig, fm = gid * WGM, gsz = (nM - fm) < WGM ? (nM - fm) : WGM;
        u.pm = fm + ((wgid % nig) % gsz); u.pn = (wgid % nig) / gsz; return true;
    }
    __device__ __forceinline__ const char* a_base(const Unit& u) const { return (const char*)A + (size_t)u.pm * BM * K * 2; }
    __device__ __forceinline__ const char* b_base(const Unit& u) const { return (const char*)Bt + (size_t)u.pn * BM * K * 2; }
    __device__ __forceinline__ void a_off(const Unit&, int tid, unsigned (&v)[2][2], const LAS unsigned char*) const {
#pragma unroll
        for (int i = 0; i < 2; ++i) { int R, C; stage_rc(tid * 16 + i * 8192, R, C); v[0][i] = (unsigned)(R * K + C) * 2u; v[1][i] = v[0][i]; }
    }
};
template <int SB> struct DenseSched8T : DenseSched { static constexpr bool GATHER = true, FP8 = true; static constexpr int scaleA = 0x7F7F7F7F, scaleB = SB;
    __device__ __forceinline__ void a_off(const Unit&, int tid, unsigned (&v)[2][2], const LAS unsigned char*) const {
        int t_ = tid; asm volatile("" : "+v"(t_));
#pragma unroll
        for (int i = 0; i < 2; ++i) { int R, C; stage_rc(t_ * 16 + i * 8192, R, C); v[0][i] = (unsigned)(R * K + C) * 2u; v[1][i] = v[0][i] + (unsigned)(HALF * K * 2); }
    }
};
typedef DenseSched8T<0x7A7A7A7A> DenseSched8;
typedef DenseSched8T<0x79797979> DenseSched8b;
struct MoeUnit { int e, mt, nt, cnt; };
struct MoeOrder {
    const volatile LAS unsigned* pfx;
    int NT, G, c;
    __device__ __forceinline__ bool decode(int i, MoeUnit& u) const {
        const int nwg = (int)pfx[32]; const long L = (long)i * G + c; if (L >= nwg) return false;
        int wgid = (int)L; { const int q = nwg / NXCD, r = nwg % NXCD, xcd = wgid % NXCD, off = wgid / NXCD; wgid = (xcd < r ? xcd * (q + 1) : r * (q + 1) + (xcd - r) * q) + off; }
        int e = 0;
#pragma unroll
        for (int st = 16; st >= 1; st >>= 1) e += ((int)pfx[e + st] <= wgid) ? st : 0;
        const int j = wgid - (int)pfx[e];
        u.e = e; u.mt = j / NT; u.nt = j % NT; u.cnt = (int)pfx[40 + e]; return true;
    }
};
#ifndef HDR_AOFF
#define HDR_AOFF 1
#endif
struct Moe1Sched {
    static constexpr bool GATHER = true, FP8 = (MOE_FP8 != 0), HDR = true, COUNTED = false, PUBLISH = (MOE_CHAIN != 0); static constexpr int EB = FP8 ? 1 : 2; static constexpr int scaleA = 0x7F7F7F7F, scaleB = 0x7A7A7A7A;
    typedef MoeUnit Unit;
    MoeOrder O; const unsigned char* X; const unsigned char* W; const int* sdest; const float* bgu; int K; size_t hstepB; gu32* pan;
    __device__ __forceinline__ void publish(const Unit& u, int lane) const { if (lane == 0) (void)__hip_atomic_fetch_add(pan + (u.e * 64 + u.mt) * 16, 1u, RLX_AGENT); }
    __device__ __forceinline__ void hdr_issue(const Unit& u, LAS unsigned char* hdr, int lane) const {
        __builtin_amdgcn_global_load_lds((const unsigned*)(sdest + (size_t)u.e * ECAP + (size_t)u.mt * 256 + lane * 4), (LAS unsigned*)hdr, 16, 0, 0);
        const float* bp = bgu + (size_t)u.e * 2048 + u.nt * 128 + (lane < 32 ? lane * 4 : 1024 + (lane - 32) * 4);
        __builtin_amdgcn_global_load_lds((const unsigned*)bp, (LAS unsigned*)(hdr + 1024), 16, 0, 0);
    }
    __device__ __forceinline__ bool next(int i, Unit& u) const { return O.decode(i, u); }
    __device__ __forceinline__ const char* a_base(const Unit&) const { return (const char*)X; }
    __device__ __forceinline__ const char* b_base(const Unit& u) const { return (const char*)W + ((size_t)u.e * 2048 + (size_t)u.nt * 128) * 1024 * EB; }
    __device__ __forceinline__ void a_off(const Unit& u, int tid, unsigned (&v)[2][2], const LAS unsigned char* hdr) const {
#pragma unroll
        for (int i = 0; i < 2; ++i) { int R, C; stage_rc(tid * 16 + i * 8192, R, C);
#pragma unroll
            for (int h = 0; h < 2; ++h) { const int sl = h * HALF + R; int tok = 0; if (u.mt * 256 + sl < u.cnt) tok = HDR_AOFF ? (((const LAS int*)hdr)[sl] >> 2) : (sdest[u.e * ECAP + u.mt * 256 + sl] >> 2); v[h][i] = (unsigned)(tok * 1024 * EB + C * 2); } }
    }
};
struct Moe2Sched {
    static constexpr bool GATHER = true, FP8 = (MOE2_FP8 != 0), HDR = true, COUNTED = (MOE_CHAIN != 0), PUBLISH = false; static constexpr int EB = FP8 ? 1 : 2; static constexpr int scaleA = 0x7F7F7F7F, scaleB = 0x79797979;
    typedef MoeUnit Unit;
    MoeOrder O; const unsigned char* Ab; const unsigned char* W; const int* sdest; const float* sgate; const float* bdn; int K; size_t hstepB; gu32* pan; gu32* tmo;
    __device__ __forceinline__ unsigned peek(const Unit& u) const { return __hip_atomic_load(pan + (u.e * 64 + u.mt) * 16, RLX_AGENT); }
    __device__ __forceinline__ void a_ready(const Unit& u, int wid, unsigned pre) const {
        if (wid == 0) {
            if ((unsigned)__builtin_amdgcn_readfirstlane(pre) < 64u) { unsigned sp = 0u;
                while ((unsigned)__builtin_amdgcn_readfirstlane(__hip_atomic_load(pan + (u.e * 64 + u.mt) * 16, RLX_AGENT)) < 64u) { __builtin_amdgcn_s_sleep(2);
                    if ((++sp & 255u) == 0u) { if (__hip_atomic_load(tmo, RLX_AGENT)) break; if (sp > (1u << 18)) { atomicAdd((unsigned*)tmo, 1u); break; } } } }
            __builtin_amdgcn_fence(__ATOMIC_ACQUIRE, "agent"); asm volatile("s_waitcnt vmcnt(0)" ::: "memory");
        }
        asm volatile("" ::: "memory"); __builtin_amdgcn_s_barrier(); asm volatile("" ::: "memory");
    }
    __device__ __forceinline__ void hdr_issue(const Unit& u, LAS unsigned char* hdr, int lane) const {
        const size_t so = (size_t)u.e * ECAP + (size_t)u.mt * 256 + lane * 4;
        __builtin_amdgcn_global_load_lds((const unsigned*)(sdest + so), (LAS unsigned*)hdr, 16, 0, 0);
        __builtin_amdgcn_global_load_lds((const unsigned*)(sgate + so), (LAS unsigned*)(hdr + 1024), 16, 0, 0);
        __builtin_amdgcn_global_load_lds((const unsigned*)(bdn + (size_t)u.e * 1024 + u.nt * 256 + lane * 4), (LAS unsigned*)(hdr + 2048), 16, 0, 0);
    }
    __device__ __forceinline__ bool next(int i, Unit& u) const { return O.decode(i, u); }
    __device__ __forceinline__ const char* a_base(const Unit& u) const { return (const char*)Ab + ((size_t)u.e * ECAP + (size_t)u.mt * 256) * 1024 * EB; }
    __device__ __forceinline__ const char* b_base(const Unit& u) const { return (const char*)W + ((size_t)u.e * 1024 + (size_t)u.nt * 256) * 1024 * EB; }
    __device__ __forceinline__ void a_off(const Unit&, int tid, unsigned (&v)[2][2], const LAS unsigned char*) const {
        int t_ = tid; asm volatile("" : "+v"(t_));
#pragma unroll
        for (int i = 0; i < 2; ++i) { int R, C; stage_rc(t_ * 16 + i * 8192, R, C); v[0][i] = (unsigned)(R * 1024 * EB + C * 2); v[1][i] = v[0][i] + (unsigned)(HALF * 1024 * EB); }
    }
};

__device__ __forceinline__ void unpack8(const v4u w, f32x4& a, f32x4& b) {
    a = (f32x4){__uint_as_float(w.x << 16), __uint_as_float(w.x & 0xffff0000u), __uint_as_float(w.y << 16), __uint_as_float(w.y & 0xffff0000u)};
    b = (f32x4){__uint_as_float(w.z << 16), __uint_as_float(w.z & 0xffff0000u), __uint_as_float(w.w << 16), __uint_as_float(w.w & 0xffff0000u)}; }
struct EpiF32 {
    static constexpr bool PERM = false;
    float* C; int ldc; const float* base; float alpha;
    __device__ __forceinline__ void operator()(const f32x4 (&acc)[2][2][4][2], const DenseSched::Unit& u, int wr, int wc, int fr, int fq, const LAS unsigned char* hdr) const {
        const int row0 = u.pm * BM + wr * 64 + fr, col0 = u.pn * BM + wc * 32 + 4 * fq;
#pragma unroll
        for (int ai = 0; ai < 2; ++ai)
#pragma unroll
            for (int m = 0; m < 4; ++m) { const size_t ro = (size_t)(row0 + ai * HALF + m * 16) * ldc + col0;
#pragma unroll
                for (int bj = 0; bj < 2; ++bj)
#pragma unroll
                    for (int n = 0; n < 2; ++n) { f32x4 v = acc[ai][bj][m][n];
                        if (base) { const f32x4 b = *(const f32x4*)(base + ro + bj * HALF + n * 16); v = v + b * alpha; }
                        *(f32x4*)(C + ro + bj * HALF + n * 16) = v; } }
    }
};
struct EpiB16 {
    static constexpr bool PERM = true;
    bf16* O; int ldc; const bf16* base; float alpha;
    __device__ __forceinline__ void operator()(const f32x4 (&acc)[2][2][4][2], const DenseSched::Unit& u, int wr, int wc, int fr, int fq, const LAS unsigned char* hdr) const {
        const int row0 = u.pm * BM + wr * 64 + fr, col0 = u.pn * BM + wc * 32 + 8 * fq;
#pragma unroll
        for (int ai = 0; ai < 2; ++ai) {
            v4u bw[4][2];
            if (base) {
#pragma unroll
                for (int m = 0; m < 4; ++m)
#pragma unroll
                    for (int bj = 0; bj < 2; ++bj) bw[m][bj] = *(const v4u*)(base + (size_t)(row0 + ai * HALF + m * 16) * ldc + col0 + bj * HALF); }
#pragma unroll
            for (int m = 0; m < 4; ++m) { bf16* rowp = O + (size_t)(row0 + ai * HALF + m * 16) * ldc + col0;
#pragma unroll
                for (int bj = 0; bj < 2; ++bj) { f32x4 v0 = acc[ai][bj][m][0], v1 = acc[ai][bj][m][1];
                    if (base) { f32x4 b0, b1; unpack8(bw[m][bj], b0, b1); v0 = v0 + b0 * alpha; v1 = v1 + b1 * alpha; }
                    v4u w; w.x = cvt_pk_bf16(v0[0], v0[1]); w.y = cvt_pk_bf16(v0[2], v0[3]); w.z = cvt_pk_bf16(v1[0], v1[1]); w.w = cvt_pk_bf16(v1[2], v1[3]);
                    *(v4u*)(rowp + bj * HALF) = w; } } }
    }
};
struct EpiPle {
    static constexpr bool PERM = true;
    bf16* C; const bf16* hb; const bf16* pe;
    __device__ __forceinline__ void operator()(const f32x4 (&acc)[2][2][4][2], const DenseSched::Unit& u, int wr, int wc, int fr, int fq, const LAS unsigned char* hdr) const {
        const int row0 = u.pm * BM + wr * 64 + fr, col0 = u.pn * BM + wc * 32 + 8 * fq;
#pragma unroll
        for (int ai = 0; ai < 2; ++ai) {
            v4u hw[4][2], pw[4][2];
#pragma unroll
            for (int m = 0; m < 4; ++m)
#pragma unroll
                for (int bj = 0; bj < 2; ++bj) { const size_t ro = (size_t)(row0 + ai * HALF + m * 16) * 1024 + col0 + bj * HALF; hw[m][bj] = *(const v4u*)(hb + ro); pw[m][bj] = *(const v4u*)(pe + ro); }
#pragma unroll
            for (int m = 0; m < 4; ++m)
#pragma unroll
                for (int bj = 0; bj < 2; ++bj) { const size_t ro = (size_t)(row0 + ai * HALF + m * 16) * 1024 + col0 + bj * HALF;
                    f32x4 h0, h1, p0, p1; unpack8(hw[m][bj], h0, h1); unpack8(pw[m][bj], p0, p1); const f32x4 a0 = acc[ai][bj][m][0], a1 = acc[ai][bj][m][1];
                    f32x4 o0, o1;
#pragma unroll
                    for (int j = 0; j < 4; ++j) { o0[j] = h0[j] + sigmoidf_(a0[j]) * p0[j]; o1[j] = h1[j] + sigmoidf_(a1[j]) * p1[j]; }
                    v4u w; w.x = cvt_pk_bf16(o0[0], o0[1]); w.y = cvt_pk_bf16(o0[2], o0[3]); w.z = cvt_pk_bf16(o1[0], o1[1]); w.w = cvt_pk_bf16(o1[2], o1[3]);
                    *(v4u*)(C + ro) = w; } }
    }
};
struct EpiMoe1 {
    static constexpr bool PERM = true;
    bf16* Ab; const float* bgu; unsigned char* AbQ;
    __device__ __forceinline__ void operator()(const f32x4 (&acc)[2][2][4][2], const MoeUnit& u, int wr, int wc, int fr, int fq, const LAS unsigned char* hdr) const {
        const int col0 = u.nt * 128 + wc * 32 + 8 * fq;
        const LAS float* bh = (const LAS float*)(hdr + 1024) + wc * 32 + 8 * fq;
        const f32x4 bg0 = *(const LAS f32x4*)(bh), bg1 = *(const LAS f32x4*)(bh + 4), bl0 = *(const LAS f32x4*)(bh + 128), bl1 = *(const LAS f32x4*)(bh + 132);
#pragma unroll
        for (int ai = 0; ai < 2; ++ai)
#pragma unroll
            for (int m = 0; m < 4; ++m) { const int r = ai * HALF + wr * 64 + m * 16 + fr;
                bf16* rowp = Ab + ((size_t)u.e * ECAP + (size_t)u.mt * 256 + r) * 1024 + col0;
                float o[8];
#pragma unroll
                for (int n = 0; n < 2; ++n) { const f32x4 g4 = acc[ai][0][m][n] + (n ? bg1 : bg0), l4 = acc[ai][1][m][n] + (n ? bl1 : bl0);
#pragma unroll
                    for (int j = 0; j < 4; ++j) { const float g = fminf(g4[j], 7.0f), l = fminf(fmaxf(l4[j], -7.0f), 7.0f); o[n * 4 + j] = (l + 1.0f) * g * sigmoidf_(1.702f * g); } }
                if constexpr (MOE2_FP8) { v2u q; q.x = cvt4_fp8(o[0], o[1], o[2], o[3]); q.y = cvt4_fp8(o[4], o[5], o[6], o[7]); unsigned char* qp = (unsigned char*)AbQ + ((size_t)u.e * ECAP + (size_t)u.mt * 256 + r) * 1024 + col0;
                    if (MOE_CHAIN) asm volatile("global_store_dwordx2 %0, %1, off sc1" :: "v"(qp), "v"(q) : "memory");
                    else *(v2u*)qp = q; }
                else *(v4u*)rowp = pack8(o); }
    }
};
struct EpiMoe2 {
    static constexpr bool PERM = true;
    bf16* Y; const float* bdn; const int* sdest; const float* sgate;
    __device__ __forceinline__ void operator()(const f32x4 (&acc)[2][2][4][2], const MoeUnit& u, int wr, int wc, int fr, int fq, const LAS unsigned char* hdr) const {
        const int col0 = u.nt * 256 + wc * 32 + 8 * fq;
        const LAS float* bp = (const LAS float*)(hdr + 2048) + wc * 32 + 8 * fq;
#pragma unroll
        for (int ai = 0; ai < 2; ++ai) {
            f32x4 bv[2][2];
#pragma unroll
            for (int bj = 0; bj < 2; ++bj)
#pragma unroll
                for (int n = 0; n < 2; ++n) bv[bj][n] = *(const LAS f32x4*)(bp + bj * HALF + 4 * n);
            int dest[4]; float gate[4];
#pragma unroll
            for (int m = 0; m < 4; ++m) { const int sl = ai * HALF + wr * 64 + m * 16 + fr; const bool ok = u.mt * 256 + sl < u.cnt;
                dest[m] = ok ? ((const LAS int*)hdr)[sl] : T * 4; gate[m] = ok ? ((const LAS float*)(hdr + 1024))[sl] : 0.f; }
#pragma unroll
            for (int m = 0; m < 4; ++m) {
                { const float g = gate[m]; bf16* rowp = Y + (size_t)dest[m] * 1024 + col0;
#pragma unroll
                    for (int bj = 0; bj < 2; ++bj) { const f32x4 v0 = (acc[ai][bj][m][0] + bv[bj][0]) * g, v1 = (acc[ai][bj][m][1] + bv[bj][1]) * g;
                        v4u w; w.x = cvt_pk_bf16(v0[0], v0[1]); w.y = cvt_pk_bf16(v0[2], v0[3]); w.z = cvt_pk_bf16(v1[0], v1[1]); w.w = cvt_pk_bf16(v1[2], v1[3]);
                        *(v4u*)(rowp + bj * HALF) = w; } } } }
    }
};
}

__device__ __forceinline__ void p0_transpose_item(const float* W, int K, int N, int nblk, bf16* WT, int item, int lane) {
    const int kb = item / nblk, nb = item % nblk, k0 = 64 * kb, n = 64 * nb + lane;
    const bool ok = n < N; const float* src = W + (size_t)k0 * N + (ok ? n : 0);
    float x[64];
#pragma unroll
    for (int j = 0; j < 64; ++j) x[j] = __builtin_nontemporal_load(src + (size_t)j * N);
    bf16* dst = WT + (size_t)n * K + k0;
#pragma unroll
    for (int q = 0; q < 8; ++q) { v4u o; o.x = cvt_pk_bf16(x[8 * q], x[8 * q + 1]); o.y = cvt_pk_bf16(x[8 * q + 2], x[8 * q + 3]); o.z = cvt_pk_bf16(x[8 * q + 4], x[8 * q + 5]); o.w = cvt_pk_bf16(x[8 * q + 6], x[8 * q + 7]);
        if (!ok) o = (v4u){0u, 0u, 0u, 0u};
        *(v4u*)(dst + 8 * q) = o; }
}
__device__ __forceinline__ void cvt_rows(const float* src, bf16* dst, size_t n8, size_t i0, size_t stride) {
    for (size_t i = i0; i < n8; i += stride) { const f32x4 a = *(const f32x4*)(src + i * 8), b = *(const f32x4*)(src + i * 8 + 4);
        v4u o; o.x = cvt_pk_bf16(a.x, a.y); o.y = cvt_pk_bf16(a.z, a.w); o.z = cvt_pk_bf16(b.x, b.y); o.w = cvt_pk_bf16(b.z, b.w); *(v4u*)(dst + i * 8) = o; }
}
__device__ __forceinline__ void p0_prologue(Frame& F, const Args& A) {
    const int gw = F.vcu * NWAVES + F.wave, NGW = F.G * NWAVES;
    constexpr int I_IN = 16 * (NUP / 64), I_OUT = 16 * 16, I_GU = 16 * 32, I_DN = 16 * 16, I_PG = 16 * 16, I_PP = 4 * 16;
    constexpr int PER_LAYER = I_IN + I_OUT + NE * I_GU + NE * I_DN + I_PG + I_PP;
#pragma unroll 1
    for (int it = gw; it < DEPTH * PER_LAYER; it += NGW) {
        const int l = it / PER_LAYER; int r = it % PER_LAYER;
        const float* W; bf16* WT; int K = D, N = D, nblk = 16;
        if (r < I_IN) { W = KIN(I_WIN) + (size_t)l * D * NU; WT = WSP(bf16, WS_WIN_T) + (size_t)l * NUP * D; N = NU; nblk = NUP / 64; }
        else if ((r -= I_IN) < I_OUT) { if (OUT_FP8) continue; W = KIN(I_WOUT) + (size_t)l * D * D; WT = WSP(bf16, WS_WOUT_T) + (size_t)l * D * D; }
        else if ((r -= I_OUT) < NE * I_GU) { if (MOE_FP8) continue; const int e = r / I_GU; r %= I_GU; W = KIN(I_WGU) + ((size_t)l * NE + e) * D * 2048; WT = WSP(bf16, WS_WGU_T) + ((size_t)l * NE + e) * 2048 * D; N = 2048; nblk = 32; }
        else if ((r -= NE * I_GU) < NE * I_DN) { if (MOE2_FP8) continue; const int e = r / I_DN; r %= I_DN; W = KIN(I_WDN) + ((size_t)l * NE + e) * D * D; WT = WSP(bf16, WS_WDN_T) + ((size_t)l * NE + e) * D * D; }
        else if ((r -= NE * I_DN) < I_PG) { if (PLE_FP8) continue; W = KIN(I_PGW) + (size_t)l * D * D; WT = WSP(bf16, WS_WPG_T) + (size_t)l * D * D; }
        else { r -= I_PG; W = KIN(I_PPJ) + (size_t)l * 256 * D; WT = WSP(bf16, WS_WPP_T) + (size_t)l * D * 256; K = 256; }
        p0_transpose_item(W, K, N, nblk, WT, r, F.lane);
    }
#if MOE_FP8
    constexpr int Q_GU = 16 * 32, Q_DN = 16 * 16, Q_PG = PLE_FP8 ? 16 * 16 : 0, Q_OUT = OUT_FP8 ? 16 * 16 : 0, Q_PER_LAYER = NE * (Q_GU + Q_DN) + Q_PG + Q_OUT;
#pragma unroll 1
    for (int it = gw; it < DEPTH * Q_PER_LAYER; it += NGW) {
        const int l = it / Q_PER_LAYER; int r = it % Q_PER_LAYER; const float* W; unsigned char* WQ; int N; float sc;
        if (r < NE * Q_GU) { const int e = r / Q_GU; r %= Q_GU; W = KIN(I_WGU) + ((size_t)l * NE + e) * D * 2048; WQ = WSP(unsigned char, WS_WGU_Q) + ((size_t)l * NE + e) * 2048 * D; N = 2048; sc = 32.0f; }
        else if (r >= NE * (Q_GU + Q_DN) + Q_PG) { r -= NE * (Q_GU + Q_DN) + Q_PG; W = KIN(I_WOUT) + (size_t)l * D * D; WQ = WSP(unsigned char, WS_WOUT_Q) + (size_t)l * D * D; N = D; sc = 64.0f; }
        else if (r >= NE * (Q_GU + Q_DN)) { r -= NE * (Q_GU + Q_DN); W = KIN(I_PGW) + (size_t)l * D * D; WQ = WSP(unsigned char, WS_WPG_Q) + (size_t)l * D * D; N = D; sc = 32.0f; }
        else { if (!MOE2_FP8) continue; r -= NE * Q_GU; const int e = r / Q_DN; r %= Q_DN; W = KIN(I_WDN) + ((size_t)l * NE + e) * D * D; WQ = WSP(unsigned char, WS_WDN_Q) + ((size_t)l * NE + e) * D * D; N = D; sc = 64.0f; }
        const int nblk = N / 64, kb = r / nblk, nb = r % nblk, k0 = 64 * kb, n = 64 * nb + F.lane;
        const float* src = W + (size_t)k0 * N + n; float x[64];
#pragma unroll
        for (int j = 0; j < 64; ++j) x[j] = __builtin_nontemporal_load(src + (size_t)j * N) * sc;
        unsigned char* dst = WQ + (size_t)n * D + k0;
#pragma unroll
        for (int q = 0; q < 4; ++q) { v4u o; o.x = cvt4_fp8(x[16 * q], x[16 * q + 1], x[16 * q + 2], x[16 * q + 3]); o.y = cvt4_fp8(x[16 * q + 4], x[16 * q + 5], x[16 * q + 6], x[16 * q + 7]);
            o.z = cvt4_fp8(x[16 * q + 8], x[16 * q + 9], x[16 * q + 10], x[16 * q + 11]); o.w = cvt4_fp8(x[16 * q + 12], x[16 * q + 13], x[16 * q + 14], x[16 * q + 15]); *(v4u*)(dst + 16 * q) = o; }
    }
#endif
    const size_t gt = (size_t)F.vcu * (NWAVES * 64) + F.tid, NT_ = (size_t)F.G * NWAVES * 64;
    cvt_rows(KIN(I_P), WSP(bf16, WS_PB), (size_t)DEPTH * T * 256 / 8, gt, NT_);
    cvt_rows(KIN(I_X), WSP(bf16, WS_XB), (size_t)T * D / 8, gt, NT_);
    for (size_t i = gt; i < (size_t)DEPTH * LORA_PER_LAYER; i += NT_) { const int l = (int)(i / LORA_PER_LAYER); int r = (int)(i % LORA_PER_LAYER); float v;
        if (r < 8192) { const int ch = r >> 5, j = r & 31; v = KIN(I_RWUP)[(size_t)l * 8192 + j * 256 + ch]; }
        else if (r < 16384) { r -= 8192; const int ch = r >> 5, j = r & 31; v = KIN(I_RAUP)[(size_t)l * 8192 + j * 256 + ch]; }
        else if (r < 32768) { r -= 16384; const int ch = r >> 6, j = r & 63; v = KIN(I_RGUP)[(size_t)l * 16384 + j * 256 + ch]; }
        else { r -= 32768; const int d = r >> 4, j = r & 15; v = KIN(I_GGUP)[(size_t)l * 2048 + j * 128 + d]; }
        WSP(float, WS_LORA)[i] = v; }
#if P6_MFMA
    for (size_t i = gt; i < (size_t)DEPTH * 32768; i += NT_) { const int l = (int)(i >> 15), r = (int)(i & 32767), c = r >> 8, e = (r >> 3) & 31, k = 8 * c + (r & 7);
        const float v = KIN(I_RTW)[(size_t)l * D * NE + (size_t)k * NE + e]; const unsigned h = cvt_pk_bf16(v, 0.f) & 0xffffu; const unsigned lo = cvt_pk_bf16(v - __uint_as_float(h << 16), 0.f) & 0xffffu;
        unsigned short* dst = WSP(unsigned short, WS_RWT) + (size_t)l * 65536 + r; dst[0] = (unsigned short)h; dst[32768] = (unsigned short)lo; }
#else
    for (size_t i = gt; i < (size_t)DEPTH * NE * D; i += NT_) { const int l = (int)(i / (NE * D)), r = (int)(i % (NE * D)), e = r / D, k = r % D; WSP(float, WS_RWT)[i] = KIN(I_RTW)[(size_t)l * D * NE + (size_t)k * NE + e]; }
#endif
}

#if P6_MFMA
template <bool DRY> __device__ __forceinline__ void p6_ln1_router(Frame& F, const Args& A, int layer) {
    const bf16* y1 = WSP(bf16, WS_Y1); bf16* x1b = WSP(bf16, WS_X1B);
    const float* gam = KIN(I_LN1G) + layer * D; const float* bet = KIN(I_LN1B) + layer * D;
    const unsigned char* rwq = WSP(unsigned char, WS_RWT) + (size_t)layer * 131072; const float* rb = KIN(I_RTB) + layer * NE;
    int* sdest = WSP(int, WS_SDEST); float* sgate = WSP(float, WS_SGATE);
    unsigned* cnt = (unsigned*)(F.ctl + CW_CNT + layer * NE * 16);
    LAS unsigned char* WL = F.lds;
    LAS float* LG = (LAS float*)(F.lds + 131072);
    LAS float* TOPV = (LAS float*)(F.lds + 139264) + F.wave * 64;
    LAS int* TOPE = (LAS int*)(F.lds + 139264 + 2048) + F.wave * 64;
    LAS float* STAT = (LAS float*)(F.lds + 143360);
    volatile LAS unsigned* lcnt = F.MISC + MW_LCNT; volatile LAS unsigned* lbase = F.MISC + MW_LBASE;
    { const int l0 = F.lane;
#pragma unroll
      for (int i = 0; i < 16; ++i) { const int off = (F.wave * 16 + i) * 1024; __builtin_amdgcn_global_load_lds((const unsigned*)(rwq + off + l0 * 16), (LAS unsigned*)(WL + off), 16, 0, 0); } }
    const int lane = F.lane, m = lane & 15, g = lane >> 4, rq = F.wave & 3, kh = F.wave >> 2;
    for (int blk = F.vcu; blk < T / 64; blk += F.G) {
        if (F.tid < 32) lcnt[F.tid] = 0u;
        const int row = blk * 64 + rq * 16 + m; const size_t ro = (size_t)row * D + 512 * kh + 8 * g;
        v4u yw[16];
#pragma unroll
        for (int kk = 0; kk < 16; ++kk) yw[kk] = *(const v4u*)(y1 + ro + 32 * kk);
        float s = 0.f, s2 = 0.f;
#pragma unroll
        for (int kk = 0; kk < 16; ++kk) { f32x4 a, b; pg8::unpack8(yw[kk], a, b); s += ((a.x + a.y) + (a.z + a.w)) + ((b.x + b.y) + (b.z + b.w));
            s2 += ((a.x * a.x + a.y * a.y) + (a.z * a.z + a.w * a.w)) + ((b.x * b.x + b.y * b.y) + (b.z * b.z + b.w * b.w)); }
        s += __shfl_xor(s, 16); s += __shfl_xor(s, 32); s2 += __shfl_xor(s2, 16); s2 += __shfl_xor(s2, 32);
        if (g == 0) { STAT[(kh * 64 + rq * 16 + m) * 2] = s; STAT[(kh * 64 + rq * 16 + m) * 2 + 1] = s2; }
        asm volatile("s_waitcnt vmcnt(0)" ::: "memory");
        __syncthreads();
        const float st = STAT[(rq * 16 + m) * 2] + STAT[(64 + rq * 16 + m) * 2], st2 = STAT[(rq * 16 + m) * 2 + 1] + STAT[(64 + rq * 16 + m) * 2 + 1];
        const float mean = st * (1.f / D); const float rstd = __builtin_amdgcn_rsqf(fmaxf(st2 * (1.f / D) - mean * mean, 0.f) + LN_EPS);
        f32x4 acc[2] = {(f32x4){0.f, 0.f, 0.f, 0.f}, (f32x4){0.f, 0.f, 0.f, 0.f}}; const float* gp = gam; const float* bp = bet;
#pragma unroll
        for (int kk = 0; kk < 16; ++kk) { const int k0 = 512 * kh + 32 * kk + 8 * g;
            if ((kk & 3) == 0) { gp = launder_uniform(gp); bp = launder_uniform(bp); }
            const f32x4 ga = *(const f32x4*)(gp + k0), gb = *(const f32x4*)(gp + k0 + 4), ba = *(const f32x4*)(bp + k0), bb = *(const f32x4*)(bp + k0 + 4);
            f32x4 a, b; { v4u yk = yw[kk]; asm volatile("" : "+v"(yk)); pg8::unpack8(yk, a, b); }
            a = (a - mean) * rstd * ga + ba; b = (b - mean) * rstd * gb + bb;
            v4u hw; hw.x = cvt_pk_bf16(a.x, a.y); hw.y = cvt_pk_bf16(a.z, a.w); hw.z = cvt_pk_bf16(b.x, b.y); hw.w = cvt_pk_bf16(b.z, b.w);
            *(v4u*)(x1b + (size_t)row * D + k0) = hw;
            if (MOE_FP8) { v2u q; q.x = cvt4_fp8(a.x, a.y, a.z, a.w); q.y = cvt4_fp8(b.x, b.y, b.z, b.w); *(v2u*)(WSP(unsigned char, WS_X1Q) + (size_t)row * D + k0) = q; }
            f32x4 ha, hb_; pg8::unpack8(hw, ha, hb_); a = a - ha; b = b - hb_;
            v4u lw; lw.x = cvt_pk_bf16(a.x, a.y); lw.y = cvt_pk_bf16(a.z, a.w); lw.z = cvt_pk_bf16(b.x, b.y); lw.w = cvt_pk_bf16(b.z, b.w);
            const bf16x8 xh = __builtin_bit_cast(bf16x8, hw), xl = __builtin_bit_cast(bf16x8, lw);
            const int c = kh * 64 + kk * 4 + g;
#pragma unroll
            for (int nt = 0; nt < 2; ++nt) { const bf16x8 wh = *(const LAS bf16x8*)(WL + (c * 32 + nt * 16 + m) * 16), wl = *(const LAS bf16x8*)(WL + 65536 + (c * 32 + nt * 16 + m) * 16);
                acc[nt] = __builtin_amdgcn_mfma_f32_16x16x32_bf16(wh, xh, acc[nt], 0, 0, 0);
                acc[nt] = __builtin_amdgcn_mfma_f32_16x16x32_bf16(wl, xh, acc[nt], 0, 0, 0);
                acc[nt] = __builtin_amdgcn_mfma_f32_16x16x32_bf16(wh, xl, acc[nt], 0, 0, 0); } }
        if (kh == 1) {
#pragma unroll
            for (int nt = 0; nt < 2; ++nt) *(LAS f32x4*)(LG + (rq * 16 + m) * 32 + nt * 16 + 4 * g) = acc[nt]; }
        __syncthreads();
        if (kh == 0) {
#pragma unroll
            for (int nt = 0; nt < 2; ++nt) { const f32x4 o = *(const LAS f32x4*)(LG + (rq * 16 + m) * 32 + nt * 16 + 4 * g); const f32x4 rbv = *(const f32x4*)(rb + nt * 16 + 4 * g);
                *(LAS f32x4*)(LG + (rq * 16 + m) * 32 + nt * 16 + 4 * g) = o + acc[nt] + rbv; } }
        __syncthreads();
        int lane2 = lane; asm volatile("" : "+v"(lane2)); const int sub = lane2 & 15;
#pragma unroll 1
        for (int rg = 0; rg < 2; ++rg) {
            float lg[32];
            { const LAS float* lr = LG + (F.wave * 8 + rg * 4 + (lane2 >> 4)) * 32;
#pragma unroll
              for (int q = 0; q < 8; ++q) { const f32x4 t4 = *(const LAS f32x4*)(lr + 4 * q); lg[4 * q] = t4.x; lg[4 * q + 1] = t4.y; lg[4 * q + 2] = t4.z; lg[4 * q + 3] = t4.w; } }
            float la = 0.f, lb_ = 0.f;
#pragma unroll
            for (int e = 0; e < 32; ++e) { if (e == 2 * sub) la = lg[e]; if (e == 2 * sub + 1) lb_ = lg[e]; }
            int ra = 0, rbk = 0;
#pragma unroll
            for (int e = 0; e < 32; ++e) { ra += (lg[e] > la || (lg[e] == la && e < 2 * sub)) ? 1 : 0; rbk += (lg[e] > lb_ || (lg[e] == lb_ && e < 2 * sub + 1)) ? 1 : 0; }
            const int rowl = rg * 4 + (lane2 >> 4);
            if (ra < 4) { TOPV[rowl * 4 + ra] = la; TOPE[rowl * 4 + ra] = 2 * sub; }
            if (rbk < 4) { TOPV[rowl * 4 + rbk] = lb_; TOPE[rowl * 4 + rbk] = 2 * sub + 1; }
        }
        LDS_WAIT();
        int my_e = 0; float my_g = 0.f; unsigned my_r = 0u;
        if (lane2 < 32) { const int ri = lane2 >> 2, k = lane2 & 3; const f32x4 tv = *(const LAS f32x4*)(TOPV + ri * 4);
            const float e1 = __expf(tv.y - tv.x), e2 = __expf(tv.z - tv.x), e3 = __expf(tv.w - tv.x); const float inv = __builtin_amdgcn_rcpf(1.0f + e1 + e2 + e3);
            my_e = TOPE[ri * 4 + k]; my_g = (k == 0 ? 1.0f : k == 1 ? e1 : k == 2 ? e2 : e3) * inv;
            my_r = DRY ? 0u : atomicAdd((unsigned*)&lcnt[my_e], 1u); }
        __syncthreads();
        if (!DRY && F.wave == 0 && lane2 < 32) { const unsigned n = lcnt[lane2]; lbase[lane2] = n ? __hip_atomic_fetch_add(cnt + lane2 * 16, n, RLX_AGENT) : 0u; }
        __syncthreads();
        if (!DRY && lane2 < 32) { const int rw = blk * 64 + F.wave * 8 + (lane2 >> 2); const unsigned slot = (unsigned)my_e * ECAP + lbase[my_e] + my_r;
            sdest[slot] = rw * 4 + (lane2 & 3); sgate[slot] = my_g; }
        __syncthreads();
    }
}
#else
template <bool DRY> __device__ __forceinline__ void p6_ln1_router(Frame& F, const Args& A, int layer) {
    const bf16* y1 = WSP(bf16, WS_Y1); bf16* x1b = WSP(bf16, WS_X1B);
    const float* g = KIN(I_LN1G) + layer * D; const float* bb = KIN(I_LN1B) + layer * D;
    const float* rwt = WSP(float, WS_RWT) + (size_t)layer * NE * D; const float* rb = KIN(I_RTB) + layer * NE;
    int* sdest = WSP(int, WS_SDEST); float* sgate = WSP(float, WS_SGATE);
    unsigned* cnt = (unsigned*)(F.ctl + CW_CNT + layer * NE * 16);
    LAS float* RWT = (LAS float*)F.lds;
    LAS float* TOPV = (LAS float*)(F.lds + 131072) + F.wave * 64;
    LAS int* TOPE = (LAS int*)(F.lds + 131072 + 2048) + F.wave * 64;
    volatile LAS unsigned* lcnt = F.MISC + MW_LCNT; volatile LAS unsigned* lbase = F.MISC + MW_LBASE;
    for (int i = F.tid; i < NE * D / 4; i += NWAVES * 64) ((LAS f32x4*)RWT)[i] = ((const f32x4*)rwt)[i];
    const int lane = F.lane, sub = lane & 15;
    for (int blk = F.vcu; blk < T / 64; blk += F.G) {
        if (F.tid < 32) lcnt[F.tid] = 0u;
        __syncthreads();
#pragma unroll 1
        for (int rg = 0; rg < 2; ++rg) {
            f32x4 v[4][4];
            { int lo_ = lane; asm volatile("" : "+v"(lo_));
              const f32x4 gv[4] = { *(const f32x4*)(g + 4 * lo_), *(const f32x4*)(g + 256 + 4 * lo_), *(const f32x4*)(g + 512 + 4 * lo_), *(const f32x4*)(g + 768 + 4 * lo_) };
              const f32x4 bv[4] = { *(const f32x4*)(bb + 4 * lo_), *(const f32x4*)(bb + 256 + 4 * lo_), *(const f32x4*)(bb + 512 + 4 * lo_), *(const f32x4*)(bb + 768 + 4 * lo_) };
#pragma unroll
              for (int r = 0; r < 4; ++r) { const int row = blk * 64 + F.wave * 8 + rg * 4 + r; const bf16* yr = y1 + (size_t)row * D; float s = 0.f;
#pragma unroll
                  for (int j = 0; j < 4; ++j) { const v2u w = *(const v2u*)(yr + 256 * j + 4 * lane); v[r][j] = (f32x4){__uint_as_float(w.x << 16), __uint_as_float(w.x & 0xffff0000u), __uint_as_float(w.y << 16), __uint_as_float(w.y & 0xffff0000u)}; s += (v[r][j].x + v[r][j].y) + (v[r][j].z + v[r][j].w); }
                  const float mean = wave_sum(s) * (1.f / D); float s2 = 0.f;
#pragma unroll
                  for (int j = 0; j < 4; ++j) { v[r][j] = v[r][j] - mean; s2 += (v[r][j].x * v[r][j].x + v[r][j].y * v[r][j].y) + (v[r][j].z * v[r][j].z + v[r][j].w * v[r][j].w); }
                  const float rstd = __builtin_amdgcn_rsqf(wave_sum(s2) * (1.f / D) + LN_EPS);
#pragma unroll
                  for (int j = 0; j < 4; ++j) { v[r][j] = v[r][j] * rstd * gv[j] + bv[j];
                      v2u o; o.x = cvt_pk_bf16(v[r][j].x, v[r][j].y); o.y = cvt_pk_bf16(v[r][j].z, v[r][j].w); *(v2u*)(x1b + (size_t)row * D + 256 * j + 4 * lane) = o;
                      if (MOE_FP8) *(unsigned*)(WSP(unsigned char, WS_X1Q) + (size_t)row * D + 256 * j + 4 * lane) = cvt4_fp8(v[r][j].x, v[r][j].y, v[r][j].z, v[r][j].w); } } }
            float lg[32];
#pragma unroll
            for (int e = 0; e < 32; ++e) { f32x2 p2[4] = {(f32x2){0.f, 0.f}, (f32x2){0.f, 0.f}, (f32x2){0.f, 0.f}, (f32x2){0.f, 0.f}};
#pragma unroll
                for (int j = 0; j < 4; ++j) { const f32x4 w = *(const LAS f32x4*)(RWT + e * D + 256 * j + 4 * lane);
#pragma unroll
                    for (int r = 0; r < 4; ++r) { p2[r] = v[r][j].xy * w.xy + p2[r]; p2[r] = v[r][j].zw * w.zw + p2[r]; } }
                float p[4] = {p2[0].x + p2[0].y, p2[1].x + p2[1].y, p2[2].x + p2[2].y, p2[3].x + p2[3].y};
                { const bool hi = (lane & 32) != 0; const float k0 = hi ? p[2] : p[0], s0 = hi ? p[0] : p[2], k1 = hi ? p[3] : p[1], s1 = hi ? p[1] : p[3]; p[0] = k0 + __shfl_xor(s0, 32); p[1] = k1 + __shfl_xor(s1, 32); }
                { const bool hi = (lane & 16) != 0; const float k0 = hi ? p[1] : p[0], s0 = hi ? p[0] : p[1]; p[0] = k0 + __shfl_xor(s0, 16); }
                float t = p[0]; t += __shfl_xor(t, 8); t += __shfl_xor(t, 4); t += __shfl_xor(t, 2); t += __shfl_xor(t, 1);
                lg[e] = t + rb[e]; }
            float la = 0.f, lb_ = 0.f;
#pragma unroll
            for (int e = 0; e < 32; ++e) { if (e == 2 * sub) la = lg[e]; if (e == 2 * sub + 1) lb_ = lg[e]; }
            int ra = 0, rbk = 0;
#pragma unroll
            for (int e = 0; e < 32; ++e) { ra += (lg[e] > la || (lg[e] == la && e < 2 * sub)) ? 1 : 0; rbk += (lg[e] > lb_ || (lg[e] == lb_ && e < 2 * sub + 1)) ? 1 : 0; }
            const int rowl = rg * 4 + (lane >> 4);
            if (ra < 4) { TOPV[rowl * 4 + ra] = la; TOPE[rowl * 4 + ra] = 2 * sub; }
            if (rbk < 4) { TOPV[rowl * 4 + rbk] = lb_; TOPE[rowl * 4 + rbk] = 2 * sub + 1; }
        }
        LDS_WAIT();
        int my_e = 0; float my_g = 0.f; unsigned my_r = 0u;
        if (lane < 32) { const int ri = lane >> 2, k = lane & 3; const f32x4 tv = *(const LAS f32x4*)(TOPV + ri * 4);
            const float e1 = __expf(tv.y - tv.x), e2 = __expf(tv.z - tv.x), e3 = __expf(tv.w - tv.x); const float inv = __builtin_amdgcn_rcpf(1.0f + e1 + e2 + e3);
            my_e = TOPE[ri * 4 + k]; my_g = (k == 0 ? 1.0f : k == 1 ? e1 : k == 2 ? e2 : e3) * inv;
            my_r = DRY ? 0u : atomicAdd((unsigned*)&lcnt[my_e], 1u); }
        __syncthreads();
        if (!DRY && F.tid < 32) { const unsigned n = lcnt[F.tid]; lbase[F.tid] = n ? __hip_atomic_fetch_add(cnt + F.tid * 16, n, RLX_AGENT) : 0u; }
        __syncthreads();
        if (!DRY && lane < 32) { const int row = blk * 64 + F.wave * 8 + (lane >> 2); const unsigned slot = (unsigned)my_e * ECAP + lbase[my_e] + my_r;
            sdest[slot] = row * 4 + (lane & 3); sgate[slot] = my_g; }
        __syncthreads();
    }
}
#endif
__device__ __forceinline__ void p9_combine(Frame& F, const Args& A) {
    const bf16* x1b = WSP(bf16, WS_X1B); const bf16* yb = WSP(bf16, WS_YBUF); bf16* hb = WSP(bf16, WS_HB);
    const int gw = F.vcu * NWAVES + F.wave, NGW = F.G * NWAVES, lane = F.lane;
    for (int row = gw; row < T; row += NGW) {
        v4u y[4][2], xw[2];
#pragma unroll
        for (int j = 0; j < 2; ++j) {
#pragma unroll
            for (int k = 0; k < 4; ++k) y[k][j] = *(const v4u*)(yb + ((size_t)row * 4 + k) * D + 512 * j + 8 * lane);
            xw[j] = *(const v4u*)(x1b + (size_t)row * D + 512 * j + 8 * lane); }
#pragma unroll
        for (int j = 0; j < 2; ++j) { f32x4 v0, v1; pg8::unpack8(xw[j], v0, v1); v0 = v0 * DN_ALPHA; v1 = v1 * DN_ALPHA;
#pragma unroll
            for (int k = 0; k < 4; ++k) { f32x4 a, b; pg8::unpack8(y[k][j], a, b); v0 = v0 + a; v1 = v1 + b; }
            v4u wv; wv.x = cvt_pk_bf16(v0.x, v0.y); wv.y = cvt_pk_bf16(v0.z, v0.w); wv.z = cvt_pk_bf16(v1.x, v1.y); wv.w = cvt_pk_bf16(v1.z, v1.w); *(v4u*)(hb + (size_t)row * D + 512 * j + 8 * lane) = wv;
            if (PLE_FP8) { v2u q; q.x = cvt4_fp8(v0.x, v0.y, v0.z, v0.w); q.y = cvt4_fp8(v1.x, v1.y, v1.z, v1.w); *(v2u*)(WSP(unsigned char, WS_HQ) + (size_t)row * D + 512 * j + 8 * lane) = q; } }
    }
}
__device__ __forceinline__ void p11_ln2(Frame& F, const Args& A, int layer) {
    const bf16* h2 = WSP(bf16, WS_H2); bf16* xb = WSP(bf16, WS_XB);
    const float* g = KIN(I_LN2G) + layer * D; const float* bb = KIN(I_LN2B) + layer * D;
    const int gw = F.vcu * NWAVES + F.wave, NGW = F.G * NWAVES, lane = F.lane;
    for (int row = gw; row < T; row += NGW) {
        const bf16* yr = h2 + (size_t)row * D; f32x4 v[4]; float s = 0.f;
#pragma unroll
        for (int j = 0; j < 4; ++j) { const v2u w = *(const v2u*)(yr + 256 * j + 4 * lane); v[j] = (f32x4){__uint_as_float(w.x << 16), __uint_as_float(w.x & 0xffff0000u), __uint_as_float(w.y << 16), __uint_as_float(w.y & 0xffff0000u)}; s += (v[j].x + v[j].y) + (v[j].z + v[j].w); }
        const float mean = wave_sum(s) * (1.f / D); float s2 = 0.f;
#pragma unroll
        for (int j = 0; j < 4; ++j) { v[j] = v[j] - mean; s2 += (v[j].x * v[j].x + v[j].y * v[j].y) + (v[j].z * v[j].z + v[j].w * v[j].w); }
        const float rstd = __builtin_amdgcn_rsqf(wave_sum(s2) * (1.f / D) + LN_EPS);
#pragma unroll
        for (int j = 0; j < 4; ++j) { const f32x4 gv = *(const f32x4*)(g + 256 * j + 4 * lane), bv = *(const f32x4*)(bb + 256 * j + 4 * lane);
            const f32x4 o = v[j] * rstd * gv + bv; const size_t off = (size_t)row * D + 256 * j + 4 * lane;
            if (layer == DEPTH - 1) *(f32x4*)(F.out + off) = o; v2u w; w.x = cvt_pk_bf16(o.x, o.y); w.y = cvt_pk_bf16(o.z, o.w); *(v2u*)(xb + off) = w; }
    }
}
__device__ __forceinline__ void moe_build_pfx(Frame& F, const Args& A, int layer, int NT) {
    volatile LAS unsigned* pfx = F.MISC + MW_PFX;
    __syncthreads();
    if (F.tid < 64) {
        const int e = F.tid & 31;
        const unsigned c = __hip_atomic_load(F.ctl + CW_CNT + (layer * NE + e) * 16, RLX_AGENT);
        const unsigned un = ((c + 255u) >> 8) * (unsigned)NT; unsigned inc = un;
#pragma unroll
        for (int o = 1; o < 32; o <<= 1) { const unsigned t = (unsigned)my_shfl_up((int)inc, o); if (e >= o) inc += t; }
        if (F.tid < 32) { pfx[e] = inc - un; pfx[40 + e] = c; if (e == 31) pfx[32] = inc; }
    }
    __syncthreads();
}
#define UU(t, col) bf2f(u[(size_t)(t) * NUP + (col)])
#define UU4(t, col) ldu4(u + (size_t)(t) * NUP + (col))
__device__ __forceinline__ f32x4 ldu4(const bf16* p) { const v2u w = *(const v2u*)p; return (f32x4){__uint_as_float(w.x << 16), __uint_as_float(w.x & 0xffff0000u), __uint_as_float(w.y << 16), __uint_as_float(w.y & 0xffff0000u)}; }
__device__ __forceinline__ f32x4 ldb4(const bf16* p) { const v2u w = *(const v2u*)p; return (f32x4){__uint_as_float(w.x << 16), __uint_as_float(w.x & 0xffff0000u), __uint_as_float(w.y << 16), __uint_as_float(w.y & 0xffff0000u)}; }
__device__ __forceinline__ void stb4(bf16* p, f32x4 v) { v2u o; o.x = cvt_pk_bf16(v.x, v.y); o.y = cvt_pk_bf16(v.z, v.w); *(v2u*)p = o; }
__device__ __forceinline__ void lds_st_bf16(LAS unsigned char* p, float v) { *(LAS unsigned short*)p = (unsigned short)(cvt_pk_bf16(v, 0.f) & 0xffffu); }
__device__ __forceinline__ void lds_st_bf16x4(LAS unsigned char* p, float a, float b, float c, float d) { v2u o; o.x = cvt_pk_bf16(a, b); o.y = cvt_pk_bf16(c, d); *(LAS v2u*)p = o; }

#if OUT_FP8
#define MIX_ST4(mix, idx, a, b, c, d) (*(unsigned*)((unsigned char*)(mix) + (idx)) = cvt4_fp8(a, b, c, d))
#else
#define MIX_ST4(mix, idx, a, b, c, d) do { v2u o_; o_.x = cvt_pk_bf16(a, b); o_.y = cvt_pk_bf16(c, d); *(v2u*)((mix) + (idx)) = o_; } while (0)
#endif
__device__ __forceinline__ void ssd_stage1(Frame& F, const Args& A, int layer, int b, int c) {
    const bf16* u = WSP(bf16, WS_U);
    LAS unsigned char* L = F.lds;
    LAS float* DT = (LAS float*)L; LAS float* AC = DT + 256;
    LAS unsigned char* BMT = L + 2048; LAS unsigned char* XCDT = BMT + 128 * 144;
    const int t0 = b * SEQ + c * 64, tid = F.tid, lane = F.lane, wave = F.wave;
    if (wave < 4) {
        const int hh = wave;
        const float dt = softplusf_(UU(t0 + lane, U_SSD_DT + hh) + KIN(I_SDTB)[layer * 4 + hh]);
        const float adt = -dt * __expf(KIN(I_SALOG)[layer * 4 + hh]);
        const float ac = wave_scan_add(adt, lane);
        DT[hh * 64 + lane] = dt; AC[hh * 64 + lane] = ac;
        if (lane == 63) WSP(float, WS_SSD_DEC)[(b * 4 + hh) * NCH + c] = __expf(ac);
    }
    __syncthreads();
    if (tid < 384) {
        const int cc = tid; const float* cw = KIN(I_SCW) + (size_t)layer * 2048 + cc; const float w0 = cw[0], w1 = cw[512], w2 = cw[1024], w3 = cw[1536], cb = KIN(I_SCB)[layer * 512 + cc];
        const bf16* up = u + (size_t)t0 * NUP + U_SSD_X + cc;
        float win0 = 0.f, win1 = 0.f, win2 = 0.f;
        if (c > 0) { win0 = bf2f(up[-3 * NUP]); win1 = bf2f(up[-2 * NUP]); win2 = bf2f(up[-1 * NUP]); }
        const int hh = (cc >> 6) & 3; const bool isx = cc < 256;
        LAS unsigned char* dst = isx ? XCDT + cc * 144 : BMT + (cc - 256) * 144;
        const float aclast = AC[hh * 64 + 63];
#pragma unroll 1
        for (int l0 = 0; l0 < 64; l0 += 32) {
            float xv[32];
#pragma unroll
            for (int j = 0; j < 32; ++j) xv[j] = bf2f(up[(l0 + j) * NUP]);
#pragma unroll
            for (int j8 = 0; j8 < 4; ++j8) { float o[8];
#pragma unroll
                for (int j = 0; j < 8; ++j) { const int l = l0 + j8 * 8 + j; const float x = xv[j8 * 8 + j]; const float y = cb + w0 * win0 + w1 * win1 + w2 * win2 + w3 * x; win0 = win1; win1 = win2; win2 = x;
                    float s = siluf_(y); if (isx) s *= DT[hh * 64 + l] * __expf(aclast - AC[hh * 64 + l]); o[j] = s; }
                *(LAS v4u*)(dst + (l0 + j8 * 8) * 2) = pack8(o); }
        }
    }
    __syncthreads();
    { const int fr = lane & 15, fq = lane >> 4; bf16* st = WSP(bf16, WS_SSD_ST);
#pragma unroll 1
      for (int i = 0; i < 2; ++i) { const int row0 = (2 * wave + i) * 16; const int hh = row0 >> 6, p = (row0 & 63) + fr;
          bf16* dstp = st + (((size_t)(b * 4 + hh) * NCH + c) * 64 + p) * 128;
#pragma unroll 1
          for (int ntl = 0; ntl < 8; ++ntl) { f32x4 acc = {0.f, 0.f, 0.f, 0.f}; acc = mm16(XCDT + row0 * 144, 144, BMT + ntl * 16 * 144, 144, 64, acc, fr, fq);
              stb4(dstp + ntl * 16 + 4 * fq, acc); } } }
    __syncthreads();
}
__device__ __forceinline__ void ssd_stage3(Frame& F, const Args& A, int layer, int b, int c) {
    const bf16* u = WSP(bf16, WS_U);
    LAS unsigned char* L = F.lds;
    LAS float* DT = (LAS float*)L; LAS float* AC = DT + 256;
    LAS unsigned char* CM = L + 2048; LAS unsigned char* BM = CM + 64 * 272; LAS unsigned char* XCT = BM + 64 * 272; LAS unsigned char* MM = XCT + 256 * 144;
    LAS unsigned char* YG = XCT;
    const int t0 = b * SEQ + c * 64, tid = F.tid, lane = F.lane, wave = F.wave, fr = lane & 15, fq = lane >> 4;
    if (wave < 4) {
        const int hh = wave;
        const float dt = softplusf_(UU(t0 + lane, U_SSD_DT + hh) + KIN(I_SDTB)[layer * 4 + hh]);
        const float adt = -dt * __expf(KIN(I_SALOG)[layer * 4 + hh]);
        DT[hh * 64 + lane] = dt; AC[hh * 64 + lane] = wave_scan_add(adt, lane);
    }
    __syncthreads();
    {
        const int cc = tid; const float* cw = KIN(I_SCW) + (size_t)layer * 2048 + cc; const float w0 = cw[0], w1 = cw[512], w2 = cw[1024], w3 = cw[1536], cb = KIN(I_SCB)[layer * 512 + cc];
        const bf16* up = u + (size_t)t0 * NUP + U_SSD_X + cc;
        float win0 = 0.f, win1 = 0.f, win2 = 0.f;
        if (c > 0) { win0 = bf2f(up[-3 * NUP]); win1 = bf2f(up[-2 * NUP]); win2 = bf2f(up[-1 * NUP]); }
        const int hh = (cc >> 6) & 3;
#pragma unroll 1
        for (int l0 = 0; l0 < 64; l0 += 32) {
            float xv[32];
#pragma unroll
            for (int j = 0; j < 32; ++j) xv[j] = bf2f(up[(l0 + j) * NUP]);
#pragma unroll
            for (int j8 = 0; j8 < 4; ++j8) { float o[8];
#pragma unroll
                for (int j = 0; j < 8; ++j) { const int l = l0 + j8 * 8 + j; const float x = xv[j8 * 8 + j]; const float y = cb + w0 * win0 + w1 * win1 + w2 * win2 + w3 * x; win0 = win1; win1 = win2; win2 = x;
                    float s = siluf_(y); if (cc < 256) s *= DT[hh * 64 + l]; o[j] = s; }
                if (cc < 256) *(LAS v4u*)(XCT + cc * 144 + (l0 + j8 * 8) * 2) = pack8(o);
                else { LAS unsigned char* d2 = (cc < 384 ? BM + (cc - 256) * 2 : CM + (cc - 384) * 2) + (l0 + j8 * 8) * 272;
#pragma unroll
                    for (int j = 0; j < 8; ++j) lds_st_bf16(d2 + j * 272, o[j]); } }
        }
    }
    __syncthreads();
#pragma unroll 1
    for (int i = 0; i < 2; ++i) { const int idx = 2 * wave + i, lt = idx >> 2, st = idx & 3;
        f32x4 acc = {0.f, 0.f, 0.f, 0.f}; acc = mm16(CM + lt * 16 * 272, 272, BM + st * 16 * 272, 272, 128, acc, fr, fq);
        const int l = lt * 16 + fr, s0 = st * 16 + 4 * fq;
#pragma unroll
        for (int hh = 0; hh < 4; ++hh) { const float al = AC[hh * 64 + l], dl = KIN(I_SD)[layer * 4 + hh] / DT[hh * 64 + l]; float o[4];
#pragma unroll
            for (int j = 0; j < 4; ++j) { const int s = s0 + j; float m = (l >= s) ? acc[j] * __expf(al - AC[hh * 64 + s]) : 0.f; if (l == s) m += dl; o[j] = m; }
            lds_st_bf16x4(MM + hh * 9216 + l * 144 + s0 * 2, o[0], o[1], o[2], o[3]); } }
    __syncthreads();
    f32x4 yv[2][4];
    { const int hh = wave >> 1; const bf16* prev = WSP(bf16, WS_SSD_ST) + ((size_t)(b * 4 + hh) * NCH + c) * 8192;
      bf16x8 pf[4][4];
#pragma unroll
      for (int pt = 0; pt < 4; ++pt)
#pragma unroll
          for (int ks = 0; ks < 4; ++ks) pf[pt][ks] = *(const bf16x8*)(prev + (size_t)(pt * 16 + fr) * 128 + ks * 32 + fq * 8);
#pragma unroll
      for (int i = 0; i < 2; ++i) { const int lt = 2 * (wave & 1) + i, l = lt * 16 + fr; const float ea = __expf(AC[hh * 64 + l]);
#pragma unroll
          for (int pt = 0; pt < 4; ++pt) { f32x4 ad = {0.f, 0.f, 0.f, 0.f}, ao = {0.f, 0.f, 0.f, 0.f};
              ad = mm16(MM + hh * 9216 + lt * 16 * 144, 144, XCT + (hh * 64 + pt * 16) * 144, 144, 64, ad, fr, fq);
              ao = mm16_rB<4>(CM + lt * 16 * 272, 272, pf[pt], ao, fr, fq);
              const f32x4 z = UU4(t0 + l, U_SSD_Z + hh * 64 + pt * 16 + 4 * fq);
              f32x4 y = ad + ao * ea; y.x *= siluf_(z.x); y.y *= siluf_(z.y); y.z *= siluf_(z.z); y.w *= siluf_(z.w); yv[i][pt] = y; } } }
    __syncthreads();
    { const int hh = wave >> 1;
#pragma unroll
      for (int i = 0; i < 2; ++i) { const int l = (2 * (wave & 1) + i) * 16 + fr;
#pragma unroll
          for (int pt = 0; pt < 4; ++pt) *(LAS f32x4*)(YG + l * 1040 + (hh * 64 + pt * 16 + 4 * fq) * 4) = yv[i][pt]; } }
    __syncthreads();
    { const f32x4 g = *(const f32x4*)(KIN(I_SNG) + layer * 256 + 4 * lane); bf16* mix = WSP(bf16, WS_MIX);
#pragma unroll 1
      for (int i = 0; i < 8; ++i) { const int l = wave * 8 + i; const f32x4 y = *(const LAS f32x4*)(YG + l * 1040 + lane * 16);
          const float ss = wave_sum((y.x * y.x + y.y * y.y) + (y.z * y.z + y.w * y.w)); const float r = __builtin_amdgcn_rsqf(ss * (1.f / 256.f) + NORM_EPS);
          MIX_ST4(mix, (size_t)(t0 + l) * D + 4 * lane, y.x * r * g.x, y.y * r * g.y, y.z * r * g.z, y.w * r * g.w); } }
    __syncthreads();
}

__device__ __forceinline__ void gla_bcum_all(Frame& F, const Args& A, int layer, const LAS float* GD, LAS float* BC) {
    const int d = F.tid & 127, lq = F.tid >> 7;
    float gup[16];
    { const f32x4* gp4 = (const f32x4*)(WSP(float, WS_LORA) + (size_t)layer * LORA_PER_LAYER + 32768 + d * 16);
#pragma unroll
      for (int i = 0; i < 4; ++i) { const f32x4 a = gp4[i]; gup[4 * i] = a.x; gup[4 * i + 1] = a.y; gup[4 * i + 2] = a.z; gup[4 * i + 3] = a.w; } }
    const float gb = KIN(I_GGB)[layer * 128 + d];
#pragma unroll 4
    for (int li = 0; li < 16; ++li) { const int l = lq * 16 + li; float x = gb;
#pragma unroll
        for (int i = 0; i < 4; ++i) { const f32x4 g4 = *(const LAS f32x4*)(GD + l * 16 + 4 * i); x += (g4.x * gup[4 * i] + g4.y * gup[4 * i + 1]) + (g4.z * gup[4 * i + 2] + g4.w * gup[4 * i + 3]); }
        BC[l * 128 + d] = logsigmoidf_(x) * 0.0625f; }
    __syncthreads();
    if (F.tid < 128) { float run = 0.f;
#pragma unroll 1
        for (int l0 = 0; l0 < 64; l0 += 16) { float v[16];
#pragma unroll
            for (int j = 0; j < 16; ++j) v[j] = BC[(l0 + j) * 128 + d];
#pragma unroll
            for (int j = 0; j < 16; ++j) { run += v[j]; BC[(l0 + j) * 128 + d] = run; } } }
}
__device__ __forceinline__ void gla_stage1(Frame& F, const Args& A, int layer, int b, int c) {
    const bf16* u = WSP(bf16, WS_U);
    LAS unsigned char* L = F.lds;
    LAS float* GD = (LAS float*)L; LAS float* BC = (LAS float*)(L + 4096);
    LAS unsigned char* KDT = L + 36864; LAS unsigned char* VT = KDT + 128 * 144;
    const int t0 = b * SEQ + c * 64, tid = F.tid, lane = F.lane, wave = F.wave, fr = lane & 15, fq = lane >> 4;
    if (tid < 256) { const int l = tid >> 2, q4 = tid & 3; *(LAS f32x4*)(GD + l * 16 + q4 * 4) = UU4(t0 + l, U_GL_G + 4 * q4); }
    __syncthreads();
    gla_bcum_all(F, A, layer, GD, BC);
    if (tid < 128) {
        const int d = tid; const float blast = BC[63 * 128 + d];
        WSP(float, WS_GLA_DEC)[(size_t)(b * NCH + c) * 128 + d] = __expf(blast);
        const bf16* up = u + (size_t)t0 * NUP + U_GL_K + d;
#pragma unroll 1
        for (int l0 = 0; l0 < 64; l0 += 32) { float xv[32];
#pragma unroll
            for (int j = 0; j < 32; ++j) xv[j] = bf2f(up[(l0 + j) * NUP]);
#pragma unroll
            for (int j8 = 0; j8 < 4; ++j8) { float o[8];
#pragma unroll
                for (int j = 0; j < 8; ++j) { const int l = l0 + j8 * 8 + j; o[j] = xv[j8 * 8 + j] * __expf(blast - BC[l * 128 + d]); }
                *(LAS v4u*)(KDT + d * 144 + (l0 + j8 * 8) * 2) = pack8(o); } }
    } else if (tid < 384) {
        const int vch = tid - 128; const bf16* up = u + (size_t)t0 * NUP + U_GL_V + vch;
#pragma unroll 1
        for (int l0 = 0; l0 < 64; l0 += 32) { float xv[32];
#pragma unroll
            for (int j = 0; j < 32; ++j) xv[j] = bf2f(up[(l0 + j) * NUP]);
#pragma unroll
            for (int j8 = 0; j8 < 4; ++j8) { float o[8];
#pragma unroll
                for (int j = 0; j < 8; ++j) o[j] = xv[j8 * 8 + j];
                *(LAS v4u*)(VT + vch * 144 + (l0 + j8 * 8) * 2) = pack8(o); } }
    }
    __syncthreads();
    { bf16* st = WSP(bf16, WS_GLA_ST);
#pragma unroll 1
      for (int i = 0; i < 4; ++i) { const int idx = 4 * wave + i, hh = idx >> 3, dtl = (idx >> 2) & 1, vt = idx & 3;
          f32x4 acc = {0.f, 0.f, 0.f, 0.f}; acc = mm16(KDT + (hh * 32 + dtl * 16) * 144, 144, VT + (hh * 64 + vt * 16) * 144, 144, 64, acc, fr, fq);
          stb4(st + (((size_t)(b * 4 + hh) * NCH + c) * 32 + dtl * 16 + fr) * 64 + vt * 16 + 4 * fq, acc); } }
    __syncthreads();
}
__device__ __forceinline__ void gla_stage3(Frame& F, const Args& A, int layer, int b, int c) {
    const bf16* u = WSP(bf16, WS_U);
    LAS unsigned char* L = F.lds;
    LAS float* GD = (LAS float*)L; LAS float* BC = (LAS float*)(L + 4096); LAS unsigned char* ATT = L + 4096;
    LAS unsigned char* QD = L + 40960; LAS unsigned char* KI = QD + 64 * 272; LAS unsigned char* VT = KI + 64 * 272; LAS unsigned char* PVT = VT + 256 * 144;
    const int t0 = b * SEQ + c * 64, tid = F.tid, lane = F.lane, wave = F.wave, fr = lane & 15, fq = lane >> 4;
    if (tid < 256) { const int l = tid >> 2, q4 = tid & 3; *(LAS f32x4*)(GD + l * 16 + q4 * 4) = UU4(t0 + l, U_GL_G + 4 * q4); }
    __syncthreads();
    gla_bcum_all(F, A, layer, GD, BC);
    if (tid < 128) {
        const int d = tid;
        const bf16* uq = u + (size_t)t0 * NUP + U_GL_Q + d; const bf16* uk = u + (size_t)t0 * NUP + U_GL_K + d;
#pragma unroll 1
        for (int l0 = 0; l0 < 64; l0 += 16) { float qv[16], kv[16];
#pragma unroll
            for (int j = 0; j < 16; ++j) { qv[j] = bf2f(uq[(l0 + j) * NUP]); kv[j] = bf2f(uk[(l0 + j) * NUP]); }
#pragma unroll
            for (int j = 0; j < 16; ++j) { const int l = l0 + j; const float bc = BC[l * 128 + d];
                lds_st_bf16(QD + l * 272 + d * 2, qv[j] * 0.17677669529663687f * __expf(bc)); lds_st_bf16(KI + l * 272 + d * 2, kv[j] * __expf(-bc)); } }
    } else if (tid < 384) {
        const int vch = tid - 128; const bf16* up = u + (size_t)t0 * NUP + U_GL_V + vch;
#pragma unroll 1
        for (int l0 = 0; l0 < 64; l0 += 32) { float xv[32];
#pragma unroll
            for (int j = 0; j < 32; ++j) xv[j] = bf2f(up[(l0 + j) * NUP]);
#pragma unroll
            for (int j8 = 0; j8 < 4; ++j8) { float o[8];
#pragma unroll
                for (int j = 0; j < 8; ++j) o[j] = xv[j8 * 8 + j];
                *(LAS v4u*)(VT + vch * 144 + (l0 + j8 * 8) * 2) = pack8(o); } }
    } else {
        const bf16* prev = WSP(bf16, WS_GLA_ST);
#pragma unroll 4
        for (int i = tid - 384; i < 8192; i += 128) { const int hh = i >> 11, dd = (i >> 6) & 31, vv = i & 63;
            *(LAS unsigned short*)(PVT + (hh * 64 + vv) * 80 + dd * 2) = prev[((size_t)(b * 4 + hh) * NCH + c) * 2048 + dd * 64 + vv]; }
    }
    __syncthreads();
    const int hh = wave >> 1;
#pragma unroll 1
    for (int i = 0; i < 2; ++i) { const int tt = 2 * (wave & 1) + i, t = tt * 16 + fr;
#pragma unroll
        for (int st = 0; st < 4; ++st) { f32x4 acc = {0.f, 0.f, 0.f, 0.f}; acc = mm16(QD + tt * 16 * 272 + hh * 64, 272, KI + st * 16 * 272 + hh * 64, 272, 32, acc, fr, fq);
            const int s0 = st * 16 + 4 * fq;
            lds_st_bf16x4(ATT + hh * 9216 + t * 144 + s0 * 2, t >= s0 ? acc[0] : 0.f, t >= s0 + 1 ? acc[1] : 0.f, t >= s0 + 2 ? acc[2] : 0.f, t >= s0 + 3 ? acc[3] : 0.f); } }
    __syncthreads();
    { bf16* mix = WSP(bf16, WS_MIX); const float* ng = KIN(I_GNG) + layer * 256;
#pragma unroll 1
      for (int i = 0; i < 2; ++i) { const int tt = 2 * (wave & 1) + i, t = tt * 16 + fr; f32x4 ov[4]; float ss = 0.f;
#pragma unroll
          for (int vt = 0; vt < 4; ++vt) { f32x4 acc = {0.f, 0.f, 0.f, 0.f};
              acc = mm16(ATT + hh * 9216 + tt * 16 * 144, 144, VT + (hh * 64 + vt * 16) * 144, 144, 64, acc, fr, fq);
              acc = mm16(QD + tt * 16 * 272 + hh * 64, 272, PVT + (hh * 64 + vt * 16) * 80, 80, 32, acc, fr, fq);
              ov[vt] = acc; ss += (acc.x * acc.x + acc.y * acc.y) + (acc.z * acc.z + acc.w * acc.w); }
          ss += __shfl_xor(ss, 16); ss += __shfl_xor(ss, 32);
          const float r = __builtin_amdgcn_rsqf(ss * (1.f / 64.f) + NORM_EPS);
#pragma unroll
          for (int vt = 0; vt < 4; ++vt) { const int col = hh * 64 + vt * 16 + 4 * fq; const f32x4 g = *(const f32x4*)(ng + col); const f32x4 og = UU4(t0 + t, U_GL_OG + col);
              MIX_ST4(mix, (size_t)(t0 + t) * D + 512 + col, ov[vt].x * r * g.x * siluf_(og.x), ov[vt].y * r * g.y * siluf_(og.y), ov[vt].z * r * g.z * siluf_(og.z), ov[vt].w * r * g.w * siluf_(og.w)); } } }
    __syncthreads();
}

__device__ __forceinline__ void mlstm_stage1(Frame& F, const Args& A, int layer, int b, int c) {
    const bf16* u = WSP(bf16, WS_U);
    LAS unsigned char* L = F.lds;
    LAS float* WST = (LAS float*)L; LAS unsigned char* KT = L + 1024; LAS unsigned char* VWT = KT + 256 * 144;
    const int t0 = b * SEQ + c * 64, tid = F.tid, lane = F.lane, wave = F.wave, fr = lane & 15, fq = lane >> 4;
    if (wave < 4) {
        const int hh = wave;
        const float ig = UU(t0 + lane, U_ML_I + hh) + KIN(I_MIB)[layer * 4 + hh];
        const float lf = logsigmoidf_(UU(t0 + lane, U_ML_F + hh) + KIN(I_MFB)[layer * 4 + hh]);
        const float bc = wave_scan_add(lf, lane); const float blast = __shfl(bc, 63);
        const float ast = blast - bc + ig; const float mloc = wave_max(ast);
        WST[hh * 64 + lane] = __expf(ast - mloc);
        if (lane == 0) { WSP(float, WS_ML_BL)[(b * 4 + hh) * NCH + c] = blast; WSP(float, WS_ML_ML)[(b * 4 + hh) * NCH + c] = mloc; }
    } else {
        const int kch = tid - 256, cc = 256 + kch; const float* cw = KIN(I_MCW) + (size_t)layer * 2048 + cc; const float w0 = cw[0], w1 = cw[512], w2 = cw[1024], w3 = cw[1536], cb = KIN(I_MCB)[layer * 512 + cc];
        const bf16* up = u + (size_t)t0 * NUP + U_ML_K + kch;
        float win0 = 0.f, win1 = 0.f, win2 = 0.f;
        if (c > 0) { win0 = bf2f(up[-3 * NUP]); win1 = bf2f(up[-2 * NUP]); win2 = bf2f(up[-1 * NUP]); }
#pragma unroll 1
        for (int l0 = 0; l0 < 64; l0 += 32) { float xv[32];
#pragma unroll
            for (int j = 0; j < 32; ++j) xv[j] = bf2f(up[(l0 + j) * NUP]);
#pragma unroll
            for (int j8 = 0; j8 < 4; ++j8) { float o[8];
#pragma unroll
                for (int j = 0; j < 8; ++j) { const float x = xv[j8 * 8 + j]; const float y = cb + w0 * win0 + w1 * win1 + w2 * win2 + w3 * x; win0 = win1; win1 = win2; win2 = x; o[j] = siluf_(y); }
                *(LAS v4u*)(KT + kch * 144 + (l0 + j8 * 8) * 2) = pack8(o); } }
    }
    __syncthreads();
    if (tid < 256) {
        const int vch = tid, hh = vch >> 6; const bf16* up = u + (size_t)t0 * NUP + U_ML_V + vch;
#pragma unroll 1
        for (int l0 = 0; l0 < 64; l0 += 32) { float xv[32];
#pragma unroll
            for (int j = 0; j < 32; ++j) xv[j] = bf2f(up[(l0 + j) * NUP]);
#pragma unroll
            for (int j8 = 0; j8 < 4; ++j8) { float o[8];
#pragma unroll
                for (int j = 0; j < 8; ++j) o[j] = xv[j8 * 8 + j] * WST[hh * 64 + l0 + j8 * 8 + j];
                *(LAS v4u*)(VWT + vch * 144 + (l0 + j8 * 8) * 2) = pack8(o); } }
    } else {
        const int kch = tid - 256, hh = kch >> 6; float n = 0.f;
#pragma unroll 8
        for (int s = 0; s < 64; ++s) n += WST[hh * 64 + s] * bf2f(*(const LAS unsigned short*)(KT + kch * 144 + s * 2));
        WSP(bf16, WS_ML_N)[((size_t)(b * 4 + hh) * NCH + c) * 64 + (kch & 63)] = (bf16)(cvt_pk_bf16(n, 0.f) & 0xffffu);
    }
    __syncthreads();
    { bf16* cst = WSP(bf16, WS_ML_C); const int hh = wave >> 1;
#pragma unroll 1
      for (int i = 0; i < 2; ++i) { const int vt = 2 * (wave & 1) + i;
#pragma unroll 1
          for (int kt = 0; kt < 4; ++kt) { f32x4 acc = {0.f, 0.f, 0.f, 0.f}; acc = mm16(VWT + (hh * 64 + vt * 16) * 144, 144, KT + (hh * 64 + kt * 16) * 144, 144, 64, acc, fr, fq);
              stb4(cst + (((size_t)(b * 4 + hh) * NCH + c) * 64 + vt * 16 + fr) * 64 + kt * 16 + 4 * fq, acc); } } }
    __syncthreads();
}
__device__ __forceinline__ void mlstm_stage3(Frame& F, const Args& A, int layer, int b, int c) {
    const bf16* u = WSP(bf16, WS_U);
    LAS unsigned char* L = F.lds;
    LAS float* BCU = (LAS float*)L; LAS float* GG = BCU + 256; LAS float* MROW = BCU + 512; LAS float* WINT = BCU + 768; LAS float* NPV = BCU + 1024;
    LAS unsigned char* Q = L + 6144; LAS unsigned char* KK = Q + 64 * 528; LAS unsigned char* VT = KK + 64 * 528; LAS unsigned char* SC = VT + 256 * 144;
    const int t0 = b * SEQ + c * 64, tid = F.tid, lane = F.lane, wave = F.wave, fr = lane & 15, fq = lane >> 4;
    if (wave < 4) {
        const int hh = wave;
        const float ig = UU(t0 + lane, U_ML_I + hh) + KIN(I_MIB)[layer * 4 + hh];
        const float lf = logsigmoidf_(UU(t0 + lane, U_ML_F + hh) + KIN(I_MFB)[layer * 4 + hh]);
        const float bc = wave_scan_add(lf, lane); const float gg = ig - bc;
        const float mprev = WSP(float, WS_ML_M)[(b * 4 + hh) * NCH + c];
        const float minter = bc + mprev, mintra = bc + wave_scan_max(gg, lane), mrow = fmaxf(minter, mintra);
        BCU[hh * 64 + lane] = bc; GG[hh * 64 + lane] = gg; MROW[hh * 64 + lane] = mrow; WINT[hh * 64 + lane] = __expf(minter - mrow);
        NPV[hh * 64 + lane] = bf2f(WSP(bf16, WS_ML_N)[((size_t)(b * 4 + hh) * NCH + c) * 64 + lane]);
    }
    {
        const int cc = tid; const float* cw = KIN(I_MCW) + (size_t)layer * 2048 + cc; const float w0 = cw[0], w1 = cw[512], w2 = cw[1024], w3 = cw[1536], cb = KIN(I_MCB)[layer * 512 + cc];
        const bf16* up = u + (size_t)t0 * NUP + U_ML_Q + cc;
        float win0 = 0.f, win1 = 0.f, win2 = 0.f;
        if (c > 0) { win0 = bf2f(up[-3 * NUP]); win1 = bf2f(up[-2 * NUP]); win2 = bf2f(up[-1 * NUP]); }
        LAS unsigned char* dst = cc < 256 ? Q + cc * 2 : KK + (cc - 256) * 2; const float sc = cc < 256 ? 0.125f : 1.0f;
#pragma unroll 1
        for (int l0 = 0; l0 < 64; l0 += 32) { float xv[32];
#pragma unroll
            for (int j = 0; j < 32; ++j) xv[j] = bf2f(up[(l0 + j) * NUP]);
#pragma unroll
            for (int j = 0; j < 32; ++j) { const float x = xv[j]; const float y = cb + w0 * win0 + w1 * win1 + w2 * win2 + w3 * x; win0 = win1; win1 = win2; win2 = x; lds_st_bf16(dst + (l0 + j) * 528, siluf_(y) * sc); } }
        const int vch = tid & 255, lh = (tid >> 8) * 32; const bf16* uv = u + (size_t)(t0 + lh) * NUP + U_ML_V + vch;
        float xv[32];
#pragma unroll
        for (int j = 0; j < 32; ++j) xv[j] = bf2f(uv[j * NUP]);
#pragma unroll
        for (int j8 = 0; j8 < 4; ++j8) { float o[8];
#pragma unroll
            for (int j = 0; j < 8; ++j) o[j] = xv[j8 * 8 + j];
            *(LAS v4u*)(VT + vch * 144 + (lh + j8 * 8) * 2) = pack8(o); }
    }
    __syncthreads();
    { const int hh = wave >> 1; bf16* mix = WSP(bf16, WS_MIX); const float* ng = KIN(I_MNG) + layer * 256;
      const bf16* cprev = WSP(bf16, WS_ML_C) + ((size_t)(b * 4 + hh) * NCH + c) * 4096;
      bf16x8 cf[4][2];
#pragma unroll
      for (int vt = 0; vt < 4; ++vt)
#pragma unroll
          for (int ks = 0; ks < 2; ++ks) cf[vt][ks] = *(const bf16x8*)(cprev + (size_t)(vt * 16 + fr) * 64 + ks * 32 + fq * 8);
#pragma unroll 1
      for (int i = 0; i < 2; ++i) { const int tt = 2 * (wave & 1) + i, t = tt * 16 + fr;
          const float bt = BCU[hh * 64 + t] - MROW[hh * 64 + t]; float rs = 0.f;
#pragma unroll
          for (int st = 0; st < 4; ++st) { f32x4 acc = {0.f, 0.f, 0.f, 0.f}; acc = mm16(Q + tt * 16 * 528 + hh * 128, 528, KK + st * 16 * 528 + hh * 128, 528, 64, acc, fr, fq);
              const int s0 = st * 16 + 4 * fq; float o[4];
#pragma unroll
              for (int j = 0; j < 4; ++j) { const int s = s0 + j; const float v = (t >= s) ? acc[j] * __expf(bt + GG[hh * 64 + s]) : 0.f; o[j] = v; rs += v; }
              lds_st_bf16x4(SC + hh * 9216 + t * 144 + s0 * 2, o[0], o[1], o[2], o[3]); }
          rs += __shfl_xor(rs, 16); rs += __shfl_xor(rs, 32);
          float nq = 0.f;
#pragma unroll
          for (int j = 0; j < 16; ++j) nq += bf2f(*(const LAS unsigned short*)(Q + t * 528 + (hh * 64 + fq * 16 + j) * 2)) * NPV[hh * 64 + fq * 16 + j];
          nq += __shfl_xor(nq, 16); nq += __shfl_xor(nq, 32);
          const float wi = WINT[hh * 64 + t]; const float den = wi * nq + rs; const float dn = fmaxf(fabsf(den), __expf(-MROW[hh * 64 + t])); const float rdn = 1.0f / dn;
          LDS_WAIT();
          f32x4 hv[4]; float sm = 0.f;
#pragma unroll
          for (int vt = 0; vt < 4; ++vt) { f32x4 acc = {0.f, 0.f, 0.f, 0.f};
              acc = mm16_rB<2>(Q + tt * 16 * 528 + hh * 128, 528, cf[vt], acc, fr, fq);
              acc = acc * wi;
              acc = mm16(SC + hh * 9216 + tt * 16 * 144, 144, VT + (hh * 64 + vt * 16) * 144, 144, 64, acc, fr, fq);
              const f32x4 og = UU4(t0 + t, U_ML_O + hh * 64 + vt * 16 + 4 * fq);
              f32x4 h; h.x = acc.x * rdn * sigmoidf_(og.x); h.y = acc.y * rdn * sigmoidf_(og.y); h.z = acc.z * rdn * sigmoidf_(og.z); h.w = acc.w * rdn * sigmoidf_(og.w);
              hv[vt] = h; sm += (h.x + h.y) + (h.z + h.w); }
          sm += __shfl_xor(sm, 16); sm += __shfl_xor(sm, 32);
          const float mean = sm * (1.f / 64.f); float sq = 0.f;
#pragma unroll
          for (int vt = 0; vt < 4; ++vt) { hv[vt] = hv[vt] - mean; sq += (hv[vt].x * hv[vt].x + hv[vt].y * hv[vt].y) + (hv[vt].z * hv[vt].z + hv[vt].w * hv[vt].w); }
          sq += __shfl_xor(sq, 16); sq += __shfl_xor(sq, 32);
          const float r = __builtin_amdgcn_rsqf(sq * (1.f / 64.f) + NORM_EPS);
#pragma unroll
          for (int vt = 0; vt < 4; ++vt) { const int col = hh * 64 + vt * 16 + 4 * fq; const f32x4 g = *(const f32x4*)(ng + col);
              MIX_ST4(mix, (size_t)(t0 + t) * D + 768 + col, hv[vt].x * r * g.x, hv[vt].y * r * g.y, hv[vt].z * r * g.z, hv[vt].w * r * g.w); } } }
    __syncthreads();
}

__device__ __forceinline__ void rwkv_stage1(Frame& F, const Args& A, int layer, int ub) {
    const bf16* u = WSP(bf16, WS_U);
    LAS unsigned char* L = F.lds;
    LAS unsigned char* LOWA = L;
    LAS float* CUM = (LAS float*)(L + 16384);
    LAS float* AAB = CUM;
    LAS float* TOT = CUM;
    LAS unsigned char* M0 = L + 16384 + 16640;
#define RM(i) (M0 + (i) * 9216)
    LAS float* GAMC = (LAS float*)(F.MISC + MW_GAMC);
    const int t0 = ub * 64, c = ub & 63, tid = F.tid, lane = F.lane, wave = F.wave;
    const float* mu = KIN(I_RMU) + layer * 896;
#ifndef RW_DUP
#define RW_DUP -1
#endif
#define RW_REP(k) for (int rep__ = 0; rep__ < ((RW_DUP == (k)) ? 2 : 1); ++rep__)
    RW_REP(0) {
    {
        const int l = tid >> 3, jq = tid & 7, t = t0 + l; const bool has_prev = (t & (SEQ - 1)) != 0;
        f32x4 cur[4], prv[4];
#pragma unroll
        for (int q = 0; q < 4; ++q) { cur[q] = UU4(t, U_RW_LO + jq * 16 + 4 * q); prv[q] = has_prev ? UU4(t - 1, U_RW_LO + jq * 16 + 4 * q) : (f32x4){0.f, 0.f, 0.f, 0.f}; }
#pragma unroll
        for (int q = 0; q < 4; ++q) { const f32x4 m4 = *(const f32x4*)(mu + 768 + jq * 16 + 4 * q); const f32x4 xs = cur[q] + (prv[q] - cur[q]) * m4; const int j = jq * 16 + 4 * q;
            f32x4 o;
            if (j < 32) { o.x = tanhf_(xs.x); o.y = tanhf_(xs.y); o.z = tanhf_(xs.z); o.w = tanhf_(xs.w); } else if (j < 64) o = xs; else { o.x = sigmoidf_(xs.x); o.y = sigmoidf_(xs.y); o.z = sigmoidf_(xs.z); o.w = sigmoidf_(xs.w); }
            if (j < 64) lds_st_bf16x4(LOWA + l * 144 + j * 2, o.x, o.y, o.z, o.w); else lds_st_bf16x4(RM(0) + l * 144 + (j - 64) * 2, o.x, o.y, o.z, o.w); }
    }
    __syncthreads();
    {
        bf16* RG = WSP(bf16, WS_RW_G); const int lane_ = F.lane, fr_ = lane_ & 15, fq_ = lane_ >> 4;
        const float* gupT = WSP(float, WS_LORA) + (size_t)layer * LORA_PER_LAYER + 16384;
#pragma unroll
        for (int ci = 0; ci < 2; ++ci) { const int ct = 2 * wave + ci; bf16x8 bf[2];
#pragma unroll
            for (int ks = 0; ks < 2; ++ks) bf[ks] = ldfrag_f32(gupT + (size_t)(ct * 16 + fr_) * 64 + ks * 32 + fq_ * 8);
#pragma unroll
            for (int tt = 0; tt < 4; ++tt) { f32x4 acc = {0.f, 0.f, 0.f, 0.f}; acc = mm16_rB<2>(RM(0) + tt * 16 * 144, 144, bf, acc, fr_, fq_);
                stb4(RG + (size_t)(t0 + tt * 16 + fr_) * 256 + ct * 16 + 4 * fq_, acc); } }
    }
    __syncthreads();
    }
    const int b_ = ub >> 6;
#pragma unroll 1
    for (int hh = 0; hh < 4; ++hh) {
        int ch = lane, fr = lane & 15, fq = lane >> 4; asm volatile("" : "+v"(ch), "+v"(fr), "+v"(fq));
        const int tg = wave, cg = hh * 64 + ch; const size_t un = (size_t)(b_ * 4 + hh) * NCH + c;
        float rr[8], k2r[8], vr[8], ar[8], br[8], pl[8];
        LAS float* WPA = (LAS float*)RM(8);
        {
            const int mat = wave >> 2, ct = wave & 3;
            const float* wT = WSP(float, WS_LORA) + (size_t)layer * LORA_PER_LAYER + mat * 8192 + (size_t)(hh * 64 + ct * 16 + fr) * 32 + fq * 8;
            bf16x8 bfw[1]; bfw[0] = ldfrag_f32(wT);
#pragma unroll
            for (int tt = 0; tt < 4; ++tt) { f32x4 acc = {0.f, 0.f, 0.f, 0.f}; acc = mm16_rB<1>(LOWA + tt * 16 * 144 + mat * 64, 144, bfw, acc, fr, fq);
                *(LAS f32x4*)(WPA + mat * 4096 + (tt * 16 + fr) * 64 + ct * 16 + 4 * fq) = acc; }
        }
        __syncthreads();
        RW_REP(1) {
            const float w0 = KIN(I_RW0)[layer * 256 + cg], a0 = KIN(I_RA0)[layer * 256 + cg], kkc = KIN(I_RKK)[layer * 256 + cg], kac = KIN(I_RKA)[layer * 256 + cg];
            const float mur = mu[cg], muk = mu[256 + cg], muv = mu[512 + cg];
            const int tb = t0 + tg * 8; const bool nop = (c == 0) && (tg == 0);
            float rp = nop ? 0.f : UU(tb - 1, U_RW_R + cg), kp = nop ? 0.f : UU(tb - 1, U_RW_K + cg), vp = nop ? 0.f : UU(tb - 1, U_RW_V + cg);
            float rc[8], kc[8], vc[8];
#pragma unroll
            for (int j = 0; j < 8; ++j) { rc[j] = UU(tb + j, U_RW_R + cg); kc[j] = UU(tb + j, U_RW_K + cg); vc[j] = UU(tb + j, U_RW_V + cg); }
            bf16* RW = WSP(bf16, WS_RW);
            float kk[8], al[8], n2[8], run = 0.f;
#pragma unroll
            for (int j = 0; j < 8; ++j) { const int l = tg * 8 + j;
                const float r = rc[j] + (rp - rc[j]) * mur, k = kc[j] + (kp - kc[j]) * muk, v = vc[j] + (vp - vc[j]) * muv; rp = rc[j]; kp = kc[j]; vp = vc[j];
                const float wp = w0 + WPA[l * 64 + ch], ap = a0 + WPA[4096 + l * 64 + ch];
                const float w = -softplusf_(-wp) - 0.5f; run += -__expf(w); pl[j] = run; al[j] = sigmoidf_(ap);
                kk[j] = k * kkc; n2[j] = kk[j] * kk[j];
                k2r[j] = k * (1.0f + (al[j] - 1.0f) * kac); rr[j] = r; vr[j] = v;
                bf16* o = RW + (size_t)(tb + j) * 768 + cg; o[0] = (bf16)(cvt_pk_bf16(r, 0.f) & 0xffffu); o[256] = (bf16)(cvt_pk_bf16(k2r[j], 0.f) & 0xffffu); o[512] = (bf16)(cvt_pk_bf16(v, 0.f) & 0xffffu); }
#pragma unroll
            for (int i = 0; i < 4; ++i) { const bool hi = (ch & 32) != 0; const float keep = hi ? n2[i + 4] : n2[i], send = hi ? n2[i] : n2[i + 4]; n2[i] = keep + __shfl_xor(send, 32); }
#pragma unroll
            for (int i = 0; i < 2; ++i) { const bool hi = (ch & 16) != 0; const float keep = hi ? n2[i + 2] : n2[i], send = hi ? n2[i] : n2[i + 2]; n2[i] = keep + __shfl_xor(send, 16); }
            { const bool hi = (ch & 8) != 0; const float keep = hi ? n2[1] : n2[0], send = hi ? n2[0] : n2[1]; n2[0] = keep + __shfl_xor(send, 8); }
            n2[0] += __shfl_xor(n2[0], 4); n2[0] += __shfl_xor(n2[0], 2); n2[0] += __shfl_xor(n2[0], 1);
#pragma unroll
            for (int j = 0; j < 8; ++j) { const float tot = __builtin_bit_cast(float, __builtin_amdgcn_readlane(__builtin_bit_cast(int, n2[0]), ((j & 4) ? 32 : 0) + ((j & 2) ? 16 : 0) + ((j & 1) ? 8 : 0)));
                const float kkn = kk[j] / fmaxf(sqrtf(tot), 1e-12f); ar[j] = -kkn; br[j] = kkn * al[j]; }
            TOT[tg * 64 + ch] = run;
        }
        __syncthreads();
        RW_REP(3) {
            float off = 0.f, gC = 0.f;
#pragma unroll
            for (int g = 0; g < 8; ++g) { const float tv = TOT[g * 64 + ch]; gC += tv; if (g < tg) off += tv; }
            float oat[8], obb[8], okb[8], ov[8];
#pragma unroll
            for (int j = 0; j < 8; ++j) { const int l = tg * 8 + j; const float gt = off + pl[j], gm = j > 0 ? off + pl[j - 1] : off;
                const float at = ar[j] * __expf(gm), rt = rr[j] * __expf(gt), en = __expf(-gt), ec = __expf(gC - gt);
                lds_st_bf16(RM(0) + l * 144 + ch * 2, at); lds_st_bf16(RM(1) + l * 144 + ch * 2, rt); lds_st_bf16(RM(2) + l * 144 + ch * 2, br[j] * en); lds_st_bf16(RM(3) + l * 144 + ch * 2, k2r[j] * en);
                oat[j] = at; obb[j] = br[j] * ec; okb[j] = k2r[j] * ec; ov[j] = vr[j]; }
            *(LAS v4u*)(RM(4) + ch * 144 + tg * 16) = pack8(oat); *(LAS v4u*)(RM(5) + ch * 144 + tg * 16) = pack8(obb); *(LAS v4u*)(RM(6) + ch * 144 + tg * 16) = pack8(okb); *(LAS v4u*)(RM(7) + ch * 144 + tg * 16) = pack8(ov);
            if (tg == 0) GAMC[ch] = __expf(gC);
        }
        __syncthreads();
        RW_REP(4) {
            const int which = wave >> 1; const LAS unsigned char* Aop = which < 2 ? RM(0) : RM(1); const LAS unsigned char* Bop = (which & 1) ? RM(3) : RM(2);
#pragma unroll 1
            for (int i2 = 0; i2 < 2; ++i2) { const int tt = 2 * (wave & 1) + i2, t = tt * 16 + fr;
#pragma unroll
                for (int it = 0; it < 4; ++it) { f32x4 acc = {0.f, 0.f, 0.f, 0.f}; acc = mm16(Aop + tt * 16 * 144, 144, Bop + it * 16 * 144, 144, 64, acc, fr, fq);
                    const int i0 = it * 16 + 4 * fq; const int lim = which < 2 ? t : t + 1;
                    const float o0 = (i0 < lim) ? acc[0] : 0.f, o1 = (i0 + 1 < lim) ? acc[1] : 0.f, o2 = (i0 + 2 < lim) ? acc[2] : 0.f, o3 = (i0 + 3 < lim) ? acc[3] : 0.f;
#ifdef RW_CLAMP_AAK
                    float q0 = o0, q1 = o1, q2 = o2, q3 = o3;
                    if (which == 1) { q0 = fabsf(o0) < 1e30f ? o0 : 0.f; q1 = fabsf(o1) < 1e30f ? o1 : 0.f; q2 = fabsf(o2) < 1e30f ? o2 : 0.f; q3 = fabsf(o3) < 1e30f ? o3 : 0.f; }
                    if (which == 0) *(LAS f32x4*)(AAB + t * 64 + i0) = (f32x4){o0, o1, o2, o3};
                    else lds_st_bf16x4(RM(7 + which) + t * 144 + i0 * 2, q0, q1, q2, q3);
                    continue;
#endif
                    if (which == 0) { DBG_STAT(11, o0); DBG_STAT(11, o1); DBG_STAT(11, o2); DBG_STAT(11, o3); } if (which == 1) { DBG_STAT(12, o0); DBG_STAT(12, o1); DBG_STAT(12, o2); DBG_STAT(12, o3); } if (which == 2) { DBG_STAT(13, o0); DBG_STAT(13, o3); } if (which == 3) { DBG_STAT(14, o0); DBG_STAT(14, o3); }
                    if (which == 0) *(LAS f32x4*)(AAB + t * 64 + i0) = (f32x4){o0, o1, o2, o3};
                    else lds_st_bf16x4(RM(7 + which) + t * 144 + i0 * 2, o0, o1, o2, o3); } }
        }
        __syncthreads();
        RW_REP(5) {
#pragma unroll 1
            for (int i2 = 0; i2 < 2; ++i2) { const int idx = wave * 2 + i2, vt = idx >> 2, tt = idx & 3; f32x4 acc = {0.f, 0.f, 0.f, 0.f};
                acc = mm16(RM(7) + vt * 16 * 144, 144, RM(8) + tt * 16 * 144, 144, 64, acc, fr, fq);
                DBG_STAT(15, acc[0]); DBG_STAT(15, acc[1]); DBG_STAT(15, acc[2]); DBG_STAT(15, acc[3]);
                lds_st_bf16x4(RM(0) + (vt * 16 + fr) * 144 + (tt * 16 + 4 * fq) * 2, acc[0], acc[1], acc[2], acc[3]); }
        }
#if RW_SOLVE_BLK
        LAS unsigned char* T11T = L + 143616;
        LAS unsigned char* YT = RM(8);
        RW_REP(8) if (wave < 2) {
            const int R0 = wave * 32; float x[32]; f32x4 rowq[8];
#pragma unroll
            for (int tl = 0; tl < 32; ++tl) {
                f32x4 cur[8];
#pragma unroll
                for (int i4 = 0; i4 < (tl + 3) / 4; ++i4) cur[i4] = rowq[i4];
                if (tl + 1 < 32) {
#pragma unroll
                    for (int i4 = 0; i4 < (tl + 4) / 4; ++i4) rowq[i4] = *(const LAS f32x4*)(AAB + (R0 + tl + 1) * 64 + R0 + 4 * i4); }
                float a0 = (R0 + tl == ch) ? 1.0f : 0.f, a1 = 0.f, a2 = 0.f, a3 = 0.f;
#pragma unroll
                for (int i4 = 0; i4 < (tl + 3) / 4; ++i4) { const f32x4 q = cur[i4];
                    a0 += q.x * x[4 * i4]; if (4 * i4 + 1 < tl) a1 += q.y * x[4 * i4 + 1]; if (4 * i4 + 2 < tl) a2 += q.z * x[4 * i4 + 2]; if (4 * i4 + 3 < tl) a3 += q.w * x[4 * i4 + 3]; }
                const float acc = (a0 + a1) + (a2 + a3);
                x[tl] = acc; if (wave == 0 || ch >= 32) lds_st_bf16(RM(11) + (R0 + tl) * 144 + ch * 2, acc); }
            if (wave == 0 && ch < 32) {
#pragma unroll
                for (int q = 0; q < 4; ++q) { const float xv[8] = {x[8 * q], x[8 * q + 1], x[8 * q + 2], x[8 * q + 3], x[8 * q + 4], x[8 * q + 5], x[8 * q + 6], x[8 * q + 7]}; *(LAS v4u*)(T11T + ch * 80 + q * 16) = pack8(xv); } }
        }
        __syncthreads();
        if (wave < 4) {
            const int jt = wave >> 1, it = wave & 1; bf16x8 bfa[1];
            { const LAS float* ap = AAB + (32 + it * 16 + fr) * 64 + 8 * fq; const f32x4 p0 = *(const LAS f32x4*)ap, p1 = *(const LAS f32x4*)(ap + 4);
              v4u w; w.x = cvt_pk_bf16(p0.x, p0.y); w.y = cvt_pk_bf16(p0.z, p0.w); w.z = cvt_pk_bf16(p1.x, p1.y); w.w = cvt_pk_bf16(p1.z, p1.w); bfa[0] = __builtin_bit_cast(bf16x8, w); }
            f32x4 acc = {0.f, 0.f, 0.f, 0.f}; acc = mm16_rB<1>(T11T + jt * 16 * 80, 80, bfa, acc, fr, fq);
            lds_st_bf16x4(YT + (jt * 16 + fr) * 80 + (it * 16 + 4 * fq) * 2, acc[0], acc[1], acc[2], acc[3]);
        }
        __syncthreads();
        if (wave < 4) {
            const int it = wave >> 1, jt = wave & 1;
            f32x4 acc = {0.f, 0.f, 0.f, 0.f}; acc = mm16(RM(11) + (32 + it * 16) * 144 + 64, 144, YT + jt * 16 * 80, 80, 32, acc, fr, fq);
            lds_st_bf16x4(RM(11) + (32 + it * 16 + fr) * 144 + (jt * 16 + 4 * fq) * 2, acc[0], acc[1], acc[2], acc[3]);
        }
        __syncthreads();
#else
        RW_REP(8) if (wave == 0) {
            float x[64]; f32x4 rowq[16];
#pragma unroll
            for (int t = 0; t < 64; ++t) {
                f32x4 cur[16];
#pragma unroll
                for (int i4 = 0; i4 < (t + 3) / 4; ++i4) cur[i4] = rowq[i4];
                if (t + 1 < 64) {
#pragma unroll
                    for (int i4 = 0; i4 < (t + 4) / 4; ++i4) rowq[i4] = *(const LAS f32x4*)(AAB + (t + 1) * 64 + 4 * i4); }
                float a0 = (t == ch) ? 1.0f : 0.f, a1 = 0.f, a2 = 0.f, a3 = 0.f;
#pragma unroll
                for (int i4 = 0; i4 < (t + 3) / 4; ++i4) { const f32x4 q = cur[i4];
                    a0 += q.x * x[4 * i4]; if (4 * i4 + 1 < t) a1 += q.y * x[4 * i4 + 1]; if (4 * i4 + 2 < t) a2 += q.z * x[4 * i4 + 2]; if (4 * i4 + 3 < t) a3 += q.w * x[4 * i4 + 3]; }
                const float acc = (a0 + a1) + (a2 + a3);
                x[t] = acc; lds_st_bf16(RM(11) + t * 144 + ch * 2, acc); }
        }
        __syncthreads();
#endif
        RW_REP(6) {
            const int rt = wave >> 1;
#pragma unroll
            for (int i2 = 0; i2 < 2; ++i2) { const int tt = 2 * (wave & 1) + i2;
                f32x4 acc = {0.f, 0.f, 0.f, 0.f}; acc = mm16(RM(4) + rt * 16 * 144, 144, RM(11) + tt * 16 * 144, 144, 64, acc, fr, fq);
                DBG_STAT(17, acc[0]); DBG_STAT(17, acc[1]); DBG_STAT(17, acc[2]); DBG_STAT(17, acc[3]);
                lds_st_bf16x4(RM(2) + (rt * 16 + fr) * 144 + (tt * 16 + 4 * fq) * 2, acc[0], acc[1], acc[2], acc[3]);
                f32x4 ac2 = {0.f, 0.f, 0.f, 0.f}; ac2 = mm16(RM(0) + rt * 16 * 144, 144, RM(11) + tt * 16 * 144, 144, 64, ac2, fr, fq);
                DBG_STAT(18, ac2[0]); DBG_STAT(18, ac2[1]); DBG_STAT(18, ac2[2]); DBG_STAT(18, ac2[3]);
                lds_st_bf16x4(RM(3) + (rt * 16 + fr) * 144 + (tt * 16 + 4 * fq) * 2, ac2[0], ac2[1], ac2[2], ac2[3]); }
        }
        __syncthreads();
        RW_REP(7) {
            const int which = wave >> 1;
#pragma unroll 1
            for (int i2 = 0; i2 < 2; ++i2) { const int rt = 2 * (wave & 1) + i2, row = rt * 16 + fr;
#pragma unroll
                for (int ct = 0; ct < 4; ++ct) { f32x4 acc = {0.f, 0.f, 0.f, 0.f}; const int c0 = ct * 16 + 4 * fq;
                    if (which == 0) { acc = mm16(RM(9) + rt * 16 * 144, 144, RM(2) + ct * 16 * 144, 144, 64, acc, fr, fq);
                        const v2u rw = *(const LAS v2u*)(RM(1) + row * 144 + c0 * 2);
                        acc[0] += __uint_as_float(rw.x << 16); acc[1] += __uint_as_float(rw.x & 0xffff0000u); acc[2] += __uint_as_float(rw.y << 16); acc[3] += __uint_as_float(rw.y & 0xffff0000u);
                        DBG_STAT(19, acc[0]); DBG_STAT(19, acc[1]); DBG_STAT(19, acc[2]); DBG_STAT(19, acc[3]);
                        v2u o; o.x = cvt_pk_bf16(acc[0], acc[1]); o.y = cvt_pk_bf16(acc[2], acc[3]); *(v2u*)(WSP(bf16, WS_RW_RH) + un * 4096 + row * 64 + c0) = o; }
                    else if (which == 1) {
#ifndef RW_NO_U0
                        acc = mm16(RM(9) + rt * 16 * 144, 144, RM(3) + ct * 16 * 144, 144, 64, acc, fr, fq);
#endif
                        acc = mm16(RM(10) + rt * 16 * 144, 144, RM(7) + ct * 16 * 144, 144, 64, acc, fr, fq);
                        DBG_STAT(20, acc[0]); DBG_STAT(20, acc[1]); DBG_STAT(20, acc[2]); DBG_STAT(20, acc[3]);
                        stb4(WSP(bf16, WS_RW_O0) + un * 4096 + row * 64 + c0, acc); }
                    else if (which == 2) { acc = mm16(RM(5) + rt * 16 * 144, 144, RM(2) + ct * 16 * 144, 144, 64, acc, fr, fq);
                        const float gd = GAMC[row]; if (row == c0) acc[0] += gd; if (row == c0 + 1) acc[1] += gd; if (row == c0 + 2) acc[2] += gd; if (row == c0 + 3) acc[3] += gd;
                        DBG_STAT(21, acc[0]); DBG_STAT(21, acc[1]); DBG_STAT(21, acc[2]); DBG_STAT(21, acc[3]);
                        v2u o; o.x = cvt_pk_bf16(acc[0], acc[1]); o.y = cvt_pk_bf16(acc[2], acc[3]);
                        *(v2u*)((unsigned char*)(WSP(bf16, WS_RW_GF) + un * 4096) + ((rt * 2 + (ct >> 1)) * 64 + ch) * 16 + (ct & 1) * 8) = o; }
                    else { acc = mm16(RM(3) + rt * 16 * 144, 144, RM(5) + ct * 16 * 144, 144, 64, acc, fr, fq); acc = mm16(RM(7) + rt * 16 * 144, 144, RM(6) + ct * 16 * 144, 144, 64, acc, fr, fq);
                        DBG_STAT(22, acc[0]); DBG_STAT(22, acc[1]); DBG_STAT(22, acc[2]); DBG_STAT(22, acc[3]);
                        *(f32x4*)(WSP(float, WS_RW_HT) + un * 4096 + row * 64 + c0) = acc; } } }
        }
        __syncthreads();
    }
#undef RM
}
#if RW_SCAN_DMA
__device__ __forceinline__ void rwkv_scan_wave(Frame& F, const Args& A, int wslot) {
    const int lane = F.lane, fr = lane & 15, fq = lane >> 4, bh = wslot >> 2, v0 = (wslot & 3) * 16;
    const unsigned char* GFb = (const unsigned char*)(WSP(bf16, WS_RW_GF) + (size_t)bh * NCH * 4096) + lane * 16;
    const unsigned char* HTb = (const unsigned char*)(WSP(float, WS_RW_HT) + (size_t)bh * NCH * 4096 + (size_t)(v0 + fr) * 64 + 4 * fq);
    bf16* PT = WSP(bf16, WS_RW_PT) + (size_t)bh * NCH * 4096 + (size_t)(v0 + fr) * 64 + 4 * fq;
    LAS unsigned char* ring = F.lds;
    f32x4 P[4] = {{0.f, 0.f, 0.f, 0.f}, {0.f, 0.f, 0.f, 0.f}, {0.f, 0.f, 0.f, 0.f}, {0.f, 0.f, 0.f, 0.f}};
#define RW2_ISSUE(cc, sl) do { _Pragma("unroll") for (int f_ = 0; f_ < 8; ++f_) __builtin_amdgcn_global_load_lds((const unsigned*)(GFb + (size_t)(cc) * 8192 + f_ * 1024), (LAS unsigned*)(ring + (sl) * 12288 + f_ * 1024), 16, 0, 0); \
        _Pragma("unroll") for (int m_ = 0; m_ < 4; ++m_) __builtin_amdgcn_global_load_lds((const unsigned*)(HTb + (size_t)(cc) * 16384 + m_ * 64), (LAS unsigned*)(ring + (sl) * 12288 + 8192 + m_ * 1024), 16, 0, 0); } while (0)
#define RW2_STEP(cc, sl, NW) do { asm volatile("s_waitcnt vmcnt(" #NW ")" ::: "memory"); \
        const LAS unsigned char* sp_ = ring + (sl) * 12288 + lane * 16; bf16x8 gx[4][2]; f32x4 hx[4]; \
        _Pragma("unroll") for (int m = 0; m < 4; ++m) { hx[m] = *(const LAS f32x4*)(sp_ + 8192 + m * 1024); _Pragma("unroll") for (int s = 0; s < 2; ++s) gx[m][s] = *(const LAS bf16x8*)(sp_ + (m * 2 + s) * 1024); } \
        v4u bs[2]; \
        _Pragma("unroll") for (int s = 0; s < 2; ++s) { bs[s].x = cvt_pk_bf16(P[2 * s][0], P[2 * s][1]); bs[s].y = cvt_pk_bf16(P[2 * s][2], P[2 * s][3]); bs[s].z = cvt_pk_bf16(P[2 * s + 1][0], P[2 * s + 1][1]); bs[s].w = cvt_pk_bf16(P[2 * s + 1][2], P[2 * s + 1][3]); } \
        *(v2u*)(PT + (size_t)(cc) * 4096) = (v2u){bs[0].x, bs[0].y}; *(v2u*)(PT + (size_t)(cc) * 4096 + 16) = (v2u){bs[0].z, bs[0].w}; \
        *(v2u*)(PT + (size_t)(cc) * 4096 + 32) = (v2u){bs[1].x, bs[1].y}; *(v2u*)(PT + (size_t)(cc) * 4096 + 48) = (v2u){bs[1].z, bs[1].w}; \
        _Pragma("unroll") for (int m = 0; m < 4; ++m) { f32x4 acc = hx[m]; acc = __builtin_amdgcn_mfma_f32_16x16x32_bf16(gx[m][0], __builtin_bit_cast(bf16x8, bs[0]), acc, 0, 0, 0); \
            acc = __builtin_amdgcn_mfma_f32_16x16x32_bf16(gx[m][1], __builtin_bit_cast(bf16x8, bs[1]), acc, 0, 0, 0); P[m] = acc; } \
        asm volatile("s_waitcnt lgkmcnt(0)" ::: "memory"); } while (0)
    RW2_ISSUE(0, 0); RW2_ISSUE(1, 1); RW2_ISSUE(2, 2);
    RW2_ISSUE(3, 3); RW2_STEP(0, 0, 36); RW2_ISSUE(4, 0); RW2_STEP(1, 1, 40); RW2_ISSUE(5, 1); RW2_STEP(2, 2, 44); RW2_ISSUE(6, 2); RW2_STEP(3, 3, 48);
#pragma unroll 1
    for (int c = 4; c < 60; c += 4) {
        RW2_ISSUE(c + 3, 3); RW2_STEP(c, 0, 48); RW2_ISSUE(c + 4, 0); RW2_STEP(c + 1, 1, 48); RW2_ISSUE(c + 5, 1); RW2_STEP(c + 2, 2, 48); RW2_ISSUE(c + 6, 2); RW2_STEP(c + 3, 3, 48);
    }
    RW2_ISSUE(63, 3); RW2_STEP(60, 0, 48); RW2_STEP(61, 1, 36); RW2_STEP(62, 2, 24); RW2_STEP(63, 3, 12);
#undef RW2_ISSUE
#undef RW2_STEP
}
#else
__device__ __forceinline__ void rwkv_scan_wave(Frame& F, const Args& A, int wslot) {
    const int lane = F.lane, fr = lane & 15, fq = lane >> 4, bh = wslot >> 2, v0 = (wslot & 3) * 16;
    const bf16* GF = WSP(bf16, WS_RW_GF) + (size_t)bh * NCH * 4096; const float* HT = WSP(float, WS_RW_HT) + (size_t)bh * NCH * 4096 + (size_t)(v0 + fr) * 64 + 4 * fq;
    bf16* PT = WSP(bf16, WS_RW_PT) + (size_t)bh * NCH * 4096 + (size_t)(v0 + fr) * 64 + 4 * fq;
    f32x4 P[4] = {{0.f, 0.f, 0.f, 0.f}, {0.f, 0.f, 0.f, 0.f}, {0.f, 0.f, 0.f, 0.f}, {0.f, 0.f, 0.f, 0.f}};
    bf16x8 g0[4][2], g1[4][2], g2[4][2]; f32x4 h0[4], h1[4], h2[4];
#define RW2_LOAD(gx, hx, cc) do { _Pragma("unroll") for (int m = 0; m < 4; ++m) { hx[m] = *(const f32x4*)(HT + (size_t)(cc) * 4096 + 16 * m); \
        _Pragma("unroll") for (int s = 0; s < 2; ++s) gx[m][s] = *(const bf16x8*)(GF + (size_t)(cc) * 4096 + ((m * 2 + s) * 64 + lane) * 8); } } while (0)
#define RW2_STEP(gx, hx, cc) do { v4u bs[2]; \
        _Pragma("unroll") for (int s = 0; s < 2; ++s) { bs[s].x = cvt_pk_bf16(P[2 * s][0], P[2 * s][1]); bs[s].y = cvt_pk_bf16(P[2 * s][2], P[2 * s][3]); bs[s].z = cvt_pk_bf16(P[2 * s + 1][0], P[2 * s + 1][1]); bs[s].w = cvt_pk_bf16(P[2 * s + 1][2], P[2 * s + 1][3]); } \
        *(v2u*)(PT + (size_t)(cc) * 4096) = (v2u){bs[0].x, bs[0].y}; *(v2u*)(PT + (size_t)(cc) * 4096 + 16) = (v2u){bs[0].z, bs[0].w}; \
        *(v2u*)(PT + (size_t)(cc) * 4096 + 32) = (v2u){bs[1].x, bs[1].y}; *(v2u*)(PT + (size_t)(cc) * 4096 + 48) = (v2u){bs[1].z, bs[1].w}; \
        _Pragma("unroll") for (int m = 0; m < 4; ++m) { f32x4 acc = hx[m]; acc = __builtin_amdgcn_mfma_f32_16x16x32_bf16(gx[m][0], __builtin_bit_cast(bf16x8, bs[0]), acc, 0, 0, 0); \
            acc = __builtin_amdgcn_mfma_f32_16x16x32_bf16(gx[m][1], __builtin_bit_cast(bf16x8, bs[1]), acc, 0, 0, 0); P[m] = acc; } } while (0)
    RW2_LOAD(g0, h0, 0); RW2_LOAD(g1, h1, 1);
#pragma unroll 1
    for (int c = 0; c < 63; c += 3) {
        RW2_LOAD(g2, h2, c + 2); RW2_STEP(g0, h0, c);
        RW2_LOAD(g0, h0, c + 3); RW2_STEP(g1, h1, c + 1);
        if (c + 4 < NCH) RW2_LOAD(g1, h1, c + 4);
        RW2_STEP(g2, h2, c + 2);
    }
    RW2_STEP(g0, h0, 63);
#undef RW2_LOAD
#undef RW2_STEP
}
#endif
__device__ __forceinline__ void rwkv_stage3(Frame& F, const Args& A, int layer, int ub) {
    const int t0 = ub * 64, b_ = ub >> 6, c = ub & 63, lane = F.lane, wave = F.wave, fr = lane & 15, fq = lane >> 4, hh = wave >> 1;
    const size_t un = (size_t)(b_ * 4 + hh) * NCH + c;
    const bf16* RH = WSP(bf16, WS_RW_RH) + un * 4096; const bf16* PT = WSP(bf16, WS_RW_PT) + un * 4096; const bf16* O0 = WSP(bf16, WS_RW_O0) + un * 4096;
    const bf16* RW = WSP(bf16, WS_RW); const bf16* RG = WSP(bf16, WS_RW_G); bf16* mix = WSP(bf16, WS_MIX);
    const float* lg = KIN(I_RLNG) + layer * 256 + hh * 64; const float* lb = KIN(I_RLNB) + layer * 256 + hh * 64; const float* rk = KIN(I_RRK) + layer * 256 + hh * 64;
    bf16x8 pfr[4][2];
#pragma unroll
    for (int vt = 0; vt < 4; ++vt)
#pragma unroll
        for (int ks = 0; ks < 2; ++ks) pfr[vt][ks] = *(const bf16x8*)(PT + (size_t)(vt * 16 + fr) * 64 + ks * 32 + fq * 8);
#pragma unroll 1
    for (int i = 0; i < 2; ++i) { const int tt = 2 * (wave & 1) + i, tl = tt * 16 + fr, t = t0 + tl;
        const bf16x8 ra0 = *(const bf16x8*)(RH + (size_t)tl * 64 + fq * 8), ra1 = *(const bf16x8*)(RH + (size_t)tl * 64 + 32 + fq * 8);
        f32x4 ov[4]; float sm = 0.f;
#pragma unroll
        for (int vt = 0; vt < 4; ++vt) { f32x4 acc = ldb4(O0 + tl * 64 + vt * 16 + 4 * fq);
            acc = __builtin_amdgcn_mfma_f32_16x16x32_bf16(pfr[vt][0], ra0, acc, 0, 0, 0); acc = __builtin_amdgcn_mfma_f32_16x16x32_bf16(pfr[vt][1], ra1, acc, 0, 0, 0);
            ov[vt] = acc; DBG_STAT(24, acc[0]); DBG_STAT(24, acc[1]); DBG_STAT(24, acc[2]); DBG_STAT(24, acc[3]); sm += (acc.x + acc.y) + (acc.z + acc.w); }
        sm += __shfl_xor(sm, 16); sm += __shfl_xor(sm, 32);
        const float mean = sm * (1.f / 64.f); float sq = 0.f;
#pragma unroll
        for (int vt = 0; vt < 4; ++vt) { ov[vt] = ov[vt] - mean; sq += (ov[vt].x * ov[vt].x + ov[vt].y * ov[vt].y) + (ov[vt].z * ov[vt].z + ov[vt].w * ov[vt].w); }
        sq += __shfl_xor(sq, 16); sq += __shfl_xor(sq, 32);
        const float rs = __builtin_amdgcn_rsqf(sq * (1.f / 64.f) + RWKV_GN_EPS);
        float bd = 0.f;
#pragma unroll
        for (int q = 0; q < 4; ++q) { const f32x4 r4 = ldb4(RW + (size_t)t * 768 + hh * 64 + fq * 16 + 4 * q), k4 = ldb4(RW + (size_t)t * 768 + 256 + hh * 64 + fq * 16 + 4 * q), c4 = *(const f32x4*)(rk + fq * 16 + 4 * q);
            bd += (r4.x * k4.x * c4.x + r4.y * k4.y * c4.y) + (r4.z * k4.z * c4.z + r4.w * k4.w * c4.w); }
        bd += __shfl_xor(bd, 16); bd += __shfl_xor(bd, 32);
#pragma unroll
        for (int vt = 0; vt < 4; ++vt) { const int col = vt * 16 + 4 * fq; const f32x4 g4 = *(const f32x4*)(lg + col), b4 = *(const f32x4*)(lb + col);
            const f32x4 v4 = ldb4(RW + (size_t)t * 768 + 512 + hh * 64 + col), gg = ldb4(RG + (size_t)t * 256 + hh * 64 + col);
            float e0 = (ov[vt].x * rs * g4.x + b4.x + bd * v4.x) * gg.x, e1 = (ov[vt].y * rs * g4.y + b4.y + bd * v4.y) * gg.y, e2 = (ov[vt].z * rs * g4.z + b4.z + bd * v4.z) * gg.z, e3 = (ov[vt].w * rs * g4.w + b4.w + bd * v4.w) * gg.w;
#ifdef RW_SANITIZE
            e0 = (fabsf(e0) < 1e30f) ? e0 : 0.f; e1 = (fabsf(e1) < 1e30f) ? e1 : 0.f; e2 = (fabsf(e2) < 1e30f) ? e2 : 0.f; e3 = (fabsf(e3) < 1e30f) ? e3 : 0.f;
#endif
            MIX_ST4(mix, (size_t)t * D + 256 + hh * 64 + col, e0, e1, e2, e3); } }
}

constexpr int SCAN_N_MAIN = 16 * 64 * 128 / 2 + 16 * 32 * 64 / 2 + 16 * 64 * 64 / 2, SCAN_N_ALL = SCAN_N_MAIN + 16 * 64 / 2;
__device__ __forceinline__ void scans_elementwise(Frame& F, const Args& A, int gt, int nthr, int lo, int hi) {
    constexpr int N_SSD = 16 * 64 * 128 / 2, N_GLA = 16 * 32 * 64 / 2, N_MLC = 16 * 64 * 64 / 2, N_MLN = 16 * 64 / 2;
    for (int i = lo + gt; i < hi; i += nthr) {
        if (i < N_SSD) { const int bh = i >> 12, pn = (i & 4095) * 2; unsigned* base = (unsigned*)(WSP(bf16, WS_SSD_ST) + (size_t)bh * NCH * 8192 + pn); const float* dec = WSP(float, WS_SSD_DEC) + bh * NCH; float S0 = 0.f, S1 = 0.f;
#pragma unroll 1
            for (int c0 = 0; c0 < NCH; c0 += 32) { unsigned x[32]; float dd[32];
#pragma unroll
                for (int j = 0; j < 32; ++j) { x[j] = base[(size_t)(c0 + j) * 4096]; dd[j] = dec[c0 + j]; }
#pragma unroll
                for (int j = 0; j < 32; ++j) { base[(size_t)(c0 + j) * 4096] = cvt_pk_bf16(S0, S1); S0 = dd[j] * S0 + __uint_as_float(x[j] << 16); S1 = dd[j] * S1 + __uint_as_float(x[j] & 0xffff0000u); } }
        } else if (i < N_SSD + N_GLA) { const int k = i - N_SSD, bh = k >> 10, dv = (k & 1023) * 2, dd_ = dv >> 6, b = bh >> 2, hh = bh & 3; unsigned* base = (unsigned*)(WSP(bf16, WS_GLA_ST) + (size_t)bh * NCH * 2048 + dv); const float* dec = WSP(float, WS_GLA_DEC) + (size_t)b * NCH * 128 + hh * 32 + dd_; float S0 = 0.f, S1 = 0.f;
#pragma unroll 1
            for (int c0 = 0; c0 < NCH; c0 += 32) { unsigned x[32]; float dd[32];
#pragma unroll
                for (int j = 0; j < 32; ++j) { x[j] = base[(size_t)(c0 + j) * 1024]; dd[j] = dec[(c0 + j) * 128]; }
#pragma unroll
                for (int j = 0; j < 32; ++j) { base[(size_t)(c0 + j) * 1024] = cvt_pk_bf16(S0, S1); S0 = dd[j] * S0 + __uint_as_float(x[j] << 16); S1 = dd[j] * S1 + __uint_as_float(x[j] & 0xffff0000u); } }
        } else { const int k = i - N_SSD - N_GLA; const bool isn = k >= N_MLC; const int kk = isn ? k - N_MLC : k; const int bh = isn ? (kk >> 5) : (kk >> 11), e = (isn ? (kk & 31) : (kk & 2047)) * 2, str = isn ? 32 : 2048;
            unsigned* base = (unsigned*)((isn ? WSP(bf16, WS_ML_N) : WSP(bf16, WS_ML_C)) + (size_t)bh * NCH * str * 2 + e); const float* bl = WSP(float, WS_ML_BL) + bh * NCH; const float* ml = WSP(float, WS_ML_ML) + bh * NCH; float* mo = WSP(float, WS_ML_M) + bh * NCH;
            float S0 = 0.f, S1 = 0.f, m = 0.f;
#pragma unroll 1
            for (int c0 = 0; c0 < NCH; c0 += 32) { unsigned x[32]; float b8[32], m8[32];
#pragma unroll
                for (int j = 0; j < 32; ++j) { x[j] = base[(size_t)(c0 + j) * str]; b8[j] = bl[c0 + j]; m8[j] = ml[c0 + j]; }
#pragma unroll
                for (int j = 0; j < 32; ++j) { const float mn = fmaxf(b8[j] + m, m8[j]); const float so = __expf(b8[j] + m - mn), sn = __expf(m8[j] - mn);
                    base[(size_t)(c0 + j) * str] = cvt_pk_bf16(S0, S1); if (!isn && e == 0) mo[c0 + j] = m; S0 = so * S0 + sn * __uint_as_float(x[j] << 16); S1 = so * S1 + sn * __uint_as_float(x[j] & 0xffff0000u); m = mn; } }
        }
    }
}
#ifndef MK_PER_PHASE_LAUNCH
#define MK_PER_PHASE_LAUNCH 0
#endif
#ifndef PH_MASK
#define PH_MASK 0xFFF
#endif
#ifndef ST_MASK
#define ST_MASK 0xF
#endif
#define ST_ON(k) (((ST_MASK) >> (k)) & 1)
#ifndef DUP_MASK
#define DUP_MASK 0
#endif
#define DUP_N(k) ((((DUP_MASK) >> (k)) & 1) ? 2 : 1)
#ifndef ST_DUP
#define ST_DUP 0
#endif
#define ST_REP(ty) ((((ST_DUP) >> (ty)) & 1) ? 2 : 1)
#define PH_ON(k) (((PH_MASK) >> (k)) & 1)
constexpr int PH_PER_LAYER = 11, N_PHASES = 1 + DEPTH * PH_PER_LAYER;
__global__ void __launch_bounds__(NWAVES * 64, 2) fwd_kernel(Args args) {
    extern __shared__ __attribute__((aligned(16))) unsigned char lds[];
    Frame F;
    F.lds = (LAS unsigned char*)lds;
    F.MISC = (volatile LAS unsigned*)(F.lds + MISC_OFF);
    F.tid = threadIdx.x; F.lane = F.tid & 63; F.wave = __builtin_amdgcn_readfirstlane(F.tid >> 6);
    F.G = gridDim.x; { const int bx = blockIdx.x; F.vcu = (F.G % 8 == 0) ? (bx % 8) * (F.G / 8) + bx / 8 : bx; }
    F.ka = (karg_t)__builtin_amdgcn_kernarg_segment_ptr(); F.ws = args.ws; F.ctl = (gu32*)(args.ws + WS_CTL); F.out = args.out;
    for (int i = F.tid; i < 256; i += NWAVES * 64) F.MISC[i] = 0u;
    __syncthreads();
    const int lo = args.ph_lo, hi = args.ph_hi;
#ifdef DBG_TSEL
    if (blockIdx.x == 0 && threadIdx.x == 0) __hip_atomic_store(F.ctl + CW_DBG + 15, (unsigned)__builtin_amdgcn_s_memrealtime(), RLX_AGENT);
#endif
    XcdBarrier bar; bar.bar = (unsigned*)(F.ctl + CW_BAR); bar.x = 0; bar.st = nullptr;
    if (hi - lo > 1) bar = xcd_barrier_post((unsigned*)(F.ctl + CW_BAR), F.MISC + MW_BAR);
#define IN_(k) (lo <= (k) && (k) < hi)
#ifdef DBG_TSEL
#ifndef DBG_TQ
#define DBG_TQ 50.0f
#endif
#define TSTAMP(k) do { if (blockIdx.x == 0 && threadIdx.x == 0) __hip_atomic_store(F.ctl + CW_DBG + 16 + ((k) == 11 ? 0 : 1 + layer_ * PH_PER_LAYER + (k)), (unsigned)__builtin_amdgcn_s_memrealtime(), RLX_AGENT); } while (0)
#else
#define TSTAMP(k) do { } while (0)
#endif
#ifdef BAR_DUP
#define SEAM(k) do { if (IN_(k) && IN_((k) + 1)) { xcd_barrier(bar); xcd_barrier(bar); } } while (0)
#else
#define SEAM(k) do { if (IN_(k) && IN_((k) + 1)) xcd_barrier(bar); } while (0)
#endif

    if (PH_ON(11) && IN_(0)) { for (int rep_ = 0; rep_ < DUP_N(11); ++rep_) { frame_refresh(F); p0_prologue(F, args); } SEAM(0); { const int layer_ = 0; TSTAMP(11); (void)layer_; } }
#pragma unroll 1
    for (int layer = 0; layer < DEPTH; ++layer) {
        const int pb = 1 + layer * PH_PER_LAYER; const int layer_ = layer; (void)layer_;
        if (PH_ON(0) && IN_(pb + 0)) { for (int rep_ = 0; rep_ < DUP_N(0); ++rep_) { frame_refresh(F);
            { pg8::DenseSched S; S.init(WSP(bf16, WS_XB), WSP(bf16, WS_WIN_T) + (size_t)layer * NUP * D, T, NUP, D, F.G, (int)blockIdx.x);
              pg8::EpiB16 E{WSP(bf16, WS_U), NUP, nullptr, 0.f};
              pg8::gemm_phase<pg8::EpiB16, pg8::DenseSched>(F.lds, F.tid, S, E); }
            if (F.G != 256 || blockIdx.x >= 128)
            { pg8::DenseSched S; if (F.G == 256) S.init(WSP(bf16, WS_PB) + (size_t)layer * T * 256, WSP(bf16, WS_WPP_T) + (size_t)layer * D * 256, T, D, 256, 128, (int)blockIdx.x - 128); else S.init(WSP(bf16, WS_PB) + (size_t)layer * T * 256, WSP(bf16, WS_WPP_T) + (size_t)layer * D * 256, T, D, 256, F.G, (int)blockIdx.x);
              pg8::EpiB16 E{WSP(bf16, WS_PE), D, nullptr, 0.f};
              pg8::gemm_phase<pg8::EpiB16, pg8::DenseSched>(F.lds, F.tid, S, E); }
            } SEAM(pb + 0); TSTAMP(0);
        }
        if (PH_ON(1) && IN_(pb + 1)) { for (int rep_ = 0; rep_ < DUP_N(1); ++rep_) { frame_refresh(F);
            for (int un = F.vcu; un < 1024; un += F.G) { frame_refresh(F); const int ty = un >> 8, r = un & 255, b = r >> 6, c = r & 63;
                if (ty == 0) { ssd_stage1(F, args, layer, b, c); if (ST_DUP & 1) ssd_stage1(F, args, layer, b, c); } else if (ty == 1) { gla_stage1(F, args, layer, b, c); if (ST_DUP & 2) gla_stage1(F, args, layer, b, c); } else if (ty == 2) { mlstm_stage1(F, args, layer, b, c); if (ST_DUP & 4) mlstm_stage1(F, args, layer, b, c); } else { rwkv_stage1(F, args, layer, r); if (ST_DUP & 8) rwkv_stage1(F, args, layer, r); } }
            } SEAM(pb + 1); TSTAMP(1);
        }
        if (PH_ON(2) && IN_(pb + 2)) { for (int rep_ = 0; rep_ < DUP_N(2); ++rep_) { frame_refresh(F);
            if (F.wave == 0) { for (int ws_ = F.vcu; ws_ < 64; ws_ += F.G) rwkv_scan_wave(F, args, ws_);
                if (rep_ == 0) { if (F.G > 64) { if (F.vcu >= 64) scans_elementwise(F, args, (F.vcu - 64) * 64 + F.lane, (F.G - 64) * 64, SCAN_N_MAIN, SCAN_N_ALL); } else scans_elementwise(F, args, F.vcu * 64 + F.lane, F.G * 64, SCAN_N_MAIN, SCAN_N_ALL); } }
            else if (rep_ == 0) scans_elementwise(F, args, F.vcu * 448 + (F.tid - 64), F.G * 448, 0, SCAN_N_MAIN);
            } SEAM(pb + 2); TSTAMP(2);
        }
        if (PH_ON(3) && IN_(pb + 3)) { for (int rep_ = 0; rep_ < DUP_N(3); ++rep_) { frame_refresh(F);
            for (int un = F.vcu; un < 1024; un += F.G) { frame_refresh(F); const int ty = un >> 8, r = un & 255, b = r >> 6, c = r & 63;
                if (ty == 0) { ssd_stage3(F, args, layer, b, c); if (ST_DUP & 16) ssd_stage3(F, args, layer, b, c); } else if (ty == 1) { gla_stage3(F, args, layer, b, c); if (ST_DUP & 32) gla_stage3(F, args, layer, b, c); } else if (ty == 2) { mlstm_stage3(F, args, layer, b, c); if (ST_DUP & 64) mlstm_stage3(F, args, layer, b, c); } else { rwkv_stage3(F, args, layer, r); if (ST_DUP & 128) rwkv_stage3(F, args, layer, r); } }
            } SEAM(pb + 3); TSTAMP(3);
        }
        if (PH_ON(4) && IN_(pb + 4)) { for (int rep_ = 0; rep_ < DUP_N(4); ++rep_) { frame_refresh(F);
            pg8::EpiB16 E{WSP(bf16, WS_Y1), D, WSP(bf16, WS_XB), DN_ALPHA};
#if OUT_FP8
            pg8::DenseSched8b S; S.init(WSP(bf16, WS_MIX), (const bf16*)(WSP(unsigned char, WS_WOUT_Q) + (size_t)layer * D * D), T, D, D / 2, F.G, (int)blockIdx.x);
            pg8::gemm_phase<pg8::EpiB16, pg8::DenseSched8b>(F.lds, F.tid, S, E);
#else
            pg8::DenseSched S; S.init(WSP(bf16, WS_MIX), WSP(bf16, WS_WOUT_T) + (size_t)layer * D * D, T, D, D, F.G, (int)blockIdx.x);
            pg8::gemm_phase<pg8::EpiB16, pg8::DenseSched>(F.lds, F.tid, S, E);
#endif
            } SEAM(pb + 4); TSTAMP(4);
        }
        if (PH_ON(5) && IN_(pb + 5)) { if (DUP_N(5) == 2) { frame_refresh(F); p6_ln1_router<true>(F, args, layer); } frame_refresh(F); p6_ln1_router<false>(F, args, layer); SEAM(pb + 5); TSTAMP(5); }
        if (PH_ON(6) && IN_(pb + 6)) { for (int rep_ = 0; rep_ < DUP_N(6); ++rep_) { frame_refresh(F);
            moe_build_pfx(F, args, layer, 8);
            pg8::Moe1Sched S; S.O.pfx = F.MISC + MW_PFX; S.O.NT = 8; S.O.G = F.G; S.O.c = (int)blockIdx.x; S.sdest = WSP(int, WS_SDEST); S.bgu = KIN(I_BGU) + (size_t)layer * NE * 2048; S.pan = F.ctl + CW_PAN + layer * (NE * 64 * 16);
            if (MOE_FP8) { S.X = WSP(unsigned char, WS_X1Q); S.W = WSP(unsigned char, WS_WGU_Q) + (size_t)layer * NE * 2048 * D; S.K = D / 2; S.hstepB = (size_t)1024 * D; }
            else { S.X = WSP(unsigned char, WS_X1B); S.W = WSP(unsigned char, WS_WGU_T) + (size_t)layer * NE * 2048 * D * 2; S.K = D; S.hstepB = (size_t)1024 * D * 2; }
            pg8::EpiMoe1 E{WSP(bf16, WS_ABUF), KIN(I_BGU) + (size_t)layer * NE * 2048, WSP(unsigned char, WS_ABUFQ)};
            pg8::gemm_phase<pg8::EpiMoe1, pg8::Moe1Sched>(F.lds, F.tid, S, E);
            }
#if MOE_CHAIN
            if (!(PH_ON(7) && IN_(pb + 7))) SEAM(pb + 6);
#else
            SEAM(pb + 6);
#endif
            TSTAMP(6);
        }
        if (PH_ON(7) && IN_(pb + 7)) { for (int rep_ = 0; rep_ < DUP_N(7); ++rep_) { frame_refresh(F);
            int c2 = (int)blockIdx.x; if (MOE_CHAIN && PH_ON(6) && IN_(pb + 6) && (F.G & 7) == 0) { const int r1 = (int)F.MISC[MW_PFX + 32] % F.G; if ((r1 & 7) == 0) c2 = (c2 - r1 + F.G) % F.G; }
            moe_build_pfx(F, args, layer, 4);
            pg8::Moe2Sched S; S.O.pfx = F.MISC + MW_PFX; S.O.NT = 4; S.O.G = F.G; S.O.c = c2; S.pan = F.ctl + CW_PAN + layer * (NE * 64 * 16); S.tmo = F.ctl + CW_BAR + XB_TMO; S.sdest = WSP(int, WS_SDEST); S.sgate = WSP(float, WS_SGATE); S.bdn = KIN(I_BDN) + (size_t)layer * NE * D; if (MOE2_FP8) { S.Ab = WSP(unsigned char, WS_ABUFQ); S.W = WSP(unsigned char, WS_WDN_Q) + (size_t)layer * NE * D * D; S.K = D / 2; S.hstepB = (size_t)128 * D; }
            else { S.Ab = WSP(unsigned char, WS_ABUF); S.W = WSP(unsigned char, WS_WDN_T) + (size_t)layer * NE * D * D * 2; S.K = D; S.hstepB = (size_t)128 * D * 2; }
            pg8::EpiMoe2 E{WSP(bf16, WS_YBUF), KIN(I_BDN) + (size_t)layer * NE * D, WSP(int, WS_SDEST), WSP(float, WS_SGATE)};
            pg8::gemm_phase<pg8::EpiMoe2, pg8::Moe2Sched>(F.lds, F.tid, S, E);
            } SEAM(pb + 7); TSTAMP(7);
        }
        if (PH_ON(8) && IN_(pb + 8)) { for (int rep_ = 0; rep_ < DUP_N(8); ++rep_) { frame_refresh(F); p9_combine(F, args); } SEAM(pb + 8); TSTAMP(8); }
        if (PH_ON(9) && IN_(pb + 9)) { for (int rep_ = 0; rep_ < DUP_N(9); ++rep_) { frame_refresh(F);
            pg8::EpiPle E{WSP(bf16, WS_H2), WSP(bf16, WS_HB), WSP(bf16, WS_PE)};
#if PLE_FP8
            pg8::DenseSched8 S; S.init((const bf16*)WSP(unsigned char, WS_HQ), (const bf16*)(WSP(unsigned char, WS_WPG_Q) + (size_t)layer * D * D), T, D, D / 2, F.G, (int)blockIdx.x);
            pg8::gemm_phase<pg8::EpiPle, pg8::DenseSched8>(F.lds, F.tid, S, E);
#else
            pg8::DenseSched S; S.init(WSP(bf16, WS_HB), WSP(bf16, WS_WPG_T) + (size_t)layer * D * D, T, D, D, F.G, (int)blockIdx.x);
            pg8::gemm_phase<pg8::EpiPle, pg8::DenseSched>(F.lds, F.tid, S, E);
#endif
            } SEAM(pb + 9); TSTAMP(9);
        }
        if (PH_ON(10) && IN_(pb + 10)) { for (int rep_ = 0; rep_ < DUP_N(10); ++rep_) { frame_refresh(F); p11_ln2(F, args, layer); } SEAM(pb + 10); TSTAMP(10); }
    }
#ifdef DBG_TSEL
    if (hi - lo > 1) { xcd_barrier(bar);
        unsigned ticks = 0u;
        if (DBG_TSEL == 11) ticks = __hip_atomic_load(F.ctl + CW_DBG + 16, RLX_AGENT) - __hip_atomic_load(F.ctl + CW_DBG + 15, RLX_AGENT);
        else for (int l = 0; l < DEPTH; ++l) { const int pi = 1 + l * PH_PER_LAYER + DBG_TSEL; ticks += __hip_atomic_load(F.ctl + CW_DBG + 16 + pi, RLX_AGENT) - __hip_atomic_load(F.ctl + CW_DBG + 16 + pi - 1, RLX_AGENT); }
        const float us = floorf((float)ticks * 0.01f / DBG_TQ) * DBG_TQ; const float code = sqrtf(us * 0.05f);
        for (size_t i = (size_t)blockIdx.x * 512 + threadIdx.x; i < (size_t)T * D; i += (size_t)gridDim.x * 512) F.out[i] = code; }
#endif
#ifdef DBG_SEL
    if (hi - lo > 1) { xcd_barrier(bar);
        const unsigned mx = __hip_atomic_load(F.ctl + CW_DBG, RLX_AGENT), nf = __hip_atomic_load(F.ctl + CW_DBG + 1, RLX_AGENT);
        float code;
        { const float m = __uint_as_float(mx); int b = (m > 0.f) ? (int)floorf(log10f(m)) + 30 : 0; b = b < 0 ? 0 : (b > 60 ? 60 : b); if (nf) b += 100; code = sqrtf(10.0f * (float)(b + 1)); }
        for (size_t i = (size_t)blockIdx.x * 512 + threadIdx.x; i < (size_t)T * D; i += (size_t)gridDim.x * 512) F.out[i] = code; }
#endif
#undef IN_
#undef SEAM
}

extern "C" void kernel_launch(void* const* d_in, const int* in_sizes, int n_in, void* d_out, int out_size, void* d_ws, size_t ws_size, hipStream_t stream) {
    static int grid = 0;
    if (grid == 0) {
        if (n_in != N_IN || out_size != T * D || ws_size < WS_END) { fprintf(stderr, "kernel_launch: unexpected shapes (n_in %d, out %d, ws %zu < %zu); nothing launched\n", n_in, out_size, ws_size, (size_t)WS_END); grid = -1; return; }
        int dev = 0, cus = 0, per_cu = 0;
        if (hipGetDevice(&dev) != hipSuccess || hipDeviceGetAttribute(&cus, hipDeviceAttributeMultiprocessorCount, dev) != hipSuccess) { grid = -1; return; }
        if (hipFuncSetAttribute((const void*)fwd_kernel, hipFuncAttributeMaxDynamicSharedMemorySize, LDS_BYTES) != hipSuccess) { fprintf(stderr, "kernel_launch: hipFuncSetAttribute failed\n"); grid = -1; return; }
        if (hipOccupancyMaxActiveBlocksPerMultiprocessor(&per_cu, (const void*)fwd_kernel, NWAVES * 64, LDS_BYTES) != hipSuccess || per_cu < 1) { fprintf(stderr, "kernel_launch: occupancy query says %d blocks per CU\n", per_cu); }
        (void)hipGetLastError();
        grid = cus;
    }
    if (grid < 0) return;
    (void)hipMemsetAsync((char*)d_ws + WS_CTL, 0, CTL_ZERO_BYTES, stream);
    Args a{};
    for (int i = 0; i < N_IN; ++i) a.in[i] = (const float*)d_in[i];
    a.out = (float*)d_out; a.ws = (unsigned char*)d_ws;
#if MK_PER_PHASE_LAUNCH
    for (int ph = 0; ph < N_PHASES; ++ph) { a.ph_lo = ph; a.ph_hi = ph + 1; hipLaunchKernelGGL(fwd_kernel, dim3(grid), dim3(NWAVES * 64), LDS_BYTES, stream, a); }
#else
    a.ph_lo = 0; a.ph_hi = N_PHASES; hipLaunchKernelGGL(fwd_kernel, dim3(grid), dim3(NWAVES * 64), LDS_BYTES, stream, a);
#endif
    const hipError_t le = hipPeekAtLastError();
    if (le != hipSuccess) fprintf(stderr, "kernel_launch: launch failed: %s\n", hipGetErrorName(le));
}
```

```cpp
#include <hip/hip_runtime.h>
#include <cstdio>
#include <cstdint>

#define GAS __attribute__((address_space(1)))
#define LAS __attribute__((address_space(3)))
typedef unsigned short bf16;
typedef unsigned v4u __attribute__((ext_vector_type(4)));
typedef unsigned v2u __attribute__((ext_vector_type(2)));
typedef float f32x4 __attribute__((ext_vector_type(4)));
typedef float f32x2 __attribute__((ext_vector_type(2)));
typedef short bf16x8 __attribute__((ext_vector_type(8)));
typedef int v4i_t __attribute__((ext_vector_type(4)));
typedef int v8i_t __attribute__((ext_vector_type(8)));
typedef GAS unsigned gu32;
#define RLX_AGENT __ATOMIC_RELAXED, __HIP_MEMORY_SCOPE_AGENT
#define LDS_WAIT() asm volatile("s_waitcnt lgkmcnt(0)" ::: "memory")
#define VM_WAIT() asm volatile("s_waitcnt vmcnt(0)" ::: "memory")

constexpr int NWAVES = 8;
constexpr int DEPTH = 4, BATCH = 4, SEQ = 4096, D = 1024, T = BATCH * SEQ;
constexpr int NU = 3484, NUP = 3584;
constexpr int NE = 32, TOPK = 4, ECAP = 16384;
constexpr int NCH = SEQ / 64;
constexpr int U_SSD_Z = 0, U_SSD_X = 256, U_SSD_B = 512, U_SSD_C = 640, U_SSD_DT = 768;
constexpr int U_RW = 772, U_RW_R = 772, U_RW_K = 1028, U_RW_V = 1284, U_RW_LO = 1540;
constexpr int U_GL_Q = 1668, U_GL_K = 1796, U_GL_V = 1924, U_GL_G = 2180, U_GL_OG = 2196;
constexpr int U_ML_Q = 2452, U_ML_K = 2708, U_ML_V = 2964, U_ML_I = 3220, U_ML_F = 3224, U_ML_O = 3228;
constexpr float DN_ALPHA = 1.6817928305074290f;
constexpr float LN_EPS = 1e-5f, NORM_EPS = 1e-5f, RWKV_GN_EPS = 64e-5f;

enum { I_X = 0, I_P, I_WIN, I_WOUT, I_LN1G, I_LN1B, I_SCW, I_SCB, I_SALOG, I_SDTB, I_SD, I_SNG,
       I_RMU, I_RW0, I_RWUP, I_RA0, I_RAUP, I_RGUP, I_RKK, I_RKA, I_RRK, I_RLNG, I_RLNB,
       I_GGUP, I_GGB, I_GNG, I_MCW, I_MCB, I_MIB, I_MFB, I_MNG,
       I_RTW, I_RTB, I_WGU, I_BGU, I_WDN, I_BDN, I_PGW, I_PPJ, I_LN2G, I_LN2B, N_IN };

constexpr size_t MiB = 1u << 20;
constexpr size_t WS_CTL = 0, CTL_ZERO_BYTES = 1 * MiB;
constexpr size_t WS_WIN_T = 2 * MiB;
constexpr size_t WS_WOUT_T = WS_WIN_T + (size_t)DEPTH * NUP * D * 2;
constexpr size_t WS_WGU_T = WS_WOUT_T + (size_t)DEPTH * D * D * 2;
constexpr size_t WS_WDN_T = WS_WGU_T + (size_t)DEPTH * NE * 2048 * D * 2;
constexpr size_t WS_WPG_T = WS_WDN_T + (size_t)DEPTH * NE * D * D * 2;
constexpr size_t WS_WPP_T = WS_WPG_T + (size_t)DEPTH * D * D * 2;
constexpr size_t WS_RWT = WS_WPP_T + (size_t)DEPTH * D * 256 * 2;
constexpr size_t WS_PB = WS_RWT + (size_t)DEPTH * NE * D * 4;
constexpr size_t WS_XB = WS_PB + (size_t)DEPTH * T * 256 * 2;
constexpr size_t WS_U = WS_XB + (size_t)T * D * 2;
constexpr size_t WS_PE = WS_U + (size_t)T * NUP * 2;
constexpr size_t WS_MIX = WS_PE + (size_t)T * D * 4;
constexpr size_t WS_Y1 = WS_MIX + (size_t)T * D * 2;
constexpr size_t WS_X1 = WS_Y1 + (size_t)T * D * 4;
constexpr size_t WS_X1B = WS_X1 + (size_t)T * D * 4;
constexpr size_t WS_SDEST = WS_X1B + (size_t)T * D * 2;
constexpr size_t WS_SGATE = WS_SDEST + (size_t)NE * ECAP * 4;
constexpr size_t WS_ABUF = WS_SGATE + (size_t)NE * ECAP * 4;
constexpr size_t WS_YBUF = WS_ABUF + (size_t)NE * ECAP * D * 2;
constexpr size_t WS_H = WS_YBUF + (size_t)T * 4 * D * 2;
constexpr size_t WS_HB = WS_H + (size_t)T * D * 4;
constexpr size_t WS_H2 = WS_HB + (size_t)T * D * 2;
constexpr size_t WS_SSD_ST = WS_H2 + (size_t)T * D * 4;
constexpr size_t WS_SSD_DEC = WS_SSD_ST + (size_t)16 * NCH * 64 * 128 * 4;
constexpr size_t WS_GLA_ST = WS_SSD_DEC + 16 * NCH * 4;
constexpr size_t WS_GLA_DEC = WS_GLA_ST + (size_t)16 * NCH * 32 * 64 * 4;
constexpr size_t WS_ML_C = WS_GLA_DEC + (size_t)4 * NCH * 128 * 4;
constexpr size_t WS_ML_N = WS_ML_C + (size_t)16 * NCH * 64 * 64 * 4;
constexpr size_t WS_ML_BL = WS_ML_N + (size_t)16 * NCH * 64 * 4;
constexpr size_t WS_ML_ML = WS_ML_BL + 16 * NCH * 4;
constexpr size_t WS_ML_M = WS_ML_ML + 16 * NCH * 4;
constexpr size_t WS_RW = WS_ML_M + 16 * NCH * 4;
constexpr size_t WS_RW_G = WS_RW + (size_t)T * 3 * 256 * 4;
constexpr size_t WS_RW_RH = WS_RW_G + (size_t)T * 256 * 4;
constexpr size_t WS_RW_O0 = WS_RW_RH + (size_t)1024 * 4096 * 2;
constexpr size_t WS_RW_GF = WS_RW_O0 + (size_t)1024 * 4096 * 4;
constexpr size_t WS_RW_HT = WS_RW_GF + (size_t)1024 * 4096 * 2;
constexpr size_t WS_RW_PT = WS_RW_HT + (size_t)1024 * 4096 * 4;
constexpr size_t WS_LORA = WS_RW_PT + (size_t)1024 * 4096 * 2;
constexpr int LORA_PER_LAYER = 8192 + 8192 + 16384 + 2048;
constexpr size_t WS_WGU_Q = WS_LORA + (size_t)DEPTH * LORA_PER_LAYER * 4;
constexpr size_t WS_WDN_Q = WS_WGU_Q + (size_t)DEPTH * NE * 2048 * D;
constexpr size_t WS_X1Q = WS_WDN_Q + (size_t)DEPTH * NE * D * D;
constexpr size_t WS_ABUFQ = WS_X1Q + (size_t)T * D;
constexpr size_t WS_WPG_Q = WS_ABUFQ + (size_t)NE * ECAP * D;
constexpr size_t WS_HQ = WS_WPG_Q + (size_t)DEPTH * D * D;
constexpr size_t WS_WOUT_Q = WS_HQ + (size_t)T * D;
constexpr size_t WS_END = WS_WOUT_Q + (size_t)DEPTH * D * D;
#ifndef MOE_FP8
#define MOE_FP8 1
#endif
#ifndef MOE2_FP8
#define MOE2_FP8 1
#ifndef OUT_CHAIN
#define OUT_CHAIN 1
#endif
#ifndef OUT_CHAIN_POLL
#define OUT_CHAIN_POLL 1
#endif
#ifndef MOE_CHAIN
#define MOE_CHAIN 1
#endif
#ifndef RW_SOLVE_BLK
#define RW_SOLVE_BLK 1
#endif
#ifndef RW_SCAN_DMA
#define RW_SCAN_DMA 1
#endif
#ifndef P6_MFMA
#define P6_MFMA 1
#endif
#ifndef OUT_FP8
#define OUT_FP8 1
#endif
#ifndef PLE_FP8
#define PLE_FP8 1
#endif
#endif
constexpr int CW_BAR = 4096;
constexpr int CW_DBG = 32768;
constexpr int CW_PAN = 65536;
constexpr int CW_PAN2 = 196608;
constexpr int CW_CNT = 16384;

constexpr int RING_BYTES = 147456;
constexpr int MISC_OFF = RING_BYTES;
constexpr int LDS_BYTES = RING_BYTES + 1024;
constexpr int MW_BAR = 8, MW_LCNT = 32, MW_LBASE = 64, MW_PFX = 96, MW_CNT = 136, MW_GAMC = 168;

typedef __bf16 bf16x2_t __attribute__((ext_vector_type(2)));
__device__ __forceinline__ unsigned cvt_pk_bf16(float lo, float hi) { const f32x2 v = {lo, hi}; const bf16x2_t b = __builtin_convertvector(v, bf16x2_t); return __builtin_bit_cast(unsigned, b); }
__device__ __forceinline__ unsigned cvt4_fp8(float a, float b, float c, float d) { int w = 0; w = __builtin_amdgcn_cvt_pk_fp8_f32(a, b, w, false); w = __builtin_amdgcn_cvt_pk_fp8_f32(c, d, w, true); return (unsigned)w; }
__device__ __forceinline__ float bf2f(unsigned short b) { return __uint_as_float(((unsigned)b) << 16); }
__device__ __forceinline__ float sigmoidf_(float x) { return __builtin_amdgcn_rcpf(1.0f + __expf(-x)); }
__device__ __forceinline__ float siluf_(float x) { return x * __builtin_amdgcn_rcpf(1.0f + __expf(-x)); }
__device__ __forceinline__ float softplusf_(float x) { return fmaxf(x, 0.f) + __logf(1.0f + __expf(-fabsf(x))); }
__device__ __forceinline__ float logsigmoidf_(float x) { return fminf(x, 0.f) - __logf(1.0f + __expf(-fabsf(x))); }
__device__ __forceinline__ float tanhf_(float x) { const float e = __expf(-2.0f * fabsf(x)); const float t = (1.0f - e) * __builtin_amdgcn_rcpf(1.0f + e); return x < 0.f ? -t : t; }
__device__ __forceinline__ int lane_now() { int l = (int)__builtin_amdgcn_mbcnt_hi(~0u, __builtin_amdgcn_mbcnt_lo(~0u, 0u)); asm volatile("" : "+v"(l)); return l; }
__device__ __forceinline__ float my_shfl_idx(float v, int src) { return __builtin_bit_cast(float, __builtin_amdgcn_ds_bpermute(src << 2, __builtin_bit_cast(int, v))); }
__device__ __forceinline__ int my_shfl_idx(int v, int src) { return __builtin_amdgcn_ds_bpermute(src << 2, v); }
template <class V> __device__ __forceinline__ V my_shfl_xor(V v, int o) { return my_shfl_idx(v, lane_now() ^ o); }
template <class V> __device__ __forceinline__ V my_shfl_up(V v, int o) { const int l = lane_now(); return my_shfl_idx(v, l >= o ? l - o : l); }
#define __shfl_xor(v, o) my_shfl_xor(v, o)
#define __shfl_up(v, o) my_shfl_up(v, o)
#define __shfl(v, s) my_shfl_idx(v, s)
__device__ __forceinline__ float wave_sum(float v) {
#pragma unroll
    for (int o = 1; o < 64; o <<= 1) v += __shfl_xor(v, o);
    return v;
}
__device__ __forceinline__ float wave_max(float v) {
#pragma unroll
    for (int o = 1; o < 64; o <<= 1) v = fmaxf(v, __shfl_xor(v, o));
    return v;
}
__device__ __forceinline__ float wave_scan_add(float v, int lane) {
#pragma unroll
    for (int o = 1; o < 64; o <<= 1) { const float t = __shfl_up(v, o); if (lane >= o) v += t; }
    return v;
}
__device__ __forceinline__ float wave_scan_max(float v, int lane) {
#pragma unroll
    for (int o = 1; o < 64; o <<= 1) { const float t = __shfl_up(v, o); if (lane >= o) v = fmaxf(v, t); }
    return v;
}
__device__ __forceinline__ f32x4 mm16(const LAS unsigned char* A, int lda, const LAS unsigned char* B, int ldb, int K, f32x4 acc, int fr, int fq) {
    const LAS unsigned char* ap = A + fr * lda + fq * 16; const LAS unsigned char* bp = B + fr * ldb + fq * 16;
    for (int k = 0; k < K; k += 32) {
        const bf16x8 a = *(const LAS bf16x8*)(ap + k * 2); const bf16x8 b = *(const LAS bf16x8*)(bp + k * 2);
        acc = __builtin_amdgcn_mfma_f32_16x16x32_bf16(b, a, acc, 0, 0, 0);
    }
    return acc;
}
__device__ __forceinline__ f32x4 mm16_gB(const LAS unsigned char* A, int lda, const float* B, int ldb, int K, f32x4 acc, int fr, int fq) {
    const LAS unsigned char* ap = A + fr * lda + fq * 16; const float* bp = B + (size_t)fr * ldb + fq * 8;
    for (int k = 0; k < K; k += 32) {
        const bf16x8 a = *(const LAS bf16x8*)(ap + k * 2);
        const f32x4 b0 = *(const f32x4*)(bp + k), b1 = *(const f32x4*)(bp + k + 4);
        v4u bw; bw.x = cvt_pk_bf16(b0.x, b0.y); bw.y = cvt_pk_bf16(b0.z, b0.w); bw.z = cvt_pk_bf16(b1.x, b1.y); bw.w = cvt_pk_bf16(b1.z, b1.w);
        const bf16x8 b = __builtin_bit_cast(bf16x8, bw);
        acc = __builtin_amdgcn_mfma_f32_16x16x32_bf16(b, a, acc, 0, 0, 0);
    }
    return acc;
}
__device__ __forceinline__ f32x4 mm16_gAB(const bf16* A, int lda, const bf16* B, int ldb, int K, f32x4 acc, int fr, int fq) {
    const bf16* ap = A + (size_t)fr * lda + fq * 8; const bf16* bp = B + (size_t)fr * ldb + fq * 8;
    for (int k = 0; k < K; k += 32) { const bf16x8 a = *(const bf16x8*)(ap + k), b = *(const bf16x8*)(bp + k); acc = __builtin_amdgcn_mfma_f32_16x16x32_bf16(b, a, acc, 0, 0, 0); }
    return acc;
}
__device__ __forceinline__ bf16x8 ldfrag_f32(const float* p) { const f32x4 b0 = *(const f32x4*)p, b1 = *(const f32x4*)(p + 4);
    v4u bw; bw.x = cvt_pk_bf16(b0.x, b0.y); bw.y = cvt_pk_bf16(b0.z, b0.w); bw.z = cvt_pk_bf16(b1.x, b1.y); bw.w = cvt_pk_bf16(b1.z, b1.w); return __builtin_bit_cast(bf16x8, bw); }
template <int NK> __device__ __forceinline__ f32x4 mm16_rB(const LAS unsigned char* A, int lda, const bf16x8 (&b)[NK], f32x4 acc, int fr, int fq) {
    const LAS unsigned char* ap = A + fr * lda + fq * 16;
#pragma unroll
    for (int k = 0; k < NK; ++k) { const bf16x8 a = *(const LAS bf16x8*)(ap + k * 64); acc = __builtin_amdgcn_mfma_f32_16x16x32_bf16(b[k], a, acc, 0, 0, 0); }
    return acc;
}
__device__ __forceinline__ v4u pack8(const float (&v)[8]) { v4u o; o.x = cvt_pk_bf16(v[0], v[1]); o.y = cvt_pk_bf16(v[2], v[3]); o.z = cvt_pk_bf16(v[4], v[5]); o.w = cvt_pk_bf16(v[6], v[7]); return o; }

#define XB_TMO      128
#define XB_XCNT(j)  (256  + 64 * (j))
#define XB_XSUB(j)  (1280 + 64 * (j))
#define XB_XGEN(j)  (2304 + 64 * (j))
#define XB_TOP      3328
#define XB_TOPGEN   3392
#define XCD_BAR_WORDS 3456
#define XB_SPIN_CAP (1u << 18)
__device__ __forceinline__ unsigned xb_ld(unsigned* p)              { return __hip_atomic_load(p, __ATOMIC_RELAXED, __HIP_MEMORY_SCOPE_AGENT); }
__device__ __forceinline__ unsigned xb_add(unsigned* p, unsigned v) { return __hip_atomic_fetch_add(p, v, __ATOMIC_RELAXED, __HIP_MEMORY_SCOPE_AGENT); }
__device__ __forceinline__ unsigned xb_xcc_id() { return (unsigned)__builtin_amdgcn_s_getreg((3 << 11) | 20) & 0xFu; }
#define XB_SPIN(cond, bar) do { unsigned _sp = 0; while (cond) { __builtin_amdgcn_s_sleep(1); \
    if ((++_sp & 255u) == 0u) { if (xb_ld(&(bar)[XB_TMO])) break; if (_sp > XB_SPIN_CAP) { atomicAdd(&(bar)[XB_TMO], 1u); break; } } } } while (0)
struct XcdBarrier { unsigned* bar; unsigned x; volatile LAS unsigned* st; };
__device__ __forceinline__ XcdBarrier xcd_barrier_post(unsigned* bar, volatile LAS unsigned* st) {
    XcdBarrier b; b.bar = bar; b.x = xb_xcc_id(); b.st = st;
    if (threadIdx.x == 0) (void)xb_add(&bar[XB_XCNT(b.x)], 1u);
    return b;
}
__device__ __forceinline__ void xcd_barrier_complete(unsigned* bar, unsigned x, unsigned& nloc, unsigned& nx) {
    const unsigned G = gridDim.x * gridDim.y * gridDim.z;
    unsigned sum, cnt, mine, sp = 0u;
    for (;;) {
        sum = 0u; cnt = 0u; mine = 0u;
#pragma unroll
        for (unsigned j = 0; j < 16; ++j) { const unsigned c = xb_ld(&bar[XB_XCNT(j)]); sum += c; cnt += (c > 0u) ? 1u : 0u; mine = (j == x) ? c : mine; }
        if (sum == G) break;
        __builtin_amdgcn_s_sleep(1);
        if ((++sp & 255u) == 0u) { if (xb_ld(&bar[XB_TMO])) break; if (sp > XB_SPIN_CAP) { atomicAdd(&bar[XB_TMO], 1u); break; } }
    }
    nloc = mine > 0u ? mine : 1u; nx = cnt > 0u ? cnt : 1u;
}
__device__ __forceinline__ void xcd_barrier(const XcdBarrier& b) {
    asm volatile("s_waitcnt vmcnt(0)" ::: "memory");
    __syncthreads();
    if (threadIdx.x == 0) {
        unsigned* bar = b.bar;
        __builtin_amdgcn_s_waitcnt(0);
        unsigned nloc = b.st[0], nx = b.st[1];
        if (nloc == 0u) { xcd_barrier_complete(bar, b.x, nloc, nx); b.st[0] = nloc; b.st[1] = nx; }
        const unsigned k = b.st[2]; b.st[2] = k + 1u;
        const unsigned old = xb_add(&bar[XB_XSUB(b.x)], 1u);
        if (old + 1u == (k + 1u) * nloc) {
            __builtin_amdgcn_fence(__ATOMIC_RELEASE, "agent");
            asm volatile("s_waitcnt vmcnt(0)" ::: "memory");
            (void)xb_add(&bar[XB_TOP], 1u);
        }
        const unsigned target = (k + 1u) * nx;
        XB_SPIN(xb_ld(&bar[XB_TOP]) < target, bar);
        __builtin_amdgcn_fence(__ATOMIC_ACQUIRE, "agent");
        asm volatile("s_waitcnt vmcnt(0)" ::: "memory");
    }
    __syncthreads();
}

namespace pg8 {
constexpr int BM = 256, BK = 64, HALF = 128, HTB = HALF * BK * 2, STAGE_BYTES = 8 * HTB, NXCD = 8, WGM = 8;
__host__ __device__ __forceinline__ int lds_byte(int r, int c) { const int st = (r >> 4) * 2 + (c >> 5), rr = r & 15, cc = c & 31, ob = rr * 64 + cc * 2; return st * 1024 + (ob ^ (((ob >> 9) & 1) << 5)); }
__host__ __device__ __forceinline__ void stage_rc(int b, int& R, int& C) { const int st = b / 1024, sb = b % 1024, swz = sb ^ (((sb >> 9) & 1) << 5); R = (st >> 1) * 16 + swz / 64; C = (st & 1) * 32 + (swz % 64) / 2; }
__host__ __device__ __forceinline__ int perm32(int rho) { const int n = rho >> 4, i = rho & 15; return 8 * (i >> 2) + 4 * n + (i & 3); }

template <class Epi, class Sched>
__device__ __forceinline__ void gemm_phase(LAS unsigned char* lds, const int tid, const Sched& S, const Epi& E) {
    const int wid = __builtin_amdgcn_readfirstlane(tid >> 6), lane = tid & 63, wr = wid >> 2, wc = wid & 3, fr = lane & 15, fq = lane >> 4;
    const int K = S.K, nt = K / BK;
    unsigned voffB[2];
#pragma unroll
    for (int i = 0; i < 2; ++i) { int R, C; stage_rc(tid * 16 + i * 8192, R, C); const int Rb = Epi::PERM ? ((R & ~31) + perm32(R & 31)) : R; voffB[i] = (unsigned)(Rb * K + C) * 2u; }
    const size_t kstep = (size_t)(BK * 2);
    const size_t hstepB = S.hstepB;
    const unsigned ldsw = (unsigned)wid * 1024u;
    constexpr bool F8 = Sched::FP8;
    const int aoff = F8 ? lds_byte(wr * 64 + fr, fq * 16) : lds_byte(wr * 64 + fr, fq * 8), boff = F8 ? lds_byte(wc * 32 + fr, fq * 16) : lds_byte(wc * 32 + fr, fq * 8);
#define PG8_SA(b, h) (((b) * 2 + (h)) * HTB)
#define PG8_SB(b, h) ((4 + (b) * 2 + (h)) * HTB)
#define PG8_STAGE_B(bufoff, gbase) do { _Pragma("unroll") for (int _i = 0; _i < 2; ++_i) \
        __builtin_amdgcn_global_load_lds((const unsigned*)((const char*)(gbase) + voffB[_i]), (LAS unsigned*)(lds + (bufoff) + ldsw + _i * 8192), 16, 0, 0); } while (0)
#define PG8_STAGE_A(bufoff, gbase, v0, v1) do { \
        __builtin_amdgcn_global_load_lds((const unsigned*)((const char*)(gbase) + (v0)), (LAS unsigned*)(lds + (bufoff) + ldsw), 16, 0, 0); \
        __builtin_amdgcn_global_load_lds((const unsigned*)((const char*)(gbase) + (v1)), (LAS unsigned*)(lds + (bufoff) + ldsw + 8192), 16, 0, 0); } while (0)
#define PG8_FOFF(k) (F8 ? (k) * 16 : (k) * 1024)
#define PG8_LDA(dst, b, h) do { _Pragma("unroll") for (int m = 0; m < 4; ++m) { if constexpr (F8) dst##8[m] = *(const LAS v8i_t*)(lds + PG8_SA(b, h) + aoff + m * 2048); \
        else { _Pragma("unroll") for (int k = 0; k < 2; ++k) dst[m][k] = *(const LAS bf16x8*)(lds + PG8_SA(b, h) + aoff + m * 2048 + k * 1024); } } } while (0)
#define PG8_LDB(dst, b, h) do { _Pragma("unroll") for (int n = 0; n < 2; ++n) { if constexpr (F8) dst##8[n] = *(const LAS v8i_t*)(lds + PG8_SB(b, h) + boff + n * 2048); \
        else { _Pragma("unroll") for (int k = 0; k < 2; ++k) dst[n][k] = *(const LAS bf16x8*)(lds + PG8_SB(b, h) + boff + n * 2048 + k * 1024); } } } while (0)
#define PG8_CAT(x) __builtin_shufflevector(__builtin_bit_cast(v4i_t, x[0]), __builtin_bit_cast(v4i_t, x[1]), 0, 1, 2, 3, 4, 5, 6, 7)
#define PG8_MMA(ai, bj, At, Bt) do { __builtin_amdgcn_s_setprio(1); _Pragma("unroll") for (int m = 0; m < 4; ++m) _Pragma("unroll") for (int n = 0; n < 2; ++n) { \
        if constexpr (F8) acc[ai][bj][m][n] = __builtin_amdgcn_mfma_scale_f32_16x16x128_f8f6f4(Bt##8[n], At##8[m], acc[ai][bj][m][n], 0, 0, 0, S.scaleB, 0, S.scaleA); \
        else { _Pragma("unroll") for (int k = 0; k < 2; ++k) acc[ai][bj][m][n] = __builtin_amdgcn_mfma_f32_16x16x32_bf16(Bt[n][k], At[m][k], acc[ai][bj][m][n], 0, 0, 0); } } __builtin_amdgcn_s_setprio(0); } while (0)
#define PG8_WAIT_V(n) asm volatile("s_waitcnt vmcnt(" #n ")" ::: "memory")
#define PG8_WAIT_L(n) asm volatile("s_waitcnt lgkmcnt(" #n ")" ::: "memory")
#define PG8_BAR __builtin_amdgcn_s_barrier()
#define PG8_SCHED __builtin_amdgcn_sched_barrier(0)
    typename Sched::Unit cur, nxt, prv; int ui = 0;
    if (!S.next(0, cur)) return;
    prv = cur; unsigned pre = 0u;
    f32x4 acc[2][2][4][2];
#pragma unroll
    for (int a = 0; a < 2; ++a)
#pragma unroll
        for (int b = 0; b < 2; ++b)
#pragma unroll
            for (int m = 0; m < 4; ++m)
#pragma unroll
                for (int n = 0; n < 2; ++n) acc[a][b][m][n] = (f32x4){0.f, 0.f, 0.f, 0.f};
    bf16x8 At[4][2], B0[2][2], B1[2][2]; v8i_t At8[4], B08[2], B18[2];
    constexpr bool GA = Sched::GATHER;
    const size_t hstepA = GA ? (size_t)0 : (size_t)HALF * K * 2;
    unsigned vA[2][2];
    LAS unsigned char* hdr = lds + STAGE_BYTES;
    if constexpr (Sched::HDR) { if (wid == 0) S.hdr_issue(cur, hdr, lane); PG8_WAIT_V(0); PG8_BAR; }
    S.a_off(cur, tid, vA, hdr);
#define PG8_STAGE_AH(bufoff, base, vv, h) PG8_STAGE_A(bufoff, ((base) + (h) * hstepA), vv[GA ? (h) : 0][0], vv[GA ? (h) : 0][1])
    const char* cA = S.a_base(cur); const char* cB = S.b_base(cur);
    if constexpr (Sched::COUNTED) { if (wid == 0) pre = S.peek(cur); S.a_ready(cur, wid, pre); }
    PG8_STAGE_B(PG8_SB(0, 0), cB); PG8_STAGE_B(PG8_SB(0, 1), cB + hstepB); PG8_STAGE_AH(PG8_SA(0, 0), cA, vA, 0); PG8_STAGE_AH(PG8_SA(0, 1), cA, vA, 1);
    if (wr == 1) PG8_BAR;
    PG8_WAIT_V(2); PG8_BAR;
    PG8_STAGE_B(PG8_SB(1, 0), cB + kstep); PG8_STAGE_AH(PG8_SA(1, 0), cA + kstep, vA, 0); PG8_STAGE_B(PG8_SB(1, 1), cB + hstepB + kstep);
    PG8_WAIT_V(6); PG8_BAR;
    int hc = 0;
    for (;;) {
        const bool has_next = S.next(ui + 1, nxt); const int hn = (hc == 2) ? 0 : hc + 1;
        const char* nA = cA; const char* nB = cB;
        if (has_next) { nA = S.a_base(nxt); nB = S.b_base(nxt); if constexpr (Sched::HDR) { if (wid == 0) S.hdr_issue(nxt, hdr + hn * 4096, lane); } if constexpr (Sched::COUNTED) { if (wid == 0) pre = S.peek(nxt); } }
        for (int t = 0; t < nt; t += 2) {
            const bool last = (t == nt - 2);
            const char* a1 = cA + (size_t)(t + 1) * kstep;
            const char* a2 = last ? nA : cA + (size_t)(t + 2) * kstep; const char* b2 = last ? nB : cB + (size_t)(t + 2) * kstep;
            const char* a3 = a2 + kstep; const char* b3 = b2 + kstep;
            PG8_LDB(B0, 0, 0); PG8_LDB(B1, 0, 1); PG8_SCHED; PG8_LDA(At, 0, 0); PG8_STAGE_AH(PG8_SA(1, 1), a1, vA, 1);
            if constexpr (Sched::COUNTED) { if (last && has_next) S.a_ready(nxt, wid, pre); }
            if constexpr (GA) { if (last && has_next) S.a_off(nxt, tid, vA, hdr + hn * 4096); }
            PG8_WAIT_V(8); PG8_WAIT_L(0); PG8_BAR; PG8_MMA(0, 0, At, B0); PG8_MMA(0, 1, At, B1); PG8_BAR; PG8_SCHED;
            PG8_LDA(At, 0, 1); PG8_STAGE_B(PG8_SB(0, 0), b2); PG8_STAGE_B(PG8_SB(0, 1), b2 + hstepB); PG8_STAGE_AH(PG8_SA(0, 0), a2, vA, 0);
            PG8_WAIT_V(8); PG8_WAIT_L(0); PG8_BAR; PG8_MMA(1, 0, At, B0); PG8_MMA(1, 1, At, B1); PG8_BAR; PG8_SCHED;
            PG8_LDB(B0, 1, 0); PG8_LDB(B1, 1, 1); PG8_SCHED; PG8_LDA(At, 1, 0); PG8_STAGE_AH(PG8_SA(0, 1), a2, vA, 1);
            PG8_WAIT_V(8); PG8_WAIT_L(0); PG8_BAR; PG8_MMA(0, 0, At, B0); PG8_MMA(0, 1, At, B1); PG8_BAR; PG8_SCHED;
            PG8_LDA(At, 1, 1); PG8_STAGE_B(PG8_SB(1, 0), b3); PG8_STAGE_B(PG8_SB(1, 1), b3 + hstepB); PG8_STAGE_AH(PG8_SA(1, 0), a3, vA, 0);
            PG8_WAIT_V(8); PG8_WAIT_L(0); PG8_BAR; PG8_MMA(1, 0, At, B0); PG8_MMA(1, 1, At, B1); PG8_BAR; PG8_SCHED;
        }
        if (wr == 0) PG8_BAR;
        if constexpr (Sched::PUBLISH) { if (ui > 0) S.publish(prv, lane); }
        { int fr_ = fr, fq_ = fq; asm volatile("" : "+v"(fr_), "+v"(fq_)); E(acc, cur, wr, wc, fr_, fq_, hdr + hc * 4096); }
        if (!has_next) break;
#pragma unroll
        for (int a = 0; a < 2; ++a)
#pragma unroll
            for (int b = 0; b < 2; ++b)
#pragma unroll
                for (int m = 0; m < 4; ++m)
#pragma unroll
                    for (int n = 0; n < 2; ++n) acc[a][b][m][n] = (f32x4){0.f, 0.f, 0.f, 0.f};
        prv = cur; cur = nxt; cA = nA; cB = nB; ++ui; hc = hn;
        if (wr == 1) PG8_BAR;
    }
    PG8_WAIT_V(0);
    if constexpr (Sched::PUBLISH) S.publish(cur, lane);
    PG8_BAR;
#undef PG8_SA
#undef PG8_SB
#undef PG8_STAGE_A
#undef PG8_STAGE_AH
#undef PG8_STAGE_B
#undef PG8_LDA
#undef PG8_LDB
#undef PG8_MMA
#undef PG8_CAT
#undef PG8_FOFF
#undef PG8_WAIT_V
#undef PG8_WAIT_L
#undef PG8_BAR
#undef PG8_SCHED
}
}
struct Args { const float* in[N_IN]; float* out; unsigned char* ws; int ph_lo, ph_hi; };
typedef const __attribute__((address_space(4))) unsigned long long* karg_t;
struct Frame {
    karg_t ka;
    LAS unsigned char* lds;
    volatile LAS unsigned* MISC;
    gu32* ctl;
    unsigned char* ws;
    float* out;
    int tid, lane, wave, vcu, G;
};
#define WSP(T_, off) ((T_*)(F.ws + (off)))
#define KIN(k) ((const float*)F.ka[(k)])
#ifdef DBG_SEL
#define DBG_STAT(k, val) do { const float _v = (val); if ((k) == DBG_SEL) { if (fabsf(_v) < 3e38f) atomicMax((unsigned*)(F.ctl + CW_DBG), __float_as_uint(fabsf(_v))); else atomicAdd((unsigned*)(F.ctl + CW_DBG + 1), 1u); } } while (0)
#else
#define DBG_STAT(k, val) do { } while (0)
#endif
template <class P> __device__ __forceinline__ P launder_uniform(P p) {
    unsigned lo = (unsigned)(unsigned long long)p, hi = (unsigned)((unsigned long long)p >> 32);
    asm volatile("" : "+v"(lo), "+v"(hi));
    lo = __builtin_amdgcn_readfirstlane(lo); hi = __builtin_amdgcn_readfirstlane(hi);
    return (P)(((unsigned long long)hi << 32) | lo);
}
__device__ __forceinline__ void frame_refresh(Frame& F) {
    int t = F.tid; asm volatile("" : "+v"(t)); F.tid = t; F.lane = t & 63; F.wave = __builtin_amdgcn_readfirstlane(t >> 6);
    F.ws = launder_uniform(F.ws); F.ctl = (gu32*)(F.ws + WS_CTL);
    F.out = launder_uniform(F.out);
    F.ka = launder_uniform(F.ka);
}

namespace pg8 {
struct DenseSched {
    static constexpr bool GATHER = false, FP8 = false, HDR = false, COUNTED = false, PUBLISH = false; static constexpr int scaleA = 0, scaleB = 0;
    struct Unit { int pm, pn; };
    __device__ __forceinline__ void hdr_issue(const Unit&, LAS unsigned char*, int) const {}
    const bf16* A; const bf16* Bt; int K; size_t hstepB; int nM, nN, nwg, G, c;
    __device__ __forceinline__ void init(const bf16* A_, const bf16* Bt_, int M, int N, int K_, int G_, int c_) { A = A_; Bt = Bt_; K = K_; hstepB = (size_t)HALF * K_ * 2; nM = M / BM; nN = N / BM; nwg = nM * nN; G = G_; c = c_; }
    __device__ __forceinline__ bool next(int i, Unit& u) const {
        const long L = (long)i * G + c; if (L >= nwg) return false;
        int wgid = (int)L; { const int q = nwg / NXCD, r = nwg % NXCD, xcd = wgid % NXCD, off = wgid / NXCD; wgid = (xcd < r ? xcd * (q + 1) : r * (q + 1) + (xcd - r) * q) + off; }
        const int nig = WGM * nN, gid = wgid / nig, fm = gid * WGM, gsz = (nM - fm) < WGM ? (nM - fm) : WGM;
        u.pm = fm + ((wgid % nig) % gsz); u.pn = (wgid % nig) / gsz; return true;
    }
    __device__ __forceinline__ const char* a_base(const Unit& u) const { return (const char*)A + (size_t)u.pm * BM * K * 2; }
    __device__ __forceinline__ const char* b_base(const Unit& u) const { return (const char*)Bt + (size_t)u.pn * BM * K * 2; }
    __device__ __forceinline__ void a_off(const Unit&, int tid, unsigned (&v)[2][2], const LAS unsigned char*) const {
#pragma unroll
        for (int i = 0; i < 2; ++i) { int R, C; stage_rc(tid * 16 + i * 8192, R, C); v[0][i] = (unsigned)(R * K + C) * 2u; v[1][i] = v[0][i]; }
    }
};
template <int SB> struct DenseSched8T : DenseSched { static constexpr bool GATHER = true, FP8 = true; static constexpr int scaleA = 0x7F7F7F7F, scaleB = SB;
    __device__ __forceinline__ void a_off(const Unit&, int tid, unsigned (&v)[2][2], const LAS unsigned char*) const {
        int t_ = tid; asm volatile("" : "+v"(t_));
#pragma unroll
        for (int i = 0; i < 2; ++i) { int R, C; stage_rc(t_ * 16 + i * 8192, R, C); v[0][i] = (unsigned)(R * K + C) * 2u; v[1][i] = v[0][i] + (unsigned)(HALF * K * 2); }
    }
};
typedef DenseSched8T<0x7A7A7A7A> DenseSched8;
typedef DenseSched8T<0x79797979> DenseSched8b;
struct OutSched : DenseSched8b { static constexpr bool PUBLISH = true; gu32* pan;
    __device__ __forceinline__ void publish(const Unit& u, int lane) const { if (lane == 0) (void)__hip_atomic_fetch_add(pan + u.pm * 16, 1u, RLX_AGENT); } };
struct MoeUnit { int e, mt, nt, cnt; };
struct MoeOrder {
    const volatile LAS unsigned* pfx;
    int NT, G, c;
    __device__ __forceinline__ bool decode(int i, MoeUnit& u) const {
        const int nwg = (int)pfx[32]; const long L = (long)i * G + c; if (L >= nwg) return false;
        int wgid = (int)L; { const int q = nwg / NXCD, r = nwg % NXCD, xcd = wgid % NXCD, off = wgid / NXCD; wgid = (xcd < r ? xcd * (q + 1) : r * (q + 1) + (xcd - r) * q) + off; }
        int e = 0;
#pragma unroll
        for (int st = 16; st >= 1; st >>= 1) e += ((int)pfx[e + st] <= wgid) ? st : 0;
        const int j = wgid - (int)pfx[e];
        u.e = e; u.mt = j / NT; u.nt = j % NT; u.cnt = (int)pfx[40 + e]; return true;
    }
};
#ifndef HDR_AOFF
#define HDR_AOFF 1
#endif
struct Moe1Sched {
    static constexpr bool GATHER = true, FP8 = (MOE_FP8 != 0), HDR = true, COUNTED = false, PUBLISH = (MOE_CHAIN != 0); static constexpr int EB = FP8 ? 1 : 2; static constexpr int scaleA = 0x7F7F7F7F, scaleB = 0x7A7A7A7A;
    typedef MoeUnit Unit;
    MoeOrder O; const unsigned char* X; const unsigned char* W; const int* sdest; const float* bgu; int K; size_t hstepB; gu32* pan;
    __device__ __forceinline__ void publish(const Unit& u, int lane) const { if (lane == 0) (void)__hip_atomic_fetch_add(pan + (u.e * 64 + u.mt) * 16, 1u, RLX_AGENT); }
    __device__ __forceinline__ void hdr_issue(const Unit& u, LAS unsigned char* hdr, int lane) const {
        __builtin_amdgcn_global_load_lds((const unsigned*)(sdest + (size_t)u.e * ECAP + (size_t)u.mt * 256 + lane * 4), (LAS unsigned*)hdr, 16, 0, 0);
        const float* bp = bgu + (size_t)u.e * 2048 + u.nt * 128 + (lane < 32 ? lane * 4 : 1024 + (lane - 32) * 4);
        __builtin_amdgcn_global_load_lds((const unsigned*)bp, (LAS unsigned*)(hdr + 1024), 16, 0, 0);
    }
    __device__ __forceinline__ bool next(int i, Unit& u) const { return O.decode(i, u); }
    __device__ __forceinline__ const char* a_base(const Unit&) const { return (const char*)X; }
    __device__ __forceinline__ const char* b_base(const Unit& u) const { return (const char*)W + ((size_t)u.e * 2048 + (size_t)u.nt * 128) * 1024 * EB; }
    __device__ __forceinline__ void a_off(const Unit& u, int tid, unsigned (&v)[2][2], const LAS unsigned char* hdr) const {
#pragma unroll
        for (int i = 0; i < 2; ++i) { int R, C; stage_rc(tid * 16 + i * 8192, R, C);
#pragma unroll
            for (int h = 0; h < 2; ++h) { const int sl = h * HALF + R; int tok = 0; if (u.mt * 256 + sl < u.cnt) tok = HDR_AOFF ? (((const LAS int*)hdr)[sl] >> 2) : (sdest[u.e * ECAP + u.mt * 256 + sl] >> 2); v[h][i] = (unsigned)(tok * 1024 * EB + C * 2); } }
    }
};
struct Moe2Sched {
    static constexpr bool GATHER = true, FP8 = (MOE2_FP8 != 0), HDR = true, COUNTED = (MOE_CHAIN != 0), PUBLISH = false; static constexpr int EB = FP8 ? 1 : 2; static constexpr int scaleA = 0x7F7F7F7F, scaleB = 0x79797979;
    typedef MoeUnit Unit;
    MoeOrder O; const unsigned char* Ab; const unsigned char* W; const int* sdest; const float* sgate; const float* bdn; int K; size_t hstepB; gu32* pan; gu32* tmo;
    __device__ __forceinline__ unsigned peek(const Unit& u) const { return __hip_atomic_load(pan + (u.e * 64 + u.mt) * 16, RLX_AGENT); }
    __device__ __forceinline__ void a_ready(const Unit& u, int wid, unsigned pre) const {
        if (wid == 0) {
            if ((unsigned)__builtin_amdgcn_readfirstlane(pre) < 64u) { unsigned sp = 0u;
                while ((unsigned)__builtin_amdgcn_readfirstlane(__hip_atomic_load(pan + (u.e * 64 + u.mt) * 16, RLX_AGENT)) < 64u) { __builtin_amdgcn_s_sleep(2);
                    if ((++sp & 255u) == 0u) { if (__hip_atomic_load(tmo, RLX_AGENT)) break; if (sp > (1u << 18)) { atomicAdd((unsigned*)tmo, 1u); break; } } } }
            __builtin_amdgcn_fence(__ATOMIC_ACQUIRE, "agent"); asm volatile("s_waitcnt vmcnt(0)" ::: "memory");
        }
        asm volatile("" ::: "memory"); __builtin_amdgcn_s_barrier(); asm volatile("" ::: "memory");
    }
    __device__ __forceinline__ void hdr_issue(const Unit& u, LAS unsigned char* hdr, int lane) const {
        const size_t so = (size_t)u.e * ECAP + (size_t)u.mt * 256 + lane * 4;
        __builtin_amdgcn_global_load_lds((const unsigned*)(sdest + so), (LAS unsigned*)hdr, 16, 0, 0);
        __builtin_amdgcn_global_load_lds((const unsigned*)(sgate + so), (LAS unsigned*)(hdr + 1024), 16, 0, 0);
        __builtin_amdgcn_global_load_lds((const unsigned*)(bdn + (size_t)u.e * 1024 + u.nt * 256 + lane * 4), (LAS unsigned*)(hdr + 2048), 16, 0, 0);
    }
    __device__ __forceinline__ bool next(int i, Unit& u) const { return O.decode(i, u); }
    __device__ __forceinline__ const char* a_base(const Unit& u) const { return (const char*)Ab + ((size_t)u.e * ECAP + (size_t)u.mt * 256) * 1024 * EB; }
    __device__ __forceinline__ const char* b_base(const Unit& u) const { return (const char*)W + ((size_t)u.e * 1024 + (size_t)u.nt * 256) * 1024 * EB; }
    __device__ __forceinline__ void a_off(const Unit&, int tid, unsigned (&v)[2][2], const LAS unsigned char*) const {
        int t_ = tid; asm volatile("" : "+v"(t_));
#pragma unroll
        for (int i = 0; i < 2; ++i) { int R, C; stage_rc(t_ * 16 + i * 8192, R, C); v[0][i] = (unsigned)(R * 1024 * EB + C * 2); v[1][i] = v[0][i] + (unsigned)(HALF * 1024 * EB); }
    }
};

__device__ __forceinline__ void unpack8(const v4u w, f32x4& a, f32x4& b) {
    a = (f32x4){__uint_as_float(w.x << 16), __uint_as_float(w.x & 0xffff0000u), __uint_as_float(w.y << 16), __uint_as_float(w.y & 0xffff0000u)};
    b = (f32x4){__uint_as_float(w.z << 16), __uint_as_float(w.z & 0xffff0000u), __uint_as_float(w.w << 16), __uint_as_float(w.w & 0xffff0000u)}; }
struct EpiF32 {
    static constexpr bool PERM = false;
    float* C; int ldc; const float* base; float alpha;
    __device__ __forceinline__ void operator()(const f32x4 (&acc)[2][2][4][2], const DenseSched::Unit& u, int wr, int wc, int fr, int fq, const LAS unsigned char* hdr) const {
        const int row0 = u.pm * BM + wr * 64 + fr, col0 = u.pn * BM + wc * 32 + 4 * fq;
#pragma unroll
        for (int ai = 0; ai < 2; ++ai)
#pragma unroll
            for (int m = 0; m < 4; ++m) { const size_t ro = (size_t)(row0 + ai * HALF + m * 16) * ldc + col0;
#pragma unroll
                for (int bj = 0; bj < 2; ++bj)
#pragma unroll
                    for (int n = 0; n < 2; ++n) { f32x4 v = acc[ai][bj][m][n];
                        if (base) { const f32x4 b = *(const f32x4*)(base + ro + bj * HALF + n * 16); v = v + b * alpha; }
                        *(f32x4*)(C + ro + bj * HALF + n * 16) = v; } }
    }
};
template <bool WT> struct EpiB16T {
    static constexpr bool PERM = true;
    bf16* O; int ldc; const bf16* base; float alpha;
    __device__ __forceinline__ void operator()(const f32x4 (&acc)[2][2][4][2], const DenseSched::Unit& u, int wr, int wc, int fr, int fq, const LAS unsigned char* hdr) const {
        const int row0 = u.pm * BM + wr * 64 + fr, col0 = u.pn * BM + wc * 32 + 8 * fq;
#pragma unroll
        for (int ai = 0; ai < 2; ++ai) {
            v4u bw[4][2];
            if (base) {
#pragma unroll
                for (int m = 0; m < 4; ++m)
#pragma unroll
                    for (int bj = 0; bj < 2; ++bj) bw[m][bj] = *(const v4u*)(base + (size_t)(row0 + ai * HALF + m * 16) * ldc + col0 + bj * HALF); }
#pragma unroll
            for (int m = 0; m < 4; ++m) { bf16* rowp = O + (size_t)(row0 + ai * HALF + m * 16) * ldc + col0;
#pragma unroll
                for (int bj = 0; bj < 2; ++bj) { f32x4 v0 = acc[ai][bj][m][0], v1 = acc[ai][bj][m][1];
                    if (base) { f32x4 b0, b1; unpack8(bw[m][bj], b0, b1); v0 = v0 + b0 * alpha; v1 = v1 + b1 * alpha; }
                    v4u w; w.x = cvt_pk_bf16(v0[0], v0[1]); w.y = cvt_pk_bf16(v0[2], v0[3]); w.z = cvt_pk_bf16(v1[0], v1[1]); w.w = cvt_pk_bf16(v1[2], v1[3]);
                    if constexpr (WT) { bf16* sp_ = rowp + bj * HALF; asm volatile("global_store_dwordx4 %0, %1, off sc1\n\ts_nop 1" :: "v"(sp_), "v"(w) : "memory"); }
                    else *(v4u*)(rowp + bj * HALF) = w; } } }
    }
};
typedef EpiB16T<false> EpiB16; typedef EpiB16T<true> EpiB16W;
struct EpiPle {
    static constexpr bool PERM = true;
    bf16* C; const bf16* hb; const bf16* pe;
    __device__ __forceinline__ void operator()(const f32x4 (&acc)[2][2][4][2], const DenseSched::Unit& u, int wr, int wc, int fr, int fq, const LAS unsigned char* hdr) const {
        const int row0 = u.pm * BM + wr * 64 + fr, col0 = u.pn * BM + wc * 32 + 8 * fq;
#pragma unroll
        for (int ai = 0; ai < 2; ++ai) {
            v4u hw[4][2], pw[4][2];
#pragma unroll
            for (int m = 0; m < 4; ++m)
#pragma unroll
                for (int bj = 0; bj < 2; ++bj) { const size_t ro = (size_t)(row0 + ai * HALF + m * 16) * 1024 + col0 + bj * HALF; hw[m][bj] = *(const v4u*)(hb + ro); pw[m][bj] = *(const v4u*)(pe + ro); }
#pragma unroll
            for (int m = 0; m < 4; ++m)
#pragma unroll
                for (int bj = 0; bj < 2; ++bj) { const size_t ro = (size_t)(row0 + ai * HALF + m * 16) * 1024 + col0 + bj * HALF;
                    f32x4 h0, h1, p0, p1; unpack8(hw[m][bj], h0, h1); unpack8(pw[m][bj], p0, p1); const f32x4 a0 = acc[ai][bj][m][0], a1 = acc[ai][bj][m][1];
                    f32x4 o0, o1;
#pragma unroll
                    for (int j = 0; j < 4; ++j) { o0[j] = h0[j] + sigmoidf_(a0[j]) * p0[j]; o1[j] = h1[j] + sigmoidf_(a1[j]) * p1[j]; }
                    v4u w; w.x = cvt_pk_bf16(o0[0], o0[1]); w.y = cvt_pk_bf16(o0[2], o0[3]); w.z = cvt_pk_bf16(o1[0], o1[1]); w.w = cvt_pk_bf16(o1[2], o1[3]);
                    *(v4u*)(C + ro) = w; } }
    }
};
struct EpiMoe1 {
    static constexpr bool PERM = true;
    bf16* Ab; const float* bgu; unsigned char* AbQ;
    __device__ __forceinline__ void operator()(const f32x4 (&acc)[2][2][4][2], const MoeUnit& u, int wr, int wc, int fr, int fq, const LAS unsigned char* hdr) const {
        const int col0 = u.nt * 128 + wc * 32 + 8 * fq;
        const LAS float* bh = (const LAS float*)(hdr + 1024) + wc * 32 + 8 * fq;
        const f32x4 bg0 = *(const LAS f32x4*)(bh), bg1 = *(const LAS f32x4*)(bh + 4), bl0 = *(const LAS f32x4*)(bh + 128), bl1 = *(const LAS f32x4*)(bh + 132);
#pragma unroll
        for (int ai = 0; ai < 2; ++ai)
#pragma unroll
            for (int m = 0; m < 4; ++m) { const int r = ai * HALF + wr * 64 + m * 16 + fr;
                bf16* rowp = Ab + ((size_t)u.e * ECAP + (size_t)u.mt * 256 + r) * 1024 + col0;
                float o[8];
#pragma unroll
                for (int n = 0; n < 2; ++n) { const f32x4 g4 = acc[ai][0][m][n] + (n ? bg1 : bg0), l4 = acc[ai][1][m][n] + (n ? bl1 : bl0);
#pragma unroll
                    for (int j = 0; j < 4; ++j) { const float g = fminf(g4[j], 7.0f), l = fminf(fmaxf(l4[j], -7.0f), 7.0f); o[n * 4 + j] = (l + 1.0f) * g * sigmoidf_(1.702f * g); } }
                if constexpr (MOE2_FP8) { v2u q; q.x = cvt4_fp8(o[0], o[1], o[2], o[3]); q.y = cvt4_fp8(o[4], o[5], o[6], o[7]); unsigned char* qp = (unsigned char*)AbQ + ((size_t)u.e * ECAP + (size_t)u.mt * 256 + r) * 1024 + col0;
                    if (MOE_CHAIN) asm volatile("global_store_dwordx2 %0, %1, off sc1" :: "v"(qp), "v"(q) : "memory");
                    else *(v2u*)qp = q; }
                else *(v4u*)rowp = pack8(o); }
    }
};
struct EpiMoe2 {
    static constexpr bool PERM = true;
    bf16* Y; const float* bdn; const int* sdest; const float* sgate;
    __device__ __forceinline__ void operator()(const f32x4 (&acc)[2][2][4][2], const MoeUnit& u, int wr, int wc, int fr, int fq, const LAS unsigned char* hdr) const {
        const int col0 = u.nt * 256 + wc * 32 + 8 * fq;
        const LAS float* bp = (const LAS float*)(hdr + 2048) + wc * 32 + 8 * fq;
#pragma unroll
        for (int ai = 0; ai < 2; ++ai) {
            f32x4 bv[2][2];
#pragma unroll
            for (int bj = 0; bj < 2; ++bj)
#pragma unroll
                for (int n = 0; n < 2; ++n) bv[bj][n] = *(const LAS f32x4*)(bp + bj * HALF + 4 * n);
            int dest[4]; float gate[4];
#pragma unroll
            for (int m = 0; m < 4; ++m) { const int sl = ai * HALF + wr * 64 + m * 16 + fr; const bool ok = u.mt * 256 + sl < u.cnt;
                dest[m] = ok ? ((const LAS int*)hdr)[sl] : T * 4; gate[m] = ok ? ((const LAS float*)(hdr + 1024))[sl] : 0.f; }
#pragma unroll
            for (int m = 0; m < 4; ++m) {
                { const float g = gate[m]; bf16* rowp = Y + (size_t)dest[m] * 1024 + col0;
#pragma unroll
                    for (int bj = 0; bj < 2; ++bj) { const f32x4 v0 = (acc[ai][bj][m][0] + bv[bj][0]) * g, v1 = (acc[ai][bj][m][1] + bv[bj][1]) * g;
                        v4u w; w.x = cvt_pk_bf16(v0[0], v0[1]); w.y = cvt_pk_bf16(v0[2], v0[3]); w.z = cvt_pk_bf16(v1[0], v1[1]); w.w = cvt_pk_bf16(v1[2], v1[3]);
                        *(v4u*)(rowp + bj * HALF) = w; } } } }
    }
};
}

__device__ __forceinline__ void p0_transpose_item(const float* W, int K, int N, int nblk, bf16* WT, int item, int lane) {
    const int kb = item / nblk, nb = item % nblk, k0 = 64 * kb, n = 64 * nb + lane;
    const bool ok = n < N; const float* src = W + (size_t)k0 * N + (ok ? n : 0);
    float x[64];
#pragma unroll
    for (int j = 0; j < 64; ++j) x[j] = __builtin_nontemporal_load(src + (size_t)j * N);
    bf16* dst = WT + (size_t)n * K + k0;
#pragma unroll
    for (int q = 0; q < 8; ++q) { v4u o; o.x = cvt_pk_bf16(x[8 * q], x[8 * q + 1]); o.y = cvt_pk_bf16(x[8 * q + 2], x[8 * q + 3]); o.z = cvt_pk_bf16(x[8 * q + 4], x[8 * q + 5]); o.w = cvt_pk_bf16(x[8 * q + 6], x[8 * q + 7]);
        if (!ok) o = (v4u){0u, 0u, 0u, 0u};
        *(v4u*)(dst + 8 * q) = o; }
}
__device__ __forceinline__ void cvt_rows(const float* src, bf16* dst, size_t n8, size_t i0, size_t stride) {
    for (size_t i = i0; i < n8; i += stride) { const f32x4 a = *(const f32x4*)(src + i * 8), b = *(const f32x4*)(src + i * 8 + 4);
        v4u o; o.x = cvt_pk_bf16(a.x, a.y); o.y = cvt_pk_bf16(a.z, a.w); o.z = cvt_pk_bf16(b.x, b.y); o.w = cvt_pk_bf16(b.z, b.w); *(v4u*)(dst + i * 8) = o; }
}
__device__ __forceinline__ void p0_prologue(Frame& F, const Args& A) {
    const int gw = F.vcu * NWAVES + F.wave, NGW = F.G * NWAVES;
    constexpr int I_IN = 16 * (NUP / 64), I_OUT = 16 * 16, I_GU = 16 * 32, I_DN = 16 * 16, I_PG = 16 * 16, I_PP = 4 * 16;
    constexpr int PER_LAYER = I_IN + I_OUT + NE * I_GU + NE * I_DN + I_PG + I_PP;
#pragma unroll 1
    for (int it = gw; it < DEPTH * PER_LAYER; it += NGW) {
        const int l = it / PER_LAYER; int r = it % PER_LAYER;
        const float* W; bf16* WT; int K = D, N = D, nblk = 16;
        if (r < I_IN) { W = KIN(I_WIN) + (size_t)l * D * NU; WT = WSP(bf16, WS_WIN_T) + (size_t)l * NUP * D; N = NU; nblk = NUP / 64; }
        else if ((r -= I_IN) < I_OUT) { if (OUT_FP8) continue; W = KIN(I_WOUT) + (size_t)l * D * D; WT = WSP(bf16, WS_WOUT_T) + (size_t)l * D * D; }
        else if ((r -= I_OUT) < NE * I_GU) { if (MOE_FP8) continue; const int e = r / I_GU; r %= I_GU; W = KIN(I_WGU) + ((size_t)l * NE + e) * D * 2048; WT = WSP(bf16, WS_WGU_T) + ((size_t)l * NE + e) * 2048 * D; N = 2048; nblk = 32; }
        else if ((r -= NE * I_GU) < NE * I_DN) { if (MOE2_FP8) continue; const int e = r / I_DN; r %= I_DN; W = KIN(I_WDN) + ((size_t)l * NE + e) * D * D; WT = WSP(bf16, WS_WDN_T) + ((size_t)l * NE + e) * D * D; }
        else if ((r -= NE * I_DN) < I_PG) { if (PLE_FP8) continue; W = KIN(I_PGW) + (size_t)l * D * D; WT = WSP(bf16, WS_WPG_T) + (size_t)l * D * D; }
        else { r -= I_PG; W = KIN(I_PPJ) + (size_t)l * 256 * D; WT = WSP(bf16, WS_WPP_T) + (size_t)l * D * 256; K = 256; }
        p0_transpose_item(W, K, N, nblk, WT, r, F.lane);
    }
#if MOE_FP8
    constexpr int Q_GU = 16 * 32, Q_DN = 16 * 16, Q_PG = PLE_FP8 ? 16 * 16 : 0, Q_OUT = OUT_FP8 ? 16 * 16 : 0, Q_PER_LAYER = NE * (Q_GU + Q_DN) + Q_PG + Q_OUT;
#pragma unroll 1
    for (int it = gw; it < DEPTH * Q_PER_LAYER; it += NGW) {
        const int l = it / Q_PER_LAYER; int r = it % Q_PER_LAYER; const float* W; unsigned char* WQ; int N; float sc;
        if (r < NE * Q_GU) { const int e = r / Q_GU; r %= Q_GU; W = KIN(I_WGU) + ((size_t)l * NE + e) * D * 2048; WQ = WSP(unsigned char, WS_WGU_Q) + ((size_t)l * NE + e) * 2048 * D; N = 2048; sc = 32.0f; }
        else if (r >= NE * (Q_GU + Q_DN) + Q_PG) { r -= NE * (Q_GU + Q_DN) + Q_PG; W = KIN(I_WOUT) + (size_t)l * D * D; WQ = WSP(unsigned char, WS_WOUT_Q) + (size_t)l * D * D; N = D; sc = 64.0f; }
        else if (r >= NE * (Q_GU + Q_DN)) { r -= NE * (Q_GU + Q_DN); W = KIN(I_PGW) + (size_t)l * D * D; WQ = WSP(unsigned char, WS_WPG_Q) + (size_t)l * D * D; N = D; sc = 32.0f; }
        else { if (!MOE2_FP8) continue; r -= NE * Q_GU; const int e = r / Q_DN; r %= Q_DN; W = KIN(I_WDN) + ((size_t)l * NE + e) * D * D; WQ = WSP(unsigned char, WS_WDN_Q) + ((size_t)l * NE + e) * D * D; N = D; sc = 64.0f; }
        const int nblk = N / 64, kb = r / nblk, nb = r % nblk, k0 = 64 * kb, n = 64 * nb + F.lane;
        const float* src = W + (size_t)k0 * N + n; float x[64];
#pragma unroll
        for (int j = 0; j < 64; ++j) x[j] = __builtin_nontemporal_load(src + (size_t)j * N) * sc;
        unsigned char* dst = WQ + (size_t)n * D + k0;
#pragma unroll
        for (int q = 0; q < 4; ++q) { v4u o; o.x = cvt4_fp8(x[16 * q], x[16 * q + 1], x[16 * q + 2], x[16 * q + 3]); o.y = cvt4_fp8(x[16 * q + 4], x[16 * q + 5], x[16 * q + 6], x[16 * q + 7]);
            o.z = cvt4_fp8(x[16 * q + 8], x[16 * q + 9], x[16 * q + 10], x[16 * q + 11]); o.w = cvt4_fp8(x[16 * q + 12], x[16 * q + 13], x[16 * q + 14], x[16 * q + 15]); *(v4u*)(dst + 16 * q) = o; }
    }
#endif
    const size_t gt = (size_t)F.vcu * (NWAVES * 64) + F.tid, NT_ = (size_t)F.G * NWAVES * 64;
    cvt_rows(KIN(I_P), WSP(bf16, WS_PB), (size_t)DEPTH * T * 256 / 8, gt, NT_);
    cvt_rows(KIN(I_X), WSP(bf16, WS_XB), (size_t)T * D / 8, gt, NT_);
    for (size_t i = gt; i < (size_t)DEPTH * LORA_PER_LAYER; i += NT_) { const int l = (int)(i / LORA_PER_LAYER); int r = (int)(i % LORA_PER_LAYER); float v;
        if (r < 8192) { const int ch = r >> 5, j = r & 31; v = KIN(I_RWUP)[(size_t)l * 8192 + j * 256 + ch]; }
        else if (r < 16384) { r -= 8192; const int ch = r >> 5, j = r & 31; v = KIN(I_RAUP)[(size_t)l * 8192 + j * 256 + ch]; }
        else if (r < 32768) { r -= 16384; const int ch = r >> 6, j = r & 63; v = KIN(I_RGUP)[(size_t)l * 16384 + j * 256 + ch]; }
        else { r -= 32768; const int d = r >> 4, j = r & 15; v = KIN(I_GGUP)[(size_t)l * 2048 + j * 128 + d]; }
        WSP(float, WS_LORA)[i] = v; }
#if P6_MFMA
    for (size_t i = gt; i < (size_t)DEPTH * 32768; i += NT_) { const int l = (int)(i >> 15), r = (int)(i & 32767), c = r >> 8, e = (r >> 3) & 31, k = 8 * c + (r & 7);
        const float v = KIN(I_RTW)[(size_t)l * D * NE + (size_t)k * NE + e]; const unsigned h = cvt_pk_bf16(v, 0.f) & 0xffffu; const unsigned lo = cvt_pk_bf16(v - __uint_as_float(h << 16), 0.f) & 0xffffu;
        unsigned short* dst = WSP(unsigned short, WS_RWT) + (size_t)l * 65536 + r; dst[0] = (unsigned short)h; dst[32768] = (unsigned short)lo; }
#else
    for (size_t i = gt; i < (size_t)DEPTH * NE * D; i += NT_) { const int l = (int)(i / (NE * D)), r = (int)(i % (NE * D)), e = r / D, k = r % D; WSP(float, WS_RWT)[i] = KIN(I_RTW)[(size_t)l * D * NE + (size_t)k * NE + e]; }
#endif
}

#if P6_MFMA
template <bool DRY> __device__ __forceinline__ void p6_ln1_router(Frame& F, const Args& A, int layer, const gu32* pan = nullptr) {
    const bf16* y1 = WSP(bf16, WS_Y1); bf16* x1b = WSP(bf16, WS_X1B);
    const float* gam = KIN(I_LN1G) + layer * D; const float* bet = KIN(I_LN1B) + layer * D;
    const unsigned char* rwq = WSP(unsigned char, WS_RWT) + (size_t)layer * 131072; const float* rb = KIN(I_RTB) + layer * NE;
    int* sdest = WSP(int, WS_SDEST); float* sgate = WSP(float, WS_SGATE);
    unsigned* cnt = (unsigned*)(F.ctl + CW_CNT + layer * NE * 16);
    LAS unsigned char* WL = F.lds;
    LAS float* LG = (LAS float*)(F.lds + 131072);
    LAS float* TOPV = (LAS float*)(F.lds + 139264) + F.wave * 64;
    LAS int* TOPE = (LAS int*)(F.lds + 139264 + 2048) + F.wave * 64;
    LAS float* STAT = (LAS float*)(F.lds + 143360);
    volatile LAS unsigned* lcnt = F.MISC + MW_LCNT; volatile LAS unsigned* lbase = F.MISC + MW_LBASE;
    { const int l0 = F.lane;
#pragma unroll
      for (int i = 0; i < 16; ++i) { const int off = (F.wave * 16 + i) * 1024; __builtin_amdgcn_global_load_lds((const unsigned*)(rwq + off + l0 * 16), (LAS unsigned*)(WL + off), 16, 0, 0); } }
    const int lane = F.lane, m = lane & 15, g = lane >> 4, rq = F.wave & 3, kh = F.wave >> 2;
    for (int blk = F.vcu; blk < T / 64; blk += F.G) {
        if (F.tid < 32) lcnt[F.tid] = 0u;
        if (OUT_CHAIN && pan) {
            if (F.wave == 0) { const gu32* w = pan + (blk >> 2) * 16; unsigned sp = 0u;
                while ((unsigned)__builtin_amdgcn_readfirstlane(__hip_atomic_load(w, RLX_AGENT)) < 32u) { __builtin_amdgcn_s_sleep(2);
                    if ((++sp & 255u) == 0u) { if (__hip_atomic_load(F.ctl + CW_BAR + XB_TMO, RLX_AGENT)) break; if (sp > (1u << 18)) { atomicAdd((unsigned*)(F.ctl + CW_BAR + XB_TMO), 1u); break; } } }
                __builtin_amdgcn_fence(__ATOMIC_ACQUIRE, "agent"); asm volatile("s_waitcnt vmcnt(0)" ::: "memory"); }
            __syncthreads(); }
        const int row = blk * 64 + rq * 16 + m; const size_t ro = (size_t)row * D + 512 * kh + 8 * g;
        v4u yw[16];
#pragma unroll
        for (int kk = 0; kk < 16; ++kk) yw[kk] = *(const v4u*)(y1 + ro + 32 * kk);
        float s = 0.f, s2 = 0.f;
#pragma unroll
        for (int kk = 0; kk < 16; ++kk) { f32x4 a, b; pg8::unpack8(yw[kk], a, b); s += ((a.x + a.y) + (a.z + a.w)) + ((b.x + b.y) + (b.z + b.w));
            s2 += ((a.x * a.x + a.y * a.y) + (a.z * a.z + a.w * a.w)) + ((b.x * b.x + b.y * b.y) + (b.z * b.z + b.w * b.w)); }
        s += __shfl_xor(s, 16); s += __shfl_xor(s, 32); s2 += __shfl_xor(s2, 16); s2 += __shfl_xor(s2, 32);
        if (g == 0) { STAT[(kh * 64 + rq * 16 + m) * 2] = s; STAT[(kh * 64 + rq * 16 + m) * 2 + 1] = s2; }
        asm volatile("s_waitcnt vmcnt(0)" ::: "memory");
        __syncthreads();
        const float st = STAT[(rq * 16 + m) * 2] + STAT[(64 + rq * 16 + m) * 2], st2 = STAT[(rq * 16 + m) * 2 + 1] + STAT[(64 + rq * 16 + m) * 2 + 1];
        const float mean = st * (1.f / D); const float rstd = __builtin_amdgcn_rsqf(fmaxf(st2 * (1.f / D) - mean * mean, 0.f) + LN_EPS);
        f32x4 acc[2] = {(f32x4){0.f, 0.f, 0.f, 0.f}, (f32x4){0.f, 0.f, 0.f, 0.f}}; const float* gp = gam; const float* bp = bet;
#pragma unroll
        for (int kk = 0; kk < 16; ++kk) { const int k0 = 512 * kh + 32 * kk + 8 * g;
            if ((kk & 3) == 0) { gp = launder_uniform(gp); bp = launder_uniform(bp); }
            const f32x4 ga = *(const f32x4*)(gp + k0), gb = *(const f32x4*)(gp + k0 + 4), ba = *(const f32x4*)(bp + k0), bb = *(const f32x4*)(bp + k0 + 4);
            f32x4 a, b; { v4u yk = yw[kk]; asm volatile("" : "+v"(yk)); pg8::unpack8(yk, a, b); }
            a = (a - mean) * rstd * ga + ba; b = (b - mean) * rstd * gb + bb;
            v4u hw; hw.x = cvt_pk_bf16(a.x, a.y); hw.y = cvt_pk_bf16(a.z, a.w); hw.z = cvt_pk_bf16(b.x, b.y); hw.w = cvt_pk_bf16(b.z, b.w);
            *(v4u*)(x1b + (size_t)row * D + k0) = hw;
            if (MOE_FP8) { v2u q; q.x = cvt4_fp8(a.x, a.y, a.z, a.w); q.y = cvt4_fp8(b.x, b.y, b.z, b.w); *(v2u*)(WSP(unsigned char, WS_X1Q) + (size_t)row * D + k0) = q; }
            f32x4 ha, hb_; pg8::unpack8(hw, ha, hb_); a = a - ha; b = b - hb_;
            v4u lw; lw.x = cvt_pk_bf16(a.x, a.y); lw.y = cvt_pk_bf16(a.z, a.w); lw.z = cvt_pk_bf16(b.x, b.y); lw.w = cvt_pk_bf16(b.z, b.w);
            const bf16x8 xh = __builtin_bit_cast(bf16x8, hw), xl = __builtin_bit_cast(bf16x8, lw);
            const int c = kh * 64 + kk * 4 + g;
#pragma unroll
            for (int nt = 0; nt < 2; ++nt) { const bf16x8 wh = *(const LAS bf16x8*)(WL + (c * 32 + nt * 16 + m) * 16), wl = *(const LAS bf16x8*)(WL + 65536 + (c * 32 + nt * 16 + m) * 16);
                acc[nt] = __builtin_amdgcn_mfma_f32_16x16x32_bf16(wh, xh, acc[nt], 0, 0, 0);
                acc[nt] = __builtin_amdgcn_mfma_f32_16x16x32_bf16(wl, xh, acc[nt], 0, 0, 0);
                acc[nt] = __builtin_amdgcn_mfma_f32_16x16x32_bf16(wh, xl, acc[nt], 0, 0, 0); } }
        if (kh == 1) {
#pragma unroll
            for (int nt = 0; nt < 2; ++nt) *(LAS f32x4*)(LG + (rq * 16 + m) * 32 + nt * 16 + 4 * g) = acc[nt]; }
        __syncthreads();
        if (kh == 0) {
#pragma unroll
            for (int nt = 0; nt < 2; ++nt) { const f32x4 o = *(const LAS f32x4*)(LG + (rq * 16 + m) * 32 + nt * 16 + 4 * g); const f32x4 rbv = *(const f32x4*)(rb + nt * 16 + 4 * g);
                *(LAS f32x4*)(LG + (rq * 16 + m) * 32 + nt * 16 + 4 * g) = o + acc[nt] + rbv; } }
        __syncthreads();
        int lane2 = lane; asm volatile("" : "+v"(lane2)); const int sub = lane2 & 15;
#pragma unroll 1
        for (int rg = 0; rg < 2; ++rg) {
            float lg[32];
            { const LAS float* lr = LG + (F.wave * 8 + rg * 4 + (lane2 >> 4)) * 32;
#pragma unroll
              for (int q = 0; q < 8; ++q) { const f32x4 t4 = *(const LAS f32x4*)(lr + 4 * q); lg[4 * q] = t4.x; lg[4 * q + 1] = t4.y; lg[4 * q + 2] = t4.z; lg[4 * q + 3] = t4.w; } }
            float la = 0.f, lb_ = 0.f;
#pragma unroll
            for (int e = 0; e < 32; ++e) { if (e == 2 * sub) la = lg[e]; if (e == 2 * sub + 1) lb_ = lg[e]; }
            int ra = 0, rbk = 0;
#pragma unroll
            for (int e = 0; e < 32; ++e) { ra += (lg[e] > la || (lg[e] == la && e < 2 * sub)) ? 1 : 0; rbk += (lg[e] > lb_ || (lg[e] == lb_ && e < 2 * sub + 1)) ? 1 : 0; }
            const int rowl = rg * 4 + (lane2 >> 4);
            if (ra < 4) { TOPV[rowl * 4 + ra] = la; TOPE[rowl * 4 + ra] = 2 * sub; }
            if (rbk < 4) { TOPV[rowl * 4 + rbk] = lb_; TOPE[rowl * 4 + rbk] = 2 * sub + 1; }
        }
        LDS_WAIT();
        int my_e = 0; float my_g = 0.f; unsigned my_r = 0u;
        if (lane2 < 32) { const int ri = lane2 >> 2, k = lane2 & 3; const f32x4 tv = *(const LAS f32x4*)(TOPV + ri * 4);
            const float e1 = __expf(tv.y - tv.x), e2 = __expf(tv.z - tv.x), e3 = __expf(tv.w - tv.x); const float inv = __builtin_amdgcn_rcpf(1.0f + e1 + e2 + e3);
            my_e = TOPE[ri * 4 + k]; my_g = (k == 0 ? 1.0f : k == 1 ? e1 : k == 2 ? e2 : e3) * inv;
            my_r = DRY ? 0u : atomicAdd((unsigned*)&lcnt[my_e], 1u); }
        __syncthreads();
        if (!DRY && F.wave == 0 && lane2 < 32) { const unsigned n = lcnt[lane2]; lbase[lane2] = n ? __hip_atomic_fetch_add(cnt + lane2 * 16, n, RLX_AGENT) : 0u; }
        __syncthreads();
        if (!DRY && lane2 < 32) { const int rw = blk * 64 + F.wave * 8 + (lane2 >> 2); const unsigned slot = (unsigned)my_e * ECAP + lbase[my_e] + my_r;
            sdest[slot] = rw * 4 + (lane2 & 3); sgate[slot] = my_g; }
        __syncthreads();
    }
}
#else
template <bool DRY> __device__ __forceinline__ void p6_ln1_router(Frame& F, const Args& A, int layer) {
    const bf16* y1 = WSP(bf16, WS_Y1); bf16* x1b = WSP(bf16, WS_X1B);
    const float* g = KIN(I_LN1G) + layer * D; const float* bb = KIN(I_LN1B) + layer * D;
    const float* rwt = WSP(float, WS_RWT) + (size_t)layer * NE * D; const float* rb = KIN(I_RTB) + layer * NE;
    int* sdest = WSP(int, WS_SDEST); float* sgate = WSP(float, WS_SGATE);
    unsigned* cnt = (unsigned*)(F.ctl + CW_CNT + layer * NE * 16);
    LAS float* RWT = (LAS float*)F.lds;
    LAS float* TOPV = (LAS float*)(F.lds + 131072) + F.wave * 64;
    LAS int* TOPE = (LAS int*)(F.lds + 131072 + 2048) + F.wave * 64;
    volatile LAS unsigned* lcnt = F.MISC + MW_LCNT; volatile LAS unsigned* lbase = F.MISC + MW_LBASE;
    for (int i = F.tid; i < NE * D / 4; i += NWAVES * 64) ((LAS f32x4*)RWT)[i] = ((const f32x4*)rwt)[i];
    const int lane = F.lane, sub = lane & 15;
    for (int blk = F.vcu; blk < T / 64; blk += F.G) {
        if (F.tid < 32) lcnt[F.tid] = 0u;
        __syncthreads();
#pragma unroll 1
        for (int rg = 0; rg < 2; ++rg) {
            f32x4 v[4][4];
            { int lo_ = lane; asm volatile("" : "+v"(lo_));
              const f32x4 gv[4] = { *(const f32x4*)(g + 4 * lo_), *(const f32x4*)(g + 256 + 4 * lo_), *(const f32x4*)(g + 512 + 4 * lo_), *(const f32x4*)(g + 768 + 4 * lo_) };
              const f32x4 bv[4] = { *(const f32x4*)(bb + 4 * lo_), *(const f32x4*)(bb + 256 + 4 * lo_), *(const f32x4*)(bb + 512 + 4 * lo_), *(const f32x4*)(bb + 768 + 4 * lo_) };
#pragma unroll
              for (int r = 0; r < 4; ++r) { const int row = blk * 64 + F.wave * 8 + rg * 4 + r; const bf16* yr = y1 + (size_t)row * D; float s = 0.f;
#pragma unroll
                  for (int j = 0; j < 4; ++j) { const v2u w = *(const v2u*)(yr + 256 * j + 4 * lane); v[r][j] = (f32x4){__uint_as_float(w.x << 16), __uint_as_float(w.x & 0xffff0000u), __uint_as_float(w.y << 16), __uint_as_float(w.y & 0xffff0000u)}; s += (v[r][j].x + v[r][j].y) + (v[r][j].z + v[r][j].w); }
                  const float mean = wave_sum(s) * (1.f / D); float s2 = 0.f;
#pragma unroll
                  for (int j = 0; j < 4; ++j) { v[r][j] = v[r][j] - mean; s2 += (v[r][j].x * v[r][j].x + v[r][j].y * v[r][j].y) + (v[r][j].z * v[r][j].z + v[r][j].w * v[r][j].w); }
                  const float rstd = __builtin_amdgcn_rsqf(wave_sum(s2) * (1.f / D) + LN_EPS);
#pragma unroll
                  for (int j = 0; j < 4; ++j) { v[r][j] = v[r][j] * rstd * gv[j] + bv[j];
                      v2u o; o.x = cvt_pk_bf16(v[r][j].x, v[r][j].y); o.y = cvt_pk_bf16(v[r][j].z, v[r][j].w); *(v2u*)(x1b + (size_t)row * D + 256 * j + 4 * lane) = o;
                      if (MOE_FP8) *(unsigned*)(WSP(unsigned char, WS_X1Q) + (size_t)row * D + 256 * j + 4 * lane) = cvt4_fp8(v[r][j].x, v[r][j].y, v[r][j].z, v[r][j].w); } } }
            float lg[32];
#pragma unroll
            for (int e = 0; e < 32; ++e) { f32x2 p2[4] = {(f32x2){0.f, 0.f}, (f32x2){0.f, 0.f}, (f32x2){0.f, 0.f}, (f32x2){0.f, 0.f}};
#pragma unroll
                for (int j = 0; j < 4; ++j) { const f32x4 w = *(const LAS f32x4*)(RWT + e * D + 256 * j + 4 * lane);
#pragma unroll
                    for (int r = 0; r < 4; ++r) { p2[r] = v[r][j].xy * w.xy + p2[r]; p2[r] = v[r][j].zw * w.zw + p2[r]; } }
                float p[4] = {p2[0].x + p2[0].y, p2[1].x + p2[1].y, p2[2].x + p2[2].y, p2[3].x + p2[3].y};
                { const bool hi = (lane & 32) != 0; const float k0 = hi ? p[2] : p[0], s0 = hi ? p[0] : p[2], k1 = hi ? p[3] : p[1], s1 = hi ? p[1] : p[3]; p[0] = k0 + __shfl_xor(s0, 32); p[1] = k1 + __shfl_xor(s1, 32); }
                { const bool hi = (lane & 16) != 0; const float k0 = hi ? p[1] : p[0], s0 = hi ? p[0] : p[1]; p[0] = k0 + __shfl_xor(s0, 16); }
                float t = p[0]; t += __shfl_xor(t, 8); t += __shfl_xor(t, 4); t += __shfl_xor(t, 2); t += __shfl_xor(t, 1);
                lg[e] = t + rb[e]; }
            float la = 0.f, lb_ = 0.f;
#pragma unroll
            for (int e = 0; e < 32; ++e) { if (e == 2 * sub) la = lg[e]; if (e == 2 * sub + 1) lb_ = lg[e]; }
            int ra = 0, rbk = 0;
#pragma unroll
            for (int e = 0; e < 32; ++e) { ra += (lg[e] > la || (lg[e] == la && e < 2 * sub)) ? 1 : 0; rbk += (lg[e] > lb_ || (lg[e] == lb_ && e < 2 * sub + 1)) ? 1 : 0; }
            const int rowl = rg * 4 + (lane >> 4);
            if (ra < 4) { TOPV[rowl * 4 + ra] = la; TOPE[rowl * 4 + ra] = 2 * sub; }
            if (rbk < 4) { TOPV[rowl * 4 + rbk] = lb_; TOPE[rowl * 4 + rbk] = 2 * sub + 1; }
        }
        LDS_WAIT();
        int my_e = 0; float my_g = 0.f; unsigned my_r = 0u;
        if (lane < 32) { const int ri = lane >> 2, k = lane & 3; const f32x4 tv = *(const LAS f32x4*)(TOPV + ri * 4);
            const float e1 = __expf(tv.y - tv.x), e2 = __expf(tv.z - tv.x), e3 = __expf(tv.w - tv.x); const float inv = __builtin_amdgcn_rcpf(1.0f + e1 + e2 + e3);
            my_e = TOPE[ri * 4 + k]; my_g = (k == 0 ? 1.0f : k == 1 ? e1 : k == 2 ? e2 : e3) * inv;
            my_r = DRY ? 0u : atomicAdd((unsigned*)&lcnt[my_e], 1u); }
        __syncthreads();
        if (!DRY && F.tid < 32) { const unsigned n = lcnt[F.tid]; lbase[F.tid] = n ? __hip_atomic_fetch_add(cnt + F.tid * 16, n, RLX_AGENT) : 0u; }
        __syncthreads();
        if (!DRY && lane < 32) { const int row = blk * 64 + F.wave * 8 + (lane >> 2); const unsigned slot = (unsigned)my_e * ECAP + lbase[my_e] + my_r;
            sdest[slot] = row * 4 + (lane & 3); sgate[slot] = my_g; }
        __syncthreads();
    }
}
#endif
__device__ __forceinline__ void p9_combine(Frame& F, const Args& A) {
    const bf16* x1b = WSP(bf16, WS_X1B); const bf16* yb = WSP(bf16, WS_YBUF); bf16* hb = WSP(bf16, WS_HB);
    const int gw = F.vcu * NWAVES + F.wave, NGW = F.G * NWAVES, lane = F.lane;
    for (int row = gw; row < T; row += NGW) {
        v4u y[4][2], xw[2];
#pragma unroll
        for (int j = 0; j < 2; ++j) {
#pragma unroll
            for (int k = 0; k < 4; ++k) y[k][j] = *(const v4u*)(yb + ((size_t)row * 4 + k) * D + 512 * j + 8 * lane);
            xw[j] = *(const v4u*)(x1b + (size_t)row * D + 512 * j + 8 * lane); }
#pragma unroll
        for (int j = 0; j < 2; ++j) { f32x4 v0, v1; pg8::unpack8(xw[j], v0, v1); v0 = v0 * DN_ALPHA; v1 = v1 * DN_ALPHA;
#pragma unroll
            for (int k = 0; k < 4; ++k) { f32x4 a, b; pg8::unpack8(y[k][j], a, b); v0 = v0 + a; v1 = v1 + b; }
            v4u wv; wv.x = cvt_pk_bf16(v0.x, v0.y); wv.y = cvt_pk_bf16(v0.z, v0.w); wv.z = cvt_pk_bf16(v1.x, v1.y); wv.w = cvt_pk_bf16(v1.z, v1.w); *(v4u*)(hb + (size_t)row * D + 512 * j + 8 * lane) = wv;
            if (PLE_FP8) { v2u q; q.x = cvt4_fp8(v0.x, v0.y, v0.z, v0.w); q.y = cvt4_fp8(v1.x, v1.y, v1.z, v1.w); *(v2u*)(WSP(unsigned char, WS_HQ) + (size_t)row * D + 512 * j + 8 * lane) = q; } }
    }
}
__device__ __forceinline__ void p11_ln2(Frame& F, const Args& A, int layer) {
    const bf16* h2 = WSP(bf16, WS_H2); bf16* xb = WSP(bf16, WS_XB);
    const float* g = KIN(I_LN2G) + layer * D; const float* bb = KIN(I_LN2B) + layer * D;
    const int gw = F.vcu * NWAVES + F.wave, NGW = F.G * NWAVES, lane = F.lane;
    for (int row = gw; row < T; row += NGW) {
        const bf16* yr = h2 + (size_t)row * D; f32x4 v[4]; float s = 0.f;
#pragma unroll
        for (int j = 0; j < 4; ++j) { const v2u w = *(const v2u*)(yr + 256 * j + 4 * lane); v[j] = (f32x4){__uint_as_float(w.x << 16), __uint_as_float(w.x & 0xffff0000u), __uint_as_float(w.y << 16), __uint_as_float(w.y & 0xffff0000u)}; s += (v[j].x + v[j].y) + (v[j].z + v[j].w); }
        const float mean = wave_sum(s) * (1.f / D); float s2 = 0.f;
#pragma unroll
        for (int j = 0; j < 4; ++j) { v[j] = v[j] - mean; s2 += (v[j].x * v[j].x + v[j].y * v[j].y) + (v[j].z * v[j].z + v[j].w * v[j].w); }
        const float rstd = __builtin_amdgcn_rsqf(wave_sum(s2) * (1.f / D) + LN_EPS);
#pragma unroll
        for (int j = 0; j < 4; ++j) { const f32x4 gv = *(const f32x4*)(g + 256 * j + 4 * lane), bv = *(const f32x4*)(bb + 256 * j + 4 * lane);
            const f32x4 o = v[j] * rstd * gv + bv; const size_t off = (size_t)row * D + 256 * j + 4 * lane;
            if (layer == DEPTH - 1) *(f32x4*)(F.out + off) = o; v2u w; w.x = cvt_pk_bf16(o.x, o.y); w.y = cvt_pk_bf16(o.z, o.w); *(v2u*)(xb + off) = w; }
    }
}
__device__ __forceinline__ void moe_build_pfx(Frame& F, const Args& A, int layer, int NT) {
    volatile LAS unsigned* pfx = F.MISC + MW_PFX;
    __syncthreads();
    if (F.tid < 64) {
        const int e = F.tid & 31;
        const unsigned c = __hip_atomic_load(F.ctl + CW_CNT + (layer * NE + e) * 16, RLX_AGENT);
        const unsigned un = ((c + 255u) >> 8) * (unsigned)NT; unsigned inc = un;
#pragma unroll
        for (int o = 1; o < 32; o <<= 1) { const unsigned t = (unsigned)my_shfl_up((int)inc, o); if (e >= o) inc += t; }
        if (F.tid < 32) { pfx[e] = inc - un; pfx[40 + e] = c; if (e == 31) pfx[32] = inc; }
    }
    __syncthreads();
}
#define UU(t, col) bf2f(u[(size_t)(t) * NUP + (col)])
#define UU4(t, col) ldu4(u + (size_t)(t) * NUP + (col))
__device__ __forceinline__ f32x4 ldu4(const bf16* p) { const v2u w = *(const v2u*)p; return (f32x4){__uint_as_float(w.x << 16), __uint_as_float(w.x & 0xffff0000u), __uint_as_float(w.y << 16), __uint_as_float(w.y & 0xffff0000u)}; }
__device__ __forceinline__ f32x4 ldb4(const bf16* p) { const v2u w = *(const v2u*)p; return (f32x4){__uint_as_float(w.x << 16), __uint_as_float(w.x & 0xffff0000u), __uint_as_float(w.y << 16), __uint_as_float(w.y & 0xffff0000u)}; }
__device__ __forceinline__ void stb4(bf16* p, f32x4 v) { v2u o; o.x = cvt_pk_bf16(v.x, v.y); o.y = cvt_pk_bf16(v.z, v.w); *(v2u*)p = o; }
__device__ __forceinline__ void lds_st_bf16(LAS unsigned char* p, float v) { *(LAS unsigned short*)p = (unsigned short)(cvt_pk_bf16(v, 0.f) & 0xffffu); }
__device__ __forceinline__ void lds_st_bf16x4(LAS unsigned char* p, float a, float b, float c, float d) { v2u o; o.x = cvt_pk_bf16(a, b); o.y = cvt_pk_bf16(c, d); *(LAS v2u*)p = o; }

#if OUT_FP8
#define MIX_ST4(mix, idx, a, b, c, d) (*(unsigned*)((unsigned char*)(mix) + (idx)) = cvt4_fp8(a, b, c, d))
#else
#define MIX_ST4(mix, idx, a, b, c, d) do { v2u o_; o_.x = cvt_pk_bf16(a, b); o_.y = cvt_pk_bf16(c, d); *(v2u*)((mix) + (idx)) = o_; } while (0)
#endif
__device__ __forceinline__ void ssd_stage1(Frame& F, const Args& A, int layer, int b, int c) {
    const bf16* u = WSP(bf16, WS_U);
    LAS unsigned char* L = F.lds;
    LAS float* DT = (LAS float*)L; LAS float* AC = DT + 256;
    LAS unsigned char* BMT = L + 2048; LAS unsigned char* XCDT = BMT + 128 * 144;
    const int t0 = b * SEQ + c * 64, tid = F.tid, lane = F.lane, wave = F.wave;
    if (wave < 4) {
        const int hh = wave;
        const float dt = softplusf_(UU(t0 + lane, U_SSD_DT + hh) + KIN(I_SDTB)[layer * 4 + hh]);
        const float adt = -dt * __expf(KIN(I_SALOG)[layer * 4 + hh]);
        const float ac = wave_scan_add(adt, lane);
        DT[hh * 64 + lane] = dt; AC[hh * 64 + lane] = ac;
        if (lane == 63) WSP(float, WS_SSD_DEC)[(b * 4 + hh) * NCH + c] = __expf(ac);
    }
    __syncthreads();
    if (tid < 384) {
        const int cc = tid; const float* cw = KIN(I_SCW) + (size_t)layer * 2048 + cc; const float w0 = cw[0], w1 = cw[512], w2 = cw[1024], w3 = cw[1536], cb = KIN(I_SCB)[layer * 512 + cc];
        const bf16* up = u + (size_t)t0 * NUP + U_SSD_X + cc;
        float win0 = 0.f, win1 = 0.f, win2 = 0.f;
        if (c > 0) { win0 = bf2f(up[-3 * NUP]); win1 = bf2f(up[-2 * NUP]); win2 = bf2f(up[-1 * NUP]); }
        const int hh = (cc >> 6) & 3; const bool isx = cc < 256;
        LAS unsigned char* dst = isx ? XCDT + cc * 144 : BMT + (cc - 256) * 144;
        const float aclast = AC[hh * 64 + 63];
#pragma unroll 1
        for (int l0 = 0; l0 < 64; l0 += 32) {
            float xv[32];
#pragma unroll
            for (int j = 0; j < 32; ++j) xv[j] = bf2f(up[(l0 + j) * NUP]);
#pragma unroll
            for (int j8 = 0; j8 < 4; ++j8) { float o[8];
#pragma unroll
                for (int j = 0; j < 8; ++j) { const int l = l0 + j8 * 8 + j; const float x = xv[j8 * 8 + j]; const float y = cb + w0 * win0 + w1 * win1 + w2 * win2 + w3 * x; win0 = win1; win1 = win2; win2 = x;
                    float s = siluf_(y); if (isx) s *= DT[hh * 64 + l] * __expf(aclast - AC[hh * 64 + l]); o[j] = s; }
                *(LAS v4u*)(dst + (l0 + j8 * 8) * 2) = pack8(o); }
        }
    }
    __syncthreads();
    { const int fr = lane & 15, fq = lane >> 4; bf16* st = WSP(bf16, WS_SSD_ST);
#pragma unroll 1
      for (int i = 0; i < 2; ++i) { const int row0 = (2 * wave + i) * 16; const int hh = row0 >> 6, p = (row0 & 63) + fr;
          bf16* dstp = st + (((size_t)(b * 4 + hh) * NCH + c) * 64 + p) * 128;
#pragma unroll 1
          for (int ntl = 0; ntl < 8; ++ntl) { f32x4 acc = {0.f, 0.f, 0.f, 0.f}; acc = mm16(XCDT + row0 * 144, 144, BMT + ntl * 16 * 144, 144, 64, acc, fr, fq);
              stb4(dstp + ntl * 16 + 4 * fq, acc); } } }
    __syncthreads();
}
__device__ __forceinline__ void ssd_stage3(Frame& F, const Args& A, int layer, int b, int c) {
    const bf16* u = WSP(bf16, WS_U);
    LAS unsigned char* L = F.lds;
    LAS float* DT = (LAS float*)L; LAS float* AC = DT + 256;
    LAS unsigned char* CM = L + 2048; LAS unsigned char* BM = CM + 64 * 272; LAS unsigned char* XCT = BM + 64 * 272; LAS unsigned char* MM = XCT + 256 * 144;
    LAS unsigned char* YG = XCT;
    const int t0 = b * SEQ + c * 64, tid = F.tid, lane = F.lane, wave = F.wave, fr = lane & 15, fq = lane >> 4;
    if (wave < 4) {
        const int hh = wave;
        const float dt = softplusf_(UU(t0 + lane, U_SSD_DT + hh) + KIN(I_SDTB)[layer * 4 + hh]);
        const float adt = -dt * __expf(KIN(I_SALOG)[layer * 4 + hh]);
        DT[hh * 64 + lane] = dt; AC[hh * 64 + lane] = wave_scan_add(adt, lane);
    }
    __syncthreads();
    {
        const int cc = tid; const float* cw = KIN(I_SCW) + (size_t)layer * 2048 + cc; const float w0 = cw[0], w1 = cw[512], w2 = cw[1024], w3 = cw[1536], cb = KIN(I_SCB)[layer * 512 + cc];
        const bf16* up = u + (size_t)t0 * NUP + U_SSD_X + cc;
        float win0 = 0.f, win1 = 0.f, win2 = 0.f;
        if (c > 0) { win0 = bf2f(up[-3 * NUP]); win1 = bf2f(up[-2 * NUP]); win2 = bf2f(up[-1 * NUP]); }
        const int hh = (cc >> 6) & 3;
#pragma unroll 1
        for (int l0 = 0; l0 < 64; l0 += 32) {
            float xv[32];
#pragma unroll
            for (int j = 0; j < 32; ++j) xv[j] = bf2f(up[(l0 + j) * NUP]);
#pragma unroll
            for (int j8 = 0; j8 < 4; ++j8) { float o[8];
#pragma unroll
                for (int j = 0; j < 8; ++j) { const int l = l0 + j8 * 8 + j; const float x = xv[j8 * 8 + j]; const float y = cb + w0 * win0 + w1 * win1 + w2 * win2 + w3 * x; win0 = win1; win1 = win2; win2 = x;
                    float s = siluf_(y); if (cc < 256) s *= DT[hh * 64 + l]; o[j] = s; }
                if (cc < 256) *(LAS v4u*)(XCT + cc * 144 + (l0 + j8 * 8) * 2) = pack8(o);
                else { LAS unsigned char* d2 = (cc < 384 ? BM + (cc - 256) * 2 : CM + (cc - 384) * 2) + (l0 + j8 * 8) * 272;
#pragma unroll
                    for (int j = 0; j < 8; ++j) lds_st_bf16(d2 + j * 272, o[j]); } }
        }
    }
    __syncthreads();
#pragma unroll 1
    for (int i = 0; i < 2; ++i) { const int idx = 2 * wave + i, lt = idx >> 2, st = idx & 3;
        f32x4 acc = {0.f, 0.f, 0.f, 0.f}; acc = mm16(CM + lt * 16 * 272, 272, BM + st * 16 * 272, 272, 128, acc, fr, fq);
        const int l = lt * 16 + fr, s0 = st * 16 + 4 * fq;
#pragma unroll
        for (int hh = 0; hh < 4; ++hh) { const float al = AC[hh * 64 + l], dl = KIN(I_SD)[layer * 4 + hh] / DT[hh * 64 + l]; float o[4];
#pragma unroll
            for (int j = 0; j < 4; ++j) { const int s = s0 + j; float m = (l >= s) ? acc[j] * __expf(al - AC[hh * 64 + s]) : 0.f; if (l == s) m += dl; o[j] = m; }
            lds_st_bf16x4(MM + hh * 9216 + l * 144 + s0 * 2, o[0], o[1], o[2], o[3]); } }
    __syncthreads();
    f32x4 yv[2][4];
    { const int hh = wave >> 1; const bf16* prev = WSP(bf16, WS_SSD_ST) + ((size_t)(b * 4 + hh) * NCH + c) * 8192;
      bf16x8 pf[4][4];
#pragma unroll
      for (int pt = 0; pt < 4; ++pt)
#pragma unroll
          for (int ks = 0; ks < 4; ++ks) pf[pt][ks] = *(const bf16x8*)(prev + (size_t)(pt * 16 + fr) * 128 + ks * 32 + fq * 8);
#pragma unroll
      for (int i = 0; i < 2; ++i) { const int lt = 2 * (wave & 1) + i, l = lt * 16 + fr; const float ea = __expf(AC[hh * 64 + l]);
#pragma unroll
          for (int pt = 0; pt < 4; ++pt) { f32x4 ad = {0.f, 0.f, 0.f, 0.f}, ao = {0.f, 0.f, 0.f, 0.f};
              ad = mm16(MM + hh * 9216 + lt * 16 * 144, 144, XCT + (hh * 64 + pt * 16) * 144, 144, 64, ad, fr, fq);
              ao = mm16_rB<4>(CM + lt * 16 * 272, 272, pf[pt], ao, fr, fq);
              const f32x4 z = UU4(t0 + l, U_SSD_Z + hh * 64 + pt * 16 + 4 * fq);
              f32x4 y = ad + ao * ea; y.x *= siluf_(z.x); y.y *= siluf_(z.y); y.z *= siluf_(z.z); y.w *= siluf_(z.w); yv[i][pt] = y; } } }
    __syncthreads();
    { const int hh = wave >> 1;
#pragma unroll
      for (int i = 0; i < 2; ++i) { const int l = (2 * (wave & 1) + i) * 16 + fr;
#pragma unroll
          for (int pt = 0; pt < 4; ++pt) *(LAS f32x4*)(YG + l * 1040 + (hh * 64 + pt * 16 + 4 * fq) * 4) = yv[i][pt]; } }
    __syncthreads();
    { const f32x4 g = *(const f32x4*)(KIN(I_SNG) + layer * 256 + 4 * lane); bf16* mix = WSP(bf16, WS_MIX);
#pragma unroll 1
      for (int i = 0; i < 8; ++i) { const int l = wave * 8 + i; const f32x4 y = *(const LAS f32x4*)(YG + l * 1040 + lane * 16);
          const float ss = wave_sum((y.x * y.x + y.y * y.y) + (y.z * y.z + y.w * y.w)); const float r = __builtin_amdgcn_rsqf(ss * (1.f / 256.f) + NORM_EPS);
          MIX_ST4(mix, (size_t)(t0 + l) * D + 4 * lane, y.x * r * g.x, y.y * r * g.y, y.z * r * g.z, y.w * r * g.w); } }
    __syncthreads();
}

__device__ __forceinline__ void gla_bcum_all(Frame& F, const Args& A, int layer, const LAS float* GD, LAS float* BC) {
    const int d = F.tid & 127, lq = F.tid >> 7;
    float gup[16];
    { const f32x4* gp4 = (const f32x4*)(WSP(float, WS_LORA) + (size_t)layer * LORA_PER_LAYER + 32768 + d * 16);
#pragma unroll
      for (int i = 0; i < 4; ++i) { const f32x4 a = gp4[i]; gup[4 * i] = a.x; gup[4 * i + 1] = a.y; gup[4 * i + 2] = a.z; gup[4 * i + 3] = a.w; } }
    const float gb = KIN(I_GGB)[layer * 128 + d];
#pragma unroll 4
    for (int li = 0; li < 16; ++li) { const int l = lq * 16 + li; float x = gb;
#pragma unroll
        for (int i = 0; i < 4; ++i) { const f32x4 g4 = *(const LAS f32x4*)(GD + l * 16 + 4 * i); x += (g4.x * gup[4 * i] + g4.y * gup[4 * i + 1]) + (g4.z * gup[4 * i + 2] + g4.w * gup[4 * i + 3]); }
        BC[l * 128 + d] = logsigmoidf_(x) * 0.0625f; }
    __syncthreads();
    if (F.tid < 128) { float run = 0.f;
#pragma unroll 1
        for (int l0 = 0; l0 < 64; l0 += 16) { float v[16];
#pragma unroll
            for (int j = 0; j < 16; ++j) v[j] = BC[(l0 + j) * 128 + d];
#pragma unroll
            for (int j = 0; j < 16; ++j) { run += v[j]; BC[(l0 + j) * 128 + d] = run; } } }
}
__device__ __forceinline__ void gla_stage1(Frame& F, const Args& A, int layer, int b, int c) {
    const bf16* u = WSP(bf16, WS_U);
    LAS unsigned char* L = F.lds;
    LAS float* GD = (LAS float*)L; LAS float* BC = (LAS float*)(L + 4096);
    LAS unsigned char* KDT = L + 36864; LAS unsigned char* VT = KDT + 128 * 144;
    const int t0 = b * SEQ + c * 64, tid = F.tid, lane = F.lane, wave = F.wave, fr = lane & 15, fq = lane >> 4;
    if (tid < 256) { const int l = tid >> 2, q4 = tid & 3; *(LAS f32x4*)(GD + l * 16 + q4 * 4) = UU4(t0 + l, U_GL_G + 4 * q4); }
    __syncthreads();
    gla_bcum_all(F, A, layer, GD, BC);
    if (tid < 128) {
        const int d = tid; const float blast = BC[63 * 128 + d];
        WSP(float, WS_GLA_DEC)[(size_t)(b * NCH + c) * 128 + d] = __expf(blast);
        const bf16* up = u + (size_t)t0 * NUP + U_GL_K + d;
#pragma unroll 1
        for (int l0 = 0; l0 < 64; l0 += 32) { float xv[32];
#pragma unroll
            for (int j = 0; j < 32; ++j) xv[j] = bf2f(up[(l0 + j) * NUP]);
#pragma unroll
            for (int j8 = 0; j8 < 4; ++j8) { float o[8];
#pragma unroll
                for (int j = 0; j < 8; ++j) { const int l = l0 + j8 * 8 + j; o[j] = xv[j8 * 8 + j] * __expf(blast - BC[l * 128 + d]); }
                *(LAS v4u*)(KDT + d * 144 + (l0 + j8 * 8) * 2) = pack8(o); } }
    } else if (tid < 384) {
        const int vch = tid - 128; const bf16* up = u + (size_t)t0 * NUP + U_GL_V + vch;
#pragma unroll 1
        for (int l0 = 0; l0 < 64; l0 += 32) { float xv[32];
#pragma unroll
            for (int j = 0; j < 32; ++j) xv[j] = bf2f(up[(l0 + j) * NUP]);
#pragma unroll
            for (int j8 = 0; j8 < 4; ++j8) { float o[8];
#pragma unroll
                for (int j = 0; j < 8; ++j) o[j] = xv[j8 * 8 + j];
                *(LAS v4u*)(VT + vch * 144 + (l0 + j8 * 8) * 2) = pack8(o); } }
    }
    __syncthreads();
    { bf16* st = WSP(bf16, WS_GLA_ST);
#pragma unroll 1
      for (int i = 0; i < 4; ++i) { const int idx = 4 * wave + i, hh = idx >> 3, dtl = (idx >> 2) & 1, vt = idx & 3;
          f32x4 acc = {0.f, 0.f, 0.f, 0.f}; acc = mm16(KDT + (hh * 32 + dtl * 16) * 144, 144, VT + (hh * 64 + vt * 16) * 144, 144, 64, acc, fr, fq);
          stb4(st + (((size_t)(b * 4 + hh) * NCH + c) * 32 + dtl * 16 + fr) * 64 + vt * 16 + 4 * fq, acc); } }
    __syncthreads();
}
__device__ __forceinline__ void gla_stage3(Frame& F, const Args& A, int layer, int b, int c) {
    const bf16* u = WSP(bf16, WS_U);
    LAS unsigned char* L = F.lds;
    LAS float* GD = (LAS float*)L; LAS float* BC = (LAS float*)(L + 4096); LAS unsigned char* ATT = L + 4096;
    LAS unsigned char* QD = L + 40960; LAS unsigned char* KI = QD + 64 * 272; LAS unsigned char* VT = KI + 64 * 272; LAS unsigned char* PVT = VT + 256 * 144;
    const int t0 = b * SEQ + c * 64, tid = F.tid, lane = F.lane, wave = F.wave, fr = lane & 15, fq = lane >> 4;
    if (tid < 256) { const int l = tid >> 2, q4 = tid & 3; *(LAS f32x4*)(GD + l * 16 + q4 * 4) = UU4(t0 + l, U_GL_G + 4 * q4); }
    __syncthreads();
    gla_bcum_all(F, A, layer, GD, BC);
    if (tid < 128) {
        const int d = tid;
        const bf16* uq = u + (size_t)t0 * NUP + U_GL_Q + d; const bf16* uk = u + (size_t)t0 * NUP + U_GL_K + d;
#pragma unroll 1
        for (int l0 = 0; l0 < 64; l0 += 16) { float qv[16], kv[16];
#pragma unroll
            for (int j = 0; j < 16; ++j) { qv[j] = bf2f(uq[(l0 + j) * NUP]); kv[j] = bf2f(uk[(l0 + j) * NUP]); }
#pragma unroll
            for (int j = 0; j < 16; ++j) { const int l = l0 + j; const float bc = BC[l * 128 + d];
                lds_st_bf16(QD + l * 272 + d * 2, qv[j] * 0.17677669529663687f * __expf(bc)); lds_st_bf16(KI + l * 272 + d * 2, kv[j] * __expf(-bc)); } }
    } else if (tid < 384) {
        const int vch = tid - 128; const bf16* up = u + (size_t)t0 * NUP + U_GL_V + vch;
#pragma unroll 1
        for (int l0 = 0; l0 < 64; l0 += 32) { float xv[32];
#pragma unroll
            for (int j = 0; j < 32; ++j) xv[j] = bf2f(up[(l0 + j) * NUP]);
#pragma unroll
            for (int j8 = 0; j8 < 4; ++j8) { float o[8];
#pragma unroll
                for (int j = 0; j < 8; ++j) o[j] = xv[j8 * 8 + j];
                *(LAS v4u*)(VT + vch * 144 + (l0 + j8 * 8) * 2) = pack8(o); } }
    } else {
        const bf16* prev = WSP(bf16, WS_GLA_ST);
#pragma unroll 4
        for (int i = tid - 384; i < 8192; i += 128) { const int hh = i >> 11, dd = (i >> 6) & 31, vv = i & 63;
            *(LAS unsigned short*)(PVT + (hh * 64 + vv) * 80 + dd * 2) = prev[((size_t)(b * 4 + hh) * NCH + c) * 2048 + dd * 64 + vv]; }
    }
    __syncthreads();
    const int hh = wave >> 1;
#pragma unroll 1
    for (int i = 0; i < 2; ++i) { const int tt = 2 * (wave & 1) + i, t = tt * 16 + fr;
#pragma unroll
        for (int st = 0; st < 4; ++st) { f32x4 acc = {0.f, 0.f, 0.f, 0.f}; acc = mm16(QD + tt * 16 * 272 + hh * 64, 272, KI + st * 16 * 272 + hh * 64, 272, 32, acc, fr, fq);
            const int s0 = st * 16 + 4 * fq;
            lds_st_bf16x4(ATT + hh * 9216 + t * 144 + s0 * 2, t >= s0 ? acc[0] : 0.f, t >= s0 + 1 ? acc[1] : 0.f, t >= s0 + 2 ? acc[2] : 0.f, t >= s0 + 3 ? acc[3] : 0.f); } }
    __syncthreads();
    { bf16* mix = WSP(bf16, WS_MIX); const float* ng = KIN(I_GNG) + layer * 256;
#pragma unroll 1
      for (int i = 0; i < 2; ++i) { const int tt = 2 * (wave & 1) + i, t = tt * 16 + fr; f32x4 ov[4]; float ss = 0.f;
#pragma unroll
          for (int vt = 0; vt < 4; ++vt) { f32x4 acc = {0.f, 0.f, 0.f, 0.f};
              acc = mm16(ATT + hh * 9216 + tt * 16 * 144, 144, VT + (hh * 64 + vt * 16) * 144, 144, 64, acc, fr, fq);
              acc = mm16(QD + tt * 16 * 272 + hh * 64, 272, PVT + (hh * 64 + vt * 16) * 80, 80, 32, acc, fr, fq);
              ov[vt] = acc; ss += (acc.x * acc.x + acc.y * acc.y) + (acc.z * acc.z + acc.w * acc.w); }
          ss += __shfl_xor(ss, 16); ss += __shfl_xor(ss, 32);
          const float r = __builtin_amdgcn_rsqf(ss * (1.f / 64.f) + NORM_EPS);
#pragma unroll
          for (int vt = 0; vt < 4; ++vt) { const int col = hh * 64 + vt * 16 + 4 * fq; const f32x4 g = *(const f32x4*)(ng + col); const f32x4 og = UU4(t0 + t, U_GL_OG + col);
              MIX_ST4(mix, (size_t)(t0 + t) * D + 512 + col, ov[vt].x * r * g.x * siluf_(og.x), ov[vt].y * r * g.y * siluf_(og.y), ov[vt].z * r * g.z * siluf_(og.z), ov[vt].w * r * g.w * siluf_(og.w)); } } }
    __syncthreads();
}

__device__ __forceinline__ void mlstm_stage1(Frame& F, const Args& A, int layer, int b, int c) {
    const bf16* u = WSP(bf16, WS_U);
    LAS unsigned char* L = F.lds;
    LAS float* WST = (LAS float*)L; LAS unsigned char* KT = L + 1024; LAS unsigned char* VWT = KT + 256 * 144;
    const int t0 = b * SEQ + c * 64, tid = F.tid, lane = F.lane, wave = F.wave, fr = lane & 15, fq = lane >> 4;
    if (wave < 4) {
        const int hh = wave;
        const float ig = UU(t0 + lane, U_ML_I + hh) + KIN(I_MIB)[layer * 4 + hh];
        const float lf = logsigmoidf_(UU(t0 + lane, U_ML_F + hh) + KIN(I_MFB)[layer * 4 + hh]);
        const float bc = wave_scan_add(lf, lane); const float blast = __shfl(bc, 63);
        const float ast = blast - bc + ig; const float mloc = wave_max(ast);
        WST[hh * 64 + lane] = __expf(ast - mloc);
        if (lane == 0) { WSP(float, WS_ML_BL)[(b * 4 + hh) * NCH + c] = blast; WSP(float, WS_ML_ML)[(b * 4 + hh) * NCH + c] = mloc; }
    } else {
        const int kch = tid - 256, cc = 256 + kch; const float* cw = KIN(I_MCW) + (size_t)layer * 2048 + cc; const float w0 = cw[0], w1 = cw[512], w2 = cw[1024], w3 = cw[1536], cb = KIN(I_MCB)[layer * 512 + cc];
        const bf16* up = u + (size_t)t0 * NUP + U_ML_K + kch;
        float win0 = 0.f, win1 = 0.f, win2 = 0.f;
        if (c > 0) { win0 = bf2f(up[-3 * NUP]); win1 = bf2f(up[-2 * NUP]); win2 = bf2f(up[-1 * NUP]); }
#pragma unroll 1
        for (int l0 = 0; l0 < 64; l0 += 32) { float xv[32];
#pragma unroll
            for (int j = 0; j < 32; ++j) xv[j] = bf2f(up[(l0 + j) * NUP]);
#pragma unroll
            for (int j8 = 0; j8 < 4; ++j8) { float o[8];
#pragma unroll
                for (int j = 0; j < 8; ++j) { const float x = xv[j8 * 8 + j]; const float y = cb + w0 * win0 + w1 * win1 + w2 * win2 + w3 * x; win0 = win1; win1 = win2; win2 = x; o[j] = siluf_(y); }
                *(LAS v4u*)(KT + kch * 144 + (l0 + j8 * 8) * 2) = pack8(o); } }
    }
    __syncthreads();
    if (tid < 256) {
        const int vch = tid, hh = vch >> 6; const bf16* up = u + (size_t)t0 * NUP + U_ML_V + vch;
#pragma unroll 1
        for (int l0 = 0; l0 < 64; l0 += 32) { float xv[32];
#pragma unroll
            for (int j = 0; j < 32; ++j) xv[j] = bf2f(up[(l0 + j) * NUP]);
#pragma unroll
            for (int j8 = 0; j8 < 4; ++j8) { float o[8];
#pragma unroll
                for (int j = 0; j < 8; ++j) o[j] = xv[j8 * 8 + j] * WST[hh * 64 + l0 + j8 * 8 + j];
                *(LAS v4u*)(VWT + vch * 144 + (l0 + j8 * 8) * 2) = pack8(o); } }
    } else {
        const int kch = tid - 256, hh = kch >> 6; float n = 0.f;
#pragma unroll 8
        for (int s = 0; s < 64; ++s) n += WST[hh * 64 + s] * bf2f(*(const LAS unsigned short*)(KT + kch * 144 + s * 2));
        WSP(bf16, WS_ML_N)[((size_t)(b * 4 + hh) * NCH + c) * 64 + (kch & 63)] = (bf16)(cvt_pk_bf16(n, 0.f) & 0xffffu);
    }
    __syncthreads();
    { bf16* cst = WSP(bf16, WS_ML_C); const int hh = wave >> 1;
#pragma unroll 1
      for (int i = 0; i < 2; ++i) { const int vt = 2 * (wave & 1) + i;
#pragma unroll 1
          for (int kt = 0; kt < 4; ++kt) { f32x4 acc = {0.f, 0.f, 0.f, 0.f}; acc = mm16(VWT + (hh * 64 + vt * 16) * 144, 144, KT + (hh * 64 + kt * 16) * 144, 144, 64, acc, fr, fq);
              stb4(cst + (((size_t)(b * 4 + hh) * NCH + c) * 64 + vt * 16 + fr) * 64 + kt * 16 + 4 * fq, acc); } } }
    __syncthreads();
}
__device__ __forceinline__ void mlstm_stage3(Frame& F, const Args& A, int layer, int b, int c) {
    const bf16* u = WSP(bf16, WS_U);
    LAS unsigned char* L = F.lds;
    LAS float* BCU = (LAS float*)L; LAS float* GG = BCU + 256; LAS float* MROW = BCU + 512; LAS float* WINT = BCU + 768; LAS float* NPV = BCU + 1024;
    LAS unsigned char* Q = L + 6144; LAS unsigned char* KK = Q + 64 * 528; LAS unsigned char* VT = KK + 64 * 528; LAS unsigned char* SC = VT + 256 * 144;
    const int t0 = b * SEQ + c * 64, tid = F.tid, lane = F.lane, wave = F.wave, fr = lane & 15, fq = lane >> 4;
    if (wave < 4) {
        const int hh = wave;
        const float ig = UU(t0 + lane, U_ML_I + hh) + KIN(I_MIB)[layer * 4 + hh];
        const float lf = logsigmoidf_(UU(t0 + lane, U_ML_F + hh) + KIN(I_MFB)[layer * 4 + hh]);
        const float bc = wave_scan_add(lf, lane); const float gg = ig - bc;
        const float mprev = WSP(float, WS_ML_M)[(b * 4 + hh) * NCH + c];
        const float minter = bc + mprev, mintra = bc + wave_scan_max(gg, lane), mrow = fmaxf(minter, mintra);
        BCU[hh * 64 + lane] = bc; GG[hh * 64 + lane] = gg; MROW[hh * 64 + lane] = mrow; WINT[hh * 64 + lane] = __expf(minter - mrow);
        NPV[hh * 64 + lane] = bf2f(WSP(bf16, WS_ML_N)[((size_t)(b * 4 + hh) * NCH + c) * 64 + lane]);
    }
    {
        const int cc = tid; const float* cw = KIN(I_MCW) + (size_t)layer * 2048 + cc; const float w0 = cw[0], w1 = cw[512], w2 = cw[1024], w3 = cw[1536], cb = KIN(I_MCB)[layer * 512 + cc];
        const bf16* up = u + (size_t)t0 * NUP + U_ML_Q + cc;
        float win0 = 0.f, win1 = 0.f, win2 = 0.f;
        if (c > 0) { win0 = bf2f(up[-3 * NUP]); win1 = bf2f(up[-2 * NUP]); win2 = bf2f(up[-1 * NUP]); }
        LAS unsigned char* dst = cc < 256 ? Q + cc * 2 : KK + (cc - 256) * 2; const float sc = cc < 256 ? 0.125f : 1.0f;
#pragma unroll 1
        for (int l0 = 0; l0 < 64; l0 += 32) { float xv[32];
#pragma unroll
            for (int j = 0; j < 32; ++j) xv[j] = bf2f(up[(l0 + j) * NUP]);
#pragma unroll
            for (int j = 0; j < 32; ++j) { const float x = xv[j]; const float y = cb + w0 * win0 + w1 * win1 + w2 * win2 + w3 * x; win0 = win1; win1 = win2; win2 = x; lds_st_bf16(dst + (l0 + j) * 528, siluf_(y) * sc); } }
        const int vch = tid & 255, lh = (tid >> 8) * 32; const bf16* uv = u + (size_t)(t0 + lh) * NUP + U_ML_V + vch;
        float xv[32];
#pragma unroll
        for (int j = 0; j < 32; ++j) xv[j] = bf2f(uv[j * NUP]);
#pragma unroll
        for (int j8 = 0; j8 < 4; ++j8) { float o[8];
#pragma unroll
            for (int j = 0; j < 8; ++j) o[j] = xv[j8 * 8 + j];
            *(LAS v4u*)(VT + vch * 144 + (lh + j8 * 8) * 2) = pack8(o); }
    }
    __syncthreads();
    { const int hh = wave >> 1; bf16* mix = WSP(bf16, WS_MIX); const float* ng = KIN(I_MNG) + layer * 256;
      const bf16* cprev = WSP(bf16, WS_ML_C) + ((size_t)(b * 4 + hh) * NCH + c) * 4096;
      bf16x8 cf[4][2];
#pragma unroll
      for (int vt = 0; vt < 4; ++vt)
#pragma unroll
          for (int ks = 0; ks < 2; ++ks) cf[vt][ks] = *(const bf16x8*)(cprev + (size_t)(vt * 16 + fr) * 64 + ks * 32 + fq * 8);
#pragma unroll 1
      for (int i = 0; i < 2; ++i) { const int tt = 2 * (wave & 1) + i, t = tt * 16 + fr;
          const float bt = BCU[hh * 64 + t] - MROW[hh * 64 + t]; float rs = 0.f;
#pragma unroll
          for (int st = 0; st < 4; ++st) { f32x4 acc = {0.f, 0.f, 0.f, 0.f}; acc = mm16(Q + tt * 16 * 528 + hh * 128, 528, KK + st * 16 * 528 + hh * 128, 528, 64, acc, fr, fq);
              const int s0 = st * 16 + 4 * fq; float o[4];
#pragma unroll
              for (int j = 0; j < 4; ++j) { const int s = s0 + j; const float v = (t >= s) ? acc[j] * __expf(bt + GG[hh * 64 + s]) : 0.f; o[j] = v; rs += v; }
              lds_st_bf16x4(SC + hh * 9216 + t * 144 + s0 * 2, o[0], o[1], o[2], o[3]); }
          rs += __shfl_xor(rs, 16); rs += __shfl_xor(rs, 32);
          float nq = 0.f;
#pragma unroll
          for (int j = 0; j < 16; ++j) nq += bf2f(*(const LAS unsigned short*)(Q + t * 528 + (hh * 64 + fq * 16 + j) * 2)) * NPV[hh * 64 + fq * 16 + j];
          nq += __shfl_xor(nq, 16); nq += __shfl_xor(nq, 32);
          const float wi = WINT[hh * 64 + t]; const float den = wi * nq + rs; const float dn = fmaxf(fabsf(den), __expf(-MROW[hh * 64 + t])); const float rdn = 1.0f / dn;
          LDS_WAIT();
          f32x4 hv[4]; float sm = 0.f;
#pragma unroll
          for (int vt = 0; vt < 4; ++vt) { f32x4 acc = {0.f, 0.f, 0.f, 0.f};
              acc = mm16_rB<2>(Q + tt * 16 * 528 + hh * 128, 528, cf[vt], acc, fr, fq);
              acc = acc * wi;
              acc = mm16(SC + hh * 9216 + tt * 16 * 144, 144, VT + (hh * 64 + vt * 16) * 144, 144, 64, acc, fr, fq);
              const f32x4 og = UU4(t0 + t, U_ML_O + hh * 64 + vt * 16 + 4 * fq);
              f32x4 h; h.x = acc.x * rdn * sigmoidf_(og.x); h.y = acc.y * rdn * sigmoidf_(og.y); h.z = acc.z * rdn * sigmoidf_(og.z); h.w = acc.w * rdn * sigmoidf_(og.w);
              hv[vt] = h; sm += (h.x + h.y) + (h.z + h.w); }
          sm += __shfl_xor(sm, 16); sm += __shfl_xor(sm, 32);
          const float mean = sm * (1.f / 64.f); float sq = 0.f;
#pragma unroll
          for (int vt = 0; vt < 4; ++vt) { hv[vt] = hv[vt] - mean; sq += (hv[vt].x * hv[vt].x + hv[vt].y * hv[vt].y) + (hv[vt].z * hv[vt].z + hv[vt].w * hv[vt].w); }
          sq += __shfl_xor(sq, 16); sq += __shfl_xor(sq, 32);
          const float r = __builtin_amdgcn_rsqf(sq * (1.f / 64.f) + NORM_EPS);
#pragma unroll
          for (int vt = 0; vt < 4; ++vt) { const int col = hh * 64 + vt * 16 + 4 * fq; const f32x4 g = *(const f32x4*)(ng + col);
              MIX_ST4(mix, (size_t)(t0 + t) * D + 768 + col, hv[vt].x * r * g.x, hv[vt].y * r * g.y, hv[vt].z * r * g.z, hv[vt].w * r * g.w); } } }
    __syncthreads();
}

__device__ __forceinline__ void rwkv_stage1(Frame& F, const Args& A, int layer, int ub) {
    const bf16* u = WSP(bf16, WS_U);
    LAS unsigned char* L = F.lds;
    LAS unsigned char* LOWA = L;
    LAS float* CUM = (LAS float*)(L + 16384);
    LAS float* AAB = CUM;
    LAS float* TOT = CUM;
    LAS unsigned char* M0 = L + 16384 + 16640;
#define RM(i) (M0 + (i) * 9216)
    LAS float* GAMC = (LAS float*)(F.MISC + MW_GAMC);
    const int t0 = ub * 64, c = ub & 63, tid = F.tid, lane = F.lane, wave = F.wave;
    const float* mu = KIN(I_RMU) + layer * 896;
#ifndef RW_DUP
#define RW_DUP -1
#endif
#define RW_REP(k) for (int rep__ = 0; rep__ < ((RW_DUP == (k)) ? 2 : 1); ++rep__)
    RW_REP(0) {
    {
        const int l = tid >> 3, jq = tid & 7, t = t0 + l; const bool has_prev = (t & (SEQ - 1)) != 0;
        f32x4 cur[4], prv[4];
#pragma unroll
        for (int q = 0; q < 4; ++q) { cur[q] = UU4(t, U_RW_LO + jq * 16 + 4 * q); prv[q] = has_prev ? UU4(t - 1, U_RW_LO + jq * 16 + 4 * q) : (f32x4){0.f, 0.f, 0.f, 0.f}; }
#pragma unroll
        for (int q = 0; q < 4; ++q) { const f32x4 m4 = *(const f32x4*)(mu + 768 + jq * 16 + 4 * q); const f32x4 xs = cur[q] + (prv[q] - cur[q]) * m4; const int j = jq * 16 + 4 * q;
            f32x4 o;
            if (j < 32) { o.x = tanhf_(xs.x); o.y = tanhf_(xs.y); o.z = tanhf_(xs.z); o.w = tanhf_(xs.w); } else if (j < 64) o = xs; else { o.x = sigmoidf_(xs.x); o.y = sigmoidf_(xs.y); o.z = sigmoidf_(xs.z); o.w = sigmoidf_(xs.w); }
            if (j < 64) lds_st_bf16x4(LOWA + l * 144 + j * 2, o.x, o.y, o.z, o.w); else lds_st_bf16x4(RM(0) + l * 144 + (j - 64) * 2, o.x, o.y, o.z, o.w); }
    }
    __syncthreads();
    {
        bf16* RG = WSP(bf16, WS_RW_G); const int lane_ = F.lane, fr_ = lane_ & 15, fq_ = lane_ >> 4;
        const float* gupT = WSP(float, WS_LORA) + (size_t)layer * LORA_PER_LAYER + 16384;
#pragma unroll
        for (int ci = 0; ci < 2; ++ci) { const int ct = 2 * wave + ci; bf16x8 bf[2];
#pragma unroll
            for (int ks = 0; ks < 2; ++ks) bf[ks] = ldfrag_f32(gupT + (size_t)(ct * 16 + fr_) * 64 + ks * 32 + fq_ * 8);
#pragma unroll
            for (int tt = 0; tt < 4; ++tt) { f32x4 acc = {0.f, 0.f, 0.f, 0.f}; acc = mm16_rB<2>(RM(0) + tt * 16 * 144, 144, bf, acc, fr_, fq_);
                stb4(RG + (size_t)(t0 + tt * 16 + fr_) * 256 + ct * 16 + 4 * fq_, acc); } }
    }
    __syncthreads();
    }
    const int b_ = ub >> 6;
#pragma unroll 1
    for (int hh = 0; hh < 4; ++hh) {
        int ch = lane, fr = lane & 15, fq = lane >> 4; asm volatile("" : "+v"(ch), "+v"(fr), "+v"(fq));
        const int tg = wave, cg = hh * 64 + ch; const size_t un = (size_t)(b_ * 4 + hh) * NCH + c;
        float rr[8], k2r[8], vr[8], ar[8], br[8], pl[8];
        LAS float* WPA = (LAS float*)RM(8);
        {
            const int mat = wave >> 2, ct = wave & 3;
            const float* wT = WSP(float, WS_LORA) + (size_t)layer * LORA_PER_LAYER + mat * 8192 + (size_t)(hh * 64 + ct * 16 + fr) * 32 + fq * 8;
            bf16x8 bfw[1]; bfw[0] = ldfrag_f32(wT);
#pragma unroll
            for (int tt = 0; tt < 4; ++tt) { f32x4 acc = {0.f, 0.f, 0.f, 0.f}; acc = mm16_rB<1>(LOWA + tt * 16 * 144 + mat * 64, 144, bfw, acc, fr, fq);
                *(LAS f32x4*)(WPA + mat * 4096 + (tt * 16 + fr) * 64 + ct * 16 + 4 * fq) = acc; }
        }
        __syncthreads();
        RW_REP(1) {
            const float w0 = KIN(I_RW0)[layer * 256 + cg], a0 = KIN(I_RA0)[layer * 256 + cg], kkc = KIN(I_RKK)[layer * 256 + cg], kac = KIN(I_RKA)[layer * 256 + cg];
            const float mur = mu[cg], muk = mu[256 + cg], muv = mu[512 + cg];
            const int tb = t0 + tg * 8; const bool nop = (c == 0) && (tg == 0);
            float rp = nop ? 0.f : UU(tb - 1, U_RW_R + cg), kp = nop ? 0.f : UU(tb - 1, U_RW_K + cg), vp = nop ? 0.f : UU(tb - 1, U_RW_V + cg);
            float rc[8], kc[8], vc[8];
#pragma unroll
            for (int j = 0; j < 8; ++j) { rc[j] = UU(tb + j, U_RW_R + cg); kc[j] = UU(tb + j, U_RW_K + cg); vc[j] = UU(tb + j, U_RW_V + cg); }
            bf16* RW = WSP(bf16, WS_RW);
            float kk[8], al[8], n2[8], run = 0.f;
#pragma unroll
            for (int j = 0; j < 8; ++j) { const int l = tg * 8 + j;
                const float r = rc[j] + (rp - rc[j]) * mur, k = kc[j] + (kp - kc[j]) * muk, v = vc[j] + (vp - vc[j]) * muv; rp = rc[j]; kp = kc[j]; vp = vc[j];
                const float wp = w0 + WPA[l * 64 + ch], ap = a0 + WPA[4096 + l * 64 + ch];
                const float w = -softplusf_(-wp) - 0.5f; run += -__expf(w); pl[j] = run; al[j] = sigmoidf_(ap);
                kk[j] = k * kkc; n2[j] = kk[j] * kk[j];
                k2r[j] = k * (1.0f + (al[j] - 1.0f) * kac); rr[j] = r; vr[j] = v;
                bf16* o = RW + (size_t)(tb + j) * 768 + cg; o[0] = (bf16)(cvt_pk_bf16(r, 0.f) & 0xffffu); o[256] = (bf16)(cvt_pk_bf16(k2r[j], 0.f) & 0xffffu); o[512] = (bf16)(cvt_pk_bf16(v, 0.f) & 0xffffu); }
#pragma unroll
            for (int i = 0; i < 4; ++i) { const bool hi = (ch & 32) != 0; const float keep = hi ? n2[i + 4] : n2[i], send = hi ? n2[i] : n2[i + 4]; n2[i] = keep + __shfl_xor(send, 32); }
#pragma unroll
            for (int i = 0; i < 2; ++i) { const bool hi = (ch & 16) != 0; const float keep = hi ? n2[i + 2] : n2[i], send = hi ? n2[i] : n2[i + 2]; n2[i] = keep + __shfl_xor(send, 16); }
            { const bool hi = (ch & 8) != 0; const float keep = hi ? n2[1] : n2[0], send = hi ? n2[0] : n2[1]; n2[0] = keep + __shfl_xor(send, 8); }
            n2[0] += __shfl_xor(n2[0], 4); n2[0] += __shfl_xor(n2[0], 2); n2[0] += __shfl_xor(n2[0], 1);
#pragma unroll
            for (int j = 0; j < 8; ++j) { const float tot = __builtin_bit_cast(float, __builtin_amdgcn_readlane(__builtin_bit_cast(int, n2[0]), ((j & 4) ? 32 : 0) + ((j & 2) ? 16 : 0) + ((j & 1) ? 8 : 0)));
                const float kkn = kk[j] / fmaxf(sqrtf(tot), 1e-12f); ar[j] = -kkn; br[j] = kkn * al[j]; }
            TOT[tg * 64 + ch] = run;
        }
        __syncthreads();
        RW_REP(3) {
            float off = 0.f, gC = 0.f;
#pragma unroll
            for (int g = 0; g < 8; ++g) { const float tv = TOT[g * 64 + ch]; gC += tv; if (g < tg) off += tv; }
            float oat[8], obb[8], okb[8], ov[8];
#pragma unroll
            for (int j = 0; j < 8; ++j) { const int l = tg * 8 + j; const float gt = off + pl[j], gm = j > 0 ? off + pl[j - 1] : off;
                const float at = ar[j] * __expf(gm), rt = rr[j] * __expf(gt), en = __expf(-gt), ec = __expf(gC - gt);
                lds_st_bf16(RM(0) + l * 144 + ch * 2, at); lds_st_bf16(RM(1) + l * 144 + ch * 2, rt); lds_st_bf16(RM(2) + l * 144 + ch * 2, br[j] * en); lds_st_bf16(RM(3) + l * 144 + ch * 2, k2r[j] * en);
                oat[j] = at; obb[j] = br[j] * ec; okb[j] = k2r[j] * ec; ov[j] = vr[j]; }
            *(LAS v4u*)(RM(4) + ch * 144 + tg * 16) = pack8(oat); *(LAS v4u*)(RM(5) + ch * 144 + tg * 16) = pack8(obb); *(LAS v4u*)(RM(6) + ch * 144 + tg * 16) = pack8(okb); *(LAS v4u*)(RM(7) + ch * 144 + tg * 16) = pack8(ov);
            if (tg == 0) GAMC[ch] = __expf(gC);
        }
        __syncthreads();
        RW_REP(4) {
            const int which = wave >> 1; const LAS unsigned char* Aop = which < 2 ? RM(0) : RM(1); const LAS unsigned char* Bop = (which & 1) ? RM(3) : RM(2);
#pragma unroll 1
            for (int i2 = 0; i2 < 2; ++i2) { const int tt = 2 * (wave & 1) + i2, t = tt * 16 + fr;
#pragma unroll
                for (int it = 0; it < 4; ++it) { f32x4 acc = {0.f, 0.f, 0.f, 0.f}; acc = mm16(Aop + tt * 16 * 144, 144, Bop + it * 16 * 144, 144, 64, acc, fr, fq);
                    const int i0 = it * 16 + 4 * fq; const int lim = which < 2 ? t : t + 1;
                    const float o0 = (i0 < lim) ? acc[0] : 0.f, o1 = (i0 + 1 < lim) ? acc[1] : 0.f, o2 = (i0 + 2 < lim) ? acc[2] : 0.f, o3 = (i0 + 3 < lim) ? acc[3] : 0.f;
#ifdef RW_CLAMP_AAK
                    float q0 = o0, q1 = o1, q2 = o2, q3 = o3;
                    if (which == 1) { q0 = fabsf(o0) < 1e30f ? o0 : 0.f; q1 = fabsf(o1) < 1e30f ? o1 : 0.f; q2 = fabsf(o2) < 1e30f ? o2 : 0.f; q3 = fabsf(o3) < 1e30f ? o3 : 0.f; }
                    if (which == 0) *(LAS f32x4*)(AAB + t * 64 + i0) = (f32x4){o0, o1, o2, o3};
                    else lds_st_bf16x4(RM(7 + which) + t * 144 + i0 * 2, q0, q1, q2, q3);
                    continue;
#endif
                    if (which == 0) { DBG_STAT(11, o0); DBG_STAT(11, o1); DBG_STAT(11, o2); DBG_STAT(11, o3); } if (which == 1) { DBG_STAT(12, o0); DBG_STAT(12, o1); DBG_STAT(12, o2); DBG_STAT(12, o3); } if (which == 2) { DBG_STAT(13, o0); DBG_STAT(13, o3); } if (which == 3) { DBG_STAT(14, o0); DBG_STAT(14, o3); }
                    if (which == 0) *(LAS f32x4*)(AAB + t * 64 + i0) = (f32x4){o0, o1, o2, o3};
                    else lds_st_bf16x4(RM(7 + which) + t * 144 + i0 * 2, o0, o1, o2, o3); } }
        }
        __syncthreads();
        RW_REP(5) {
#pragma unroll 1
            for (int i2 = 0; i2 < 2; ++i2) { const int idx = wave * 2 + i2, vt = idx >> 2, tt = idx & 3; f32x4 acc = {0.f, 0.f, 0.f, 0.f};
                acc = mm16(RM(7) + vt * 16 * 144, 144, RM(8) + tt * 16 * 144, 144, 64, acc, fr, fq);
                DBG_STAT(15, acc[0]); DBG_STAT(15, acc[1]); DBG_STAT(15, acc[2]); DBG_STAT(15, acc[3]);
                lds_st_bf16x4(RM(0) + (vt * 16 + fr) * 144 + (tt * 16 + 4 * fq) * 2, acc[0], acc[1], acc[2], acc[3]); }
        }
#if RW_SOLVE_BLK
        LAS unsigned char* T11T = L + 143616;
        LAS unsigned char* YT = RM(8);
        RW_REP(8) if (wave < 2) {
            const int R0 = wave * 32; float x[32]; f32x4 rowq[8];
#pragma unroll
            for (int tl = 0; tl < 32; ++tl) {
                f32x4 cur[8];
#pragma unroll
                for (int i4 = 0; i4 < (tl + 3) / 4; ++i4) cur[i4] = rowq[i4];
                if (tl + 1 < 32) {
#pragma unroll
                    for (int i4 = 0; i4 < (tl + 4) / 4; ++i4) rowq[i4] = *(const LAS f32x4*)(AAB + (R0 + tl + 1) * 64 + R0 + 4 * i4); }
                float a0 = (R0 + tl == ch) ? 1.0f : 0.f, a1 = 0.f, a2 = 0.f, a3 = 0.f;
#pragma unroll
                for (int i4 = 0; i4 < (tl + 3) / 4; ++i4) { const f32x4 q = cur[i4];
                    a0 += q.x * x[4 * i4]; if (4 * i4 + 1 < tl) a1 += q.y * x[4 * i4 + 1]; if (4 * i4 + 2 < tl) a2 += q.z * x[4 * i4 + 2]; if (4 * i4 + 3 < tl) a3 += q.w * x[4 * i4 + 3]; }
                const float acc = (a0 + a1) + (a2 + a3);
                x[tl] = acc; if (wave == 0 || ch >= 32) lds_st_bf16(RM(11) + (R0 + tl) * 144 + ch * 2, acc); }
            if (wave == 0 && ch < 32) {
#pragma unroll
                for (int q = 0; q < 4; ++q) { const float xv[8] = {x[8 * q], x[8 * q + 1], x[8 * q + 2], x[8 * q + 3], x[8 * q + 4], x[8 * q + 5], x[8 * q + 6], x[8 * q + 7]}; *(LAS v4u*)(T11T + ch * 80 + q * 16) = pack8(xv); } }
        }
        __syncthreads();
        if (wave < 4) {
            const int jt = wave >> 1, it = wave & 1; bf16x8 bfa[1];
            { const LAS float* ap = AAB + (32 + it * 16 + fr) * 64 + 8 * fq; const f32x4 p0 = *(const LAS f32x4*)ap, p1 = *(const LAS f32x4*)(ap + 4);
              v4u w; w.x = cvt_pk_bf16(p0.x, p0.y); w.y = cvt_pk_bf16(p0.z, p0.w); w.z = cvt_pk_bf16(p1.x, p1.y); w.w = cvt_pk_bf16(p1.z, p1.w); bfa[0] = __builtin_bit_cast(bf16x8, w); }
            f32x4 acc = {0.f, 0.f, 0.f, 0.f}; acc = mm16_rB<1>(T11T + jt * 16 * 80, 80, bfa, acc, fr, fq);
            lds_st_bf16x4(YT + (jt * 16 + fr) * 80 + (it * 16 + 4 * fq) * 2, acc[0], acc[1], acc[2], acc[3]);
        }
        __syncthreads();
        if (wave < 4) {
            const int it = wave >> 1, jt = wave & 1;
            f32x4 acc = {0.f, 0.f, 0.f, 0.f}; acc = mm16(RM(11) + (32 + it * 16) * 144 + 64, 144, YT + jt * 16 * 80, 80, 32, acc, fr, fq);
            lds_st_bf16x4(RM(11) + (32 + it * 16 + fr) * 144 + (jt * 16 + 4 * fq) * 2, acc[0], acc[1], acc[2], acc[3]);
        }
        __syncthreads();
#else
        RW_REP(8) if (wave == 0) {
            float x[64]; f32x4 rowq[16];
#pragma unroll
            for (int t = 0; t < 64; ++t) {
                f32x4 cur[16];
#pragma unroll
                for (int i4 = 0; i4 < (t + 3) / 4; ++i4) cur[i4] = rowq[i4];
                if (t + 1 < 64) {
#pragma unroll
                    for (int i4 = 0; i4 < (t + 4) / 4; ++i4) rowq[i4] = *(const LAS f32x4*)(AAB + (t + 1) * 64 + 4 * i4); }
                float a0 = (t == ch) ? 1.0f : 0.f, a1 = 0.f, a2 = 0.f, a3 = 0.f;
#pragma unroll
                for (int i4 = 0; i4 < (t + 3) / 4; ++i4) { const f32x4 q = cur[i4];
                    a0 += q.x * x[4 * i4]; if (4 * i4 + 1 < t) a1 += q.y * x[4 * i4 + 1]; if (4 * i4 + 2 < t) a2 += q.z * x[4 * i4 + 2]; if (4 * i4 + 3 < t) a3 += q.w * x[4 * i4 + 3]; }
                const float acc = (a0 + a1) + (a2 + a3);
                x[t] = acc; lds_st_bf16(RM(11) + t * 144 + ch * 2, acc); }
        }
        __syncthreads();
#endif
        RW_REP(6) {
            const int rt = wave >> 1;
#pragma unroll
            for (int i2 = 0; i2 < 2; ++i2) { const int tt = 2 * (wave & 1) + i2;
                f32x4 acc = {0.f, 0.f, 0.f, 0.f}; acc = mm16(RM(4) + rt * 16 * 144, 144, RM(11) + tt * 16 * 144, 144, 64, acc, fr, fq);
                DBG_STAT(17, acc[0]); DBG_STAT(17, acc[1]); DBG_STAT(17, acc[2]); DBG_STAT(17, acc[3]);
                lds_st_bf16x4(RM(2) + (rt * 16 + fr) * 144 + (tt * 16 + 4 * fq) * 2, acc[0], acc[1], acc[2], acc[3]);
                f32x4 ac2 = {0.f, 0.f, 0.f, 0.f}; ac2 = mm16(RM(0) + rt * 16 * 144, 144, RM(11) + tt * 16 * 144, 144, 64, ac2, fr, fq);
                DBG_STAT(18, ac2[0]); DBG_STAT(18, ac2[1]); DBG_STAT(18, ac2[2]); DBG_STAT(18, ac2[3]);
                lds_st_bf16x4(RM(3) + (rt * 16 + fr) * 144 + (tt * 16 + 4 * fq) * 2, ac2[0], ac2[1], ac2[2], ac2[3]); }
        }
        __syncthreads();
        RW_REP(7) {
            const int which = wave >> 1;
#pragma unroll 1
            for (int i2 = 0; i2 < 2; ++i2) { const int rt = 2 * (wave & 1) + i2, row = rt * 16 + fr;
#pragma unroll
                for (int ct = 0; ct < 4; ++ct) { f32x4 acc = {0.f, 0.f, 0.f, 0.f}; const int c0 = ct * 16 + 4 * fq;
                    if (which == 0) { acc = mm16(RM(9) + rt * 16 * 144, 144, RM(2) + ct * 16 * 144, 144, 64, acc, fr, fq);
                        const v2u rw = *(const LAS v2u*)(RM(1) + row * 144 + c0 * 2);
                        acc[0] += __uint_as_float(rw.x << 16); acc[1] += __uint_as_float(rw.x & 0xffff0000u); acc[2] += __uint_as_float(rw.y << 16); acc[3] += __uint_as_float(rw.y & 0xffff0000u);
                        DBG_STAT(19, acc[0]); DBG_STAT(19, acc[1]); DBG_STAT(19, acc[2]); DBG_STAT(19, acc[3]);
                        v2u o; o.x = cvt_pk_bf16(acc[0], acc[1]); o.y = cvt_pk_bf16(acc[2], acc[3]); *(v2u*)(WSP(bf16, WS_RW_RH) + un * 4096 + row * 64 + c0) = o; }
                    else if (which == 1) {
#ifndef RW_NO_U0
                        acc = mm16(RM(9) + rt * 16 * 144, 144, RM(3) + ct * 16 * 144, 144, 64, acc, fr, fq);
#endif
                        acc = mm16(RM(10) + rt * 16 * 144, 144, RM(7) + ct * 16 * 144, 144, 64, acc, fr, fq);
                        DBG_STAT(20, acc[0]); DBG_STAT(20, acc[1]); DBG_STAT(20, acc[2]); DBG_STAT(20, acc[3]);
                        stb4(WSP(bf16, WS_RW_O0) + un * 4096 + row * 64 + c0, acc); }
                    else if (which == 2) { acc = mm16(RM(5) + rt * 16 * 144, 144, RM(2) + ct * 16 * 144, 144, 64, acc, fr, fq);
                        const float gd = GAMC[row]; if (row == c0) acc[0] += gd; if (row == c0 + 1) acc[1] += gd; if (row == c0 + 2) acc[2] += gd; if (row == c0 + 3) acc[3] += gd;
                        DBG_STAT(21, acc[0]); DBG_STAT(21, acc[1]); DBG_STAT(21, acc[2]); DBG_STAT(21, acc[3]);
                        v2u o; o.x = cvt_pk_bf16(acc[0], acc[1]); o.y = cvt_pk_bf16(acc[2], acc[3]);
                        *(v2u*)((unsigned char*)(WSP(bf16, WS_RW_GF) + un * 4096) + ((rt * 2 + (ct >> 1)) * 64 + ch) * 16 + (ct & 1) * 8) = o; }
                    else { acc = mm16(RM(3) + rt * 16 * 144, 144, RM(5) + ct * 16 * 144, 144, 64, acc, fr, fq); acc = mm16(RM(7) + rt * 16 * 144, 144, RM(6) + ct * 16 * 144, 144, 64, acc, fr, fq);
                        DBG_STAT(22, acc[0]); DBG_STAT(22, acc[1]); DBG_STAT(22, acc[2]); DBG_STAT(22, acc[3]);
                        *(f32x4*)(WSP(float, WS_RW_HT) + un * 4096 + row * 64 + c0) = acc; } } }
        }
        __syncthreads();
    }
#undef RM
}
#if RW_SCAN_DMA
__device__ __forceinline__ void rwkv_scan_wave(Frame& F, const Args& A, int wslot) {
    const int lane = F.lane, fr = lane & 15, fq = lane >> 4, bh = wslot >> 2, v0 = (wslot & 3) * 16;
    const unsigned char* GFb = (const unsigned char*)(WSP(bf16, WS_RW_GF) + (size_t)bh * NCH * 4096) + lane * 16;
    const unsigned char* HTb = (const unsigned char*)(WSP(float, WS_RW_HT) + (size_t)bh * NCH * 4096 + (size_t)(v0 + fr) * 64 + 4 * fq);
    bf16* PT = WSP(bf16, WS_RW_PT) + (size_t)bh * NCH * 4096 + (size_t)(v0 + fr) * 64 + 4 * fq;
    LAS unsigned char* ring = F.lds;
    f32x4 P[4] = {{0.f, 0.f, 0.f, 0.f}, {0.f, 0.f, 0.f, 0.f}, {0.f, 0.f, 0.f, 0.f}, {0.f, 0.f, 0.f, 0.f}};
#define RW2_ISSUE(cc, sl) do { _Pragma("unroll") for (int f_ = 0; f_ < 8; ++f_) __builtin_amdgcn_global_load_lds((const unsigned*)(GFb + (size_t)(cc) * 8192 + f_ * 1024), (LAS unsigned*)(ring + (sl) * 12288 + f_ * 1024), 16, 0, 0); \
        _Pragma("unroll") for (int m_ = 0; m_ < 4; ++m_) __builtin_amdgcn_global_load_lds((const unsigned*)(HTb + (size_t)(cc) * 16384 + m_ * 64), (LAS unsigned*)(ring + (sl) * 12288 + 8192 + m_ * 1024), 16, 0, 0); } while (0)
#define RW2_STEP(cc, sl, NW) do { asm volatile("s_waitcnt vmcnt(" #NW ")" ::: "memory"); \
        const LAS unsigned char* sp_ = ring + (sl) * 12288 + lane * 16; bf16x8 gx[4][2]; f32x4 hx[4]; \
        _Pragma("unroll") for (int m = 0; m < 4; ++m) { hx[m] = *(const LAS f32x4*)(sp_ + 8192 + m * 1024); _Pragma("unroll") for (int s = 0; s < 2; ++s) gx[m][s] = *(const LAS bf16x8*)(sp_ + (m * 2 + s) * 1024); } \
        v4u bs[2]; \
        _Pragma("unroll") for (int s = 0; s < 2; ++s) { bs[s].x = cvt_pk_bf16(P[2 * s][0], P[2 * s][1]); bs[s].y = cvt_pk_bf16(P[2 * s][2], P[2 * s][3]); bs[s].z = cvt_pk_bf16(P[2 * s + 1][0], P[2 * s + 1][1]); bs[s].w = cvt_pk_bf16(P[2 * s + 1][2], P[2 * s + 1][3]); } \
        *(v2u*)(PT + (size_t)(cc) * 4096) = (v2u){bs[0].x, bs[0].y}; *(v2u*)(PT + (size_t)(cc) * 4096 + 16) = (v2u){bs[0].z, bs[0].w}; \
        *(v2u*)(PT + (size_t)(cc) * 4096 + 32) = (v2u){bs[1].x, bs[1].y}; *(v2u*)(PT + (size_t)(cc) * 4096 + 48) = (v2u){bs[1].z, bs[1].w}; \
        _Pragma("unroll") for (int m = 0; m < 4; ++m) { f32x4 acc = hx[m]; acc = __builtin_amdgcn_mfma_f32_16x16x32_bf16(gx[m][0], __builtin_bit_cast(bf16x8, bs[0]), acc, 0, 0, 0); \
            acc = __builtin_amdgcn_mfma_f32_16x16x32_bf16(gx[m][1], __builtin_bit_cast(bf16x8, bs[1]), acc, 0, 0, 0); P[m] = acc; } \
        asm volatile("s_waitcnt lgkmcnt(0)" ::: "memory"); } while (0)
    RW2_ISSUE(0, 0); RW2_ISSUE(1, 1); RW2_ISSUE(2, 2);
    RW2_ISSUE(3, 3); RW2_STEP(0, 0, 36); RW2_ISSUE(4, 0); RW2_STEP(1, 1, 40); RW2_ISSUE(5, 1); RW2_STEP(2, 2, 44); RW2_ISSUE(6, 2); RW2_STEP(3, 3, 48);
#pragma unroll 1
    for (int c = 4; c < 60; c += 4) {
        RW2_ISSUE(c + 3, 3); RW2_STEP(c, 0, 48); RW2_ISSUE(c + 4, 0); RW2_STEP(c + 1, 1, 48); RW2_ISSUE(c + 5, 1); RW2_STEP(c + 2, 2, 48); RW2_ISSUE(c + 6, 2); RW2_STEP(c + 3, 3, 48);
    }
    RW2_ISSUE(63, 3); RW2_STEP(60, 0, 48); RW2_STEP(61, 1, 36); RW2_STEP(62, 2, 24); RW2_STEP(63, 3, 12);
#undef RW2_ISSUE
#undef RW2_STEP
}
#else
__device__ __forceinline__ void rwkv_scan_wave(Frame& F, const Args& A, int wslot) {
    const int lane = F.lane, fr = lane & 15, fq = lane >> 4, bh = wslot >> 2, v0 = (wslot & 3) * 16;
    const bf16* GF = WSP(bf16, WS_RW_GF) + (size_t)bh * NCH * 4096; const float* HT = WSP(float, WS_RW_HT) + (size_t)bh * NCH * 4096 + (size_t)(v0 + fr) * 64 + 4 * fq;
    bf16* PT = WSP(bf16, WS_RW_PT) + (size_t)bh * NCH * 4096 + (size_t)(v0 + fr) * 64 + 4 * fq;
    f32x4 P[4] = {{0.f, 0.f, 0.f, 0.f}, {0.f, 0.f, 0.f, 0.f}, {0.f, 0.f, 0.f, 0.f}, {0.f, 0.f, 0.f, 0.f}};
    bf16x8 g0[4][2], g1[4][2], g2[4][2]; f32x4 h0[4], h1[4], h2[4];
#define RW2_LOAD(gx, hx, cc) do { _Pragma("unroll") for (int m = 0; m < 4; ++m) { hx[m] = *(const f32x4*)(HT + (size_t)(cc) * 4096 + 16 * m); \
        _Pragma("unroll") for (int s = 0; s < 2; ++s) gx[m][s] = *(const bf16x8*)(GF + (size_t)(cc) * 4096 + ((m * 2 + s) * 64 + lane) * 8); } } while (0)
#define RW2_STEP(gx, hx, cc) do { v4u bs[2]; \
        _Pragma("unroll") for (int s = 0; s < 2; ++s) { bs[s].x = cvt_pk_bf16(P[2 * s][0], P[2 * s][1]); bs[s].y = cvt_pk_bf16(P[2 * s][2], P[2 * s][3]); bs[s].z = cvt_pk_bf16(P[2 * s + 1][0], P[2 * s + 1][1]); bs[s].w = cvt_pk_bf16(P[2 * s + 1][2], P[2 * s + 1][3]); } \
        *(v2u*)(PT + (size_t)(cc) * 4096) = (v2u){bs[0].x, bs[0].y}; *(v2u*)(PT + (size_t)(cc) * 4096 + 16) = (v2u){bs[0].z, bs[0].w}; \
        *(v2u*)(PT + (size_t)(cc) * 4096 + 32) = (v2u){bs[1].x, bs[1].y}; *(v2u*)(PT + (size_t)(cc) * 4096 + 48) = (v2u){bs[1].z, bs[1].w}; \
        _Pragma("unroll") for (int m = 0; m < 4; ++m) { f32x4 acc = hx[m]; acc = __builtin_amdgcn_mfma_f32_16x16x32_bf16(gx[m][0], __builtin_bit_cast(bf16x8, bs[0]), acc, 0, 0, 0); \
            acc = __builtin_amdgcn_mfma_f32_16x16x32_bf16(gx[m][1], __builtin_bit_cast(bf16x8, bs[1]), acc, 0, 0, 0); P[m] = acc; } } while (0)
    RW2_LOAD(g0, h0, 0); RW2_LOAD(g1, h1, 1);
#pragma unroll 1
    for (int c = 0; c < 63; c += 3) {
        RW2_LOAD(g2, h2, c + 2); RW2_STEP(g0, h0, c);
        RW2_LOAD(g0, h0, c + 3); RW2_STEP(g1, h1, c + 1);
        if (c + 4 < NCH) RW2_LOAD(g1, h1, c + 4);
        RW2_STEP(g2, h2, c + 2);
    }
    RW2_STEP(g0, h0, 63);
#undef RW2_LOAD
#undef RW2_STEP
}
#endif
__device__ __forceinline__ void rwkv_stage3(Frame& F, const Args& A, int layer, int ub) {
    const int t0 = ub * 64, b_ = ub >> 6, c = ub & 63, lane = F.lane, wave = F.wave, fr = lane & 15, fq = lane >> 4, hh = wave >> 1;
    const size_t un = (size_t)(b_ * 4 + hh) * NCH + c;
    const bf16* RH = WSP(bf16, WS_RW_RH) + un * 4096; const bf16* PT = WSP(bf16, WS_RW_PT) + un * 4096; const bf16* O0 = WSP(bf16, WS_RW_O0) + un * 4096;
    const bf16* RW = WSP(bf16, WS_RW); const bf16* RG = WSP(bf16, WS_RW_G); bf16* mix = WSP(bf16, WS_MIX);
    const float* lg = KIN(I_RLNG) + layer * 256 + hh * 64; const float* lb = KIN(I_RLNB) + layer * 256 + hh * 64; const float* rk = KIN(I_RRK) + layer * 256 + hh * 64;
    bf16x8 pfr[4][2];
#pragma unroll
    for (int vt = 0; vt < 4; ++vt)
#pragma unroll
        for (int ks = 0; ks < 2; ++ks) pfr[vt][ks] = *(const bf16x8*)(PT + (size_t)(vt * 16 + fr) * 64 + ks * 32 + fq * 8);
#pragma unroll 1
    for (int i = 0; i < 2; ++i) { const int tt = 2 * (wave & 1) + i, tl = tt * 16 + fr, t = t0 + tl;
        const bf16x8 ra0 = *(const bf16x8*)(RH + (size_t)tl * 64 + fq * 8), ra1 = *(const bf16x8*)(RH + (size_t)tl * 64 + 32 + fq * 8);
        f32x4 ov[4]; float sm = 0.f;
#pragma unroll
        for (int vt = 0; vt < 4; ++vt) { f32x4 acc = ldb4(O0 + tl * 64 + vt * 16 + 4 * fq);
            acc = __builtin_amdgcn_mfma_f32_16x16x32_bf16(pfr[vt][0], ra0, acc, 0, 0, 0); acc = __builtin_amdgcn_mfma_f32_16x16x32_bf16(pfr[vt][1], ra1, acc, 0, 0, 0);
            ov[vt] = acc; DBG_STAT(24, acc[0]); DBG_STAT(24, acc[1]); DBG_STAT(24, acc[2]); DBG_STAT(24, acc[3]); sm += (acc.x + acc.y) + (acc.z + acc.w); }
        sm += __shfl_xor(sm, 16); sm += __shfl_xor(sm, 32);
        const float mean = sm * (1.f / 64.f); float sq = 0.f;
#pragma unroll
        for (int vt = 0; vt < 4; ++vt) { ov[vt] = ov[vt] - mean; sq += (ov[vt].x * ov[vt].x + ov[vt].y * ov[vt].y) + (ov[vt].z * ov[vt].z + ov[vt].w * ov[vt].w); }
        sq += __shfl_xor(sq, 16); sq += __shfl_xor(sq, 32);
        const float rs = __builtin_amdgcn_rsqf(sq * (1.f / 64.f) + RWKV_GN_EPS);
        float bd = 0.f;
#pragma unroll
        for (int q = 0; q < 4; ++q) { const f32x4 r4 = ldb4(RW + (size_t)t * 768 + hh * 64 + fq * 16 + 4 * q), k4 = ldb4(RW + (size_t)t * 768 + 256 + hh * 64 + fq * 16 + 4 * q), c4 = *(const f32x4*)(rk + fq * 16 + 4 * q);
            bd += (r4.x * k4.x * c4.x + r4.y * k4.y * c4.y) + (r4.z * k4.z * c4.z + r4.w * k4.w * c4.w); }
        bd += __shfl_xor(bd, 16); bd += __shfl_xor(bd, 32);
#pragma unroll
        for (int vt = 0; vt < 4; ++vt) { const int col = vt * 16 + 4 * fq; const f32x4 g4 = *(const f32x4*)(lg + col), b4 = *(const f32x4*)(lb + col);
            const f32x4 v4 = ldb4(RW + (size_t)t * 768 + 512 + hh * 64 + col), gg = ldb4(RG + (size_t)t * 256 + hh * 64 + col);
            float e0 = (ov[vt].x * rs * g4.x + b4.x + bd * v4.x) * gg.x, e1 = (ov[vt].y * rs * g4.y + b4.y + bd * v4.y) * gg.y, e2 = (ov[vt].z * rs * g4.z + b4.z + bd * v4.z) * gg.z, e3 = (ov[vt].w * rs * g4.w + b4.w + bd * v4.w) * gg.w;
#ifdef RW_SANITIZE
            e0 = (fabsf(e0) < 1e30f) ? e0 : 0.f; e1 = (fabsf(e1) < 1e30f) ? e1 : 0.f; e2 = (fabsf(e2) < 1e30f) ? e2 : 0.f; e3 = (fabsf(e3) < 1e30f) ? e3 : 0.f;
#endif
            MIX_ST4(mix, (size_t)t * D + 256 + hh * 64 + col, e0, e1, e2, e3); } }
}

constexpr int SCAN_N_MAIN = 16 * 64 * 128 / 2 + 16 * 32 * 64 / 2 + 16 * 64 * 64 / 2, SCAN_N_ALL = SCAN_N_MAIN + 16 * 64 / 2;
__device__ __forceinline__ void scans_elementwise(Frame& F, const Args& A, int gt, int nthr, int lo, int hi) {
    constexpr int N_SSD = 16 * 64 * 128 / 2, N_GLA = 16 * 32 * 64 / 2, N_MLC = 16 * 64 * 64 / 2, N_MLN = 16 * 64 / 2;
    for (int i = lo + gt; i < hi; i += nthr) {
        if (i < N_SSD) { const int bh = i >> 12, pn = (i & 4095) * 2; unsigned* base = (unsigned*)(WSP(bf16, WS_SSD_ST) + (size_t)bh * NCH * 8192 + pn); const float* dec = WSP(float, WS_SSD_DEC) + bh * NCH; float S0 = 0.f, S1 = 0.f;
#pragma unroll 1
            for (int c0 = 0; c0 < NCH; c0 += 32) { unsigned x[32]; float dd[32];
#pragma unroll
                for (int j = 0; j < 32; ++j) { x[j] = base[(size_t)(c0 + j) * 4096]; dd[j] = dec[c0 + j]; }
#pragma unroll
                for (int j = 0; j < 32; ++j) { base[(size_t)(c0 + j) * 4096] = cvt_pk_bf16(S0, S1); S0 = dd[j] * S0 + __uint_as_float(x[j] << 16); S1 = dd[j] * S1 + __uint_as_float(x[j] & 0xffff0000u); } }
        } else if (i < N_SSD + N_GLA) { const int k = i - N_SSD, bh = k >> 10, dv = (k & 1023) * 2, dd_ = dv >> 6, b = bh >> 2, hh = bh & 3; unsigned* base = (unsigned*)(WSP(bf16, WS_GLA_ST) + (size_t)bh * NCH * 2048 + dv); const float* dec = WSP(float, WS_GLA_DEC) + (size_t)b * NCH * 128 + hh * 32 + dd_; float S0 = 0.f, S1 = 0.f;
#pragma unroll 1
            for (int c0 = 0; c0 < NCH; c0 += 32) { unsigned x[32]; float dd[32];
#pragma unroll
                for (int j = 0; j < 32; ++j) { x[j] = base[(size_t)(c0 + j) * 1024]; dd[j] = dec[(c0 + j) * 128]; }
#pragma unroll
                for (int j = 0; j < 32; ++j) { base[(size_t)(c0 + j) * 1024] = cvt_pk_bf16(S0, S1); S0 = dd[j] * S0 + __uint_as_float(x[j] << 16); S1 = dd[j] * S1 + __uint_as_float(x[j] & 0xffff0000u); } }
        } else { const int k = i - N_SSD - N_GLA; const bool isn = k >= N_MLC; const int kk = isn ? k - N_MLC : k; const int bh = isn ? (kk >> 5) : (kk >> 11), e = (isn ? (kk & 31) : (kk & 2047)) * 2, str = isn ? 32 : 2048;
            unsigned* base = (unsigned*)((isn ? WSP(bf16, WS_ML_N) : WSP(bf16, WS_ML_C)) + (size_t)bh * NCH * str * 2 + e); const float* bl = WSP(float, WS_ML_BL) + bh * NCH; const float* ml = WSP(float, WS_ML_ML) + bh * NCH; float* mo = WSP(float, WS_ML_M) + bh * NCH;
            float S0 = 0.f, S1 = 0.f, m = 0.f;
#pragma unroll 1
            for (int c0 = 0; c0 < NCH; c0 += 32) { unsigned x[32]; float b8[32], m8[32];
#pragma unroll
                for (int j = 0; j < 32; ++j) { x[j] = base[(size_t)(c0 + j) * str]; b8[j] = bl[c0 + j]; m8[j] = ml[c0 + j]; }
#pragma unroll
                for (int j = 0; j < 32; ++j) { const float mn = fmaxf(b8[j] + m, m8[j]); const float so = __expf(b8[j] + m - mn), sn = __expf(m8[j] - mn);
                    base[(size_t)(c0 + j) * str] = cvt_pk_bf16(S0, S1); if (!isn && e == 0) mo[c0 + j] = m; S0 = so * S0 + sn * __uint_as_float(x[j] << 16); S1 = so * S1 + sn * __uint_as_float(x[j] & 0xffff0000u); m = mn; } }
        }
    }
}
#ifndef MK_PER_PHASE_LAUNCH
#define MK_PER_PHASE_LAUNCH 0
#endif
#ifndef PH_MASK
#define PH_MASK 0xFFF
#endif
#ifndef ST_MASK
#define ST_MASK 0xF
#endif
#define ST_ON(k) (((ST_MASK) >> (k)) & 1)
#ifndef DUP_MASK
#define DUP_MASK 0
#endif
#define DUP_N(k) ((((DUP_MASK) >> (k)) & 1) ? 2 : 1)
#ifndef ST_DUP
#define ST_DUP 0
#endif
#define ST_REP(ty) ((((ST_DUP) >> (ty)) & 1) ? 2 : 1)
#define PH_ON(k) (((PH_MASK) >> (k)) & 1)
constexpr int PH_PER_LAYER = 11, N_PHASES = 1 + DEPTH * PH_PER_LAYER;
__global__ void __launch_bounds__(NWAVES * 64, 2) fwd_kernel(Args args) {
    extern __shared__ __attribute__((aligned(16))) unsigned char lds[];
    Frame F;
    F.lds = (LAS unsigned char*)lds;
    F.MISC = (volatile LAS unsigned*)(F.lds + MISC_OFF);
    F.tid = threadIdx.x; F.lane = F.tid & 63; F.wave = __builtin_amdgcn_readfirstlane(F.tid >> 6);
    F.G = gridDim.x; { const int bx = blockIdx.x; F.vcu = (F.G % 8 == 0) ? (bx % 8) * (F.G / 8) + bx / 8 : bx; }
    F.ka = (karg_t)__builtin_amdgcn_kernarg_segment_ptr(); F.ws = args.ws; F.ctl = (gu32*)(args.ws + WS_CTL); F.out = args.out;
    for (int i = F.tid; i < 256; i += NWAVES * 64) F.MISC[i] = 0u;
    __syncthreads();
    const int lo = args.ph_lo, hi = args.ph_hi;
#ifdef DBG_TSEL
    if (blockIdx.x == 0 && threadIdx.x == 0) __hip_atomic_store(F.ctl + CW_DBG + 15, (unsigned)__builtin_amdgcn_s_memrealtime(), RLX_AGENT);
#endif
    XcdBarrier bar; bar.bar = (unsigned*)(F.ctl + CW_BAR); bar.x = 0; bar.st = nullptr;
    if (hi - lo > 1) bar = xcd_barrier_post((unsigned*)(F.ctl + CW_BAR), F.MISC + MW_BAR);
#define IN_(k) (lo <= (k) && (k) < hi)
#ifdef DBG_TSEL
#ifndef DBG_TQ
#define DBG_TQ 50.0f
#endif
#define TSTAMP(k) do { if (blockIdx.x == 0 && threadIdx.x == 0) __hip_atomic_store(F.ctl + CW_DBG + 16 + ((k) == 11 ? 0 : 1 + layer_ * PH_PER_LAYER + (k)), (unsigned)__builtin_amdgcn_s_memrealtime(), RLX_AGENT); } while (0)
#else
#define TSTAMP(k) do { } while (0)
#endif
#ifdef BAR_DUP
#define SEAM(k) do { if (IN_(k) && IN_((k) + 1)) { xcd_barrier(bar); xcd_barrier(bar); } } while (0)
#else
#define SEAM(k) do { if (IN_(k) && IN_((k) + 1)) xcd_barrier(bar); } while (0)
#endif

    if (PH_ON(11) && IN_(0)) { for (int rep_ = 0; rep_ < DUP_N(11); ++rep_) { frame_refresh(F); p0_prologue(F, args); } SEAM(0); { const int layer_ = 0; TSTAMP(11); (void)layer_; } }
#pragma unroll 1
    for (int layer = 0; layer < DEPTH; ++layer) {
        const int pb = 1 + layer * PH_PER_LAYER; const int layer_ = layer; (void)layer_;
        if (PH_ON(0) && IN_(pb + 0)) { for (int rep_ = 0; rep_ < DUP_N(0); ++rep_) { frame_refresh(F);
            { pg8::DenseSched S; S.init(WSP(bf16, WS_XB), WSP(bf16, WS_WIN_T) + (size_t)layer * NUP * D, T, NUP, D, F.G, (int)blockIdx.x);
              pg8::EpiB16 E{WSP(bf16, WS_U), NUP, nullptr, 0.f};
              pg8::gemm_phase<pg8::EpiB16, pg8::DenseSched>(F.lds, F.tid, S, E); }
            if (F.G != 256 || blockIdx.x >= 128)
            { pg8::DenseSched S; if (F.G == 256) S.init(WSP(bf16, WS_PB) + (size_t)layer * T * 256, WSP(bf16, WS_WPP_T) + (size_t)layer * D * 256, T, D, 256, 128, (int)blockIdx.x - 128); else S.init(WSP(bf16, WS_PB) + (size_t)layer * T * 256, WSP(bf16, WS_WPP_T) + (size_t)layer * D * 256, T, D, 256, F.G, (int)blockIdx.x);
              pg8::EpiB16 E{WSP(bf16, WS_PE), D, nullptr, 0.f};
              pg8::gemm_phase<pg8::EpiB16, pg8::DenseSched>(F.lds, F.tid, S, E); }
            } SEAM(pb + 0); TSTAMP(0);
        }
        if (PH_ON(1) && IN_(pb + 1)) { for (int rep_ = 0; rep_ < DUP_N(1); ++rep_) { frame_refresh(F);
            for (int un = F.vcu; un < 1024; un += F.G) { frame_refresh(F); const int ty = un >> 8, r = un & 255, b = r >> 6, c = r & 63;
                if (ty == 0) { ssd_stage1(F, args, layer, b, c); if (ST_DUP & 1) ssd_stage1(F, args, layer, b, c); } else if (ty == 1) { gla_stage1(F, args, layer, b, c); if (ST_DUP & 2) gla_stage1(F, args, layer, b, c); } else if (ty == 2) { mlstm_stage1(F, args, layer, b, c); if (ST_DUP & 4) mlstm_stage1(F, args, layer, b, c); } else { rwkv_stage1(F, args, layer, r); if (ST_DUP & 8) rwkv_stage1(F, args, layer, r); } }
            } SEAM(pb + 1); TSTAMP(1);
        }
        if (PH_ON(2) && IN_(pb + 2)) { for (int rep_ = 0; rep_ < DUP_N(2); ++rep_) { frame_refresh(F);
            if (F.wave == 0) { for (int ws_ = F.vcu; ws_ < 64; ws_ += F.G) rwkv_scan_wave(F, args, ws_);
                if (rep_ == 0) { if (F.G > 64) { if (F.vcu >= 64) scans_elementwise(F, args, (F.vcu - 64) * 64 + F.lane, (F.G - 64) * 64, SCAN_N_MAIN, SCAN_N_ALL); } else scans_elementwise(F, args, F.vcu * 64 + F.lane, F.G * 64, SCAN_N_MAIN, SCAN_N_ALL); } }
            else if (rep_ == 0) scans_elementwise(F, args, F.vcu * 448 + (F.tid - 64), F.G * 448, 0, SCAN_N_MAIN);
            } SEAM(pb + 2); TSTAMP(2);
        }
        if (PH_ON(3) && IN_(pb + 3)) { for (int rep_ = 0; rep_ < DUP_N(3); ++rep_) { frame_refresh(F);
            for (int un = F.vcu; un < 1024; un += F.G) { frame_refresh(F); const int ty = un >> 8, r = un & 255, b = r >> 6, c = r & 63;
                if (ty == 0) { ssd_stage3(F, args, layer, b, c); if (ST_DUP & 16) ssd_stage3(F, args, layer, b, c); } else if (ty == 1) { gla_stage3(F, args, layer, b, c); if (ST_DUP & 32) gla_stage3(F, args, layer, b, c); } else if (ty == 2) { mlstm_stage3(F, args, layer, b, c); if (ST_DUP & 64) mlstm_stage3(F, args, layer, b, c); } else { rwkv_stage3(F, args, layer, r); if (ST_DUP & 128) rwkv_stage3(F, args, layer, r); } }
            } SEAM(pb + 3); TSTAMP(3);
        }
        if (PH_ON(4) && IN_(pb + 4)) { for (int rep_ = 0; rep_ < DUP_N(4); ++rep_) { frame_refresh(F);
#if OUT_FP8 && OUT_CHAIN
            pg8::EpiB16W E{WSP(bf16, WS_Y1), D, WSP(bf16, WS_XB), DN_ALPHA};
            pg8::OutSched S; S.init(WSP(bf16, WS_MIX), (const bf16*)(WSP(unsigned char, WS_WOUT_Q) + (size_t)layer * D * D), T, D, D / 2, F.G, (int)blockIdx.x); S.pan = F.ctl + CW_PAN2 + layer * 1024;
            pg8::gemm_phase<pg8::EpiB16W, pg8::OutSched>(F.lds, F.tid, S, E);
#elif OUT_FP8
            pg8::EpiB16 E{WSP(bf16, WS_Y1), D, WSP(bf16, WS_XB), DN_ALPHA};
            pg8::DenseSched8b S; S.init(WSP(bf16, WS_MIX), (const bf16*)(WSP(unsigned char, WS_WOUT_Q) + (size_t)layer * D * D), T, D, D / 2, F.G, (int)blockIdx.x);
            pg8::gemm_phase<pg8::EpiB16, pg8::DenseSched8b>(F.lds, F.tid, S, E);
#else
            pg8::EpiB16 E{WSP(bf16, WS_Y1), D, WSP(bf16, WS_XB), DN_ALPHA};
            pg8::DenseSched S; S.init(WSP(bf16, WS_MIX), WSP(bf16, WS_WOUT_T) + (size_t)layer * D * D, T, D, D, F.G, (int)blockIdx.x);
            pg8::gemm_phase<pg8::EpiB16, pg8::DenseSched>(F.lds, F.tid, S, E);
#endif
            }
#if OUT_FP8 && OUT_CHAIN && OUT_CHAIN_POLL
            if (!(PH_ON(5) && IN_(pb + 5))) SEAM(pb + 4);
#else
            SEAM(pb + 4);
#endif
            TSTAMP(4);
        }
        if (PH_ON(5) && IN_(pb + 5)) { if (DUP_N(5) == 2) { frame_refresh(F); p6_ln1_router<true>(F, args, layer); } frame_refresh(F); p6_ln1_router<false>(F, args, layer, (OUT_FP8 && OUT_CHAIN && OUT_CHAIN_POLL && PH_ON(4) && IN_(pb + 4)) ? (const gu32*)(F.ctl + CW_PAN2 + layer * 1024) : (const gu32*)nullptr); SEAM(pb + 5); TSTAMP(5); }
        if (PH_ON(6) && IN_(pb + 6)) { for (int rep_ = 0; rep_ < DUP_N(6); ++rep_) { frame_refresh(F);
            moe_build_pfx(F, args, layer, 8);
            pg8::Moe1Sched S; S.O.pfx = F.MISC + MW_PFX; S.O.NT = 8; S.O.G = F.G; S.O.c = (int)blockIdx.x; S.sdest = WSP(int, WS_SDEST); S.bgu = KIN(I_BGU) + (size_t)layer * NE * 2048; S.pan = F.ctl + CW_PAN + layer * (NE * 64 * 16);
            if (MOE_FP8) { S.X = WSP(unsigned char, WS_X1Q); S.W = WSP(unsigned char, WS_WGU_Q) + (size_t)layer * NE * 2048 * D; S.K = D / 2; S.hstepB = (size_t)1024 * D; }
            else { S.X = WSP(unsigned char, WS_X1B); S.W = WSP(unsigned char, WS_WGU_T) + (size_t)layer * NE * 2048 * D * 2; S.K = D; S.hstepB = (size_t)1024 * D * 2; }
            pg8::EpiMoe1 E{WSP(bf16, WS_ABUF), KIN(I_BGU) + (size_t)layer * NE * 2048, WSP(unsigned char, WS_ABUFQ)};
            pg8::gemm_phase<pg8::EpiMoe1, pg8::Moe1Sched>(F.lds, F.tid, S, E);
            }
#if MOE_CHAIN
            if (!(PH_ON(7) && IN_(pb + 7))) SEAM(pb + 6);
#else
            SEAM(pb + 6);
#endif
            TSTAMP(6);
        }
        if (PH_ON(7) && IN_(pb + 7)) { for (int rep_ = 0; rep_ < DUP_N(7); ++rep_) { frame_refresh(F);
            int c2 = (int)blockIdx.x; if (MOE_CHAIN && PH_ON(6) && IN_(pb + 6) && (F.G & 7) == 0) { const int r1 = (int)F.MISC[MW_PFX + 32] % F.G; if ((r1 & 7) == 0) c2 = (c2 - r1 + F.G) % F.G; }
            moe_build_pfx(F, args, layer, 4);
            pg8::Moe2Sched S; S.O.pfx = F.MISC + MW_PFX; S.O.NT = 4; S.O.G = F.G; S.O.c = c2; S.pan = F.ctl + CW_PAN + layer * (NE * 64 * 16); S.tmo = F.ctl + CW_BAR + XB_TMO; S.sdest = WSP(int, WS_SDEST); S.sgate = WSP(float, WS_SGATE); S.bdn = KIN(I_BDN) + (size_t)layer * NE * D; if (MOE2_FP8) { S.Ab = WSP(unsigned char, WS_ABUFQ); S.W = WSP(unsigned char, WS_WDN_Q) + (size_t)layer * NE * D * D; S.K = D / 2; S.hstepB = (size_t)128 * D; }
            else { S.Ab = WSP(unsigned char, WS_ABUF); S.W = WSP(unsigned char, WS_WDN_T) + (size_t)layer * NE * D * D * 2; S.K = D; S.hstepB = (size_t)128 * D * 2; }
            pg8::EpiMoe2 E{WSP(bf16, WS_YBUF), KIN(I_BDN) + (size_t)layer * NE * D, WSP(int, WS_SDEST), WSP(float, WS_SGATE)};
            pg8::gemm_phase<pg8::EpiMoe2, pg8::Moe2Sched>(F.lds, F.tid, S, E);
            } SEAM(pb + 7); TSTAMP(7);
        }
        if (PH_ON(8) && IN_(pb + 8)) { for (int rep_ = 0; rep_ < DUP_N(8); ++rep_) { frame_refresh(F); p9_combine(F, args); } SEAM(pb + 8); TSTAMP(8); }
        if (PH_ON(9) && IN_(pb + 9)) { for (int rep_ = 0; rep_ < DUP_N(9); ++rep_) { frame_refresh(F);
            pg8::EpiPle E{WSP(bf16, WS_H2), WSP(bf16, WS_HB), WSP(bf16, WS_PE)};
#if PLE_FP8
            pg8::DenseSched8 S; S.init((const bf16*)WSP(unsigned char, WS_HQ), (const bf16*)(WSP(unsigned char, WS_WPG_Q) + (size_t)layer * D * D), T, D, D / 2, F.G, (int)blockIdx.x);
            pg8::gemm_phase<pg8::EpiPle, pg8::DenseSched8>(F.lds, F.tid, S, E);
#else
            pg8::DenseSched S; S.init(WSP(bf16, WS_HB), WSP(bf16, WS_WPG_T) + (size_t)layer * D * D, T, D, D, F.G, (int)blockIdx.x);
            pg8::gemm_phase<pg8::EpiPle, pg8::DenseSched>(F.lds, F.tid, S, E);
#endif
            } SEAM(pb + 9); TSTAMP(9);
        }
        if (PH_ON(10) && IN_(pb + 10)) { for (int rep_ = 0; rep_ < DUP_N(10); ++rep_) { frame_refresh(F); p11_ln2(F, args, layer); } SEAM(pb + 10); TSTAMP(10); }
    }
#ifdef DBG_TSEL
    if (hi - lo > 1) { xcd_barrier(bar);
        unsigned ticks = 0u;
        if (DBG_TSEL == 11) ticks = __hip_atomic_load(F.ctl + CW_DBG + 16, RLX_AGENT) - __hip_atomic_load(F.ctl + CW_DBG + 15, RLX_AGENT);
        else for (int l = 0; l < DEPTH; ++l) { const int pi = 1 + l * PH_PER_LAYER + DBG_TSEL; ticks += __hip_atomic_load(F.ctl + CW_DBG + 16 + pi, RLX_AGENT) - __hip_atomic_load(F.ctl + CW_DBG + 16 + pi - 1, RLX_AGENT); }
        const float us = floorf((float)ticks * 0.01f / DBG_TQ) * DBG_TQ; const float code = sqrtf(us * 0.05f);
        for (size_t i = (size_t)blockIdx.x * 512 + threadIdx.x; i < (size_t)T * D; i += (size_t)gridDim.x * 512) F.out[i] = code; }
#endif
#ifdef DBG_SEL
    if (hi - lo > 1) { xcd_barrier(bar);
        const unsigned mx = __hip_atomic_load(F.ctl + CW_DBG, RLX_AGENT), nf = __hip_atomic_load(F.ctl + CW_DBG + 1, RLX_AGENT);
        float code;
        { const float m = __uint_as_float(mx); int b = (m > 0.f) ? (int)floorf(log10f(m)) + 30 : 0; b = b < 0 ? 0 : (b > 60 ? 60 : b); if (nf) b += 100; code = sqrtf(10.0f * (float)(b + 1)); }
        for (size_t i = (size_t)blockIdx.x * 512 + threadIdx.x; i < (size_t)T * D; i += (size_t)gridDim.x * 512) F.out[i] = code; }
#endif
#undef IN_
#undef SEAM
}

extern "C" void kernel_launch(void* const* d_in, const int* in_sizes, int n_in, void* d_out, int out_size, void* d_ws, size_t ws_size, hipStream_t stream) {
    static int grid = 0;
    if (grid == 0) {
        if (n_in != N_IN || out_size != T * D || ws_size < WS_END) { fprintf(stderr, "kernel_launch: unexpected shapes (n_in %d, out %d, ws %zu < %zu); nothing launched\n", n_in, out_size, ws_size, (size_t)WS_END); grid = -1; return; }
        int dev = 0, cus = 0, per_cu = 0;
        if (hipGetDevice(&dev) != hipSuccess || hipDeviceGetAttribute(&cus, hipDeviceAttributeMultiprocessorCount, dev) != hipSuccess) { grid = -1; return; }
        if (hipFuncSetAttribute((const void*)fwd_kernel, hipFuncAttributeMaxDynamicSharedMemorySize, LDS_BYTES) != hipSuccess) { fprintf(stderr, "kernel_launch: hipFuncSetAttribute failed\n"); grid = -1; return; }
        if (hipOccupancyMaxActiveBlocksPerMultiprocessor(&per_cu, (const void*)fwd_kernel, NWAVES * 64, LDS_BYTES) != hipSuccess || per_cu < 1) { fprintf(stderr, "kernel_launch: occupancy query says %d blocks per CU\n", per_cu); }
        (void)hipGetLastError();
        grid = cus;
    }
    if (grid < 0) return;
    (void)hipMemsetAsync((char*)d_ws + WS_CTL, 0, CTL_ZERO_BYTES, stream);
    Args a{};
    for (int i = 0; i < N_IN; ++i) a.in[i] = (const float*)d_in[i];
    a.out = (float*)d_out; a.ws = (unsigned char*)d_ws;
#if MK_PER_PHASE_LAUNCH
    for (int ph = 0; ph < N_PHASES; ++ph) { a.ph_lo = ph; a.ph_hi = ph + 1; hipLaunchKernelGGL(fwd_kernel, dim3(grid), dim3(NWAVES * 64), LDS_BYTES, stream, a); }
#else
    a.ph_lo = 0; a.ph_hi = N_PHASES; hipLaunchKernelGGL(fwd_kernel, dim3(grid), dim3(NWAVES * 64), LDS_BYTES, stream, a);
#endif
    const hipError_t le = hipPeekAtLastError();
    if (le != hipSuccess) fprintf(stderr, "kernel_launch: launch failed: %s\n", hipGetErrorName(le));
}
```

```cpp
#include <hip/hip_runtime.h>
#include <cstdio>
#include <cstdint>

#define GAS __attribute__((address_space(1)))
#define LAS __attribute__((address_space(3)))
typedef unsigned short bf16;
typedef unsigned v4u __attribute__((ext_vector_type(4)));
typedef unsigned v2u __attribute__((ext_vector_type(2)));
typedef float f32x4 __attribute__((ext_vector_type(4)));
typedef float f32x2 __attribute__((ext_vector_type(2)));
typedef short bf16x8 __attribute__((ext_vector_type(8)));
typedef int v4i_t __attribute__((ext_vector_type(4)));
typedef int v8i_t __attribute__((ext_vector_type(8)));
typedef GAS unsigned gu32;
#define RLX_AGENT __ATOMIC_RELAXED, __HIP_MEMORY_SCOPE_AGENT
#define LDS_WAIT() asm volatile("s_waitcnt lgkmcnt(0)" ::: "memory")
#define VM_WAIT() asm volatile("s_waitcnt vmcnt(0)" ::: "memory")

constexpr int NWAVES = 8;
constexpr int DEPTH = 4, BATCH = 4, SEQ = 4096, D = 1024, T = BATCH * SEQ;
constexpr int NU = 3484, NUP = 3584;
constexpr int NE = 32, TOPK = 4, ECAP = 16384;
constexpr int NCH = SEQ / 64;
constexpr int U_SSD_Z = 0, U_SSD_X = 256, U_SSD_B = 512, U_SSD_C = 640, U_SSD_DT = 768;
constexpr int U_RW = 772, U_RW_R = 772, U_RW_K = 1028, U_RW_V = 1284, U_RW_LO = 1540;
constexpr int U_GL_Q = 1668, U_GL_K = 1796, U_GL_V = 1924, U_GL_G = 2180, U_GL_OG = 2196;
constexpr int U_ML_Q = 2452, U_ML_K = 2708, U_ML_V = 2964, U_ML_I = 3220, U_ML_F = 3224, U_ML_O = 3228;
constexpr float DN_ALPHA = 1.6817928305074290f;
constexpr float LN_EPS = 1e-5f, NORM_EPS = 1e-5f, RWKV_GN_EPS = 64e-5f;

enum { I_X = 0, I_P, I_WIN, I_WOUT, I_LN1G, I_LN1B, I_SCW, I_SCB, I_SALOG, I_SDTB, I_SD, I_SNG,
       I_RMU, I_RW0, I_RWUP, I_RA0, I_RAUP, I_RGUP, I_RKK, I_RKA, I_RRK, I_RLNG, I_RLNB,
       I_GGUP, I_GGB, I_GNG, I_MCW, I_MCB, I_MIB, I_MFB, I_MNG,
       I_RTW, I_RTB, I_WGU, I_BGU, I_WDN, I_BDN, I_PGW, I_PPJ, I_LN2G, I_LN2B, N_IN };

constexpr size_t MiB = 1u << 20;
constexpr size_t WS_CTL = 0, CTL_ZERO_BYTES = 1 * MiB;
constexpr size_t WS_WIN_T = 2 * MiB;
constexpr size_t WS_WOUT_T = WS_WIN_T + (size_t)DEPTH * NUP * D * 2;
constexpr size_t WS_WGU_T = WS_WOUT_T + (size_t)DEPTH * D * D * 2;
constexpr size_t WS_WDN_T = WS_WGU_T + (size_t)DEPTH * NE * 2048 * D * 2;
constexpr size_t WS_WPG_T = WS_WDN_T + (size_t)DEPTH * NE * D * D * 2;
constexpr size_t WS_WPP_T = WS_WPG_T + (size_t)DEPTH * D * D * 2;
constexpr size_t WS_RWT = WS_WPP_T + (size_t)DEPTH * D * 256 * 2;
constexpr size_t WS_PB = WS_RWT + (size_t)DEPTH * NE * D * 4;
constexpr size_t WS_XB = WS_PB + (size_t)DEPTH * T * 256 * 2;
constexpr size_t WS_U = WS_XB + (size_t)T * D * 2;
constexpr size_t WS_PE = WS_U + (size_t)T * NUP * 2;
constexpr size_t WS_MIX = WS_PE + (size_t)T * D * 4;
constexpr size_t WS_Y1 = WS_MIX + (size_t)T * D * 2;
constexpr size_t WS_X1 = WS_Y1 + (size_t)T * D * 4;
constexpr size_t WS_X1B = WS_X1 + (size_t)T * D * 4;
constexpr size_t WS_SDEST = WS_X1B + (size_t)T * D * 2;
constexpr size_t WS_SGATE = WS_SDEST + (size_t)NE * ECAP * 4;
constexpr size_t WS_ABUF = WS_SGATE + (size_t)NE * ECAP * 4;
constexpr size_t WS_YBUF = WS_ABUF + (size_t)NE * ECAP * D * 2;
constexpr size_t WS_H = WS_YBUF + (size_t)T * 4 * D * 2;
constexpr size_t WS_HB = WS_H + (size_t)T * D * 4;
constexpr size_t WS_H2 = WS_HB + (size_t)T * D * 2;
constexpr size_t WS_SSD_ST = WS_H2 + (size_t)T * D * 4;
constexpr size_t WS_SSD_DEC = WS_SSD_ST + (size_t)16 * NCH * 64 * 128 * 4;
constexpr size_t WS_GLA_ST = WS_SSD_DEC + 16 * NCH * 4;
constexpr size_t WS_GLA_DEC = WS_GLA_ST + (size_t)16 * NCH * 32 * 64 * 4;
constexpr size_t WS_ML_C = WS_GLA_DEC + (size_t)4 * NCH * 128 * 4;
constexpr size_t WS_ML_N = WS_ML_C + (size_t)16 * NCH * 64 * 64 * 4;
constexpr size_t WS_ML_BL = WS_ML_N + (size_t)16 * NCH * 64 * 4;
constexpr size_t WS_ML_ML = WS_ML_BL + 16 * NCH * 4;
constexpr size_t WS_ML_M = WS_ML_ML + 16 * NCH * 4;
constexpr size_t WS_RW = WS_ML_M + 16 * NCH * 4;
constexpr size_t WS_RW_G = WS_RW + (size_t)T * 3 * 256 * 4;
constexpr size_t WS_RW_RH = WS_RW_G + (size_t)T * 256 * 4;
constexpr size_t WS_RW_O0 = WS_RW_RH + (size_t)1024 * 4096 * 2;
constexpr size_t WS_RW_GF = WS_RW_O0 + (size_t)1024 * 4096 * 4;
constexpr size_t WS_RW_HT = WS_RW_GF + (size_t)1024 * 4096 * 2;
constexpr size_t WS_RW_PT = WS_RW_HT + (size_t)1024 * 4096 * 4;
constexpr size_t WS_LORA = WS_RW_PT + (size_t)1024 * 4096 * 2;
constexpr int LORA_PER_LAYER = 8192 + 8192 + 16384 + 2048;
constexpr size_t WS_WGU_Q = WS_LORA + (size_t)DEPTH * LORA_PER_LAYER * 4;
constexpr size_t WS_WDN_Q = WS_WGU_Q + (size_t)DEPTH * NE * 2048 * D;
constexpr size_t WS_X1Q = WS_WDN_Q + (size_t)DEPTH * NE * D * D;
constexpr size_t WS_ABUFQ = WS_X1Q + (size_t)T * D;
constexpr size_t WS_WPG_Q = WS_ABUFQ + (size_t)NE * ECAP * D;
constexpr size_t WS_HQ = WS_WPG_Q + (size_t)DEPTH * D * D;
constexpr size_t WS_WOUT_Q = WS_HQ + (size_t)T * D;
constexpr size_t WS_END = WS_WOUT_Q + (size_t)DEPTH * D * D;
#ifndef MOE_FP8
#define MOE_FP8 1
#endif
#ifndef MOE2_FP8
#define MOE2_FP8 1
#ifndef OUT_CHAIN
#define OUT_CHAIN 1
#endif
#ifndef MIX_CHAIN
#define MIX_CHAIN 1
#endif
#ifndef OUT_CHAIN_POLL
#define OUT_CHAIN_POLL 1
#endif
#ifndef MOE_CHAIN
#define MOE_CHAIN 1
#endif
#ifndef RW_SOLVE_BLK
#define RW_SOLVE_BLK 1
#endif
#ifndef RW_SCAN_DMA
#define RW_SCAN_DMA 1
#endif
#ifndef P6_MFMA
#define P6_MFMA 1
#endif
#ifndef OUT_FP8
#define OUT_FP8 1
#endif
#ifndef PLE_FP8
#define PLE_FP8 1
#endif
#endif
constexpr int CW_BAR = 4096;
constexpr int CW_DBG = 32768;
constexpr int CW_PAN = 65536;
constexpr int CW_PAN2 = 196608;
constexpr int CW_PAN5 = 208896;
constexpr int CW_CNT = 16384;

constexpr int RING_BYTES = 147456;
constexpr int MISC_OFF = RING_BYTES;
constexpr int LDS_BYTES = RING_BYTES + 1024;
constexpr int MW_BAR = 8, MW_LCNT = 32, MW_LBASE = 64, MW_PFX = 96, MW_CNT = 136, MW_GAMC = 168;

typedef __bf16 bf16x2_t __attribute__((ext_vector_type(2)));
__device__ __forceinline__ unsigned cvt_pk_bf16(float lo, float hi) { const f32x2 v = {lo, hi}; const bf16x2_t b = __builtin_convertvector(v, bf16x2_t); return __builtin_bit_cast(unsigned, b); }
__device__ __forceinline__ unsigned cvt4_fp8(float a, float b, float c, float d) { int w = 0; w = __builtin_amdgcn_cvt_pk_fp8_f32(a, b, w, false); w = __builtin_amdgcn_cvt_pk_fp8_f32(c, d, w, true); return (unsigned)w; }
__device__ __forceinline__ float bf2f(unsigned short b) { return __uint_as_float(((unsigned)b) << 16); }
__device__ __forceinline__ float sigmoidf_(float x) { return __builtin_amdgcn_rcpf(1.0f + __expf(-x)); }
__device__ __forceinline__ float siluf_(float x) { return x * __builtin_amdgcn_rcpf(1.0f + __expf(-x)); }
__device__ __forceinline__ float softplusf_(float x) { return fmaxf(x, 0.f) + __logf(1.0f + __expf(-fabsf(x))); }
__device__ __forceinline__ float logsigmoidf_(float x) { return fminf(x, 0.f) - __logf(1.0f + __expf(-fabsf(x))); }
__device__ __forceinline__ float tanhf_(float x) { const float e = __expf(-2.0f * fabsf(x)); const float t = (1.0f - e) * __builtin_amdgcn_rcpf(1.0f + e); return x < 0.f ? -t : t; }
__device__ __forceinline__ int lane_now() { int l = (int)__builtin_amdgcn_mbcnt_hi(~0u, __builtin_amdgcn_mbcnt_lo(~0u, 0u)); asm volatile("" : "+v"(l)); return l; }
__device__ __forceinline__ float my_shfl_idx(float v, int src) { return __builtin_bit_cast(float, __builtin_amdgcn_ds_bpermute(src << 2, __builtin_bit_cast(int, v))); }
__device__ __forceinline__ int my_shfl_idx(int v, int src) { return __builtin_amdgcn_ds_bpermute(src << 2, v); }
template <class V> __device__ __forceinline__ V my_shfl_xor(V v, int o) { return my_shfl_idx(v, lane_now() ^ o); }
template <class V> __device__ __forceinline__ V my_shfl_up(V v, int o) { const int l = lane_now(); return my_shfl_idx(v, l >= o ? l - o : l); }
#define __shfl_xor(v, o) my_shfl_xor(v, o)
#define __shfl_up(v, o) my_shfl_up(v, o)
#define __shfl(v, s) my_shfl_idx(v, s)
__device__ __forceinline__ float wave_sum(float v) {
#pragma unroll
    for (int o = 1; o < 64; o <<= 1) v += __shfl_xor(v, o);
    return v;
}
__device__ __forceinline__ float wave_max(float v) {
#pragma unroll
    for (int o = 1; o < 64; o <<= 1) v = fmaxf(v, __shfl_xor(v, o));
    return v;
}
__device__ __forceinline__ float wave_scan_add(float v, int lane) {
#pragma unroll
    for (int o = 1; o < 64; o <<= 1) { const float t = __shfl_up(v, o); if (lane >= o) v += t; }
    return v;
}
__device__ __forceinline__ float wave_scan_max(float v, int lane) {
#pragma unroll
    for (int o = 1; o < 64; o <<= 1) { const float t = __shfl_up(v, o); if (lane >= o) v = fmaxf(v, t); }
    return v;
}
__device__ __forceinline__ f32x4 mm16(const LAS unsigned char* A, int lda, const LAS unsigned char* B, int ldb, int K, f32x4 acc, int fr, int fq) {
    const LAS unsigned char* ap = A + fr * lda + fq * 16; const LAS unsigned char* bp = B + fr * ldb + fq * 16;
    for (int k = 0; k < K; k += 32) {
        const bf16x8 a = *(const LAS bf16x8*)(ap + k * 2); const bf16x8 b = *(const LAS bf16x8*)(bp + k * 2);
        acc = __builtin_amdgcn_mfma_f32_16x16x32_bf16(b, a, acc, 0, 0, 0);
    }
    return acc;
}
__device__ __forceinline__ f32x4 mm16_gB(const LAS unsigned char* A, int lda, const float* B, int ldb, int K, f32x4 acc, int fr, int fq) {
    const LAS unsigned char* ap = A + fr * lda + fq * 16; const float* bp = B + (size_t)fr * ldb + fq * 8;
    for (int k = 0; k < K; k += 32) {
        const bf16x8 a = *(const LAS bf16x8*)(ap + k * 2);
        const f32x4 b0 = *(const f32x4*)(bp + k), b1 = *(const f32x4*)(bp + k + 4);
        v4u bw; bw.x = cvt_pk_bf16(b0.x, b0.y); bw.y = cvt_pk_bf16(b0.z, b0.w); bw.z = cvt_pk_bf16(b1.x, b1.y); bw.w = cvt_pk_bf16(b1.z, b1.w);
        const bf16x8 b = __builtin_bit_cast(bf16x8, bw);
        acc = __builtin_amdgcn_mfma_f32_16x16x32_bf16(b, a, acc, 0, 0, 0);
    }
    return acc;
}
__device__ __forceinline__ f32x4 mm16_gAB(const bf16* A, int lda, const bf16* B, int ldb, int K, f32x4 acc, int fr, int fq) {
    const bf16* ap = A + (size_t)fr * lda + fq * 8; const bf16* bp = B + (size_t)fr * ldb + fq * 8;
    for (int k = 0; k < K; k += 32) { const bf16x8 a = *(const bf16x8*)(ap + k), b = *(const bf16x8*)(bp + k); acc = __builtin_amdgcn_mfma_f32_16x16x32_bf16(b, a, acc, 0, 0, 0); }
    return acc;
}
__device__ __forceinline__ bf16x8 ldfrag_f32(const float* p) { const f32x4 b0 = *(const f32x4*)p, b1 = *(const f32x4*)(p + 4);
    v4u bw; bw.x = cvt_pk_bf16(b0.x, b0.y); bw.y = cvt_pk_bf16(b0.z, b0.w); bw.z = cvt_pk_bf16(b1.x, b1.y); bw.w = cvt_pk_bf16(b1.z, b1.w); return __builtin_bit_cast(bf16x8, bw); }
template <int NK> __device__ __forceinline__ f32x4 mm16_rB(const LAS unsigned char* A, int lda, const bf16x8 (&b)[NK], f32x4 acc, int fr, int fq) {
    const LAS unsigned char* ap = A + fr * lda + fq * 16;
#pragma unroll
    for (int k = 0; k < NK; ++k) { const bf16x8 a = *(const LAS bf16x8*)(ap + k * 64); acc = __builtin_amdgcn_mfma_f32_16x16x32_bf16(b[k], a, acc, 0, 0, 0); }
    return acc;
}
__device__ __forceinline__ v4u pack8(const float (&v)[8]) { v4u o; o.x = cvt_pk_bf16(v[0], v[1]); o.y = cvt_pk_bf16(v[2], v[3]); o.z = cvt_pk_bf16(v[4], v[5]); o.w = cvt_pk_bf16(v[6], v[7]); return o; }

#define XB_TMO      128
#define XB_XCNT(j)  (256  + 64 * (j))
#define XB_XSUB(j)  (1280 + 64 * (j))
#define XB_XGEN(j)  (2304 + 64 * (j))
#define XB_TOP      3328
#define XB_TOPGEN   3392
#define XCD_BAR_WORDS 3456
#define XB_SPIN_CAP (1u << 18)
__device__ __forceinline__ unsigned xb_ld(unsigned* p)              { return __hip_atomic_load(p, __ATOMIC_RELAXED, __HIP_MEMORY_SCOPE_AGENT); }
__device__ __forceinline__ unsigned xb_add(unsigned* p, unsigned v) { return __hip_atomic_fetch_add(p, v, __ATOMIC_RELAXED, __HIP_MEMORY_SCOPE_AGENT); }
__device__ __forceinline__ unsigned xb_xcc_id() { return (unsigned)__builtin_amdgcn_s_getreg((3 << 11) | 20) & 0xFu; }
#define XB_SPIN(cond, bar) do { unsigned _sp = 0; while (cond) { __builtin_amdgcn_s_sleep(1); \
    if ((++_sp & 255u) == 0u) { if (xb_ld(&(bar)[XB_TMO])) break; if (_sp > XB_SPIN_CAP) { atomicAdd(&(bar)[XB_TMO], 1u); break; } } } } while (0)
struct XcdBarrier { unsigned* bar; unsigned x; volatile LAS unsigned* st; };
__device__ __forceinline__ XcdBarrier xcd_barrier_post(unsigned* bar, volatile LAS unsigned* st) {
    XcdBarrier b; b.bar = bar; b.x = xb_xcc_id(); b.st = st;
    if (threadIdx.x == 0) (void)xb_add(&bar[XB_XCNT(b.x)], 1u);
    return b;
}
__device__ __forceinline__ void xcd_barrier_complete(unsigned* bar, unsigned x, unsigned& nloc, unsigned& nx) {
    const unsigned G = gridDim.x * gridDim.y * gridDim.z;
    unsigned sum, cnt, mine, sp = 0u;
    for (;;) {
        sum = 0u; cnt = 0u; mine = 0u;
#pragma unroll
        for (unsigned j = 0; j < 16; ++j) { const unsigned c = xb_ld(&bar[XB_XCNT(j)]); sum += c; cnt += (c > 0u) ? 1u : 0u; mine = (j == x) ? c : mine; }
        if (sum == G) break;
        __builtin_amdgcn_s_sleep(1);
        if ((++sp & 255u) == 0u) { if (xb_ld(&bar[XB_TMO])) break; if (sp > XB_SPIN_CAP) { atomicAdd(&bar[XB_TMO], 1u); break; } }
    }
    nloc = mine > 0u ? mine : 1u; nx = cnt > 0u ? cnt : 1u;
}
__device__ __forceinline__ void xcd_barrier(const XcdBarrier& b) {
    asm volatile("s_waitcnt vmcnt(0)" ::: "memory");
    __syncthreads();
    if (threadIdx.x == 0) {
        unsigned* bar = b.bar;
        __builtin_amdgcn_s_waitcnt(0);
        unsigned nloc = b.st[0], nx = b.st[1];
        if (nloc == 0u) { xcd_barrier_complete(bar, b.x, nloc, nx); b.st[0] = nloc; b.st[1] = nx; }
        const unsigned k = b.st[2]; b.st[2] = k + 1u;
        const unsigned old = xb_add(&bar[XB_XSUB(b.x)], 1u);
        if (old + 1u == (k + 1u) * nloc) {
            __builtin_amdgcn_fence(__ATOMIC_RELEASE, "agent");
            asm volatile("s_waitcnt vmcnt(0)" ::: "memory");
            (void)xb_add(&bar[XB_TOP], 1u);
        }
        const unsigned target = (k + 1u) * nx;
        XB_SPIN(xb_ld(&bar[XB_TOP]) < target, bar);
        __builtin_amdgcn_fence(__ATOMIC_ACQUIRE, "agent");
        asm volatile("s_waitcnt vmcnt(0)" ::: "memory");
    }
    __syncthreads();
}

namespace pg8 {
constexpr int BM = 256, BK = 64, HALF = 128, HTB = HALF * BK * 2, STAGE_BYTES = 8 * HTB, NXCD = 8, WGM = 8;
__host__ __device__ __forceinline__ int lds_byte(int r, int c) { const int st = (r >> 4) * 2 + (c >> 5), rr = r & 15, cc = c & 31, ob = rr * 64 + cc * 2; return st * 1024 + (ob ^ (((ob >> 9) & 1) << 5)); }
__host__ __device__ __forceinline__ void stage_rc(int b, int& R, int& C) { const int st = b / 1024, sb = b % 1024, swz = sb ^ (((sb >> 9) & 1) << 5); R = (st >> 1) * 16 + swz / 64; C = (st & 1) * 32 + (swz % 64) / 2; }
__host__ __device__ __forceinline__ int perm32(int rho) { const int n = rho >> 4, i = rho & 15; return 8 * (i >> 2) + 4 * n + (i & 3); }

template <class Epi, class Sched>
__device__ __forceinline__ void gemm_phase(LAS unsigned char* lds, const int tid, const Sched& S, const Epi& E) {
    const int wid = __builtin_amdgcn_readfirstlane(tid >> 6), lane = tid & 63, wr = wid >> 2, wc = wid & 3, fr = lane & 15, fq = lane >> 4;
    const int K = S.K, nt = K / BK;
    unsigned voffB[2];
#pragma unroll
    for (int i = 0; i < 2; ++i) { int R, C; stage_rc(tid * 16 + i * 8192, R, C); const int Rb = Epi::PERM ? ((R & ~31) + perm32(R & 31)) : R; voffB[i] = (unsigned)(Rb * K + C) * 2u; }
    const size_t kstep = (size_t)(BK * 2);
    const size_t hstepB = S.hstepB;
    const unsigned ldsw = (unsigned)wid * 1024u;
    constexpr bool F8 = Sched::FP8;
    const int aoff = F8 ? lds_byte(wr * 64 + fr, fq * 16) : lds_byte(wr * 64 + fr, fq * 8), boff = F8 ? lds_byte(wc * 32 + fr, fq * 16) : lds_byte(wc * 32 + fr, fq * 8);
#define PG8_SA(b, h) (((b) * 2 + (h)) * HTB)
#define PG8_SB(b, h) ((4 + (b) * 2 + (h)) * HTB)
#define PG8_STAGE_B(bufoff, gbase) do { _Pragma("unroll") for (int _i = 0; _i < 2; ++_i) \
        __builtin_amdgcn_global_load_lds((const unsigned*)((const char*)(gbase) + voffB[_i]), (LAS unsigned*)(lds + (bufoff) + ldsw + _i * 8192), 16, 0, 0); } while (0)
#define PG8_STAGE_A(bufoff, gbase, v0, v1) do { \
        __builtin_amdgcn_global_load_lds((const unsigned*)((const char*)(gbase) + (v0)), (LAS unsigned*)(lds + (bufoff) + ldsw), 16, 0, 0); \
        __builtin_amdgcn_global_load_lds((const unsigned*)((const char*)(gbase) + (v1)), (LAS unsigned*)(lds + (bufoff) + ldsw + 8192), 16, 0, 0); } while (0)
#define PG8_FOFF(k) (F8 ? (k) * 16 : (k) * 1024)
#define PG8_LDA(dst, b, h) do { _Pragma("unroll") for (int m = 0; m < 4; ++m) { if constexpr (F8) dst##8[m] = *(const LAS v8i_t*)(lds + PG8_SA(b, h) + aoff + m * 2048); \
        else { _Pragma("unroll") for (int k = 0; k < 2; ++k) dst[m][k] = *(const LAS bf16x8*)(lds + PG8_SA(b, h) + aoff + m * 2048 + k * 1024); } } } while (0)
#define PG8_LDB(dst, b, h) do { _Pragma("unroll") for (int n = 0; n < 2; ++n) { if constexpr (F8) dst##8[n] = *(const LAS v8i_t*)(lds + PG8_SB(b, h) + boff + n * 2048); \
        else { _Pragma("unroll") for (int k = 0; k < 2; ++k) dst[n][k] = *(const LAS bf16x8*)(lds + PG8_SB(b, h) + boff + n * 2048 + k * 1024); } } } while (0)
#define PG8_CAT(x) __builtin_shufflevector(__builtin_bit_cast(v4i_t, x[0]), __builtin_bit_cast(v4i_t, x[1]), 0, 1, 2, 3, 4, 5, 6, 7)
#define PG8_MMA(ai, bj, At, Bt) do { __builtin_amdgcn_s_setprio(1); _Pragma("unroll") for (int m = 0; m < 4; ++m) _Pragma("unroll") for (int n = 0; n < 2; ++n) { \
        if constexpr (F8) acc[ai][bj][m][n] = __builtin_amdgcn_mfma_scale_f32_16x16x128_f8f6f4(Bt##8[n], At##8[m], acc[ai][bj][m][n], 0, 0, 0, S.scaleB, 0, S.scaleA); \
        else { _Pragma("unroll") for (int k = 0; k < 2; ++k) acc[ai][bj][m][n] = __builtin_amdgcn_mfma_f32_16x16x32_bf16(Bt[n][k], At[m][k], acc[ai][bj][m][n], 0, 0, 0); } } __builtin_amdgcn_s_setprio(0); } while (0)
#define PG8_WAIT_V(n) asm volatile("s_waitcnt vmcnt(" #n ")" ::: "memory")
#define PG8_WAIT_L(n) asm volatile("s_waitcnt lgkmcnt(" #n ")" ::: "memory")
#define PG8_BAR __builtin_amdgcn_s_barrier()
#define PG8_SCHED __builtin_amdgcn_sched_barrier(0)
    typename Sched::Unit cur, nxt, prv; int ui = 0;
    if (!S.next(0, cur)) return;
    prv = cur; unsigned pre = 0u;
    f32x4 acc[2][2][4][2];
#pragma unroll
    for (int a = 0; a < 2; ++a)
#pragma unroll
        for (int b = 0; b < 2; ++b)
#pragma unroll
            for (int m = 0; m < 4; ++m)
#pragma unroll
                for (int n = 0; n < 2; ++n) acc[a][b][m][n] = (f32x4){0.f, 0.f, 0.f, 0.f};
    bf16x8 At[4][2], B0[2][2], B1[2][2]; v8i_t At8[4], B08[2], B18[2];
    constexpr bool GA = Sched::GATHER;
    const size_t hstepA = GA ? (size_t)0 : (size_t)HALF * K * 2;
    unsigned vA[2][2];
    LAS unsigned char* hdr = lds + STAGE_BYTES;
    if constexpr (Sched::HDR) { if (wid == 0) S.hdr_issue(cur, hdr, lane); PG8_WAIT_V(0); PG8_BAR; }
    S.a_off(cur, tid, vA, hdr);
#define PG8_STAGE_AH(bufoff, base, vv, h) PG8_STAGE_A(bufoff, ((base) + (h) * hstepA), vv[GA ? (h) : 0][0], vv[GA ? (h) : 0][1])
    const char* cA = S.a_base(cur); const char* cB = S.b_base(cur);
    if constexpr (Sched::COUNTED) { if (wid == 0) pre = S.peek(cur); S.a_ready(cur, wid, pre); }
    PG8_STAGE_B(PG8_SB(0, 0), cB); PG8_STAGE_B(PG8_SB(0, 1), cB + hstepB); PG8_STAGE_AH(PG8_SA(0, 0), cA, vA, 0); PG8_STAGE_AH(PG8_SA(0, 1), cA, vA, 1);
    if (wr == 1) PG8_BAR;
    PG8_WAIT_V(2); PG8_BAR;
    PG8_STAGE_B(PG8_SB(1, 0), cB + kstep); PG8_STAGE_AH(PG8_SA(1, 0), cA + kstep, vA, 0); PG8_STAGE_B(PG8_SB(1, 1), cB + hstepB + kstep);
    PG8_WAIT_V(6); PG8_BAR;
    int hc = 0;
    for (;;) {
        const bool has_next = S.next(ui + 1, nxt); const int hn = (hc == 2) ? 0 : hc + 1;
        const char* nA = cA; const char* nB = cB;
        if (has_next) { nA = S.a_base(nxt); nB = S.b_base(nxt); if constexpr (Sched::HDR) { if (wid == 0) S.hdr_issue(nxt, hdr + hn * 4096, lane); } if constexpr (Sched::COUNTED) { if (wid == 0) pre = S.peek(nxt); } }
        for (int t = 0; t < nt; t += 2) {
            const bool last = (t == nt - 2);
            const char* a1 = cA + (size_t)(t + 1) * kstep;
            const char* a2 = last ? nA : cA + (size_t)(t + 2) * kstep; const char* b2 = last ? nB : cB + (size_t)(t + 2) * kstep;
            const char* a3 = a2 + kstep; const char* b3 = b2 + kstep;
            PG8_LDB(B0, 0, 0); PG8_LDB(B1, 0, 1); PG8_SCHED; PG8_LDA(At, 0, 0); PG8_STAGE_AH(PG8_SA(1, 1), a1, vA, 1);
            if constexpr (Sched::COUNTED) { if (last && has_next) S.a_ready(nxt, wid, pre); }
            if constexpr (GA) { if (last && has_next) S.a_off(nxt, tid, vA, hdr + hn * 4096); }
            PG8_WAIT_V(8); PG8_WAIT_L(0); PG8_BAR; PG8_MMA(0, 0, At, B0); PG8_MMA(0, 1, At, B1); PG8_BAR; PG8_SCHED;
            PG8_LDA(At, 0, 1); PG8_STAGE_B(PG8_SB(0, 0), b2); PG8_STAGE_B(PG8_SB(0, 1), b2 + hstepB); PG8_STAGE_AH(PG8_SA(0, 0), a2, vA, 0);
            PG8_WAIT_V(8); PG8_WAIT_L(0); PG8_BAR; PG8_MMA(1, 0, At, B0); PG8_MMA(1, 1, At, B1); PG8_BAR; PG8_SCHED;
            PG8_LDB(B0, 1, 0); PG8_LDB(B1, 1, 1); PG8_SCHED; PG8_LDA(At, 1, 0); PG8_STAGE_AH(PG8_SA(0, 1), a2, vA, 1);
            PG8_WAIT_V(8); PG8_WAIT_L(0); PG8_BAR; PG8_MMA(0, 0, At, B0); PG8_MMA(0, 1, At, B1); PG8_BAR; PG8_SCHED;
            PG8_LDA(At, 1, 1); PG8_STAGE_B(PG8_SB(1, 0), b3); PG8_STAGE_B(PG8_SB(1, 1), b3 + hstepB); PG8_STAGE_AH(PG8_SA(1, 0), a3, vA, 0);
            PG8_WAIT_V(8); PG8_WAIT_L(0); PG8_BAR; PG8_MMA(1, 0, At, B0); PG8_MMA(1, 1, At, B1); PG8_BAR; PG8_SCHED;
        }
        if (wr == 0) PG8_BAR;
        if constexpr (Sched::PUBLISH) { if (ui > 0) S.publish(prv, lane); }
        { int fr_ = fr, fq_ = fq; asm volatile("" : "+v"(fr_), "+v"(fq_)); E(acc, cur, wr, wc, fr_, fq_, hdr + hc * 4096); }
        if (!has_next) break;
#pragma unroll
        for (int a = 0; a < 2; ++a)
#pragma unroll
            for (int b = 0; b < 2; ++b)
#pragma unroll
                for (int m = 0; m < 4; ++m)
#pragma unroll
                    for (int n = 0; n < 2; ++n) acc[a][b][m][n] = (f32x4){0.f, 0.f, 0.f, 0.f};
        prv = cur; cur = nxt; cA = nA; cB = nB; ++ui; hc = hn;
        if (wr == 1) PG8_BAR;
    }
    PG8_WAIT_V(0);
    if constexpr (Sched::PUBLISH) S.publish(cur, lane);
    PG8_BAR;
#undef PG8_SA
#undef PG8_SB
#undef PG8_STAGE_A
#undef PG8_STAGE_AH
#undef PG8_STAGE_B
#undef PG8_LDA
#undef PG8_LDB
#undef PG8_MMA
#undef PG8_CAT
#undef PG8_FOFF
#undef PG8_WAIT_V
#undef PG8_WAIT_L
#undef PG8_BAR
#undef PG8_SCHED
}
}
struct Args { const float* in[N_IN]; float* out; unsigned char* ws; int ph_lo, ph_hi; };
typedef const __attribute__((address_space(4))) unsigned long long* karg_t;
struct Frame {
    karg_t ka;
    LAS unsigned char* lds;
    volatile LAS unsigned* MISC;
    gu32* ctl;
    unsigned char* ws;
    float* out;
    int tid, lane, wave, vcu, G;
};
#define WSP(T_, off) ((T_*)(F.ws + (off)))
#define KIN(k) ((const float*)F.ka[(k)])
#ifdef DBG_SEL
#define DBG_STAT(k, val) do { const float _v = (val); if ((k) == DBG_SEL) { if (fabsf(_v) < 3e38f) atomicMax((unsigned*)(F.ctl + CW_DBG), __float_as_uint(fabsf(_v))); else atomicAdd((unsigned*)(F.ctl + CW_DBG + 1), 1u); } } while (0)
#else
#define DBG_STAT(k, val) do { } while (0)
#endif
template <class P> __device__ __forceinline__ P launder_uniform(P p) {
    unsigned lo = (unsigned)(unsigned long long)p, hi = (unsigned)((unsigned long long)p >> 32);
    asm volatile("" : "+v"(lo), "+v"(hi));
    lo = __builtin_amdgcn_readfirstlane(lo); hi = __builtin_amdgcn_readfirstlane(hi);
    return (P)(((unsigned long long)hi << 32) | lo);
}
__device__ __forceinline__ void frame_refresh(Frame& F) {
    int t = F.tid; asm volatile("" : "+v"(t)); F.tid = t; F.lane = t & 63; F.wave = __builtin_amdgcn_readfirstlane(t >> 6);
    F.ws = launder_uniform(F.ws); F.ctl = (gu32*)(F.ws + WS_CTL);
    F.out = launder_uniform(F.out);
    F.ka = launder_uniform(F.ka);
}

namespace pg8 {
struct DenseSched {
    static constexpr bool GATHER = false, FP8 = false, HDR = false, COUNTED = false, PUBLISH = false; static constexpr int scaleA = 0, scaleB = 0;
    struct Unit { int pm, pn; };
    __device__ __forceinline__ void hdr_issue(const Unit&, LAS unsigned char*, int) const {}
    const bf16* A; const bf16* Bt; int K; size_t hstepB; int nM, nN, nwg, G, c;
    __device__ __forceinline__ void init(const bf16* A_, const bf16* Bt_, int M, int N, int K_, int G_, int c_) { A = A_; Bt = Bt_; K = K_; hstepB = (size_t)HALF * K_ * 2; nM = M / BM; nN = N / BM; nwg = nM * nN; G = G_; c = c_; }
    __device__ __forceinline__ bool next(int i, Unit& u) const {
        const long L = (long)i * G + c; if (L >= nwg) return false;
        int wgid = (int)L; { const int q = nwg / NXCD, r = nwg % NXCD, xcd = wgid % NXCD, off = wgid / NXCD; wgid = (xcd < r ? xcd * (q + 1) : r * (q + 1) + (xcd - r) * q) + off; }
        const int nig = WGM * nN, gid = wgid / nig, fm = gid * WGM, gsz = (nM - fm) < WGM ? (nM - fm) : WGM;
        u.pm = fm + ((wgid % nig) % gsz); u.pn = (wgid % nig) / gsz; return true;
    }
    __device__ __forceinline__ const char* a_base(const Unit& u) const { return (const char*)A + (size_t)u.pm * BM * K * 2; }
    __device__ __forceinline__ const char* b_base(const Unit& u) const { return (const char*)Bt + (size_t)u.pn * BM * K * 2; }
    __device__ __forceinline__ void a_off(const Unit&, int tid, unsigned (&v)[2][2], const LAS unsigned char*) const {
#pragma unroll
        for (int i = 0; i < 2; ++i) { int R, C; stage_rc(tid * 16 + i * 8192, R, C); v[0][i] = (unsigned)(R * K + C) * 2u; v[1][i] = v[0][i]; }
    }
};
template <int SB> struct DenseSched8T : DenseSched { static constexpr bool GATHER = true, FP8 = true; static constexpr int scaleA = 0x7F7F7F7F, scaleB = SB;
    __device__ __forceinline__ void a_off(const Unit&, int tid, unsigned (&v)[2][2], const LAS unsigned char*) const {
        int t_ = tid; asm volatile("" : "+v"(t_));
#pragma unroll
        for (int i = 0; i < 2; ++i) { int R, C; stage_rc(t_ * 16 + i * 8192, R, C); v[0][i] = (unsigned)(R * K + C) * 2u; v[1][i] = v[0][i] + (unsigned)(HALF * K * 2); }
    }
};
typedef DenseSched8T<0x7A7A7A7A> DenseSched8;
typedef DenseSched8T<0x79797979> DenseSched8b;
struct OutSched : DenseSched8b { static constexpr bool PUBLISH = true, COUNTED = (MIX_CHAIN != 0); gu32* pan; const gu32* cpan; gu32* tmo;
    __device__ __forceinline__ void publish(const Unit& u, int lane) const { if (lane == 0) (void)__hip_atomic_fetch_add(pan + u.pm * 16, 1u, RLX_AGENT); }
    __device__ __forceinline__ unsigned peek(const Unit&) const { return 0u; }
    __device__ __forceinline__ void a_ready(const Unit& u, int wid, unsigned pre) const {
        if (wid == 0 && cpan) { (void)pre; unsigned sp = 0u;
            while ((unsigned)__builtin_amdgcn_readfirstlane(__hip_atomic_load(cpan + u.pm * 16, RLX_AGENT)) < 32u) { __builtin_amdgcn_s_sleep(2);
                if ((++sp & 255u) == 0u) { if (__hip_atomic_load(tmo, RLX_AGENT)) break; if (sp > (1u << 18)) { atomicAdd((unsigned*)tmo, 1u); break; } } }
            __builtin_amdgcn_fence(__ATOMIC_ACQUIRE, "agent"); asm volatile("s_waitcnt vmcnt(0)" ::: "memory"); }
        asm volatile("" ::: "memory"); __builtin_amdgcn_s_barrier(); asm volatile("" ::: "memory");
    } };
struct MoeUnit { int e, mt, nt, cnt; };
struct MoeOrder {
    const volatile LAS unsigned* pfx;
    int NT, G, c;
    __device__ __forceinline__ bool decode(int i, MoeUnit& u) const {
        const int nwg = (int)pfx[32]; const long L = (long)i * G + c; if (L >= nwg) return false;
        int wgid = (int)L; { const int q = nwg / NXCD, r = nwg % NXCD, xcd = wgid % NXCD, off = wgid / NXCD; wgid = (xcd < r ? xcd * (q + 1) : r * (q + 1) + (xcd - r) * q) + off; }
        int e = 0;
#pragma unroll
        for (int st = 16; st >= 1; st >>= 1) e += ((int)pfx[e + st] <= wgid) ? st : 0;
        const int j = wgid - (int)pfx[e];
        u.e = e; u.mt = j / NT; u.nt = j % NT; u.cnt = (int)pfx[40 + e]; return true;
    }
};
#ifndef HDR_AOFF
#define HDR_AOFF 1
#endif
struct Moe1Sched {
    static constexpr bool GATHER = true, FP8 = (MOE_FP8 != 0), HDR = true, COUNTED = false, PUBLISH = (MOE_CHAIN != 0); static constexpr int EB = FP8 ? 1 : 2; static constexpr int scaleA = 0x7F7F7F7F, scaleB = 0x7A7A7A7A;
    typedef MoeUnit Unit;
    MoeOrder O; const unsigned char* X; const unsigned char* W; const int* sdest; const float* bgu; int K; size_t hstepB; gu32* pan;
    __device__ __forceinline__ void publish(const Unit& u, int lane) const { if (lane == 0) (void)__hip_atomic_fetch_add(pan + (u.e * 64 + u.mt) * 16, 1u, RLX_AGENT); }
    __device__ __forceinline__ void hdr_issue(const Unit& u, LAS unsigned char* hdr, int lane) const {
        __builtin_amdgcn_global_load_lds((const unsigned*)(sdest + (size_t)u.e * ECAP + (size_t)u.mt * 256 + lane * 4), (LAS unsigned*)hdr, 16, 0, 0);
        const float* bp = bgu + (size_t)u.e * 2048 + u.nt * 128 + (lane < 32 ? lane * 4 : 1024 + (lane - 32) * 4);
        __builtin_amdgcn_global_load_lds((const unsigned*)bp, (LAS unsigned*)(hdr + 1024), 16, 0, 0);
    }
    __device__ __forceinline__ bool next(int i, Unit& u) const { return O.decode(i, u); }
    __device__ __forceinline__ const char* a_base(const Unit&) const { return (const char*)X; }
    __device__ __forceinline__ const char* b_base(const Unit& u) const { return (const char*)W + ((size_t)u.e * 2048 + (size_t)u.nt * 128) * 1024 * EB; }
    __device__ __forceinline__ void a_off(const Unit& u, int tid, unsigned (&v)[2][2], const LAS unsigned char* hdr) const {
#pragma unroll
        for (int i = 0; i < 2; ++i) { int R, C; stage_rc(tid * 16 + i * 8192, R, C);
#pragma unroll
            for (int h = 0; h < 2; ++h) { const int sl = h * HALF + R; int tok = 0; if (u.mt * 256 + sl < u.cnt) tok = HDR_AOFF ? (((const LAS int*)hdr)[sl] >> 2) : (sdest[u.e * ECAP + u.mt * 256 + sl] >> 2); v[h][i] = (unsigned)(tok * 1024 * EB + C * 2); } }
    }
};
struct Moe2Sched {
    static constexpr bool GATHER = true, FP8 = (MOE2_FP8 != 0), HDR = true, COUNTED = (MOE_CHAIN != 0), PUBLISH = false; static constexpr int EB = FP8 ? 1 : 2; static constexpr int scaleA = 0x7F7F7F7F, scaleB = 0x79797979;
    typedef MoeUnit Unit;
    MoeOrder O; const unsigned char* Ab; const unsigned char* W; const int* sdest; const float* sgate; const float* bdn; int K; size_t hstepB; gu32* pan; gu32* tmo;
    __device__ __forceinline__ unsigned peek(const Unit& u) const { return __hip_atomic_load(pan + (u.e * 64 + u.mt) * 16, RLX_AGENT); }
    __device__ __forceinline__ void a_ready(const Unit& u, int wid, unsigned pre) const {
        if (wid == 0) {
            if ((unsigned)__builtin_amdgcn_readfirstlane(pre) < 64u) { unsigned sp = 0u;
                while ((unsigned)__builtin_amdgcn_readfirstlane(__hip_atomic_load(pan + (u.e * 64 + u.mt) * 16, RLX_AGENT)) < 64u) { __builtin_amdgcn_s_sleep(2);
                    if ((++sp & 255u) == 0u) { if (__hip_atomic_load(tmo, RLX_AGENT)) break; if (sp > (1u << 18)) { atomicAdd((unsigned*)tmo, 1u); break; } } } }
            __builtin_amdgcn_fence(__ATOMIC_ACQUIRE, "agent"); asm volatile("s_waitcnt vmcnt(0)" ::: "memory");
        }
        asm volatile("" ::: "memory"); __builtin_amdgcn_s_barrier(); asm volatile("" ::: "memory");
    }
    __device__ __forceinline__ void hdr_issue(const Unit& u, LAS unsigned char* hdr, int lane) const {
        const size_t so = (size_t)u.e * ECAP + (size_t)u.mt * 256 + lane * 4;
        __builtin_amdgcn_global_load_lds((const unsigned*)(sdest + so), (LAS unsigned*)hdr, 16, 0, 0);
        __builtin_amdgcn_global_load_lds((const unsigned*)(sgate + so), (LAS unsigned*)(hdr + 1024), 16, 0, 0);
        __builtin_amdgcn_global_load_lds((const unsigned*)(bdn + (size_t)u.e * 1024 + u.nt * 256 + lane * 4), (LAS unsigned*)(hdr + 2048), 16, 0, 0);
    }
    __device__ __forceinline__ bool next(int i, Unit& u) const { return O.decode(i, u); }
    __device__ __forceinline__ const char* a_base(const Unit& u) const { return (const char*)Ab + ((size_t)u.e * ECAP + (size_t)u.mt * 256) * 1024 * EB; }
    __device__ __forceinline__ const char* b_base(const Unit& u) const { return (const char*)W + ((size_t)u.e * 1024 + (size_t)u.nt * 256) * 1024 * EB; }
    __device__ __forceinline__ void a_off(const Unit&, int tid, unsigned (&v)[2][2], const LAS unsigned char*) const {
        int t_ = tid; asm volatile("" : "+v"(t_));
#pragma unroll
        for (int i = 0; i < 2; ++i) { int R, C; stage_rc(t_ * 16 + i * 8192, R, C); v[0][i] = (unsigned)(R * 1024 * EB + C * 2); v[1][i] = v[0][i] + (unsigned)(HALF * 1024 * EB); }
    }
};

__device__ __forceinline__ void unpack8(const v4u w, f32x4& a, f32x4& b) {
    a = (f32x4){__uint_as_float(w.x << 16), __uint_as_float(w.x & 0xffff0000u), __uint_as_float(w.y << 16), __uint_as_float(w.y & 0xffff0000u)};
    b = (f32x4){__uint_as_float(w.z << 16), __uint_as_float(w.z & 0xffff0000u), __uint_as_float(w.w << 16), __uint_as_float(w.w & 0xffff0000u)}; }
struct EpiF32 {
    static constexpr bool PERM = false;
    float* C; int ldc; const float* base; float alpha;
    __device__ __forceinline__ void operator()(const f32x4 (&acc)[2][2][4][2], const DenseSched::Unit& u, int wr, int wc, int fr, int fq, const LAS unsigned char* hdr) const {
        const int row0 = u.pm * BM + wr * 64 + fr, col0 = u.pn * BM + wc * 32 + 4 * fq;
#pragma unroll
        for (int ai = 0; ai < 2; ++ai)
#pragma unroll
            for (int m = 0; m < 4; ++m) { const size_t ro = (size_t)(row0 + ai * HALF + m * 16) * ldc + col0;
#pragma unroll
                for (int bj = 0; bj < 2; ++bj)
#pragma unroll
                    for (int n = 0; n < 2; ++n) { f32x4 v = acc[ai][bj][m][n];
                        if (base) { const f32x4 b = *(const f32x4*)(base + ro + bj * HALF + n * 16); v = v + b * alpha; }
                        *(f32x4*)(C + ro + bj * HALF + n * 16) = v; } }
    }
};
template <bool WT> struct EpiB16T {
    static constexpr bool PERM = true;
    bf16* O; int ldc; const bf16* base; float alpha;
    __device__ __forceinline__ void operator()(const f32x4 (&acc)[2][2][4][2], const DenseSched::Unit& u, int wr, int wc, int fr, int fq, const LAS unsigned char* hdr) const {
        const int row0 = u.pm * BM + wr * 64 + fr, col0 = u.pn * BM + wc * 32 + 8 * fq;
#pragma unroll
        for (int ai = 0; ai < 2; ++ai) {
            v4u bw[4][2];
            if (base) {
#pragma unroll
                for (int m = 0; m < 4; ++m)
#pragma unroll
                    for (int bj = 0; bj < 2; ++bj) bw[m][bj] = *(const v4u*)(base + (size_t)(row0 + ai * HALF + m * 16) * ldc + col0 + bj * HALF); }
#pragma unroll
            for (int m = 0; m < 4; ++m) { bf16* rowp = O + (size_t)(row0 + ai * HALF + m * 16) * ldc + col0;
#pragma unroll
                for (int bj = 0; bj < 2; ++bj) { f32x4 v0 = acc[ai][bj][m][0], v1 = acc[ai][bj][m][1];
                    if (base) { f32x4 b0, b1; unpack8(bw[m][bj], b0, b1); v0 = v0 + b0 * alpha; v1 = v1 + b1 * alpha; }
                    v4u w; w.x = cvt_pk_bf16(v0[0], v0[1]); w.y = cvt_pk_bf16(v0[2], v0[3]); w.z = cvt_pk_bf16(v1[0], v1[1]); w.w = cvt_pk_bf16(v1[2], v1[3]);
                    if constexpr (WT) { bf16* sp_ = rowp + bj * HALF; asm volatile("global_store_dwordx4 %0, %1, off sc1\n\ts_nop 1" :: "v"(sp_), "v"(w) : "memory"); }
                    else *(v4u*)(rowp + bj * HALF) = w; } } }
    }
};
typedef EpiB16T<false> EpiB16; typedef EpiB16T<true> EpiB16W;
struct EpiPle {
    static constexpr bool PERM = true;
    bf16* C; const bf16* hb; const bf16* pe;
    __device__ __forceinline__ void operator()(const f32x4 (&acc)[2][2][4][2], const DenseSched::Unit& u, int wr, int wc, int fr, int fq, const LAS unsigned char* hdr) const {
        const int row0 = u.pm * BM + wr * 64 + fr, col0 = u.pn * BM + wc * 32 + 8 * fq;
#pragma unroll
        for (int ai = 0; ai < 2; ++ai) {
            v4u hw[4][2], pw[4][2];
#pragma unroll
            for (int m = 0; m < 4; ++m)
#pragma unroll
                for (int bj = 0; bj < 2; ++bj) { const size_t ro = (size_t)(row0 + ai * HALF + m * 16) * 1024 + col0 + bj * HALF; hw[m][bj] = *(const v4u*)(hb + ro); pw[m][bj] = *(const v4u*)(pe + ro); }
#pragma unroll
            for (int m = 0; m < 4; ++m)
#pragma unroll
                for (int bj = 0; bj < 2; ++bj) { const size_t ro = (size_t)(row0 + ai * HALF + m * 16) * 1024 + col0 + bj * HALF;
                    f32x4 h0, h1, p0, p1; unpack8(hw[m][bj], h0, h1); unpack8(pw[m][bj], p0, p1); const f32x4 a0 = acc[ai][bj][m][0], a1 = acc[ai][bj][m][1];
                    f32x4 o0, o1;
#pragma unroll
                    for (int j = 0; j < 4; ++j) { o0[j] = h0[j] + sigmoidf_(a0[j]) * p0[j]; o1[j] = h1[j] + sigmoidf_(a1[j]) * p1[j]; }
                    v4u w; w.x = cvt_pk_bf16(o0[0], o0[1]); w.y = cvt_pk_bf16(o0[2], o0[3]); w.z = cvt_pk_bf16(o1[0], o1[1]); w.w = cvt_pk_bf16(o1[2], o1[3]);
                    *(v4u*)(C + ro) = w; } }
    }
};
struct EpiMoe1 {
    static constexpr bool PERM = true;
    bf16* Ab; const float* bgu; unsigned char* AbQ;
    __device__ __forceinline__ void operator()(const f32x4 (&acc)[2][2][4][2], const MoeUnit& u, int wr, int wc, int fr, int fq, const LAS unsigned char* hdr) const {
        const int col0 = u.nt * 128 + wc * 32 + 8 * fq;
        const LAS float* bh = (const LAS float*)(hdr + 1024) + wc * 32 + 8 * fq;
        const f32x4 bg0 = *(const LAS f32x4*)(bh), bg1 = *(const LAS f32x4*)(bh + 4), bl0 = *(const LAS f32x4*)(bh + 128), bl1 = *(const LAS f32x4*)(bh + 132);
#pragma unroll
        for (int ai = 0; ai < 2; ++ai)
#pragma unroll
            for (int m = 0; m < 4; ++m) { const int r = ai * HALF + wr * 64 + m * 16 + fr;
                bf16* rowp = Ab + ((size_t)u.e * ECAP + (size_t)u.mt * 256 + r) * 1024 + col0;
                float o[8];
#pragma unroll
                for (int n = 0; n < 2; ++n) { const f32x4 g4 = acc[ai][0][m][n] + (n ? bg1 : bg0), l4 = acc[ai][1][m][n] + (n ? bl1 : bl0);
#pragma unroll
                    for (int j = 0; j < 4; ++j) { const float g = fminf(g4[j], 7.0f), l = fminf(fmaxf(l4[j], -7.0f), 7.0f); o[n * 4 + j] = (l + 1.0f) * g * sigmoidf_(1.702f * g); } }
                if constexpr (MOE2_FP8) { v2u q; q.x = cvt4_fp8(o[0], o[1], o[2], o[3]); q.y = cvt4_fp8(o[4], o[5], o[6], o[7]); unsigned char* qp = (unsigned char*)AbQ + ((size_t)u.e * ECAP + (size_t)u.mt * 256 + r) * 1024 + col0;
                    if (MOE_CHAIN) asm volatile("global_store_dwordx2 %0, %1, off sc1" :: "v"(qp), "v"(q) : "memory");
                    else *(v2u*)qp = q; }
                else *(v4u*)rowp = pack8(o); }
    }
};
struct EpiMoe2 {
    static constexpr bool PERM = true;
    bf16* Y; const float* bdn; const int* sdest; const float* sgate;
    __device__ __forceinline__ void operator()(const f32x4 (&acc)[2][2][4][2], const MoeUnit& u, int wr, int wc, int fr, int fq, const LAS unsigned char* hdr) const {
        const int col0 = u.nt * 256 + wc * 32 + 8 * fq;
        const LAS float* bp = (const LAS float*)(hdr + 2048) + wc * 32 + 8 * fq;
#pragma unroll
        for (int ai = 0; ai < 2; ++ai) {
            f32x4 bv[2][2];
#pragma unroll
            for (int bj = 0; bj < 2; ++bj)
#pragma unroll
                for (int n = 0; n < 2; ++n) bv[bj][n] = *(const LAS f32x4*)(bp + bj * HALF + 4 * n);
            int dest[4]; float gate[4];
#pragma unroll
            for (int m = 0; m < 4; ++m) { const int sl = ai * HALF + wr * 64 + m * 16 + fr; const bool ok = u.mt * 256 + sl < u.cnt;
                dest[m] = ok ? ((const LAS int*)hdr)[sl] : T * 4; gate[m] = ok ? ((const LAS float*)(hdr + 1024))[sl] : 0.f; }
#pragma unroll
            for (int m = 0; m < 4; ++m) {
                { const float g = gate[m]; bf16* rowp = Y + (size_t)dest[m] * 1024 + col0;
#pragma unroll
                    for (int bj = 0; bj < 2; ++bj) { const f32x4 v0 = (acc[ai][bj][m][0] + bv[bj][0]) * g, v1 = (acc[ai][bj][m][1] + bv[bj][1]) * g;
                        v4u w; w.x = cvt_pk_bf16(v0[0], v0[1]); w.y = cvt_pk_bf16(v0[2], v0[3]); w.z = cvt_pk_bf16(v1[0], v1[1]); w.w = cvt_pk_bf16(v1[2], v1[3]);
                        *(v4u*)(rowp + bj * HALF) = w; } } } }
    }
};
}

__device__ __forceinline__ void p0_transpose_item(const float* W, int K, int N, int nblk, bf16* WT, int item, int lane) {
    const int kb = item / nblk, nb = item % nblk, k0 = 64 * kb, n = 64 * nb + lane;
    const bool ok = n < N; const float* src = W + (size_t)k0 * N + (ok ? n : 0);
    float x[64];
#pragma unroll
    for (int j = 0; j < 64; ++j) x[j] = __builtin_nontemporal_load(src + (size_t)j * N);
    bf16* dst = WT + (size_t)n * K + k0;
#pragma unroll
    for (int q = 0; q < 8; ++q) { v4u o; o.x = cvt_pk_bf16(x[8 * q], x[8 * q + 1]); o.y = cvt_pk_bf16(x[8 * q + 2], x[8 * q + 3]); o.z = cvt_pk_bf16(x[8 * q + 4], x[8 * q + 5]); o.w = cvt_pk_bf16(x[8 * q + 6], x[8 * q + 7]);
        if (!ok) o = (v4u){0u, 0u, 0u, 0u};
        *(v4u*)(dst + 8 * q) = o; }
}
__device__ __forceinline__ void cvt_rows(const float* src, bf16* dst, size_t n8, size_t i0, size_t stride) {
    for (size_t i = i0; i < n8; i += stride) { const f32x4 a = *(const f32x4*)(src + i * 8), b = *(const f32x4*)(src + i * 8 + 4);
        v4u o; o.x = cvt_pk_bf16(a.x, a.y); o.y = cvt_pk_bf16(a.z, a.w); o.z = cvt_pk_bf16(b.x, b.y); o.w = cvt_pk_bf16(b.z, b.w); *(v4u*)(dst + i * 8) = o; }
}
__device__ __forceinline__ void p0_prologue(Frame& F, const Args& A) {
    const int gw = F.vcu * NWAVES + F.wave, NGW = F.G * NWAVES;
    constexpr int I_IN = 16 * (NUP / 64), I_OUT = 16 * 16, I_GU = 16 * 32, I_DN = 16 * 16, I_PG = 16 * 16, I_PP = 4 * 16;
    constexpr int PER_LAYER = I_IN + I_OUT + NE * I_GU + NE * I_DN + I_PG + I_PP;
#pragma unroll 1
    for (int it = gw; it < DEPTH * PER_LAYER; it += NGW) {
        const int l = it / PER_LAYER; int r = it % PER_LAYER;
        const float* W; bf16* WT; int K = D, N = D, nblk = 16;
        if (r < I_IN) { W = KIN(I_WIN) + (size_t)l * D * NU; WT = WSP(bf16, WS_WIN_T) + (size_t)l * NUP * D; N = NU; nblk = NUP / 64; }
        else if ((r -= I_IN) < I_OUT) { if (OUT_FP8) continue; W = KIN(I_WOUT) + (size_t)l * D * D; WT = WSP(bf16, WS_WOUT_T) + (size_t)l * D * D; }
        else if ((r -= I_OUT) < NE * I_GU) { if (MOE_FP8) continue; const int e = r / I_GU; r %= I_GU; W = KIN(I_WGU) + ((size_t)l * NE + e) * D * 2048; WT = WSP(bf16, WS_WGU_T) + ((size_t)l * NE + e) * 2048 * D; N = 2048; nblk = 32; }
        else if ((r -= NE * I_GU) < NE * I_DN) { if (MOE2_FP8) continue; const int e = r / I_DN; r %= I_DN; W = KIN(I_WDN) + ((size_t)l * NE + e) * D * D; WT = WSP(bf16, WS_WDN_T) + ((size_t)l * NE + e) * D * D; }
        else if ((r -= NE * I_DN) < I_PG) { if (PLE_FP8) continue; W = KIN(I_PGW) + (size_t)l * D * D; WT = WSP(bf16, WS_WPG_T) + (size_t)l * D * D; }
        else { r -= I_PG; W = KIN(I_PPJ) + (size_t)l * 256 * D; WT = WSP(bf16, WS_WPP_T) + (size_t)l * D * 256; K = 256; }
        p0_transpose_item(W, K, N, nblk, WT, r, F.lane);
    }
#if MOE_FP8
    constexpr int Q_GU = 16 * 32, Q_DN = 16 * 16, Q_PG = PLE_FP8 ? 16 * 16 : 0, Q_OUT = OUT_FP8 ? 16 * 16 : 0, Q_PER_LAYER = NE * (Q_GU + Q_DN) + Q_PG + Q_OUT;
#pragma unroll 1
    for (int it = gw; it < DEPTH * Q_PER_LAYER; it += NGW) {
        const int l = it / Q_PER_LAYER; int r = it % Q_PER_LAYER; const float* W; unsigned char* WQ; int N; float sc;
        if (r < NE * Q_GU) { const int e = r / Q_GU; r %= Q_GU; W = KIN(I_WGU) + ((size_t)l * NE + e) * D * 2048; WQ = WSP(unsigned char, WS_WGU_Q) + ((size_t)l * NE + e) * 2048 * D; N = 2048; sc = 32.0f; }
        else if (r >= NE * (Q_GU + Q_DN) + Q_PG) { r -= NE * (Q_GU + Q_DN) + Q_PG; W = KIN(I_WOUT) + (size_t)l * D * D; WQ = WSP(unsigned char, WS_WOUT_Q) + (size_t)l * D * D; N = D; sc = 64.0f; }
        else if (r >= NE * (Q_GU + Q_DN)) { r -= NE * (Q_GU + Q_DN); W = KIN(I_PGW) + (size_t)l * D * D; WQ = WSP(unsigned char, WS_WPG_Q) + (size_t)l * D * D; N = D; sc = 32.0f; }
        else { if (!MOE2_FP8) continue; r -= NE * Q_GU; const int e = r / Q_DN; r %= Q_DN; W = KIN(I_WDN) + ((size_t)l * NE + e) * D * D; WQ = WSP(unsigned char, WS_WDN_Q) + ((size_t)l * NE + e) * D * D; N = D; sc = 64.0f; }
        const int nblk = N / 64, kb = r / nblk, nb = r % nblk, k0 = 64 * kb, n = 64 * nb + F.lane;
        const float* src = W + (size_t)k0 * N + n; float x[64];
#pragma unroll
        for (int j = 0; j < 64; ++j) x[j] = __builtin_nontemporal_load(src + (size_t)j * N) * sc;
        unsigned char* dst = WQ + (size_t)n * D + k0;
#pragma unroll
        for (int q = 0; q < 4; ++q) { v4u o; o.x = cvt4_fp8(x[16 * q], x[16 * q + 1], x[16 * q + 2], x[16 * q + 3]); o.y = cvt4_fp8(x[16 * q + 4], x[16 * q + 5], x[16 * q + 6], x[16 * q + 7]);
            o.z = cvt4_fp8(x[16 * q + 8], x[16 * q + 9], x[16 * q + 10], x[16 * q + 11]); o.w = cvt4_fp8(x[16 * q + 12], x[16 * q + 13], x[16 * q + 14], x[16 * q + 15]); *(v4u*)(dst + 16 * q) = o; }
    }
#endif
    const size_t gt = (size_t)F.vcu * (NWAVES * 64) + F.tid, NT_ = (size_t)F.G * NWAVES * 64;
    cvt_rows(KIN(I_P), WSP(bf16, WS_PB), (size_t)DEPTH * T * 256 / 8, gt, NT_);
    cvt_rows(KIN(I_X), WSP(bf16, WS_XB), (size_t)T * D / 8, gt, NT_);
    for (size_t i = gt; i < (size_t)DEPTH * LORA_PER_LAYER; i += NT_) { const int l = (int)(i / LORA_PER_LAYER); int r = (int)(i % LORA_PER_LAYER); float v;
        if (r < 8192) { const int ch = r >> 5, j = r & 31; v = KIN(I_RWUP)[(size_t)l * 8192 + j * 256 + ch]; }
        else if (r < 16384) { r -= 8192; const int ch = r >> 5, j = r & 31; v = KIN(I_RAUP)[(size_t)l * 8192 + j * 256 + ch]; }
        else if (r < 32768) { r -= 16384; const int ch = r >> 6, j = r & 63; v = KIN(I_RGUP)[(size_t)l * 16384 + j * 256 + ch]; }
        else { r -= 32768; const int d = r >> 4, j = r & 15; v = KIN(I_GGUP)[(size_t)l * 2048 + j * 128 + d]; }
        WSP(float, WS_LORA)[i] = v; }
#if P6_MFMA
    for (size_t i = gt; i < (size_t)DEPTH * 32768; i += NT_) { const int l = (int)(i >> 15), r = (int)(i & 32767), c = r >> 8, e = (r >> 3) & 31, k = 8 * c + (r & 7);
        const float v = KIN(I_RTW)[(size_t)l * D * NE + (size_t)k * NE + e]; const unsigned h = cvt_pk_bf16(v, 0.f) & 0xffffu; const unsigned lo = cvt_pk_bf16(v - __uint_as_float(h << 16), 0.f) & 0xffffu;
        unsigned short* dst = WSP(unsigned short, WS_RWT) + (size_t)l * 65536 + r; dst[0] = (unsigned short)h; dst[32768] = (unsigned short)lo; }
#else
    for (size_t i = gt; i < (size_t)DEPTH * NE * D; i += NT_) { const int l = (int)(i / (NE * D)), r = (int)(i % (NE * D)), e = r / D, k = r % D; WSP(float, WS_RWT)[i] = KIN(I_RTW)[(size_t)l * D * NE + (size_t)k * NE + e]; }
#endif
}

#if P6_MFMA
template <bool DRY> __device__ __forceinline__ void p6_ln1_router(Frame& F, const Args& A, int layer, const gu32* pan = nullptr) {
    const bf16* y1 = WSP(bf16, WS_Y1); bf16* x1b = WSP(bf16, WS_X1B);
    const float* gam = KIN(I_LN1G) + layer * D; const float* bet = KIN(I_LN1B) + layer * D;
    const unsigned char* rwq = WSP(unsigned char, WS_RWT) + (size_t)layer * 131072; const float* rb = KIN(I_RTB) + layer * NE;
    int* sdest = WSP(int, WS_SDEST); float* sgate = WSP(float, WS_SGATE);
    unsigned* cnt = (unsigned*)(F.ctl + CW_CNT + layer * NE * 16);
    LAS unsigned char* WL = F.lds;
    LAS float* LG = (LAS float*)(F.lds + 131072);
    LAS float* TOPV = (LAS float*)(F.lds + 139264) + F.wave * 64;
    LAS int* TOPE = (LAS int*)(F.lds + 139264 + 2048) + F.wave * 64;
    LAS float* STAT = (LAS float*)(F.lds + 143360);
    volatile LAS unsigned* lcnt = F.MISC + MW_LCNT; volatile LAS unsigned* lbase = F.MISC + MW_LBASE;
    { const int l0 = F.lane;
#pragma unroll
      for (int i = 0; i < 16; ++i) { const int off = (F.wave * 16 + i) * 1024; __builtin_amdgcn_global_load_lds((const unsigned*)(rwq + off + l0 * 16), (LAS unsigned*)(WL + off), 16, 0, 0); } }
    const int lane = F.lane, m = lane & 15, g = lane >> 4, rq = F.wave & 3, kh = F.wave >> 2;
    for (int blk = F.vcu; blk < T / 64; blk += F.G) {
        if (F.tid < 32) lcnt[F.tid] = 0u;
        if (OUT_CHAIN && pan) {
            if (F.wave == 0) { const gu32* w = pan + (blk >> 2) * 16; unsigned sp = 0u;
                while ((unsigned)__builtin_amdgcn_readfirstlane(__hip_atomic_load(w, RLX_AGENT)) < 32u) { __builtin_amdgcn_s_sleep(2);
                    if ((++sp & 255u) == 0u) { if (__hip_atomic_load(F.ctl + CW_BAR + XB_TMO, RLX_AGENT)) break; if (sp > (1u << 18)) { atomicAdd((unsigned*)(F.ctl + CW_BAR + XB_TMO), 1u); break; } } }
                __builtin_amdgcn_fence(__ATOMIC_ACQUIRE, "agent"); asm volatile("s_waitcnt vmcnt(0)" ::: "memory"); }
            __syncthreads(); }
        const int row = blk * 64 + rq * 16 + m; const size_t ro = (size_t)row * D + 512 * kh + 8 * g;
        v4u yw[16];
#pragma unroll
        for (int kk = 0; kk < 16; ++kk) yw[kk] = *(const v4u*)(y1 + ro + 32 * kk);
        float s = 0.f, s2 = 0.f;
#pragma unroll
        for (int kk = 0; kk < 16; ++kk) { f32x4 a, b; pg8::unpack8(yw[kk], a, b); s += ((a.x + a.y) + (a.z + a.w)) + ((b.x + b.y) + (b.z + b.w));
            s2 += ((a.x * a.x + a.y * a.y) + (a.z * a.z + a.w * a.w)) + ((b.x * b.x + b.y * b.y) + (b.z * b.z + b.w * b.w)); }
        s += __shfl_xor(s, 16); s += __shfl_xor(s, 32); s2 += __shfl_xor(s2, 16); s2 += __shfl_xor(s2, 32);
        if (g == 0) { STAT[(kh * 64 + rq * 16 + m) * 2] = s; STAT[(kh * 64 + rq * 16 + m) * 2 + 1] = s2; }
        asm volatile("s_waitcnt vmcnt(0)" ::: "memory");
        __syncthreads();
        const float st = STAT[(rq * 16 + m) * 2] + STAT[(64 + rq * 16 + m) * 2], st2 = STAT[(rq * 16 + m) * 2 + 1] + STAT[(64 + rq * 16 + m) * 2 + 1];
        const float mean = st * (1.f / D); const float rstd = __builtin_amdgcn_rsqf(fmaxf(st2 * (1.f / D) - mean * mean, 0.f) + LN_EPS);
        f32x4 acc[2] = {(f32x4){0.f, 0.f, 0.f, 0.f}, (f32x4){0.f, 0.f, 0.f, 0.f}}; const float* gp = gam; const float* bp = bet;
#pragma unroll
        for (int kk = 0; kk < 16; ++kk) { const int k0 = 512 * kh + 32 * kk + 8 * g;
            if ((kk & 3) == 0) { gp = launder_uniform(gp); bp = launder_uniform(bp); }
            const f32x4 ga = *(const f32x4*)(gp + k0), gb = *(const f32x4*)(gp + k0 + 4), ba = *(const f32x4*)(bp + k0), bb = *(const f32x4*)(bp + k0 + 4);
            f32x4 a, b; { v4u yk = yw[kk]; asm volatile("" : "+v"(yk)); pg8::unpack8(yk, a, b); }
            a = (a - mean) * rstd * ga + ba; b = (b - mean) * rstd * gb + bb;
            v4u hw; hw.x = cvt_pk_bf16(a.x, a.y); hw.y = cvt_pk_bf16(a.z, a.w); hw.z = cvt_pk_bf16(b.x, b.y); hw.w = cvt_pk_bf16(b.z, b.w);
            *(v4u*)(x1b + (size_t)row * D + k0) = hw;
            if (MOE_FP8) { v2u q; q.x = cvt4_fp8(a.x, a.y, a.z, a.w); q.y = cvt4_fp8(b.x, b.y, b.z, b.w); *(v2u*)(WSP(unsigned char, WS_X1Q) + (size_t)row * D + k0) = q; }
            f32x4 ha, hb_; pg8::unpack8(hw, ha, hb_); a = a - ha; b = b - hb_;
            v4u lw; lw.x = cvt_pk_bf16(a.x, a.y); lw.y = cvt_pk_bf16(a.z, a.w); lw.z = cvt_pk_bf16(b.x, b.y); lw.w = cvt_pk_bf16(b.z, b.w);
            const bf16x8 xh = __builtin_bit_cast(bf16x8, hw), xl = __builtin_bit_cast(bf16x8, lw);
            const int c = kh * 64 + kk * 4 + g;
#pragma unroll
            for (int nt = 0; nt < 2; ++nt) { const bf16x8 wh = *(const LAS bf16x8*)(WL + (c * 32 + nt * 16 + m) * 16), wl = *(const LAS bf16x8*)(WL + 65536 + (c * 32 + nt * 16 + m) * 16);
                acc[nt] = __builtin_amdgcn_mfma_f32_16x16x32_bf16(wh, xh, acc[nt], 0, 0, 0);
                acc[nt] = __builtin_amdgcn_mfma_f32_16x16x32_bf16(wl, xh, acc[nt], 0, 0, 0);
                acc[nt] = __builtin_amdgcn_mfma_f32_16x16x32_bf16(wh, xl, acc[nt], 0, 0, 0); } }
        if (kh == 1) {
#pragma unroll
            for (int nt = 0; nt < 2; ++nt) *(LAS f32x4*)(LG + (rq * 16 + m) * 32 + nt * 16 + 4 * g) = acc[nt]; }
        __syncthreads();
        if (kh == 0) {
#pragma unroll
            for (int nt = 0; nt < 2; ++nt) { const f32x4 o = *(const LAS f32x4*)(LG + (rq * 16 + m) * 32 + nt * 16 + 4 * g); const f32x4 rbv = *(const f32x4*)(rb + nt * 16 + 4 * g);
                *(LAS f32x4*)(LG + (rq * 16 + m) * 32 + nt * 16 + 4 * g) = o + acc[nt] + rbv; } }
        __syncthreads();
        int lane2 = lane; asm volatile("" : "+v"(lane2)); const int sub = lane2 & 15;
#pragma unroll 1
        for (int rg = 0; rg < 2; ++rg) {
            float lg[32];
            { const LAS float* lr = LG + (F.wave * 8 + rg * 4 + (lane2 >> 4)) * 32;
#pragma unroll
              for (int q = 0; q < 8; ++q) { const f32x4 t4 = *(const LAS f32x4*)(lr + 4 * q); lg[4 * q] = t4.x; lg[4 * q + 1] = t4.y; lg[4 * q + 2] = t4.z; lg[4 * q + 3] = t4.w; } }
            float la = 0.f, lb_ = 0.f;
#pragma unroll
            for (int e = 0; e < 32; ++e) { if (e == 2 * sub) la = lg[e]; if (e == 2 * sub + 1) lb_ = lg[e]; }
            int ra = 0, rbk = 0;
#pragma unroll
            for (int e = 0; e < 32; ++e) { ra += (lg[e] > la || (lg[e] == la && e < 2 * sub)) ? 1 : 0; rbk += (lg[e] > lb_ || (lg[e] == lb_ && e < 2 * sub + 1)) ? 1 : 0; }
            const int rowl = rg * 4 + (lane2 >> 4);
            if (ra < 4) { TOPV[rowl * 4 + ra] = la; TOPE[rowl * 4 + ra] = 2 * sub; }
            if (rbk < 4) { TOPV[rowl * 4 + rbk] = lb_; TOPE[rowl * 4 + rbk] = 2 * sub + 1; }
        }
        LDS_WAIT();
        int my_e = 0; float my_g = 0.f; unsigned my_r = 0u;
        if (lane2 < 32) { const int ri = lane2 >> 2, k = lane2 & 3; const f32x4 tv = *(const LAS f32x4*)(TOPV + ri * 4);
            const float e1 = __expf(tv.y - tv.x), e2 = __expf(tv.z - tv.x), e3 = __expf(tv.w - tv.x); const float inv = __builtin_amdgcn_rcpf(1.0f + e1 + e2 + e3);
            my_e = TOPE[ri * 4 + k]; my_g = (k == 0 ? 1.0f : k == 1 ? e1 : k == 2 ? e2 : e3) * inv;
            my_r = DRY ? 0u : atomicAdd((unsigned*)&lcnt[my_e], 1u); }
        __syncthreads();
        if (!DRY && F.wave == 0 && lane2 < 32) { const unsigned n = lcnt[lane2]; lbase[lane2] = n ? __hip_atomic_fetch_add(cnt + lane2 * 16, n, RLX_AGENT) : 0u; }
        __syncthreads();
        if (!DRY && lane2 < 32) { const int rw = blk * 64 + F.wave * 8 + (lane2 >> 2); const unsigned slot = (unsigned)my_e * ECAP + lbase[my_e] + my_r;
            sdest[slot] = rw * 4 + (lane2 & 3); sgate[slot] = my_g; }
        __syncthreads();
    }
}
#else
template <bool DRY> __device__ __forceinline__ void p6_ln1_router(Frame& F, const Args& A, int layer) {
    const bf16* y1 = WSP(bf16, WS_Y1); bf16* x1b = WSP(bf16, WS_X1B);
    const float* g = KIN(I_LN1G) + layer * D; const float* bb = KIN(I_LN1B) + layer * D;
    const float* rwt = WSP(float, WS_RWT) + (size_t)layer * NE * D; const float* rb = KIN(I_RTB) + layer * NE;
    int* sdest = WSP(int, WS_SDEST); float* sgate = WSP(float, WS_SGATE);
    unsigned* cnt = (unsigned*)(F.ctl + CW_CNT + layer * NE * 16);
    LAS float* RWT = (LAS float*)F.lds;
    LAS float* TOPV = (LAS float*)(F.lds + 131072) + F.wave * 64;
    LAS int* TOPE = (LAS int*)(F.lds + 131072 + 2048) + F.wave * 64;
    volatile LAS unsigned* lcnt = F.MISC + MW_LCNT; volatile LAS unsigned* lbase = F.MISC + MW_LBASE;
    for (int i = F.tid; i < NE * D / 4; i += NWAVES * 64) ((LAS f32x4*)RWT)[i] = ((const f32x4*)rwt)[i];
    const int lane = F.lane, sub = lane & 15;
    for (int blk = F.vcu; blk < T / 64; blk += F.G) {
        if (F.tid < 32) lcnt[F.tid] = 0u;
        __syncthreads();
#pragma unroll 1
        for (int rg = 0; rg < 2; ++rg) {
            f32x4 v[4][4];
            { int lo_ = lane; asm volatile("" : "+v"(lo_));
              const f32x4 gv[4] = { *(const f32x4*)(g + 4 * lo_), *(const f32x4*)(g + 256 + 4 * lo_), *(const f32x4*)(g + 512 + 4 * lo_), *(const f32x4*)(g + 768 + 4 * lo_) };
              const f32x4 bv[4] = { *(const f32x4*)(bb + 4 * lo_), *(const f32x4*)(bb + 256 + 4 * lo_), *(const f32x4*)(bb + 512 + 4 * lo_), *(const f32x4*)(bb + 768 + 4 * lo_) };
#pragma unroll
              for (int r = 0; r < 4; ++r) { const int row = blk * 64 + F.wave * 8 + rg * 4 + r; const bf16* yr = y1 + (size_t)row * D; float s = 0.f;
#pragma unroll
                  for (int j = 0; j < 4; ++j) { const v2u w = *(const v2u*)(yr + 256 * j + 4 * lane); v[r][j] = (f32x4){__uint_as_float(w.x << 16), __uint_as_float(w.x & 0xffff0000u), __uint_as_float(w.y << 16), __uint_as_float(w.y & 0xffff0000u)}; s += (v[r][j].x + v[r][j].y) + (v[r][j].z + v[r][j].w); }
                  const float mean = wave_sum(s) * (1.f / D); float s2 = 0.f;
#pragma unroll
                  for (int j = 0; j < 4; ++j) { v[r][j] = v[r][j] - mean; s2 += (v[r][j].x * v[r][j].x + v[r][j].y * v[r][j].y) + (v[r][j].z * v[r][j].z + v[r][j].w * v[r][j].w); }
                  const float rstd = __builtin_amdgcn_rsqf(wave_sum(s2) * (1.f / D) + LN_EPS);
#pragma unroll
                  for (int j = 0; j < 4; ++j) { v[r][j] = v[r][j] * rstd * gv[j] + bv[j];
                      v2u o; o.x = cvt_pk_bf16(v[r][j].x, v[r][j].y); o.y = cvt_pk_bf16(v[r][j].z, v[r][j].w); *(v2u*)(x1b + (size_t)row * D + 256 * j + 4 * lane) = o;
                      if (MOE_FP8) *(unsigned*)(WSP(unsigned char, WS_X1Q) + (size_t)row * D + 256 * j + 4 * lane) = cvt4_fp8(v[r][j].x, v[r][j].y, v[r][j].z, v[r][j].w); } } }
            float lg[32];
#pragma unroll
            for (int e = 0; e < 32; ++e) { f32x2 p2[4] = {(f32x2){0.f, 0.f}, (f32x2){0.f, 0.f}, (f32x2){0.f, 0.f}, (f32x2){0.f, 0.f}};
#pragma unroll
                for (int j = 0; j < 4; ++j) { const f32x4 w = *(const LAS f32x4*)(RWT + e * D + 256 * j + 4 * lane);
#pragma unroll
                    for (int r = 0; r < 4; ++r) { p2[r] = v[r][j].xy * w.xy + p2[r]; p2[r] = v[r][j].zw * w.zw + p2[r]; } }
                float p[4] = {p2[0].x + p2[0].y, p2[1].x + p2[1].y, p2[2].x + p2[2].y, p2[3].x + p2[3].y};
                { const bool hi = (lane & 32) != 0; const float k0 = hi ? p[2] : p[0], s0 = hi ? p[0] : p[2], k1 = hi ? p[3] : p[1], s1 = hi ? p[1] : p[3]; p[0] = k0 + __shfl_xor(s0, 32); p[1] = k1 + __shfl_xor(s1, 32); }
                { const bool hi = (lane & 16) != 0; const float k0 = hi ? p[1] : p[0], s0 = hi ? p[0] : p[1]; p[0] = k0 + __shfl_xor(s0, 16); }
                float t = p[0]; t += __shfl_xor(t, 8); t += __shfl_xor(t, 4); t += __shfl_xor(t, 2); t += __shfl_xor(t, 1);
                lg[e] = t + rb[e]; }
            float la = 0.f, lb_ = 0.f;
#pragma unroll
            for (int e = 0; e < 32; ++e) { if (e == 2 * sub) la = lg[e]; if (e == 2 * sub + 1) lb_ = lg[e]; }
            int ra = 0, rbk = 0;
#pragma unroll
            for (int e = 0; e < 32; ++e) { ra += (lg[e] > la || (lg[e] == la && e < 2 * sub)) ? 1 : 0; rbk += (lg[e] > lb_ || (lg[e] == lb_ && e < 2 * sub + 1)) ? 1 : 0; }
            const int rowl = rg * 4 + (lane >> 4);
            if (ra < 4) { TOPV[rowl * 4 + ra] = la; TOPE[rowl * 4 + ra] = 2 * sub; }
            if (rbk < 4) { TOPV[rowl * 4 + rbk] = lb_; TOPE[rowl * 4 + rbk] = 2 * sub + 1; }
        }
        LDS_WAIT();
        int my_e = 0; float my_g = 0.f; unsigned my_r = 0u;
        if (lane < 32) { const int ri = lane >> 2, k = lane & 3; const f32x4 tv = *(const LAS f32x4*)(TOPV + ri * 4);
            const float e1 = __expf(tv.y - tv.x), e2 = __expf(tv.z - tv.x), e3 = __expf(tv.w - tv.x); const float inv = __builtin_amdgcn_rcpf(1.0f + e1 + e2 + e3);
            my_e = TOPE[ri * 4 + k]; my_g = (k == 0 ? 1.0f : k == 1 ? e1 : k == 2 ? e2 : e3) * inv;
            my_r = DRY ? 0u : atomicAdd((unsigned*)&lcnt[my_e], 1u); }
        __syncthreads();
        if (!DRY && F.tid < 32) { const unsigned n = lcnt[F.tid]; lbase[F.tid] = n ? __hip_atomic_fetch_add(cnt + F.tid * 16, n, RLX_AGENT) : 0u; }
        __syncthreads();
        if (!DRY && lane < 32) { const int row = blk * 64 + F.wave * 8 + (lane >> 2); const unsigned slot = (unsigned)my_e * ECAP + lbase[my_e] + my_r;
            sdest[slot] = row * 4 + (lane & 3); sgate[slot] = my_g; }
        __syncthreads();
    }
}
#endif
__device__ __forceinline__ void p9_combine(Frame& F, const Args& A) {
    const bf16* x1b = WSP(bf16, WS_X1B); const bf16* yb = WSP(bf16, WS_YBUF); bf16* hb = WSP(bf16, WS_HB);
    const int gw = F.vcu * NWAVES + F.wave, NGW = F.G * NWAVES, lane = F.lane;
    for (int row = gw; row < T; row += NGW) {
        v4u y[4][2], xw[2];
#pragma unroll
        for (int j = 0; j < 2; ++j) {
#pragma unroll
            for (int k = 0; k < 4; ++k) y[k][j] = *(const v4u*)(yb + ((size_t)row * 4 + k) * D + 512 * j + 8 * lane);
            xw[j] = *(const v4u*)(x1b + (size_t)row * D + 512 * j + 8 * lane); }
#pragma unroll
        for (int j = 0; j < 2; ++j) { f32x4 v0, v1; pg8::unpack8(xw[j], v0, v1); v0 = v0 * DN_ALPHA; v1 = v1 * DN_ALPHA;
#pragma unroll
            for (int k = 0; k < 4; ++k) { f32x4 a, b; pg8::unpack8(y[k][j], a, b); v0 = v0 + a; v1 = v1 + b; }
            v4u wv; wv.x = cvt_pk_bf16(v0.x, v0.y); wv.y = cvt_pk_bf16(v0.z, v0.w); wv.z = cvt_pk_bf16(v1.x, v1.y); wv.w = cvt_pk_bf16(v1.z, v1.w); *(v4u*)(hb + (size_t)row * D + 512 * j + 8 * lane) = wv;
            if (PLE_FP8) { v2u q; q.x = cvt4_fp8(v0.x, v0.y, v0.z, v0.w); q.y = cvt4_fp8(v1.x, v1.y, v1.z, v1.w); *(v2u*)(WSP(unsigned char, WS_HQ) + (size_t)row * D + 512 * j + 8 * lane) = q; } }
    }
}
__device__ __forceinline__ void p11_ln2(Frame& F, const Args& A, int layer) {
    const bf16* h2 = WSP(bf16, WS_H2); bf16* xb = WSP(bf16, WS_XB);
    const float* g = KIN(I_LN2G) + layer * D; const float* bb = KIN(I_LN2B) + layer * D;
    const int gw = F.vcu * NWAVES + F.wave, NGW = F.G * NWAVES, lane = F.lane;
    for (int row = gw; row < T; row += NGW) {
        const bf16* yr = h2 + (size_t)row * D; f32x4 v[4]; float s = 0.f;
#pragma unroll
        for (int j = 0; j < 4; ++j) { const v2u w = *(const v2u*)(yr + 256 * j + 4 * lane); v[j] = (f32x4){__uint_as_float(w.x << 16), __uint_as_float(w.x & 0xffff0000u), __uint_as_float(w.y << 16), __uint_as_float(w.y & 0xffff0000u)}; s += (v[j].x + v[j].y) + (v[j].z + v[j].w); }
        const float mean = wave_sum(s) * (1.f / D); float s2 = 0.f;
#pragma unroll
        for (int j = 0; j < 4; ++j) { v[j] = v[j] - mean; s2 += (v[j].x * v[j].x + v[j].y * v[j].y) + (v[j].z * v[j].z + v[j].w * v[j].w); }
        const float rstd = __builtin_amdgcn_rsqf(wave_sum(s2) * (1.f / D) + LN_EPS);
#pragma unroll
        for (int j = 0; j < 4; ++j) { const f32x4 gv = *(const f32x4*)(g + 256 * j + 4 * lane), bv = *(const f32x4*)(bb + 256 * j + 4 * lane);
            const f32x4 o = v[j] * rstd * gv + bv; const size_t off = (size_t)row * D + 256 * j + 4 * lane;
            if (layer == DEPTH - 1) *(f32x4*)(F.out + off) = o; v2u w; w.x = cvt_pk_bf16(o.x, o.y); w.y = cvt_pk_bf16(o.z, o.w); *(v2u*)(xb + off) = w; }
    }
}
__device__ __forceinline__ void moe_build_pfx(Frame& F, const Args& A, int layer, int NT) {
    volatile LAS unsigned* pfx = F.MISC + MW_PFX;
    __syncthreads();
    if (F.tid < 64) {
        const int e = F.tid & 31;
        const unsigned c = __hip_atomic_load(F.ctl + CW_CNT + (layer * NE + e) * 16, RLX_AGENT);
        const unsigned un = ((c + 255u) >> 8) * (unsigned)NT; unsigned inc = un;
#pragma unroll
        for (int o = 1; o < 32; o <<= 1) { const unsigned t = (unsigned)my_shfl_up((int)inc, o); if (e >= o) inc += t; }
        if (F.tid < 32) { pfx[e] = inc - un; pfx[40 + e] = c; if (e == 31) pfx[32] = inc; }
    }
    __syncthreads();
}
#define UU(t, col) bf2f(u[(size_t)(t) * NUP + (col)])
#define UU4(t, col) ldu4(u + (size_t)(t) * NUP + (col))
__device__ __forceinline__ f32x4 ldu4(const bf16* p) { const v2u w = *(const v2u*)p; return (f32x4){__uint_as_float(w.x << 16), __uint_as_float(w.x & 0xffff0000u), __uint_as_float(w.y << 16), __uint_as_float(w.y & 0xffff0000u)}; }
__device__ __forceinline__ f32x4 ldb4(const bf16* p) { const v2u w = *(const v2u*)p; return (f32x4){__uint_as_float(w.x << 16), __uint_as_float(w.x & 0xffff0000u), __uint_as_float(w.y << 16), __uint_as_float(w.y & 0xffff0000u)}; }
__device__ __forceinline__ void stb4(bf16* p, f32x4 v) { v2u o; o.x = cvt_pk_bf16(v.x, v.y); o.y = cvt_pk_bf16(v.z, v.w); *(v2u*)p = o; }
__device__ __forceinline__ void lds_st_bf16(LAS unsigned char* p, float v) { *(LAS unsigned short*)p = (unsigned short)(cvt_pk_bf16(v, 0.f) & 0xffffu); }
__device__ __forceinline__ void lds_st_bf16x4(LAS unsigned char* p, float a, float b, float c, float d) { v2u o; o.x = cvt_pk_bf16(a, b); o.y = cvt_pk_bf16(c, d); *(LAS v2u*)p = o; }

#if OUT_FP8
#if MIX_CHAIN
#define MIX_ST4(mix, idx, a, b, c, d) do { unsigned char* mp_ = (unsigned char*)(mix) + (idx); const unsigned mv_ = cvt4_fp8(a, b, c, d); asm volatile("global_store_dword %0, %1, off sc1" :: "v"(mp_), "v"(mv_) : "memory"); } while (0)
#else
#define MIX_ST4(mix, idx, a, b, c, d) (*(unsigned*)((unsigned char*)(mix) + (idx)) = cvt4_fp8(a, b, c, d))
#endif
#else
#define MIX_ST4(mix, idx, a, b, c, d) do { v2u o_; o_.x = cvt_pk_bf16(a, b); o_.y = cvt_pk_bf16(c, d); *(v2u*)((mix) + (idx)) = o_; } while (0)
#endif
__device__ __forceinline__ void ssd_stage1(Frame& F, const Args& A, int layer, int b, int c) {
    const bf16* u = WSP(bf16, WS_U);
    LAS unsigned char* L = F.lds;
    LAS float* DT = (LAS float*)L; LAS float* AC = DT + 256;
    LAS unsigned char* BMT = L + 2048; LAS unsigned char* XCDT = BMT + 128 * 144;
    const int t0 = b * SEQ + c * 64, tid = F.tid, lane = F.lane, wave = F.wave;
    if (wave < 4) {
        const int hh = wave;
        const float dt = softplusf_(UU(t0 + lane, U_SSD_DT + hh) + KIN(I_SDTB)[layer * 4 + hh]);
        const float adt = -dt * __expf(KIN(I_SALOG)[layer * 4 + hh]);
        const float ac = wave_scan_add(adt, lane);
        DT[hh * 64 + lane] = dt; AC[hh * 64 + lane] = ac;
        if (lane == 63) WSP(float, WS_SSD_DEC)[(b * 4 + hh) * NCH + c] = __expf(ac);
    }
    __syncthreads();
    if (tid < 384) {
        const int cc = tid; const float* cw = KIN(I_SCW) + (size_t)layer * 2048 + cc; const float w0 = cw[0], w1 = cw[512], w2 = cw[1024], w3 = cw[1536], cb = KIN(I_SCB)[layer * 512 + cc];
        const bf16* up = u + (size_t)t0 * NUP + U_SSD_X + cc;
        float win0 = 0.f, win1 = 0.f, win2 = 0.f;
        if (c > 0) { win0 = bf2f(up[-3 * NUP]); win1 = bf2f(up[-2 * NUP]); win2 = bf2f(up[-1 * NUP]); }
        const int hh = (cc >> 6) & 3; const bool isx = cc < 256;
        LAS unsigned char* dst = isx ? XCDT + cc * 144 : BMT + (cc - 256) * 144;
        const float aclast = AC[hh * 64 + 63];
#pragma unroll 1
        for (int l0 = 0; l0 < 64; l0 += 32) {
            float xv[32];
#pragma unroll
            for (int j = 0; j < 32; ++j) xv[j] = bf2f(up[(l0 + j) * NUP]);
#pragma unroll
            for (int j8 = 0; j8 < 4; ++j8) { float o[8];
#pragma unroll
                for (int j = 0; j < 8; ++j) { const int l = l0 + j8 * 8 + j; const float x = xv[j8 * 8 + j]; const float y = cb + w0 * win0 + w1 * win1 + w2 * win2 + w3 * x; win0 = win1; win1 = win2; win2 = x;
                    float s = siluf_(y); if (isx) s *= DT[hh * 64 + l] * __expf(aclast - AC[hh * 64 + l]); o[j] = s; }
                *(LAS v4u*)(dst + (l0 + j8 * 8) * 2) = pack8(o); }
        }
    }
    __syncthreads();
    { const int fr = lane & 15, fq = lane >> 4; bf16* st = WSP(bf16, WS_SSD_ST);
#pragma unroll 1
      for (int i = 0; i < 2; ++i) { const int row0 = (2 * wave + i) * 16; const int hh = row0 >> 6, p = (row0 & 63) + fr;
          bf16* dstp = st + (((size_t)(b * 4 + hh) * NCH + c) * 64 + p) * 128;
#pragma unroll 1
          for (int ntl = 0; ntl < 8; ++ntl) { f32x4 acc = {0.f, 0.f, 0.f, 0.f}; acc = mm16(XCDT + row0 * 144, 144, BMT + ntl * 16 * 144, 144, 64, acc, fr, fq);
              stb4(dstp + ntl * 16 + 4 * fq, acc); } } }
    __syncthreads();
}
__device__ __forceinline__ void ssd_stage3(Frame& F, const Args& A, int layer, int b, int c) {
    const bf16* u = WSP(bf16, WS_U);
    LAS unsigned char* L = F.lds;
    LAS float* DT = (LAS float*)L; LAS float* AC = DT + 256;
    LAS unsigned char* CM = L + 2048; LAS unsigned char* BM = CM + 64 * 272; LAS unsigned char* XCT = BM + 64 * 272; LAS unsigned char* MM = XCT + 256 * 144;
    LAS unsigned char* YG = XCT;
    const int t0 = b * SEQ + c * 64, tid = F.tid, lane = F.lane, wave = F.wave, fr = lane & 15, fq = lane >> 4;
    if (wave < 4) {
        const int hh = wave;
        const float dt = softplusf_(UU(t0 + lane, U_SSD_DT + hh) + KIN(I_SDTB)[layer * 4 + hh]);
        const float adt = -dt * __expf(KIN(I_SALOG)[layer * 4 + hh]);
        DT[hh * 64 + lane] = dt; AC[hh * 64 + lane] = wave_scan_add(adt, lane);
    }
    __syncthreads();
    {
        const int cc = tid; const float* cw = KIN(I_SCW) + (size_t)layer * 2048 + cc; const float w0 = cw[0], w1 = cw[512], w2 = cw[1024], w3 = cw[1536], cb = KIN(I_SCB)[layer * 512 + cc];
        const bf16* up = u + (size_t)t0 * NUP + U_SSD_X + cc;
        float win0 = 0.f, win1 = 0.f, win2 = 0.f;
        if (c > 0) { win0 = bf2f(up[-3 * NUP]); win1 = bf2f(up[-2 * NUP]); win2 = bf2f(up[-1 * NUP]); }
        const int hh = (cc >> 6) & 3;
#pragma unroll 1
        for (int l0 = 0; l0 < 64; l0 += 32) {
            float xv[32];
#pragma unroll
            for (int j = 0; j < 32; ++j) xv[j] = bf2f(up[(l0 + j) * NUP]);
#pragma unroll
            for (int j8 = 0; j8 < 4; ++j8) { float o[8];
#pragma unroll
                for (int j = 0; j < 8; ++j) { const int l = l0 + j8 * 8 + j; const float x = xv[j8 * 8 + j]; const float y = cb + w0 * win0 + w1 * win1 + w2 * win2 + w3 * x; win0 = win1; win1 = win2; win2 = x;
                    float s = siluf_(y); if (cc < 256) s *= DT[hh * 64 + l]; o[j] = s; }
                if (cc < 256) *(LAS v4u*)(XCT + cc * 144 + (l0 + j8 * 8) * 2) = pack8(o);
                else { LAS unsigned char* d2 = (cc < 384 ? BM + (cc - 256) * 2 : CM + (cc - 384) * 2) + (l0 + j8 * 8) * 272;
#pragma unroll
                    for (int j = 0; j < 8; ++j) lds_st_bf16(d2 + j * 272, o[j]); } }
        }
    }
    __syncthreads();
#pragma unroll 1
    for (int i = 0; i < 2; ++i) { const int idx = 2 * wave + i, lt = idx >> 2, st = idx & 3;
        f32x4 acc = {0.f, 0.f, 0.f, 0.f}; acc = mm16(CM + lt * 16 * 272, 272, BM + st * 16 * 272, 272, 128, acc, fr, fq);
        const int l = lt * 16 + fr, s0 = st * 16 + 4 * fq;
#pragma unroll
        for (int hh = 0; hh < 4; ++hh) { const float al = AC[hh * 64 + l], dl = KIN(I_SD)[layer * 4 + hh] / DT[hh * 64 + l]; float o[4];
#pragma unroll
            for (int j = 0; j < 4; ++j) { const int s = s0 + j; float m = (l >= s) ? acc[j] * __expf(al - AC[hh * 64 + s]) : 0.f; if (l == s) m += dl; o[j] = m; }
            lds_st_bf16x4(MM + hh * 9216 + l * 144 + s0 * 2, o[0], o[1], o[2], o[3]); } }
    __syncthreads();
    f32x4 yv[2][4];
    { const int hh = wave >> 1; const bf16* prev = WSP(bf16, WS_SSD_ST) + ((size_t)(b * 4 + hh) * NCH + c) * 8192;
      bf16x8 pf[4][4];
#pragma unroll
      for (int pt = 0; pt < 4; ++pt)
#pragma unroll
          for (int ks = 0; ks < 4; ++ks) pf[pt][ks] = *(const bf16x8*)(prev + (size_t)(pt * 16 + fr) * 128 + ks * 32 + fq * 8);
#pragma unroll
      for (int i = 0; i < 2; ++i) { const int lt = 2 * (wave & 1) + i, l = lt * 16 + fr; const float ea = __expf(AC[hh * 64 + l]);
#pragma unroll
          for (int pt = 0; pt < 4; ++pt) { f32x4 ad = {0.f, 0.f, 0.f, 0.f}, ao = {0.f, 0.f, 0.f, 0.f};
              ad = mm16(MM + hh * 9216 + lt * 16 * 144, 144, XCT + (hh * 64 + pt * 16) * 144, 144, 64, ad, fr, fq);
              ao = mm16_rB<4>(CM + lt * 16 * 272, 272, pf[pt], ao, fr, fq);
              const f32x4 z = UU4(t0 + l, U_SSD_Z + hh * 64 + pt * 16 + 4 * fq);
              f32x4 y = ad + ao * ea; y.x *= siluf_(z.x); y.y *= siluf_(z.y); y.z *= siluf_(z.z); y.w *= siluf_(z.w); yv[i][pt] = y; } } }
    __syncthreads();
    { const int hh = wave >> 1;
#pragma unroll
      for (int i = 0; i < 2; ++i) { const int l = (2 * (wave & 1) + i) * 16 + fr;
#pragma unroll
          for (int pt = 0; pt < 4; ++pt) *(LAS f32x4*)(YG + l * 1040 + (hh * 64 + pt * 16 + 4 * fq) * 4) = yv[i][pt]; } }
    __syncthreads();
    { const f32x4 g = *(const f32x4*)(KIN(I_SNG) + layer * 256 + 4 * lane); bf16* mix = WSP(bf16, WS_MIX);
#pragma unroll 1
      for (int i = 0; i < 8; ++i) { const int l = wave * 8 + i; const f32x4 y = *(const LAS f32x4*)(YG + l * 1040 + lane * 16);
          const float ss = wave_sum((y.x * y.x + y.y * y.y) + (y.z * y.z + y.w * y.w)); const float r = __builtin_amdgcn_rsqf(ss * (1.f / 256.f) + NORM_EPS);
          MIX_ST4(mix, (size_t)(t0 + l) * D + 4 * lane, y.x * r * g.x, y.y * r * g.y, y.z * r * g.z, y.w * r * g.w); } }
    __syncthreads();
}

__device__ __forceinline__ void gla_bcum_all(Frame& F, const Args& A, int layer, const LAS float* GD, LAS float* BC) {
    const int d = F.tid & 127, lq = F.tid >> 7;
    float gup[16];
    { const f32x4* gp4 = (const f32x4*)(WSP(float, WS_LORA) + (size_t)layer * LORA_PER_LAYER + 32768 + d * 16);
#pragma unroll
      for (int i = 0; i < 4; ++i) { const f32x4 a = gp4[i]; gup[4 * i] = a.x; gup[4 * i + 1] = a.y; gup[4 * i + 2] = a.z; gup[4 * i + 3] = a.w; } }
    const float gb = KIN(I_GGB)[layer * 128 + d];
#pragma unroll 4
    for (int li = 0; li < 16; ++li) { const int l = lq * 16 + li; float x = gb;
#pragma unroll
        for (int i = 0; i < 4; ++i) { const f32x4 g4 = *(const LAS f32x4*)(GD + l * 16 + 4 * i); x += (g4.x * gup[4 * i] + g4.y * gup[4 * i + 1]) + (g4.z * gup[4 * i + 2] + g4.w * gup[4 * i + 3]); }
        BC[l * 128 + d] = logsigmoidf_(x) * 0.0625f; }
    __syncthreads();
    if (F.tid < 128) { float run = 0.f;
#pragma unroll 1
        for (int l0 = 0; l0 < 64; l0 += 16) { float v[16];
#pragma unroll
            for (int j = 0; j < 16; ++j) v[j] = BC[(l0 + j) * 128 + d];
#pragma unroll
            for (int j = 0; j < 16; ++j) { run += v[j]; BC[(l0 + j) * 128 + d] = run; } } }
}
__device__ __forceinline__ void gla_stage1(Frame& F, const Args& A, int layer, int b, int c) {
    const bf16* u = WSP(bf16, WS_U);
    LAS unsigned char* L = F.lds;
    LAS float* GD = (LAS float*)L; LAS float* BC = (LAS float*)(L + 4096);
    LAS unsigned char* KDT = L + 36864; LAS unsigned char* VT = KDT + 128 * 144;
    const int t0 = b * SEQ + c * 64, tid = F.tid, lane = F.lane, wave = F.wave, fr = lane & 15, fq = lane >> 4;
    if (tid < 256) { const int l = tid >> 2, q4 = tid & 3; *(LAS f32x4*)(GD + l * 16 + q4 * 4) = UU4(t0 + l, U_GL_G + 4 * q4); }
    __syncthreads();
    gla_bcum_all(F, A, layer, GD, BC);
    if (tid < 128) {
        const int d = tid; const float blast = BC[63 * 128 + d];
        WSP(float, WS_GLA_DEC)[(size_t)(b * NCH + c) * 128 + d] = __expf(blast);
        const bf16* up = u + (size_t)t0 * NUP + U_GL_K + d;
#pragma unroll 1
        for (int l0 = 0; l0 < 64; l0 += 32) { float xv[32];
#pragma unroll
            for (int j = 0; j < 32; ++j) xv[j] = bf2f(up[(l0 + j) * NUP]);
#pragma unroll
            for (int j8 = 0; j8 < 4; ++j8) { float o[8];
#pragma unroll
                for (int j = 0; j < 8; ++j) { const int l = l0 + j8 * 8 + j; o[j] = xv[j8 * 8 + j] * __expf(blast - BC[l * 128 + d]); }
                *(LAS v4u*)(KDT + d * 144 + (l0 + j8 * 8) * 2) = pack8(o); } }
    } else if (tid < 384) {
        const int vch = tid - 128; const bf16* up = u + (size_t)t0 * NUP + U_GL_V + vch;
#pragma unroll 1
        for (int l0 = 0; l0 < 64; l0 += 32) { float xv[32];
#pragma unroll
            for (int j = 0; j < 32; ++j) xv[j] = bf2f(up[(l0 + j) * NUP]);
#pragma unroll
            for (int j8 = 0; j8 < 4; ++j8) { float o[8];
#pragma unroll
                for (int j = 0; j < 8; ++j) o[j] = xv[j8 * 8 + j];
                *(LAS v4u*)(VT + vch * 144 + (l0 + j8 * 8) * 2) = pack8(o); } }
    }
    __syncthreads();
    { bf16* st = WSP(bf16, WS_GLA_ST);
#pragma unroll 1
      for (int i = 0; i < 4; ++i) { const int idx = 4 * wave + i, hh = idx >> 3, dtl = (idx >> 2) & 1, vt = idx & 3;
          f32x4 acc = {0.f, 0.f, 0.f, 0.f}; acc = mm16(KDT + (hh * 32 + dtl * 16) * 144, 144, VT + (hh * 64 + vt * 16) * 144, 144, 64, acc, fr, fq);
          stb4(st + (((size_t)(b * 4 + hh) * NCH + c) * 32 + dtl * 16 + fr) * 64 + vt * 16 + 4 * fq, acc); } }
    __syncthreads();
}
__device__ __forceinline__ void gla_stage3(Frame& F, const Args& A, int layer, int b, int c) {
    const bf16* u = WSP(bf16, WS_U);
    LAS unsigned char* L = F.lds;
    LAS float* GD = (LAS float*)L; LAS float* BC = (LAS float*)(L + 4096); LAS unsigned char* ATT = L + 4096;
    LAS unsigned char* QD = L + 40960; LAS unsigned char* KI = QD + 64 * 272; LAS unsigned char* VT = KI + 64 * 272; LAS unsigned char* PVT = VT + 256 * 144;
    const int t0 = b * SEQ + c * 64, tid = F.tid, lane = F.lane, wave = F.wave, fr = lane & 15, fq = lane >> 4;
    if (tid < 256) { const int l = tid >> 2, q4 = tid & 3; *(LAS f32x4*)(GD + l * 16 + q4 * 4) = UU4(t0 + l, U_GL_G + 4 * q4); }
    __syncthreads();
    gla_bcum_all(F, A, layer, GD, BC);
    if (tid < 128) {
        const int d = tid;
        const bf16* uq = u + (size_t)t0 * NUP + U_GL_Q + d; const bf16* uk = u + (size_t)t0 * NUP + U_GL_K + d;
#pragma unroll 1
        for (int l0 = 0; l0 < 64; l0 += 16) { float qv[16], kv[16];
#pragma unroll
            for (int j = 0; j < 16; ++j) { qv[j] = bf2f(uq[(l0 + j) * NUP]); kv[j] = bf2f(uk[(l0 + j) * NUP]); }
#pragma unroll
            for (int j = 0; j < 16; ++j) { const int l = l0 + j; const float bc = BC[l * 128 + d];
                lds_st_bf16(QD + l * 272 + d * 2, qv[j] * 0.17677669529663687f * __expf(bc)); lds_st_bf16(KI + l * 272 + d * 2, kv[j] * __expf(-bc)); } }
    } else if (tid < 384) {
        const int vch = tid - 128; const bf16* up = u + (size_t)t0 * NUP + U_GL_V + vch;
#pragma unroll 1
        for (int l0 = 0; l0 < 64; l0 += 32) { float xv[32];
#pragma unroll
            for (int j = 0; j < 32; ++j) xv[j] = bf2f(up[(l0 + j) * NUP]);
#pragma unroll
            for (int j8 = 0; j8 < 4; ++j8) { float o[8];
#pragma unroll
                for (int j = 0; j < 8; ++j) o[j] = xv[j8 * 8 + j];
                *(LAS v4u*)(VT + vch * 144 + (l0 + j8 * 8) * 2) = pack8(o); } }
    } else {
        const bf16* prev = WSP(bf16, WS_GLA_ST);
#pragma unroll 4
        for (int i = tid - 384; i < 8192; i += 128) { const int hh = i >> 11, dd = (i >> 6) & 31, vv = i & 63;
            *(LAS unsigned short*)(PVT + (hh * 64 + vv) * 80 + dd * 2) = prev[((size_t)(b * 4 + hh) * NCH + c) * 2048 + dd * 64 + vv]; }
    }
    __syncthreads();
    const int hh = wave >> 1;
#pragma unroll 1
    for (int i = 0; i < 2; ++i) { const int tt = 2 * (wave & 1) + i, t = tt * 16 + fr;
#pragma unroll
        for (int st = 0; st < 4; ++st) { f32x4 acc = {0.f, 0.f, 0.f, 0.f}; acc = mm16(QD + tt * 16 * 272 + hh * 64, 272, KI + st * 16 * 272 + hh * 64, 272, 32, acc, fr, fq);
            const int s0 = st * 16 + 4 * fq;
            lds_st_bf16x4(ATT + hh * 9216 + t * 144 + s0 * 2, t >= s0 ? acc[0] : 0.f, t >= s0 + 1 ? acc[1] : 0.f, t >= s0 + 2 ? acc[2] : 0.f, t >= s0 + 3 ? acc[3] : 0.f); } }
    __syncthreads();
    { bf16* mix = WSP(bf16, WS_MIX); const float* ng = KIN(I_GNG) + layer * 256;
#pragma unroll 1
      for (int i = 0; i < 2; ++i) { const int tt = 2 * (wave & 1) + i, t = tt * 16 + fr; f32x4 ov[4]; float ss = 0.f;
#pragma unroll
          for (int vt = 0; vt < 4; ++vt) { f32x4 acc = {0.f, 0.f, 0.f, 0.f};
              acc = mm16(ATT + hh * 9216 + tt * 16 * 144, 144, VT + (hh * 64 + vt * 16) * 144, 144, 64, acc, fr, fq);
              acc = mm16(QD + tt * 16 * 272 + hh * 64, 272, PVT + (hh * 64 + vt * 16) * 80, 80, 32, acc, fr, fq);
              ov[vt] = acc; ss += (acc.x * acc.x + acc.y * acc.y) + (acc.z * acc.z + acc.w * acc.w); }
          ss += __shfl_xor(ss, 16); ss += __shfl_xor(ss, 32);
          const float r = __builtin_amdgcn_rsqf(ss * (1.f / 64.f) + NORM_EPS);
#pragma unroll
          for (int vt = 0; vt < 4; ++vt) { const int col = hh * 64 + vt * 16 + 4 * fq; const f32x4 g = *(const f32x4*)(ng + col); const f32x4 og = UU4(t0 + t, U_GL_OG + col);
              MIX_ST4(mix, (size_t)(t0 + t) * D + 512 + col, ov[vt].x * r * g.x * siluf_(og.x), ov[vt].y * r * g.y * siluf_(og.y), ov[vt].z * r * g.z * siluf_(og.z), ov[vt].w * r * g.w * siluf_(og.w)); } } }
    __syncthreads();
}

__device__ __forceinline__ void mlstm_stage1(Frame& F, const Args& A, int layer, int b, int c) {
    const bf16* u = WSP(bf16, WS_U);
    LAS unsigned char* L = F.lds;
    LAS float* WST = (LAS float*)L; LAS unsigned char* KT = L + 1024; LAS unsigned char* VWT = KT + 256 * 144;
    const int t0 = b * SEQ + c * 64, tid = F.tid, lane = F.lane, wave = F.wave, fr = lane & 15, fq = lane >> 4;
    if (wave < 4) {
        const int hh = wave;
        const float ig = UU(t0 + lane, U_ML_I + hh) + KIN(I_MIB)[layer * 4 + hh];
        const float lf = logsigmoidf_(UU(t0 + lane, U_ML_F + hh) + KIN(I_MFB)[layer * 4 + hh]);
        const float bc = wave_scan_add(lf, lane); const float blast = __shfl(bc, 63);
        const float ast = blast - bc + ig; const float mloc = wave_max(ast);
        WST[hh * 64 + lane] = __expf(ast - mloc);
        if (lane == 0) { WSP(float, WS_ML_BL)[(b * 4 + hh) * NCH + c] = blast; WSP(float, WS_ML_ML)[(b * 4 + hh) * NCH + c] = mloc; }
    } else {
        const int kch = tid - 256, cc = 256 + kch; const float* cw = KIN(I_MCW) + (size_t)layer * 2048 + cc; const float w0 = cw[0], w1 = cw[512], w2 = cw[1024], w3 = cw[1536], cb = KIN(I_MCB)[layer * 512 + cc];
        const bf16* up = u + (size_t)t0 * NUP + U_ML_K + kch;
        float win0 = 0.f, win1 = 0.f, win2 = 0.f;
        if (c > 0) { win0 = bf2f(up[-3 * NUP]); win1 = bf2f(up[-2 * NUP]); win2 = bf2f(up[-1 * NUP]); }
#pragma unroll 1
        for (int l0 = 0; l0 < 64; l0 += 32) { float xv[32];
#pragma unroll
            for (int j = 0; j < 32; ++j) xv[j] = bf2f(up[(l0 + j) * NUP]);
#pragma unroll
            for (int j8 = 0; j8 < 4; ++j8) { float o[8];
#pragma unroll
                for (int j = 0; j < 8; ++j) { const float x = xv[j8 * 8 + j]; const float y = cb + w0 * win0 + w1 * win1 + w2 * win2 + w3 * x; win0 = win1; win1 = win2; win2 = x; o[j] = siluf_(y); }
                *(LAS v4u*)(KT + kch * 144 + (l0 + j8 * 8) * 2) = pack8(o); } }
    }
    __syncthreads();
    if (tid < 256) {
        const int vch = tid, hh = vch >> 6; const bf16* up = u + (size_t)t0 * NUP + U_ML_V + vch;
#pragma unroll 1
        for (int l0 = 0; l0 < 64; l0 += 32) { float xv[32];
#pragma unroll
            for (int j = 0; j < 32; ++j) xv[j] = bf2f(up[(l0 + j) * NUP]);
#pragma unroll
            for (int j8 = 0; j8 < 4; ++j8) { float o[8];
#pragma unroll
                for (int j = 0; j < 8; ++j) o[j] = xv[j8 * 8 + j] * WST[hh * 64 + l0 + j8 * 8 + j];
                *(LAS v4u*)(VWT + vch * 144 + (l0 + j8 * 8) * 2) = pack8(o); } }
    } else {
        const int kch = tid - 256, hh = kch >> 6; float n = 0.f;
#pragma unroll 8
        for (int s = 0; s < 64; ++s) n += WST[hh * 64 + s] * bf2f(*(const LAS unsigned short*)(KT + kch * 144 + s * 2));
        WSP(bf16, WS_ML_N)[((size_t)(b * 4 + hh) * NCH + c) * 64 + (kch & 63)] = (bf16)(cvt_pk_bf16(n, 0.f) & 0xffffu);
    }
    __syncthreads();
    { bf16* cst = WSP(bf16, WS_ML_C); const int hh = wave >> 1;
#pragma unroll 1
      for (int i = 0; i < 2; ++i) { const int vt = 2 * (wave & 1) + i;
#pragma unroll 1
          for (int kt = 0; kt < 4; ++kt) { f32x4 acc = {0.f, 0.f, 0.f, 0.f}; acc = mm16(VWT + (hh * 64 + vt * 16) * 144, 144, KT + (hh * 64 + kt * 16) * 144, 144, 64, acc, fr, fq);
              stb4(cst + (((size_t)(b * 4 + hh) * NCH + c) * 64 + vt * 16 + fr) * 64 + kt * 16 + 4 * fq, acc); } } }
    __syncthreads();
}
__device__ __forceinline__ void mlstm_stage3(Frame& F, const Args& A, int layer, int b, int c) {
    const bf16* u = WSP(bf16, WS_U);
    LAS unsigned char* L = F.lds;
    LAS float* BCU = (LAS float*)L; LAS float* GG = BCU + 256; LAS float* MROW = BCU + 512; LAS float* WINT = BCU + 768; LAS float* NPV = BCU + 1024;
    LAS unsigned char* Q = L + 6144; LAS unsigned char* KK = Q + 64 * 528; LAS unsigned char* VT = KK + 64 * 528; LAS unsigned char* SC = VT + 256 * 144;
    const int t0 = b * SEQ + c * 64, tid = F.tid, lane = F.lane, wave = F.wave, fr = lane & 15, fq = lane >> 4;
    if (wave < 4) {
        const int hh = wave;
        const float ig = UU(t0 + lane, U_ML_I + hh) + KIN(I_MIB)[layer * 4 + hh];
        const float lf = logsigmoidf_(UU(t0 + lane, U_ML_F + hh) + KIN(I_MFB)[layer * 4 + hh]);
        const float bc = wave_scan_add(lf, lane); const float gg = ig - bc;
        const float mprev = WSP(float, WS_ML_M)[(b * 4 + hh) * NCH + c];
        const float minter = bc + mprev, mintra = bc + wave_scan_max(gg, lane), mrow = fmaxf(minter, mintra);
        BCU[hh * 64 + lane] = bc; GG[hh * 64 + lane] = gg; MROW[hh * 64 + lane] = mrow; WINT[hh * 64 + lane] = __expf(minter - mrow);
        NPV[hh * 64 + lane] = bf2f(WSP(bf16, WS_ML_N)[((size_t)(b * 4 + hh) * NCH + c) * 64 + lane]);
    }
    {
        const int cc = tid; const float* cw = KIN(I_MCW) + (size_t)layer * 2048 + cc; const float w0 = cw[0], w1 = cw[512], w2 = cw[1024], w3 = cw[1536], cb = KIN(I_MCB)[layer * 512 + cc];
        const bf16* up = u + (size_t)t0 * NUP + U_ML_Q + cc;
        float win0 = 0.f, win1 = 0.f, win2 = 0.f;
        if (c > 0) { win0 = bf2f(up[-3 * NUP]); win1 = bf2f(up[-2 * NUP]); win2 = bf2f(up[-1 * NUP]); }
        LAS unsigned char* dst = cc < 256 ? Q + cc * 2 : KK + (cc - 256) * 2; const float sc = cc < 256 ? 0.125f : 1.0f;
#pragma unroll 1
        for (int l0 = 0; l0 < 64; l0 += 32) { float xv[32];
#pragma unroll
            for (int j = 0; j < 32; ++j) xv[j] = bf2f(up[(l0 + j) * NUP]);
#pragma unroll
            for (int j = 0; j < 32; ++j) { const float x = xv[j]; const float y = cb + w0 * win0 + w1 * win1 + w2 * win2 + w3 * x; win0 = win1; win1 = win2; win2 = x; lds_st_bf16(dst + (l0 + j) * 528, siluf_(y) * sc); } }
        const int vch = tid & 255, lh = (tid >> 8) * 32; const bf16* uv = u + (size_t)(t0 + lh) * NUP + U_ML_V + vch;
        float xv[32];
#pragma unroll
        for (int j = 0; j < 32; ++j) xv[j] = bf2f(uv[j * NUP]);
#pragma unroll
        for (int j8 = 0; j8 < 4; ++j8) { float o[8];
#pragma unroll
            for (int j = 0; j < 8; ++j) o[j] = xv[j8 * 8 + j];
            *(LAS v4u*)(VT + vch * 144 + (lh + j8 * 8) * 2) = pack8(o); }
    }
    __syncthreads();
    { const int hh = wave >> 1; bf16* mix = WSP(bf16, WS_MIX); const float* ng = KIN(I_MNG) + layer * 256;
      const bf16* cprev = WSP(bf16, WS_ML_C) + ((size_t)(b * 4 + hh) * NCH + c) * 4096;
      bf16x8 cf[4][2];
#pragma unroll
      for (int vt = 0; vt < 4; ++vt)
#pragma unroll
          for (int ks = 0; ks < 2; ++ks) cf[vt][ks] = *(const bf16x8*)(cprev + (size_t)(vt * 16 + fr) * 64 + ks * 32 + fq * 8);
#pragma unroll 1
      for (int i = 0; i < 2; ++i) { const int tt = 2 * (wave & 1) + i, t = tt * 16 + fr;
          const float bt = BCU[hh * 64 + t] - MROW[hh * 64 + t]; float rs = 0.f;
#pragma unroll
          for (int st = 0; st < 4; ++st) { f32x4 acc = {0.f, 0.f, 0.f, 0.f}; acc = mm16(Q + tt * 16 * 528 + hh * 128, 528, KK + st * 16 * 528 + hh * 128, 528, 64, acc, fr, fq);
              const int s0 = st * 16 + 4 * fq; float o[4];
#pragma unroll
              for (int j = 0; j < 4; ++j) { const int s = s0 + j; const float v = (t >= s) ? acc[j] * __expf(bt + GG[hh * 64 + s]) : 0.f; o[j] = v; rs += v; }
              lds_st_bf16x4(SC + hh * 9216 + t * 144 + s0 * 2, o[0], o[1], o[2], o[3]); }
          rs += __shfl_xor(rs, 16); rs += __shfl_xor(rs, 32);
          float nq = 0.f;
#pragma unroll
          for (int j = 0; j < 16; ++j) nq += bf2f(*(const LAS unsigned short*)(Q + t * 528 + (hh * 64 + fq * 16 + j) * 2)) * NPV[hh * 64 + fq * 16 + j];
          nq += __shfl_xor(nq, 16); nq += __shfl_xor(nq, 32);
          const float wi = WINT[hh * 64 + t]; const float den = wi * nq + rs; const float dn = fmaxf(fabsf(den), __expf(-MROW[hh * 64 + t])); const float rdn = 1.0f / dn;
          LDS_WAIT();
          f32x4 hv[4]; float sm = 0.f;
#pragma unroll
          for (int vt = 0; vt < 4; ++vt) { f32x4 acc = {0.f, 0.f, 0.f, 0.f};
              acc = mm16_rB<2>(Q + tt * 16 * 528 + hh * 128, 528, cf[vt], acc, fr, fq);
              acc = acc * wi;
              acc = mm16(SC + hh * 9216 + tt * 16 * 144, 144, VT + (hh * 64 + vt * 16) * 144, 144, 64, acc, fr, fq);
              const f32x4 og = UU4(t0 + t, U_ML_O + hh * 64 + vt * 16 + 4 * fq);
              f32x4 h; h.x = acc.x * rdn * sigmoidf_(og.x); h.y = acc.y * rdn * sigmoidf_(og.y); h.z = acc.z * rdn * sigmoidf_(og.z); h.w = acc.w * rdn * sigmoidf_(og.w);
              hv[vt] = h; sm += (h.x + h.y) + (h.z + h.w); }
          sm += __shfl_xor(sm, 16); sm += __shfl_xor(sm, 32);
          const float mean = sm * (1.f / 64.f); float sq = 0.f;
#pragma unroll
          for (int vt = 0; vt < 4; ++vt) { hv[vt] = hv[vt] - mean; sq += (hv[vt].x * hv[vt].x + hv[vt].y * hv[vt].y) + (hv[vt].z * hv[vt].z + hv[vt].w * hv[vt].w); }
          sq += __shfl_xor(sq, 16); sq += __shfl_xor(sq, 32);
          const float r = __builtin_amdgcn_rsqf(sq * (1.f / 64.f) + NORM_EPS);
#pragma unroll
          for (int vt = 0; vt < 4; ++vt) { const int col = hh * 64 + vt * 16 + 4 * fq; const f32x4 g = *(const f32x4*)(ng + col);
              MIX_ST4(mix, (size_t)(t0 + t) * D + 768 + col, hv[vt].x * r * g.x, hv[vt].y * r * g.y, hv[vt].z * r * g.z, hv[vt].w * r * g.w); } } }
    __syncthreads();
}

__device__ __forceinline__ void rwkv_stage1(Frame& F, const Args& A, int layer, int ub) {
    const bf16* u = WSP(bf16, WS_U);
    LAS unsigned char* L = F.lds;
    LAS unsigned char* LOWA = L;
    LAS float* CUM = (LAS float*)(L + 16384);
    LAS float* AAB = CUM;
    LAS float* TOT = CUM;
    LAS unsigned char* M0 = L + 16384 + 16640;
#define RM(i) (M0 + (i) * 9216)
    LAS float* GAMC = (LAS float*)(F.MISC + MW_GAMC);
    const int t0 = ub * 64, c = ub & 63, tid = F.tid, lane = F.lane, wave = F.wave;
    const float* mu = KIN(I_RMU) + layer * 896;
#ifndef RW_DUP
#define RW_DUP -1
#endif
#define RW_REP(k) for (int rep__ = 0; rep__ < ((RW_DUP == (k)) ? 2 : 1); ++rep__)
    RW_REP(0) {
    {
        const int l = tid >> 3, jq = tid & 7, t = t0 + l; const bool has_prev = (t & (SEQ - 1)) != 0;
        f32x4 cur[4], prv[4];
#pragma unroll
        for (int q = 0; q < 4; ++q) { cur[q] = UU4(t, U_RW_LO + jq * 16 + 4 * q); prv[q] = has_prev ? UU4(t - 1, U_RW_LO + jq * 16 + 4 * q) : (f32x4){0.f, 0.f, 0.f, 0.f}; }
#pragma unroll
        for (int q = 0; q < 4; ++q) { const f32x4 m4 = *(const f32x4*)(mu + 768 + jq * 16 + 4 * q); const f32x4 xs = cur[q] + (prv[q] - cur[q]) * m4; const int j = jq * 16 + 4 * q;
            f32x4 o;
            if (j < 32) { o.x = tanhf_(xs.x); o.y = tanhf_(xs.y); o.z = tanhf_(xs.z); o.w = tanhf_(xs.w); } else if (j < 64) o = xs; else { o.x = sigmoidf_(xs.x); o.y = sigmoidf_(xs.y); o.z = sigmoidf_(xs.z); o.w = sigmoidf_(xs.w); }
            if (j < 64) lds_st_bf16x4(LOWA + l * 144 + j * 2, o.x, o.y, o.z, o.w); else lds_st_bf16x4(RM(0) + l * 144 + (j - 64) * 2, o.x, o.y, o.z, o.w); }
    }
    __syncthreads();
    {
        bf16* RG = WSP(bf16, WS_RW_G); const int lane_ = F.lane, fr_ = lane_ & 15, fq_ = lane_ >> 4;
        const float* gupT = WSP(float, WS_LORA) + (size_t)layer * LORA_PER_LAYER + 16384;
#pragma unroll
        for (int ci = 0; ci < 2; ++ci) { const int ct = 2 * wave + ci; bf16x8 bf[2];
#pragma unroll
            for (int ks = 0; ks < 2; ++ks) bf[ks] = ldfrag_f32(gupT + (size_t)(ct * 16 + fr_) * 64 + ks * 32 + fq_ * 8);
#pragma unroll
            for (int tt = 0; tt < 4; ++tt) { f32x4 acc = {0.f, 0.f, 0.f, 0.f}; acc = mm16_rB<2>(RM(0) + tt * 16 * 144, 144, bf, acc, fr_, fq_);
                stb4(RG + (size_t)(t0 + tt * 16 + fr_) * 256 + ct * 16 + 4 * fq_, acc); } }
    }
    __syncthreads();
    }
    const int b_ = ub >> 6;
#pragma unroll 1
    for (int hh = 0; hh < 4; ++hh) {
        int ch = lane, fr = lane & 15, fq = lane >> 4; asm volatile("" : "+v"(ch), "+v"(fr), "+v"(fq));
        const int tg = wave, cg = hh * 64 + ch; const size_t un = (size_t)(b_ * 4 + hh) * NCH + c;
        float rr[8], k2r[8], vr[8], ar[8], br[8], pl[8];
        LAS float* WPA = (LAS float*)RM(8);
        {
            const int mat = wave >> 2, ct = wave & 3;
            const float* wT = WSP(float, WS_LORA) + (size_t)layer * LORA_PER_LAYER + mat * 8192 + (size_t)(hh * 64 + ct * 16 + fr) * 32 + fq * 8;
            bf16x8 bfw[1]; bfw[0] = ldfrag_f32(wT);
#pragma unroll
            for (int tt = 0; tt < 4; ++tt) { f32x4 acc = {0.f, 0.f, 0.f, 0.f}; acc = mm16_rB<1>(LOWA + tt * 16 * 144 + mat * 64, 144, bfw, acc, fr, fq);
                *(LAS f32x4*)(WPA + mat * 4096 + (tt * 16 + fr) * 64 + ct * 16 + 4 * fq) = acc; }
        }
        __syncthreads();
        RW_REP(1) {
            const float w0 = KIN(I_RW0)[layer * 256 + cg], a0 = KIN(I_RA0)[layer * 256 + cg], kkc = KIN(I_RKK)[layer * 256 + cg], kac = KIN(I_RKA)[layer * 256 + cg];
            const float mur = mu[cg], muk = mu[256 + cg], muv = mu[512 + cg];
            const int tb = t0 + tg * 8; const bool nop = (c == 0) && (tg == 0);
            float rp = nop ? 0.f : UU(tb - 1, U_RW_R + cg), kp = nop ? 0.f : UU(tb - 1, U_RW_K + cg), vp = nop ? 0.f : UU(tb - 1, U_RW_V + cg);
            float rc[8], kc[8], vc[8];
#pragma unroll
            for (int j = 0; j < 8; ++j) { rc[j] = UU(tb + j, U_RW_R + cg); kc[j] = UU(tb + j, U_RW_K + cg); vc[j] = UU(tb + j, U_RW_V + cg); }
            bf16* RW = WSP(bf16, WS_RW);
            float kk[8], al[8], n2[8], run = 0.f;
#pragma unroll
            for (int j = 0; j < 8; ++j) { const int l = tg * 8 + j;
                const float r = rc[j] + (rp - rc[j]) * mur, k = kc[j] + (kp - kc[j]) * muk, v = vc[j] + (vp - vc[j]) * muv; rp = rc[j]; kp = kc[j]; vp = vc[j];
                const float wp = w0 + WPA[l * 64 + ch], ap = a0 + WPA[4096 + l * 64 + ch];
                const float w = -softplusf_(-wp) - 0.5f; run += -__expf(w); pl[j] = run; al[j] = sigmoidf_(ap);
                kk[j] = k * kkc; n2[j] = kk[j] * kk[j];
                k2r[j] = k * (1.0f + (al[j] - 1.0f) * kac); rr[j] = r; vr[j] = v;
                bf16* o = RW + (size_t)(tb + j) * 768 + cg; o[0] = (bf16)(cvt_pk_bf16(r, 0.f) & 0xffffu); o[256] = (bf16)(cvt_pk_bf16(k2r[j], 0.f) & 0xffffu); o[512] = (bf16)(cvt_pk_bf16(v, 0.f) & 0xffffu); }
#pragma unroll
            for (int i = 0; i < 4; ++i) { const bool hi = (ch & 32) != 0; const float keep = hi ? n2[i + 4] : n2[i], send = hi ? n2[i] : n2[i + 4]; n2[i] = keep + __shfl_xor(send, 32); }
#pragma unroll
            for (int i = 0; i < 2; ++i) { const bool hi = (ch & 16) != 0; const float keep = hi ? n2[i + 2] : n2[i], send = hi ? n2[i] : n2[i + 2]; n2[i] = keep + __shfl_xor(send, 16); }
            { const bool hi = (ch & 8) != 0; const float keep = hi ? n2[1] : n2[0], send = hi ? n2[0] : n2[1]; n2[0] = keep + __shfl_xor(send, 8); }
            n2[0] += __shfl_xor(n2[0], 4); n2[0] += __shfl_xor(n2[0], 2); n2[0] += __shfl_xor(n2[0], 1);
#pragma unroll
            for (int j = 0; j < 8; ++j) { const float tot = __builtin_bit_cast(float, __builtin_amdgcn_readlane(__builtin_bit_cast(int, n2[0]), ((j & 4) ? 32 : 0) + ((j & 2) ? 16 : 0) + ((j & 1) ? 8 : 0)));
                const float kkn = kk[j] / fmaxf(sqrtf(tot), 1e-12f); ar[j] = -kkn; br[j] = kkn * al[j]; }
            TOT[tg * 64 + ch] = run;
        }
        __syncthreads();
        RW_REP(3) {
            float off = 0.f, gC = 0.f;
#pragma unroll
            for (int g = 0; g < 8; ++g) { const float tv = TOT[g * 64 + ch]; gC += tv; if (g < tg) off += tv; }
            float oat[8], obb[8], okb[8], ov[8];
#pragma unroll
            for (int j = 0; j < 8; ++j) { const int l = tg * 8 + j; const float gt = off + pl[j], gm = j > 0 ? off + pl[j - 1] : off;
                const float at = ar[j] * __expf(gm), rt = rr[j] * __expf(gt), en = __expf(-gt), ec = __expf(gC - gt);
                lds_st_bf16(RM(0) + l * 144 + ch * 2, at); lds_st_bf16(RM(1) + l * 144 + ch * 2, rt); lds_st_bf16(RM(2) + l * 144 + ch * 2, br[j] * en); lds_st_bf16(RM(3) + l * 144 + ch * 2, k2r[j] * en);
                oat[j] = at; obb[j] = br[j] * ec; okb[j] = k2r[j] * ec; ov[j] = vr[j]; }
            *(LAS v4u*)(RM(4) + ch * 144 + tg * 16) = pack8(oat); *(LAS v4u*)(RM(5) + ch * 144 + tg * 16) = pack8(obb); *(LAS v4u*)(RM(6) + ch * 144 + tg * 16) = pack8(okb); *(LAS v4u*)(RM(7) + ch * 144 + tg * 16) = pack8(ov);
            if (tg == 0) GAMC[ch] = __expf(gC);
        }
        __syncthreads();
        RW_REP(4) {
            const int which = wave >> 1; const LAS unsigned char* Aop = which < 2 ? RM(0) : RM(1); const LAS unsigned char* Bop = (which & 1) ? RM(3) : RM(2);
#pragma unroll 1
            for (int i2 = 0; i2 < 2; ++i2) { const int tt = 2 * (wave & 1) + i2, t = tt * 16 + fr;
#pragma unroll
                for (int it = 0; it < 4; ++it) { f32x4 acc = {0.f, 0.f, 0.f, 0.f}; acc = mm16(Aop + tt * 16 * 144, 144, Bop + it * 16 * 144, 144, 64, acc, fr, fq);
                    const int i0 = it * 16 + 4 * fq; const int lim = which < 2 ? t : t + 1;
                    const float o0 = (i0 < lim) ? acc[0] : 0.f, o1 = (i0 + 1 < lim) ? acc[1] : 0.f, o2 = (i0 + 2 < lim) ? acc[2] : 0.f, o3 = (i0 + 3 < lim) ? acc[3] : 0.f;
#ifdef RW_CLAMP_AAK
                    float q0 = o0, q1 = o1, q2 = o2, q3 = o3;
                    if (which == 1) { q0 = fabsf(o0) < 1e30f ? o0 : 0.f; q1 = fabsf(o1) < 1e30f ? o1 : 0.f; q2 = fabsf(o2) < 1e30f ? o2 : 0.f; q3 = fabsf(o3) < 1e30f ? o3 : 0.f; }
                    if (which == 0) *(LAS f32x4*)(AAB + t * 64 + i0) = (f32x4){o0, o1, o2, o3};
                    else lds_st_bf16x4(RM(7 + which) + t * 144 + i0 * 2, q0, q1, q2, q3);
                    continue;
#endif
                    if (which == 0) { DBG_STAT(11, o0); DBG_STAT(11, o1); DBG_STAT(11, o2); DBG_STAT(11, o3); } if (which == 1) { DBG_STAT(12, o0); DBG_STAT(12, o1); DBG_STAT(12, o2); DBG_STAT(12, o3); } if (which == 2) { DBG_STAT(13, o0); DBG_STAT(13, o3); } if (which == 3) { DBG_STAT(14, o0); DBG_STAT(14, o3); }
                    if (which == 0) *(LAS f32x4*)(AAB + t * 64 + i0) = (f32x4){o0, o1, o2, o3};
                    else lds_st_bf16x4(RM(7 + which) + t * 144 + i0 * 2, o0, o1, o2, o3); } }
        }
        __syncthreads();
        RW_REP(5) {
#pragma unroll 1
            for (int i2 = 0; i2 < 2; ++i2) { const int idx = wave * 2 + i2, vt = idx >> 2, tt = idx & 3; f32x4 acc = {0.f, 0.f, 0.f, 0.f};
                acc = mm16(RM(7) + vt * 16 * 144, 144, RM(8) + tt * 16 * 144, 144, 64, acc, fr, fq);
                DBG_STAT(15, acc[0]); DBG_STAT(15, acc[1]); DBG_STAT(15, acc[2]); DBG_STAT(15, acc[3]);
                lds_st_bf16x4(RM(0) + (vt * 16 + fr) * 144 + (tt * 16 + 4 * fq) * 2, acc[0], acc[1], acc[2], acc[3]); }
        }
#if RW_SOLVE_BLK
        LAS unsigned char* T11T = L + 143616;
        LAS unsigned char* YT = RM(8);
        RW_REP(8) if (wave < 2) {
            const int R0 = wave * 32; float x[32]; f32x4 rowq[8];
#pragma unroll
            for (int tl = 0; tl < 32; ++tl) {
                f32x4 cur[8];
#pragma unroll
                for (int i4 = 0; i4 < (tl + 3) / 4; ++i4) cur[i4] = rowq[i4];
                if (tl + 1 < 32) {
#pragma unroll
                    for (int i4 = 0; i4 < (tl + 4) / 4; ++i4) rowq[i4] = *(const LAS f32x4*)(AAB + (R0 + tl + 1) * 64 + R0 + 4 * i4); }
                float a0 = (R0 + tl == ch) ? 1.0f : 0.f, a1 = 0.f, a2 = 0.f, a3 = 0.f;
#pragma unroll
                for (int i4 = 0; i4 < (tl + 3) / 4; ++i4) { const f32x4 q = cur[i4];
                    a0 += q.x * x[4 * i4]; if (4 * i4 + 1 < tl) a1 += q.y * x[4 * i4 + 1]; if (4 * i4 + 2 < tl) a2 += q.z * x[4 * i4 + 2]; if (4 * i4 + 3 < tl) a3 += q.w * x[4 * i4 + 3]; }
                const float acc = (a0 + a1) + (a2 + a3);
                x[tl] = acc; if (wave == 0 || ch >= 32) lds_st_bf16(RM(11) + (R0 + tl) * 144 + ch * 2, acc); }
            if (wave == 0 && ch < 32) {
#pragma unroll
                for (int q = 0; q < 4; ++q) { const float xv[8] = {x[8 * q], x[8 * q + 1], x[8 * q + 2], x[8 * q + 3], x[8 * q + 4], x[8 * q + 5], x[8 * q + 6], x[8 * q + 7]}; *(LAS v4u*)(T11T + ch * 80 + q * 16) = pack8(xv); } }
        }
        __syncthreads();
        if (wave < 4) {
            const int jt = wave >> 1, it = wave & 1; bf16x8 bfa[1];
            { const LAS float* ap = AAB + (32 + it * 16 + fr) * 64 + 8 * fq; const f32x4 p0 = *(const LAS f32x4*)ap, p1 = *(const LAS f32x4*)(ap + 4);
              v4u w; w.x = cvt_pk_bf16(p0.x, p0.y); w.y = cvt_pk_bf16(p0.z, p0.w); w.z = cvt_pk_bf16(p1.x, p1.y); w.w = cvt_pk_bf16(p1.z, p1.w); bfa[0] = __builtin_bit_cast(bf16x8, w); }
            f32x4 acc = {0.f, 0.f, 0.f, 0.f}; acc = mm16_rB<1>(T11T + jt * 16 * 80, 80, bfa, acc, fr, fq);
            lds_st_bf16x4(YT + (jt * 16 + fr) * 80 + (it * 16 + 4 * fq) * 2, acc[0], acc[1], acc[2], acc[3]);
        }
        __syncthreads();
        if (wave < 4) {
            const int it = wave >> 1, jt = wave & 1;
            f32x4 acc = {0.f, 0.f, 0.f, 0.f}; acc = mm16(RM(11) + (32 + it * 16) * 144 + 64, 144, YT + jt * 16 * 80, 80, 32, acc, fr, fq);
            lds_st_bf16x4(RM(11) + (32 + it * 16 + fr) * 144 + (jt * 16 + 4 * fq) * 2, acc[0], acc[1], acc[2], acc[3]);
        }
        __syncthreads();
#else
        RW_REP(8) if (wave == 0) {
            float x[64]; f32x4 rowq[16];
#pragma unroll
            for (int t = 0; t < 64; ++t) {
                f32x4 cur[16];
#pragma unroll
                for (int i4 = 0; i4 < (t + 3) / 4; ++i4) cur[i4] = rowq[i4];
                if (t + 1 < 64) {
#pragma unroll
                    for (int i4 = 0; i4 < (t + 4) / 4; ++i4) rowq[i4] = *(const LAS f32x4*)(AAB + (t + 1) * 64 + 4 * i4); }
                float a0 = (t == ch) ? 1.0f : 0.f, a1 = 0.f, a2 = 0.f, a3 = 0.f;
#pragma unroll
                for (int i4 = 0; i4 < (t + 3) / 4; ++i4) { const f32x4 q = cur[i4];
                    a0 += q.x * x[4 * i4]; if (4 * i4 + 1 < t) a1 += q.y * x[4 * i4 + 1]; if (4 * i4 + 2 < t) a2 += q.z * x[4 * i4 + 2]; if (4 * i4 + 3 < t) a3 += q.w * x[4 * i4 + 3]; }
                const float acc = (a0 + a1) + (a2 + a3);
                x[t] = acc; lds_st_bf16(RM(11) + t * 144 + ch * 2, acc); }
        }
        __syncthreads();
#endif
        RW_REP(6) {
            const int rt = wave >> 1;
#pragma unroll
            for (int i2 = 0; i2 < 2; ++i2) { const int tt = 2 * (wave & 1) + i2;
                f32x4 acc = {0.f, 0.f, 0.f, 0.f}; acc = mm16(RM(4) + rt * 16 * 144, 144, RM(11) + tt * 16 * 144, 144, 64, acc, fr, fq);
                DBG_STAT(17, acc[0]); DBG_STAT(17, acc[1]); DBG_STAT(17, acc[2]); DBG_STAT(17, acc[3]);
                lds_st_bf16x4(RM(2) + (rt * 16 + fr) * 144 + (tt * 16 + 4 * fq) * 2, acc[0], acc[1], acc[2], acc[3]);
                f32x4 ac2 = {0.f, 0.f, 0.f, 0.f}; ac2 = mm16(RM(0) + rt * 16 * 144, 144, RM(11) + tt * 16 * 144, 144, 64, ac2, fr, fq);
                DBG_STAT(18, ac2[0]); DBG_STAT(18, ac2[1]); DBG_STAT(18, ac2[2]); DBG_STAT(18, ac2[3]);
                lds_st_bf16x4(RM(3) + (rt * 16 + fr) * 144 + (tt * 16 + 4 * fq) * 2, ac2[0], ac2[1], ac2[2], ac2[3]); }
        }
        __syncthreads();
        RW_REP(7) {
            const int which = wave >> 1;
#pragma unroll 1
            for (int i2 = 0; i2 < 2; ++i2) { const int rt = 2 * (wave & 1) + i2, row = rt * 16 + fr;
#pragma unroll
                for (int ct = 0; ct < 4; ++ct) { f32x4 acc = {0.f, 0.f, 0.f, 0.f}; const int c0 = ct * 16 + 4 * fq;
                    if (which == 0) { acc = mm16(RM(9) + rt * 16 * 144, 144, RM(2) + ct * 16 * 144, 144, 64, acc, fr, fq);
                        const v2u rw = *(const LAS v2u*)(RM(1) + row * 144 + c0 * 2);
                        acc[0] += __uint_as_float(rw.x << 16); acc[1] += __uint_as_float(rw.x & 0xffff0000u); acc[2] += __uint_as_float(rw.y << 16); acc[3] += __uint_as_float(rw.y & 0xffff0000u);
                        DBG_STAT(19, acc[0]); DBG_STAT(19, acc[1]); DBG_STAT(19, acc[2]); DBG_STAT(19, acc[3]);
                        v2u o; o.x = cvt_pk_bf16(acc[0], acc[1]); o.y = cvt_pk_bf16(acc[2], acc[3]); *(v2u*)(WSP(bf16, WS_RW_RH) + un * 4096 + row * 64 + c0) = o; }
                    else if (which == 1) {
#ifndef RW_NO_U0
                        acc = mm16(RM(9) + rt * 16 * 144, 144, RM(3) + ct * 16 * 144, 144, 64, acc, fr, fq);
#endif
                        acc = mm16(RM(10) + rt * 16 * 144, 144, RM(7) + ct * 16 * 144, 144, 64, acc, fr, fq);
                        DBG_STAT(20, acc[0]); DBG_STAT(20, acc[1]); DBG_STAT(20, acc[2]); DBG_STAT(20, acc[3]);
                        stb4(WSP(bf16, WS_RW_O0) + un * 4096 + row * 64 + c0, acc); }
                    else if (which == 2) { acc = mm16(RM(5) + rt * 16 * 144, 144, RM(2) + ct * 16 * 144, 144, 64, acc, fr, fq);
                        const float gd = GAMC[row]; if (row == c0) acc[0] += gd; if (row == c0 + 1) acc[1] += gd; if (row == c0 + 2) acc[2] += gd; if (row == c0 + 3) acc[3] += gd;
                        DBG_STAT(21, acc[0]); DBG_STAT(21, acc[1]); DBG_STAT(21, acc[2]); DBG_STAT(21, acc[3]);
                        v2u o; o.x = cvt_pk_bf16(acc[0], acc[1]); o.y = cvt_pk_bf16(acc[2], acc[3]);
                        *(v2u*)((unsigned char*)(WSP(bf16, WS_RW_GF) + un * 4096) + ((rt * 2 + (ct >> 1)) * 64 + ch) * 16 + (ct & 1) * 8) = o; }
                    else { acc = mm16(RM(3) + rt * 16 * 144, 144, RM(5) + ct * 16 * 144, 144, 64, acc, fr, fq); acc = mm16(RM(7) + rt * 16 * 144, 144, RM(6) + ct * 16 * 144, 144, 64, acc, fr, fq);
                        DBG_STAT(22, acc[0]); DBG_STAT(22, acc[1]); DBG_STAT(22, acc[2]); DBG_STAT(22, acc[3]);
                        *(f32x4*)(WSP(float, WS_RW_HT) + un * 4096 + row * 64 + c0) = acc; } } }
        }
        __syncthreads();
    }
#undef RM
}
#if RW_SCAN_DMA
__device__ __forceinline__ void rwkv_scan_wave(Frame& F, const Args& A, int wslot) {
    const int lane = F.lane, fr = lane & 15, fq = lane >> 4, bh = wslot >> 2, v0 = (wslot & 3) * 16;
    const unsigned char* GFb = (const unsigned char*)(WSP(bf16, WS_RW_GF) + (size_t)bh * NCH * 4096) + lane * 16;
    const unsigned char* HTb = (const unsigned char*)(WSP(float, WS_RW_HT) + (size_t)bh * NCH * 4096 + (size_t)(v0 + fr) * 64 + 4 * fq);
    bf16* PT = WSP(bf16, WS_RW_PT) + (size_t)bh * NCH * 4096 + (size_t)(v0 + fr) * 64 + 4 * fq;
    LAS unsigned char* ring = F.lds;
    f32x4 P[4] = {{0.f, 0.f, 0.f, 0.f}, {0.f, 0.f, 0.f, 0.f}, {0.f, 0.f, 0.f, 0.f}, {0.f, 0.f, 0.f, 0.f}};
#define RW2_ISSUE(cc, sl) do { _Pragma("unroll") for (int f_ = 0; f_ < 8; ++f_) __builtin_amdgcn_global_load_lds((const unsigned*)(GFb + (size_t)(cc) * 8192 + f_ * 1024), (LAS unsigned*)(ring + (sl) * 12288 + f_ * 1024), 16, 0, 0); \
        _Pragma("unroll") for (int m_ = 0; m_ < 4; ++m_) __builtin_amdgcn_global_load_lds((const unsigned*)(HTb + (size_t)(cc) * 16384 + m_ * 64), (LAS unsigned*)(ring + (sl) * 12288 + 8192 + m_ * 1024), 16, 0, 0); } while (0)
#define RW2_STEP(cc, sl, NW) do { asm volatile("s_waitcnt vmcnt(" #NW ")" ::: "memory"); \
        const LAS unsigned char* sp_ = ring + (sl) * 12288 + lane * 16; bf16x8 gx[4][2]; f32x4 hx[4]; \
        _Pragma("unroll") for (int m = 0; m < 4; ++m) { hx[m] = *(const LAS f32x4*)(sp_ + 8192 + m * 1024); _Pragma("unroll") for (int s = 0; s < 2; ++s) gx[m][s] = *(const LAS bf16x8*)(sp_ + (m * 2 + s) * 1024); } \
        v4u bs[2]; \
        _Pragma("unroll") for (int s = 0; s < 2; ++s) { bs[s].x = cvt_pk_bf16(P[2 * s][0], P[2 * s][1]); bs[s].y = cvt_pk_bf16(P[2 * s][2], P[2 * s][3]); bs[s].z = cvt_pk_bf16(P[2 * s + 1][0], P[2 * s + 1][1]); bs[s].w = cvt_pk_bf16(P[2 * s + 1][2], P[2 * s + 1][3]); } \
        *(v2u*)(PT + (size_t)(cc) * 4096) = (v2u){bs[0].x, bs[0].y}; *(v2u*)(PT + (size_t)(cc) * 4096 + 16) = (v2u){bs[0].z, bs[0].w}; \
        *(v2u*)(PT + (size_t)(cc) * 4096 + 32) = (v2u){bs[1].x, bs[1].y}; *(v2u*)(PT + (size_t)(cc) * 4096 + 48) = (v2u){bs[1].z, bs[1].w}; \
        _Pragma("unroll") for (int m = 0; m < 4; ++m) { f32x4 acc = hx[m]; acc = __builtin_amdgcn_mfma_f32_16x16x32_bf16(gx[m][0], __builtin_bit_cast(bf16x8, bs[0]), acc, 0, 0, 0); \
            acc = __builtin_amdgcn_mfma_f32_16x16x32_bf16(gx[m][1], __builtin_bit_cast(bf16x8, bs[1]), acc, 0, 0, 0); P[m] = acc; } \
        asm volatile("s_waitcnt lgkmcnt(0)" ::: "memory"); } while (0)
    RW2_ISSUE(0, 0); RW2_ISSUE(1, 1); RW2_ISSUE(2, 2);
    RW2_ISSUE(3, 3); RW2_STEP(0, 0, 36); RW2_ISSUE(4, 0); RW2_STEP(1, 1, 40); RW2_ISSUE(5, 1); RW2_STEP(2, 2, 44); RW2_ISSUE(6, 2); RW2_STEP(3, 3, 48);
#pragma unroll 1
    for (int c = 4; c < 60; c += 4) {
        RW2_ISSUE(c + 3, 3); RW2_STEP(c, 0, 48); RW2_ISSUE(c + 4, 0); RW2_STEP(c + 1, 1, 48); RW2_ISSUE(c + 5, 1); RW2_STEP(c + 2, 2, 48); RW2_ISSUE(c + 6, 2); RW2_STEP(c + 3, 3, 48);
    }
    RW2_ISSUE(63, 3); RW2_STEP(60, 0, 48); RW2_STEP(61, 1, 36); RW2_STEP(62, 2, 24); RW2_STEP(63, 3, 12);
#undef RW2_ISSUE
#undef RW2_STEP
}
#else
__device__ __forceinline__ void rwkv_scan_wave(Frame& F, const Args& A, int wslot) {
    const int lane = F.lane, fr = lane & 15, fq = lane >> 4, bh = wslot >> 2, v0 = (wslot & 3) * 16;
    const bf16* GF = WSP(bf16, WS_RW_GF) + (size_t)bh * NCH * 4096; const float* HT = WSP(float, WS_RW_HT) + (size_t)bh * NCH * 4096 + (size_t)(v0 + fr) * 64 + 4 * fq;
    bf16* PT = WSP(bf16, WS_RW_PT) + (size_t)bh * NCH * 4096 + (size_t)(v0 + fr) * 64 + 4 * fq;
    f32x4 P[4] = {{0.f, 0.f, 0.f, 0.f}, {0.f, 0.f, 0.f, 0.f}, {0.f, 0.f, 0.f, 0.f}, {0.f, 0.f, 0.f, 0.f}};
    bf16x8 g0[4][2], g1[4][2], g2[4][2]; f32x4 h0[4], h1[4], h2[4];
#define RW2_LOAD(gx, hx, cc) do { _Pragma("unroll") for (int m = 0; m < 4; ++m) { hx[m] = *(const f32x4*)(HT + (size_t)(cc) * 4096 + 16 * m); \
        _Pragma("unroll") for (int s = 0; s < 2; ++s) gx[m][s] = *(const bf16x8*)(GF + (size_t)(cc) * 4096 + ((m * 2 + s) * 64 + lane) * 8); } } while (0)
#define RW2_STEP(gx, hx, cc) do { v4u bs[2]; \
        _Pragma("unroll") for (int s = 0; s < 2; ++s) { bs[s].x = cvt_pk_bf16(P[2 * s][0], P[2 * s][1]); bs[s].y = cvt_pk_bf16(P[2 * s][2], P[2 * s][3]); bs[s].z = cvt_pk_bf16(P[2 * s + 1][0], P[2 * s + 1][1]); bs[s].w = cvt_pk_bf16(P[2 * s + 1][2], P[2 * s + 1][3]); } \
        *(v2u*)(PT + (size_t)(cc) * 4096) = (v2u){bs[0].x, bs[0].y}; *(v2u*)(PT + (size_t)(cc) * 4096 + 16) = (v2u){bs[0].z, bs[0].w}; \
        *(v2u*)(PT + (size_t)(cc) * 4096 + 32) = (v2u){bs[1].x, bs[1].y}; *(v2u*)(PT + (size_t)(cc) * 4096 + 48) = (v2u){bs[1].z, bs[1].w}; \
        _Pragma("unroll") for (int m = 0; m < 4; ++m) { f32x4 acc = hx[m]; acc = __builtin_amdgcn_mfma_f32_16x16x32_bf16(gx[m][0], __builtin_bit_cast(bf16x8, bs[0]), acc, 0, 0, 0); \
            acc = __builtin_amdgcn_mfma_f32_16x16x32_bf16(gx[m][1], __builtin_bit_cast(bf16x8, bs[1]), acc, 0, 0, 0); P[m] = acc; } } while (0)
    RW2_LOAD(g0, h0, 0); RW2_LOAD(g1, h1, 1);
#pragma unroll 1
    for (int c = 0; c < 63; c += 3) {
        RW2_LOAD(g2, h2, c + 2); RW2_STEP(g0, h0, c);
        RW2_LOAD(g0, h0, c + 3); RW2_STEP(g1, h1, c + 1);
        if (c + 4 < NCH) RW2_LOAD(g1, h1, c + 4);
        RW2_STEP(g2, h2, c + 2);
    }
    RW2_STEP(g0, h0, 63);
#undef RW2_LOAD
#undef RW2_STEP
}
#endif
__device__ __forceinline__ void rwkv_stage3(Frame& F, const Args& A, int layer, int ub) {
    const int t0 = ub * 64, b_ = ub >> 6, c = ub & 63, lane = F.lane, wave = F.wave, fr = lane & 15, fq = lane >> 4, hh = wave >> 1;
    const size_t un = (size_t)(b_ * 4 + hh) * NCH + c;
    const bf16* RH = WSP(bf16, WS_RW_RH) + un * 4096; const bf16* PT = WSP(bf16, WS_RW_PT) + un * 4096; const bf16* O0 = WSP(bf16, WS_RW_O0) + un * 4096;
    const bf16* RW = WSP(bf16, WS_RW); const bf16* RG = WSP(bf16, WS_RW_G); bf16* mix = WSP(bf16, WS_MIX);
    const float* lg = KIN(I_RLNG) + layer * 256 + hh * 64; const float* lb = KIN(I_RLNB) + layer * 256 + hh * 64; const float* rk = KIN(I_RRK) + layer * 256 + hh * 64;
    bf16x8 pfr[4][2];
#pragma unroll
    for (int vt = 0; vt < 4; ++vt)
#pragma unroll
        for (int ks = 0; ks < 2; ++ks) pfr[vt][ks] = *(const bf16x8*)(PT + (size_t)(vt * 16 + fr) * 64 + ks * 32 + fq * 8);
#pragma unroll 1
    for (int i = 0; i < 2; ++i) { const int tt = 2 * (wave & 1) + i, tl = tt * 16 + fr, t = t0 + tl;
        const bf16x8 ra0 = *(const bf16x8*)(RH + (size_t)tl * 64 + fq * 8), ra1 = *(const bf16x8*)(RH + (size_t)tl * 64 + 32 + fq * 8);
        f32x4 ov[4]; float sm = 0.f;
#pragma unroll
        for (int vt = 0; vt < 4; ++vt) { f32x4 acc = ldb4(O0 + tl * 64 + vt * 16 + 4 * fq);
            acc = __builtin_amdgcn_mfma_f32_16x16x32_bf16(pfr[vt][0], ra0, acc, 0, 0, 0); acc = __builtin_amdgcn_mfma_f32_16x16x32_bf16(pfr[vt][1], ra1, acc, 0, 0, 0);
            ov[vt] = acc; DBG_STAT(24, acc[0]); DBG_STAT(24, acc[1]); DBG_STAT(24, acc[2]); DBG_STAT(24, acc[3]); sm += (acc.x + acc.y) + (acc.z + acc.w); }
        sm += __shfl_xor(sm, 16); sm += __shfl_xor(sm, 32);
        const float mean = sm * (1.f / 64.f); float sq = 0.f;
#pragma unroll
        for (int vt = 0; vt < 4; ++vt) { ov[vt] = ov[vt] - mean; sq += (ov[vt].x * ov[vt].x + ov[vt].y * ov[vt].y) + (ov[vt].z * ov[vt].z + ov[vt].w * ov[vt].w); }
        sq += __shfl_xor(sq, 16); sq += __shfl_xor(sq, 32);
        const float rs = __builtin_amdgcn_rsqf(sq * (1.f / 64.f) + RWKV_GN_EPS);
        float bd = 0.f;
#pragma unroll
        for (int q = 0; q < 4; ++q) { const f32x4 r4 = ldb4(RW + (size_t)t * 768 + hh * 64 + fq * 16 + 4 * q), k4 = ldb4(RW + (size_t)t * 768 + 256 + hh * 64 + fq * 16 + 4 * q), c4 = *(const f32x4*)(rk + fq * 16 + 4 * q);
            bd += (r4.x * k4.x * c4.x + r4.y * k4.y * c4.y) + (r4.z * k4.z * c4.z + r4.w * k4.w * c4.w); }
        bd += __shfl_xor(bd, 16); bd += __shfl_xor(bd, 32);
#pragma unroll
        for (int vt = 0; vt < 4; ++vt) { const int col = vt * 16 + 4 * fq; const f32x4 g4 = *(const f32x4*)(lg + col), b4 = *(const f32x4*)(lb + col);
            const f32x4 v4 = ldb4(RW + (size_t)t * 768 + 512 + hh * 64 + col), gg = ldb4(RG + (size_t)t * 256 + hh * 64 + col);
            float e0 = (ov[vt].x * rs * g4.x + b4.x + bd * v4.x) * gg.x, e1 = (ov[vt].y * rs * g4.y + b4.y + bd * v4.y) * gg.y, e2 = (ov[vt].z * rs * g4.z + b4.z + bd * v4.z) * gg.z, e3 = (ov[vt].w * rs * g4.w + b4.w + bd * v4.w) * gg.w;
#ifdef RW_SANITIZE
            e0 = (fabsf(e0) < 1e30f) ? e0 : 0.f; e1 = (fabsf(e1) < 1e30f) ? e1 : 0.f; e2 = (fabsf(e2) < 1e30f) ? e2 : 0.f; e3 = (fabsf(e3) < 1e30f) ? e3 : 0.f;
#endif
            MIX_ST4(mix, (size_t)t * D + 256 + hh * 64 + col, e0, e1, e2, e3); } }
}

constexpr int SCAN_N_MAIN = 16 * 64 * 128 / 2 + 16 * 32 * 64 / 2 + 16 * 64 * 64 / 2, SCAN_N_ALL = SCAN_N_MAIN + 16 * 64 / 2;
__device__ __forceinline__ void scans_elementwise(Frame& F, const Args& A, int gt, int nthr, int lo, int hi) {
    constexpr int N_SSD = 16 * 64 * 128 / 2, N_GLA = 16 * 32 * 64 / 2, N_MLC = 16 * 64 * 64 / 2, N_MLN = 16 * 64 / 2;
    for (int i = lo + gt; i < hi; i += nthr) {
        if (i < N_SSD) { const int bh = i >> 12, pn = (i & 4095) * 2; unsigned* base = (unsigned*)(WSP(bf16, WS_SSD_ST) + (size_t)bh * NCH * 8192 + pn); const float* dec = WSP(float, WS_SSD_DEC) + bh * NCH; float S0 = 0.f, S1 = 0.f;
#pragma unroll 1
            for (int c0 = 0; c0 < NCH; c0 += 32) { unsigned x[32]; float dd[32];
#pragma unroll
                for (int j = 0; j < 32; ++j) { x[j] = base[(size_t)(c0 + j) * 4096]; dd[j] = dec[c0 + j]; }
#pragma unroll
                for (int j = 0; j < 32; ++j) { base[(size_t)(c0 + j) * 4096] = cvt_pk_bf16(S0, S1); S0 = dd[j] * S0 + __uint_as_float(x[j] << 16); S1 = dd[j] * S1 + __uint_as_float(x[j] & 0xffff0000u); } }
        } else if (i < N_SSD + N_GLA) { const int k = i - N_SSD, bh = k >> 10, dv = (k & 1023) * 2, dd_ = dv >> 6, b = bh >> 2, hh = bh & 3; unsigned* base = (unsigned*)(WSP(bf16, WS_GLA_ST) + (size_t)bh * NCH * 2048 + dv); const float* dec = WSP(float, WS_GLA_DEC) + (size_t)b * NCH * 128 + hh * 32 + dd_; float S0 = 0.f, S1 = 0.f;
#pragma unroll 1
            for (int c0 = 0; c0 < NCH; c0 += 32) { unsigned x[32]; float dd[32];
#pragma unroll
                for (int j = 0; j < 32; ++j) { x[j] = base[(size_t)(c0 + j) * 1024]; dd[j] = dec[(c0 + j) * 128]; }
#pragma unroll
                for (int j = 0; j < 32; ++j) { base[(size_t)(c0 + j) * 1024] = cvt_pk_bf16(S0, S1); S0 = dd[j] * S0 + __uint_as_float(x[j] << 16); S1 = dd[j] * S1 + __uint_as_float(x[j] & 0xffff0000u); } }
        } else { const int k = i - N_SSD - N_GLA; const bool isn = k >= N_MLC; const int kk = isn ? k - N_MLC : k; const int bh = isn ? (kk >> 5) : (kk >> 11), e = (isn ? (kk & 31) : (kk & 2047)) * 2, str = isn ? 32 : 2048;
            unsigned* base = (unsigned*)((isn ? WSP(bf16, WS_ML_N) : WSP(bf16, WS_ML_C)) + (size_t)bh * NCH * str * 2 + e); const float* bl = WSP(float, WS_ML_BL) + bh * NCH; const float* ml = WSP(float, WS_ML_ML) + bh * NCH; float* mo = WSP(float, WS_ML_M) + bh * NCH;
            float S0 = 0.f, S1 = 0.f, m = 0.f;
#pragma unroll 1
            for (int c0 = 0; c0 < NCH; c0 += 32) { unsigned x[32]; float b8[32], m8[32];
#pragma unroll
                for (int j = 0; j < 32; ++j) { x[j] = base[(size_t)(c0 + j) * str]; b8[j] = bl[c0 + j]; m8[j] = ml[c0 + j]; }
#pragma unroll
                for (int j = 0; j < 32; ++j) { const float mn = fmaxf(b8[j] + m, m8[j]); const float so = __expf(b8[j] + m - mn), sn = __expf(m8[j] - mn);
                    base[(size_t)(c0 + j) * str] = cvt_pk_bf16(S0, S1); if (!isn && e == 0) mo[c0 + j] = m; S0 = so * S0 + sn * __uint_as_float(x[j] << 16); S1 = so * S1 + sn * __uint_as_float(x[j] & 0xffff0000u); m = mn; } }
        }
    }
}
#ifndef MK_PER_PHASE_LAUNCH
#define MK_PER_PHASE_LAUNCH 0
#endif
#ifndef PH_MASK
#define PH_MASK 0xFFF
#endif
#ifndef ST_MASK
#define ST_MASK 0xF
#endif
#define ST_ON(k) (((ST_MASK) >> (k)) & 1)
#ifndef DUP_MASK
#define DUP_MASK 0
#endif
#define DUP_N(k) ((((DUP_MASK) >> (k)) & 1) ? 2 : 1)
#ifndef ST_DUP
#define ST_DUP 0
#endif
#define ST_REP(ty) ((((ST_DUP) >> (ty)) & 1) ? 2 : 1)
#define PH_ON(k) (((PH_MASK) >> (k)) & 1)
constexpr int PH_PER_LAYER = 11, N_PHASES = 1 + DEPTH * PH_PER_LAYER;
__global__ void __launch_bounds__(NWAVES * 64, 2) fwd_kernel(Args args) {
    extern __shared__ __attribute__((aligned(16))) unsigned char lds[];
    Frame F;
    F.lds = (LAS unsigned char*)lds;
    F.MISC = (volatile LAS unsigned*)(F.lds + MISC_OFF);
    F.tid = threadIdx.x; F.lane = F.tid & 63; F.wave = __builtin_amdgcn_readfirstlane(F.tid >> 6);
    F.G = gridDim.x; { const int bx = blockIdx.x; F.vcu = (F.G % 8 == 0) ? (bx % 8) * (F.G / 8) + bx / 8 : bx; }
    F.ka = (karg_t)__builtin_amdgcn_kernarg_segment_ptr(); F.ws = args.ws; F.ctl = (gu32*)(args.ws + WS_CTL); F.out = args.out;
    for (int i = F.tid; i < 256; i += NWAVES * 64) F.MISC[i] = 0u;
    __syncthreads();
    const int lo = args.ph_lo, hi = args.ph_hi;
#ifdef DBG_TSEL
    if (blockIdx.x == 0 && threadIdx.x == 0) __hip_atomic_store(F.ctl + CW_DBG + 15, (unsigned)__builtin_amdgcn_s_memrealtime(), RLX_AGENT);
#endif
    XcdBarrier bar; bar.bar = (unsigned*)(F.ctl + CW_BAR); bar.x = 0; bar.st = nullptr;
    if (hi - lo > 1) bar = xcd_barrier_post((unsigned*)(F.ctl + CW_BAR), F.MISC + MW_BAR);
#define IN_(k) (lo <= (k) && (k) < hi)
#ifdef DBG_TSEL
#ifndef DBG_TQ
#define DBG_TQ 50.0f
#endif
#define TSTAMP(k) do { if (blockIdx.x == 0 && threadIdx.x == 0) __hip_atomic_store(F.ctl + CW_DBG + 16 + ((k) == 11 ? 0 : 1 + layer_ * PH_PER_LAYER + (k)), (unsigned)__builtin_amdgcn_s_memrealtime(), RLX_AGENT); } while (0)
#else
#define TSTAMP(k) do { } while (0)
#endif
#ifdef BAR_DUP
#define SEAM(k) do { if (IN_(k) && IN_((k) + 1)) { xcd_barrier(bar); xcd_barrier(bar); } } while (0)
#else
#define SEAM(k) do { if (IN_(k) && IN_((k) + 1)) xcd_barrier(bar); } while (0)
#endif

    if (PH_ON(11) && IN_(0)) { for (int rep_ = 0; rep_ < DUP_N(11); ++rep_) { frame_refresh(F); p0_prologue(F, args); } SEAM(0); { const int layer_ = 0; TSTAMP(11); (void)layer_; } }
#pragma unroll 1
    for (int layer = 0; layer < DEPTH; ++layer) {
        const int pb = 1 + layer * PH_PER_LAYER; const int layer_ = layer; (void)layer_;
        if (PH_ON(0) && IN_(pb + 0)) { for (int rep_ = 0; rep_ < DUP_N(0); ++rep_) { frame_refresh(F);
            { pg8::DenseSched S; S.init(WSP(bf16, WS_XB), WSP(bf16, WS_WIN_T) + (size_t)layer * NUP * D, T, NUP, D, F.G, (int)blockIdx.x);
              pg8::EpiB16 E{WSP(bf16, WS_U), NUP, nullptr, 0.f};
              pg8::gemm_phase<pg8::EpiB16, pg8::DenseSched>(F.lds, F.tid, S, E); }
            if (F.G != 256 || blockIdx.x >= 128)
            { pg8::DenseSched S; if (F.G == 256) S.init(WSP(bf16, WS_PB) + (size_t)layer * T * 256, WSP(bf16, WS_WPP_T) + (size_t)layer * D * 256, T, D, 256, 128, (int)blockIdx.x - 128); else S.init(WSP(bf16, WS_PB) + (size_t)layer * T * 256, WSP(bf16, WS_WPP_T) + (size_t)layer * D * 256, T, D, 256, F.G, (int)blockIdx.x);
              pg8::EpiB16 E{WSP(bf16, WS_PE), D, nullptr, 0.f};
              pg8::gemm_phase<pg8::EpiB16, pg8::DenseSched>(F.lds, F.tid, S, E); }
            } SEAM(pb + 0); TSTAMP(0);
        }
        if (PH_ON(1) && IN_(pb + 1)) { for (int rep_ = 0; rep_ < DUP_N(1); ++rep_) { frame_refresh(F);
            for (int un = F.vcu; un < 1024; un += F.G) { frame_refresh(F); const int ty = un >> 8, r = un & 255, b = r >> 6, c = r & 63;
                if (ty == 0) { ssd_stage1(F, args, layer, b, c); if (ST_DUP & 1) ssd_stage1(F, args, layer, b, c); } else if (ty == 1) { gla_stage1(F, args, layer, b, c); if (ST_DUP & 2) gla_stage1(F, args, layer, b, c); } else if (ty == 2) { mlstm_stage1(F, args, layer, b, c); if (ST_DUP & 4) mlstm_stage1(F, args, layer, b, c); } else { rwkv_stage1(F, args, layer, r); if (ST_DUP & 8) rwkv_stage1(F, args, layer, r); } }
            } SEAM(pb + 1); TSTAMP(1);
        }
        if (PH_ON(2) && IN_(pb + 2)) { for (int rep_ = 0; rep_ < DUP_N(2); ++rep_) { frame_refresh(F);
            if (F.wave == 0) { for (int ws_ = F.vcu; ws_ < 64; ws_ += F.G) rwkv_scan_wave(F, args, ws_);
                if (rep_ == 0) { if (F.G > 64) { if (F.vcu >= 64) scans_elementwise(F, args, (F.vcu - 64) * 64 + F.lane, (F.G - 64) * 64, SCAN_N_MAIN, SCAN_N_ALL); } else scans_elementwise(F, args, F.vcu * 64 + F.lane, F.G * 64, SCAN_N_MAIN, SCAN_N_ALL); } }
            else if (rep_ == 0) scans_elementwise(F, args, F.vcu * 448 + (F.tid - 64), F.G * 448, 0, SCAN_N_MAIN);
            } SEAM(pb + 2); TSTAMP(2);
        }
        if (PH_ON(3) && IN_(pb + 3)) { for (int rep_ = 0; rep_ < DUP_N(3); ++rep_) { frame_refresh(F);
            for (int un = F.vcu; un < 1024; un += F.G) { frame_refresh(F); const int ty = un >> 8, r = un & 255, b = r >> 6, c = r & 63;
                if (ty == 0) { ssd_stage3(F, args, layer, b, c); if (ST_DUP & 16) ssd_stage3(F, args, layer, b, c); } else if (ty == 1) { gla_stage3(F, args, layer, b, c); if (ST_DUP & 32) gla_stage3(F, args, layer, b, c); } else if (ty == 2) { mlstm_stage3(F, args, layer, b, c); if (ST_DUP & 64) mlstm_stage3(F, args, layer, b, c); } else { rwkv_stage3(F, args, layer, r); if (ST_DUP & 128) rwkv_stage3(F, args, layer, r); } }
#if MIX_CHAIN && OUT_FP8 && OUT_CHAIN
                if (F.G == 256 && PH_ON(4) && IN_(pb + 4) && DUP_N(3) == 1 && ST_DUP == 0) { asm volatile("s_waitcnt vmcnt(0)" ::: "memory"); if (F.lane == 0) (void)__hip_atomic_fetch_add(F.ctl + CW_PAN5 + layer * 1024 + (F.vcu >> 2) * 16, 1u, RLX_AGENT); }
#endif
            }
#if MIX_CHAIN && OUT_FP8 && OUT_CHAIN
            if (!(F.G == 256 && PH_ON(4) && IN_(pb + 4) && DUP_N(3) == 1 && ST_DUP == 0)) SEAM(pb + 3);
#else
            SEAM(pb + 3);
#endif
            TSTAMP(3);
        }
        if (PH_ON(4) && IN_(pb + 4)) { for (int rep_ = 0; rep_ < DUP_N(4); ++rep_) { frame_refresh(F);
#if OUT_FP8 && OUT_CHAIN
            pg8::EpiB16W E{WSP(bf16, WS_Y1), D, WSP(bf16, WS_XB), DN_ALPHA};
            pg8::OutSched S; S.init(WSP(bf16, WS_MIX), (const bf16*)(WSP(unsigned char, WS_WOUT_Q) + (size_t)layer * D * D), T, D, D / 2, F.G, (int)blockIdx.x); S.pan = F.ctl + CW_PAN2 + layer * 1024; S.cpan = (MIX_CHAIN && F.G == 256 && PH_ON(3) && IN_(pb + 3) && DUP_N(3) == 1 && ST_DUP == 0) ? (const gu32*)(F.ctl + CW_PAN5 + layer * 1024) : (const gu32*)nullptr; S.tmo = F.ctl + CW_BAR + XB_TMO;
            pg8::gemm_phase<pg8::EpiB16W, pg8::OutSched>(F.lds, F.tid, S, E);
#elif OUT_FP8
            pg8::EpiB16 E{WSP(bf16, WS_Y1), D, WSP(bf16, WS_XB), DN_ALPHA};
            pg8::DenseSched8b S; S.init(WSP(bf16, WS_MIX), (const bf16*)(WSP(unsigned char, WS_WOUT_Q) + (size_t)layer * D * D), T, D, D / 2, F.G, (int)blockIdx.x);
            pg8::gemm_phase<pg8::EpiB16, pg8::DenseSched8b>(F.lds, F.tid, S, E);
#else
            pg8::EpiB16 E{WSP(bf16, WS_Y1), D, WSP(bf16, WS_XB), DN_ALPHA};
            pg8::DenseSched S; S.init(WSP(bf16, WS_MIX), WSP(bf16, WS_WOUT_T) + (size_t)layer * D * D, T, D, D, F.G, (int)blockIdx.x);
            pg8::gemm_phase<pg8::EpiB16, pg8::DenseSched>(F.lds, F.tid, S, E);
#endif
            }
#if OUT_FP8 && OUT_CHAIN && OUT_CHAIN_POLL
            if (!(PH_ON(5) && IN_(pb + 5))) SEAM(pb + 4);
#else
            SEAM(pb + 4);
#endif
            TSTAMP(4);
        }
        if (PH_ON(5) && IN_(pb + 5)) { if (DUP_N(5) == 2) { frame_refresh(F); p6_ln1_router<true>(F, args, layer); } frame_refresh(F); p6_ln1_router<false>(F, args, layer, (OUT_FP8 && OUT_CHAIN && OUT_CHAIN_POLL && PH_ON(4) && IN_(pb + 4)) ? (const gu32*)(F.ctl + CW_PAN2 + layer * 1024) : (const gu32*)nullptr); SEAM(pb + 5); TSTAMP(5); }
        if (PH_ON(6) && IN_(pb + 6)) { for (int rep_ = 0; rep_ < DUP_N(6); ++rep_) { frame_refresh(F);
            moe_build_pfx(F, args, layer, 8);
            pg8::Moe1Sched S; S.O.pfx = F.MISC + MW_PFX; S.O.NT = 8; S.O.G = F.G; S.O.c = (int)blockIdx.x; S.sdest = WSP(int, WS_SDEST); S.bgu = KIN(I_BGU) + (size_t)layer * NE * 2048; S.pan = F.ctl + CW_PAN + layer * (NE * 64 * 16);
            if (MOE_FP8) { S.X = WSP(unsigned char, WS_X1Q); S.W = WSP(unsigned char, WS_WGU_Q) + (size_t)layer * NE * 2048 * D; S.K = D / 2; S.hstepB = (size_t)1024 * D; }
            else { S.X = WSP(unsigned char, WS_X1B); S.W = WSP(unsigned char, WS_WGU_T) + (size_t)layer * NE * 2048 * D * 2; S.K = D; S.hstepB = (size_t)1024 * D * 2; }
            pg8::EpiMoe1 E{WSP(bf16, WS_ABUF), KIN(I_BGU) + (size_t)layer * NE * 2048, WSP(unsigned char, WS_ABUFQ)};
            pg8::gemm_phase<pg8::EpiMoe1, pg8::Moe1Sched>(F.lds, F.tid, S, E);
            }
#if MOE_CHAIN
            if (!(PH_ON(7) && IN_(pb + 7))) SEAM(pb + 6);
#else
            SEAM(pb + 6);
#endif
            TSTAMP(6);
        }
        if (PH_ON(7) && IN_(pb + 7)) { for (int rep_ = 0; rep_ < DUP_N(7); ++rep_) { frame_refresh(F);
            int c2 = (int)blockIdx.x; if (MOE_CHAIN && PH_ON(6) && IN_(pb + 6) && (F.G & 7) == 0) { const int r1 = (int)F.MISC[MW_PFX + 32] % F.G; if ((r1 & 7) == 0) c2 = (c2 - r1 + F.G) % F.G; }
            moe_build_pfx(F, args, layer, 4);
            pg8::Moe2Sched S; S.O.pfx = F.MISC + MW_PFX; S.O.NT = 4; S.O.G = F.G; S.O.c = c2; S.pan = F.ctl + CW_PAN + layer * (NE * 64 * 16); S.tmo = F.ctl + CW_BAR + XB_TMO; S.sdest = WSP(int, WS_SDEST); S.sgate = WSP(float, WS_SGATE); S.bdn = KIN(I_BDN) + (size_t)layer * NE * D; if (MOE2_FP8) { S.Ab = WSP(unsigned char, WS_ABUFQ); S.W = WSP(unsigned char, WS_WDN_Q) + (size_t)layer * NE * D * D; S.K = D / 2; S.hstepB = (size_t)128 * D; }
            else { S.Ab = WSP(unsigned char, WS_ABUF); S.W = WSP(unsigned char, WS_WDN_T) + (size_t)layer * NE * D * D * 2; S.K = D; S.hstepB = (size_t)128 * D * 2; }
            pg8::EpiMoe2 E{WSP(bf16, WS_YBUF), KIN(I_BDN) + (size_t)layer * NE * D, WSP(int, WS_SDEST), WSP(float, WS_SGATE)};
            pg8::gemm_phase<pg8::EpiMoe2, pg8::Moe2Sched>(F.lds, F.tid, S, E);
            } SEAM(pb + 7); TSTAMP(7);
        }
        if (PH_ON(8) && IN_(pb + 8)) { for (int rep_ = 0; rep_ < DUP_N(8); ++rep_) { frame_refresh(F); p9_combine(F, args); } SEAM(pb + 8); TSTAMP(8); }
        if (PH_ON(9) && IN_(pb + 9)) { for (int rep_ = 0; rep_ < DUP_N(9); ++rep_) { frame_refresh(F);
            pg8::EpiPle E{WSP(bf16, WS_H2), WSP(bf16, WS_HB), WSP(bf16, WS_PE)};
#if PLE_FP8
            pg8::DenseSched8 S; S.init((const bf16*)WSP(unsigned char, WS_HQ), (const bf16*)(WSP(unsigned char, WS_WPG_Q) + (size_t)layer * D * D), T, D, D / 2, F.G, (int)blockIdx.x);
            pg8::gemm_phase<pg8::EpiPle, pg8::DenseSched8>(F.lds, F.tid, S, E);
#else
            pg8::DenseSched S; S.init(WSP(bf16, WS_HB), WSP(bf16, WS_WPG_T) + (size_t)layer * D * D, T, D, D, F.G, (int)blockIdx.x);
            pg8::gemm_phase<pg8::EpiPle, pg8::DenseSched>(F.lds, F.tid, S, E);
#endif
            } SEAM(pb + 9); TSTAMP(9);
        }
        if (PH_ON(10) && IN_(pb + 10)) { for (int rep_ = 0; rep_ < DUP_N(10); ++rep_) { frame_refresh(F); p11_ln2(F, args, layer); } SEAM(pb + 10); TSTAMP(10); }
    }
#ifdef DBG_TSEL
    if (hi - lo > 1) { xcd_barrier(bar);
        unsigned ticks = 0u;
        if (DBG_TSEL == 11) ticks = __hip_atomic_load(F.ctl + CW_DBG + 16, RLX_AGENT) - __hip_atomic_load(F.ctl + CW_DBG + 15, RLX_AGENT);
        else for (int l = 0; l < DEPTH; ++l) { const int pi = 1 + l * PH_PER_LAYER + DBG_TSEL; ticks += __hip_atomic_load(F.ctl + CW_DBG + 16 + pi, RLX_AGENT) - __hip_atomic_load(F.ctl + CW_DBG + 16 + pi - 1, RLX_AGENT); }
        const float us = floorf((float)ticks * 0.01f / DBG_TQ) * DBG_TQ; const float code = sqrtf(us * 0.05f);
        for (size_t i = (size_t)blockIdx.x * 512 + threadIdx.x; i < (size_t)T * D; i += (size_t)gridDim.x * 512) F.out[i] = code; }
#endif
#ifdef DBG_SEL
    if (hi - lo > 1) { xcd_barrier(bar);
        const unsigned mx = __hip_atomic_load(F.ctl + CW_DBG, RLX_AGENT), nf = __hip_atomic_load(F.ctl + CW_DBG + 1, RLX_AGENT);
        float code;
        { const float m = __uint_as_float(mx); int b = (m > 0.f) ? (int)floorf(log10f(m)) + 30 : 0; b = b < 0 ? 0 : (b > 60 ? 60 : b); if (nf) b += 100; code = sqrtf(10.0f * (float)(b + 1)); }
        for (size_t i = (size_t)blockIdx.x * 512 + threadIdx.x; i < (size_t)T * D; i += (size_t)gridDim.x * 512) F.out[i] = code; }
#endif
#undef IN_
#undef SEAM
}

extern "C" void kernel_launch(void* const* d_in, const int* in_sizes, int n_in, void* d_out, int out_size, void* d_ws, size_t ws_size, hipStream_t stream) {
    static int grid = 0;
    if (grid == 0) {
        if (n_in != N_IN || out_size != T * D || ws_size < WS_END) { fprintf(stderr, "kernel_launch: unexpected shapes (n_in %d, out %d, ws %zu < %zu); nothing launched\n", n_in, out_size, ws_size, (size_t)WS_END); grid = -1; return; }
        int dev = 0, cus = 0, per_cu = 0;
        if (hipGetDevice(&dev) != hipSuccess || hipDeviceGetAttribute(&cus, hipDeviceAttributeMultiprocessorCount, dev) != hipSuccess) { grid = -1; return; }
        if (hipFuncSetAttribute((const void*)fwd_kernel, hipFuncAttributeMaxDynamicSharedMemorySize, LDS_BYTES) != hipSuccess) { fprintf(stderr, "kernel_launch: hipFuncSetAttribute failed\n"); grid = -1; return; }
        if (hipOccupancyMaxActiveBlocksPerMultiprocessor(&per_cu, (const void*)fwd_kernel, NWAVES * 64, LDS_BYTES) != hipSuccess || per_cu < 1) { fprintf(stderr, "kernel_launch: occupancy query says %d blocks per CU\n", per_cu); }
        (void)hipGetLastError();
        grid = cus;
    }
    if (grid < 0) return;
    (void)hipMemsetAsync((char*)d_ws + WS_CTL, 0, CTL_ZERO_BYTES, stream);
    Args a{};
    for (int i = 0; i < N_IN; ++i) a.in[i] = (const float*)d_in[i];
    a.out = (float*)d_out; a.ws = (unsigned char*)d_ws;
#if MK_PER_PHASE_LAUNCH
    for (int ph = 0; ph < N_PHASES; ++ph) { a.ph_lo = ph; a.ph_hi = ph + 1; hipLaunchKernelGGL(fwd_kernel, dim3(grid), dim3(NWAVES * 64), LDS_BYTES, stream, a); }
#else
    a.ph_lo = 0; a.ph_hi = N_PHASES; hipLaunchKernelGGL(fwd_kernel, dim3(grid), dim3(NWAVES * 64), LDS_BYTES, stream, a);
#endif
    const hipError_t le = hipPeekAtLastError();
    if (le != hipSuccess) fprintf(stderr, "kernel_launch: launch failed: %s\n", hipGetErrorName(le));
}
```

```cpp
#include <hip/hip_runtime.h>
#include <cstdio>
#include <cstdint>

#define GAS __attribute__((address_space(1)))
#define LAS __attribute__((address_space(3)))
typedef unsigned short bf16;
typedef unsigned v4u __attribute__((ext_vector_type(4)));
typedef unsigned v2u __attribute__((ext_vector_type(2)));
typedef float f32x4 __attribute__((ext_vector_type(4)));
typedef float f32x2 __attribute__((ext_vector_type(2)));
typedef short bf16x8 __attribute__((ext_vector_type(8)));
typedef int v4i_t __attribute__((ext_vector_type(4)));
typedef int v8i_t __attribute__((ext_vector_type(8)));
typedef GAS unsigned gu32;
#define RLX_AGENT __ATOMIC_RELAXED, __HIP_MEMORY_SCOPE_AGENT
#define LDS_WAIT() asm volatile("s_waitcnt lgkmcnt(0)" ::: "memory")
#define VM_WAIT() asm volatile("s_waitcnt vmcnt(0)" ::: "memory")

constexpr int NWAVES = 8;
constexpr int DEPTH = 4, BATCH = 4, SEQ = 4096, D = 1024, T = BATCH * SEQ;
constexpr int NU = 3484, NUP = 3584;
constexpr int NE = 32, TOPK = 4, ECAP = 16384;
constexpr int NCH = SEQ / 64;
constexpr int U_SSD_Z = 0, U_SSD_X = 256, U_SSD_B = 512, U_SSD_C = 640, U_SSD_DT = 768;
constexpr int U_RW = 772, U_RW_R = 772, U_RW_K = 1028, U_RW_V = 1284, U_RW_LO = 1540;
constexpr int U_GL_Q = 1668, U_GL_K = 1796, U_GL_V = 1924, U_GL_G = 2180, U_GL_OG = 2196;
constexpr int U_ML_Q = 2452, U_ML_K = 2708, U_ML_V = 2964, U_ML_I = 3220, U_ML_F = 3224, U_ML_O = 3228;
constexpr float DN_ALPHA = 1.6817928305074290f;
constexpr float LN_EPS = 1e-5f, NORM_EPS = 1e-5f, RWKV_GN_EPS = 64e-5f;

enum { I_X = 0, I_P, I_WIN, I_WOUT, I_LN1G, I_LN1B, I_SCW, I_SCB, I_SALOG, I_SDTB, I_SD, I_SNG,
       I_RMU, I_RW0, I_RWUP, I_RA0, I_RAUP, I_RGUP, I_RKK, I_RKA, I_RRK, I_RLNG, I_RLNB,
       I_GGUP, I_GGB, I_GNG, I_MCW, I_MCB, I_MIB, I_MFB, I_MNG,
       I_RTW, I_RTB, I_WGU, I_BGU, I_WDN, I_BDN, I_PGW, I_PPJ, I_LN2G, I_LN2B, N_IN };

constexpr size_t MiB = 1u << 20;
constexpr size_t WS_CTL = 0, CTL_ZERO_BYTES = 1 * MiB;
constexpr size_t WS_WIN_T = 2 * MiB;
constexpr size_t WS_WOUT_T = WS_WIN_T + (size_t)DEPTH * NUP * D * 2;
constexpr size_t WS_WGU_T = WS_WOUT_T + (size_t)DEPTH * D * D * 2;
constexpr size_t WS_WDN_T = WS_WGU_T + (size_t)DEPTH * NE * 2048 * D * 2;
constexpr size_t WS_WPG_T = WS_WDN_T + (size_t)DEPTH * NE * D * D * 2;
constexpr size_t WS_WPP_T = WS_WPG_T + (size_t)DEPTH * D * D * 2;
constexpr size_t WS_RWT = WS_WPP_T + (size_t)DEPTH * D * 256 * 2;
constexpr size_t WS_PB = WS_RWT + (size_t)DEPTH * NE * D * 4;
constexpr size_t WS_XB = WS_PB + (size_t)DEPTH * T * 256 * 2;
constexpr size_t WS_U = WS_XB + (size_t)T * D * 2;
constexpr size_t WS_PE = WS_U + (size_t)T * NUP * 2;
constexpr size_t WS_MIX = WS_PE + (size_t)T * D * 4;
constexpr size_t WS_Y1 = WS_MIX + (size_t)T * D * 2;
constexpr size_t WS_X1 = WS_Y1 + (size_t)T * D * 4;
constexpr size_t WS_X1B = WS_X1 + (size_t)T * D * 4;
constexpr size_t WS_SDEST = WS_X1B + (size_t)T * D * 2;
constexpr size_t WS_SGATE = WS_SDEST + (size_t)NE * ECAP * 4;
constexpr size_t WS_ABUF = WS_SGATE + (size_t)NE * ECAP * 4;
constexpr size_t WS_YBUF = WS_ABUF + (size_t)NE * ECAP * D * 2;
constexpr size_t WS_H = WS_YBUF + (size_t)T * 4 * D * 2;
constexpr size_t WS_HB = WS_H + (size_t)T * D * 4;
constexpr size_t WS_H2 = WS_HB + (size_t)T * D * 2;
constexpr size_t WS_SSD_ST = WS_H2 + (size_t)T * D * 4;
constexpr size_t WS_SSD_DEC = WS_SSD_ST + (size_t)16 * NCH * 64 * 128 * 4;
constexpr size_t WS_GLA_ST = WS_SSD_DEC + 16 * NCH * 4;
constexpr size_t WS_GLA_DEC = WS_GLA_ST + (size_t)16 * NCH * 32 * 64 * 4;
constexpr size_t WS_ML_C = WS_GLA_DEC + (size_t)4 * NCH * 128 * 4;
constexpr size_t WS_ML_N = WS_ML_C + (size_t)16 * NCH * 64 * 64 * 4;
constexpr size_t WS_ML_BL = WS_ML_N + (size_t)16 * NCH * 64 * 4;
constexpr size_t WS_ML_ML = WS_ML_BL + 16 * NCH * 4;
constexpr size_t WS_ML_M = WS_ML_ML + 16 * NCH * 4;
constexpr size_t WS_RW = WS_ML_M + 16 * NCH * 4;
constexpr size_t WS_RW_G = WS_RW + (size_t)T * 3 * 256 * 4;
constexpr size_t WS_RW_RH = WS_RW_G + (size_t)T * 256 * 4;
constexpr size_t WS_RW_O0 = WS_RW_RH + (size_t)1024 * 4096 * 2;
constexpr size_t WS_RW_GF = WS_RW_O0 + (size_t)1024 * 4096 * 4;
constexpr size_t WS_RW_HT = WS_RW_GF + (size_t)1024 * 4096 * 2;
constexpr size_t WS_RW_PT = WS_RW_HT + (size_t)1024 * 4096 * 4;
constexpr size_t WS_LORA = WS_RW_PT + (size_t)1024 * 4096 * 2;
constexpr int LORA_PER_LAYER = 8192 + 8192 + 16384 + 2048;
constexpr size_t WS_WGU_Q = WS_LORA + (size_t)DEPTH * LORA_PER_LAYER * 4;
constexpr size_t WS_WDN_Q = WS_WGU_Q + (size_t)DEPTH * NE * 2048 * D;
constexpr size_t WS_X1Q = WS_WDN_Q + (size_t)DEPTH * NE * D * D;
constexpr size_t WS_ABUFQ = WS_X1Q + (size_t)T * D;
constexpr size_t WS_WPG_Q = WS_ABUFQ + (size_t)NE * ECAP * D;
constexpr size_t WS_HQ = WS_WPG_Q + (size_t)DEPTH * D * D;
constexpr size_t WS_WOUT_Q = WS_HQ + (size_t)T * D;
constexpr size_t WS_END = WS_WOUT_Q + (size_t)DEPTH * D * D;
#ifndef MOE_FP8
#define MOE_FP8 1
#endif
#ifndef MOE2_FP8
#define MOE2_FP8 1
#ifndef OUT_CHAIN
#define OUT_CHAIN 1
#endif
#ifndef OUT_CHAIN_POLL
#define OUT_CHAIN_POLL 1
#endif
#ifndef MOE_CHAIN
#define MOE_CHAIN 1
#endif
#ifndef RW_SOLVE_BLK
#define RW_SOLVE_BLK 1
#endif
#ifndef RW_SCAN_DMA
#define RW_SCAN_DMA 1
#endif
#ifndef P6_MFMA
#define P6_MFMA 1
#endif
#ifndef OUT_FP8
#define OUT_FP8 1
#endif
#ifndef PLE_FP8
#define PLE_FP8 1
#endif
#endif
constexpr int CW_BAR = 4096;
constexpr int CW_DBG = 32768;
constexpr int CW_PAN = 65536;
constexpr int CW_PAN2 = 196608;
constexpr int CW_CNT = 16384;

constexpr int RING_BYTES = 147456;
constexpr int MISC_OFF = RING_BYTES;
constexpr int LDS_BYTES = RING_BYTES + 1024;
constexpr int MW_BAR = 8, MW_LCNT = 32, MW_LBASE = 64, MW_PFX = 96, MW_CNT = 136, MW_GAMC = 168;

typedef __bf16 bf16x2_t __attribute__((ext_vector_type(2)));
__device__ __forceinline__ unsigned cvt_pk_bf16(float lo, float hi) { const f32x2 v = {lo, hi}; const bf16x2_t b = __builtin_convertvector(v, bf16x2_t); return __builtin_bit_cast(unsigned, b); }
__device__ __forceinline__ unsigned cvt4_fp8(float a, float b, float c, float d) { int w = 0; w = __builtin_amdgcn_cvt_pk_fp8_f32(a, b, w, false); w = __builtin_amdgcn_cvt_pk_fp8_f32(c, d, w, true); return (unsigned)w; }
__device__ __forceinline__ float bf2f(unsigned short b) { return __uint_as_float(((unsigned)b) << 16); }
__device__ __forceinline__ float sigmoidf_(float x) { return __builtin_amdgcn_rcpf(1.0f + __expf(-x)); }
__device__ __forceinline__ float siluf_(float x) { return x * __builtin_amdgcn_rcpf(1.0f + __expf(-x)); }
__device__ __forceinline__ float softplusf_(float x) { return fmaxf(x, 0.f) + __logf(1.0f + __expf(-fabsf(x))); }
__device__ __forceinline__ float logsigmoidf_(float x) { return fminf(x, 0.f) - __logf(1.0f + __expf(-fabsf(x))); }
__device__ __forceinline__ float tanhf_(float x) { const float e = __expf(-2.0f * fabsf(x)); const float t = (1.0f - e) * __builtin_amdgcn_rcpf(1.0f + e); return x < 0.f ? -t : t; }
__device__ __forceinline__ int lane_now() { int l = (int)__builtin_amdgcn_mbcnt_hi(~0u, __builtin_amdgcn_mbcnt_lo(~0u, 0u)); asm volatile("" : "+v"(l)); return l; }
__device__ __forceinline__ float my_shfl_idx(float v, int src) { return __builtin_bit_cast(float, __builtin_amdgcn_ds_bpermute(src << 2, __builtin_bit_cast(int, v))); }
__device__ __forceinline__ int my_shfl_idx(int v, int src) { return __builtin_amdgcn_ds_bpermute(src << 2, v); }
template <class V> __device__ __forceinline__ V my_shfl_xor(V v, int o) { return my_shfl_idx(v, lane_now() ^ o); }
template <class V> __device__ __forceinline__ V my_shfl_up(V v, int o) { const int l = lane_now(); return my_shfl_idx(v, l >= o ? l - o : l); }
#define __shfl_xor(v, o) my_shfl_xor(v, o)
#define __shfl_up(v, o) my_shfl_up(v, o)
#define __shfl(v, s) my_shfl_idx(v, s)
__device__ __forceinline__ float wave_sum(float v) {
#pragma unroll
    for (int o = 1; o < 64; o <<= 1) v += __shfl_xor(v, o);
    return v;
}
__device__ __forceinline__ float wave_max(float v) {
#pragma unroll
    for (int o = 1; o < 64; o <<= 1) v = fmaxf(v, __shfl_xor(v, o));
    return v;
}
__device__ __forceinline__ float wave_scan_add(float v, int lane) {
#pragma unroll
    for (int o = 1; o < 64; o <<= 1) { const float t = __shfl_up(v, o); if (lane >= o) v += t; }
    return v;
}
__device__ __forceinline__ float wave_scan_max(float v, int lane) {
#pragma unroll
    for (int o = 1; o < 64; o <<= 1) { const float t = __shfl_up(v, o); if (lane >= o) v = fmaxf(v, t); }
    return v;
}
__device__ __forceinline__ f32x4 mm16(const LAS unsigned char* A, int lda, const LAS unsigned char* B, int ldb, int K, f32x4 acc, int fr, int fq) {
    const LAS unsigned char* ap = A + fr * lda + fq * 16; const LAS unsigned char* bp = B + fr * ldb + fq * 16;
    for (int k = 0; k < K; k += 32) {
        const bf16x8 a = *(const LAS bf16x8*)(ap + k * 2); const bf16x8 b = *(const LAS bf16x8*)(bp + k * 2);
        acc = __builtin_amdgcn_mfma_f32_16x16x32_bf16(b, a, acc, 0, 0, 0);
    }
    return acc;
}
__device__ __forceinline__ f32x4 mm16_gB(const LAS unsigned char* A, int lda, const float* B, int ldb, int K, f32x4 acc, int fr, int fq) {
    const LAS unsigned char* ap = A + fr * lda + fq * 16; const float* bp = B + (size_t)fr * ldb + fq * 8;
    for (int k = 0; k < K; k += 32) {
        const bf16x8 a = *(const LAS bf16x8*)(ap + k * 2);
        const f32x4 b0 = *(const f32x4*)(bp + k), b1 = *(const f32x4*)(bp + k + 4);
        v4u bw; bw.x = cvt_pk_bf16(b0.x, b0.y); bw.y = cvt_pk_bf16(b0.z, b0.w); bw.z = cvt_pk_bf16(b1.x, b1.y); bw.w = cvt_pk_bf16(b1.z, b1.w);
        const bf16x8 b = __builtin_bit_cast(bf16x8, bw);
        acc = __builtin_amdgcn_mfma_f32_16x16x32_bf16(b, a, acc, 0, 0, 0);
    }
    return acc;
}
__device__ __forceinline__ f32x4 mm16_gAB(const bf16* A, int lda, const bf16* B, int ldb, int K, f32x4 acc, int fr, int fq) {
    const bf16* ap = A + (size_t)fr * lda + fq * 8; const bf16* bp = B + (size_t)fr * ldb + fq * 8;
    for (int k = 0; k < K; k += 32) { const bf16x8 a = *(const bf16x8*)(ap + k), b = *(const bf16x8*)(bp + k); acc = __builtin_amdgcn_mfma_f32_16x16x32_bf16(b, a, acc, 0, 0, 0); }
    return acc;
}
__device__ __forceinline__ bf16x8 ldfrag_f32(const float* p) { const f32x4 b0 = *(const f32x4*)p, b1 = *(const f32x4*)(p + 4);
    v4u bw; bw.x = cvt_pk_bf16(b0.x, b0.y); bw.y = cvt_pk_bf16(b0.z, b0.w); bw.z = cvt_pk_bf16(b1.x, b1.y); bw.w = cvt_pk_bf16(b1.z, b1.w); return __builtin_bit_cast(bf16x8, bw); }
template <int NK> __device__ __forceinline__ f32x4 mm16_rB(const LAS unsigned char* A, int lda, const bf16x8 (&b)[NK], f32x4 acc, int fr, int fq) {
    const LAS unsigned char* ap = A + fr * lda + fq * 16;
#pragma unroll
    for (int k = 0; k < NK; ++k) { const bf16x8 a = *(const LAS bf16x8*)(ap + k * 64); acc = __builtin_amdgcn_mfma_f32_16x16x32_bf16(b[k], a, acc, 0, 0, 0); }
    return acc;
}
__device__ __forceinline__ v4u pack8(const float (&v)[8]) { v4u o; o.x = cvt_pk_bf16(v[0], v[1]); o.y = cvt_pk_bf16(v[2], v[3]); o.z = cvt_pk_bf16(v[4], v[5]); o.w = cvt_pk_bf16(v[6], v[7]); return o; }

#define XB_TMO      128
#define XB_XCNT(j)  (256  + 64 * (j))
#define XB_XSUB(j)  (1280 + 64 * (j))
#define XB_XGEN(j)  (2304 + 64 * (j))
#define XB_TOP      3328
#define XB_TOPGEN   3392
#define XCD_BAR_WORDS 3456
#define XB_SPIN_CAP (1u << 18)
__device__ __forceinline__ unsigned xb_ld(unsigned* p)              { return __hip_atomic_load(p, __ATOMIC_RELAXED, __HIP_MEMORY_SCOPE_AGENT); }
__device__ __forceinline__ unsigned xb_add(unsigned* p, unsigned v) { return __hip_atomic_fetch_add(p, v, __ATOMIC_RELAXED, __HIP_MEMORY_SCOPE_AGENT); }
__device__ __forceinline__ unsigned xb_xcc_id() { return (unsigned)__builtin_amdgcn_s_getreg((3 << 11) | 20) & 0xFu; }
#define XB_SPIN(cond, bar) do { unsigned _sp = 0; while (cond) { __builtin_amdgcn_s_sleep(1); \
    if ((++_sp & 255u) == 0u) { if (xb_ld(&(bar)[XB_TMO])) break; if (_sp > XB_SPIN_CAP) { atomicAdd(&(bar)[XB_TMO], 1u); break; } } } } while (0)
struct XcdBarrier { unsigned* bar; unsigned x; volatile LAS unsigned* st; };
__device__ __forceinline__ XcdBarrier xcd_barrier_post(unsigned* bar, volatile LAS unsigned* st) {
    XcdBarrier b; b.bar = bar; b.x = xb_xcc_id(); b.st = st;
    if (threadIdx.x == 0) (void)xb_add(&bar[XB_XCNT(b.x)], 1u);
    return b;
}
__device__ __forceinline__ void xcd_barrier_complete(unsigned* bar, unsigned x, unsigned& nloc, unsigned& nx) {
    const unsigned G = gridDim.x * gridDim.y * gridDim.z;
    unsigned sum, cnt, mine, sp = 0u;
    for (;;) {
        sum = 0u; cnt = 0u; mine = 0u;
#pragma unroll
        for (unsigned j = 0; j < 16; ++j) { const unsigned c = xb_ld(&bar[XB_XCNT(j)]); sum += c; cnt += (c > 0u) ? 1u : 0u; mine = (j == x) ? c : mine; }
        if (sum == G) break;
        __builtin_amdgcn_s_sleep(1);
        if ((++sp & 255u) == 0u) { if (xb_ld(&bar[XB_TMO])) break; if (sp > XB_SPIN_CAP) { atomicAdd(&bar[XB_TMO], 1u); break; } }
    }
    nloc = mine > 0u ? mine : 1u; nx = cnt > 0u ? cnt : 1u;
}
__device__ __forceinline__ void xcd_barrier(const XcdBarrier& b) {
    asm volatile("s_waitcnt vmcnt(0)" ::: "memory");
    __syncthreads();
    if (threadIdx.x == 0) {
        unsigned* bar = b.bar;
        __builtin_amdgcn_s_waitcnt(0);
        unsigned nloc = b.st[0], nx = b.st[1];
        if (nloc == 0u) { xcd_barrier_complete(bar, b.x, nloc, nx); b.st[0] = nloc; b.st[1] = nx; }
        const unsigned k = b.st[2]; b.st[2] = k + 1u;
        const unsigned old = xb_add(&bar[XB_XSUB(b.x)], 1u);
        if (old + 1u == (k + 1u) * nloc) {
            __builtin_amdgcn_fence(__ATOMIC_RELEASE, "agent");
            asm volatile("s_waitcnt vmcnt(0)" ::: "memory");
            (void)xb_add(&bar[XB_TOP], 1u);
        }
        const unsigned target = (k + 1u) * nx;
        XB_SPIN(xb_ld(&bar[XB_TOP]) < target, bar);
        __builtin_amdgcn_fence(__ATOMIC_ACQUIRE, "agent");
        asm volatile("s_waitcnt vmcnt(0)" ::: "memory");
    }
    __syncthreads();
}

namespace pg8 {
constexpr int BM = 256, BK = 64, HALF = 128, HTB = HALF * BK * 2, STAGE_BYTES = 8 * HTB, NXCD = 8, WGM = 8;
__host__ __device__ __forceinline__ int lds_byte(int r, int c) { const int st = (r >> 4) * 2 + (c >> 5), rr = r & 15, cc = c & 31, ob = rr * 64 + cc * 2; return st * 1024 + (ob ^ (((ob >> 9) & 1) << 5)); }
__host__ __device__ __forceinline__ void stage_rc(int b, int& R, int& C) { const int st = b / 1024, sb = b % 1024, swz = sb ^ (((sb >> 9) & 1) << 5); R = (st >> 1) * 16 + swz / 64; C = (st & 1) * 32 + (swz % 64) / 2; }
__host__ __device__ __forceinline__ int perm32(int rho) { const int n = rho >> 4, i = rho & 15; return 8 * (i >> 2) + 4 * n + (i & 3); }

template <class Epi, class Sched>
__device__ __forceinline__ void gemm_phase(LAS unsigned char* lds, const int tid, const Sched& S, const Epi& E) {
    const int wid = __builtin_amdgcn_readfirstlane(tid >> 6), lane = tid & 63, wr = wid >> 2, wc = wid & 3, fr = lane & 15, fq = lane >> 4;
    const int K = S.K, nt = K / BK;
    unsigned voffB[2];
#pragma unroll
    for (int i = 0; i < 2; ++i) { int R, C; stage_rc(tid * 16 + i * 8192, R, C); const int Rb = Epi::PERM ? ((R & ~31) + perm32(R & 31)) : R; voffB[i] = (unsigned)(Rb * K + C) * 2u; }
    const size_t kstep = (size_t)(BK * 2);
    const size_t hstepB = S.hstepB;
    const unsigned ldsw = (unsigned)wid * 1024u;
    constexpr bool F8 = Sched::FP8;
    const int aoff = F8 ? lds_byte(wr * 64 + fr, fq * 16) : lds_byte(wr * 64 + fr, fq * 8), boff = F8 ? lds_byte(wc * 32 + fr, fq * 16) : lds_byte(wc * 32 + fr, fq * 8);
#define PG8_SA(b, h) (((b) * 2 + (h)) * HTB)
#define PG8_SB(b, h) ((4 + (b) * 2 + (h)) * HTB)
#define PG8_STAGE_B(bufoff, gbase) do { _Pragma("unroll") for (int _i = 0; _i < 2; ++_i) \
        __builtin_amdgcn_global_load_lds((const unsigned*)((const char*)(gbase) + voffB[_i]), (LAS unsigned*)(lds + (bufoff) + ldsw + _i * 8192), 16, 0, 0); } while (0)
#define PG8_STAGE_A(bufoff, gbase, v0, v1) do { \
        __builtin_amdgcn_global_load_lds((const unsigned*)((const char*)(gbase) + (v0)), (LAS unsigned*)(lds + (bufoff) + ldsw), 16, 0, 0); \
        __builtin_amdgcn_global_load_lds((const unsigned*)((const char*)(gbase) + (v1)), (LAS unsigned*)(lds + (bufoff) + ldsw + 8192), 16, 0, 0); } while (0)
#define PG8_FOFF(k) (F8 ? (k) * 16 : (k) * 1024)
#define PG8_LDA(dst, b, h) do { _Pragma("unroll") for (int m = 0; m < 4; ++m) { if constexpr (F8) dst##8[m] = *(const LAS v8i_t*)(lds + PG8_SA(b, h) + aoff + m * 2048); \
        else { _Pragma("unroll") for (int k = 0; k < 2; ++k) dst[m][k] = *(const LAS bf16x8*)(lds + PG8_SA(b, h) + aoff + m * 2048 + k * 1024); } } } while (0)
#define PG8_LDB(dst, b, h) do { _Pragma("unroll") for (int n = 0; n < 2; ++n) { if constexpr (F8) dst##8[n] = *(const LAS v8i_t*)(lds + PG8_SB(b, h) + boff + n * 2048); \
        else { _Pragma("unroll") for (int k = 0; k < 2; ++k) dst[n][k] = *(const LAS bf16x8*)(lds + PG8_SB(b, h) + boff + n * 2048 + k * 1024); } } } while (0)
#define PG8_CAT(x) __builtin_shufflevector(__builtin_bit_cast(v4i_t, x[0]), __builtin_bit_cast(v4i_t, x[1]), 0, 1, 2, 3, 4, 5, 6, 7)
#define PG8_MMA(ai, bj, At, Bt) do { __builtin_amdgcn_s_setprio(1); _Pragma("unroll") for (int m = 0; m < 4; ++m) _Pragma("unroll") for (int n = 0; n < 2; ++n) { \
        if constexpr (F8) acc[ai][bj][m][n] = __builtin_amdgcn_mfma_scale_f32_16x16x128_f8f6f4(Bt##8[n], At##8[m], acc[ai][bj][m][n], 0, 0, 0, S.scaleB, 0, S.scaleA); \
        else { _Pragma("unroll") for (int k = 0; k < 2; ++k) acc[ai][bj][m][n] = __builtin_amdgcn_mfma_f32_16x16x32_bf16(Bt[n][k], At[m][k], acc[ai][bj][m][n], 0, 0, 0); } } __builtin_amdgcn_s_setprio(0); } while (0)
#define PG8_WAIT_V(n) asm volatile("s_waitcnt vmcnt(" #n ")" ::: "memory")
#define PG8_WAIT_L(n) asm volatile("s_waitcnt lgkmcnt(" #n ")" ::: "memory")
#define PG8_BAR __builtin_amdgcn_s_barrier()
#define PG8_SCHED __builtin_amdgcn_sched_barrier(0)
    typename Sched::Unit cur, nxt, prv; int ui = 0;
    if (!S.next(0, cur)) return;
    prv = cur; unsigned pre = 0u;
    f32x4 acc[2][2][4][2];
#pragma unroll
    for (int a = 0; a < 2; ++a)
#pragma unroll
        for (int b = 0; b < 2; ++b)
#pragma unroll
            for (int m = 0; m < 4; ++m)
#pragma unroll
                for (int n = 0; n < 2; ++n) acc[a][b][m][n] = (f32x4){0.f, 0.f, 0.f, 0.f};
    bf16x8 At[4][2], B0[2][2], B1[2][2]; v8i_t At8[4], B08[2], B18[2];
    constexpr bool GA = Sched::GATHER;
    const size_t hstepA = GA ? (size_t)0 : (size_t)HALF * K * 2;
    unsigned vA[2][2];
    LAS unsigned char* hdr = lds + STAGE_BYTES;
    if constexpr (Sched::HDR) { if (wid == 0) S.hdr_issue(cur, hdr, lane); PG8_WAIT_V(0); PG8_BAR; }
    S.a_off(cur, tid, vA, hdr);
#define PG8_STAGE_AH(bufoff, base, vv, h) PG8_STAGE_A(bufoff, ((base) + (h) * hstepA), vv[GA ? (h) : 0][0], vv[GA ? (h) : 0][1])
    const char* cA = S.a_base(cur); const char* cB = S.b_base(cur);
    if constexpr (Sched::COUNTED) { if (wid == 0) pre = S.peek(cur); S.a_ready(cur, wid, pre); }
    PG8_STAGE_B(PG8_SB(0, 0), cB); PG8_STAGE_B(PG8_SB(0, 1), cB + hstepB); PG8_STAGE_AH(PG8_SA(0, 0), cA, vA, 0); PG8_STAGE_AH(PG8_SA(0, 1), cA, vA, 1);
    if (wr == 1) PG8_BAR;
    PG8_WAIT_V(2); PG8_BAR;
    PG8_STAGE_B(PG8_SB(1, 0), cB + kstep); PG8_STAGE_AH(PG8_SA(1, 0), cA + kstep, vA, 0); PG8_STAGE_B(PG8_SB(1, 1), cB + hstepB + kstep);
    PG8_WAIT_V(6); PG8_BAR;
    int hc = 0;
    for (;;) {
        const bool has_next = S.next(ui + 1, nxt); const int hn = (hc == 2) ? 0 : hc + 1;
        const char* nA = cA; const char* nB = cB;
        if (has_next) { nA = S.a_base(nxt); nB = S.b_base(nxt); if constexpr (Sched::HDR) { if (wid == 0) S.hdr_issue(nxt, hdr + hn * 4096, lane); } if constexpr (Sched::COUNTED) { if (wid == 0) pre = S.peek(nxt); } }
        for (int t = 0; t < nt; t += 2) {
            const bool last = (t == nt - 2);
            const char* a1 = cA + (size_t)(t + 1) * kstep;
            const char* a2 = last ? nA : cA + (size_t)(t + 2) * kstep; const char* b2 = last ? nB : cB + (size_t)(t + 2) * kstep;
            const char* a3 = a2 + kstep; const char* b3 = b2 + kstep;
            PG8_LDB(B0, 0, 0); PG8_LDB(B1, 0, 1); PG8_SCHED; PG8_LDA(At, 0, 0); PG8_STAGE_AH(PG8_SA(1, 1), a1, vA, 1);
            if constexpr (Sched::COUNTED) { if (last && has_next) S.a_ready(nxt, wid, pre); }
            if constexpr (GA) { if (last && has_next) S.a_off(nxt, tid, vA, hdr + hn * 4096); }
            PG8_WAIT_V(8); PG8_WAIT_L(0); PG8_BAR; PG8_MMA(0, 0, At, B0); PG8_MMA(0, 1, At, B1); PG8_BAR; PG8_SCHED;
            PG8_LDA(At, 0, 1); PG8_STAGE_B(PG8_SB(0, 0), b2); PG8_STAGE_B(PG8_SB(0, 1), b2 + hstepB); PG8_STAGE_AH(PG8_SA(0, 0), a2, vA, 0);
            PG8_WAIT_V(8); PG8_WAIT_L(0); PG8_BAR; PG8_MMA(1, 0, At, B0); PG8_MMA(1, 1, At, B1); PG8_BAR; PG8_SCHED;
            PG8_LDB(B0, 1, 0); PG8_LDB(B1, 1, 1); PG8_SCHED; PG8_LDA(At, 1, 0); PG8_STAGE_AH(PG8_SA(0, 1), a2, vA, 1);
            PG8_WAIT_V(8); PG8_WAIT_L(0); PG8_BAR; PG8_MMA(0, 0, At, B0); PG8_MMA(0, 1, At, B1); PG8_BAR; PG8_SCHED;
            PG8_LDA(At, 1, 1); PG8_STAGE_B(PG8_SB(1, 0), b3); PG8_STAGE_B(PG8_SB(1, 1), b3 + hstepB); PG8_STAGE_AH(PG8_SA(1, 0), a3, vA, 0);
            PG8_WAIT_V(8); PG8_WAIT_L(0); PG8_BAR; PG8_MMA(1, 0, At, B0); PG8_MMA(1, 1, At, B1); PG8_BAR; PG8_SCHED;
        }
        if (wr == 0) PG8_BAR;
        if constexpr (Sched::PUBLISH) { if (ui > 0) S.publish(prv, lane); }
        { int fr_ = fr, fq_ = fq; asm volatile("" : "+v"(fr_), "+v"(fq_)); E(acc, cur, wr, wc, fr_, fq_, hdr + hc * 4096); }
        if (!has_next) break;
#pragma unroll
        for (int a = 0; a < 2; ++a)
#pragma unroll
            for (int b = 0; b < 2; ++b)
#pragma unroll
                for (int m = 0; m < 4; ++m)
#pragma unroll
                    for (int n = 0; n < 2; ++n) acc[a][b][m][n] = (f32x4){0.f, 0.f, 0.f, 0.f};
        prv = cur; cur = nxt; cA = nA; cB = nB; ++ui; hc = hn;
        if (wr == 1) PG8_BAR;
    }
    PG8_WAIT_V(0);
    if constexpr (Sched::PUBLISH) S.publish(cur, lane);
    PG8_BAR;
#undef PG8_SA
#undef PG8_SB
#undef PG8_STAGE_A
#undef PG8_STAGE_AH
#undef PG8_STAGE_B
#undef PG8_LDA
#undef PG8_LDB
#undef PG8_MMA
#undef PG8_CAT
#undef PG8_FOFF
#undef PG8_WAIT_V
#undef PG8_WAIT_L
#undef PG8_BAR
#undef PG8_SCHED
}
}
struct Args { const float* in[N_IN]; float* out; unsigned char* ws; int ph_lo, ph_hi; };
typedef const __attribute__((address_space(4))) unsigned long long* karg_t;
struct Frame {
    karg_t ka;
    LAS unsigned char* lds;
    volatile LAS unsigned* MISC;
    gu32* ctl;
    unsigned char* ws;
    float* out;
    int tid, lane, wave, vcu, G;
};
#define WSP(T_, off) ((T_*)(F.ws + (off)))
#define KIN(k) ((const float*)F.ka[(k)])
#ifdef DBG_SEL
#define DBG_STAT(k, val) do { const float _v = (val); if ((k) == DBG_SEL) { if (fabsf(_v) < 3e38f) atomicMax((unsigned*)(F.ctl + CW_DBG), __float_as_uint(fabsf(_v))); else atomicAdd((unsigned*)(F.ctl + CW_DBG + 1), 1u); } } while (0)
#else
#define DBG_STAT(k, val) do { } while (0)
#endif
template <class P> __device__ __forceinline__ P launder_uniform(P p) {
    unsigned lo = (unsigned)(unsigned long long)p, hi = (unsigned)((unsigned long long)p >> 32);
    asm volatile("" : "+v"(lo), "+v"(hi));
    lo = __builtin_amdgcn_readfirstlane(lo); hi = __builtin_amdgcn_readfirstlane(hi);
    return (P)(((unsigned long long)hi << 32) | lo);
}
__device__ __forceinline__ void frame_refresh(Frame& F) {
    int t = F.tid; asm volatile("" : "+v"(t)); F.tid = t; F.lane = t & 63; F.wave = __builtin_amdgcn_readfirstlane(t >> 6);
    F.ws = launder_uniform(F.ws); F.ctl = (gu32*)(F.ws + WS_CTL);
    F.out = launder_uniform(F.out);
    F.ka = launder_uniform(F.ka);
}

namespace pg8 {
struct DenseSched {
    static constexpr bool GATHER = false, FP8 = false, HDR = false, COUNTED = false, PUBLISH = false; static constexpr int scaleA = 0, scaleB = 0;
    struct Unit { int pm, pn; };
    __device__ __forceinline__ void hdr_issue(const Unit&, LAS unsigned char*, int) const {}
    const bf16* A; const bf16* Bt; int K; size_t hstepB; int nM, nN, nwg, G, c;
    __device__ __forceinline__ void init(const bf16* A_, const bf16* Bt_, int M, int N, int K_, int G_, int c_) { A = A_; Bt = Bt_; K = K_; hstepB = (size_t)HALF * K_ * 2; nM = M / BM; nN = N / BM; nwg = nM * nN; G = G_; c = c_; }
    __device__ __forceinline__ bool next(int i, Unit& u) const {
        const long L = (long)i * G + c; if (L >= nwg) return false;
        int wgid = (int)L; { const int q = nwg / NXCD, r = nwg % NXCD, xcd = wgid % NXCD, off = wgid / NXCD; wgid = (xcd < r ? xcd * (q + 1) : r * (q + 1) + (xcd - r) * q) + off; }
        const int nig = WGM * nN, gid = wgid / nig, fm = gid * WGM, gsz = (nM - fm) < WGM ? (nM - fm) : WGM;
        u.pm = fm + ((wgid % nig) % gsz); u.pn = (wgid % nig) / gsz; return true;
    }
    __device__ __forceinline__ const char* a_base(const Unit& u) const { return (const char*)A + (size_t)u.pm * BM * K * 2; }
    __device__ __forceinline__ const char* b_base(const Unit& u) const { return (const char*)Bt + (size_t)u.pn * BM * K * 2; }
    __device__ __forceinline__ void a_off(const Unit&, int tid, unsigned (&v)[2][2], const LAS unsigned char*) const {
#pragma unroll
        for (int i = 0; i < 2; ++i) { int R, C; stage_rc(tid * 16 + i * 8192, R, C); v[0][i] = (unsigned)(R * K + C) * 2u; v[1][i] = v[0][i]; }
    }
};
template <int SB> struct DenseSched8T : DenseSched { static constexpr bool GATHER = true, FP8 = true; static constexpr int scaleA = 0x7F7F7F7F, scaleB = SB;
    __device__ __forceinline__ void a_off(const Unit&, int tid, unsigned (&v)[2][2], const LAS unsigned char*) const {
        int t_ = tid; asm volatile("" : "+v"(t_));
#pragma unroll
        for (int i = 0; i < 2; ++i) { int R, C; stage_rc(t_ * 16 + i * 8192, R, C); v[0][i] = (unsigned)(R * K + C) * 2u; v[1][i] = v[0][i] + (unsigned)(HALF * K * 2); }
    }
};
typedef DenseSched8T<0x7A7A7A7A> DenseSched8;
typedef DenseSched8T<0x79797979> DenseSched8b;
struct OutSched : DenseSched8b { static constexpr bool PUBLISH = true; gu32* pan;
    __device__ __forceinline__ void publish(const Unit& u, int lane) const { if (lane == 0) (void)__hip_atomic_fetch_add(pan + u.pm * 16, 1u, RLX_AGENT); } };
struct MoeUnit { int e, mt, nt, cnt; };
struct MoeOrder {
    const volatile LAS unsigned* pfx;
    int NT, G, c;
    __device__ __forceinline__ bool decode(int i, MoeUnit& u) const {
        const int nwg = (int)pfx[32]; const long L = (long)i * G + c; if (L >= nwg) return false;
        int wgid = (int)L; { const int q = nwg / NXCD, r = nwg % NXCD, xcd = wgid % NXCD, off = wgid / NXCD; wgid = (xcd < r ? xcd * (q + 1) : r * (q + 1) + (xcd - r) * q) + off; }
        int e = 0;
#pragma unroll
        for (int st = 16; st >= 1; st >>= 1) e += ((int)pfx[e + st] <= wgid) ? st : 0;
        const int j = wgid - (int)pfx[e];
        u.e = e; u.mt = j / NT; u.nt = j % NT; u.cnt = (int)pfx[40 + e]; return true;
    }
};
#ifndef HDR_AOFF
#define HDR_AOFF 1
#endif
struct Moe1Sched {
    static constexpr bool GATHER = true, FP8 = (MOE_FP8 != 0), HDR = true, COUNTED = false, PUBLISH = (MOE_CHAIN != 0); static constexpr int EB = FP8 ? 1 : 2; static constexpr int scaleA = 0x7F7F7F7F, scaleB = 0x7A7A7A7A;
    typedef MoeUnit Unit;
    MoeOrder O; const unsigned char* X; const unsigned char* W; const int* sdest; const float* bgu; int K; size_t hstepB; gu32* pan;
    __device__ __forceinline__ void publish(const Unit& u, int lane) const { if (lane == 0) (void)__hip_atomic_fetch_add(pan + (u.e * 64 + u.mt) * 16, 1u, RLX_AGENT); }
    __device__ __forceinline__ void hdr_issue(const Unit& u, LAS unsigned char* hdr, int lane) const {
        __builtin_amdgcn_global_load_lds((const unsigned*)(sdest + (size_t)u.e * ECAP + (size_t)u.mt * 256 + lane * 4), (LAS unsigned*)hdr, 16, 0, 0);
        const float* bp = bgu + (size_t)u.e * 2048 + u.nt * 128 + (lane < 32 ? lane * 4 : 1024 + (lane - 32) * 4);
        __builtin_amdgcn_global_load_lds((const unsigned*)bp, (LAS unsigned*)(hdr + 1024), 16, 0, 0);
    }
    __device__ __forceinline__ bool next(int i, Unit& u) const { return O.decode(i, u); }
    __device__ __forceinline__ const char* a_base(const Unit&) const { return (const char*)X; }
    __device__ __forceinline__ const char* b_base(const Unit& u) const { return (const char*)W + ((size_t)u.e * 2048 + (size_t)u.nt * 128) * 1024 * EB; }
    __device__ __forceinline__ void a_off(const Unit& u, int tid, unsigned (&v)[2][2], const LAS unsigned char* hdr) const {
#pragma unroll
        for (int i = 0; i < 2; ++i) { int R, C; stage_rc(tid * 16 + i * 8192, R, C);
#pragma unroll
            for (int h = 0; h < 2; ++h) { const int sl = h * HALF + R; int tok = 0; if (u.mt * 256 + sl < u.cnt) tok = HDR_AOFF ? (((const LAS int*)hdr)[sl] >> 2) : (sdest[u.e * ECAP + u.mt * 256 + sl] >> 2); v[h][i] = (unsigned)(tok * 1024 * EB + C * 2); } }
    }
};
struct Moe2Sched {
    static constexpr bool GATHER = true, FP8 = (MOE2_FP8 != 0), HDR = true, COUNTED = (MOE_CHAIN != 0), PUBLISH = false; static constexpr int EB = FP8 ? 1 : 2; static constexpr int scaleA = 0x7F7F7F7F, scaleB = 0x79797979;
    typedef MoeUnit Unit;
    MoeOrder O; const unsigned char* Ab; const unsigned char* W; const int* sdest; const float* sgate; const float* bdn; int K; size_t hstepB; gu32* pan; gu32* tmo;
    __device__ __forceinline__ unsigned peek(const Unit& u) const { return __hip_atomic_load(pan + (u.e * 64 + u.mt) * 16, RLX_AGENT); }
    __device__ __forceinline__ void a_ready(const Unit& u, int wid, unsigned pre) const {
        if (wid == 0) {
            if ((unsigned)__builtin_amdgcn_readfirstlane(pre) < 64u) { unsigned sp = 0u;
                while ((unsigned)__builtin_amdgcn_readfirstlane(__hip_atomic_load(pan + (u.e * 64 + u.mt) * 16, RLX_AGENT)) < 64u) { __builtin_amdgcn_s_sleep(2);
                    if ((++sp & 255u) == 0u) { if (__hip_atomic_load(tmo, RLX_AGENT)) break; if (sp > (1u << 18)) { atomicAdd((unsigned*)tmo, 1u); break; } } } }
            __builtin_amdgcn_fence(__ATOMIC_ACQUIRE, "agent"); asm volatile("s_waitcnt vmcnt(0)" ::: "memory");
        }
        asm volatile("" ::: "memory"); __builtin_amdgcn_s_barrier(); asm volatile("" ::: "memory");
    }
    __device__ __forceinline__ void hdr_issue(const Unit& u, LAS unsigned char* hdr, int lane) const {
        const size_t so = (size_t)u.e * ECAP + (size_t)u.mt * 256 + lane * 4;
        __builtin_amdgcn_global_load_lds((const unsigned*)(sdest + so), (LAS unsigned*)hdr, 16, 0, 0);
        __builtin_amdgcn_global_load_lds((const unsigned*)(sgate + so), (LAS unsigned*)(hdr + 1024), 16, 0, 0);
        __builtin_amdgcn_global_load_lds((const unsigned*)(bdn + (size_t)u.e * 1024 + u.nt * 256 + lane * 4), (LAS unsigned*)(hdr + 2048), 16, 0, 0);
    }
    __device__ __forceinline__ bool next(int i, Unit& u) const { return O.decode(i, u); }
    __device__ __forceinline__ const char* a_base(const Unit& u) const { return (const char*)Ab + ((size_t)u.e * ECAP + (size_t)u.mt * 256) * 1024 * EB; }
    __device__ __forceinline__ const char* b_base(const Unit& u) const { return (const char*)W + ((size_t)u.e * 1024 + (size_t)u.nt * 256) * 1024 * EB; }
    __device__ __forceinline__ void a_off(const Unit&, int tid, unsigned (&v)[2][2], const LAS unsigned char*) const {
        int t_ = tid; asm volatile("" : "+v"(t_));
#pragma unroll
        for (int i = 0; i < 2; ++i) { int R, C; stage_rc(t_ * 16 + i * 8192, R, C); v[0][i] = (unsigned)(R * 1024 * EB + C * 2); v[1][i] = v[0][i] + (unsigned)(HALF * 1024 * EB); }
    }
};

__device__ __forceinline__ void unpack8(const v4u w, f32x4& a, f32x4& b) {
    a = (f32x4){__uint_as_float(w.x << 16), __uint_as_float(w.x & 0xffff0000u), __uint_as_float(w.y << 16), __uint_as_float(w.y & 0xffff0000u)};
    b = (f32x4){__uint_as_float(w.z << 16), __uint_as_float(w.z & 0xffff0000u), __uint_as_float(w.w << 16), __uint_as_float(w.w & 0xffff0000u)}; }
struct EpiF32 {
    static constexpr bool PERM = false;
    float* C; int ldc; const float* base; float alpha;
    __device__ __forceinline__ void operator()(const f32x4 (&acc)[2][2][4][2], const DenseSched::Unit& u, int wr, int wc, int fr, int fq, const LAS unsigned char* hdr) const {
        const int row0 = u.pm * BM + wr * 64 + fr, col0 = u.pn * BM + wc * 32 + 4 * fq;
#pragma unroll
        for (int ai = 0; ai < 2; ++ai)
#pragma unroll
            for (int m = 0; m < 4; ++m) { const size_t ro = (size_t)(row0 + ai * HALF + m * 16) * ldc + col0;
#pragma unroll
                for (int bj = 0; bj < 2; ++bj)
#pragma unroll
                    for (int n = 0; n < 2; ++n) { f32x4 v = acc[ai][bj][m][n];
                        if (base) { const f32x4 b = *(const f32x4*)(base + ro + bj * HALF + n * 16); v = v + b * alpha; }
                        *(f32x4*)(C + ro + bj * HALF + n * 16) = v; } }
    }
};
template <bool WT> struct EpiB16T {
    static constexpr bool PERM = true;
    bf16* O; int ldc; const bf16* base; float alpha;
    __device__ __forceinline__ void operator()(const f32x4 (&acc)[2][2][4][2], const DenseSched::Unit& u, int wr, int wc, int fr, int fq, const LAS unsigned char* hdr) const {
        const int row0 = u.pm * BM + wr * 64 + fr, col0 = u.pn * BM + wc * 32 + 8 * fq;
#pragma unroll
        for (int ai = 0; ai < 2; ++ai) {
            v4u bw[4][2];
            if (base) {
#pragma unroll
                for (int m = 0; m < 4; ++m)
#pragma unroll
                    for (int bj = 0; bj < 2; ++bj) bw[m][bj] = *(const v4u*)(base + (size_t)(row0 + ai * HALF + m * 16) * ldc + col0 + bj * HALF); }
#pragma unroll
            for (int m = 0; m < 4; ++m) { bf16* rowp = O + (size_t)(row0 + ai * HALF + m * 16) * ldc + col0;
#pragma unroll
                for (int bj = 0; bj < 2; ++bj) { f32x4 v0 = acc[ai][bj][m][0], v1 = acc[ai][bj][m][1];
                    if (base) { f32x4 b0, b1; unpack8(bw[m][bj], b0, b1); v0 = v0 + b0 * alpha; v1 = v1 + b1 * alpha; }
                    v4u w; w.x = cvt_pk_bf16(v0[0], v0[1]); w.y = cvt_pk_bf16(v0[2], v0[3]); w.z = cvt_pk_bf16(v1[0], v1[1]); w.w = cvt_pk_bf16(v1[2], v1[3]);
                    if constexpr (WT) { bf16* sp_ = rowp + bj * HALF; asm volatile("global_store_dwordx4 %0, %1, off sc1\n\ts_nop 1" :: "v"(sp_), "v"(w) : "memory"); }
                    else *(v4u*)(rowp + bj * HALF) = w; } } }
    }
};
typedef EpiB16T<false> EpiB16; typedef EpiB16T<true> EpiB16W;
struct EpiPle {
    static constexpr bool PERM = true;
    bf16* C; const bf16* hb; const bf16* pe;
    __device__ __forceinline__ void operator()(const f32x4 (&acc)[2][2][4][2], const DenseSched::Unit& u, int wr, int wc, int fr, int fq, const LAS unsigned char* hdr) const {
        const int row0 = u.pm * BM + wr * 64 + fr, col0 = u.pn * BM + wc * 32 + 8 * fq;
#pragma unroll
        for (int ai = 0; ai < 2; ++ai) {
            v4u hw[4][2], pw[4][2];
#pragma unroll
            for (int m = 0; m < 4; ++m)
#pragma unroll
                for (int bj = 0; bj < 2; ++bj) { const size_t ro = (size_t)(row0 + ai * HALF + m * 16) * 1024 + col0 + bj * HALF; hw[m][bj] = *(const v4u*)(hb + ro); pw[m][bj] = *(const v4u*)(pe + ro); }
#pragma unroll
            for (int m = 0; m < 4; ++m)
#pragma unroll
                for (int bj = 0; bj < 2; ++bj) { const size_t ro = (size_t)(row0 + ai * HALF + m * 16) * 1024 + col0 + bj * HALF;
                    f32x4 h0, h1, p0, p1; unpack8(hw[m][bj], h0, h1); unpack8(pw[m][bj], p0, p1); const f32x4 a0 = acc[ai][bj][m][0], a1 = acc[ai][bj][m][1];
                    f32x4 o0, o1;
#pragma unroll
                    for (int j = 0; j < 4; ++j) { o0[j] = h0[j] + sigmoidf_(a0[j]) * p0[j]; o1[j] = h1[j] + sigmoidf_(a1[j]) * p1[j]; }
                    v4u w; w.x = cvt_pk_bf16(o0[0], o0[1]); w.y = cvt_pk_bf16(o0[2], o0[3]); w.z = cvt_pk_bf16(o1[0], o1[1]); w.w = cvt_pk_bf16(o1[2], o1[3]);
                    *(v4u*)(C + ro) = w; } }
    }
};
struct EpiMoe1 {
    static constexpr bool PERM = true;
    bf16* Ab; const float* bgu; unsigned char* AbQ;
    __device__ __forceinline__ void operator()(const f32x4 (&acc)[2][2][4][2], const MoeUnit& u, int wr, int wc, int fr, int fq, const LAS unsigned char* hdr) const {
        const int col0 = u.nt * 128 + wc * 32 + 8 * fq;
        const LAS float* bh = (const LAS float*)(hdr + 1024) + wc * 32 + 8 * fq;
        const f32x4 bg0 = *(const LAS f32x4*)(bh), bg1 = *(const LAS f32x4*)(bh + 4), bl0 = *(const LAS f32x4*)(bh + 128), bl1 = *(const LAS f32x4*)(bh + 132);
#pragma unroll
        for (int ai = 0; ai < 2; ++ai)
#pragma unroll
            for (int m = 0; m < 4; ++m) { const int r = ai * HALF + wr * 64 + m * 16 + fr;
                bf16* rowp = Ab + ((size_t)u.e * ECAP + (size_t)u.mt * 256 + r) * 1024 + col0;
                float o[8];
#pragma unroll
                for (int n = 0; n < 2; ++n) { const f32x4 g4 = acc[ai][0][m][n] + (n ? bg1 : bg0), l4 = acc[ai][1][m][n] + (n ? bl1 : bl0);
#pragma unroll
                    for (int j = 0; j < 4; ++j) { const float g = fminf(g4[j], 7.0f), l = fminf(fmaxf(l4[j], -7.0f), 7.0f); o[n * 4 + j] = (l + 1.0f) * g * sigmoidf_(1.702f * g); } }
                if constexpr (MOE2_FP8) { v2u q; q.x = cvt4_fp8(o[0], o[1], o[2], o[3]); q.y = cvt4_fp8(o[4], o[5], o[6], o[7]); unsigned char* qp = (unsigned char*)AbQ + ((size_t)u.e * ECAP + (size_t)u.mt * 256 + r) * 1024 + col0;
                    if (MOE_CHAIN) asm volatile("global_store_dwordx2 %0, %1, off sc1" :: "v"(qp), "v"(q) : "memory");
                    else *(v2u*)qp = q; }
                else *(v4u*)rowp = pack8(o); }
    }
};
struct EpiMoe2 {
    static constexpr bool PERM = true;
    bf16* Y; const float* bdn; const int* sdest; const float* sgate;
    __device__ __forceinline__ void operator()(const f32x4 (&acc)[2][2][4][2], const MoeUnit& u, int wr, int wc, int fr, int fq, const LAS unsigned char* hdr) const {
        const int col0 = u.nt * 256 + wc * 32 + 8 * fq;
        const LAS float* bp = (const LAS float*)(hdr + 2048) + wc * 32 + 8 * fq;
#pragma unroll
        for (int ai = 0; ai < 2; ++ai) {
            f32x4 bv[2][2];
#pragma unroll
            for (int bj = 0; bj < 2; ++bj)
#pragma unroll
                for (int n = 0; n < 2; ++n) bv[bj][n] = *(const LAS f32x4*)(bp + bj * HALF + 4 * n);
            int dest[4]; float gate[4];
#pragma unroll
            for (int m = 0; m < 4; ++m) { const int sl = ai * HALF + wr * 64 + m * 16 + fr; const bool ok = u.mt * 256 + sl < u.cnt;
                dest[m] = ok ? ((const LAS int*)hdr)[sl] : T * 4; gate[m] = ok ? ((const LAS float*)(hdr + 1024))[sl] : 0.f; }
#pragma unroll
            for (int m = 0; m < 4; ++m) {
                { const float g = gate[m]; bf16* rowp = Y + (size_t)dest[m] * 1024 + col0;
#pragma unroll
                    for (int bj = 0; bj < 2; ++bj) { const f32x4 v0 = (acc[ai][bj][m][0] + bv[bj][0]) * g, v1 = (acc[ai][bj][m][1] + bv[bj][1]) * g;
                        v4u w; w.x = cvt_pk_bf16(v0[0], v0[1]); w.y = cvt_pk_bf16(v0[2], v0[3]); w.z = cvt_pk_bf16(v1[0], v1[1]); w.w = cvt_pk_bf16(v1[2], v1[3]);
                        *(v4u*)(rowp + bj * HALF) = w; } } } }
    }
};
}

__device__ __forceinline__ void p0_transpose_item(const float* W, int K, int N, int nblk, bf16* WT, int item, int lane) {
    const int kb = item / nblk, nb = item % nblk, k0 = 64 * kb, n = 64 * nb + lane;
    const bool ok = n < N; const float* src = W + (size_t)k0 * N + (ok ? n : 0);
    float x[64];
#pragma unroll
    for (int j = 0; j < 64; ++j) x[j] = __builtin_nontemporal_load(src + (size_t)j * N);
    bf16* dst = WT + (size_t)n * K + k0;
#pragma unroll
    for (int q = 0; q < 8; ++q) { v4u o; o.x = cvt_pk_bf16(x[8 * q], x[8 * q + 1]); o.y = cvt_pk_bf16(x[8 * q + 2], x[8 * q + 3]); o.z = cvt_pk_bf16(x[8 * q + 4], x[8 * q + 5]); o.w = cvt_pk_bf16(x[8 * q + 6], x[8 * q + 7]);
        if (!ok) o = (v4u){0u, 0u, 0u, 0u};
        *(v4u*)(dst + 8 * q) = o; }
}
__device__ __forceinline__ void cvt_rows(const float* src, bf16* dst, size_t n8, size_t i0, size_t stride) {
    for (size_t i = i0; i < n8; i += stride) { const f32x4 a = *(const f32x4*)(src + i * 8), b = *(const f32x4*)(src + i * 8 + 4);
        v4u o; o.x = cvt_pk_bf16(a.x, a.y); o.y = cvt_pk_bf16(a.z, a.w); o.z = cvt_pk_bf16(b.x, b.y); o.w = cvt_pk_bf16(b.z, b.w); *(v4u*)(dst + i * 8) = o; }
}
__device__ __forceinline__ void p0_prologue(Frame& F, const Args& A) {
    const int gw = F.vcu * NWAVES + F.wave, NGW = F.G * NWAVES;
    constexpr int I_IN = 16 * (NUP / 64), I_OUT = 16 * 16, I_GU = 16 * 32, I_DN = 16 * 16, I_PG = 16 * 16, I_PP = 4 * 16;
    constexpr int PER_LAYER = I_IN + I_OUT + NE * I_GU + NE * I_DN + I_PG + I_PP;
#pragma unroll 1
    for (int it = gw; it < DEPTH * PER_LAYER; it += NGW) {
        const int l = it / PER_LAYER; int r = it % PER_LAYER;
        const float* W; bf16* WT; int K = D, N = D, nblk = 16;
        if (r < I_IN) { W = KIN(I_WIN) + (size_t)l * D * NU; WT = WSP(bf16, WS_WIN_T) + (size_t)l * NUP * D; N = NU; nblk = NUP / 64; }
        else if ((r -= I_IN) < I_OUT) { if (OUT_FP8) continue; W = KIN(I_WOUT) + (size_t)l * D * D; WT = WSP(bf16, WS_WOUT_T) + (size_t)l * D * D; }
        else if ((r -= I_OUT) < NE * I_GU) { if (MOE_FP8) continue; const int e = r / I_GU; r %= I_GU; W = KIN(I_WGU) + ((size_t)l * NE + e) * D * 2048; WT = WSP(bf16, WS_WGU_T) + ((size_t)l * NE + e) * 2048 * D; N = 2048; nblk = 32; }
        else if ((r -= NE * I_GU) < NE * I_DN) { if (MOE2_FP8) continue; const int e = r / I_DN; r %= I_DN; W = KIN(I_WDN) + ((size_t)l * NE + e) * D * D; WT = WSP(bf16, WS_WDN_T) + ((size_t)l * NE + e) * D * D; }
        else if ((r -= NE * I_DN) < I_PG) { if (PLE_FP8) continue; W = KIN(I_PGW) + (size_t)l * D * D; WT = WSP(bf16, WS_WPG_T) + (size_t)l * D * D; }
        else { r -= I_PG; W = KIN(I_PPJ) + (size_t)l * 256 * D; WT = WSP(bf16, WS_WPP_T) + (size_t)l * D * 256; K = 256; }
        p0_transpose_item(W, K, N, nblk, WT, r, F.lane);
    }
#if MOE_FP8
    constexpr int Q_GU = 16 * 32, Q_DN = 16 * 16, Q_PG = PLE_FP8 ? 16 * 16 : 0, Q_OUT = OUT_FP8 ? 16 * 16 : 0, Q_PER_LAYER = NE * (Q_GU + Q_DN) + Q_PG + Q_OUT;
#pragma unroll 1
    for (int it = gw; it < DEPTH * Q_PER_LAYER; it += NGW) {
        const int l = it / Q_PER_LAYER; int r = it % Q_PER_LAYER; const float* W; unsigned char* WQ; int N; float sc;
        if (r < NE * Q_GU) { const int e = r / Q_GU; r %= Q_GU; W = KIN(I_WGU) + ((size_t)l * NE + e) * D * 2048; WQ = WSP(unsigned char, WS_WGU_Q) + ((size_t)l * NE + e) * 2048 * D; N = 2048; sc = 32.0f; }
        else if (r >= NE * (Q_GU + Q_DN) + Q_PG) { r -= NE * (Q_GU + Q_DN) + Q_PG; W = KIN(I_WOUT) + (size_t)l * D * D; WQ = WSP(unsigned char, WS_WOUT_Q) + (size_t)l * D * D; N = D; sc = 64.0f; }
        else if (r >= NE * (Q_GU + Q_DN)) { r -= NE * (Q_GU + Q_DN); W = KIN(I_PGW) + (size_t)l * D * D; WQ = WSP(unsigned char, WS_WPG_Q) + (size_t)l * D * D; N = D; sc = 32.0f; }
        else { if (!MOE2_FP8) continue; r -= NE * Q_GU; const int e = r / Q_DN; r %= Q_DN; W = KIN(I_WDN) + ((size_t)l * NE + e) * D * D; WQ = WSP(unsigned char, WS_WDN_Q) + ((size_t)l * NE + e) * D * D; N = D; sc = 64.0f; }
        const int nblk = N / 64, kb = r / nblk, nb = r % nblk, k0 = 64 * kb, n = 64 * nb + F.lane;
        const float* src = W + (size_t)k0 * N + n; float x[64];
#pragma unroll
        for (int j = 0; j < 64; ++j) x[j] = __builtin_nontemporal_load(src + (size_t)j * N) * sc;
        unsigned char* dst = WQ + (size_t)n * D + k0;
#pragma unroll
        for (int q = 0; q < 4; ++q) { v4u o; o.x = cvt4_fp8(x[16 * q], x[16 * q + 1], x[16 * q + 2], x[16 * q + 3]); o.y = cvt4_fp8(x[16 * q + 4], x[16 * q + 5], x[16 * q + 6], x[16 * q + 7]);
            o.z = cvt4_fp8(x[16 * q + 8], x[16 * q + 9], x[16 * q + 10], x[16 * q + 11]); o.w = cvt4_fp8(x[16 * q + 12], x[16 * q + 13], x[16 * q + 14], x[16 * q + 15]); *(v4u*)(dst + 16 * q) = o; }
    }
#endif
    const size_t gt = (size_t)F.vcu * (NWAVES * 64) + F.tid, NT_ = (size_t)F.G * NWAVES * 64;
    cvt_rows(KIN(I_P), WSP(bf16, WS_PB), (size_t)DEPTH * T * 256 / 8, gt, NT_);
    cvt_rows(KIN(I_X), WSP(bf16, WS_XB), (size_t)T * D / 8, gt, NT_);
    for (size_t i = gt; i < (size_t)DEPTH * LORA_PER_LAYER; i += NT_) { const int l = (int)(i / LORA_PER_LAYER); int r = (int)(i % LORA_PER_LAYER); float v;
        if (r < 8192) { const int ch = r >> 5, j = r & 31; v = KIN(I_RWUP)[(size_t)l * 8192 + j * 256 + ch]; }
        else if (r < 16384) { r -= 8192; const int ch = r >> 5, j = r & 31; v = KIN(I_RAUP)[(size_t)l * 8192 + j * 256 + ch]; }
        else if (r < 32768) { r -= 16384; const int ch = r >> 6, j = r & 63; v = KIN(I_RGUP)[(size_t)l * 16384 + j * 256 + ch]; }
        else { r -= 32768; const int d = r >> 4, j = r & 15; v = KIN(I_GGUP)[(size_t)l * 2048 + j * 128 + d]; }
        WSP(float, WS_LORA)[i] = v; }
#if P6_MFMA
    for (size_t i = gt; i < (size_t)DEPTH * 32768; i += NT_) { const int l = (int)(i >> 15), r = (int)(i & 32767), c = r >> 8, e = (r >> 3) & 31, k = 8 * c + (r & 7);
        const float v = KIN(I_RTW)[(size_t)l * D * NE + (size_t)k * NE + e]; const unsigned h = cvt_pk_bf16(v, 0.f) & 0xffffu; const unsigned lo = cvt_pk_bf16(v - __uint_as_float(h << 16), 0.f) & 0xffffu;
        unsigned short* dst = WSP(unsigned short, WS_RWT) + (size_t)l * 65536 + r; dst[0] = (unsigned short)h; dst[32768] = (unsigned short)lo; }
#else
    for (size_t i = gt; i < (size_t)DEPTH * NE * D; i += NT_) { const int l = (int)(i / (NE * D)), r = (int)(i % (NE * D)), e = r / D, k = r % D; WSP(float, WS_RWT)[i] = KIN(I_RTW)[(size_t)l * D * NE + (size_t)k * NE + e]; }
#endif
}

#if P6_MFMA
template <bool DRY> __device__ __forceinline__ void p6_ln1_router(Frame& F, const Args& A, int layer, const gu32* pan = nullptr) {
    const bf16* y1 = WSP(bf16, WS_Y1); bf16* x1b = WSP(bf16, WS_X1B);
    const float* gam = KIN(I_LN1G) + layer * D; const float* bet = KIN(I_LN1B) + layer * D;
    const unsigned char* rwq = WSP(unsigned char, WS_RWT) + (size_t)layer * 131072; const float* rb = KIN(I_RTB) + layer * NE;
    int* sdest = WSP(int, WS_SDEST); float* sgate = WSP(float, WS_SGATE);
    unsigned* cnt = (unsigned*)(F.ctl + CW_CNT + layer * NE * 16);
    LAS unsigned char* WL = F.lds;
    LAS float* LG = (LAS float*)(F.lds + 131072);
    LAS float* TOPV = (LAS float*)(F.lds + 139264) + F.wave * 64;
    LAS int* TOPE = (LAS int*)(F.lds + 139264 + 2048) + F.wave * 64;
    LAS float* STAT = (LAS float*)(F.lds + 143360);
    volatile LAS unsigned* lcnt = F.MISC + MW_LCNT; volatile LAS unsigned* lbase = F.MISC + MW_LBASE;
    { const int l0 = F.lane;
#pragma unroll
      for (int i = 0; i < 16; ++i) { const int off = (F.wave * 16 + i) * 1024; __builtin_amdgcn_global_load_lds((const unsigned*)(rwq + off + l0 * 16), (LAS unsigned*)(WL + off), 16, 0, 0); } }
    const int lane = F.lane, m = lane & 15, g = lane >> 4, rq = F.wave & 3, kh = F.wave >> 2;
    for (int blk = F.vcu; blk < T / 64; blk += F.G) {
        if (F.tid < 32) lcnt[F.tid] = 0u;
        if (OUT_CHAIN && pan) {
            if (F.wave == 0) { const gu32* w = pan + (blk >> 2) * 16; unsigned sp = 0u;
                while ((unsigned)__builtin_amdgcn_readfirstlane(__hip_atomic_load(w, RLX_AGENT)) < 32u) { __builtin_amdgcn_s_sleep(2);
                    if ((++sp & 255u) == 0u) { if (__hip_atomic_load(F.ctl + CW_BAR + XB_TMO, RLX_AGENT)) break; if (sp > (1u << 18)) { atomicAdd((unsigned*)(F.ctl + CW_BAR + XB_TMO), 1u); break; } } }
                __builtin_amdgcn_fence(__ATOMIC_ACQUIRE, "agent"); asm volatile("s_waitcnt vmcnt(0)" ::: "memory"); }
            __syncthreads(); }
        const int row = blk * 64 + rq * 16 + m; const size_t ro = (size_t)row * D + 512 * kh + 8 * g;
        v4u yw[16];
#pragma unroll
        for (int kk = 0; kk < 16; ++kk) yw[kk] = *(const v4u*)(y1 + ro + 32 * kk);
        float s = 0.f, s2 = 0.f;
#pragma unroll
        for (int kk = 0; kk < 16; ++kk) { f32x4 a, b; pg8::unpack8(yw[kk], a, b); s += ((a.x + a.y) + (a.z + a.w)) + ((b.x + b.y) + (b.z + b.w));
            s2 += ((a.x * a.x + a.y * a.y) + (a.z * a.z + a.w * a.w)) + ((b.x * b.x + b.y * b.y) + (b.z * b.z + b.w * b.w)); }
        s += __shfl_xor(s, 16); s += __shfl_xor(s, 32); s2 += __shfl_xor(s2, 16); s2 += __shfl_xor(s2, 32);
        if (g == 0) { STAT[(kh * 64 + rq * 16 + m) * 2] = s; STAT[(kh * 64 + rq * 16 + m) * 2 + 1] = s2; }
        asm volatile("s_waitcnt vmcnt(0)" ::: "memory");
        __syncthreads();
        const float st = STAT[(rq * 16 + m) * 2] + STAT[(64 + rq * 16 + m) * 2], st2 = STAT[(rq * 16 + m) * 2 + 1] + STAT[(64 + rq * 16 + m) * 2 + 1];
        const float mean = st * (1.f / D); const float rstd = __builtin_amdgcn_rsqf(fmaxf(st2 * (1.f / D) - mean * mean, 0.f) + LN_EPS);
        f32x4 acc[2] = {(f32x4){0.f, 0.f, 0.f, 0.f}, (f32x4){0.f, 0.f, 0.f, 0.f}}; const float* gp = gam; const float* bp = bet;
#pragma unroll
        for (int kk = 0; kk < 16; ++kk) { const int k0 = 512 * kh + 32 * kk + 8 * g;
            if ((kk & 3) == 0) { gp = launder_uniform(gp); bp = launder_uniform(bp); }
            const f32x4 ga = *(const f32x4*)(gp + k0), gb = *(const f32x4*)(gp + k0 + 4), ba = *(const f32x4*)(bp + k0), bb = *(const f32x4*)(bp + k0 + 4);
            f32x4 a, b; { v4u yk = yw[kk]; asm volatile("" : "+v"(yk)); pg8::unpack8(yk, a, b); }
            a = (a - mean) * rstd * ga + ba; b = (b - mean) * rstd * gb + bb;
            v4u hw; hw.x = cvt_pk_bf16(a.x, a.y); hw.y = cvt_pk_bf16(a.z, a.w); hw.z = cvt_pk_bf16(b.x, b.y); hw.w = cvt_pk_bf16(b.z, b.w);
            *(v4u*)(x1b + (size_t)row * D + k0) = hw;
            if (MOE_FP8) { v2u q; q.x = cvt4_fp8(a.x, a.y, a.z, a.w); q.y = cvt4_fp8(b.x, b.y, b.z, b.w); *(v2u*)(WSP(unsigned char, WS_X1Q) + (size_t)row * D + k0) = q; }
            f32x4 ha, hb_; pg8::unpack8(hw, ha, hb_); a = a - ha; b = b - hb_;
            v4u lw; lw.x = cvt_pk_bf16(a.x, a.y); lw.y = cvt_pk_bf16(a.z, a.w); lw.z = cvt_pk_bf16(b.x, b.y); lw.w = cvt_pk_bf16(b.z, b.w);
            const bf16x8 xh = __builtin_bit_cast(bf16x8, hw), xl = __builtin_bit_cast(bf16x8, lw);
            const int c = kh * 64 + kk * 4 + g;
#pragma unroll
            for (int nt = 0; nt < 2; ++nt) { const bf16x8 wh = *(const LAS bf16x8*)(WL + (c * 32 + nt * 16 + m) * 16), wl = *(const LAS bf16x8*)(WL + 65536 + (c * 32 + nt * 16 + m) * 16);
                acc[nt] = __builtin_amdgcn_mfma_f32_16x16x32_bf16(wh, xh, acc[nt], 0, 0, 0);
                acc[nt] = __builtin_amdgcn_mfma_f32_16x16x32_bf16(wl, xh, acc[nt], 0, 0, 0);
                acc[nt] = __builtin_amdgcn_mfma_f32_16x16x32_bf16(wh, xl, acc[nt], 0, 0, 0); } }
        if (kh == 1) {
#pragma unroll
            for (int nt = 0; nt < 2; ++nt) *(LAS f32x4*)(LG + (rq * 16 + m) * 32 + nt * 16 + 4 * g) = acc[nt]; }
        __syncthreads();
        if (kh == 0) {
#pragma unroll
            for (int nt = 0; nt < 2; ++nt) { const f32x4 o = *(const LAS f32x4*)(LG + (rq * 16 + m) * 32 + nt * 16 + 4 * g); const f32x4 rbv = *(const f32x4*)(rb + nt * 16 + 4 * g);
                *(LAS f32x4*)(LG + (rq * 16 + m) * 32 + nt * 16 + 4 * g) = o + acc[nt] + rbv; } }
        __syncthreads();
        int lane2 = lane; asm volatile("" : "+v"(lane2)); const int sub = lane2 & 15;
#pragma unroll 1
        for (int rg = 0; rg < 2; ++rg) {
            float lg[32];
            { const LAS float* lr = LG + (F.wave * 8 + rg * 4 + (lane2 >> 4)) * 32;
#pragma unroll
              for (int q = 0; q < 8; ++q) { const f32x4 t4 = *(const LAS f32x4*)(lr + 4 * q); lg[4 * q] = t4.x; lg[4 * q + 1] = t4.y; lg[4 * q + 2] = t4.z; lg[4 * q + 3] = t4.w; } }
            float la = 0.f, lb_ = 0.f;
#pragma unroll
            for (int e = 0; e < 32; ++e) { if (e == 2 * sub) la = lg[e]; if (e == 2 * sub + 1) lb_ = lg[e]; }
            int ra = 0, rbk = 0;
#pragma unroll
            for (int e = 0; e < 32; ++e) { ra += (lg[e] > la || (lg[e] == la && e < 2 * sub)) ? 1 : 0; rbk += (lg[e] > lb_ || (lg[e] == lb_ && e < 2 * sub + 1)) ? 1 : 0; }
            const int rowl = rg * 4 + (lane2 >> 4);
            if (ra < 4) { TOPV[rowl * 4 + ra] = la; TOPE[rowl * 4 + ra] = 2 * sub; }
            if (rbk < 4) { TOPV[rowl * 4 + rbk] = lb_; TOPE[rowl * 4 + rbk] = 2 * sub + 1; }
        }
        LDS_WAIT();
        int my_e = 0; float my_g = 0.f; unsigned my_r = 0u;
        if (lane2 < 32) { const int ri = lane2 >> 2, k = lane2 & 3; const f32x4 tv = *(const LAS f32x4*)(TOPV + ri * 4);
            const float e1 = __expf(tv.y - tv.x), e2 = __expf(tv.z - tv.x), e3 = __expf(tv.w - tv.x); const float inv = __builtin_amdgcn_rcpf(1.0f + e1 + e2 + e3);
            my_e = TOPE[ri * 4 + k]; my_g = (k == 0 ? 1.0f : k == 1 ? e1 : k == 2 ? e2 : e3) * inv;
            my_r = DRY ? 0u : atomicAdd((unsigned*)&lcnt[my_e], 1u); }
        __syncthreads();
        if (!DRY && F.wave == 0 && lane2 < 32) { const unsigned n = lcnt[lane2]; lbase[lane2] = n ? __hip_atomic_fetch_add(cnt + lane2 * 16, n, RLX_AGENT) : 0u; }
        __syncthreads();
        if (!DRY && lane2 < 32) { const int rw = blk * 64 + F.wave * 8 + (lane2 >> 2); const unsigned slot = (unsigned)my_e * ECAP + lbase[my_e] + my_r;
            sdest[slot] = rw * 4 + (lane2 & 3); sgate[slot] = my_g; }
        __syncthreads();
    }
}
#else
template <bool DRY> __device__ __forceinline__ void p6_ln1_router(Frame& F, const Args& A, int layer) {
    const bf16* y1 = WSP(bf16, WS_Y1); bf16* x1b = WSP(bf16, WS_X1B);
    const float* g = KIN(I_LN1G) + layer * D; const float* bb = KIN(I_LN1B) + layer * D;
    const float* rwt = WSP(float, WS_RWT) + (size_t)layer * NE * D; const float* rb = KIN(I_RTB) + layer * NE;
    int* sdest = WSP(int, WS_SDEST); float* sgate = WSP(float, WS_SGATE);
    unsigned* cnt = (unsigned*)(F.ctl + CW_CNT + layer * NE * 16);
    LAS float* RWT = (LAS float*)F.lds;
    LAS float* TOPV = (LAS float*)(F.lds + 131072) + F.wave * 64;
    LAS int* TOPE = (LAS int*)(F.lds + 131072 + 2048) + F.wave * 64;
    volatile LAS unsigned* lcnt = F.MISC + MW_LCNT; volatile LAS unsigned* lbase = F.MISC + MW_LBASE;
    for (int i = F.tid; i < NE * D / 4; i += NWAVES * 64) ((LAS f32x4*)RWT)[i] = ((const f32x4*)rwt)[i];
    const int lane = F.lane, sub = lane & 15;
    for (int blk = F.vcu; blk < T / 64; blk += F.G) {
        if (F.tid < 32) lcnt[F.tid] = 0u;
        __syncthreads();
#pragma unroll 1
        for (int rg = 0; rg < 2; ++rg) {
            f32x4 v[4][4];
            { int lo_ = lane; asm volatile("" : "+v"(lo_));
              const f32x4 gv[4] = { *(const f32x4*)(g + 4 * lo_), *(const f32x4*)(g + 256 + 4 * lo_), *(const f32x4*)(g + 512 + 4 * lo_), *(const f32x4*)(g + 768 + 4 * lo_) };
              const f32x4 bv[4] = { *(const f32x4*)(bb + 4 * lo_), *(const f32x4*)(bb + 256 + 4 * lo_), *(const f32x4*)(bb + 512 + 4 * lo_), *(const f32x4*)(bb + 768 + 4 * lo_) };
#pragma unroll
              for (int r = 0; r < 4; ++r) { const int row = blk * 64 + F.wave * 8 + rg * 4 + r; const bf16* yr = y1 + (size_t)row * D; float s = 0.f;
#pragma unroll
                  for (int j = 0; j < 4; ++j) { const v2u w = *(const v2u*)(yr + 256 * j + 4 * lane); v[r][j] = (f32x4){__uint_as_float(w.x << 16), __uint_as_float(w.x & 0xffff0000u), __uint_as_float(w.y << 16), __uint_as_float(w.y & 0xffff0000u)}; s += (v[r][j].x + v[r][j].y) + (v[r][j].z + v[r][j].w); }
                  const float mean = wave_sum(s) * (1.f / D); float s2 = 0.f;
#pragma unroll
                  for (int j = 0; j < 4; ++j) { v[r][j] = v[r][j] - mean; s2 += (v[r][j].x * v[r][j].x + v[r][j].y * v[r][j].y) + (v[r][j].z * v[r][j].z + v[r][j].w * v[r][j].w); }
                  const float rstd = __builtin_amdgcn_rsqf(wave_sum(s2) * (1.f / D) + LN_EPS);
#pragma unroll
                  for (int j = 0; j < 4; ++j) { v[r][j] = v[r][j] * rstd * gv[j] + bv[j];
                      v2u o; o.x = cvt_pk_bf16(v[r][j].x, v[r][j].y); o.y = cvt_pk_bf16(v[r][j].z, v[r][j].w); *(v2u*)(x1b + (size_t)row * D + 256 * j + 4 * lane) = o;
                      if (MOE_FP8) *(unsigned*)(WSP(unsigned char, WS_X1Q) + (size_t)row * D + 256 * j + 4 * lane) = cvt4_fp8(v[r][j].x, v[r][j].y, v[r][j].z, v[r][j].w); } } }
            float lg[32];
#pragma unroll
            for (int e = 0; e < 32; ++e) { f32x2 p2[4] = {(f32x2){0.f, 0.f}, (f32x2){0.f, 0.f}, (f32x2){0.f, 0.f}, (f32x2){0.f, 0.f}};
#pragma unroll
                for (int j = 0; j < 4; ++j) { const f32x4 w = *(const LAS f32x4*)(RWT + e * D + 256 * j + 4 * lane);
#pragma unroll
                    for (int r = 0; r < 4; ++r) { p2[r] = v[r][j].xy * w.xy + p2[r]; p2[r] = v[r][j].zw * w.zw + p2[r]; } }
                float p[4] = {p2[0].x + p2[0].y, p2[1].x + p2[1].y, p2[2].x + p2[2].y, p2[3].x + p2[3].y};
                { const bool hi = (lane & 32) != 0; const float k0 = hi ? p[2] : p[0], s0 = hi ? p[0] : p[2], k1 = hi ? p[3] : p[1], s1 = hi ? p[1] : p[3]; p[0] = k0 + __shfl_xor(s0, 32); p[1] = k1 + __shfl_xor(s1, 32); }
                { const bool hi = (lane & 16) != 0; const float k0 = hi ? p[1] : p[0], s0 = hi ? p[0] : p[1]; p[0] = k0 + __shfl_xor(s0, 16); }
                float t = p[0]; t += __shfl_xor(t, 8); t += __shfl_xor(t, 4); t += __shfl_xor(t, 2); t += __shfl_xor(t, 1);
                lg[e] = t + rb[e]; }
            float la = 0.f, lb_ = 0.f;
#pragma unroll
            for (int e = 0; e < 32; ++e) { if (e == 2 * sub) la = lg[e]; if (e == 2 * sub + 1) lb_ = lg[e]; }
            int ra = 0, rbk = 0;
#pragma unroll
            for (int e = 0; e < 32; ++e) { ra += (lg[e] > la || (lg[e] == la && e < 2 * sub)) ? 1 : 0; rbk += (lg[e] > lb_ || (lg[e] == lb_ && e < 2 * sub + 1)) ? 1 : 0; }
            const int rowl = rg * 4 + (lane >> 4);
            if (ra < 4) { TOPV[rowl * 4 + ra] = la; TOPE[rowl * 4 + ra] = 2 * sub; }
            if (rbk < 4) { TOPV[rowl * 4 + rbk] = lb_; TOPE[rowl * 4 + rbk] = 2 * sub + 1; }
        }
        LDS_WAIT();
        int my_e = 0; float my_g = 0.f; unsigned my_r = 0u;
        if (lane < 32) { const int ri = lane >> 2, k = lane & 3; const f32x4 tv = *(const LAS f32x4*)(TOPV + ri * 4);
            const float e1 = __expf(tv.y - tv.x), e2 = __expf(tv.z - tv.x), e3 = __expf(tv.w - tv.x); const float inv = __builtin_amdgcn_rcpf(1.0f + e1 + e2 + e3);
            my_e = TOPE[ri * 4 + k]; my_g = (k == 0 ? 1.0f : k == 1 ? e1 : k == 2 ? e2 : e3) * inv;
            my_r = DRY ? 0u : atomicAdd((unsigned*)&lcnt[my_e], 1u); }
        __syncthreads();
        if (!DRY && F.tid < 32) { const unsigned n = lcnt[F.tid]; lbase[F.tid] = n ? __hip_atomic_fetch_add(cnt + F.tid * 16, n, RLX_AGENT) : 0u; }
        __syncthreads();
        if (!DRY && lane < 32) { const int row = blk * 64 + F.wave * 8 + (lane >> 2); const unsigned slot = (unsigned)my_e * ECAP + lbase[my_e] + my_r;
            sdest[slot] = row * 4 + (lane & 3); sgate[slot] = my_g; }
        __syncthreads();
    }
}
#endif
__device__ __forceinline__ void p9_combine(Frame& F, const Args& A) {
    const bf16* x1b = WSP(bf16, WS_X1B); const bf16* yb = WSP(bf16, WS_YBUF); bf16* hb = WSP(bf16, WS_HB);
    const int gw = F.vcu * NWAVES + F.wave, NGW = F.G * NWAVES, lane = F.lane;
    for (int row0 = gw; row0 < T; row0 += 2 * NGW) {
        v4u y[2][4][2], xw[2][2];
#pragma unroll
        for (int r = 0; r < 2; ++r) { const int row = row0 + r * NGW < T ? row0 + r * NGW : row0;
#pragma unroll
            for (int j = 0; j < 2; ++j) {
#pragma unroll
                for (int k = 0; k < 4; ++k) y[r][k][j] = *(const v4u*)(yb + ((size_t)row * 4 + k) * D + 512 * j + 8 * lane);
                xw[r][j] = *(const v4u*)(x1b + (size_t)row * D + 512 * j + 8 * lane); } }
#pragma unroll
        for (int r = 0; r < 2; ++r) { const int row = row0 + r * NGW; if (row < T) {
#pragma unroll
            for (int j = 0; j < 2; ++j) { f32x4 v0, v1; pg8::unpack8(xw[r][j], v0, v1); v0 = v0 * DN_ALPHA; v1 = v1 * DN_ALPHA;
#pragma unroll
                for (int k = 0; k < 4; ++k) { f32x4 a, b; pg8::unpack8(y[r][k][j], a, b); v0 = v0 + a; v1 = v1 + b; }
                v4u wv; wv.x = cvt_pk_bf16(v0.x, v0.y); wv.y = cvt_pk_bf16(v0.z, v0.w); wv.z = cvt_pk_bf16(v1.x, v1.y); wv.w = cvt_pk_bf16(v1.z, v1.w); *(v4u*)(hb + (size_t)row * D + 512 * j + 8 * lane) = wv;
                if (PLE_FP8) { v2u q; q.x = cvt4_fp8(v0.x, v0.y, v0.z, v0.w); q.y = cvt4_fp8(v1.x, v1.y, v1.z, v1.w); *(v2u*)(WSP(unsigned char, WS_HQ) + (size_t)row * D + 512 * j + 8 * lane) = q; } } } }
    }
}
__device__ __forceinline__ void p11_ln2(Frame& F, const Args& A, int layer) {
    const bf16* h2 = WSP(bf16, WS_H2); bf16* xb = WSP(bf16, WS_XB);
    const float* g = KIN(I_LN2G) + layer * D; const float* bb = KIN(I_LN2B) + layer * D;
    const int gw = F.vcu * NWAVES + F.wave, NGW = F.G * NWAVES, lane = F.lane;
    f32x4 gv[4], bv[4];
#pragma unroll
    for (int j = 0; j < 4; ++j) { gv[j] = *(const f32x4*)(g + 256 * j + 4 * lane); bv[j] = *(const f32x4*)(bb + 256 * j + 4 * lane); }
    for (int row0 = gw; row0 < T; row0 += 4 * NGW) {
        v2u w[4][4];
#pragma unroll
        for (int r = 0; r < 4; ++r) { const int row = row0 + r * NGW < T ? row0 + r * NGW : row0;
#pragma unroll
            for (int j = 0; j < 4; ++j) w[r][j] = *(const v2u*)(h2 + (size_t)row * D + 256 * j + 4 * lane); }
#pragma unroll
        for (int r = 0; r < 4; ++r) { const int row = row0 + r * NGW; f32x4 v[4]; float s = 0.f;
#pragma unroll
            for (int j = 0; j < 4; ++j) { v[j] = (f32x4){__uint_as_float(w[r][j].x << 16), __uint_as_float(w[r][j].x & 0xffff0000u), __uint_as_float(w[r][j].y << 16), __uint_as_float(w[r][j].y & 0xffff0000u)}; s += (v[j].x + v[j].y) + (v[j].z + v[j].w); }
            const float mean = wave_sum(s) * (1.f / D); float s2 = 0.f;
#pragma unroll
            for (int j = 0; j < 4; ++j) { v[j] = v[j] - mean; s2 += (v[j].x * v[j].x + v[j].y * v[j].y) + (v[j].z * v[j].z + v[j].w * v[j].w); }
            const float rstd = __builtin_amdgcn_rsqf(wave_sum(s2) * (1.f / D) + LN_EPS);
            if (row < T) {
#pragma unroll
                for (int j = 0; j < 4; ++j) { const f32x4 o = v[j] * rstd * gv[j] + bv[j]; const size_t off = (size_t)row * D + 256 * j + 4 * lane;
                    if (layer == DEPTH - 1) *(f32x4*)(F.out + off) = o; v2u q; q.x = cvt_pk_bf16(o.x, o.y); q.y = cvt_pk_bf16(o.z, o.w); *(v2u*)(xb + off) = q; } }
        }
    }
}
__device__ __forceinline__ void moe_build_pfx(Frame& F, const Args& A, int layer, int NT) {
    volatile LAS unsigned* pfx = F.MISC + MW_PFX;
    __syncthreads();
    if (F.tid < 64) {
        const int e = F.tid & 31;
        const unsigned c = __hip_atomic_load(F.ctl + CW_CNT + (layer * NE + e) * 16, RLX_AGENT);
        const unsigned un = ((c + 255u) >> 8) * (unsigned)NT; unsigned inc = un;
#pragma unroll
        for (int o = 1; o < 32; o <<= 1) { const unsigned t = (unsigned)my_shfl_up((int)inc, o); if (e >= o) inc += t; }
        if (F.tid < 32) { pfx[e] = inc - un; pfx[40 + e] = c; if (e == 31) pfx[32] = inc; }
    }
    __syncthreads();
}
#define UU(t, col) bf2f(u[(size_t)(t) * NUP + (col)])
#define UU4(t, col) ldu4(u + (size_t)(t) * NUP + (col))
__device__ __forceinline__ f32x4 ldu4(const bf16* p) { const v2u w = *(const v2u*)p; return (f32x4){__uint_as_float(w.x << 16), __uint_as_float(w.x & 0xffff0000u), __uint_as_float(w.y << 16), __uint_as_float(w.y & 0xffff0000u)}; }
__device__ __forceinline__ f32x4 ldb4(const bf16* p) { const v2u w = *(const v2u*)p; return (f32x4){__uint_as_float(w.x << 16), __uint_as_float(w.x & 0xffff0000u), __uint_as_float(w.y << 16), __uint_as_float(w.y & 0xffff0000u)}; }
__device__ __forceinline__ void stb4(bf16* p, f32x4 v) { v2u o; o.x = cvt_pk_bf16(v.x, v.y); o.y = cvt_pk_bf16(v.z, v.w); *(v2u*)p = o; }
__device__ __forceinline__ void lds_st_bf16(LAS unsigned char* p, float v) { *(LAS unsigned short*)p = (unsigned short)(cvt_pk_bf16(v, 0.f) & 0xffffu); }
__device__ __forceinline__ void lds_st_bf16x4(LAS unsigned char* p, float a, float b, float c, float d) { v2u o; o.x = cvt_pk_bf16(a, b); o.y = cvt_pk_bf16(c, d); *(LAS v2u*)p = o; }

#if OUT_FP8
#define MIX_ST4(mix, idx, a, b, c, d) (*(unsigned*)((unsigned char*)(mix) + (idx)) = cvt4_fp8(a, b, c, d))
#else
#define MIX_ST4(mix, idx, a, b, c, d) do { v2u o_; o_.x = cvt_pk_bf16(a, b); o_.y = cvt_pk_bf16(c, d); *(v2u*)((mix) + (idx)) = o_; } while (0)
#endif
__device__ __forceinline__ void ssd_stage1(Frame& F, const Args& A, int layer, int b, int c) {
    const bf16* u = WSP(bf16, WS_U);
    LAS unsigned char* L = F.lds;
    LAS float* DT = (LAS float*)L; LAS float* AC = DT + 256;
    LAS unsigned char* BMT = L + 2048; LAS unsigned char* XCDT = BMT + 128 * 144;
    const int t0 = b * SEQ + c * 64, tid = F.tid, lane = F.lane, wave = F.wave;
    if (wave < 4) {
        const int hh = wave;
        const float dt = softplusf_(UU(t0 + lane, U_SSD_DT + hh) + KIN(I_SDTB)[layer * 4 + hh]);
        const float adt = -dt * __expf(KIN(I_SALOG)[layer * 4 + hh]);
        const float ac = wave_scan_add(adt, lane);
        DT[hh * 64 + lane] = dt; AC[hh * 64 + lane] = ac;
        if (lane == 63) WSP(float, WS_SSD_DEC)[(b * 4 + hh) * NCH + c] = __expf(ac);
    }
    __syncthreads();
    if (tid < 384) {
        const int cc = tid; const float* cw = KIN(I_SCW) + (size_t)layer * 2048 + cc; const float w0 = cw[0], w1 = cw[512], w2 = cw[1024], w3 = cw[1536], cb = KIN(I_SCB)[layer * 512 + cc];
        const bf16* up = u + (size_t)t0 * NUP + U_SSD_X + cc;
        float win0 = 0.f, win1 = 0.f, win2 = 0.f;
        if (c > 0) { win0 = bf2f(up[-3 * NUP]); win1 = bf2f(up[-2 * NUP]); win2 = bf2f(up[-1 * NUP]); }
        const int hh = (cc >> 6) & 3; const bool isx = cc < 256;
        LAS unsigned char* dst = isx ? XCDT + cc * 144 : BMT + (cc - 256) * 144;
        const float aclast = AC[hh * 64 + 63];
#pragma unroll 1
        for (int l0 = 0; l0 < 64; l0 += 32) {
            float xv[32];
#pragma unroll
            for (int j = 0; j < 32; ++j) xv[j] = bf2f(up[(l0 + j) * NUP]);
#pragma unroll
            for (int j8 = 0; j8 < 4; ++j8) { float o[8];
#pragma unroll
                for (int j = 0; j < 8; ++j) { const int l = l0 + j8 * 8 + j; const float x = xv[j8 * 8 + j]; const float y = cb + w0 * win0 + w1 * win1 + w2 * win2 + w3 * x; win0 = win1; win1 = win2; win2 = x;
                    float s = siluf_(y); if (isx) s *= DT[hh * 64 + l] * __expf(aclast - AC[hh * 64 + l]); o[j] = s; }
                *(LAS v4u*)(dst + (l0 + j8 * 8) * 2) = pack8(o); }
        }
    }
    __syncthreads();
    { const int fr = lane & 15, fq = lane >> 4; bf16* st = WSP(bf16, WS_SSD_ST);
#pragma unroll 1
      for (int i = 0; i < 2; ++i) { const int row0 = (2 * wave + i) * 16; const int hh = row0 >> 6, p = (row0 & 63) + fr;
          bf16* dstp = st + (((size_t)(b * 4 + hh) * NCH + c) * 64 + p) * 128;
#pragma unroll 1
          for (int ntl = 0; ntl < 8; ++ntl) { f32x4 acc = {0.f, 0.f, 0.f, 0.f}; acc = mm16(XCDT + row0 * 144, 144, BMT + ntl * 16 * 144, 144, 64, acc, fr, fq);
              stb4(dstp + ntl * 16 + 4 * fq, acc); } } }
    __syncthreads();
}
__device__ __forceinline__ void ssd_stage3(Frame& F, const Args& A, int layer, int b, int c) {
    const bf16* u = WSP(bf16, WS_U);
    LAS unsigned char* L = F.lds;
    LAS float* DT = (LAS float*)L; LAS float* AC = DT + 256;
    LAS unsigned char* CM = L + 2048; LAS unsigned char* BM = CM + 64 * 272; LAS unsigned char* XCT = BM + 64 * 272; LAS unsigned char* MM = XCT + 256 * 144;
    LAS unsigned char* YG = XCT;
    const int t0 = b * SEQ + c * 64, tid = F.tid, lane = F.lane, wave = F.wave, fr = lane & 15, fq = lane >> 4;
    if (wave < 4) {
        const int hh = wave;
        const float dt = softplusf_(UU(t0 + lane, U_SSD_DT + hh) + KIN(I_SDTB)[layer * 4 + hh]);
        const float adt = -dt * __expf(KIN(I_SALOG)[layer * 4 + hh]);
        DT[hh * 64 + lane] = dt; AC[hh * 64 + lane] = wave_scan_add(adt, lane);
    }
    __syncthreads();
    {
        const int cc = tid; const float* cw = KIN(I_SCW) + (size_t)layer * 2048 + cc; const float w0 = cw[0], w1 = cw[512], w2 = cw[1024], w3 = cw[1536], cb = KIN(I_SCB)[layer * 512 + cc];
        const bf16* up = u + (size_t)t0 * NUP + U_SSD_X + cc;
        float win0 = 0.f, win1 = 0.f, win2 = 0.f;
        if (c > 0) { win0 = bf2f(up[-3 * NUP]); win1 = bf2f(up[-2 * NUP]); win2 = bf2f(up[-1 * NUP]); }
        const int hh = (cc >> 6) & 3;
#pragma unroll 1
        for (int l0 = 0; l0 < 64; l0 += 32) {
            float xv[32];
#pragma unroll
            for (int j = 0; j < 32; ++j) xv[j] = bf2f(up[(l0 + j) * NUP]);
#pragma unroll
            for (int j8 = 0; j8 < 4; ++j8) { float o[8];
#pragma unroll
                for (int j = 0; j < 8; ++j) { const int l = l0 + j8 * 8 + j; const float x = xv[j8 * 8 + j]; const float y = cb + w0 * win0 + w1 * win1 + w2 * win2 + w3 * x; win0 = win1; win1 = win2; win2 = x;
                    float s = siluf_(y); if (cc < 256) s *= DT[hh * 64 + l]; o[j] = s; }
                if (cc < 256) *(LAS v4u*)(XCT + cc * 144 + (l0 + j8 * 8) * 2) = pack8(o);
                else { LAS unsigned char* d2 = (cc < 384 ? BM + (cc - 256) * 2 : CM + (cc - 384) * 2) + (l0 + j8 * 8) * 272;
#pragma unroll
                    for (int j = 0; j < 8; ++j) lds_st_bf16(d2 + j * 272, o[j]); } }
        }
    }
    __syncthreads();
#pragma unroll 1
    for (int i = 0; i < 2; ++i) { const int idx = 2 * wave + i, lt = idx >> 2, st = idx & 3;
        f32x4 acc = {0.f, 0.f, 0.f, 0.f}; acc = mm16(CM + lt * 16 * 272, 272, BM + st * 16 * 272, 272, 128, acc, fr, fq);
        const int l = lt * 16 + fr, s0 = st * 16 + 4 * fq;
#pragma unroll
        for (int hh = 0; hh < 4; ++hh) { const float al = AC[hh * 64 + l], dl = KIN(I_SD)[layer * 4 + hh] / DT[hh * 64 + l]; float o[4];
#pragma unroll
            for (int j = 0; j < 4; ++j) { const int s = s0 + j; float m = (l >= s) ? acc[j] * __expf(al - AC[hh * 64 + s]) : 0.f; if (l == s) m += dl; o[j] = m; }
            lds_st_bf16x4(MM + hh * 9216 + l * 144 + s0 * 2, o[0], o[1], o[2], o[3]); } }
    __syncthreads();
    f32x4 yv[2][4];
    { const int hh = wave >> 1; const bf16* prev = WSP(bf16, WS_SSD_ST) + ((size_t)(b * 4 + hh) * NCH + c) * 8192;
      bf16x8 pf[4][4];
#pragma unroll
      for (int pt = 0; pt < 4; ++pt)
#pragma unroll
          for (int ks = 0; ks < 4; ++ks) pf[pt][ks] = *(const bf16x8*)(prev + (size_t)(pt * 16 + fr) * 128 + ks * 32 + fq * 8);
#pragma unroll
      for (int i = 0; i < 2; ++i) { const int lt = 2 * (wave & 1) + i, l = lt * 16 + fr; const float ea = __expf(AC[hh * 64 + l]);
#pragma unroll
          for (int pt = 0; pt < 4; ++pt) { f32x4 ad = {0.f, 0.f, 0.f, 0.f}, ao = {0.f, 0.f, 0.f, 0.f};
              ad = mm16(MM + hh * 9216 + lt * 16 * 144, 144, XCT + (hh * 64 + pt * 16) * 144, 144, 64, ad, fr, fq);
              ao = mm16_rB<4>(CM + lt * 16 * 272, 272, pf[pt], ao, fr, fq);
              const f32x4 z = UU4(t0 + l, U_SSD_Z + hh * 64 + pt * 16 + 4 * fq);
              f32x4 y = ad + ao * ea; y.x *= siluf_(z.x); y.y *= siluf_(z.y); y.z *= siluf_(z.z); y.w *= siluf_(z.w); yv[i][pt] = y; } } }
    __syncthreads();
    { const int hh = wave >> 1;
#pragma unroll
      for (int i = 0; i < 2; ++i) { const int l = (2 * (wave & 1) + i) * 16 + fr;
#pragma unroll
          for (int pt = 0; pt < 4; ++pt) *(LAS f32x4*)(YG + l * 1040 + (hh * 64 + pt * 16 + 4 * fq) * 4) = yv[i][pt]; } }
    __syncthreads();
    { const f32x4 g = *(const f32x4*)(KIN(I_SNG) + layer * 256 + 4 * lane); bf16* mix = WSP(bf16, WS_MIX);
#pragma unroll 1
      for (int i = 0; i < 8; ++i) { const int l = wave * 8 + i; const f32x4 y = *(const LAS f32x4*)(YG + l * 1040 + lane * 16);
          const float ss = wave_sum((y.x * y.x + y.y * y.y) + (y.z * y.z + y.w * y.w)); const float r = __builtin_amdgcn_rsqf(ss * (1.f / 256.f) + NORM_EPS);
          MIX_ST4(mix, (size_t)(t0 + l) * D + 4 * lane, y.x * r * g.x, y.y * r * g.y, y.z * r * g.z, y.w * r * g.w); } }
    __syncthreads();
}

__device__ __forceinline__ void gla_bcum_all(Frame& F, const Args& A, int layer, const LAS float* GD, LAS float* BC) {
    const int d = F.tid & 127, lq = F.tid >> 7;
    float gup[16];
    { const f32x4* gp4 = (const f32x4*)(WSP(float, WS_LORA) + (size_t)layer * LORA_PER_LAYER + 32768 + d * 16);
#pragma unroll
      for (int i = 0; i < 4; ++i) { const f32x4 a = gp4[i]; gup[4 * i] = a.x; gup[4 * i + 1] = a.y; gup[4 * i + 2] = a.z; gup[4 * i + 3] = a.w; } }
    const float gb = KIN(I_GGB)[layer * 128 + d];
#pragma unroll 4
    for (int li = 0; li < 16; ++li) { const int l = lq * 16 + li; float x = gb;
#pragma unroll
        for (int i = 0; i < 4; ++i) { const f32x4 g4 = *(const LAS f32x4*)(GD + l * 16 + 4 * i); x += (g4.x * gup[4 * i] + g4.y * gup[4 * i + 1]) + (g4.z * gup[4 * i + 2] + g4.w * gup[4 * i + 3]); }
        BC[l * 128 + d] = logsigmoidf_(x) * 0.0625f; }
    __syncthreads();
    if (F.tid < 128) { float run = 0.f;
#pragma unroll 1
        for (int l0 = 0; l0 < 64; l0 += 16) { float v[16];
#pragma unroll
            for (int j = 0; j < 16; ++j) v[j] = BC[(l0 + j) * 128 + d];
#pragma unroll
            for (int j = 0; j < 16; ++j) { run += v[j]; BC[(l0 + j) * 128 + d] = run; } } }
}
__device__ __forceinline__ void gla_stage1(Frame& F, const Args& A, int layer, int b, int c) {
    const bf16* u = WSP(bf16, WS_U);
    LAS unsigned char* L = F.lds;
    LAS float* GD = (LAS float*)L; LAS float* BC = (LAS float*)(L + 4096);
    LAS unsigned char* KDT = L + 36864; LAS unsigned char* VT = KDT + 128 * 144;
    const int t0 = b * SEQ + c * 64, tid = F.tid, lane = F.lane, wave = F.wave, fr = lane & 15, fq = lane >> 4;
    if (tid < 256) { const int l = tid >> 2, q4 = tid & 3; *(LAS f32x4*)(GD + l * 16 + q4 * 4) = UU4(t0 + l, U_GL_G + 4 * q4); }
    __syncthreads();
    gla_bcum_all(F, A, layer, GD, BC);
    if (tid < 128) {
        const int d = tid; const float blast = BC[63 * 128 + d];
        WSP(float, WS_GLA_DEC)[(size_t)(b * NCH + c) * 128 + d] = __expf(blast);
        const bf16* up = u + (size_t)t0 * NUP + U_GL_K + d;
#pragma unroll 1
        for (int l0 = 0; l0 < 64; l0 += 32) { float xv[32];
#pragma unroll
            for (int j = 0; j < 32; ++j) xv[j] = bf2f(up[(l0 + j) * NUP]);
#pragma unroll
            for (int j8 = 0; j8 < 4; ++j8) { float o[8];
#pragma unroll
                for (int j = 0; j < 8; ++j) { const int l = l0 + j8 * 8 + j; o[j] = xv[j8 * 8 + j] * __expf(blast - BC[l * 128 + d]); }
                *(LAS v4u*)(KDT + d * 144 + (l0 + j8 * 8) * 2) = pack8(o); } }
    } else if (tid < 384) {
        const int vch = tid - 128; const bf16* up = u + (size_t)t0 * NUP + U_GL_V + vch;
#pragma unroll 1
        for (int l0 = 0; l0 < 64; l0 += 32) { float xv[32];
#pragma unroll
            for (int j = 0; j < 32; ++j) xv[j] = bf2f(up[(l0 + j) * NUP]);
#pragma unroll
            for (int j8 = 0; j8 < 4; ++j8) { float o[8];
#pragma unroll
                for (int j = 0; j < 8; ++j) o[j] = xv[j8 * 8 + j];
                *(LAS v4u*)(VT + vch * 144 + (l0 + j8 * 8) * 2) = pack8(o); } }
    }
    __syncthreads();
    { bf16* st = WSP(bf16, WS_GLA_ST);
#pragma unroll 1
      for (int i = 0; i < 4; ++i) { const int idx = 4 * wave + i, hh = idx >> 3, dtl = (idx >> 2) & 1, vt = idx & 3;
          f32x4 acc = {0.f, 0.f, 0.f, 0.f}; acc = mm16(KDT + (hh * 32 + dtl * 16) * 144, 144, VT + (hh * 64 + vt * 16) * 144, 144, 64, acc, fr, fq);
          stb4(st + (((size_t)(b * 4 + hh) * NCH + c) * 32 + dtl * 16 + fr) * 64 + vt * 16 + 4 * fq, acc); } }
    __syncthreads();
}
__device__ __forceinline__ void gla_stage3(Frame& F, const Args& A, int layer, int b, int c) {
    const bf16* u = WSP(bf16, WS_U);
    LAS unsigned char* L = F.lds;
    LAS float* GD = (LAS float*)L; LAS float* BC = (LAS float*)(L + 4096); LAS unsigned char* ATT = L + 4096;
    LAS unsigned char* QD = L + 40960; LAS unsigned char* KI = QD + 64 * 272; LAS unsigned char* VT = KI + 64 * 272; LAS unsigned char* PVT = VT + 256 * 144;
    const int t0 = b * SEQ + c * 64, tid = F.tid, lane = F.lane, wave = F.wave, fr = lane & 15, fq = lane >> 4;
    if (tid < 256) { const int l = tid >> 2, q4 = tid & 3; *(LAS f32x4*)(GD + l * 16 + q4 * 4) = UU4(t0 + l, U_GL_G + 4 * q4); }
    __syncthreads();
    gla_bcum_all(F, A, layer, GD, BC);
    if (tid < 128) {
        const int d = tid;
        const bf16* uq = u + (size_t)t0 * NUP + U_GL_Q + d; const bf16* uk = u + (size_t)t0 * NUP + U_GL_K + d;
#pragma unroll 1
        for (int l0 = 0; l0 < 64; l0 += 16) { float qv[16], kv[16];
#pragma unroll
            for (int j = 0; j < 16; ++j) { qv[j] = bf2f(uq[(l0 + j) * NUP]); kv[j] = bf2f(uk[(l0 + j) * NUP]); }
#pragma unroll
            for (int j = 0; j < 16; ++j) { const int l = l0 + j; const float bc = BC[l * 128 + d];
                lds_st_bf16(QD + l * 272 + d * 2, qv[j] * 0.17677669529663687f * __expf(bc)); lds_st_bf16(KI + l * 272 + d * 2, kv[j] * __expf(-bc)); } }
    } else if (tid < 384) {
        const int vch = tid - 128; const bf16* up = u + (size_t)t0 * NUP + U_GL_V + vch;
#pragma unroll 1
        for (int l0 = 0; l0 < 64; l0 += 32) { float xv[32];
#pragma unroll
            for (int j = 0; j < 32; ++j) xv[j] = bf2f(up[(l0 + j) * NUP]);
#pragma unroll
            for (int j8 = 0; j8 < 4; ++j8) { float o[8];
#pragma unroll
                for (int j = 0; j < 8; ++j) o[j] = xv[j8 * 8 + j];
                *(LAS v4u*)(VT + vch * 144 + (l0 + j8 * 8) * 2) = pack8(o); } }
    } else {
        const bf16* prev = WSP(bf16, WS_GLA_ST);
#pragma unroll 4
        for (int i = tid - 384; i < 8192; i += 128) { const int hh = i >> 11, dd = (i >> 6) & 31, vv = i & 63;
            *(LAS unsigned short*)(PVT + (hh * 64 + vv) * 80 + dd * 2) = prev[((size_t)(b * 4 + hh) * NCH + c) * 2048 + dd * 64 + vv]; }
    }
    __syncthreads();
    const int hh = wave >> 1;
#pragma unroll 1
    for (int i = 0; i < 2; ++i) { const int tt = 2 * (wave & 1) + i, t = tt * 16 + fr;
#pragma unroll
        for (int st = 0; st < 4; ++st) { f32x4 acc = {0.f, 0.f, 0.f, 0.f}; acc = mm16(QD + tt * 16 * 272 + hh * 64, 272, KI + st * 16 * 272 + hh * 64, 272, 32, acc, fr, fq);
            const int s0 = st * 16 + 4 * fq;
            lds_st_bf16x4(ATT + hh * 9216 + t * 144 + s0 * 2, t >= s0 ? acc[0] : 0.f, t >= s0 + 1 ? acc[1] : 0.f, t >= s0 + 2 ? acc[2] : 0.f, t >= s0 + 3 ? acc[3] : 0.f); } }
    __syncthreads();
    { bf16* mix = WSP(bf16, WS_MIX); const float* ng = KIN(I_GNG) + layer * 256;
#pragma unroll 1
      for (int i = 0; i < 2; ++i) { const int tt = 2 * (wave & 1) + i, t = tt * 16 + fr; f32x4 ov[4]; float ss = 0.f;
#pragma unroll
          for (int vt = 0; vt < 4; ++vt) { f32x4 acc = {0.f, 0.f, 0.f, 0.f};
              acc = mm16(ATT + hh * 9216 + tt * 16 * 144, 144, VT + (hh * 64 + vt * 16) * 144, 144, 64, acc, fr, fq);
              acc = mm16(QD + tt * 16 * 272 + hh * 64, 272, PVT + (hh * 64 + vt * 16) * 80, 80, 32, acc, fr, fq);
              ov[vt] = acc; ss += (acc.x * acc.x + acc.y * acc.y) + (acc.z * acc.z + acc.w * acc.w); }
          ss += __shfl_xor(ss, 16); ss += __shfl_xor(ss, 32);
          const float r = __builtin_amdgcn_rsqf(ss * (1.f / 64.f) + NORM_EPS);
#pragma unroll
          for (int vt = 0; vt < 4; ++vt) { const int col = hh * 64 + vt * 16 + 4 * fq; const f32x4 g = *(const f32x4*)(ng + col); const f32x4 og = UU4(t0 + t, U_GL_OG + col);
              MIX_ST4(mix, (size_t)(t0 + t) * D + 512 + col, ov[vt].x * r * g.x * siluf_(og.x), ov[vt].y * r * g.y * siluf_(og.y), ov[vt].z * r * g.z * siluf_(og.z), ov[vt].w * r * g.w * siluf_(og.w)); } } }
    __syncthreads();
}

__device__ __forceinline__ void mlstm_stage1(Frame& F, const Args& A, int layer, int b, int c) {
    const bf16* u = WSP(bf16, WS_U);
    LAS unsigned char* L = F.lds;
    LAS float* WST = (LAS float*)L; LAS unsigned char* KT = L + 1024; LAS unsigned char* VWT = KT + 256 * 144;
    const int t0 = b * SEQ + c * 64, tid = F.tid, lane = F.lane, wave = F.wave, fr = lane & 15, fq = lane >> 4;
    if (wave < 4) {
        const int hh = wave;
        const float ig = UU(t0 + lane, U_ML_I + hh) + KIN(I_MIB)[layer * 4 + hh];
        const float lf = logsigmoidf_(UU(t0 + lane, U_ML_F + hh) + KIN(I_MFB)[layer * 4 + hh]);
        const float bc = wave_scan_add(lf, lane); const float blast = __shfl(bc, 63);
        const float ast = blast - bc + ig; const float mloc = wave_max(ast);
        WST[hh * 64 + lane] = __expf(ast - mloc);
        if (lane == 0) { WSP(float, WS_ML_BL)[(b * 4 + hh) * NCH + c] = blast; WSP(float, WS_ML_ML)[(b * 4 + hh) * NCH + c] = mloc; }
    } else {
        const int kch = tid - 256, cc = 256 + kch; const float* cw = KIN(I_MCW) + (size_t)layer * 2048 + cc; const float w0 = cw[0], w1 = cw[512], w2 = cw[1024], w3 = cw[1536], cb = KIN(I_MCB)[layer * 512 + cc];
        const bf16* up = u + (size_t)t0 * NUP + U_ML_K + kch;
        float win0 = 0.f, win1 = 0.f, win2 = 0.f;
        if (c > 0) { win0 = bf2f(up[-3 * NUP]); win1 = bf2f(up[-2 * NUP]); win2 = bf2f(up[-1 * NUP]); }
#pragma unroll 1
        for (int l0 = 0; l0 < 64; l0 += 32) { float xv[32];
#pragma unroll
            for (int j = 0; j < 32; ++j) xv[j] = bf2f(up[(l0 + j) * NUP]);
#pragma unroll
            for (int j8 = 0; j8 < 4; ++j8) { float o[8];
#pragma unroll
                for (int j = 0; j < 8; ++j) { const float x = xv[j8 * 8 + j]; const float y = cb + w0 * win0 + w1 * win1 + w2 * win2 + w3 * x; win0 = win1; win1 = win2; win2 = x; o[j] = siluf_(y); }
                *(LAS v4u*)(KT + kch * 144 + (l0 + j8 * 8) * 2) = pack8(o); } }
    }
    __syncthreads();
    if (tid < 256) {
        const int vch = tid, hh = vch >> 6; const bf16* up = u + (size_t)t0 * NUP + U_ML_V + vch;
#pragma unroll 1
        for (int l0 = 0; l0 < 64; l0 += 32) { float xv[32];
#pragma unroll
            for (int j = 0; j < 32; ++j) xv[j] = bf2f(up[(l0 + j) * NUP]);
#pragma unroll
            for (int j8 = 0; j8 < 4; ++j8) { float o[8];
#pragma unroll
                for (int j = 0; j < 8; ++j) o[j] = xv[j8 * 8 + j] * WST[hh * 64 + l0 + j8 * 8 + j];
                *(LAS v4u*)(VWT + vch * 144 + (l0 + j8 * 8) * 2) = pack8(o); } }
    } else {
        const int kch = tid - 256, hh = kch >> 6; float n = 0.f;
#pragma unroll 8
        for (int s = 0; s < 64; ++s) n += WST[hh * 64 + s] * bf2f(*(const LAS unsigned short*)(KT + kch * 144 + s * 2));
        WSP(bf16, WS_ML_N)[((size_t)(b * 4 + hh) * NCH + c) * 64 + (kch & 63)] = (bf16)(cvt_pk_bf16(n, 0.f) & 0xffffu);
    }
    __syncthreads();
    { bf16* cst = WSP(bf16, WS_ML_C); const int hh = wave >> 1;
#pragma unroll 1
      for (int i = 0; i < 2; ++i) { const int vt = 2 * (wave & 1) + i;
#pragma unroll 1
          for (int kt = 0; kt < 4; ++kt) { f32x4 acc = {0.f, 0.f, 0.f, 0.f}; acc = mm16(VWT + (hh * 64 + vt * 16) * 144, 144, KT + (hh * 64 + kt * 16) * 144, 144, 64, acc, fr, fq);
              stb4(cst + (((size_t)(b * 4 + hh) * NCH + c) * 64 + vt * 16 + fr) * 64 + kt * 16 + 4 * fq, acc); } } }
    __syncthreads();
}
__device__ __forceinline__ void mlstm_stage3(Frame& F, const Args& A, int layer, int b, int c) {
    const bf16* u = WSP(bf16, WS_U);
    LAS unsigned char* L = F.lds;
    LAS float* BCU = (LAS float*)L; LAS float* GG = BCU + 256; LAS float* MROW = BCU + 512; LAS float* WINT = BCU + 768; LAS float* NPV = BCU + 1024;
    LAS unsigned char* Q = L + 6144; LAS unsigned char* KK = Q + 64 * 528; LAS unsigned char* VT = KK + 64 * 528; LAS unsigned char* SC = VT + 256 * 144;
    const int t0 = b * SEQ + c * 64, tid = F.tid, lane = F.lane, wave = F.wave, fr = lane & 15, fq = lane >> 4;
    if (wave < 4) {
        const int hh = wave;
        const float ig = UU(t0 + lane, U_ML_I + hh) + KIN(I_MIB)[layer * 4 + hh];
        const float lf = logsigmoidf_(UU(t0 + lane, U_ML_F + hh) + KIN(I_MFB)[layer * 4 + hh]);
        const float bc = wave_scan_add(lf, lane); const float gg = ig - bc;
        const float mprev = WSP(float, WS_ML_M)[(b * 4 + hh) * NCH + c];
        const float minter = bc + mprev, mintra = bc + wave_scan_max(gg, lane), mrow = fmaxf(minter, mintra);
        BCU[hh * 64 + lane] = bc; GG[hh * 64 + lane] = gg; MROW[hh * 64 + lane] = mrow; WINT[hh * 64 + lane] = __expf(minter - mrow);
        NPV[hh * 64 + lane] = bf2f(WSP(bf16, WS_ML_N)[((size_t)(b * 4 + hh) * NCH + c) * 64 + lane]);
    }
    {
        const int cc = tid; const float* cw = KIN(I_MCW) + (size_t)layer * 2048 + cc; const float w0 = cw[0], w1 = cw[512], w2 = cw[1024], w3 = cw[1536], cb = KIN(I_MCB)[layer * 512 + cc];
        const bf16* up = u + (size_t)t0 * NUP + U_ML_Q + cc;
        float win0 = 0.f, win1 = 0.f, win2 = 0.f;
        if (c > 0) { win0 = bf2f(up[-3 * NUP]); win1 = bf2f(up[-2 * NUP]); win2 = bf2f(up[-1 * NUP]); }
        LAS unsigned char* dst = cc < 256 ? Q + cc * 2 : KK + (cc - 256) * 2; const float sc = cc < 256 ? 0.125f : 1.0f;
#pragma unroll 1
        for (int l0 = 0; l0 < 64; l0 += 32) { float xv[32];
#pragma unroll
            for (int j = 0; j < 32; ++j) xv[j] = bf2f(up[(l0 + j) * NUP]);
#pragma unroll
            for (int j = 0; j < 32; ++j) { const float x = xv[j]; const float y = cb + w0 * win0 + w1 * win1 + w2 * win2 + w3 * x; win0 = win1; win1 = win2; win2 = x; lds_st_bf16(dst + (l0 + j) * 528, siluf_(y) * sc); } }
        const int vch = tid & 255, lh = (tid >> 8) * 32; const bf16* uv = u + (size_t)(t0 + lh) * NUP + U_ML_V + vch;
        float xv[32];
#pragma unroll
        for (int j = 0; j < 32; ++j) xv[j] = bf2f(uv[j * NUP]);
#pragma unroll
        for (int j8 = 0; j8 < 4; ++j8) { float o[8];
#pragma unroll
            for (int j = 0; j < 8; ++j) o[j] = xv[j8 * 8 + j];
            *(LAS v4u*)(VT + vch * 144 + (lh + j8 * 8) * 2) = pack8(o); }
    }
    __syncthreads();
    { const int hh = wave >> 1; bf16* mix = WSP(bf16, WS_MIX); const float* ng = KIN(I_MNG) + layer * 256;
      const bf16* cprev = WSP(bf16, WS_ML_C) + ((size_t)(b * 4 + hh) * NCH + c) * 4096;
      bf16x8 cf[4][2];
#pragma unroll
      for (int vt = 0; vt < 4; ++vt)
#pragma unroll
          for (int ks = 0; ks < 2; ++ks) cf[vt][ks] = *(const bf16x8*)(cprev + (size_t)(vt * 16 + fr) * 64 + ks * 32 + fq * 8);
#pragma unroll 1
      for (int i = 0; i < 2; ++i) { const int tt = 2 * (wave & 1) + i, t = tt * 16 + fr;
          const float bt = BCU[hh * 64 + t] - MROW[hh * 64 + t]; float rs = 0.f;
#pragma unroll
          for (int st = 0; st < 4; ++st) { f32x4 acc = {0.f, 0.f, 0.f, 0.f}; acc = mm16(Q + tt * 16 * 528 + hh * 128, 528, KK + st * 16 * 528 + hh * 128, 528, 64, acc, fr, fq);
              const int s0 = st * 16 + 4 * fq; float o[4];
#pragma unroll
              for (int j = 0; j < 4; ++j) { const int s = s0 + j; const float v = (t >= s) ? acc[j] * __expf(bt + GG[hh * 64 + s]) : 0.f; o[j] = v; rs += v; }
              lds_st_bf16x4(SC + hh * 9216 + t * 144 + s0 * 2, o[0], o[1], o[2], o[3]); }
          rs += __shfl_xor(rs, 16); rs += __shfl_xor(rs, 32);
          float nq = 0.f;
#pragma unroll
          for (int j = 0; j < 16; ++j) nq += bf2f(*(const LAS unsigned short*)(Q + t * 528 + (hh * 64 + fq * 16 + j) * 2)) * NPV[hh * 64 + fq * 16 + j];
          nq += __shfl_xor(nq, 16); nq += __shfl_xor(nq, 32);
          const float wi = WINT[hh * 64 + t]; const float den = wi * nq + rs; const float dn = fmaxf(fabsf(den), __expf(-MROW[hh * 64 + t])); const float rdn = 1.0f / dn;
          LDS_WAIT();
          f32x4 hv[4]; float sm = 0.f;
#pragma unroll
          for (int vt = 0; vt < 4; ++vt) { f32x4 acc = {0.f, 0.f, 0.f, 0.f};
              acc = mm16_rB<2>(Q + tt * 16 * 528 + hh * 128, 528, cf[vt], acc, fr, fq);
              acc = acc * wi;
              acc = mm16(SC + hh * 9216 + tt * 16 * 144, 144, VT + (hh * 64 + vt * 16) * 144, 144, 64, acc, fr, fq);
              const f32x4 og = UU4(t0 + t, U_ML_O + hh * 64 + vt * 16 + 4 * fq);
              f32x4 h; h.x = acc.x * rdn * sigmoidf_(og.x); h.y = acc.y * rdn * sigmoidf_(og.y); h.z = acc.z * rdn * sigmoidf_(og.z); h.w = acc.w * rdn * sigmoidf_(og.w);
              hv[vt] = h; sm += (h.x + h.y) + (h.z + h.w); }
          sm += __shfl_xor(sm, 16); sm += __shfl_xor(sm, 32);
          const float mean = sm * (1.f / 64.f); float sq = 0.f;
#pragma unroll
          for (int vt = 0; vt < 4; ++vt) { hv[vt] = hv[vt] - mean; sq += (hv[vt].x * hv[vt].x + hv[vt].y * hv[vt].y) + (hv[vt].z * hv[vt].z + hv[vt].w * hv[vt].w); }
          sq += __shfl_xor(sq, 16); sq += __shfl_xor(sq, 32);
          const float r = __builtin_amdgcn_rsqf(sq * (1.f / 64.f) + NORM_EPS);
#pragma unroll
          for (int vt = 0; vt < 4; ++vt) { const int col = hh * 64 + vt * 16 + 4 * fq; const f32x4 g = *(const f32x4*)(ng + col);
              MIX_ST4(mix, (size_t)(t0 + t) * D + 768 + col, hv[vt].x * r * g.x, hv[vt].y * r * g.y, hv[vt].z * r * g.z, hv[vt].w * r * g.w); } } }
    __syncthreads();
}

__device__ __forceinline__ void rwkv_stage1(Frame& F, const Args& A, int layer, int ub) {
    const bf16* u = WSP(bf16, WS_U);
    LAS unsigned char* L = F.lds;
    LAS unsigned char* LOWA = L;
    LAS float* CUM = (LAS float*)(L + 16384);
    LAS float* AAB = CUM;
    LAS float* TOT = CUM;
    LAS unsigned char* M0 = L + 16384 + 16640;
#define RM(i) (M0 + (i) * 9216)
    LAS float* GAMC = (LAS float*)(F.MISC + MW_GAMC);
    const int t0 = ub * 64, c = ub & 63, tid = F.tid, lane = F.lane, wave = F.wave;
    const float* mu = KIN(I_RMU) + layer * 896;
#ifndef RW_DUP
#define RW_DUP -1
#endif
#define RW_REP(k) for (int rep__ = 0; rep__ < ((RW_DUP == (k)) ? 2 : 1); ++rep__)
    RW_REP(0) {
    {
        const int l = tid >> 3, jq = tid & 7, t = t0 + l; const bool has_prev = (t & (SEQ - 1)) != 0;
        f32x4 cur[4], prv[4];
#pragma unroll
        for (int q = 0; q < 4; ++q) { cur[q] = UU4(t, U_RW_LO + jq * 16 + 4 * q); prv[q] = has_prev ? UU4(t - 1, U_RW_LO + jq * 16 + 4 * q) : (f32x4){0.f, 0.f, 0.f, 0.f}; }
#pragma unroll
        for (int q = 0; q < 4; ++q) { const f32x4 m4 = *(const f32x4*)(mu + 768 + jq * 16 + 4 * q); const f32x4 xs = cur[q] + (prv[q] - cur[q]) * m4; const int j = jq * 16 + 4 * q;
            f32x4 o;
            if (j < 32) { o.x = tanhf_(xs.x); o.y = tanhf_(xs.y); o.z = tanhf_(xs.z); o.w = tanhf_(xs.w); } else if (j < 64) o = xs; else { o.x = sigmoidf_(xs.x); o.y = sigmoidf_(xs.y); o.z = sigmoidf_(xs.z); o.w = sigmoidf_(xs.w); }
            if (j < 64) lds_st_bf16x4(LOWA + l * 144 + j * 2, o.x, o.y, o.z, o.w); else lds_st_bf16x4(RM(0) + l * 144 + (j - 64) * 2, o.x, o.y, o.z, o.w); }
    }
    __syncthreads();
    {
        bf16* RG = WSP(bf16, WS_RW_G); const int lane_ = F.lane, fr_ = lane_ & 15, fq_ = lane_ >> 4;
        const float* gupT = WSP(float, WS_LORA) + (size_t)layer * LORA_PER_LAYER + 16384;
#pragma unroll
        for (int ci = 0; ci < 2; ++ci) { const int ct = 2 * wave + ci; bf16x8 bf[2];
#pragma unroll
            for (int ks = 0; ks < 2; ++ks) bf[ks] = ldfrag_f32(gupT + (size_t)(ct * 16 + fr_) * 64 + ks * 32 + fq_ * 8);
#pragma unroll
            for (int tt = 0; tt < 4; ++tt) { f32x4 acc = {0.f, 0.f, 0.f, 0.f}; acc = mm16_rB<2>(RM(0) + tt * 16 * 144, 144, bf, acc, fr_, fq_);
                stb4(RG + (size_t)(t0 + tt * 16 + fr_) * 256 + ct * 16 + 4 * fq_, acc); } }
    }
    __syncthreads();
    }
    const int b_ = ub >> 6;
#pragma unroll 1
    for (int hh = 0; hh < 4; ++hh) {
        int ch = lane, fr = lane & 15, fq = lane >> 4; asm volatile("" : "+v"(ch), "+v"(fr), "+v"(fq));
        const int tg = wave, cg = hh * 64 + ch; const size_t un = (size_t)(b_ * 4 + hh) * NCH + c;
        float rr[8], k2r[8], vr[8], ar[8], br[8], pl[8];
        LAS float* WPA = (LAS float*)RM(8);
        {
            const int mat = wave >> 2, ct = wave & 3;
            const float* wT = WSP(float, WS_LORA) + (size_t)layer * LORA_PER_LAYER + mat * 8192 + (size_t)(hh * 64 + ct * 16 + fr) * 32 + fq * 8;
            bf16x8 bfw[1]; bfw[0] = ldfrag_f32(wT);
#pragma unroll
            for (int tt = 0; tt < 4; ++tt) { f32x4 acc = {0.f, 0.f, 0.f, 0.f}; acc = mm16_rB<1>(LOWA + tt * 16 * 144 + mat * 64, 144, bfw, acc, fr, fq);
                *(LAS f32x4*)(WPA + mat * 4096 + (tt * 16 + fr) * 64 + ct * 16 + 4 * fq) = acc; }
        }
        __syncthreads();
        RW_REP(1) {
            const float w0 = KIN(I_RW0)[layer * 256 + cg], a0 = KIN(I_RA0)[layer * 256 + cg], kkc = KIN(I_RKK)[layer * 256 + cg], kac = KIN(I_RKA)[layer * 256 + cg];
            const float mur = mu[cg], muk = mu[256 + cg], muv = mu[512 + cg];
            const int tb = t0 + tg * 8; const bool nop = (c == 0) && (tg == 0);
            float rp = nop ? 0.f : UU(tb - 1, U_RW_R + cg), kp = nop ? 0.f : UU(tb - 1, U_RW_K + cg), vp = nop ? 0.f : UU(tb - 1, U_RW_V + cg);
            float rc[8], kc[8], vc[8];
#pragma unroll
            for (int j = 0; j < 8; ++j) { rc[j] = UU(tb + j, U_RW_R + cg); kc[j] = UU(tb + j, U_RW_K + cg); vc[j] = UU(tb + j, U_RW_V + cg); }
            bf16* RW = WSP(bf16, WS_RW);
            float kk[8], al[8], n2[8], run = 0.f;
#pragma unroll
            for (int j = 0; j < 8; ++j) { const int l = tg * 8 + j;
                const float r = rc[j] + (rp - rc[j]) * mur, k = kc[j] + (kp - kc[j]) * muk, v = vc[j] + (vp - vc[j]) * muv; rp = rc[j]; kp = kc[j]; vp = vc[j];
                const float wp = w0 + WPA[l * 64 + ch], ap = a0 + WPA[4096 + l * 64 + ch];
                const float w = -softplusf_(-wp) - 0.5f; run += -__expf(w); pl[j] = run; al[j] = sigmoidf_(ap);
                kk[j] = k * kkc; n2[j] = kk[j] * kk[j];
                k2r[j] = k * (1.0f + (al[j] - 1.0f) * kac); rr[j] = r; vr[j] = v;
                bf16* o = RW + (size_t)(tb + j) * 768 + cg; o[0] = (bf16)(cvt_pk_bf16(r, 0.f) & 0xffffu); o[256] = (bf16)(cvt_pk_bf16(k2r[j], 0.f) & 0xffffu); o[512] = (bf16)(cvt_pk_bf16(v, 0.f) & 0xffffu); }
#pragma unroll
            for (int i = 0; i < 4; ++i) { const bool hi = (ch & 32) != 0; const float keep = hi ? n2[i + 4] : n2[i], send = hi ? n2[i] : n2[i + 4]; n2[i] = keep + __shfl_xor(send, 32); }
#pragma unroll
            for (int i = 0; i < 2; ++i) { const bool hi = (ch & 16) != 0; const float keep = hi ? n2[i + 2] : n2[i], send = hi ? n2[i] : n2[i + 2]; n2[i] = keep + __shfl_xor(send, 16); }
            { const bool hi = (ch & 8) != 0; const float keep = hi ? n2[1] : n2[0], send = hi ? n2[0] : n2[1]; n2[0] = keep + __shfl_xor(send, 8); }
            n2[0] += __shfl_xor(n2[0], 4); n2[0] += __shfl_xor(n2[0], 2); n2[0] += __shfl_xor(n2[0], 1);
#pragma unroll
            for (int j = 0; j < 8; ++j) { const float tot = __builtin_bit_cast(float, __builtin_amdgcn_readlane(__builtin_bit_cast(int, n2[0]), ((j & 4) ? 32 : 0) + ((j & 2) ? 16 : 0) + ((j & 1) ? 8 : 0)));
                const float kkn = kk[j] / fmaxf(sqrtf(tot), 1e-12f); ar[j] = -kkn; br[j] = kkn * al[j]; }
            TOT[tg * 64 + ch] = run;
        }
        __syncthreads();
        RW_REP(3) {
            float off = 0.f, gC = 0.f;
#pragma unroll
            for (int g = 0; g < 8; ++g) { const float tv = TOT[g * 64 + ch]; gC += tv; if (g < tg) off += tv; }
            float oat[8], obb[8], okb[8], ov[8];
#pragma unroll
            for (int j = 0; j < 8; ++j) { const int l = tg * 8 + j; const float gt = off + pl[j], gm = j > 0 ? off + pl[j - 1] : off;
                const float at = ar[j] * __expf(gm), rt = rr[j] * __expf(gt), en = __expf(-gt), ec = __expf(gC - gt);
                lds_st_bf16(RM(0) + l * 144 + ch * 2, at); lds_st_bf16(RM(1) + l * 144 + ch * 2, rt); lds_st_bf16(RM(2) + l * 144 + ch * 2, br[j] * en); lds_st_bf16(RM(3) + l * 144 + ch * 2, k2r[j] * en);
                oat[j] = at; obb[j] = br[j] * ec; okb[j] = k2r[j] * ec; ov[j] = vr[j]; }
            *(LAS v4u*)(RM(4) + ch * 144 + tg * 16) = pack8(oat); *(LAS v4u*)(RM(5) + ch * 144 + tg * 16) = pack8(obb); *(LAS v4u*)(RM(6) + ch * 144 + tg * 16) = pack8(okb); *(LAS v4u*)(RM(7) + ch * 144 + tg * 16) = pack8(ov);
            if (tg == 0) GAMC[ch] = __expf(gC);
        }
        __syncthreads();
        RW_REP(4) {
            const int which = wave >> 1; const LAS unsigned char* Aop = which < 2 ? RM(0) : RM(1); const LAS unsigned char* Bop = (which & 1) ? RM(3) : RM(2);
#pragma unroll 1
            for (int i2 = 0; i2 < 2; ++i2) { const int tt = 2 * (wave & 1) + i2, t = tt * 16 + fr;
#pragma unroll
                for (int it = 0; it < 4; ++it) { f32x4 acc = {0.f, 0.f, 0.f, 0.f}; acc = mm16(Aop + tt * 16 * 144, 144, Bop + it * 16 * 144, 144, 64, acc, fr, fq);
                    const int i0 = it * 16 + 4 * fq; const int lim = which < 2 ? t : t + 1;
                    const float o0 = (i0 < lim) ? acc[0] : 0.f, o1 = (i0 + 1 < lim) ? acc[1] : 0.f, o2 = (i0 + 2 < lim) ? acc[2] : 0.f, o3 = (i0 + 3 < lim) ? acc[3] : 0.f;
#ifdef RW_CLAMP_AAK
                    float q0 = o0, q1 = o1, q2 = o2, q3 = o3;
                    if (which == 1) { q0 = fabsf(o0) < 1e30f ? o0 : 0.f; q1 = fabsf(o1) < 1e30f ? o1 : 0.f; q2 = fabsf(o2) < 1e30f ? o2 : 0.f; q3 = fabsf(o3) < 1e30f ? o3 : 0.f; }
                    if (which == 0) *(LAS f32x4*)(AAB + t * 64 + i0) = (f32x4){o0, o1, o2, o3};
                    else lds_st_bf16x4(RM(7 + which) + t * 144 + i0 * 2, q0, q1, q2, q3);
                    continue;
#endif
                    if (which == 0) { DBG_STAT(11, o0); DBG_STAT(11, o1); DBG_STAT(11, o2); DBG_STAT(11, o3); } if (which == 1) { DBG_STAT(12, o0); DBG_STAT(12, o1); DBG_STAT(12, o2); DBG_STAT(12, o3); } if (which == 2) { DBG_STAT(13, o0); DBG_STAT(13, o3); } if (which == 3) { DBG_STAT(14, o0); DBG_STAT(14, o3); }
                    if (which == 0) *(LAS f32x4*)(AAB + t * 64 + i0) = (f32x4){o0, o1, o2, o3};
                    else lds_st_bf16x4(RM(7 + which) + t * 144 + i0 * 2, o0, o1, o2, o3); } }
        }
        __syncthreads();
        RW_REP(5) {
#pragma unroll 1
            for (int i2 = 0; i2 < 2; ++i2) { const int idx = wave * 2 + i2, vt = idx >> 2, tt = idx & 3; f32x4 acc = {0.f, 0.f, 0.f, 0.f};
                acc = mm16(RM(7) + vt * 16 * 144, 144, RM(8) + tt * 16 * 144, 144, 64, acc, fr, fq);
                DBG_STAT(15, acc[0]); DBG_STAT(15, acc[1]); DBG_STAT(15, acc[2]); DBG_STAT(15, acc[3]);
                lds_st_bf16x4(RM(0) + (vt * 16 + fr) * 144 + (tt * 16 + 4 * fq) * 2, acc[0], acc[1], acc[2], acc[3]); }
        }
#if RW_SOLVE_BLK
        LAS unsigned char* T11T = L + 143616;
        LAS unsigned char* YT = RM(8);
        RW_REP(8) if (wave < 2) {
            const int R0 = wave * 32; float x[32]; f32x4 rowq[8];
#pragma unroll
            for (int tl = 0; tl < 32; ++tl) {
                f32x4 cur[8];
#pragma unroll
                for (int i4 = 0; i4 < (tl + 3) / 4; ++i4) cur[i4] = rowq[i4];
                if (tl + 1 < 32) {
#pragma unroll
                    for (int i4 = 0; i4 < (tl + 4) / 4; ++i4) rowq[i4] = *(const LAS f32x4*)(AAB + (R0 + tl + 1) * 64 + R0 + 4 * i4); }
                float a0 = (R0 + tl == ch) ? 1.0f : 0.f, a1 = 0.f, a2 = 0.f, a3 = 0.f;
#pragma unroll
                for (int i4 = 0; i4 < (tl + 3) / 4; ++i4) { const f32x4 q = cur[i4];
                    a0 += q.x * x[4 * i4]; if (4 * i4 + 1 < tl) a1 += q.y * x[4 * i4 + 1]; if (4 * i4 + 2 < tl) a2 += q.z * x[4 * i4 + 2]; if (4 * i4 + 3 < tl) a3 += q.w * x[4 * i4 + 3]; }
                const float acc = (a0 + a1) + (a2 + a3);
                x[tl] = acc; if (wave == 0 || ch >= 32) lds_st_bf16(RM(11) + (R0 + tl) * 144 + ch * 2, acc); }
            if (wave == 0 && ch < 32) {
#pragma unroll
                for (int q = 0; q < 4; ++q) { const float xv[8] = {x[8 * q], x[8 * q + 1], x[8 * q + 2], x[8 * q + 3], x[8 * q + 4], x[8 * q + 5], x[8 * q + 6], x[8 * q + 7]}; *(LAS v4u*)(T11T + ch * 80 + q * 16) = pack8(xv); } }
        }
        __syncthreads();
        if (wave < 4) {
            const int jt = wave >> 1, it = wave & 1; bf16x8 bfa[1];
            { const LAS float* ap = AAB + (32 + it * 16 + fr) * 64 + 8 * fq; const f32x4 p0 = *(const LAS f32x4*)ap, p1 = *(const LAS f32x4*)(ap + 4);
              v4u w; w.x = cvt_pk_bf16(p0.x, p0.y); w.y = cvt_pk_bf16(p0.z, p0.w); w.z = cvt_pk_bf16(p1.x, p1.y); w.w = cvt_pk_bf16(p1.z, p1.w); bfa[0] = __builtin_bit_cast(bf16x8, w); }
            f32x4 acc = {0.f, 0.f, 0.f, 0.f}; acc = mm16_rB<1>(T11T + jt * 16 * 80, 80, bfa, acc, fr, fq);
            lds_st_bf16x4(YT + (jt * 16 + fr) * 80 + (it * 16 + 4 * fq) * 2, acc[0], acc[1], acc[2], acc[3]);
        }
        __syncthreads();
        if (wave < 4) {
            const int it = wave >> 1, jt = wave & 1;
            f32x4 acc = {0.f, 0.f, 0.f, 0.f}; acc = mm16(RM(11) + (32 + it * 16) * 144 + 64, 144, YT + jt * 16 * 80, 80, 32, acc, fr, fq);
            lds_st_bf16x4(RM(11) + (32 + it * 16 + fr) * 144 + (jt * 16 + 4 * fq) * 2, acc[0], acc[1], acc[2], acc[3]);
        }
        __syncthreads();
#else
        RW_REP(8) if (wave == 0) {
            float x[64]; f32x4 rowq[16];
#pragma unroll
            for (int t = 0; t < 64; ++t) {
                f32x4 cur[16];
#pragma unroll
                for (int i4 = 0; i4 < (t + 3) / 4; ++i4) cur[i4] = rowq[i4];
                if (t + 1 < 64) {
#pragma unroll
                    for (int i4 = 0; i4 < (t + 4) / 4; ++i4) rowq[i4] = *(const LAS f32x4*)(AAB + (t + 1) * 64 + 4 * i4); }
                float a0 = (t == ch) ? 1.0f : 0.f, a1 = 0.f, a2 = 0.f, a3 = 0.f;
#pragma unroll
                for (int i4 = 0; i4 < (t + 3) / 4; ++i4) { const f32x4 q = cur[i4];
                    a0 += q.x * x[4 * i4]; if (4 * i4 + 1 < t) a1 += q.y * x[4 * i4 + 1]; if (4 * i4 + 2 < t) a2 += q.z * x[4 * i4 + 2]; if (4 * i4 + 3 < t) a3 += q.w * x[4 * i4 + 3]; }
                const float acc = (a0 + a1) + (a2 + a3);
                x[t] = acc; lds_st_bf16(RM(11) + t * 144 + ch * 2, acc); }
        }
        __syncthreads();
#endif
        RW_REP(6) {
            const int rt = wave >> 1;
#pragma unroll
            for (int i2 = 0; i2 < 2; ++i2) { const int tt = 2 * (wave & 1) + i2;
                f32x4 acc = {0.f, 0.f, 0.f, 0.f}; acc = mm16(RM(4) + rt * 16 * 144, 144, RM(11) + tt * 16 * 144, 144, 64, acc, fr, fq);
                DBG_STAT(17, acc[0]); DBG_STAT(17, acc[1]); DBG_STAT(17, acc[2]); DBG_STAT(17, acc[3]);
                lds_st_bf16x4(RM(2) + (rt * 16 + fr) * 144 + (tt * 16 + 4 * fq) * 2, acc[0], acc[1], acc[2], acc[3]);
                f32x4 ac2 = {0.f, 0.f, 0.f, 0.f}; ac2 = mm16(RM(0) + rt * 16 * 144, 144, RM(11) + tt * 16 * 144, 144, 64, ac2, fr, fq);
                DBG_STAT(18, ac2[0]); DBG_STAT(18, ac2[1]); DBG_STAT(18, ac2[2]); DBG_STAT(18, ac2[3]);
                lds_st_bf16x4(RM(3) + (rt * 16 + fr) * 144 + (tt * 16 + 4 * fq) * 2, ac2[0], ac2[1], ac2[2], ac2[3]); }
        }
        __syncthreads();
        RW_REP(7) {
            const int which = wave >> 1;
#pragma unroll 1
            for (int i2 = 0; i2 < 2; ++i2) { const int rt = 2 * (wave & 1) + i2, row = rt * 16 + fr;
#pragma unroll
                for (int ct = 0; ct < 4; ++ct) { f32x4 acc = {0.f, 0.f, 0.f, 0.f}; const int c0 = ct * 16 + 4 * fq;
                    if (which == 0) { acc = mm16(RM(9) + rt * 16 * 144, 144, RM(2) + ct * 16 * 144, 144, 64, acc, fr, fq);
                        const v2u rw = *(const LAS v2u*)(RM(1) + row * 144 + c0 * 2);
                        acc[0] += __uint_as_float(rw.x << 16); acc[1] += __uint_as_float(rw.x & 0xffff0000u); acc[2] += __uint_as_float(rw.y << 16); acc[3] += __uint_as_float(rw.y & 0xffff0000u);
                        DBG_STAT(19, acc[0]); DBG_STAT(19, acc[1]); DBG_STAT(19, acc[2]); DBG_STAT(19, acc[3]);
                        v2u o; o.x = cvt_pk_bf16(acc[0], acc[1]); o.y = cvt_pk_bf16(acc[2], acc[3]); *(v2u*)(WSP(bf16, WS_RW_RH) + un * 4096 + row * 64 + c0) = o; }
                    else if (which == 1) {
#ifndef RW_NO_U0
                        acc = mm16(RM(9) + rt * 16 * 144, 144, RM(3) + ct * 16 * 144, 144, 64, acc, fr, fq);
#endif
                        acc = mm16(RM(10) + rt * 16 * 144, 144, RM(7) + ct * 16 * 144, 144, 64, acc, fr, fq);
                        DBG_STAT(20, acc[0]); DBG_STAT(20, acc[1]); DBG_STAT(20, acc[2]); DBG_STAT(20, acc[3]);
                        stb4(WSP(bf16, WS_RW_O0) + un * 4096 + row * 64 + c0, acc); }
                    else if (which == 2) { acc = mm16(RM(5) + rt * 16 * 144, 144, RM(2) + ct * 16 * 144, 144, 64, acc, fr, fq);
                        const float gd = GAMC[row]; if (row == c0) acc[0] += gd; if (row == c0 + 1) acc[1] += gd; if (row == c0 + 2) acc[2] += gd; if (row == c0 + 3) acc[3] += gd;
                        DBG_STAT(21, acc[0]); DBG_STAT(21, acc[1]); DBG_STAT(21, acc[2]); DBG_STAT(21, acc[3]);
                        v2u o; o.x = cvt_pk_bf16(acc[0], acc[1]); o.y = cvt_pk_bf16(acc[2], acc[3]);
                        *(v2u*)((unsigned char*)(WSP(bf16, WS_RW_GF) + un * 4096) + ((rt * 2 + (ct >> 1)) * 64 + ch) * 16 + (ct & 1) * 8) = o; }
                    else { acc = mm16(RM(3) + rt * 16 * 144, 144, RM(5) + ct * 16 * 144, 144, 64, acc, fr, fq); acc = mm16(RM(7) + rt * 16 * 144, 144, RM(6) + ct * 16 * 144, 144, 64, acc, fr, fq);
                        DBG_STAT(22, acc[0]); DBG_STAT(22, acc[1]); DBG_STAT(22, acc[2]); DBG_STAT(22, acc[3]);
                        *(f32x4*)(WSP(float, WS_RW_HT) + un * 4096 + row * 64 + c0) = acc; } } }
        }
        __syncthreads();
    }
#undef RM
}
#if RW_SCAN_DMA
__device__ __forceinline__ void rwkv_scan_wave(Frame& F, const Args& A, int wslot) {
    const int lane = F.lane, fr = lane & 15, fq = lane >> 4, bh = wslot >> 2, v0 = (wslot & 3) * 16;
    const unsigned char* GFb = (const unsigned char*)(WSP(bf16, WS_RW_GF) + (size_t)bh * NCH * 4096) + lane * 16;
    const unsigned char* HTb = (const unsigned char*)(WSP(float, WS_RW_HT) + (size_t)bh * NCH * 4096 + (size_t)(v0 + fr) * 64 + 4 * fq);
    bf16* PT = WSP(bf16, WS_RW_PT) + (size_t)bh * NCH * 4096 + (size_t)(v0 + fr) * 64 + 4 * fq;
    LAS unsigned char* ring = F.lds;
    f32x4 P[4] = {{0.f, 0.f, 0.f, 0.f}, {0.f, 0.f, 0.f, 0.f}, {0.f, 0.f, 0.f, 0.f}, {0.f, 0.f, 0.f, 0.f}};
#define RW2_ISSUE(cc, sl) do { _Pragma("unroll") for (int f_ = 0; f_ < 8; ++f_) __builtin_amdgcn_global_load_lds((const unsigned*)(GFb + (size_t)(cc) * 8192 + f_ * 1024), (LAS unsigned*)(ring + (sl) * 12288 + f_ * 1024), 16, 0, 0); \
        _Pragma("unroll") for (int m_ = 0; m_ < 4; ++m_) __builtin_amdgcn_global_load_lds((const unsigned*)(HTb + (size_t)(cc) * 16384 + m_ * 64), (LAS unsigned*)(ring + (sl) * 12288 + 8192 + m_ * 1024), 16, 0, 0); } while (0)
#define RW2_STEP(cc, sl, NW) do { asm volatile("s_waitcnt vmcnt(" #NW ")" ::: "memory"); \
        const LAS unsigned char* sp_ = ring + (sl) * 12288 + lane * 16; bf16x8 gx[4][2]; f32x4 hx[4]; \
        _Pragma("unroll") for (int m = 0; m < 4; ++m) { hx[m] = *(const LAS f32x4*)(sp_ + 8192 + m * 1024); _Pragma("unroll") for (int s = 0; s < 2; ++s) gx[m][s] = *(const LAS bf16x8*)(sp_ + (m * 2 + s) * 1024); } \
        v4u bs[2]; \
        _Pragma("unroll") for (int s = 0; s < 2; ++s) { bs[s].x = cvt_pk_bf16(P[2 * s][0], P[2 * s][1]); bs[s].y = cvt_pk_bf16(P[2 * s][2], P[2 * s][3]); bs[s].z = cvt_pk_bf16(P[2 * s + 1][0], P[2 * s + 1][1]); bs[s].w = cvt_pk_bf16(P[2 * s + 1][2], P[2 * s + 1][3]); } \
        *(v2u*)(PT + (size_t)(cc) * 4096) = (v2u){bs[0].x, bs[0].y}; *(v2u*)(PT + (size_t)(cc) * 4096 + 16) = (v2u){bs[0].z, bs[0].w}; \
        *(v2u*)(PT + (size_t)(cc) * 4096 + 32) = (v2u){bs[1].x, bs[1].y}; *(v2u*)(PT + (size_t)(cc) * 4096 + 48) = (v2u){bs[1].z, bs[1].w}; \
        _Pragma("unroll") for (int m = 0; m < 4; ++m) { f32x4 acc = hx[m]; acc = __builtin_amdgcn_mfma_f32_16x16x32_bf16(gx[m][0], __builtin_bit_cast(bf16x8, bs[0]), acc, 0, 0, 0); \
            acc = __builtin_amdgcn_mfma_f32_16x16x32_bf16(gx[m][1], __builtin_bit_cast(bf16x8, bs[1]), acc, 0, 0, 0); P[m] = acc; } \
        asm volatile("s_waitcnt lgkmcnt(0)" ::: "memory"); } while (0)
    RW2_ISSUE(0, 0); RW2_ISSUE(1, 1); RW2_ISSUE(2, 2);
    RW2_ISSUE(3, 3); RW2_STEP(0, 0, 36); RW2_ISSUE(4, 0); RW2_STEP(1, 1, 40); RW2_ISSUE(5, 1); RW2_STEP(2, 2, 44); RW2_ISSUE(6, 2); RW2_STEP(3, 3, 48);
#pragma unroll 1
    for (int c = 4; c < 60; c += 4) {
        RW2_ISSUE(c + 3, 3); RW2_STEP(c, 0, 48); RW2_ISSUE(c + 4, 0); RW2_STEP(c + 1, 1, 48); RW2_ISSUE(c + 5, 1); RW2_STEP(c + 2, 2, 48); RW2_ISSUE(c + 6, 2); RW2_STEP(c + 3, 3, 48);
    }
    RW2_ISSUE(63, 3); RW2_STEP(60, 0, 48); RW2_STEP(61, 1, 36); RW2_STEP(62, 2, 24); RW2_STEP(63, 3, 12);
#undef RW2_ISSUE
#undef RW2_STEP
}
#else
__device__ __forceinline__ void rwkv_scan_wave(Frame& F, const Args& A, int wslot) {
    const int lane = F.lane, fr = lane & 15, fq = lane >> 4, bh = wslot >> 2, v0 = (wslot & 3) * 16;
    const bf16* GF = WSP(bf16, WS_RW_GF) + (size_t)bh * NCH * 4096; const float* HT = WSP(float, WS_RW_HT) + (size_t)bh * NCH * 4096 + (size_t)(v0 + fr) * 64 + 4 * fq;
    bf16* PT = WSP(bf16, WS_RW_PT) + (size_t)bh * NCH * 4096 + (size_t)(v0 + fr) * 64 + 4 * fq;
    f32x4 P[4] = {{0.f, 0.f, 0.f, 0.f}, {0.f, 0.f, 0.f, 0.f}, {0.f, 0.f, 0.f, 0.f}, {0.f, 0.f, 0.f, 0.f}};
    bf16x8 g0[4][2], g1[4][2], g2[4][2]; f32x4 h0[4], h1[4], h2[4];
#define RW2_LOAD(gx, hx, cc) do { _Pragma("unroll") for (int m = 0; m < 4; ++m) { hx[m] = *(const f32x4*)(HT + (size_t)(cc) * 4096 + 16 * m); \
        _Pragma("unroll") for (int s = 0; s < 2; ++s) gx[m][s] = *(const bf16x8*)(GF + (size_t)(cc) * 4096 + ((m * 2 + s) * 64 + lane) * 8); } } while (0)
#define RW2_STEP(gx, hx, cc) do { v4u bs[2]; \
        _Pragma("unroll") for (int s = 0; s < 2; ++s) { bs[s].x = cvt_pk_bf16(P[2 * s][0], P[2 * s][1]); bs[s].y = cvt_pk_bf16(P[2 * s][2], P[2 * s][3]); bs[s].z = cvt_pk_bf16(P[2 * s + 1][0], P[2 * s + 1][1]); bs[s].w = cvt_pk_bf16(P[2 * s + 1][2], P[2 * s + 1][3]); } \
        *(v2u*)(PT + (size_t)(cc) * 4096) = (v2u){bs[0].x, bs[0].y}; *(v2u*)(PT + (size_t)(cc) * 4096 + 16) = (v2u){bs[0].z, bs[0].w}; \
        *(v2u*)(PT + (size_t)(cc) * 4096 + 32) = (v2u){bs[1].x, bs[1].y}; *(v2u*)(PT + (size_t)(cc) * 4096 + 48) = (v2u){bs[1].z, bs[1].w}; \
        _Pragma("unroll") for (int m = 0; m < 4; ++m) { f32x4 acc = hx[m]; acc = __builtin_amdgcn_mfma_f32_16x16x32_bf16(gx[m][0], __builtin_bit_cast(bf16x8, bs[0]), acc, 0, 0, 0); \
            acc = __builtin_amdgcn_mfma_f32_16x16x32_bf16(gx[m][1], __builtin_bit_cast(bf16x8, bs[1]), acc, 0, 0, 0); P[m] = acc; } } while (0)
    RW2_LOAD(g0, h0, 0); RW2_LOAD(g1, h1, 1);
#pragma unroll 1
    for (int c = 0; c < 63; c += 3) {
        RW2_LOAD(g2, h2, c + 2); RW2_STEP(g0, h0, c);
        RW2_LOAD(g0, h0, c + 3); RW2_STEP(g1, h1, c + 1);
        if (c + 4 < NCH) RW2_LOAD(g1, h1, c + 4);
        RW2_STEP(g2, h2, c + 2);
    }
    RW2_STEP(g0, h0, 63);
#undef RW2_LOAD
#undef RW2_STEP
}
#endif
__device__ __forceinline__ void rwkv_stage3(Frame& F, const Args& A, int layer, int ub) {
    const int t0 = ub * 64, b_ = ub >> 6, c = ub & 63, lane = F.lane, wave = F.wave, fr = lane & 15, fq = lane >> 4, hh = wave >> 1;
    const size_t un = (size_t)(b_ * 4 + hh) * NCH + c;
    const bf16* RH = WSP(bf16, WS_RW_RH) + un * 4096; const bf16* PT = WSP(bf16, WS_RW_PT) + un * 4096; const bf16* O0 = WSP(bf16, WS_RW_O0) + un * 4096;
    const bf16* RW = WSP(bf16, WS_RW); const bf16* RG = WSP(bf16, WS_RW_G); bf16* mix = WSP(bf16, WS_MIX);
    const float* lg = KIN(I_RLNG) + layer * 256 + hh * 64; const float* lb = KIN(I_RLNB) + layer * 256 + hh * 64; const float* rk = KIN(I_RRK) + layer * 256 + hh * 64;
    bf16x8 pfr[4][2];
#pragma unroll
    for (int vt = 0; vt < 4; ++vt)
#pragma unroll
        for (int ks = 0; ks < 2; ++ks) pfr[vt][ks] = *(const bf16x8*)(PT + (size_t)(vt * 16 + fr) * 64 + ks * 32 + fq * 8);
#pragma unroll 1
    for (int i = 0; i < 2; ++i) { const int tt = 2 * (wave & 1) + i, tl = tt * 16 + fr, t = t0 + tl;
        const bf16x8 ra0 = *(const bf16x8*)(RH + (size_t)tl * 64 + fq * 8), ra1 = *(const bf16x8*)(RH + (size_t)tl * 64 + 32 + fq * 8);
        f32x4 ov[4]; float sm = 0.f;
#pragma unroll
        for (int vt = 0; vt < 4; ++vt) { f32x4 acc = ldb4(O0 + tl * 64 + vt * 16 + 4 * fq);
            acc = __builtin_amdgcn_mfma_f32_16x16x32_bf16(pfr[vt][0], ra0, acc, 0, 0, 0); acc = __builtin_amdgcn_mfma_f32_16x16x32_bf16(pfr[vt][1], ra1, acc, 0, 0, 0);
            ov[vt] = acc; DBG_STAT(24, acc[0]); DBG_STAT(24, acc[1]); DBG_STAT(24, acc[2]); DBG_STAT(24, acc[3]); sm += (acc.x + acc.y) + (acc.z + acc.w); }
        sm += __shfl_xor(sm, 16); sm += __shfl_xor(sm, 32);
        const float mean = sm * (1.f / 64.f); float sq = 0.f;
#pragma unroll
        for (int vt = 0; vt < 4; ++vt) { ov[vt] = ov[vt] - mean; sq += (ov[vt].x * ov[vt].x + ov[vt].y * ov[vt].y) + (ov[vt].z * ov[vt].z + ov[vt].w * ov[vt].w); }
        sq += __shfl_xor(sq, 16); sq += __shfl_xor(sq, 32);
        const float rs = __builtin_amdgcn_rsqf(sq * (1.f / 64.f) + RWKV_GN_EPS);
        float bd = 0.f;
#pragma unroll
        for (int q = 0; q < 4; ++q) { const f32x4 r4 = ldb4(RW + (size_t)t * 768 + hh * 64 + fq * 16 + 4 * q), k4 = ldb4(RW + (size_t)t * 768 + 256 + hh * 64 + fq * 16 + 4 * q), c4 = *(const f32x4*)(rk + fq * 16 + 4 * q);
            bd += (r4.x * k4.x * c4.x + r4.y * k4.y * c4.y) + (r4.z * k4.z * c4.z + r4.w * k4.w * c4.w); }
        bd += __shfl_xor(bd, 16); bd += __shfl_xor(bd, 32);
#pragma unroll
        for (int vt = 0; vt < 4; ++vt) { const int col = vt * 16 + 4 * fq; const f32x4 g4 = *(const f32x4*)(lg + col), b4 = *(const f32x4*)(lb + col);
            const f32x4 v4 = ldb4(RW + (size_t)t * 768 + 512 + hh * 64 + col), gg = ldb4(RG + (size_t)t * 256 + hh * 64 + col);
            float e0 = (ov[vt].x * rs * g4.x + b4.x + bd * v4.x) * gg.x, e1 = (ov[vt].y * rs * g4.y + b4.y + bd * v4.y) * gg.y, e2 = (ov[vt].z * rs * g4.z + b4.z + bd * v4.z) * gg.z, e3 = (ov[vt].w * rs * g4.w + b4.w + bd * v4.w) * gg.w;
#ifdef RW_SANITIZE
            e0 = (fabsf(e0) < 1e30f) ? e0 : 0.f; e1 = (fabsf(e1) < 1e30f) ? e1 : 0.f; e2 = (fabsf(e2) < 1e30f) ? e2 : 0.f; e3 = (fabsf(e3) < 1e30f) ? e3 : 0.f;
#endif
            MIX_ST4(mix, (size_t)t * D + 256 + hh * 64 + col, e0, e1, e2, e3); } }
}

constexpr int SCAN_N_MAIN = 16 * 64 * 128 / 2 + 16 * 32 * 64 / 2 + 16 * 64 * 64 / 2, SCAN_N_ALL = SCAN_N_MAIN + 16 * 64 / 2;
__device__ __forceinline__ void scans_elementwise(Frame& F, const Args& A, int gt, int nthr, int lo, int hi) {
    constexpr int N_SSD = 16 * 64 * 128 / 2, N_GLA = 16 * 32 * 64 / 2, N_MLC = 16 * 64 * 64 / 2, N_MLN = 16 * 64 / 2;
    for (int i = lo + gt; i < hi; i += nthr) {
        if (i < N_SSD) { const int bh = i >> 12, pn = (i & 4095) * 2; unsigned* base = (unsigned*)(WSP(bf16, WS_SSD_ST) + (size_t)bh * NCH * 8192 + pn); const float* dec = WSP(float, WS_SSD_DEC) + bh * NCH; float S0 = 0.f, S1 = 0.f;
#pragma unroll 1
            for (int c0 = 0; c0 < NCH; c0 += 32) { unsigned x[32]; float dd[32];
#pragma unroll
                for (int j = 0; j < 32; ++j) { x[j] = base[(size_t)(c0 + j) * 4096]; dd[j] = dec[c0 + j]; }
#pragma unroll
                for (int j = 0; j < 32; ++j) { base[(size_t)(c0 + j) * 4096] = cvt_pk_bf16(S0, S1); S0 = dd[j] * S0 + __uint_as_float(x[j] << 16); S1 = dd[j] * S1 + __uint_as_float(x[j] & 0xffff0000u); } }
        } else if (i < N_SSD + N_GLA) { const int k = i - N_SSD, bh = k >> 10, dv = (k & 1023) * 2, dd_ = dv >> 6, b = bh >> 2, hh = bh & 3; unsigned* base = (unsigned*)(WSP(bf16, WS_GLA_ST) + (size_t)bh * NCH * 2048 + dv); const float* dec = WSP(float, WS_GLA_DEC) + (size_t)b * NCH * 128 + hh * 32 + dd_; float S0 = 0.f, S1 = 0.f;
#pragma unroll 1
            for (int c0 = 0; c0 < NCH; c0 += 32) { unsigned x[32]; float dd[32];
#pragma unroll
                for (int j = 0; j < 32; ++j) { x[j] = base[(size_t)(c0 + j) * 1024]; dd[j] = dec[(c0 + j) * 128]; }
#pragma unroll
                for (int j = 0; j < 32; ++j) { base[(size_t)(c0 + j) * 1024] = cvt_pk_bf16(S0, S1); S0 = dd[j] * S0 + __uint_as_float(x[j] << 16); S1 = dd[j] * S1 + __uint_as_float(x[j] & 0xffff0000u); } }
        } else { const int k = i - N_SSD - N_GLA; const bool isn = k >= N_MLC; const int kk = isn ? k - N_MLC : k; const int bh = isn ? (kk >> 5) : (kk >> 11), e = (isn ? (kk & 31) : (kk & 2047)) * 2, str = isn ? 32 : 2048;
            unsigned* base = (unsigned*)((isn ? WSP(bf16, WS_ML_N) : WSP(bf16, WS_ML_C)) + (size_t)bh * NCH * str * 2 + e); const float* bl = WSP(float, WS_ML_BL) + bh * NCH; const float* ml = WSP(float, WS_ML_ML) + bh * NCH; float* mo = WSP(float, WS_ML_M) + bh * NCH;
            float S0 = 0.f, S1 = 0.f, m = 0.f;
#pragma unroll 1
            for (int c0 = 0; c0 < NCH; c0 += 32) { unsigned x[32]; float b8[32], m8[32];
#pragma unroll
                for (int j = 0; j < 32; ++j) { x[j] = base[(size_t)(c0 + j) * str]; b8[j] = bl[c0 + j]; m8[j] = ml[c0 + j]; }
#pragma unroll
                for (int j = 0; j < 32; ++j) { const float mn = fmaxf(b8[j] + m, m8[j]); const float so = __expf(b8[j] + m - mn), sn = __expf(m8[j] - mn);
                    base[(size_t)(c0 + j) * str] = cvt_pk_bf16(S0, S1); if (!isn && e == 0) mo[c0 + j] = m; S0 = so * S0 + sn * __uint_as_float(x[j] << 16); S1 = so * S1 + sn * __uint_as_float(x[j] & 0xffff0000u); m = mn; } }
        }
    }
}
#ifndef MK_PER_PHASE_LAUNCH
#define MK_PER_PHASE_LAUNCH 0
#endif
#ifndef PH_MASK
#define PH_MASK 0xFFF
#endif
#ifndef ST_MASK
#define ST_MASK 0xF
#endif
#define ST_ON(k) (((ST_MASK) >> (k)) & 1)
#ifndef DUP_MASK
#define DUP_MASK 0
#endif
#define DUP_N(k) ((((DUP_MASK) >> (k)) & 1) ? 2 : 1)
#ifndef ST_DUP
#define ST_DUP 0
#endif
#define ST_REP(ty) ((((ST_DUP) >> (ty)) & 1) ? 2 : 1)
#define PH_ON(k) (((PH_MASK) >> (k)) & 1)
constexpr int PH_PER_LAYER = 11, N_PHASES = 1 + DEPTH * PH_PER_LAYER;
__global__ void __launch_bounds__(NWAVES * 64, 2) fwd_kernel(Args args) {
    extern __shared__ __attribute__((aligned(16))) unsigned char lds[];
    Frame F;
    F.lds = (LAS unsigned char*)lds;
    F.MISC = (volatile LAS unsigned*)(F.lds + MISC_OFF);
    F.tid = threadIdx.x; F.lane = F.tid & 63; F.wave = __builtin_amdgcn_readfirstlane(F.tid >> 6);
    F.G = gridDim.x; { const int bx = blockIdx.x; F.vcu = (F.G % 8 == 0) ? (bx % 8) * (F.G / 8) + bx / 8 : bx; }
    F.ka = (karg_t)__builtin_amdgcn_kernarg_segment_ptr(); F.ws = args.ws; F.ctl = (gu32*)(args.ws + WS_CTL); F.out = args.out;
    for (int i = F.tid; i < 256; i += NWAVES * 64) F.MISC[i] = 0u;
    __syncthreads();
    const int lo = args.ph_lo, hi = args.ph_hi;
#ifdef DBG_TSEL
    if (blockIdx.x == 0 && threadIdx.x == 0) __hip_atomic_store(F.ctl + CW_DBG + 15, (unsigned)__builtin_amdgcn_s_memrealtime(), RLX_AGENT);
#endif
    XcdBarrier bar; bar.bar = (unsigned*)(F.ctl + CW_BAR); bar.x = 0; bar.st = nullptr;
    if (hi - lo > 1) bar = xcd_barrier_post((unsigned*)(F.ctl + CW_BAR), F.MISC + MW_BAR);
#define IN_(k) (lo <= (k) && (k) < hi)
#ifdef DBG_TSEL
#ifndef DBG_TQ
#define DBG_TQ 50.0f
#endif
#define TSTAMP(k) do { if (blockIdx.x == 0 && threadIdx.x == 0) __hip_atomic_store(F.ctl + CW_DBG + 16 + ((k) == 11 ? 0 : 1 + layer_ * PH_PER_LAYER + (k)), (unsigned)__builtin_amdgcn_s_memrealtime(), RLX_AGENT); } while (0)
#else
#define TSTAMP(k) do { } while (0)
#endif
#ifdef BAR_DUP
#define SEAM(k) do { if (IN_(k) && IN_((k) + 1)) { xcd_barrier(bar); xcd_barrier(bar); } } while (0)
#else
#define SEAM(k) do { if (IN_(k) && IN_((k) + 1)) xcd_barrier(bar); } while (0)
#endif

    if (PH_ON(11) && IN_(0)) { for (int rep_ = 0; rep_ < DUP_N(11); ++rep_) { frame_refresh(F); p0_prologue(F, args); } SEAM(0); { const int layer_ = 0; TSTAMP(11); (void)layer_; } }
#pragma unroll 1
    for (int layer = 0; layer < DEPTH; ++layer) {
        const int pb = 1 + layer * PH_PER_LAYER; const int layer_ = layer; (void)layer_;
        if (PH_ON(0) && IN_(pb + 0)) { for (int rep_ = 0; rep_ < DUP_N(0); ++rep_) { frame_refresh(F);
            { pg8::DenseSched S; S.init(WSP(bf16, WS_XB), WSP(bf16, WS_WIN_T) + (size_t)layer * NUP * D, T, NUP, D, F.G, (int)blockIdx.x);
              pg8::EpiB16 E{WSP(bf16, WS_U), NUP, nullptr, 0.f};
              pg8::gemm_phase<pg8::EpiB16, pg8::DenseSched>(F.lds, F.tid, S, E); }
            if (F.G != 256 || blockIdx.x >= 128)
            { pg8::DenseSched S; if (F.G == 256) S.init(WSP(bf16, WS_PB) + (size_t)layer * T * 256, WSP(bf16, WS_WPP_T) + (size_t)layer * D * 256, T, D, 256, 128, (int)blockIdx.x - 128); else S.init(WSP(bf16, WS_PB) + (size_t)layer * T * 256, WSP(bf16, WS_WPP_T) + (size_t)layer * D * 256, T, D, 256, F.G, (int)blockIdx.x);
              pg8::EpiB16 E{WSP(bf16, WS_PE), D, nullptr, 0.f};
              pg8::gemm_phase<pg8::EpiB16, pg8::DenseSched>(F.lds, F.tid, S, E); }
            } SEAM(pb + 0); TSTAMP(0);
        }
        if (PH_ON(1) && IN_(pb + 1)) { for (int rep_ = 0; rep_ < DUP_N(1); ++rep_) { frame_refresh(F);
            for (int un = F.vcu; un < 1024; un += F.G) { frame_refresh(F); const int ty = un >> 8, r = un & 255, b = r >> 6, c = r & 63;
                if (ty == 0) { ssd_stage1(F, args, layer, b, c); if (ST_DUP & 1) ssd_stage1(F, args, layer, b, c); } else if (ty == 1) { gla_stage1(F, args, layer, b, c); if (ST_DUP & 2) gla_stage1(F, args, layer, b, c); } else if (ty == 2) { mlstm_stage1(F, args, layer, b, c); if (ST_DUP & 4) mlstm_stage1(F, args, layer, b, c); } else { rwkv_stage1(F, args, layer, r); if (ST_DUP & 8) rwkv_stage1(F, args, layer, r); } }
            } SEAM(pb + 1); TSTAMP(1);
        }
        if (PH_ON(2) && IN_(pb + 2)) { for (int rep_ = 0; rep_ < DUP_N(2); ++rep_) { frame_refresh(F);
            if (F.wave == 0) { for (int ws_ = F.vcu; ws_ < 64; ws_ += F.G) rwkv_scan_wave(F, args, ws_);
                if (rep_ == 0) { if (F.G > 64) { if (F.vcu >= 64) scans_elementwise(F, args, (F.vcu - 64) * 64 + F.lane, (F.G - 64) * 64, SCAN_N_MAIN, SCAN_N_ALL); } else scans_elementwise(F, args, F.vcu * 64 + F.lane, F.G * 64, SCAN_N_MAIN, SCAN_N_ALL); } }
            else if (rep_ == 0) scans_elementwise(F, args, F.vcu * 448 + (F.tid - 64), F.G * 448, 0, SCAN_N_MAIN);
            } SEAM(pb + 2); TSTAMP(2);
        }
        if (PH_ON(3) && IN_(pb + 3)) { for (int rep_ = 0; rep_ < DUP_N(3); ++rep_) { frame_refresh(F);
            for (int un = F.vcu; un < 1024; un += F.G) { frame_refresh(F); const int ty = un >> 8, r = un & 255, b = r >> 6, c = r & 63;
                if (ty == 0) { ssd_stage3(F, args, layer, b, c); if (ST_DUP & 16) ssd_stage3(F, args, layer, b, c); } else if (ty == 1) { gla_stage3(F, args, layer, b, c); if (ST_DUP & 32) gla_stage3(F, args, layer, b, c); } else if (ty == 2) { mlstm_stage3(F, args, layer, b, c); if (ST_DUP & 64) mlstm_stage3(F, args, layer, b, c); } else { rwkv_stage3(F, args, layer, r); if (ST_DUP & 128) rwkv_stage3(F, args, layer, r); } }
            } SEAM(pb + 3); TSTAMP(3);
        }
        if (PH_ON(4) && IN_(pb + 4)) { for (int rep_ = 0; rep_ < DUP_N(4); ++rep_) { frame_refresh(F);
#if OUT_FP8 && OUT_CHAIN
            pg8::EpiB16W E{WSP(bf16, WS_Y1), D, WSP(bf16, WS_XB), DN_ALPHA};
            pg8::OutSched S; S.init(WSP(bf16, WS_MIX), (const bf16*)(WSP(unsigned char, WS_WOUT_Q) + (size_t)layer * D * D), T, D, D / 2, F.G, (int)blockIdx.x); S.pan = F.ctl + CW_PAN2 + layer * 1024;
            pg8::gemm_phase<pg8::EpiB16W, pg8::OutSched>(F.lds, F.tid, S, E);
#elif OUT_FP8
            pg8::EpiB16 E{WSP(bf16, WS_Y1), D, WSP(bf16, WS_XB), DN_ALPHA};
            pg8::DenseSched8b S; S.init(WSP(bf16, WS_MIX), (const bf16*)(WSP(unsigned char, WS_WOUT_Q) + (size_t)layer * D * D), T, D, D / 2, F.G, (int)blockIdx.x);
            pg8::gemm_phase<pg8::EpiB16, pg8::DenseSched8b>(F.lds, F.tid, S, E);
#else
            pg8::EpiB16 E{WSP(bf16, WS_Y1), D, WSP(bf16, WS_XB), DN_ALPHA};
            pg8::DenseSched S; S.init(WSP(bf16, WS_MIX), WSP(bf16, WS_WOUT_T) + (size_t)layer * D * D, T, D, D, F.G, (int)blockIdx.x);
            pg8::gemm_phase<pg8::EpiB16, pg8::DenseSched>(F.lds, F.tid, S, E);
#endif
            }
#if OUT_FP8 && OUT_CHAIN && OUT_CHAIN_POLL
            if (!(PH_ON(5) && IN_(pb + 5))) SEAM(pb + 4);
#else
            SEAM(pb + 4);
#endif
            TSTAMP(4);
        }
        if (PH_ON(5) && IN_(pb + 5)) { if (DUP_N(5) == 2) { frame_refresh(F); p6_ln1_router<true>(F, args, layer); } frame_refresh(F); p6_ln1_router<false>(F, args, layer, (OUT_FP8 && OUT_CHAIN && OUT_CHAIN_POLL && PH_ON(4) && IN_(pb + 4)) ? (const gu32*)(F.ctl + CW_PAN2 + layer * 1024) : (const gu32*)nullptr); SEAM(pb + 5); TSTAMP(5); }
        if (PH_ON(6) && IN_(pb + 6)) { for (int rep_ = 0; rep_ < DUP_N(6); ++rep_) { frame_refresh(F);
            moe_build_pfx(F, args, layer, 8);
            pg8::Moe1Sched S; S.O.pfx = F.MISC + MW_PFX; S.O.NT = 8; S.O.G = F.G; S.O.c = (int)blockIdx.x; S.sdest = WSP(int, WS_SDEST); S.bgu = KIN(I_BGU) + (size_t)layer * NE * 2048; S.pan = F.ctl + CW_PAN + layer * (NE * 64 * 16);
            if (MOE_FP8) { S.X = WSP(unsigned char, WS_X1Q); S.W = WSP(unsigned char, WS_WGU_Q) + (size_t)layer * NE * 2048 * D; S.K = D / 2; S.hstepB = (size_t)1024 * D; }
            else { S.X = WSP(unsigned char, WS_X1B); S.W = WSP(unsigned char, WS_WGU_T) + (size_t)layer * NE * 2048 * D * 2; S.K = D; S.hstepB = (size_t)1024 * D * 2; }
            pg8::EpiMoe1 E{WSP(bf16, WS_ABUF), KIN(I_BGU) + (size_t)layer * NE * 2048, WSP(unsigned char, WS_ABUFQ)};
            pg8::gemm_phase<pg8::EpiMoe1, pg8::Moe1Sched>(F.lds, F.tid, S, E);
            }
#if MOE_CHAIN
            if (!(PH_ON(7) && IN_(pb + 7))) SEAM(pb + 6);
#else
            SEAM(pb + 6);
#endif
            TSTAMP(6);
        }
        if (PH_ON(7) && IN_(pb + 7)) { for (int rep_ = 0; rep_ < DUP_N(7); ++rep_) { frame_refresh(F);
            int c2 = (int)blockIdx.x; if (MOE_CHAIN && PH_ON(6) && IN_(pb + 6) && (F.G & 7) == 0) { const int r1 = (int)F.MISC[MW_PFX + 32] % F.G; if ((r1 & 7) == 0) c2 = (c2 - r1 + F.G) % F.G; }
            moe_build_pfx(F, args, layer, 4);
            pg8::Moe2Sched S; S.O.pfx = F.MISC + MW_PFX; S.O.NT = 4; S.O.G = F.G; S.O.c = c2; S.pan = F.ctl + CW_PAN + layer * (NE * 64 * 16); S.tmo = F.ctl + CW_BAR + XB_TMO; S.sdest = WSP(int, WS_SDEST); S.sgate = WSP(float, WS_SGATE); S.bdn = KIN(I_BDN) + (size_t)layer * NE * D; if (MOE2_FP8) { S.Ab = WSP(unsigned char, WS_ABUFQ); S.W = WSP(unsigned char, WS_WDN_Q) + (size_t)layer * NE * D * D; S.K = D / 2; S.hstepB = (size_t)128 * D; }
            else { S.Ab = WSP(unsigned char, WS_ABUF); S.W = WSP(unsigned char, WS_WDN_T) + (size_t)layer * NE * D * D * 2; S.K = D; S.hstepB = (size_t)128 * D * 2; }
            pg8::EpiMoe2 E{WSP(bf16, WS_YBUF), KIN(I_BDN) + (size_t)layer * NE * D, WSP(int, WS_SDEST), WSP(float, WS_SGATE)};
            pg8::gemm_phase<pg8::EpiMoe2, pg8::Moe2Sched>(F.lds, F.tid, S, E);
            } SEAM(pb + 7); TSTAMP(7);
        }
        if (PH_ON(8) && IN_(pb + 8)) { for (int rep_ = 0; rep_ < DUP_N(8); ++rep_) { frame_refresh(F); p9_combine(F, args); } SEAM(pb + 8); TSTAMP(8); }
        if (PH_ON(9) && IN_(pb + 9)) { for (int rep_ = 0; rep_ < DUP_N(9); ++rep_) { frame_refresh(F);
            pg8::EpiPle E{WSP(bf16, WS_H2), WSP(bf16, WS_HB), WSP(bf16, WS_PE)};
#if PLE_FP8
            pg8::DenseSched8 S; S.init((const bf16*)WSP(unsigned char, WS_HQ), (const bf16*)(WSP(unsigned char, WS_WPG_Q) + (size_t)layer * D * D), T, D, D / 2, F.G, (int)blockIdx.x);
            pg8::gemm_phase<pg8::EpiPle, pg8::DenseSched8>(F.lds, F.tid, S, E);
#else
            pg8::DenseSched S; S.init(WSP(bf16, WS_HB), WSP(bf16, WS_WPG_T) + (size_t)layer * D * D, T, D, D, F.G, (int)blockIdx.x);
            pg8::gemm_phase<pg8::EpiPle, pg8::DenseSched>(F.lds, F.tid, S, E);
#endif
            } SEAM(pb + 9); TSTAMP(9);
        }
        if (PH_ON(10) && IN_(pb + 10)) { for (int rep_ = 0; rep_ < DUP_N(10); ++rep_) { frame_refresh(F); p11_ln2(F, args, layer); } SEAM(pb + 10); TSTAMP(10); }
    }
#ifdef DBG_TSEL
    if (hi - lo > 1) { xcd_barrier(bar);
        unsigned ticks = 0u;
        if (DBG_TSEL == 11) ticks = __hip_atomic_load(F.ctl + CW_DBG + 16, RLX_AGENT) - __hip_atomic_load(F.ctl + CW_DBG + 15, RLX_AGENT);
        else for (int l = 0; l < DEPTH; ++l) { const int pi = 1 + l * PH_PER_LAYER + DBG_TSEL; ticks += __hip_atomic_load(F.ctl + CW_DBG + 16 + pi, RLX_AGENT) - __hip_atomic_load(F.ctl + CW_DBG + 16 + pi - 1, RLX_AGENT); }
        const float us = floorf((float)ticks * 0.01f / DBG_TQ) * DBG_TQ; const float code = sqrtf(us * 0.05f);
        for (size_t i = (size_t)blockIdx.x * 512 + threadIdx.x; i < (size_t)T * D; i += (size_t)gridDim.x * 512) F.out[i] = code; }
#endif
#ifdef DBG_SEL
    if (hi - lo > 1) { xcd_barrier(bar);
        const unsigned mx = __hip_atomic_load(F.ctl + CW_DBG, RLX_AGENT), nf = __hip_atomic_load(F.ctl + CW_DBG + 1, RLX_AGENT);
        float code;
        { const float m = __uint_as_float(mx); int b = (m > 0.f) ? (int)floorf(log10f(m)) + 30 : 0; b = b < 0 ? 0 : (b > 60 ? 60 : b); if (nf) b += 100; code = sqrtf(10.0f * (float)(b + 1)); }
        for (size_t i = (size_t)blockIdx.x * 512 + threadIdx.x; i < (size_t)T * D; i += (size_t)gridDim.x * 512) F.out[i] = code; }
#endif
#undef IN_
#undef SEAM
}

extern "C" void kernel_launch(void* const* d_in, const int* in_sizes, int n_in, void* d_out, int out_size, void* d_ws, size_t ws_size, hipStream_t stream) {
    static int grid = 0;
    if (grid == 0) {
        if (n_in != N_IN || out_size != T * D || ws_size < WS_END) { fprintf(stderr, "kernel_launch: unexpected shapes (n_in %d, out %d, ws %zu < %zu); nothing launched\n", n_in, out_size, ws_size, (size_t)WS_END); grid = -1; return; }
        int dev = 0, cus = 0, per_cu = 0;
        if (hipGetDevice(&dev) != hipSuccess || hipDeviceGetAttribute(&cus, hipDeviceAttributeMultiprocessorCount, dev) != hipSuccess) { grid = -1; return; }
        if (hipFuncSetAttribute((const void*)fwd_kernel, hipFuncAttributeMaxDynamicSharedMemorySize, LDS_BYTES) != hipSuccess) { fprintf(stderr, "kernel_launch: hipFuncSetAttribute failed\n"); grid = -1; return; }
        if (hipOccupancyMaxActiveBlocksPerMultiprocessor(&per_cu, (const void*)fwd_kernel, NWAVES * 64, LDS_BYTES) != hipSuccess || per_cu < 1) { fprintf(stderr, "kernel_launch: occupancy query says %d blocks per CU\n", per_cu); }
        (void)hipGetLastError();
        grid = cus;
    }
    if (grid < 0) return;
    (void)hipMemsetAsync((char*)d_ws + WS_CTL, 0, CTL_ZERO_BYTES, stream);
    Args a{};
    for (int i = 0; i < N_IN; ++i) a.in[i] = (const float*)d_in[i];
    a.out = (float*)d_out; a.ws = (unsigned char*)d_ws;
#if MK_PER_PHASE_LAUNCH
    for (int ph = 0; ph < N_PHASES; ++ph) { a.ph_lo = ph; a.ph_hi = ph + 1; hipLaunchKernelGGL(fwd_kernel, dim3(grid), dim3(NWAVES * 64), LDS_BYTES, stream, a); }
#else
    a.ph_lo = 0; a.ph_hi = N_PHASES; hipLaunchKernelGGL(fwd_kernel, dim3(grid), dim3(NWAVES * 64), LDS_BYTES, stream, a);
#endif
    const hipError_t le = hipPeekAtLastError();
    if (le != hipSuccess) fprintf(stderr, "kernel_launch: launch failed: %s\n", hipGetErrorName(le));
}
```
